# Optimizing an MI355X kernel written in HIP

```python
import jax, jax.numpy as jnp
from jax import lax
import numpy as np

D_MODEL = 1024
BATCH = 4
SEQ = 8192
DEPTH = 1

N_HEADS_A = 8
N_KV_GROUPS = 2
HEADS_PER_GROUP = N_HEADS_A // N_KV_GROUPS
HEAD_DIM = 64
L_CMP = 32
D_CMP = 16
CMP_HIDDEN = 256
L_SLC = 64
N_SELECT = 16
WINDOW = 512
Q_BLOCK = 128
ROPE_THETA = 10000.0
FORCE_SCORE = 1e4
NEG_INF = -1e30
N_HEADS_B = 8
HEAD_DIM_B = 64
W_LORA = 64
A_LORA = 64
G_LORA = 128
GN_EPS = 64e-5
N_GROUPS = 4
EXPERTS_PER_GROUP = 8
N_EXPERTS = N_GROUPS * EXPERTS_PER_GROUP
TOP_K = 2
D_EXPERT = 256
MOE_BLOCK = 256
RMS_EPS = 1e-6
WIDTH_A = N_HEADS_A * HEAD_DIM
KV_WIDTH = N_KV_GROUPS * HEAD_DIM
WIDTH_B = N_HEADS_B * HEAD_DIM_B
C_RWKV = 3 * WIDTH_B + W_LORA + A_LORA + G_LORA
C_IN = WIDTH_A + 6 * KV_WIDTH + 3 * N_HEADS_A + C_RWKV + 2 * D_MODEL

kernel_name = "hybrid_nsa_rwkv7_hiermoe"


def rms_norm(x, g):
    xf = x.astype(jnp.float32)
    y = xf * lax.rsqrt(jnp.mean(xf * xf, axis=-1, keepdims=True) + RMS_EPS)
    return (y * g.astype(jnp.float32)).astype(x.dtype)


def rope(x, pos):
    half = x.shape[-1] // 2
    freqs = jnp.power(ROPE_THETA, -jnp.arange(half, dtype=jnp.float32) / half)
    ang = pos.astype(jnp.float32)[..., None] * freqs
    cos, sin = jnp.cos(ang)[:, :, None, :], jnp.sin(ang)[:, :, None, :]
    xf = x.astype(jnp.float32)
    x1, x2 = xf[..., :half], xf[..., half:]
    return jnp.concatenate([x1 * cos - x2 * sin, x1 * sin + x2 * cos], axis=-1).astype(x.dtype)


def masked_softmax(s, valid):
    p = jax.nn.softmax(jnp.where(valid, s, NEG_INF), axis=-1)
    return jnp.where(valid, p, 0.0)


def compress(kv, pe, w1, b1, w2, b2):
    bsz, s = kv.shape[:2]
    n_cmp = (s - L_CMP) // D_CMP + 1
    idx = np.arange(n_cmp)[:, None] * D_CMP + np.arange(L_CMP)[None, :]
    blk = kv[:, idx] + pe[:, None, :]
    blk = blk.transpose(0, 1, 3, 2, 4).reshape(bsz, n_cmp, N_KV_GROUPS, L_CMP * HEAD_DIM)
    return jax.nn.gelu(blk @ w1 + b1) @ w2 + b2


def nsa_mixer(q, k_c, v_c, k_slc, v_slc, k_win, v_win, gates):
    bsz, s = q.shape[:2]
    n_cmp = k_c.shape[1]
    n_slc = s // L_SLC
    n_top = min(N_SELECT, n_slc)
    scale = HEAD_DIM ** -0.5
    f32 = jnp.float32
    cmp_end = jnp.arange(n_cmp) * D_CMP + (L_CMP - 1)
    ii = np.arange(n_cmp)[:, None]
    jj = np.arange(n_slc)[None, :]
    overlap = jnp.asarray((ii * D_CMP < (jj + 1) * L_SLC) & (ii * D_CMP + L_CMP > jj * L_SLC), f32)
    blk_ids = jnp.arange(n_slc)
    ks_blk = k_slc.reshape(bsz, n_slc, L_SLC, N_KV_GROUPS, HEAD_DIM).transpose(0, 3, 1, 2, 4)
    vs_blk = v_slc.reshape(bsz, n_slc, L_SLC, N_KV_GROUPS, HEAD_DIM).transpose(0, 3, 1, 2, 4)
    pad = ((0, 0), (WINDOW, 0), (0, 0), (0, 0))
    kw_pad, vw_pad = jnp.pad(k_win, pad), jnp.pad(v_win, pad)
    bi = jnp.arange(bsz)[:, None, None, None]
    gi = jnp.arange(N_KV_GROUPS)[None, :, None, None]
    v_c32 = v_c.astype(f32)

    def block(qb_i):
        s0 = qb_i * Q_BLOCK
        t = s0 + jnp.arange(Q_BLOCK)
        qb = lax.dynamic_slice_in_dim(q, s0, Q_BLOCK, axis=1).reshape(
            bsz, Q_BLOCK, N_KV_GROUPS, HEADS_PER_GROUP, HEAD_DIM)
        gb = jax.nn.sigmoid(lax.dynamic_slice_in_dim(gates, s0, Q_BLOCK, axis=1).astype(f32)).reshape(
            bsz, Q_BLOCK, N_KV_GROUPS, HEADS_PER_GROUP, 3)
        s_c = jnp.einsum('bqghd,bngd->bghqn', qb, k_c, preferred_element_type=f32) * scale
        p_c = masked_softmax(s_c, cmp_end[None, :] <= t[:, None])
        o_c = jnp.einsum('bghqn,bngd->bqghd', p_c, v_c32)
        imp = jnp.einsum('bghqn,nj->bgqj', p_c, overlap)
        cur = t // L_SLC
        valid_s = blk_ids[None, :] <= cur[:, None]
        forced = (blk_ids[None, :] == 0) | (blk_ids[None, :] == cur[:, None]) | (blk_ids[None, :] == cur[:, None] - 1)
        score = jnp.where(forced, FORCE_SCORE, jnp.where(valid_s, imp, -1.0))
        _, sel = lax.top_k(score, n_top)
        k_sel = ks_blk[bi, gi, sel].reshape(bsz, N_KV_GROUPS, Q_BLOCK, n_top * L_SLC, HEAD_DIM)
        v_sel = vs_blk[bi, gi, sel].reshape(bsz, N_KV_GROUPS, Q_BLOCK, n_top * L_SLC, HEAD_DIM)
        pos_sel = (sel[..., None] * L_SLC + jnp.arange(L_SLC)).reshape(bsz, N_KV_GROUPS, Q_BLOCK, n_top * L_SLC)
        s_s = jnp.einsum('bqghd,bgqkd->bghqk', qb, k_sel, preferred_element_type=f32) * scale
        p_s = masked_softmax(s_s, (pos_sel <= t[:, None])[:, :, None])
        o_s = jnp.einsum('bghqk,bgqkd->bqghd', p_s, v_sel.astype(f32))
        kw = lax.dynamic_slice_in_dim(kw_pad, s0, WINDOW + Q_BLOCK, axis=1)
        vw = lax.dynamic_slice_in_dim(vw_pad, s0, WINDOW + Q_BLOCK, axis=1)
        pos_w = s0 - WINDOW + jnp.arange(WINDOW + Q_BLOCK)
        valid_w = (pos_w[None, :] <= t[:, None]) & (pos_w[None, :] > t[:, None] - WINDOW) & (pos_w[None, :] >= 0)
        s_w = jnp.einsum('bqghd,bkgd->bghqk', qb, kw, preferred_element_type=f32) * scale
        p_w = masked_softmax(s_w, valid_w)
        o_w = jnp.einsum('bghqk,bkgd->bqghd', p_w, vw.astype(f32))
        o = gb[..., 0:1] * o_c + gb[..., 1:2] * o_s + gb[..., 2:3] * o_w
        return o.reshape(bsz, Q_BLOCK, WIDTH_A).astype(q.dtype)

    out = lax.map(block, jnp.arange(s // Q_BLOCK))
    return out.transpose(1, 0, 2, 3).reshape(bsz, s, WIDTH_A)


def rwkv7_mixer(p, mu, w0, w2, a0, a2, g2, k_k, k_a, r_k, ln_w, ln_b):
    bsz, s = p.shape[:2]
    f32 = jnp.float32
    p_prev = jnp.pad(p[:, :-1], ((0, 0), (1, 0), (0, 0)))
    xs = p + (p_prev - p) * mu
    r, k, v, xw, xa, xg = jnp.split(xs, np.cumsum([WIDTH_B, WIDTH_B, WIDTH_B, W_LORA, A_LORA]), axis=-1)
    w_log = -jax.nn.softplus(-(w0 + jnp.tanh(xw) @ w2)) - 0.5
    decay = jnp.exp(-jnp.exp(w_log.astype(f32)))
    a = jax.nn.sigmoid(a0 + xa @ a2)
    g = jax.nn.sigmoid(xg) @ g2
    heads = lambda z: z.reshape(bsz, s, N_HEADS_B, HEAD_DIM_B).astype(f32)
    kk = heads(k * k_k)
    kk = kk / jnp.maximum(jnp.linalg.norm(kk, axis=-1, keepdims=True), 1e-12)
    k = k * (1 + (a - 1) * k_a)
    rh, kh, vh, ah, wh = heads(r), heads(k), heads(v), heads(a), heads(decay)

    def step(state, inp):
        r_t, w_t, k_t, v_t, kk_t, a_t = inp
        sa = jnp.einsum('bhvk,bhk->bhv', state, -kk_t)
        state = state * w_t[:, :, None, :] + sa[..., None] * (kk_t * a_t)[:, :, None, :] \
            + v_t[..., None] * k_t[:, :, None, :]
        return state, jnp.einsum('bhvk,bhk->bhv', state, r_t)

    tm = lambda z: jnp.swapaxes(z, 0, 1)
    state0 = jnp.zeros((bsz, N_HEADS_B, HEAD_DIM_B, HEAD_DIM_B), f32)
    _, y = lax.scan(step, state0, (tm(rh), tm(wh), tm(kh), tm(vh), tm(kk), tm(ah)))
    y = tm(y)
    mean = jnp.mean(y, axis=-1, keepdims=True)
    var = jnp.mean(jnp.square(y - mean), axis=-1, keepdims=True)
    y = ((y - mean) * lax.rsqrt(var + GN_EPS)).reshape(bsz, s, WIDTH_B) * ln_w + ln_b
    bonus = jnp.sum(rh * kh * r_k, axis=-1, keepdims=True) * vh
    y = y + bonus.reshape(bsz, s, WIDTH_B)
    return (y * g).astype(p.dtype)


def hier_moe(h, w_grp, b_grp, w_exp, b_exp, e_w1, e_w3, e_w2):
    bsz, s, d = h.shape
    n_tok = bsz * s
    f32 = jnp.float32
    t = h.reshape(n_tok, d)
    grp_logits = (t @ w_grp + b_grp).astype(f32)
    p_grp = jax.nn.softmax(grp_logits, axis=-1)
    g_star = jnp.argmax(grp_logits, axis=-1)
    p_g = jnp.take_along_axis(p_grp, g_star[:, None], axis=1)[:, 0]
    exp_logits = (t @ w_exp + b_exp).astype(f32).reshape(n_tok, N_GROUPS, EXPERTS_PER_GROUP)
    in_grp = jnp.take_along_axis(exp_logits, g_star[:, None, None], axis=1)[:, 0]
    top_p, top_j = lax.top_k(jax.nn.softmax(in_grp, axis=-1), TOP_K)
    gate = p_g[:, None] * top_p / jnp.sum(top_p, axis=-1, keepdims=True)
    expert = g_star[:, None] * EXPERTS_PER_GROUP + top_j
    n_asg = n_tok * TOP_K
    e_flat = expert.reshape(n_asg)
    tok_flat = jnp.repeat(jnp.arange(n_tok), TOP_K)
    gate_flat = gate.reshape(n_asg)
    order = jnp.argsort(e_flat)
    e_sorted = e_flat[order]
    counts = jnp.bincount(e_flat, length=N_EXPERTS)
    padded = (counts + MOE_BLOCK - 1) // MOE_BLOCK * MOE_BLOCK
    pad_end = jnp.cumsum(padded)
    pad_start = pad_end - padded
    start = jnp.cumsum(counts) - counts
    dest = pad_start[e_sorted] + (jnp.arange(n_asg) - start[e_sorted])
    n_pad = n_asg + N_EXPERTS * MOE_BLOCK
    buf_tok = jnp.zeros((n_pad,), jnp.int32).at[dest].set(tok_flat[order].astype(jnp.int32))
    buf_gate = jnp.zeros((n_pad,), f32).at[dest].set(gate_flat[order])
    n_blk = n_pad // MOE_BLOCK
    blk_expert = jnp.minimum(jnp.searchsorted(pad_end, jnp.arange(n_blk) * MOE_BLOCK, side='right'), N_EXPERTS - 1)

    def run_block(args):
        tok_idx, g_b, e = args
        xb = t[tok_idx]
        hid = jax.nn.silu(xb @ e_w1[e]) * (xb @ e_w3[e])
        return ((hid @ e_w2[e]) * g_b[:, None]).astype(t.dtype)

    y = lax.map(run_block, (buf_tok.reshape(n_blk, MOE_BLOCK), buf_gate.reshape(n_blk, MOE_BLOCK), blk_expert))
    out = jax.ops.segment_sum(y.reshape(n_pad, d), buf_tok, num_segments=n_tok)
    return out.reshape(bsz, s, d).astype(h.dtype)


def setup_inputs(seed: int = 0) -> dict:
    key = jax.random.key(seed)
    ks = iter(jax.random.split(key, 48))
    f32 = jnp.float32
    nrm = lambda shape, sc: jax.random.normal(next(ks), shape, f32) * sc
    gain = lambda shape: 1.0 + nrm(shape, 0.02)
    L = DEPTH
    inp = {}
    inp['x'] = nrm((BATCH, SEQ, D_MODEL), 1.0)
    inp['positions'] = jnp.broadcast_to(jnp.arange(SEQ, dtype=jnp.int32), (BATCH, SEQ))
    inp['g_mix'] = gain((L, D_MODEL))
    inp['w_in'] = nrm((L, D_MODEL, C_IN), D_MODEL ** -0.5)
    for nm in ('k', 'v'):
        inp['cmp_pe_' + nm] = nrm((L, L_CMP, HEAD_DIM), 0.1)
        inp['cmp_w1_' + nm] = nrm((L, L_CMP * HEAD_DIM, CMP_HIDDEN), (L_CMP * HEAD_DIM) ** -0.5)
        inp['cmp_b1_' + nm] = nrm((L, CMP_HIDDEN), 0.02)
        inp['cmp_w2_' + nm] = nrm((L, CMP_HIDDEN, HEAD_DIM), CMP_HIDDEN ** -0.5)
        inp['cmp_b2_' + nm] = nrm((L, HEAD_DIM), 0.02)
    inp['rwkv_mu'] = jax.random.uniform(next(ks), (L, C_RWKV), f32)
    inp['rwkv_w0'] = jax.random.uniform(next(ks), (L, WIDTH_B), f32, -5.0, 1.0)
    inp['rwkv_w2'] = nrm((L, W_LORA, WIDTH_B), W_LORA ** -0.5)
    inp['rwkv_a0'] = nrm((L, WIDTH_B), 0.5)
    inp['rwkv_a2'] = nrm((L, A_LORA, WIDTH_B), A_LORA ** -0.5)
    inp['rwkv_g2'] = nrm((L, G_LORA, WIDTH_B), G_LORA ** -0.5)
    inp['rwkv_k_k'] = 0.85 + nrm((L, WIDTH_B), 0.05)
    inp['rwkv_k_a'] = 1.0 + nrm((L, WIDTH_B), 0.05)
    inp['rwkv_r_k'] = nrm((L, N_HEADS_B, HEAD_DIM_B), 0.1)
    inp['rwkv_ln_w'] = gain((L, WIDTH_B))
    inp['rwkv_ln_b'] = nrm((L, WIDTH_B), 0.02)
    inp['w_proj_a'] = nrm((L, WIDTH_A, D_MODEL), WIDTH_A ** -0.5)
    inp['w_proj_b'] = nrm((L, WIDTH_B, D_MODEL), WIDTH_B ** -0.5)
    inp['w_out'] = nrm((L, D_MODEL, D_MODEL), D_MODEL ** -0.5)
    inp['g_ffn'] = gain((L, D_MODEL))
    inp['w_grp'] = nrm((L, D_MODEL, N_GROUPS), D_MODEL ** -0.5)
    inp['b_grp'] = nrm((L, N_GROUPS), 0.01)
    inp['w_exp'] = nrm((L, D_MODEL, N_EXPERTS), D_MODEL ** -0.5)
    inp['b_exp'] = nrm((L, N_EXPERTS), 0.01)
    inp['e_w1'] = nrm((L, N_EXPERTS, D_MODEL, D_EXPERT), D_MODEL ** -0.5)
    inp['e_w3'] = nrm((L, N_EXPERTS, D_MODEL, D_EXPERT), D_MODEL ** -0.5)
    inp['e_w2'] = nrm((L, N_EXPERTS, D_EXPERT, D_MODEL), D_EXPERT ** -0.5)
    inp['g_final'] = gain((D_MODEL,))
    return inp


def reference(x, positions, g_mix, w_in,
              cmp_pe_k, cmp_w1_k, cmp_b1_k, cmp_w2_k, cmp_b2_k,
              cmp_pe_v, cmp_w1_v, cmp_b1_v, cmp_w2_v, cmp_b2_v,
              rwkv_mu, rwkv_w0, rwkv_w2, rwkv_a0, rwkv_a2, rwkv_g2,
              rwkv_k_k, rwkv_k_a, rwkv_r_k, rwkv_ln_w, rwkv_ln_b,
              w_proj_a, w_proj_b, w_out, g_ffn,
              w_grp, b_grp, w_exp, b_exp, e_w1, e_w3, e_w2, g_final):
    bsz, s, _ = x.shape
    splits = np.cumsum([WIDTH_A] + [KV_WIDTH] * 6 + [3 * N_HEADS_A, C_RWKV, D_MODEL])
    for l in range(DEPTH):
        h = rms_norm(x, g_mix[l])
        p = h @ w_in[l]
        q, kc, vc, ksl, vsl, kwn, vwn, nsa_g, p_rwkv, gate_a, gate_b = jnp.split(p, splits, axis=-1)
        hd = lambda z, n: z.reshape(bsz, s, n, HEAD_DIM)
        q = rope(hd(q, N_HEADS_A), positions)
        kc = rope(hd(kc, N_KV_GROUPS), positions)
        ksl = rope(hd(ksl, N_KV_GROUPS), positions)
        kwn = rope(hd(kwn, N_KV_GROUPS), positions)
        vc, vsl, vwn = hd(vc, N_KV_GROUPS), hd(vsl, N_KV_GROUPS), hd(vwn, N_KV_GROUPS)
        k_c = compress(kc, cmp_pe_k[l], cmp_w1_k[l], cmp_b1_k[l], cmp_w2_k[l], cmp_b2_k[l])
        v_c = compress(vc, cmp_pe_v[l], cmp_w1_v[l], cmp_b1_v[l], cmp_w2_v[l], cmp_b2_v[l])
        o_a = nsa_mixer(q, k_c, v_c, ksl, vsl, kwn, vwn, nsa_g.reshape(bsz, s, N_HEADS_A, 3))
        o_b = rwkv7_mixer(p_rwkv, rwkv_mu[l], rwkv_w0[l], rwkv_w2[l], rwkv_a0[l], rwkv_a2[l], rwkv_g2[l],
                          rwkv_k_k[l], rwkv_k_a[l], rwkv_r_k[l], rwkv_ln_w[l], rwkv_ln_b[l])
        merged = jax.nn.sigmoid(gate_a) * (o_a @ w_proj_a[l]) + jax.nn.sigmoid(gate_b) * (o_b @ w_proj_b[l])
        x = x + merged @ w_out[l]
        h2 = rms_norm(x, g_ffn[l])
        x = x + hier_moe(h2, w_grp[l], b_grp[l], w_exp[l], b_exp[l], e_w1[l], e_w3[l], e_w2[l])
    return rms_norm(x, g_final)
```

```cpp
#include <hip/hip_runtime.h>
#include <stdint.h>

typedef unsigned short u16;
using bf16x8 = __attribute__((ext_vector_type(8))) short;
using f32x4  = __attribute__((ext_vector_type(4))) float;

#ifndef PROBE
#define PROBE 0
#endif
#ifndef MEGA
#define MEGA 1
#endif
#ifndef GEMM_NAIVE
#define GEMM_NAIVE 0
#endif

constexpr int B_ = 4, S_ = 8192, D_ = 1024, NTOK = B_ * S_;
constexpr int CIN = 5144;
constexpr int NCMP = 511;
constexpr int CRW = 1792;
constexpr int NEXP = 32;
constexpr int NTHREADS = 256;
constexpr int SMEM_BYTES = 65536;

struct P {
    const float* x; const int* pos; const float* g_mix; const float* w_in;
    const float *pe_k, *w1_k, *b1_k, *w2_k, *b2_k, *pe_v, *w1_v, *b1_v, *w2_v, *b2_v;
    const float *mu, *w0, *w2, *a0, *a2, *g2, *k_k, *k_a, *r_k, *ln_w, *ln_b;
    const float *wpa, *wpb, *wout, *g_ffn, *w_grp, *b_grp, *w_exp, *b_exp, *e_w1, *e_w3, *e_w2, *g_final;
    float* out;
    u16* hbuf; float* rope; u16 *q, *kc, *vc, *ksl, *vsl, *kwn, *vwn; float* nsag; u16* prw;
    float *kcmp, *vcmp; float* wdec; u16 *av, *gv; u16 *oa, *ob; u16* merged; float* x1;
    int* tok_e; float* tok_gate; int* tokslot; int* list_tok; float* list_gate;
    int* counts; int* offs; int* cursor; int* blk_e; int* blk_r0; int* nblk;
    u16* hid; u16* ybuf; unsigned* bar;
};

__device__ __forceinline__ u16 f2bf(float f) { unsigned u = __float_as_uint(f); u += 0x7FFFu + ((u >> 16) & 1u); return (u16)(u >> 16); }
__device__ __forceinline__ float bf2f(u16 h) { return __uint_as_float(((unsigned)h) << 16); }
__device__ __forceinline__ unsigned pack2(float a, float b) { return (unsigned)f2bf(a) | ((unsigned)f2bf(b) << 16); }
__device__ __forceinline__ float sigmoidf_(float x) { return 1.f / (1.f + __expf(-x)); }
__device__ __forceinline__ float wave_sum(float v) {
#pragma unroll
    for (int o = 32; o > 0; o >>= 1) v += __shfl_xor(v, o, 64);
    return v;
}
__device__ __forceinline__ float wave_max(float v) {
#pragma unroll
    for (int o = 32; o > 0; o >>= 1) v = fmaxf(v, __shfl_xor(v, o, 64));
    return v;
}

#define MFMA16(acc, a, b) asm volatile("s_nop 1\n\tv_mfma_f32_16x16x32_bf16 %0, %1, %2, %0" : "+v"(acc) : "v"(a), "v"(b))
template <class AL, class BL>
__device__ __forceinline__ void gemm_tile64(int K, AL aload, BL bload, f32x4 (&acc)[4], u16* As, u16* Bs) {
    const int tid = threadIdx.x, lane = tid & 63, wv = tid >> 6;
#pragma unroll
    for (int i = 0; i < 4; i++) acc[i] = f32x4{0.f, 0.f, 0.f, 0.f};
    for (int k0 = 0; k0 < K; k0 += 32) {
        {
            const int r = tid >> 2, kc = (tid & 3) * 8;
            uint4 v = aload(r, k0 + kc);
            *(uint4*)&As[r * 40 + kc] = v;
        }
        {
            const int n = tid & 63, kq = (tid >> 6) * 8;
            uint4 v;
            v.x = pack2(bload(k0 + kq + 0, n), bload(k0 + kq + 1, n));
            v.y = pack2(bload(k0 + kq + 2, n), bload(k0 + kq + 3, n));
            v.z = pack2(bload(k0 + kq + 4, n), bload(k0 + kq + 5, n));
            v.w = pack2(bload(k0 + kq + 6, n), bload(k0 + kq + 7, n));
            *(uint4*)&Bs[n * 40 + kq] = v;
        }
        __syncthreads();
#if GEMM_NAIVE
#pragma unroll
        for (int n = 0; n < 4; n++)
#pragma unroll
            for (int j = 0; j < 4; j++) {
                const int row = wv * 16 + (lane >> 4) * 4 + j, col = n * 16 + (lane & 15);
                float s = 0.f;
                for (int kk = 0; kk < 32; kk++) s += bf2f(As[row * 40 + kk]) * bf2f(Bs[col * 40 + kk]);
                acc[n][j] += s;
            }
#else
        {
            bf16x8 a, b0, b1, b2, b3;
#pragma unroll
            for (int j = 0; j < 8; j++) {
                a[j]  = (short)As[(wv * 16 + (lane & 15)) * 40 + (lane >> 4) * 8 + j];
                b0[j] = (short)Bs[(0 * 16 + (lane & 15)) * 40 + (lane >> 4) * 8 + j];
                b1[j] = (short)Bs[(1 * 16 + (lane & 15)) * 40 + (lane >> 4) * 8 + j];
                b2[j] = (short)Bs[(2 * 16 + (lane & 15)) * 40 + (lane >> 4) * 8 + j];
                b3[j] = (short)Bs[(3 * 16 + (lane & 15)) * 40 + (lane >> 4) * 8 + j];
            }
            MFMA16(acc[0], a, b0); MFMA16(acc[1], a, b1); MFMA16(acc[2], a, b2); MFMA16(acc[3], a, b3);
        }
#endif
        __syncthreads();
    }
#if !GEMM_NAIVE
    asm volatile("s_nop 15\n\ts_nop 15" : "+v"(acc[0]), "+v"(acc[1]), "+v"(acc[2]), "+v"(acc[3]));
#endif
}

__constant__ double ROPE_FREQ[32] = {
    1.00000000000000000000e+00, 7.49894209332455874417e-01, 5.62341325190349072827e-01, 4.21696503428582225581e-01,
    3.16227766016837941176e-01, 2.37137370566165517349e-01, 1.77827941003892292526e-01, 1.33352143216332402753e-01,
    1.00000000000000005551e-01, 7.49894209332455791150e-02, 5.62341325190349114460e-02, 4.21696503428582239459e-02,
    3.16227766016837913421e-02, 2.37137370566165538166e-02, 1.77827941003892292526e-02, 1.33352143216332406223e-02,
    1.00000000000000002082e-02, 7.49894209332455791150e-03, 5.62341325190349097113e-03, 4.21696503428582291501e-03,
    3.16227766016837939442e-03, 2.37137370566165538166e-03, 1.77827941003892275179e-03, 1.33352143216332406223e-03,
    1.00000000000000002082e-03, 7.49894209332455856203e-04, 5.62341325190349097113e-04, 4.21696503428582237290e-04,
    3.16227766016837939442e-04, 2.37137370566165538166e-04, 1.77827941003892269758e-04, 1.33352143216332395381e-04};
__device__ void ph_prologue(const P& p, int bid, int nb, char* smem) {
    const int tid = threadIdx.x, lane = tid & 63, wv = tid >> 6;
    if (bid == 0 && tid < 64) {
        if (tid < 32) { p.counts[tid] = 0; p.cursor[tid] = 0; }
    }
    for (int row = bid * 4 + wv; row < NTOK; row += nb * 4) {
        const float* xr = p.x + (size_t)row * D_;
        float v[16];
        float ss = 0.f;
#pragma unroll
        for (int i = 0; i < 4; i++) {
            float4 t = *(const float4*)&xr[i * 256 + lane * 4];
            v[4 * i] = t.x; v[4 * i + 1] = t.y; v[4 * i + 2] = t.z; v[4 * i + 3] = t.w;
            ss += t.x * t.x + t.y * t.y + t.z * t.z + t.w * t.w;
        }
        ss = wave_sum(ss);
        const float rs = rsqrtf(ss * (1.f / D_) + 1e-6f);
#pragma unroll
        for (int i = 0; i < 4; i++) {
            const int c = i * 256 + lane * 4;
            float4 g = *(const float4*)&p.g_mix[c];
            uint2 o;
            o.x = pack2(v[4 * i] * rs * g.x, v[4 * i + 1] * rs * g.y);
            o.y = pack2(v[4 * i + 2] * rs * g.z, v[4 * i + 3] * rs * g.w);
            *(uint2*)&p.hbuf[(size_t)row * D_ + c] = o;
        }
    }
}

__device__ void ph_inproj(const P& p, int bid, int nb, char* smem) {
    u16* As = (u16*)smem; u16* Bs = As + 64 * 40;
    const int tid = threadIdx.x, lane = tid & 63, wv = tid >> 6;
    constexpr int NCT = (3096 + 63) / 64;
    const int nitems = (NTOK / 64) * NCT;
    for (int it = bid; it < nitems; it += nb) {
        const int rt = it / NCT, ct = it % NCT;
        const int r0 = rt * 64, c0 = ct * 64;
        f32x4 acc[4];
#if PROBE == 2
        auto aload = [&](int r, int k) -> uint4 {
            const float4 f0 = *(const float4*)&p.x[(size_t)(r0 + r) * D_ + k], f1 = *(const float4*)&p.x[(size_t)(r0 + r) * D_ + k + 4];
            uint4 v; v.x = pack2(f0.x, f0.y); v.y = pack2(f0.z, f0.w); v.z = pack2(f1.x, f1.y); v.w = pack2(f1.z, f1.w); return v; };
#else
        auto aload = [&](int r, int k) -> uint4 { return *(const uint4*)&p.hbuf[(size_t)(r0 + r) * D_ + k]; };
#endif
        auto bload = [&](int k, int n) -> float { return p.w_in[(size_t)k * CIN + c0 + n]; };
        gemm_tile64(D_, aload, bload, acc, As, Bs);
        if (c0 < 1280) {
            u16* dst; int stride, cb; bool rope;
            if (c0 < 512)       { dst = p.q;   stride = 512; cb = c0;        rope = true; }
            else if (c0 < 640)  { dst = p.kc;  stride = 128; cb = c0 - 512;  rope = true; }
            else if (c0 < 768)  { dst = p.vc;  stride = 128; cb = c0 - 640;  rope = false; }
            else if (c0 < 896)  { dst = p.ksl; stride = 128; cb = c0 - 768;  rope = true; }
            else if (c0 < 1024) { dst = p.vsl; stride = 128; cb = c0 - 896;  rope = false; }
            else if (c0 < 1152) { dst = p.kwn; stride = 128; cb = c0 - 1024; rope = true; }
            else                { dst = p.vwn; stride = 128; cb = c0 - 1152; rope = false; }
#pragma unroll
            for (int j = 0; j < 4; j++) {
                const int row = r0 + wv * 16 + (lane >> 4) * 4 + j;
#pragma unroll
                for (int n = 0; n < 2; n++) {
                    const int d = n * 16 + (lane & 15);
                    float x1 = acc[n][j], x2 = acc[n + 2][j];
                    float o1 = x1, o2 = x2;
                    if (rope) {
                        const double ang = (double)p.pos[row] * ROPE_FREQ[d];
                        const double kq = rint(ang * 0.15915494309189535);
                        const float rr = (float)(fma(-kq, 6.283185307179586, ang) - kq * 2.4492935982947064e-16);
                        const float cs = cosf(rr), sn = sinf(rr);
                        o1 = x1 * cs - x2 * sn; o2 = x1 * sn + x2 * cs;
                    }
                    dst[(size_t)row * stride + cb + d] = f2bf(o1);
                    dst[(size_t)row * stride + cb + d + 32] = f2bf(o2);
                }
            }
        } else {
#pragma unroll
            for (int j = 0; j < 4; j++) {
                const int row = r0 + wv * 16 + (lane >> 4) * 4 + j;
#pragma unroll
                for (int n = 0; n < 4; n++) {
                    const int gc = c0 + n * 16 + (lane & 15);
                    const float v = acc[n][j];
                    if (gc < 1304) p.nsag[(size_t)row * 24 + (gc - 1280)] = sigmoidf_(v);
                    else if (gc < 3096) p.prw[(size_t)row * CRW + (gc - 1304)] = f2bf(v);
                }
            }
        }
    }
}

__device__ __forceinline__ float gelu_tanh(float x) {
    const float c = 0.7978845608028654f;
    return 0.5f * x * (1.f + tanhf(c * (x + 0.044715f * x * x * x)));
}
__device__ void ph_compress(const P& p, int bid, int nb, char* smem) {
    float* blk = (float*)smem; float* hid = blk + 2048;
    const int tid = threadIdx.x;
    const int nitems = 2 * B_ * NCMP * 2;
    for (int it = bid; it < nitems; it += nb) {
        int t = it;
        const int g = t & 1; t >>= 1;
        const int i = t % NCMP; t /= NCMP;
        const int b = t & 3; const int kv = t >> 2;
        const u16* src = kv ? p.vc : p.kc;
        const float* pe = kv ? p.pe_v : p.pe_k;
        const float* w1 = kv ? p.w1_v : p.w1_k;
        const float* b1 = kv ? p.b1_v : p.b1_k;
        const float* w2 = kv ? p.w2_v : p.w2_k;
        const float* b2 = kv ? p.b2_v : p.b2_k;
        float* dst = kv ? p.vcmp : p.kcmp;
        __syncthreads();
        for (int e = tid; e < 2048; e += NTHREADS) {
            const int l = e >> 6, d = e & 63;
            blk[e] = bf2f(src[(size_t)(b * S_ + 16 * i + l) * 128 + g * 64 + d]) + pe[e];
        }
        __syncthreads();
        {
            float a0 = 0.f, a1 = 0.f, a2 = 0.f, a3 = 0.f;
#pragma unroll 2
            for (int e = 0; e < 2048; e += 4) {
                a0 += blk[e] * w1[(size_t)e * 256 + tid];
                a1 += blk[e + 1] * w1[(size_t)(e + 1) * 256 + tid];
                a2 += blk[e + 2] * w1[(size_t)(e + 2) * 256 + tid];
                a3 += blk[e + 3] * w1[(size_t)(e + 3) * 256 + tid];
            }
            hid[tid] = gelu_tanh(b1[tid] + (a0 + a1) + (a2 + a3));
        }
        __syncthreads();
        if (tid < 64) {
            float a = b2[tid];
#pragma unroll 4
            for (int j = 0; j < 256; j++) a += hid[j] * w2[j * 64 + tid];
            dst[((size_t)(b * NCMP + i) * 2 + g) * 64 + tid] = a;
        }
    }
}

__device__ void ph_rwkv_pre(const P& p, int bid, int nb, char* smem) {
    float* hw = (float*)smem; float* ha = hw + 64; float* hg = ha + 64;
    const int tid = threadIdx.x;
    for (int n = bid; n < NTOK; n += nb) {
        const int t = n & (S_ - 1);
        __syncthreads();
        {
            const int c = 1536 + tid;
            const float cur = bf2f(p.prw[(size_t)n * CRW + c]);
            const float prev = (t > 0) ? bf2f(p.prw[(size_t)(n - 1) * CRW + c]) : 0.f;
            const float xs = cur + (prev - cur) * p.mu[c];
            if (tid < 64) hw[tid] = tanhf(xs);
            else if (tid < 128) ha[tid - 64] = xs;
            else hg[tid - 128] = sigmoidf_(xs);
        }
        __syncthreads();
#pragma unroll 1
        for (int rep = 0; rep < 2; rep++) {
            const int c = tid + rep * 256;
            float wl = p.w0[c], al = p.a0[c], gl = 0.f;
#pragma unroll 4
            for (int j = 0; j < 64; j++) { wl += hw[j] * p.w2[j * 512 + c]; al += ha[j] * p.a2[j * 512 + c]; }
#pragma unroll 4
            for (int j = 0; j < 128; j++) gl += hg[j] * p.g2[j * 512 + c];
            const float z = -wl;
            const float sp = fmaxf(z, 0.f) + log1pf(__expf(-fabsf(z)));
            const float wlog = -sp - 0.5f;
            p.wdec[(size_t)n * 512 + c] = __expf(-__expf(wlog));
            p.av[(size_t)n * 512 + c] = f2bf(sigmoidf_(al));
            p.gv[(size_t)n * 512 + c] = f2bf(gl);
        }
    }
}

__device__ __forceinline__ float dot64_bf(const float* qs, const u16* krow) {
    float s = 0.f;
#pragma unroll
    for (int c = 0; c < 8; c++) {
        uint4 v = *(const uint4*)&krow[c * 8];
        s += qs[c * 8 + 0] * __uint_as_float(v.x << 16) + qs[c * 8 + 1] * __uint_as_float(v.x & 0xFFFF0000u);
        s += qs[c * 8 + 2] * __uint_as_float(v.y << 16) + qs[c * 8 + 3] * __uint_as_float(v.y & 0xFFFF0000u);
        s += qs[c * 8 + 4] * __uint_as_float(v.z << 16) + qs[c * 8 + 5] * __uint_as_float(v.z & 0xFFFF0000u);
        s += qs[c * 8 + 6] * __uint_as_float(v.w << 16) + qs[c * 8 + 7] * __uint_as_float(v.w & 0xFFFF0000u);
    }
    return s;
}
__device__ void ph_nsa(const P& p, int bid, int nb, char* smem) {
    float* qs = (float*)smem;
    float* pc = qs + 256;
    float* ps = pc + 2048;
    float* imp = ps + 4096;
    int* sel = (int*)(imp + 128);
    const int tid = threadIdx.x, lane = tid & 63, hh = tid >> 6;
    const int nitems = NTOK * 2;
    for (int it = bid; it < nitems; it += nb) {
        const int g = it & 1; const int n = it >> 1;
        const int b = n >> 13, t = n & (S_ - 1);
        const int head = g * 4 + hh;
        __syncthreads();
        qs[hh * 64 + lane] = bf2f(p.q[(size_t)n * 512 + head * 64 + lane]) * 0.125f;
        __syncthreads();
        const float* qh = qs + hh * 64;
        const int nvalid = (t >= 31) ? min((t - 31) / 16 + 1, NCMP) : 0;
        float oc = 0.f;
        {
            float sr[8]; float m = -3.0e38f;
#pragma unroll
            for (int i = 0; i < 8; i++) {
                const int nn = lane + 64 * i;
                float s = -3.0e38f;
                if (nn < nvalid) {
                    const float* kr = p.kcmp + ((size_t)(b * NCMP + nn) * 2 + g) * 64;
                    float a = 0.f;
                    for (int d = 0; d < 64; d++) a += qh[d] * kr[d];
                    s = a;
                }
                sr[i] = s; m = fmaxf(m, s);
            }
            m = wave_max(m);
            float sum = 0.f;
#pragma unroll
            for (int i = 0; i < 8; i++) { const int nn = lane + 64 * i; sr[i] = (nn < nvalid) ? __expf(sr[i] - m) : 0.f; sum += sr[i]; }
            sum = wave_sum(sum);
            const float inv = (nvalid > 0) ? 1.f / sum : 0.f;
#pragma unroll
            for (int i = 0; i < 8; i++) pc[hh * 512 + lane + 64 * i] = sr[i] * inv;
        }
        __syncthreads();
        for (int nn = 0; nn < nvalid; nn++) oc += pc[hh * 512 + nn] * p.vcmp[((size_t)(b * NCMP + nn) * 2 + g) * 64 + lane];
        const int cur = t >> 6;
        if (tid < 128) {
            const int j = tid; float v = 0.f;
            for (int nn = 4 * j - 1; nn <= 4 * j + 3; nn++)
                if (nn >= 0 && nn < NCMP) v += pc[nn] + pc[512 + nn] + pc[1024 + nn] + pc[1536 + nn];
            const bool forced = (j == 0) || (j == cur) || (j == cur - 1);
            imp[j] = forced ? 1e4f : ((j <= cur) ? v : -1.f);
        }
        __syncthreads();
        if (hh == 0) {
            float s0 = imp[lane], s1 = imp[lane + 64];
            for (int r = 0; r < 16; r++) {
                float bv; int bi;
                if (s0 >= s1) { bv = s0; bi = lane; } else { bv = s1; bi = lane + 64; }
#pragma unroll
                for (int o = 32; o > 0; o >>= 1) {
                    const float ov = __shfl_xor(bv, o, 64); const int oi = __shfl_xor(bi, o, 64);
                    if (ov > bv || (ov == bv && oi < bi)) { bv = ov; bi = oi; }
                }
                if (lane == 0) sel[r] = bi;
                if (bi == lane) s0 = -3.0e38f;
                if (bi == lane + 64) s1 = -3.0e38f;
            }
        }
        __syncthreads();
        float os = 0.f;
        {
            float sv[16]; float m = -3.0e38f;
#pragma unroll
            for (int bi = 0; bi < 16; bi++) {
                const int pos = sel[bi] * 64 + lane;
                float s = -3.0e38f;
                if (pos <= t) s = dot64_bf(qh, p.ksl + (size_t)(b * S_ + pos) * 128 + g * 64);
                sv[bi] = s; m = fmaxf(m, s);
            }
            m = wave_max(m);
            float sum = 0.f;
#pragma unroll
            for (int bi = 0; bi < 16; bi++) { const int pos = sel[bi] * 64 + lane; sv[bi] = (pos <= t) ? __expf(sv[bi] - m) : 0.f; sum += sv[bi]; }
            sum = wave_sum(sum);
            const float inv = 1.f / sum;
#pragma unroll
            for (int bi = 0; bi < 16; bi++) ps[hh * 1024 + bi * 64 + lane] = sv[bi] * inv;
        }
        __syncthreads();
        for (int bi = 0; bi < 16; bi++) {
            const int j = sel[bi];
            if (j > cur) continue;
            const int kmax = (j == cur) ? (t - j * 64) : 63;
            for (int kk = 0; kk <= kmax; kk++)
                os += ps[hh * 1024 + bi * 64 + kk] * bf2f(p.vsl[(size_t)(b * S_ + j * 64 + kk) * 128 + g * 64 + lane]);
        }
        __syncthreads();
        float ow = 0.f;
        {
            float sw[8]; float m = -3.0e38f;
#pragma unroll
            for (int i = 0; i < 8; i++) {
                const int pos = t - 511 + lane + 64 * i;
                float s = -3.0e38f;
                if (pos >= 0) s = dot64_bf(qh, p.kwn + (size_t)(b * S_ + pos) * 128 + g * 64);
                sw[i] = s; m = fmaxf(m, s);
            }
            m = wave_max(m);
            float sum = 0.f;
#pragma unroll
            for (int i = 0; i < 8; i++) { const int pos = t - 511 + lane + 64 * i; sw[i] = (pos >= 0) ? __expf(sw[i] - m) : 0.f; sum += sw[i]; }
            sum = wave_sum(sum);
            const float inv = 1.f / sum;
#pragma unroll
            for (int i = 0; i < 8; i++) ps[hh * 1024 + lane + 64 * i] = sw[i] * inv;
        }
        __syncthreads();
        {
            const int k0 = (t - 511 < 0) ? (511 - t) : 0;
            for (int kk = k0; kk < 512; kk++)
                ow += ps[hh * 1024 + kk] * bf2f(p.vwn[(size_t)(b * S_ + t - 511 + kk) * 128 + g * 64 + lane]);
        }
        const float g0 = p.nsag[(size_t)n * 24 + head * 3 + 0], g1 = p.nsag[(size_t)n * 24 + head * 3 + 1], g2 = p.nsag[(size_t)n * 24 + head * 3 + 2];
        p.oa[(size_t)n * 512 + head * 64 + lane] = f2bf(g0 * oc + g1 * os + g2 * ow);
    }
}

__device__ void ph_rwkv_scan(const P& p, int bid, int nb, char* smem) {
    constexpr int T = 32;
    float* sr = (float*)smem;
    float* sw = sr + T * 64;
    float* sk = sw + T * 64;
    float* sv = sk + T * 64;
    float* snk = sv + T * 64;
    float* ska = snk + T * 64;
    float* sbon = ska + T * 64;
    const int tid = threadIdx.x, lane = tid & 63, wv = tid >> 6;
    for (int it = bid; it < B_ * 8; it += nb) {
        const int b = it >> 3, h = it & 7;
        const int ch = h * 64 + lane;
        const float mur = p.mu[ch], muk = p.mu[512 + ch], muv = p.mu[1024 + ch];
        const float kkw = p.k_k[ch], kaw = p.k_a[ch], rkw = p.r_k[ch];
        const float lnw = p.ln_w[ch], lnb = p.ln_b[ch];
        float St[64];
#pragma unroll
        for (int k = 0; k < 64; k++) St[k] = 0.f;
        for (int t0 = 0; t0 < S_; t0 += T) {
            __syncthreads();
            for (int s = wv; s < T; s += 4) {
                const int t = t0 + s; const size_t n = (size_t)b * S_ + t;
                const u16* cr = p.prw + n * CRW;
                float r = bf2f(cr[ch]), k = bf2f(cr[512 + ch]), v = bf2f(cr[1024 + ch]);
                float pr = 0.f, pk = 0.f, pv = 0.f;
                if (t > 0) { const u16* pp = cr - CRW; pr = bf2f(pp[ch]); pk = bf2f(pp[512 + ch]); pv = bf2f(pp[1024 + ch]); }
                r = r + (pr - r) * mur; k = k + (pk - k) * muk; v = v + (pv - v) * muv;
                const float a = bf2f(p.av[n * 512 + ch]);
                float kk = k * kkw;
                const float nrm = fmaxf(sqrtf(wave_sum(kk * kk)), 1e-12f);
                kk = kk / nrm;
                const float k2 = k * (1.f + (a - 1.f) * kaw);
                const float bon = wave_sum(r * k2 * rkw);
                sr[s * 64 + lane] = r; sw[s * 64 + lane] = p.wdec[n * 512 + ch]; sk[s * 64 + lane] = k2; sv[s * 64 + lane] = v;
                snk[s * 64 + lane] = -kk; ska[s * 64 + lane] = kk * a;
                if (lane == 0) sbon[s] = bon;
            }
            __syncthreads();
            if (wv == 0) {
                for (int s = 0; s < T; s++) {
                    float sa0 = 0.f, sa1 = 0.f, sa2 = 0.f, sa3 = 0.f;
#pragma unroll
                    for (int k = 0; k < 64; k += 4) {
                        sa0 += St[k] * snk[s * 64 + k]; sa1 += St[k + 1] * snk[s * 64 + k + 1];
                        sa2 += St[k + 2] * snk[s * 64 + k + 2]; sa3 += St[k + 3] * snk[s * 64 + k + 3];
                    }
                    const float sa = (sa0 + sa1) + (sa2 + sa3);
                    const float vv = sv[s * 64 + lane];
                    float y0 = 0.f, y1 = 0.f, y2 = 0.f, y3 = 0.f;
#pragma unroll
                    for (int k = 0; k < 64; k += 4) {
                        St[k]     = St[k]     * sw[s * 64 + k]     + sa * ska[s * 64 + k]     + vv * sk[s * 64 + k];
                        St[k + 1] = St[k + 1] * sw[s * 64 + k + 1] + sa * ska[s * 64 + k + 1] + vv * sk[s * 64 + k + 1];
                        St[k + 2] = St[k + 2] * sw[s * 64 + k + 2] + sa * ska[s * 64 + k + 2] + vv * sk[s * 64 + k + 2];
                        St[k + 3] = St[k + 3] * sw[s * 64 + k + 3] + sa * ska[s * 64 + k + 3] + vv * sk[s * 64 + k + 3];
                        y0 += St[k] * sr[s * 64 + k]; y1 += St[k + 1] * sr[s * 64 + k + 1];
                        y2 += St[k + 2] * sr[s * 64 + k + 2]; y3 += St[k + 3] * sr[s * 64 + k + 3];
                    }
                    const float y = (y0 + y1) + (y2 + y3);
                    const float mean = wave_sum(y) * (1.f / 64.f);
                    const float dv = y - mean;
                    const float var = wave_sum(dv * dv) * (1.f / 64.f);
                    float yn = dv * rsqrtf(var + 64e-5f) * lnw + lnb;
                    yn += sbon[s] * vv;
                    const size_t n = (size_t)b * S_ + t0 + s;
                    p.ob[n * 512 + ch] = f2bf(yn * bf2f(p.gv[n * 512 + ch]));
                }
            }
        }
    }
}

__device__ void ph_merge(const P& p, int bid, int nb, char* smem) {
    u16* As = (u16*)smem; u16* Bs = As + 64 * 40;
    const int tid = threadIdx.x, lane = tid & 63, wv = tid >> 6;
    const int nitems = (NTOK / 64) * 16;
    for (int it = bid; it < nitems; it += nb) {
        const int rt = it >> 4, ct = it & 15;
        const int r0 = rt * 64, c0 = ct * 64;
        f32x4 acc[4], m[4];
        auto ah = [&](int r, int k) -> uint4 { return *(const uint4*)&p.hbuf[(size_t)(r0 + r) * D_ + k]; };
        auto aoa = [&](int r, int k) -> uint4 { return *(const uint4*)&p.oa[(size_t)(r0 + r) * 512 + k]; };
        auto aob = [&](int r, int k) -> uint4 { return *(const uint4*)&p.ob[(size_t)(r0 + r) * 512 + k]; };
        auto bga = [&](int k, int n) -> float { return p.w_in[(size_t)k * CIN + 3096 + c0 + n]; };
        auto bgb = [&](int k, int n) -> float { return p.w_in[(size_t)k * CIN + 4120 + c0 + n]; };
        auto bpa = [&](int k, int n) -> float { return p.wpa[(size_t)k * D_ + c0 + n]; };
        auto bpb = [&](int k, int n) -> float { return p.wpb[(size_t)k * D_ + c0 + n]; };
        gemm_tile64(D_, ah, bga, acc, As, Bs);
#pragma unroll
        for (int n = 0; n < 4; n++)
#pragma unroll
            for (int j = 0; j < 4; j++) m[n][j] = sigmoidf_(acc[n][j]);
        gemm_tile64(512, aoa, bpa, acc, As, Bs);
#pragma unroll
        for (int n = 0; n < 4; n++)
#pragma unroll
            for (int j = 0; j < 4; j++) m[n][j] *= acc[n][j];
        gemm_tile64(D_, ah, bgb, acc, As, Bs);
        f32x4 sb[4];
#pragma unroll
        for (int n = 0; n < 4; n++)
#pragma unroll
            for (int j = 0; j < 4; j++) sb[n][j] = sigmoidf_(acc[n][j]);
        gemm_tile64(512, aob, bpb, acc, As, Bs);
#pragma unroll
        for (int n = 0; n < 4; n++)
#pragma unroll
            for (int j = 0; j < 4; j++) {
                const int row = r0 + wv * 16 + (lane >> 4) * 4 + j, col = c0 + n * 16 + (lane & 15);
                p.merged[(size_t)row * D_ + col] = f2bf(m[n][j] + sb[n][j] * acc[n][j]);
            }
    }
}

__device__ void ph_outproj(const P& p, int bid, int nb, char* smem) {
    u16* As = (u16*)smem; u16* Bs = As + 64 * 40;
    const int tid = threadIdx.x, lane = tid & 63, wv = tid >> 6;
    const int nitems = (NTOK / 64) * 16;
    for (int it = bid; it < nitems; it += nb) {
        const int rt = it >> 4, ct = it & 15;
        const int r0 = rt * 64, c0 = ct * 64;
        f32x4 acc[4];
        auto am = [&](int r, int k) -> uint4 { return *(const uint4*)&p.merged[(size_t)(r0 + r) * D_ + k]; };
        auto bw = [&](int k, int n) -> float { return p.wout[(size_t)k * D_ + c0 + n]; };
        gemm_tile64(D_, am, bw, acc, As, Bs);
#pragma unroll
        for (int n = 0; n < 4; n++)
#pragma unroll
            for (int j = 0; j < 4; j++) {
                const int row = r0 + wv * 16 + (lane >> 4) * 4 + j, col = c0 + n * 16 + (lane & 15);
                p.x1[(size_t)row * D_ + col] = p.x[(size_t)row * D_ + col] + acc[n][j];
            }
    }
}

__device__ void ph_route(const P& p, int bid, int nb, char* smem) {
    float* red = (float*)smem;
    const int tid = threadIdx.x, lane = tid & 63, wv = tid >> 6;
    for (int n = bid; n < NTOK; n += nb) {
        const float4 xv = *(const float4*)&p.x1[(size_t)n * D_ + tid * 4];
        float ss = xv.x * xv.x + xv.y * xv.y + xv.z * xv.z + xv.w * xv.w;
        ss = wave_sum(ss);
        __syncthreads();
        if (lane == 0) red[wv] = ss;
        __syncthreads();
        const float tot = red[0] + red[1] + red[2] + red[3];
        const float rs = rsqrtf(tot * (1.f / D_) + 1e-6f);
        const float4 gf = *(const float4*)&p.g_ffn[tid * 4];
        float hv[4] = {xv.x * rs * gf.x, xv.y * rs * gf.y, xv.z * rs * gf.z, xv.w * rs * gf.w};
        uint2 o; o.x = pack2(hv[0], hv[1]); o.y = pack2(hv[2], hv[3]);
        *(uint2*)&p.hbuf[(size_t)n * D_ + tid * 4] = o;
        float lg[36];
#pragma unroll
        for (int j = 0; j < 36; j++) lg[j] = 0.f;
#pragma unroll
        for (int i = 0; i < 4; i++) {
            const int k = tid * 4 + i;
            const float4 wg = *(const float4*)&p.w_grp[k * 4];
            lg[0] += hv[i] * wg.x; lg[1] += hv[i] * wg.y; lg[2] += hv[i] * wg.z; lg[3] += hv[i] * wg.w;
#pragma unroll
            for (int j = 0; j < 8; j++) {
                const float4 we = *(const float4*)&p.w_exp[k * 32 + j * 4];
                lg[4 + j * 4] += hv[i] * we.x; lg[5 + j * 4] += hv[i] * we.y; lg[6 + j * 4] += hv[i] * we.z; lg[7 + j * 4] += hv[i] * we.w;
            }
        }
#pragma unroll
        for (int j = 0; j < 36; j++) lg[j] = wave_sum(lg[j]);
        __syncthreads();
        if (lane == 0) {
#pragma unroll
            for (int j = 0; j < 36; j++) red[wv * 36 + j] = lg[j];
        }
        __syncthreads();
        if (tid == 0) {
            float gl[4]; int gs = 0;
#pragma unroll
            for (int j = 0; j < 4; j++) gl[j] = red[j] + red[36 + j] + red[72 + j] + red[108 + j] + p.b_grp[j];
            float gm = gl[0];
#pragma unroll
            for (int j = 1; j < 4; j++) if (gl[j] > gm) { gm = gl[j]; gs = j; }
            float gsum = 0.f;
#pragma unroll
            for (int j = 0; j < 4; j++) gsum += __expf(gl[j] - gm);
            const float pg = 1.f / gsum;
            float el[8]; float em = -3.0e38f;
#pragma unroll
            for (int j = 0; j < 8; j++) {
                const int c = 4 + gs * 8 + j;
                el[j] = red[c] + red[36 + c] + red[72 + c] + red[108 + c] + p.b_exp[gs * 8 + j];
                em = fmaxf(em, el[j]);
            }
            int j0 = 0, j1 = -1; float v0 = -3.0e38f, v1 = -3.0e38f;
#pragma unroll
            for (int j = 0; j < 8; j++) { el[j] = __expf(el[j] - em); }
#pragma unroll
            for (int j = 0; j < 8; j++) { if (el[j] > v0) { v0 = el[j]; j0 = j; } }
#pragma unroll
            for (int j = 0; j < 8; j++) { if (j != j0 && el[j] > v1) { v1 = el[j]; j1 = j; } }
            const float den = v0 + v1;
            const int e0 = gs * 8 + j0, e1 = gs * 8 + j1;
            p.tok_e[n * 2] = e0; p.tok_e[n * 2 + 1] = e1;
            p.tok_gate[n * 2] = pg * v0 / den; p.tok_gate[n * 2 + 1] = pg * v1 / den;
            atomicAdd(&p.counts[e0], 1); atomicAdd(&p.counts[e1], 1);
        }
    }
}

__device__ void ph_offsets(const P& p, int bid, int nb, char* smem) {
    if (bid == 0 && threadIdx.x == 0) {
        int off = 0, nb_ = 0;
        for (int e = 0; e < NEXP; e++) {
            const int c = p.counts[e];
            p.offs[e] = off;
            for (int r = 0; r < c; r += 64) { p.blk_e[nb_] = e; p.blk_r0[nb_] = off + r; nb_++; }
            off += c;
        }
        p.offs[NEXP] = off;
        *p.nblk = nb_;
    }
}
__device__ void ph_scatter(const P& p, int bid, int nb, char* smem) {
    for (int i = bid * NTHREADS + threadIdx.x; i < NTOK * 2; i += nb * NTHREADS) {
        const int e = p.tok_e[i];
        const int slot = p.offs[e] + atomicAdd(&p.cursor[e], 1);
        p.list_tok[slot] = i >> 1; p.list_gate[slot] = p.tok_gate[i]; p.tokslot[i] = slot;
    }
}
__device__ void ph_moe1(const P& p, int bid, int nb, char* smem) {
    u16* As = (u16*)smem; u16* Bs = As + 64 * 40;
    const int tid = threadIdx.x, lane = tid & 63, wv = tid >> 6;
    const int nitems = (*p.nblk) * 4;
    for (int it = bid; it < nitems; it += nb) {
        const int bi = it >> 2, ct = it & 3;
        const int e = p.blk_e[bi], r0 = p.blk_r0[bi], c0 = ct * 64;
        const int rend = p.offs[e + 1];
        f32x4 acc[4], h1[4];
        auto al = [&](int r, int k) -> uint4 { int s = r0 + r; if (s >= rend) s = rend - 1; return *(const uint4*)&p.hbuf[(size_t)p.list_tok[s] * D_ + k]; };
        auto b1 = [&](int k, int n) -> float { return p.e_w1[((size_t)e * D_ + k) * 256 + c0 + n]; };
        auto b3 = [&](int k, int n) -> float { return p.e_w3[((size_t)e * D_ + k) * 256 + c0 + n]; };
        gemm_tile64(D_, al, b1, acc, As, Bs);
#pragma unroll
        for (int n = 0; n < 4; n++)
#pragma unroll
            for (int j = 0; j < 4; j++) { const float v = acc[n][j]; h1[n][j] = v * sigmoidf_(v); }
        gemm_tile64(D_, al, b3, acc, As, Bs);
#pragma unroll
        for (int n = 0; n < 4; n++)
#pragma unroll
            for (int j = 0; j < 4; j++) {
                const int s = r0 + wv * 16 + (lane >> 4) * 4 + j, col = c0 + n * 16 + (lane & 15);
                if (s < rend) p.hid[(size_t)s * 256 + col] = f2bf(h1[n][j] * acc[n][j]);
            }
    }
}
__device__ void ph_moe2(const P& p, int bid, int nb, char* smem) {
    u16* As = (u16*)smem; u16* Bs = As + 64 * 40;
    const int tid = threadIdx.x, lane = tid & 63, wv = tid >> 6;
    const int nitems = (*p.nblk) * 16;
    for (int it = bid; it < nitems; it += nb) {
        const int bi = it >> 4, ct = it & 15;
        const int e = p.blk_e[bi], r0 = p.blk_r0[bi], c0 = ct * 64;
        const int rend = p.offs[e + 1];
        f32x4 acc[4];
        auto al = [&](int r, int k) -> uint4 { int s = r0 + r; if (s >= rend) s = rend - 1; return *(const uint4*)&p.hid[(size_t)s * 256 + k]; };
        auto b2 = [&](int k, int n) -> float { return p.e_w2[((size_t)e * 256 + k) * D_ + c0 + n]; };
        gemm_tile64(256, al, b2, acc, As, Bs);
#pragma unroll
        for (int j = 0; j < 4; j++) {
            const int s = r0 + wv * 16 + (lane >> 4) * 4 + j;
            if (s < rend) {
                const float gt = p.list_gate[s];
#pragma unroll
                for (int n = 0; n < 4; n++) p.ybuf[(size_t)s * D_ + c0 + n * 16 + (lane & 15)] = f2bf(acc[n][j] * gt);
            }
        }
    }
}
__device__ void ph_final(const P& p, int bid, int nb, char* smem) {
    const int tid = threadIdx.x, lane = tid & 63, wv = tid >> 6;
    for (int row = bid * 4 + wv; row < NTOK; row += nb * 4) {
        const int s0 = p.tokslot[row * 2], s1 = p.tokslot[row * 2 + 1];
        float v[16]; float ss = 0.f;
#pragma unroll
        for (int i = 0; i < 4; i++) {
            const int c = i * 256 + lane * 4;
            const float4 t = *(const float4*)&p.x1[(size_t)row * D_ + c];
            const uint2 a = *(const uint2*)&p.ybuf[(size_t)s0 * D_ + c];
            const uint2 bq = *(const uint2*)&p.ybuf[(size_t)s1 * D_ + c];
            v[4 * i]     = t.x + __uint_as_float(a.x << 16) + __uint_as_float(bq.x << 16);
            v[4 * i + 1] = t.y + __uint_as_float(a.x & 0xFFFF0000u) + __uint_as_float(bq.x & 0xFFFF0000u);
            v[4 * i + 2] = t.z + __uint_as_float(a.y << 16) + __uint_as_float(bq.y << 16);
            v[4 * i + 3] = t.w + __uint_as_float(a.y & 0xFFFF0000u) + __uint_as_float(bq.y & 0xFFFF0000u);
            ss += v[4 * i] * v[4 * i] + v[4 * i + 1] * v[4 * i + 1] + v[4 * i + 2] * v[4 * i + 2] + v[4 * i + 3] * v[4 * i + 3];
        }
        ss = wave_sum(ss);
        const float rs = rsqrtf(ss * (1.f / D_) + 1e-6f);
#pragma unroll
        for (int i = 0; i < 4; i++) {
            const int c = i * 256 + lane * 4;
            const float4 g = *(const float4*)&p.g_final[c];
            float4 o; o.x = v[4 * i] * rs * g.x; o.y = v[4 * i + 1] * rs * g.y; o.z = v[4 * i + 2] * rs * g.z; o.w = v[4 * i + 3] * rs * g.w;
            *(float4*)&p.out[(size_t)row * D_ + c] = o;
        }
    }
}

#define XB_TMO      128
#define XB_XCNT(j)  (256  + 64 * (j))
#define XB_XSUB(j)  (1280 + 64 * (j))
#define XB_XGEN(j)  (2304 + 64 * (j))
#define XB_TOP      3328
#define XB_TOPGEN   3392
#define XCD_BAR_WORDS 3456
#define XB_SPIN_CAP (1u << 18)
#define LAS __attribute__((address_space(3)))

__device__ __forceinline__ unsigned xb_ld(unsigned* p)              { return __hip_atomic_load(p, __ATOMIC_RELAXED, __HIP_MEMORY_SCOPE_AGENT); }
__device__ __forceinline__ unsigned xb_add(unsigned* p, unsigned v) { return __hip_atomic_fetch_add(p, v, __ATOMIC_RELAXED, __HIP_MEMORY_SCOPE_AGENT); }
__device__ __forceinline__ unsigned xb_xcc_id() { return (unsigned)__builtin_amdgcn_s_getreg((3 << 11) | 20) & 0xFu; }
#define XB_SPIN(cond, bar) do { unsigned _sp = 0; while (cond) { __builtin_amdgcn_s_sleep(1); \
    if ((++_sp & 255u) == 0u) { if (xb_ld(&(bar)[XB_TMO])) break; if (_sp > XB_SPIN_CAP) { atomicAdd(&(bar)[XB_TMO], 1u); break; } } } } while (0)

struct XcdBarrier {
    unsigned* bar; unsigned x;
    volatile LAS unsigned* st;
};

__device__ __forceinline__ XcdBarrier xcd_barrier_post(unsigned* bar, volatile LAS unsigned* st) {
    XcdBarrier b; b.bar = bar; b.x = xb_xcc_id(); b.st = st;
    if (threadIdx.x == 0) (void)xb_add(&bar[XB_XCNT(b.x)], 1u);
    return b;
}
__device__ __forceinline__ void xcd_barrier_complete(unsigned* bar, unsigned x, unsigned& nloc, unsigned& nx) {
    const unsigned G = gridDim.x * gridDim.y * gridDim.z;
    unsigned sum, cnt, mine, sp = 0u;
    for (;;) {
        sum = 0u; cnt = 0u; mine = 0u;
#pragma unroll
        for (unsigned j = 0; j < 16; ++j) { const unsigned c = xb_ld(&bar[XB_XCNT(j)]); sum += c; cnt += (c > 0u) ? 1u : 0u; mine = (j == x) ? c : mine; }
        if (sum == G) break;
        __builtin_amdgcn_s_sleep(1);
        if ((++sp & 255u) == 0u) { if (xb_ld(&bar[XB_TMO])) break; if (sp > XB_SPIN_CAP) { atomicAdd(&bar[XB_TMO], 1u); break; } }
    }
    nloc = mine > 0u ? mine : 1u; nx = cnt > 0u ? cnt : 1u;
}

__device__ __forceinline__ void xcd_barrier(const XcdBarrier& b) {
    asm volatile("s_waitcnt vmcnt(0)" ::: "memory");
    __syncthreads();
    if (threadIdx.x == 0) {
        unsigned* bar = b.bar;
        __builtin_amdgcn_s_waitcnt(0);
        unsigned nloc = b.st[0], nx = b.st[1];
        if (nloc == 0u) { xcd_barrier_complete(bar, b.x, nloc, nx); b.st[0] = nloc; b.st[1] = nx; }
        const unsigned old = xb_add(&bar[XB_XSUB(b.x)], 1u);
        const unsigned gen = old / nloc;
        if (old + 1u == (gen + 1u) * nloc) {
            __builtin_amdgcn_fence(__ATOMIC_RELEASE, "agent");
            asm volatile("s_waitcnt vmcnt(0)" ::: "memory");
            const unsigned og = xb_add(&bar[XB_TOP], 1u);
            const unsigned tg = og / nx;
            if (og + 1u == (tg + 1u) * nx) xb_add(&bar[XB_TOPGEN], 1u);
            else XB_SPIN(xb_ld(&bar[XB_TOPGEN]) == tg, bar);
            __builtin_amdgcn_fence(__ATOMIC_ACQUIRE, "agent");
            xb_add(&bar[XB_XGEN(b.x)], 1u);
            asm volatile("s_waitcnt vmcnt(0)" ::: "memory");
        } else {
            XB_SPIN(xb_ld(&bar[XB_XGEN(b.x)]) == gen, bar);
            __builtin_amdgcn_fence(__ATOMIC_ACQUIRE, "agent");
            asm volatile("s_waitcnt vmcnt(0)" ::: "memory");
        }
    }
    __syncthreads();
}


template <int PH>
__device__ __forceinline__ void run_phase(const P& p, int bid, int nb, char* smem) {
    if constexpr (PH == 0) ph_prologue(p, bid, nb, smem);
    if constexpr (PH == 1) ph_inproj(p, bid, nb, smem);
    if constexpr (PH == 2) { ph_compress(p, bid, nb, smem); __syncthreads(); ph_rwkv_pre(p, bid, nb, smem); }
    if constexpr (PH == 3) {
        if (bid < 32) ph_rwkv_scan(p, bid, 32, smem);
        else ph_nsa(p, bid - 32, nb - 32, smem);
    }
    if constexpr (PH == 4) ph_merge(p, bid, nb, smem);
    if constexpr (PH == 5) ph_outproj(p, bid, nb, smem);
    if constexpr (PH == 6) ph_route(p, bid, nb, smem);
    if constexpr (PH == 7) ph_offsets(p, bid, nb, smem);
    if constexpr (PH == 8) ph_scatter(p, bid, nb, smem);
    if constexpr (PH == 9) ph_moe1(p, bid, nb, smem);
    if constexpr (PH == 10) ph_moe2(p, bid, nb, smem);
    if constexpr (PH == 11) ph_final(p, bid, nb, smem);
}

template <int PH>
__global__ void __launch_bounds__(NTHREADS) kph(P p) {
    extern __shared__ __attribute__((aligned(16))) char smem[];
    run_phase<PH>(p, blockIdx.x, gridDim.x, smem);
}


__global__ void __launch_bounds__(NTHREADS, 2) mega(P p) {
    extern __shared__ __attribute__((aligned(16))) char smem[];
    volatile LAS unsigned* st = (volatile LAS unsigned*)(smem + SMEM_BYTES - 16);
    if (threadIdx.x == 0) { st[0] = 0u; st[1] = 0u; st[2] = 0u; st[3] = 0u; }
    __syncthreads();
    XcdBarrier bar = xcd_barrier_post(p.bar, st);
    const int bid = blockIdx.x, nb = gridDim.x;
    run_phase<0>(p, bid, nb, smem); xcd_barrier(bar);
#if PROBE == 7
    for (size_t i = (size_t)bid * NTHREADS + threadIdx.x; i < (size_t)NTOK * D_; i += (size_t)nb * NTHREADS) {
        p.out[i] = bf2f(p.hbuf[i]) + p.rope[i & (size_t)(NTOK * 64 - 1)];
    }
    return;
#endif
    run_phase<1>(p, bid, nb, smem); xcd_barrier(bar);
#if PROBE == 2
    for (size_t i = (size_t)bid * NTHREADS + threadIdx.x; i < (size_t)NTOK * D_; i += (size_t)nb * NTHREADS) {
        const size_t n = i >> 10; const int c = (int)(i & 1023);
        p.out[i] = bf2f(p.q[n * 512 + (c & 511)]);
    }
    return;
#endif
    run_phase<2>(p, bid, nb, smem); xcd_barrier(bar);
    run_phase<3>(p, bid, nb, smem); xcd_barrier(bar);
    run_phase<4>(p, bid, nb, smem); xcd_barrier(bar);
    run_phase<5>(p, bid, nb, smem); xcd_barrier(bar);
    run_phase<6>(p, bid, nb, smem); xcd_barrier(bar);
    run_phase<7>(p, bid, nb, smem); xcd_barrier(bar);
    run_phase<8>(p, bid, nb, smem); xcd_barrier(bar);
    run_phase<9>(p, bid, nb, smem); xcd_barrier(bar);
    run_phase<10>(p, bid, nb, smem); xcd_barrier(bar);
    run_phase<11>(p, bid, nb, smem);
}

__global__ void __launch_bounds__(NTHREADS) kprobe(P p) {
    for (size_t i = (size_t)blockIdx.x * NTHREADS + threadIdx.x; i < (size_t)NTOK * D_; i += (size_t)gridDim.x * NTHREADS) {
        const size_t n = i >> 10; const int c = (int)(i & 1023);
        float v = 0.f;
#if PROBE == 1
        v = (c < 512) ? bf2f(p.oa[n * 512 + c]) : bf2f(p.ob[n * 512 + c - 512]);
#elif PROBE == 2
        v = (c < 512) ? bf2f(p.q[n * 512 + c]) : bf2f(p.prw[n * CRW + c - 512]);
#elif PROBE == 3
        v = p.x1[i];
#elif PROBE == 4
        v = bf2f(p.oa[n * 512 + (c & 511)]);
#elif PROBE == 5
        v = bf2f(p.ob[n * 512 + (c & 511)]);
#endif
        p.out[i] = v;
    }
}

extern "C" void kernel_launch(void* const* d_in, const int* in_sizes, int n_in,
                              void* d_out, int out_size, void* d_ws, size_t ws_size,
                              hipStream_t stream) {
    P p{};
    p.x = (const float*)d_in[0]; p.pos = (const int*)d_in[1]; p.g_mix = (const float*)d_in[2]; p.w_in = (const float*)d_in[3];
    p.pe_k = (const float*)d_in[4]; p.w1_k = (const float*)d_in[5]; p.b1_k = (const float*)d_in[6]; p.w2_k = (const float*)d_in[7]; p.b2_k = (const float*)d_in[8];
    p.pe_v = (const float*)d_in[9]; p.w1_v = (const float*)d_in[10]; p.b1_v = (const float*)d_in[11]; p.w2_v = (const float*)d_in[12]; p.b2_v = (const float*)d_in[13];
    p.mu = (const float*)d_in[14]; p.w0 = (const float*)d_in[15]; p.w2 = (const float*)d_in[16]; p.a0 = (const float*)d_in[17]; p.a2 = (const float*)d_in[18];
    p.g2 = (const float*)d_in[19]; p.k_k = (const float*)d_in[20]; p.k_a = (const float*)d_in[21]; p.r_k = (const float*)d_in[22]; p.ln_w = (const float*)d_in[23]; p.ln_b = (const float*)d_in[24];
    p.wpa = (const float*)d_in[25]; p.wpb = (const float*)d_in[26]; p.wout = (const float*)d_in[27]; p.g_ffn = (const float*)d_in[28];
    p.w_grp = (const float*)d_in[29]; p.b_grp = (const float*)d_in[30]; p.w_exp = (const float*)d_in[31]; p.b_exp = (const float*)d_in[32];
    p.e_w1 = (const float*)d_in[33]; p.e_w3 = (const float*)d_in[34]; p.e_w2 = (const float*)d_in[35]; p.g_final = (const float*)d_in[36];
    p.out = (float*)d_out;
    char* ws = (char*)d_ws;
    const size_t MiB = 1ull << 20;
    p.hbuf = (u16*)(ws + 0 * MiB);
    p.q    = (u16*)(ws + 64 * MiB);
    p.kc   = (u16*)(ws + 96 * MiB);  p.vc  = (u16*)(ws + 104 * MiB);
    p.ksl  = (u16*)(ws + 112 * MiB); p.vsl = (u16*)(ws + 120 * MiB);
    p.kwn  = (u16*)(ws + 128 * MiB); p.vwn = (u16*)(ws + 136 * MiB);
    p.nsag = (float*)(ws + 144 * MiB);
    p.rope = (float*)(ws + 147 * MiB);
    p.kcmp = (float*)(ws + 155 * MiB); p.vcmp = (float*)(ws + 156 * MiB);
    p.prw  = (u16*)(ws + 160 * MiB);
    p.wdec = (float*)(ws + 272 * MiB);
    p.av   = (u16*)(ws + 336 * MiB);
    p.gv   = (u16*)(ws + 368 * MiB);
    p.oa   = (u16*)(ws + 400 * MiB);
    p.ob   = (u16*)(ws + 432 * MiB);
    p.merged = (u16*)(ws + 64 * MiB);
    p.x1   = (float*)(ws + 160 * MiB);
    char* rt = ws + 288 * MiB;
    p.tok_e = (int*)(rt);                        rt += NTOK * 2 * 4;
    p.tok_gate = (float*)(rt);                   rt += NTOK * 2 * 4;
    p.tokslot = (int*)(rt);                      rt += NTOK * 2 * 4;
    p.list_tok = (int*)(rt);                     rt += NTOK * 2 * 4;
    p.list_gate = (float*)(rt);                  rt += NTOK * 2 * 4;
    p.blk_e = (int*)(rt);                        rt += 2048 * 4;
    p.blk_r0 = (int*)(rt);                       rt += 2048 * 4;
    p.hid  = (u16*)(ws + 296 * MiB);
    p.ybuf = (u16*)(ws + 336 * MiB);
    char* misc = ws + 470 * MiB;
    p.counts = (int*)(misc); p.cursor = (int*)(misc + 256); p.offs = (int*)(misc + 512); p.nblk = (int*)(misc + 1024);
    p.bar = (unsigned*)(ws + 471 * MiB);

    if (ws_size < (size_t)480 * MiB) return;
#if MEGA
    {
        static int mgrid = 0;
        if (mgrid == 0) {
            int dev = 0, cus = 0, per_cu = 0;
            hipGetDevice(&dev);
            hipDeviceGetAttribute(&cus, hipDeviceAttributeMultiprocessorCount, dev);
            hipFuncSetAttribute((const void*)mega, hipFuncAttributeMaxDynamicSharedMemorySize, SMEM_BYTES);
            hipOccupancyMaxActiveBlocksPerMultiprocessor(&per_cu, (const void*)mega, NTHREADS, SMEM_BYTES);
            (void)hipGetLastError();
            if (per_cu < 1) per_cu = 1;
            if (per_cu > 2) per_cu = 2;
            mgrid = cus * per_cu;
        }
        hipMemsetAsync(p.bar, 0, XCD_BAR_WORDS * sizeof(unsigned), stream);
        mega<<<mgrid, NTHREADS, SMEM_BYTES, stream>>>(p);
        return;
    }
#endif
    const int grid = 1024;
    kph<0><<<grid, NTHREADS, SMEM_BYTES, stream>>>(p);
    kph<1><<<grid, NTHREADS, SMEM_BYTES, stream>>>(p);
    kph<2><<<grid, NTHREADS, SMEM_BYTES, stream>>>(p);
    kph<3><<<grid, NTHREADS, SMEM_BYTES, stream>>>(p);
#if PROBE == 1 || PROBE == 2 || PROBE == 4 || PROBE == 5
    kprobe<<<grid, NTHREADS, 0, stream>>>(p); return;
#endif
    kph<4><<<grid, NTHREADS, SMEM_BYTES, stream>>>(p);
    kph<5><<<grid, NTHREADS, SMEM_BYTES, stream>>>(p);
#if PROBE == 3
    kprobe<<<grid, NTHREADS, 0, stream>>>(p); return;
#endif
    kph<6><<<grid, NTHREADS, SMEM_BYTES, stream>>>(p);
    kph<7><<<grid, NTHREADS, SMEM_BYTES, stream>>>(p);
    kph<8><<<grid, NTHREADS, SMEM_BYTES, stream>>>(p);
    kph<9><<<grid, NTHREADS, SMEM_BYTES, stream>>>(p);
    kph<10><<<grid, NTHREADS, SMEM_BYTES, stream>>>(p);
    kph<11><<<grid, NTHREADS, SMEM_BYTES, stream>>>(p);
}
```

```cpp
#include <hip/hip_runtime.h>
#include <stdint.h>

typedef unsigned short u16;
using bf16x8 = __attribute__((ext_vector_type(8))) short;
using f32x4  = __attribute__((ext_vector_type(4))) float;

#ifndef MEGA
#define MEGA 1
#endif

constexpr int B_ = 4, S_ = 8192, D_ = 1024, NTOK = B_ * S_;
constexpr int CIN = 5144;
constexpr int NCMP = 511;
constexpr int CRW = 1792;
constexpr int NEXP = 32;
constexpr int NT = 512;
constexpr int NW = NT / 64;
constexpr int SMEM_BYTES = 144 * 1024;
constexpr int SCAN_BLOCKS = 16;
constexpr float QSCALE = 0.125f * 1.4426950408889634f;

struct P {
    const float* x; const int* pos; const float* g_mix; const float* w_in;
    const float *pe_k, *w1_k, *b1_k, *w2_k, *b2_k, *pe_v, *w1_v, *b1_v, *w2_v, *b2_v;
    const float *mu, *w0, *w2, *a0, *a2, *g2, *k_k, *k_a, *r_k, *ln_w, *ln_b;
    const float *wpa, *wpb, *wout, *g_ffn, *w_grp, *b_grp, *w_exp, *b_exp, *e_w1, *e_w3, *e_w2, *g_final;
    float* out;
    u16* hbuf; u16 *q, *kc, *vc, *ksl, *vslT, *kwn, *vwnT, *kcb, *vcT; float* nsag; u16* prw;
    u16* cdat; float* bon; u16 *w2T, *a2T, *g2T; u16 *oa, *ob; u16* merged; float* x1;
    int* tok_e; float* tok_gate; int* tokslot; int* list_tok; float* list_gate;
    int* counts; int* offs; int* cursor; int* blk_e; int* blk_r0; int* nblk;
    u16* hid; u16* ybuf; unsigned* bar;
    u16 *winT, *wgT, *wpaT, *wpbT, *woutT, *ew1T, *ew3T, *ew2T;
};

__device__ __forceinline__ u16 f2bf(float f) { unsigned u = __float_as_uint(f); u += 0x7FFFu + ((u >> 16) & 1u); return (u16)(u >> 16); }
__device__ __forceinline__ float bf2f(u16 h) { return __uint_as_float(((unsigned)h) << 16); }
__device__ __forceinline__ unsigned pack2(float a, float b) { return (unsigned)f2bf(a) | ((unsigned)f2bf(b) << 16); }
__device__ __forceinline__ float sigmoidf_(float x) { return 1.f / (1.f + __expf(-x)); }
__device__ __forceinline__ int get_tid() { int t = threadIdx.x; asm volatile("" : "+v"(t)); return t; }
__device__ __forceinline__ float wave_sum(float v) {
#pragma unroll
    for (int o = 32; o > 0; o >>= 1) v += __shfl_xor(v, o, 64);
    return v;
}

__constant__ double ROPE_FREQ[32] = {
    1.00000000000000000000e+00, 7.49894209332455874417e-01, 5.62341325190349072827e-01, 4.21696503428582225581e-01,
    3.16227766016837941176e-01, 2.37137370566165517349e-01, 1.77827941003892292526e-01, 1.33352143216332402753e-01,
    1.00000000000000005551e-01, 7.49894209332455791150e-02, 5.62341325190349114460e-02, 4.21696503428582239459e-02,
    3.16227766016837913421e-02, 2.37137370566165538166e-02, 1.77827941003892292526e-02, 1.33352143216332406223e-02,
    1.00000000000000002082e-02, 7.49894209332455791150e-03, 5.62341325190349097113e-03, 4.21696503428582291501e-03,
    3.16227766016837939442e-03, 2.37137370566165538166e-03, 1.77827941003892275179e-03, 1.33352143216332406223e-03,
    1.00000000000000002082e-03, 7.49894209332455856203e-04, 5.62341325190349097113e-04, 4.21696503428582237290e-04,
    3.16227766016837939442e-04, 2.37137370566165538166e-04, 1.77827941003892269758e-04, 1.33352143216332395381e-04};

constexpr int GSTR = 72;
constexpr int G_AS = 256 * GSTR, G_BS = 128 * GSTR;
template <class ARow>
__device__ __forceinline__ void gemm_core(int K, ARow arow, const u16* __restrict__ BT, int ldb, f32x4 (&acc)[4][4], u16* sm) {
    u16* As = sm; u16* Bs = sm + 2 * G_AS;
    const int tid = get_tid(), lane = tid & 63, wv = tid >> 6;
    const int wm = wv >> 1, wn = wv & 1;
    const int lr = tid >> 3, lk = (tid & 7) * 8;
    const u16* ap0 = arow(lr) + lk; const u16* ap1 = arow(lr + 64) + lk;
    const u16* ap2 = arow(lr + 128) + lk; const u16* ap3 = arow(lr + 192) + lk;
    const u16* bp0 = BT + (size_t)lr * ldb + lk; const u16* bp1 = BT + (size_t)(lr + 64) * ldb + lk;
#pragma unroll
    for (int mt = 0; mt < 4; mt++)
#pragma unroll
        for (int nt = 0; nt < 4; nt++) acc[mt][nt] = f32x4{0.f, 0.f, 0.f, 0.f};
    uint4 ra0, ra1, ra2, ra3, rb0, rb1;
    ra0 = *(const uint4*)ap0; ra1 = *(const uint4*)ap1; ra2 = *(const uint4*)ap2; ra3 = *(const uint4*)ap3;
    rb0 = *(const uint4*)bp0; rb1 = *(const uint4*)bp1;
    *(uint4*)&As[lr * GSTR + lk] = ra0; *(uint4*)&As[(lr + 64) * GSTR + lk] = ra1;
    *(uint4*)&As[(lr + 128) * GSTR + lk] = ra2; *(uint4*)&As[(lr + 192) * GSTR + lk] = ra3;
    *(uint4*)&Bs[lr * GSTR + lk] = rb0; *(uint4*)&Bs[(lr + 64) * GSTR + lk] = rb1;
    __syncthreads();
    const int nk = K >> 6;
    for (int kt = 0; kt < nk; kt++) {
        const int buf = kt & 1;
        if (kt + 1 < nk) {
            const int ko = (kt + 1) * 64;
            ra0 = *(const uint4*)(ap0 + ko); ra1 = *(const uint4*)(ap1 + ko); ra2 = *(const uint4*)(ap2 + ko); ra3 = *(const uint4*)(ap3 + ko);
            rb0 = *(const uint4*)(bp0 + ko); rb1 = *(const uint4*)(bp1 + ko);
        }
        const u16* Ab = As + buf * G_AS + (wm * 64 + (lane & 15)) * GSTR + (lane >> 4) * 8;
        const u16* Bb = Bs + buf * G_BS + (wn * 64 + (lane & 15)) * GSTR + (lane >> 4) * 8;
#pragma unroll
        for (int ks = 0; ks < 2; ks++) {
            bf16x8 af[4], bfr[4];
#pragma unroll
            for (int mt = 0; mt < 4; mt++) af[mt] = *(const bf16x8*)&Ab[mt * 16 * GSTR + ks * 32];
#pragma unroll
            for (int nt = 0; nt < 4; nt++) bfr[nt] = *(const bf16x8*)&Bb[nt * 16 * GSTR + ks * 32];
#pragma unroll
            for (int mt = 0; mt < 4; mt++)
#pragma unroll
                for (int nt = 0; nt < 4; nt++) acc[mt][nt] = __builtin_amdgcn_mfma_f32_16x16x32_bf16(af[mt], bfr[nt], acc[mt][nt], 0, 0, 0);
        }
        if (kt + 1 < nk) {
            u16* Aw = As + (buf ^ 1) * G_AS; u16* Bw = Bs + (buf ^ 1) * G_BS;
            *(uint4*)&Aw[lr * GSTR + lk] = ra0; *(uint4*)&Aw[(lr + 64) * GSTR + lk] = ra1;
            *(uint4*)&Aw[(lr + 128) * GSTR + lk] = ra2; *(uint4*)&Aw[(lr + 192) * GSTR + lk] = ra3;
            *(uint4*)&Bw[lr * GSTR + lk] = rb0; *(uint4*)&Bw[(lr + 64) * GSTR + lk] = rb1;
        }
        __syncthreads();
    }
}

template <class SRC>
__device__ __forceinline__ void convert_wT(const float* __restrict__ W, int K, int N, u16* __restrict__ WT, int rows, SRC src, int gtid, int gnt) {
    const int kch = K >> 3;
    const int total = rows * kch;
    for (int i = gtid; i < total; i += gnt) {
        const int kc = i / rows, j = i - kc * rows;
        const int sc = src(j);
        uint4 v = make_uint4(0u, 0u, 0u, 0u);
        if (sc >= 0) {
            const float* wp = W + (size_t)(kc * 8) * N + sc;
            v.x = pack2(wp[0], wp[(size_t)N]); v.y = pack2(wp[2 * (size_t)N], wp[3 * (size_t)N]);
            v.z = pack2(wp[4 * (size_t)N], wp[5 * (size_t)N]); v.w = pack2(wp[6 * (size_t)N], wp[7 * (size_t)N]);
        }
        *(uint4*)&WT[(size_t)j * K + kc * 8] = v;
    }
}

__device__ void ph_prologue(const P& p, int bid, int nb, char* smem) {
    const int tid = get_tid(), lane = tid & 63, wv = tid >> 6;
    if (bid == 0) {
        if (tid < 32) { p.counts[tid] = 0; p.cursor[tid] = 0; }
        for (int i = tid; i < 8 * 64; i += NT) {
            const int bg = i >> 6, d = i & 63;
            p.kcb[((size_t)bg * 512 + 511) * 64 + d] = 0;
            p.vcT[(((size_t)bg * 8 + 7) * 64 + d) * 64 + 63] = 0;
        }
    }
    {
        const int gtid = bid * NT + tid, gnt = nb * NT;
        convert_wT(p.w_in, D_, CIN, p.winT, 3200, [](int j) { return j < 1280 ? j : (j < 3072 ? j + 24 : (j < 3096 ? 1280 + (j - 3072) : -1)); }, gtid, gnt);
        convert_wT(p.w_in, D_, CIN, p.wgT, 2048, [](int j) { return 3096 + j; }, gtid, gnt);
        convert_wT(p.wpa, 512, D_, p.wpaT, 1024, [](int j) { return j; }, gtid, gnt);
        convert_wT(p.wpb, 512, D_, p.wpbT, 1024, [](int j) { return j; }, gtid, gnt);
        convert_wT(p.wout, D_, D_, p.woutT, 1024, [](int j) { return j; }, gtid, gnt);
        convert_wT(p.w2, 64, 512, p.w2T, 512, [](int j) { return j; }, gtid, gnt);
        convert_wT(p.a2, 64, 512, p.a2T, 512, [](int j) { return j; }, gtid, gnt);
        convert_wT(p.g2, 128, 512, p.g2T, 512, [](int j) { return j; }, gtid, gnt);
    }
    for (int row = bid * NW + wv; row < NTOK; row += nb * NW) {
        const float* xr = p.x + (size_t)row * D_;
        float v[16];
        float ss = 0.f;
#pragma unroll
        for (int i = 0; i < 4; i++) {
            float4 t = *(const float4*)&xr[i * 256 + lane * 4];
            v[4 * i] = t.x; v[4 * i + 1] = t.y; v[4 * i + 2] = t.z; v[4 * i + 3] = t.w;
            ss += t.x * t.x + t.y * t.y + t.z * t.z + t.w * t.w;
        }
        ss = wave_sum(ss);
        const float rs = rsqrtf(ss * (1.f / D_) + 1e-6f);
#pragma unroll
        for (int i = 0; i < 4; i++) {
            const int c = i * 256 + lane * 4;
            float4 g = *(const float4*)&p.g_mix[c];
            uint2 o;
            o.x = pack2(v[4 * i] * rs * g.x, v[4 * i + 1] * rs * g.y);
            o.y = pack2(v[4 * i + 2] * rs * g.z, v[4 * i + 3] * rs * g.w);
            *(uint2*)&p.hbuf[(size_t)row * D_ + c] = o;
        }
    }
}

__device__ void ph_inproj(const P& p, int bid, int nb, char* smem) {
    u16* sm = (u16*)smem;
    const int tid = get_tid(), lane = tid & 63, wv = tid >> 6;
    const int wm = wv >> 1, wn = wv & 1;
    constexpr int NCT = 25;
    const int nitems = (NTOK / 256) * NCT;
    for (int it = bid; it < nitems; it += nb) {
        const int ct = it % NCT, rt = it / NCT;
        const int r0 = rt * 256, c0 = ct * 128;
        f32x4 acc[4][4];
        gemm_core(D_, [&](int r) { return p.hbuf + (size_t)(r0 + r) * D_; }, p.winT + (size_t)c0 * D_, D_, acc, sm);
        const int hc = c0 + wn * 64;
        const int rb = r0 + wm * 64;
        if (hc < 1280) {
            const bool rope = (hc < 640) || (hc >= 768 && hc < 896) || (hc >= 1024 && hc < 1152);
            const bool vtr = (hc >= 896 && hc < 1024) || (hc >= 1152);
            const int bb = rb >> 13, tb = rb & (S_ - 1);
#pragma unroll
            for (int mt = 0; mt < 4; mt++) {
#pragma unroll
                for (int nt = 0; nt < 2; nt++) {
                    const int d = nt * 16 + (lane & 15);
                    float o1[4], o2[4];
#pragma unroll
                    for (int j = 0; j < 4; j++) {
                        const int row = rb + mt * 16 + (lane >> 4) * 4 + j;
                        const float x1 = acc[mt][nt][j], x2 = acc[mt][nt + 2][j];
                        if (rope) {
                            const double ang = (double)p.pos[row] * ROPE_FREQ[d];
                            const double kq = rint(ang * 0.15915494309189535);
                            const float rr = (float)(fma(-kq, 6.283185307179586, ang) - kq * 2.4492935982947064e-16);
                            const float cs = cosf(rr), sn = sinf(rr);
                            o1[j] = x1 * cs - x2 * sn; o2[j] = x1 * sn + x2 * cs;
                        } else { o1[j] = x1; o2[j] = x2; }
                    }
                    if (hc < 512) {
#pragma unroll
                        for (int j = 0; j < 4; j++) {
                            const size_t row = rb + mt * 16 + (lane >> 4) * 4 + j;
                            p.q[row * 512 + hc + d] = f2bf(o1[j] * QSCALE);
                            p.q[row * 512 + hc + d + 32] = f2bf(o2[j] * QSCALE);
                        }
                    } else if (hc < 768) {
                        u16* dst = (hc < 640) ? p.kc : p.vc;
                        const int cb = (hc < 640) ? (hc - 512) : (hc - 640);
#pragma unroll
                        for (int j = 0; j < 4; j++) {
                            const size_t row = rb + mt * 16 + (lane >> 4) * 4 + j;
                            dst[row * 128 + cb + d] = f2bf(o1[j]);
                            dst[row * 128 + cb + d + 32] = f2bf(o2[j]);
                        }
                    } else if (!vtr) {
                        u16* dst = (hc < 896) ? p.ksl : p.kwn;
                        const int g = ((hc < 896) ? (hc - 768) : (hc - 1024)) >> 6;
#pragma unroll
                        for (int j = 0; j < 4; j++) {
                            const size_t t = tb + mt * 16 + (lane >> 4) * 4 + j;
                            dst[((size_t)(bb * 2 + g) * S_ + t) * 64 + d] = f2bf(o1[j]);
                            dst[((size_t)(bb * 2 + g) * S_ + t) * 64 + d + 32] = f2bf(o2[j]);
                        }
                    } else {
                        u16* dst = (hc < 1024) ? p.vslT : p.vwnT;
                        const int g = ((hc < 1024) ? (hc - 896) : (hc - 1152)) >> 6;
                        u16* base = dst + ((size_t)(bb * 2 + g) * 128 + (tb >> 6)) * 4096;
                        const int tl = mt * 16 + (lane >> 4) * 4;
                        uint2 v1, v2;
                        v1.x = pack2(o1[0], o1[1]); v1.y = pack2(o1[2], o1[3]);
                        v2.x = pack2(o2[0], o2[1]); v2.y = pack2(o2[2], o2[3]);
                        *(uint2*)&base[d * 64 + tl] = v1;
                        *(uint2*)&base[(d + 32) * 64 + tl] = v2;
                    }
                }
            }
        } else if (hc < 3072) {
#pragma unroll
            for (int mt = 0; mt < 4; mt++)
#pragma unroll
                for (int j = 0; j < 4; j++) {
                    const size_t row = rb + mt * 16 + (lane >> 4) * 4 + j;
#pragma unroll
                    for (int nt = 0; nt < 4; nt++) p.prw[row * CRW + (hc - 1280) + nt * 16 + (lane & 15)] = f2bf(acc[mt][nt][j]);
                }
        } else if (hc == 3072) {
#pragma unroll
            for (int mt = 0; mt < 4; mt++)
#pragma unroll
                for (int j = 0; j < 4; j++) {
                    const size_t row = rb + mt * 16 + (lane >> 4) * 4 + j;
#pragma unroll
                    for (int nt = 0; nt < 2; nt++) {
                        const int c = nt * 16 + (lane & 15);
                        if (c < 24) p.nsag[row * 24 + c] = sigmoidf_(acc[mt][nt][j]);
                    }
                }
        }
    }
}

__device__ __forceinline__ float gelu_tanh(float x) {
    const float c = 0.7978845608028654f;
    return 0.5f * x * (1.f + tanhf(c * (x + 0.044715f * x * x * x)));
}
__device__ void ph_compress(const P& p, int bid, int nb, char* smem) {
    float* blk = (float*)smem; float* hid = blk + 2048; float* part = hid + 256;
    const int tid = get_tid();
    const int nitems = 2 * B_ * NCMP * 2;
    for (int it = bid; it < nitems; it += nb) {
        int t = it;
        const int g = t & 1; t >>= 1;
        const int i = t % NCMP; t /= NCMP;
        const int b = t & 3; const int kv = t >> 2;
        const u16* src = kv ? p.vc : p.kc;
        const float* pe = kv ? p.pe_v : p.pe_k;
        const float* w1 = kv ? p.w1_v : p.w1_k;
        const float* b1 = kv ? p.b1_v : p.b1_k;
        const float* w2 = kv ? p.w2_v : p.w2_k;
        const float* b2 = kv ? p.b2_v : p.b2_k;
        __syncthreads();
        for (int e = tid; e < 2048; e += NT) {
            const int l = e >> 6, d = e & 63;
            blk[e] = bf2f(src[(size_t)(b * S_ + 16 * i + l) * 128 + g * 64 + d]) + pe[e];
        }
        __syncthreads();
        {
            const int j = tid & 255, half = tid >> 8;
            float a0 = 0.f, a1 = 0.f, a2 = 0.f, a3 = 0.f;
#pragma unroll 2
            for (int e = half * 1024; e < half * 1024 + 1024; e += 4) {
                a0 += blk[e] * w1[(size_t)e * 256 + j];
                a1 += blk[e + 1] * w1[(size_t)(e + 1) * 256 + j];
                a2 += blk[e + 2] * w1[(size_t)(e + 2) * 256 + j];
                a3 += blk[e + 3] * w1[(size_t)(e + 3) * 256 + j];
            }
            part[tid] = (a0 + a1) + (a2 + a3);
        }
        __syncthreads();
        if (tid < 256) hid[tid] = gelu_tanh(b1[tid] + part[tid] + part[tid + 256]);
        __syncthreads();
        if (tid < 64) {
            float a = b2[tid];
#pragma unroll 4
            for (int j = 0; j < 256; j++) a += hid[j] * w2[j * 64 + tid];
            const int bg = b * 2 + g;
            if (kv == 0) p.kcb[((size_t)bg * 512 + i) * 64 + tid] = f2bf(a);
            else p.vcT[(((size_t)bg * 8 + (i >> 6)) * 64 + tid) * 64 + (i & 63)] = f2bf(a);
        }
    }
}

constexpr int KSTR = 72;
struct Sub { f32x4 O[4]; float m, l; };
#define NEG_BIG (-1.0e30f)

__device__ __forceinline__ float xq_max(float v) {
    v = fmaxf(v, __shfl_xor(v, 16, 64));
    v = fmaxf(v, __shfl_xor(v, 32, 64));
    return v;
}
__device__ __forceinline__ float xq_sum(float v) {
    v += __shfl_xor(v, 16, 64);
    v += __shfl_xor(v, 32, 64);
    return v;
}
template <bool MASK, bool IMP, bool PV>
__device__ __forceinline__ void nsa_visit(const u16* Ks, const u16* Vs, const bf16x8* qp, Sub& s, int lo, int hi, int lane, float* e, float* p3) {
    const int kr = lane & 15, qq = lane >> 4;
    f32x4 S[4];
    const bf16x8 qf0 = qp[0], qf1 = qp[64];
#pragma unroll
    for (int kt = 0; kt < 4; kt++) {
        S[kt] = f32x4{0.f, 0.f, 0.f, 0.f};
#pragma unroll
        for (int ks = 0; ks < 2; ks++) {
            const bf16x8 a = *(const bf16x8*)&Ks[(kt * 16 + kr) * KSTR + ks * 32 + qq * 8];
            S[kt] = __builtin_amdgcn_mfma_f32_16x16x32_bf16(a, ks ? qf1 : qf0, S[kt], 0, 0, 0);
        }
    }
    float mx = NEG_BIG;
#pragma unroll
    for (int kt = 0; kt < 4; kt++)
#pragma unroll
        for (int r = 0; r < 4; r++) {
            if (MASK) { const int o = kt * 16 + qq * 4 + r; if (o < lo || o > hi) S[kt][r] = -INFINITY; }
            mx = fmaxf(mx, S[kt][r]);
        }
    mx = xq_max(mx);
    const float mnew = fmaxf(s.m, mx);
    const float alpha = __builtin_amdgcn_exp2f(s.m - mnew);
    s.m = mnew;
    float psum = 0.f;
#pragma unroll
    for (int kt = 0; kt < 4; kt++) {
#pragma unroll
        for (int r = 0; r < 4; r++) { S[kt][r] = __builtin_amdgcn_exp2f(S[kt][r] - mnew); }
        const float ee = (S[kt][0] + S[kt][1]) + (S[kt][2] + S[kt][3]);
        psum += ee;
        if (IMP) { e[kt] = ee; p3[kt] = S[kt][3]; }
    }
    s.l = s.l * alpha + psum;
    if (PV) {
#pragma unroll
        for (int dt = 0; dt < 4; dt++)
#pragma unroll
            for (int r = 0; r < 4; r++) s.O[dt][r] *= alpha;
        bf16x8 pb[2];
#pragma unroll
        for (int k2 = 0; k2 < 2; k2++) {
            union { bf16x8 v; unsigned u[4]; } t;
            t.u[0] = pack2(S[2 * k2][0], S[2 * k2][1]); t.u[1] = pack2(S[2 * k2][2], S[2 * k2][3]);
            t.u[2] = pack2(S[2 * k2 + 1][0], S[2 * k2 + 1][1]); t.u[3] = pack2(S[2 * k2 + 1][2], S[2 * k2 + 1][3]);
            pb[k2] = t.v;
        }
#pragma unroll
        for (int dt = 0; dt < 4; dt++)
#pragma unroll
            for (int k2 = 0; k2 < 2; k2++) {
                union { bf16x8 v; uint2 h[2]; } a;
                a.h[0] = *(const uint2*)&Vs[(dt * 16 + kr) * KSTR + k2 * 32 + qq * 4];
                a.h[1] = *(const uint2*)&Vs[(dt * 16 + kr) * KSTR + k2 * 32 + 16 + qq * 4];
                s.O[dt] = __builtin_amdgcn_mfma_f32_16x16x32_bf16(a.v, pb[k2], s.O[dt], 0, 0, 0);
            }
    }
}
template <int MODE>
__device__ __forceinline__ void nsa_fold(Sub& s, float* ol, float gate) {
    const float lt = xq_sum(s.l);
    const float sc = (lt > 0.f) ? gate / lt : 0.f;
#pragma unroll
    for (int dt = 0; dt < 4; dt++)
#pragma unroll
        for (int r = 0; r < 4; r++) {
            float v = s.O[dt][r] * sc;
            if (MODE == 1) v += ol[(dt * 4 + r) * 64];
            ol[(dt * 4 + r) * 64] = v;
            s.O[dt][r] = 0.f;
        }
    s.m = NEG_BIG; s.l = 0.f;
}

__device__ void ph_nsa(const P& p, int bid, int nb, char* smem) {
    u16* Kb = (u16*)smem;
    u16* Vb = Kb + 2 * 64 * KSTR;
    unsigned* selm = (unsigned*)(Vb + 2 * 64 * KSTR);
    int* blist = (int*)(selm + 256);
    int* nlistp = blist + 128;
    float* impl = (float*)(nlistp + 4);
    float* outl = impl;
    bf16x8* qsm = (bf16x8*)(outl + NW * 2 * 16 * 64);
    const int tid = get_tid(), lane = tid & 63, wv = tid >> 6;
    const int kr = lane & 15, qq = lane >> 4, ts = kr >> 2, hh = kr & 3;
    const int srow = tid >> 3, sch = tid & 7;
    float* myimp = impl + wv * (32 * 2 * 16);
    const int nitems = B_ * 2 * 128;
    for (int it = bid; it < nitems; it += nb) {
        const int tt = 127 - (it >> 3);
        const int bg = it & 7, b = bg >> 1, g = bg & 1;
        const int t0 = tt * 64, cur = tt;
        const int head = g * 4 + hh;
        Sub st[2];
        float* myout = outl + wv * (2 * 16 * 64) + lane;
        int tl[2]; size_t ntok[2];
#pragma unroll
        for (int u = 0; u < 2; u++) {
            tl[u] = 8 * wv + 4 * u + ts;
            ntok[u] = (size_t)b * S_ + t0 + tl[u];
#pragma unroll
            for (int ks = 0; ks < 2; ks++) qsm[((wv * 2 + u) * 2 + ks) * 64 + lane] = *(const bf16x8*)&p.q[ntok[u] * 512 + head * 64 + ks * 32 + qq * 8];
#pragma unroll
            for (int dt = 0; dt < 4; dt++) st[u].O[dt] = f32x4{0.f, 0.f, 0.f, 0.f};
            st[u].m = NEG_BIG; st[u].l = 0.f;
        }
        const u16* kcb = p.kcb + (size_t)bg * 512 * 64;
        const u16* vcT = p.vcT + (size_t)bg * 8 * 4096;
        int nv[2];
#pragma unroll
        for (int u = 0; u < 2; u++) { const int t = t0 + tl[u]; nv[u] = (t >= 31) ? min((t - 31) / 16 + 1, NCMP) : 0; }
        const int tmax = t0 + 63;
        const int nvmax = (tmax >= 31) ? min((tmax - 31) / 16 + 1, NCMP) : 0;
        const int nvb = (nvmax + 63) >> 6;
        __syncthreads();
        for (int kb = 0; kb < nvb; kb++) {
            *(uint4*)&Kb[srow * KSTR + sch * 8] = *(const uint4*)&kcb[((size_t)kb * 64 + srow) * 64 + sch * 8];
            __syncthreads();
#pragma unroll
            for (int u = 0; u < 2; u++) nsa_visit<true, false, false>(Kb, Vb, qsm + (wv * 2 + u) * 128 + lane, st[u], 0, nv[u] - kb * 64 - 1, lane, nullptr, nullptr);
            __syncthreads();
        }
        float invl[2];
#pragma unroll
        for (int u = 0; u < 2; u++) { const float lt = xq_sum(st[u].l); invl[u] = (lt > 0.f) ? 1.f / lt : 0.f; st[u].l = 0.f; }
        float carry[2] = {0.f, 0.f};
        for (int kb = 0; kb < nvb; kb++) {
            *(uint4*)&Kb[srow * KSTR + sch * 8] = *(const uint4*)&kcb[((size_t)kb * 64 + srow) * 64 + sch * 8];
            *(uint4*)&Vb[srow * KSTR + sch * 8] = *(const uint4*)&vcT[((size_t)kb * 64 + srow) * 64 + sch * 8];
            __syncthreads();
#pragma unroll
            for (int u = 0; u < 2; u++) {
                float e[4], p3[4];
                nsa_visit<true, true, true>(Kb, Vb, qsm + (wv * 2 + u) * 128 + lane, st[u], 0, nv[u] - kb * 64 - 1, lane, e, p3);
#pragma unroll
                for (int kt = 0; kt < 4; kt++) {
                    float ev = e[kt] * invl[u], pv = p3[kt] * invl[u];
                    ev += __shfl_xor(ev, 1, 64); ev += __shfl_xor(ev, 2, 64);
                    pv += __shfl_xor(pv, 1, 64); pv += __shfl_xor(pv, 2, 64);
                    const float sh = __shfl(pv, (lane - 16) & 63, 64);
                    const float nbv = (qq == 0) ? carry[u] : sh;
                    carry[u] = sh;
                    myimp[((kb * 4 + kt) * 2 + u) * 16 + ts * 4 + qq] = ev + nbv;
                }
            }
            __syncthreads();
        }
#pragma unroll
        for (int u = 0; u < 2; u++) {
            float impv[32];
#pragma unroll
            for (int kk = 0; kk < 32; kk++) impv[kk] = (kk < nvb * 4) ? myimp[(kk * 2 + u) * 16 + ts * 4 + qq] : 0.f;
            unsigned cmask = 0u;
#pragma unroll
            for (int kk = 0; kk < 32; kk++) { const int j = 4 * kk + qq; if (j >= 1 && j <= cur - 2) cmask |= (1u << kk); }
            unsigned sel = 0u;
            const int ncand = max(0, cur - 2);
            const int nforced = (cur >= 2) ? 3 : (cur + 1);
            const int need = 16 - nforced;
            if (ncand <= need) sel = cmask;
            else {
                for (int rnd = 0; rnd < need; rnd++) {
                    float best = -1.f; int bk = 0;
#pragma unroll
                    for (int kk = 0; kk < 32; kk++) {
                        const float v = ((cmask >> kk) & 1u) ? impv[kk] : -1.f;
                        if (v > best) { best = v; bk = kk; }
                    }
                    int bj = (best >= 0.f) ? (4 * bk + qq) : 9999;
#pragma unroll
                    for (int o = 16; o <= 32; o <<= 1) {
                        const float ov = __shfl_xor(best, o, 64); const int oj = __shfl_xor(bj, o, 64);
                        if (ov > best || (ov == best && oj < bj)) { best = ov; bj = oj; }
                    }
                    if (bj < 512 && (bj & 3) == qq) { cmask &= ~(1u << (bj >> 2)); sel |= (1u << (bj >> 2)); }
                }
            }
            if (qq == 0) sel |= 1u;
            if ((cur & 3) == qq) sel |= (1u << (cur >> 2));
            if (cur >= 1 && ((cur - 1) & 3) == qq) sel |= (1u << ((cur - 1) >> 2));
            if (hh == 0) selm[tl[u] * 4 + qq] = sel;
        }
        __syncthreads();
#pragma unroll
        for (int u = 0; u < 2; u++) nsa_fold<0>(st[u], myout + u * 1024, p.nsag[ntok[u] * 24 + head * 3 + 0]);
        bool need_j = false; int lrank = 0;
        {
            const int t2 = get_tid();
            if (t2 < 128) {
                const int j = t2; unsigned any = 0u;
                for (int tk = 0; tk < 64; tk++) any |= (selm[tk * 4 + (j & 3)] >> (j >> 2)) & 1u;
                need_j = (any != 0u) && (j <= cur);
                const unsigned long long bal = __ballot(need_j);
                lrank = __popcll(bal & ((1ull << (t2 & 63)) - 1ull));
                if ((t2 & 63) == 0) nlistp[t2 >> 6] = __popcll(bal);
            }
            __syncthreads();
            if (t2 < 128 && need_j) blist[lrank + ((t2 >= 64) ? nlistp[0] : 0)] = t2;
            __syncthreads();
        }
        const int nlist = nlistp[0] + nlistp[1];
        const u16* ksl = p.ksl + (size_t)bg * S_ * 64;
        const u16* vslT = p.vslT + (size_t)bg * 128 * 4096;
        {
            uint4 kreg, vreg;
            {
                const int j = blist[0];
                kreg = *(const uint4*)&ksl[((size_t)j * 64 + srow) * 64 + sch * 8];
                vreg = *(const uint4*)&vslT[((size_t)j * 64 + srow) * 64 + sch * 8];
                *(uint4*)&Kb[srow * KSTR + sch * 8] = kreg; *(uint4*)&Vb[srow * KSTR + sch * 8] = vreg;
            }
            __syncthreads();
            for (int idx = 0; idx < nlist; idx++) {
                const int j = blist[idx];
                const int buf = idx & 1;
                if (idx + 1 < nlist) {
                    const int j2 = blist[idx + 1];
                    kreg = *(const uint4*)&ksl[((size_t)j2 * 64 + srow) * 64 + sch * 8];
                    vreg = *(const uint4*)&vslT[((size_t)j2 * 64 + srow) * 64 + sch * 8];
                }
                const u16* Ks = Kb + buf * 64 * KSTR; const u16* Vs = Vb + buf * 64 * KSTR;
#pragma unroll
                for (int u = 0; u < 2; u++) {
                    const unsigned w = selm[tl[u] * 4 + (j & 3)];
                    const bool sb = ((w >> (j >> 2)) & 1u) != 0u;
                    if (__any(sb)) {
                        const int hi = sb ? ((j == cur) ? tl[u] : 63) : -1;
                        if (__all(sb) && j != cur) nsa_visit<false, false, true>(Ks, Vs, qsm + (wv * 2 + u) * 128 + lane, st[u], 0, 63, lane, nullptr, nullptr);
                        else nsa_visit<true, false, true>(Ks, Vs, qsm + (wv * 2 + u) * 128 + lane, st[u], 0, hi, lane, nullptr, nullptr);
                    }
                }
                if (idx + 1 < nlist) {
                    *(uint4*)&Kb[(buf ^ 1) * 64 * KSTR + srow * KSTR + sch * 8] = kreg;
                    *(uint4*)&Vb[(buf ^ 1) * 64 * KSTR + srow * KSTR + sch * 8] = vreg;
                }
                __syncthreads();
            }
        }
#pragma unroll
        for (int u = 0; u < 2; u++) nsa_fold<1>(st[u], myout + u * 1024, p.nsag[ntok[u] * 24 + head * 3 + 1]);
        const u16* kwn = p.kwn + (size_t)bg * S_ * 64;
        const u16* vwnT = p.vwnT + (size_t)bg * 128 * 4096;
        {
            const int jlo = max(0, cur - 8);
            uint4 kreg, vreg;
            kreg = *(const uint4*)&kwn[((size_t)jlo * 64 + srow) * 64 + sch * 8];
            vreg = *(const uint4*)&vwnT[((size_t)jlo * 64 + srow) * 64 + sch * 8];
            *(uint4*)&Kb[srow * KSTR + sch * 8] = kreg; *(uint4*)&Vb[srow * KSTR + sch * 8] = vreg;
            __syncthreads();
            for (int j = jlo; j <= cur; j++) {
                const int buf = (j - jlo) & 1;
                if (j < cur) {
                    kreg = *(const uint4*)&kwn[((size_t)(j + 1) * 64 + srow) * 64 + sch * 8];
                    vreg = *(const uint4*)&vwnT[((size_t)(j + 1) * 64 + srow) * 64 + sch * 8];
                }
                const u16* Ks = Kb + buf * 64 * KSTR; const u16* Vs = Vb + buf * 64 * KSTR;
#pragma unroll
                for (int u = 0; u < 2; u++) {
                    if (j == cur) nsa_visit<true, false, true>(Ks, Vs, qsm + (wv * 2 + u) * 128 + lane, st[u], 0, tl[u], lane, nullptr, nullptr);
                    else if (j == cur - 8) nsa_visit<true, false, true>(Ks, Vs, qsm + (wv * 2 + u) * 128 + lane, st[u], tl[u] + 1, 63, lane, nullptr, nullptr);
                    else nsa_visit<false, false, true>(Ks, Vs, qsm + (wv * 2 + u) * 128 + lane, st[u], 0, 63, lane, nullptr, nullptr);
                }
                if (j < cur) {
                    *(uint4*)&Kb[(buf ^ 1) * 64 * KSTR + srow * KSTR + sch * 8] = kreg;
                    *(uint4*)&Vb[(buf ^ 1) * 64 * KSTR + srow * KSTR + sch * 8] = vreg;
                }
                __syncthreads();
            }
        }
#pragma unroll
        for (int u = 0; u < 2; u++) {
            nsa_fold<1>(st[u], myout + u * 1024, p.nsag[ntok[u] * 24 + head * 3 + 2]);
            const float* ol = myout + u * 1024;
#pragma unroll
            for (int dt = 0; dt < 4; dt++) {
                uint2 o; o.x = pack2(ol[(dt * 4 + 0) * 64], ol[(dt * 4 + 1) * 64]); o.y = pack2(ol[(dt * 4 + 2) * 64], ol[(dt * 4 + 3) * 64]);
                *(uint2*)&p.oa[ntok[u] * 512 + head * 64 + dt * 16 + qq * 4] = o;
            }
        }
    }
}

constexpr int RS = 72;
constexpr int RSLOT = 64 * RS;
__device__ __forceinline__ void mm64(const u16* A, int lda, const u16* Bz, int ldb, f32x4 (&acc)[2], int lane, int wv) {
    const int mt = wv >> 1, nt0 = (wv & 1) * 2, kr = lane & 15, qq = lane >> 4;
#pragma unroll
    for (int ks = 0; ks < 2; ks++) {
        const bf16x8 a = *(const bf16x8*)&A[(mt * 16 + kr) * lda + ks * 32 + qq * 8];
#pragma unroll
        for (int i = 0; i < 2; i++) {
            const bf16x8 b = *(const bf16x8*)&Bz[((nt0 + i) * 16 + kr) * ldb + ks * 32 + qq * 8];
            acc[i] = __builtin_amdgcn_mfma_f32_16x16x32_bf16(a, b, acc[i], 0, 0, 0);
        }
    }
}
__device__ __forceinline__ void st_t(u16* dst, int ld, const f32x4& v, int mt, int nt, int lane) {
    uint2 o; o.x = pack2(v[0], v[1]); o.y = pack2(v[2], v[3]);
    *(uint2*)&dst[(nt * 16 + (lane & 15)) * ld + mt * 16 + (lane >> 4) * 4] = o;
}
__device__ __forceinline__ void st_n(u16* dst, int ld, const f32x4& v, int mt, int nt, int lane) {
#pragma unroll
    for (int r = 0; r < 4; r++) dst[(mt * 16 + (lane >> 4) * 4 + r) * ld + nt * 16 + (lane & 15)] = f2bf(v[r]);
}
#define ZACC(a) { a[0] = f32x4{0.f, 0.f, 0.f, 0.f}; a[1] = f32x4{0.f, 0.f, 0.f, 0.f}; }

__device__ void ph_rwkv_chunk(const P& p, int bid, int nb, char* smem) {
    u16* sl = (u16*)smem;
    float* tot = (float*)(sl + 14 * RSLOT);
    float* gl = tot + 512;
#define RW_IDX const int tid = get_tid(), lane = tid & 63, wv = tid >> 6, mt = wv >> 1, nt0 = (wv & 1) * 2, kr = lane & 15, qq = lane >> 4; (void)mt; (void)nt0; (void)kr; (void)qq; (void)lane;
    const int nitems = B_ * 8 * 128;
    for (int it = bid; it < nitems; it += nb) {
        const int h = it & 7, c = (it >> 3) & 127, b = it >> 10;
        const size_t n0 = (size_t)b * S_ + c * 64;
        u16* cd = p.cdat + ((size_t)((b * 8 + h) * 128 + c)) * 4 * 4096;
        __syncthreads();
        {
            RW_IDX
            const int t = tid >> 3, part = tid & 7;
            const size_t n = n0 + t;
            const bool hasprev = (c * 64 + t) > 0;
            u16* dst = sl + (part >> 1) * RSLOT + t * RS + (part & 1) * 32;
#pragma unroll
            for (int j = 0; j < 4; j++) {
                const int col = 1536 + part * 32 + j * 8;
                const uint4 cu = *(const uint4*)&p.prw[n * CRW + col];
                uint4 pv = make_uint4(0u, 0u, 0u, 0u);
                if (hasprev) pv = *(const uint4*)&p.prw[(n - 1) * CRW + col];
                const unsigned cw[4] = {cu.x, cu.y, cu.z, cu.w}, pw[4] = {pv.x, pv.y, pv.z, pv.w};
                unsigned ow[4];
#pragma unroll
                for (int e2 = 0; e2 < 4; e2++) {
                    float x0 = __uint_as_float(cw[e2] << 16), x1 = __uint_as_float(cw[e2] & 0xFFFF0000u);
                    const float q0 = __uint_as_float(pw[e2] << 16), q1 = __uint_as_float(pw[e2] & 0xFFFF0000u);
                    x0 = x0 + (q0 - x0) * p.mu[col + 2 * e2]; x1 = x1 + (q1 - x1) * p.mu[col + 2 * e2 + 1];
                    if (part < 2) { x0 = tanhf(x0); x1 = tanhf(x1); }
                    else if (part >= 4) { x0 = sigmoidf_(x0); x1 = sigmoidf_(x1); }
                    ow[e2] = pack2(x0, x1);
                }
                *(uint4*)&dst[j * 8] = make_uint4(ow[0], ow[1], ow[2], ow[3]);
            }
        }
        __syncthreads();
        float* LW = (float*)(sl + 8 * RSLOT); float* LA = (float*)(sl + 10 * RSLOT);
        {
            RW_IDX
            f32x4 acc[2];
            ZACC(acc); mm64(sl, RS, p.w2T + (size_t)h * 64 * 64, 64, acc, lane, wv);
#pragma unroll
            for (int i = 0; i < 2; i++)
#pragma unroll
                for (int r = 0; r < 4; r++) {
                    const int t = mt * 16 + qq * 4 + r, cc = (nt0 + i) * 16 + kr;
                    const float wl = p.w0[h * 64 + cc] + acc[i][r];
                    const float z = -wl;
                    const float sp = fmaxf(z, 0.f) + log1pf(__expf(-fabsf(z)));
                    LW[t * 64 + cc] = -__expf(-sp - 0.5f);
                }
            ZACC(acc); mm64(sl + RSLOT, RS, p.a2T + (size_t)h * 64 * 64, 64, acc, lane, wv);
#pragma unroll
            for (int i = 0; i < 2; i++)
#pragma unroll
                for (int r = 0; r < 4; r++) {
                    const int t = mt * 16 + qq * 4 + r, cc = (nt0 + i) * 16 + kr;
                    LA[t * 64 + cc] = sigmoidf_(p.a0[h * 64 + cc] + acc[i][r]);
                }
            ZACC(acc);
            mm64(sl + 2 * RSLOT, RS, p.g2T + (size_t)h * 64 * 128, 128, acc, lane, wv);
            mm64(sl + 3 * RSLOT, RS, p.g2T + (size_t)h * 64 * 128 + 64, 128, acc, lane, wv);
#pragma unroll
            for (int i = 0; i < 2; i++)
#pragma unroll
                for (int r = 0; r < 4; r++) {
                    const int t = mt * 16 + qq * 4 + r, cc = (nt0 + i) * 16 + kr;
                    p.ob[(n0 + t) * 512 + h * 64 + cc] = f2bf(acc[i][r]);
                }
        }
        __syncthreads();
        {
            RW_IDX
            const int ch = h * 64 + lane;
            const float mur = p.mu[ch], muk = p.mu[512 + ch], muv = p.mu[1024 + ch];
            const float kkw = p.k_k[ch], kaw = p.k_a[ch], rkw = p.r_k[ch];
            float rr[8], k2[8], vv[8], kkn[8], aa[8], lg[8], cs[8];
            float run = 0.f;
#pragma unroll
            for (int i = 0; i < 8; i++) {
                const int t = wv * 8 + i; const size_t n = n0 + t;
                const u16* cr = p.prw + n * CRW;
                float r = bf2f(cr[ch]), k = bf2f(cr[512 + ch]), v = bf2f(cr[1024 + ch]);
                float pr = 0.f, pk = 0.f, pv = 0.f;
                if (c * 64 + t > 0) { const u16* pp = cr - CRW; pr = bf2f(pp[ch]); pk = bf2f(pp[512 + ch]); pv = bf2f(pp[1024 + ch]); }
                r = r + (pr - r) * mur; k = k + (pk - k) * muk; v = v + (pv - v) * muv;
                const float a = LA[t * 64 + lane];
                lg[i] = LW[t * 64 + lane];
                float kk = k * kkw;
                const float nrm = fmaxf(sqrtf(wave_sum(kk * kk)), 1e-12f);
                kkn[i] = kk / nrm;
                k2[i] = k * (1.f + (a - 1.f) * kaw);
                const float bon = wave_sum(r * k2[i] * rkw);
                if (lane == 0) p.bon[n * 8 + h] = bon;
                rr[i] = r; vv[i] = v; aa[i] = a;
                run += lg[i]; cs[i] = run;
            }
            tot[wv * 64 + lane] = run;
            __syncthreads();
            float off = 0.f, cumL = 0.f;
#pragma unroll
            for (int w2 = 0; w2 < 8; w2++) { const float tv = tot[w2 * 64 + lane]; cumL += tv; if (w2 < wv) off += tv; }
            if (wv == 0) gl[lane] = __expf(cumL);
            unsigned pa[4], pb[4], pk4[4], pv4[4];
#pragma unroll
            for (int i = 0; i < 8; i += 2) {
                float at[2], bt[2], kt[2], rt[2];
#pragma unroll
                for (int e2 = 0; e2 < 2; e2++) {
                    const int ii = i + e2; const int t = wv * 8 + ii;
                    const float cm = off + cs[ii];
                    const float g = __expf(cm), gp = __expf(cm - lg[ii]), gi = __expf(-cm);
                    at[e2] = -kkn[ii] * gp; bt[e2] = kkn[ii] * aa[ii] * gi; kt[e2] = k2[ii] * gi; rt[e2] = rr[ii] * g;
                    sl[0 * RSLOT + t * RS + lane] = f2bf(at[e2]);
                    sl[1 * RSLOT + t * RS + lane] = f2bf(bt[e2]);
                    sl[2 * RSLOT + t * RS + lane] = f2bf(kt[e2]);
                    sl[3 * RSLOT + t * RS + lane] = f2bf(rt[e2]);
                }
                pa[i >> 1] = pack2(at[0], at[1]); pb[i >> 1] = pack2(bt[0], bt[1]);
                pk4[i >> 1] = pack2(kt[0], kt[1]); pv4[i >> 1] = pack2(vv[i], vv[i + 1]);
            }
            *(uint4*)&sl[4 * RSLOT + lane * RS + wv * 8] = make_uint4(pa[0], pa[1], pa[2], pa[3]);
            *(uint4*)&sl[5 * RSLOT + lane * RS + wv * 8] = make_uint4(pb[0], pb[1], pb[2], pb[3]);
            *(uint4*)&sl[6 * RSLOT + lane * RS + wv * 8] = make_uint4(pk4[0], pk4[1], pk4[2], pk4[3]);
            *(uint4*)&sl[7 * RSLOT + lane * RS + wv * 8] = make_uint4(pv4[0], pv4[1], pv4[2], pv4[3]);
        }
        __syncthreads();
        {
            RW_IDX
            f32x4 acc[2];
            ZACC(acc); mm64(sl + 1 * RSLOT, RS, sl + 0 * RSLOT, RS, acc, lane, wv);
#pragma unroll
            for (int i = 0; i < 2; i++) {
                f32x4 pm;
#pragma unroll
                for (int r = 0; r < 4; r++) {
                    const int m = mt * 16 + qq * 4 + r, n = (nt0 + i) * 16 + kr;
                    if (!(m < n)) acc[i][r] = 0.f;
                    pm[r] = acc[i][r] + ((m == n) ? 1.f : 0.f);
                }
                st_t(sl + 8 * RSLOT, RS, acc[i], mt, nt0 + i, lane);
                st_n(sl + 9 * RSLOT, RS, acc[i], mt, nt0 + i, lane);
                st_t(sl + 13 * RSLOT, RS, pm, mt, nt0 + i, lane);
            }
            ZACC(acc); mm64(sl + 0 * RSLOT, RS, sl + 2 * RSLOT, RS, acc, lane, wv);
#pragma unroll
            for (int i = 0; i < 2; i++) {
#pragma unroll
                for (int r = 0; r < 4; r++) { const int m = mt * 16 + qq * 4 + r, n = (nt0 + i) * 16 + kr; if (!(m > n)) acc[i][r] = 0.f; }
                st_t(sl + 10 * RSLOT, RS, acc[i], mt, nt0 + i, lane);
            }
            ZACC(acc); mm64(sl + 1 * RSLOT, RS, sl + 3 * RSLOT, RS, acc, lane, wv);
#pragma unroll
            for (int i = 0; i < 2; i++) {
#pragma unroll
                for (int r = 0; r < 4; r++) { const int m = mt * 16 + qq * 4 + r, n = (nt0 + i) * 16 + kr; if (m > n) acc[i][r] = 0.f; }
                st_t(sl + 11 * RSLOT, RS, acc[i], mt, nt0 + i, lane);
            }
            ZACC(acc); mm64(sl + 2 * RSLOT, RS, sl + 3 * RSLOT, RS, acc, lane, wv);
#pragma unroll
            for (int i = 0; i < 2; i++) {
#pragma unroll
                for (int r = 0; r < 4; r++) { const int m = mt * 16 + qq * 4 + r, n = (nt0 + i) * 16 + kr; if (m > n) acc[i][r] = 0.f; }
                st_t(sl + 12 * RSLOT, RS, acc[i], mt, nt0 + i, lane);
            }
        }
        __syncthreads();
        u16* X = sl + 8 * RSLOT; u16* XT = sl + 9 * RSLOT; u16* X2 = sl + 0 * RSLOT; u16* X2T = sl + 1 * RSLOT;
        u16* Pc = sl + 13 * RSLOT; u16* Pn = sl + 2 * RSLOT;
#pragma unroll 1
        for (int j = 1; j <= 6; j++) {
            RW_IDX
            f32x4 acc[2];
            if (j <= 5) {
                ZACC(acc); mm64(X, RS, XT, RS, acc, lane, wv);
#pragma unroll
                for (int i = 0; i < 2; i++) { st_t(X2T, RS, acc[i], mt, nt0 + i, lane); st_n(X2, RS, acc[i], mt, nt0 + i, lane); }
            }
            if (j >= 2) {
                ZACC(acc); mm64(XT, RS, Pc, RS, acc, lane, wv);
#pragma unroll
                for (int i = 0; i < 2; i++) {
                    const uint2 pv = *(const uint2*)&Pc[((nt0 + i) * 16 + kr) * RS + mt * 16 + qq * 4];
                    acc[i][0] += __uint_as_float(pv.x << 16); acc[i][1] += __uint_as_float(pv.x & 0xFFFF0000u);
                    acc[i][2] += __uint_as_float(pv.y << 16); acc[i][3] += __uint_as_float(pv.y & 0xFFFF0000u);
                    st_t(Pn, RS, acc[i], mt, nt0 + i, lane);
                }
            }
            __syncthreads();
            if (j >= 2) { u16* tp = Pc; Pc = Pn; Pn = tp; }
            if (j <= 5) { u16* tx = X; X = X2; X2 = tx; tx = XT; XT = X2T; X2T = tx; }
        }
        u16* TT = Pc;
        {
            RW_IDX
            f32x4 acc[2];
            ZACC(acc); mm64(TT, RS, sl + 4 * RSLOT, RS, acc, lane, wv);
#pragma unroll
            for (int i = 0; i < 2; i++) st_t(sl + 0 * RSLOT, RS, acc[i], mt, nt0 + i, lane);
            ZACC(acc); mm64(sl + 10 * RSLOT, RS, TT, RS, acc, lane, wv);
#pragma unroll
            for (int i = 0; i < 2; i++) st_t(sl + 8 * RSLOT, RS, acc[i], mt, nt0 + i, lane);
        }
        __syncthreads();
        {
            RW_IDX
            f32x4 acc[2];
            ZACC(acc); mm64(sl + 8 * RSLOT, RS, sl + 7 * RSLOT, RS, acc, lane, wv);
#pragma unroll
            for (int i = 0; i < 2; i++) st_t(sl + 9 * RSLOT, RS, acc[i], mt, nt0 + i, lane);
            ZACC(acc); mm64(sl + 0 * RSLOT, RS, sl + 5 * RSLOT, RS, acc, lane, wv);
#pragma unroll
            for (int i = 0; i < 2; i++) {
                const int n = (nt0 + i) * 16 + kr; const float gn = gl[n];
#pragma unroll
                for (int r = 0; r < 4; r++) { const int m = mt * 16 + qq * 4 + r; acc[i][r] = acc[i][r] * gn + ((m == n) ? gn : 0.f); }
                st_t(cd, 64, acc[i], mt, nt0 + i, lane);
            }
            ZACC(acc); mm64(sl + 0 * RSLOT, RS, sl + 11 * RSLOT, RS, acc, lane, wv);
#pragma unroll
            for (int i = 0; i < 2; i++) {
                const uint2 rv = *(const uint2*)&sl[3 * RSLOT + ((nt0 + i) * 16 + kr) * RS + mt * 16 + qq * 4];
                acc[i][0] += __uint_as_float(rv.x << 16); acc[i][1] += __uint_as_float(rv.x & 0xFFFF0000u);
                acc[i][2] += __uint_as_float(rv.y << 16); acc[i][3] += __uint_as_float(rv.y & 0xFFFF0000u);
                st_t(cd + 2 * 4096, 64, acc[i], mt, nt0 + i, lane);
            }
        }
        __syncthreads();
        {
            RW_IDX
            f32x4 acc[2];
            ZACC(acc);
            mm64(sl + 5 * RSLOT, RS, sl + 9 * RSLOT, RS, acc, lane, wv);
            mm64(sl + 6 * RSLOT, RS, sl + 7 * RSLOT, RS, acc, lane, wv);
#pragma unroll
            for (int i = 0; i < 2; i++) {
#pragma unroll
                for (int r = 0; r < 4; r++) acc[i][r] *= gl[mt * 16 + qq * 4 + r];
                st_t(cd + 1 * 4096, 64, acc[i], mt, nt0 + i, lane);
            }
            ZACC(acc);
            mm64(sl + 9 * RSLOT, RS, sl + 11 * RSLOT, RS, acc, lane, wv);
            mm64(sl + 7 * RSLOT, RS, sl + 12 * RSLOT, RS, acc, lane, wv);
#pragma unroll
            for (int i = 0; i < 2; i++) st_t(cd + 3 * 4096, 64, acc[i], mt, nt0 + i, lane);
        }
    }
}

__device__ void ph_rwkv_seq(const P& p, int bid, int nb, char* smem) {
    u16* SL = (u16*)smem;
    float* red = (float*)(SL + 2 * RSLOT);
    const int tid = get_tid(), lane = tid & 63, wv = tid >> 6;
    const int kr = lane & 15, qq = lane >> 4, chn = wv >> 2, vt = wv & 3;
    for (int pair = bid; pair < B_ * 4; pair += nb) {
        const int bh = pair * 2 + chn, b = bh >> 3, h = bh & 7;
        u16* mySL = SL + chn * RSLOT;
        __syncthreads();
#pragma unroll
        for (int ks = 0; ks < 2; ks++) *(uint4*)&mySL[(vt * 16 + kr) * RS + ks * 32 + qq * 8] = make_uint4(0u, 0u, 0u, 0u);
        const u16* cbase = p.cdat + (size_t)bh * 128 * 4 * 4096;
        const int vch = h * 64 + vt * 16 + qq * 4;
        float lnw[4], lnb[4], muv[4];
#pragma unroll
        for (int r = 0; r < 4; r++) { lnw[r] = p.ln_w[vch + r]; lnb[r] = p.ln_b[vch + r]; muv[r] = p.mu[1024 + vch + r]; }
        bf16x8 GA[4][2], QB[4][2];
#pragma unroll
        for (int m4 = 0; m4 < 4; m4++)
#pragma unroll
            for (int ks = 0; ks < 2; ks++) {
                GA[m4][ks] = *(const bf16x8*)&cbase[(m4 * 16 + kr) * 64 + ks * 32 + qq * 8];
                QB[m4][ks] = *(const bf16x8*)&cbase[2 * 4096 + (m4 * 16 + kr) * 64 + ks * 32 + qq * 8];
            }
#pragma unroll 1
        for (int c = 0; c < 128; c++) {
            const u16* cd = cbase + (size_t)c * 4 * 4096;
            bf16x8 GAn[4][2], QBn[4][2];
            const u16* cdn = cd + ((c < 127) ? 4 * 4096 : 0);
#pragma unroll
            for (int m4 = 0; m4 < 4; m4++)
#pragma unroll
                for (int ks = 0; ks < 2; ks++) {
                    GAn[m4][ks] = *(const bf16x8*)&cdn[(m4 * 16 + kr) * 64 + ks * 32 + qq * 8];
                    QBn[m4][ks] = *(const bf16x8*)&cdn[2 * 4096 + (m4 * 16 + kr) * 64 + ks * 32 + qq * 8];
                }
            uint2 hin[4], yin[4];
#pragma unroll
            for (int m4 = 0; m4 < 4; m4++) {
                hin[m4] = *(const uint2*)&cd[1 * 4096 + (vt * 16 + kr) * 64 + m4 * 16 + qq * 4];
                yin[m4] = *(const uint2*)&cd[3 * 4096 + (m4 * 16 + kr) * 64 + vt * 16 + qq * 4];
            }
            bf16x8 Z0[2];
#pragma unroll
            for (int ks = 0; ks < 2; ks++) Z0[ks] = *(const bf16x8*)&mySL[(vt * 16 + kr) * RS + ks * 32 + qq * 8];
            f32x4 zs[4];
#pragma unroll
            for (int m4 = 0; m4 < 4; m4++) {
                zs[m4] = f32x4{__uint_as_float(hin[m4].x << 16), __uint_as_float(hin[m4].x & 0xFFFF0000u),
                               __uint_as_float(hin[m4].y << 16), __uint_as_float(hin[m4].y & 0xFFFF0000u)};
#pragma unroll
                for (int ks = 0; ks < 2; ks++) zs[m4] = __builtin_amdgcn_mfma_f32_16x16x32_bf16(GA[m4][ks], Z0[ks], zs[m4], 0, 0, 0);
            }
#pragma unroll
            for (int m4 = 0; m4 < 4; m4++) {
                uint2 o; o.x = pack2(zs[m4][0], zs[m4][1]); o.y = pack2(zs[m4][2], zs[m4][3]);
                *(uint2*)&mySL[(vt * 16 + kr) * RS + m4 * 16 + qq * 4] = o;
            }
            f32x4 ys[4];
            float* myred = red + ((c & 1) * 2 + chn) * (4 * 64 * 2);
#pragma unroll
            for (int n4 = 0; n4 < 4; n4++) {
                ys[n4] = f32x4{__uint_as_float(yin[n4].x << 16), __uint_as_float(yin[n4].x & 0xFFFF0000u),
                               __uint_as_float(yin[n4].y << 16), __uint_as_float(yin[n4].y & 0xFFFF0000u)};
#pragma unroll
                for (int ks = 0; ks < 2; ks++) ys[n4] = __builtin_amdgcn_mfma_f32_16x16x32_bf16(Z0[ks], QB[n4][ks], ys[n4], 0, 0, 0);
                float s1 = (ys[n4][0] + ys[n4][1]) + (ys[n4][2] + ys[n4][3]);
                float s2 = (ys[n4][0] * ys[n4][0] + ys[n4][1] * ys[n4][1]) + (ys[n4][2] * ys[n4][2] + ys[n4][3] * ys[n4][3]);
                s1 += __shfl_xor(s1, 16, 64); s1 += __shfl_xor(s1, 32, 64);
                s2 += __shfl_xor(s2, 16, 64); s2 += __shfl_xor(s2, 32, 64);
                if (qq == 0) { myred[(vt * 64 + n4 * 16 + kr) * 2] = s1; myred[(vt * 64 + n4 * 16 + kr) * 2 + 1] = s2; }
            }
            __syncthreads();
#pragma unroll
            for (int n4 = 0; n4 < 4; n4++) {
                const int t = n4 * 16 + kr;
                float t1 = 0.f, t2 = 0.f;
#pragma unroll
                for (int v4 = 0; v4 < 4; v4++) { t1 += myred[(v4 * 64 + t) * 2]; t2 += myred[(v4 * 64 + t) * 2 + 1]; }
                const float mean = t1 * (1.f / 64.f);
                const float var = fmaxf(t2 * (1.f / 64.f) - mean * mean, 0.f);
                const float rstd = rsqrtf(var + 64e-5f);
                const size_t n = (size_t)b * S_ + c * 64 + t;
                const uint2 vc = *(const uint2*)&p.prw[n * CRW + 1024 + vch];
                uint2 vp = make_uint2(0u, 0u);
                if (c * 64 + t > 0) vp = *(const uint2*)&p.prw[(n - 1) * CRW + 1024 + vch];
                const uint2 gg = *(const uint2*)&p.ob[n * 512 + vch];
                const float bon = p.bon[n * 8 + h];
                const float vcf[4] = {__uint_as_float(vc.x << 16), __uint_as_float(vc.x & 0xFFFF0000u), __uint_as_float(vc.y << 16), __uint_as_float(vc.y & 0xFFFF0000u)};
                const float vpf[4] = {__uint_as_float(vp.x << 16), __uint_as_float(vp.x & 0xFFFF0000u), __uint_as_float(vp.y << 16), __uint_as_float(vp.y & 0xFFFF0000u)};
                const float ggf[4] = {__uint_as_float(gg.x << 16), __uint_as_float(gg.x & 0xFFFF0000u), __uint_as_float(gg.y << 16), __uint_as_float(gg.y & 0xFFFF0000u)};
                float o[4];
#pragma unroll
                for (int r = 0; r < 4; r++) {
                    const float vsh = vcf[r] + (vpf[r] - vcf[r]) * muv[r];
                    o[r] = ((ys[n4][r] - mean) * rstd * lnw[r] + lnb[r] + bon * vsh) * ggf[r];
                }
                uint2 ov; ov.x = pack2(o[0], o[1]); ov.y = pack2(o[2], o[3]);
                *(uint2*)&p.ob[n * 512 + vch] = ov;
            }
#pragma unroll
            for (int m4 = 0; m4 < 4; m4++)
#pragma unroll
                for (int ks = 0; ks < 2; ks++) { GA[m4][ks] = GAn[m4][ks]; QB[m4][ks] = QBn[m4][ks]; }
        }
    }
}

template <int PASS>
__device__ __forceinline__ void merge_sweep(const P& p, int bid, int nb, u16* sm) {
    const int tid = get_tid(), lane = tid & 63, wv = tid >> 6;
    const int wm = wv >> 1, wn = wv & 1;
    u16* tmp2 = (u16*)p.x1;
    const int nitems = (NTOK / 256) * 8;
    for (int it = bid; it < nitems; it += nb) {
        const int ct = it & 7, rt = it >> 3;
        const int r0 = rt * 256, c0 = ct * 128;
        f32x4 acc[4][4];
        if (PASS == 0) gemm_core(512, [&](int r) { return p.oa + (size_t)(r0 + r) * 512; }, p.wpaT + (size_t)c0 * 512, 512, acc, sm);
        if (PASS == 1) gemm_core(D_, [&](int r) { return p.hbuf + (size_t)(r0 + r) * D_; }, p.wgT + (size_t)c0 * D_, D_, acc, sm);
        if (PASS == 2) gemm_core(512, [&](int r) { return p.ob + (size_t)(r0 + r) * 512; }, p.wpbT + (size_t)c0 * 512, 512, acc, sm);
        if (PASS == 3) gemm_core(D_, [&](int r) { return p.hbuf + (size_t)(r0 + r) * D_; }, p.wgT + (size_t)(1024 + c0) * D_, D_, acc, sm);
#pragma unroll
        for (int mt = 0; mt < 4; mt++) {
#pragma unroll
            for (int j = 0; j < 4; j++) {
                const size_t row = r0 + wm * 64 + mt * 16 + (lane >> 4) * 4 + j;
#pragma unroll
                for (int nt = 0; nt < 4; nt++) {
                    const size_t idx = row * D_ + c0 + wn * 64 + nt * 16 + (lane & 15);
                    const float v = acc[mt][nt][j];
                    if (PASS == 0) p.merged[idx] = f2bf(v);
                    if (PASS == 1) p.merged[idx] = f2bf(bf2f(p.merged[idx]) * sigmoidf_(v));
                    if (PASS == 2) tmp2[idx] = f2bf(v);
                    if (PASS == 3) p.merged[idx] = f2bf(bf2f(p.merged[idx]) + bf2f(tmp2[idx]) * sigmoidf_(v));
                }
            }
            asm volatile("" ::: "memory");
        }
    }
    __syncthreads();
}
__device__ void ph_merge(const P& p, int bid, int nb, char* smem) {
    u16* sm = (u16*)smem;
    merge_sweep<0>(p, bid, nb, sm);
    merge_sweep<1>(p, bid, nb, sm);
    merge_sweep<2>(p, bid, nb, sm);
    merge_sweep<3>(p, bid, nb, sm);
}

__device__ void ph_outproj(const P& p, int bid, int nb, char* smem) {
    u16* sm = (u16*)smem;
    const int tid = get_tid(), lane = tid & 63, wv = tid >> 6;
    const int wm = wv >> 1, wn = wv & 1;
    const int nitems = (NTOK / 256) * 8;
    for (int it = bid; it < nitems; it += nb) {
        const int ct = it & 7, rt = it >> 3;
        const int r0 = rt * 256, c0 = ct * 128;
        f32x4 acc[4][4];
        gemm_core(D_, [&](int r) { return p.merged + (size_t)(r0 + r) * D_; }, p.woutT + (size_t)c0 * D_, D_, acc, sm);
#pragma unroll
        for (int mt = 0; mt < 4; mt++)
#pragma unroll
            for (int nt = 0; nt < 4; nt++)
#pragma unroll
                for (int j = 0; j < 4; j++) {
                    const size_t row = r0 + wm * 64 + mt * 16 + (lane >> 4) * 4 + j;
                    const int col = c0 + wn * 64 + nt * 16 + (lane & 15);
                    p.x1[row * D_ + col] = p.x[row * D_ + col] + acc[mt][nt][j];
                }
    }
}

__device__ void ph_route(const P& p, int bid, int nb, char* smem) {
    float* red = (float*)smem;
    const int tid = get_tid(), lane = tid & 63, wv = tid >> 6;
    {
        const int gtid = bid * NT + tid, gnt = nb * NT;
        for (int e = 0; e < NEXP; e++) {
            convert_wT(p.e_w1 + (size_t)e * D_ * 256, D_, 256, p.ew1T + (size_t)e * 256 * D_, 256, [](int j) { return j; }, gtid, gnt);
            convert_wT(p.e_w3 + (size_t)e * D_ * 256, D_, 256, p.ew3T + (size_t)e * 256 * D_, 256, [](int j) { return j; }, gtid, gnt);
            convert_wT(p.e_w2 + (size_t)e * 256 * D_, 256, D_, p.ew2T + (size_t)e * D_ * 256, 1024, [](int j) { return j; }, gtid, gnt);
        }
    }
    for (int n = bid; n < NTOK; n += nb) {
        const float2 xv = *(const float2*)&p.x1[(size_t)n * D_ + tid * 2];
        float ss = xv.x * xv.x + xv.y * xv.y;
        ss = wave_sum(ss);
        __syncthreads();
        if (lane == 0) red[wv] = ss;
        __syncthreads();
        float tot = 0.f;
#pragma unroll
        for (int w = 0; w < NW; w++) tot += red[w];
        const float rs = rsqrtf(tot * (1.f / D_) + 1e-6f);
        const float2 gf = *(const float2*)&p.g_ffn[tid * 2];
        float hv[2] = {xv.x * rs * gf.x, xv.y * rs * gf.y};
        *(unsigned*)&p.hbuf[(size_t)n * D_ + tid * 2] = pack2(hv[0], hv[1]);
        float lg[36];
#pragma unroll
        for (int j = 0; j < 36; j++) lg[j] = 0.f;
#pragma unroll
        for (int i = 0; i < 2; i++) {
            const int k = tid * 2 + i;
            const float4 wg = *(const float4*)&p.w_grp[k * 4];
            lg[0] += hv[i] * wg.x; lg[1] += hv[i] * wg.y; lg[2] += hv[i] * wg.z; lg[3] += hv[i] * wg.w;
#pragma unroll
            for (int j = 0; j < 8; j++) {
                const float4 we = *(const float4*)&p.w_exp[k * 32 + j * 4];
                lg[4 + j * 4] += hv[i] * we.x; lg[5 + j * 4] += hv[i] * we.y; lg[6 + j * 4] += hv[i] * we.z; lg[7 + j * 4] += hv[i] * we.w;
            }
        }
#pragma unroll
        for (int j = 0; j < 36; j++) lg[j] = wave_sum(lg[j]);
        __syncthreads();
        if (lane == 0) {
#pragma unroll
            for (int j = 0; j < 36; j++) red[wv * 36 + j] = lg[j];
        }
        __syncthreads();
        if (tid == 0) {
            float gl[4]; int gs = 0;
#pragma unroll
            for (int j = 0; j < 4; j++) {
                float a = p.b_grp[j];
#pragma unroll
                for (int w = 0; w < NW; w++) a += red[w * 36 + j];
                gl[j] = a;
            }
            float gm = gl[0];
#pragma unroll
            for (int j = 1; j < 4; j++) if (gl[j] > gm) { gm = gl[j]; gs = j; }
            float gsum = 0.f;
#pragma unroll
            for (int j = 0; j < 4; j++) gsum += __expf(gl[j] - gm);
            const float pg = 1.f / gsum;
            float el[8]; float em = -3.0e38f;
#pragma unroll
            for (int j = 0; j < 8; j++) {
                const int c = 4 + gs * 8 + j;
                float a = p.b_exp[gs * 8 + j];
#pragma unroll
                for (int w = 0; w < NW; w++) a += red[w * 36 + c];
                el[j] = a;
                em = fmaxf(em, el[j]);
            }
            int j0 = 0, j1 = -1; float v0 = -3.0e38f, v1 = -3.0e38f;
#pragma unroll
            for (int j = 0; j < 8; j++) { el[j] = __expf(el[j] - em); }
#pragma unroll
            for (int j = 0; j < 8; j++) { if (el[j] > v0) { v0 = el[j]; j0 = j; } }
#pragma unroll
            for (int j = 0; j < 8; j++) { if (j != j0 && el[j] > v1) { v1 = el[j]; j1 = j; } }
            const float den = v0 + v1;
            const int e0 = gs * 8 + j0, e1 = gs * 8 + j1;
            p.tok_e[n * 2] = e0; p.tok_e[n * 2 + 1] = e1;
            p.tok_gate[n * 2] = pg * v0 / den; p.tok_gate[n * 2 + 1] = pg * v1 / den;
            atomicAdd(&p.counts[e0], 1); atomicAdd(&p.counts[e1], 1);
        }
    }
}

__device__ void ph_offsets(const P& p, int bid, int nb, char* smem) {
    if (bid == 0 && threadIdx.x == 0) {
        int off = 0, nb_ = 0;
        for (int e = 0; e < NEXP; e++) {
            const int c = p.counts[e];
            p.offs[e] = off;
            for (int r = 0; r < c; r += 256) { p.blk_e[nb_] = e; p.blk_r0[nb_] = off + r; nb_++; }
            off += c;
        }
        p.offs[NEXP] = off;
        *p.nblk = nb_;
    }
}
__device__ void ph_scatter(const P& p, int bid, int nb, char* smem) {
    for (int i = bid * NT + threadIdx.x; i < NTOK * 2; i += nb * NT) {
        const int e = p.tok_e[i];
        const int slot = p.offs[e] + atomicAdd(&p.cursor[e], 1);
        p.list_tok[slot] = i >> 1; p.list_gate[slot] = p.tok_gate[i]; p.tokslot[i] = slot;
    }
}
template <int PASS>
__device__ __forceinline__ void moe1_sweep(const P& p, int bid, int nb, u16* sm) {
    const int tid = get_tid(), lane = tid & 63, wv = tid >> 6;
    const int wm = wv >> 1, wn = wv & 1;
    const int nitems = (*p.nblk) * 2;
    for (int it = bid; it < nitems; it += nb) {
        const int bi = it >> 1, ct = it & 1;
        const int e = p.blk_e[bi], r0 = p.blk_r0[bi], c0 = ct * 128;
        const int rend = p.offs[e + 1];
        auto arow = [&](int r) { int sl = r0 + r; if (sl >= rend) sl = rend - 1; return p.hbuf + (size_t)p.list_tok[sl] * D_; };
        f32x4 acc[4][4];
        gemm_core(D_, arow, ((PASS == 0) ? p.ew1T : p.ew3T) + ((size_t)e * 256 + c0) * D_, D_, acc, sm);
#pragma unroll
        for (int mt = 0; mt < 4; mt++) {
#pragma unroll
            for (int j = 0; j < 4; j++) {
                const int sl = r0 + wm * 64 + mt * 16 + (lane >> 4) * 4 + j;
                if (sl < rend) {
#pragma unroll
                    for (int nt = 0; nt < 4; nt++) {
                        const size_t idx = (size_t)sl * 256 + c0 + wn * 64 + nt * 16 + (lane & 15);
                        const float v = acc[mt][nt][j];
                        if (PASS == 0) p.hid[idx] = f2bf(v * sigmoidf_(v));
                        else p.hid[idx] = f2bf(bf2f(p.hid[idx]) * v);
                    }
                }
            }
            asm volatile("" ::: "memory");
        }
    }
    __syncthreads();
}
__device__ void ph_moe1(const P& p, int bid, int nb, char* smem) {
    u16* sm = (u16*)smem;
    moe1_sweep<0>(p, bid, nb, sm);
    moe1_sweep<1>(p, bid, nb, sm);
}
__device__ void ph_moe2(const P& p, int bid, int nb, char* smem) {
    u16* sm = (u16*)smem;
    const int tid = get_tid(), lane = tid & 63, wv = tid >> 6;
    const int wm = wv >> 1, wn = wv & 1;
    const int nitems = (*p.nblk) * 8;
    for (int it = bid; it < nitems; it += nb) {
        const int bi = it >> 3, ct = it & 7;
        const int e = p.blk_e[bi], r0 = p.blk_r0[bi], c0 = ct * 128;
        const int rend = p.offs[e + 1];
        f32x4 acc[4][4];
        auto arow = [&](int r) { int sl = r0 + r; if (sl >= rend) sl = rend - 1; return p.hid + (size_t)sl * 256; };
        gemm_core(256, arow, p.ew2T + ((size_t)e * D_ + c0) * 256, 256, acc, sm);
#pragma unroll
        for (int mt = 0; mt < 4; mt++)
#pragma unroll
            for (int j = 0; j < 4; j++) {
                const int sl = r0 + wm * 64 + mt * 16 + (lane >> 4) * 4 + j;
                if (sl < rend) {
                    const float gt = p.list_gate[sl];
#pragma unroll
                    for (int nt = 0; nt < 4; nt++) p.ybuf[(size_t)sl * D_ + c0 + wn * 64 + nt * 16 + (lane & 15)] = f2bf(acc[mt][nt][j] * gt);
                }
            }
    }
}
__device__ void ph_final(const P& p, int bid, int nb, char* smem) {
    const int tid = get_tid(), lane = tid & 63, wv = tid >> 6;
    for (int row = bid * NW + wv; row < NTOK; row += nb * NW) {
        const int s0 = p.tokslot[row * 2], s1 = p.tokslot[row * 2 + 1];
        float v[16]; float ss = 0.f;
#pragma unroll
        for (int i = 0; i < 4; i++) {
            const int c = i * 256 + lane * 4;
            const float4 t = *(const float4*)&p.x1[(size_t)row * D_ + c];
            const uint2 a = *(const uint2*)&p.ybuf[(size_t)s0 * D_ + c];
            const uint2 bq = *(const uint2*)&p.ybuf[(size_t)s1 * D_ + c];
            v[4 * i]     = t.x + __uint_as_float(a.x << 16) + __uint_as_float(bq.x << 16);
            v[4 * i + 1] = t.y + __uint_as_float(a.x & 0xFFFF0000u) + __uint_as_float(bq.x & 0xFFFF0000u);
            v[4 * i + 2] = t.z + __uint_as_float(a.y << 16) + __uint_as_float(bq.y << 16);
            v[4 * i + 3] = t.w + __uint_as_float(a.y & 0xFFFF0000u) + __uint_as_float(bq.y & 0xFFFF0000u);
            ss += v[4 * i] * v[4 * i] + v[4 * i + 1] * v[4 * i + 1] + v[4 * i + 2] * v[4 * i + 2] + v[4 * i + 3] * v[4 * i + 3];
        }
        ss = wave_sum(ss);
        const float rs = rsqrtf(ss * (1.f / D_) + 1e-6f);
#pragma unroll
        for (int i = 0; i < 4; i++) {
            const int c = i * 256 + lane * 4;
            const float4 g = *(const float4*)&p.g_final[c];
            float4 o; o.x = v[4 * i] * rs * g.x; o.y = v[4 * i + 1] * rs * g.y; o.z = v[4 * i + 2] * rs * g.z; o.w = v[4 * i + 3] * rs * g.w;
            *(float4*)&p.out[(size_t)row * D_ + c] = o;
        }
    }
}

#define XB_TMO      128
#define XB_XCNT(j)  (256  + 64 * (j))
#define XB_XSUB(j)  (1280 + 64 * (j))
#define XB_XGEN(j)  (2304 + 64 * (j))
#define XB_TOP      3328
#define XB_TOPGEN   3392
#define XCD_BAR_WORDS 3456
#define XB_SPIN_CAP (1u << 18)
#define LAS __attribute__((address_space(3)))

__device__ __forceinline__ unsigned xb_ld(unsigned* p)              { return __hip_atomic_load(p, __ATOMIC_RELAXED, __HIP_MEMORY_SCOPE_AGENT); }
__device__ __forceinline__ unsigned xb_add(unsigned* p, unsigned v) { return __hip_atomic_fetch_add(p, v, __ATOMIC_RELAXED, __HIP_MEMORY_SCOPE_AGENT); }
__device__ __forceinline__ unsigned xb_xcc_id() { return (unsigned)__builtin_amdgcn_s_getreg((3 << 11) | 20) & 0xFu; }
#define XB_SPIN(cond, bar) do { unsigned _sp = 0; while (cond) { __builtin_amdgcn_s_sleep(1); \
    if ((++_sp & 255u) == 0u) { if (xb_ld(&(bar)[XB_TMO])) break; if (_sp > XB_SPIN_CAP) { atomicAdd(&(bar)[XB_TMO], 1u); break; } } } } while (0)

struct XcdBarrier {
    unsigned* bar; unsigned x;
    volatile LAS unsigned* st;
};

__device__ __forceinline__ XcdBarrier xcd_barrier_post(unsigned* bar, volatile LAS unsigned* st) {
    XcdBarrier b; b.bar = bar; b.x = xb_xcc_id(); b.st = st;
    if (threadIdx.x == 0) (void)xb_add(&bar[XB_XCNT(b.x)], 1u);
    return b;
}
__device__ __forceinline__ void xcd_barrier_complete(unsigned* bar, unsigned x, unsigned& nloc, unsigned& nx) {
    const unsigned G = gridDim.x * gridDim.y * gridDim.z;
    unsigned sum, cnt, mine, sp = 0u;
    for (;;) {
        sum = 0u; cnt = 0u; mine = 0u;
#pragma unroll
        for (unsigned j = 0; j < 16; ++j) { const unsigned c = xb_ld(&bar[XB_XCNT(j)]); sum += c; cnt += (c > 0u) ? 1u : 0u; mine = (j == x) ? c : mine; }
        if (sum == G) break;
        __builtin_amdgcn_s_sleep(1);
        if ((++sp & 255u) == 0u) { if (xb_ld(&bar[XB_TMO])) break; if (sp > XB_SPIN_CAP) { atomicAdd(&bar[XB_TMO], 1u); break; } }
    }
    nloc = mine > 0u ? mine : 1u; nx = cnt > 0u ? cnt : 1u;
}

__device__ __forceinline__ void xcd_barrier(const XcdBarrier& b) {
    asm volatile("s_waitcnt vmcnt(0)" ::: "memory");
    __syncthreads();
    if (threadIdx.x == 0) {
        unsigned* bar = b.bar;
        __builtin_amdgcn_s_waitcnt(0);
        unsigned nloc = b.st[0], nx = b.st[1];
        if (nloc == 0u) { xcd_barrier_complete(bar, b.x, nloc, nx); b.st[0] = nloc; b.st[1] = nx; }
        const unsigned old = xb_add(&bar[XB_XSUB(b.x)], 1u);
        const unsigned gen = old / nloc;
        if (old + 1u == (gen + 1u) * nloc) {
            __builtin_amdgcn_fence(__ATOMIC_RELEASE, "agent");
            asm volatile("s_waitcnt vmcnt(0)" ::: "memory");
            const unsigned og = xb_add(&bar[XB_TOP], 1u);
            const unsigned tg = og / nx;
            if (og + 1u == (tg + 1u) * nx) xb_add(&bar[XB_TOPGEN], 1u);
            else XB_SPIN(xb_ld(&bar[XB_TOPGEN]) == tg, bar);
            __builtin_amdgcn_fence(__ATOMIC_ACQUIRE, "agent");
            xb_add(&bar[XB_XGEN(b.x)], 1u);
            asm volatile("s_waitcnt vmcnt(0)" ::: "memory");
        } else {
            XB_SPIN(xb_ld(&bar[XB_XGEN(b.x)]) == gen, bar);
            __builtin_amdgcn_fence(__ATOMIC_ACQUIRE, "agent");
            asm volatile("s_waitcnt vmcnt(0)" ::: "memory");
        }
    }
    __syncthreads();
}

template <int PH>
__device__ __forceinline__ void run_phase(const P& p, int bid, int nb, char* smem) {
    if constexpr (PH == 0) ph_prologue(p, bid, nb, smem);
    if constexpr (PH == 1) ph_inproj(p, bid, nb, smem);
    if constexpr (PH == 2) { ph_compress(p, bid, nb, smem); __syncthreads(); ph_rwkv_chunk(p, bid, nb, smem); }
    if constexpr (PH == 3) {
        if (bid < SCAN_BLOCKS) ph_rwkv_seq(p, bid, SCAN_BLOCKS, smem);
        else ph_nsa(p, bid - SCAN_BLOCKS, nb - SCAN_BLOCKS, smem);
    }
    if constexpr (PH == 4) ph_merge(p, bid, nb, smem);
    if constexpr (PH == 5) ph_outproj(p, bid, nb, smem);
    if constexpr (PH == 6) ph_route(p, bid, nb, smem);
    if constexpr (PH == 7) ph_offsets(p, bid, nb, smem);
    if constexpr (PH == 8) ph_scatter(p, bid, nb, smem);
    if constexpr (PH == 9) ph_moe1(p, bid, nb, smem);
    if constexpr (PH == 10) ph_moe2(p, bid, nb, smem);
    if constexpr (PH == 11) ph_final(p, bid, nb, smem);
}

template <int PH>
__global__ void __launch_bounds__(NT) kph(P p) {
    extern __shared__ __attribute__((aligned(16))) char smem[];
    run_phase<PH>(p, blockIdx.x, gridDim.x, smem);
}

__global__ void __launch_bounds__(NT, 2) mega(P p) {
    extern __shared__ __attribute__((aligned(16))) char smem[];
    volatile LAS unsigned* st = (volatile LAS unsigned*)(smem + SMEM_BYTES - 16);
    if (threadIdx.x == 0) { st[0] = 0u; st[1] = 0u; st[2] = 0u; st[3] = 0u; }
    __syncthreads();
    XcdBarrier bar = xcd_barrier_post(p.bar, st);
    const int bid = blockIdx.x, nb = gridDim.x;
    run_phase<0>(p, bid, nb, smem); xcd_barrier(bar);
    run_phase<1>(p, bid, nb, smem); xcd_barrier(bar);
    run_phase<2>(p, bid, nb, smem); xcd_barrier(bar);
    run_phase<3>(p, bid, nb, smem); xcd_barrier(bar);
    run_phase<4>(p, bid, nb, smem); xcd_barrier(bar);
    run_phase<5>(p, bid, nb, smem); xcd_barrier(bar);
    run_phase<6>(p, bid, nb, smem); xcd_barrier(bar);
    run_phase<7>(p, bid, nb, smem); xcd_barrier(bar);
    run_phase<8>(p, bid, nb, smem); xcd_barrier(bar);
    run_phase<9>(p, bid, nb, smem); xcd_barrier(bar);
    run_phase<10>(p, bid, nb, smem); xcd_barrier(bar);
    run_phase<11>(p, bid, nb, smem);
}

extern "C" void kernel_launch(void* const* d_in, const int* in_sizes, int n_in,
                              void* d_out, int out_size, void* d_ws, size_t ws_size,
                              hipStream_t stream) {
    P p{};
    p.x = (const float*)d_in[0]; p.pos = (const int*)d_in[1]; p.g_mix = (const float*)d_in[2]; p.w_in = (const float*)d_in[3];
    p.pe_k = (const float*)d_in[4]; p.w1_k = (const float*)d_in[5]; p.b1_k = (const float*)d_in[6]; p.w2_k = (const float*)d_in[7]; p.b2_k = (const float*)d_in[8];
    p.pe_v = (const float*)d_in[9]; p.w1_v = (const float*)d_in[10]; p.b1_v = (const float*)d_in[11]; p.w2_v = (const float*)d_in[12]; p.b2_v = (const float*)d_in[13];
    p.mu = (const float*)d_in[14]; p.w0 = (const float*)d_in[15]; p.w2 = (const float*)d_in[16]; p.a0 = (const float*)d_in[17]; p.a2 = (const float*)d_in[18];
    p.g2 = (const float*)d_in[19]; p.k_k = (const float*)d_in[20]; p.k_a = (const float*)d_in[21]; p.r_k = (const float*)d_in[22]; p.ln_w = (const float*)d_in[23]; p.ln_b = (const float*)d_in[24];
    p.wpa = (const float*)d_in[25]; p.wpb = (const float*)d_in[26]; p.wout = (const float*)d_in[27]; p.g_ffn = (const float*)d_in[28];
    p.w_grp = (const float*)d_in[29]; p.b_grp = (const float*)d_in[30]; p.w_exp = (const float*)d_in[31]; p.b_exp = (const float*)d_in[32];
    p.e_w1 = (const float*)d_in[33]; p.e_w3 = (const float*)d_in[34]; p.e_w2 = (const float*)d_in[35]; p.g_final = (const float*)d_in[36];
    p.out = (float*)d_out;
    char* ws = (char*)d_ws;
    const size_t MiB = 1ull << 20;
    p.hbuf = (u16*)(ws + 0 * MiB);
    p.q    = (u16*)(ws + 64 * MiB);
    p.kc   = (u16*)(ws + 96 * MiB);  p.vc   = (u16*)(ws + 104 * MiB);
    p.ksl  = (u16*)(ws + 112 * MiB); p.vslT = (u16*)(ws + 120 * MiB);
    p.kwn  = (u16*)(ws + 128 * MiB); p.vwnT = (u16*)(ws + 136 * MiB);
    p.nsag = (float*)(ws + 144 * MiB);
    p.kcb  = (u16*)(ws + 148 * MiB); p.vcT  = (u16*)(ws + 149 * MiB);
    p.prw  = (u16*)(ws + 160 * MiB);
    p.cdat = (u16*)(ws + 272 * MiB);
    p.bon  = (float*)(ws + 150 * MiB);
    p.w2T  = (u16*)(ws + 151 * MiB); p.a2T = p.w2T + 512 * 64; p.g2T = p.a2T + 512 * 64;
    p.oa   = (u16*)(ws + 400 * MiB);
    p.ob   = (u16*)(ws + 432 * MiB);
    p.merged = (u16*)(ws + 64 * MiB);
    p.x1   = (float*)(ws + 160 * MiB);
    char* rt = ws + 288 * MiB;
    p.tok_e = (int*)(rt);                        rt += NTOK * 2 * 4;
    p.tok_gate = (float*)(rt);                   rt += NTOK * 2 * 4;
    p.tokslot = (int*)(rt);                      rt += NTOK * 2 * 4;
    p.list_tok = (int*)(rt);                     rt += NTOK * 2 * 4;
    p.list_gate = (float*)(rt);                  rt += NTOK * 2 * 4;
    p.blk_e = (int*)(rt);                        rt += 2048 * 4;
    p.blk_r0 = (int*)(rt);                       rt += 2048 * 4;
    p.hid  = (u16*)(ws + 296 * MiB);
    p.ybuf = (u16*)(ws + 336 * MiB);
    char* misc = ws + 470 * MiB;
    p.counts = (int*)(misc); p.cursor = (int*)(misc + 256); p.offs = (int*)(misc + 512); p.nblk = (int*)(misc + 1024);
    p.bar = (unsigned*)(ws + 471 * MiB);
    {
        char* wa = ws + 472 * MiB;
        p.winT = (u16*)wa;  wa += (size_t)3200 * 1024 * 2;
        p.wgT  = (u16*)wa;  wa += (size_t)2048 * 1024 * 2;
        p.wpaT = (u16*)wa;  wa += (size_t)1024 * 512 * 2;
        p.wpbT = (u16*)wa;  wa += (size_t)1024 * 512 * 2;
        p.woutT = (u16*)wa; wa += (size_t)1024 * 1024 * 2;
        p.ew1T = (u16*)(ws + 64 * MiB);  p.ew3T = (u16*)(ws + 80 * MiB);  p.ew2T = (u16*)(ws + 96 * MiB);
    }
    if (ws_size < (size_t)490 * MiB) return;

#if MEGA
    {
        static int mgrid = 0;
        if (mgrid == 0) {
            int dev = 0, cus = 0, per_cu = 0;
            hipGetDevice(&dev);
            hipDeviceGetAttribute(&cus, hipDeviceAttributeMultiprocessorCount, dev);
            hipFuncSetAttribute((const void*)mega, hipFuncAttributeMaxDynamicSharedMemorySize, SMEM_BYTES);
            hipOccupancyMaxActiveBlocksPerMultiprocessor(&per_cu, (const void*)mega, NT, SMEM_BYTES);
            (void)hipGetLastError();
            mgrid = cus;
        }
        hipMemsetAsync(p.bar, 0, XCD_BAR_WORDS * sizeof(unsigned), stream);
        mega<<<mgrid, NT, SMEM_BYTES, stream>>>(p);
        return;
    }
#else
    const int grid = 512;
    hipFuncSetAttribute((const void*)kph<0>, hipFuncAttributeMaxDynamicSharedMemorySize, SMEM_BYTES);
    hipFuncSetAttribute((const void*)kph<1>, hipFuncAttributeMaxDynamicSharedMemorySize, SMEM_BYTES);
    hipFuncSetAttribute((const void*)kph<2>, hipFuncAttributeMaxDynamicSharedMemorySize, SMEM_BYTES);
    hipFuncSetAttribute((const void*)kph<3>, hipFuncAttributeMaxDynamicSharedMemorySize, SMEM_BYTES);
    hipFuncSetAttribute((const void*)kph<4>, hipFuncAttributeMaxDynamicSharedMemorySize, SMEM_BYTES);
    hipFuncSetAttribute((const void*)kph<5>, hipFuncAttributeMaxDynamicSharedMemorySize, SMEM_BYTES);
    hipFuncSetAttribute((const void*)kph<6>, hipFuncAttributeMaxDynamicSharedMemorySize, SMEM_BYTES);
    hipFuncSetAttribute((const void*)kph<7>, hipFuncAttributeMaxDynamicSharedMemorySize, SMEM_BYTES);
    hipFuncSetAttribute((const void*)kph<8>, hipFuncAttributeMaxDynamicSharedMemorySize, SMEM_BYTES);
    hipFuncSetAttribute((const void*)kph<9>, hipFuncAttributeMaxDynamicSharedMemorySize, SMEM_BYTES);
    hipFuncSetAttribute((const void*)kph<10>, hipFuncAttributeMaxDynamicSharedMemorySize, SMEM_BYTES);
    hipFuncSetAttribute((const void*)kph<11>, hipFuncAttributeMaxDynamicSharedMemorySize, SMEM_BYTES);
    kph<0><<<grid, NT, SMEM_BYTES, stream>>>(p);
    kph<1><<<grid, NT, SMEM_BYTES, stream>>>(p);
    kph<2><<<grid, NT, SMEM_BYTES, stream>>>(p);
    kph<3><<<grid, NT, SMEM_BYTES, stream>>>(p);
    kph<4><<<grid, NT, SMEM_BYTES, stream>>>(p);
    kph<5><<<grid, NT, SMEM_BYTES, stream>>>(p);
    kph<6><<<grid, NT, SMEM_BYTES, stream>>>(p);
    kph<7><<<grid, NT, SMEM_BYTES, stream>>>(p);
    kph<8><<<grid, NT, SMEM_BYTES, stream>>>(p);
    kph<9><<<grid, NT, SMEM_BYTES, stream>>>(p);
    kph<10><<<grid, NT, SMEM_BYTES, stream>>>(p);
    kph<11><<<grid, NT, SMEM_BYTES, stream>>>(p);
#endif
}
```

```cpp
#include <hip/hip_runtime.h>
#include <stdint.h>

typedef unsigned short u16;
using bf16x8 = __attribute__((ext_vector_type(8))) short;
using f32x4  = __attribute__((ext_vector_type(4))) float;

#ifndef MEGA
#define MEGA 1
#endif

constexpr int B_ = 4, S_ = 8192, D_ = 1024, NTOK = B_ * S_;
constexpr int CIN = 5144;
constexpr int NCMP = 511;
constexpr int CRW = 1792;
constexpr int NEXP = 32;
constexpr int NT = 512;
constexpr int NW = NT / 64;
constexpr int SMEM_BYTES = 160 * 1024;
constexpr int SCAN_BLOCKS = 16;
constexpr float QSCALE = 0.125f * 1.4426950408889634f;

struct P {
    const float* x; const int* pos; const float* g_mix; const float* w_in;
    const float *pe_k, *w1_k, *b1_k, *w2_k, *b2_k, *pe_v, *w1_v, *b1_v, *w2_v, *b2_v;
    const float *mu, *w0, *w2, *a0, *a2, *g2, *k_k, *k_a, *r_k, *ln_w, *ln_b;
    const float *wpa, *wpb, *wout, *g_ffn, *w_grp, *b_grp, *w_exp, *b_exp, *e_w1, *e_w3, *e_w2, *g_final;
    float* out;
    u16* hbuf; u16 *q, *kc, *vc, *ksl, *vslT, *kwn, *vwnT, *kcb, *vcT; float* nsag; u16* prw;
    u16* cdat; float* bon; u16 *w2T, *a2T, *g2T; u16 *oa, *ob; u16* merged; float* x1;
    int* tok_e; float* tok_gate; int* tokslot; int* list_tok; float* list_gate;
    int* counts; int* offs; int* cursor; int* blk_e; int* blk_r0; int* nblk;
    u16* hid; u16* ybuf; unsigned* bar;
    u16 *winT, *wgT, *wpaT, *wpbT, *woutT, *ew1T, *ew3T, *ew2T;
    u16 *cw1Tk, *cw1Tv, *cw2Tk, *cw2Tv, *chid, *xact; float *cb1k, *cb1v;
};

typedef __bf16 bf16x2_t __attribute__((ext_vector_type(2)));
typedef float f32x2_t __attribute__((ext_vector_type(2)));
__device__ __forceinline__ unsigned pack2(float a, float b) {
    f32x2_t f = {a, b};
    return __builtin_bit_cast(unsigned, __builtin_convertvector(f, bf16x2_t));
}
__device__ __forceinline__ u16 f2bf(float f) { return (u16)(pack2(f, f) & 0xFFFFu); }
__device__ __forceinline__ float bf2f(u16 h) { return __uint_as_float(((unsigned)h) << 16); }
__device__ __forceinline__ float sigmoidf_(float x) { return __builtin_amdgcn_rcpf(1.f + __expf(-x)); }
__device__ __forceinline__ int get_tid() { int t = threadIdx.x; asm volatile("" : "+v"(t)); return t; }
__device__ __forceinline__ uint2 pack4(const f32x4& v) { uint2 o; o.x = pack2(v[0], v[1]); o.y = pack2(v[2], v[3]); return o; }
__device__ __forceinline__ f32x4 unpack4(uint2 u) { return f32x4{__uint_as_float(u.x << 16), __uint_as_float(u.x & 0xFFFF0000u), __uint_as_float(u.y << 16), __uint_as_float(u.y & 0xFFFF0000u)}; }
#define LDS_BARRIER() do { asm volatile("s_waitcnt lgkmcnt(0)" ::: "memory"); __builtin_amdgcn_s_barrier(); asm volatile("" ::: "memory"); } while (0)
__device__ __forceinline__ int opaque(int x) { asm volatile("" : "+v"(x)); return x; }
template <int CTRL>
__device__ __forceinline__ float dppf(float x) { return __int_as_float(__builtin_amdgcn_update_dpp(0, __float_as_int(x), CTRL, 0xF, 0xF, true)); }
__device__ __forceinline__ float wave_sum(float v) {
    v += dppf<0xB1>(v);
    v += dppf<0x4E>(v);
    v += dppf<0x141>(v);
    v += dppf<0x140>(v);
    const int vi = __float_as_int(v);
    return (__int_as_float(__builtin_amdgcn_readlane(vi, 0)) + __int_as_float(__builtin_amdgcn_readlane(vi, 16)))
         + (__int_as_float(__builtin_amdgcn_readlane(vi, 32)) + __int_as_float(__builtin_amdgcn_readlane(vi, 48)));
}

__device__ __forceinline__ float xrow_sum(float v) {
    auto r = __builtin_amdgcn_permlane16_swap(__float_as_uint(v), __float_as_uint(v), false, false);
    v = __uint_as_float(r[0]) + __uint_as_float(r[1]);
    auto r2 = __builtin_amdgcn_permlane32_swap(__float_as_uint(v), __float_as_uint(v), false, false);
    return __uint_as_float(r2[0]) + __uint_as_float(r2[1]);
}
__device__ __forceinline__ float xrow_max(float v) {
    auto r = __builtin_amdgcn_permlane16_swap(__float_as_uint(v), __float_as_uint(v), false, false);
    v = fmaxf(__uint_as_float(r[0]), __uint_as_float(r[1]));
    auto r2 = __builtin_amdgcn_permlane32_swap(__float_as_uint(v), __float_as_uint(v), false, false);
    return fmaxf(__uint_as_float(r2[0]), __uint_as_float(r2[1]));
}
__constant__ double ROPE_FREQ[32] = {
    1.00000000000000000000e+00, 7.49894209332455874417e-01, 5.62341325190349072827e-01, 4.21696503428582225581e-01,
    3.16227766016837941176e-01, 2.37137370566165517349e-01, 1.77827941003892292526e-01, 1.33352143216332402753e-01,
    1.00000000000000005551e-01, 7.49894209332455791150e-02, 5.62341325190349114460e-02, 4.21696503428582239459e-02,
    3.16227766016837913421e-02, 2.37137370566165538166e-02, 1.77827941003892292526e-02, 1.33352143216332406223e-02,
    1.00000000000000002082e-02, 7.49894209332455791150e-03, 5.62341325190349097113e-03, 4.21696503428582291501e-03,
    3.16227766016837939442e-03, 2.37137370566165538166e-03, 1.77827941003892275179e-03, 1.33352143216332406223e-03,
    1.00000000000000002082e-03, 7.49894209332455856203e-04, 5.62341325190349097113e-04, 4.21696503428582237290e-04,
    3.16227766016837939442e-04, 2.37137370566165538166e-04, 1.77827941003892269758e-04, 1.33352143216332395381e-04};

constexpr int G_ABYTES = 256 * 64 * 2, G_BBYTES = 128 * 64 * 2, G_TILE = G_ABYTES + G_BBYTES;
#define LAS3 __attribute__((address_space(3)))
#define GAS1 __attribute__((address_space(1)))
__device__ __forceinline__ void glds16(const u16* g, char* l) {
    __builtin_amdgcn_global_load_lds((const GAS1 unsigned*)g, (LAS3 unsigned*)l, 16, 0, 0);
}
template <bool TR = false, class ARow>
__device__ __forceinline__ void gemm_core(int K, ARow arow, const u16* __restrict__ BT, int ldb, f32x4 (&acc)[4][4], u16* sm) {
    char* base = (char*)sm;
    const int tid = get_tid(), lane = tid & 63, wv = tid >> 6;
    const int wm = wv >> 1, wn = wv & 1, kr = lane & 15, qq = lane >> 4;
    const int lr = tid >> 3, lk = ((tid & 7) ^ ((lr >> 1) & 7)) * 8;
    const u16* ap0 = arow(lr) + lk; const u16* ap1 = arow(lr + 64) + lk;
    const u16* ap2 = arow(lr + 128) + lk; const u16* ap3 = arow(lr + 192) + lk;
    const u16* bp0 = BT + (size_t)lr * ldb + lk; const u16* bp1 = BT + (size_t)(lr + 64) * ldb + lk;
#pragma unroll
    for (int mt = 0; mt < 4; mt++)
#pragma unroll
        for (int nt = 0; nt < 4; nt++) acc[mt][nt] = f32x4{0.f, 0.f, 0.f, 0.f};
    const int nk = K >> 6;
#define G_ISSUE(t, b) { char* d = base + (b) * G_TILE + tid * 16; const int ko = (t) * 64; \
        glds16(ap0 + ko, d); glds16(ap1 + ko, d + 8192); glds16(ap2 + ko, d + 16384); glds16(ap3 + ko, d + 24576); \
        glds16(bp0 + ko, d + G_ABYTES); glds16(bp1 + ko, d + G_ABYTES + 8192); }
    const int sw = kr >> 1;
    const int po0 = ((0 * 4 + qq) ^ sw) * 16, po1 = ((1 * 4 + qq) ^ sw) * 16;
    const int aoff = (wm * 64 + kr) * 128, boff = G_ABYTES + (wn * 64 + kr) * 128;
#define G_READ(FA, FB, b) { const char* Ab = base + (b) * G_TILE + aoff; const char* Bb = base + (b) * G_TILE + boff; \
        _Pragma("unroll") for (int mt = 0; mt < 4; mt++) { FA[0][mt] = *(const bf16x8*)(Ab + mt * 2048 + po0); FA[1][mt] = *(const bf16x8*)(Ab + mt * 2048 + po1); } \
        _Pragma("unroll") for (int nt = 0; nt < 4; nt++) { FB[0][nt] = *(const bf16x8*)(Bb + nt * 2048 + po0); FB[1][nt] = *(const bf16x8*)(Bb + nt * 2048 + po1); } }
#define G_MMA(FA, FB) { __builtin_amdgcn_s_setprio(1); \
        _Pragma("unroll") for (int ks = 0; ks < 2; ks++) \
            _Pragma("unroll") for (int nt = 0; nt < 4; nt++) \
                _Pragma("unroll") for (int mt = 0; mt < 4; mt++) \
                    acc[mt][nt] = TR ? __builtin_amdgcn_mfma_f32_16x16x32_bf16(FA[ks][mt], FB[ks][nt], acc[mt][nt], 0, 0, 0) \
                                     : __builtin_amdgcn_mfma_f32_16x16x32_bf16(FB[ks][nt], FA[ks][mt], acc[mt][nt], 0, 0, 0); \
        __builtin_amdgcn_s_setprio(0); }
    bf16x8 fa0[2][4], fb0[2][4], fa1[2][4], fb1[2][4];
    G_ISSUE(0, 0)
    if (nk > 1) G_ISSUE(1, 1)
    if (nk > 2) G_ISSUE(2, 2)
    if (nk > 2) asm volatile("s_waitcnt vmcnt(12)" ::: "memory");
    else if (nk > 1) asm volatile("s_waitcnt vmcnt(6)" ::: "memory");
    else asm volatile("s_waitcnt vmcnt(0)" ::: "memory");
    __builtin_amdgcn_s_barrier();
    G_READ(fa0, fb0, 0)
    int bnext = 1, bfree = 0;
#define G_STEP(FAC, FBC, FAN, FBN, kt) { \
        if ((kt) + 1 < nk) { \
            if ((kt) + 2 < nk) asm volatile("s_waitcnt vmcnt(6) lgkmcnt(0)" ::: "memory"); else asm volatile("s_waitcnt vmcnt(0) lgkmcnt(0)" ::: "memory"); \
            __builtin_amdgcn_s_barrier();                   \
            if ((kt) + 3 < nk) G_ISSUE((kt) + 3, bfree) \
            G_READ(FAN, FBN, bnext) \
        } \
        G_MMA(FAC, FBC) \
        bfree = bnext; bnext = (bnext == 2) ? 0 : bnext + 1; }
    for (int kt = 0; kt < nk; kt += 2) {
        G_STEP(fa0, fb0, fa1, fb1, kt)
        G_STEP(fa1, fb1, fa0, fb0, kt + 1)
    }
    __builtin_amdgcn_s_barrier();
#undef G_READ
#undef G_MMA
#undef G_STEP
#undef G_ISSUE
}

__device__ __forceinline__ int xcd_item(int bid, int nb, int k, int nitems) {
    if (nb & 7) return bid + k * nb;
    const int per = nb >> 3, chunk = (nitems + 7) >> 3;
    const int j = k * per + (bid >> 3);
    return (j < chunk) ? (bid & 7) * chunk + j : nitems;
}
template <class SRC>
__device__ __forceinline__ void convert_wT(const float* __restrict__ W, int K, int N, u16* __restrict__ WT, int rows, SRC src, int gtid, int gnt) {
    const int kch = K >> 3;
    const int total = rows * kch;
    for (int i = gtid; i < total; i += gnt) {
        const int kc = i / rows, j = i - kc * rows;
        const int sc = src(j);
        uint4 v = make_uint4(0u, 0u, 0u, 0u);
        if (sc >= 0) {
            const float* wp = W + (size_t)(kc * 8) * N + sc;
            v.x = pack2(wp[0], wp[(size_t)N]); v.y = pack2(wp[2 * (size_t)N], wp[3 * (size_t)N]);
            v.z = pack2(wp[4 * (size_t)N], wp[5 * (size_t)N]); v.w = pack2(wp[6 * (size_t)N], wp[7 * (size_t)N]);
        }
        *(uint4*)&WT[(size_t)j * K + kc * 8] = v;
    }
}

__device__ void ph_prologue(const P& p, int bid, int nb, char* smem) {
    const int tid = get_tid(), lane = tid & 63, wv = tid >> 6;
    if (bid >= 1 && bid <= 64) {
        const int j = tid & 255; const bool isv = tid >= 256;
        const float* pe = isv ? p.pe_v : p.pe_k; const float* w1 = isv ? p.w1_v : p.w1_k;
        const int kb = (bid - 1) * 32;
        float a0 = 0.f, a1 = 0.f;
#pragma unroll 4
        for (int k = kb; k < kb + 32; k += 2) { a0 += pe[k] * w1[(size_t)k * 256 + j]; a1 += pe[k + 1] * w1[(size_t)(k + 1) * 256 + j]; }
        atomicAdd(&(isv ? p.cb1v : p.cb1k)[j], a0 + a1);
    }
    if (bid == 0) {
        if (tid < 32) { p.counts[tid] = 0; p.cursor[tid] = 0; }
        for (int i = tid; i < 8 * 64; i += NT) {
            const int bg = i >> 6, d = i & 63;
            p.kcb[((size_t)bg * 512 + 511) * 64 + d] = 0;
            p.vcT[(((size_t)bg * 8 + 7) * 64 + d) * 64 + 63] = 0;
        }
    }
    {
        const int gtid = bid * NT + tid, gnt = nb * NT;
        convert_wT(p.w_in, D_, CIN, p.winT, 3200, [](int j) { return j < 1280 ? j : (j < 3072 ? j + 24 : (j < 3096 ? 1280 + (j - 3072) : -1)); }, gtid, gnt);
        convert_wT(p.w_in, D_, CIN, p.wgT, 2048, [](int j) { return 3096 + j; }, gtid, gnt);
        convert_wT(p.wpa, 512, D_, p.wpaT, 1024, [](int j) { return j; }, gtid, gnt);
        convert_wT(p.wpb, 512, D_, p.wpbT, 1024, [](int j) { return j; }, gtid, gnt);
        convert_wT(p.wout, D_, D_, p.woutT, 1024, [](int j) { return j; }, gtid, gnt);
        convert_wT(p.w2, 64, 512, p.w2T, 512, [](int j) { return j; }, gtid, gnt);
        convert_wT(p.w1_k, 2048, 256, p.cw1Tk, 256, [](int j) { return j; }, gtid, gnt);
        convert_wT(p.w1_v, 2048, 256, p.cw1Tv, 256, [](int j) { return j; }, gtid, gnt);
        convert_wT(p.w2_k, 256, 64, p.cw2Tk, 128, [](int j) { return j < 64 ? j : -1; }, gtid, gnt);
        convert_wT(p.w2_v, 256, 64, p.cw2Tv, 128, [](int j) { return j < 64 ? j : -1; }, gtid, gnt);
        convert_wT(p.a2, 64, 512, p.a2T, 512, [](int j) { return j; }, gtid, gnt);
        convert_wT(p.g2, 128, 512, p.g2T, 512, [](int j) { return j; }, gtid, gnt);
    }
    for (int row = bid * NW + wv; row < NTOK; row += nb * NW) {
        const float* xr = p.x + (size_t)row * D_;
        float v[16];
        float ss = 0.f;
#pragma unroll
        for (int i = 0; i < 4; i++) {
            float4 t = *(const float4*)&xr[i * 256 + lane * 4];
            v[4 * i] = t.x; v[4 * i + 1] = t.y; v[4 * i + 2] = t.z; v[4 * i + 3] = t.w;
            ss += t.x * t.x + t.y * t.y + t.z * t.z + t.w * t.w;
        }
        ss = wave_sum(ss);
        const float rs = rsqrtf(ss * (1.f / D_) + 1e-6f);
#pragma unroll
        for (int i = 0; i < 4; i++) {
            const int c = i * 256 + lane * 4;
            float4 g = *(const float4*)&p.g_mix[c];
            uint2 o;
            o.x = pack2(v[4 * i] * rs * g.x, v[4 * i + 1] * rs * g.y);
            o.y = pack2(v[4 * i + 2] * rs * g.z, v[4 * i + 3] * rs * g.w);
            *(uint2*)&p.hbuf[(size_t)row * D_ + c] = o;
        }
    }
}

__device__ void ph_inproj(const P& p, int bid, int nb, char* smem) {
    u16* sm = (u16*)smem;
    const int tid = get_tid(), lane = tid & 63, wv = tid >> 6;
    const int wm = wv >> 1, wn = wv & 1;
    constexpr int NCT = 25;
    const int nitems = (NTOK / 256) * NCT;
    for (int kk = 0;; kk++) {
        int ct, rt;
        if (nb == 256) {
            const int st = kk * 8 + (bid & 7), r = bid >> 3;
            if (st >= 100) break;
            if (st < 96) { rt = 4 * (st / 3) + (r >> 3); ct = 8 * (st % 3) + (r & 7); }
            else { rt = (st - 96) * 32 + r; ct = 24; }
        } else {
            const int it = bid + kk * nb;
            if (it >= nitems) break;
            ct = it % NCT; rt = it / NCT;
        }
        const int r0 = rt * 256, c0 = ct * 128;
        f32x4 acc[4][4];
        const int hc = c0 + wn * 64;
        const int rb = r0 + wm * 64;
        const int bb = rb >> 13, tb = rb & (S_ - 1);
        if (ct == 7 || ct == 9) {
            gemm_core<true>(D_, [&](int r) { return p.hbuf + (size_t)(r0 + r) * D_; }, p.winT + (size_t)c0 * D_, D_, acc, sm);
            const int le = get_tid() & 63;
            u16* dst = (ct == 7) ? p.vslT : p.vwnT;
            u16* base = dst + ((size_t)(bb * 2 + wn) * 128 + (tb >> 6)) * 4096;
#pragma unroll
            for (int mt = 0; mt < 4; mt++)
#pragma unroll
                for (int nt = 0; nt < 4; nt++)
                    *(uint2*)&base[(nt * 16 + (le & 15)) * 64 + mt * 16 + (le >> 4) * 4] = pack4(acc[mt][nt]);
            continue;
        }
        gemm_core<false>(D_, [&](int r) { return p.hbuf + (size_t)(r0 + r) * D_; }, p.winT + (size_t)c0 * D_, D_, acc, sm);
        const int le = get_tid() & 63, kr = le & 15, q4 = (le >> 4) * 4;
        if (hc < 1280) {
            const bool rope = (hc < 640) || (hc >= 768 && hc < 896) || (hc >= 1024 && hc < 1152);
#pragma unroll
            for (int mt = 0; mt < 4; mt++) {
                const size_t row = rb + mt * 16 + kr;
                const double posd = (double)p.pos[row];
#pragma unroll
                for (int nt = 0; nt < 2; nt++) {
                    f32x4 o1 = acc[mt][nt], o2 = acc[mt][nt + 2];
                    if (rope) {
#pragma unroll
                        for (int r = 0; r < 4; r++) {
                            const double tr = posd * ROPE_FREQ[nt * 16 + q4 + r] * 0.15915494309189535;
                            const float fr = (float)(tr - rint(tr));
                            const float cs = __builtin_amdgcn_cosf(fr), sn = __builtin_amdgcn_sinf(fr);
                            const float x1 = o1[r], x2 = o2[r];
                            o1[r] = x1 * cs - x2 * sn; o2[r] = x1 * sn + x2 * cs;
                        }
                    }
                    const int d = nt * 16 + q4;
                    if (hc < 512) {
#pragma unroll
                        for (int r = 0; r < 4; r++) { o1[r] *= QSCALE; o2[r] *= QSCALE; }
                        *(uint2*)&p.q[row * 512 + hc + d] = pack4(o1);
                        *(uint2*)&p.q[row * 512 + hc + d + 32] = pack4(o2);
                    } else {
                        u16* dst; int g;
                        if (hc < 640) { dst = p.kc; g = (hc - 512) >> 6; }
                        else if (hc < 768) { dst = p.vc; g = (hc - 640) >> 6; }
                        else if (hc < 896) { dst = p.ksl; g = (hc - 768) >> 6; }
                        else { dst = p.kwn; g = (hc - 1024) >> 6; }
                        const size_t t = tb + mt * 16 + kr;
                        u16* rp = dst + ((size_t)(bb * 2 + g) * S_ + t) * 64 + d;
                        *(uint2*)rp = pack4(o1);
                        *(uint2*)(rp + 32) = pack4(o2);
                    }
                }
            }
        } else if (hc < 3072) {
#pragma unroll
            for (int mt = 0; mt < 4; mt++) {
                const size_t row = rb + mt * 16 + kr;
#pragma unroll
                for (int nt = 0; nt < 4; nt++) *(uint2*)&p.prw[row * CRW + (hc - 1280) + nt * 16 + q4] = pack4(acc[mt][nt]);
            }
        } else if (hc == 3072) {
#pragma unroll
            for (int mt = 0; mt < 4; mt++) {
                const size_t row = rb + mt * 16 + kr;
#pragma unroll
                for (int nt = 0; nt < 2; nt++) {
                    const int c = nt * 16 + q4;
                    if (c + 3 < 24) {
                        float4 o; o.x = sigmoidf_(acc[mt][nt][0]); o.y = sigmoidf_(acc[mt][nt][1]); o.z = sigmoidf_(acc[mt][nt][2]); o.w = sigmoidf_(acc[mt][nt][3]);
                        *(float4*)&p.nsag[row * 24 + c] = o;
                    }
                }
            }
        }
    }
}

__device__ __forceinline__ float gelu_tanh(float x) {
    const float c = 0.7978845608028654f;
    return 0.5f * x * (1.f + tanhf(c * (x + 0.044715f * x * x * x)));
}
__device__ void ph_compress(const P& p, int bid, int nb, char* smem) {
    u16* sm = (u16*)smem;
    const int tid = get_tid(), lane = tid & 63, wv = tid >> 6;
    const int wm = wv >> 1, wn = wv & 1;
    for (int it = bid; it < 32; it += nb) {
        const int rt = it & 1, g = (it >> 1) & 1, b = (it >> 2) & 3, kv = it >> 4;
        const int bg = b * 2 + g, i0 = rt * 256;
        const u16* src = (kv ? p.vc : p.kc) + (size_t)bg * S_ * 64;
        const u16* w1T = kv ? p.cw1Tv : p.cw1Tk;
        const u16* w2T = kv ? p.cw2Tv : p.cw2Tk;
        const float* cb1 = kv ? p.cb1v : p.cb1k;
        const float* b1 = kv ? p.b1_v : p.b1_k;
        const float* b2 = kv ? p.b2_v : p.b2_k;
        u16* hidp = p.chid + (size_t)it * 256 * 256;
        auto arow = [&](int r) { int i = i0 + r; if (i > 510) i = 510; return src + (size_t)i * 1024; };
#pragma unroll 1
        for (int ct = 0; ct < 2; ct++) {
            f32x4 acc[4][4];
            gemm_core<false>(2048, arow, w1T + (size_t)ct * 128 * 2048, 2048, acc, sm);
            const int le = get_tid() & 63;
#pragma unroll
            for (int mt = 0; mt < 4; mt++) {
                const int r = wm * 64 + mt * 16 + (le & 15);
#pragma unroll
                for (int nt = 0; nt < 4; nt++) {
                    const int col = ct * 128 + wn * 64 + nt * 16 + (le >> 4) * 4;
                    const float4 c1 = *(const float4*)&cb1[col], bb1 = *(const float4*)&b1[col];
                    f32x4 o;
                    o[0] = gelu_tanh(acc[mt][nt][0] + c1.x + bb1.x); o[1] = gelu_tanh(acc[mt][nt][1] + c1.y + bb1.y);
                    o[2] = gelu_tanh(acc[mt][nt][2] + c1.z + bb1.z); o[3] = gelu_tanh(acc[mt][nt][3] + c1.w + bb1.w);
                    *(uint2*)&hidp[r * 256 + col] = pack4(o);
                }
            }
        }
        __syncthreads();
        {
            f32x4 acc[4][4];
            gemm_core<true>(256, [&](int r) { return hidp + (size_t)r * 256; }, w2T, 256, acc, sm);
            if (wn == 0) {
#pragma unroll
                for (int mt = 0; mt < 4; mt++)
#pragma unroll
                    for (int nt = 0; nt < 4; nt++) {
                        const int d = nt * 16 + (lane & 15);
                        const int ib = i0 + wm * 64 + mt * 16 + (lane >> 4) * 4;
                        float o[4];
#pragma unroll
                        for (int j = 0; j < 4; j++) o[j] = (ib + j < NCMP) ? (acc[mt][nt][j] + b2[d]) : 0.f;
                        if (kv == 0) {
#pragma unroll
                            for (int j = 0; j < 4; j++) p.kcb[((size_t)bg * 512 + ib + j) * 64 + d] = f2bf(o[j]);
                        } else {
                            uint2 ov; ov.x = pack2(o[0], o[1]); ov.y = pack2(o[2], o[3]);
                            *(uint2*)&p.vcT[(((size_t)bg * 8 + (ib >> 6)) * 64 + d) * 64 + (ib & 63)] = ov;
                        }
                    }
            }
        }
        __syncthreads();
    }
}

constexpr int KSTR = 72;
struct Sub { f32x4 O[4]; float m, l; };
#define NEG_BIG (-1.0e30f)

__device__ __forceinline__ float xq_max(float v) {
    return xrow_max(v);
}
__device__ __forceinline__ float xq_sum(float v) {
    return xrow_sum(v);
}
template <bool MASK, bool IMP, bool PV>
__device__ __forceinline__ void nsa_visit(const u16* Ks, const u16* Vs, const bf16x8* qp, Sub& s, int lo, int hi, int lane, float* e, float* p3) {
    const int kr = lane & 15, qq = lane >> 4;
    f32x4 S[4];
    const bf16x8 qf0 = qp[0], qf1 = qp[64];
    bf16x8 kf[4][2];
#pragma unroll
    for (int kt = 0; kt < 4; kt++)
#pragma unroll
        for (int ks = 0; ks < 2; ks++) kf[kt][ks] = *(const bf16x8*)&Ks[(kt * 16 + kr) * KSTR + ks * 32 + qq * 8];
    __builtin_amdgcn_sched_barrier(0);
#pragma unroll
    for (int kt = 0; kt < 4; kt++) {
        S[kt] = __builtin_amdgcn_mfma_f32_16x16x32_bf16(kf[kt][0], qf0, f32x4{0.f, 0.f, 0.f, 0.f}, 0, 0, 0);
        S[kt] = __builtin_amdgcn_mfma_f32_16x16x32_bf16(kf[kt][1], qf1, S[kt], 0, 0, 0);
    }
    union VF { bf16x8 v; uint2 h[2]; };
    float mx = NEG_BIG;
#pragma unroll
    for (int kt = 0; kt < 4; kt++)
#pragma unroll
        for (int r = 0; r < 4; r++) {
            if (MASK) { const int o = kt * 16 + qq * 4 + r; if (o < lo || o > hi) S[kt][r] = -INFINITY; }
            mx = fmaxf(mx, S[kt][r]);
        }
    mx = xq_max(mx);
    const float mnew = fmaxf(s.m, mx);
    const float alpha = __builtin_amdgcn_exp2f(s.m - mnew);
    s.m = mnew;
    float psum = 0.f;
#pragma unroll
    for (int kt = 0; kt < 4; kt++) {
#pragma unroll
        for (int r = 0; r < 4; r++) { S[kt][r] = __builtin_amdgcn_exp2f(S[kt][r] - mnew); }
        const float ee = (S[kt][0] + S[kt][1]) + (S[kt][2] + S[kt][3]);
        psum += ee;
        if (IMP) { e[kt] = ee; p3[kt] = S[kt][3]; }
    }
    s.l = s.l * alpha + psum;
    if (PV) {
        if (!__all(alpha == 1.f)) {
#pragma unroll
            for (int dt = 0; dt < 4; dt++)
#pragma unroll
                for (int r = 0; r < 4; r++) s.O[dt][r] *= alpha;
        }
        VF vf[4][2];
#pragma unroll
        for (int dt = 0; dt < 4; dt++)
#pragma unroll
            for (int k2 = 0; k2 < 2; k2++) {
                vf[dt][k2].h[0] = *(const uint2*)&Vs[(dt * 16 + kr) * KSTR + k2 * 32 + qq * 4];
                vf[dt][k2].h[1] = *(const uint2*)&Vs[(dt * 16 + kr) * KSTR + k2 * 32 + 16 + qq * 4];
            }
        bf16x8 pb[2];
#pragma unroll
        for (int k2 = 0; k2 < 2; k2++) {
            union { bf16x8 v; unsigned u[4]; } t;
            t.u[0] = pack2(S[2 * k2][0], S[2 * k2][1]); t.u[1] = pack2(S[2 * k2][2], S[2 * k2][3]);
            t.u[2] = pack2(S[2 * k2 + 1][0], S[2 * k2 + 1][1]); t.u[3] = pack2(S[2 * k2 + 1][2], S[2 * k2 + 1][3]);
            pb[k2] = t.v;
        }
        __builtin_amdgcn_sched_barrier(0);
#pragma unroll
        for (int dt = 0; dt < 4; dt++)
#pragma unroll
            for (int k2 = 0; k2 < 2; k2++) s.O[dt] = __builtin_amdgcn_mfma_f32_16x16x32_bf16(vf[dt][k2].v, pb[k2], s.O[dt], 0, 0, 0);
    }
}
template <int MODE>
__device__ __forceinline__ void nsa_fold(Sub& s, float* ol, float gate) {
    const float lt = xq_sum(s.l);
    const float sc = (lt > 0.f) ? gate / lt : 0.f;
#pragma unroll
    for (int dt = 0; dt < 4; dt++)
#pragma unroll
        for (int r = 0; r < 4; r++) {
            float v = s.O[dt][r] * sc;
            if (MODE == 1) v += ol[(dt * 4 + r) * 64];
            ol[(dt * 4 + r) * 64] = v;
            s.O[dt][r] = 0.f;
        }
    s.m = NEG_BIG; s.l = 0.f;
}

#define NSA_TOK(u) const int t3_ = get_tid(); const size_t ntk_ = (size_t)b * S_ + t0 + 8 * (t3_ >> 6) + 4 * (u) + ((t3_ & 15) >> 2); const int hd_ = g * 4 + (t3_ & 3);
__device__ void ph_nsa(const P& p, int bid, int nb, char* smem) {
    u16* Kb = (u16*)smem;
    u16* Vb = Kb + 2 * 64 * KSTR;
    unsigned* selm = (unsigned*)(Vb + 2 * 64 * KSTR);
    int* blist = (int*)(selm + 256);
    int* nlistp = blist + 128;
    float* impl = (float*)(nlistp + 4);
    float* outl = impl;
    bf16x8* qsm = (bf16x8*)(outl + NW * 2 * 16 * 64);
    const int tid = get_tid(), lane = tid & 63, wv = tid >> 6;
    const int kr = lane & 15, qq = lane >> 4, ts = kr >> 2, hh = kr & 3;
#define SROW (get_tid() >> 3)
#define SCH (get_tid() & 7)
    float* myimp = impl + wv * (32 * 2 * 16);
    const int nitems = B_ * 2 * 128;
    for (int it = bid; it < nitems; it += nb) {
        const int tt = 127 - (it >> 3);
        const int bg = it & 7, b = bg >> 1, g = bg & 1;
        const int t0 = tt * 64, cur = tt;
        const int head = g * 4 + hh;
        Sub st[2];
        float* myout = outl + wv * (2 * 16 * 64) + lane;
        int tl[2]; size_t ntok[2];
#pragma unroll
        for (int u = 0; u < 2; u++) {
            tl[u] = 8 * wv + 4 * u + ts;
            ntok[u] = (size_t)b * S_ + t0 + tl[u];
#pragma unroll
            for (int ks = 0; ks < 2; ks++) qsm[((wv * 2 + u) * 2 + ks) * 64 + lane] = *(const bf16x8*)&p.q[ntok[u] * 512 + head * 64 + ks * 32 + qq * 8];
#pragma unroll
            for (int dt = 0; dt < 4; dt++) st[u].O[dt] = f32x4{0.f, 0.f, 0.f, 0.f};
            st[u].m = NEG_BIG; st[u].l = 0.f;
        }
        const u16* kcb = p.kcb + (size_t)bg * 512 * 64;
        const u16* vcT = p.vcT + (size_t)bg * 8 * 4096;
        int nv[2];
#pragma unroll
        for (int u = 0; u < 2; u++) { const int t = t0 + tl[u]; nv[u] = (t >= 31) ? min((t - 31) / 16 + 1, NCMP) : 0; }
        const int tmax = t0 + 63;
        const int nvmax = (tmax >= 31) ? min((tmax - 31) / 16 + 1, NCMP) : 0;
        const int nvb = (nvmax + 63) >> 6;
        __syncthreads();
        for (int kb = 0; kb < nvb; kb++) {
            const int sr_ = SROW, sc_ = SCH;
            *(uint4*)&Kb[sr_ * KSTR + sc_ * 8] = *(const uint4*)&kcb[((size_t)kb * 64 + sr_) * 64 + sc_ * 8];
            __syncthreads();
#pragma unroll
            for (int u = 0; u < 2; u++) nsa_visit<true, false, false>(Kb, Vb, qsm + (wv * 2 + u) * 128 + lane, st[u], 0, nv[u] - kb * 64 - 1, lane, nullptr, nullptr);
            __syncthreads();
        }
        float invl[2];
#pragma unroll
        for (int u = 0; u < 2; u++) { const float lt = xq_sum(st[u].l); invl[u] = (lt > 0.f) ? 1.f / lt : 0.f; st[u].l = 0.f; }
        float carry[2] = {0.f, 0.f};
        for (int kb = 0; kb < nvb; kb++) {
            const int sr_ = SROW, sc_ = SCH;
            *(uint4*)&Kb[sr_ * KSTR + sc_ * 8] = *(const uint4*)&kcb[((size_t)kb * 64 + sr_) * 64 + sc_ * 8];
            *(uint4*)&Vb[sr_ * KSTR + sc_ * 8] = *(const uint4*)&vcT[((size_t)kb * 64 + sr_) * 64 + sc_ * 8];
            __syncthreads();
#pragma unroll
            for (int u = 0; u < 2; u++) {
                float e[4], p3[4];
                nsa_visit<true, true, true>(Kb, Vb, qsm + (wv * 2 + u) * 128 + lane, st[u], 0, nv[u] - kb * 64 - 1, lane, e, p3);
#pragma unroll
                for (int kt = 0; kt < 4; kt++) {
                    float ev = e[kt] * invl[u], pv = p3[kt] * invl[u];
                    ev += dppf<0xB1>(ev); ev += dppf<0x4E>(ev);
                    pv += dppf<0xB1>(pv); pv += dppf<0x4E>(pv);
                    const float sh = __shfl(pv, (lane - 16) & 63, 64);
                    const float nbv = (qq == 0) ? carry[u] : sh;
                    carry[u] = sh;
                    myimp[((kb * 4 + kt) * 2 + u) * 16 + ts * 4 + qq] = ev + nbv;
                }
            }
            __syncthreads();
        }
#pragma unroll
        for (int u = 0; u < 2; u++) {
            float impv[32];
#pragma unroll
            for (int kk = 0; kk < 32; kk++) impv[kk] = (kk < nvb * 4) ? myimp[(kk * 2 + u) * 16 + ts * 4 + qq] : 0.f;
            unsigned cmask = 0u;
#pragma unroll
            for (int kk = 0; kk < 32; kk++) { const int j = 4 * kk + qq; if (j >= 1 && j <= cur - 2) cmask |= (1u << kk); }
            unsigned sel = 0u;
            const int ncand = max(0, cur - 2);
            const int nforced = (cur >= 2) ? 3 : (cur + 1);
            const int need = 16 - nforced;
            if (ncand <= need) sel = cmask;
            else {
                for (int rnd = 0; rnd < need; rnd++) {
                    float best = -1.f; int bk = 0;
#pragma unroll
                    for (int kk = 0; kk < 32; kk++) {
                        const float v = ((cmask >> kk) & 1u) ? impv[kk] : -1.f;
                        if (v > best) { best = v; bk = kk; }
                    }
                    int bj = (best >= 0.f) ? (4 * bk + qq) : 9999;
                    {
                        auto rv = __builtin_amdgcn_permlane16_swap(__float_as_uint(best), __float_as_uint(best), false, false);
                        auto rj = __builtin_amdgcn_permlane16_swap((unsigned)bj, (unsigned)bj, false, false);
                        float v0 = __uint_as_float(rv[0]), v1 = __uint_as_float(rv[1]); int j0 = (int)rj[0], j1 = (int)rj[1];
                        if (v1 > v0 || (v1 == v0 && j1 < j0)) { v0 = v1; j0 = j1; }
                        rv = __builtin_amdgcn_permlane32_swap(__float_as_uint(v0), __float_as_uint(v0), false, false);
                        rj = __builtin_amdgcn_permlane32_swap((unsigned)j0, (unsigned)j0, false, false);
                        best = __uint_as_float(rv[0]); bj = (int)rj[0];
                        const float v2 = __uint_as_float(rv[1]); const int j2 = (int)rj[1];
                        if (v2 > best || (v2 == best && j2 < bj)) { best = v2; bj = j2; }
                    }
                    if (bj < 512 && (bj & 3) == qq) { cmask &= ~(1u << (bj >> 2)); sel |= (1u << (bj >> 2)); }
                }
            }
            if (qq == 0) sel |= 1u;
            if ((cur & 3) == qq) sel |= (1u << (cur >> 2));
            if (cur >= 1 && ((cur - 1) & 3) == qq) sel |= (1u << ((cur - 1) >> 2));
            if (hh == 0) selm[tl[u] * 4 + qq] = sel;
        }
        __syncthreads();
#pragma unroll
        for (int u = 0; u < 2; u++) { NSA_TOK(u) nsa_fold<0>(st[u], myout + u * 1024, p.nsag[ntk_ * 24 + hd_ * 3 + 0]); }
        bool need_j = false; int lrank = 0;
        {
            const int t2 = get_tid();
            if (t2 < 128) {
                const int j = t2; unsigned any = 0u;
                for (int tk = 0; tk < 64; tk++) any |= (selm[tk * 4 + (j & 3)] >> (j >> 2)) & 1u;
                need_j = (any != 0u) && (j <= cur);
                const unsigned long long bal = __ballot(need_j);
                lrank = __popcll(bal & ((1ull << (t2 & 63)) - 1ull));
                if ((t2 & 63) == 0) nlistp[t2 >> 6] = __popcll(bal);
            }
            __syncthreads();
            if (t2 < 128 && need_j) blist[lrank + ((t2 >= 64) ? nlistp[0] : 0)] = t2;
            __syncthreads();
        }
        const int nlist = nlistp[0] + nlistp[1];
        const u16* ksl = p.ksl + (size_t)bg * S_ * 64;
        const u16* vslT = p.vslT + (size_t)bg * 128 * 4096;
        {
            const int sr_ = SROW, sc_ = SCH;
            uint4 kreg, vreg;
            {
                const int j = blist[0];
                kreg = *(const uint4*)&ksl[((size_t)j * 64 + sr_) * 64 + sc_ * 8];
                vreg = *(const uint4*)&vslT[((size_t)j * 64 + sr_) * 64 + sc_ * 8];
                *(uint4*)&Kb[sr_ * KSTR + sc_ * 8] = kreg; *(uint4*)&Vb[sr_ * KSTR + sc_ * 8] = vreg;
            }
            __syncthreads();
            for (int idx = 0; idx < nlist; idx++) {
                const int j = blist[idx];
                const int buf = idx & 1;
                if (idx + 1 < nlist) {
                    const int j2 = blist[idx + 1];
                    kreg = *(const uint4*)&ksl[((size_t)j2 * 64 + sr_) * 64 + sc_ * 8];
                    vreg = *(const uint4*)&vslT[((size_t)j2 * 64 + sr_) * 64 + sc_ * 8];
                }
                const u16* Ks = Kb + buf * 64 * KSTR; const u16* Vs = Vb + buf * 64 * KSTR;
#pragma unroll
                for (int u = 0; u < 2; u++) {
                    const unsigned w = selm[tl[u] * 4 + (j & 3)];
                    const bool sb = ((w >> (j >> 2)) & 1u) != 0u;
                    if (__any(sb)) {
                        const int hi = sb ? ((j == cur) ? tl[u] : 63) : -1;
                        if (__all(sb) && j != cur) nsa_visit<false, false, true>(Ks, Vs, qsm + (wv * 2 + u) * 128 + lane, st[u], 0, 63, lane, nullptr, nullptr);
                        else nsa_visit<true, false, true>(Ks, Vs, qsm + (wv * 2 + u) * 128 + lane, st[u], 0, hi, lane, nullptr, nullptr);
                    }
                }
                if (idx + 1 < nlist) {
                    *(uint4*)&Kb[(buf ^ 1) * 64 * KSTR + sr_ * KSTR + sc_ * 8] = kreg;
                    *(uint4*)&Vb[(buf ^ 1) * 64 * KSTR + sr_ * KSTR + sc_ * 8] = vreg;
                }
                __syncthreads();
            }
        }
#pragma unroll
        for (int u = 0; u < 2; u++) { NSA_TOK(u) nsa_fold<1>(st[u], myout + u * 1024, p.nsag[ntk_ * 24 + hd_ * 3 + 1]); }
        const u16* kwn = p.kwn + (size_t)bg * S_ * 64;
        const u16* vwnT = p.vwnT + (size_t)bg * 128 * 4096;
        {
            const int jlo = max(0, cur - 8);
            const int sr_ = SROW, sc_ = SCH;
            uint4 kreg, vreg;
            kreg = *(const uint4*)&kwn[((size_t)jlo * 64 + sr_) * 64 + sc_ * 8];
            vreg = *(const uint4*)&vwnT[((size_t)jlo * 64 + sr_) * 64 + sc_ * 8];
            *(uint4*)&Kb[sr_ * KSTR + sc_ * 8] = kreg; *(uint4*)&Vb[sr_ * KSTR + sc_ * 8] = vreg;
            __syncthreads();
            for (int j = jlo; j <= cur; j++) {
                const int buf = (j - jlo) & 1;
                if (j < cur) {
                    kreg = *(const uint4*)&kwn[((size_t)(j + 1) * 64 + sr_) * 64 + sc_ * 8];
                    vreg = *(const uint4*)&vwnT[((size_t)(j + 1) * 64 + sr_) * 64 + sc_ * 8];
                }
                const u16* Ks = Kb + buf * 64 * KSTR; const u16* Vs = Vb + buf * 64 * KSTR;
#pragma unroll
                for (int u = 0; u < 2; u++) {
                    if (j == cur) nsa_visit<true, false, true>(Ks, Vs, qsm + (wv * 2 + u) * 128 + lane, st[u], 0, tl[u], lane, nullptr, nullptr);
                    else if (j == cur - 8) nsa_visit<true, false, true>(Ks, Vs, qsm + (wv * 2 + u) * 128 + lane, st[u], tl[u] + 1, 63, lane, nullptr, nullptr);
                    else nsa_visit<false, false, true>(Ks, Vs, qsm + (wv * 2 + u) * 128 + lane, st[u], 0, 63, lane, nullptr, nullptr);
                }
                if (j < cur) {
                    *(uint4*)&Kb[(buf ^ 1) * 64 * KSTR + sr_ * KSTR + sc_ * 8] = kreg;
                    *(uint4*)&Vb[(buf ^ 1) * 64 * KSTR + sr_ * KSTR + sc_ * 8] = vreg;
                }
                __syncthreads();
            }
        }
#pragma unroll
        for (int u = 0; u < 2; u++) {
            NSA_TOK(u)
            nsa_fold<1>(st[u], myout + u * 1024, p.nsag[ntk_ * 24 + hd_ * 3 + 2]);
            const float* ol = myout + u * 1024;
#pragma unroll
            for (int dt = 0; dt < 4; dt++) {
                uint2 o; o.x = pack2(ol[(dt * 4 + 0) * 64], ol[(dt * 4 + 1) * 64]); o.y = pack2(ol[(dt * 4 + 2) * 64], ol[(dt * 4 + 3) * 64]);
                *(uint2*)&p.oa[ntk_ * 512 + hd_ * 64 + dt * 16 + ((t3_ & 63) >> 4) * 4] = o;
            }
        }
    }
}

constexpr int RS = 72;
constexpr int RSLOT = 64 * RS;
__device__ __forceinline__ void mm64(const u16* A, int lda, const u16* Bz, int ldb, f32x4 (&acc)[2], int lane, int wv) {
    const int mt = wv >> 1, nt0 = (wv & 1) * 2, kr = lane & 15, qq = lane >> 4;
#pragma unroll
    for (int ks = 0; ks < 2; ks++) {
        const bf16x8 a = *(const bf16x8*)&A[(mt * 16 + kr) * lda + ks * 32 + qq * 8];
#pragma unroll
        for (int i = 0; i < 2; i++) {
            const bf16x8 b = *(const bf16x8*)&Bz[((nt0 + i) * 16 + kr) * ldb + ks * 32 + qq * 8];
            acc[i] = __builtin_amdgcn_mfma_f32_16x16x32_bf16(a, b, acc[i], 0, 0, 0);
        }
    }
}
__device__ __forceinline__ void st_t(u16* dst, int ld, const f32x4& v, int mt, int nt, int lane) {
    uint2 o; o.x = pack2(v[0], v[1]); o.y = pack2(v[2], v[3]);
    *(uint2*)&dst[(nt * 16 + (lane & 15)) * ld + mt * 16 + (lane >> 4) * 4] = o;
}
__device__ __forceinline__ void st_n(u16* dst, int ld, const f32x4& v, int mt, int nt, int lane) {
#pragma unroll
    for (int r = 0; r < 4; r++) dst[(mt * 16 + (lane >> 4) * 4 + r) * ld + nt * 16 + (lane & 15)] = f2bf(v[r]);
}
#define ZACC(a) { a[0] = f32x4{0.f, 0.f, 0.f, 0.f}; a[1] = f32x4{0.f, 0.f, 0.f, 0.f}; }

__device__ void ph_rwkv_chunk(const P& p, int bid, int nb, char* smem) {
    u16* sl = (u16*)smem;
    float* tot = (float*)(sl + 14 * RSLOT);
    float* gl = tot + 512;
#define RW_IDX const int tid = get_tid(), lane = tid & 63, wv = tid >> 6, mt = wv >> 1, nt0 = (wv & 1) * 2, kr = lane & 15, qq = lane >> 4; (void)mt; (void)nt0; (void)kr; (void)qq; (void)lane;
    const int nitems = B_ * 128;
    for (int it0 = bid; it0 < nitems; it0 += nb) {
      const int c = it0 & 127, b = it0 >> 7;
      const size_t n0 = (size_t)b * S_ + c * 64;
      __syncthreads();
      {
          RW_IDX
          const int t = tid >> 3, part = tid & 7;
          const size_t n = n0 + t;
          const bool hasprev = (c * 64 + t) > 0;
          u16* dst = p.xact + n * 256 + part * 32;
#pragma unroll
          for (int j = 0; j < 4; j++) {
              const int col = 1536 + part * 32 + j * 8;
              const uint4 cu = *(const uint4*)&p.prw[n * CRW + col];
              uint4 pv = make_uint4(0u, 0u, 0u, 0u);
              if (hasprev) pv = *(const uint4*)&p.prw[(n - 1) * CRW + col];
              const unsigned cw[4] = {cu.x, cu.y, cu.z, cu.w}, pw[4] = {pv.x, pv.y, pv.z, pv.w};
              unsigned ow[4];
#pragma unroll
              for (int e2 = 0; e2 < 4; e2++) {
                  float x0 = __uint_as_float(cw[e2] << 16), x1 = __uint_as_float(cw[e2] & 0xFFFF0000u);
                  const float q0 = __uint_as_float(pw[e2] << 16), q1 = __uint_as_float(pw[e2] & 0xFFFF0000u);
                  x0 = x0 + (q0 - x0) * p.mu[col + 2 * e2]; x1 = x1 + (q1 - x1) * p.mu[col + 2 * e2 + 1];
                  if (part < 2) { x0 = tanhf(x0); x1 = tanhf(x1); }
                  else if (part >= 4) { x0 = sigmoidf_(x0); x1 = sigmoidf_(x1); }
                  ow[e2] = pack2(x0, x1);
              }
              *(uint4*)&dst[j * 8] = make_uint4(ow[0], ow[1], ow[2], ow[3]);
          }
      }
      __syncthreads();
      const u16* xa = p.xact + n0 * 256;
#pragma unroll 1
      for (int h = 0; h < 8; h++) {
        u16* cd = p.cdat + ((size_t)((b * 8 + h) * 128 + c)) * 4 * 4096;
        __syncthreads();
        float* LW = (float*)(sl + 8 * RSLOT); float* LA = (float*)(sl + 10 * RSLOT);
        {
            RW_IDX
            f32x4 acc[2];
            ZACC(acc); mm64(xa, 256, p.w2T + (size_t)h * 64 * 64, 64, acc, lane, wv);
#pragma unroll
            for (int i = 0; i < 2; i++)
#pragma unroll
                for (int r = 0; r < 4; r++) {
                    const int t = mt * 16 + qq * 4 + r, cc = (nt0 + i) * 16 + kr;
                    const float wl = p.w0[h * 64 + cc] + acc[i][r];
                    const float z = -wl;
                    const float sp = fmaxf(z, 0.f) + log1pf(__expf(-fabsf(z)));
                    LW[t * 64 + cc] = -__expf(-sp - 0.5f);
                }
            ZACC(acc); mm64(xa + 64, 256, p.a2T + (size_t)h * 64 * 64, 64, acc, lane, wv);
#pragma unroll
            for (int i = 0; i < 2; i++)
#pragma unroll
                for (int r = 0; r < 4; r++) {
                    const int t = mt * 16 + qq * 4 + r, cc = (nt0 + i) * 16 + kr;
                    LA[t * 64 + cc] = sigmoidf_(p.a0[h * 64 + cc] + acc[i][r]);
                }
            ZACC(acc);
            mm64(xa + 128, 256, p.g2T + (size_t)h * 64 * 128, 128, acc, lane, wv);
            mm64(xa + 192, 256, p.g2T + (size_t)h * 64 * 128 + 64, 128, acc, lane, wv);
#pragma unroll
            for (int i = 0; i < 2; i++)
#pragma unroll
                for (int r = 0; r < 4; r++) {
                    const int t = mt * 16 + qq * 4 + r, cc = (nt0 + i) * 16 + kr;
                    p.ob[(n0 + t) * 512 + h * 64 + cc] = f2bf(acc[i][r]);
                }
        }
        __syncthreads();
        {
            RW_IDX
            const int ch = h * 64 + lane;
            const float mur = p.mu[ch], muk = p.mu[512 + ch], muv = p.mu[1024 + ch];
            const float kkw = p.k_k[ch], kaw = p.k_a[ch], rkw = p.r_k[ch];
            float rr[8], k2[8], vv[8], kkn[8], aa[8], lg[8], cs[8];
            float run = 0.f;
#pragma unroll
            for (int i = 0; i < 8; i++) {
                const int t = wv * 8 + i; const size_t n = n0 + t;
                const u16* cr = p.prw + n * CRW;
                float r = bf2f(cr[ch]), k = bf2f(cr[512 + ch]), v = bf2f(cr[1024 + ch]);
                float pr = 0.f, pk = 0.f, pv = 0.f;
                if (c * 64 + t > 0) { const u16* pp = cr - CRW; pr = bf2f(pp[ch]); pk = bf2f(pp[512 + ch]); pv = bf2f(pp[1024 + ch]); }
                r = r + (pr - r) * mur; k = k + (pk - k) * muk; v = v + (pv - v) * muv;
                const float a = LA[t * 64 + lane];
                lg[i] = LW[t * 64 + lane];
                float kk = k * kkw;
                const float nrm = fmaxf(sqrtf(wave_sum(kk * kk)), 1e-12f);
                kkn[i] = kk / nrm;
                k2[i] = k * (1.f + (a - 1.f) * kaw);
                const float bon = wave_sum(r * k2[i] * rkw);
                if (lane == 0) p.bon[n * 8 + h] = bon;
                rr[i] = r; vv[i] = v; aa[i] = a;
                run += lg[i]; cs[i] = run;
            }
            tot[wv * 64 + lane] = run;
            __syncthreads();
            float off = 0.f, cumL = 0.f;
#pragma unroll
            for (int w2 = 0; w2 < 8; w2++) { const float tv = tot[w2 * 64 + lane]; cumL += tv; if (w2 < wv) off += tv; }
            if (wv == 0) gl[lane] = __expf(cumL);
            unsigned pa[4], pb[4], pk4[4], pv4[4];
#pragma unroll
            for (int i = 0; i < 8; i += 2) {
                float at[2], bt[2], kt[2], rt[2];
#pragma unroll
                for (int e2 = 0; e2 < 2; e2++) {
                    const int ii = i + e2; const int t = wv * 8 + ii;
                    const float cm = off + cs[ii];
                    const float g = __expf(cm), gp = __expf(cm - lg[ii]), gi = __expf(-cm);
                    at[e2] = -kkn[ii] * gp; bt[e2] = kkn[ii] * aa[ii] * gi; kt[e2] = k2[ii] * gi; rt[e2] = rr[ii] * g;
                    sl[0 * RSLOT + t * RS + lane] = f2bf(at[e2]);
                    sl[1 * RSLOT + t * RS + lane] = f2bf(bt[e2]);
                    sl[2 * RSLOT + t * RS + lane] = f2bf(kt[e2]);
                    sl[3 * RSLOT + t * RS + lane] = f2bf(rt[e2]);
                }
                pa[i >> 1] = pack2(at[0], at[1]); pb[i >> 1] = pack2(bt[0], bt[1]);
                pk4[i >> 1] = pack2(kt[0], kt[1]); pv4[i >> 1] = pack2(vv[i], vv[i + 1]);
            }
            *(uint4*)&sl[4 * RSLOT + lane * RS + wv * 8] = make_uint4(pa[0], pa[1], pa[2], pa[3]);
            *(uint4*)&sl[5 * RSLOT + lane * RS + wv * 8] = make_uint4(pb[0], pb[1], pb[2], pb[3]);
            *(uint4*)&sl[6 * RSLOT + lane * RS + wv * 8] = make_uint4(pk4[0], pk4[1], pk4[2], pk4[3]);
            *(uint4*)&sl[7 * RSLOT + lane * RS + wv * 8] = make_uint4(pv4[0], pv4[1], pv4[2], pv4[3]);
        }
        __syncthreads();
        {
            RW_IDX
            f32x4 acc[2];
            ZACC(acc); mm64(sl + 1 * RSLOT, RS, sl + 0 * RSLOT, RS, acc, lane, wv);
#pragma unroll
            for (int i = 0; i < 2; i++) {
                f32x4 pm;
#pragma unroll
                for (int r = 0; r < 4; r++) {
                    const int m = mt * 16 + qq * 4 + r, n = (nt0 + i) * 16 + kr;
                    if (!(m < n)) acc[i][r] = 0.f;
                    pm[r] = acc[i][r] + ((m == n) ? 1.f : 0.f);
                }
                st_t(sl + 8 * RSLOT, RS, acc[i], mt, nt0 + i, lane);
                st_n(sl + 9 * RSLOT, RS, acc[i], mt, nt0 + i, lane);
                st_t(sl + 13 * RSLOT, RS, pm, mt, nt0 + i, lane);
            }
            ZACC(acc); mm64(sl + 0 * RSLOT, RS, sl + 2 * RSLOT, RS, acc, lane, wv);
#pragma unroll
            for (int i = 0; i < 2; i++) {
#pragma unroll
                for (int r = 0; r < 4; r++) { const int m = mt * 16 + qq * 4 + r, n = (nt0 + i) * 16 + kr; if (!(m > n)) acc[i][r] = 0.f; }
                st_t(sl + 10 * RSLOT, RS, acc[i], mt, nt0 + i, lane);
            }
            ZACC(acc); mm64(sl + 1 * RSLOT, RS, sl + 3 * RSLOT, RS, acc, lane, wv);
#pragma unroll
            for (int i = 0; i < 2; i++) {
#pragma unroll
                for (int r = 0; r < 4; r++) { const int m = mt * 16 + qq * 4 + r, n = (nt0 + i) * 16 + kr; if (m > n) acc[i][r] = 0.f; }
                st_t(sl + 11 * RSLOT, RS, acc[i], mt, nt0 + i, lane);
            }
            ZACC(acc); mm64(sl + 2 * RSLOT, RS, sl + 3 * RSLOT, RS, acc, lane, wv);
#pragma unroll
            for (int i = 0; i < 2; i++) {
#pragma unroll
                for (int r = 0; r < 4; r++) { const int m = mt * 16 + qq * 4 + r, n = (nt0 + i) * 16 + kr; if (m > n) acc[i][r] = 0.f; }
                st_t(sl + 12 * RSLOT, RS, acc[i], mt, nt0 + i, lane);
            }
        }
        LDS_BARRIER();
        u16* X = sl + 8 * RSLOT; u16* XT = sl + 9 * RSLOT; u16* X2 = sl + 0 * RSLOT; u16* X2T = sl + 1 * RSLOT;
        u16* Pc = sl + 13 * RSLOT; u16* Pn = sl + 2 * RSLOT;
#pragma unroll 1
        for (int j = 1; j <= 6; j++) {
            RW_IDX
            f32x4 acc[2];
            if (j <= 5) {
                ZACC(acc); mm64(X, RS, XT, RS, acc, lane, wv);
#pragma unroll
                for (int i = 0; i < 2; i++) { st_t(X2T, RS, acc[i], mt, nt0 + i, lane); st_n(X2, RS, acc[i], mt, nt0 + i, lane); }
            }
            if (j >= 2) {
                ZACC(acc); mm64(XT, RS, Pc, RS, acc, lane, wv);
#pragma unroll
                for (int i = 0; i < 2; i++) {
                    const uint2 pv = *(const uint2*)&Pc[((nt0 + i) * 16 + kr) * RS + mt * 16 + qq * 4];
                    acc[i][0] += __uint_as_float(pv.x << 16); acc[i][1] += __uint_as_float(pv.x & 0xFFFF0000u);
                    acc[i][2] += __uint_as_float(pv.y << 16); acc[i][3] += __uint_as_float(pv.y & 0xFFFF0000u);
                    st_t(Pn, RS, acc[i], mt, nt0 + i, lane);
                }
            }
            LDS_BARRIER();
            if (j >= 2) { u16* tp = Pc; Pc = Pn; Pn = tp; }
            if (j <= 5) { u16* tx = X; X = X2; X2 = tx; tx = XT; XT = X2T; X2T = tx; }
        }
        u16* TT = Pc;
        {
            RW_IDX
            f32x4 acc[2];
            ZACC(acc); mm64(TT, RS, sl + 4 * RSLOT, RS, acc, lane, wv);
#pragma unroll
            for (int i = 0; i < 2; i++) st_t(sl + 0 * RSLOT, RS, acc[i], mt, nt0 + i, lane);
            ZACC(acc); mm64(sl + 10 * RSLOT, RS, TT, RS, acc, lane, wv);
#pragma unroll
            for (int i = 0; i < 2; i++) st_t(sl + 8 * RSLOT, RS, acc[i], mt, nt0 + i, lane);
        }
        LDS_BARRIER();
        {
            RW_IDX
            f32x4 acc[2];
            ZACC(acc); mm64(sl + 8 * RSLOT, RS, sl + 7 * RSLOT, RS, acc, lane, wv);
#pragma unroll
            for (int i = 0; i < 2; i++) st_t(sl + 9 * RSLOT, RS, acc[i], mt, nt0 + i, lane);
            ZACC(acc); mm64(sl + 0 * RSLOT, RS, sl + 5 * RSLOT, RS, acc, lane, wv);
#pragma unroll
            for (int i = 0; i < 2; i++) {
                const int n = (nt0 + i) * 16 + kr; const float gn = gl[n];
#pragma unroll
                for (int r = 0; r < 4; r++) { const int m = mt * 16 + qq * 4 + r; acc[i][r] = acc[i][r] * gn + ((m == n) ? gn : 0.f); }
                st_t(cd, 64, acc[i], mt, nt0 + i, lane);
            }
            ZACC(acc); mm64(sl + 0 * RSLOT, RS, sl + 11 * RSLOT, RS, acc, lane, wv);
#pragma unroll
            for (int i = 0; i < 2; i++) {
                const uint2 rv = *(const uint2*)&sl[3 * RSLOT + ((nt0 + i) * 16 + kr) * RS + mt * 16 + qq * 4];
                acc[i][0] += __uint_as_float(rv.x << 16); acc[i][1] += __uint_as_float(rv.x & 0xFFFF0000u);
                acc[i][2] += __uint_as_float(rv.y << 16); acc[i][3] += __uint_as_float(rv.y & 0xFFFF0000u);
                st_t(cd + 2 * 4096, 64, acc[i], mt, nt0 + i, lane);
            }
        }
        LDS_BARRIER();
        {
            RW_IDX
            f32x4 acc[2];
            ZACC(acc);
            mm64(sl + 5 * RSLOT, RS, sl + 9 * RSLOT, RS, acc, lane, wv);
            mm64(sl + 6 * RSLOT, RS, sl + 7 * RSLOT, RS, acc, lane, wv);
#pragma unroll
            for (int i = 0; i < 2; i++) {
#pragma unroll
                for (int r = 0; r < 4; r++) acc[i][r] *= gl[mt * 16 + qq * 4 + r];
                st_t(cd + 1 * 4096, 64, acc[i], mt, nt0 + i, lane);
            }
            ZACC(acc);
            mm64(sl + 9 * RSLOT, RS, sl + 11 * RSLOT, RS, acc, lane, wv);
            mm64(sl + 7 * RSLOT, RS, sl + 12 * RSLOT, RS, acc, lane, wv);
#pragma unroll
            for (int i = 0; i < 2; i++) st_t(cd + 3 * 4096, 64, acc[i], mt, nt0 + i, lane);
        }
      }
    }
}

__device__ void ph_rwkv_seq(const P& p, int bid, int nb, char* smem) {
    u16* SL = (u16*)smem;
    const int tid = get_tid(), lane = tid & 63, wv = __builtin_amdgcn_readfirstlane(tid >> 6);
    const int kr = lane & 15, qq = lane >> 4, chn = wv >> 2, vt = wv & 3;
    for (int pair = bid; pair < B_ * 4; pair += nb) {
        const int bh = pair * 2 + chn;
        u16* mySL = SL + chn * RSLOT;
        __syncthreads();
#pragma unroll
        for (int ks = 0; ks < 2; ks++) *(uint4*)&mySL[(vt * 16 + kr) * RS + ks * 32 + qq * 8] = make_uint4(0u, 0u, 0u, 0u);
        u16* cbase = p.cdat + (size_t)bh * 128 * 4 * 4096;
        bf16x8 GA0[4][2], GA1[4][2], GA2[4][2], GA3[4][2]; uint2 H0[4], H1[4], H2[4], H3[4];
#define SEQ_LD(GAx, Hx, c) { const u16* cd_ = cbase + (size_t)(c) * 4 * 4096; \
            _Pragma("unroll") for (int m4 = 0; m4 < 4; m4++) { \
                _Pragma("unroll") for (int ks = 0; ks < 2; ks++) GAx[m4][ks] = *(const bf16x8*)&cd_[(m4 * 16 + kr) * 64 + ks * 32 + qq * 8]; \
                Hx[m4] = *(const uint2*)&cd_[1 * 4096 + (vt * 16 + kr) * 64 + m4 * 16 + qq * 4]; } }
#define SEQ_STEP(GAx, Hx, c) { \
            bf16x8 Z0[2]; \
            _Pragma("unroll") for (int ks = 0; ks < 2; ks++) Z0[ks] = *(const bf16x8*)&mySL[(vt * 16 + kr) * RS + ks * 32 + qq * 8]; \
            f32x4 zs[4]; \
            _Pragma("unroll") for (int m4 = 0; m4 < 4; m4++) { \
                zs[m4] = unpack4(Hx[m4]); \
                _Pragma("unroll") for (int ks = 0; ks < 2; ks++) zs[m4] = __builtin_amdgcn_mfma_f32_16x16x32_bf16(GAx[m4][ks], Z0[ks], zs[m4], 0, 0, 0); } \
            u16* sn_ = cbase + (size_t)(c) * 4 * 4096 + 1 * 4096 + (vt * 16 + kr) * 64 + qq * 4; \
            _Pragma("unroll") for (int m4 = 0; m4 < 4; m4++) { \
                const uint2 pk_ = pack4(zs[m4]); \
                *(uint2*)&mySL[(vt * 16 + kr) * RS + m4 * 16 + qq * 4] = pk_; \
                *(uint2*)&sn_[m4 * 16] = pk_; } \
            if ((c) + 4 < 128) SEQ_LD(GAx, Hx, (c) + 4) }
        SEQ_LD(GA0, H0, 0) SEQ_LD(GA1, H1, 1) SEQ_LD(GA2, H2, 2) SEQ_LD(GA3, H3, 3)
#pragma unroll 1
        for (int c = 0; c < 128; c += 4) {
            SEQ_STEP(GA0, H0, c)
            SEQ_STEP(GA1, H1, c + 1)
            SEQ_STEP(GA2, H2, c + 2)
            SEQ_STEP(GA3, H3, c + 3)
        }
#undef SEQ_LD
#undef SEQ_STEP
    }
}

__device__ void ph_rwkv_out(const P& p, int bid, int nb, char* smem) {
    const int tid = get_tid(), lane = tid & 63, wv = tid >> 6;
    const int kr = lane & 15, qq = lane >> 4;
    for (int it = bid * NW + wv; it < B_ * 8 * 128; it += nb * NW) {
        const int c = it & 127, bh = it >> 7, b = bh >> 3, h = bh & 7;
        const u16* cd = p.cdat + ((size_t)bh * 128 + c) * 4 * 4096;
        f32x4 ys[4][4];
#pragma unroll
        for (int mt = 0; mt < 4; mt++)
#pragma unroll
            for (int nt = 0; nt < 4; nt++) ys[mt][nt] = unpack4(*(const uint2*)&cd[3 * 4096 + (nt * 16 + kr) * 64 + mt * 16 + qq * 4]);
        if (c > 0) {
            const u16* s0 = cd - 4 * 4096 + 1 * 4096;
#pragma unroll
            for (int ks = 0; ks < 2; ks++) {
                bf16x8 af[4], bq[4];
#pragma unroll
                for (int mt = 0; mt < 4; mt++) af[mt] = *(const bf16x8*)&s0[(mt * 16 + kr) * 64 + ks * 32 + qq * 8];
#pragma unroll
                for (int nt = 0; nt < 4; nt++) bq[nt] = *(const bf16x8*)&cd[2 * 4096 + (nt * 16 + kr) * 64 + ks * 32 + qq * 8];
#pragma unroll
                for (int mt = 0; mt < 4; mt++)
#pragma unroll
                    for (int nt = 0; nt < 4; nt++) ys[mt][nt] = __builtin_amdgcn_mfma_f32_16x16x32_bf16(af[mt], bq[nt], ys[mt][nt], 0, 0, 0);
            }
        }
#pragma unroll
        for (int nt = 0; nt < 4; nt++) {
            float s1 = 0.f, s2 = 0.f;
#pragma unroll
            for (int mt = 0; mt < 4; mt++)
#pragma unroll
                for (int r = 0; r < 4; r++) { s1 += ys[mt][nt][r]; s2 += ys[mt][nt][r] * ys[mt][nt][r]; }
            s1 = xrow_sum(s1); s2 = xrow_sum(s2);
            const float mean = s1 * (1.f / 64.f);
            const float var = fmaxf(s2 * (1.f / 64.f) - mean * mean, 0.f);
            const float rstd = rsqrtf(var + 64e-5f);
            const int t = nt * 16 + kr;
            const size_t n = (size_t)b * S_ + c * 64 + t;
            const float bon = p.bon[n * 8 + h];
#pragma unroll
            for (int mt = 0; mt < 4; mt++) {
                const int vch = h * 64 + mt * 16 + qq * 4;
                const f32x4 vcf = unpack4(*(const uint2*)&p.prw[n * CRW + 1024 + vch]);
                const f32x4 vpf = (c * 64 + t > 0) ? unpack4(*(const uint2*)&p.prw[(n - 1) * CRW + 1024 + vch]) : f32x4{0.f, 0.f, 0.f, 0.f};
                const f32x4 ggf = unpack4(*(const uint2*)&p.ob[n * 512 + vch]);
                const float4 lw = *(const float4*)&p.ln_w[vch], lb = *(const float4*)&p.ln_b[vch], mv = *(const float4*)&p.mu[1024 + vch];
                const float lwa[4] = {lw.x, lw.y, lw.z, lw.w}, lba[4] = {lb.x, lb.y, lb.z, lb.w}, mva[4] = {mv.x, mv.y, mv.z, mv.w};
                f32x4 o;
#pragma unroll
                for (int r = 0; r < 4; r++) {
                    const float vsh = vcf[r] + (vpf[r] - vcf[r]) * mva[r];
                    o[r] = ((ys[mt][nt][r] - mean) * rstd * lwa[r] + lba[r] + bon * vsh) * ggf[r];
                }
                *(uint2*)&p.ob[n * 512 + vch] = pack4(o);
            }
        }
    }
}

template <int PASS>
__device__ __forceinline__ void merge_sweep(const P& p, int bid, int nb, u16* sm) {
    const int tid = get_tid(), lane = tid & 63, wv = tid >> 6;
    const int wm = wv >> 1, wn = wv & 1;
    u16* tmp2 = (u16*)p.x1;
    const int nitems = (NTOK / 256) * 8;
    for (int kk = 0;; kk++) {
        const int it = xcd_item(bid, nb, kk, nitems);
        if (it >= nitems) break;
        const int ct = it & 7, rt = it >> 3;
        const int r0 = rt * 256, c0 = ct * 128;
        f32x4 acc[4][4];
        if (PASS == 0) gemm_core<false>(512, [&](int r) { return p.oa + (size_t)(r0 + r) * 512; }, p.wpaT + (size_t)c0 * 512, 512, acc, sm);
        if (PASS == 1) gemm_core<false>(D_, [&](int r) { return p.hbuf + (size_t)(r0 + r) * D_; }, p.wgT + (size_t)c0 * D_, D_, acc, sm);
        if (PASS == 2) gemm_core<false>(512, [&](int r) { return p.ob + (size_t)(r0 + r) * 512; }, p.wpbT + (size_t)c0 * 512, 512, acc, sm);
        if (PASS == 3) gemm_core<false>(D_, [&](int r) { return p.hbuf + (size_t)(r0 + r) * D_; }, p.wgT + (size_t)(1024 + c0) * D_, D_, acc, sm);
        const int t2 = get_tid(), le = t2 & 63, wm2 = t2 >> 7, wn2 = (t2 >> 6) & 1;
#pragma unroll
        for (int mt = 0; mt < 4; mt++) {
            const size_t rowo = (size_t)(r0 + wm2 * 64 + mt * 16 + (le & 15)) * D_ + c0 + wn2 * 64 + (le >> 4) * 4;
            uint2 m1[4], m2[4];
            if (PASS == 1 || PASS == 3) {
#pragma unroll
                for (int nt = 0; nt < 4; nt++) { m1[nt] = *(const uint2*)&p.merged[rowo + nt * 16]; if (PASS == 3) m2[nt] = *(const uint2*)&tmp2[rowo + nt * 16]; }
            }
#pragma unroll
            for (int nt = 0; nt < 4; nt++) {
                f32x4 v = acc[mt][nt];
                if (PASS == 1) { const f32x4 a = unpack4(m1[nt]);
#pragma unroll
                    for (int r = 0; r < 4; r++) v[r] = a[r] * sigmoidf_(v[r]); }
                if (PASS == 3) { const f32x4 a = unpack4(m1[nt]), b2 = unpack4(m2[nt]);
#pragma unroll
                    for (int r = 0; r < 4; r++) v[r] = a[r] + b2[r] * sigmoidf_(v[r]); }
                if (PASS == 2) *(uint2*)&tmp2[rowo + nt * 16] = pack4(v);
                else *(uint2*)&p.merged[rowo + nt * 16] = pack4(v);
            }
            asm volatile("" ::: "memory");
        }
    }
    __syncthreads();
}
__device__ void ph_merge(const P& p, int bid, int nb, char* smem) {
    u16* sm = (u16*)smem;
    merge_sweep<0>(p, bid, nb, sm);
    merge_sweep<1>(p, bid, nb, sm);
    merge_sweep<2>(p, bid, nb, sm);
    merge_sweep<3>(p, bid, nb, sm);
}

__device__ void ph_outproj(const P& p, int bid, int nb, char* smem) {
    u16* sm = (u16*)smem;
    const int tid = get_tid(), lane = tid & 63, wv = tid >> 6;
    const int wm = wv >> 1, wn = wv & 1;
    const int nitems = (NTOK / 256) * 8;
    for (int kk = 0;; kk++) {
        const int it = xcd_item(bid, nb, kk, nitems);
        if (it >= nitems) break;
        const int ct = it & 7, rt = it >> 3;
        const int r0 = rt * 256, c0 = ct * 128;
        f32x4 acc[4][4];
        gemm_core(D_, [&](int r) { return p.merged + (size_t)(r0 + r) * D_; }, p.woutT + (size_t)c0 * D_, D_, acc, sm);
        const int t2 = get_tid(), le = t2 & 63, wm2 = t2 >> 7, wn2 = (t2 >> 6) & 1;
#pragma unroll
        for (int mt = 0; mt < 4; mt++) {
            const size_t rowo = (size_t)(r0 + wm2 * 64 + mt * 16 + (le & 15)) * D_ + c0 + wn2 * 64 + (le >> 4) * 4;
            float4 xin[4];
#pragma unroll
            for (int nt = 0; nt < 4; nt++) xin[nt] = *(const float4*)&p.x[rowo + nt * 16];
#pragma unroll
            for (int nt = 0; nt < 4; nt++) {
                float4 o; o.x = xin[nt].x + acc[mt][nt][0]; o.y = xin[nt].y + acc[mt][nt][1]; o.z = xin[nt].z + acc[mt][nt][2]; o.w = xin[nt].w + acc[mt][nt][3];
                *(float4*)&p.x1[rowo + nt * 16] = o;
            }
        }
    }
}

__device__ __forceinline__ float red8f(float x) {
    x += dppf<0xB1>(x);
    x += dppf<0x4E>(x);
    x += dppf<0x141>(x);
    return x;
}
__device__ void ph_route(const P& p, int bid, int nb, char* smem) {
    float* wr = (float*)smem;
    const int tid = get_tid(), lane = tid & 63, wv = tid >> 6;
    {
        const int gtid = bid * NT + tid, gnt = nb * NT;
        const int per_e = 256 * 128 + 256 * 128 + 1024 * 32;
        for (int i = gtid; i < NEXP * per_e; i += gnt) {
            const int e = i / per_e; int r = i - e * per_e;
            const float* W; u16* WT; int K, N, rows;
            if (r < 256 * 128) { W = p.e_w1 + (size_t)e * D_ * 256; WT = p.ew1T + (size_t)e * 256 * D_; K = D_; N = 256; rows = 256; }
            else if (r < 2 * 256 * 128) { r -= 256 * 128; W = p.e_w3 + (size_t)e * D_ * 256; WT = p.ew3T + (size_t)e * 256 * D_; K = D_; N = 256; rows = 256; }
            else { r -= 2 * 256 * 128; W = p.e_w2 + (size_t)e * 256 * D_; WT = p.ew2T + (size_t)e * D_ * 256; K = 256; N = D_; rows = 1024; }
            const int kc = r / rows, j = r - kc * rows;
            const float* wp = W + (size_t)(kc * 8) * N + j;
            uint4 v;
            v.x = pack2(wp[0], wp[(size_t)N]); v.y = pack2(wp[2 * (size_t)N], wp[3 * (size_t)N]);
            v.z = pack2(wp[4 * (size_t)N], wp[5 * (size_t)N]); v.w = pack2(wp[6 * (size_t)N], wp[7 * (size_t)N]);
            *(uint4*)&WT[(size_t)j * K + kc * 8] = v;
        }
    }
    for (int i = tid; i < 1024 * 36; i += NT) {
        const int k = i / 36, j = i - k * 36;
        wr[i] = (j < 4) ? p.w_grp[k * 4 + j] : p.w_exp[k * 32 + (j - 4)];
    }
    __syncthreads();
    const int sub = lane & 7, tk = lane >> 3;
    for (int n0 = (bid * NW + wv) * 8; n0 < NTOK; n0 += nb * NW * 8) {
        const size_t n = (size_t)n0 + tk;
        const float* xr = p.x1 + n * D_;
        float acc[36]; float ss = 0.f;
#pragma unroll
        for (int j = 0; j < 36; j++) acc[j] = 0.f;
#pragma unroll 2
        for (int i = 0; i < 32; i++) {
            const int k0 = i * 32 + sub * 4;
            const float4 xv = *(const float4*)&xr[k0];
            const float4 gf = *(const float4*)&p.g_ffn[k0];
            ss += xv.x * xv.x + xv.y * xv.y + xv.z * xv.z + xv.w * xv.w;
            const float hv[4] = {xv.x * gf.x, xv.y * gf.y, xv.z * gf.z, xv.w * gf.w};
#pragma unroll
            for (int e2 = 0; e2 < 4; e2++) {
                const float* wrow = wr + (k0 + e2) * 36;
#pragma unroll
                for (int j4 = 0; j4 < 9; j4++) {
                    const float4 wv4 = *(const float4*)&wrow[j4 * 4];
                    acc[j4 * 4 + 0] += hv[e2] * wv4.x; acc[j4 * 4 + 1] += hv[e2] * wv4.y;
                    acc[j4 * 4 + 2] += hv[e2] * wv4.z; acc[j4 * 4 + 3] += hv[e2] * wv4.w;
                }
            }
        }
        ss = red8f(ss);
#pragma unroll
        for (int j = 0; j < 36; j++) acc[j] = red8f(acc[j]);
        const float rs = rsqrtf(ss * (1.f / D_) + 1e-6f);
#pragma unroll 4
        for (int i = 0; i < 32; i++) {
            const int k0 = i * 32 + sub * 4;
            const float4 xv = *(const float4*)&xr[k0];
            const float4 gf = *(const float4*)&p.g_ffn[k0];
            uint2 o; o.x = pack2(xv.x * rs * gf.x, xv.y * rs * gf.y); o.y = pack2(xv.z * rs * gf.z, xv.w * rs * gf.w);
            *(uint2*)&p.hbuf[n * D_ + k0] = o;
        }
        if (sub == 0) {
            float gl[4]; int gs = 0;
#pragma unroll
            for (int j = 0; j < 4; j++) gl[j] = acc[j] * rs + p.b_grp[j];
            float gm = gl[0];
#pragma unroll
            for (int j = 1; j < 4; j++) if (gl[j] > gm) { gm = gl[j]; gs = j; }
            float gsum = 0.f;
#pragma unroll
            for (int j = 0; j < 4; j++) gsum += __expf(gl[j] - gm);
            const float pg = 1.f / gsum;
            float el[8]; float em = -3.0e38f;
#pragma unroll
            for (int j = 0; j < 8; j++) {
                float a = (gs == 0) ? acc[4 + j] : ((gs == 1) ? acc[12 + j] : ((gs == 2) ? acc[20 + j] : acc[28 + j]));
                a = a * rs + p.b_exp[gs * 8 + j];
                el[j] = a; em = fmaxf(em, a);
            }
            int j0 = 0, j1 = -1; float v0 = -3.0e38f, v1 = -3.0e38f;
#pragma unroll
            for (int j = 0; j < 8; j++) { el[j] = __expf(el[j] - em); }
#pragma unroll
            for (int j = 0; j < 8; j++) { if (el[j] > v0) { v0 = el[j]; j0 = j; } }
#pragma unroll
            for (int j = 0; j < 8; j++) { if (j != j0 && el[j] > v1) { v1 = el[j]; j1 = j; } }
            const float den = v0 + v1;
            const int e0 = gs * 8 + j0, e1 = gs * 8 + j1;
            p.tok_e[n * 2] = e0; p.tok_e[n * 2 + 1] = e1;
            p.tok_gate[n * 2] = pg * v0 / den; p.tok_gate[n * 2 + 1] = pg * v1 / den;
            atomicAdd(&p.counts[e0], 1); atomicAdd(&p.counts[e1], 1);
        }
    }
}

__device__ void ph_scatter(const P& p, int bid, int nb, char* smem) {
    int* offl = (int*)smem;
    int* hist = offl + 64;
    int* gbase = hist + 32;
    const int tid = get_tid();
    if (tid == 0) {
        int off = 0;
        for (int e = 0; e < NEXP; e++) { offl[e] = off; off += p.counts[e]; }
        offl[NEXP] = off;
    }
    if (bid == 0 && tid == 64) {
        int off = 0, nb_ = 0;
        for (int e = 0; e < NEXP; e++) {
            const int c = p.counts[e];
            p.offs[e] = off;
            for (int r = 0; r < c; r += 256) { p.blk_e[nb_] = e; p.blk_r0[nb_] = off + r; nb_++; }
            off += c;
        }
        p.offs[NEXP] = off;
        *p.nblk = nb_;
    }
    for (int base = bid * NT; base < NTOK * 2; base += nb * NT) {
        __syncthreads();
        if (tid < 32) hist[tid] = 0;
        __syncthreads();
        const int i = base + tid;
        const int e = p.tok_e[i];
        const int rl = atomicAdd(&hist[e], 1);
        __syncthreads();
        if (tid < 32) gbase[tid] = atomicAdd(&p.cursor[tid], hist[tid]);
        __syncthreads();
        const int slot = offl[e] + gbase[e] + rl;
        p.list_tok[slot] = i >> 1; p.list_gate[slot] = p.tok_gate[i]; p.tokslot[i] = slot;
    }
}
template <int PASS>
__device__ __forceinline__ void moe1_sweep(const P& p, int bid, int nb, u16* sm) {
    const int tid = get_tid(), lane = tid & 63, wv = tid >> 6;
    const int wm = wv >> 1, wn = wv & 1;
    const int nitems = (*p.nblk) * 2;
    for (int kk = 0;; kk++) {
        const int it = xcd_item(bid, nb, kk, nitems);
        if (it >= nitems) break;
        const int bi = it >> 1, ct = it & 1;
        const int e = p.blk_e[bi], r0 = p.blk_r0[bi], c0 = ct * 128;
        const int rend = p.offs[e + 1];
        auto arow = [&](int r) { int sl = r0 + r; if (sl >= rend) sl = rend - 1; return p.hbuf + (size_t)p.list_tok[sl] * D_; };
        f32x4 acc[4][4];
        gemm_core(D_, arow, ((PASS == 0) ? p.ew1T : p.ew3T) + ((size_t)e * 256 + c0) * D_, D_, acc, sm);
        const int t2 = get_tid(), le = t2 & 63, wm2 = t2 >> 7, wn2 = (t2 >> 6) & 1;
#pragma unroll
        for (int mt = 0; mt < 4; mt++) {
            const int sl = r0 + wm2 * 64 + mt * 16 + (le & 15);
            if (sl < rend) {
                u16* hp = p.hid + (size_t)sl * 256 + c0 + wn2 * 64 + (le >> 4) * 4;
                uint2 m1[4];
                if (PASS == 1) {
#pragma unroll
                    for (int nt = 0; nt < 4; nt++) m1[nt] = *(const uint2*)&hp[nt * 16];
                }
#pragma unroll
                for (int nt = 0; nt < 4; nt++) {
                    f32x4 v = acc[mt][nt];
                    if (PASS == 0) {
#pragma unroll
                        for (int r = 0; r < 4; r++) v[r] = v[r] * sigmoidf_(v[r]);
                    } else {
                        const f32x4 a = unpack4(m1[nt]);
#pragma unroll
                        for (int r = 0; r < 4; r++) v[r] = a[r] * v[r];
                    }
                    *(uint2*)&hp[nt * 16] = pack4(v);
                }
            }
            asm volatile("" ::: "memory");
        }
    }
    __syncthreads();
}
__device__ void ph_moe1(const P& p, int bid, int nb, char* smem) {
    u16* sm = (u16*)smem;
    moe1_sweep<0>(p, bid, nb, sm);
    moe1_sweep<1>(p, bid, nb, sm);
}
__device__ void ph_moe2(const P& p, int bid, int nb, char* smem) {
    u16* sm = (u16*)smem;
    const int tid = get_tid(), lane = tid & 63, wv = tid >> 6;
    const int wm = wv >> 1, wn = wv & 1;
    const int nitems = (*p.nblk) * 8;
    for (int kk = 0;; kk++) {
        const int it = xcd_item(bid, nb, kk, nitems);
        if (it >= nitems) break;
        const int bi = it >> 3, ct = it & 7;
        const int e = p.blk_e[bi], r0 = p.blk_r0[bi], c0 = ct * 128;
        const int rend = p.offs[e + 1];
        f32x4 acc[4][4];
        auto arow = [&](int r) { int sl = r0 + r; if (sl >= rend) sl = rend - 1; return p.hid + (size_t)sl * 256; };
        gemm_core(256, arow, p.ew2T + ((size_t)e * D_ + c0) * 256, 256, acc, sm);
        const int t2 = get_tid(), le = t2 & 63, wm2 = t2 >> 7, wn2 = (t2 >> 6) & 1;
#pragma unroll
        for (int mt = 0; mt < 4; mt++) {
            const int sl = r0 + wm2 * 64 + mt * 16 + (le & 15);
            if (sl < rend) {
                const float gt = p.list_gate[sl];
                u16* yp = p.ybuf + (size_t)sl * D_ + c0 + wn2 * 64 + (le >> 4) * 4;
#pragma unroll
                for (int nt = 0; nt < 4; nt++) {
                    f32x4 v = acc[mt][nt];
#pragma unroll
                    for (int r = 0; r < 4; r++) v[r] *= gt;
                    *(uint2*)&yp[nt * 16] = pack4(v);
                }
            }
        }
    }
}
__device__ void ph_final(const P& p, int bid, int nb, char* smem) {
    const int tid = get_tid(), lane = tid & 63, wv = tid >> 6;
    for (int row = bid * NW + wv; row < NTOK; row += nb * NW) {
        const int s0 = p.tokslot[row * 2], s1 = p.tokslot[row * 2 + 1];
        float v[16]; float ss = 0.f;
#pragma unroll
        for (int i = 0; i < 4; i++) {
            const int c = i * 256 + lane * 4;
            const float4 t = *(const float4*)&p.x1[(size_t)row * D_ + c];
            const uint2 a = *(const uint2*)&p.ybuf[(size_t)s0 * D_ + c];
            const uint2 bq = *(const uint2*)&p.ybuf[(size_t)s1 * D_ + c];
            v[4 * i]     = t.x + __uint_as_float(a.x << 16) + __uint_as_float(bq.x << 16);
            v[4 * i + 1] = t.y + __uint_as_float(a.x & 0xFFFF0000u) + __uint_as_float(bq.x & 0xFFFF0000u);
            v[4 * i + 2] = t.z + __uint_as_float(a.y << 16) + __uint_as_float(bq.y << 16);
            v[4 * i + 3] = t.w + __uint_as_float(a.y & 0xFFFF0000u) + __uint_as_float(bq.y & 0xFFFF0000u);
            ss += v[4 * i] * v[4 * i] + v[4 * i + 1] * v[4 * i + 1] + v[4 * i + 2] * v[4 * i + 2] + v[4 * i + 3] * v[4 * i + 3];
        }
        ss = wave_sum(ss);
        const float rs = rsqrtf(ss * (1.f / D_) + 1e-6f);
#pragma unroll
        for (int i = 0; i < 4; i++) {
            const int c = i * 256 + lane * 4;
            const float4 g = *(const float4*)&p.g_final[c];
            float4 o; o.x = v[4 * i] * rs * g.x; o.y = v[4 * i + 1] * rs * g.y; o.z = v[4 * i + 2] * rs * g.z; o.w = v[4 * i + 3] * rs * g.w;
            *(float4*)&p.out[(size_t)row * D_ + c] = o;
        }
    }
}

#define XB_TMO      128
#define XB_XCNT(j)  (256  + 64 * (j))
#define XB_XSUB(j)  (1280 + 64 * (j))
#define XB_XGEN(j)  (2304 + 64 * (j))
#define XB_TOP      3328
#define XB_TOPGEN   3392
#define XCD_BAR_WORDS 3456
#define XB_SPIN_CAP (1u << 18)
#define LAS __attribute__((address_space(3)))

__device__ __forceinline__ unsigned xb_ld(unsigned* p)              { return __hip_atomic_load(p, __ATOMIC_RELAXED, __HIP_MEMORY_SCOPE_AGENT); }
__device__ __forceinline__ unsigned xb_add(unsigned* p, unsigned v) { return __hip_atomic_fetch_add(p, v, __ATOMIC_RELAXED, __HIP_MEMORY_SCOPE_AGENT); }
__device__ __forceinline__ unsigned xb_xcc_id() { return (unsigned)__builtin_amdgcn_s_getreg((3 << 11) | 20) & 0xFu; }
#define XB_SPIN(cond, bar) do { unsigned _sp = 0; while (cond) { __builtin_amdgcn_s_sleep(1); \
    if ((++_sp & 255u) == 0u) { if (xb_ld(&(bar)[XB_TMO])) break; if (_sp > XB_SPIN_CAP) { atomicAdd(&(bar)[XB_TMO], 1u); break; } } } } while (0)

struct XcdBarrier {
    unsigned* bar; unsigned x;
    volatile LAS unsigned* st;
};

__device__ __forceinline__ XcdBarrier xcd_barrier_post(unsigned* bar, volatile LAS unsigned* st) {
    XcdBarrier b; b.bar = bar; b.x = xb_xcc_id(); b.st = st;
    if (threadIdx.x == 0) (void)xb_add(&bar[XB_XCNT(b.x)], 1u);
    return b;
}
__device__ __forceinline__ void xcd_barrier_complete(unsigned* bar, unsigned x, unsigned& nloc, unsigned& nx) {
    const unsigned G = gridDim.x * gridDim.y * gridDim.z;
    unsigned sum, cnt, mine, sp = 0u;
    for (;;) {
        sum = 0u; cnt = 0u; mine = 0u;
#pragma unroll
        for (unsigned j = 0; j < 16; ++j) { const unsigned c = xb_ld(&bar[XB_XCNT(j)]); sum += c; cnt += (c > 0u) ? 1u : 0u; mine = (j == x) ? c : mine; }
        if (sum == G) break;
        __builtin_amdgcn_s_sleep(1);
        if ((++sp & 255u) == 0u) { if (xb_ld(&bar[XB_TMO])) break; if (sp > XB_SPIN_CAP) { atomicAdd(&bar[XB_TMO], 1u); break; } }
    }
    nloc = mine > 0u ? mine : 1u; nx = cnt > 0u ? cnt : 1u;
}

__device__ __forceinline__ void xcd_barrier(const XcdBarrier& b) {
    asm volatile("s_waitcnt vmcnt(0)" ::: "memory");
    __syncthreads();
    if (threadIdx.x == 0) {
        unsigned* bar = b.bar;
        __builtin_amdgcn_s_waitcnt(0);
        unsigned nloc = b.st[0], nx = b.st[1];
        if (nloc == 0u) { xcd_barrier_complete(bar, b.x, nloc, nx); b.st[0] = nloc; b.st[1] = nx; }
        const unsigned old = xb_add(&bar[XB_XSUB(b.x)], 1u);
        const unsigned gen = old / nloc;
        if (old + 1u == (gen + 1u) * nloc) {
            __builtin_amdgcn_fence(__ATOMIC_RELEASE, "agent");
            asm volatile("s_waitcnt vmcnt(0)" ::: "memory");
            const unsigned og = xb_add(&bar[XB_TOP], 1u);
            const unsigned tg = og / nx;
            if (og + 1u == (tg + 1u) * nx) xb_add(&bar[XB_TOPGEN], 1u);
            else XB_SPIN(xb_ld(&bar[XB_TOPGEN]) == tg, bar);
            __builtin_amdgcn_fence(__ATOMIC_ACQUIRE, "agent");
            xb_add(&bar[XB_XGEN(b.x)], 1u);
            asm volatile("s_waitcnt vmcnt(0)" ::: "memory");
        } else {
            XB_SPIN(xb_ld(&bar[XB_XGEN(b.x)]) == gen, bar);
            __builtin_amdgcn_fence(__ATOMIC_ACQUIRE, "agent");
            asm volatile("s_waitcnt vmcnt(0)" ::: "memory");
        }
    }
    __syncthreads();
}

template <int PH>
__device__ __forceinline__ void run_phase(const P& p, int bid, int nb, char* smem) {
    if constexpr (PH == 0) ph_prologue(p, bid, nb, smem);
    if constexpr (PH == 1) ph_inproj(p, bid, nb, smem);
    if constexpr (PH == 2) { ph_compress(p, bid, nb, smem); __syncthreads(); ph_rwkv_chunk(p, bid, nb, smem); }
    if constexpr (PH == 3) {
        if (bid < SCAN_BLOCKS) ph_rwkv_seq(p, bid, SCAN_BLOCKS, smem);
        else ph_nsa(p, bid - SCAN_BLOCKS, nb - SCAN_BLOCKS, smem);
    }
    if constexpr (PH == 12) ph_rwkv_out(p, bid, nb, smem);
    if constexpr (PH == 4) ph_merge(p, bid, nb, smem);
    if constexpr (PH == 5) ph_outproj(p, bid, nb, smem);
    if constexpr (PH == 6) ph_route(p, bid, nb, smem);
    if constexpr (PH == 7) ph_scatter(p, bid, nb, smem);
    if constexpr (PH == 9) ph_moe1(p, bid, nb, smem);
    if constexpr (PH == 10) ph_moe2(p, bid, nb, smem);
    if constexpr (PH == 11) ph_final(p, bid, nb, smem);
}

template <int PH>
__global__ void __launch_bounds__(NT) kph(P p) {
    extern __shared__ __attribute__((aligned(16))) char smem[];
    run_phase<PH>(p, blockIdx.x, gridDim.x, smem);
}

__global__ void __launch_bounds__(NT, 2) mega(P p) {
    extern __shared__ __attribute__((aligned(16))) char smem[];
    volatile LAS unsigned* st = (volatile LAS unsigned*)(smem + SMEM_BYTES - 16);
    if (threadIdx.x == 0) { st[0] = 0u; st[1] = 0u; st[2] = 0u; st[3] = 0u; }
    __syncthreads();
    XcdBarrier bar = xcd_barrier_post(p.bar, st);
    const int bid = blockIdx.x, nb = gridDim.x;
    run_phase<0>(p, bid, nb, smem); xcd_barrier(bar);
    run_phase<1>(p, bid, nb, smem); xcd_barrier(bar);
    run_phase<2>(p, bid, nb, smem); xcd_barrier(bar);
    run_phase<3>(p, bid, nb, smem); xcd_barrier(bar);
    run_phase<12>(p, bid, nb, smem); xcd_barrier(bar);
    run_phase<4>(p, bid, nb, smem); xcd_barrier(bar);
    run_phase<5>(p, bid, nb, smem); xcd_barrier(bar);
    run_phase<6>(p, bid, nb, smem); xcd_barrier(bar);
    run_phase<7>(p, bid, nb, smem); xcd_barrier(bar);
    run_phase<9>(p, bid, nb, smem); xcd_barrier(bar);
    run_phase<10>(p, bid, nb, smem); xcd_barrier(bar);
    run_phase<11>(p, bid, nb, smem);
}

extern "C" void kernel_launch(void* const* d_in, const int* in_sizes, int n_in,
                              void* d_out, int out_size, void* d_ws, size_t ws_size,
                              hipStream_t stream) {
    P p{};
    p.x = (const float*)d_in[0]; p.pos = (const int*)d_in[1]; p.g_mix = (const float*)d_in[2]; p.w_in = (const float*)d_in[3];
    p.pe_k = (const float*)d_in[4]; p.w1_k = (const float*)d_in[5]; p.b1_k = (const float*)d_in[6]; p.w2_k = (const float*)d_in[7]; p.b2_k = (const float*)d_in[8];
    p.pe_v = (const float*)d_in[9]; p.w1_v = (const float*)d_in[10]; p.b1_v = (const float*)d_in[11]; p.w2_v = (const float*)d_in[12]; p.b2_v = (const float*)d_in[13];
    p.mu = (const float*)d_in[14]; p.w0 = (const float*)d_in[15]; p.w2 = (const float*)d_in[16]; p.a0 = (const float*)d_in[17]; p.a2 = (const float*)d_in[18];
    p.g2 = (const float*)d_in[19]; p.k_k = (const float*)d_in[20]; p.k_a = (const float*)d_in[21]; p.r_k = (const float*)d_in[22]; p.ln_w = (const float*)d_in[23]; p.ln_b = (const float*)d_in[24];
    p.wpa = (const float*)d_in[25]; p.wpb = (const float*)d_in[26]; p.wout = (const float*)d_in[27]; p.g_ffn = (const float*)d_in[28];
    p.w_grp = (const float*)d_in[29]; p.b_grp = (const float*)d_in[30]; p.w_exp = (const float*)d_in[31]; p.b_exp = (const float*)d_in[32];
    p.e_w1 = (const float*)d_in[33]; p.e_w3 = (const float*)d_in[34]; p.e_w2 = (const float*)d_in[35]; p.g_final = (const float*)d_in[36];
    p.out = (float*)d_out;
    char* ws = (char*)d_ws;
    const size_t MiB = 1ull << 20;
    p.hbuf = (u16*)(ws + 0 * MiB);
    p.q    = (u16*)(ws + 64 * MiB);
    p.kc   = (u16*)(ws + 96 * MiB);  p.vc   = (u16*)(ws + 104 * MiB);
    p.ksl  = (u16*)(ws + 112 * MiB); p.vslT = (u16*)(ws + 120 * MiB);
    p.kwn  = (u16*)(ws + 128 * MiB); p.vwnT = (u16*)(ws + 136 * MiB);
    p.nsag = (float*)(ws + 144 * MiB);
    p.kcb  = (u16*)(ws + 148 * MiB); p.vcT  = (u16*)(ws + 149 * MiB);
    p.prw  = (u16*)(ws + 160 * MiB);
    p.cdat = (u16*)(ws + 272 * MiB);
    p.bon  = (float*)(ws + 150 * MiB);
    p.w2T  = (u16*)(ws + 151 * MiB); p.a2T = p.w2T + 512 * 64; p.g2T = p.a2T + 512 * 64;
    p.cw1Tk = (u16*)(ws + 152 * MiB); p.cw1Tv = (u16*)(ws + 153 * MiB);
    p.cw2Tk = (u16*)(ws + 154 * MiB); p.cw2Tv = p.cw2Tk + 128 * 256;
    p.chid = (u16*)(ws + 155 * MiB);
    p.xact = (u16*)(ws + 488 * MiB);
    p.oa   = (u16*)(ws + 400 * MiB);
    p.ob   = (u16*)(ws + 432 * MiB);
    p.merged = (u16*)(ws + 64 * MiB);
    p.x1   = (float*)(ws + 160 * MiB);
    char* rt = ws + 288 * MiB;
    p.tok_e = (int*)(rt);                        rt += NTOK * 2 * 4;
    p.tok_gate = (float*)(rt);                   rt += NTOK * 2 * 4;
    p.tokslot = (int*)(rt);                      rt += NTOK * 2 * 4;
    p.list_tok = (int*)(rt);                     rt += NTOK * 2 * 4;
    p.list_gate = (float*)(rt);                  rt += NTOK * 2 * 4;
    p.blk_e = (int*)(rt);                        rt += 2048 * 4;
    p.blk_r0 = (int*)(rt);                       rt += 2048 * 4;
    p.hid  = (u16*)(ws + 296 * MiB);
    p.ybuf = (u16*)(ws + 336 * MiB);
    char* misc = ws + 470 * MiB;
    p.counts = (int*)(misc); p.cursor = (int*)(misc + 256); p.offs = (int*)(misc + 512); p.nblk = (int*)(misc + 1024);
    p.bar = (unsigned*)(ws + 471 * MiB);
    p.cb1k = (float*)(p.bar + XCD_BAR_WORDS); p.cb1v = p.cb1k + 256;
    {
        char* wa = ws + 472 * MiB;
        p.winT = (u16*)wa;  wa += (size_t)3200 * 1024 * 2;
        p.wgT  = (u16*)wa;  wa += (size_t)2048 * 1024 * 2;
        p.wpaT = (u16*)wa;  wa += (size_t)1024 * 512 * 2;
        p.wpbT = (u16*)wa;  wa += (size_t)1024 * 512 * 2;
        p.woutT = (u16*)wa; wa += (size_t)1024 * 1024 * 2;
        p.ew1T = (u16*)(ws + 64 * MiB);  p.ew3T = (u16*)(ws + 80 * MiB);  p.ew2T = (u16*)(ws + 96 * MiB);
    }
    if (ws_size < (size_t)505 * MiB) return;

#if MEGA
    {
        static int mgrid = 0;
        if (mgrid == 0) {
            int dev = 0, cus = 0, per_cu = 0;
            hipGetDevice(&dev);
            hipDeviceGetAttribute(&cus, hipDeviceAttributeMultiprocessorCount, dev);
            hipFuncSetAttribute((const void*)mega, hipFuncAttributeMaxDynamicSharedMemorySize, SMEM_BYTES);
            hipOccupancyMaxActiveBlocksPerMultiprocessor(&per_cu, (const void*)mega, NT, SMEM_BYTES);
            (void)hipGetLastError();
            mgrid = cus;
        }
        hipMemsetAsync(p.bar, 0, XCD_BAR_WORDS * sizeof(unsigned) + 512 * sizeof(float), stream);
        mega<<<mgrid, NT, SMEM_BYTES, stream>>>(p);
        return;
    }
#else
    const int grid = 512;
    hipMemsetAsync(p.bar, 0, XCD_BAR_WORDS * sizeof(unsigned) + 512 * sizeof(float), stream);
    hipFuncSetAttribute((const void*)kph<0>, hipFuncAttributeMaxDynamicSharedMemorySize, SMEM_BYTES);
    hipFuncSetAttribute((const void*)kph<1>, hipFuncAttributeMaxDynamicSharedMemorySize, SMEM_BYTES);
    hipFuncSetAttribute((const void*)kph<2>, hipFuncAttributeMaxDynamicSharedMemorySize, SMEM_BYTES);
    hipFuncSetAttribute((const void*)kph<3>, hipFuncAttributeMaxDynamicSharedMemorySize, SMEM_BYTES);
    hipFuncSetAttribute((const void*)kph<4>, hipFuncAttributeMaxDynamicSharedMemorySize, SMEM_BYTES);
    hipFuncSetAttribute((const void*)kph<5>, hipFuncAttributeMaxDynamicSharedMemorySize, SMEM_BYTES);
    hipFuncSetAttribute((const void*)kph<6>, hipFuncAttributeMaxDynamicSharedMemorySize, SMEM_BYTES);
    hipFuncSetAttribute((const void*)kph<7>, hipFuncAttributeMaxDynamicSharedMemorySize, SMEM_BYTES);
    hipFuncSetAttribute((const void*)kph<8>, hipFuncAttributeMaxDynamicSharedMemorySize, SMEM_BYTES);
    hipFuncSetAttribute((const void*)kph<9>, hipFuncAttributeMaxDynamicSharedMemorySize, SMEM_BYTES);
    hipFuncSetAttribute((const void*)kph<10>, hipFuncAttributeMaxDynamicSharedMemorySize, SMEM_BYTES);
    hipFuncSetAttribute((const void*)kph<11>, hipFuncAttributeMaxDynamicSharedMemorySize, SMEM_BYTES);
    kph<0><<<grid, NT, SMEM_BYTES, stream>>>(p);
    kph<1><<<grid, NT, SMEM_BYTES, stream>>>(p);
    kph<2><<<grid, NT, SMEM_BYTES, stream>>>(p);
    kph<3><<<grid, NT, SMEM_BYTES, stream>>>(p);
    kph<12><<<grid, NT, SMEM_BYTES, stream>>>(p);
    kph<4><<<grid, NT, SMEM_BYTES, stream>>>(p);
    kph<5><<<grid, NT, SMEM_BYTES, stream>>>(p);
    kph<6><<<grid, NT, SMEM_BYTES, stream>>>(p);
    kph<7><<<grid, NT, SMEM_BYTES, stream>>>(p);
    kph<8><<<grid, NT, SMEM_BYTES, stream>>>(p);
    kph<9><<<grid, NT, SMEM_BYTES, stream>>>(p);
    kph<10><<<grid, NT, SMEM_BYTES, stream>>>(p);
    kph<11><<<grid, NT, SMEM_BYTES, stream>>>(p);
#endif
}
```

```cpp
#include <hip/hip_runtime.h>
#include <stdint.h>

typedef unsigned short u16;
using bf16x8 = __attribute__((ext_vector_type(8))) short;
using f32x4  = __attribute__((ext_vector_type(4))) float;

#ifndef MEGA
#define MEGA 1
#endif

constexpr int B_ = 4, S_ = 8192, D_ = 1024, NTOK = B_ * S_;
constexpr int CIN = 5144;
constexpr int NCMP = 511;
constexpr int CRW = 1792;
constexpr int NEXP = 32;
constexpr int NT = 512;
constexpr int NW = NT / 64;
constexpr int SMEM_BYTES = 160 * 1024;
constexpr int SCAN_BLOCKS = 16;
constexpr float QSCALE = 0.125f * 1.4426950408889634f;

struct P {
    const float* x; const int* pos; const float* g_mix; const float* w_in;
    const float *pe_k, *w1_k, *b1_k, *w2_k, *b2_k, *pe_v, *w1_v, *b1_v, *w2_v, *b2_v;
    const float *mu, *w0, *w2, *a0, *a2, *g2, *k_k, *k_a, *r_k, *ln_w, *ln_b;
    const float *wpa, *wpb, *wout, *g_ffn, *w_grp, *b_grp, *w_exp, *b_exp, *e_w1, *e_w3, *e_w2, *g_final;
    float* out;
    u16* hbuf; u16 *q, *kc, *vc, *ksl, *vslT, *kwn, *vwnT, *kcb, *vcT; float* nsag; u16* prw;
    u16* cdat; float* bon; u16 *w2T, *a2T, *g2T; u16 *oa, *ob; u16* merged; float* x1;
    int* tok_e; float* tok_gate; int* tokslot; int* list_tok; float* list_gate;
    int* counts; int* offs; int* cursor; int* blk_e; int* blk_r0; int* nblk;
    u16* hid; u16* ybuf; unsigned* bar;
    u16 *winT, *wgT, *wpaT, *wpbT, *woutT, *ew1T, *ew3T, *ew2T;
    u16 *cw1Tk, *cw1Tv, *cw2Tk, *cw2Tv, *chid, *xact; float *cb1k, *cb1v;
};

typedef __bf16 bf16x2_t __attribute__((ext_vector_type(2)));
typedef float f32x2_t __attribute__((ext_vector_type(2)));
__device__ __forceinline__ unsigned pack2(float a, float b) {
    f32x2_t f = {a, b};
    return __builtin_bit_cast(unsigned, __builtin_convertvector(f, bf16x2_t));
}
__device__ __forceinline__ u16 f2bf(float f) { return (u16)(pack2(f, f) & 0xFFFFu); }
__device__ __forceinline__ float bf2f(u16 h) { return __uint_as_float(((unsigned)h) << 16); }
__device__ __forceinline__ float sigmoidf_(float x) { return __builtin_amdgcn_rcpf(1.f + __expf(-x)); }
__device__ __forceinline__ int get_tid() { int t = threadIdx.x; asm volatile("" : "+v"(t)); return t; }
__device__ __forceinline__ uint2 pack4(const f32x4& v) { uint2 o; o.x = pack2(v[0], v[1]); o.y = pack2(v[2], v[3]); return o; }
__device__ __forceinline__ f32x4 unpack4(uint2 u) { return f32x4{__uint_as_float(u.x << 16), __uint_as_float(u.x & 0xFFFF0000u), __uint_as_float(u.y << 16), __uint_as_float(u.y & 0xFFFF0000u)}; }
#define LDS_BARRIER() do { asm volatile("s_waitcnt lgkmcnt(0)" ::: "memory"); __builtin_amdgcn_s_barrier(); asm volatile("" ::: "memory"); } while (0)
__device__ __forceinline__ int opaque(int x) { asm volatile("" : "+v"(x)); return x; }
template <int CTRL>
__device__ __forceinline__ float dppf(float x) { return __int_as_float(__builtin_amdgcn_update_dpp(0, __float_as_int(x), CTRL, 0xF, 0xF, true)); }
__device__ __forceinline__ float wave_sum(float v) {
    v += dppf<0xB1>(v);
    v += dppf<0x4E>(v);
    v += dppf<0x141>(v);
    v += dppf<0x140>(v);
    const int vi = __float_as_int(v);
    return (__int_as_float(__builtin_amdgcn_readlane(vi, 0)) + __int_as_float(__builtin_amdgcn_readlane(vi, 16)))
         + (__int_as_float(__builtin_amdgcn_readlane(vi, 32)) + __int_as_float(__builtin_amdgcn_readlane(vi, 48)));
}

__device__ __forceinline__ float xrow_sum(float v) {
    auto r = __builtin_amdgcn_permlane16_swap(__float_as_uint(v), __float_as_uint(v), false, false);
    v = __uint_as_float(r[0]) + __uint_as_float(r[1]);
    auto r2 = __builtin_amdgcn_permlane32_swap(__float_as_uint(v), __float_as_uint(v), false, false);
    return __uint_as_float(r2[0]) + __uint_as_float(r2[1]);
}
__device__ __forceinline__ float xrow_max(float v) {
    auto r = __builtin_amdgcn_permlane16_swap(__float_as_uint(v), __float_as_uint(v), false, false);
    v = fmaxf(__uint_as_float(r[0]), __uint_as_float(r[1]));
    auto r2 = __builtin_amdgcn_permlane32_swap(__float_as_uint(v), __float_as_uint(v), false, false);
    return fmaxf(__uint_as_float(r2[0]), __uint_as_float(r2[1]));
}
__constant__ double ROPE_FREQ[32] = {
    1.00000000000000000000e+00, 7.49894209332455874417e-01, 5.62341325190349072827e-01, 4.21696503428582225581e-01,
    3.16227766016837941176e-01, 2.37137370566165517349e-01, 1.77827941003892292526e-01, 1.33352143216332402753e-01,
    1.00000000000000005551e-01, 7.49894209332455791150e-02, 5.62341325190349114460e-02, 4.21696503428582239459e-02,
    3.16227766016837913421e-02, 2.37137370566165538166e-02, 1.77827941003892292526e-02, 1.33352143216332406223e-02,
    1.00000000000000002082e-02, 7.49894209332455791150e-03, 5.62341325190349097113e-03, 4.21696503428582291501e-03,
    3.16227766016837939442e-03, 2.37137370566165538166e-03, 1.77827941003892275179e-03, 1.33352143216332406223e-03,
    1.00000000000000002082e-03, 7.49894209332455856203e-04, 5.62341325190349097113e-04, 4.21696503428582237290e-04,
    3.16227766016837939442e-04, 2.37137370566165538166e-04, 1.77827941003892269758e-04, 1.33352143216332395381e-04};

constexpr int G_ABYTES = 256 * 64 * 2, G_BBYTES = 128 * 64 * 2, G_TILE = G_ABYTES + G_BBYTES;
#define LAS3 __attribute__((address_space(3)))
#define GAS1 __attribute__((address_space(1)))
__device__ __forceinline__ void glds16(const u16* g, char* l) {
    __builtin_amdgcn_global_load_lds((const GAS1 unsigned*)g, (LAS3 unsigned*)l, 16, 0, 0);
}
template <bool TR = false, class ARow>
__device__ __forceinline__ void gemm_core(int K, ARow arow, const u16* __restrict__ BT, int ldb, f32x4 (&acc)[4][4], u16* sm) {
    char* base = (char*)sm;
    const int tid = get_tid(), lane = tid & 63, wv = tid >> 6;
    const int wm = wv >> 1, wn = wv & 1, kr = lane & 15, qq = lane >> 4;
    const int lr = tid >> 3, lk = ((tid & 7) ^ ((lr >> 1) & 7)) * 8;
    const u16* ap0 = arow(lr) + lk; const u16* ap1 = arow(lr + 64) + lk;
    const u16* ap2 = arow(lr + 128) + lk; const u16* ap3 = arow(lr + 192) + lk;
    const u16* bp0 = BT + (size_t)lr * ldb + lk; const u16* bp1 = BT + (size_t)(lr + 64) * ldb + lk;
#pragma unroll
    for (int mt = 0; mt < 4; mt++)
#pragma unroll
        for (int nt = 0; nt < 4; nt++) acc[mt][nt] = f32x4{0.f, 0.f, 0.f, 0.f};
    const int nk = K >> 6;
#define G_ISSUE(t, b) { char* d = base + (b) * G_TILE + tid * 16; const int ko = (t) * 64; \
        glds16(ap0 + ko, d); glds16(ap1 + ko, d + 8192); glds16(ap2 + ko, d + 16384); glds16(ap3 + ko, d + 24576); \
        glds16(bp0 + ko, d + G_ABYTES); glds16(bp1 + ko, d + G_ABYTES + 8192); }
    const int sw = kr >> 1;
    const int po0 = ((0 * 4 + qq) ^ sw) * 16, po1 = ((1 * 4 + qq) ^ sw) * 16;
    const int aoff = (wm * 64 + kr) * 128, boff = G_ABYTES + (wn * 64 + kr) * 128;
#define G_READ(FA, FB, b) { const char* Ab = base + (b) * G_TILE + aoff; const char* Bb = base + (b) * G_TILE + boff; \
        _Pragma("unroll") for (int mt = 0; mt < 4; mt++) { FA[0][mt] = *(const bf16x8*)(Ab + mt * 2048 + po0); FA[1][mt] = *(const bf16x8*)(Ab + mt * 2048 + po1); } \
        _Pragma("unroll") for (int nt = 0; nt < 4; nt++) { FB[0][nt] = *(const bf16x8*)(Bb + nt * 2048 + po0); FB[1][nt] = *(const bf16x8*)(Bb + nt * 2048 + po1); } }
#define G_MMA(FA, FB) { __builtin_amdgcn_s_setprio(1); \
        _Pragma("unroll") for (int ks = 0; ks < 2; ks++) \
            _Pragma("unroll") for (int nt = 0; nt < 4; nt++) \
                _Pragma("unroll") for (int mt = 0; mt < 4; mt++) \
                    acc[mt][nt] = TR ? __builtin_amdgcn_mfma_f32_16x16x32_bf16(FA[ks][mt], FB[ks][nt], acc[mt][nt], 0, 0, 0) \
                                     : __builtin_amdgcn_mfma_f32_16x16x32_bf16(FB[ks][nt], FA[ks][mt], acc[mt][nt], 0, 0, 0); \
        __builtin_amdgcn_s_setprio(0); }
    bf16x8 fa0[2][4], fb0[2][4], fa1[2][4], fb1[2][4];
    G_ISSUE(0, 0)
    if (nk > 1) G_ISSUE(1, 1)
    if (nk > 2) G_ISSUE(2, 2)
    if (nk > 2) asm volatile("s_waitcnt vmcnt(12)" ::: "memory");
    else if (nk > 1) asm volatile("s_waitcnt vmcnt(6)" ::: "memory");
    else asm volatile("s_waitcnt vmcnt(0)" ::: "memory");
    __builtin_amdgcn_s_barrier();
    G_READ(fa0, fb0, 0)
    int bnext = 1, bfree = 0;
#define G_STEP(FAC, FBC, FAN, FBN, kt) { \
        if ((kt) + 1 < nk) { \
            if ((kt) + 2 < nk) asm volatile("s_waitcnt vmcnt(6) lgkmcnt(0)" ::: "memory"); else asm volatile("s_waitcnt vmcnt(0) lgkmcnt(0)" ::: "memory"); \
            __builtin_amdgcn_s_barrier();                   \
            if ((kt) + 3 < nk) G_ISSUE((kt) + 3, bfree) \
            G_READ(FAN, FBN, bnext) \
        } \
        G_MMA(FAC, FBC) \
        bfree = bnext; bnext = (bnext == 2) ? 0 : bnext + 1; }
    for (int kt = 0; kt < nk; kt += 2) {
        G_STEP(fa0, fb0, fa1, fb1, kt)
        G_STEP(fa1, fb1, fa0, fb0, kt + 1)
    }
    __builtin_amdgcn_s_barrier();
#undef G_READ
#undef G_MMA
#undef G_STEP
#undef G_ISSUE
}

__device__ __forceinline__ int xcd_item(int bid, int nb, int k, int nitems) {
    if (nb & 7) return bid + k * nb;
    const int per = nb >> 3, chunk = (nitems + 7) >> 3;
    const int j = k * per + (bid >> 3);
    return (j < chunk) ? (bid & 7) * chunk + j : nitems;
}
struct GUnit { int pm, pn; };
constexpr int G8_HTB = 128 * 64 * 2;
__device__ __forceinline__ int g8_lds_byte(int r, int c) { const int st = (r >> 4) * 2 + (c >> 5), rr = r & 15, cc = c & 31, ob = rr * 64 + cc * 2; return st * 1024 + (ob ^ (((ob >> 9) & 1) << 5)); }
__device__ __forceinline__ void g8_stage_rc(int b, int& R, int& C) { const int st = b / 1024, sb = b % 1024, swz = sb ^ (((sb >> 9) & 1) << 5); R = (st >> 1) * 16 + swz / 64; C = (st & 1) * 32 + (swz % 64) / 2; }
__host__ __device__ __forceinline__ int perm32(int rho) { const int n = rho >> 4, i = rho & 15; return 8 * (i >> 2) + 4 * n + (i & 3); }

template <class Epi, class Sched>
__device__ __forceinline__ void gemm256(char* smem, const char* Ab, int K, const Sched& S, const Epi& E) {
    LAS3 unsigned char* lds = (LAS3 unsigned char*)smem;
    const int tid = get_tid(), wid = __builtin_amdgcn_readfirstlane(tid >> 6), lane = tid & 63, wr = wid >> 2, wc = wid & 3, fr = lane & 15, fq = lane >> 4;
    const int nt = K >> 6;
    int sR[2], sC[2];
    unsigned voffB[2], voffA[2][2];
#pragma unroll
    for (int i = 0; i < 2; ++i) { g8_stage_rc(tid * 16 + i * 8192, sR[i], sC[i]); voffB[i] = (unsigned)(sR[i] * K + sC[i]) * 2u; }
    const size_t kstep = 128;
    const size_t hstep = (size_t)128 * K * 2;
    const unsigned ldsw = (unsigned)wid * 1024u;
    const int aoff = g8_lds_byte(wr * 64 + fr, fq * 8), boff = g8_lds_byte(wc * 32 + fr, fq * 8);
#define G8_SA(b, h) (((b) * 2 + (h)) * G8_HTB)
#define G8_SB(b, h) ((4 + (b) * 2 + (h)) * G8_HTB)
#define G8_STAGE2(bufoff, gbase, v0, v1) do { \
        __builtin_amdgcn_global_load_lds((const GAS1 unsigned*)((const char*)(gbase) + (v0)), (LAS3 unsigned*)(lds + (bufoff) + ldsw), 16, 0, 0); \
        __builtin_amdgcn_global_load_lds((const GAS1 unsigned*)((const char*)(gbase) + (v1)), (LAS3 unsigned*)(lds + (bufoff) + ldsw + 8192), 16, 0, 0); } while (0)
#define G8_STAGEB(bufoff, gbase) G8_STAGE2(bufoff, gbase, voffB[0], voffB[1])
#define G8_LDA(dst, b, h) do { _Pragma("unroll") for (int m = 0; m < 4; ++m) _Pragma("unroll") for (int k = 0; k < 2; ++k) dst[m][k] = *(const LAS3 bf16x8*)(lds + G8_SA(b, h) + aoff + m * 2048 + k * 1024); } while (0)
#define G8_LDB(dst, b, h) do { _Pragma("unroll") for (int n = 0; n < 2; ++n) _Pragma("unroll") for (int k = 0; k < 2; ++k) dst[n][k] = *(const LAS3 bf16x8*)(lds + G8_SB(b, h) + boff + n * 2048 + k * 1024); } while (0)
#define G8_MMA(ai, bj, At, Bt) do { __builtin_amdgcn_s_setprio(1); _Pragma("unroll") for (int m = 0; m < 4; ++m) _Pragma("unroll") for (int n = 0; n < 2; ++n) _Pragma("unroll") for (int k = 0; k < 2; ++k) \
        acc[ai][bj][m][n] = __builtin_amdgcn_mfma_f32_16x16x32_bf16(Bt[n][k], At[m][k], acc[ai][bj][m][n], 0, 0, 0); __builtin_amdgcn_s_setprio(0); } while (0)
#define G8_WAIT_V(n) asm volatile("s_waitcnt vmcnt(" #n ")" ::: "memory")
#define G8_WAIT_L(n) asm volatile("s_waitcnt lgkmcnt(" #n ")" ::: "memory")
#define G8_BAR __builtin_amdgcn_s_barrier()
#define G8_SCHED __builtin_amdgcn_sched_barrier(0)
    GUnit cur, nxt; int ui = 0;
    if (!S.next(0, cur)) return;
    f32x4 acc[2][2][4][2];
#pragma unroll
    for (int a = 0; a < 2; ++a)
#pragma unroll
        for (int b = 0; b < 2; ++b)
#pragma unroll
            for (int m = 0; m < 4; ++m)
#pragma unroll
                for (int n = 0; n < 2; ++n) acc[a][b][m][n] = (f32x4){0.f, 0.f, 0.f, 0.f};
    bf16x8 At[4][2], B0[2][2], B1[2][2];
#pragma unroll
    for (int h = 0; h < 2; ++h)
#pragma unroll
        for (int i = 0; i < 2; ++i) voffA[h][i] = S.a_off(cur, h, sR[i]) + (unsigned)sC[i] * 2u;
    const char* cB = S.b_ptr(cur);
    G8_STAGEB(G8_SB(0, 0), cB); G8_STAGE2(G8_SA(0, 0), Ab, voffA[0][0], voffA[0][1]); G8_STAGEB(G8_SB(0, 1), cB + hstep); G8_STAGE2(G8_SA(0, 1), Ab, voffA[1][0], voffA[1][1]);
    if (wr == 1) G8_BAR;
    G8_WAIT_V(4); G8_BAR;
    G8_STAGEB(G8_SB(1, 0), cB + kstep); G8_STAGE2(G8_SA(1, 0), Ab + kstep, voffA[0][0], voffA[0][1]); G8_STAGEB(G8_SB(1, 1), cB + hstep + kstep);
    G8_WAIT_V(6); G8_BAR;
    for (;;) {
        const bool has_next = S.next(ui + 1, nxt);
        const char* nB = has_next ? S.b_ptr(nxt) : cB;
        for (int t = 0; t < nt; t += 2) {
            const bool last = (t == nt - 2);
            const char* a1 = Ab + (size_t)(t + 1) * kstep;
            const unsigned va10 = voffA[1][0], va11 = voffA[1][1];
            if (last && has_next) {
#pragma unroll
                for (int h = 0; h < 2; ++h)
#pragma unroll
                    for (int i = 0; i < 2; ++i) voffA[h][i] = S.a_off(nxt, h, sR[i]) + (unsigned)sC[i] * 2u;
            }
            const char* a2 = last ? Ab : Ab + (size_t)(t + 2) * kstep; const char* b2 = last ? nB : cB + (size_t)(t + 2) * kstep;
            const char* a3 = a2 + kstep; const char* b3 = b2 + kstep;
            G8_LDB(B0, 0, 0); G8_SCHED; G8_LDA(At, 0, 0); G8_STAGE2(G8_SA(1, 1), a1, va10, va11);
            G8_WAIT_L(8); G8_BAR; G8_WAIT_L(0); G8_MMA(0, 0, At, B0); G8_BAR; G8_SCHED;
            G8_LDB(B1, 0, 1); G8_STAGEB(G8_SB(0, 0), b2);
            G8_BAR; G8_WAIT_L(0); G8_MMA(0, 1, At, B1); G8_BAR;
            G8_LDA(At, 0, 1); G8_STAGE2(G8_SA(0, 0), a2, voffA[0][0], voffA[0][1]);
            G8_BAR; G8_WAIT_L(0); G8_MMA(1, 0, At, B0); G8_BAR; G8_SCHED;
            G8_STAGEB(G8_SB(0, 1), b2 + hstep);
            G8_WAIT_V(6); G8_BAR; G8_MMA(1, 1, At, B1); G8_BAR;
            G8_LDB(B0, 1, 0); G8_SCHED; G8_LDA(At, 1, 0); G8_STAGE2(G8_SA(0, 1), a2, voffA[1][0], voffA[1][1]);
            G8_WAIT_L(8); G8_BAR; G8_WAIT_L(0); G8_MMA(0, 0, At, B0); G8_BAR; G8_SCHED;
            G8_LDB(B1, 1, 1); G8_STAGEB(G8_SB(1, 0), b3);
            G8_BAR; G8_WAIT_L(0); G8_MMA(0, 1, At, B1); G8_BAR;
            G8_LDA(At, 1, 1); G8_STAGE2(G8_SA(1, 0), a3, voffA[0][0], voffA[0][1]);
            G8_BAR; G8_WAIT_L(0); G8_MMA(1, 0, At, B0); G8_BAR; G8_SCHED;
            G8_STAGEB(G8_SB(1, 1), b3 + hstep);
            G8_WAIT_V(6); G8_BAR; G8_MMA(1, 1, At, B1); G8_BAR;
        }
        E(acc, cur, wr, wc, fr, fq);
        if (!has_next) break;
#pragma unroll
        for (int a = 0; a < 2; ++a)
#pragma unroll
            for (int b = 0; b < 2; ++b)
#pragma unroll
                for (int m = 0; m < 4; ++m)
#pragma unroll
                    for (int n = 0; n < 2; ++n) acc[a][b][m][n] = (f32x4){0.f, 0.f, 0.f, 0.f};
        cur = nxt; cB = nB; ++ui;
    }
    G8_WAIT_V(0);
    if (wr == 0) G8_BAR;
    G8_BAR;
#undef G8_SA
#undef G8_SB
#undef G8_STAGE2
#undef G8_STAGEB
#undef G8_LDA
#undef G8_LDB
#undef G8_MMA
#undef G8_WAIT_V
#undef G8_WAIT_L
#undef G8_BAR
#undef G8_SCHED
}
struct DenseSched {
    int nM, nN, nwg, G, c, K; const char* Bt;
    __device__ __forceinline__ void init(int M, int N, int K_, const void* Bt_, int G_, int c_) { nM = M >> 8; nN = N >> 8; nwg = nM * nN; G = G_; c = c_; K = K_; Bt = (const char*)Bt_; }
    __device__ __forceinline__ bool next(int i, GUnit& u) const {
        const int L = i * G + c; if (L >= nwg) return false;
        int wgid = L; { const int q = nwg >> 3, r = nwg & 7, xcd = wgid & 7, off = wgid >> 3; wgid = (xcd < r ? xcd * (q + 1) : r * (q + 1) + (xcd - r) * q) + off; }
        const int nig = 8 * nN, gid = wgid / nig, fm = gid * 8, gsz = (nM - fm) < 8 ? (nM - fm) : 8, w = wgid - gid * nig;
        u.pn = w / gsz; u.pm = fm + (w - u.pn * gsz); return true;
    }
    __device__ __forceinline__ unsigned a_off(const GUnit& u, int h, int R) const { return (unsigned)((u.pm * 256 + h * 128 + R) * K) * 2u; }
    __device__ __forceinline__ const char* b_ptr(const GUnit& u) const { return Bt + (size_t)u.pn * 256 * K * 2; }
};

template <class SRC>
__device__ __forceinline__ void convert_wT(const float* __restrict__ W, int K, int N, u16* __restrict__ WT, int rows, SRC src, int gtid, int gnt) {
    const int kch = K >> 3;
    const int total = rows * kch;
    for (int i = gtid; i < total; i += gnt) {
        const int kc = i / rows, j = i - kc * rows;
        const int sc = src(j);
        uint4 v = make_uint4(0u, 0u, 0u, 0u);
        if (sc >= 0) {
            const float* wp = W + (size_t)(kc * 8) * N + sc;
            v.x = pack2(wp[0], wp[(size_t)N]); v.y = pack2(wp[2 * (size_t)N], wp[3 * (size_t)N]);
            v.z = pack2(wp[4 * (size_t)N], wp[5 * (size_t)N]); v.w = pack2(wp[6 * (size_t)N], wp[7 * (size_t)N]);
        }
        *(uint4*)&WT[(size_t)j * K + kc * 8] = v;
    }
}

__device__ void ph_prologue(const P& p, int bid, int nb, char* smem) {
    const int tid = get_tid(), lane = tid & 63, wv = tid >> 6;
    if (bid >= 1 && bid <= 64) {
        const int j = tid & 255; const bool isv = tid >= 256;
        const float* pe = isv ? p.pe_v : p.pe_k; const float* w1 = isv ? p.w1_v : p.w1_k;
        const int kb = (bid - 1) * 32;
        float a0 = 0.f, a1 = 0.f;
#pragma unroll 4
        for (int k = kb; k < kb + 32; k += 2) { a0 += pe[k] * w1[(size_t)k * 256 + j]; a1 += pe[k + 1] * w1[(size_t)(k + 1) * 256 + j]; }
        atomicAdd(&(isv ? p.cb1v : p.cb1k)[j], a0 + a1);
    }
    if (bid == 0) {
        if (tid < 32) { p.counts[tid] = 0; p.cursor[tid] = 0; }
        for (int i = tid; i < 8 * 64; i += NT) {
            const int bg = i >> 6, d = i & 63;
            p.kcb[((size_t)bg * 512 + 511) * 64 + d] = 0;
            p.vcT[(((size_t)bg * 8 + 7) * 64 + d) * 64 + 63] = 0;
        }
    }
    {
        const int gtid = bid * NT + tid, gnt = nb * NT;
        convert_wT(p.w_in, D_, CIN, p.winT, 3328, [](int j) {
            const int t = j >> 8, s = j & 255;
            if (t < 5) {
                const int bj = s >> 7, wc = (s >> 5) & 3, n = (s >> 4) & 1, i = s & 15;
                const int dim = 32 * bj + 8 * (i >> 2) + 4 * n + (i & 3), hq = 4 * t + wc;
                int hb;
                if (hq < 8) hb = 64 * hq;
                else { const int k = (hq - 8) >> 1; hb = (k == 0 ? 512 : (k == 1 ? 640 : (k == 2 ? 768 : (k == 3 ? 1024 : (k == 4 ? 896 : 1152))))) + 64 * (hq & 1); }
                return hb + dim;
            }
            const int c = (s & ~31) + perm32(s & 31);
            if (t < 12) return 1304 + (t - 5) * 256 + c;
            return c < 24 ? 1280 + c : -1; }, gtid, gnt);
        convert_wT(p.w_in, D_, CIN, p.wgT, 2048, [](int j) { return 3096 + (j & ~31) + perm32(j & 31); }, gtid, gnt);
        convert_wT(p.wpa, 512, D_, p.wpaT, 1024, [](int j) { return (j & ~31) + perm32(j & 31); }, gtid, gnt);
        convert_wT(p.wpb, 512, D_, p.wpbT, 1024, [](int j) { return (j & ~31) + perm32(j & 31); }, gtid, gnt);
        convert_wT(p.wout, D_, D_, p.woutT, 1024, [](int j) { return j; }, gtid, gnt);
        convert_wT(p.w2, 64, 512, p.w2T, 512, [](int j) { return j; }, gtid, gnt);
        convert_wT(p.w1_k, 2048, 256, p.cw1Tk, 256, [](int j) { return j; }, gtid, gnt);
        convert_wT(p.w1_v, 2048, 256, p.cw1Tv, 256, [](int j) { return j; }, gtid, gnt);
        convert_wT(p.w2_k, 256, 64, p.cw2Tk, 128, [](int j) { return j < 64 ? j : -1; }, gtid, gnt);
        convert_wT(p.w2_v, 256, 64, p.cw2Tv, 128, [](int j) { return j < 64 ? j : -1; }, gtid, gnt);
        convert_wT(p.a2, 64, 512, p.a2T, 512, [](int j) { return j; }, gtid, gnt);
        convert_wT(p.g2, 128, 512, p.g2T, 512, [](int j) { return j; }, gtid, gnt);
    }
    for (int row = bid * NW + wv; row < NTOK; row += nb * NW) {
        const float* xr = p.x + (size_t)row * D_;
        float v[16];
        float ss = 0.f;
#pragma unroll
        for (int i = 0; i < 4; i++) {
            float4 t = *(const float4*)&xr[i * 256 + lane * 4];
            v[4 * i] = t.x; v[4 * i + 1] = t.y; v[4 * i + 2] = t.z; v[4 * i + 3] = t.w;
            ss += t.x * t.x + t.y * t.y + t.z * t.z + t.w * t.w;
        }
        ss = wave_sum(ss);
        const float rs = rsqrtf(ss * (1.f / D_) + 1e-6f);
#pragma unroll
        for (int i = 0; i < 4; i++) {
            const int c = i * 256 + lane * 4;
            float4 g = *(const float4*)&p.g_mix[c];
            uint2 o;
            o.x = pack2(v[4 * i] * rs * g.x, v[4 * i + 1] * rs * g.y);
            o.y = pack2(v[4 * i + 2] * rs * g.z, v[4 * i + 3] * rs * g.w);
            *(uint2*)&p.hbuf[(size_t)row * D_ + c] = o;
        }
    }
}

__device__ __forceinline__ uint4 pack8(const f32x4& a, const f32x4& b) { uint4 o; o.x = pack2(a[0], a[1]); o.y = pack2(a[2], a[3]); o.z = pack2(b[0], b[1]); o.w = pack2(b[2], b[3]); return o; }
struct EpiInproj {
    const P* pp;
    __device__ __forceinline__ void operator()(const f32x4 (&acc)[2][2][4][2], const GUnit& u, int, int, int, int) const {
        const int t2_ = get_tid(), wid_ = __builtin_amdgcn_readfirstlane(t2_ >> 6), wr = wid_ >> 2, wc = wid_ & 3, fr = t2_ & 15, fq = (t2_ >> 4) & 3;
        const P& p = *pp;
        const int pn = u.pn;
        const int rowb = u.pm * 256 + wr * 64;
        if (pn < 4) {
            const int hq = 4 * pn + wc;
            const bool rope = !(pn == 2 && wc >= 2);
            u16* dst; size_t rstride; int cofs;
            if (pn < 2) { dst = p.q; rstride = 512; cofs = hq * 64; }
            else { dst = (pn == 2) ? (wc < 2 ? p.kc : p.vc) : (wc < 2 ? p.ksl : p.kwn); rstride = 64; cofs = 0; }
            const int g = wc & 1;
#pragma unroll
            for (int ai = 0; ai < 2; ++ai)
#pragma unroll
                for (int m = 0; m < 4; ++m) {
                    const int row = rowb + ai * 128 + m * 16 + fr;
                    f32x4 o1[2], o2[2];
#pragma unroll
                    for (int n = 0; n < 2; ++n) { o1[n] = acc[ai][0][m][n]; o2[n] = acc[ai][1][m][n]; }
                    if (rope) {
                        const double posd = (double)p.pos[row];
#pragma unroll
                        for (int n = 0; n < 2; ++n)
#pragma unroll
                            for (int j = 0; j < 4; ++j) {
                                const double tr = posd * ROPE_FREQ[8 * fq + 4 * n + j] * 0.15915494309189535;
                                const float fr_ = (float)(tr - rint(tr));
                                const float cs = __builtin_amdgcn_cosf(fr_), sn = __builtin_amdgcn_sinf(fr_);
                                const float x1 = o1[n][j], x2 = o2[n][j];
                                o1[n][j] = x1 * cs - x2 * sn; o2[n][j] = x1 * sn + x2 * cs;
                            }
                    }
                    size_t ro;
                    if (pn < 2) {
#pragma unroll
                        for (int n = 0; n < 2; ++n)
#pragma unroll
                            for (int j = 0; j < 4; ++j) { o1[n][j] *= QSCALE; o2[n][j] *= QSCALE; }
                        ro = (size_t)row * 512 + cofs + 8 * fq;
                    } else {
                        const int bb = row >> 13, t = row & (S_ - 1);
                        ro = ((size_t)(bb * 2 + g) * S_ + t) * 64 + 8 * fq;
                    }
                    *(uint4*)&dst[ro] = pack8(o1[0], o1[1]);
                    *(uint4*)&dst[ro + 32] = pack8(o2[0], o2[1]);
                }
        } else if (pn == 4) {
            u16* dst = (wc < 2) ? p.vslT : p.vwnT;
            const int g = wc & 1;
#pragma unroll
            for (int ai = 0; ai < 2; ++ai) {
                const int r0 = rowb + ai * 128, bb = r0 >> 13, tb = r0 & (S_ - 1);
                u16* base = dst + ((size_t)(bb * 2 + g) * 128 + (tb >> 6)) * 4096;
#pragma unroll
                for (int m = 0; m < 4; ++m)
#pragma unroll
                    for (int bj = 0; bj < 2; ++bj)
#pragma unroll
                        for (int n = 0; n < 2; ++n)
#pragma unroll
                            for (int j = 0; j < 4; ++j)
                                base[(32 * bj + 8 * fq + 4 * n + j) * 64 + m * 16 + fr] = f2bf(acc[ai][bj][m][n][j]);
            }
        } else if (pn < 12) {
            const int cb = (pn - 5) * 256 + wc * 32 + 8 * fq;
#pragma unroll
            for (int ai = 0; ai < 2; ++ai)
#pragma unroll
                for (int m = 0; m < 4; ++m) {
                    const size_t ro = (size_t)(rowb + ai * 128 + m * 16 + fr) * CRW + cb;
#pragma unroll
                    for (int bj = 0; bj < 2; ++bj) *(uint4*)&p.prw[ro + bj * 128] = pack8(acc[ai][bj][m][0], acc[ai][bj][m][1]);
                }
        } else {
            if (wc == 0 && fq < 3) {
#pragma unroll
                for (int ai = 0; ai < 2; ++ai)
#pragma unroll
                    for (int m = 0; m < 4; ++m) {
                        const size_t ro = (size_t)(rowb + ai * 128 + m * 16 + fr) * 24 + 8 * fq;
#pragma unroll
                        for (int n = 0; n < 2; ++n) {
                            float4 o; o.x = sigmoidf_(acc[ai][0][m][n][0]); o.y = sigmoidf_(acc[ai][0][m][n][1]); o.z = sigmoidf_(acc[ai][0][m][n][2]); o.w = sigmoidf_(acc[ai][0][m][n][3]);
                            *(float4*)&p.nsag[ro + 4 * n] = o;
                        }
                    }
            }
        }
    }
};
__device__ void ph_inproj(const P& p, int bid, int nb, char* smem) {
    DenseSched S; S.init(NTOK, 3328, D_, p.winT, nb, bid);
    EpiInproj E{&p};
    gemm256(smem, (const char*)p.hbuf, D_, S, E);
}

__device__ __forceinline__ float gelu_tanh(float x) {
    const float c = 0.7978845608028654f;
    return 0.5f * x * (1.f + tanhf(c * (x + 0.044715f * x * x * x)));
}
__device__ void ph_compress(const P& p, int bid, int nb, char* smem) {
    u16* sm = (u16*)smem;
    const int tid = get_tid(), lane = tid & 63, wv = tid >> 6;
    const int wm = wv >> 1, wn = wv & 1;
    for (int it = bid; it < 32; it += nb) {
        const int rt = it & 1, g = (it >> 1) & 1, b = (it >> 2) & 3, kv = it >> 4;
        const int bg = b * 2 + g, i0 = rt * 256;
        const u16* src = (kv ? p.vc : p.kc) + (size_t)bg * S_ * 64;
        const u16* w1T = kv ? p.cw1Tv : p.cw1Tk;
        const u16* w2T = kv ? p.cw2Tv : p.cw2Tk;
        const float* cb1 = kv ? p.cb1v : p.cb1k;
        const float* b1 = kv ? p.b1_v : p.b1_k;
        const float* b2 = kv ? p.b2_v : p.b2_k;
        u16* hidp = p.chid + (size_t)it * 256 * 256;
        auto arow = [&](int r) { int i = i0 + r; if (i > 510) i = 510; return src + (size_t)i * 1024; };
#pragma unroll 1
        for (int ct = 0; ct < 2; ct++) {
            f32x4 acc[4][4];
            gemm_core<false>(2048, arow, w1T + (size_t)ct * 128 * 2048, 2048, acc, sm);
            const int le = get_tid() & 63;
#pragma unroll
            for (int mt = 0; mt < 4; mt++) {
                const int r = wm * 64 + mt * 16 + (le & 15);
#pragma unroll
                for (int nt = 0; nt < 4; nt++) {
                    const int col = ct * 128 + wn * 64 + nt * 16 + (le >> 4) * 4;
                    const float4 c1 = *(const float4*)&cb1[col], bb1 = *(const float4*)&b1[col];
                    f32x4 o;
                    o[0] = gelu_tanh(acc[mt][nt][0] + c1.x + bb1.x); o[1] = gelu_tanh(acc[mt][nt][1] + c1.y + bb1.y);
                    o[2] = gelu_tanh(acc[mt][nt][2] + c1.z + bb1.z); o[3] = gelu_tanh(acc[mt][nt][3] + c1.w + bb1.w);
                    *(uint2*)&hidp[r * 256 + col] = pack4(o);
                }
            }
        }
        __syncthreads();
        {
            f32x4 acc[4][4];
            gemm_core<true>(256, [&](int r) { return hidp + (size_t)r * 256; }, w2T, 256, acc, sm);
            if (wn == 0) {
#pragma unroll
                for (int mt = 0; mt < 4; mt++)
#pragma unroll
                    for (int nt = 0; nt < 4; nt++) {
                        const int d = nt * 16 + (lane & 15);
                        const int ib = i0 + wm * 64 + mt * 16 + (lane >> 4) * 4;
                        float o[4];
#pragma unroll
                        for (int j = 0; j < 4; j++) o[j] = (ib + j < NCMP) ? (acc[mt][nt][j] + b2[d]) : 0.f;
                        if (kv == 0) {
#pragma unroll
                            for (int j = 0; j < 4; j++) p.kcb[((size_t)bg * 512 + ib + j) * 64 + d] = f2bf(o[j]);
                        } else {
                            uint2 ov; ov.x = pack2(o[0], o[1]); ov.y = pack2(o[2], o[3]);
                            *(uint2*)&p.vcT[(((size_t)bg * 8 + (ib >> 6)) * 64 + d) * 64 + (ib & 63)] = ov;
                        }
                    }
            }
        }
        __syncthreads();
    }
}

constexpr int KSTR = 72;
struct Sub { f32x4 O[4]; float m, l; };
#define NEG_BIG (-1.0e30f)

__device__ __forceinline__ float xq_max(float v) {
    return xrow_max(v);
}
__device__ __forceinline__ float xq_sum(float v) {
    return xrow_sum(v);
}
template <bool MASK, bool IMP, bool PV>
__device__ __forceinline__ void nsa_visit(const u16* Ks, const u16* Vs, const bf16x8* qp, Sub& s, int lo, int hi, int lane, float* e, float* p3) {
    const int kr = lane & 15, qq = lane >> 4;
    f32x4 S[4];
    const bf16x8 qf0 = qp[0], qf1 = qp[64];
    bf16x8 kf[4][2];
#pragma unroll
    for (int kt = 0; kt < 4; kt++)
#pragma unroll
        for (int ks = 0; ks < 2; ks++) kf[kt][ks] = *(const bf16x8*)&Ks[(kt * 16 + kr) * KSTR + ks * 32 + qq * 8];
    __builtin_amdgcn_sched_barrier(0);
#pragma unroll
    for (int kt = 0; kt < 4; kt++) {
        S[kt] = __builtin_amdgcn_mfma_f32_16x16x32_bf16(kf[kt][0], qf0, f32x4{0.f, 0.f, 0.f, 0.f}, 0, 0, 0);
        S[kt] = __builtin_amdgcn_mfma_f32_16x16x32_bf16(kf[kt][1], qf1, S[kt], 0, 0, 0);
    }
    union VF { bf16x8 v; uint2 h[2]; };
    float mx = NEG_BIG;
#pragma unroll
    for (int kt = 0; kt < 4; kt++)
#pragma unroll
        for (int r = 0; r < 4; r++) {
            if (MASK) { const int o = kt * 16 + qq * 4 + r; if (o < lo || o > hi) S[kt][r] = -INFINITY; }
            mx = fmaxf(mx, S[kt][r]);
        }
    mx = xq_max(mx);
    const float mnew = fmaxf(s.m, mx);
    const float alpha = __builtin_amdgcn_exp2f(s.m - mnew);
    s.m = mnew;
    float psum = 0.f;
#pragma unroll
    for (int kt = 0; kt < 4; kt++) {
#pragma unroll
        for (int r = 0; r < 4; r++) { S[kt][r] = __builtin_amdgcn_exp2f(S[kt][r] - mnew); }
        const float ee = (S[kt][0] + S[kt][1]) + (S[kt][2] + S[kt][3]);
        psum += ee;
        if (IMP) { e[kt] = ee; p3[kt] = S[kt][3]; }
    }
    s.l = s.l * alpha + psum;
    if (PV) {
        if (!__all(alpha == 1.f)) {
#pragma unroll
            for (int dt = 0; dt < 4; dt++)
#pragma unroll
                for (int r = 0; r < 4; r++) s.O[dt][r] *= alpha;
        }
        VF vf[4][2];
#pragma unroll
        for (int dt = 0; dt < 4; dt++)
#pragma unroll
            for (int k2 = 0; k2 < 2; k2++) {
                vf[dt][k2].h[0] = *(const uint2*)&Vs[(dt * 16 + kr) * KSTR + k2 * 32 + qq * 4];
                vf[dt][k2].h[1] = *(const uint2*)&Vs[(dt * 16 + kr) * KSTR + k2 * 32 + 16 + qq * 4];
            }
        bf16x8 pb[2];
#pragma unroll
        for (int k2 = 0; k2 < 2; k2++) {
            union { bf16x8 v; unsigned u[4]; } t;
            t.u[0] = pack2(S[2 * k2][0], S[2 * k2][1]); t.u[1] = pack2(S[2 * k2][2], S[2 * k2][3]);
            t.u[2] = pack2(S[2 * k2 + 1][0], S[2 * k2 + 1][1]); t.u[3] = pack2(S[2 * k2 + 1][2], S[2 * k2 + 1][3]);
            pb[k2] = t.v;
        }
        __builtin_amdgcn_sched_barrier(0);
#pragma unroll
        for (int dt = 0; dt < 4; dt++)
#pragma unroll
            for (int k2 = 0; k2 < 2; k2++) s.O[dt] = __builtin_amdgcn_mfma_f32_16x16x32_bf16(vf[dt][k2].v, pb[k2], s.O[dt], 0, 0, 0);
    }
}
template <int MODE>
__device__ __forceinline__ void nsa_fold(Sub& s, float* ol, float gate) {
    const float lt = xq_sum(s.l);
    const float sc = (lt > 0.f) ? gate / lt : 0.f;
#pragma unroll
    for (int dt = 0; dt < 4; dt++)
#pragma unroll
        for (int r = 0; r < 4; r++) {
            float v = s.O[dt][r] * sc;
            if (MODE == 1) v += ol[(dt * 4 + r) * 64];
            ol[(dt * 4 + r) * 64] = v;
            s.O[dt][r] = 0.f;
        }
    s.m = NEG_BIG; s.l = 0.f;
}

#define NSA_TOK(u) const int t3_ = get_tid(); const size_t ntk_ = (size_t)b * S_ + t0 + 8 * (t3_ >> 6) + 4 * (u) + ((t3_ & 15) >> 2); const int hd_ = g * 4 + (t3_ & 3);
__device__ void ph_nsa(const P& p, int bid, int nb, char* smem) {
    u16* Kb = (u16*)smem;
    u16* Vb = Kb + 2 * 64 * KSTR;
    unsigned* selm = (unsigned*)(Vb + 2 * 64 * KSTR);
    int* blist = (int*)(selm + 256);
    int* nlistp = blist + 128;
    float* impl = (float*)(nlistp + 4);
    float* outl = impl;
    bf16x8* qsm = (bf16x8*)(outl + NW * 2 * 16 * 64);
    const int tid = get_tid(), lane = tid & 63, wv = tid >> 6;
    const int kr = lane & 15, qq = lane >> 4, ts = kr >> 2, hh = kr & 3;
#define SROW (get_tid() >> 3)
#define SCH (get_tid() & 7)
    float* myimp = impl + wv * (32 * 2 * 16);
    const int nitems = B_ * 2 * 128;
    for (int it = bid; it < nitems; it += nb) {
        const int tt = 127 - (it >> 3);
        const int bg = it & 7, b = bg >> 1, g = bg & 1;
        const int t0 = tt * 64, cur = tt;
        const int head = g * 4 + hh;
        Sub st[2];
        float* myout = outl + wv * (2 * 16 * 64) + lane;
        int tl[2]; size_t ntok[2];
#pragma unroll
        for (int u = 0; u < 2; u++) {
            tl[u] = 8 * wv + 4 * u + ts;
            ntok[u] = (size_t)b * S_ + t0 + tl[u];
#pragma unroll
            for (int ks = 0; ks < 2; ks++) qsm[((wv * 2 + u) * 2 + ks) * 64 + lane] = *(const bf16x8*)&p.q[ntok[u] * 512 + head * 64 + ks * 32 + qq * 8];
#pragma unroll
            for (int dt = 0; dt < 4; dt++) st[u].O[dt] = f32x4{0.f, 0.f, 0.f, 0.f};
            st[u].m = NEG_BIG; st[u].l = 0.f;
        }
        const u16* kcb = p.kcb + (size_t)bg * 512 * 64;
        const u16* vcT = p.vcT + (size_t)bg * 8 * 4096;
        int nv[2];
#pragma unroll
        for (int u = 0; u < 2; u++) { const int t = t0 + tl[u]; nv[u] = (t >= 31) ? min((t - 31) / 16 + 1, NCMP) : 0; }
        const int tmax = t0 + 63;
        const int nvmax = (tmax >= 31) ? min((tmax - 31) / 16 + 1, NCMP) : 0;
        const int nvb = (nvmax + 63) >> 6;
        __syncthreads();
        for (int kb = 0; kb < nvb; kb++) {
            const int sr_ = SROW, sc_ = SCH;
            *(uint4*)&Kb[sr_ * KSTR + sc_ * 8] = *(const uint4*)&kcb[((size_t)kb * 64 + sr_) * 64 + sc_ * 8];
            __syncthreads();
#pragma unroll
            for (int u = 0; u < 2; u++) nsa_visit<true, false, false>(Kb, Vb, qsm + (wv * 2 + u) * 128 + lane, st[u], 0, nv[u] - kb * 64 - 1, lane, nullptr, nullptr);
            __syncthreads();
        }
        float invl[2];
#pragma unroll
        for (int u = 0; u < 2; u++) { const float lt = xq_sum(st[u].l); invl[u] = (lt > 0.f) ? 1.f / lt : 0.f; st[u].l = 0.f; }
        float carry[2] = {0.f, 0.f};
        for (int kb = 0; kb < nvb; kb++) {
            const int sr_ = SROW, sc_ = SCH;
            *(uint4*)&Kb[sr_ * KSTR + sc_ * 8] = *(const uint4*)&kcb[((size_t)kb * 64 + sr_) * 64 + sc_ * 8];
            *(uint4*)&Vb[sr_ * KSTR + sc_ * 8] = *(const uint4*)&vcT[((size_t)kb * 64 + sr_) * 64 + sc_ * 8];
            __syncthreads();
#pragma unroll
            for (int u = 0; u < 2; u++) {
                float e[4], p3[4];
                nsa_visit<true, true, true>(Kb, Vb, qsm + (wv * 2 + u) * 128 + lane, st[u], 0, nv[u] - kb * 64 - 1, lane, e, p3);
#pragma unroll
                for (int kt = 0; kt < 4; kt++) {
                    float ev = e[kt] * invl[u], pv = p3[kt] * invl[u];
                    ev += dppf<0xB1>(ev); ev += dppf<0x4E>(ev);
                    pv += dppf<0xB1>(pv); pv += dppf<0x4E>(pv);
                    const float sh = __shfl(pv, (lane - 16) & 63, 64);
                    const float nbv = (qq == 0) ? carry[u] : sh;
                    carry[u] = sh;
                    myimp[((kb * 4 + kt) * 2 + u) * 16 + ts * 4 + qq] = ev + nbv;
                }
            }
            __syncthreads();
        }
#pragma unroll
        for (int u = 0; u < 2; u++) {
            float impv[32];
#pragma unroll
            for (int kk = 0; kk < 32; kk++) impv[kk] = (kk < nvb * 4) ? myimp[(kk * 2 + u) * 16 + ts * 4 + qq] : 0.f;
            unsigned cmask = 0u;
#pragma unroll
            for (int kk = 0; kk < 32; kk++) { const int j = 4 * kk + qq; if (j >= 1 && j <= cur - 2) cmask |= (1u << kk); }
            unsigned sel = 0u;
            const int ncand = max(0, cur - 2);
            const int nforced = (cur >= 2) ? 3 : (cur + 1);
            const int need = 16 - nforced;
            if (ncand <= need) sel = cmask;
            else {
                for (int rnd = 0; rnd < need; rnd++) {
                    float best = -1.f; int bk = 0;
#pragma unroll
                    for (int kk = 0; kk < 32; kk++) {
                        const float v = ((cmask >> kk) & 1u) ? impv[kk] : -1.f;
                        if (v > best) { best = v; bk = kk; }
                    }
                    int bj = (best >= 0.f) ? (4 * bk + qq) : 9999;
                    {
                        auto rv = __builtin_amdgcn_permlane16_swap(__float_as_uint(best), __float_as_uint(best), false, false);
                        auto rj = __builtin_amdgcn_permlane16_swap((unsigned)bj, (unsigned)bj, false, false);
                        float v0 = __uint_as_float(rv[0]), v1 = __uint_as_float(rv[1]); int j0 = (int)rj[0], j1 = (int)rj[1];
                        if (v1 > v0 || (v1 == v0 && j1 < j0)) { v0 = v1; j0 = j1; }
                        rv = __builtin_amdgcn_permlane32_swap(__float_as_uint(v0), __float_as_uint(v0), false, false);
                        rj = __builtin_amdgcn_permlane32_swap((unsigned)j0, (unsigned)j0, false, false);
                        best = __uint_as_float(rv[0]); bj = (int)rj[0];
                        const float v2 = __uint_as_float(rv[1]); const int j2 = (int)rj[1];
                        if (v2 > best || (v2 == best && j2 < bj)) { best = v2; bj = j2; }
                    }
                    if (bj < 512 && (bj & 3) == qq) { cmask &= ~(1u << (bj >> 2)); sel |= (1u << (bj >> 2)); }
                }
            }
            if (qq == 0) sel |= 1u;
            if ((cur & 3) == qq) sel |= (1u << (cur >> 2));
            if (cur >= 1 && ((cur - 1) & 3) == qq) sel |= (1u << ((cur - 1) >> 2));
            if (hh == 0) selm[tl[u] * 4 + qq] = sel;
        }
        __syncthreads();
#pragma unroll
        for (int u = 0; u < 2; u++) { NSA_TOK(u) nsa_fold<0>(st[u], myout + u * 1024, p.nsag[ntk_ * 24 + hd_ * 3 + 0]); }
        bool need_j = false; int lrank = 0;
        {
            const int t2 = get_tid();
            if (t2 < 128) {
                const int j = t2; unsigned any = 0u;
                for (int tk = 0; tk < 64; tk++) any |= (selm[tk * 4 + (j & 3)] >> (j >> 2)) & 1u;
                need_j = (any != 0u) && (j <= cur);
                const unsigned long long bal = __ballot(need_j);
                lrank = __popcll(bal & ((1ull << (t2 & 63)) - 1ull));
                if ((t2 & 63) == 0) nlistp[t2 >> 6] = __popcll(bal);
            }
            __syncthreads();
            if (t2 < 128 && need_j) blist[lrank + ((t2 >= 64) ? nlistp[0] : 0)] = t2;
            __syncthreads();
        }
        const int nlist = nlistp[0] + nlistp[1];
        const u16* ksl = p.ksl + (size_t)bg * S_ * 64;
        const u16* vslT = p.vslT + (size_t)bg * 128 * 4096;
        {
            const int sr_ = SROW, sc_ = SCH;
            uint4 kreg, vreg;
            {
                const int j = blist[0];
                kreg = *(const uint4*)&ksl[((size_t)j * 64 + sr_) * 64 + sc_ * 8];
                vreg = *(const uint4*)&vslT[((size_t)j * 64 + sr_) * 64 + sc_ * 8];
                *(uint4*)&Kb[sr_ * KSTR + sc_ * 8] = kreg; *(uint4*)&Vb[sr_ * KSTR + sc_ * 8] = vreg;
            }
            __syncthreads();
            for (int idx = 0; idx < nlist; idx++) {
                const int j = blist[idx];
                const int buf = idx & 1;
                if (idx + 1 < nlist) {
                    const int j2 = blist[idx + 1];
                    kreg = *(const uint4*)&ksl[((size_t)j2 * 64 + sr_) * 64 + sc_ * 8];
                    vreg = *(const uint4*)&vslT[((size_t)j2 * 64 + sr_) * 64 + sc_ * 8];
                }
                const u16* Ks = Kb + buf * 64 * KSTR; const u16* Vs = Vb + buf * 64 * KSTR;
#pragma unroll
                for (int u = 0; u < 2; u++) {
                    const unsigned w = selm[tl[u] * 4 + (j & 3)];
                    const bool sb = ((w >> (j >> 2)) & 1u) != 0u;
                    if (__any(sb)) {
                        const int hi = sb ? ((j == cur) ? tl[u] : 63) : -1;
                        if (__all(sb) && j != cur) nsa_visit<false, false, true>(Ks, Vs, qsm + (wv * 2 + u) * 128 + lane, st[u], 0, 63, lane, nullptr, nullptr);
                        else nsa_visit<true, false, true>(Ks, Vs, qsm + (wv * 2 + u) * 128 + lane, st[u], 0, hi, lane, nullptr, nullptr);
                    }
                }
                if (idx + 1 < nlist) {
                    *(uint4*)&Kb[(buf ^ 1) * 64 * KSTR + sr_ * KSTR + sc_ * 8] = kreg;
                    *(uint4*)&Vb[(buf ^ 1) * 64 * KSTR + sr_ * KSTR + sc_ * 8] = vreg;
                }
                __syncthreads();
            }
        }
#pragma unroll
        for (int u = 0; u < 2; u++) { NSA_TOK(u) nsa_fold<1>(st[u], myout + u * 1024, p.nsag[ntk_ * 24 + hd_ * 3 + 1]); }
        const u16* kwn = p.kwn + (size_t)bg * S_ * 64;
        const u16* vwnT = p.vwnT + (size_t)bg * 128 * 4096;
        {
            const int jlo = max(0, cur - 8);
            const int sr_ = SROW, sc_ = SCH;
            uint4 kreg, vreg;
            kreg = *(const uint4*)&kwn[((size_t)jlo * 64 + sr_) * 64 + sc_ * 8];
            vreg = *(const uint4*)&vwnT[((size_t)jlo * 64 + sr_) * 64 + sc_ * 8];
            *(uint4*)&Kb[sr_ * KSTR + sc_ * 8] = kreg; *(uint4*)&Vb[sr_ * KSTR + sc_ * 8] = vreg;
            __syncthreads();
            for (int j = jlo; j <= cur; j++) {
                const int buf = (j - jlo) & 1;
                if (j < cur) {
                    kreg = *(const uint4*)&kwn[((size_t)(j + 1) * 64 + sr_) * 64 + sc_ * 8];
                    vreg = *(const uint4*)&vwnT[((size_t)(j + 1) * 64 + sr_) * 64 + sc_ * 8];
                }
                const u16* Ks = Kb + buf * 64 * KSTR; const u16* Vs = Vb + buf * 64 * KSTR;
#pragma unroll
                for (int u = 0; u < 2; u++) {
                    if (j == cur) nsa_visit<true, false, true>(Ks, Vs, qsm + (wv * 2 + u) * 128 + lane, st[u], 0, tl[u], lane, nullptr, nullptr);
                    else if (j == cur - 8) nsa_visit<true, false, true>(Ks, Vs, qsm + (wv * 2 + u) * 128 + lane, st[u], tl[u] + 1, 63, lane, nullptr, nullptr);
                    else nsa_visit<false, false, true>(Ks, Vs, qsm + (wv * 2 + u) * 128 + lane, st[u], 0, 63, lane, nullptr, nullptr);
                }
                if (j < cur) {
                    *(uint4*)&Kb[(buf ^ 1) * 64 * KSTR + sr_ * KSTR + sc_ * 8] = kreg;
                    *(uint4*)&Vb[(buf ^ 1) * 64 * KSTR + sr_ * KSTR + sc_ * 8] = vreg;
                }
                __syncthreads();
            }
        }
#pragma unroll
        for (int u = 0; u < 2; u++) {
            NSA_TOK(u)
            nsa_fold<1>(st[u], myout + u * 1024, p.nsag[ntk_ * 24 + hd_ * 3 + 2]);
            const float* ol = myout + u * 1024;
#pragma unroll
            for (int dt = 0; dt < 4; dt++) {
                uint2 o; o.x = pack2(ol[(dt * 4 + 0) * 64], ol[(dt * 4 + 1) * 64]); o.y = pack2(ol[(dt * 4 + 2) * 64], ol[(dt * 4 + 3) * 64]);
                *(uint2*)&p.oa[ntk_ * 512 + hd_ * 64 + dt * 16 + ((t3_ & 63) >> 4) * 4] = o;
            }
        }
    }
}

constexpr int RS = 72;
constexpr int RSLOT = 64 * RS;
__device__ __forceinline__ void mm64(const u16* A, int lda, const u16* Bz, int ldb, f32x4 (&acc)[2], int lane, int wv) {
    const int mt = wv >> 1, nt0 = (wv & 1) * 2, kr = lane & 15, qq = lane >> 4;
    bf16x8 a[2], b[2][2];
#pragma unroll
    for (int ks = 0; ks < 2; ks++) {
        a[ks] = *(const bf16x8*)&A[(mt * 16 + kr) * lda + ks * 32 + qq * 8];
#pragma unroll
        for (int i = 0; i < 2; i++) b[ks][i] = *(const bf16x8*)&Bz[((nt0 + i) * 16 + kr) * ldb + ks * 32 + qq * 8];
    }
#pragma unroll
    for (int ks = 0; ks < 2; ks++)
#pragma unroll
        for (int i = 0; i < 2; i++) acc[i] = __builtin_amdgcn_mfma_f32_16x16x32_bf16(a[ks], b[ks][i], acc[i], 0, 0, 0);
}
__device__ __forceinline__ void st_t(u16* dst, int ld, const f32x4& v, int mt, int nt, int lane) {
    uint2 o; o.x = pack2(v[0], v[1]); o.y = pack2(v[2], v[3]);
    *(uint2*)&dst[(nt * 16 + (lane & 15)) * ld + mt * 16 + (lane >> 4) * 4] = o;
}
__device__ __forceinline__ void st_n(u16* dst, int ld, const f32x4& v, int mt, int nt, int lane) {
#pragma unroll
    for (int r = 0; r < 4; r++) dst[(mt * 16 + (lane >> 4) * 4 + r) * ld + nt * 16 + (lane & 15)] = f2bf(v[r]);
}
#define ZACC(a) { a[0] = f32x4{0.f, 0.f, 0.f, 0.f}; a[1] = f32x4{0.f, 0.f, 0.f, 0.f}; }

__device__ void ph_rwkv_chunk(const P& p, int bid, int nb, char* smem) {
    u16* sl = (u16*)smem;
    float* tot = (float*)(sl + 14 * RSLOT);
    float* gl = tot + 512;
#define RW_IDX const int tid = get_tid(), lane = tid & 63, wv = tid >> 6, mt = wv >> 1, nt0 = (wv & 1) * 2, kr = lane & 15, qq = lane >> 4; (void)mt; (void)nt0; (void)kr; (void)qq; (void)lane;
    const int nitems = B_ * 128;
    for (int it0 = bid; it0 < nitems; it0 += nb) {
      const int c = it0 & 127, b = it0 >> 7;
      const size_t n0 = (size_t)b * S_ + c * 64;
      __syncthreads();
      {
          RW_IDX
          const int t = tid >> 3, part = tid & 7;
          const size_t n = n0 + t;
          const bool hasprev = (c * 64 + t) > 0;
          u16* dst = p.xact + n * 256 + part * 32;
#pragma unroll
          for (int j = 0; j < 4; j++) {
              const int col = 1536 + part * 32 + j * 8;
              const uint4 cu = *(const uint4*)&p.prw[n * CRW + col];
              uint4 pv = make_uint4(0u, 0u, 0u, 0u);
              if (hasprev) pv = *(const uint4*)&p.prw[(n - 1) * CRW + col];
              const unsigned cw[4] = {cu.x, cu.y, cu.z, cu.w}, pw[4] = {pv.x, pv.y, pv.z, pv.w};
              unsigned ow[4];
#pragma unroll
              for (int e2 = 0; e2 < 4; e2++) {
                  float x0 = __uint_as_float(cw[e2] << 16), x1 = __uint_as_float(cw[e2] & 0xFFFF0000u);
                  const float q0 = __uint_as_float(pw[e2] << 16), q1 = __uint_as_float(pw[e2] & 0xFFFF0000u);
                  x0 = x0 + (q0 - x0) * p.mu[col + 2 * e2]; x1 = x1 + (q1 - x1) * p.mu[col + 2 * e2 + 1];
                  if (part < 2) { x0 = tanhf(x0); x1 = tanhf(x1); }
                  else if (part >= 4) { x0 = sigmoidf_(x0); x1 = sigmoidf_(x1); }
                  ow[e2] = pack2(x0, x1);
              }
              *(uint4*)&dst[j * 8] = make_uint4(ow[0], ow[1], ow[2], ow[3]);
          }
      }
      __syncthreads();
      const u16* xa = p.xact + n0 * 256;
#pragma unroll 1
      for (int h = 0; h < 8; h++) {
        u16* cd = p.cdat + ((size_t)((b * 8 + h) * 128 + c)) * 4 * 4096;
        LDS_BARRIER();
        float* LW = (float*)(sl + 8 * RSLOT); float* LA = (float*)(sl + 10 * RSLOT);
        {
            RW_IDX
            bf16x8 xa_[8], wb[2][2], ab[2][2], gb[2][4];
#pragma unroll
            for (int k8 = 0; k8 < 8; k8++) xa_[k8] = *(const bf16x8*)&xa[(mt * 16 + kr) * 256 + k8 * 32 + qq * 8];
#pragma unroll
            for (int i = 0; i < 2; i++) {
                const int cc = (nt0 + i) * 16 + kr;
#pragma unroll
                for (int ks = 0; ks < 2; ks++) {
                    wb[i][ks] = *(const bf16x8*)&p.w2T[((size_t)h * 64 + cc) * 64 + ks * 32 + qq * 8];
                    ab[i][ks] = *(const bf16x8*)&p.a2T[((size_t)h * 64 + cc) * 64 + ks * 32 + qq * 8];
                }
#pragma unroll
                for (int ks = 0; ks < 4; ks++) gb[i][ks] = *(const bf16x8*)&p.g2T[((size_t)h * 64 + cc) * 128 + ks * 32 + qq * 8];
            }
            f32x4 aw[2], aa2[2], ag[2];
#pragma unroll
            for (int i = 0; i < 2; i++) {
                aw[i] = f32x4{0.f, 0.f, 0.f, 0.f}; aa2[i] = aw[i]; ag[i] = aw[i];
#pragma unroll
                for (int ks = 0; ks < 2; ks++) {
                    aw[i] = __builtin_amdgcn_mfma_f32_16x16x32_bf16(xa_[ks], wb[i][ks], aw[i], 0, 0, 0);
                    aa2[i] = __builtin_amdgcn_mfma_f32_16x16x32_bf16(xa_[2 + ks], ab[i][ks], aa2[i], 0, 0, 0);
                }
#pragma unroll
                for (int ks = 0; ks < 4; ks++) ag[i] = __builtin_amdgcn_mfma_f32_16x16x32_bf16(xa_[4 + ks], gb[i][ks], ag[i], 0, 0, 0);
            }
#pragma unroll
            for (int i = 0; i < 2; i++)
#pragma unroll
                for (int r = 0; r < 4; r++) {
                    const int t = mt * 16 + qq * 4 + r, cc = (nt0 + i) * 16 + kr;
                    const float wl = p.w0[h * 64 + cc] + aw[i][r];
                    const float z = -wl;
                    const float sp = fmaxf(z, 0.f) + log1pf(__expf(-fabsf(z)));
                    LW[t * 64 + cc] = -__expf(-sp - 0.5f);
                    LA[t * 64 + cc] = sigmoidf_(p.a0[h * 64 + cc] + aa2[i][r]);
                    p.ob[(n0 + t) * 512 + h * 64 + cc] = f2bf(ag[i][r]);
                }
        }
        LDS_BARRIER();
        {
            RW_IDX
            const int ch = h * 64 + lane;
            const float mur = p.mu[ch], muk = p.mu[512 + ch], muv = p.mu[1024 + ch];
            const float kkw = p.k_k[ch], kaw = p.k_a[ch], rkw = p.r_k[ch];
            float rr[8], k2[8], vv[8], kkn[8], aa[8], lg[8], cs[8];
            float run = 0.f;
#pragma unroll
            for (int i = 0; i < 8; i++) {
                const int t = wv * 8 + i; const size_t n = n0 + t;
                const u16* cr = p.prw + n * CRW;
                float r = bf2f(cr[ch]), k = bf2f(cr[512 + ch]), v = bf2f(cr[1024 + ch]);
                float pr = 0.f, pk = 0.f, pv = 0.f;
                if (c * 64 + t > 0) { const u16* pp = cr - CRW; pr = bf2f(pp[ch]); pk = bf2f(pp[512 + ch]); pv = bf2f(pp[1024 + ch]); }
                r = r + (pr - r) * mur; k = k + (pk - k) * muk; v = v + (pv - v) * muv;
                const float a = LA[t * 64 + lane];
                lg[i] = LW[t * 64 + lane];
                float kk = k * kkw;
                const float nrm = fmaxf(sqrtf(wave_sum(kk * kk)), 1e-12f);
                kkn[i] = kk / nrm;
                k2[i] = k * (1.f + (a - 1.f) * kaw);
                const float bon = wave_sum(r * k2[i] * rkw);
                if (lane == 0) p.bon[n * 8 + h] = bon;
                rr[i] = r; vv[i] = v; aa[i] = a;
                run += lg[i]; cs[i] = run;
            }
            tot[wv * 64 + lane] = run;
            LDS_BARRIER();
            float off = 0.f, cumL = 0.f;
#pragma unroll
            for (int w2 = 0; w2 < 8; w2++) { const float tv = tot[w2 * 64 + lane]; cumL += tv; if (w2 < wv) off += tv; }
            if (wv == 0) gl[lane] = __expf(cumL);
            unsigned pa[4], pb[4], pk4[4], pv4[4];
#pragma unroll
            for (int i = 0; i < 8; i += 2) {
                float at[2], bt[2], kt[2], rt[2];
#pragma unroll
                for (int e2 = 0; e2 < 2; e2++) {
                    const int ii = i + e2; const int t = wv * 8 + ii;
                    const float cm = off + cs[ii];
                    const float g = __expf(cm), gp = __expf(cm - lg[ii]), gi = __expf(-cm);
                    at[e2] = -kkn[ii] * gp; bt[e2] = kkn[ii] * aa[ii] * gi; kt[e2] = k2[ii] * gi; rt[e2] = rr[ii] * g;
                    sl[0 * RSLOT + t * RS + lane] = f2bf(at[e2]);
                    sl[1 * RSLOT + t * RS + lane] = f2bf(bt[e2]);
                    sl[2 * RSLOT + t * RS + lane] = f2bf(kt[e2]);
                    sl[3 * RSLOT + t * RS + lane] = f2bf(rt[e2]);
                }
                pa[i >> 1] = pack2(at[0], at[1]); pb[i >> 1] = pack2(bt[0], bt[1]);
                pk4[i >> 1] = pack2(kt[0], kt[1]); pv4[i >> 1] = pack2(vv[i], vv[i + 1]);
            }
            *(uint4*)&sl[4 * RSLOT + lane * RS + wv * 8] = make_uint4(pa[0], pa[1], pa[2], pa[3]);
            *(uint4*)&sl[5 * RSLOT + lane * RS + wv * 8] = make_uint4(pb[0], pb[1], pb[2], pb[3]);
            *(uint4*)&sl[6 * RSLOT + lane * RS + wv * 8] = make_uint4(pk4[0], pk4[1], pk4[2], pk4[3]);
            *(uint4*)&sl[7 * RSLOT + lane * RS + wv * 8] = make_uint4(pv4[0], pv4[1], pv4[2], pv4[3]);
        }
        LDS_BARRIER();
        {
            RW_IDX
            f32x4 acc[2];
            ZACC(acc); mm64(sl + 1 * RSLOT, RS, sl + 0 * RSLOT, RS, acc, lane, wv);
#pragma unroll
            for (int i = 0; i < 2; i++) {
                f32x4 pm;
#pragma unroll
                for (int r = 0; r < 4; r++) {
                    const int m = mt * 16 + qq * 4 + r, n = (nt0 + i) * 16 + kr;
                    if (!(m < n)) acc[i][r] = 0.f;
                    pm[r] = acc[i][r] + ((m == n) ? 1.f : 0.f);
                }
                st_t(sl + 8 * RSLOT, RS, acc[i], mt, nt0 + i, lane);
                st_n(sl + 9 * RSLOT, RS, acc[i], mt, nt0 + i, lane);
                st_t(sl + 13 * RSLOT, RS, pm, mt, nt0 + i, lane);
            }
            ZACC(acc); mm64(sl + 0 * RSLOT, RS, sl + 2 * RSLOT, RS, acc, lane, wv);
#pragma unroll
            for (int i = 0; i < 2; i++) {
#pragma unroll
                for (int r = 0; r < 4; r++) { const int m = mt * 16 + qq * 4 + r, n = (nt0 + i) * 16 + kr; if (!(m > n)) acc[i][r] = 0.f; }
                st_t(sl + 10 * RSLOT, RS, acc[i], mt, nt0 + i, lane);
            }
            ZACC(acc); mm64(sl + 1 * RSLOT, RS, sl + 3 * RSLOT, RS, acc, lane, wv);
#pragma unroll
            for (int i = 0; i < 2; i++) {
#pragma unroll
                for (int r = 0; r < 4; r++) { const int m = mt * 16 + qq * 4 + r, n = (nt0 + i) * 16 + kr; if (m > n) acc[i][r] = 0.f; }
                st_t(sl + 11 * RSLOT, RS, acc[i], mt, nt0 + i, lane);
            }
            ZACC(acc); mm64(sl + 2 * RSLOT, RS, sl + 3 * RSLOT, RS, acc, lane, wv);
#pragma unroll
            for (int i = 0; i < 2; i++) {
#pragma unroll
                for (int r = 0; r < 4; r++) { const int m = mt * 16 + qq * 4 + r, n = (nt0 + i) * 16 + kr; if (m > n) acc[i][r] = 0.f; }
                st_t(sl + 12 * RSLOT, RS, acc[i], mt, nt0 + i, lane);
            }
        }
        LDS_BARRIER();
        u16* X = sl + 8 * RSLOT; u16* XT = sl + 9 * RSLOT; u16* X2 = sl + 0 * RSLOT; u16* X2T = sl + 1 * RSLOT;
        u16* Pc = sl + 13 * RSLOT; u16* Pn = sl + 2 * RSLOT;
#pragma unroll 1
        for (int j = 1; j <= 6; j++) {
            RW_IDX
            f32x4 acc[2];
            if (j <= 5) {
                ZACC(acc); mm64(X, RS, XT, RS, acc, lane, wv);
#pragma unroll
                for (int i = 0; i < 2; i++) { st_t(X2T, RS, acc[i], mt, nt0 + i, lane); st_n(X2, RS, acc[i], mt, nt0 + i, lane); }
            }
            if (j >= 2) {
                ZACC(acc); mm64(XT, RS, Pc, RS, acc, lane, wv);
#pragma unroll
                for (int i = 0; i < 2; i++) {
                    const uint2 pv = *(const uint2*)&Pc[((nt0 + i) * 16 + kr) * RS + mt * 16 + qq * 4];
                    acc[i][0] += __uint_as_float(pv.x << 16); acc[i][1] += __uint_as_float(pv.x & 0xFFFF0000u);
                    acc[i][2] += __uint_as_float(pv.y << 16); acc[i][3] += __uint_as_float(pv.y & 0xFFFF0000u);
                    st_t(Pn, RS, acc[i], mt, nt0 + i, lane);
                }
            }
            LDS_BARRIER();
            if (j >= 2) { u16* tp = Pc; Pc = Pn; Pn = tp; }
            if (j <= 5) { u16* tx = X; X = X2; X2 = tx; tx = XT; XT = X2T; X2T = tx; }
        }
        u16* TT = Pc;
        {
            RW_IDX
            f32x4 acc[2];
            ZACC(acc); mm64(TT, RS, sl + 4 * RSLOT, RS, acc, lane, wv);
#pragma unroll
            for (int i = 0; i < 2; i++) st_t(sl + 0 * RSLOT, RS, acc[i], mt, nt0 + i, lane);
            ZACC(acc); mm64(sl + 10 * RSLOT, RS, TT, RS, acc, lane, wv);
#pragma unroll
            for (int i = 0; i < 2; i++) st_t(sl + 8 * RSLOT, RS, acc[i], mt, nt0 + i, lane);
        }
        LDS_BARRIER();
        {
            RW_IDX
            f32x4 acc[2];
            ZACC(acc); mm64(sl + 8 * RSLOT, RS, sl + 7 * RSLOT, RS, acc, lane, wv);
#pragma unroll
            for (int i = 0; i < 2; i++) st_t(sl + 9 * RSLOT, RS, acc[i], mt, nt0 + i, lane);
            ZACC(acc); mm64(sl + 0 * RSLOT, RS, sl + 5 * RSLOT, RS, acc, lane, wv);
#pragma unroll
            for (int i = 0; i < 2; i++) {
                const int n = (nt0 + i) * 16 + kr; const float gn = gl[n];
#pragma unroll
                for (int r = 0; r < 4; r++) { const int m = mt * 16 + qq * 4 + r; acc[i][r] = acc[i][r] * gn + ((m == n) ? gn : 0.f); }
                st_t(cd, 64, acc[i], mt, nt0 + i, lane);
            }
            ZACC(acc); mm64(sl + 0 * RSLOT, RS, sl + 11 * RSLOT, RS, acc, lane, wv);
#pragma unroll
            for (int i = 0; i < 2; i++) {
                const uint2 rv = *(const uint2*)&sl[3 * RSLOT + ((nt0 + i) * 16 + kr) * RS + mt * 16 + qq * 4];
                acc[i][0] += __uint_as_float(rv.x << 16); acc[i][1] += __uint_as_float(rv.x & 0xFFFF0000u);
                acc[i][2] += __uint_as_float(rv.y << 16); acc[i][3] += __uint_as_float(rv.y & 0xFFFF0000u);
                st_t(cd + 2 * 4096, 64, acc[i], mt, nt0 + i, lane);
            }
        }
        LDS_BARRIER();
        {
            RW_IDX
            f32x4 acc[2];
            ZACC(acc);
            mm64(sl + 5 * RSLOT, RS, sl + 9 * RSLOT, RS, acc, lane, wv);
            mm64(sl + 6 * RSLOT, RS, sl + 7 * RSLOT, RS, acc, lane, wv);
#pragma unroll
            for (int i = 0; i < 2; i++) {
#pragma unroll
                for (int r = 0; r < 4; r++) acc[i][r] *= gl[mt * 16 + qq * 4 + r];
                st_t(cd + 1 * 4096, 64, acc[i], mt, nt0 + i, lane);
            }
            ZACC(acc);
            mm64(sl + 9 * RSLOT, RS, sl + 11 * RSLOT, RS, acc, lane, wv);
            mm64(sl + 7 * RSLOT, RS, sl + 12 * RSLOT, RS, acc, lane, wv);
#pragma unroll
            for (int i = 0; i < 2; i++) st_t(cd + 3 * 4096, 64, acc[i], mt, nt0 + i, lane);
        }
      }
    }
}

__device__ void ph_rwkv_seq(const P& p, int bid, int nb, char* smem) {
    u16* SL = (u16*)smem;
    const int tid = get_tid(), lane = tid & 63, wv = __builtin_amdgcn_readfirstlane(tid >> 6);
    const int kr = lane & 15, qq = lane >> 4, chn = wv >> 2, vt = wv & 3;
    for (int pair = bid; pair < B_ * 4; pair += nb) {
        const int bh = pair * 2 + chn;
        u16* mySL = SL + chn * RSLOT;
        __syncthreads();
#pragma unroll
        for (int ks = 0; ks < 2; ks++) *(uint4*)&mySL[(vt * 16 + kr) * RS + ks * 32 + qq * 8] = make_uint4(0u, 0u, 0u, 0u);
        u16* cbase = p.cdat + (size_t)bh * 128 * 4 * 4096;
        bf16x8 GA0[4][2], GA1[4][2], GA2[4][2], GA3[4][2]; uint2 H0[4], H1[4], H2[4], H3[4];
#define SEQ_LD(GAx, Hx, c) { const u16* cd_ = cbase + (size_t)(c) * 4 * 4096; \
            _Pragma("unroll") for (int m4 = 0; m4 < 4; m4++) { \
                _Pragma("unroll") for (int ks = 0; ks < 2; ks++) GAx[m4][ks] = *(const bf16x8*)&cd_[(m4 * 16 + kr) * 64 + ks * 32 + qq * 8]; \
                Hx[m4] = *(const uint2*)&cd_[1 * 4096 + (vt * 16 + kr) * 64 + m4 * 16 + qq * 4]; } }
#define SEQ_STEP(GAx, Hx, c) { \
            bf16x8 Z0[2]; \
            _Pragma("unroll") for (int ks = 0; ks < 2; ks++) Z0[ks] = *(const bf16x8*)&mySL[(vt * 16 + kr) * RS + ks * 32 + qq * 8]; \
            f32x4 zs[4]; \
            _Pragma("unroll") for (int m4 = 0; m4 < 4; m4++) { \
                zs[m4] = unpack4(Hx[m4]); \
                _Pragma("unroll") for (int ks = 0; ks < 2; ks++) zs[m4] = __builtin_amdgcn_mfma_f32_16x16x32_bf16(GAx[m4][ks], Z0[ks], zs[m4], 0, 0, 0); } \
            u16* sn_ = cbase + (size_t)(c) * 4 * 4096 + 1 * 4096 + (vt * 16 + kr) * 64 + qq * 4; \
            _Pragma("unroll") for (int m4 = 0; m4 < 4; m4++) { \
                const uint2 pk_ = pack4(zs[m4]); \
                *(uint2*)&mySL[(vt * 16 + kr) * RS + m4 * 16 + qq * 4] = pk_; \
                *(uint2*)&sn_[m4 * 16] = pk_; } \
            if ((c) + 4 < 128) SEQ_LD(GAx, Hx, (c) + 4) }
        SEQ_LD(GA0, H0, 0) SEQ_LD(GA1, H1, 1) SEQ_LD(GA2, H2, 2) SEQ_LD(GA3, H3, 3)
#pragma unroll 1
        for (int c = 0; c < 128; c += 4) {
            SEQ_STEP(GA0, H0, c)
            SEQ_STEP(GA1, H1, c + 1)
            SEQ_STEP(GA2, H2, c + 2)
            SEQ_STEP(GA3, H3, c + 3)
        }
#undef SEQ_LD
#undef SEQ_STEP
    }
}

__device__ void ph_rwkv_out(const P& p, int bid, int nb, char* smem) {
    const int tid = get_tid(), lane = tid & 63, wv = tid >> 6;
    const int kr = lane & 15, qq = lane >> 4;
    for (int it = bid * NW + wv; it < B_ * 8 * 128; it += nb * NW) {
        const int c = it & 127, bh = it >> 7, b = bh >> 3, h = bh & 7;
        const u16* cd = p.cdat + ((size_t)bh * 128 + c) * 4 * 4096;
        f32x4 ys[4][4];
#pragma unroll
        for (int mt = 0; mt < 4; mt++)
#pragma unroll
            for (int nt = 0; nt < 4; nt++) ys[mt][nt] = unpack4(*(const uint2*)&cd[3 * 4096 + (nt * 16 + kr) * 64 + mt * 16 + qq * 4]);
        if (c > 0) {
            const u16* s0 = cd - 4 * 4096 + 1 * 4096;
#pragma unroll
            for (int ks = 0; ks < 2; ks++) {
                bf16x8 af[4], bq[4];
#pragma unroll
                for (int mt = 0; mt < 4; mt++) af[mt] = *(const bf16x8*)&s0[(mt * 16 + kr) * 64 + ks * 32 + qq * 8];
#pragma unroll
                for (int nt = 0; nt < 4; nt++) bq[nt] = *(const bf16x8*)&cd[2 * 4096 + (nt * 16 + kr) * 64 + ks * 32 + qq * 8];
#pragma unroll
                for (int mt = 0; mt < 4; mt++)
#pragma unroll
                    for (int nt = 0; nt < 4; nt++) ys[mt][nt] = __builtin_amdgcn_mfma_f32_16x16x32_bf16(af[mt], bq[nt], ys[mt][nt], 0, 0, 0);
            }
        }
#pragma unroll
        for (int nt = 0; nt < 4; nt++) {
            float s1 = 0.f, s2 = 0.f;
#pragma unroll
            for (int mt = 0; mt < 4; mt++)
#pragma unroll
                for (int r = 0; r < 4; r++) { s1 += ys[mt][nt][r]; s2 += ys[mt][nt][r] * ys[mt][nt][r]; }
            s1 = xrow_sum(s1); s2 = xrow_sum(s2);
            const float mean = s1 * (1.f / 64.f);
            const float var = fmaxf(s2 * (1.f / 64.f) - mean * mean, 0.f);
            const float rstd = rsqrtf(var + 64e-5f);
            const int t = nt * 16 + kr;
            const size_t n = (size_t)b * S_ + c * 64 + t;
            const float bon = p.bon[n * 8 + h];
#pragma unroll
            for (int mt = 0; mt < 4; mt++) {
                const int vch = h * 64 + mt * 16 + qq * 4;
                const f32x4 vcf = unpack4(*(const uint2*)&p.prw[n * CRW + 1024 + vch]);
                const f32x4 vpf = (c * 64 + t > 0) ? unpack4(*(const uint2*)&p.prw[(n - 1) * CRW + 1024 + vch]) : f32x4{0.f, 0.f, 0.f, 0.f};
                const f32x4 ggf = unpack4(*(const uint2*)&p.ob[n * 512 + vch]);
                const float4 lw = *(const float4*)&p.ln_w[vch], lb = *(const float4*)&p.ln_b[vch], mv = *(const float4*)&p.mu[1024 + vch];
                const float lwa[4] = {lw.x, lw.y, lw.z, lw.w}, lba[4] = {lb.x, lb.y, lb.z, lb.w}, mva[4] = {mv.x, mv.y, mv.z, mv.w};
                f32x4 o;
#pragma unroll
                for (int r = 0; r < 4; r++) {
                    const float vsh = vcf[r] + (vpf[r] - vcf[r]) * mva[r];
                    o[r] = ((ys[mt][nt][r] - mean) * rstd * lwa[r] + lba[r] + bon * vsh) * ggf[r];
                }
                *(uint2*)&p.ob[n * 512 + vch] = pack4(o);
            }
        }
    }
}

__device__ __forceinline__ void unpack8(const uint4& u, f32x4& a, f32x4& b) {
    a = f32x4{__uint_as_float(u.x << 16), __uint_as_float(u.x & 0xFFFF0000u), __uint_as_float(u.y << 16), __uint_as_float(u.y & 0xFFFF0000u)};
    b = f32x4{__uint_as_float(u.z << 16), __uint_as_float(u.z & 0xFFFF0000u), __uint_as_float(u.w << 16), __uint_as_float(u.w & 0xFFFF0000u)};
}
struct EpiMerge {
    u16* merged; u16* tmp2; int pass;
    __device__ __forceinline__ void operator()(const f32x4 (&acc)[2][2][4][2], const GUnit& u, int, int, int, int) const {
        const int t2_ = get_tid(), wid_ = __builtin_amdgcn_readfirstlane(t2_ >> 6), wr = wid_ >> 2, wc = wid_ & 3, fr = t2_ & 15, fq = (t2_ >> 4) & 3;
        const int row0 = u.pm * 256 + wr * 64 + fr, col0 = u.pn * 256 + wc * 32 + 8 * fq;
#pragma unroll
        for (int ai = 0; ai < 2; ++ai)
#pragma unroll
            for (int m = 0; m < 4; ++m) {
                const size_t off = (size_t)(row0 + ai * 128 + m * 16) * D_ + col0;
                uint4 m1[2], m2[2];
                if (pass == 1 || pass == 3) {
#pragma unroll
                    for (int bj = 0; bj < 2; ++bj) { m1[bj] = *(const uint4*)&merged[off + bj * 128]; if (pass == 3) m2[bj] = *(const uint4*)&tmp2[off + bj * 128]; }
                }
#pragma unroll
                for (int bj = 0; bj < 2; ++bj) {
                    f32x4 v0 = acc[ai][bj][m][0], v1 = acc[ai][bj][m][1];
                    if (pass == 1) { f32x4 a0, a1; unpack8(m1[bj], a0, a1);
#pragma unroll
                        for (int r = 0; r < 4; r++) { v0[r] = a0[r] * sigmoidf_(v0[r]); v1[r] = a1[r] * sigmoidf_(v1[r]); } }
                    if (pass == 3) { f32x4 a0, a1, b0, b1; unpack8(m1[bj], a0, a1); unpack8(m2[bj], b0, b1);
#pragma unroll
                        for (int r = 0; r < 4; r++) { v0[r] = a0[r] + b0[r] * sigmoidf_(v0[r]); v1[r] = a1[r] + b1[r] * sigmoidf_(v1[r]); } }
                    *(uint4*)&((pass == 2) ? tmp2 : merged)[off + bj * 128] = pack8(v0, v1);
                }
                asm volatile("" ::: "memory");
            }
    }
};
__device__ void ph_merge(const P& p, int bid, int nb, char* smem) {
    u16* tmp2 = (u16*)p.x1;
#pragma unroll 1
    for (int pass = 0; pass < 4; ++pass) {
        const int K = (pass & 1) ? D_ : 512;
        const u16* A = (pass & 1) ? p.hbuf : (pass == 0 ? p.oa : p.ob);
        const u16* Bt = (pass == 0) ? p.wpaT : (pass == 1 ? p.wgT : (pass == 2 ? p.wpbT : p.wgT + (size_t)1024 * D_));
        DenseSched S; S.init(NTOK, D_, K, Bt, nb, bid);
        EpiMerge E{p.merged, tmp2, pass};
        gemm256(smem, (const char*)A, K, S, E);
    }
}

struct EpiOutproj {
    const float* x; float* x1;
    __device__ __forceinline__ void operator()(const f32x4 (&acc)[2][2][4][2], const GUnit& u, int, int, int, int) const {
        const int t2_ = get_tid(), wid_ = __builtin_amdgcn_readfirstlane(t2_ >> 6), wr = wid_ >> 2, wc = wid_ & 3, fr = t2_ & 15, fq = (t2_ >> 4) & 3;
        const int row0 = u.pm * 256 + wr * 64 + fr, col0 = u.pn * 256 + wc * 32 + 4 * fq;
#pragma unroll
        for (int ai = 0; ai < 2; ++ai)
#pragma unroll
            for (int m = 0; m < 4; ++m) {
                const size_t off = (size_t)(row0 + ai * 128 + m * 16) * D_ + col0;
                f32x4 xin[2][2];
#pragma unroll
                for (int bj = 0; bj < 2; ++bj)
#pragma unroll
                    for (int n = 0; n < 2; ++n) xin[bj][n] = *(const f32x4*)&x[off + bj * 128 + n * 16];
#pragma unroll
                for (int bj = 0; bj < 2; ++bj)
#pragma unroll
                    for (int n = 0; n < 2; ++n) *(f32x4*)&x1[off + bj * 128 + n * 16] = xin[bj][n] + acc[ai][bj][m][n];
                asm volatile("" ::: "memory");
            }
    }
};
__device__ void ph_outproj(const P& p, int bid, int nb, char* smem) {
    DenseSched S; S.init(NTOK, D_, D_, p.woutT, nb, bid);
    EpiOutproj E{p.x, p.x1};
    gemm256(smem, (const char*)p.merged, D_, S, E);
}

__device__ __forceinline__ float red8f(float x) {
    x += dppf<0xB1>(x);
    x += dppf<0x4E>(x);
    x += dppf<0x141>(x);
    return x;
}
__device__ void ph_route(const P& p, int bid, int nb, char* smem) {
    float* wr = (float*)smem;
    const int tid = get_tid(), lane = tid & 63, wv = tid >> 6;
    {
        const int gtid = bid * NT + tid, gnt = nb * NT;
        const int per_e = 256 * 128 + 256 * 128 + 1024 * 32;
        for (int i = gtid; i < NEXP * per_e; i += gnt) {
            const int e = i / per_e; int r = i - e * per_e;
            const float* W; u16* WT; int K, N, rows;
            if (r < 256 * 128) { W = p.e_w1 + (size_t)e * D_ * 256; WT = p.ew1T + (size_t)e * 256 * D_; K = D_; N = 256; rows = 256; }
            else if (r < 2 * 256 * 128) { r -= 256 * 128; W = p.e_w3 + (size_t)e * D_ * 256; WT = p.ew3T + (size_t)e * 256 * D_; K = D_; N = 256; rows = 256; }
            else { r -= 2 * 256 * 128; W = p.e_w2 + (size_t)e * 256 * D_; WT = p.ew2T + (size_t)e * D_ * 256; K = 256; N = D_; rows = 1024; }
            const int kc = r / rows, j = r - kc * rows;
            const float* wp = W + (size_t)(kc * 8) * N + j;
            uint4 v;
            v.x = pack2(wp[0], wp[(size_t)N]); v.y = pack2(wp[2 * (size_t)N], wp[3 * (size_t)N]);
            v.z = pack2(wp[4 * (size_t)N], wp[5 * (size_t)N]); v.w = pack2(wp[6 * (size_t)N], wp[7 * (size_t)N]);
            *(uint4*)&WT[(size_t)j * K + kc * 8] = v;
        }
    }
    for (int i = tid; i < 1024 * 36; i += NT) {
        const int k = i / 36, j = i - k * 36;
        wr[i] = (j < 4) ? p.w_grp[k * 4 + j] : p.w_exp[k * 32 + (j - 4)];
    }
    __syncthreads();
    const int sub = lane & 7, tk = lane >> 3;
    for (int n0 = (bid * NW + wv) * 8; n0 < NTOK; n0 += nb * NW * 8) {
        const size_t n = (size_t)n0 + tk;
        const float* xr = p.x1 + n * D_;
        float acc[36]; float ss = 0.f;
#pragma unroll
        for (int j = 0; j < 36; j++) acc[j] = 0.f;
#pragma unroll 2
        for (int i = 0; i < 32; i++) {
            const int k0 = i * 32 + sub * 4;
            const float4 xv = *(const float4*)&xr[k0];
            const float4 gf = *(const float4*)&p.g_ffn[k0];
            ss += xv.x * xv.x + xv.y * xv.y + xv.z * xv.z + xv.w * xv.w;
            const float hv[4] = {xv.x * gf.x, xv.y * gf.y, xv.z * gf.z, xv.w * gf.w};
#pragma unroll
            for (int e2 = 0; e2 < 4; e2++) {
                const float* wrow = wr + (k0 + e2) * 36;
#pragma unroll
                for (int j4 = 0; j4 < 9; j4++) {
                    const float4 wv4 = *(const float4*)&wrow[j4 * 4];
                    acc[j4 * 4 + 0] += hv[e2] * wv4.x; acc[j4 * 4 + 1] += hv[e2] * wv4.y;
                    acc[j4 * 4 + 2] += hv[e2] * wv4.z; acc[j4 * 4 + 3] += hv[e2] * wv4.w;
                }
            }
        }
        ss = red8f(ss);
#pragma unroll
        for (int j = 0; j < 36; j++) acc[j] = red8f(acc[j]);
        const float rs = rsqrtf(ss * (1.f / D_) + 1e-6f);
#pragma unroll 4
        for (int i = 0; i < 32; i++) {
            const int k0 = i * 32 + sub * 4;
            const float4 xv = *(const float4*)&xr[k0];
            const float4 gf = *(const float4*)&p.g_ffn[k0];
            uint2 o; o.x = pack2(xv.x * rs * gf.x, xv.y * rs * gf.y); o.y = pack2(xv.z * rs * gf.z, xv.w * rs * gf.w);
            *(uint2*)&p.hbuf[n * D_ + k0] = o;
        }
        if (sub == 0) {
            float gl[4]; int gs = 0;
#pragma unroll
            for (int j = 0; j < 4; j++) gl[j] = acc[j] * rs + p.b_grp[j];
            float gm = gl[0];
#pragma unroll
            for (int j = 1; j < 4; j++) if (gl[j] > gm) { gm = gl[j]; gs = j; }
            float gsum = 0.f;
#pragma unroll
            for (int j = 0; j < 4; j++) gsum += __expf(gl[j] - gm);
            const float pg = 1.f / gsum;
            float el[8]; float em = -3.0e38f;
#pragma unroll
            for (int j = 0; j < 8; j++) {
                float a = (gs == 0) ? acc[4 + j] : ((gs == 1) ? acc[12 + j] : ((gs == 2) ? acc[20 + j] : acc[28 + j]));
                a = a * rs + p.b_exp[gs * 8 + j];
                el[j] = a; em = fmaxf(em, a);
            }
            int j0 = 0, j1 = -1; float v0 = -3.0e38f, v1 = -3.0e38f;
#pragma unroll
            for (int j = 0; j < 8; j++) { el[j] = __expf(el[j] - em); }
#pragma unroll
            for (int j = 0; j < 8; j++) { if (el[j] > v0) { v0 = el[j]; j0 = j; } }
#pragma unroll
            for (int j = 0; j < 8; j++) { if (j != j0 && el[j] > v1) { v1 = el[j]; j1 = j; } }
            const float den = v0 + v1;
            const int e0 = gs * 8 + j0, e1 = gs * 8 + j1;
            p.tok_e[n * 2] = e0; p.tok_e[n * 2 + 1] = e1;
            p.tok_gate[n * 2] = pg * v0 / den; p.tok_gate[n * 2 + 1] = pg * v1 / den;
            atomicAdd(&p.counts[e0], 1); atomicAdd(&p.counts[e1], 1);
        }
    }
}

__device__ void ph_scatter(const P& p, int bid, int nb, char* smem) {
    int* offl = (int*)smem;
    int* hist = offl + 64;
    int* gbase = hist + 32;
    const int tid = get_tid();
    if (tid == 0) {
        int off = 0;
        for (int e = 0; e < NEXP; e++) { offl[e] = off; off += p.counts[e]; }
        offl[NEXP] = off;
    }
    if (bid == 0 && tid == 64) {
        int off = 0, nb_ = 0;
        for (int e = 0; e < NEXP; e++) {
            const int c = p.counts[e];
            p.offs[e] = off;
            for (int r = 0; r < c; r += 256) { p.blk_e[nb_] = e; p.blk_r0[nb_] = off + r; nb_++; }
            off += c;
        }
        p.offs[NEXP] = off;
        *p.nblk = nb_;
    }
    for (int base = bid * NT; base < NTOK * 2; base += nb * NT) {
        __syncthreads();
        if (tid < 32) hist[tid] = 0;
        __syncthreads();
        const int i = base + tid;
        const int e = p.tok_e[i];
        const int rl = atomicAdd(&hist[e], 1);
        __syncthreads();
        if (tid < 32) gbase[tid] = atomicAdd(&p.cursor[tid], hist[tid]);
        __syncthreads();
        const int slot = offl[e] + gbase[e] + rl;
        p.list_tok[slot] = i >> 1; p.list_gate[slot] = p.tok_gate[i]; p.tokslot[i] = slot;
    }
}
template <int PASS>
__device__ __forceinline__ void moe1_sweep(const P& p, int bid, int nb, u16* sm) {
    const int tid = get_tid(), lane = tid & 63, wv = tid >> 6;
    const int wm = wv >> 1, wn = wv & 1;
    const int nitems = (*p.nblk) * 2;
    for (int kk = 0;; kk++) {
        const int it = xcd_item(bid, nb, kk, nitems);
        if (it >= nitems) break;
        const int bi = it >> 1, ct = it & 1;
        const int e = p.blk_e[bi], r0 = p.blk_r0[bi], c0 = ct * 128;
        const int rend = p.offs[e + 1];
        auto arow = [&](int r) { int sl = r0 + r; if (sl >= rend) sl = rend - 1; return p.hbuf + (size_t)p.list_tok[sl] * D_; };
        f32x4 acc[4][4];
        gemm_core(D_, arow, ((PASS == 0) ? p.ew1T : p.ew3T) + ((size_t)e * 256 + c0) * D_, D_, acc, sm);
        const int t2 = get_tid(), le = t2 & 63, wm2 = t2 >> 7, wn2 = (t2 >> 6) & 1;
#pragma unroll
        for (int mt = 0; mt < 4; mt++) {
            const int sl = r0 + wm2 * 64 + mt * 16 + (le & 15);
            if (sl < rend) {
                u16* hp = p.hid + (size_t)sl * 256 + c0 + wn2 * 64 + (le >> 4) * 4;
                uint2 m1[4];
                if (PASS == 1) {
#pragma unroll
                    for (int nt = 0; nt < 4; nt++) m1[nt] = *(const uint2*)&hp[nt * 16];
                }
#pragma unroll
                for (int nt = 0; nt < 4; nt++) {
                    f32x4 v = acc[mt][nt];
                    if (PASS == 0) {
#pragma unroll
                        for (int r = 0; r < 4; r++) v[r] = v[r] * sigmoidf_(v[r]);
                    } else {
                        const f32x4 a = unpack4(m1[nt]);
#pragma unroll
                        for (int r = 0; r < 4; r++) v[r] = a[r] * v[r];
                    }
                    *(uint2*)&hp[nt * 16] = pack4(v);
                }
            }
            asm volatile("" ::: "memory");
        }
    }
    __syncthreads();
}
__device__ void ph_moe1(const P& p, int bid, int nb, char* smem) {
    u16* sm = (u16*)smem;
    moe1_sweep<0>(p, bid, nb, sm);
    moe1_sweep<1>(p, bid, nb, sm);
}
__device__ void ph_moe2(const P& p, int bid, int nb, char* smem) {
    u16* sm = (u16*)smem;
    const int tid = get_tid(), lane = tid & 63, wv = tid >> 6;
    const int wm = wv >> 1, wn = wv & 1;
    const int nitems = (*p.nblk) * 8;
    for (int kk = 0;; kk++) {
        const int it = xcd_item(bid, nb, kk, nitems);
        if (it >= nitems) break;
        const int bi = it >> 3, ct = it & 7;
        const int e = p.blk_e[bi], r0 = p.blk_r0[bi], c0 = ct * 128;
        const int rend = p.offs[e + 1];
        f32x4 acc[4][4];
        auto arow = [&](int r) { int sl = r0 + r; if (sl >= rend) sl = rend - 1; return p.hid + (size_t)sl * 256; };
        gemm_core(256, arow, p.ew2T + ((size_t)e * D_ + c0) * 256, 256, acc, sm);
        const int t2 = get_tid(), le = t2 & 63, wm2 = t2 >> 7, wn2 = (t2 >> 6) & 1;
#pragma unroll
        for (int mt = 0; mt < 4; mt++) {
            const int sl = r0 + wm2 * 64 + mt * 16 + (le & 15);
            if (sl < rend) {
                const float gt = p.list_gate[sl];
                u16* yp = p.ybuf + (size_t)sl * D_ + c0 + wn2 * 64 + (le >> 4) * 4;
#pragma unroll
                for (int nt = 0; nt < 4; nt++) {
                    f32x4 v = acc[mt][nt];
#pragma unroll
                    for (int r = 0; r < 4; r++) v[r] *= gt;
                    *(uint2*)&yp[nt * 16] = pack4(v);
                }
            }
        }
    }
}
__device__ void ph_final(const P& p, int bid, int nb, char* smem) {
    const int tid = get_tid(), lane = tid & 63, wv = tid >> 6;
    for (int row = bid * NW + wv; row < NTOK; row += nb * NW) {
        const int s0 = p.tokslot[row * 2], s1 = p.tokslot[row * 2 + 1];
        float v[16]; float ss = 0.f;
#pragma unroll
        for (int i = 0; i < 4; i++) {
            const int c = i * 256 + lane * 4;
            const float4 t = *(const float4*)&p.x1[(size_t)row * D_ + c];
            const uint2 a = *(const uint2*)&p.ybuf[(size_t)s0 * D_ + c];
            const uint2 bq = *(const uint2*)&p.ybuf[(size_t)s1 * D_ + c];
            v[4 * i]     = t.x + __uint_as_float(a.x << 16) + __uint_as_float(bq.x << 16);
            v[4 * i + 1] = t.y + __uint_as_float(a.x & 0xFFFF0000u) + __uint_as_float(bq.x & 0xFFFF0000u);
            v[4 * i + 2] = t.z + __uint_as_float(a.y << 16) + __uint_as_float(bq.y << 16);
            v[4 * i + 3] = t.w + __uint_as_float(a.y & 0xFFFF0000u) + __uint_as_float(bq.y & 0xFFFF0000u);
            ss += v[4 * i] * v[4 * i] + v[4 * i + 1] * v[4 * i + 1] + v[4 * i + 2] * v[4 * i + 2] + v[4 * i + 3] * v[4 * i + 3];
        }
        ss = wave_sum(ss);
        const float rs = rsqrtf(ss * (1.f / D_) + 1e-6f);
#pragma unroll
        for (int i = 0; i < 4; i++) {
            const int c = i * 256 + lane * 4;
            const float4 g = *(const float4*)&p.g_final[c];
            float4 o; o.x = v[4 * i] * rs * g.x; o.y = v[4 * i + 1] * rs * g.y; o.z = v[4 * i + 2] * rs * g.z; o.w = v[4 * i + 3] * rs * g.w;
            *(float4*)&p.out[(size_t)row * D_ + c] = o;
        }
    }
}

#define XB_TMO      128
#define XB_XCNT(j)  (256  + 64 * (j))
#define XB_XSUB(j)  (1280 + 64 * (j))
#define XB_XGEN(j)  (2304 + 64 * (j))
#define XB_TOP      3328
#define XB_TOPGEN   3392
#define XCD_BAR_WORDS 3456
#define XB_SPIN_CAP (1u << 18)
#define LAS __attribute__((address_space(3)))

__device__ __forceinline__ unsigned xb_ld(unsigned* p)              { return __hip_atomic_load(p, __ATOMIC_RELAXED, __HIP_MEMORY_SCOPE_AGENT); }
__device__ __forceinline__ unsigned xb_add(unsigned* p, unsigned v) { return __hip_atomic_fetch_add(p, v, __ATOMIC_RELAXED, __HIP_MEMORY_SCOPE_AGENT); }
__device__ __forceinline__ unsigned xb_xcc_id() { return (unsigned)__builtin_amdgcn_s_getreg((3 << 11) | 20) & 0xFu; }
#define XB_SPIN(cond, bar) do { unsigned _sp = 0; while (cond) { __builtin_amdgcn_s_sleep(1); \
    if ((++_sp & 255u) == 0u) { if (xb_ld(&(bar)[XB_TMO])) break; if (_sp > XB_SPIN_CAP) { atomicAdd(&(bar)[XB_TMO], 1u); break; } } } } while (0)

struct XcdBarrier {
    unsigned* bar; unsigned x;
    volatile LAS unsigned* st;
};

__device__ __forceinline__ XcdBarrier xcd_barrier_post(unsigned* bar, volatile LAS unsigned* st) {
    XcdBarrier b; b.bar = bar; b.x = xb_xcc_id(); b.st = st;
    if (threadIdx.x == 0) (void)xb_add(&bar[XB_XCNT(b.x)], 1u);
    return b;
}
__device__ __forceinline__ void xcd_barrier_complete(unsigned* bar, unsigned x, unsigned& nloc, unsigned& nx) {
    const unsigned G = gridDim.x * gridDim.y * gridDim.z;
    unsigned sum, cnt, mine, sp = 0u;
    for (;;) {
        sum = 0u; cnt = 0u; mine = 0u;
#pragma unroll
        for (unsigned j = 0; j < 16; ++j) { const unsigned c = xb_ld(&bar[XB_XCNT(j)]); sum += c; cnt += (c > 0u) ? 1u : 0u; mine = (j == x) ? c : mine; }
        if (sum == G) break;
        __builtin_amdgcn_s_sleep(1);
        if ((++sp & 255u) == 0u) { if (xb_ld(&bar[XB_TMO])) break; if (sp > XB_SPIN_CAP) { atomicAdd(&bar[XB_TMO], 1u); break; } }
    }
    nloc = mine > 0u ? mine : 1u; nx = cnt > 0u ? cnt : 1u;
}

__device__ __forceinline__ void xcd_barrier(const XcdBarrier& b) {
    asm volatile("s_waitcnt vmcnt(0)" ::: "memory");
    __syncthreads();
    if (threadIdx.x == 0) {
        unsigned* bar = b.bar;
        __builtin_amdgcn_s_waitcnt(0);
        unsigned nloc = b.st[0], nx = b.st[1];
        if (nloc == 0u) { xcd_barrier_complete(bar, b.x, nloc, nx); b.st[0] = nloc; b.st[1] = nx; }
        const unsigned old = xb_add(&bar[XB_XSUB(b.x)], 1u);
        const unsigned gen = old / nloc;
        if (old + 1u == (gen + 1u) * nloc) {
            __builtin_amdgcn_fence(__ATOMIC_RELEASE, "agent");
            asm volatile("s_waitcnt vmcnt(0)" ::: "memory");
            const unsigned og = xb_add(&bar[XB_TOP], 1u);
            const unsigned tg = og / nx;
            if (og + 1u == (tg + 1u) * nx) xb_add(&bar[XB_TOPGEN], 1u);
            else XB_SPIN(xb_ld(&bar[XB_TOPGEN]) == tg, bar);
            __builtin_amdgcn_fence(__ATOMIC_ACQUIRE, "agent");
            xb_add(&bar[XB_XGEN(b.x)], 1u);
            asm volatile("s_waitcnt vmcnt(0)" ::: "memory");
        } else {
            XB_SPIN(xb_ld(&bar[XB_XGEN(b.x)]) == gen, bar);
            __builtin_amdgcn_fence(__ATOMIC_ACQUIRE, "agent");
            asm volatile("s_waitcnt vmcnt(0)" ::: "memory");
        }
    }
    __syncthreads();
}

template <int PH>
__device__ __forceinline__ void run_phase(const P& p, int bid, int nb, char* smem) {
    if constexpr (PH == 0) ph_prologue(p, bid, nb, smem);
    if constexpr (PH == 1) ph_inproj(p, bid, nb, smem);
    if constexpr (PH == 2) { ph_compress(p, bid, nb, smem); __syncthreads(); ph_rwkv_chunk(p, bid, nb, smem); }
    if constexpr (PH == 3) {
        if (bid < SCAN_BLOCKS) ph_rwkv_seq(p, bid, SCAN_BLOCKS, smem);
        else ph_nsa(p, bid - SCAN_BLOCKS, nb - SCAN_BLOCKS, smem);
    }
    if constexpr (PH == 12) ph_rwkv_out(p, bid, nb, smem);
    if constexpr (PH == 4) ph_merge(p, bid, nb, smem);
    if constexpr (PH == 5) ph_outproj(p, bid, nb, smem);
    if constexpr (PH == 6) ph_route(p, bid, nb, smem);
    if constexpr (PH == 7) ph_scatter(p, bid, nb, smem);
    if constexpr (PH == 9) ph_moe1(p, bid, nb, smem);
    if constexpr (PH == 10) ph_moe2(p, bid, nb, smem);
    if constexpr (PH == 11) ph_final(p, bid, nb, smem);
}

template <int PH>
__global__ void __launch_bounds__(NT) kph(P p) {
    extern __shared__ __attribute__((aligned(16))) char smem[];
    run_phase<PH>(p, blockIdx.x, gridDim.x, smem);
}

__global__ void __launch_bounds__(NT, 2) mega(P p) {
    extern __shared__ __attribute__((aligned(16))) char smem[];
    volatile LAS unsigned* st = (volatile LAS unsigned*)(smem + SMEM_BYTES - 16);
    if (threadIdx.x == 0) { st[0] = 0u; st[1] = 0u; st[2] = 0u; st[3] = 0u; }
    __syncthreads();
    XcdBarrier bar = xcd_barrier_post(p.bar, st);
    const int bid = blockIdx.x, nb = gridDim.x;
    run_phase<0>(p, bid, nb, smem); xcd_barrier(bar);
    run_phase<1>(p, bid, nb, smem); xcd_barrier(bar);
    run_phase<2>(p, bid, nb, smem); xcd_barrier(bar);
    run_phase<3>(p, bid, nb, smem); xcd_barrier(bar);
    run_phase<12>(p, bid, nb, smem); xcd_barrier(bar);
    run_phase<4>(p, bid, nb, smem); xcd_barrier(bar);
    run_phase<5>(p, bid, nb, smem); xcd_barrier(bar);
    run_phase<6>(p, bid, nb, smem); xcd_barrier(bar);
    run_phase<7>(p, bid, nb, smem); xcd_barrier(bar);
    run_phase<9>(p, bid, nb, smem); xcd_barrier(bar);
    run_phase<10>(p, bid, nb, smem); xcd_barrier(bar);
    run_phase<11>(p, bid, nb, smem);
}

extern "C" void kernel_launch(void* const* d_in, const int* in_sizes, int n_in,
                              void* d_out, int out_size, void* d_ws, size_t ws_size,
                              hipStream_t stream) {
    P p{};
    p.x = (const float*)d_in[0]; p.pos = (const int*)d_in[1]; p.g_mix = (const float*)d_in[2]; p.w_in = (const float*)d_in[3];
    p.pe_k = (const float*)d_in[4]; p.w1_k = (const float*)d_in[5]; p.b1_k = (const float*)d_in[6]; p.w2_k = (const float*)d_in[7]; p.b2_k = (const float*)d_in[8];
    p.pe_v = (const float*)d_in[9]; p.w1_v = (const float*)d_in[10]; p.b1_v = (const float*)d_in[11]; p.w2_v = (const float*)d_in[12]; p.b2_v = (const float*)d_in[13];
    p.mu = (const float*)d_in[14]; p.w0 = (const float*)d_in[15]; p.w2 = (const float*)d_in[16]; p.a0 = (const float*)d_in[17]; p.a2 = (const float*)d_in[18];
    p.g2 = (const float*)d_in[19]; p.k_k = (const float*)d_in[20]; p.k_a = (const float*)d_in[21]; p.r_k = (const float*)d_in[22]; p.ln_w = (const float*)d_in[23]; p.ln_b = (const float*)d_in[24];
    p.wpa = (const float*)d_in[25]; p.wpb = (const float*)d_in[26]; p.wout = (const float*)d_in[27]; p.g_ffn = (const float*)d_in[28];
    p.w_grp = (const float*)d_in[29]; p.b_grp = (const float*)d_in[30]; p.w_exp = (const float*)d_in[31]; p.b_exp = (const float*)d_in[32];
    p.e_w1 = (const float*)d_in[33]; p.e_w3 = (const float*)d_in[34]; p.e_w2 = (const float*)d_in[35]; p.g_final = (const float*)d_in[36];
    p.out = (float*)d_out;
    char* ws = (char*)d_ws;
    const size_t MiB = 1ull << 20;
    p.hbuf = (u16*)(ws + 0 * MiB);
    p.q    = (u16*)(ws + 64 * MiB);
    p.kc   = (u16*)(ws + 96 * MiB);  p.vc   = (u16*)(ws + 104 * MiB);
    p.ksl  = (u16*)(ws + 112 * MiB); p.vslT = (u16*)(ws + 120 * MiB);
    p.kwn  = (u16*)(ws + 128 * MiB); p.vwnT = (u16*)(ws + 136 * MiB);
    p.nsag = (float*)(ws + 144 * MiB);
    p.kcb  = (u16*)(ws + 148 * MiB); p.vcT  = (u16*)(ws + 149 * MiB);
    p.prw  = (u16*)(ws + 160 * MiB);
    p.cdat = (u16*)(ws + 272 * MiB);
    p.bon  = (float*)(ws + 150 * MiB);
    p.w2T  = (u16*)(ws + 151 * MiB); p.a2T = p.w2T + 512 * 64; p.g2T = p.a2T + 512 * 64;
    p.cw1Tk = (u16*)(ws + 152 * MiB); p.cw1Tv = (u16*)(ws + 153 * MiB);
    p.cw2Tk = (u16*)(ws + 154 * MiB); p.cw2Tv = p.cw2Tk + 128 * 256;
    p.chid = (u16*)(ws + 155 * MiB);
    p.xact = (u16*)(ws + 488 * MiB);
    p.oa   = (u16*)(ws + 400 * MiB);
    p.ob   = (u16*)(ws + 432 * MiB);
    p.merged = (u16*)(ws + 64 * MiB);
    p.x1   = (float*)(ws + 160 * MiB);
    char* rt = ws + 288 * MiB;
    p.tok_e = (int*)(rt);                        rt += NTOK * 2 * 4;
    p.tok_gate = (float*)(rt);                   rt += NTOK * 2 * 4;
    p.tokslot = (int*)(rt);                      rt += NTOK * 2 * 4;
    p.list_tok = (int*)(rt);                     rt += NTOK * 2 * 4;
    p.list_gate = (float*)(rt);                  rt += NTOK * 2 * 4;
    p.blk_e = (int*)(rt);                        rt += 2048 * 4;
    p.blk_r0 = (int*)(rt);                       rt += 2048 * 4;
    p.hid  = (u16*)(ws + 296 * MiB);
    p.ybuf = (u16*)(ws + 336 * MiB);
    char* misc = ws + 470 * MiB;
    p.counts = (int*)(misc); p.cursor = (int*)(misc + 256); p.offs = (int*)(misc + 512); p.nblk = (int*)(misc + 1024);
    p.bar = (unsigned*)(ws + 471 * MiB);
    p.cb1k = (float*)(p.bar + XCD_BAR_WORDS); p.cb1v = p.cb1k + 256;
    {
        char* wa = ws + 472 * MiB;
        p.winT = (u16*)wa;  wa += (size_t)3328 * 1024 * 2;
        p.wgT  = (u16*)wa;  wa += (size_t)2048 * 1024 * 2;
        p.wpaT = (u16*)wa;  wa += (size_t)1024 * 512 * 2;
        p.wpbT = (u16*)wa;  wa += (size_t)1024 * 512 * 2;
        p.woutT = (u16*)wa; wa += (size_t)1024 * 1024 * 2;
        p.ew1T = (u16*)(ws + 64 * MiB);  p.ew3T = (u16*)(ws + 80 * MiB);  p.ew2T = (u16*)(ws + 96 * MiB);
    }
    if (ws_size < (size_t)505 * MiB) return;

#if MEGA
    {
        static int mgrid = 0;
        if (mgrid == 0) {
            int dev = 0, cus = 0, per_cu = 0;
            hipGetDevice(&dev);
            hipDeviceGetAttribute(&cus, hipDeviceAttributeMultiprocessorCount, dev);
            hipFuncSetAttribute((const void*)mega, hipFuncAttributeMaxDynamicSharedMemorySize, SMEM_BYTES);
            hipOccupancyMaxActiveBlocksPerMultiprocessor(&per_cu, (const void*)mega, NT, SMEM_BYTES);
            (void)hipGetLastError();
            mgrid = cus;
        }
        hipMemsetAsync(p.bar, 0, XCD_BAR_WORDS * sizeof(unsigned) + 512 * sizeof(float), stream);
        mega<<<mgrid, NT, SMEM_BYTES, stream>>>(p);
        return;
    }
#else
    const int grid = 512;
    hipMemsetAsync(p.bar, 0, XCD_BAR_WORDS * sizeof(unsigned) + 512 * sizeof(float), stream);
    hipFuncSetAttribute((const void*)kph<0>, hipFuncAttributeMaxDynamicSharedMemorySize, SMEM_BYTES);
    hipFuncSetAttribute((const void*)kph<1>, hipFuncAttributeMaxDynamicSharedMemorySize, SMEM_BYTES);
    hipFuncSetAttribute((const void*)kph<2>, hipFuncAttributeMaxDynamicSharedMemorySize, SMEM_BYTES);
    hipFuncSetAttribute((const void*)kph<3>, hipFuncAttributeMaxDynamicSharedMemorySize, SMEM_BYTES);
    hipFuncSetAttribute((const void*)kph<4>, hipFuncAttributeMaxDynamicSharedMemorySize, SMEM_BYTES);
    hipFuncSetAttribute((const void*)kph<5>, hipFuncAttributeMaxDynamicSharedMemorySize, SMEM_BYTES);
    hipFuncSetAttribute((const void*)kph<6>, hipFuncAttributeMaxDynamicSharedMemorySize, SMEM_BYTES);
    hipFuncSetAttribute((const void*)kph<7>, hipFuncAttributeMaxDynamicSharedMemorySize, SMEM_BYTES);
    hipFuncSetAttribute((const void*)kph<8>, hipFuncAttributeMaxDynamicSharedMemorySize, SMEM_BYTES);
    hipFuncSetAttribute((const void*)kph<9>, hipFuncAttributeMaxDynamicSharedMemorySize, SMEM_BYTES);
    hipFuncSetAttribute((const void*)kph<10>, hipFuncAttributeMaxDynamicSharedMemorySize, SMEM_BYTES);
    hipFuncSetAttribute((const void*)kph<11>, hipFuncAttributeMaxDynamicSharedMemorySize, SMEM_BYTES);
    kph<0><<<grid, NT, SMEM_BYTES, stream>>>(p);
    kph<1><<<grid, NT, SMEM_BYTES, stream>>>(p);
    kph<2><<<grid, NT, SMEM_BYTES, stream>>>(p);
    kph<3><<<grid, NT, SMEM_BYTES, stream>>>(p);
    kph<12><<<grid, NT, SMEM_BYTES, stream>>>(p);
    kph<4><<<grid, NT, SMEM_BYTES, stream>>>(p);
    kph<5><<<grid, NT, SMEM_BYTES, stream>>>(p);
    kph<6><<<grid, NT, SMEM_BYTES, stream>>>(p);
    kph<7><<<grid, NT, SMEM_BYTES, stream>>>(p);
    kph<8><<<grid, NT, SMEM_BYTES, stream>>>(p);
    kph<9><<<grid, NT, SMEM_BYTES, stream>>>(p);
    kph<10><<<grid, NT, SMEM_BYTES, stream>>>(p);
    kph<11><<<grid, NT, SMEM_BYTES, stream>>>(p);
#endif
}
```

```cpp
#include <hip/hip_runtime.h>
#include <stdint.h>

typedef unsigned short u16;
using bf16x8 = __attribute__((ext_vector_type(8))) short;
using f32x4  = __attribute__((ext_vector_type(4))) float;

#ifndef MEGA
#define MEGA 1
#endif

constexpr int B_ = 4, S_ = 8192, D_ = 1024, NTOK = B_ * S_;
constexpr int CIN = 5144;
constexpr int NCMP = 511;
constexpr int CRW = 1792;
constexpr int NEXP = 32;
constexpr int NT = 512;
constexpr int NW = NT / 64;
constexpr int SMEM_BYTES = 160 * 1024;
constexpr int SCAN_BLOCKS = 16;
constexpr float QSCALE = 0.125f * 1.4426950408889634f;

struct P {
    const float* x; const int* pos; const float* g_mix; const float* w_in;
    const float *pe_k, *w1_k, *b1_k, *w2_k, *b2_k, *pe_v, *w1_v, *b1_v, *w2_v, *b2_v;
    const float *mu, *w0, *w2, *a0, *a2, *g2, *k_k, *k_a, *r_k, *ln_w, *ln_b;
    const float *wpa, *wpb, *wout, *g_ffn, *w_grp, *b_grp, *w_exp, *b_exp, *e_w1, *e_w3, *e_w2, *g_final;
    float* out;
    u16* hbuf; u16 *q, *kc, *vc, *ksl, *vslT, *kwn, *vwnT, *kcb, *vcT; float* nsag; u16* prw;
    u16* cdat; float* bon; u16 *w2T, *a2T, *g2T; u16 *oa, *ob; u16* merged; float* x1;
    int* tok_e; float* tok_gate; int* tokslot; int* list_tok; float* list_gate;
    int* counts; int* offs; int* cursor; int* blk_e; int* blk_r0; int* nblk;
    u16* hid; u16* ybuf; unsigned* bar;
    u16 *winT, *wgT, *wpaT, *wpbT, *woutT, *ew1T, *ew3T, *ew2T;
    u16 *cw1Tk, *cw1Tv, *cw2Tk, *cw2Tv, *chid, *xact; float *cb1k, *cb1v;
};

typedef __bf16 bf16x2_t __attribute__((ext_vector_type(2)));
typedef float f32x2_t __attribute__((ext_vector_type(2)));
__device__ __forceinline__ unsigned pack2(float a, float b) {
    f32x2_t f = {a, b};
    return __builtin_bit_cast(unsigned, __builtin_convertvector(f, bf16x2_t));
}
__device__ __forceinline__ u16 f2bf(float f) { return (u16)(pack2(f, f) & 0xFFFFu); }
__device__ __forceinline__ float bf2f(u16 h) { return __uint_as_float(((unsigned)h) << 16); }
__device__ __forceinline__ float sigmoidf_(float x) { return __builtin_amdgcn_rcpf(1.f + __expf(-x)); }
__device__ __forceinline__ int get_tid() { int t = threadIdx.x; asm volatile("" : "+v"(t)); return t; }
__device__ __forceinline__ uint2 pack4(const f32x4& v) { uint2 o; o.x = pack2(v[0], v[1]); o.y = pack2(v[2], v[3]); return o; }
__device__ __forceinline__ f32x4 unpack4(uint2 u) { return f32x4{__uint_as_float(u.x << 16), __uint_as_float(u.x & 0xFFFF0000u), __uint_as_float(u.y << 16), __uint_as_float(u.y & 0xFFFF0000u)}; }
#define LDS_BARRIER() do { asm volatile("s_waitcnt lgkmcnt(0)" ::: "memory"); __builtin_amdgcn_s_barrier(); asm volatile("" ::: "memory"); } while (0)
__device__ __forceinline__ int opaque(int x) { asm volatile("" : "+v"(x)); return x; }
template <int CTRL>
__device__ __forceinline__ float dppf(float x) { return __int_as_float(__builtin_amdgcn_update_dpp(0, __float_as_int(x), CTRL, 0xF, 0xF, true)); }
__device__ __forceinline__ float wave_sum(float v) {
    v += dppf<0xB1>(v);
    v += dppf<0x4E>(v);
    v += dppf<0x141>(v);
    v += dppf<0x140>(v);
    const int vi = __float_as_int(v);
    return (__int_as_float(__builtin_amdgcn_readlane(vi, 0)) + __int_as_float(__builtin_amdgcn_readlane(vi, 16)))
         + (__int_as_float(__builtin_amdgcn_readlane(vi, 32)) + __int_as_float(__builtin_amdgcn_readlane(vi, 48)));
}

__device__ __forceinline__ float xrow_sum(float v) {
    auto r = __builtin_amdgcn_permlane16_swap(__float_as_uint(v), __float_as_uint(v), false, false);
    v = __uint_as_float(r[0]) + __uint_as_float(r[1]);
    auto r2 = __builtin_amdgcn_permlane32_swap(__float_as_uint(v), __float_as_uint(v), false, false);
    return __uint_as_float(r2[0]) + __uint_as_float(r2[1]);
}
__device__ __forceinline__ float xrow_max(float v) {
    auto r = __builtin_amdgcn_permlane16_swap(__float_as_uint(v), __float_as_uint(v), false, false);
    v = fmaxf(__uint_as_float(r[0]), __uint_as_float(r[1]));
    auto r2 = __builtin_amdgcn_permlane32_swap(__float_as_uint(v), __float_as_uint(v), false, false);
    return fmaxf(__uint_as_float(r2[0]), __uint_as_float(r2[1]));
}
__constant__ double ROPE_FREQ[32] = {
    1.00000000000000000000e+00, 7.49894209332455874417e-01, 5.62341325190349072827e-01, 4.21696503428582225581e-01,
    3.16227766016837941176e-01, 2.37137370566165517349e-01, 1.77827941003892292526e-01, 1.33352143216332402753e-01,
    1.00000000000000005551e-01, 7.49894209332455791150e-02, 5.62341325190349114460e-02, 4.21696503428582239459e-02,
    3.16227766016837913421e-02, 2.37137370566165538166e-02, 1.77827941003892292526e-02, 1.33352143216332406223e-02,
    1.00000000000000002082e-02, 7.49894209332455791150e-03, 5.62341325190349097113e-03, 4.21696503428582291501e-03,
    3.16227766016837939442e-03, 2.37137370566165538166e-03, 1.77827941003892275179e-03, 1.33352143216332406223e-03,
    1.00000000000000002082e-03, 7.49894209332455856203e-04, 5.62341325190349097113e-04, 4.21696503428582237290e-04,
    3.16227766016837939442e-04, 2.37137370566165538166e-04, 1.77827941003892269758e-04, 1.33352143216332395381e-04};

constexpr int G_ABYTES = 256 * 64 * 2, G_BBYTES = 128 * 64 * 2, G_TILE = G_ABYTES + G_BBYTES;
#define LAS3 __attribute__((address_space(3)))
#define GAS1 __attribute__((address_space(1)))
__device__ __forceinline__ void glds16(const u16* g, char* l) {
    __builtin_amdgcn_global_load_lds((const GAS1 unsigned*)g, (LAS3 unsigned*)l, 16, 0, 0);
}
template <bool TR = false, class ARow>
__device__ __forceinline__ void gemm_core(int K, ARow arow, const u16* __restrict__ BT, int ldb, f32x4 (&acc)[4][4], u16* sm) {
    char* base = (char*)sm;
    const int tid = get_tid(), lane = tid & 63, wv = tid >> 6;
    const int wm = wv >> 1, wn = wv & 1, kr = lane & 15, qq = lane >> 4;
    const int lr = tid >> 3, lk = ((tid & 7) ^ ((lr >> 1) & 7)) * 8;
    const u16* ap0 = arow(lr) + lk; const u16* ap1 = arow(lr + 64) + lk;
    const u16* ap2 = arow(lr + 128) + lk; const u16* ap3 = arow(lr + 192) + lk;
    const u16* bp0 = BT + (size_t)lr * ldb + lk; const u16* bp1 = BT + (size_t)(lr + 64) * ldb + lk;
#pragma unroll
    for (int mt = 0; mt < 4; mt++)
#pragma unroll
        for (int nt = 0; nt < 4; nt++) acc[mt][nt] = f32x4{0.f, 0.f, 0.f, 0.f};
    const int nk = K >> 6;
#define G_ISSUE(t, b) { char* d = base + (b) * G_TILE + tid * 16; const int ko = (t) * 64; \
        glds16(ap0 + ko, d); glds16(ap1 + ko, d + 8192); glds16(ap2 + ko, d + 16384); glds16(ap3 + ko, d + 24576); \
        glds16(bp0 + ko, d + G_ABYTES); glds16(bp1 + ko, d + G_ABYTES + 8192); }
    const int sw = kr >> 1;
    const int po0 = ((0 * 4 + qq) ^ sw) * 16, po1 = ((1 * 4 + qq) ^ sw) * 16;
    const int aoff = (wm * 64 + kr) * 128, boff = G_ABYTES + (wn * 64 + kr) * 128;
#define G_READ(FA, FB, b) { const char* Ab = base + (b) * G_TILE + aoff; const char* Bb = base + (b) * G_TILE + boff; \
        _Pragma("unroll") for (int mt = 0; mt < 4; mt++) { FA[0][mt] = *(const bf16x8*)(Ab + mt * 2048 + po0); FA[1][mt] = *(const bf16x8*)(Ab + mt * 2048 + po1); } \
        _Pragma("unroll") for (int nt = 0; nt < 4; nt++) { FB[0][nt] = *(const bf16x8*)(Bb + nt * 2048 + po0); FB[1][nt] = *(const bf16x8*)(Bb + nt * 2048 + po1); } }
#define G_MMA(FA, FB) { __builtin_amdgcn_s_setprio(1); \
        _Pragma("unroll") for (int ks = 0; ks < 2; ks++) \
            _Pragma("unroll") for (int nt = 0; nt < 4; nt++) \
                _Pragma("unroll") for (int mt = 0; mt < 4; mt++) \
                    acc[mt][nt] = TR ? __builtin_amdgcn_mfma_f32_16x16x32_bf16(FA[ks][mt], FB[ks][nt], acc[mt][nt], 0, 0, 0) \
                                     : __builtin_amdgcn_mfma_f32_16x16x32_bf16(FB[ks][nt], FA[ks][mt], acc[mt][nt], 0, 0, 0); \
        __builtin_amdgcn_s_setprio(0); }
    bf16x8 fa0[2][4], fb0[2][4], fa1[2][4], fb1[2][4];
    G_ISSUE(0, 0)
    if (nk > 1) G_ISSUE(1, 1)
    if (nk > 2) G_ISSUE(2, 2)
    if (nk > 2) asm volatile("s_waitcnt vmcnt(12)" ::: "memory");
    else if (nk > 1) asm volatile("s_waitcnt vmcnt(6)" ::: "memory");
    else asm volatile("s_waitcnt vmcnt(0)" ::: "memory");
    __builtin_amdgcn_s_barrier();
    G_READ(fa0, fb0, 0)
    int bnext = 1, bfree = 0;
#define G_STEP(FAC, FBC, FAN, FBN, kt) { \
        if ((kt) + 1 < nk) { \
            if ((kt) + 2 < nk) asm volatile("s_waitcnt vmcnt(6) lgkmcnt(0)" ::: "memory"); else asm volatile("s_waitcnt vmcnt(0) lgkmcnt(0)" ::: "memory"); \
            __builtin_amdgcn_s_barrier();                   \
            if ((kt) + 3 < nk) G_ISSUE((kt) + 3, bfree) \
            G_READ(FAN, FBN, bnext) \
        } \
        G_MMA(FAC, FBC) \
        bfree = bnext; bnext = (bnext == 2) ? 0 : bnext + 1; }
    for (int kt = 0; kt < nk; kt += 2) {
        G_STEP(fa0, fb0, fa1, fb1, kt)
        G_STEP(fa1, fb1, fa0, fb0, kt + 1)
    }
    __builtin_amdgcn_s_barrier();
#undef G_READ
#undef G_MMA
#undef G_STEP
#undef G_ISSUE
}

__device__ __forceinline__ int xcd_item(int bid, int nb, int k, int nitems) {
    if (nb & 7) return bid + k * nb;
    const int per = nb >> 3, chunk = (nitems + 7) >> 3;
    const int j = k * per + (bid >> 3);
    return (j < chunk) ? (bid & 7) * chunk + j : nitems;
}
struct GUnit { int pm, pn; };
constexpr int G8_HTB = 128 * 64 * 2;
__device__ __forceinline__ int g8_lds_byte(int r, int c) { const int st = (r >> 4) * 2 + (c >> 5), rr = r & 15, cc = c & 31, ob = rr * 64 + cc * 2; return st * 1024 + (ob ^ (((ob >> 9) & 1) << 5)); }
__device__ __forceinline__ void g8_stage_rc(int b, int& R, int& C) { const int st = b / 1024, sb = b % 1024, swz = sb ^ (((sb >> 9) & 1) << 5); R = (st >> 1) * 16 + swz / 64; C = (st & 1) * 32 + (swz % 64) / 2; }
__host__ __device__ __forceinline__ int perm32(int rho) { const int n = rho >> 4, i = rho & 15; return 8 * (i >> 2) + 4 * n + (i & 3); }

template <class Epi, class Sched>
__device__ __forceinline__ void gemm256(char* smem, const char* Ab, int K, const Sched& S, const Epi& E) {
    LAS3 unsigned char* lds = (LAS3 unsigned char*)smem;
    const int tid = get_tid(), wid = __builtin_amdgcn_readfirstlane(tid >> 6), lane = tid & 63, wr = wid >> 2, wc = wid & 3, fr = lane & 15, fq = lane >> 4;
    int nt = K >> 6; asm volatile("" : "+s"(nt));
    unsigned voffB[2], voffA[2][2];
#pragma unroll
    for (int i = 0; i < 2; ++i) { int sR, sC; g8_stage_rc(tid * 16 + i * 8192, sR, sC); voffB[i] = (unsigned)(sR * K + sC) * 2u; }
#define G8_AOFFS(un) do { const int t3_ = get_tid(); _Pragma("unroll") for (int i = 0; i < 2; ++i) { int sR, sC; g8_stage_rc(t3_ * 16 + i * 8192, sR, sC); \
        _Pragma("unroll") for (int h = 0; h < 2; ++h) voffA[h][i] = S.a_off(un, h, sR) + (unsigned)sC * 2u; } } while (0)
    const size_t kstep = 128;
    const size_t hstep = (size_t)128 * K * 2;
    const unsigned ldsw = (unsigned)wid * 1024u;
    const int aoff = g8_lds_byte(wr * 64 + fr, fq * 8), boff = g8_lds_byte(wc * 32 + fr, fq * 8);
#define G8_SA(b, h) (((b) * 2 + (h)) * G8_HTB)
#define G8_SB(b, h) ((4 + (b) * 2 + (h)) * G8_HTB)
#define G8_STAGE2(bufoff, gbase, v0, v1) do { \
        __builtin_amdgcn_global_load_lds((const GAS1 unsigned*)((const char*)(gbase) + (v0)), (LAS3 unsigned*)(lds + (bufoff) + ldsw), 16, 0, 0); \
        __builtin_amdgcn_global_load_lds((const GAS1 unsigned*)((const char*)(gbase) + (v1)), (LAS3 unsigned*)(lds + (bufoff) + ldsw + 8192), 16, 0, 0); } while (0)
#define G8_STAGEB(bufoff, gbase) G8_STAGE2(bufoff, gbase, voffB[0], voffB[1])
#define G8_LDA(dst, b, h) do { _Pragma("unroll") for (int m = 0; m < 4; ++m) _Pragma("unroll") for (int k = 0; k < 2; ++k) dst[m][k] = *(const LAS3 bf16x8*)(lds + G8_SA(b, h) + aoff + m * 2048 + k * 1024); } while (0)
#define G8_LDB(dst, b, h) do { _Pragma("unroll") for (int n = 0; n < 2; ++n) _Pragma("unroll") for (int k = 0; k < 2; ++k) dst[n][k] = *(const LAS3 bf16x8*)(lds + G8_SB(b, h) + boff + n * 2048 + k * 1024); } while (0)
#define G8_MMA(ai, bj, At, Bt) do { __builtin_amdgcn_s_setprio(1); _Pragma("unroll") for (int m = 0; m < 4; ++m) _Pragma("unroll") for (int n = 0; n < 2; ++n) _Pragma("unroll") for (int k = 0; k < 2; ++k) \
        acc[ai][bj][m][n] = __builtin_amdgcn_mfma_f32_16x16x32_bf16(Bt[n][k], At[m][k], acc[ai][bj][m][n], 0, 0, 0); __builtin_amdgcn_s_setprio(0); } while (0)
#define G8_WAIT_V(n) asm volatile("s_waitcnt vmcnt(" #n ")" ::: "memory")
#define G8_WAIT_L(n) asm volatile("s_waitcnt lgkmcnt(" #n ")" ::: "memory")
#define G8_BAR __builtin_amdgcn_s_barrier()
#define G8_SCHED __builtin_amdgcn_sched_barrier(0)
    GUnit cur, nxt; int ui = 0;
    if (!S.next(0, cur)) return;
    f32x4 acc[2][2][4][2];
#pragma unroll
    for (int a = 0; a < 2; ++a)
#pragma unroll
        for (int b = 0; b < 2; ++b)
#pragma unroll
            for (int m = 0; m < 4; ++m)
#pragma unroll
                for (int n = 0; n < 2; ++n) acc[a][b][m][n] = (f32x4){0.f, 0.f, 0.f, 0.f};
    bf16x8 At[4][2], B0[2][2], B1[2][2];
    G8_AOFFS(cur);
    const char* cB = S.b_ptr(cur);
    G8_STAGEB(G8_SB(0, 0), cB); G8_STAGE2(G8_SA(0, 0), Ab, voffA[0][0], voffA[0][1]); G8_STAGEB(G8_SB(0, 1), cB + hstep); G8_STAGE2(G8_SA(0, 1), Ab, voffA[1][0], voffA[1][1]);
    if (wr == 1) G8_BAR;
    G8_WAIT_V(4); G8_BAR;
    G8_STAGEB(G8_SB(1, 0), cB + kstep); G8_STAGE2(G8_SA(1, 0), Ab + kstep, voffA[0][0], voffA[0][1]); G8_STAGEB(G8_SB(1, 1), cB + hstep + kstep);
    G8_WAIT_V(6); G8_BAR;
    for (;;) {
        const bool has_next = S.next(ui + 1, nxt);
        const char* nB = has_next ? S.b_ptr(nxt) : cB;
        for (int t = 0; t < nt; t += 2) {
            const bool last = (t == nt - 2);
            const char* a1 = Ab + (size_t)(t + 1) * kstep;
            const unsigned va10 = voffA[1][0], va11 = voffA[1][1];
            if (last && has_next) G8_AOFFS(nxt);
            const char* a2 = last ? Ab : Ab + (size_t)(t + 2) * kstep; const char* b2 = last ? nB : cB + (size_t)(t + 2) * kstep;
            const char* a3 = a2 + kstep; const char* b3 = b2 + kstep;
            G8_LDB(B0, 0, 0); G8_SCHED; G8_LDA(At, 0, 0); G8_STAGE2(G8_SA(1, 1), a1, va10, va11);
            G8_WAIT_L(8); G8_BAR; G8_WAIT_L(0); G8_MMA(0, 0, At, B0); G8_BAR; G8_SCHED;
            G8_LDB(B1, 0, 1); G8_STAGEB(G8_SB(0, 0), b2);
            G8_BAR; G8_WAIT_L(0); G8_MMA(0, 1, At, B1); G8_BAR;
            G8_LDA(At, 0, 1); G8_STAGE2(G8_SA(0, 0), a2, voffA[0][0], voffA[0][1]);
            G8_BAR; G8_WAIT_L(0); G8_MMA(1, 0, At, B0); G8_BAR; G8_SCHED;
            G8_STAGEB(G8_SB(0, 1), b2 + hstep);
            G8_WAIT_V(6); G8_BAR; G8_MMA(1, 1, At, B1); G8_BAR;
            G8_LDB(B0, 1, 0); G8_SCHED; G8_LDA(At, 1, 0); G8_STAGE2(G8_SA(0, 1), a2, voffA[1][0], voffA[1][1]);
            G8_WAIT_L(8); G8_BAR; G8_WAIT_L(0); G8_MMA(0, 0, At, B0); G8_BAR; G8_SCHED;
            G8_LDB(B1, 1, 1); G8_STAGEB(G8_SB(1, 0), b3);
            G8_BAR; G8_WAIT_L(0); G8_MMA(0, 1, At, B1); G8_BAR;
            G8_LDA(At, 1, 1); G8_STAGE2(G8_SA(1, 0), a3, voffA[0][0], voffA[0][1]);
            G8_BAR; G8_WAIT_L(0); G8_MMA(1, 0, At, B0); G8_BAR; G8_SCHED;
            G8_STAGEB(G8_SB(1, 1), b3 + hstep);
            G8_WAIT_V(6); G8_BAR; G8_MMA(1, 1, At, B1); G8_BAR;
        }
        E(acc, cur, wr, wc, fr, fq);
        if (!has_next) break;
#pragma unroll
        for (int a = 0; a < 2; ++a)
#pragma unroll
            for (int b = 0; b < 2; ++b)
#pragma unroll
                for (int m = 0; m < 4; ++m)
#pragma unroll
                    for (int n = 0; n < 2; ++n) acc[a][b][m][n] = (f32x4){0.f, 0.f, 0.f, 0.f};
        cur = nxt; cB = nB; ++ui;
    }
    G8_WAIT_V(0);
    if (wr == 0) G8_BAR;
    G8_BAR;
#undef G8_SA
#undef G8_AOFFS
#undef G8_SB
#undef G8_STAGE2
#undef G8_STAGEB
#undef G8_LDA
#undef G8_LDB
#undef G8_MMA
#undef G8_WAIT_V
#undef G8_WAIT_L
#undef G8_BAR
#undef G8_SCHED
}
struct DenseSched {
    int nM, nN, nwg, G, c, K; const char* Bt;
    __device__ __forceinline__ void init(int M, int N, int K_, const void* Bt_, int G_, int c_) { nM = M >> 8; nN = N >> 8; nwg = nM * nN; G = G_; c = c_; K = K_; Bt = (const char*)Bt_; }
    __device__ __forceinline__ bool next(int i, GUnit& u) const {
        const int L = i * G + c; if (L >= nwg) return false;
        int wgid = L; { const int q = nwg >> 3, r = nwg & 7, xcd = wgid & 7, off = wgid >> 3; wgid = (xcd < r ? xcd * (q + 1) : r * (q + 1) + (xcd - r) * q) + off; }
        const int nig = 8 * nN, gid = wgid / nig, fm = gid * 8, gsz = (nM - fm) < 8 ? (nM - fm) : 8, w = wgid - gid * nig;
        u.pn = w / gsz; u.pm = fm + (w - u.pn * gsz); return true;
    }
    __device__ __forceinline__ unsigned a_off(const GUnit& u, int h, int R) const { return (unsigned)((u.pm * 256 + h * 128 + R) * K) * 2u; }
    __device__ __forceinline__ const char* b_ptr(const GUnit& u) const { return Bt + (size_t)u.pn * 256 * K * 2; }
};

template <class SRC>
__device__ __forceinline__ void convert_wT(const float* __restrict__ W, int K, int N, u16* __restrict__ WT, int rows, SRC src, int gtid, int gnt) {
    const int kch = K >> 3;
    const int total = rows * kch;
    for (int i = gtid; i < total; i += gnt) {
        const int kc = i / rows, j = i - kc * rows;
        const int sc = src(j);
        uint4 v = make_uint4(0u, 0u, 0u, 0u);
        if (sc >= 0) {
            const float* wp = W + (size_t)(kc * 8) * N + sc;
            v.x = pack2(wp[0], wp[(size_t)N]); v.y = pack2(wp[2 * (size_t)N], wp[3 * (size_t)N]);
            v.z = pack2(wp[4 * (size_t)N], wp[5 * (size_t)N]); v.w = pack2(wp[6 * (size_t)N], wp[7 * (size_t)N]);
        }
        *(uint4*)&WT[(size_t)j * K + kc * 8] = v;
    }
}

__device__ void ph_prologue(const P& p, int bid, int nb, char* smem) {
    const int tid = get_tid(), lane = tid & 63, wv = tid >> 6;
    if (bid >= 1 && bid <= 64) {
        const int j = tid & 255; const bool isv = tid >= 256;
        const float* pe = isv ? p.pe_v : p.pe_k; const float* w1 = isv ? p.w1_v : p.w1_k;
        const int kb = (bid - 1) * 32;
        float a0 = 0.f, a1 = 0.f;
#pragma unroll 4
        for (int k = kb; k < kb + 32; k += 2) { a0 += pe[k] * w1[(size_t)k * 256 + j]; a1 += pe[k + 1] * w1[(size_t)(k + 1) * 256 + j]; }
        atomicAdd(&(isv ? p.cb1v : p.cb1k)[j], a0 + a1);
    }
    if (bid == 0) {
        if (tid < 32) { p.counts[tid] = 0; p.cursor[tid] = 0; }
        for (int i = tid; i < 8 * 64; i += NT) {
            const int bg = i >> 6, d = i & 63;
            p.kcb[((size_t)bg * 512 + 511) * 64 + d] = 0;
            p.vcT[(((size_t)bg * 8 + 7) * 64 + d) * 64 + 63] = 0;
        }
    }
    {
        const int gtid = bid * NT + tid, gnt = nb * NT;
        convert_wT(p.w_in, D_, CIN, p.winT, 3328, [](int j) {
            const int t = j >> 8, s = j & 255;
            if (t < 5) {
                const int bj = s >> 7, wc = (s >> 5) & 3, n = (s >> 4) & 1, i = s & 15;
                const int dim = 32 * bj + 8 * (i >> 2) + 4 * n + (i & 3), hq = 4 * t + wc;
                int hb;
                if (hq < 8) hb = 64 * hq;
                else { const int k = (hq - 8) >> 1; hb = (k == 0 ? 512 : (k == 1 ? 640 : (k == 2 ? 768 : (k == 3 ? 1024 : (k == 4 ? 896 : 1152))))) + 64 * (hq & 1); }
                return hb + dim;
            }
            const int c = (s & ~31) + perm32(s & 31);
            if (t < 12) return 1304 + (t - 5) * 256 + c;
            return c < 24 ? 1280 + c : -1; }, gtid, gnt);
        convert_wT(p.w_in, D_, CIN, p.wgT, 2048, [](int j) { return 3096 + (j & ~31) + perm32(j & 31); }, gtid, gnt);
        convert_wT(p.wpa, 512, D_, p.wpaT, 1024, [](int j) { return (j & ~31) + perm32(j & 31); }, gtid, gnt);
        convert_wT(p.wpb, 512, D_, p.wpbT, 1024, [](int j) { return (j & ~31) + perm32(j & 31); }, gtid, gnt);
        convert_wT(p.wout, D_, D_, p.woutT, 1024, [](int j) { return j; }, gtid, gnt);
        convert_wT(p.w2, 64, 512, p.w2T, 512, [](int j) { return j; }, gtid, gnt);
        convert_wT(p.w1_k, 2048, 256, p.cw1Tk, 256, [](int j) { return j; }, gtid, gnt);
        convert_wT(p.w1_v, 2048, 256, p.cw1Tv, 256, [](int j) { return j; }, gtid, gnt);
        convert_wT(p.w2_k, 256, 64, p.cw2Tk, 128, [](int j) { return j < 64 ? j : -1; }, gtid, gnt);
        convert_wT(p.w2_v, 256, 64, p.cw2Tv, 128, [](int j) { return j < 64 ? j : -1; }, gtid, gnt);
        convert_wT(p.a2, 64, 512, p.a2T, 512, [](int j) { return j; }, gtid, gnt);
        convert_wT(p.g2, 128, 512, p.g2T, 512, [](int j) { return j; }, gtid, gnt);
    }
    for (int row = bid * NW + wv; row < NTOK; row += nb * NW) {
        const float* xr = p.x + (size_t)row * D_;
        float v[16];
        float ss = 0.f;
#pragma unroll
        for (int i = 0; i < 4; i++) {
            float4 t = *(const float4*)&xr[i * 256 + lane * 4];
            v[4 * i] = t.x; v[4 * i + 1] = t.y; v[4 * i + 2] = t.z; v[4 * i + 3] = t.w;
            ss += t.x * t.x + t.y * t.y + t.z * t.z + t.w * t.w;
        }
        ss = wave_sum(ss);
        const float rs = rsqrtf(ss * (1.f / D_) + 1e-6f);
#pragma unroll
        for (int i = 0; i < 4; i++) {
            const int c = i * 256 + lane * 4;
            float4 g = *(const float4*)&p.g_mix[c];
            uint2 o;
            o.x = pack2(v[4 * i] * rs * g.x, v[4 * i + 1] * rs * g.y);
            o.y = pack2(v[4 * i + 2] * rs * g.z, v[4 * i + 3] * rs * g.w);
            *(uint2*)&p.hbuf[(size_t)row * D_ + c] = o;
        }
    }
}

__device__ __forceinline__ uint4 pack8(const f32x4& a, const f32x4& b) { uint4 o; o.x = pack2(a[0], a[1]); o.y = pack2(a[2], a[3]); o.z = pack2(b[0], b[1]); o.w = pack2(b[2], b[3]); return o; }
struct EpiInproj {
    const P* pp;
    __device__ __forceinline__ void operator()(const f32x4 (&acc)[2][2][4][2], const GUnit& u, int, int, int, int) const {
        const int t2_ = get_tid(), wid_ = __builtin_amdgcn_readfirstlane(t2_ >> 6), wr = wid_ >> 2, wc = wid_ & 3, fr = t2_ & 15, fq = (t2_ >> 4) & 3;
        const P& p = *pp;
        const int pn = u.pn;
        const int rowb = u.pm * 256 + wr * 64;
        if (pn < 4) {
            const int hq = 4 * pn + wc;
            const bool rope = !(pn == 2 && wc >= 2);
            u16* dst; size_t rstride; int cofs;
            if (pn < 2) { dst = p.q; rstride = 512; cofs = hq * 64; }
            else { dst = (pn == 2) ? (wc < 2 ? p.kc : p.vc) : (wc < 2 ? p.ksl : p.kwn); rstride = 64; cofs = 0; }
            const int g = wc & 1;
#pragma unroll
            for (int ai = 0; ai < 2; ++ai)
#pragma unroll
                for (int m = 0; m < 4; ++m) {
                    const int row = rowb + ai * 128 + m * 16 + fr;
                    f32x4 o1[2], o2[2];
#pragma unroll
                    for (int n = 0; n < 2; ++n) { o1[n] = acc[ai][0][m][n]; o2[n] = acc[ai][1][m][n]; }
                    if (rope) {
                        const double posd = (double)p.pos[row];
#pragma unroll
                        for (int n = 0; n < 2; ++n)
#pragma unroll
                            for (int j = 0; j < 4; ++j) {
                                const double tr = posd * ROPE_FREQ[8 * fq + 4 * n + j] * 0.15915494309189535;
                                const float fr_ = (float)(tr - rint(tr));
                                const float cs = __builtin_amdgcn_cosf(fr_), sn = __builtin_amdgcn_sinf(fr_);
                                const float x1 = o1[n][j], x2 = o2[n][j];
                                o1[n][j] = x1 * cs - x2 * sn; o2[n][j] = x1 * sn + x2 * cs;
                            }
                    }
                    size_t ro;
                    if (pn < 2) {
#pragma unroll
                        for (int n = 0; n < 2; ++n)
#pragma unroll
                            for (int j = 0; j < 4; ++j) { o1[n][j] *= QSCALE; o2[n][j] *= QSCALE; }
                        ro = (size_t)row * 512 + cofs + 8 * fq;
                    } else {
                        const int bb = row >> 13, t = row & (S_ - 1);
                        ro = ((size_t)(bb * 2 + g) * S_ + t) * 64 + 8 * fq;
                    }
                    *(uint4*)&dst[ro] = pack8(o1[0], o1[1]);
                    *(uint4*)&dst[ro + 32] = pack8(o2[0], o2[1]);
                }
        } else if (pn == 4) {
            u16* dst = (wc < 2) ? p.vslT : p.vwnT;
            const int g = wc & 1;
#pragma unroll
            for (int ai = 0; ai < 2; ++ai) {
                const int r0 = rowb + ai * 128, bb = r0 >> 13, tb = r0 & (S_ - 1);
                u16* base = dst + ((size_t)(bb * 2 + g) * 128 + (tb >> 6)) * 4096;
#pragma unroll
                for (int m = 0; m < 4; ++m)
#pragma unroll
                    for (int bj = 0; bj < 2; ++bj)
#pragma unroll
                        for (int n = 0; n < 2; ++n)
#pragma unroll
                            for (int j = 0; j < 4; ++j)
                                base[(32 * bj + 8 * fq + 4 * n + j) * 64 + m * 16 + fr] = f2bf(acc[ai][bj][m][n][j]);
            }
        } else if (pn < 12) {
            const int cb = (pn - 5) * 256 + wc * 32 + 8 * fq;
#pragma unroll
            for (int ai = 0; ai < 2; ++ai)
#pragma unroll
                for (int m = 0; m < 4; ++m) {
                    const size_t ro = (size_t)(rowb + ai * 128 + m * 16 + fr) * CRW + cb;
#pragma unroll
                    for (int bj = 0; bj < 2; ++bj) *(uint4*)&p.prw[ro + bj * 128] = pack8(acc[ai][bj][m][0], acc[ai][bj][m][1]);
                }
        } else {
            if (wc == 0 && fq < 3) {
#pragma unroll
                for (int ai = 0; ai < 2; ++ai)
#pragma unroll
                    for (int m = 0; m < 4; ++m) {
                        const size_t ro = (size_t)(rowb + ai * 128 + m * 16 + fr) * 24 + 8 * fq;
#pragma unroll
                        for (int n = 0; n < 2; ++n) {
                            float4 o; o.x = sigmoidf_(acc[ai][0][m][n][0]); o.y = sigmoidf_(acc[ai][0][m][n][1]); o.z = sigmoidf_(acc[ai][0][m][n][2]); o.w = sigmoidf_(acc[ai][0][m][n][3]);
                            *(float4*)&p.nsag[ro + 4 * n] = o;
                        }
                    }
            }
        }
    }
};
__device__ void ph_inproj(const P& p, int bid, int nb, char* smem) {
    DenseSched S; S.init(NTOK, 3328, D_, p.winT, nb, bid);
    EpiInproj E{&p};
    gemm256(smem, (const char*)p.hbuf, D_, S, E);
}

__device__ __forceinline__ float gelu_tanh(float x) {
    const float c = 0.7978845608028654f;
    return 0.5f * x * (1.f + tanhf(c * (x + 0.044715f * x * x * x)));
}
__device__ void ph_compress(const P& p, int bid, int nb, char* smem) {
    u16* sm = (u16*)smem;
    const int tid = get_tid(), lane = tid & 63, wv = tid >> 6;
    const int wm = wv >> 1, wn = wv & 1;
    for (int it = bid; it < 32; it += nb) {
        const int rt = it & 1, g = (it >> 1) & 1, b = (it >> 2) & 3, kv = it >> 4;
        const int bg = b * 2 + g, i0 = rt * 256;
        const u16* src = (kv ? p.vc : p.kc) + (size_t)bg * S_ * 64;
        const u16* w1T = kv ? p.cw1Tv : p.cw1Tk;
        const u16* w2T = kv ? p.cw2Tv : p.cw2Tk;
        const float* cb1 = kv ? p.cb1v : p.cb1k;
        const float* b1 = kv ? p.b1_v : p.b1_k;
        const float* b2 = kv ? p.b2_v : p.b2_k;
        u16* hidp = p.chid + (size_t)it * 256 * 256;
        auto arow = [&](int r) { int i = i0 + r; if (i > 510) i = 510; return src + (size_t)i * 1024; };
#pragma unroll 1
        for (int ct = 0; ct < 2; ct++) {
            f32x4 acc[4][4];
            gemm_core<false>(2048, arow, w1T + (size_t)ct * 128 * 2048, 2048, acc, sm);
            const int le = get_tid() & 63;
#pragma unroll
            for (int mt = 0; mt < 4; mt++) {
                const int r = wm * 64 + mt * 16 + (le & 15);
#pragma unroll
                for (int nt = 0; nt < 4; nt++) {
                    const int col = ct * 128 + wn * 64 + nt * 16 + (le >> 4) * 4;
                    const float4 c1 = *(const float4*)&cb1[col], bb1 = *(const float4*)&b1[col];
                    f32x4 o;
                    o[0] = gelu_tanh(acc[mt][nt][0] + c1.x + bb1.x); o[1] = gelu_tanh(acc[mt][nt][1] + c1.y + bb1.y);
                    o[2] = gelu_tanh(acc[mt][nt][2] + c1.z + bb1.z); o[3] = gelu_tanh(acc[mt][nt][3] + c1.w + bb1.w);
                    *(uint2*)&hidp[r * 256 + col] = pack4(o);
                }
            }
        }
        __syncthreads();
        {
            f32x4 acc[4][4];
            gemm_core<true>(256, [&](int r) { return hidp + (size_t)r * 256; }, w2T, 256, acc, sm);
            if (wn == 0) {
#pragma unroll
                for (int mt = 0; mt < 4; mt++)
#pragma unroll
                    for (int nt = 0; nt < 4; nt++) {
                        const int d = nt * 16 + (lane & 15);
                        const int ib = i0 + wm * 64 + mt * 16 + (lane >> 4) * 4;
                        float o[4];
#pragma unroll
                        for (int j = 0; j < 4; j++) o[j] = (ib + j < NCMP) ? (acc[mt][nt][j] + b2[d]) : 0.f;
                        if (kv == 0) {
#pragma unroll
                            for (int j = 0; j < 4; j++) p.kcb[((size_t)bg * 512 + ib + j) * 64 + d] = f2bf(o[j]);
                        } else {
                            uint2 ov; ov.x = pack2(o[0], o[1]); ov.y = pack2(o[2], o[3]);
                            *(uint2*)&p.vcT[(((size_t)bg * 8 + (ib >> 6)) * 64 + d) * 64 + (ib & 63)] = ov;
                        }
                    }
            }
        }
        __syncthreads();
    }
}

constexpr int KSTR = 72;
struct Sub { f32x4 O[4]; float m, l; };
#define NEG_BIG (-1.0e30f)

__device__ __forceinline__ float xq_max(float v) {
    return xrow_max(v);
}
__device__ __forceinline__ float xq_sum(float v) {
    return xrow_sum(v);
}
template <bool MASK, bool IMP, bool PV>
__device__ __forceinline__ void nsa_visit(const u16* Ks, const u16* Vs, const u16* qrow, Sub& s, int lo, int hi, int lane, float* e, float* p3) {
    const int kr = lane & 15, qq = lane >> 4;
    f32x4 S[4];
    const int qsw = (kr & 3) >> 1;
    const bf16x8 qf0 = *(const bf16x8*)(qrow + ((qq ^ qsw) << 3)), qf1 = *(const bf16x8*)(qrow + (((4 + qq) ^ qsw) << 3));
    bf16x8 kf[4][2];
    const int swz = kr >> 1;
    {
        const char* kb_ = (const char*)Ks + kr * 128;
        const int ko0 = (qq ^ swz) << 4, ko1 = ko0 ^ 64;
#pragma unroll
        for (int kt = 0; kt < 4; kt++) { kf[kt][0] = *(const bf16x8*)(kb_ + kt * 2048 + ko0); kf[kt][1] = *(const bf16x8*)(kb_ + kt * 2048 + ko1); }
    }
    __builtin_amdgcn_sched_barrier(0);
#pragma unroll
    for (int kt = 0; kt < 4; kt++) {
        S[kt] = __builtin_amdgcn_mfma_f32_16x16x32_bf16(kf[kt][0], qf0, f32x4{0.f, 0.f, 0.f, 0.f}, 0, 0, 0);
        S[kt] = __builtin_amdgcn_mfma_f32_16x16x32_bf16(kf[kt][1], qf1, S[kt], 0, 0, 0);
    }
    union VF { bf16x8 v; uint2 h[2]; };
    float mx = NEG_BIG;
#pragma unroll
    for (int kt = 0; kt < 4; kt++)
#pragma unroll
        for (int r = 0; r < 4; r++) {
            if (MASK) { const int o = kt * 16 + qq * 4 + r; if (o < lo || o > hi) S[kt][r] = -INFINITY; }
            mx = fmaxf(mx, S[kt][r]);
        }
    mx = xq_max(mx);
    const float mnew = fmaxf(s.m, mx);
    const float alpha = __builtin_amdgcn_exp2f(s.m - mnew);
    s.m = mnew;
    float psum = 0.f;
#pragma unroll
    for (int kt = 0; kt < 4; kt++) {
#pragma unroll
        for (int r = 0; r < 4; r++) { S[kt][r] = __builtin_amdgcn_exp2f(S[kt][r] - mnew); }
        const float ee = (S[kt][0] + S[kt][1]) + (S[kt][2] + S[kt][3]);
        psum += ee;
        if (IMP) { e[kt] = ee; p3[kt] = S[kt][3]; }
    }
    s.l = s.l * alpha + psum;
    if (PV) {
        if (!__all(alpha == 1.f)) {
#pragma unroll
            for (int dt = 0; dt < 4; dt++)
#pragma unroll
                for (int r = 0; r < 4; r++) s.O[dt][r] *= alpha;
        }
        VF vf[4][2];
        {
            const char* vb_ = (const char*)Vs + kr * 128 + (qq & 1) * 8;
            const int vo = ((qq >> 1) ^ swz) << 4;
#pragma unroll
            for (int dt = 0; dt < 4; dt++)
#pragma unroll
                for (int k2 = 0; k2 < 2; k2++) {
                    vf[dt][k2].h[0] = *(const uint2*)(vb_ + dt * 2048 + (vo ^ (k2 * 64)));
                    vf[dt][k2].h[1] = *(const uint2*)(vb_ + dt * 2048 + (vo ^ (k2 * 64 + 32)));
                }
        }
        bf16x8 pb[2];
#pragma unroll
        for (int k2 = 0; k2 < 2; k2++) {
            union { bf16x8 v; unsigned u[4]; } t;
            t.u[0] = pack2(S[2 * k2][0], S[2 * k2][1]); t.u[1] = pack2(S[2 * k2][2], S[2 * k2][3]);
            t.u[2] = pack2(S[2 * k2 + 1][0], S[2 * k2 + 1][1]); t.u[3] = pack2(S[2 * k2 + 1][2], S[2 * k2 + 1][3]);
            pb[k2] = t.v;
        }
        __builtin_amdgcn_sched_barrier(0);
#pragma unroll
        for (int dt = 0; dt < 4; dt++)
#pragma unroll
            for (int k2 = 0; k2 < 2; k2++) s.O[dt] = __builtin_amdgcn_mfma_f32_16x16x32_bf16(vf[dt][k2].v, pb[k2], s.O[dt], 0, 0, 0);
    }
}
template <int MMODE>
__device__ __forceinline__ void nsa_visit_g(const u16* Ks, const u16* Vs, const u16* qs, float* Os, float* Ms, float* Ls, int tok, bool valid, int lane) {
    const int kr = lane & 15, qq = lane >> 4, hh = kr & 3;
    const int row = tok * 4 + hh;
    float* orow = Os + row * 64;
    f32x4 O[4];
#pragma unroll
    for (int dt = 0; dt < 4; dt++) O[dt] = *(const f32x4*)(orow + (((dt * 4 + qq) ^ hh) << 2));
    const float m_old = Ms[row], l_old = Ls[row];
    const u16* qrow = qs + row * 64;
    const int qsw = hh >> 1;
    const bf16x8 qf0 = *(const bf16x8*)(qrow + ((qq ^ qsw) << 3)), qf1 = *(const bf16x8*)(qrow + (((4 + qq) ^ qsw) << 3));
    bf16x8 kf[4][2];
    const int swz = kr >> 1;
    {
        const char* kb_ = (const char*)Ks + kr * 128;
        const int ko0 = (qq ^ swz) << 4, ko1 = ko0 ^ 64;
#pragma unroll
        for (int kt = 0; kt < 4; kt++) { kf[kt][0] = *(const bf16x8*)(kb_ + kt * 2048 + ko0); kf[kt][1] = *(const bf16x8*)(kb_ + kt * 2048 + ko1); }
    }
    __builtin_amdgcn_sched_barrier(0);
    f32x4 S[4];
#pragma unroll
    for (int kt = 0; kt < 4; kt++) {
        S[kt] = __builtin_amdgcn_mfma_f32_16x16x32_bf16(kf[kt][0], qf0, f32x4{0.f, 0.f, 0.f, 0.f}, 0, 0, 0);
        S[kt] = __builtin_amdgcn_mfma_f32_16x16x32_bf16(kf[kt][1], qf1, S[kt], 0, 0, 0);
    }
    union VF { bf16x8 v; uint2 h[2]; };
    VF vf[4][2];
    {
        const char* vb_ = (const char*)Vs + kr * 128 + (qq & 1) * 8;
        const int vo = ((qq >> 1) ^ swz) << 4;
#pragma unroll
        for (int dt = 0; dt < 4; dt++)
#pragma unroll
            for (int k2 = 0; k2 < 2; k2++) {
                vf[dt][k2].h[0] = *(const uint2*)(vb_ + dt * 2048 + (vo ^ (k2 * 64)));
                vf[dt][k2].h[1] = *(const uint2*)(vb_ + dt * 2048 + (vo ^ (k2 * 64 + 32)));
            }
    }
    float mx = NEG_BIG;
#pragma unroll
    for (int kt = 0; kt < 4; kt++)
#pragma unroll
        for (int r = 0; r < 4; r++) {
            if (MMODE == 1) { const int o = kt * 16 + qq * 4 + r; if (o > tok) S[kt][r] = -INFINITY; }
            if (MMODE == 2) { const int o = kt * 16 + qq * 4 + r; if (o <= tok) S[kt][r] = -INFINITY; }
            mx = fmaxf(mx, S[kt][r]);
        }
    if (!valid) mx = NEG_BIG;
    mx = xq_max(mx);
    const float mnew = fmaxf(m_old, mx);
    const float alpha = __builtin_amdgcn_exp2f(m_old - mnew);
    float psum = 0.f;
#pragma unroll
    for (int kt = 0; kt < 4; kt++) {
#pragma unroll
        for (int r = 0; r < 4; r++) { S[kt][r] = __builtin_amdgcn_exp2f(S[kt][r] - mnew); }
        psum += (S[kt][0] + S[kt][1]) + (S[kt][2] + S[kt][3]);
    }
    psum = xq_sum(psum);
    if (valid && qq == 0) { Ms[row] = mnew; Ls[row] = l_old * alpha + psum; }
#pragma unroll
    for (int dt = 0; dt < 4; dt++)
#pragma unroll
        for (int r = 0; r < 4; r++) O[dt][r] *= alpha;
    bf16x8 pb[2];
#pragma unroll
    for (int k2 = 0; k2 < 2; k2++) {
        union { bf16x8 v; unsigned u[4]; } t;
        t.u[0] = pack2(S[2 * k2][0], S[2 * k2][1]); t.u[1] = pack2(S[2 * k2][2], S[2 * k2][3]);
        t.u[2] = pack2(S[2 * k2 + 1][0], S[2 * k2 + 1][1]); t.u[3] = pack2(S[2 * k2 + 1][2], S[2 * k2 + 1][3]);
        pb[k2] = t.v;
    }
    __builtin_amdgcn_sched_barrier(0);
#pragma unroll
    for (int dt = 0; dt < 4; dt++)
#pragma unroll
        for (int k2 = 0; k2 < 2; k2++) O[dt] = __builtin_amdgcn_mfma_f32_16x16x32_bf16(vf[dt][k2].v, pb[k2], O[dt], 0, 0, 0);
    if (valid) {
#pragma unroll
        for (int dt = 0; dt < 4; dt++) *(f32x4*)(orow + (((dt * 4 + qq) ^ hh) << 2)) = O[dt];
    }
}
__device__ __forceinline__ void nsa_fold_lds(float* Os, float* Ms, float* Ls, int row, int qq, int hh, f32x4 (&T)[4], float gate, bool reset) {
    const float lt = Ls[row];
    const float sc = (lt > 0.f) ? gate / lt : 0.f;
#pragma unroll
    for (int dt = 0; dt < 4; dt++) {
        float* op = Os + row * 64 + (((dt * 4 + qq) ^ hh) << 2);
        const f32x4 o = *(const f32x4*)op;
#pragma unroll
        for (int r = 0; r < 4; r++) T[dt][r] += o[r] * sc;
        if (reset) *(f32x4*)op = f32x4{0.f, 0.f, 0.f, 0.f};
    }
    asm volatile("s_waitcnt lgkmcnt(0)" ::: "memory");
    if (reset && qq == 0) { Ms[row] = NEG_BIG; Ls[row] = 0.f; }
}
template <int MODE>
__device__ __forceinline__ void nsa_fold(Sub& s, f32x4 (&T)[4], float gate) {
    const float lt = xq_sum(s.l);
    const float sc = (lt > 0.f) ? gate / lt : 0.f;
#pragma unroll
    for (int dt = 0; dt < 4; dt++)
#pragma unroll
        for (int r = 0; r < 4; r++) {
            const float v = s.O[dt][r] * sc;
            T[dt][r] = (MODE == 1) ? T[dt][r] + v : v;
            s.O[dt][r] = 0.f;
        }
    s.m = NEG_BIG; s.l = 0.f;
}

constexpr int NSA_R = 3;
template <bool HASV, class KSrc, class VSrc, class Body>
__device__ __forceinline__ void nsa_stream(char* ring, int n, KSrc ksrc, VSrc vsrc, Body body) {
    const int t = get_tid();
    const int so = (t >> 3) * 64 + (((t & 7) ^ ((t >> 4) & 7)) << 3);
    char* dl = ring + t * 16;
#define NSA_ISSUE(i, slot) { glds16(ksrc(i) + so, dl + (slot) * 16384); if (HASV) glds16(vsrc(i) + so, dl + (slot) * 16384 + 8192); }
    asm volatile("s_waitcnt lgkmcnt(0)" ::: "memory");
    __builtin_amdgcn_s_barrier();
    if (n > 0) NSA_ISSUE(0, 0)
    if (n > 1) NSA_ISSUE(1, 1)
    int slot = 0;
    for (int i = 0; i < n; i++) {
        if (i + 1 < n) { if (HASV) asm volatile("s_waitcnt vmcnt(2)" ::: "memory"); else asm volatile("s_waitcnt vmcnt(1)" ::: "memory"); }
        else asm volatile("s_waitcnt vmcnt(0)" ::: "memory");
        asm volatile("s_waitcnt lgkmcnt(0)" ::: "memory");
        __builtin_amdgcn_s_barrier();
        asm volatile("" ::: "memory");
        const int sl2 = (slot == 0) ? 2 : slot - 1;
        if (i + 2 < n) NSA_ISSUE(i + 2, sl2)
        body(i, (const u16*)(ring + slot * 16384), (const u16*)(ring + slot * 16384 + 8192));
        slot = (slot == 2) ? 0 : slot + 1;
    }
#undef NSA_ISSUE
}
#define NSA_TOK(u) const int t3_ = get_tid(); const size_t ntk_ = (size_t)b * S_ + t0 + 8 * (t3_ >> 6) + 4 * (u) + ((t3_ & 15) >> 2); const int hd_ = g * 4 + (t3_ & 3);
__device__ void ph_nsa(const P& p, int bid, int nb, char* smem) {
    char* ring = smem;
    unsigned* selm = (unsigned*)(smem + NSA_R * 16384);
    int* blist = (int*)(selm + 256);
    int* nlistp = blist + 128;
    int* lcnt = nlistp + 4;
    unsigned char* lists = (unsigned char*)(lcnt + 128);
    float* Ms = (float*)(lists + 128 * 64);
    float* Ls = Ms + 256;
    float* Os = Ls + 256;
    float* impl = Os;
    u16* qs = (u16*)(Os + 64 * 4 * 64);
    const int nitems = B_ * 2 * 128;
    for (int it = bid; it < nitems; it += nb) {
        const int tid = get_tid(), lane = tid & 63, wv = tid >> 6;
        const int kr = lane & 15, qq = lane >> 4, ts = kr >> 2, hh = kr & 3;
        float* myimp = impl + wv * (32 * 2 * 16);
        const int tt = 127 - (it >> 3);
        const int bg = it & 7, b = bg >> 1, g = bg & 1;
        const int t0 = tt * 64, cur = tt;
        const int head = g * 4 + hh;
        Sub st[2];
        f32x4 T[2][4];
        int tl[2]; size_t ntok[2];
        __syncthreads();
#pragma unroll
        for (int u = 0; u < 2; u++) {
            tl[u] = 8 * wv + 4 * u + ts;
            ntok[u] = (size_t)b * S_ + t0 + tl[u];
#pragma unroll
            for (int ks = 0; ks < 2; ks++) *(bf16x8*)&qs[(tl[u] * 4 + hh) * 64 + (((ks * 4 + qq) ^ (hh >> 1)) << 3)] = *(const bf16x8*)&p.q[ntok[u] * 512 + head * 64 + ks * 32 + qq * 8];
#pragma unroll
            for (int dt = 0; dt < 4; dt++) st[u].O[dt] = f32x4{0.f, 0.f, 0.f, 0.f};
            st[u].m = NEG_BIG; st[u].l = 0.f;
        }
        const u16* kcb = p.kcb + (size_t)bg * 512 * 64;
        const u16* vcT = p.vcT + (size_t)bg * 8 * 4096;
        int nv[2];
#pragma unroll
        for (int u = 0; u < 2; u++) { const int t = t0 + tl[u]; nv[u] = (t >= 31) ? min((t - 31) / 16 + 1, NCMP) : 0; }
        const int tmax = t0 + 63;
        const int nvmax = (tmax >= 31) ? min((tmax - 31) / 16 + 1, NCMP) : 0;
        const int nvb = (nvmax + 63) >> 6;
        __syncthreads();
        nsa_stream<false>(ring, nvb, [&](int kb) { return kcb + (size_t)kb * 4096; }, [&](int kb) { return vcT + (size_t)kb * 4096; },
            [&](int kb, const u16* Ks, const u16* Vs) {
#pragma unroll
                for (int u = 0; u < 2; u++) nsa_visit<true, false, false>(Ks, Vs, qs + (tl[u] * 4 + hh) * 64, st[u], 0, nv[u] - kb * 64 - 1, lane, nullptr, nullptr);
            });
        float invl[2];
#pragma unroll
        for (int u = 0; u < 2; u++) { const float lt = xq_sum(st[u].l); invl[u] = (lt > 0.f) ? 1.f / lt : 0.f; st[u].l = 0.f; }
        float carry[2] = {0.f, 0.f};
        nsa_stream<true>(ring, nvb, [&](int kb) { return kcb + (size_t)kb * 4096; }, [&](int kb) { return vcT + (size_t)kb * 4096; },
            [&](int kb, const u16* Ks, const u16* Vs) {
#pragma unroll
            for (int u = 0; u < 2; u++) {
                float e[4], p3[4];
                nsa_visit<true, true, true>(Ks, Vs, qs + (tl[u] * 4 + hh) * 64, st[u], 0, nv[u] - kb * 64 - 1, lane, e, p3);
#pragma unroll
                for (int kt = 0; kt < 4; kt++) {
                    float ev = e[kt] * invl[u], pv = p3[kt] * invl[u];
                    ev += dppf<0xB1>(ev); ev += dppf<0x4E>(ev);
                    pv += dppf<0xB1>(pv); pv += dppf<0x4E>(pv);
                    const float sh = __shfl(pv, (lane - 16) & 63, 64);
                    const float nbv = (qq == 0) ? carry[u] : sh;
                    carry[u] = sh;
                    myimp[((kb * 4 + kt) * 2 + u) * 16 + ts * 4 + qq] = ev + nbv;
                }
            }
            });
#pragma unroll
        for (int u = 0; u < 2; u++) {
            float impv[32];
#pragma unroll
            for (int kk = 0; kk < 32; kk++) impv[kk] = (kk < nvb * 4) ? myimp[(kk * 2 + u) * 16 + ts * 4 + qq] : 0.f;
            unsigned cmask = 0u;
#pragma unroll
            for (int kk = 0; kk < 32; kk++) { const int j = 4 * kk + qq; if (j >= 1 && j <= cur - 2) cmask |= (1u << kk); }
            unsigned sel = 0u;
            const int ncand = max(0, cur - 2);
            const int nforced = (cur >= 2) ? 3 : (cur + 1);
            const int need = 16 - nforced;
            if (ncand <= need) sel = cmask;
            else {
                for (int rnd = 0; rnd < need; rnd++) {
                    float best = -1.f; int bk = 0;
#pragma unroll
                    for (int kk = 0; kk < 32; kk++) {
                        const float v = ((cmask >> kk) & 1u) ? impv[kk] : -1.f;
                        if (v > best) { best = v; bk = kk; }
                    }
                    int bj = (best >= 0.f) ? (4 * bk + qq) : 9999;
                    {
                        auto rv = __builtin_amdgcn_permlane16_swap(__float_as_uint(best), __float_as_uint(best), false, false);
                        auto rj = __builtin_amdgcn_permlane16_swap((unsigned)bj, (unsigned)bj, false, false);
                        float v0 = __uint_as_float(rv[0]), v1 = __uint_as_float(rv[1]); int j0 = (int)rj[0], j1 = (int)rj[1];
                        if (v1 > v0 || (v1 == v0 && j1 < j0)) { v0 = v1; j0 = j1; }
                        rv = __builtin_amdgcn_permlane32_swap(__float_as_uint(v0), __float_as_uint(v0), false, false);
                        rj = __builtin_amdgcn_permlane32_swap((unsigned)j0, (unsigned)j0, false, false);
                        best = __uint_as_float(rv[0]); bj = (int)rj[0];
                        const float v2 = __uint_as_float(rv[1]); const int j2 = (int)rj[1];
                        if (v2 > best || (v2 == best && j2 < bj)) { best = v2; bj = j2; }
                    }
                    if (bj < 512 && (bj & 3) == qq) { cmask &= ~(1u << (bj >> 2)); sel |= (1u << (bj >> 2)); }
                }
            }
            if (qq == 0) sel |= 1u;
            if ((cur & 3) == qq) sel |= (1u << (cur >> 2));
            if (cur >= 1 && ((cur - 1) & 3) == qq) sel |= (1u << ((cur - 1) >> 2));
            if (hh == 0) selm[tl[u] * 4 + qq] = sel;
        }
        __syncthreads();
#pragma unroll
        for (int u = 0; u < 2; u++) { NSA_TOK(u) nsa_fold<0>(st[u], T[u], p.nsag[ntk_ * 24 + hd_ * 3 + 0]); }
        {
            const int t2 = get_tid();
#pragma unroll
            for (int i = 0; i < 8; i++) *(f32x4*)&Os[(i * NT + t2) * 4] = f32x4{0.f, 0.f, 0.f, 0.f};
            if (t2 < 256) { Ms[t2] = NEG_BIG; Ls[t2] = 0.f; }
            unsigned long long tm = 0ull; int lrank = 0;
            if (t2 < 128) {
                const int j = t2;
                for (int tk = 0; tk < 64; tk++) tm |= (unsigned long long)((selm[tk * 4 + (j & 3)] >> (j >> 2)) & 1u) << tk;
                if (j > cur) tm = 0ull;
                const unsigned long long bal = __ballot(tm != 0ull);
                lrank = __popcll(bal & ((1ull << (t2 & 63)) - 1ull));
                if ((t2 & 63) == 0) nlistp[t2 >> 6] = __popcll(bal);
            }
            __syncthreads();
            if (t2 < 128 && tm != 0ull) {
                const int pos = lrank + ((t2 >= 64) ? nlistp[0] : 0);
                blist[pos] = t2; lcnt[pos] = __popcll(tm);
                int c = 0;
                while (tm) { lists[pos * 64 + c] = (unsigned char)(__ffsll((long long)tm) - 1); c++; tm &= tm - 1ull; }
            }
            __syncthreads();
        }
        const int nlist = nlistp[0] + nlistp[1];
        const u16* ksl = p.ksl + (size_t)bg * S_ * 64;
        const u16* vslT = p.vslT + (size_t)bg * 128 * 4096;
        {
            const int t4 = get_tid(), wv4 = __builtin_amdgcn_readfirstlane(t4 >> 6), ts4 = (t4 & 15) >> 2;
            const int td = t4 & 255;
            const int so = (td >> 3) * 64 + (((td & 7) ^ ((td >> 4) & 7)) << 3);
            char* dl = ring + td * 16;
#define NSA_ISSUE2(i, slot) if (wv4 >= 4) { const int jj_ = blist[i]; const u16* kp_ = ksl + (size_t)jj_ * 4096 + so; const u16* vp_ = vslT + (size_t)jj_ * 4096 + so; char* d_ = dl + (slot) * 16384; \
                glds16(kp_, d_); glds16(kp_ + 2048, d_ + 4096); glds16(vp_, d_ + 8192); glds16(vp_ + 2048, d_ + 12288); }
            asm volatile("s_waitcnt lgkmcnt(0)" ::: "memory");
            __builtin_amdgcn_s_barrier();
            if (nlist > 0) NSA_ISSUE2(0, 0)
            if (nlist > 1) NSA_ISSUE2(1, 1)
            int jn = 0, nn = 0, tokn = 0;
            if (nlist > 0) { jn = blist[0]; nn = lcnt[0]; tokn = lists[wv4 * 4 + ts4]; }
            int slot = 0;
            for (int i = 0; i < nlist; i++) {
                if (i + 1 < nlist) asm volatile("s_waitcnt vmcnt(4)" ::: "memory"); else asm volatile("s_waitcnt vmcnt(0)" ::: "memory");
                asm volatile("s_waitcnt lgkmcnt(0)" ::: "memory");
                __builtin_amdgcn_s_barrier();
                asm volatile("" ::: "memory");
                const int sl2 = (slot == 0) ? 2 : slot - 1;
                if (i + 2 < nlist) NSA_ISSUE2(i + 2, sl2)
                const int j = jn, n = nn, tok0 = tokn;
                if (i + 1 < nlist) { jn = blist[i + 1]; nn = lcnt[i + 1]; tokn = lists[(i + 1) * 64 + wv4 * 4 + ts4]; }
                const u16* Ks = (const u16*)(ring + slot * 16384); const u16* Vs = Ks + 4096;
                for (int qd = wv4; qd * 4 < n; qd += NW) {
                    const int e = qd * 4 + ts4;
                    const bool valid = e < n;
                    int tok = (qd == wv4) ? tok0 : (int)lists[i * 64 + (e & 63)];
                    if (!valid) tok = 0;
                    if (j == cur) nsa_visit_g<1>(Ks, Vs, qs, Os, Ms, Ls, tok, valid, t4 & 63);
                    else nsa_visit_g<0>(Ks, Vs, qs, Os, Ms, Ls, tok, valid, t4 & 63);
                }
                slot = (slot == 2) ? 0 : slot + 1;
            }
#undef NSA_ISSUE2
        }
        __syncthreads();
#pragma unroll
        for (int u = 0; u < 2; u++) {
            NSA_TOK(u)
            const int t5 = t3_ & 63;
            nsa_fold_lds(Os, Ms, Ls, (8 * (t3_ >> 6) + 4 * u + ((t5 & 15) >> 2)) * 4 + (t5 & 3), t5 >> 4, t5 & 3, T[u], p.nsag[ntk_ * 24 + hd_ * 3 + 1], true);
        }
        const u16* kwn = p.kwn + (size_t)bg * S_ * 64;
        const u16* vwnT = p.vwnT + (size_t)bg * 128 * 4096;
        {
            const int jlo = max(0, cur - 8);
            nsa_stream<true>(ring, cur - jlo + 1, [&](int i) { return kwn + (size_t)(jlo + i) * 4096; }, [&](int i) { return vwnT + (size_t)(jlo + i) * 4096; },
                [&](int i, const u16* Ks, const u16* Vs) {
                    const int j = jlo + i;
                    const int t4 = get_tid();
#pragma unroll
                    for (int u = 0; u < 2; u++) {
                        const int tok = 8 * (t4 >> 6) + 4 * u + ((t4 & 15) >> 2);
                        if (j == cur) nsa_visit_g<1>(Ks, Vs, qs, Os, Ms, Ls, tok, true, t4 & 63);
                        else if (j == cur - 8) nsa_visit_g<2>(Ks, Vs, qs, Os, Ms, Ls, tok, true, t4 & 63);
                        else nsa_visit_g<0>(Ks, Vs, qs, Os, Ms, Ls, tok, true, t4 & 63);
                    }
                });
        }
#pragma unroll
        for (int u = 0; u < 2; u++) {
            NSA_TOK(u)
            { const int t5 = t3_ & 63; nsa_fold_lds(Os, Ms, Ls, (8 * (t3_ >> 6) + 4 * u + ((t5 & 15) >> 2)) * 4 + (t5 & 3), t5 >> 4, t5 & 3, T[u], p.nsag[ntk_ * 24 + hd_ * 3 + 2], false); }
#pragma unroll
            for (int dt = 0; dt < 4; dt++) *(uint2*)&p.oa[ntk_ * 512 + hd_ * 64 + dt * 16 + ((t3_ & 63) >> 4) * 4] = pack4(T[u][dt]);
        }
    }
}

constexpr int RS = 72;
constexpr int RSLOT = 64 * RS;
__device__ __forceinline__ void mm64(const u16* A, int lda, const u16* Bz, int ldb, f32x4 (&acc)[2], int lane, int wv) {
    const int mt = wv >> 1, nt0 = (wv & 1) * 2, kr = lane & 15, qq = lane >> 4;
    bf16x8 a[2], b[2][2];
#pragma unroll
    for (int ks = 0; ks < 2; ks++) {
        a[ks] = *(const bf16x8*)&A[(mt * 16 + kr) * lda + ks * 32 + qq * 8];
#pragma unroll
        for (int i = 0; i < 2; i++) b[ks][i] = *(const bf16x8*)&Bz[((nt0 + i) * 16 + kr) * ldb + ks * 32 + qq * 8];
    }
#pragma unroll
    for (int ks = 0; ks < 2; ks++)
#pragma unroll
        for (int i = 0; i < 2; i++) acc[i] = __builtin_amdgcn_mfma_f32_16x16x32_bf16(a[ks], b[ks][i], acc[i], 0, 0, 0);
}
__device__ __forceinline__ void st_t(u16* dst, int ld, const f32x4& v, int mt, int nt, int lane) {
    uint2 o; o.x = pack2(v[0], v[1]); o.y = pack2(v[2], v[3]);
    *(uint2*)&dst[(nt * 16 + (lane & 15)) * ld + mt * 16 + (lane >> 4) * 4] = o;
}
__device__ __forceinline__ void st_n(u16* dst, int ld, const f32x4& v, int mt, int nt, int lane) {
#pragma unroll
    for (int r = 0; r < 4; r++) dst[(mt * 16 + (lane >> 4) * 4 + r) * ld + nt * 16 + (lane & 15)] = f2bf(v[r]);
}
#define ZACC(a) { a[0] = f32x4{0.f, 0.f, 0.f, 0.f}; a[1] = f32x4{0.f, 0.f, 0.f, 0.f}; }

__device__ void ph_rwkv_chunk(const P& p, int bid, int nb, char* smem) {
    u16* sl = (u16*)smem;
    float* tot = (float*)(sl + 14 * RSLOT);
    float* gl = tot + 512;
#define RW_IDX const int tid = get_tid(), lane = tid & 63, wv = tid >> 6, mt = wv >> 1, nt0 = (wv & 1) * 2, kr = lane & 15, qq = lane >> 4; (void)mt; (void)nt0; (void)kr; (void)qq; (void)lane;
    const int nitems = B_ * 128;
    for (int it0 = bid; it0 < nitems; it0 += nb) {
      const int c = it0 & 127, b = it0 >> 7;
      const size_t n0 = (size_t)b * S_ + c * 64;
      __syncthreads();
      {
          RW_IDX
          const int t = tid >> 3, part = tid & 7;
          const size_t n = n0 + t;
          const bool hasprev = (c * 64 + t) > 0;
          u16* dst = p.xact + n * 256 + part * 32;
#pragma unroll
          for (int j = 0; j < 4; j++) {
              const int col = 1536 + part * 32 + j * 8;
              const uint4 cu = *(const uint4*)&p.prw[n * CRW + col];
              uint4 pv = make_uint4(0u, 0u, 0u, 0u);
              if (hasprev) pv = *(const uint4*)&p.prw[(n - 1) * CRW + col];
              const unsigned cw[4] = {cu.x, cu.y, cu.z, cu.w}, pw[4] = {pv.x, pv.y, pv.z, pv.w};
              unsigned ow[4];
#pragma unroll
              for (int e2 = 0; e2 < 4; e2++) {
                  float x0 = __uint_as_float(cw[e2] << 16), x1 = __uint_as_float(cw[e2] & 0xFFFF0000u);
                  const float q0 = __uint_as_float(pw[e2] << 16), q1 = __uint_as_float(pw[e2] & 0xFFFF0000u);
                  x0 = x0 + (q0 - x0) * p.mu[col + 2 * e2]; x1 = x1 + (q1 - x1) * p.mu[col + 2 * e2 + 1];
                  if (part < 2) { x0 = tanhf(x0); x1 = tanhf(x1); }
                  else if (part >= 4) { x0 = sigmoidf_(x0); x1 = sigmoidf_(x1); }
                  ow[e2] = pack2(x0, x1);
              }
              *(uint4*)&dst[j * 8] = make_uint4(ow[0], ow[1], ow[2], ow[3]);
          }
      }
      __syncthreads();
      const u16* xa = p.xact + n0 * 256;
#pragma unroll 1
      for (int h = 0; h < 8; h++) {
        u16* cd = p.cdat + ((size_t)((b * 8 + h) * 128 + c)) * 4 * 4096;
        LDS_BARRIER();
        float* LW = (float*)(sl + 8 * RSLOT); float* LA = (float*)(sl + 10 * RSLOT);
        {
            RW_IDX
            bf16x8 xa_[8], wb[2][2], ab[2][2], gb[2][4];
#pragma unroll
            for (int k8 = 0; k8 < 8; k8++) xa_[k8] = *(const bf16x8*)&xa[(mt * 16 + kr) * 256 + k8 * 32 + qq * 8];
#pragma unroll
            for (int i = 0; i < 2; i++) {
                const int cc = (nt0 + i) * 16 + kr;
#pragma unroll
                for (int ks = 0; ks < 2; ks++) {
                    wb[i][ks] = *(const bf16x8*)&p.w2T[((size_t)h * 64 + cc) * 64 + ks * 32 + qq * 8];
                    ab[i][ks] = *(const bf16x8*)&p.a2T[((size_t)h * 64 + cc) * 64 + ks * 32 + qq * 8];
                }
#pragma unroll
                for (int ks = 0; ks < 4; ks++) gb[i][ks] = *(const bf16x8*)&p.g2T[((size_t)h * 64 + cc) * 128 + ks * 32 + qq * 8];
            }
            f32x4 aw[2], aa2[2], ag[2];
#pragma unroll
            for (int i = 0; i < 2; i++) {
                aw[i] = f32x4{0.f, 0.f, 0.f, 0.f}; aa2[i] = aw[i]; ag[i] = aw[i];
#pragma unroll
                for (int ks = 0; ks < 2; ks++) {
                    aw[i] = __builtin_amdgcn_mfma_f32_16x16x32_bf16(xa_[ks], wb[i][ks], aw[i], 0, 0, 0);
                    aa2[i] = __builtin_amdgcn_mfma_f32_16x16x32_bf16(xa_[2 + ks], ab[i][ks], aa2[i], 0, 0, 0);
                }
#pragma unroll
                for (int ks = 0; ks < 4; ks++) ag[i] = __builtin_amdgcn_mfma_f32_16x16x32_bf16(xa_[4 + ks], gb[i][ks], ag[i], 0, 0, 0);
            }
#pragma unroll
            for (int i = 0; i < 2; i++)
#pragma unroll
                for (int r = 0; r < 4; r++) {
                    const int t = mt * 16 + qq * 4 + r, cc = (nt0 + i) * 16 + kr;
                    const float wl = p.w0[h * 64 + cc] + aw[i][r];
                    const float z = -wl;
                    const float sp = fmaxf(z, 0.f) + log1pf(__expf(-fabsf(z)));
                    LW[t * 64 + cc] = -__expf(-sp - 0.5f);
                    LA[t * 64 + cc] = sigmoidf_(p.a0[h * 64 + cc] + aa2[i][r]);
                    p.ob[(n0 + t) * 512 + h * 64 + cc] = f2bf(ag[i][r]);
                }
        }
        LDS_BARRIER();
        {
            RW_IDX
            const int ch = h * 64 + lane;
            const float mur = p.mu[ch], muk = p.mu[512 + ch], muv = p.mu[1024 + ch];
            const float kkw = p.k_k[ch], kaw = p.k_a[ch], rkw = p.r_k[ch];
            float rr[8], k2[8], vv[8], kkn[8], aa[8], lg[8], cs[8];
            float run = 0.f;
#pragma unroll
            for (int i = 0; i < 8; i++) {
                const int t = wv * 8 + i; const size_t n = n0 + t;
                const u16* cr = p.prw + n * CRW;
                float r = bf2f(cr[ch]), k = bf2f(cr[512 + ch]), v = bf2f(cr[1024 + ch]);
                float pr = 0.f, pk = 0.f, pv = 0.f;
                if (c * 64 + t > 0) { const u16* pp = cr - CRW; pr = bf2f(pp[ch]); pk = bf2f(pp[512 + ch]); pv = bf2f(pp[1024 + ch]); }
                r = r + (pr - r) * mur; k = k + (pk - k) * muk; v = v + (pv - v) * muv;
                const float a = LA[t * 64 + lane];
                lg[i] = LW[t * 64 + lane];
                float kk = k * kkw;
                const float nrm = fmaxf(sqrtf(wave_sum(kk * kk)), 1e-12f);
                kkn[i] = kk / nrm;
                k2[i] = k * (1.f + (a - 1.f) * kaw);
                const float bon = wave_sum(r * k2[i] * rkw);
                if (lane == 0) p.bon[n * 8 + h] = bon;
                rr[i] = r; vv[i] = v; aa[i] = a;
                run += lg[i]; cs[i] = run;
            }
            tot[wv * 64 + lane] = run;
            LDS_BARRIER();
            float off = 0.f, cumL = 0.f;
#pragma unroll
            for (int w2 = 0; w2 < 8; w2++) { const float tv = tot[w2 * 64 + lane]; cumL += tv; if (w2 < wv) off += tv; }
            if (wv == 0) gl[lane] = __expf(cumL);
            unsigned pa[4], pb[4], pk4[4], pv4[4];
#pragma unroll
            for (int i = 0; i < 8; i += 2) {
                float at[2], bt[2], kt[2], rt[2];
#pragma unroll
                for (int e2 = 0; e2 < 2; e2++) {
                    const int ii = i + e2; const int t = wv * 8 + ii;
                    const float cm = off + cs[ii];
                    const float g = __expf(cm), gp = __expf(cm - lg[ii]), gi = __expf(-cm);
                    at[e2] = -kkn[ii] * gp; bt[e2] = kkn[ii] * aa[ii] * gi; kt[e2] = k2[ii] * gi; rt[e2] = rr[ii] * g;
                    sl[0 * RSLOT + t * RS + lane] = f2bf(at[e2]);
                    sl[1 * RSLOT + t * RS + lane] = f2bf(bt[e2]);
                    sl[2 * RSLOT + t * RS + lane] = f2bf(kt[e2]);
                    sl[3 * RSLOT + t * RS + lane] = f2bf(rt[e2]);
                }
                pa[i >> 1] = pack2(at[0], at[1]); pb[i >> 1] = pack2(bt[0], bt[1]);
                pk4[i >> 1] = pack2(kt[0], kt[1]); pv4[i >> 1] = pack2(vv[i], vv[i + 1]);
            }
            *(uint4*)&sl[4 * RSLOT + lane * RS + wv * 8] = make_uint4(pa[0], pa[1], pa[2], pa[3]);
            *(uint4*)&sl[5 * RSLOT + lane * RS + wv * 8] = make_uint4(pb[0], pb[1], pb[2], pb[3]);
            *(uint4*)&sl[6 * RSLOT + lane * RS + wv * 8] = make_uint4(pk4[0], pk4[1], pk4[2], pk4[3]);
            *(uint4*)&sl[7 * RSLOT + lane * RS + wv * 8] = make_uint4(pv4[0], pv4[1], pv4[2], pv4[3]);
        }
        LDS_BARRIER();
        {
            RW_IDX
            f32x4 acc[2];
            ZACC(acc); mm64(sl + 1 * RSLOT, RS, sl + 0 * RSLOT, RS, acc, lane, wv);
#pragma unroll
            for (int i = 0; i < 2; i++) {
                f32x4 pm;
#pragma unroll
                for (int r = 0; r < 4; r++) {
                    const int m = mt * 16 + qq * 4 + r, n = (nt0 + i) * 16 + kr;
                    if (!(m < n)) acc[i][r] = 0.f;
                    pm[r] = acc[i][r] + ((m == n) ? 1.f : 0.f);
                }
                st_t(sl + 8 * RSLOT, RS, acc[i], mt, nt0 + i, lane);
                st_n(sl + 9 * RSLOT, RS, acc[i], mt, nt0 + i, lane);
                st_t(sl + 13 * RSLOT, RS, pm, mt, nt0 + i, lane);
            }
            ZACC(acc); mm64(sl + 0 * RSLOT, RS, sl + 2 * RSLOT, RS, acc, lane, wv);
#pragma unroll
            for (int i = 0; i < 2; i++) {
#pragma unroll
                for (int r = 0; r < 4; r++) { const int m = mt * 16 + qq * 4 + r, n = (nt0 + i) * 16 + kr; if (!(m > n)) acc[i][r] = 0.f; }
                st_t(sl + 10 * RSLOT, RS, acc[i], mt, nt0 + i, lane);
            }
            ZACC(acc); mm64(sl + 1 * RSLOT, RS, sl + 3 * RSLOT, RS, acc, lane, wv);
#pragma unroll
            for (int i = 0; i < 2; i++) {
#pragma unroll
                for (int r = 0; r < 4; r++) { const int m = mt * 16 + qq * 4 + r, n = (nt0 + i) * 16 + kr; if (m > n) acc[i][r] = 0.f; }
                st_t(sl + 11 * RSLOT, RS, acc[i], mt, nt0 + i, lane);
            }
            ZACC(acc); mm64(sl + 2 * RSLOT, RS, sl + 3 * RSLOT, RS, acc, lane, wv);
#pragma unroll
            for (int i = 0; i < 2; i++) {
#pragma unroll
                for (int r = 0; r < 4; r++) { const int m = mt * 16 + qq * 4 + r, n = (nt0 + i) * 16 + kr; if (m > n) acc[i][r] = 0.f; }
                st_t(sl + 12 * RSLOT, RS, acc[i], mt, nt0 + i, lane);
            }
        }
        LDS_BARRIER();
        u16* X = sl + 8 * RSLOT; u16* XT = sl + 9 * RSLOT; u16* X2 = sl + 0 * RSLOT; u16* X2T = sl + 1 * RSLOT;
        u16* Pc = sl + 13 * RSLOT; u16* Pn = sl + 2 * RSLOT;
#pragma unroll 1
        for (int j = 1; j <= 6; j++) {
            RW_IDX
            f32x4 acc[2];
            if (j <= 5) {
                ZACC(acc); mm64(X, RS, XT, RS, acc, lane, wv);
#pragma unroll
                for (int i = 0; i < 2; i++) { st_t(X2T, RS, acc[i], mt, nt0 + i, lane); st_n(X2, RS, acc[i], mt, nt0 + i, lane); }
            }
            if (j >= 2) {
                ZACC(acc); mm64(XT, RS, Pc, RS, acc, lane, wv);
#pragma unroll
                for (int i = 0; i < 2; i++) {
                    const uint2 pv = *(const uint2*)&Pc[((nt0 + i) * 16 + kr) * RS + mt * 16 + qq * 4];
                    acc[i][0] += __uint_as_float(pv.x << 16); acc[i][1] += __uint_as_float(pv.x & 0xFFFF0000u);
                    acc[i][2] += __uint_as_float(pv.y << 16); acc[i][3] += __uint_as_float(pv.y & 0xFFFF0000u);
                    st_t(Pn, RS, acc[i], mt, nt0 + i, lane);
                }
            }
            LDS_BARRIER();
            if (j >= 2) { u16* tp = Pc; Pc = Pn; Pn = tp; }
            if (j <= 5) { u16* tx = X; X = X2; X2 = tx; tx = XT; XT = X2T; X2T = tx; }
        }
        u16* TT = Pc;
        {
            RW_IDX
            f32x4 acc[2];
            ZACC(acc); mm64(TT, RS, sl + 4 * RSLOT, RS, acc, lane, wv);
#pragma unroll
            for (int i = 0; i < 2; i++) st_t(sl + 0 * RSLOT, RS, acc[i], mt, nt0 + i, lane);
            ZACC(acc); mm64(sl + 10 * RSLOT, RS, TT, RS, acc, lane, wv);
#pragma unroll
            for (int i = 0; i < 2; i++) st_t(sl + 8 * RSLOT, RS, acc[i], mt, nt0 + i, lane);
        }
        LDS_BARRIER();
        {
            RW_IDX
            f32x4 acc[2];
            ZACC(acc); mm64(sl + 8 * RSLOT, RS, sl + 7 * RSLOT, RS, acc, lane, wv);
#pragma unroll
            for (int i = 0; i < 2; i++) st_t(sl + 9 * RSLOT, RS, acc[i], mt, nt0 + i, lane);
            ZACC(acc); mm64(sl + 0 * RSLOT, RS, sl + 5 * RSLOT, RS, acc, lane, wv);
#pragma unroll
            for (int i = 0; i < 2; i++) {
                const int n = (nt0 + i) * 16 + kr; const float gn = gl[n];
#pragma unroll
                for (int r = 0; r < 4; r++) { const int m = mt * 16 + qq * 4 + r; acc[i][r] = acc[i][r] * gn + ((m == n) ? gn : 0.f); }
                st_t(cd, 64, acc[i], mt, nt0 + i, lane);
            }
            ZACC(acc); mm64(sl + 0 * RSLOT, RS, sl + 11 * RSLOT, RS, acc, lane, wv);
#pragma unroll
            for (int i = 0; i < 2; i++) {
                const uint2 rv = *(const uint2*)&sl[3 * RSLOT + ((nt0 + i) * 16 + kr) * RS + mt * 16 + qq * 4];
                acc[i][0] += __uint_as_float(rv.x << 16); acc[i][1] += __uint_as_float(rv.x & 0xFFFF0000u);
                acc[i][2] += __uint_as_float(rv.y << 16); acc[i][3] += __uint_as_float(rv.y & 0xFFFF0000u);
                st_t(cd + 2 * 4096, 64, acc[i], mt, nt0 + i, lane);
            }
        }
        LDS_BARRIER();
        {
            RW_IDX
            f32x4 acc[2];
            ZACC(acc);
            mm64(sl + 5 * RSLOT, RS, sl + 9 * RSLOT, RS, acc, lane, wv);
            mm64(sl + 6 * RSLOT, RS, sl + 7 * RSLOT, RS, acc, lane, wv);
#pragma unroll
            for (int i = 0; i < 2; i++) {
#pragma unroll
                for (int r = 0; r < 4; r++) acc[i][r] *= gl[mt * 16 + qq * 4 + r];
                st_t(cd + 1 * 4096, 64, acc[i], mt, nt0 + i, lane);
            }
            ZACC(acc);
            mm64(sl + 9 * RSLOT, RS, sl + 11 * RSLOT, RS, acc, lane, wv);
            mm64(sl + 7 * RSLOT, RS, sl + 12 * RSLOT, RS, acc, lane, wv);
#pragma unroll
            for (int i = 0; i < 2; i++) st_t(cd + 3 * 4096, 64, acc[i], mt, nt0 + i, lane);
        }
      }
    }
}

__device__ void ph_rwkv_seq(const P& p, int bid, int nb, char* smem) {
    u16* SL = (u16*)smem;
    const int tid = get_tid(), lane = tid & 63, wv = __builtin_amdgcn_readfirstlane(tid >> 6);
    const int kr = lane & 15, qq = lane >> 4, chn = wv >> 2, vt = wv & 3;
    for (int pair = bid; pair < B_ * 4; pair += nb) {
        const int bh = pair * 2 + chn;
        u16* mySL = SL + chn * RSLOT;
        __syncthreads();
#pragma unroll
        for (int ks = 0; ks < 2; ks++) *(uint4*)&mySL[(vt * 16 + kr) * RS + ks * 32 + qq * 8] = make_uint4(0u, 0u, 0u, 0u);
        u16* cbase = p.cdat + (size_t)bh * 128 * 4 * 4096;
        bf16x8 GA0[4][2], GA1[4][2], GA2[4][2], GA3[4][2]; uint2 H0[4], H1[4], H2[4], H3[4];
#define SEQ_LD(GAx, Hx, c) { const u16* cd_ = cbase + (size_t)(c) * 4 * 4096; \
            _Pragma("unroll") for (int m4 = 0; m4 < 4; m4++) { \
                _Pragma("unroll") for (int ks = 0; ks < 2; ks++) GAx[m4][ks] = *(const bf16x8*)&cd_[(m4 * 16 + kr) * 64 + ks * 32 + qq * 8]; \
                Hx[m4] = *(const uint2*)&cd_[1 * 4096 + (vt * 16 + kr) * 64 + m4 * 16 + qq * 4]; } }
#define SEQ_STEP(GAx, Hx, c) { \
            bf16x8 Z0[2]; \
            _Pragma("unroll") for (int ks = 0; ks < 2; ks++) Z0[ks] = *(const bf16x8*)&mySL[(vt * 16 + kr) * RS + ks * 32 + qq * 8]; \
            f32x4 zs[4]; \
            _Pragma("unroll") for (int m4 = 0; m4 < 4; m4++) { \
                zs[m4] = unpack4(Hx[m4]); \
                _Pragma("unroll") for (int ks = 0; ks < 2; ks++) zs[m4] = __builtin_amdgcn_mfma_f32_16x16x32_bf16(GAx[m4][ks], Z0[ks], zs[m4], 0, 0, 0); } \
            u16* sn_ = cbase + (size_t)(c) * 4 * 4096 + 1 * 4096 + (vt * 16 + kr) * 64 + qq * 4; \
            _Pragma("unroll") for (int m4 = 0; m4 < 4; m4++) { \
                const uint2 pk_ = pack4(zs[m4]); \
                *(uint2*)&mySL[(vt * 16 + kr) * RS + m4 * 16 + qq * 4] = pk_; \
                *(uint2*)&sn_[m4 * 16] = pk_; } \
            if ((c) + 4 < 128) SEQ_LD(GAx, Hx, (c) + 4) }
        SEQ_LD(GA0, H0, 0) SEQ_LD(GA1, H1, 1) SEQ_LD(GA2, H2, 2) SEQ_LD(GA3, H3, 3)
#pragma unroll 1
        for (int c = 0; c < 128; c += 4) {
            SEQ_STEP(GA0, H0, c)
            SEQ_STEP(GA1, H1, c + 1)
            SEQ_STEP(GA2, H2, c + 2)
            SEQ_STEP(GA3, H3, c + 3)
        }
#undef SEQ_LD
#undef SEQ_STEP
    }
}

__device__ void ph_rwkv_out(const P& p, int bid, int nb, char* smem) {
    const int tid = get_tid(), lane = tid & 63, wv = tid >> 6;
    const int kr = lane & 15, qq = lane >> 4;
    for (int it = bid * NW + wv; it < B_ * 8 * 128; it += nb * NW) {
        const int c = it & 127, bh = it >> 7, b = bh >> 3, h = bh & 7;
        const u16* cd = p.cdat + ((size_t)bh * 128 + c) * 4 * 4096;
        f32x4 ys[4][4];
#pragma unroll
        for (int mt = 0; mt < 4; mt++)
#pragma unroll
            for (int nt = 0; nt < 4; nt++) ys[mt][nt] = unpack4(*(const uint2*)&cd[3 * 4096 + (nt * 16 + kr) * 64 + mt * 16 + qq * 4]);
        if (c > 0) {
            const u16* s0 = cd - 4 * 4096 + 1 * 4096;
#pragma unroll
            for (int ks = 0; ks < 2; ks++) {
                bf16x8 af[4], bq[4];
#pragma unroll
                for (int mt = 0; mt < 4; mt++) af[mt] = *(const bf16x8*)&s0[(mt * 16 + kr) * 64 + ks * 32 + qq * 8];
#pragma unroll
                for (int nt = 0; nt < 4; nt++) bq[nt] = *(const bf16x8*)&cd[2 * 4096 + (nt * 16 + kr) * 64 + ks * 32 + qq * 8];
#pragma unroll
                for (int mt = 0; mt < 4; mt++)
#pragma unroll
                    for (int nt = 0; nt < 4; nt++) ys[mt][nt] = __builtin_amdgcn_mfma_f32_16x16x32_bf16(af[mt], bq[nt], ys[mt][nt], 0, 0, 0);
            }
        }
#pragma unroll
        for (int nt = 0; nt < 4; nt++) {
            float s1 = 0.f, s2 = 0.f;
#pragma unroll
            for (int mt = 0; mt < 4; mt++)
#pragma unroll
                for (int r = 0; r < 4; r++) { s1 += ys[mt][nt][r]; s2 += ys[mt][nt][r] * ys[mt][nt][r]; }
            s1 = xrow_sum(s1); s2 = xrow_sum(s2);
            const float mean = s1 * (1.f / 64.f);
            const float var = fmaxf(s2 * (1.f / 64.f) - mean * mean, 0.f);
            const float rstd = rsqrtf(var + 64e-5f);
            const int t = nt * 16 + kr;
            const size_t n = (size_t)b * S_ + c * 64 + t;
            const float bon = p.bon[n * 8 + h];
#pragma unroll
            for (int mt = 0; mt < 4; mt++) {
                const int vch = h * 64 + mt * 16 + qq * 4;
                const f32x4 vcf = unpack4(*(const uint2*)&p.prw[n * CRW + 1024 + vch]);
                const f32x4 vpf = (c * 64 + t > 0) ? unpack4(*(const uint2*)&p.prw[(n - 1) * CRW + 1024 + vch]) : f32x4{0.f, 0.f, 0.f, 0.f};
                const f32x4 ggf = unpack4(*(const uint2*)&p.ob[n * 512 + vch]);
                const float4 lw = *(const float4*)&p.ln_w[vch], lb = *(const float4*)&p.ln_b[vch], mv = *(const float4*)&p.mu[1024 + vch];
                const float lwa[4] = {lw.x, lw.y, lw.z, lw.w}, lba[4] = {lb.x, lb.y, lb.z, lb.w}, mva[4] = {mv.x, mv.y, mv.z, mv.w};
                f32x4 o;
#pragma unroll
                for (int r = 0; r < 4; r++) {
                    const float vsh = vcf[r] + (vpf[r] - vcf[r]) * mva[r];
                    o[r] = ((ys[mt][nt][r] - mean) * rstd * lwa[r] + lba[r] + bon * vsh) * ggf[r];
                }
                *(uint2*)&p.ob[n * 512 + vch] = pack4(o);
            }
        }
    }
}

__device__ __forceinline__ void unpack8(const uint4& u, f32x4& a, f32x4& b) {
    a = f32x4{__uint_as_float(u.x << 16), __uint_as_float(u.x & 0xFFFF0000u), __uint_as_float(u.y << 16), __uint_as_float(u.y & 0xFFFF0000u)};
    b = f32x4{__uint_as_float(u.z << 16), __uint_as_float(u.z & 0xFFFF0000u), __uint_as_float(u.w << 16), __uint_as_float(u.w & 0xFFFF0000u)};
}
struct EpiMerge {
    u16* merged; u16* tmp2; int pass;
    __device__ __forceinline__ void operator()(const f32x4 (&acc)[2][2][4][2], const GUnit& u, int, int, int, int) const {
        const int t2_ = get_tid(), wid_ = __builtin_amdgcn_readfirstlane(t2_ >> 6), wr = wid_ >> 2, wc = wid_ & 3, fr = t2_ & 15, fq = (t2_ >> 4) & 3;
        const int row0 = u.pm * 256 + wr * 64 + fr, col0 = u.pn * 256 + wc * 32 + 8 * fq;
#pragma unroll
        for (int ai = 0; ai < 2; ++ai)
#pragma unroll
            for (int m = 0; m < 4; ++m) {
                const size_t off = (size_t)(row0 + ai * 128 + m * 16) * D_ + col0;
                uint4 m1[2], m2[2];
                if (pass == 1 || pass == 3) {
#pragma unroll
                    for (int bj = 0; bj < 2; ++bj) { m1[bj] = *(const uint4*)&merged[off + bj * 128]; if (pass == 3) m2[bj] = *(const uint4*)&tmp2[off + bj * 128]; }
                }
#pragma unroll
                for (int bj = 0; bj < 2; ++bj) {
                    f32x4 v0 = acc[ai][bj][m][0], v1 = acc[ai][bj][m][1];
                    if (pass == 1) { f32x4 a0, a1; unpack8(m1[bj], a0, a1);
#pragma unroll
                        for (int r = 0; r < 4; r++) { v0[r] = a0[r] * sigmoidf_(v0[r]); v1[r] = a1[r] * sigmoidf_(v1[r]); } }
                    if (pass == 3) { f32x4 a0, a1, b0, b1; unpack8(m1[bj], a0, a1); unpack8(m2[bj], b0, b1);
#pragma unroll
                        for (int r = 0; r < 4; r++) { v0[r] = a0[r] + b0[r] * sigmoidf_(v0[r]); v1[r] = a1[r] + b1[r] * sigmoidf_(v1[r]); } }
                    *(uint4*)&((pass == 2) ? tmp2 : merged)[off + bj * 128] = pack8(v0, v1);
                }
                asm volatile("" ::: "memory");
            }
    }
};
__device__ void ph_merge(const P& p, int bid, int nb, char* smem) {
    u16* tmp2 = (u16*)p.x1;
#pragma unroll 1
    for (int pass = 0; pass < 4; ++pass) {
        const int K = (pass & 1) ? D_ : 512;
        const u16* A = (pass & 1) ? p.hbuf : (pass == 0 ? p.oa : p.ob);
        const u16* Bt = (pass == 0) ? p.wpaT : (pass == 1 ? p.wgT : (pass == 2 ? p.wpbT : p.wgT + (size_t)1024 * D_));
        DenseSched S; S.init(NTOK, D_, K, Bt, nb, bid);
        EpiMerge E{p.merged, tmp2, pass};
        gemm256(smem, (const char*)A, K, S, E);
    }
}

struct EpiOutproj {
    const float* x; float* x1;
    __device__ __forceinline__ void operator()(const f32x4 (&acc)[2][2][4][2], const GUnit& u, int, int, int, int) const {
        const int t2_ = get_tid(), wid_ = __builtin_amdgcn_readfirstlane(t2_ >> 6), wr = wid_ >> 2, wc = wid_ & 3, fr = t2_ & 15, fq = (t2_ >> 4) & 3;
        const int row0 = u.pm * 256 + wr * 64 + fr, col0 = u.pn * 256 + wc * 32 + 4 * fq;
#pragma unroll
        for (int ai = 0; ai < 2; ++ai)
#pragma unroll
            for (int m = 0; m < 4; ++m) {
                const size_t off = (size_t)(row0 + ai * 128 + m * 16) * D_ + col0;
                f32x4 xin[2][2];
#pragma unroll
                for (int bj = 0; bj < 2; ++bj)
#pragma unroll
                    for (int n = 0; n < 2; ++n) xin[bj][n] = *(const f32x4*)&x[off + bj * 128 + n * 16];
#pragma unroll
                for (int bj = 0; bj < 2; ++bj)
#pragma unroll
                    for (int n = 0; n < 2; ++n) *(f32x4*)&x1[off + bj * 128 + n * 16] = xin[bj][n] + acc[ai][bj][m][n];
                asm volatile("" ::: "memory");
            }
    }
};
__device__ void ph_outproj(const P& p, int bid, int nb, char* smem) {
    DenseSched S; S.init(NTOK, D_, D_, p.woutT, nb, bid);
    EpiOutproj E{p.x, p.x1};
    gemm256(smem, (const char*)p.merged, D_, S, E);
}

__device__ __forceinline__ float red8f(float x) {
    x += dppf<0xB1>(x);
    x += dppf<0x4E>(x);
    x += dppf<0x141>(x);
    return x;
}
__device__ void ph_route(const P& p, int bid, int nb, char* smem) {
    float* wr = (float*)smem;
    const int tid = get_tid(), lane = tid & 63, wv = tid >> 6;
    {
        const int gtid = bid * NT + tid, gnt = nb * NT;
        const int per_e = 512 * 128 + 1024 * 32;
        for (int i = gtid; i < NEXP * per_e; i += gnt) {
            const int e = i / per_e; int r = i - e * per_e;
            const float* wp; u16* dstp; int N;
            if (r < 512 * 128) {
                const int kc = r >> 9, j = r & 511, half = j >> 8, sl = j & 255, sp = sl & 127;
                const int col = half * 128 + (sp & ~31) + perm32(sp & 31);
                N = 256; wp = ((sl >> 7) ? p.e_w3 : p.e_w1) + (size_t)e * D_ * 256 + (size_t)(kc * 8) * 256 + col;
                dstp = p.ew1T + ((size_t)e * 512 + j) * D_ + kc * 8;
            } else {
                r -= 512 * 128;
                const int kc = r >> 10, j = r & 1023;
                const int col = (j & ~31) + perm32(j & 31);
                N = D_; wp = p.e_w2 + (size_t)e * 256 * D_ + (size_t)(kc * 8) * D_ + col;
                dstp = p.ew2T + ((size_t)e * D_ + j) * 256 + kc * 8;
            }
            uint4 v;
            v.x = pack2(wp[0], wp[(size_t)N]); v.y = pack2(wp[2 * (size_t)N], wp[3 * (size_t)N]);
            v.z = pack2(wp[4 * (size_t)N], wp[5 * (size_t)N]); v.w = pack2(wp[6 * (size_t)N], wp[7 * (size_t)N]);
            *(uint4*)dstp = v;
        }
    }
    for (int i = tid; i < 1024 * 36; i += NT) {
        const int k = i / 36, j = i - k * 36;
        wr[i] = (j < 4) ? p.w_grp[k * 4 + j] : p.w_exp[k * 32 + (j - 4)];
    }
    __syncthreads();
    const int sub = lane & 7, tk = lane >> 3;
    for (int n0 = (bid * NW + wv) * 8; n0 < NTOK; n0 += nb * NW * 8) {
        const size_t n = (size_t)n0 + tk;
        const float* xr = p.x1 + n * D_;
        float acc[36]; float ss = 0.f;
#pragma unroll
        for (int j = 0; j < 36; j++) acc[j] = 0.f;
#pragma unroll 2
        for (int i = 0; i < 32; i++) {
            const int k0 = i * 32 + sub * 4;
            const float4 xv = *(const float4*)&xr[k0];
            const float4 gf = *(const float4*)&p.g_ffn[k0];
            ss += xv.x * xv.x + xv.y * xv.y + xv.z * xv.z + xv.w * xv.w;
            const float hv[4] = {xv.x * gf.x, xv.y * gf.y, xv.z * gf.z, xv.w * gf.w};
#pragma unroll
            for (int e2 = 0; e2 < 4; e2++) {
                const float* wrow = wr + (k0 + e2) * 36;
#pragma unroll
                for (int j4 = 0; j4 < 9; j4++) {
                    const float4 wv4 = *(const float4*)&wrow[j4 * 4];
                    acc[j4 * 4 + 0] += hv[e2] * wv4.x; acc[j4 * 4 + 1] += hv[e2] * wv4.y;
                    acc[j4 * 4 + 2] += hv[e2] * wv4.z; acc[j4 * 4 + 3] += hv[e2] * wv4.w;
                }
            }
        }
        ss = red8f(ss);
#pragma unroll
        for (int j = 0; j < 36; j++) acc[j] = red8f(acc[j]);
        const float rs = rsqrtf(ss * (1.f / D_) + 1e-6f);
#pragma unroll 4
        for (int i = 0; i < 32; i++) {
            const int k0 = i * 32 + sub * 4;
            const float4 xv = *(const float4*)&xr[k0];
            const float4 gf = *(const float4*)&p.g_ffn[k0];
            uint2 o; o.x = pack2(xv.x * rs * gf.x, xv.y * rs * gf.y); o.y = pack2(xv.z * rs * gf.z, xv.w * rs * gf.w);
            *(uint2*)&p.hbuf[n * D_ + k0] = o;
        }
        if (sub == 0) {
            float gl[4]; int gs = 0;
#pragma unroll
            for (int j = 0; j < 4; j++) gl[j] = acc[j] * rs + p.b_grp[j];
            float gm = gl[0];
#pragma unroll
            for (int j = 1; j < 4; j++) if (gl[j] > gm) { gm = gl[j]; gs = j; }
            float gsum = 0.f;
#pragma unroll
            for (int j = 0; j < 4; j++) gsum += __expf(gl[j] - gm);
            const float pg = 1.f / gsum;
            float el[8]; float em = -3.0e38f;
#pragma unroll
            for (int j = 0; j < 8; j++) {
                float a = (gs == 0) ? acc[4 + j] : ((gs == 1) ? acc[12 + j] : ((gs == 2) ? acc[20 + j] : acc[28 + j]));
                a = a * rs + p.b_exp[gs * 8 + j];
                el[j] = a; em = fmaxf(em, a);
            }
            int j0 = 0, j1 = -1; float v0 = -3.0e38f, v1 = -3.0e38f;
#pragma unroll
            for (int j = 0; j < 8; j++) { el[j] = __expf(el[j] - em); }
#pragma unroll
            for (int j = 0; j < 8; j++) { if (el[j] > v0) { v0 = el[j]; j0 = j; } }
#pragma unroll
            for (int j = 0; j < 8; j++) { if (j != j0 && el[j] > v1) { v1 = el[j]; j1 = j; } }
            const float den = v0 + v1;
            const int e0 = gs * 8 + j0, e1 = gs * 8 + j1;
            p.tok_e[n * 2] = e0; p.tok_e[n * 2 + 1] = e1;
            p.tok_gate[n * 2] = pg * v0 / den; p.tok_gate[n * 2 + 1] = pg * v1 / den;
            atomicAdd(&p.counts[e0], 1); atomicAdd(&p.counts[e1], 1);
        }
    }
}

__device__ void ph_scatter(const P& p, int bid, int nb, char* smem) {
    int* offl = (int*)smem;
    int* hist = offl + 64;
    int* gbase = hist + 32;
    const int tid = get_tid();
    if (tid == 0) {
        int off = 0;
        for (int e = 0; e < NEXP; e++) { offl[e] = off; off += p.counts[e]; }
        offl[NEXP] = off;
    }
    if (bid == 0 && tid == 64) {
        int off = 0, nb_ = 0;
        for (int e = 0; e < NEXP; e++) {
            const int c = p.counts[e];
            p.offs[e] = off;
            for (int r = 0; r < c; r += 256) { p.blk_e[nb_] = e; p.blk_r0[nb_] = off + r; nb_++; }
            off += c;
        }
        p.offs[NEXP] = off;
        *p.nblk = nb_;
    }
    for (int base = bid * NT; base < NTOK * 2; base += nb * NT) {
        __syncthreads();
        if (tid < 32) hist[tid] = 0;
        __syncthreads();
        const int i = base + tid;
        const int e = p.tok_e[i];
        const int rl = atomicAdd(&hist[e], 1);
        __syncthreads();
        if (tid < 32) gbase[tid] = atomicAdd(&p.cursor[tid], hist[tid]);
        __syncthreads();
        const int slot = offl[e] + gbase[e] + rl;
        p.list_tok[slot] = i >> 1; p.list_gate[slot] = p.tok_gate[i]; p.tokslot[i] = slot;
    }
}
template <int CTS>
struct MoeSched {
    const P* pp; int nunits, G, c; unsigned rowbytes; const u16* Bt; size_t b_estride, b_tstride;
    bool gather;
    __device__ __forceinline__ bool next(int i, GUnit& u) const {
        const int L = i * G + c; if (L >= nunits) return false;
        int wgid = L; { const int q = nunits >> 3, r = nunits & 7, xcd = wgid & 7, off = wgid >> 3; wgid = (xcd < r ? xcd * (q + 1) : r * (q + 1) + (xcd - r) * q) + off; }
        u.pm = wgid / CTS; u.pn = wgid & (CTS - 1); return true;
    }
    __device__ __forceinline__ unsigned a_off(const GUnit& u, int h, int R) const {
        const P& p = *pp;
        const int e = __builtin_amdgcn_readfirstlane(p.blk_e[u.pm]), rend = __builtin_amdgcn_readfirstlane(p.offs[e + 1]);
        int sl = __builtin_amdgcn_readfirstlane(p.blk_r0[u.pm]) + h * 128 + R; if (sl >= rend) sl = rend - 1;
        return (unsigned)(gather ? p.list_tok[sl] : sl) * rowbytes;
    }
    __device__ __forceinline__ const char* b_ptr(const GUnit& u) const { return (const char*)(Bt + (size_t)__builtin_amdgcn_readfirstlane(pp->blk_e[u.pm]) * b_estride + (size_t)u.pn * b_tstride); }
};
struct EpiMoe1 {
    const P* pp;
    __device__ __forceinline__ void operator()(const f32x4 (&acc)[2][2][4][2], const GUnit& u, int, int, int, int) const {
        const int t2_ = get_tid(), wid_ = __builtin_amdgcn_readfirstlane(t2_ >> 6), wr = wid_ >> 2, wc = wid_ & 3, fr = t2_ & 15, fq = (t2_ >> 4) & 3;
        const P& p = *pp;
        const int e = __builtin_amdgcn_readfirstlane(p.blk_e[u.pm]), r0 = __builtin_amdgcn_readfirstlane(p.blk_r0[u.pm]), rend = __builtin_amdgcn_readfirstlane(p.offs[e + 1]);
#pragma unroll
        for (int ai = 0; ai < 2; ++ai)
#pragma unroll
            for (int m = 0; m < 4; ++m) {
                const int sl = r0 + ai * 128 + wr * 64 + m * 16 + fr;
                if (sl < rend) {
                    f32x4 v[2];
#pragma unroll
                    for (int n = 0; n < 2; ++n)
#pragma unroll
                        for (int r = 0; r < 4; r++) { const float a = acc[ai][0][m][n][r]; v[n][r] = a * sigmoidf_(a) * acc[ai][1][m][n][r]; }
                    *(uint4*)&p.hid[(size_t)sl * 256 + u.pn * 128 + wc * 32 + 8 * fq] = pack8(v[0], v[1]);
                }
            }
    }
};
__device__ void ph_moe1(const P& p, int bid, int nb, char* smem) {
    MoeSched<2> S{&p, __builtin_amdgcn_readfirstlane(*p.nblk) * 2, nb, bid, (unsigned)(D_ * 2), p.ew1T, (size_t)512 * D_, (size_t)256 * D_, true};
    EpiMoe1 E{&p};
    gemm256(smem, (const char*)p.hbuf, D_, S, E);
}
struct EpiMoe2 {
    const P* pp;
    __device__ __forceinline__ void operator()(const f32x4 (&acc)[2][2][4][2], const GUnit& u, int, int, int, int) const {
        const int t2_ = get_tid(), wid_ = __builtin_amdgcn_readfirstlane(t2_ >> 6), wr = wid_ >> 2, wc = wid_ & 3, fr = t2_ & 15, fq = (t2_ >> 4) & 3;
        const P& p = *pp;
        const int e = __builtin_amdgcn_readfirstlane(p.blk_e[u.pm]), r0 = __builtin_amdgcn_readfirstlane(p.blk_r0[u.pm]), rend = __builtin_amdgcn_readfirstlane(p.offs[e + 1]);
#pragma unroll
        for (int ai = 0; ai < 2; ++ai)
#pragma unroll
            for (int m = 0; m < 4; ++m) {
                const int sl = r0 + ai * 128 + wr * 64 + m * 16 + fr;
                if (sl < rend) {
                    const float gt = p.list_gate[sl];
                    u16* yp = p.ybuf + (size_t)sl * D_ + u.pn * 256 + wc * 32 + 8 * fq;
#pragma unroll
                    for (int bj = 0; bj < 2; ++bj) *(uint4*)&yp[bj * 128] = pack8(acc[ai][bj][m][0] * gt, acc[ai][bj][m][1] * gt);
                }
            }
    }
};
__device__ void ph_moe2(const P& p, int bid, int nb, char* smem) {
    MoeSched<4> S{&p, __builtin_amdgcn_readfirstlane(*p.nblk) * 4, nb, bid, 512u, p.ew2T, (size_t)D_ * 256, (size_t)256 * 256, false};
    EpiMoe2 E{&p};
    gemm256(smem, (const char*)p.hid, 256, S, E);
}
__device__ void ph_final(const P& p, int bid, int nb, char* smem) {
    const int tid = get_tid(), lane = tid & 63, wv = tid >> 6;
    for (int row = bid * NW + wv; row < NTOK; row += nb * NW) {
        const int s0 = p.tokslot[row * 2], s1 = p.tokslot[row * 2 + 1];
        float v[16]; float ss = 0.f;
#pragma unroll
        for (int i = 0; i < 4; i++) {
            const int c = i * 256 + lane * 4;
            const float4 t = *(const float4*)&p.x1[(size_t)row * D_ + c];
            const uint2 a = *(const uint2*)&p.ybuf[(size_t)s0 * D_ + c];
            const uint2 bq = *(const uint2*)&p.ybuf[(size_t)s1 * D_ + c];
            v[4 * i]     = t.x + __uint_as_float(a.x << 16) + __uint_as_float(bq.x << 16);
            v[4 * i + 1] = t.y + __uint_as_float(a.x & 0xFFFF0000u) + __uint_as_float(bq.x & 0xFFFF0000u);
            v[4 * i + 2] = t.z + __uint_as_float(a.y << 16) + __uint_as_float(bq.y << 16);
            v[4 * i + 3] = t.w + __uint_as_float(a.y & 0xFFFF0000u) + __uint_as_float(bq.y & 0xFFFF0000u);
            ss += v[4 * i] * v[4 * i] + v[4 * i + 1] * v[4 * i + 1] + v[4 * i + 2] * v[4 * i + 2] + v[4 * i + 3] * v[4 * i + 3];
        }
        ss = wave_sum(ss);
        const float rs = rsqrtf(ss * (1.f / D_) + 1e-6f);
#pragma unroll
        for (int i = 0; i < 4; i++) {
            const int c = i * 256 + lane * 4;
            const float4 g = *(const float4*)&p.g_final[c];
            float4 o; o.x = v[4 * i] * rs * g.x; o.y = v[4 * i + 1] * rs * g.y; o.z = v[4 * i + 2] * rs * g.z; o.w = v[4 * i + 3] * rs * g.w;
            *(float4*)&p.out[(size_t)row * D_ + c] = o;
        }
    }
}

#define XB_TMO      128
#define XB_XCNT(j)  (256  + 64 * (j))
#define XB_XSUB(j)  (1280 + 64 * (j))
#define XB_XGEN(j)  (2304 + 64 * (j))
#define XB_TOP      3328
#define XB_TOPGEN   3392
#define XCD_BAR_WORDS 3456
#define XB_SPIN_CAP (1u << 18)
#define LAS __attribute__((address_space(3)))

__device__ __forceinline__ unsigned xb_ld(unsigned* p)              { return __hip_atomic_load(p, __ATOMIC_RELAXED, __HIP_MEMORY_SCOPE_AGENT); }
__device__ __forceinline__ unsigned xb_add(unsigned* p, unsigned v) { return __hip_atomic_fetch_add(p, v, __ATOMIC_RELAXED, __HIP_MEMORY_SCOPE_AGENT); }
__device__ __forceinline__ unsigned xb_xcc_id() { return (unsigned)__builtin_amdgcn_s_getreg((3 << 11) | 20) & 0xFu; }
#define XB_SPIN(cond, bar) do { unsigned _sp = 0; while (cond) { __builtin_amdgcn_s_sleep(1); \
    if ((++_sp & 255u) == 0u) { if (xb_ld(&(bar)[XB_TMO])) break; if (_sp > XB_SPIN_CAP) { atomicAdd(&(bar)[XB_TMO], 1u); break; } } } } while (0)

struct XcdBarrier {
    unsigned* bar; unsigned x;
    volatile LAS unsigned* st;
};

__device__ __forceinline__ XcdBarrier xcd_barrier_post(unsigned* bar, volatile LAS unsigned* st) {
    XcdBarrier b; b.bar = bar; b.x = xb_xcc_id(); b.st = st;
    if (threadIdx.x == 0) (void)xb_add(&bar[XB_XCNT(b.x)], 1u);
    return b;
}
__device__ __forceinline__ void xcd_barrier_complete(unsigned* bar, unsigned x, unsigned& nloc, unsigned& nx) {
    const unsigned G = gridDim.x * gridDim.y * gridDim.z;
    unsigned sum, cnt, mine, sp = 0u;
    for (;;) {
        sum = 0u; cnt = 0u; mine = 0u;
#pragma unroll
        for (unsigned j = 0; j < 16; ++j) { const unsigned c = xb_ld(&bar[XB_XCNT(j)]); sum += c; cnt += (c > 0u) ? 1u : 0u; mine = (j == x) ? c : mine; }
        if (sum == G) break;
        __builtin_amdgcn_s_sleep(1);
        if ((++sp & 255u) == 0u) { if (xb_ld(&bar[XB_TMO])) break; if (sp > XB_SPIN_CAP) { atomicAdd(&bar[XB_TMO], 1u); break; } }
    }
    nloc = mine > 0u ? mine : 1u; nx = cnt > 0u ? cnt : 1u;
}

__device__ __forceinline__ void xcd_barrier(const XcdBarrier& b) {
    asm volatile("s_waitcnt vmcnt(0)" ::: "memory");
    __syncthreads();
    if (threadIdx.x == 0) {
        unsigned* bar = b.bar;
        __builtin_amdgcn_s_waitcnt(0);
        unsigned nloc = b.st[0], nx = b.st[1];
        if (nloc == 0u) { xcd_barrier_complete(bar, b.x, nloc, nx); b.st[0] = nloc; b.st[1] = nx; }
        const unsigned old = xb_add(&bar[XB_XSUB(b.x)], 1u);
        const unsigned gen = old / nloc;
        if (old + 1u == (gen + 1u) * nloc) {
            __builtin_amdgcn_fence(__ATOMIC_RELEASE, "agent");
            asm volatile("s_waitcnt vmcnt(0)" ::: "memory");
            const unsigned og = xb_add(&bar[XB_TOP], 1u);
            const unsigned tg = og / nx;
            if (og + 1u == (tg + 1u) * nx) xb_add(&bar[XB_TOPGEN], 1u);
            else XB_SPIN(xb_ld(&bar[XB_TOPGEN]) == tg, bar);
            __builtin_amdgcn_fence(__ATOMIC_ACQUIRE, "agent");
            xb_add(&bar[XB_XGEN(b.x)], 1u);
            asm volatile("s_waitcnt vmcnt(0)" ::: "memory");
        } else {
            XB_SPIN(xb_ld(&bar[XB_XGEN(b.x)]) == gen, bar);
            __builtin_amdgcn_fence(__ATOMIC_ACQUIRE, "agent");
            asm volatile("s_waitcnt vmcnt(0)" ::: "memory");
        }
    }
    __syncthreads();
}

template <int PH>
__device__ __forceinline__ void run_phase(const P& p, int bid, int nb, char* smem) {
    if constexpr (PH == 0) ph_prologue(p, bid, nb, smem);
    if constexpr (PH == 1) ph_inproj(p, bid, nb, smem);
    if constexpr (PH == 2) { ph_compress(p, bid, nb, smem); __syncthreads(); ph_rwkv_chunk(p, bid, nb, smem); }
    if constexpr (PH == 3) {
        if (bid < SCAN_BLOCKS) ph_rwkv_seq(p, bid, SCAN_BLOCKS, smem);
        else ph_nsa(p, bid - SCAN_BLOCKS, nb - SCAN_BLOCKS, smem);
    }
    if constexpr (PH == 12) ph_rwkv_out(p, bid, nb, smem);
    if constexpr (PH == 4) ph_merge(p, bid, nb, smem);
    if constexpr (PH == 5) ph_outproj(p, bid, nb, smem);
    if constexpr (PH == 6) ph_route(p, bid, nb, smem);
    if constexpr (PH == 7) ph_scatter(p, bid, nb, smem);
    if constexpr (PH == 9) ph_moe1(p, bid, nb, smem);
    if constexpr (PH == 10) ph_moe2(p, bid, nb, smem);
    if constexpr (PH == 11) ph_final(p, bid, nb, smem);
}

template <int PH>
__global__ void __launch_bounds__(NT) kph(P p) {
    extern __shared__ __attribute__((aligned(16))) char smem[];
    run_phase<PH>(p, blockIdx.x, gridDim.x, smem);
}

__global__ void __launch_bounds__(NT, 2) mega(P p) {
    extern __shared__ __attribute__((aligned(16))) char smem[];
    volatile LAS unsigned* st = (volatile LAS unsigned*)(smem + SMEM_BYTES - 16);
    if (threadIdx.x == 0) { st[0] = 0u; st[1] = 0u; st[2] = 0u; st[3] = 0u; }
    __syncthreads();
    XcdBarrier bar = xcd_barrier_post(p.bar, st);
    const int bid = blockIdx.x, nb = gridDim.x;
    run_phase<0>(p, bid, nb, smem); xcd_barrier(bar);
    run_phase<1>(p, bid, nb, smem); xcd_barrier(bar);
    run_phase<2>(p, bid, nb, smem); xcd_barrier(bar);
    run_phase<3>(p, bid, nb, smem); xcd_barrier(bar);
    run_phase<12>(p, bid, nb, smem); xcd_barrier(bar);
    run_phase<4>(p, bid, nb, smem); xcd_barrier(bar);
    run_phase<5>(p, bid, nb, smem); xcd_barrier(bar);
    run_phase<6>(p, bid, nb, smem); xcd_barrier(bar);
    run_phase<7>(p, bid, nb, smem); xcd_barrier(bar);
    run_phase<9>(p, bid, nb, smem); xcd_barrier(bar);
    run_phase<10>(p, bid, nb, smem); xcd_barrier(bar);
    run_phase<11>(p, bid, nb, smem);
}

extern "C" void kernel_launch(void* const* d_in, const int* in_sizes, int n_in,
                              void* d_out, int out_size, void* d_ws, size_t ws_size,
                              hipStream_t stream) {
    P p{};
    p.x = (const float*)d_in[0]; p.pos = (const int*)d_in[1]; p.g_mix = (const float*)d_in[2]; p.w_in = (const float*)d_in[3];
    p.pe_k = (const float*)d_in[4]; p.w1_k = (const float*)d_in[5]; p.b1_k = (const float*)d_in[6]; p.w2_k = (const float*)d_in[7]; p.b2_k = (const float*)d_in[8];
    p.pe_v = (const float*)d_in[9]; p.w1_v = (const float*)d_in[10]; p.b1_v = (const float*)d_in[11]; p.w2_v = (const float*)d_in[12]; p.b2_v = (const float*)d_in[13];
    p.mu = (const float*)d_in[14]; p.w0 = (const float*)d_in[15]; p.w2 = (const float*)d_in[16]; p.a0 = (const float*)d_in[17]; p.a2 = (const float*)d_in[18];
    p.g2 = (const float*)d_in[19]; p.k_k = (const float*)d_in[20]; p.k_a = (const float*)d_in[21]; p.r_k = (const float*)d_in[22]; p.ln_w = (const float*)d_in[23]; p.ln_b = (const float*)d_in[24];
    p.wpa = (const float*)d_in[25]; p.wpb = (const float*)d_in[26]; p.wout = (const float*)d_in[27]; p.g_ffn = (const float*)d_in[28];
    p.w_grp = (const float*)d_in[29]; p.b_grp = (const float*)d_in[30]; p.w_exp = (const float*)d_in[31]; p.b_exp = (const float*)d_in[32];
    p.e_w1 = (const float*)d_in[33]; p.e_w3 = (const float*)d_in[34]; p.e_w2 = (const float*)d_in[35]; p.g_final = (const float*)d_in[36];
    p.out = (float*)d_out;
    char* ws = (char*)d_ws;
    const size_t MiB = 1ull << 20;
    p.hbuf = (u16*)(ws + 0 * MiB);
    p.q    = (u16*)(ws + 64 * MiB);
    p.kc   = (u16*)(ws + 96 * MiB);  p.vc   = (u16*)(ws + 104 * MiB);
    p.ksl  = (u16*)(ws + 112 * MiB); p.vslT = (u16*)(ws + 120 * MiB);
    p.kwn  = (u16*)(ws + 128 * MiB); p.vwnT = (u16*)(ws + 136 * MiB);
    p.nsag = (float*)(ws + 144 * MiB);
    p.kcb  = (u16*)(ws + 148 * MiB); p.vcT  = (u16*)(ws + 149 * MiB);
    p.prw  = (u16*)(ws + 160 * MiB);
    p.cdat = (u16*)(ws + 272 * MiB);
    p.bon  = (float*)(ws + 150 * MiB);
    p.w2T  = (u16*)(ws + 151 * MiB); p.a2T = p.w2T + 512 * 64; p.g2T = p.a2T + 512 * 64;
    p.cw1Tk = (u16*)(ws + 152 * MiB); p.cw1Tv = (u16*)(ws + 153 * MiB);
    p.cw2Tk = (u16*)(ws + 154 * MiB); p.cw2Tv = p.cw2Tk + 128 * 256;
    p.chid = (u16*)(ws + 155 * MiB);
    p.xact = (u16*)(ws + 488 * MiB);
    p.oa   = (u16*)(ws + 400 * MiB);
    p.ob   = (u16*)(ws + 432 * MiB);
    p.merged = (u16*)(ws + 64 * MiB);
    p.x1   = (float*)(ws + 160 * MiB);
    char* rt = ws + 288 * MiB;
    p.tok_e = (int*)(rt);                        rt += NTOK * 2 * 4;
    p.tok_gate = (float*)(rt);                   rt += NTOK * 2 * 4;
    p.tokslot = (int*)(rt);                      rt += NTOK * 2 * 4;
    p.list_tok = (int*)(rt);                     rt += NTOK * 2 * 4;
    p.list_gate = (float*)(rt);                  rt += NTOK * 2 * 4;
    p.blk_e = (int*)(rt);                        rt += 2048 * 4;
    p.blk_r0 = (int*)(rt);                       rt += 2048 * 4;
    p.hid  = (u16*)(ws + 296 * MiB);
    p.ybuf = (u16*)(ws + 336 * MiB);
    char* misc = ws + 470 * MiB;
    p.counts = (int*)(misc); p.cursor = (int*)(misc + 256); p.offs = (int*)(misc + 512); p.nblk = (int*)(misc + 1024);
    p.bar = (unsigned*)(ws + 471 * MiB);
    p.cb1k = (float*)(p.bar + XCD_BAR_WORDS); p.cb1v = p.cb1k + 256;
    {
        char* wa = ws + 472 * MiB;
        p.winT = (u16*)wa;  wa += (size_t)3328 * 1024 * 2;
        p.wgT  = (u16*)wa;  wa += (size_t)2048 * 1024 * 2;
        p.wpaT = (u16*)wa;  wa += (size_t)1024 * 512 * 2;
        p.wpbT = (u16*)wa;  wa += (size_t)1024 * 512 * 2;
        p.woutT = (u16*)wa; wa += (size_t)1024 * 1024 * 2;
        p.ew1T = (u16*)(ws + 64 * MiB);  p.ew3T = (u16*)(ws + 80 * MiB);  p.ew2T = (u16*)(ws + 96 * MiB);
    }
    if (ws_size < (size_t)505 * MiB) return;

#if MEGA
    {
        static int mgrid = 0;
        if (mgrid == 0) {
            int dev = 0, cus = 0, per_cu = 0;
            hipGetDevice(&dev);
            hipDeviceGetAttribute(&cus, hipDeviceAttributeMultiprocessorCount, dev);
            hipFuncSetAttribute((const void*)mega, hipFuncAttributeMaxDynamicSharedMemorySize, SMEM_BYTES);
            hipOccupancyMaxActiveBlocksPerMultiprocessor(&per_cu, (const void*)mega, NT, SMEM_BYTES);
            (void)hipGetLastError();
            mgrid = cus;
        }
        hipMemsetAsync(p.bar, 0, XCD_BAR_WORDS * sizeof(unsigned) + 512 * sizeof(float), stream);
        mega<<<mgrid, NT, SMEM_BYTES, stream>>>(p);
        return;
    }
#else
    const int grid = 512;
    hipMemsetAsync(p.bar, 0, XCD_BAR_WORDS * sizeof(unsigned) + 512 * sizeof(float), stream);
    hipFuncSetAttribute((const void*)kph<0>, hipFuncAttributeMaxDynamicSharedMemorySize, SMEM_BYTES);
    hipFuncSetAttribute((const void*)kph<1>, hipFuncAttributeMaxDynamicSharedMemorySize, SMEM_BYTES);
    hipFuncSetAttribute((const void*)kph<2>, hipFuncAttributeMaxDynamicSharedMemorySize, SMEM_BYTES);
    hipFuncSetAttribute((const void*)kph<3>, hipFuncAttributeMaxDynamicSharedMemorySize, SMEM_BYTES);
    hipFuncSetAttribute((const void*)kph<4>, hipFuncAttributeMaxDynamicSharedMemorySize, SMEM_BYTES);
    hipFuncSetAttribute((const void*)kph<5>, hipFuncAttributeMaxDynamicSharedMemorySize, SMEM_BYTES);
    hipFuncSetAttribute((const void*)kph<6>, hipFuncAttributeMaxDynamicSharedMemorySize, SMEM_BYTES);
    hipFuncSetAttribute((const void*)kph<7>, hipFuncAttributeMaxDynamicSharedMemorySize, SMEM_BYTES);
    hipFuncSetAttribute((const void*)kph<8>, hipFuncAttributeMaxDynamicSharedMemorySize, SMEM_BYTES);
    hipFuncSetAttribute((const void*)kph<9>, hipFuncAttributeMaxDynamicSharedMemorySize, SMEM_BYTES);
    hipFuncSetAttribute((const void*)kph<10>, hipFuncAttributeMaxDynamicSharedMemorySize, SMEM_BYTES);
    hipFuncSetAttribute((const void*)kph<11>, hipFuncAttributeMaxDynamicSharedMemorySize, SMEM_BYTES);
    kph<0><<<grid, NT, SMEM_BYTES, stream>>>(p);
    kph<1><<<grid, NT, SMEM_BYTES, stream>>>(p);
    kph<2><<<grid, NT, SMEM_BYTES, stream>>>(p);
    kph<3><<<grid, NT, SMEM_BYTES, stream>>>(p);
    kph<12><<<grid, NT, SMEM_BYTES, stream>>>(p);
    kph<4><<<grid, NT, SMEM_BYTES, stream>>>(p);
    kph<5><<<grid, NT, SMEM_BYTES, stream>>>(p);
    kph<6><<<grid, NT, SMEM_BYTES, stream>>>(p);
    kph<7><<<grid, NT, SMEM_BYTES, stream>>>(p);
    kph<8><<<grid, NT, SMEM_BYTES, stream>>>(p);
    kph<9><<<grid, NT, SMEM_BYTES, stream>>>(p);
    kph<10><<<grid, NT, SMEM_BYTES, stream>>>(p);
    kph<11><<<grid, NT, SMEM_BYTES, stream>>>(p);
#endif
}
```

```cpp
#include <hip/hip_runtime.h>
#include <stdint.h>

typedef unsigned short u16;
using bf16x8 = __attribute__((ext_vector_type(8))) short;
using f32x4  = __attribute__((ext_vector_type(4))) float;

#ifndef MEGA
#define MEGA 1
#endif

constexpr int B_ = 4, S_ = 8192, D_ = 1024, NTOK = B_ * S_;
constexpr int CIN = 5144;
constexpr int NCMP = 511;
constexpr int CRW = 1792;
constexpr int NEXP = 32;
constexpr int NT = 512;
constexpr int NW = NT / 64;
constexpr int SMEM_BYTES = 160 * 1024;
constexpr int SCAN_BLOCKS = 16;
#ifndef TPROBE
#define TPROBE 0
#define TPSEL 0
#endif
constexpr float QSCALE = 0.125f * 1.4426950408889634f;

struct P {
    const float* x; const int* pos; const float* g_mix; const float* w_in;
    const float *pe_k, *w1_k, *b1_k, *w2_k, *b2_k, *pe_v, *w1_v, *b1_v, *w2_v, *b2_v;
    const float *mu, *w0, *w2, *a0, *a2, *g2, *k_k, *k_a, *r_k, *ln_w, *ln_b;
    const float *wpa, *wpb, *wout, *g_ffn, *w_grp, *b_grp, *w_exp, *b_exp, *e_w1, *e_w3, *e_w2, *g_final;
    float* out;
    u16* hbuf; u16 *q, *kc, *vc, *ksl, *vslT, *kwn, *vwnT, *kcb, *vcT; float* nsag; u16* prw;
    u16* cdat; float* bon; u16 *w2T, *a2T, *g2T; u16 *oa, *ob; u16* merged; float* x1;
    int* tok_e; float* tok_gate; int* tokslot; int* list_tok; float* list_gate;
    int* counts; int* offs; int* cursor; int* blk_e; int* blk_r0; int* nblk;
    u16* hid; u16* ybuf; unsigned* bar;
    u16 *winT, *wgT, *wpaT, *wpbT, *woutT, *ew1T, *ew3T, *ew2T;
    u16 *cw1Tk, *cw1Tv, *cw2Tk, *cw2Tv, *chid, *xact; float *cb1k, *cb1v;
};

typedef __bf16 bf16x2_t __attribute__((ext_vector_type(2)));
typedef float f32x2_t __attribute__((ext_vector_type(2)));
__device__ __forceinline__ unsigned pack2(float a, float b) {
    f32x2_t f = {a, b};
    return __builtin_bit_cast(unsigned, __builtin_convertvector(f, bf16x2_t));
}
__device__ __forceinline__ u16 f2bf(float f) { return (u16)(pack2(f, f) & 0xFFFFu); }
__device__ __forceinline__ float bf2f(u16 h) { return __uint_as_float(((unsigned)h) << 16); }
__device__ __forceinline__ float sigmoidf_(float x) { return __builtin_amdgcn_rcpf(1.f + __expf(-x)); }
__device__ __forceinline__ int get_tid() { int t = threadIdx.x; asm volatile("" : "+v"(t)); return t; }
__device__ __forceinline__ uint2 pack4(const f32x4& v) { uint2 o; o.x = pack2(v[0], v[1]); o.y = pack2(v[2], v[3]); return o; }
__device__ __forceinline__ f32x4 unpack4(uint2 u) { return f32x4{__uint_as_float(u.x << 16), __uint_as_float(u.x & 0xFFFF0000u), __uint_as_float(u.y << 16), __uint_as_float(u.y & 0xFFFF0000u)}; }
#define LDS_BARRIER() do { asm volatile("s_waitcnt lgkmcnt(0)" ::: "memory"); __builtin_amdgcn_s_barrier(); asm volatile("" ::: "memory"); } while (0)
__device__ __forceinline__ int opaque(int x) { asm volatile("" : "+v"(x)); return x; }
template <int CTRL>
__device__ __forceinline__ float dppf(float x) { return __int_as_float(__builtin_amdgcn_update_dpp(0, __float_as_int(x), CTRL, 0xF, 0xF, true)); }
__device__ __forceinline__ float wave_sum(float v) {
    v += dppf<0xB1>(v);
    v += dppf<0x4E>(v);
    v += dppf<0x141>(v);
    v += dppf<0x140>(v);
    const int vi = __float_as_int(v);
    return (__int_as_float(__builtin_amdgcn_readlane(vi, 0)) + __int_as_float(__builtin_amdgcn_readlane(vi, 16)))
         + (__int_as_float(__builtin_amdgcn_readlane(vi, 32)) + __int_as_float(__builtin_amdgcn_readlane(vi, 48)));
}

__device__ __forceinline__ float xrow_sum(float v) {
    auto r = __builtin_amdgcn_permlane16_swap(__float_as_uint(v), __float_as_uint(v), false, false);
    v = __uint_as_float(r[0]) + __uint_as_float(r[1]);
    auto r2 = __builtin_amdgcn_permlane32_swap(__float_as_uint(v), __float_as_uint(v), false, false);
    return __uint_as_float(r2[0]) + __uint_as_float(r2[1]);
}
__device__ __forceinline__ float xrow_max(float v) {
    auto r = __builtin_amdgcn_permlane16_swap(__float_as_uint(v), __float_as_uint(v), false, false);
    v = fmaxf(__uint_as_float(r[0]), __uint_as_float(r[1]));
    auto r2 = __builtin_amdgcn_permlane32_swap(__float_as_uint(v), __float_as_uint(v), false, false);
    return fmaxf(__uint_as_float(r2[0]), __uint_as_float(r2[1]));
}
__constant__ double ROPE_FREQ[32] = {
    1.00000000000000000000e+00, 7.49894209332455874417e-01, 5.62341325190349072827e-01, 4.21696503428582225581e-01,
    3.16227766016837941176e-01, 2.37137370566165517349e-01, 1.77827941003892292526e-01, 1.33352143216332402753e-01,
    1.00000000000000005551e-01, 7.49894209332455791150e-02, 5.62341325190349114460e-02, 4.21696503428582239459e-02,
    3.16227766016837913421e-02, 2.37137370566165538166e-02, 1.77827941003892292526e-02, 1.33352143216332406223e-02,
    1.00000000000000002082e-02, 7.49894209332455791150e-03, 5.62341325190349097113e-03, 4.21696503428582291501e-03,
    3.16227766016837939442e-03, 2.37137370566165538166e-03, 1.77827941003892275179e-03, 1.33352143216332406223e-03,
    1.00000000000000002082e-03, 7.49894209332455856203e-04, 5.62341325190349097113e-04, 4.21696503428582237290e-04,
    3.16227766016837939442e-04, 2.37137370566165538166e-04, 1.77827941003892269758e-04, 1.33352143216332395381e-04};

constexpr int G_ABYTES = 256 * 64 * 2, G_BBYTES = 128 * 64 * 2, G_TILE = G_ABYTES + G_BBYTES;
#define LAS3 __attribute__((address_space(3)))
#define GAS1 __attribute__((address_space(1)))
__device__ __forceinline__ void glds16(const u16* g, char* l) {
    __builtin_amdgcn_global_load_lds((const GAS1 unsigned*)g, (LAS3 unsigned*)l, 16, 0, 0);
}
template <bool TR = false, class ARow>
__device__ __forceinline__ void gemm_core(int K, ARow arow, const u16* __restrict__ BT, int ldb, f32x4 (&acc)[4][4], u16* sm) {
    char* base = (char*)sm;
    const int tid = get_tid(), lane = tid & 63, wv = tid >> 6;
    const int wm = wv >> 1, wn = wv & 1, kr = lane & 15, qq = lane >> 4;
    const int lr = tid >> 3, lk = ((tid & 7) ^ ((lr >> 1) & 7)) * 8;
    const u16* ap0 = arow(lr) + lk; const u16* ap1 = arow(lr + 64) + lk;
    const u16* ap2 = arow(lr + 128) + lk; const u16* ap3 = arow(lr + 192) + lk;
    const u16* bp0 = BT + (size_t)lr * ldb + lk; const u16* bp1 = BT + (size_t)(lr + 64) * ldb + lk;
#pragma unroll
    for (int mt = 0; mt < 4; mt++)
#pragma unroll
        for (int nt = 0; nt < 4; nt++) acc[mt][nt] = f32x4{0.f, 0.f, 0.f, 0.f};
    const int nk = K >> 6;
#define G_ISSUE(t, b) { char* d = base + (b) * G_TILE + tid * 16; const int ko = (t) * 64; \
        glds16(ap0 + ko, d); glds16(ap1 + ko, d + 8192); glds16(ap2 + ko, d + 16384); glds16(ap3 + ko, d + 24576); \
        glds16(bp0 + ko, d + G_ABYTES); glds16(bp1 + ko, d + G_ABYTES + 8192); }
    const int sw = kr >> 1;
    const int po0 = ((0 * 4 + qq) ^ sw) * 16, po1 = ((1 * 4 + qq) ^ sw) * 16;
    const int aoff = (wm * 64 + kr) * 128, boff = G_ABYTES + (wn * 64 + kr) * 128;
#define G_READ(FA, FB, b) { const char* Ab = base + (b) * G_TILE + aoff; const char* Bb = base + (b) * G_TILE + boff; \
        _Pragma("unroll") for (int mt = 0; mt < 4; mt++) { FA[0][mt] = *(const bf16x8*)(Ab + mt * 2048 + po0); FA[1][mt] = *(const bf16x8*)(Ab + mt * 2048 + po1); } \
        _Pragma("unroll") for (int nt = 0; nt < 4; nt++) { FB[0][nt] = *(const bf16x8*)(Bb + nt * 2048 + po0); FB[1][nt] = *(const bf16x8*)(Bb + nt * 2048 + po1); } }
#define G_MMA(FA, FB) { __builtin_amdgcn_s_setprio(1); \
        _Pragma("unroll") for (int ks = 0; ks < 2; ks++) \
            _Pragma("unroll") for (int nt = 0; nt < 4; nt++) \
                _Pragma("unroll") for (int mt = 0; mt < 4; mt++) \
                    acc[mt][nt] = TR ? __builtin_amdgcn_mfma_f32_16x16x32_bf16(FA[ks][mt], FB[ks][nt], acc[mt][nt], 0, 0, 0) \
                                     : __builtin_amdgcn_mfma_f32_16x16x32_bf16(FB[ks][nt], FA[ks][mt], acc[mt][nt], 0, 0, 0); \
        __builtin_amdgcn_s_setprio(0); }
    bf16x8 fa0[2][4], fb0[2][4], fa1[2][4], fb1[2][4];
    G_ISSUE(0, 0)
    if (nk > 1) G_ISSUE(1, 1)
    if (nk > 2) G_ISSUE(2, 2)
    if (nk > 2) asm volatile("s_waitcnt vmcnt(12)" ::: "memory");
    else if (nk > 1) asm volatile("s_waitcnt vmcnt(6)" ::: "memory");
    else asm volatile("s_waitcnt vmcnt(0)" ::: "memory");
    __builtin_amdgcn_s_barrier();
    G_READ(fa0, fb0, 0)
    int bnext = 1, bfree = 0;
#define G_STEP(FAC, FBC, FAN, FBN, kt) { \
        if ((kt) + 1 < nk) { \
            if ((kt) + 2 < nk) asm volatile("s_waitcnt vmcnt(6) lgkmcnt(0)" ::: "memory"); else asm volatile("s_waitcnt vmcnt(0) lgkmcnt(0)" ::: "memory"); \
            __builtin_amdgcn_s_barrier();                   \
            if ((kt) + 3 < nk) G_ISSUE((kt) + 3, bfree) \
            G_READ(FAN, FBN, bnext) \
        } \
        G_MMA(FAC, FBC) \
        bfree = bnext; bnext = (bnext == 2) ? 0 : bnext + 1; }
    for (int kt = 0; kt < nk; kt += 2) {
        G_STEP(fa0, fb0, fa1, fb1, kt)
        G_STEP(fa1, fb1, fa0, fb0, kt + 1)
    }
    __builtin_amdgcn_s_barrier();
#undef G_READ
#undef G_MMA
#undef G_STEP
#undef G_ISSUE
}

__device__ __forceinline__ int xcd_item(int bid, int nb, int k, int nitems) {
    if (nb & 7) return bid + k * nb;
    const int per = nb >> 3, chunk = (nitems + 7) >> 3;
    const int j = k * per + (bid >> 3);
    return (j < chunk) ? (bid & 7) * chunk + j : nitems;
}
struct GUnit { int pm, pn; };
constexpr int G8_HTB = 128 * 64 * 2;
__device__ __forceinline__ int g8_lds_byte(int r, int c) { const int st = (r >> 4) * 2 + (c >> 5), rr = r & 15, cc = c & 31, ob = rr * 64 + cc * 2; return st * 1024 + (ob ^ (((ob >> 9) & 1) << 5)); }
__device__ __forceinline__ void g8_stage_rc(int b, int& R, int& C) { const int st = b / 1024, sb = b % 1024, swz = sb ^ (((sb >> 9) & 1) << 5); R = (st >> 1) * 16 + swz / 64; C = (st & 1) * 32 + (swz % 64) / 2; }
__host__ __device__ __forceinline__ int perm32(int rho) { const int n = rho >> 4, i = rho & 15; return 8 * (i >> 2) + 4 * n + (i & 3); }

template <class Epi, class Sched>
__device__ __forceinline__ void gemm256(char* smem, const char* Ab, int K, const Sched& S, const Epi& E) {
    LAS3 unsigned char* lds = (LAS3 unsigned char*)smem;
    const int tid = get_tid(), wid = __builtin_amdgcn_readfirstlane(tid >> 6), lane = tid & 63, wr = wid >> 2, wc = wid & 3, fr = lane & 15, fq = lane >> 4;
    int nt = K >> 6; asm volatile("" : "+s"(nt));
    unsigned voffB[2], voffA[2][2];
#pragma unroll
    for (int i = 0; i < 2; ++i) { int sR, sC; g8_stage_rc(tid * 16 + i * 8192, sR, sC); voffB[i] = (unsigned)(sR * K + sC) * 2u; }
#define G8_AOFFS(un) do { const int t3_ = get_tid(); _Pragma("unroll") for (int i = 0; i < 2; ++i) { int sR, sC; g8_stage_rc(t3_ * 16 + i * 8192, sR, sC); \
        _Pragma("unroll") for (int h = 0; h < 2; ++h) voffA[h][i] = S.a_off(un, h, sR) + (unsigned)sC * 2u; } } while (0)
    const size_t kstep = 128;
    const size_t hstep = (size_t)128 * K * 2;
    const unsigned ldsw = (unsigned)wid * 1024u;
    const int aoff = g8_lds_byte(wr * 64 + fr, fq * 8), boff = g8_lds_byte(wc * 32 + fr, fq * 8);
#define G8_SA(b, h) (((b) * 2 + (h)) * G8_HTB)
#define G8_SB(b, h) ((4 + (b) * 2 + (h)) * G8_HTB)
#define G8_STAGE2(bufoff, gbase, v0, v1) do { \
        __builtin_amdgcn_global_load_lds((const GAS1 unsigned*)((const char*)(gbase) + (v0)), (LAS3 unsigned*)(lds + (bufoff) + ldsw), 16, 0, 0); \
        __builtin_amdgcn_global_load_lds((const GAS1 unsigned*)((const char*)(gbase) + (v1)), (LAS3 unsigned*)(lds + (bufoff) + ldsw + 8192), 16, 0, 0); } while (0)
#define G8_STAGEB(bufoff, gbase) G8_STAGE2(bufoff, gbase, voffB[0], voffB[1])
#define G8_LDA(dst, b, h) do { _Pragma("unroll") for (int m = 0; m < 4; ++m) _Pragma("unroll") for (int k = 0; k < 2; ++k) dst[m][k] = *(const LAS3 bf16x8*)(lds + G8_SA(b, h) + aoff + m * 2048 + k * 1024); } while (0)
#define G8_LDB(dst, b, h) do { _Pragma("unroll") for (int n = 0; n < 2; ++n) _Pragma("unroll") for (int k = 0; k < 2; ++k) dst[n][k] = *(const LAS3 bf16x8*)(lds + G8_SB(b, h) + boff + n * 2048 + k * 1024); } while (0)
#define G8_MMA(ai, bj, At, Bt) do { __builtin_amdgcn_s_setprio(1); _Pragma("unroll") for (int m = 0; m < 4; ++m) _Pragma("unroll") for (int n = 0; n < 2; ++n) _Pragma("unroll") for (int k = 0; k < 2; ++k) \
        acc[ai][bj][m][n] = __builtin_amdgcn_mfma_f32_16x16x32_bf16(Bt[n][k], At[m][k], acc[ai][bj][m][n], 0, 0, 0); __builtin_amdgcn_s_setprio(0); } while (0)
#define G8_WAIT_V(n) asm volatile("s_waitcnt vmcnt(" #n ")" ::: "memory")
#define G8_WAIT_L(n) asm volatile("s_waitcnt lgkmcnt(" #n ")" ::: "memory")
#define G8_BAR __builtin_amdgcn_s_barrier()
#define G8_SCHED __builtin_amdgcn_sched_barrier(0)
    GUnit cur, nxt; int ui = 0;
    if (!S.next(0, cur)) return;
    f32x4 acc[2][2][4][2];
#pragma unroll
    for (int a = 0; a < 2; ++a)
#pragma unroll
        for (int b = 0; b < 2; ++b)
#pragma unroll
            for (int m = 0; m < 4; ++m)
#pragma unroll
                for (int n = 0; n < 2; ++n) acc[a][b][m][n] = (f32x4){0.f, 0.f, 0.f, 0.f};
    bf16x8 At[4][2], B0[2][2], B1[2][2];
    G8_AOFFS(cur);
    const char* cB = S.b_ptr(cur);
    G8_STAGEB(G8_SB(0, 0), cB); G8_STAGE2(G8_SA(0, 0), Ab, voffA[0][0], voffA[0][1]); G8_STAGEB(G8_SB(0, 1), cB + hstep); G8_STAGE2(G8_SA(0, 1), Ab, voffA[1][0], voffA[1][1]);
    if (wr == 1) G8_BAR;
    G8_WAIT_V(4); G8_BAR;
    G8_STAGEB(G8_SB(1, 0), cB + kstep); G8_STAGE2(G8_SA(1, 0), Ab + kstep, voffA[0][0], voffA[0][1]); G8_STAGEB(G8_SB(1, 1), cB + hstep + kstep);
    G8_WAIT_V(6); G8_BAR;
    for (;;) {
        const bool has_next = S.next(ui + 1, nxt);
        const char* nB = has_next ? S.b_ptr(nxt) : cB;
        for (int t = 0; t < nt; t += 2) {
            const bool last = (t == nt - 2);
            const char* a1 = Ab + (size_t)(t + 1) * kstep;
            const unsigned va10 = voffA[1][0], va11 = voffA[1][1];
            if (last && has_next) G8_AOFFS(nxt);
            const char* a2 = last ? Ab : Ab + (size_t)(t + 2) * kstep; const char* b2 = last ? nB : cB + (size_t)(t + 2) * kstep;
            const char* a3 = a2 + kstep; const char* b3 = b2 + kstep;
            G8_LDB(B0, 0, 0); G8_SCHED; G8_LDA(At, 0, 0); G8_STAGE2(G8_SA(1, 1), a1, va10, va11);
            G8_WAIT_L(8); G8_BAR; G8_WAIT_L(0); G8_MMA(0, 0, At, B0); G8_BAR; G8_SCHED;
            G8_LDB(B1, 0, 1); G8_STAGEB(G8_SB(0, 0), b2);
            G8_BAR; G8_WAIT_L(0); G8_MMA(0, 1, At, B1); G8_BAR;
            G8_LDA(At, 0, 1); G8_STAGE2(G8_SA(0, 0), a2, voffA[0][0], voffA[0][1]);
            G8_BAR; G8_WAIT_L(0); G8_MMA(1, 0, At, B0); G8_BAR; G8_SCHED;
            G8_STAGEB(G8_SB(0, 1), b2 + hstep);
            G8_WAIT_V(6); G8_BAR; G8_MMA(1, 1, At, B1); G8_BAR;
            G8_LDB(B0, 1, 0); G8_SCHED; G8_LDA(At, 1, 0); G8_STAGE2(G8_SA(0, 1), a2, voffA[1][0], voffA[1][1]);
            G8_WAIT_L(8); G8_BAR; G8_WAIT_L(0); G8_MMA(0, 0, At, B0); G8_BAR; G8_SCHED;
            G8_LDB(B1, 1, 1); G8_STAGEB(G8_SB(1, 0), b3);
            G8_BAR; G8_WAIT_L(0); G8_MMA(0, 1, At, B1); G8_BAR;
            G8_LDA(At, 1, 1); G8_STAGE2(G8_SA(1, 0), a3, voffA[0][0], voffA[0][1]);
            G8_BAR; G8_WAIT_L(0); G8_MMA(1, 0, At, B0); G8_BAR; G8_SCHED;
            G8_STAGEB(G8_SB(1, 1), b3 + hstep);
            G8_WAIT_V(6); G8_BAR; G8_MMA(1, 1, At, B1); G8_BAR;
        }
        E(acc, cur, wr, wc, fr, fq);
        if (!has_next) break;
#pragma unroll
        for (int a = 0; a < 2; ++a)
#pragma unroll
            for (int b = 0; b < 2; ++b)
#pragma unroll
                for (int m = 0; m < 4; ++m)
#pragma unroll
                    for (int n = 0; n < 2; ++n) acc[a][b][m][n] = (f32x4){0.f, 0.f, 0.f, 0.f};
        cur = nxt; cB = nB; ++ui;
    }
    G8_WAIT_V(0);
    if (wr == 0) G8_BAR;
    G8_BAR;
#undef G8_SA
#undef G8_AOFFS
#undef G8_SB
#undef G8_STAGE2
#undef G8_STAGEB
#undef G8_LDA
#undef G8_LDB
#undef G8_MMA
#undef G8_WAIT_V
#undef G8_WAIT_L
#undef G8_BAR
#undef G8_SCHED
}
struct DenseSched {
    int nM, nN, nwg, G, c, K; const char* Bt;
    __device__ __forceinline__ void init(int M, int N, int K_, const void* Bt_, int G_, int c_) { nM = M >> 8; nN = N >> 8; nwg = nM * nN; G = G_; c = c_; K = K_; Bt = (const char*)Bt_; }
    __device__ __forceinline__ bool next(int i, GUnit& u) const {
        const int L = i * G + c; if (L >= nwg) return false;
        int wgid = L; { const int q = nwg >> 3, r = nwg & 7, xcd = wgid & 7, off = wgid >> 3; wgid = (xcd < r ? xcd * (q + 1) : r * (q + 1) + (xcd - r) * q) + off; }
        const int nig = 8 * nN, gid = wgid / nig, fm = gid * 8, gsz = (nM - fm) < 8 ? (nM - fm) : 8, w = wgid - gid * nig;
        u.pn = w / gsz; u.pm = fm + (w - u.pn * gsz); return true;
    }
    __device__ __forceinline__ unsigned a_off(const GUnit& u, int h, int R) const { return (unsigned)((u.pm * 256 + h * 128 + R) * K) * 2u; }
    __device__ __forceinline__ const char* b_ptr(const GUnit& u) const { return Bt + (size_t)u.pn * 256 * K * 2; }
};

template <class SRC>
__device__ __forceinline__ void convert_wT(const float* __restrict__ W, int K, int N, u16* __restrict__ WT, int rows, SRC src, int gtid, int gnt) {
    const int kch = K >> 3;
    const int total = rows * kch;
    for (int i = gtid; i < total; i += gnt) {
        const int kc = i / rows, j = i - kc * rows;
        const int sc = src(j);
        uint4 v = make_uint4(0u, 0u, 0u, 0u);
        if (sc >= 0) {
            const float* wp = W + (size_t)(kc * 8) * N + sc;
            v.x = pack2(wp[0], wp[(size_t)N]); v.y = pack2(wp[2 * (size_t)N], wp[3 * (size_t)N]);
            v.z = pack2(wp[4 * (size_t)N], wp[5 * (size_t)N]); v.w = pack2(wp[6 * (size_t)N], wp[7 * (size_t)N]);
        }
        *(uint4*)&WT[(size_t)j * K + kc * 8] = v;
    }
}

__device__ void ph_prologue(const P& p, int bid, int nb, char* smem) {
    const int tid = get_tid(), lane = tid & 63, wv = tid >> 6;
    if (bid >= 1 && bid <= 64) {
        const int j = tid & 255; const bool isv = tid >= 256;
        const float* pe = isv ? p.pe_v : p.pe_k; const float* w1 = isv ? p.w1_v : p.w1_k;
        const int kb = (bid - 1) * 32;
        float a0 = 0.f, a1 = 0.f;
#pragma unroll 4
        for (int k = kb; k < kb + 32; k += 2) { a0 += pe[k] * w1[(size_t)k * 256 + j]; a1 += pe[k + 1] * w1[(size_t)(k + 1) * 256 + j]; }
        atomicAdd(&(isv ? p.cb1v : p.cb1k)[j], a0 + a1);
    }
    if (bid == 0) {
        if (tid < 32) { p.counts[tid] = 0; p.cursor[tid] = 0; }
        for (int i = tid; i < 8 * 64; i += NT) {
            const int bg = i >> 6, d = i & 63;
            p.kcb[((size_t)bg * 512 + 511) * 64 + d] = 0;
            p.vcT[(((size_t)bg * 8 + 7) * 64 + d) * 64 + 63] = 0;
        }
    }
    {
        const int gtid = bid * NT + tid, gnt = nb * NT;
        convert_wT(p.w_in, D_, CIN, p.winT, 3328, [](int j) {
            const int t = j >> 8, s = j & 255;
            if (t < 5) {
                const int bj = s >> 7, wc = (s >> 5) & 3, n = (s >> 4) & 1, i = s & 15;
                const int dim = 32 * bj + 8 * (i >> 2) + 4 * n + (i & 3), hq = 4 * t + wc;
                int hb;
                if (hq < 8) hb = 64 * hq;
                else { const int k = (hq - 8) >> 1; hb = (k == 0 ? 512 : (k == 1 ? 640 : (k == 2 ? 768 : (k == 3 ? 1024 : (k == 4 ? 896 : 1152))))) + 64 * (hq & 1); }
                return hb + dim;
            }
            const int c = (s & ~31) + perm32(s & 31);
            if (t < 12) return 1304 + (t - 5) * 256 + c;
            return c < 24 ? 1280 + c : -1; }, gtid, gnt);
        convert_wT(p.w_in, D_, CIN, p.wgT, 2048, [](int j) { return 3096 + (j & ~31) + perm32(j & 31); }, gtid, gnt);
        convert_wT(p.wpa, 512, D_, p.wpaT, 1024, [](int j) { return (j & ~31) + perm32(j & 31); }, gtid, gnt);
        convert_wT(p.wpb, 512, D_, p.wpbT, 1024, [](int j) { return (j & ~31) + perm32(j & 31); }, gtid, gnt);
        convert_wT(p.wout, D_, D_, p.woutT, 1024, [](int j) { return j; }, gtid, gnt);
        convert_wT(p.w2, 64, 512, p.w2T, 512, [](int j) { return j; }, gtid, gnt);
        convert_wT(p.w1_k, 2048, 256, p.cw1Tk, 256, [](int j) { return j; }, gtid, gnt);
        convert_wT(p.w1_v, 2048, 256, p.cw1Tv, 256, [](int j) { return j; }, gtid, gnt);
        convert_wT(p.w2_k, 256, 64, p.cw2Tk, 128, [](int j) { return j < 64 ? j : -1; }, gtid, gnt);
        convert_wT(p.w2_v, 256, 64, p.cw2Tv, 128, [](int j) { return j < 64 ? j : -1; }, gtid, gnt);
        convert_wT(p.a2, 64, 512, p.a2T, 512, [](int j) { return j; }, gtid, gnt);
        convert_wT(p.g2, 128, 512, p.g2T, 512, [](int j) { return j; }, gtid, gnt);
    }
    for (int row = bid * NW + wv; row < NTOK; row += nb * NW) {
        const float* xr = p.x + (size_t)row * D_;
        float v[16];
        float ss = 0.f;
#pragma unroll
        for (int i = 0; i < 4; i++) {
            float4 t = *(const float4*)&xr[i * 256 + lane * 4];
            v[4 * i] = t.x; v[4 * i + 1] = t.y; v[4 * i + 2] = t.z; v[4 * i + 3] = t.w;
            ss += t.x * t.x + t.y * t.y + t.z * t.z + t.w * t.w;
        }
        ss = wave_sum(ss);
        const float rs = rsqrtf(ss * (1.f / D_) + 1e-6f);
#pragma unroll
        for (int i = 0; i < 4; i++) {
            const int c = i * 256 + lane * 4;
            float4 g = *(const float4*)&p.g_mix[c];
            uint2 o;
            o.x = pack2(v[4 * i] * rs * g.x, v[4 * i + 1] * rs * g.y);
            o.y = pack2(v[4 * i + 2] * rs * g.z, v[4 * i + 3] * rs * g.w);
            *(uint2*)&p.hbuf[(size_t)row * D_ + c] = o;
        }
    }
}

__device__ __forceinline__ uint4 pack8(const f32x4& a, const f32x4& b) { uint4 o; o.x = pack2(a[0], a[1]); o.y = pack2(a[2], a[3]); o.z = pack2(b[0], b[1]); o.w = pack2(b[2], b[3]); return o; }
struct EpiInproj {
    const P* pp;
    __device__ __forceinline__ void operator()(const f32x4 (&acc)[2][2][4][2], const GUnit& u, int, int, int, int) const {
        const int t2_ = get_tid(), wid_ = __builtin_amdgcn_readfirstlane(t2_ >> 6), wr = wid_ >> 2, wc = wid_ & 3, fr = t2_ & 15, fq = (t2_ >> 4) & 3;
        const P& p = *pp;
        const int pn = u.pn;
        const int rowb = u.pm * 256 + wr * 64;
        if (pn < 4) {
            const int hq = 4 * pn + wc;
            const bool rope = !(pn == 2 && wc >= 2);
            u16* dst; size_t rstride; int cofs;
            if (pn < 2) { dst = p.q; rstride = 512; cofs = hq * 64; }
            else { dst = (pn == 2) ? (wc < 2 ? p.kc : p.vc) : (wc < 2 ? p.ksl : p.kwn); rstride = 64; cofs = 0; }
            const int g = wc & 1;
#pragma unroll
            for (int ai = 0; ai < 2; ++ai)
#pragma unroll
                for (int m = 0; m < 4; ++m) {
                    const int row = rowb + ai * 128 + m * 16 + fr;
                    f32x4 o1[2], o2[2];
#pragma unroll
                    for (int n = 0; n < 2; ++n) { o1[n] = acc[ai][0][m][n]; o2[n] = acc[ai][1][m][n]; }
                    if (rope) {
                        const double posd = (double)p.pos[row];
#pragma unroll
                        for (int n = 0; n < 2; ++n)
#pragma unroll
                            for (int j = 0; j < 4; ++j) {
                                const double tr = posd * ROPE_FREQ[8 * fq + 4 * n + j] * 0.15915494309189535;
                                const float fr_ = (float)(tr - rint(tr));
                                const float cs = __builtin_amdgcn_cosf(fr_), sn = __builtin_amdgcn_sinf(fr_);
                                const float x1 = o1[n][j], x2 = o2[n][j];
                                o1[n][j] = x1 * cs - x2 * sn; o2[n][j] = x1 * sn + x2 * cs;
                            }
                    }
                    size_t ro;
                    if (pn < 2) {
#pragma unroll
                        for (int n = 0; n < 2; ++n)
#pragma unroll
                            for (int j = 0; j < 4; ++j) { o1[n][j] *= QSCALE; o2[n][j] *= QSCALE; }
                        ro = (size_t)row * 512 + cofs + 8 * fq;
                    } else {
                        const int bb = row >> 13, t = row & (S_ - 1);
                        ro = ((size_t)(bb * 2 + g) * S_ + t) * 64 + 8 * fq;
                    }
                    *(uint4*)&dst[ro] = pack8(o1[0], o1[1]);
                    *(uint4*)&dst[ro + 32] = pack8(o2[0], o2[1]);
                }
        } else if (pn == 4) {
            u16* dst = (wc < 2) ? p.vslT : p.vwnT;
            const int g = wc & 1;
#pragma unroll
            for (int ai = 0; ai < 2; ++ai) {
                const int r0 = rowb + ai * 128, bb = r0 >> 13, tb = r0 & (S_ - 1);
                u16* base = dst + ((size_t)(bb * 2 + g) * 128 + (tb >> 6)) * 4096;
#pragma unroll
                for (int m = 0; m < 4; ++m)
#pragma unroll
                    for (int bj = 0; bj < 2; ++bj)
#pragma unroll
                        for (int n = 0; n < 2; ++n)
#pragma unroll
                            for (int j = 0; j < 4; ++j)
                                base[(32 * bj + 8 * fq + 4 * n + j) * 64 + m * 16 + fr] = f2bf(acc[ai][bj][m][n][j]);
            }
        } else if (pn < 12) {
            const int cb = (pn - 5) * 256 + wc * 32 + 8 * fq;
#pragma unroll
            for (int ai = 0; ai < 2; ++ai)
#pragma unroll
                for (int m = 0; m < 4; ++m) {
                    const size_t ro = (size_t)(rowb + ai * 128 + m * 16 + fr) * CRW + cb;
#pragma unroll
                    for (int bj = 0; bj < 2; ++bj) *(uint4*)&p.prw[ro + bj * 128] = pack8(acc[ai][bj][m][0], acc[ai][bj][m][1]);
                }
        } else {
            if (wc == 0 && fq < 3) {
#pragma unroll
                for (int ai = 0; ai < 2; ++ai)
#pragma unroll
                    for (int m = 0; m < 4; ++m) {
                        const size_t ro = (size_t)(rowb + ai * 128 + m * 16 + fr) * 24 + 8 * fq;
#pragma unroll
                        for (int n = 0; n < 2; ++n) {
                            float4 o; o.x = sigmoidf_(acc[ai][0][m][n][0]); o.y = sigmoidf_(acc[ai][0][m][n][1]); o.z = sigmoidf_(acc[ai][0][m][n][2]); o.w = sigmoidf_(acc[ai][0][m][n][3]);
                            *(float4*)&p.nsag[ro + 4 * n] = o;
                        }
                    }
            }
        }
    }
};
__device__ void ph_inproj(const P& p, int bid, int nb, char* smem) {
    DenseSched S; S.init(NTOK, 3328, D_, p.winT, nb, bid);
    EpiInproj E{&p};
    gemm256(smem, (const char*)p.hbuf, D_, S, E);
}

__device__ __forceinline__ float gelu_tanh(float x) {
    const float c = 0.7978845608028654f;
    return 0.5f * x * (1.f + tanhf(c * (x + 0.044715f * x * x * x)));
}
__device__ void ph_compress(const P& p, int bid, int nb, char* smem) {
    u16* sm = (u16*)smem;
    const int tid = get_tid(), lane = tid & 63, wv = tid >> 6;
    const int wm = wv >> 1, wn = wv & 1;
    for (int it = bid; it < 32; it += nb) {
        const int rt = it & 1, g = (it >> 1) & 1, b = (it >> 2) & 3, kv = it >> 4;
        const int bg = b * 2 + g, i0 = rt * 256;
        const u16* src = (kv ? p.vc : p.kc) + (size_t)bg * S_ * 64;
        const u16* w1T = kv ? p.cw1Tv : p.cw1Tk;
        const u16* w2T = kv ? p.cw2Tv : p.cw2Tk;
        const float* cb1 = kv ? p.cb1v : p.cb1k;
        const float* b1 = kv ? p.b1_v : p.b1_k;
        const float* b2 = kv ? p.b2_v : p.b2_k;
        u16* hidp = p.chid + (size_t)it * 256 * 256;
        auto arow = [&](int r) { int i = i0 + r; if (i > 510) i = 510; return src + (size_t)i * 1024; };
#pragma unroll 1
        for (int ct = 0; ct < 2; ct++) {
            f32x4 acc[4][4];
            gemm_core<false>(2048, arow, w1T + (size_t)ct * 128 * 2048, 2048, acc, sm);
            const int le = get_tid() & 63;
#pragma unroll
            for (int mt = 0; mt < 4; mt++) {
                const int r = wm * 64 + mt * 16 + (le & 15);
#pragma unroll
                for (int nt = 0; nt < 4; nt++) {
                    const int col = ct * 128 + wn * 64 + nt * 16 + (le >> 4) * 4;
                    const float4 c1 = *(const float4*)&cb1[col], bb1 = *(const float4*)&b1[col];
                    f32x4 o;
                    o[0] = gelu_tanh(acc[mt][nt][0] + c1.x + bb1.x); o[1] = gelu_tanh(acc[mt][nt][1] + c1.y + bb1.y);
                    o[2] = gelu_tanh(acc[mt][nt][2] + c1.z + bb1.z); o[3] = gelu_tanh(acc[mt][nt][3] + c1.w + bb1.w);
                    *(uint2*)&hidp[r * 256 + col] = pack4(o);
                }
            }
        }
        __syncthreads();
        {
            f32x4 acc[4][4];
            gemm_core<true>(256, [&](int r) { return hidp + (size_t)r * 256; }, w2T, 256, acc, sm);
            if (wn == 0) {
#pragma unroll
                for (int mt = 0; mt < 4; mt++)
#pragma unroll
                    for (int nt = 0; nt < 4; nt++) {
                        const int d = nt * 16 + (lane & 15);
                        const int ib = i0 + wm * 64 + mt * 16 + (lane >> 4) * 4;
                        float o[4];
#pragma unroll
                        for (int j = 0; j < 4; j++) o[j] = (ib + j < NCMP) ? (acc[mt][nt][j] + b2[d]) : 0.f;
                        if (kv == 0) {
#pragma unroll
                            for (int j = 0; j < 4; j++) p.kcb[((size_t)bg * 512 + ib + j) * 64 + d] = f2bf(o[j]);
                        } else {
                            uint2 ov; ov.x = pack2(o[0], o[1]); ov.y = pack2(o[2], o[3]);
                            *(uint2*)&p.vcT[(((size_t)bg * 8 + (ib >> 6)) * 64 + d) * 64 + (ib & 63)] = ov;
                        }
                    }
            }
        }
        __syncthreads();
    }
}

#ifndef NSAPROBE
#define NSAPROBE 0
#endif
#define NSA_TS(k) if (NSAPROBE == k) ts_ = __builtin_amdgcn_s_memrealtime();
#define NSA_TE(k) if (NSAPROBE == k) tacc_ += __builtin_amdgcn_s_memrealtime() - ts_;
constexpr int KSTR = 72;
struct Sub { f32x4 O[4]; float m, l; };
#define NEG_BIG (-1.0e30f)

__device__ __forceinline__ float xq_max(float v) {
    return xrow_max(v);
}
__device__ __forceinline__ float xq_sum(float v) {
    return xrow_sum(v);
}
template <bool MASK, bool IMP, bool PV>
__device__ __forceinline__ void nsa_visit(const u16* Ks, const u16* Vs, const u16* qrow, Sub& s, int lo, int hi, int lane, float* e, float* p3) {
    const int kr = lane & 15, qq = lane >> 4;
    f32x4 S[4];
    const int qsw = ((kr & 3) >> 1) ^ ((kr >> 2) << 1);
    const bf16x8 qf0 = *(const bf16x8*)(qrow + ((qq ^ qsw) << 3)), qf1 = *(const bf16x8*)(qrow + (((4 + qq) ^ qsw) << 3));
    bf16x8 kf[4][2];
    const int swz = kr >> 1;
    {
        const char* kb_ = (const char*)Ks + kr * 128;
        const int ko0 = (qq ^ swz) << 4, ko1 = ko0 ^ 64;
#pragma unroll
        for (int kt = 0; kt < 4; kt++) { kf[kt][0] = *(const bf16x8*)(kb_ + kt * 2048 + ko0); kf[kt][1] = *(const bf16x8*)(kb_ + kt * 2048 + ko1); }
    }
    __builtin_amdgcn_sched_barrier(0);
#pragma unroll
    for (int kt = 0; kt < 4; kt++) {
        S[kt] = __builtin_amdgcn_mfma_f32_16x16x32_bf16(kf[kt][0], qf0, f32x4{0.f, 0.f, 0.f, 0.f}, 0, 0, 0);
        S[kt] = __builtin_amdgcn_mfma_f32_16x16x32_bf16(kf[kt][1], qf1, S[kt], 0, 0, 0);
    }
    union VF { bf16x8 v; uint2 h[2]; };
    float mx = NEG_BIG;
#pragma unroll
    for (int kt = 0; kt < 4; kt++)
#pragma unroll
        for (int r = 0; r < 4; r++) {
            if (MASK) { const int o = kt * 16 + qq * 4 + r; if (o < lo || o > hi) S[kt][r] = -INFINITY; }
            mx = fmaxf(mx, S[kt][r]);
        }
    mx = xq_max(mx);
    const float mnew = fmaxf(s.m, mx);
    const float alpha = __builtin_amdgcn_exp2f(s.m - mnew);
    s.m = mnew;
    float psum = 0.f;
#pragma unroll
    for (int kt = 0; kt < 4; kt++) {
#pragma unroll
        for (int r = 0; r < 4; r++) { S[kt][r] = __builtin_amdgcn_exp2f(S[kt][r] - mnew); }
        const float ee = (S[kt][0] + S[kt][1]) + (S[kt][2] + S[kt][3]);
        psum += ee;
        if (IMP) { e[kt] = ee; p3[kt] = S[kt][3]; }
    }
    s.l = s.l * alpha + psum;
    if (PV) {
        if (!__all(alpha == 1.f)) {
#pragma unroll
            for (int dt = 0; dt < 4; dt++)
#pragma unroll
                for (int r = 0; r < 4; r++) s.O[dt][r] *= alpha;
        }
        VF vf[4][2];
        {
            const char* vb_ = (const char*)Vs + kr * 128 + (qq & 1) * 8;
            const int vo = ((qq >> 1) ^ swz) << 4;
#pragma unroll
            for (int dt = 0; dt < 4; dt++)
#pragma unroll
                for (int k2 = 0; k2 < 2; k2++) {
                    vf[dt][k2].h[0] = *(const uint2*)(vb_ + dt * 2048 + (vo ^ (k2 * 64)));
                    vf[dt][k2].h[1] = *(const uint2*)(vb_ + dt * 2048 + (vo ^ (k2 * 64 + 32)));
                }
        }
        bf16x8 pb[2];
#pragma unroll
        for (int k2 = 0; k2 < 2; k2++) {
            union { bf16x8 v; unsigned u[4]; } t;
            t.u[0] = pack2(S[2 * k2][0], S[2 * k2][1]); t.u[1] = pack2(S[2 * k2][2], S[2 * k2][3]);
            t.u[2] = pack2(S[2 * k2 + 1][0], S[2 * k2 + 1][1]); t.u[3] = pack2(S[2 * k2 + 1][2], S[2 * k2 + 1][3]);
            pb[k2] = t.v;
        }
        __builtin_amdgcn_sched_barrier(0);
#pragma unroll
        for (int dt = 0; dt < 4; dt++)
#pragma unroll
            for (int k2 = 0; k2 < 2; k2++) s.O[dt] = __builtin_amdgcn_mfma_f32_16x16x32_bf16(vf[dt][k2].v, pb[k2], s.O[dt], 0, 0, 0);
    }
}
template <int MMODE, bool FIXM>
__device__ __forceinline__ void nsa_visit_g(const u16* Ks, const u16* Vs, const u16* qs, float* Os, float* Ms, float* Ls, int tok, bool valid, int lane) {
    const int kr = lane & 15, qq = lane >> 4, hh = kr & 3;
    const int row = tok * 4 + hh;
    float* orow = Os + row * 64;
    f32x4 O[4];
    const int osw = hh ^ ((tok & 3) << 2);
#pragma unroll
    for (int dt = 0; dt < 4; dt++) O[dt] = *(const f32x4*)(orow + (((dt * 4 + qq) ^ osw) << 2));
    const float m_old = Ms[row], l_old = Ls[row];
    const u16* qrow = qs + row * 64;
    const int qsw = (hh >> 1) ^ ((tok & 3) << 1);
    const bf16x8 qf0 = *(const bf16x8*)(qrow + ((qq ^ qsw) << 3)), qf1 = *(const bf16x8*)(qrow + (((4 + qq) ^ qsw) << 3));
    bf16x8 kf[4][2];
    const int swz = kr >> 1;
    {
        const char* kb_ = (const char*)Ks + kr * 128;
        const int ko0 = (qq ^ swz) << 4, ko1 = ko0 ^ 64;
#pragma unroll
        for (int kt = 0; kt < 4; kt++) { kf[kt][0] = *(const bf16x8*)(kb_ + kt * 2048 + ko0); kf[kt][1] = *(const bf16x8*)(kb_ + kt * 2048 + ko1); }
    }
    __builtin_amdgcn_sched_barrier(0);
    f32x4 S[4];
#pragma unroll
    for (int kt = 0; kt < 4; kt++) {
        S[kt] = __builtin_amdgcn_mfma_f32_16x16x32_bf16(kf[kt][0], qf0, f32x4{0.f, 0.f, 0.f, 0.f}, 0, 0, 0);
        S[kt] = __builtin_amdgcn_mfma_f32_16x16x32_bf16(kf[kt][1], qf1, S[kt], 0, 0, 0);
    }
    union VF { bf16x8 v; uint2 h[2]; };
    VF vf[4][2];
    {
        const char* vb_ = (const char*)Vs + kr * 128 + (qq & 1) * 8;
        const int vo = ((qq >> 1) ^ swz) << 4;
#pragma unroll
        for (int dt = 0; dt < 4; dt++)
#pragma unroll
            for (int k2 = 0; k2 < 2; k2++) {
                vf[dt][k2].h[0] = *(const uint2*)(vb_ + dt * 2048 + (vo ^ (k2 * 64)));
                vf[dt][k2].h[1] = *(const uint2*)(vb_ + dt * 2048 + (vo ^ (k2 * 64 + 32)));
            }
    }
    float mx = NEG_BIG;
#pragma unroll
    for (int kt = 0; kt < 4; kt++)
#pragma unroll
        for (int r = 0; r < 4; r++) {
            if (MMODE == 1) { const int o = kt * 16 + qq * 4 + r; if (o > tok) S[kt][r] = -INFINITY; }
            if (MMODE == 2) { const int o = kt * 16 + qq * 4 + r; if (o <= tok) S[kt][r] = -INFINITY; }
            if (FIXM) { if (!valid) S[kt][r] = -INFINITY; } else mx = fmaxf(mx, S[kt][r]);
        }
    float mnew = m_old, alpha = 1.f;
    if (!FIXM) {
        if (!valid) mx = NEG_BIG;
        mx = xq_max(mx);
        mnew = fmaxf(m_old, mx);
        alpha = __builtin_amdgcn_exp2f(m_old - mnew);
    }
    float psum = 0.f;
#pragma unroll
    for (int kt = 0; kt < 4; kt++) {
#pragma unroll
        for (int r = 0; r < 4; r++) { S[kt][r] = __builtin_amdgcn_exp2f(S[kt][r] - mnew); }
        psum += (S[kt][0] + S[kt][1]) + (S[kt][2] + S[kt][3]);
    }
    psum = xq_sum(psum);
    if (FIXM) { if (valid && qq == 0) Ls[row] = l_old + psum; }
    else {
        if (valid && qq == 0) { Ms[row] = mnew; Ls[row] = l_old * alpha + psum; }
#pragma unroll
        for (int dt = 0; dt < 4; dt++)
#pragma unroll
            for (int r = 0; r < 4; r++) O[dt][r] *= alpha;
    }
    bf16x8 pb[2];
#pragma unroll
    for (int k2 = 0; k2 < 2; k2++) {
        union { bf16x8 v; unsigned u[4]; } t;
        t.u[0] = pack2(S[2 * k2][0], S[2 * k2][1]); t.u[1] = pack2(S[2 * k2][2], S[2 * k2][3]);
        t.u[2] = pack2(S[2 * k2 + 1][0], S[2 * k2 + 1][1]); t.u[3] = pack2(S[2 * k2 + 1][2], S[2 * k2 + 1][3]);
        pb[k2] = t.v;
    }
    __builtin_amdgcn_sched_barrier(0);
#pragma unroll
    for (int dt = 0; dt < 4; dt++)
#pragma unroll
        for (int k2 = 0; k2 < 2; k2++) O[dt] = __builtin_amdgcn_mfma_f32_16x16x32_bf16(vf[dt][k2].v, pb[k2], O[dt], 0, 0, 0);
    if (valid) {
#pragma unroll
        for (int dt = 0; dt < 4; dt++) *(f32x4*)(orow + (((dt * 4 + qq) ^ osw) << 2)) = O[dt];
    }
}
__device__ __forceinline__ void nsa_fold_lds(float* Os, float* Ms, float* Ls, int row, int qq, int hh, f32x4 (&T)[4], float gate, bool reset) {
    const float lt = Ls[row];
    const float sc = (lt > 0.f) ? gate / lt : 0.f;
#pragma unroll
    for (int dt = 0; dt < 4; dt++) {
        float* op = Os + row * 64 + (((dt * 4 + qq) ^ hh ^ (((row >> 2) & 3) << 2)) << 2);
        const f32x4 o = *(const f32x4*)op;
#pragma unroll
        for (int r = 0; r < 4; r++) T[dt][r] += o[r] * sc;
        if (reset) *(f32x4*)op = f32x4{0.f, 0.f, 0.f, 0.f};
    }
    asm volatile("s_waitcnt lgkmcnt(0)" ::: "memory");
    if (reset && qq == 0) { Ms[row] = NEG_BIG; Ls[row] = 0.f; }
}
template <int MODE>
__device__ __forceinline__ void nsa_fold(Sub& s, f32x4 (&T)[4], float gate) {
    const float lt = xq_sum(s.l);
    const float sc = (lt > 0.f) ? gate / lt : 0.f;
#pragma unroll
    for (int dt = 0; dt < 4; dt++)
#pragma unroll
        for (int r = 0; r < 4; r++) {
            const float v = s.O[dt][r] * sc;
            T[dt][r] = (MODE == 1) ? T[dt][r] + v : v;
            s.O[dt][r] = 0.f;
        }
    s.m = NEG_BIG; s.l = 0.f;
}

constexpr int NSA_R = 3;
template <bool HASV, class KSrc, class VSrc, class Body>
__device__ __forceinline__ void nsa_stream(char* ring, int n, KSrc ksrc, VSrc vsrc, Body body) {
    const int t = get_tid();
    const int so = (t >> 3) * 64 + (((t & 7) ^ ((t >> 4) & 7)) << 3);
    char* dl = ring + t * 16;
#define NSA_ISSUE(i, slot) { glds16(ksrc(i) + so, dl + (slot) * 16384); if (HASV) glds16(vsrc(i) + so, dl + (slot) * 16384 + 8192); }
    asm volatile("s_waitcnt lgkmcnt(0)" ::: "memory");
    __builtin_amdgcn_s_barrier();
    if (n > 0) NSA_ISSUE(0, 0)
    if (n > 1) NSA_ISSUE(1, 1)
    int slot = 0;
    for (int i = 0; i < n; i++) {
        if (i + 1 < n) { if (HASV) asm volatile("s_waitcnt vmcnt(2)" ::: "memory"); else asm volatile("s_waitcnt vmcnt(1)" ::: "memory"); }
        else asm volatile("s_waitcnt vmcnt(0)" ::: "memory");
        asm volatile("s_waitcnt lgkmcnt(0)" ::: "memory");
        __builtin_amdgcn_s_barrier();
        asm volatile("" ::: "memory");
        const int sl2 = (slot == 0) ? 2 : slot - 1;
        if (i + 2 < n) NSA_ISSUE(i + 2, sl2)
        body(i, (const u16*)(ring + slot * 16384), (const u16*)(ring + slot * 16384 + 8192));
        slot = (slot == 2) ? 0 : slot + 1;
    }
#undef NSA_ISSUE
}
#define NSA_TOK(u) const int t3_ = get_tid(); const size_t ntk_ = (size_t)b * S_ + t0 + 8 * (t3_ >> 6) + 4 * (u) + ((t3_ & 15) >> 2); const int hd_ = g * 4 + (t3_ & 3);
__device__ void ph_nsa(const P& p, int bid, int nb, char* smem) {
    char* ring = smem;
    unsigned* selm = (unsigned*)(smem + NSA_R * 16384);
    int* blist = (int*)(selm + 256);
    int* nlistp = blist + 128;
    int* lcnt = nlistp + 4;
    unsigned char* lists = (unsigned char*)(lcnt + 128);
    float* Ms = (float*)(lists + 128 * 64);
    float* Ls = Ms + 256;
    float* Os = Ls + 256;
    float* impl = Os;
    u16* qs = (u16*)(Os + 64 * 4 * 64);
    unsigned long long ts_ = 0, tacc_ = 0;
    const int nitems = B_ * 2 * 128;
    for (int rr = 0;; rr++) {
        const int it = (rr & 1) ? (rr + 1) * nb - 1 - bid : rr * nb + bid;
        if (rr * nb >= nitems) break;
        if (it >= nitems) continue;
        const int tid = get_tid(), lane = tid & 63, wv = tid >> 6;
        const int kr = lane & 15, qq = lane >> 4, ts = kr >> 2, hh = kr & 3;
        float* myimp = impl + wv * (32 * 2 * 16);
        const int tt = 127 - (it >> 3);
        const int bg = it & 7, b = bg >> 1, g = bg & 1;
        const int t0 = tt * 64, cur = tt;
        const int head = g * 4 + hh;
        Sub st[2];
        f32x4 T[2][4];
        int tl[2]; size_t ntok[2];
        __syncthreads();
#pragma unroll
        for (int u = 0; u < 2; u++) {
            tl[u] = 8 * wv + 4 * u + ts;
            ntok[u] = (size_t)b * S_ + t0 + tl[u];
#pragma unroll
            for (int ks = 0; ks < 2; ks++) *(bf16x8*)&qs[(tl[u] * 4 + hh) * 64 + (((ks * 4 + qq) ^ (hh >> 1) ^ ((tl[u] & 3) << 1)) << 3)] = *(const bf16x8*)&p.q[ntok[u] * 512 + head * 64 + ks * 32 + qq * 8];
#pragma unroll
            for (int dt = 0; dt < 4; dt++) st[u].O[dt] = f32x4{0.f, 0.f, 0.f, 0.f};
            st[u].m = NEG_BIG; st[u].l = 0.f;
        }
        const u16* kcb = p.kcb + (size_t)bg * 512 * 64;
        const u16* vcT = p.vcT + (size_t)bg * 8 * 4096;
        int nv[2];
#pragma unroll
        for (int u = 0; u < 2; u++) { const int t = t0 + tl[u]; nv[u] = (t >= 31) ? min((t - 31) / 16 + 1, NCMP) : 0; }
        const int tmax = t0 + 63;
        const int nvmax = (tmax >= 31) ? min((tmax - 31) / 16 + 1, NCMP) : 0;
        const int nvb = (nvmax + 63) >> 6;
        NSA_TS(1)
        __syncthreads();
        nsa_stream<false>(ring, nvb, [&](int kb) { return kcb + (size_t)kb * 4096; }, [&](int kb) { return vcT + (size_t)kb * 4096; },
            [&](int kb, const u16* Ks, const u16* Vs) {
#pragma unroll
                for (int u = 0; u < 2; u++) nsa_visit<true, false, false>(Ks, Vs, qs + (tl[u] * 4 + hh) * 64, st[u], 0, nv[u] - kb * 64 - 1, lane, nullptr, nullptr);
            });
        float invl[2];
#pragma unroll
        for (int u = 0; u < 2; u++) { const float lt = xq_sum(st[u].l); invl[u] = (lt > 0.f) ? 1.f / lt : 0.f; st[u].l = 0.f; }
        float carry[2] = {0.f, 0.f};
        nsa_stream<true>(ring, nvb, [&](int kb) { return kcb + (size_t)kb * 4096; }, [&](int kb) { return vcT + (size_t)kb * 4096; },
            [&](int kb, const u16* Ks, const u16* Vs) {
#pragma unroll
            for (int u = 0; u < 2; u++) {
                float e[4], p3[4];
                nsa_visit<true, true, true>(Ks, Vs, qs + (tl[u] * 4 + hh) * 64, st[u], 0, nv[u] - kb * 64 - 1, lane, e, p3);
#pragma unroll
                for (int kt = 0; kt < 4; kt++) {
                    float ev = e[kt] * invl[u], pv = p3[kt] * invl[u];
                    ev += dppf<0xB1>(ev); ev += dppf<0x4E>(ev);
                    pv += dppf<0xB1>(pv); pv += dppf<0x4E>(pv);
                    const float sh = __shfl(pv, (lane - 16) & 63, 64);
                    const float nbv = (qq == 0) ? carry[u] : sh;
                    carry[u] = sh;
                    myimp[((kb * 4 + kt) * 2 + u) * 16 + ts * 4 + qq] = ev + nbv;
                }
            }
            });
        NSA_TE(1)
        NSA_TS(2)
#pragma unroll
        for (int u = 0; u < 2; u++) {
            float mv[8];
#pragma unroll
            for (int i = 0; i < 8; i++) {
                const int kk = 8 * hh + i, j = 4 * kk + qq;
                const float v = myimp[(kk * 2 + u) * 16 + ts * 4 + qq];
                mv[i] = (j >= 1 && j <= cur - 2) ? v : -1.f;
            }
            unsigned sel = 0u;
            const int ncand = max(0, cur - 2);
            const int nforced = (cur >= 2) ? 3 : (cur + 1);
            const int need = 16 - nforced;
            if (ncand <= need) {
#pragma unroll
                for (int i = 0; i < 8; i++) if (mv[i] >= 0.f) sel |= (1u << i);
            } else {
                for (int rnd = 0; rnd < need; rnd++) {
                    const float b01 = fmaxf(mv[0], mv[1]), b23 = fmaxf(mv[2], mv[3]), b45 = fmaxf(mv[4], mv[5]), b67 = fmaxf(mv[6], mv[7]);
                    float best = fmaxf(fmaxf(b01, b23), fmaxf(b45, b67));
                    int bi = 7;
#pragma unroll
                    for (int i = 6; i >= 0; i--) bi = (mv[i] == best) ? i : bi;
                    int bj = (best >= 0.f) ? (4 * (8 * hh + bi) + qq) : 9999;
#define TK_MERGE(ov, oj) { const float v2_ = (ov); const int j2_ = (oj); const bool tk_ = (v2_ > best) || (v2_ == best && j2_ < bj); best = tk_ ? v2_ : best; bj = tk_ ? j2_ : bj; }
                    TK_MERGE(dppf<0xB1>(best), __builtin_amdgcn_update_dpp(0, bj, 0xB1, 0xF, 0xF, true))
                    TK_MERGE(dppf<0x4E>(best), __builtin_amdgcn_update_dpp(0, bj, 0x4E, 0xF, 0xF, true))
                    {
                        auto rv = __builtin_amdgcn_permlane16_swap(__float_as_uint(best), __float_as_uint(best), false, false);
                        auto rj = __builtin_amdgcn_permlane16_swap((unsigned)bj, (unsigned)bj, false, false);
                        float v0 = __uint_as_float(rv[0]), v1 = __uint_as_float(rv[1]); int j0 = (int)rj[0], j1 = (int)rj[1];
                        if (v1 > v0 || (v1 == v0 && j1 < j0)) { v0 = v1; j0 = j1; }
                        rv = __builtin_amdgcn_permlane32_swap(__float_as_uint(v0), __float_as_uint(v0), false, false);
                        rj = __builtin_amdgcn_permlane32_swap((unsigned)j0, (unsigned)j0, false, false);
                        best = __uint_as_float(rv[0]); bj = (int)rj[0];
                        const float v2 = __uint_as_float(rv[1]); const int j2 = (int)rj[1];
                        if (v2 > best || (v2 == best && j2 < bj)) { best = v2; bj = j2; }
                    }
#undef TK_MERGE
                    const bool mine = (bj < 512) && ((bj >> 5) == hh) && ((bj & 3) == qq);
                    const int li = (bj >> 2) & 7;
#pragma unroll
                    for (int i = 0; i < 8; i++) mv[i] = (mine && li == i) ? -1.f : mv[i];
                    if (mine) sel |= (1u << li);
                }
            }
            if (qq == 0 && hh == 0) sel |= 1u;
            if ((cur & 3) == qq && (cur >> 5) == hh) sel |= (1u << ((cur >> 2) & 7));
            if (cur >= 1 && ((cur - 1) & 3) == qq && ((cur - 1) >> 5) == hh) sel |= (1u << (((cur - 1) >> 2) & 7));
            unsigned w = sel << (8 * hh);
            w |= (unsigned)__builtin_amdgcn_update_dpp(0, (int)w, 0xB1, 0xF, 0xF, true);
            w |= (unsigned)__builtin_amdgcn_update_dpp(0, (int)w, 0x4E, 0xF, 0xF, true);
            if (hh == 0) selm[tl[u] * 4 + qq] = w;
        }
        NSA_TE(2)
        NSA_TS(3)
        __syncthreads();
#pragma unroll
        for (int u = 0; u < 2; u++) { NSA_TOK(u) nsa_fold<0>(st[u], T[u], p.nsag[ntk_ * 24 + hd_ * 3 + 0]); }
        {
            const int t2 = get_tid();
#pragma unroll
            for (int i = 0; i < 8; i++) *(f32x4*)&Os[(i * NT + t2) * 4] = f32x4{0.f, 0.f, 0.f, 0.f};
            if (t2 < 256) { Ms[t2] = NEG_BIG; Ls[t2] = 0.f; }
            unsigned long long tm = 0ull; int lrank = 0;
            if (t2 < 128) {
                const int j = t2;
                for (int tk = 0; tk < 64; tk++) tm |= (unsigned long long)((selm[tk * 4 + (j & 3)] >> (j >> 2)) & 1u) << tk;
                if (j > cur) tm = 0ull;
                const unsigned long long bal = __ballot(tm != 0ull);
                lrank = __popcll(bal & ((1ull << (t2 & 63)) - 1ull));
                if ((t2 & 63) == 0) nlistp[t2 >> 6] = __popcll(bal);
            }
            __syncthreads();
            if (t2 < 128 && tm != 0ull) {
                const int pos = lrank + ((t2 >= 64) ? nlistp[0] : 0);
                blist[pos] = t2; lcnt[pos] = __popcll(tm);
                int c = 0;
                while (tm) { lists[pos * 64 + c] = (unsigned char)(__ffsll((long long)tm) - 1); c++; tm &= tm - 1ull; }
            }
            __syncthreads();
        }
        const int nlist = nlistp[0] + nlistp[1];
        NSA_TE(3)
        NSA_TS(4)
        const u16* ksl = p.ksl + (size_t)bg * S_ * 64;
        const u16* vslT = p.vslT + (size_t)bg * 128 * 4096;
        {
            const int t4 = get_tid(), wv4 = __builtin_amdgcn_readfirstlane(t4 >> 6), ts4 = (t4 & 15) >> 2;
            const int td = t4 & 255;
            const int so = (td >> 3) * 64 + (((td & 7) ^ ((td >> 4) & 7)) << 3);
            char* dl = ring + td * 16;
#define NSA_RI(i) (nlist - 1 - (i))
#define NSA_ISSUE2(i, slot) if (wv4 >= 4) { const int jj_ = blist[NSA_RI(i)]; const u16* kp_ = ksl + (size_t)jj_ * 4096 + so; const u16* vp_ = vslT + (size_t)jj_ * 4096 + so; char* d_ = dl + (slot) * 16384; \
                glds16(kp_, d_); glds16(kp_ + 2048, d_ + 4096); glds16(vp_, d_ + 8192); glds16(vp_ + 2048, d_ + 12288); }
            asm volatile("s_waitcnt lgkmcnt(0)" ::: "memory");
            __builtin_amdgcn_s_barrier();
            if (nlist > 0) NSA_ISSUE2(0, 0)
            if (nlist > 1) NSA_ISSUE2(1, 1)
            int jn = 0, nn = 0, tokn = 0;
            if (nlist > 0) { jn = blist[NSA_RI(0)]; nn = lcnt[NSA_RI(0)]; tokn = lists[NSA_RI(0) * 64 + wv4 * 4 + ts4]; }
            int slot = 0;
            for (int i = 0; i < nlist; i++) {
                if (i + 1 < nlist) asm volatile("s_waitcnt vmcnt(4)" ::: "memory"); else asm volatile("s_waitcnt vmcnt(0)" ::: "memory");
                asm volatile("s_waitcnt lgkmcnt(0)" ::: "memory");
                __builtin_amdgcn_s_barrier();
                asm volatile("" ::: "memory");
                const int sl2 = (slot == 0) ? 2 : slot - 1;
                if (i + 2 < nlist) NSA_ISSUE2(i + 2, sl2)
                const int j = jn, n = nn, tok0 = tokn;
                if (i + 1 < nlist) { jn = blist[NSA_RI(i + 1)]; nn = lcnt[NSA_RI(i + 1)]; tokn = lists[NSA_RI(i + 1) * 64 + wv4 * 4 + ts4]; }
                const u16* Ks = (const u16*)(ring + slot * 16384); const u16* Vs = Ks + 4096;
                for (int qd = wv4; qd * 4 < n; qd += NW) {
                    const int e = qd * 4 + ts4;
                    const bool valid = e < n;
                    int tok = (qd == wv4) ? tok0 : (int)lists[NSA_RI(i) * 64 + (e & 63)];
                    if (!valid) tok = 0;
                    if (j == cur) nsa_visit_g<1, false>(Ks, Vs, qs, Os, Ms, Ls, tok, valid, t4 & 63);
                    else nsa_visit_g<0, true>(Ks, Vs, qs, Os, Ms, Ls, tok, valid, t4 & 63);
                }
                slot = (slot == 2) ? 0 : slot + 1;
            }
#undef NSA_RI
#undef NSA_ISSUE2
        }
        __syncthreads();
        NSA_TE(4)
        NSA_TS(5)
#pragma unroll
        for (int u = 0; u < 2; u++) {
            NSA_TOK(u)
            const int t5 = t3_ & 63;
            nsa_fold_lds(Os, Ms, Ls, (8 * (t3_ >> 6) + 4 * u + ((t5 & 15) >> 2)) * 4 + (t5 & 3), t5 >> 4, t5 & 3, T[u], p.nsag[ntk_ * 24 + hd_ * 3 + 1], true);
        }
        const u16* kwn = p.kwn + (size_t)bg * S_ * 64;
        const u16* vwnT = p.vwnT + (size_t)bg * 128 * 4096;
        {
            const int jlo = max(0, cur - 8);
            nsa_stream<true>(ring, cur - jlo + 1, [&](int i) { return kwn + (size_t)(cur - i) * 4096; }, [&](int i) { return vwnT + (size_t)(cur - i) * 4096; },
                [&](int i, const u16* Ks, const u16* Vs) {
                    const int j = cur - i;
                    const int t4 = get_tid();
#pragma unroll
                    for (int u = 0; u < 2; u++) {
                        const int tok = 8 * (t4 >> 6) + 4 * u + ((t4 & 15) >> 2);
                        if (j == cur) nsa_visit_g<1, false>(Ks, Vs, qs, Os, Ms, Ls, tok, true, t4 & 63);
                        else if (j == cur - 8) nsa_visit_g<2, true>(Ks, Vs, qs, Os, Ms, Ls, tok, true, t4 & 63);
                        else nsa_visit_g<0, true>(Ks, Vs, qs, Os, Ms, Ls, tok, true, t4 & 63);
                    }
                });
        }
#pragma unroll
        for (int u = 0; u < 2; u++) {
            NSA_TOK(u)
            { const int t5 = t3_ & 63; nsa_fold_lds(Os, Ms, Ls, (8 * (t3_ >> 6) + 4 * u + ((t5 & 15) >> 2)) * 4 + (t5 & 3), t5 >> 4, t5 & 3, T[u], p.nsag[ntk_ * 24 + hd_ * 3 + 2], false); }
#pragma unroll
            for (int dt = 0; dt < 4; dt++) *(uint2*)&p.oa[ntk_ * 512 + hd_ * 64 + dt * 16 + ((t3_ & 63) >> 4) * 4] = pack4(T[u][dt]);
        }
        NSA_TE(5)
    }
    if (NSAPROBE) { __syncthreads(); const unsigned long long t1_ = __builtin_amdgcn_s_memrealtime(); while (__builtin_amdgcn_s_memrealtime() - t1_ < tacc_) __builtin_amdgcn_s_sleep(8); }
}

constexpr int RS = 72;
constexpr int RSLOT = 64 * RS;
__device__ __forceinline__ void mm64(const u16* A, int lda, const u16* Bz, int ldb, f32x4 (&acc)[2], int lane, int wv) {
    const int mt = wv >> 1, nt0 = (wv & 1) * 2, kr = lane & 15, qq = lane >> 4;
    bf16x8 a[2], b[2][2];
#pragma unroll
    for (int ks = 0; ks < 2; ks++) {
        a[ks] = *(const bf16x8*)&A[(mt * 16 + kr) * lda + ks * 32 + qq * 8];
#pragma unroll
        for (int i = 0; i < 2; i++) b[ks][i] = *(const bf16x8*)&Bz[((nt0 + i) * 16 + kr) * ldb + ks * 32 + qq * 8];
    }
#pragma unroll
    for (int ks = 0; ks < 2; ks++)
#pragma unroll
        for (int i = 0; i < 2; i++) acc[i] = __builtin_amdgcn_mfma_f32_16x16x32_bf16(a[ks], b[ks][i], acc[i], 0, 0, 0);
}
__device__ __forceinline__ void st_t(u16* dst, int ld, const f32x4& v, int mt, int nt, int lane) {
    uint2 o; o.x = pack2(v[0], v[1]); o.y = pack2(v[2], v[3]);
    *(uint2*)&dst[(nt * 16 + (lane & 15)) * ld + mt * 16 + (lane >> 4) * 4] = o;
}
__device__ __forceinline__ void st_n(u16* dst, int ld, const f32x4& v, int mt, int nt, int lane) {
#pragma unroll
    for (int r = 0; r < 4; r++) dst[(mt * 16 + (lane >> 4) * 4 + r) * ld + nt * 16 + (lane & 15)] = f2bf(v[r]);
}
#define ZACC(a) { a[0] = f32x4{0.f, 0.f, 0.f, 0.f}; a[1] = f32x4{0.f, 0.f, 0.f, 0.f}; }

__device__ void ph_rwkv_chunk(const P& p, int bid, int nb, char* smem) {
    u16* sl = (u16*)smem;
    float* tot = (float*)(sl + 14 * RSLOT);
    float* gl = tot + 512;
#define RW_IDX const int tid = get_tid(), lane = tid & 63, wv = tid >> 6, mt = wv >> 1, nt0 = (wv & 1) * 2, kr = lane & 15, qq = lane >> 4; (void)mt; (void)nt0; (void)kr; (void)qq; (void)lane;
    const int nitems = B_ * 128;
    for (int it0 = bid; it0 < nitems; it0 += nb) {
      const int c = it0 & 127, b = it0 >> 7;
      const size_t n0 = (size_t)b * S_ + c * 64;
      __syncthreads();
      {
          RW_IDX
          const int t = tid >> 3, part = tid & 7;
          const size_t n = n0 + t;
          const bool hasprev = (c * 64 + t) > 0;
          u16* dst = p.xact + n * 256 + part * 32;
#pragma unroll
          for (int j = 0; j < 4; j++) {
              const int col = 1536 + part * 32 + j * 8;
              const uint4 cu = *(const uint4*)&p.prw[n * CRW + col];
              uint4 pv = make_uint4(0u, 0u, 0u, 0u);
              if (hasprev) pv = *(const uint4*)&p.prw[(n - 1) * CRW + col];
              const unsigned cw[4] = {cu.x, cu.y, cu.z, cu.w}, pw[4] = {pv.x, pv.y, pv.z, pv.w};
              unsigned ow[4];
#pragma unroll
              for (int e2 = 0; e2 < 4; e2++) {
                  float x0 = __uint_as_float(cw[e2] << 16), x1 = __uint_as_float(cw[e2] & 0xFFFF0000u);
                  const float q0 = __uint_as_float(pw[e2] << 16), q1 = __uint_as_float(pw[e2] & 0xFFFF0000u);
                  x0 = x0 + (q0 - x0) * p.mu[col + 2 * e2]; x1 = x1 + (q1 - x1) * p.mu[col + 2 * e2 + 1];
                  if (part < 2) { x0 = tanhf(x0); x1 = tanhf(x1); }
                  else if (part >= 4) { x0 = sigmoidf_(x0); x1 = sigmoidf_(x1); }
                  ow[e2] = pack2(x0, x1);
              }
              *(uint4*)&dst[j * 8] = make_uint4(ow[0], ow[1], ow[2], ow[3]);
          }
      }
      __syncthreads();
      const u16* xa = p.xact + n0 * 256;
#pragma unroll 1
      for (int h = 0; h < 8; h++) {
        u16* cd = p.cdat + ((size_t)((b * 8 + h) * 128 + c)) * 4 * 4096;
        LDS_BARRIER();
        float* LW = (float*)(sl + 8 * RSLOT); float* LA = (float*)(sl + 10 * RSLOT);
        {
            RW_IDX
            bf16x8 xa_[8], wb[2][2], ab[2][2], gb[2][4];
#pragma unroll
            for (int k8 = 0; k8 < 8; k8++) xa_[k8] = *(const bf16x8*)&xa[(mt * 16 + kr) * 256 + k8 * 32 + qq * 8];
#pragma unroll
            for (int i = 0; i < 2; i++) {
                const int cc = (nt0 + i) * 16 + kr;
#pragma unroll
                for (int ks = 0; ks < 2; ks++) {
                    wb[i][ks] = *(const bf16x8*)&p.w2T[((size_t)h * 64 + cc) * 64 + ks * 32 + qq * 8];
                    ab[i][ks] = *(const bf16x8*)&p.a2T[((size_t)h * 64 + cc) * 64 + ks * 32 + qq * 8];
                }
#pragma unroll
                for (int ks = 0; ks < 4; ks++) gb[i][ks] = *(const bf16x8*)&p.g2T[((size_t)h * 64 + cc) * 128 + ks * 32 + qq * 8];
            }
            f32x4 aw[2], aa2[2], ag[2];
#pragma unroll
            for (int i = 0; i < 2; i++) {
                aw[i] = f32x4{0.f, 0.f, 0.f, 0.f}; aa2[i] = aw[i]; ag[i] = aw[i];
#pragma unroll
                for (int ks = 0; ks < 2; ks++) {
                    aw[i] = __builtin_amdgcn_mfma_f32_16x16x32_bf16(xa_[ks], wb[i][ks], aw[i], 0, 0, 0);
                    aa2[i] = __builtin_amdgcn_mfma_f32_16x16x32_bf16(xa_[2 + ks], ab[i][ks], aa2[i], 0, 0, 0);
                }
#pragma unroll
                for (int ks = 0; ks < 4; ks++) ag[i] = __builtin_amdgcn_mfma_f32_16x16x32_bf16(xa_[4 + ks], gb[i][ks], ag[i], 0, 0, 0);
            }
#pragma unroll
            for (int i = 0; i < 2; i++)
#pragma unroll
                for (int r = 0; r < 4; r++) {
                    const int t = mt * 16 + qq * 4 + r, cc = (nt0 + i) * 16 + kr;
                    const float wl = p.w0[h * 64 + cc] + aw[i][r];
                    const float z = -wl;
                    const float sp = fmaxf(z, 0.f) + log1pf(__expf(-fabsf(z)));
                    LW[t * 64 + cc] = -__expf(-sp - 0.5f);
                    LA[t * 64 + cc] = sigmoidf_(p.a0[h * 64 + cc] + aa2[i][r]);
                    p.ob[(n0 + t) * 512 + h * 64 + cc] = f2bf(ag[i][r]);
                }
        }
        LDS_BARRIER();
        {
            RW_IDX
            const int ch = h * 64 + lane;
            const float mur = p.mu[ch], muk = p.mu[512 + ch], muv = p.mu[1024 + ch];
            const float kkw = p.k_k[ch], kaw = p.k_a[ch], rkw = p.r_k[ch];
            float rr[8], k2[8], vv[8], kkn[8], aa[8], lg[8], cs[8];
            float run = 0.f;
#pragma unroll
            for (int i = 0; i < 8; i++) {
                const int t = wv * 8 + i; const size_t n = n0 + t;
                const u16* cr = p.prw + n * CRW;
                float r = bf2f(cr[ch]), k = bf2f(cr[512 + ch]), v = bf2f(cr[1024 + ch]);
                float pr = 0.f, pk = 0.f, pv = 0.f;
                if (c * 64 + t > 0) { const u16* pp = cr - CRW; pr = bf2f(pp[ch]); pk = bf2f(pp[512 + ch]); pv = bf2f(pp[1024 + ch]); }
                r = r + (pr - r) * mur; k = k + (pk - k) * muk; v = v + (pv - v) * muv;
                const float a = LA[t * 64 + lane];
                lg[i] = LW[t * 64 + lane];
                float kk = k * kkw;
                const float nrm = fmaxf(sqrtf(wave_sum(kk * kk)), 1e-12f);
                kkn[i] = kk / nrm;
                k2[i] = k * (1.f + (a - 1.f) * kaw);
                const float bon = wave_sum(r * k2[i] * rkw);
                if (lane == 0) p.bon[n * 8 + h] = bon;
                rr[i] = r; vv[i] = v; aa[i] = a;
                run += lg[i]; cs[i] = run;
            }
            tot[wv * 64 + lane] = run;
            LDS_BARRIER();
            float off = 0.f, cumL = 0.f;
#pragma unroll
            for (int w2 = 0; w2 < 8; w2++) { const float tv = tot[w2 * 64 + lane]; cumL += tv; if (w2 < wv) off += tv; }
            if (wv == 0) gl[lane] = __expf(cumL);
            unsigned pa[4], pb[4], pk4[4], pv4[4];
#pragma unroll
            for (int i = 0; i < 8; i += 2) {
                float at[2], bt[2], kt[2], rt[2];
#pragma unroll
                for (int e2 = 0; e2 < 2; e2++) {
                    const int ii = i + e2; const int t = wv * 8 + ii;
                    const float cm = off + cs[ii];
                    const float g = __expf(cm), gp = __expf(cm - lg[ii]), gi = __expf(-cm);
                    at[e2] = -kkn[ii] * gp; bt[e2] = kkn[ii] * aa[ii] * gi; kt[e2] = k2[ii] * gi; rt[e2] = rr[ii] * g;
                    sl[0 * RSLOT + t * RS + lane] = f2bf(at[e2]);
                    sl[1 * RSLOT + t * RS + lane] = f2bf(bt[e2]);
                    sl[2 * RSLOT + t * RS + lane] = f2bf(kt[e2]);
                    sl[3 * RSLOT + t * RS + lane] = f2bf(rt[e2]);
                }
                pa[i >> 1] = pack2(at[0], at[1]); pb[i >> 1] = pack2(bt[0], bt[1]);
                pk4[i >> 1] = pack2(kt[0], kt[1]); pv4[i >> 1] = pack2(vv[i], vv[i + 1]);
            }
            *(uint4*)&sl[4 * RSLOT + lane * RS + wv * 8] = make_uint4(pa[0], pa[1], pa[2], pa[3]);
            *(uint4*)&sl[5 * RSLOT + lane * RS + wv * 8] = make_uint4(pb[0], pb[1], pb[2], pb[3]);
            *(uint4*)&sl[6 * RSLOT + lane * RS + wv * 8] = make_uint4(pk4[0], pk4[1], pk4[2], pk4[3]);
            *(uint4*)&sl[7 * RSLOT + lane * RS + wv * 8] = make_uint4(pv4[0], pv4[1], pv4[2], pv4[3]);
        }
        LDS_BARRIER();
        {
            RW_IDX
            f32x4 acc[2];
            ZACC(acc); mm64(sl + 1 * RSLOT, RS, sl + 0 * RSLOT, RS, acc, lane, wv);
#pragma unroll
            for (int i = 0; i < 2; i++) {
                f32x4 pm;
#pragma unroll
                for (int r = 0; r < 4; r++) {
                    const int m = mt * 16 + qq * 4 + r, n = (nt0 + i) * 16 + kr;
                    if (!(m < n)) acc[i][r] = 0.f;
                    pm[r] = acc[i][r] + ((m == n) ? 1.f : 0.f);
                }
                st_t(sl + 8 * RSLOT, RS, acc[i], mt, nt0 + i, lane);
                st_n(sl + 9 * RSLOT, RS, acc[i], mt, nt0 + i, lane);
                st_t(sl + 13 * RSLOT, RS, pm, mt, nt0 + i, lane);
            }
            ZACC(acc); mm64(sl + 0 * RSLOT, RS, sl + 2 * RSLOT, RS, acc, lane, wv);
#pragma unroll
            for (int i = 0; i < 2; i++) {
#pragma unroll
                for (int r = 0; r < 4; r++) { const int m = mt * 16 + qq * 4 + r, n = (nt0 + i) * 16 + kr; if (!(m > n)) acc[i][r] = 0.f; }
                st_t(sl + 10 * RSLOT, RS, acc[i], mt, nt0 + i, lane);
            }
            ZACC(acc); mm64(sl + 1 * RSLOT, RS, sl + 3 * RSLOT, RS, acc, lane, wv);
#pragma unroll
            for (int i = 0; i < 2; i++) {
#pragma unroll
                for (int r = 0; r < 4; r++) { const int m = mt * 16 + qq * 4 + r, n = (nt0 + i) * 16 + kr; if (m > n) acc[i][r] = 0.f; }
                st_t(sl + 11 * RSLOT, RS, acc[i], mt, nt0 + i, lane);
            }
            ZACC(acc); mm64(sl + 2 * RSLOT, RS, sl + 3 * RSLOT, RS, acc, lane, wv);
#pragma unroll
            for (int i = 0; i < 2; i++) {
#pragma unroll
                for (int r = 0; r < 4; r++) { const int m = mt * 16 + qq * 4 + r, n = (nt0 + i) * 16 + kr; if (m > n) acc[i][r] = 0.f; }
                st_t(sl + 12 * RSLOT, RS, acc[i], mt, nt0 + i, lane);
            }
        }
        LDS_BARRIER();
        u16* X = sl + 8 * RSLOT; u16* XT = sl + 9 * RSLOT; u16* X2 = sl + 0 * RSLOT; u16* X2T = sl + 1 * RSLOT;
        u16* Pc = sl + 13 * RSLOT; u16* Pn = sl + 2 * RSLOT;
#pragma unroll 1
        for (int j = 1; j <= 6; j++) {
            RW_IDX
            f32x4 acc[2];
            if (j <= 5) {
                ZACC(acc); mm64(X, RS, XT, RS, acc, lane, wv);
#pragma unroll
                for (int i = 0; i < 2; i++) { st_t(X2T, RS, acc[i], mt, nt0 + i, lane); st_n(X2, RS, acc[i], mt, nt0 + i, lane); }
            }
            if (j >= 2) {
                ZACC(acc); mm64(XT, RS, Pc, RS, acc, lane, wv);
#pragma unroll
                for (int i = 0; i < 2; i++) {
                    const uint2 pv = *(const uint2*)&Pc[((nt0 + i) * 16 + kr) * RS + mt * 16 + qq * 4];
                    acc[i][0] += __uint_as_float(pv.x << 16); acc[i][1] += __uint_as_float(pv.x & 0xFFFF0000u);
                    acc[i][2] += __uint_as_float(pv.y << 16); acc[i][3] += __uint_as_float(pv.y & 0xFFFF0000u);
                    st_t(Pn, RS, acc[i], mt, nt0 + i, lane);
                }
            }
            LDS_BARRIER();
            if (j >= 2) { u16* tp = Pc; Pc = Pn; Pn = tp; }
            if (j <= 5) { u16* tx = X; X = X2; X2 = tx; tx = XT; XT = X2T; X2T = tx; }
        }
        u16* TT = Pc;
        {
            RW_IDX
            f32x4 acc[2];
            ZACC(acc); mm64(TT, RS, sl + 4 * RSLOT, RS, acc, lane, wv);
#pragma unroll
            for (int i = 0; i < 2; i++) st_t(sl + 0 * RSLOT, RS, acc[i], mt, nt0 + i, lane);
            ZACC(acc); mm64(sl + 10 * RSLOT, RS, TT, RS, acc, lane, wv);
#pragma unroll
            for (int i = 0; i < 2; i++) st_t(sl + 8 * RSLOT, RS, acc[i], mt, nt0 + i, lane);
        }
        LDS_BARRIER();
        {
            RW_IDX
            f32x4 acc[2];
            ZACC(acc); mm64(sl + 8 * RSLOT, RS, sl + 7 * RSLOT, RS, acc, lane, wv);
#pragma unroll
            for (int i = 0; i < 2; i++) st_t(sl + 9 * RSLOT, RS, acc[i], mt, nt0 + i, lane);
            ZACC(acc); mm64(sl + 0 * RSLOT, RS, sl + 5 * RSLOT, RS, acc, lane, wv);
#pragma unroll
            for (int i = 0; i < 2; i++) {
                const int n = (nt0 + i) * 16 + kr; const float gn = gl[n];
#pragma unroll
                for (int r = 0; r < 4; r++) { const int m = mt * 16 + qq * 4 + r; acc[i][r] = acc[i][r] * gn + ((m == n) ? gn : 0.f); }
                st_t(cd, 64, acc[i], mt, nt0 + i, lane);
            }
            ZACC(acc); mm64(sl + 0 * RSLOT, RS, sl + 11 * RSLOT, RS, acc, lane, wv);
#pragma unroll
            for (int i = 0; i < 2; i++) {
                const uint2 rv = *(const uint2*)&sl[3 * RSLOT + ((nt0 + i) * 16 + kr) * RS + mt * 16 + qq * 4];
                acc[i][0] += __uint_as_float(rv.x << 16); acc[i][1] += __uint_as_float(rv.x & 0xFFFF0000u);
                acc[i][2] += __uint_as_float(rv.y << 16); acc[i][3] += __uint_as_float(rv.y & 0xFFFF0000u);
                st_t(cd + 2 * 4096, 64, acc[i], mt, nt0 + i, lane);
            }
        }
        LDS_BARRIER();
        {
            RW_IDX
            f32x4 acc[2];
            ZACC(acc);
            mm64(sl + 5 * RSLOT, RS, sl + 9 * RSLOT, RS, acc, lane, wv);
            mm64(sl + 6 * RSLOT, RS, sl + 7 * RSLOT, RS, acc, lane, wv);
#pragma unroll
            for (int i = 0; i < 2; i++) {
#pragma unroll
                for (int r = 0; r < 4; r++) acc[i][r] *= gl[mt * 16 + qq * 4 + r];
                st_t(cd + 1 * 4096, 64, acc[i], mt, nt0 + i, lane);
            }
            ZACC(acc);
            mm64(sl + 9 * RSLOT, RS, sl + 11 * RSLOT, RS, acc, lane, wv);
            mm64(sl + 7 * RSLOT, RS, sl + 12 * RSLOT, RS, acc, lane, wv);
#pragma unroll
            for (int i = 0; i < 2; i++) st_t(cd + 3 * 4096, 64, acc[i], mt, nt0 + i, lane);
        }
      }
    }
}

__device__ void ph_rwkv_seq(const P& p, int bid, int nb, char* smem) {
    u16* SL = (u16*)smem;
    const int tid = get_tid(), lane = tid & 63, wv = __builtin_amdgcn_readfirstlane(tid >> 6);
    const int kr = lane & 15, qq = lane >> 4, chn = wv >> 2, vt = wv & 3;
    for (int pair = bid; pair < B_ * 4; pair += nb) {
        const int bh = pair * 2 + chn;
        u16* mySL = SL + chn * RSLOT;
        __syncthreads();
#pragma unroll
        for (int ks = 0; ks < 2; ks++) *(uint4*)&mySL[(vt * 16 + kr) * RS + ks * 32 + qq * 8] = make_uint4(0u, 0u, 0u, 0u);
        u16* cbase = p.cdat + (size_t)bh * 128 * 4 * 4096;
        bf16x8 GA0[4][2], GA1[4][2], GA2[4][2], GA3[4][2]; uint2 H0[4], H1[4], H2[4], H3[4];
#define SEQ_LD(GAx, Hx, c) { const u16* cd_ = cbase + (size_t)(c) * 4 * 4096; \
            _Pragma("unroll") for (int m4 = 0; m4 < 4; m4++) { \
                _Pragma("unroll") for (int ks = 0; ks < 2; ks++) GAx[m4][ks] = *(const bf16x8*)&cd_[(m4 * 16 + kr) * 64 + ks * 32 + qq * 8]; \
                Hx[m4] = *(const uint2*)&cd_[1 * 4096 + (vt * 16 + kr) * 64 + m4 * 16 + qq * 4]; } }
#define SEQ_STEP(GAx, Hx, c) { \
            bf16x8 Z0[2]; \
            _Pragma("unroll") for (int ks = 0; ks < 2; ks++) Z0[ks] = *(const bf16x8*)&mySL[(vt * 16 + kr) * RS + ks * 32 + qq * 8]; \
            f32x4 zs[4]; \
            _Pragma("unroll") for (int m4 = 0; m4 < 4; m4++) { \
                zs[m4] = unpack4(Hx[m4]); \
                _Pragma("unroll") for (int ks = 0; ks < 2; ks++) zs[m4] = __builtin_amdgcn_mfma_f32_16x16x32_bf16(GAx[m4][ks], Z0[ks], zs[m4], 0, 0, 0); } \
            u16* sn_ = cbase + (size_t)(c) * 4 * 4096 + 1 * 4096 + (vt * 16 + kr) * 64 + qq * 4; \
            _Pragma("unroll") for (int m4 = 0; m4 < 4; m4++) { \
                const uint2 pk_ = pack4(zs[m4]); \
                *(uint2*)&mySL[(vt * 16 + kr) * RS + m4 * 16 + qq * 4] = pk_; \
                *(uint2*)&sn_[m4 * 16] = pk_; } \
            if ((c) + 4 < 128) SEQ_LD(GAx, Hx, (c) + 4) }
        SEQ_LD(GA0, H0, 0) SEQ_LD(GA1, H1, 1) SEQ_LD(GA2, H2, 2) SEQ_LD(GA3, H3, 3)
#pragma unroll 1
        for (int c = 0; c < 128; c += 4) {
            SEQ_STEP(GA0, H0, c)
            SEQ_STEP(GA1, H1, c + 1)
            SEQ_STEP(GA2, H2, c + 2)
            SEQ_STEP(GA3, H3, c + 3)
        }
#undef SEQ_LD
#undef SEQ_STEP
    }
}

__device__ void ph_rwkv_out(const P& p, int bid, int nb, char* smem) {
    const int tid = get_tid(), lane = tid & 63, wv = tid >> 6;
    const int kr = lane & 15, qq = lane >> 4;
    for (int it = bid * NW + wv; it < B_ * 8 * 128; it += nb * NW) {
        const int c = it & 127, bh = it >> 7, b = bh >> 3, h = bh & 7;
        const u16* cd = p.cdat + ((size_t)bh * 128 + c) * 4 * 4096;
        f32x4 ys[4][4];
#pragma unroll
        for (int mt = 0; mt < 4; mt++)
#pragma unroll
            for (int nt = 0; nt < 4; nt++) ys[mt][nt] = unpack4(*(const uint2*)&cd[3 * 4096 + (nt * 16 + kr) * 64 + mt * 16 + qq * 4]);
        if (c > 0) {
            const u16* s0 = cd - 4 * 4096 + 1 * 4096;
#pragma unroll
            for (int ks = 0; ks < 2; ks++) {
                bf16x8 af[4], bq[4];
#pragma unroll
                for (int mt = 0; mt < 4; mt++) af[mt] = *(const bf16x8*)&s0[(mt * 16 + kr) * 64 + ks * 32 + qq * 8];
#pragma unroll
                for (int nt = 0; nt < 4; nt++) bq[nt] = *(const bf16x8*)&cd[2 * 4096 + (nt * 16 + kr) * 64 + ks * 32 + qq * 8];
#pragma unroll
                for (int mt = 0; mt < 4; mt++)
#pragma unroll
                    for (int nt = 0; nt < 4; nt++) ys[mt][nt] = __builtin_amdgcn_mfma_f32_16x16x32_bf16(af[mt], bq[nt], ys[mt][nt], 0, 0, 0);
            }
        }
#pragma unroll
        for (int nt = 0; nt < 4; nt++) {
            float s1 = 0.f, s2 = 0.f;
#pragma unroll
            for (int mt = 0; mt < 4; mt++)
#pragma unroll
                for (int r = 0; r < 4; r++) { s1 += ys[mt][nt][r]; s2 += ys[mt][nt][r] * ys[mt][nt][r]; }
            s1 = xrow_sum(s1); s2 = xrow_sum(s2);
            const float mean = s1 * (1.f / 64.f);
            const float var = fmaxf(s2 * (1.f / 64.f) - mean * mean, 0.f);
            const float rstd = rsqrtf(var + 64e-5f);
            const int t = nt * 16 + kr;
            const size_t n = (size_t)b * S_ + c * 64 + t;
            const float bon = p.bon[n * 8 + h];
#pragma unroll
            for (int mt = 0; mt < 4; mt++) {
                const int vch = h * 64 + mt * 16 + qq * 4;
                const f32x4 vcf = unpack4(*(const uint2*)&p.prw[n * CRW + 1024 + vch]);
                const f32x4 vpf = (c * 64 + t > 0) ? unpack4(*(const uint2*)&p.prw[(n - 1) * CRW + 1024 + vch]) : f32x4{0.f, 0.f, 0.f, 0.f};
                const f32x4 ggf = unpack4(*(const uint2*)&p.ob[n * 512 + vch]);
                const float4 lw = *(const float4*)&p.ln_w[vch], lb = *(const float4*)&p.ln_b[vch], mv = *(const float4*)&p.mu[1024 + vch];
                const float lwa[4] = {lw.x, lw.y, lw.z, lw.w}, lba[4] = {lb.x, lb.y, lb.z, lb.w}, mva[4] = {mv.x, mv.y, mv.z, mv.w};
                f32x4 o;
#pragma unroll
                for (int r = 0; r < 4; r++) {
                    const float vsh = vcf[r] + (vpf[r] - vcf[r]) * mva[r];
                    o[r] = ((ys[mt][nt][r] - mean) * rstd * lwa[r] + lba[r] + bon * vsh) * ggf[r];
                }
                *(uint2*)&p.ob[n * 512 + vch] = pack4(o);
            }
        }
    }
}

__device__ __forceinline__ void unpack8(const uint4& u, f32x4& a, f32x4& b) {
    a = f32x4{__uint_as_float(u.x << 16), __uint_as_float(u.x & 0xFFFF0000u), __uint_as_float(u.y << 16), __uint_as_float(u.y & 0xFFFF0000u)};
    b = f32x4{__uint_as_float(u.z << 16), __uint_as_float(u.z & 0xFFFF0000u), __uint_as_float(u.w << 16), __uint_as_float(u.w & 0xFFFF0000u)};
}
struct EpiMerge {
    u16* merged; u16* tmp2; int pass;
    __device__ __forceinline__ void operator()(const f32x4 (&acc)[2][2][4][2], const GUnit& u, int, int, int, int) const {
        const int t2_ = get_tid(), wid_ = __builtin_amdgcn_readfirstlane(t2_ >> 6), wr = wid_ >> 2, wc = wid_ & 3, fr = t2_ & 15, fq = (t2_ >> 4) & 3;
        const int row0 = u.pm * 256 + wr * 64 + fr, col0 = u.pn * 256 + wc * 32 + 8 * fq;
#pragma unroll
        for (int ai = 0; ai < 2; ++ai)
#pragma unroll
            for (int m = 0; m < 4; ++m) {
                const size_t off = (size_t)(row0 + ai * 128 + m * 16) * D_ + col0;
                uint4 m1[2], m2[2];
                if (pass == 1 || pass == 3) {
#pragma unroll
                    for (int bj = 0; bj < 2; ++bj) { m1[bj] = *(const uint4*)&merged[off + bj * 128]; if (pass == 3) m2[bj] = *(const uint4*)&tmp2[off + bj * 128]; }
                }
#pragma unroll
                for (int bj = 0; bj < 2; ++bj) {
                    f32x4 v0 = acc[ai][bj][m][0], v1 = acc[ai][bj][m][1];
                    if (pass == 1) { f32x4 a0, a1; unpack8(m1[bj], a0, a1);
#pragma unroll
                        for (int r = 0; r < 4; r++) { v0[r] = a0[r] * sigmoidf_(v0[r]); v1[r] = a1[r] * sigmoidf_(v1[r]); } }
                    if (pass == 3) { f32x4 a0, a1, b0, b1; unpack8(m1[bj], a0, a1); unpack8(m2[bj], b0, b1);
#pragma unroll
                        for (int r = 0; r < 4; r++) { v0[r] = a0[r] + b0[r] * sigmoidf_(v0[r]); v1[r] = a1[r] + b1[r] * sigmoidf_(v1[r]); } }
                    *(uint4*)&((pass == 2) ? tmp2 : merged)[off + bj * 128] = pack8(v0, v1);
                }
                asm volatile("" ::: "memory");
            }
    }
};
__device__ void ph_merge(const P& p, int bid, int nb, char* smem) {
    u16* tmp2 = (u16*)p.x1;
#pragma unroll 1
    for (int pass = 0; pass < 4; ++pass) {
        const int K = (pass & 1) ? D_ : 512;
        const u16* A = (pass & 1) ? p.hbuf : (pass == 0 ? p.oa : p.ob);
        const u16* Bt = (pass == 0) ? p.wpaT : (pass == 1 ? p.wgT : (pass == 2 ? p.wpbT : p.wgT + (size_t)1024 * D_));
        DenseSched S; S.init(NTOK, D_, K, Bt, nb, bid);
        EpiMerge E{p.merged, tmp2, pass};
        gemm256(smem, (const char*)A, K, S, E);
    }
}

struct EpiOutproj {
    const float* x; float* x1;
    __device__ __forceinline__ void operator()(const f32x4 (&acc)[2][2][4][2], const GUnit& u, int, int, int, int) const {
        const int t2_ = get_tid(), wid_ = __builtin_amdgcn_readfirstlane(t2_ >> 6), wr = wid_ >> 2, wc = wid_ & 3, fr = t2_ & 15, fq = (t2_ >> 4) & 3;
        const int row0 = u.pm * 256 + wr * 64 + fr, col0 = u.pn * 256 + wc * 32 + 4 * fq;
#pragma unroll
        for (int ai = 0; ai < 2; ++ai)
#pragma unroll
            for (int m = 0; m < 4; ++m) {
                const size_t off = (size_t)(row0 + ai * 128 + m * 16) * D_ + col0;
                f32x4 xin[2][2];
#pragma unroll
                for (int bj = 0; bj < 2; ++bj)
#pragma unroll
                    for (int n = 0; n < 2; ++n) xin[bj][n] = *(const f32x4*)&x[off + bj * 128 + n * 16];
#pragma unroll
                for (int bj = 0; bj < 2; ++bj)
#pragma unroll
                    for (int n = 0; n < 2; ++n) *(f32x4*)&x1[off + bj * 128 + n * 16] = xin[bj][n] + acc[ai][bj][m][n];
                asm volatile("" ::: "memory");
            }
    }
};
__device__ void ph_outproj(const P& p, int bid, int nb, char* smem) {
    DenseSched S; S.init(NTOK, D_, D_, p.woutT, nb, bid);
    EpiOutproj E{p.x, p.x1};
    gemm256(smem, (const char*)p.merged, D_, S, E);
}

__device__ __forceinline__ float red8f(float x) {
    x += dppf<0xB1>(x);
    x += dppf<0x4E>(x);
    x += dppf<0x141>(x);
    return x;
}
__device__ void ph_route(const P& p, int bid, int nb, char* smem) {
    float* wr = (float*)smem;
    const int tid = get_tid(), lane = tid & 63, wv = tid >> 6;
    {
        const int gtid = bid * NT + tid, gnt = nb * NT;
        const int per_e = 512 * 128 + 1024 * 32;
        for (int i = gtid; i < NEXP * per_e; i += gnt) {
            const int e = i / per_e; int r = i - e * per_e;
            const float* wp; u16* dstp; int N;
            if (r < 512 * 128) {
                const int kc = r >> 9, j = r & 511, half = j >> 8, sl = j & 255, sp = sl & 127;
                const int col = half * 128 + (sp & ~31) + perm32(sp & 31);
                N = 256; wp = ((sl >> 7) ? p.e_w3 : p.e_w1) + (size_t)e * D_ * 256 + (size_t)(kc * 8) * 256 + col;
                dstp = p.ew1T + ((size_t)e * 512 + j) * D_ + kc * 8;
            } else {
                r -= 512 * 128;
                const int kc = r >> 10, j = r & 1023;
                const int col = (j & ~31) + perm32(j & 31);
                N = D_; wp = p.e_w2 + (size_t)e * 256 * D_ + (size_t)(kc * 8) * D_ + col;
                dstp = p.ew2T + ((size_t)e * D_ + j) * 256 + kc * 8;
            }
            uint4 v;
            v.x = pack2(wp[0], wp[(size_t)N]); v.y = pack2(wp[2 * (size_t)N], wp[3 * (size_t)N]);
            v.z = pack2(wp[4 * (size_t)N], wp[5 * (size_t)N]); v.w = pack2(wp[6 * (size_t)N], wp[7 * (size_t)N]);
            *(uint4*)dstp = v;
        }
    }
    for (int i = tid; i < 1024 * 36; i += NT) {
        const int k = i / 36, j = i - k * 36;
        wr[i] = (j < 4) ? p.w_grp[k * 4 + j] : p.w_exp[k * 32 + (j - 4)];
    }
    __syncthreads();
    const int sub = lane & 7, tk = lane >> 3;
    for (int n0 = (bid * NW + wv) * 8; n0 < NTOK; n0 += nb * NW * 8) {
        const size_t n = (size_t)n0 + tk;
        const float* xr = p.x1 + n * D_;
        float acc[36]; float ss = 0.f;
#pragma unroll
        for (int j = 0; j < 36; j++) acc[j] = 0.f;
#pragma unroll 2
        for (int i = 0; i < 32; i++) {
            const int k0 = i * 32 + sub * 4;
            const float4 xv = *(const float4*)&xr[k0];
            const float4 gf = *(const float4*)&p.g_ffn[k0];
            ss += xv.x * xv.x + xv.y * xv.y + xv.z * xv.z + xv.w * xv.w;
            const float hv[4] = {xv.x * gf.x, xv.y * gf.y, xv.z * gf.z, xv.w * gf.w};
#pragma unroll
            for (int e2 = 0; e2 < 4; e2++) {
                const float* wrow = wr + (k0 + e2) * 36;
#pragma unroll
                for (int j4 = 0; j4 < 9; j4++) {
                    const float4 wv4 = *(const float4*)&wrow[j4 * 4];
                    acc[j4 * 4 + 0] += hv[e2] * wv4.x; acc[j4 * 4 + 1] += hv[e2] * wv4.y;
                    acc[j4 * 4 + 2] += hv[e2] * wv4.z; acc[j4 * 4 + 3] += hv[e2] * wv4.w;
                }
            }
        }
        ss = red8f(ss);
#pragma unroll
        for (int j = 0; j < 36; j++) acc[j] = red8f(acc[j]);
        const float rs = rsqrtf(ss * (1.f / D_) + 1e-6f);
#pragma unroll 4
        for (int i = 0; i < 32; i++) {
            const int k0 = i * 32 + sub * 4;
            const float4 xv = *(const float4*)&xr[k0];
            const float4 gf = *(const float4*)&p.g_ffn[k0];
            uint2 o; o.x = pack2(xv.x * rs * gf.x, xv.y * rs * gf.y); o.y = pack2(xv.z * rs * gf.z, xv.w * rs * gf.w);
            *(uint2*)&p.hbuf[n * D_ + k0] = o;
        }
        if (sub == 0) {
            float gl[4]; int gs = 0;
#pragma unroll
            for (int j = 0; j < 4; j++) gl[j] = acc[j] * rs + p.b_grp[j];
            float gm = gl[0];
#pragma unroll
            for (int j = 1; j < 4; j++) if (gl[j] > gm) { gm = gl[j]; gs = j; }
            float gsum = 0.f;
#pragma unroll
            for (int j = 0; j < 4; j++) gsum += __expf(gl[j] - gm);
            const float pg = 1.f / gsum;
            float el[8]; float em = -3.0e38f;
#pragma unroll
            for (int j = 0; j < 8; j++) {
                float a = (gs == 0) ? acc[4 + j] : ((gs == 1) ? acc[12 + j] : ((gs == 2) ? acc[20 + j] : acc[28 + j]));
                a = a * rs + p.b_exp[gs * 8 + j];
                el[j] = a; em = fmaxf(em, a);
            }
            int j0 = 0, j1 = -1; float v0 = -3.0e38f, v1 = -3.0e38f;
#pragma unroll
            for (int j = 0; j < 8; j++) { el[j] = __expf(el[j] - em); }
#pragma unroll
            for (int j = 0; j < 8; j++) { if (el[j] > v0) { v0 = el[j]; j0 = j; } }
#pragma unroll
            for (int j = 0; j < 8; j++) { if (j != j0 && el[j] > v1) { v1 = el[j]; j1 = j; } }
            const float den = v0 + v1;
            const int e0 = gs * 8 + j0, e1 = gs * 8 + j1;
            p.tok_e[n * 2] = e0; p.tok_e[n * 2 + 1] = e1;
            p.tok_gate[n * 2] = pg * v0 / den; p.tok_gate[n * 2 + 1] = pg * v1 / den;
            atomicAdd(&p.counts[e0], 1); atomicAdd(&p.counts[e1], 1);
        }
    }
}

__device__ void ph_scatter(const P& p, int bid, int nb, char* smem) {
    int* offl = (int*)smem;
    int* hist = offl + 64;
    int* gbase = hist + 32;
    const int tid = get_tid();
    if (tid == 0) {
        int off = 0;
        for (int e = 0; e < NEXP; e++) { offl[e] = off; off += p.counts[e]; }
        offl[NEXP] = off;
    }
    if (bid == 0 && tid == 64) {
        int off = 0, nb_ = 0;
        for (int e = 0; e < NEXP; e++) {
            const int c = p.counts[e];
            p.offs[e] = off;
            for (int r = 0; r < c; r += 256) { p.blk_e[nb_] = e; p.blk_r0[nb_] = off + r; nb_++; }
            off += c;
        }
        p.offs[NEXP] = off;
        *p.nblk = nb_;
    }
    for (int base = bid * NT; base < NTOK * 2; base += nb * NT) {
        __syncthreads();
        if (tid < 32) hist[tid] = 0;
        __syncthreads();
        const int i = base + tid;
        const int e = p.tok_e[i];
        const int rl = atomicAdd(&hist[e], 1);
        __syncthreads();
        if (tid < 32) gbase[tid] = atomicAdd(&p.cursor[tid], hist[tid]);
        __syncthreads();
        const int slot = offl[e] + gbase[e] + rl;
        p.list_tok[slot] = i >> 1; p.list_gate[slot] = p.tok_gate[i]; p.tokslot[i] = slot;
    }
}
template <int CTS>
struct MoeSched {
    const P* pp; int nunits, G, c; unsigned rowbytes; const u16* Bt; size_t b_estride, b_tstride;
    bool gather;
    __device__ __forceinline__ bool next(int i, GUnit& u) const {
        const int L = i * G + c; if (L >= nunits) return false;
        int wgid = L; { const int q = nunits >> 3, r = nunits & 7, xcd = wgid & 7, off = wgid >> 3; wgid = (xcd < r ? xcd * (q + 1) : r * (q + 1) + (xcd - r) * q) + off; }
        u.pm = wgid / CTS; u.pn = wgid & (CTS - 1); return true;
    }
    __device__ __forceinline__ unsigned a_off(const GUnit& u, int h, int R) const {
        const P& p = *pp;
        const int e = __builtin_amdgcn_readfirstlane(p.blk_e[u.pm]), rend = __builtin_amdgcn_readfirstlane(p.offs[e + 1]);
        int sl = __builtin_amdgcn_readfirstlane(p.blk_r0[u.pm]) + h * 128 + R; if (sl >= rend) sl = rend - 1;
        return (unsigned)(gather ? p.list_tok[sl] : sl) * rowbytes;
    }
    __device__ __forceinline__ const char* b_ptr(const GUnit& u) const { return (const char*)(Bt + (size_t)__builtin_amdgcn_readfirstlane(pp->blk_e[u.pm]) * b_estride + (size_t)u.pn * b_tstride); }
};
struct EpiMoe1 {
    const P* pp;
    __device__ __forceinline__ void operator()(const f32x4 (&acc)[2][2][4][2], const GUnit& u, int, int, int, int) const {
        const int t2_ = get_tid(), wid_ = __builtin_amdgcn_readfirstlane(t2_ >> 6), wr = wid_ >> 2, wc = wid_ & 3, fr = t2_ & 15, fq = (t2_ >> 4) & 3;
        const P& p = *pp;
        const int e = __builtin_amdgcn_readfirstlane(p.blk_e[u.pm]), r0 = __builtin_amdgcn_readfirstlane(p.blk_r0[u.pm]), rend = __builtin_amdgcn_readfirstlane(p.offs[e + 1]);
#pragma unroll
        for (int ai = 0; ai < 2; ++ai)
#pragma unroll
            for (int m = 0; m < 4; ++m) {
                const int sl = r0 + ai * 128 + wr * 64 + m * 16 + fr;
                if (sl < rend) {
                    f32x4 v[2];
#pragma unroll
                    for (int n = 0; n < 2; ++n)
#pragma unroll
                        for (int r = 0; r < 4; r++) { const float a = acc[ai][0][m][n][r]; v[n][r] = a * sigmoidf_(a) * acc[ai][1][m][n][r]; }
                    *(uint4*)&p.hid[(size_t)sl * 256 + u.pn * 128 + wc * 32 + 8 * fq] = pack8(v[0], v[1]);
                }
            }
    }
};
__device__ void ph_moe1(const P& p, int bid, int nb, char* smem) {
    MoeSched<2> S{&p, __builtin_amdgcn_readfirstlane(*p.nblk) * 2, nb, bid, (unsigned)(D_ * 2), p.ew1T, (size_t)512 * D_, (size_t)256 * D_, true};
    EpiMoe1 E{&p};
    gemm256(smem, (const char*)p.hbuf, D_, S, E);
}
struct EpiMoe2 {
    const P* pp;
    __device__ __forceinline__ void operator()(const f32x4 (&acc)[2][2][4][2], const GUnit& u, int, int, int, int) const {
        const int t2_ = get_tid(), wid_ = __builtin_amdgcn_readfirstlane(t2_ >> 6), wr = wid_ >> 2, wc = wid_ & 3, fr = t2_ & 15, fq = (t2_ >> 4) & 3;
        const P& p = *pp;
        const int e = __builtin_amdgcn_readfirstlane(p.blk_e[u.pm]), r0 = __builtin_amdgcn_readfirstlane(p.blk_r0[u.pm]), rend = __builtin_amdgcn_readfirstlane(p.offs[e + 1]);
#pragma unroll
        for (int ai = 0; ai < 2; ++ai)
#pragma unroll
            for (int m = 0; m < 4; ++m) {
                const int sl = r0 + ai * 128 + wr * 64 + m * 16 + fr;
                if (sl < rend) {
                    const float gt = p.list_gate[sl];
                    u16* yp = p.ybuf + (size_t)sl * D_ + u.pn * 256 + wc * 32 + 8 * fq;
#pragma unroll
                    for (int bj = 0; bj < 2; ++bj) *(uint4*)&yp[bj * 128] = pack8(acc[ai][bj][m][0] * gt, acc[ai][bj][m][1] * gt);
                }
            }
    }
};
__device__ void ph_moe2(const P& p, int bid, int nb, char* smem) {
    MoeSched<4> S{&p, __builtin_amdgcn_readfirstlane(*p.nblk) * 4, nb, bid, 512u, p.ew2T, (size_t)D_ * 256, (size_t)256 * 256, false};
    EpiMoe2 E{&p};
    gemm256(smem, (const char*)p.hid, 256, S, E);
}
__device__ void ph_final(const P& p, int bid, int nb, char* smem) {
    const int tid = get_tid(), lane = tid & 63, wv = tid >> 6;
    for (int row = bid * NW + wv; row < NTOK; row += nb * NW) {
        const int s0 = p.tokslot[row * 2], s1 = p.tokslot[row * 2 + 1];
        float v[16]; float ss = 0.f;
#pragma unroll
        for (int i = 0; i < 4; i++) {
            const int c = i * 256 + lane * 4;
            const float4 t = *(const float4*)&p.x1[(size_t)row * D_ + c];
            const uint2 a = *(const uint2*)&p.ybuf[(size_t)s0 * D_ + c];
            const uint2 bq = *(const uint2*)&p.ybuf[(size_t)s1 * D_ + c];
            v[4 * i]     = t.x + __uint_as_float(a.x << 16) + __uint_as_float(bq.x << 16);
            v[4 * i + 1] = t.y + __uint_as_float(a.x & 0xFFFF0000u) + __uint_as_float(bq.x & 0xFFFF0000u);
            v[4 * i + 2] = t.z + __uint_as_float(a.y << 16) + __uint_as_float(bq.y << 16);
            v[4 * i + 3] = t.w + __uint_as_float(a.y & 0xFFFF0000u) + __uint_as_float(bq.y & 0xFFFF0000u);
            ss += v[4 * i] * v[4 * i] + v[4 * i + 1] * v[4 * i + 1] + v[4 * i + 2] * v[4 * i + 2] + v[4 * i + 3] * v[4 * i + 3];
        }
        ss = wave_sum(ss);
        const float rs = rsqrtf(ss * (1.f / D_) + 1e-6f);
#pragma unroll
        for (int i = 0; i < 4; i++) {
            const int c = i * 256 + lane * 4;
            const float4 g = *(const float4*)&p.g_final[c];
            float4 o; o.x = v[4 * i] * rs * g.x; o.y = v[4 * i + 1] * rs * g.y; o.z = v[4 * i + 2] * rs * g.z; o.w = v[4 * i + 3] * rs * g.w;
            *(float4*)&p.out[(size_t)row * D_ + c] = o;
        }
    }
}

#define XB_TMO      128
#define XB_XCNT(j)  (256  + 64 * (j))
#define XB_XSUB(j)  (1280 + 64 * (j))
#define XB_XGEN(j)  (2304 + 64 * (j))
#define XB_TOP      3328
#define XB_TOPGEN   3392
#define XCD_BAR_WORDS 3456
#define XB_SPIN_CAP (1u << 18)
#define LAS __attribute__((address_space(3)))

__device__ __forceinline__ unsigned xb_ld(unsigned* p)              { return __hip_atomic_load(p, __ATOMIC_RELAXED, __HIP_MEMORY_SCOPE_AGENT); }
__device__ __forceinline__ unsigned xb_add(unsigned* p, unsigned v) { return __hip_atomic_fetch_add(p, v, __ATOMIC_RELAXED, __HIP_MEMORY_SCOPE_AGENT); }
__device__ __forceinline__ unsigned xb_xcc_id() { return (unsigned)__builtin_amdgcn_s_getreg((3 << 11) | 20) & 0xFu; }
#define XB_SPIN(cond, bar) do { unsigned _sp = 0; while (cond) { __builtin_amdgcn_s_sleep(1); \
    if ((++_sp & 255u) == 0u) { if (xb_ld(&(bar)[XB_TMO])) break; if (_sp > XB_SPIN_CAP) { atomicAdd(&(bar)[XB_TMO], 1u); break; } } } } while (0)

struct XcdBarrier {
    unsigned* bar; unsigned x;
    volatile LAS unsigned* st;
};

__device__ __forceinline__ XcdBarrier xcd_barrier_post(unsigned* bar, volatile LAS unsigned* st) {
    XcdBarrier b; b.bar = bar; b.x = xb_xcc_id(); b.st = st;
    if (threadIdx.x == 0) (void)xb_add(&bar[XB_XCNT(b.x)], 1u);
    return b;
}
__device__ __forceinline__ void xcd_barrier_complete(unsigned* bar, unsigned x, unsigned& nloc, unsigned& nx) {
    const unsigned G = gridDim.x * gridDim.y * gridDim.z;
    unsigned sum, cnt, mine, sp = 0u;
    for (;;) {
        sum = 0u; cnt = 0u; mine = 0u;
#pragma unroll
        for (unsigned j = 0; j < 16; ++j) { const unsigned c = xb_ld(&bar[XB_XCNT(j)]); sum += c; cnt += (c > 0u) ? 1u : 0u; mine = (j == x) ? c : mine; }
        if (sum == G) break;
        __builtin_amdgcn_s_sleep(1);
        if ((++sp & 255u) == 0u) { if (xb_ld(&bar[XB_TMO])) break; if (sp > XB_SPIN_CAP) { atomicAdd(&bar[XB_TMO], 1u); break; } }
    }
    nloc = mine > 0u ? mine : 1u; nx = cnt > 0u ? cnt : 1u;
}

__device__ __forceinline__ void xcd_barrier(const XcdBarrier& b) {
    asm volatile("s_waitcnt vmcnt(0)" ::: "memory");
    __syncthreads();
    if (threadIdx.x == 0) {
        unsigned* bar = b.bar;
        __builtin_amdgcn_s_waitcnt(0);
        unsigned nloc = b.st[0], nx = b.st[1];
        if (nloc == 0u) { xcd_barrier_complete(bar, b.x, nloc, nx); b.st[0] = nloc; b.st[1] = nx; }
        const unsigned old = xb_add(&bar[XB_XSUB(b.x)], 1u);
        const unsigned gen = old / nloc;
        if (old + 1u == (gen + 1u) * nloc) {
            __builtin_amdgcn_fence(__ATOMIC_RELEASE, "agent");
            asm volatile("s_waitcnt vmcnt(0)" ::: "memory");
            const unsigned og = xb_add(&bar[XB_TOP], 1u);
            const unsigned tg = og / nx;
            if (og + 1u == (tg + 1u) * nx) xb_add(&bar[XB_TOPGEN], 1u);
            else XB_SPIN(xb_ld(&bar[XB_TOPGEN]) == tg, bar);
            __builtin_amdgcn_fence(__ATOMIC_ACQUIRE, "agent");
            xb_add(&bar[XB_XGEN(b.x)], 1u);
            asm volatile("s_waitcnt vmcnt(0)" ::: "memory");
        } else {
            XB_SPIN(xb_ld(&bar[XB_XGEN(b.x)]) == gen, bar);
            __builtin_amdgcn_fence(__ATOMIC_ACQUIRE, "agent");
            asm volatile("s_waitcnt vmcnt(0)" ::: "memory");
        }
    }
    __syncthreads();
}

template <int PH>
__device__ __forceinline__ void run_phase(const P& p, int bid, int nb, char* smem) {
    if constexpr (PH == 0) ph_prologue(p, bid, nb, smem);
    if constexpr (PH == 1) ph_inproj(p, bid, nb, smem);
    if constexpr (PH == 2) { ph_compress(p, bid, nb, smem); __syncthreads(); ph_rwkv_chunk(p, bid, nb, smem); }
    if constexpr (PH == 3) {
        if (bid < SCAN_BLOCKS) ph_rwkv_seq(p, bid, SCAN_BLOCKS, smem);
        else ph_nsa(p, bid - SCAN_BLOCKS, nb - SCAN_BLOCKS, smem);
    }
    if constexpr (PH == 12) ph_rwkv_out(p, bid, nb, smem);
    if constexpr (PH == 4) ph_merge(p, bid, nb, smem);
    if constexpr (PH == 5) ph_outproj(p, bid, nb, smem);
    if constexpr (PH == 6) ph_route(p, bid, nb, smem);
    if constexpr (PH == 7) ph_scatter(p, bid, nb, smem);
    if constexpr (PH == 9) ph_moe1(p, bid, nb, smem);
    if constexpr (PH == 10) ph_moe2(p, bid, nb, smem);
    if constexpr (PH == 11) ph_final(p, bid, nb, smem);
}

template <int PH>
__global__ void __launch_bounds__(NT) kph(P p) {
    extern __shared__ __attribute__((aligned(16))) char smem[];
    run_phase<PH>(p, blockIdx.x, gridDim.x, smem);
}

__global__ void __launch_bounds__(NT, 2) mega(P p) {
    extern __shared__ __attribute__((aligned(16))) char smem[];
    volatile LAS unsigned* st = (volatile LAS unsigned*)(smem + SMEM_BYTES - 16);
    if (threadIdx.x == 0) { st[0] = 0u; st[1] = 0u; st[2] = 0u; st[3] = 0u; }
    __syncthreads();
    XcdBarrier bar = xcd_barrier_post(p.bar, st);
    const int bid = blockIdx.x, nb = gridDim.x;
#define RUNP(N, BAR) { unsigned long long t0_ = 0; if ((TPROBE >> N) & 1) t0_ = __builtin_amdgcn_s_memrealtime(); run_phase<N>(p, bid, nb, smem); \
        unsigned long long tw_ = 0; if (((TPROBE >> N) & 1) && TPSEL) tw_ = __builtin_amdgcn_s_memrealtime() - t0_; if (BAR) xcd_barrier(bar); \
        if ((TPROBE >> N) & 1) { const unsigned long long t1_ = __builtin_amdgcn_s_memrealtime(); const unsigned long long dt_ = TPSEL ? tw_ : t1_ - t0_; \
            if (!TPSEL || (TPSEL == 1 ? (bid < SCAN_BLOCKS) : (bid >= SCAN_BLOCKS))) while (__builtin_amdgcn_s_memrealtime() - t1_ < dt_) __builtin_amdgcn_s_sleep(8); if (TPSEL) xcd_barrier(bar); } }
    RUNP(0, 1) RUNP(1, 1) RUNP(2, 1) RUNP(3, 1) RUNP(12, 1) RUNP(4, 1) RUNP(5, 1) RUNP(6, 1) RUNP(7, 1) RUNP(9, 1) RUNP(10, 1) RUNP(11, 0)
}

extern "C" void kernel_launch(void* const* d_in, const int* in_sizes, int n_in,
                              void* d_out, int out_size, void* d_ws, size_t ws_size,
                              hipStream_t stream) {
    P p{};
    p.x = (const float*)d_in[0]; p.pos = (const int*)d_in[1]; p.g_mix = (const float*)d_in[2]; p.w_in = (const float*)d_in[3];
    p.pe_k = (const float*)d_in[4]; p.w1_k = (const float*)d_in[5]; p.b1_k = (const float*)d_in[6]; p.w2_k = (const float*)d_in[7]; p.b2_k = (const float*)d_in[8];
    p.pe_v = (const float*)d_in[9]; p.w1_v = (const float*)d_in[10]; p.b1_v = (const float*)d_in[11]; p.w2_v = (const float*)d_in[12]; p.b2_v = (const float*)d_in[13];
    p.mu = (const float*)d_in[14]; p.w0 = (const float*)d_in[15]; p.w2 = (const float*)d_in[16]; p.a0 = (const float*)d_in[17]; p.a2 = (const float*)d_in[18];
    p.g2 = (const float*)d_in[19]; p.k_k = (const float*)d_in[20]; p.k_a = (const float*)d_in[21]; p.r_k = (const float*)d_in[22]; p.ln_w = (const float*)d_in[23]; p.ln_b = (const float*)d_in[24];
    p.wpa = (const float*)d_in[25]; p.wpb = (const float*)d_in[26]; p.wout = (const float*)d_in[27]; p.g_ffn = (const float*)d_in[28];
    p.w_grp = (const float*)d_in[29]; p.b_grp = (const float*)d_in[30]; p.w_exp = (const float*)d_in[31]; p.b_exp = (const float*)d_in[32];
    p.e_w1 = (const float*)d_in[33]; p.e_w3 = (const float*)d_in[34]; p.e_w2 = (const float*)d_in[35]; p.g_final = (const float*)d_in[36];
    p.out = (float*)d_out;
    char* ws = (char*)d_ws;
    const size_t MiB = 1ull << 20;
    p.hbuf = (u16*)(ws + 0 * MiB);
    p.q    = (u16*)(ws + 64 * MiB);
    p.kc   = (u16*)(ws + 96 * MiB);  p.vc   = (u16*)(ws + 104 * MiB);
    p.ksl  = (u16*)(ws + 112 * MiB); p.vslT = (u16*)(ws + 120 * MiB);
    p.kwn  = (u16*)(ws + 128 * MiB); p.vwnT = (u16*)(ws + 136 * MiB);
    p.nsag = (float*)(ws + 144 * MiB);
    p.kcb  = (u16*)(ws + 148 * MiB); p.vcT  = (u16*)(ws + 149 * MiB);
    p.prw  = (u16*)(ws + 160 * MiB);
    p.cdat = (u16*)(ws + 272 * MiB);
    p.bon  = (float*)(ws + 150 * MiB);
    p.w2T  = (u16*)(ws + 151 * MiB); p.a2T = p.w2T + 512 * 64; p.g2T = p.a2T + 512 * 64;
    p.cw1Tk = (u16*)(ws + 152 * MiB); p.cw1Tv = (u16*)(ws + 153 * MiB);
    p.cw2Tk = (u16*)(ws + 154 * MiB); p.cw2Tv = p.cw2Tk + 128 * 256;
    p.chid = (u16*)(ws + 155 * MiB);
    p.xact = (u16*)(ws + 488 * MiB);
    p.oa   = (u16*)(ws + 400 * MiB);
    p.ob   = (u16*)(ws + 432 * MiB);
    p.merged = (u16*)(ws + 64 * MiB);
    p.x1   = (float*)(ws + 160 * MiB);
    char* rt = ws + 288 * MiB;
    p.tok_e = (int*)(rt);                        rt += NTOK * 2 * 4;
    p.tok_gate = (float*)(rt);                   rt += NTOK * 2 * 4;
    p.tokslot = (int*)(rt);                      rt += NTOK * 2 * 4;
    p.list_tok = (int*)(rt);                     rt += NTOK * 2 * 4;
    p.list_gate = (float*)(rt);                  rt += NTOK * 2 * 4;
    p.blk_e = (int*)(rt);                        rt += 2048 * 4;
    p.blk_r0 = (int*)(rt);                       rt += 2048 * 4;
    p.hid  = (u16*)(ws + 296 * MiB);
    p.ybuf = (u16*)(ws + 336 * MiB);
    char* misc = ws + 470 * MiB;
    p.counts = (int*)(misc); p.cursor = (int*)(misc + 256); p.offs = (int*)(misc + 512); p.nblk = (int*)(misc + 1024);
    p.bar = (unsigned*)(ws + 471 * MiB);
    p.cb1k = (float*)(p.bar + XCD_BAR_WORDS); p.cb1v = p.cb1k + 256;
    {
        char* wa = ws + 472 * MiB;
        p.winT = (u16*)wa;  wa += (size_t)3328 * 1024 * 2;
        p.wgT  = (u16*)wa;  wa += (size_t)2048 * 1024 * 2;
        p.wpaT = (u16*)wa;  wa += (size_t)1024 * 512 * 2;
        p.wpbT = (u16*)wa;  wa += (size_t)1024 * 512 * 2;
        p.woutT = (u16*)wa; wa += (size_t)1024 * 1024 * 2;
        p.ew1T = (u16*)(ws + 64 * MiB);  p.ew3T = (u16*)(ws + 80 * MiB);  p.ew2T = (u16*)(ws + 96 * MiB);
    }
    if (ws_size < (size_t)505 * MiB) return;

#if MEGA
    {
        static int mgrid = 0;
        if (mgrid == 0) {
            int dev = 0, cus = 0, per_cu = 0;
            hipGetDevice(&dev);
            hipDeviceGetAttribute(&cus, hipDeviceAttributeMultiprocessorCount, dev);
            hipFuncSetAttribute((const void*)mega, hipFuncAttributeMaxDynamicSharedMemorySize, SMEM_BYTES);
            hipOccupancyMaxActiveBlocksPerMultiprocessor(&per_cu, (const void*)mega, NT, SMEM_BYTES);
            (void)hipGetLastError();
            mgrid = cus;
        }
        hipMemsetAsync(p.bar, 0, XCD_BAR_WORDS * sizeof(unsigned) + 512 * sizeof(float), stream);
        mega<<<mgrid, NT, SMEM_BYTES, stream>>>(p);
        return;
    }
#else
    const int grid = 512;
    hipMemsetAsync(p.bar, 0, XCD_BAR_WORDS * sizeof(unsigned) + 512 * sizeof(float), stream);
    hipFuncSetAttribute((const void*)kph<0>, hipFuncAttributeMaxDynamicSharedMemorySize, SMEM_BYTES);
    hipFuncSetAttribute((const void*)kph<1>, hipFuncAttributeMaxDynamicSharedMemorySize, SMEM_BYTES);
    hipFuncSetAttribute((const void*)kph<2>, hipFuncAttributeMaxDynamicSharedMemorySize, SMEM_BYTES);
    hipFuncSetAttribute((const void*)kph<3>, hipFuncAttributeMaxDynamicSharedMemorySize, SMEM_BYTES);
    hipFuncSetAttribute((const void*)kph<4>, hipFuncAttributeMaxDynamicSharedMemorySize, SMEM_BYTES);
    hipFuncSetAttribute((const void*)kph<5>, hipFuncAttributeMaxDynamicSharedMemorySize, SMEM_BYTES);
    hipFuncSetAttribute((const void*)kph<6>, hipFuncAttributeMaxDynamicSharedMemorySize, SMEM_BYTES);
    hipFuncSetAttribute((const void*)kph<7>, hipFuncAttributeMaxDynamicSharedMemorySize, SMEM_BYTES);
    hipFuncSetAttribute((const void*)kph<8>, hipFuncAttributeMaxDynamicSharedMemorySize, SMEM_BYTES);
    hipFuncSetAttribute((const void*)kph<9>, hipFuncAttributeMaxDynamicSharedMemorySize, SMEM_BYTES);
    hipFuncSetAttribute((const void*)kph<10>, hipFuncAttributeMaxDynamicSharedMemorySize, SMEM_BYTES);
    hipFuncSetAttribute((const void*)kph<11>, hipFuncAttributeMaxDynamicSharedMemorySize, SMEM_BYTES);
    kph<0><<<grid, NT, SMEM_BYTES, stream>>>(p);
    kph<1><<<grid, NT, SMEM_BYTES, stream>>>(p);
    kph<2><<<grid, NT, SMEM_BYTES, stream>>>(p);
    kph<3><<<grid, NT, SMEM_BYTES, stream>>>(p);
    kph<12><<<grid, NT, SMEM_BYTES, stream>>>(p);
    kph<4><<<grid, NT, SMEM_BYTES, stream>>>(p);
    kph<5><<<grid, NT, SMEM_BYTES, stream>>>(p);
    kph<6><<<grid, NT, SMEM_BYTES, stream>>>(p);
    kph<7><<<grid, NT, SMEM_BYTES, stream>>>(p);
    kph<8><<<grid, NT, SMEM_BYTES, stream>>>(p);
    kph<9><<<grid, NT, SMEM_BYTES, stream>>>(p);
    kph<10><<<grid, NT, SMEM_BYTES, stream>>>(p);
    kph<11><<<grid, NT, SMEM_BYTES, stream>>>(p);
#endif
}
```

```cpp
#include <hip/hip_runtime.h>
#include <stdint.h>

typedef unsigned short u16;
using bf16x8 = __attribute__((ext_vector_type(8))) short;
using f32x4  = __attribute__((ext_vector_type(4))) float;

#ifndef MEGA
#define MEGA 1
#endif

constexpr int B_ = 4, S_ = 8192, D_ = 1024, NTOK = B_ * S_;
constexpr int CIN = 5144;
constexpr int NCMP = 511;
constexpr int CRW = 1792;
constexpr int NEXP = 32;
constexpr int NT = 512;
constexpr int NW = NT / 64;
constexpr int SMEM_BYTES = 160 * 1024;
constexpr int SCAN_BLOCKS = 16;
#ifndef TPROBE
#define TPROBE 0
#define TPSEL 0
#endif
constexpr float QSCALE = 0.125f * 1.4426950408889634f;

struct P {
    const float* x; const int* pos; const float* g_mix; const float* w_in;
    const float *pe_k, *w1_k, *b1_k, *w2_k, *b2_k, *pe_v, *w1_v, *b1_v, *w2_v, *b2_v;
    const float *mu, *w0, *w2, *a0, *a2, *g2, *k_k, *k_a, *r_k, *ln_w, *ln_b;
    const float *wpa, *wpb, *wout, *g_ffn, *w_grp, *b_grp, *w_exp, *b_exp, *e_w1, *e_w3, *e_w2, *g_final;
    float* out;
    u16* hbuf; u16 *q, *kc, *vc, *ksl, *vslT, *kwn, *vwnT, *kcb, *vcT; float* nsag; u16* prw;
    u16* cdat; float* bon; u16 *w2T, *a2T, *g2T; u16 *oa, *ob; u16* merged; float* x1;
    int* tok_e; float* tok_gate; int* tokslot; int* list_tok; float* list_gate;
    int* counts; int* offs; int* cursor; int* blk_e; int* blk_r0; int* nblk; float* rsb;
    u16* hid; u16* ybuf; unsigned* bar;
    u16 *winT, *wgT, *wpaT, *wpbT, *woutT, *ew1T, *ew3T, *ew2T;
    u16 *cw1Tk, *cw1Tv, *cw2Tk, *cw2Tv, *chid, *xact; float *cb1k, *cb1v;
};

typedef __bf16 bf16x2_t __attribute__((ext_vector_type(2)));
typedef float f32x2_t __attribute__((ext_vector_type(2)));
__device__ __forceinline__ unsigned pack2(float a, float b) {
    f32x2_t f = {a, b};
    return __builtin_bit_cast(unsigned, __builtin_convertvector(f, bf16x2_t));
}
__device__ __forceinline__ u16 f2bf(float f) { return (u16)(pack2(f, f) & 0xFFFFu); }
__device__ __forceinline__ float bf2f(u16 h) { return __uint_as_float(((unsigned)h) << 16); }
__device__ __forceinline__ float sigmoidf_(float x) { return __builtin_amdgcn_rcpf(1.f + __expf(-x)); }
__device__ __forceinline__ int get_tid() { int t = threadIdx.x; asm volatile("" : "+v"(t)); return t; }
__device__ __forceinline__ uint2 pack4(const f32x4& v) { uint2 o; o.x = pack2(v[0], v[1]); o.y = pack2(v[2], v[3]); return o; }
__device__ __forceinline__ f32x4 unpack4(uint2 u) { return f32x4{__uint_as_float(u.x << 16), __uint_as_float(u.x & 0xFFFF0000u), __uint_as_float(u.y << 16), __uint_as_float(u.y & 0xFFFF0000u)}; }
#define LDS_BARRIER() do { asm volatile("s_waitcnt lgkmcnt(0)" ::: "memory"); __builtin_amdgcn_s_barrier(); asm volatile("" ::: "memory"); } while (0)
__device__ __forceinline__ int opaque(int x) { asm volatile("" : "+v"(x)); return x; }
template <int CTRL>
__device__ __forceinline__ float dppf(float x) { return __int_as_float(__builtin_amdgcn_update_dpp(0, __float_as_int(x), CTRL, 0xF, 0xF, true)); }
__device__ __forceinline__ float wave_sum(float v) {
    v += dppf<0xB1>(v);
    v += dppf<0x4E>(v);
    v += dppf<0x141>(v);
    v += dppf<0x140>(v);
    const int vi = __float_as_int(v);
    return (__int_as_float(__builtin_amdgcn_readlane(vi, 0)) + __int_as_float(__builtin_amdgcn_readlane(vi, 16)))
         + (__int_as_float(__builtin_amdgcn_readlane(vi, 32)) + __int_as_float(__builtin_amdgcn_readlane(vi, 48)));
}

__device__ __forceinline__ float xrow_sum(float v) {
    auto r = __builtin_amdgcn_permlane16_swap(__float_as_uint(v), __float_as_uint(v), false, false);
    v = __uint_as_float(r[0]) + __uint_as_float(r[1]);
    auto r2 = __builtin_amdgcn_permlane32_swap(__float_as_uint(v), __float_as_uint(v), false, false);
    return __uint_as_float(r2[0]) + __uint_as_float(r2[1]);
}
__device__ __forceinline__ float xrow_max(float v) {
    auto r = __builtin_amdgcn_permlane16_swap(__float_as_uint(v), __float_as_uint(v), false, false);
    v = fmaxf(__uint_as_float(r[0]), __uint_as_float(r[1]));
    auto r2 = __builtin_amdgcn_permlane32_swap(__float_as_uint(v), __float_as_uint(v), false, false);
    return fmaxf(__uint_as_float(r2[0]), __uint_as_float(r2[1]));
}
__constant__ double ROPE_FREQ[32] = {
    1.00000000000000000000e+00, 7.49894209332455874417e-01, 5.62341325190349072827e-01, 4.21696503428582225581e-01,
    3.16227766016837941176e-01, 2.37137370566165517349e-01, 1.77827941003892292526e-01, 1.33352143216332402753e-01,
    1.00000000000000005551e-01, 7.49894209332455791150e-02, 5.62341325190349114460e-02, 4.21696503428582239459e-02,
    3.16227766016837913421e-02, 2.37137370566165538166e-02, 1.77827941003892292526e-02, 1.33352143216332406223e-02,
    1.00000000000000002082e-02, 7.49894209332455791150e-03, 5.62341325190349097113e-03, 4.21696503428582291501e-03,
    3.16227766016837939442e-03, 2.37137370566165538166e-03, 1.77827941003892275179e-03, 1.33352143216332406223e-03,
    1.00000000000000002082e-03, 7.49894209332455856203e-04, 5.62341325190349097113e-04, 4.21696503428582237290e-04,
    3.16227766016837939442e-04, 2.37137370566165538166e-04, 1.77827941003892269758e-04, 1.33352143216332395381e-04};

constexpr int G_ABYTES = 256 * 64 * 2, G_BBYTES = 128 * 64 * 2, G_TILE = G_ABYTES + G_BBYTES;
#define LAS3 __attribute__((address_space(3)))
#define GAS1 __attribute__((address_space(1)))
__device__ __forceinline__ void glds16(const u16* g, char* l) {
    __builtin_amdgcn_global_load_lds((const GAS1 unsigned*)g, (LAS3 unsigned*)l, 16, 0, 0);
}
template <bool TR = false, class ARow>
__device__ __forceinline__ void gemm_core(int K, ARow arow, const u16* __restrict__ BT, int ldb, f32x4 (&acc)[4][4], u16* sm) {
    char* base = (char*)sm;
    const int tid = get_tid(), lane = tid & 63, wv = tid >> 6;
    const int wm = wv >> 1, wn = wv & 1, kr = lane & 15, qq = lane >> 4;
    const int lr = tid >> 3, lk = ((tid & 7) ^ ((lr >> 1) & 7)) * 8;
    const u16* ap0 = arow(lr) + lk; const u16* ap1 = arow(lr + 64) + lk;
    const u16* ap2 = arow(lr + 128) + lk; const u16* ap3 = arow(lr + 192) + lk;
    const u16* bp0 = BT + (size_t)lr * ldb + lk; const u16* bp1 = BT + (size_t)(lr + 64) * ldb + lk;
#pragma unroll
    for (int mt = 0; mt < 4; mt++)
#pragma unroll
        for (int nt = 0; nt < 4; nt++) acc[mt][nt] = f32x4{0.f, 0.f, 0.f, 0.f};
    const int nk = K >> 6;
#define G_ISSUE(t, b) { char* d = base + (b) * G_TILE + tid * 16; const int ko = (t) * 64; \
        glds16(ap0 + ko, d); glds16(ap1 + ko, d + 8192); glds16(ap2 + ko, d + 16384); glds16(ap3 + ko, d + 24576); \
        glds16(bp0 + ko, d + G_ABYTES); glds16(bp1 + ko, d + G_ABYTES + 8192); }
    const int sw = kr >> 1;
    const int po0 = ((0 * 4 + qq) ^ sw) * 16, po1 = ((1 * 4 + qq) ^ sw) * 16;
    const int aoff = (wm * 64 + kr) * 128, boff = G_ABYTES + (wn * 64 + kr) * 128;
#define G_READ(FA, FB, b) { const char* Ab = base + (b) * G_TILE + aoff; const char* Bb = base + (b) * G_TILE + boff; \
        _Pragma("unroll") for (int mt = 0; mt < 4; mt++) { FA[0][mt] = *(const bf16x8*)(Ab + mt * 2048 + po0); FA[1][mt] = *(const bf16x8*)(Ab + mt * 2048 + po1); } \
        _Pragma("unroll") for (int nt = 0; nt < 4; nt++) { FB[0][nt] = *(const bf16x8*)(Bb + nt * 2048 + po0); FB[1][nt] = *(const bf16x8*)(Bb + nt * 2048 + po1); } }
#define G_MMA(FA, FB) { __builtin_amdgcn_s_setprio(1); \
        _Pragma("unroll") for (int ks = 0; ks < 2; ks++) \
            _Pragma("unroll") for (int nt = 0; nt < 4; nt++) \
                _Pragma("unroll") for (int mt = 0; mt < 4; mt++) \
                    acc[mt][nt] = TR ? __builtin_amdgcn_mfma_f32_16x16x32_bf16(FA[ks][mt], FB[ks][nt], acc[mt][nt], 0, 0, 0) \
                                     : __builtin_amdgcn_mfma_f32_16x16x32_bf16(FB[ks][nt], FA[ks][mt], acc[mt][nt], 0, 0, 0); \
        __builtin_amdgcn_s_setprio(0); }
    bf16x8 fa0[2][4], fb0[2][4], fa1[2][4], fb1[2][4];
    G_ISSUE(0, 0)
    if (nk > 1) G_ISSUE(1, 1)
    if (nk > 2) G_ISSUE(2, 2)
    if (nk > 2) asm volatile("s_waitcnt vmcnt(12)" ::: "memory");
    else if (nk > 1) asm volatile("s_waitcnt vmcnt(6)" ::: "memory");
    else asm volatile("s_waitcnt vmcnt(0)" ::: "memory");
    __builtin_amdgcn_s_barrier();
    G_READ(fa0, fb0, 0)
    int bnext = 1, bfree = 0;
#define G_STEP(FAC, FBC, FAN, FBN, kt) { \
        if ((kt) + 1 < nk) { \
            if ((kt) + 2 < nk) asm volatile("s_waitcnt vmcnt(6) lgkmcnt(0)" ::: "memory"); else asm volatile("s_waitcnt vmcnt(0) lgkmcnt(0)" ::: "memory"); \
            __builtin_amdgcn_s_barrier();                   \
            if ((kt) + 3 < nk) G_ISSUE((kt) + 3, bfree) \
            G_READ(FAN, FBN, bnext) \
        } \
        G_MMA(FAC, FBC) \
        bfree = bnext; bnext = (bnext == 2) ? 0 : bnext + 1; }
    for (int kt = 0; kt < nk; kt += 2) {
        G_STEP(fa0, fb0, fa1, fb1, kt)
        G_STEP(fa1, fb1, fa0, fb0, kt + 1)
    }
    __builtin_amdgcn_s_barrier();
#undef G_READ
#undef G_MMA
#undef G_STEP
#undef G_ISSUE
}

__device__ __forceinline__ int xcd_item(int bid, int nb, int k, int nitems) {
    if (nb & 7) return bid + k * nb;
    const int per = nb >> 3, chunk = (nitems + 7) >> 3;
    const int j = k * per + (bid >> 3);
    return (j < chunk) ? (bid & 7) * chunk + j : nitems;
}
struct GUnit { int pm, pn; };
constexpr int G8_HTB = 128 * 64 * 2;
__device__ __forceinline__ int g8_lds_byte(int r, int c) { const int st = (r >> 4) * 2 + (c >> 5), rr = r & 15, cc = c & 31, ob = rr * 64 + cc * 2; return st * 1024 + (ob ^ (((ob >> 9) & 1) << 5)); }
__device__ __forceinline__ void g8_stage_rc(int b, int& R, int& C) { const int st = b / 1024, sb = b % 1024, swz = sb ^ (((sb >> 9) & 1) << 5); R = (st >> 1) * 16 + swz / 64; C = (st & 1) * 32 + (swz % 64) / 2; }
__host__ __device__ __forceinline__ int perm32(int rho) { const int n = rho >> 4, i = rho & 15; return 8 * (i >> 2) + 4 * n + (i & 3); }

template <class Epi, class Sched>
__device__ __forceinline__ void gemm256(char* smem, const char* Ab, int K, const Sched& S, const Epi& E) {
    LAS3 unsigned char* lds = (LAS3 unsigned char*)smem;
    const int tid = get_tid(), wid = __builtin_amdgcn_readfirstlane(tid >> 6), lane = tid & 63, wr = wid >> 2, wc = wid & 3, fr = lane & 15, fq = lane >> 4;
    int nt = K >> 6; asm volatile("" : "+s"(nt));
    unsigned voffB[2], voffA[2][2];
#pragma unroll
    for (int i = 0; i < 2; ++i) { int sR, sC; g8_stage_rc(tid * 16 + i * 8192, sR, sC); voffB[i] = (unsigned)(sR * K + sC) * 2u; }
#define G8_AOFFS(un) do { const int t3_ = get_tid(); _Pragma("unroll") for (int i = 0; i < 2; ++i) { int sR, sC; g8_stage_rc(t3_ * 16 + i * 8192, sR, sC); \
        _Pragma("unroll") for (int h = 0; h < 2; ++h) voffA[h][i] = S.a_off(un, h, sR) + (unsigned)sC * 2u; } } while (0)
    const size_t kstep = 128;
    const size_t hstep = (size_t)128 * K * 2;
    const unsigned ldsw = (unsigned)wid * 1024u;
    const int aoff = g8_lds_byte(wr * 64 + fr, fq * 8), boff = g8_lds_byte(wc * 32 + fr, fq * 8);
#define G8_SA(b, h) (((b) * 2 + (h)) * G8_HTB)
#define G8_SB(b, h) ((4 + (b) * 2 + (h)) * G8_HTB)
#define G8_STAGE2(bufoff, gbase, v0, v1) do { \
        __builtin_amdgcn_global_load_lds((const GAS1 unsigned*)((const char*)(gbase) + (v0)), (LAS3 unsigned*)(lds + (bufoff) + ldsw), 16, 0, 0); \
        __builtin_amdgcn_global_load_lds((const GAS1 unsigned*)((const char*)(gbase) + (v1)), (LAS3 unsigned*)(lds + (bufoff) + ldsw + 8192), 16, 0, 0); } while (0)
#define G8_STAGEB(bufoff, gbase) G8_STAGE2(bufoff, gbase, voffB[0], voffB[1])
#define G8_LDA(dst, b, h) do { _Pragma("unroll") for (int m = 0; m < 4; ++m) _Pragma("unroll") for (int k = 0; k < 2; ++k) dst[m][k] = *(const LAS3 bf16x8*)(lds + G8_SA(b, h) + aoff + m * 2048 + k * 1024); } while (0)
#define G8_LDB(dst, b, h) do { _Pragma("unroll") for (int n = 0; n < 2; ++n) _Pragma("unroll") for (int k = 0; k < 2; ++k) dst[n][k] = *(const LAS3 bf16x8*)(lds + G8_SB(b, h) + boff + n * 2048 + k * 1024); } while (0)
#define G8_MMA(ai, bj, At, Bt) do { __builtin_amdgcn_s_setprio(1); _Pragma("unroll") for (int m = 0; m < 4; ++m) _Pragma("unroll") for (int n = 0; n < 2; ++n) _Pragma("unroll") for (int k = 0; k < 2; ++k) \
        acc[ai][bj][m][n] = __builtin_amdgcn_mfma_f32_16x16x32_bf16(Bt[n][k], At[m][k], acc[ai][bj][m][n], 0, 0, 0); __builtin_amdgcn_s_setprio(0); } while (0)
#define G8_WAIT_V(n) asm volatile("s_waitcnt vmcnt(" #n ")" ::: "memory")
#define G8_WAIT_L(n) asm volatile("s_waitcnt lgkmcnt(" #n ")" ::: "memory")
#define G8_BAR __builtin_amdgcn_s_barrier()
#define G8_SCHED __builtin_amdgcn_sched_barrier(0)
    GUnit cur, nxt; int ui = 0;
    if (!S.next(0, cur)) return;
    f32x4 acc[2][2][4][2];
#pragma unroll
    for (int a = 0; a < 2; ++a)
#pragma unroll
        for (int b = 0; b < 2; ++b)
#pragma unroll
            for (int m = 0; m < 4; ++m)
#pragma unroll
                for (int n = 0; n < 2; ++n) acc[a][b][m][n] = (f32x4){0.f, 0.f, 0.f, 0.f};
    bf16x8 At[4][2], B0[2][2], B1[2][2];
    G8_AOFFS(cur);
    const char* cB = S.b_ptr(cur);
    G8_STAGEB(G8_SB(0, 0), cB); G8_STAGE2(G8_SA(0, 0), Ab, voffA[0][0], voffA[0][1]); G8_STAGEB(G8_SB(0, 1), cB + hstep); G8_STAGE2(G8_SA(0, 1), Ab, voffA[1][0], voffA[1][1]);
    if (wr == 1) G8_BAR;
    G8_WAIT_V(4); G8_BAR;
    G8_STAGEB(G8_SB(1, 0), cB + kstep); G8_STAGE2(G8_SA(1, 0), Ab + kstep, voffA[0][0], voffA[0][1]); G8_STAGEB(G8_SB(1, 1), cB + hstep + kstep);
    G8_WAIT_V(6); G8_BAR;
    for (;;) {
        const bool has_next = S.next(ui + 1, nxt);
        const char* nB = has_next ? S.b_ptr(nxt) : cB;
        for (int t = 0; t < nt; t += 2) {
            const bool last = (t == nt - 2);
            const char* a1 = Ab + (size_t)(t + 1) * kstep;
            const unsigned va10 = voffA[1][0], va11 = voffA[1][1];
            if (last && has_next) G8_AOFFS(nxt);
            const char* a2 = last ? Ab : Ab + (size_t)(t + 2) * kstep; const char* b2 = last ? nB : cB + (size_t)(t + 2) * kstep;
            const char* a3 = a2 + kstep; const char* b3 = b2 + kstep;
            G8_LDB(B0, 0, 0); G8_SCHED; G8_LDA(At, 0, 0); G8_STAGE2(G8_SA(1, 1), a1, va10, va11);
            G8_WAIT_L(8); G8_BAR; G8_WAIT_L(0); G8_MMA(0, 0, At, B0); G8_BAR; G8_SCHED;
            G8_LDB(B1, 0, 1); G8_STAGEB(G8_SB(0, 0), b2);
            G8_BAR; G8_WAIT_L(0); G8_MMA(0, 1, At, B1); G8_BAR;
            G8_LDA(At, 0, 1); G8_STAGE2(G8_SA(0, 0), a2, voffA[0][0], voffA[0][1]);
            G8_BAR; G8_WAIT_L(0); G8_MMA(1, 0, At, B0); G8_BAR; G8_SCHED;
            G8_STAGEB(G8_SB(0, 1), b2 + hstep);
            G8_WAIT_V(6); G8_BAR; G8_MMA(1, 1, At, B1); G8_BAR;
            G8_LDB(B0, 1, 0); G8_SCHED; G8_LDA(At, 1, 0); G8_STAGE2(G8_SA(0, 1), a2, voffA[1][0], voffA[1][1]);
            G8_WAIT_L(8); G8_BAR; G8_WAIT_L(0); G8_MMA(0, 0, At, B0); G8_BAR; G8_SCHED;
            G8_LDB(B1, 1, 1); G8_STAGEB(G8_SB(1, 0), b3);
            G8_BAR; G8_WAIT_L(0); G8_MMA(0, 1, At, B1); G8_BAR;
            G8_LDA(At, 1, 1); G8_STAGE2(G8_SA(1, 0), a3, voffA[0][0], voffA[0][1]);
            G8_BAR; G8_WAIT_L(0); G8_MMA(1, 0, At, B0); G8_BAR; G8_SCHED;
            G8_STAGEB(G8_SB(1, 1), b3 + hstep);
            G8_WAIT_V(6); G8_BAR; G8_MMA(1, 1, At, B1); G8_BAR;
        }
        E(acc, cur, wr, wc, fr, fq);
        if (!has_next) break;
#pragma unroll
        for (int a = 0; a < 2; ++a)
#pragma unroll
            for (int b = 0; b < 2; ++b)
#pragma unroll
                for (int m = 0; m < 4; ++m)
#pragma unroll
                    for (int n = 0; n < 2; ++n) acc[a][b][m][n] = (f32x4){0.f, 0.f, 0.f, 0.f};
        cur = nxt; cB = nB; ++ui;
    }
    G8_WAIT_V(0);
    if (wr == 0) G8_BAR;
    G8_BAR;
#undef G8_SA
#undef G8_AOFFS
#undef G8_SB
#undef G8_STAGE2
#undef G8_STAGEB
#undef G8_LDA
#undef G8_LDB
#undef G8_MMA
#undef G8_WAIT_V
#undef G8_WAIT_L
#undef G8_BAR
#undef G8_SCHED
}
struct DenseSched {
    int nM, nN, nwg, G, c, K; const char* Bt;
    __device__ __forceinline__ void init(int M, int N, int K_, const void* Bt_, int G_, int c_) { nM = M >> 8; nN = N >> 8; nwg = nM * nN; G = G_; c = c_; K = K_; Bt = (const char*)Bt_; }
    __device__ __forceinline__ bool next(int i, GUnit& u) const {
        const int L = i * G + c; if (L >= nwg) return false;
        int wgid = L; { const int q = nwg >> 3, r = nwg & 7, xcd = wgid & 7, off = wgid >> 3; wgid = (xcd < r ? xcd * (q + 1) : r * (q + 1) + (xcd - r) * q) + off; }
        const int nig = 8 * nN, gid = wgid / nig, fm = gid * 8, gsz = (nM - fm) < 8 ? (nM - fm) : 8, w = wgid - gid * nig;
        u.pn = w / gsz; u.pm = fm + (w - u.pn * gsz); return true;
    }
    __device__ __forceinline__ unsigned a_off(const GUnit& u, int h, int R) const { return (unsigned)((u.pm * 256 + h * 128 + R) * K) * 2u; }
    __device__ __forceinline__ const char* b_ptr(const GUnit& u) const { return Bt + (size_t)u.pn * 256 * K * 2; }
};

template <class SRC>
__device__ __forceinline__ void convert_wT(const float* __restrict__ W, int K, int N, u16* __restrict__ WT, int rows, SRC src, int gtid, int gnt) {
    const int kch = K >> 3;
    const int total = rows * kch;
    for (int i = gtid; i < total; i += gnt) {
        const int kc = i / rows, j = i - kc * rows;
        const int sc = src(j);
        uint4 v = make_uint4(0u, 0u, 0u, 0u);
        if (sc >= 0) {
            const float* wp = W + (size_t)(kc * 8) * N + sc;
            v.x = pack2(wp[0], wp[(size_t)N]); v.y = pack2(wp[2 * (size_t)N], wp[3 * (size_t)N]);
            v.z = pack2(wp[4 * (size_t)N], wp[5 * (size_t)N]); v.w = pack2(wp[6 * (size_t)N], wp[7 * (size_t)N]);
        }
        *(uint4*)&WT[(size_t)j * K + kc * 8] = v;
    }
}

__device__ void ph_prologue(const P& p, int bid, int nb, char* smem) {
    const int tid = get_tid(), lane = tid & 63, wv = tid >> 6;
    if (bid >= 1 && bid <= 64) {
        const int j = tid & 255; const bool isv = tid >= 256;
        const float* pe = isv ? p.pe_v : p.pe_k; const float* w1 = isv ? p.w1_v : p.w1_k;
        const int kb = (bid - 1) * 32;
        float a0 = 0.f, a1 = 0.f;
#pragma unroll 4
        for (int k = kb; k < kb + 32; k += 2) { a0 += pe[k] * w1[(size_t)k * 256 + j]; a1 += pe[k + 1] * w1[(size_t)(k + 1) * 256 + j]; }
        atomicAdd(&(isv ? p.cb1v : p.cb1k)[j], a0 + a1);
    }
    if (bid == 0) {
        if (tid < 32) { p.counts[tid] = 0; p.cursor[tid] = 0; }
        for (int i = tid; i < 8 * 64; i += NT) {
            const int bg = i >> 6, d = i & 63;
            p.kcb[((size_t)bg * 512 + 511) * 64 + d] = 0;
            p.vcT[(((size_t)bg * 8 + 7) * 64 + d) * 64 + 63] = 0;
        }
    }
    {
        const int gtid = bid * NT + tid, gnt = nb * NT;
        convert_wT(p.w_in, D_, CIN, p.winT, 3328, [](int j) {
            const int t = j >> 8, s = j & 255;
            if (t < 5) {
                const int bj = s >> 7, wc = (s >> 5) & 3, n = (s >> 4) & 1, i = s & 15;
                const int dim = 32 * bj + 8 * (i >> 2) + 4 * n + (i & 3), hq = 4 * t + wc;
                int hb;
                if (hq < 8) hb = 64 * hq;
                else { const int k = (hq - 8) >> 1; hb = (k == 0 ? 512 : (k == 1 ? 640 : (k == 2 ? 768 : (k == 3 ? 1024 : (k == 4 ? 896 : 1152))))) + 64 * (hq & 1); }
                return hb + dim;
            }
            const int c = (s & ~31) + perm32(s & 31);
            if (t < 12) return 1304 + (t - 5) * 256 + c;
            return c < 24 ? 1280 + c : -1; }, gtid, gnt);
        convert_wT(p.w_in, D_, CIN, p.wgT, 2048, [](int j) { return 3096 + (j & ~31) + perm32(j & 31); }, gtid, gnt);
        convert_wT(p.wpa, 512, D_, p.wpaT, 1024, [](int j) { return (j & ~31) + perm32(j & 31); }, gtid, gnt);
        convert_wT(p.wpb, 512, D_, p.wpbT, 1024, [](int j) { return (j & ~31) + perm32(j & 31); }, gtid, gnt);
        convert_wT(p.wout, D_, D_, p.woutT, 1024, [](int j) { return j; }, gtid, gnt);
        convert_wT(p.w2, 64, 512, p.w2T, 512, [](int j) { return j; }, gtid, gnt);
        convert_wT(p.w1_k, 2048, 256, p.cw1Tk, 256, [](int j) { return j; }, gtid, gnt);
        convert_wT(p.w1_v, 2048, 256, p.cw1Tv, 256, [](int j) { return j; }, gtid, gnt);
        convert_wT(p.w2_k, 256, 64, p.cw2Tk, 128, [](int j) { return j < 64 ? j : -1; }, gtid, gnt);
        convert_wT(p.w2_v, 256, 64, p.cw2Tv, 128, [](int j) { return j < 64 ? j : -1; }, gtid, gnt);
        convert_wT(p.a2, 64, 512, p.a2T, 512, [](int j) { return j; }, gtid, gnt);
        convert_wT(p.g2, 128, 512, p.g2T, 512, [](int j) { return j; }, gtid, gnt);
    }
    for (int row = bid * NW + wv; row < NTOK; row += nb * NW) {
        const float* xr = p.x + (size_t)row * D_;
        float v[16];
        float ss = 0.f;
#pragma unroll
        for (int i = 0; i < 4; i++) {
            float4 t = *(const float4*)&xr[i * 256 + lane * 4];
            v[4 * i] = t.x; v[4 * i + 1] = t.y; v[4 * i + 2] = t.z; v[4 * i + 3] = t.w;
            ss += t.x * t.x + t.y * t.y + t.z * t.z + t.w * t.w;
        }
        ss = wave_sum(ss);
        const float rs = rsqrtf(ss * (1.f / D_) + 1e-6f);
#pragma unroll
        for (int i = 0; i < 4; i++) {
            const int c = i * 256 + lane * 4;
            float4 g = *(const float4*)&p.g_mix[c];
            uint2 o;
            o.x = pack2(v[4 * i] * rs * g.x, v[4 * i + 1] * rs * g.y);
            o.y = pack2(v[4 * i + 2] * rs * g.z, v[4 * i + 3] * rs * g.w);
            *(uint2*)&p.hbuf[(size_t)row * D_ + c] = o;
        }
    }
}

__device__ __forceinline__ uint4 pack8(const f32x4& a, const f32x4& b) { uint4 o; o.x = pack2(a[0], a[1]); o.y = pack2(a[2], a[3]); o.z = pack2(b[0], b[1]); o.w = pack2(b[2], b[3]); return o; }
struct EpiInproj {
    const P* pp;
    __device__ __forceinline__ void operator()(const f32x4 (&acc)[2][2][4][2], const GUnit& u, int, int, int, int) const {
        const int t2_ = get_tid(), wid_ = __builtin_amdgcn_readfirstlane(t2_ >> 6), wr = wid_ >> 2, wc = wid_ & 3, fr = t2_ & 15, fq = (t2_ >> 4) & 3;
        const P& p = *pp;
        const int pn = u.pn;
        const int rowb = u.pm * 256 + wr * 64;
        if (pn < 4) {
            const int hq = 4 * pn + wc;
            const bool rope = !(pn == 2 && wc >= 2);
            u16* dst; size_t rstride; int cofs;
            if (pn < 2) { dst = p.q; rstride = 512; cofs = hq * 64; }
            else { dst = (pn == 2) ? (wc < 2 ? p.kc : p.vc) : (wc < 2 ? p.ksl : p.kwn); rstride = 64; cofs = 0; }
            const int g = wc & 1;
#pragma unroll
            for (int ai = 0; ai < 2; ++ai)
#pragma unroll
                for (int m = 0; m < 4; ++m) {
                    const int row = rowb + ai * 128 + m * 16 + fr;
                    f32x4 o1[2], o2[2];
#pragma unroll
                    for (int n = 0; n < 2; ++n) { o1[n] = acc[ai][0][m][n]; o2[n] = acc[ai][1][m][n]; }
                    if (rope) {
                        const double posd = (double)p.pos[row];
#pragma unroll
                        for (int n = 0; n < 2; ++n)
#pragma unroll
                            for (int j = 0; j < 4; ++j) {
                                const double tr = posd * ROPE_FREQ[8 * fq + 4 * n + j] * 0.15915494309189535;
                                const float fr_ = (float)(tr - rint(tr));
                                const float cs = __builtin_amdgcn_cosf(fr_), sn = __builtin_amdgcn_sinf(fr_);
                                const float x1 = o1[n][j], x2 = o2[n][j];
                                o1[n][j] = x1 * cs - x2 * sn; o2[n][j] = x1 * sn + x2 * cs;
                            }
                    }
                    size_t ro;
                    if (pn < 2) {
#pragma unroll
                        for (int n = 0; n < 2; ++n)
#pragma unroll
                            for (int j = 0; j < 4; ++j) { o1[n][j] *= QSCALE; o2[n][j] *= QSCALE; }
                        ro = (size_t)row * 512 + cofs + 8 * fq;
                    } else {
                        const int bb = row >> 13, t = row & (S_ - 1);
                        ro = ((size_t)(bb * 2 + g) * S_ + t) * 64 + 8 * fq;
                    }
                    *(uint4*)&dst[ro] = pack8(o1[0], o1[1]);
                    *(uint4*)&dst[ro + 32] = pack8(o2[0], o2[1]);
                }
        } else if (pn == 4) {
            u16* dst = (wc < 2) ? p.vslT : p.vwnT;
            const int g = wc & 1;
#pragma unroll
            for (int ai = 0; ai < 2; ++ai) {
                const int r0 = rowb + ai * 128, bb = r0 >> 13, tb = r0 & (S_ - 1);
                u16* base = dst + ((size_t)(bb * 2 + g) * 128 + (tb >> 6)) * 4096;
#pragma unroll
                for (int m = 0; m < 4; ++m)
#pragma unroll
                    for (int bj = 0; bj < 2; ++bj)
#pragma unroll
                        for (int n = 0; n < 2; ++n)
#pragma unroll
                            for (int j = 0; j < 4; ++j)
                                base[(32 * bj + 8 * fq + 4 * n + j) * 64 + m * 16 + fr] = f2bf(acc[ai][bj][m][n][j]);
            }
        } else if (pn < 12) {
            const int cb = (pn - 5) * 256 + wc * 32 + 8 * fq;
#pragma unroll
            for (int ai = 0; ai < 2; ++ai)
#pragma unroll
                for (int m = 0; m < 4; ++m) {
                    const size_t ro = (size_t)(rowb + ai * 128 + m * 16 + fr) * CRW + cb;
#pragma unroll
                    for (int bj = 0; bj < 2; ++bj) *(uint4*)&p.prw[ro + bj * 128] = pack8(acc[ai][bj][m][0], acc[ai][bj][m][1]);
                }
        } else {
            if (wc == 0 && fq < 3) {
#pragma unroll
                for (int ai = 0; ai < 2; ++ai)
#pragma unroll
                    for (int m = 0; m < 4; ++m) {
                        const size_t ro = (size_t)(rowb + ai * 128 + m * 16 + fr) * 24 + 8 * fq;
#pragma unroll
                        for (int n = 0; n < 2; ++n) {
                            float4 o; o.x = sigmoidf_(acc[ai][0][m][n][0]); o.y = sigmoidf_(acc[ai][0][m][n][1]); o.z = sigmoidf_(acc[ai][0][m][n][2]); o.w = sigmoidf_(acc[ai][0][m][n][3]);
                            *(float4*)&p.nsag[ro + 4 * n] = o;
                        }
                    }
            }
        }
    }
};
__device__ void ph_inproj(const P& p, int bid, int nb, char* smem) {
    DenseSched S; S.init(NTOK, 3328, D_, p.winT, nb, bid);
    EpiInproj E{&p};
    gemm256(smem, (const char*)p.hbuf, D_, S, E);
}

__device__ __forceinline__ float gelu_tanh(float x) {
    const float c = 0.7978845608028654f;
    return 0.5f * x * (1.f + tanhf(c * (x + 0.044715f * x * x * x)));
}
__device__ void ph_compress(const P& p, int bid, int nb, char* smem) {
    u16* sm = (u16*)smem;
    const int tid = get_tid(), lane = tid & 63, wv = tid >> 6;
    const int wm = wv >> 1, wn = wv & 1;
    for (int it = bid; it < 32; it += nb) {
        const int rt = it & 1, g = (it >> 1) & 1, b = (it >> 2) & 3, kv = it >> 4;
        const int bg = b * 2 + g, i0 = rt * 256;
        const u16* src = (kv ? p.vc : p.kc) + (size_t)bg * S_ * 64;
        const u16* w1T = kv ? p.cw1Tv : p.cw1Tk;
        const u16* w2T = kv ? p.cw2Tv : p.cw2Tk;
        const float* cb1 = kv ? p.cb1v : p.cb1k;
        const float* b1 = kv ? p.b1_v : p.b1_k;
        const float* b2 = kv ? p.b2_v : p.b2_k;
        u16* hidp = p.chid + (size_t)it * 256 * 256;
        auto arow = [&](int r) { int i = i0 + r; if (i > 510) i = 510; return src + (size_t)i * 1024; };
#pragma unroll 1
        for (int ct = 0; ct < 2; ct++) {
            f32x4 acc[4][4];
            gemm_core<false>(2048, arow, w1T + (size_t)ct * 128 * 2048, 2048, acc, sm);
            const int le = get_tid() & 63;
#pragma unroll
            for (int mt = 0; mt < 4; mt++) {
                const int r = wm * 64 + mt * 16 + (le & 15);
#pragma unroll
                for (int nt = 0; nt < 4; nt++) {
                    const int col = ct * 128 + wn * 64 + nt * 16 + (le >> 4) * 4;
                    const float4 c1 = *(const float4*)&cb1[col], bb1 = *(const float4*)&b1[col];
                    f32x4 o;
                    o[0] = gelu_tanh(acc[mt][nt][0] + c1.x + bb1.x); o[1] = gelu_tanh(acc[mt][nt][1] + c1.y + bb1.y);
                    o[2] = gelu_tanh(acc[mt][nt][2] + c1.z + bb1.z); o[3] = gelu_tanh(acc[mt][nt][3] + c1.w + bb1.w);
                    *(uint2*)&hidp[r * 256 + col] = pack4(o);
                }
            }
        }
        __syncthreads();
        {
            f32x4 acc[4][4];
            gemm_core<true>(256, [&](int r) { return hidp + (size_t)r * 256; }, w2T, 256, acc, sm);
            if (wn == 0) {
#pragma unroll
                for (int mt = 0; mt < 4; mt++)
#pragma unroll
                    for (int nt = 0; nt < 4; nt++) {
                        const int d = nt * 16 + (lane & 15);
                        const int ib = i0 + wm * 64 + mt * 16 + (lane >> 4) * 4;
                        float o[4];
#pragma unroll
                        for (int j = 0; j < 4; j++) o[j] = (ib + j < NCMP) ? (acc[mt][nt][j] + b2[d]) : 0.f;
                        if (kv == 0) {
#pragma unroll
                            for (int j = 0; j < 4; j++) p.kcb[((size_t)bg * 512 + ib + j) * 64 + d] = f2bf(o[j]);
                        } else {
                            uint2 ov; ov.x = pack2(o[0], o[1]); ov.y = pack2(o[2], o[3]);
                            *(uint2*)&p.vcT[(((size_t)bg * 8 + (ib >> 6)) * 64 + d) * 64 + (ib & 63)] = ov;
                        }
                    }
            }
        }
        __syncthreads();
    }
}

#ifndef NSAPROBE
#define NSAPROBE 0
#endif
#define NSA_TS(k) if (NSAPROBE == k) ts_ = __builtin_amdgcn_s_memrealtime();
#define NSA_TE(k) if (NSAPROBE == k) tacc_ += __builtin_amdgcn_s_memrealtime() - ts_;
constexpr int KSTR = 72;
struct Sub { f32x4 O[4]; float m, l; };
#define NEG_BIG (-1.0e30f)

__device__ __forceinline__ float xq_max(float v) {
    return xrow_max(v);
}
__device__ __forceinline__ float xq_sum(float v) {
    return xrow_sum(v);
}
template <bool MASK, bool IMP, bool PV>
__device__ __forceinline__ void nsa_visit(const u16* Ks, const u16* Vs, const u16* qrow, Sub& s, int lo, int hi, int lane, float* e, float* p3) {
    const int kr = lane & 15, qq = lane >> 4;
    f32x4 S[4];
    const int qsw = ((kr & 3) >> 1) ^ ((kr >> 2) << 1);
    const bf16x8 qf0 = *(const bf16x8*)(qrow + ((qq ^ qsw) << 3)), qf1 = *(const bf16x8*)(qrow + (((4 + qq) ^ qsw) << 3));
    bf16x8 kf[4][2];
    const int swz = kr >> 1;
    {
        const char* kb_ = (const char*)Ks + kr * 128;
        const int ko0 = (qq ^ swz) << 4, ko1 = ko0 ^ 64;
#pragma unroll
        for (int kt = 0; kt < 4; kt++) { kf[kt][0] = *(const bf16x8*)(kb_ + kt * 2048 + ko0); kf[kt][1] = *(const bf16x8*)(kb_ + kt * 2048 + ko1); }
    }
    __builtin_amdgcn_sched_barrier(0);
#pragma unroll
    for (int kt = 0; kt < 4; kt++) {
        S[kt] = __builtin_amdgcn_mfma_f32_16x16x32_bf16(kf[kt][0], qf0, f32x4{0.f, 0.f, 0.f, 0.f}, 0, 0, 0);
        S[kt] = __builtin_amdgcn_mfma_f32_16x16x32_bf16(kf[kt][1], qf1, S[kt], 0, 0, 0);
    }
    union VF { bf16x8 v; uint2 h[2]; };
    float mx = NEG_BIG;
#pragma unroll
    for (int kt = 0; kt < 4; kt++)
#pragma unroll
        for (int r = 0; r < 4; r++) {
            if (MASK) { const int o = kt * 16 + qq * 4 + r; if (o < lo || o > hi) S[kt][r] = -INFINITY; }
            mx = fmaxf(mx, S[kt][r]);
        }
    mx = xq_max(mx);
    const float mnew = fmaxf(s.m, mx);
    const float alpha = __builtin_amdgcn_exp2f(s.m - mnew);
    s.m = mnew;
    float psum = 0.f;
#pragma unroll
    for (int kt = 0; kt < 4; kt++) {
#pragma unroll
        for (int r = 0; r < 4; r++) { S[kt][r] = __builtin_amdgcn_exp2f(S[kt][r] - mnew); }
        const float ee = (S[kt][0] + S[kt][1]) + (S[kt][2] + S[kt][3]);
        psum += ee;
        if (IMP) { e[kt] = ee; p3[kt] = S[kt][3]; }
    }
    s.l = s.l * alpha + psum;
    if (PV) {
        if (!__all(alpha == 1.f)) {
#pragma unroll
            for (int dt = 0; dt < 4; dt++)
#pragma unroll
                for (int r = 0; r < 4; r++) s.O[dt][r] *= alpha;
        }
        VF vf[4][2];
        {
            const char* vb_ = (const char*)Vs + kr * 128 + (qq & 1) * 8;
            const int vo = ((qq >> 1) ^ swz) << 4;
#pragma unroll
            for (int dt = 0; dt < 4; dt++)
#pragma unroll
                for (int k2 = 0; k2 < 2; k2++) {
                    vf[dt][k2].h[0] = *(const uint2*)(vb_ + dt * 2048 + (vo ^ (k2 * 64)));
                    vf[dt][k2].h[1] = *(const uint2*)(vb_ + dt * 2048 + (vo ^ (k2 * 64 + 32)));
                }
        }
        bf16x8 pb[2];
#pragma unroll
        for (int k2 = 0; k2 < 2; k2++) {
            union { bf16x8 v; unsigned u[4]; } t;
            t.u[0] = pack2(S[2 * k2][0], S[2 * k2][1]); t.u[1] = pack2(S[2 * k2][2], S[2 * k2][3]);
            t.u[2] = pack2(S[2 * k2 + 1][0], S[2 * k2 + 1][1]); t.u[3] = pack2(S[2 * k2 + 1][2], S[2 * k2 + 1][3]);
            pb[k2] = t.v;
        }
        __builtin_amdgcn_sched_barrier(0);
#pragma unroll
        for (int dt = 0; dt < 4; dt++)
#pragma unroll
            for (int k2 = 0; k2 < 2; k2++) s.O[dt] = __builtin_amdgcn_mfma_f32_16x16x32_bf16(vf[dt][k2].v, pb[k2], s.O[dt], 0, 0, 0);
    }
}
template <int MMODE, bool FIXM>
__device__ __forceinline__ void nsa_visit_g(const u16* Ks, const u16* Vs, const u16* qs, float* Os, float* Ms, float* Ls, int tok, bool valid, int lane) {
    const int kr = lane & 15, qq = lane >> 4, hh = kr & 3;
    const int row = tok * 4 + hh;
    float* orow = Os + row * 64;
    f32x4 O[4];
    const int osw = hh ^ ((tok & 3) << 2);
#pragma unroll
    for (int dt = 0; dt < 4; dt++) O[dt] = *(const f32x4*)(orow + (((dt * 4 + qq) ^ osw) << 2));
    const float m_old = Ms[row], l_old = Ls[row];
    const u16* qrow = qs + row * 64;
    const int qsw = (hh >> 1) ^ ((tok & 3) << 1);
    const bf16x8 qf0 = *(const bf16x8*)(qrow + ((qq ^ qsw) << 3)), qf1 = *(const bf16x8*)(qrow + (((4 + qq) ^ qsw) << 3));
    bf16x8 kf[4][2];
    const int swz = kr >> 1;
    {
        const char* kb_ = (const char*)Ks + kr * 128;
        const int ko0 = (qq ^ swz) << 4, ko1 = ko0 ^ 64;
#pragma unroll
        for (int kt = 0; kt < 4; kt++) { kf[kt][0] = *(const bf16x8*)(kb_ + kt * 2048 + ko0); kf[kt][1] = *(const bf16x8*)(kb_ + kt * 2048 + ko1); }
    }
    __builtin_amdgcn_sched_barrier(0);
    f32x4 S[4];
#pragma unroll
    for (int kt = 0; kt < 4; kt++) {
        S[kt] = __builtin_amdgcn_mfma_f32_16x16x32_bf16(kf[kt][0], qf0, f32x4{0.f, 0.f, 0.f, 0.f}, 0, 0, 0);
        S[kt] = __builtin_amdgcn_mfma_f32_16x16x32_bf16(kf[kt][1], qf1, S[kt], 0, 0, 0);
    }
    union VF { bf16x8 v; uint2 h[2]; };
    VF vf[4][2];
    {
        const char* vb_ = (const char*)Vs + kr * 128 + (qq & 1) * 8;
        const int vo = ((qq >> 1) ^ swz) << 4;
#pragma unroll
        for (int dt = 0; dt < 4; dt++)
#pragma unroll
            for (int k2 = 0; k2 < 2; k2++) {
                vf[dt][k2].h[0] = *(const uint2*)(vb_ + dt * 2048 + (vo ^ (k2 * 64)));
                vf[dt][k2].h[1] = *(const uint2*)(vb_ + dt * 2048 + (vo ^ (k2 * 64 + 32)));
            }
    }
    float mx = NEG_BIG;
#pragma unroll
    for (int kt = 0; kt < 4; kt++)
#pragma unroll
        for (int r = 0; r < 4; r++) {
            if (MMODE == 1) { const int o = kt * 16 + qq * 4 + r; if (o > tok) S[kt][r] = -INFINITY; }
            if (MMODE == 2) { const int o = kt * 16 + qq * 4 + r; if (o <= tok) S[kt][r] = -INFINITY; }
            if (FIXM) { if (!valid) S[kt][r] = -INFINITY; } else mx = fmaxf(mx, S[kt][r]);
        }
    float mnew = m_old, alpha = 1.f;
    if (!FIXM) {
        if (!valid) mx = NEG_BIG;
        mx = xq_max(mx);
        mnew = fmaxf(m_old, mx);
        alpha = __builtin_amdgcn_exp2f(m_old - mnew);
    }
    float psum = 0.f;
#pragma unroll
    for (int kt = 0; kt < 4; kt++) {
#pragma unroll
        for (int r = 0; r < 4; r++) { S[kt][r] = __builtin_amdgcn_exp2f(S[kt][r] - mnew); }
        psum += (S[kt][0] + S[kt][1]) + (S[kt][2] + S[kt][3]);
    }
    psum = xq_sum(psum);
    if (FIXM) { if (valid && qq == 0) Ls[row] = l_old + psum; }
    else {
        if (valid && qq == 0) { Ms[row] = mnew; Ls[row] = l_old * alpha + psum; }
#pragma unroll
        for (int dt = 0; dt < 4; dt++)
#pragma unroll
            for (int r = 0; r < 4; r++) O[dt][r] *= alpha;
    }
    bf16x8 pb[2];
#pragma unroll
    for (int k2 = 0; k2 < 2; k2++) {
        union { bf16x8 v; unsigned u[4]; } t;
        t.u[0] = pack2(S[2 * k2][0], S[2 * k2][1]); t.u[1] = pack2(S[2 * k2][2], S[2 * k2][3]);
        t.u[2] = pack2(S[2 * k2 + 1][0], S[2 * k2 + 1][1]); t.u[3] = pack2(S[2 * k2 + 1][2], S[2 * k2 + 1][3]);
        pb[k2] = t.v;
    }
    __builtin_amdgcn_sched_barrier(0);
#pragma unroll
    for (int dt = 0; dt < 4; dt++)
#pragma unroll
        for (int k2 = 0; k2 < 2; k2++) O[dt] = __builtin_amdgcn_mfma_f32_16x16x32_bf16(vf[dt][k2].v, pb[k2], O[dt], 0, 0, 0);
    if (valid) {
#pragma unroll
        for (int dt = 0; dt < 4; dt++) *(f32x4*)(orow + (((dt * 4 + qq) ^ osw) << 2)) = O[dt];
    }
}
__device__ __forceinline__ void nsa_fold_lds(float* Os, float* Ms, float* Ls, int row, int qq, int hh, f32x4 (&T)[4], float gate, bool reset) {
    const float lt = Ls[row];
    const float sc = (lt > 0.f) ? gate / lt : 0.f;
#pragma unroll
    for (int dt = 0; dt < 4; dt++) {
        float* op = Os + row * 64 + (((dt * 4 + qq) ^ hh ^ (((row >> 2) & 3) << 2)) << 2);
        const f32x4 o = *(const f32x4*)op;
#pragma unroll
        for (int r = 0; r < 4; r++) T[dt][r] += o[r] * sc;
        if (reset) *(f32x4*)op = f32x4{0.f, 0.f, 0.f, 0.f};
    }
    asm volatile("s_waitcnt lgkmcnt(0)" ::: "memory");
    if (reset && qq == 0) { Ms[row] = NEG_BIG; Ls[row] = 0.f; }
}
template <int MODE>
__device__ __forceinline__ void nsa_fold(Sub& s, f32x4 (&T)[4], float gate) {
    const float lt = xq_sum(s.l);
    const float sc = (lt > 0.f) ? gate / lt : 0.f;
#pragma unroll
    for (int dt = 0; dt < 4; dt++)
#pragma unroll
        for (int r = 0; r < 4; r++) {
            const float v = s.O[dt][r] * sc;
            T[dt][r] = (MODE == 1) ? T[dt][r] + v : v;
            s.O[dt][r] = 0.f;
        }
    s.m = NEG_BIG; s.l = 0.f;
}

constexpr int NSA_R = 3;
template <bool HASV, class KSrc, class VSrc, class Body>
__device__ __forceinline__ void nsa_stream(char* ring, int n, KSrc ksrc, VSrc vsrc, Body body) {
    const int t = get_tid();
    const int so = (t >> 3) * 64 + (((t & 7) ^ ((t >> 4) & 7)) << 3);
    char* dl = ring + t * 16;
#define NSA_ISSUE(i, slot) { glds16(ksrc(i) + so, dl + (slot) * 16384); if (HASV) glds16(vsrc(i) + so, dl + (slot) * 16384 + 8192); }
    asm volatile("s_waitcnt lgkmcnt(0)" ::: "memory");
    __builtin_amdgcn_s_barrier();
    if (n > 0) NSA_ISSUE(0, 0)
    if (n > 1) NSA_ISSUE(1, 1)
    int slot = 0;
    for (int i = 0; i < n; i++) {
        if (i + 1 < n) { if (HASV) asm volatile("s_waitcnt vmcnt(2)" ::: "memory"); else asm volatile("s_waitcnt vmcnt(1)" ::: "memory"); }
        else asm volatile("s_waitcnt vmcnt(0)" ::: "memory");
        asm volatile("s_waitcnt lgkmcnt(0)" ::: "memory");
        __builtin_amdgcn_s_barrier();
        asm volatile("" ::: "memory");
        const int sl2 = (slot == 0) ? 2 : slot - 1;
        if (i + 2 < n) NSA_ISSUE(i + 2, sl2)
        body(i, (const u16*)(ring + slot * 16384), (const u16*)(ring + slot * 16384 + 8192));
        slot = (slot == 2) ? 0 : slot + 1;
    }
#undef NSA_ISSUE
}
#define NSA_TOK(u) const int t3_ = get_tid(); const size_t ntk_ = (size_t)b * S_ + t0 + 8 * (t3_ >> 6) + 4 * (u) + ((t3_ & 15) >> 2); const int hd_ = g * 4 + (t3_ & 3);
__device__ void ph_nsa(const P& p, int bid, int nb, char* smem) {
    char* ring = smem;
    unsigned* selm = (unsigned*)(smem + NSA_R * 16384);
    int* blist = (int*)(selm + 256);
    int* nlistp = blist + 128;
    int* lcnt = nlistp + 4;
    unsigned char* lists = (unsigned char*)(lcnt + 128);
    float* Ms = (float*)(lists + 128 * 64);
    float* Ls = Ms + 256;
    float* Os = Ls + 256;
    float* impl = Os;
    u16* qs = (u16*)(Os + 64 * 4 * 64);
    unsigned long long ts_ = 0, tacc_ = 0;
    const int nitems = B_ * 2 * 128;
    for (int rr = 0;; rr++) {
        const int it = (rr & 1) ? (rr + 1) * nb - 1 - bid : rr * nb + bid;
        if (rr * nb >= nitems) break;
        if (it >= nitems) continue;
        const int tid = get_tid(), lane = tid & 63, wv = tid >> 6;
        const int kr = lane & 15, qq = lane >> 4, ts = kr >> 2, hh = kr & 3;
        float* myimp = impl + wv * (32 * 2 * 16);
        const int tt = 127 - (it >> 3);
        const int bg = it & 7, b = bg >> 1, g = bg & 1;
        const int t0 = tt * 64, cur = tt;
        const int head = g * 4 + hh;
        Sub st[2];
        f32x4 T[2][4];
        int tl[2]; size_t ntok[2];
        __syncthreads();
#pragma unroll
        for (int u = 0; u < 2; u++) {
            tl[u] = 8 * wv + 4 * u + ts;
            ntok[u] = (size_t)b * S_ + t0 + tl[u];
#pragma unroll
            for (int ks = 0; ks < 2; ks++) *(bf16x8*)&qs[(tl[u] * 4 + hh) * 64 + (((ks * 4 + qq) ^ (hh >> 1) ^ ((tl[u] & 3) << 1)) << 3)] = *(const bf16x8*)&p.q[ntok[u] * 512 + head * 64 + ks * 32 + qq * 8];
#pragma unroll
            for (int dt = 0; dt < 4; dt++) st[u].O[dt] = f32x4{0.f, 0.f, 0.f, 0.f};
            st[u].m = NEG_BIG; st[u].l = 0.f;
        }
        const u16* kcb = p.kcb + (size_t)bg * 512 * 64;
        const u16* vcT = p.vcT + (size_t)bg * 8 * 4096;
        int nv[2];
#pragma unroll
        for (int u = 0; u < 2; u++) { const int t = t0 + tl[u]; nv[u] = (t >= 31) ? min((t - 31) / 16 + 1, NCMP) : 0; }
        const int tmax = t0 + 63;
        const int nvmax = (tmax >= 31) ? min((tmax - 31) / 16 + 1, NCMP) : 0;
        const int nvb = (nvmax + 63) >> 6;
        NSA_TS(1)
        __syncthreads();
        nsa_stream<false>(ring, nvb, [&](int kb) { return kcb + (size_t)kb * 4096; }, [&](int kb) { return vcT + (size_t)kb * 4096; },
            [&](int kb, const u16* Ks, const u16* Vs) {
#pragma unroll
                for (int u = 0; u < 2; u++) nsa_visit<true, false, false>(Ks, Vs, qs + (tl[u] * 4 + hh) * 64, st[u], 0, nv[u] - kb * 64 - 1, lane, nullptr, nullptr);
            });
        float invl[2];
#pragma unroll
        for (int u = 0; u < 2; u++) { const float lt = xq_sum(st[u].l); invl[u] = (lt > 0.f) ? 1.f / lt : 0.f; st[u].l = 0.f; }
        float carry[2] = {0.f, 0.f};
        nsa_stream<true>(ring, nvb, [&](int kb) { return kcb + (size_t)kb * 4096; }, [&](int kb) { return vcT + (size_t)kb * 4096; },
            [&](int kb, const u16* Ks, const u16* Vs) {
#pragma unroll
            for (int u = 0; u < 2; u++) {
                float e[4], p3[4];
                nsa_visit<true, true, true>(Ks, Vs, qs + (tl[u] * 4 + hh) * 64, st[u], 0, nv[u] - kb * 64 - 1, lane, e, p3);
#pragma unroll
                for (int kt = 0; kt < 4; kt++) {
                    float ev = e[kt] * invl[u], pv = p3[kt] * invl[u];
                    ev += dppf<0xB1>(ev); ev += dppf<0x4E>(ev);
                    pv += dppf<0xB1>(pv); pv += dppf<0x4E>(pv);
                    const float sh = __shfl(pv, (lane - 16) & 63, 64);
                    const float nbv = (qq == 0) ? carry[u] : sh;
                    carry[u] = sh;
                    myimp[((kb * 4 + kt) * 2 + u) * 16 + ts * 4 + qq] = ev + nbv;
                }
            }
            });
        NSA_TE(1)
        NSA_TS(2)
#pragma unroll
        for (int u = 0; u < 2; u++) {
            float mv[8];
#pragma unroll
            for (int i = 0; i < 8; i++) {
                const int kk = 8 * hh + i, j = 4 * kk + qq;
                const float v = myimp[(kk * 2 + u) * 16 + ts * 4 + qq];
                mv[i] = (j >= 1 && j <= cur - 2) ? v : -1.f;
            }
            unsigned sel = 0u;
            const int ncand = max(0, cur - 2);
            const int nforced = (cur >= 2) ? 3 : (cur + 1);
            const int need = 16 - nforced;
            if (ncand <= need) {
#pragma unroll
                for (int i = 0; i < 8; i++) if (mv[i] >= 0.f) sel |= (1u << i);
            } else {
                for (int rnd = 0; rnd < need; rnd++) {
                    const float b01 = fmaxf(mv[0], mv[1]), b23 = fmaxf(mv[2], mv[3]), b45 = fmaxf(mv[4], mv[5]), b67 = fmaxf(mv[6], mv[7]);
                    float best = fmaxf(fmaxf(b01, b23), fmaxf(b45, b67));
                    int bi = 7;
#pragma unroll
                    for (int i = 6; i >= 0; i--) bi = (mv[i] == best) ? i : bi;
                    int bj = (best >= 0.f) ? (4 * (8 * hh + bi) + qq) : 9999;
#define TK_MERGE(ov, oj) { const float v2_ = (ov); const int j2_ = (oj); const bool tk_ = (v2_ > best) || (v2_ == best && j2_ < bj); best = tk_ ? v2_ : best; bj = tk_ ? j2_ : bj; }
                    TK_MERGE(dppf<0xB1>(best), __builtin_amdgcn_update_dpp(0, bj, 0xB1, 0xF, 0xF, true))
                    TK_MERGE(dppf<0x4E>(best), __builtin_amdgcn_update_dpp(0, bj, 0x4E, 0xF, 0xF, true))
                    {
                        auto rv = __builtin_amdgcn_permlane16_swap(__float_as_uint(best), __float_as_uint(best), false, false);
                        auto rj = __builtin_amdgcn_permlane16_swap((unsigned)bj, (unsigned)bj, false, false);
                        float v0 = __uint_as_float(rv[0]), v1 = __uint_as_float(rv[1]); int j0 = (int)rj[0], j1 = (int)rj[1];
                        if (v1 > v0 || (v1 == v0 && j1 < j0)) { v0 = v1; j0 = j1; }
                        rv = __builtin_amdgcn_permlane32_swap(__float_as_uint(v0), __float_as_uint(v0), false, false);
                        rj = __builtin_amdgcn_permlane32_swap((unsigned)j0, (unsigned)j0, false, false);
                        best = __uint_as_float(rv[0]); bj = (int)rj[0];
                        const float v2 = __uint_as_float(rv[1]); const int j2 = (int)rj[1];
                        if (v2 > best || (v2 == best && j2 < bj)) { best = v2; bj = j2; }
                    }
#undef TK_MERGE
                    const bool mine = (bj < 512) && ((bj >> 5) == hh) && ((bj & 3) == qq);
                    const int li = (bj >> 2) & 7;
#pragma unroll
                    for (int i = 0; i < 8; i++) mv[i] = (mine && li == i) ? -1.f : mv[i];
                    if (mine) sel |= (1u << li);
                }
            }
            if (qq == 0 && hh == 0) sel |= 1u;
            if ((cur & 3) == qq && (cur >> 5) == hh) sel |= (1u << ((cur >> 2) & 7));
            if (cur >= 1 && ((cur - 1) & 3) == qq && ((cur - 1) >> 5) == hh) sel |= (1u << (((cur - 1) >> 2) & 7));
            unsigned w = sel << (8 * hh);
            w |= (unsigned)__builtin_amdgcn_update_dpp(0, (int)w, 0xB1, 0xF, 0xF, true);
            w |= (unsigned)__builtin_amdgcn_update_dpp(0, (int)w, 0x4E, 0xF, 0xF, true);
            if (hh == 0) selm[tl[u] * 4 + qq] = w;
        }
        NSA_TE(2)
        NSA_TS(3)
        __syncthreads();
#pragma unroll
        for (int u = 0; u < 2; u++) { NSA_TOK(u) nsa_fold<0>(st[u], T[u], p.nsag[ntk_ * 24 + hd_ * 3 + 0]); }
        {
            const int t2 = get_tid();
#pragma unroll
            for (int i = 0; i < 8; i++) *(f32x4*)&Os[(i * NT + t2) * 4] = f32x4{0.f, 0.f, 0.f, 0.f};
            if (t2 < 256) { Ms[t2] = NEG_BIG; Ls[t2] = 0.f; }
            unsigned long long tm = 0ull; int lrank = 0;
            if (t2 < 128) {
                const int j = t2;
                for (int tk = 0; tk < 64; tk++) tm |= (unsigned long long)((selm[tk * 4 + (j & 3)] >> (j >> 2)) & 1u) << tk;
                if (j > cur) tm = 0ull;
                const unsigned long long bal = __ballot(tm != 0ull);
                lrank = __popcll(bal & ((1ull << (t2 & 63)) - 1ull));
                if ((t2 & 63) == 0) nlistp[t2 >> 6] = __popcll(bal);
            }
            __syncthreads();
            if (t2 < 128 && tm != 0ull) {
                const int pos = lrank + ((t2 >= 64) ? nlistp[0] : 0);
                blist[pos] = t2; lcnt[pos] = __popcll(tm);
                int c = 0;
                while (tm) { lists[pos * 64 + c] = (unsigned char)(__ffsll((long long)tm) - 1); c++; tm &= tm - 1ull; }
            }
            __syncthreads();
        }
        const int nlist = nlistp[0] + nlistp[1];
        NSA_TE(3)
        NSA_TS(4)
        const u16* ksl = p.ksl + (size_t)bg * S_ * 64;
        const u16* vslT = p.vslT + (size_t)bg * 128 * 4096;
        {
            const int t4 = get_tid(), wv4 = __builtin_amdgcn_readfirstlane(t4 >> 6), ts4 = (t4 & 15) >> 2;
            const int td = t4 & 255;
            const int so = (td >> 3) * 64 + (((td & 7) ^ ((td >> 4) & 7)) << 3);
            char* dl = ring + td * 16;
#define NSA_RI(i) (nlist - 1 - (i))
#define NSA_ISSUE2(i, slot) if (wv4 >= 4) { const int jj_ = blist[NSA_RI(i)]; const u16* kp_ = ksl + (size_t)jj_ * 4096 + so; const u16* vp_ = vslT + (size_t)jj_ * 4096 + so; char* d_ = dl + (slot) * 16384; \
                glds16(kp_, d_); glds16(kp_ + 2048, d_ + 4096); glds16(vp_, d_ + 8192); glds16(vp_ + 2048, d_ + 12288); }
            asm volatile("s_waitcnt lgkmcnt(0)" ::: "memory");
            __builtin_amdgcn_s_barrier();
            if (nlist > 0) NSA_ISSUE2(0, 0)
            if (nlist > 1) NSA_ISSUE2(1, 1)
            int jn = 0, nn = 0, tokn = 0;
            if (nlist > 0) { jn = blist[NSA_RI(0)]; nn = lcnt[NSA_RI(0)]; tokn = lists[NSA_RI(0) * 64 + wv4 * 4 + ts4]; }
            int slot = 0;
            for (int i = 0; i < nlist; i++) {
                if (i + 1 < nlist) asm volatile("s_waitcnt vmcnt(4)" ::: "memory"); else asm volatile("s_waitcnt vmcnt(0)" ::: "memory");
                asm volatile("s_waitcnt lgkmcnt(0)" ::: "memory");
                __builtin_amdgcn_s_barrier();
                asm volatile("" ::: "memory");
                const int sl2 = (slot == 0) ? 2 : slot - 1;
                if (i + 2 < nlist) NSA_ISSUE2(i + 2, sl2)
                const int j = jn, n = nn, tok0 = tokn;
                if (i + 1 < nlist) { jn = blist[NSA_RI(i + 1)]; nn = lcnt[NSA_RI(i + 1)]; tokn = lists[NSA_RI(i + 1) * 64 + wv4 * 4 + ts4]; }
                const u16* Ks = (const u16*)(ring + slot * 16384); const u16* Vs = Ks + 4096;
                for (int qd = wv4; qd * 4 < n; qd += NW) {
                    const int e = qd * 4 + ts4;
                    const bool valid = e < n;
                    int tok = (qd == wv4) ? tok0 : (int)lists[NSA_RI(i) * 64 + (e & 63)];
                    if (!valid) tok = 0;
                    if (j == cur) nsa_visit_g<1, false>(Ks, Vs, qs, Os, Ms, Ls, tok, valid, t4 & 63);
                    else nsa_visit_g<0, true>(Ks, Vs, qs, Os, Ms, Ls, tok, valid, t4 & 63);
                }
                slot = (slot == 2) ? 0 : slot + 1;
            }
#undef NSA_RI
#undef NSA_ISSUE2
        }
        __syncthreads();
        NSA_TE(4)
        NSA_TS(5)
#pragma unroll
        for (int u = 0; u < 2; u++) {
            NSA_TOK(u)
            const int t5 = t3_ & 63;
            nsa_fold_lds(Os, Ms, Ls, (8 * (t3_ >> 6) + 4 * u + ((t5 & 15) >> 2)) * 4 + (t5 & 3), t5 >> 4, t5 & 3, T[u], p.nsag[ntk_ * 24 + hd_ * 3 + 1], true);
        }
        const u16* kwn = p.kwn + (size_t)bg * S_ * 64;
        const u16* vwnT = p.vwnT + (size_t)bg * 128 * 4096;
        {
            const int jlo = max(0, cur - 8);
            nsa_stream<true>(ring, cur - jlo + 1, [&](int i) { return kwn + (size_t)(cur - i) * 4096; }, [&](int i) { return vwnT + (size_t)(cur - i) * 4096; },
                [&](int i, const u16* Ks, const u16* Vs) {
                    const int j = cur - i;
                    const int t4 = get_tid();
#pragma unroll
                    for (int u = 0; u < 2; u++) {
                        const int tok = 8 * (t4 >> 6) + 4 * u + ((t4 & 15) >> 2);
                        if (j == cur) nsa_visit_g<1, false>(Ks, Vs, qs, Os, Ms, Ls, tok, true, t4 & 63);
                        else if (j == cur - 8) nsa_visit_g<2, true>(Ks, Vs, qs, Os, Ms, Ls, tok, true, t4 & 63);
                        else nsa_visit_g<0, true>(Ks, Vs, qs, Os, Ms, Ls, tok, true, t4 & 63);
                    }
                });
        }
#pragma unroll
        for (int u = 0; u < 2; u++) {
            NSA_TOK(u)
            { const int t5 = t3_ & 63; nsa_fold_lds(Os, Ms, Ls, (8 * (t3_ >> 6) + 4 * u + ((t5 & 15) >> 2)) * 4 + (t5 & 3), t5 >> 4, t5 & 3, T[u], p.nsag[ntk_ * 24 + hd_ * 3 + 2], false); }
#pragma unroll
            for (int dt = 0; dt < 4; dt++) *(uint2*)&p.oa[ntk_ * 512 + hd_ * 64 + dt * 16 + ((t3_ & 63) >> 4) * 4] = pack4(T[u][dt]);
        }
        NSA_TE(5)
    }
    if (NSAPROBE) { __syncthreads(); const unsigned long long t1_ = __builtin_amdgcn_s_memrealtime(); while (__builtin_amdgcn_s_memrealtime() - t1_ < tacc_) __builtin_amdgcn_s_sleep(8); }
}

constexpr int RS = 72;
constexpr int RSLOT = 64 * RS;
__device__ __forceinline__ void mm64(const u16* A, int lda, const u16* Bz, int ldb, f32x4 (&acc)[2], int lane, int wv) {
    const int mt = wv >> 1, nt0 = (wv & 1) * 2, kr = lane & 15, qq = lane >> 4;
    bf16x8 a[2], b[2][2];
#pragma unroll
    for (int ks = 0; ks < 2; ks++) {
        a[ks] = *(const bf16x8*)&A[(mt * 16 + kr) * lda + ks * 32 + qq * 8];
#pragma unroll
        for (int i = 0; i < 2; i++) b[ks][i] = *(const bf16x8*)&Bz[((nt0 + i) * 16 + kr) * ldb + ks * 32 + qq * 8];
    }
#pragma unroll
    for (int ks = 0; ks < 2; ks++)
#pragma unroll
        for (int i = 0; i < 2; i++) acc[i] = __builtin_amdgcn_mfma_f32_16x16x32_bf16(a[ks], b[ks][i], acc[i], 0, 0, 0);
}
__device__ __forceinline__ void st_t(u16* dst, int ld, const f32x4& v, int mt, int nt, int lane) {
    uint2 o; o.x = pack2(v[0], v[1]); o.y = pack2(v[2], v[3]);
    *(uint2*)&dst[(nt * 16 + (lane & 15)) * ld + mt * 16 + (lane >> 4) * 4] = o;
}
__device__ __forceinline__ void st_n(u16* dst, int ld, const f32x4& v, int mt, int nt, int lane) {
#pragma unroll
    for (int r = 0; r < 4; r++) dst[(mt * 16 + (lane >> 4) * 4 + r) * ld + nt * 16 + (lane & 15)] = f2bf(v[r]);
}
#define ZACC(a) { a[0] = f32x4{0.f, 0.f, 0.f, 0.f}; a[1] = f32x4{0.f, 0.f, 0.f, 0.f}; }

__device__ void ph_rwkv_chunk(const P& p, int bid, int nb, char* smem) {
    u16* sl = (u16*)smem;
    float* tot = (float*)(sl + 14 * RSLOT);
    float* gl = tot + 512;
#define RW_IDX const int tid = get_tid(), lane = tid & 63, wv = tid >> 6, mt = wv >> 1, nt0 = (wv & 1) * 2, kr = lane & 15, qq = lane >> 4; (void)mt; (void)nt0; (void)kr; (void)qq; (void)lane;
    const int nitems = B_ * 128;
    for (int it0 = bid; it0 < nitems; it0 += nb) {
      const int c = it0 & 127, b = it0 >> 7;
      const size_t n0 = (size_t)b * S_ + c * 64;
      __syncthreads();
      {
          RW_IDX
          const int t = tid >> 3, part = tid & 7;
          const size_t n = n0 + t;
          const bool hasprev = (c * 64 + t) > 0;
          u16* dst = p.xact + n * 256 + part * 32;
#pragma unroll
          for (int j = 0; j < 4; j++) {
              const int col = 1536 + part * 32 + j * 8;
              const uint4 cu = *(const uint4*)&p.prw[n * CRW + col];
              uint4 pv = make_uint4(0u, 0u, 0u, 0u);
              if (hasprev) pv = *(const uint4*)&p.prw[(n - 1) * CRW + col];
              const unsigned cw[4] = {cu.x, cu.y, cu.z, cu.w}, pw[4] = {pv.x, pv.y, pv.z, pv.w};
              unsigned ow[4];
#pragma unroll
              for (int e2 = 0; e2 < 4; e2++) {
                  float x0 = __uint_as_float(cw[e2] << 16), x1 = __uint_as_float(cw[e2] & 0xFFFF0000u);
                  const float q0 = __uint_as_float(pw[e2] << 16), q1 = __uint_as_float(pw[e2] & 0xFFFF0000u);
                  x0 = x0 + (q0 - x0) * p.mu[col + 2 * e2]; x1 = x1 + (q1 - x1) * p.mu[col + 2 * e2 + 1];
                  if (part < 2) { x0 = tanhf(x0); x1 = tanhf(x1); }
                  else if (part >= 4) { x0 = sigmoidf_(x0); x1 = sigmoidf_(x1); }
                  ow[e2] = pack2(x0, x1);
              }
              *(uint4*)&dst[j * 8] = make_uint4(ow[0], ow[1], ow[2], ow[3]);
          }
      }
      __syncthreads();
      const u16* xa = p.xact + n0 * 256;
#pragma unroll 1
      for (int h = 0; h < 8; h++) {
        u16* cd = p.cdat + ((size_t)((b * 8 + h) * 128 + c)) * 4 * 4096;
        LDS_BARRIER();
        float* LW = (float*)(sl + 8 * RSLOT); float* LA = (float*)(sl + 10 * RSLOT);
        {
            RW_IDX
            bf16x8 xa_[8], wb[2][2], ab[2][2], gb[2][4];
#pragma unroll
            for (int k8 = 0; k8 < 8; k8++) xa_[k8] = *(const bf16x8*)&xa[(mt * 16 + kr) * 256 + k8 * 32 + qq * 8];
#pragma unroll
            for (int i = 0; i < 2; i++) {
                const int cc = (nt0 + i) * 16 + kr;
#pragma unroll
                for (int ks = 0; ks < 2; ks++) {
                    wb[i][ks] = *(const bf16x8*)&p.w2T[((size_t)h * 64 + cc) * 64 + ks * 32 + qq * 8];
                    ab[i][ks] = *(const bf16x8*)&p.a2T[((size_t)h * 64 + cc) * 64 + ks * 32 + qq * 8];
                }
#pragma unroll
                for (int ks = 0; ks < 4; ks++) gb[i][ks] = *(const bf16x8*)&p.g2T[((size_t)h * 64 + cc) * 128 + ks * 32 + qq * 8];
            }
            f32x4 aw[2], aa2[2], ag[2];
#pragma unroll
            for (int i = 0; i < 2; i++) {
                aw[i] = f32x4{0.f, 0.f, 0.f, 0.f}; aa2[i] = aw[i]; ag[i] = aw[i];
#pragma unroll
                for (int ks = 0; ks < 2; ks++) {
                    aw[i] = __builtin_amdgcn_mfma_f32_16x16x32_bf16(xa_[ks], wb[i][ks], aw[i], 0, 0, 0);
                    aa2[i] = __builtin_amdgcn_mfma_f32_16x16x32_bf16(xa_[2 + ks], ab[i][ks], aa2[i], 0, 0, 0);
                }
#pragma unroll
                for (int ks = 0; ks < 4; ks++) ag[i] = __builtin_amdgcn_mfma_f32_16x16x32_bf16(xa_[4 + ks], gb[i][ks], ag[i], 0, 0, 0);
            }
#pragma unroll
            for (int i = 0; i < 2; i++)
#pragma unroll
                for (int r = 0; r < 4; r++) {
                    const int t = mt * 16 + qq * 4 + r, cc = (nt0 + i) * 16 + kr;
                    const float wl = p.w0[h * 64 + cc] + aw[i][r];
                    const float z = -wl;
                    const float sp = fmaxf(z, 0.f) + log1pf(__expf(-fabsf(z)));
                    LW[t * 64 + cc] = -__expf(-sp - 0.5f);
                    LA[t * 64 + cc] = sigmoidf_(p.a0[h * 64 + cc] + aa2[i][r]);
                    p.ob[(n0 + t) * 512 + h * 64 + cc] = f2bf(ag[i][r]);
                }
        }
        LDS_BARRIER();
        {
            RW_IDX
            const int ch = h * 64 + lane;
            const float mur = p.mu[ch], muk = p.mu[512 + ch], muv = p.mu[1024 + ch];
            const float kkw = p.k_k[ch], kaw = p.k_a[ch], rkw = p.r_k[ch];
            float rr[8], k2[8], vv[8], kkn[8], aa[8], lg[8], cs[8];
            float run = 0.f;
#pragma unroll
            for (int i = 0; i < 8; i++) {
                const int t = wv * 8 + i; const size_t n = n0 + t;
                const u16* cr = p.prw + n * CRW;
                float r = bf2f(cr[ch]), k = bf2f(cr[512 + ch]), v = bf2f(cr[1024 + ch]);
                float pr = 0.f, pk = 0.f, pv = 0.f;
                if (c * 64 + t > 0) { const u16* pp = cr - CRW; pr = bf2f(pp[ch]); pk = bf2f(pp[512 + ch]); pv = bf2f(pp[1024 + ch]); }
                r = r + (pr - r) * mur; k = k + (pk - k) * muk; v = v + (pv - v) * muv;
                const float a = LA[t * 64 + lane];
                lg[i] = LW[t * 64 + lane];
                float kk = k * kkw;
                const float nrm = fmaxf(sqrtf(wave_sum(kk * kk)), 1e-12f);
                kkn[i] = kk / nrm;
                k2[i] = k * (1.f + (a - 1.f) * kaw);
                const float bon = wave_sum(r * k2[i] * rkw);
                if (lane == 0) p.bon[n * 8 + h] = bon;
                rr[i] = r; vv[i] = v; aa[i] = a;
                run += lg[i]; cs[i] = run;
            }
            tot[wv * 64 + lane] = run;
            LDS_BARRIER();
            float off = 0.f, cumL = 0.f;
#pragma unroll
            for (int w2 = 0; w2 < 8; w2++) { const float tv = tot[w2 * 64 + lane]; cumL += tv; if (w2 < wv) off += tv; }
            if (wv == 0) gl[lane] = __expf(cumL);
            unsigned pa[4], pb[4], pk4[4], pv4[4];
#pragma unroll
            for (int i = 0; i < 8; i += 2) {
                float at[2], bt[2], kt[2], rt[2];
#pragma unroll
                for (int e2 = 0; e2 < 2; e2++) {
                    const int ii = i + e2; const int t = wv * 8 + ii;
                    const float cm = off + cs[ii];
                    const float g = __expf(cm), gp = __expf(cm - lg[ii]), gi = __expf(-cm);
                    at[e2] = -kkn[ii] * gp; bt[e2] = kkn[ii] * aa[ii] * gi; kt[e2] = k2[ii] * gi; rt[e2] = rr[ii] * g;
                    sl[0 * RSLOT + t * RS + lane] = f2bf(at[e2]);
                    sl[1 * RSLOT + t * RS + lane] = f2bf(bt[e2]);
                    sl[2 * RSLOT + t * RS + lane] = f2bf(kt[e2]);
                    sl[3 * RSLOT + t * RS + lane] = f2bf(rt[e2]);
                }
                pa[i >> 1] = pack2(at[0], at[1]); pb[i >> 1] = pack2(bt[0], bt[1]);
                pk4[i >> 1] = pack2(kt[0], kt[1]); pv4[i >> 1] = pack2(vv[i], vv[i + 1]);
            }
            *(uint4*)&sl[4 * RSLOT + lane * RS + wv * 8] = make_uint4(pa[0], pa[1], pa[2], pa[3]);
            *(uint4*)&sl[5 * RSLOT + lane * RS + wv * 8] = make_uint4(pb[0], pb[1], pb[2], pb[3]);
            *(uint4*)&sl[6 * RSLOT + lane * RS + wv * 8] = make_uint4(pk4[0], pk4[1], pk4[2], pk4[3]);
            *(uint4*)&sl[7 * RSLOT + lane * RS + wv * 8] = make_uint4(pv4[0], pv4[1], pv4[2], pv4[3]);
        }
        LDS_BARRIER();
        {
            RW_IDX
            f32x4 acc[2];
            ZACC(acc); mm64(sl + 1 * RSLOT, RS, sl + 0 * RSLOT, RS, acc, lane, wv);
#pragma unroll
            for (int i = 0; i < 2; i++) {
                f32x4 pm;
#pragma unroll
                for (int r = 0; r < 4; r++) {
                    const int m = mt * 16 + qq * 4 + r, n = (nt0 + i) * 16 + kr;
                    if (!(m < n)) acc[i][r] = 0.f;
                    pm[r] = acc[i][r] + ((m == n) ? 1.f : 0.f);
                }
                st_t(sl + 8 * RSLOT, RS, acc[i], mt, nt0 + i, lane);
                st_n(sl + 9 * RSLOT, RS, acc[i], mt, nt0 + i, lane);
                st_t(sl + 13 * RSLOT, RS, pm, mt, nt0 + i, lane);
            }
            ZACC(acc); mm64(sl + 0 * RSLOT, RS, sl + 2 * RSLOT, RS, acc, lane, wv);
#pragma unroll
            for (int i = 0; i < 2; i++) {
#pragma unroll
                for (int r = 0; r < 4; r++) { const int m = mt * 16 + qq * 4 + r, n = (nt0 + i) * 16 + kr; if (!(m > n)) acc[i][r] = 0.f; }
                st_t(sl + 10 * RSLOT, RS, acc[i], mt, nt0 + i, lane);
            }
            ZACC(acc); mm64(sl + 1 * RSLOT, RS, sl + 3 * RSLOT, RS, acc, lane, wv);
#pragma unroll
            for (int i = 0; i < 2; i++) {
#pragma unroll
                for (int r = 0; r < 4; r++) { const int m = mt * 16 + qq * 4 + r, n = (nt0 + i) * 16 + kr; if (m > n) acc[i][r] = 0.f; }
                st_t(sl + 11 * RSLOT, RS, acc[i], mt, nt0 + i, lane);
            }
            ZACC(acc); mm64(sl + 2 * RSLOT, RS, sl + 3 * RSLOT, RS, acc, lane, wv);
#pragma unroll
            for (int i = 0; i < 2; i++) {
#pragma unroll
                for (int r = 0; r < 4; r++) { const int m = mt * 16 + qq * 4 + r, n = (nt0 + i) * 16 + kr; if (m > n) acc[i][r] = 0.f; }
                st_t(sl + 12 * RSLOT, RS, acc[i], mt, nt0 + i, lane);
            }
        }
        LDS_BARRIER();
        u16* X = sl + 8 * RSLOT; u16* XT = sl + 9 * RSLOT; u16* X2 = sl + 0 * RSLOT; u16* X2T = sl + 1 * RSLOT;
        u16* Pc = sl + 13 * RSLOT; u16* Pn = sl + 2 * RSLOT;
#pragma unroll 1
        for (int j = 1; j <= 6; j++) {
            RW_IDX
            f32x4 acc[2];
            if (j <= 5) {
                ZACC(acc); mm64(X, RS, XT, RS, acc, lane, wv);
#pragma unroll
                for (int i = 0; i < 2; i++) { st_t(X2T, RS, acc[i], mt, nt0 + i, lane); st_n(X2, RS, acc[i], mt, nt0 + i, lane); }
            }
            if (j >= 2) {
                ZACC(acc); mm64(XT, RS, Pc, RS, acc, lane, wv);
#pragma unroll
                for (int i = 0; i < 2; i++) {
                    const uint2 pv = *(const uint2*)&Pc[((nt0 + i) * 16 + kr) * RS + mt * 16 + qq * 4];
                    acc[i][0] += __uint_as_float(pv.x << 16); acc[i][1] += __uint_as_float(pv.x & 0xFFFF0000u);
                    acc[i][2] += __uint_as_float(pv.y << 16); acc[i][3] += __uint_as_float(pv.y & 0xFFFF0000u);
                    st_t(Pn, RS, acc[i], mt, nt0 + i, lane);
                }
            }
            LDS_BARRIER();
            if (j >= 2) { u16* tp = Pc; Pc = Pn; Pn = tp; }
            if (j <= 5) { u16* tx = X; X = X2; X2 = tx; tx = XT; XT = X2T; X2T = tx; }
        }
        u16* TT = Pc;
        {
            RW_IDX
            f32x4 acc[2];
            ZACC(acc); mm64(TT, RS, sl + 4 * RSLOT, RS, acc, lane, wv);
#pragma unroll
            for (int i = 0; i < 2; i++) st_t(sl + 0 * RSLOT, RS, acc[i], mt, nt0 + i, lane);
            ZACC(acc); mm64(sl + 10 * RSLOT, RS, TT, RS, acc, lane, wv);
#pragma unroll
            for (int i = 0; i < 2; i++) st_t(sl + 8 * RSLOT, RS, acc[i], mt, nt0 + i, lane);
        }
        LDS_BARRIER();
        {
            RW_IDX
            f32x4 acc[2];
            ZACC(acc); mm64(sl + 8 * RSLOT, RS, sl + 7 * RSLOT, RS, acc, lane, wv);
#pragma unroll
            for (int i = 0; i < 2; i++) st_t(sl + 9 * RSLOT, RS, acc[i], mt, nt0 + i, lane);
            ZACC(acc); mm64(sl + 0 * RSLOT, RS, sl + 5 * RSLOT, RS, acc, lane, wv);
#pragma unroll
            for (int i = 0; i < 2; i++) {
                const int n = (nt0 + i) * 16 + kr; const float gn = gl[n];
#pragma unroll
                for (int r = 0; r < 4; r++) { const int m = mt * 16 + qq * 4 + r; acc[i][r] = acc[i][r] * gn + ((m == n) ? gn : 0.f); }
                st_t(cd, 64, acc[i], mt, nt0 + i, lane);
            }
            ZACC(acc); mm64(sl + 0 * RSLOT, RS, sl + 11 * RSLOT, RS, acc, lane, wv);
#pragma unroll
            for (int i = 0; i < 2; i++) {
                const uint2 rv = *(const uint2*)&sl[3 * RSLOT + ((nt0 + i) * 16 + kr) * RS + mt * 16 + qq * 4];
                acc[i][0] += __uint_as_float(rv.x << 16); acc[i][1] += __uint_as_float(rv.x & 0xFFFF0000u);
                acc[i][2] += __uint_as_float(rv.y << 16); acc[i][3] += __uint_as_float(rv.y & 0xFFFF0000u);
                st_t(cd + 2 * 4096, 64, acc[i], mt, nt0 + i, lane);
            }
        }
        LDS_BARRIER();
        {
            RW_IDX
            f32x4 acc[2];
            ZACC(acc);
            mm64(sl + 5 * RSLOT, RS, sl + 9 * RSLOT, RS, acc, lane, wv);
            mm64(sl + 6 * RSLOT, RS, sl + 7 * RSLOT, RS, acc, lane, wv);
#pragma unroll
            for (int i = 0; i < 2; i++) {
#pragma unroll
                for (int r = 0; r < 4; r++) acc[i][r] *= gl[mt * 16 + qq * 4 + r];
                st_t(cd + 1 * 4096, 64, acc[i], mt, nt0 + i, lane);
            }
            ZACC(acc);
            mm64(sl + 9 * RSLOT, RS, sl + 11 * RSLOT, RS, acc, lane, wv);
            mm64(sl + 7 * RSLOT, RS, sl + 12 * RSLOT, RS, acc, lane, wv);
#pragma unroll
            for (int i = 0; i < 2; i++) st_t(cd + 3 * 4096, 64, acc[i], mt, nt0 + i, lane);
        }
      }
    }
}

__device__ void ph_rwkv_seq(const P& p, int bid, int nb, char* smem) {
    u16* SL = (u16*)smem;
    const int tid = get_tid(), lane = tid & 63, wv = __builtin_amdgcn_readfirstlane(tid >> 6);
    const int kr = lane & 15, qq = lane >> 4, chn = wv >> 2, vt = wv & 3;
    for (int pair = bid; pair < B_ * 4; pair += nb) {
        const int bh = pair * 2 + chn;
        u16* mySL = SL + chn * RSLOT;
        __syncthreads();
#pragma unroll
        for (int ks = 0; ks < 2; ks++) *(uint4*)&mySL[(vt * 16 + kr) * RS + ks * 32 + qq * 8] = make_uint4(0u, 0u, 0u, 0u);
        u16* cbase = p.cdat + (size_t)bh * 128 * 4 * 4096;
        bf16x8 GA0[4][2], GA1[4][2], GA2[4][2], GA3[4][2]; uint2 H0[4], H1[4], H2[4], H3[4];
#define SEQ_LD(GAx, Hx, c) { const u16* cd_ = cbase + (size_t)(c) * 4 * 4096; \
            _Pragma("unroll") for (int m4 = 0; m4 < 4; m4++) { \
                _Pragma("unroll") for (int ks = 0; ks < 2; ks++) GAx[m4][ks] = *(const bf16x8*)&cd_[(m4 * 16 + kr) * 64 + ks * 32 + qq * 8]; \
                Hx[m4] = *(const uint2*)&cd_[1 * 4096 + (vt * 16 + kr) * 64 + m4 * 16 + qq * 4]; } }
#define SEQ_STEP(GAx, Hx, c) { \
            bf16x8 Z0[2]; \
            _Pragma("unroll") for (int ks = 0; ks < 2; ks++) Z0[ks] = *(const bf16x8*)&mySL[(vt * 16 + kr) * RS + ks * 32 + qq * 8]; \
            f32x4 zs[4]; \
            _Pragma("unroll") for (int m4 = 0; m4 < 4; m4++) { \
                zs[m4] = unpack4(Hx[m4]); \
                _Pragma("unroll") for (int ks = 0; ks < 2; ks++) zs[m4] = __builtin_amdgcn_mfma_f32_16x16x32_bf16(GAx[m4][ks], Z0[ks], zs[m4], 0, 0, 0); } \
            u16* sn_ = cbase + (size_t)(c) * 4 * 4096 + 1 * 4096 + (vt * 16 + kr) * 64 + qq * 4; \
            _Pragma("unroll") for (int m4 = 0; m4 < 4; m4++) { \
                const uint2 pk_ = pack4(zs[m4]); \
                *(uint2*)&mySL[(vt * 16 + kr) * RS + m4 * 16 + qq * 4] = pk_; \
                *(uint2*)&sn_[m4 * 16] = pk_; } \
            if ((c) + 4 < 128) SEQ_LD(GAx, Hx, (c) + 4) }
        SEQ_LD(GA0, H0, 0) SEQ_LD(GA1, H1, 1) SEQ_LD(GA2, H2, 2) SEQ_LD(GA3, H3, 3)
#pragma unroll 1
        for (int c = 0; c < 128; c += 4) {
            SEQ_STEP(GA0, H0, c)
            SEQ_STEP(GA1, H1, c + 1)
            SEQ_STEP(GA2, H2, c + 2)
            SEQ_STEP(GA3, H3, c + 3)
        }
#undef SEQ_LD
#undef SEQ_STEP
    }
}

__device__ void ph_rwkv_out(const P& p, int bid, int nb, char* smem) {
    const int tid = get_tid(), lane = tid & 63, wv = tid >> 6;
    const int kr = lane & 15, qq = lane >> 4;
    for (int it = bid * NW + wv; it < B_ * 8 * 128; it += nb * NW) {
        const int c = it & 127, bh = it >> 7, b = bh >> 3, h = bh & 7;
        const u16* cd = p.cdat + ((size_t)bh * 128 + c) * 4 * 4096;
        f32x4 ys[4][4];
#pragma unroll
        for (int mt = 0; mt < 4; mt++)
#pragma unroll
            for (int nt = 0; nt < 4; nt++) ys[mt][nt] = unpack4(*(const uint2*)&cd[3 * 4096 + (nt * 16 + kr) * 64 + mt * 16 + qq * 4]);
        if (c > 0) {
            const u16* s0 = cd - 4 * 4096 + 1 * 4096;
#pragma unroll
            for (int ks = 0; ks < 2; ks++) {
                bf16x8 af[4], bq[4];
#pragma unroll
                for (int mt = 0; mt < 4; mt++) af[mt] = *(const bf16x8*)&s0[(mt * 16 + kr) * 64 + ks * 32 + qq * 8];
#pragma unroll
                for (int nt = 0; nt < 4; nt++) bq[nt] = *(const bf16x8*)&cd[2 * 4096 + (nt * 16 + kr) * 64 + ks * 32 + qq * 8];
#pragma unroll
                for (int mt = 0; mt < 4; mt++)
#pragma unroll
                    for (int nt = 0; nt < 4; nt++) ys[mt][nt] = __builtin_amdgcn_mfma_f32_16x16x32_bf16(af[mt], bq[nt], ys[mt][nt], 0, 0, 0);
            }
        }
#pragma unroll
        for (int nt = 0; nt < 4; nt++) {
            float s1 = 0.f, s2 = 0.f;
#pragma unroll
            for (int mt = 0; mt < 4; mt++)
#pragma unroll
                for (int r = 0; r < 4; r++) { s1 += ys[mt][nt][r]; s2 += ys[mt][nt][r] * ys[mt][nt][r]; }
            s1 = xrow_sum(s1); s2 = xrow_sum(s2);
            const float mean = s1 * (1.f / 64.f);
            const float var = fmaxf(s2 * (1.f / 64.f) - mean * mean, 0.f);
            const float rstd = rsqrtf(var + 64e-5f);
            const int t = nt * 16 + kr;
            const size_t n = (size_t)b * S_ + c * 64 + t;
            const float bon = p.bon[n * 8 + h];
#pragma unroll
            for (int mt = 0; mt < 4; mt++) {
                const int vch = h * 64 + mt * 16 + qq * 4;
                const f32x4 vcf = unpack4(*(const uint2*)&p.prw[n * CRW + 1024 + vch]);
                const f32x4 vpf = (c * 64 + t > 0) ? unpack4(*(const uint2*)&p.prw[(n - 1) * CRW + 1024 + vch]) : f32x4{0.f, 0.f, 0.f, 0.f};
                const f32x4 ggf = unpack4(*(const uint2*)&p.ob[n * 512 + vch]);
                const float4 lw = *(const float4*)&p.ln_w[vch], lb = *(const float4*)&p.ln_b[vch], mv = *(const float4*)&p.mu[1024 + vch];
                const float lwa[4] = {lw.x, lw.y, lw.z, lw.w}, lba[4] = {lb.x, lb.y, lb.z, lb.w}, mva[4] = {mv.x, mv.y, mv.z, mv.w};
                f32x4 o;
#pragma unroll
                for (int r = 0; r < 4; r++) {
                    const float vsh = vcf[r] + (vpf[r] - vcf[r]) * mva[r];
                    o[r] = ((ys[mt][nt][r] - mean) * rstd * lwa[r] + lba[r] + bon * vsh) * ggf[r];
                }
                *(uint2*)&p.ob[n * 512 + vch] = pack4(o);
            }
        }
    }
}

__device__ __forceinline__ void unpack8(const uint4& u, f32x4& a, f32x4& b) {
    a = f32x4{__uint_as_float(u.x << 16), __uint_as_float(u.x & 0xFFFF0000u), __uint_as_float(u.y << 16), __uint_as_float(u.y & 0xFFFF0000u)};
    b = f32x4{__uint_as_float(u.z << 16), __uint_as_float(u.z & 0xFFFF0000u), __uint_as_float(u.w << 16), __uint_as_float(u.w & 0xFFFF0000u)};
}
struct EpiMerge {
    u16* merged; u16* tmp2; int pass;
    __device__ __forceinline__ void operator()(const f32x4 (&acc)[2][2][4][2], const GUnit& u, int, int, int, int) const {
        const int t2_ = get_tid(), wid_ = __builtin_amdgcn_readfirstlane(t2_ >> 6), wr = wid_ >> 2, wc = wid_ & 3, fr = t2_ & 15, fq = (t2_ >> 4) & 3;
        const int row0 = u.pm * 256 + wr * 64 + fr, col0 = u.pn * 256 + wc * 32 + 8 * fq;
#pragma unroll
        for (int ai = 0; ai < 2; ++ai)
#pragma unroll
            for (int m = 0; m < 4; ++m) {
                const size_t off = (size_t)(row0 + ai * 128 + m * 16) * D_ + col0;
                uint4 m1[2], m2[2];
                if (pass == 1 || pass == 3) {
#pragma unroll
                    for (int bj = 0; bj < 2; ++bj) { m1[bj] = *(const uint4*)&merged[off + bj * 128]; if (pass == 3) m2[bj] = *(const uint4*)&tmp2[off + bj * 128]; }
                }
#pragma unroll
                for (int bj = 0; bj < 2; ++bj) {
                    f32x4 v0 = acc[ai][bj][m][0], v1 = acc[ai][bj][m][1];
                    if (pass == 1) { f32x4 a0, a1; unpack8(m1[bj], a0, a1);
#pragma unroll
                        for (int r = 0; r < 4; r++) { v0[r] = a0[r] * sigmoidf_(v0[r]); v1[r] = a1[r] * sigmoidf_(v1[r]); } }
                    if (pass == 3) { f32x4 a0, a1, b0, b1; unpack8(m1[bj], a0, a1); unpack8(m2[bj], b0, b1);
#pragma unroll
                        for (int r = 0; r < 4; r++) { v0[r] = a0[r] + b0[r] * sigmoidf_(v0[r]); v1[r] = a1[r] + b1[r] * sigmoidf_(v1[r]); } }
                    *(uint4*)&((pass == 2) ? tmp2 : merged)[off + bj * 128] = pack8(v0, v1);
                }
                asm volatile("" ::: "memory");
            }
    }
};
__device__ void ph_merge(const P& p, int bid, int nb, char* smem) {
    u16* tmp2 = (u16*)p.x1;
#pragma unroll 1
    for (int pass = 0; pass < 4; ++pass) {
        const int K = (pass & 1) ? D_ : 512;
        const u16* A = (pass & 1) ? p.hbuf : (pass == 0 ? p.oa : p.ob);
        const u16* Bt = (pass == 0) ? p.wpaT : (pass == 1 ? p.wgT : (pass == 2 ? p.wpbT : p.wgT + (size_t)1024 * D_));
        DenseSched S; S.init(NTOK, D_, K, Bt, nb, bid);
        EpiMerge E{p.merged, tmp2, pass};
        gemm256(smem, (const char*)A, K, S, E);
    }
}

struct EpiOutproj {
    const float* x; float* x1;
    __device__ __forceinline__ void operator()(const f32x4 (&acc)[2][2][4][2], const GUnit& u, int, int, int, int) const {
        const int t2_ = get_tid(), wid_ = __builtin_amdgcn_readfirstlane(t2_ >> 6), wr = wid_ >> 2, wc = wid_ & 3, fr = t2_ & 15, fq = (t2_ >> 4) & 3;
        const int row0 = u.pm * 256 + wr * 64 + fr, col0 = u.pn * 256 + wc * 32 + 4 * fq;
#pragma unroll
        for (int ai = 0; ai < 2; ++ai)
#pragma unroll
            for (int m = 0; m < 4; ++m) {
                const size_t off = (size_t)(row0 + ai * 128 + m * 16) * D_ + col0;
                f32x4 xin[2][2];
#pragma unroll
                for (int bj = 0; bj < 2; ++bj)
#pragma unroll
                    for (int n = 0; n < 2; ++n) xin[bj][n] = *(const f32x4*)&x[off + bj * 128 + n * 16];
#pragma unroll
                for (int bj = 0; bj < 2; ++bj)
#pragma unroll
                    for (int n = 0; n < 2; ++n) *(f32x4*)&x1[off + bj * 128 + n * 16] = xin[bj][n] + acc[ai][bj][m][n];
                asm volatile("" ::: "memory");
            }
    }
};
__device__ void ph_outproj(const P& p, int bid, int nb, char* smem) {
    DenseSched S; S.init(NTOK, D_, D_, p.woutT, nb, bid);
    EpiOutproj E{p.x, p.x1};
    gemm256(smem, (const char*)p.merged, D_, S, E);
}

__device__ __forceinline__ float red8f(float x) {
    x += dppf<0xB1>(x);
    x += dppf<0x4E>(x);
    x += dppf<0x141>(x);
    return x;
}
__device__ void ph_route(const P& p, int bid, int nb, char* smem) {
    float* wr = (float*)smem;
    const int tid = get_tid(), lane = tid & 63, wv = tid >> 6;
    {
        const int gtid = bid * NT + tid, gnt = nb * NT;
        const int per_e = 512 * 128 + 1024 * 32;
        for (int i = gtid; i < NEXP * per_e; i += gnt) {
            const int e = i / per_e; int r = i - e * per_e;
            const float* wp; u16* dstp; int N;
            if (r < 512 * 128) {
                const int kc = r >> 9, j = r & 511, half = j >> 8, sl = j & 255, sp = sl & 127;
                const int col = half * 128 + (sp & ~31) + perm32(sp & 31);
                N = 256; wp = ((sl >> 7) ? p.e_w3 : p.e_w1) + (size_t)e * D_ * 256 + (size_t)(kc * 8) * 256 + col;
                dstp = p.ew1T + ((size_t)e * 512 + j) * D_ + kc * 8;
            } else {
                r -= 512 * 128;
                const int kc = r >> 10, j = r & 1023;
                const int col = (j & ~31) + perm32(j & 31);
                N = D_; wp = p.e_w2 + (size_t)e * 256 * D_ + (size_t)(kc * 8) * D_ + col;
                dstp = p.ew2T + ((size_t)e * D_ + j) * 256 + kc * 8;
            }
            uint4 v;
            v.x = pack2(wp[0], wp[(size_t)N]); v.y = pack2(wp[2 * (size_t)N], wp[3 * (size_t)N]);
            v.z = pack2(wp[4 * (size_t)N], wp[5 * (size_t)N]); v.w = pack2(wp[6 * (size_t)N], wp[7 * (size_t)N]);
            *(uint4*)dstp = v;
        }
    }
    for (int i = tid; i < 1024 * 36; i += NT) {
        const int k = i / 36, j = i - k * 36;
        const int kp = (k & ~31) + ((k & 3) << 3) + ((k >> 2) & 7);
        wr[kp * 36 + j] = (j < 4) ? p.w_grp[k * 4 + j] : p.w_exp[k * 32 + (j - 4)];
    }
    int* lcount = (int*)(smem + 1024 * 36 * 4);
    if (tid < 32) lcount[tid] = 0;
    __syncthreads();
    const int sub = lane & 7, tk = lane >> 3;
    for (int n0 = (bid * NW + wv) * 16; n0 < NTOK; n0 += nb * NW * 16) {
        float acc[2][36]; float ss[2] = {0.f, 0.f};
#pragma unroll
        for (int t = 0; t < 2; t++)
#pragma unroll
            for (int j = 0; j < 36; j++) acc[t][j] = 0.f;
#pragma unroll 1
        for (int i0 = 0; i0 < 32; i0 += 4) {
            float4 xv[2][4];
#pragma unroll
            for (int t = 0; t < 2; t++)
#pragma unroll
                for (int i = 0; i < 4; i++) xv[t][i] = *(const float4*)&p.x1[(size_t)(n0 + 8 * t + tk) * D_ + (i0 + i) * 32 + sub * 4];
#pragma unroll
            for (int i = 0; i < 4; i++) {
                const int k0 = (i0 + i) * 32 + sub * 4;
                const float4 gf = *(const float4*)&p.g_ffn[k0];
                float hv[2][4];
#pragma unroll
                for (int t = 0; t < 2; t++) {
                    const float4 x = xv[t][i];
                    ss[t] += x.x * x.x + x.y * x.y + x.z * x.z + x.w * x.w;
                    hv[t][0] = x.x * gf.x; hv[t][1] = x.y * gf.y; hv[t][2] = x.z * gf.z; hv[t][3] = x.w * gf.w;
                    uint2 o; o.x = pack2(hv[t][0], hv[t][1]); o.y = pack2(hv[t][2], hv[t][3]);
                    *(uint2*)&p.hbuf[(size_t)(n0 + 8 * t + tk) * D_ + k0] = o;
                }
#pragma unroll
                for (int e2 = 0; e2 < 4; e2++) {
                    asm volatile("" ::: "memory");
                    const float* wrow = wr + ((i0 + i) * 32 + e2 * 8 + sub) * 36;
#pragma unroll
                    for (int j4 = 0; j4 < 9; j4++) {
                        const float4 wv4 = *(const float4*)&wrow[j4 * 4];
#pragma unroll
                        for (int t = 0; t < 2; t++) {
                            acc[t][j4 * 4 + 0] += hv[t][e2] * wv4.x; acc[t][j4 * 4 + 1] += hv[t][e2] * wv4.y;
                            acc[t][j4 * 4 + 2] += hv[t][e2] * wv4.z; acc[t][j4 * 4 + 3] += hv[t][e2] * wv4.w;
                        }
                    }
                }
            }
        }
#pragma unroll
        for (int t = 0; t < 2; t++) {
            const size_t n = (size_t)n0 + 8 * t + tk;
            const float sst = red8f(ss[t]);
#pragma unroll
            for (int j = 0; j < 36; j++) acc[t][j] = red8f(acc[t][j]);
            const float rs = rsqrtf(sst * (1.f / D_) + 1e-6f);
            if (sub == 0) {
                p.rsb[n] = rs;
                float gl[4]; int gs = 0;
#pragma unroll
                for (int j = 0; j < 4; j++) gl[j] = acc[t][j] * rs + p.b_grp[j];
                float gm = gl[0];
#pragma unroll
                for (int j = 1; j < 4; j++) if (gl[j] > gm) { gm = gl[j]; gs = j; }
                float gsum = 0.f;
#pragma unroll
                for (int j = 0; j < 4; j++) gsum += __expf(gl[j] - gm);
                const float pg = 1.f / gsum;
                float el[8]; float em = -3.0e38f;
#pragma unroll
                for (int j = 0; j < 8; j++) {
                    float a = (gs == 0) ? acc[t][4 + j] : ((gs == 1) ? acc[t][12 + j] : ((gs == 2) ? acc[t][20 + j] : acc[t][28 + j]));
                    a = a * rs + p.b_exp[gs * 8 + j];
                    el[j] = a; em = fmaxf(em, a);
                }
                int j0 = 0, j1 = -1; float v0 = -3.0e38f, v1 = -3.0e38f;
#pragma unroll
                for (int j = 0; j < 8; j++) { el[j] = __expf(el[j] - em); }
#pragma unroll
                for (int j = 0; j < 8; j++) { if (el[j] > v0) { v0 = el[j]; j0 = j; } }
#pragma unroll
                for (int j = 0; j < 8; j++) { if (j != j0 && el[j] > v1) { v1 = el[j]; j1 = j; } }
                const float den = v0 + v1;
                const int e0 = gs * 8 + j0, e1 = gs * 8 + j1;
                p.tok_e[n * 2] = e0; p.tok_e[n * 2 + 1] = e1;
                p.tok_gate[n * 2] = pg * v0 / den; p.tok_gate[n * 2 + 1] = pg * v1 / den;
                atomicAdd(&lcount[e0], 1); atomicAdd(&lcount[e1], 1);
            }
        }
    }
    __syncthreads();
    { const int t2 = get_tid(); if (t2 < 32) { const int c = lcount[t2]; if (c) atomicAdd(&p.counts[t2], c); } }
}

__device__ void ph_scatter(const P& p, int bid, int nb, char* smem) {
    int* offl = (int*)smem;
    int* hist = offl + 64;
    int* gbase = hist + 32;
    const int tid = get_tid();
    if (tid == 0) {
        int off = 0;
        for (int e = 0; e < NEXP; e++) { offl[e] = off; off += p.counts[e]; }
        offl[NEXP] = off;
    }
    if (bid == 0 && tid == 64) {
        int off = 0, nb_ = 0;
        for (int e = 0; e < NEXP; e++) {
            const int c = p.counts[e];
            p.offs[e] = off;
            for (int r = 0; r < c; r += 256) { p.blk_e[nb_] = e; p.blk_r0[nb_] = off + r; nb_++; }
            off += c;
        }
        p.offs[NEXP] = off;
        *p.nblk = nb_;
    }
    for (int base = bid * NT; base < NTOK * 2; base += nb * NT) {
        __syncthreads();
        if (tid < 32) hist[tid] = 0;
        __syncthreads();
        const int i = base + tid;
        const int e = p.tok_e[i];
        const int rl = atomicAdd(&hist[e], 1);
        __syncthreads();
        if (tid < 32) gbase[tid] = atomicAdd(&p.cursor[tid], hist[tid]);
        __syncthreads();
        const int slot = offl[e] + gbase[e] + rl;
        p.list_tok[slot] = i >> 1; p.list_gate[slot] = p.tok_gate[i]; p.tokslot[i] = slot;
    }
}
template <int CTS>
struct MoeSched {
    const P* pp; int nunits, G, c; unsigned rowbytes; const u16* Bt; size_t b_estride, b_tstride;
    bool gather;
    __device__ __forceinline__ bool next(int i, GUnit& u) const {
        const int L = i * G + c; if (L >= nunits) return false;
        int wgid = L; { const int q = nunits >> 3, r = nunits & 7, xcd = wgid & 7, off = wgid >> 3; wgid = (xcd < r ? xcd * (q + 1) : r * (q + 1) + (xcd - r) * q) + off; }
        u.pm = wgid / CTS; u.pn = wgid & (CTS - 1); return true;
    }
    __device__ __forceinline__ unsigned a_off(const GUnit& u, int h, int R) const {
        const P& p = *pp;
        const int e = __builtin_amdgcn_readfirstlane(p.blk_e[u.pm]), rend = __builtin_amdgcn_readfirstlane(p.offs[e + 1]);
        int sl = __builtin_amdgcn_readfirstlane(p.blk_r0[u.pm]) + h * 128 + R; if (sl >= rend) sl = rend - 1;
        return (unsigned)(gather ? p.list_tok[sl] : sl) * rowbytes;
    }
    __device__ __forceinline__ const char* b_ptr(const GUnit& u) const { return (const char*)(Bt + (size_t)__builtin_amdgcn_readfirstlane(pp->blk_e[u.pm]) * b_estride + (size_t)u.pn * b_tstride); }
};
struct EpiMoe1 {
    const P* pp;
    __device__ __forceinline__ void operator()(const f32x4 (&acc)[2][2][4][2], const GUnit& u, int, int, int, int) const {
        const int t2_ = get_tid(), wid_ = __builtin_amdgcn_readfirstlane(t2_ >> 6), wr = wid_ >> 2, wc = wid_ & 3, fr = t2_ & 15, fq = (t2_ >> 4) & 3;
        const P& p = *pp;
        const int e = __builtin_amdgcn_readfirstlane(p.blk_e[u.pm]), r0 = __builtin_amdgcn_readfirstlane(p.blk_r0[u.pm]), rend = __builtin_amdgcn_readfirstlane(p.offs[e + 1]);
#pragma unroll
        for (int ai = 0; ai < 2; ++ai)
#pragma unroll
            for (int m = 0; m < 4; ++m) {
                const int sl = r0 + ai * 128 + wr * 64 + m * 16 + fr;
                if (sl < rend) {
                    const float rs = p.rsb[p.list_tok[sl]];
                    f32x4 v[2];
#pragma unroll
                    for (int n = 0; n < 2; ++n)
#pragma unroll
                        for (int r = 0; r < 4; r++) { const float a = acc[ai][0][m][n][r] * rs; v[n][r] = a * sigmoidf_(a) * (acc[ai][1][m][n][r] * rs); }
                    *(uint4*)&p.hid[(size_t)sl * 256 + u.pn * 128 + wc * 32 + 8 * fq] = pack8(v[0], v[1]);
                }
            }
    }
};
__device__ void ph_moe1(const P& p, int bid, int nb, char* smem) {
    MoeSched<2> S{&p, __builtin_amdgcn_readfirstlane(*p.nblk) * 2, nb, bid, (unsigned)(D_ * 2), p.ew1T, (size_t)512 * D_, (size_t)256 * D_, true};
    EpiMoe1 E{&p};
    gemm256(smem, (const char*)p.hbuf, D_, S, E);
}
struct EpiMoe2 {
    const P* pp;
    __device__ __forceinline__ void operator()(const f32x4 (&acc)[2][2][4][2], const GUnit& u, int, int, int, int) const {
        const int t2_ = get_tid(), wid_ = __builtin_amdgcn_readfirstlane(t2_ >> 6), wr = wid_ >> 2, wc = wid_ & 3, fr = t2_ & 15, fq = (t2_ >> 4) & 3;
        const P& p = *pp;
        const int e = __builtin_amdgcn_readfirstlane(p.blk_e[u.pm]), r0 = __builtin_amdgcn_readfirstlane(p.blk_r0[u.pm]), rend = __builtin_amdgcn_readfirstlane(p.offs[e + 1]);
#pragma unroll
        for (int ai = 0; ai < 2; ++ai)
#pragma unroll
            for (int m = 0; m < 4; ++m) {
                const int sl = r0 + ai * 128 + wr * 64 + m * 16 + fr;
                if (sl < rend) {
                    const float gt = p.list_gate[sl];
                    u16* yp = p.ybuf + (size_t)sl * D_ + u.pn * 256 + wc * 32 + 8 * fq;
#pragma unroll
                    for (int bj = 0; bj < 2; ++bj) *(uint4*)&yp[bj * 128] = pack8(acc[ai][bj][m][0] * gt, acc[ai][bj][m][1] * gt);
                }
            }
    }
};
__device__ void ph_moe2(const P& p, int bid, int nb, char* smem) {
    MoeSched<4> S{&p, __builtin_amdgcn_readfirstlane(*p.nblk) * 4, nb, bid, 512u, p.ew2T, (size_t)D_ * 256, (size_t)256 * 256, false};
    EpiMoe2 E{&p};
    gemm256(smem, (const char*)p.hid, 256, S, E);
}
__device__ void ph_final(const P& p, int bid, int nb, char* smem) {
    const int tid = get_tid(), lane = tid & 63, wv = tid >> 6;
    for (int row = bid * NW + wv; row < NTOK; row += nb * NW) {
        const int s0 = p.tokslot[row * 2], s1 = p.tokslot[row * 2 + 1];
        float v[16]; float ss = 0.f;
#pragma unroll
        for (int i = 0; i < 4; i++) {
            const int c = i * 256 + lane * 4;
            const float4 t = *(const float4*)&p.x1[(size_t)row * D_ + c];
            const uint2 a = *(const uint2*)&p.ybuf[(size_t)s0 * D_ + c];
            const uint2 bq = *(const uint2*)&p.ybuf[(size_t)s1 * D_ + c];
            v[4 * i]     = t.x + __uint_as_float(a.x << 16) + __uint_as_float(bq.x << 16);
            v[4 * i + 1] = t.y + __uint_as_float(a.x & 0xFFFF0000u) + __uint_as_float(bq.x & 0xFFFF0000u);
            v[4 * i + 2] = t.z + __uint_as_float(a.y << 16) + __uint_as_float(bq.y << 16);
            v[4 * i + 3] = t.w + __uint_as_float(a.y & 0xFFFF0000u) + __uint_as_float(bq.y & 0xFFFF0000u);
            ss += v[4 * i] * v[4 * i] + v[4 * i + 1] * v[4 * i + 1] + v[4 * i + 2] * v[4 * i + 2] + v[4 * i + 3] * v[4 * i + 3];
        }
        ss = wave_sum(ss);
        const float rs = rsqrtf(ss * (1.f / D_) + 1e-6f);
#pragma unroll
        for (int i = 0; i < 4; i++) {
            const int c = i * 256 + lane * 4;
            const float4 g = *(const float4*)&p.g_final[c];
            float4 o; o.x = v[4 * i] * rs * g.x; o.y = v[4 * i + 1] * rs * g.y; o.z = v[4 * i + 2] * rs * g.z; o.w = v[4 * i + 3] * rs * g.w;
            *(float4*)&p.out[(size_t)row * D_ + c] = o;
        }
    }
}

#define XB_TMO      128
#define XB_XCNT(j)  (256  + 64 * (j))
#define XB_XSUB(j)  (1280 + 64 * (j))
#define XB_XGEN(j)  (2304 + 64 * (j))
#define XB_TOP      3328
#define XB_TOPGEN   3392
#define XCD_BAR_WORDS 3456
#define XB_SPIN_CAP (1u << 18)
#define LAS __attribute__((address_space(3)))

__device__ __forceinline__ unsigned xb_ld(unsigned* p)              { return __hip_atomic_load(p, __ATOMIC_RELAXED, __HIP_MEMORY_SCOPE_AGENT); }
__device__ __forceinline__ unsigned xb_add(unsigned* p, unsigned v) { return __hip_atomic_fetch_add(p, v, __ATOMIC_RELAXED, __HIP_MEMORY_SCOPE_AGENT); }
__device__ __forceinline__ unsigned xb_xcc_id() { return (unsigned)__builtin_amdgcn_s_getreg((3 << 11) | 20) & 0xFu; }
#define XB_SPIN(cond, bar) do { unsigned _sp = 0; while (cond) { __builtin_amdgcn_s_sleep(1); \
    if ((++_sp & 255u) == 0u) { if (xb_ld(&(bar)[XB_TMO])) break; if (_sp > XB_SPIN_CAP) { atomicAdd(&(bar)[XB_TMO], 1u); break; } } } } while (0)

struct XcdBarrier {
    unsigned* bar; unsigned x;
    volatile LAS unsigned* st;
};

__device__ __forceinline__ XcdBarrier xcd_barrier_post(unsigned* bar, volatile LAS unsigned* st) {
    XcdBarrier b; b.bar = bar; b.x = xb_xcc_id(); b.st = st;
    if (threadIdx.x == 0) (void)xb_add(&bar[XB_XCNT(b.x)], 1u);
    return b;
}
__device__ __forceinline__ void xcd_barrier_complete(unsigned* bar, unsigned x, unsigned& nloc, unsigned& nx) {
    const unsigned G = gridDim.x * gridDim.y * gridDim.z;
    unsigned sum, cnt, mine, sp = 0u;
    for (;;) {
        sum = 0u; cnt = 0u; mine = 0u;
#pragma unroll
        for (unsigned j = 0; j < 16; ++j) { const unsigned c = xb_ld(&bar[XB_XCNT(j)]); sum += c; cnt += (c > 0u) ? 1u : 0u; mine = (j == x) ? c : mine; }
        if (sum == G) break;
        __builtin_amdgcn_s_sleep(1);
        if ((++sp & 255u) == 0u) { if (xb_ld(&bar[XB_TMO])) break; if (sp > XB_SPIN_CAP) { atomicAdd(&bar[XB_TMO], 1u); break; } }
    }
    nloc = mine > 0u ? mine : 1u; nx = cnt > 0u ? cnt : 1u;
}

__device__ __forceinline__ void xcd_barrier(const XcdBarrier& b) {
    asm volatile("s_waitcnt vmcnt(0)" ::: "memory");
    __syncthreads();
    if (threadIdx.x == 0) {
        unsigned* bar = b.bar;
        __builtin_amdgcn_s_waitcnt(0);
        unsigned nloc = b.st[0], nx = b.st[1];
        if (nloc == 0u) { xcd_barrier_complete(bar, b.x, nloc, nx); b.st[0] = nloc; b.st[1] = nx; }
        const unsigned old = xb_add(&bar[XB_XSUB(b.x)], 1u);
        const unsigned gen = old / nloc;
        if (old + 1u == (gen + 1u) * nloc) {
            __builtin_amdgcn_fence(__ATOMIC_RELEASE, "agent");
            asm volatile("s_waitcnt vmcnt(0)" ::: "memory");
            const unsigned og = xb_add(&bar[XB_TOP], 1u);
            const unsigned tg = og / nx;
            if (og + 1u == (tg + 1u) * nx) xb_add(&bar[XB_TOPGEN], 1u);
            else XB_SPIN(xb_ld(&bar[XB_TOPGEN]) == tg, bar);
            __builtin_amdgcn_fence(__ATOMIC_ACQUIRE, "agent");
            xb_add(&bar[XB_XGEN(b.x)], 1u);
            asm volatile("s_waitcnt vmcnt(0)" ::: "memory");
        } else {
            XB_SPIN(xb_ld(&bar[XB_XGEN(b.x)]) == gen, bar);
            __builtin_amdgcn_fence(__ATOMIC_ACQUIRE, "agent");
            asm volatile("s_waitcnt vmcnt(0)" ::: "memory");
        }
    }
    __syncthreads();
}

template <int PH>
__device__ __forceinline__ void run_phase(const P& p, int bid, int nb, char* smem) {
    if constexpr (PH == 0) ph_prologue(p, bid, nb, smem);
    if constexpr (PH == 1) ph_inproj(p, bid, nb, smem);
    if constexpr (PH == 2) { ph_compress(p, bid, nb, smem); __syncthreads(); ph_rwkv_chunk(p, bid, nb, smem); }
    if constexpr (PH == 3) {
        if (bid < SCAN_BLOCKS) ph_rwkv_seq(p, bid, SCAN_BLOCKS, smem);
        else ph_nsa(p, bid - SCAN_BLOCKS, nb - SCAN_BLOCKS, smem);
    }
    if constexpr (PH == 12) ph_rwkv_out(p, bid, nb, smem);
    if constexpr (PH == 4) ph_merge(p, bid, nb, smem);
    if constexpr (PH == 5) ph_outproj(p, bid, nb, smem);
    if constexpr (PH == 6) ph_route(p, bid, nb, smem);
    if constexpr (PH == 7) ph_scatter(p, bid, nb, smem);
    if constexpr (PH == 9) ph_moe1(p, bid, nb, smem);
    if constexpr (PH == 10) ph_moe2(p, bid, nb, smem);
    if constexpr (PH == 11) ph_final(p, bid, nb, smem);
}

template <int PH>
__global__ void __launch_bounds__(NT) kph(P p) {
    extern __shared__ __attribute__((aligned(16))) char smem[];
    run_phase<PH>(p, blockIdx.x, gridDim.x, smem);
}

__global__ void __launch_bounds__(NT, 2) mega(P p) {
    extern __shared__ __attribute__((aligned(16))) char smem[];
    volatile LAS unsigned* st = (volatile LAS unsigned*)(smem + SMEM_BYTES - 16);
    if (threadIdx.x == 0) { st[0] = 0u; st[1] = 0u; st[2] = 0u; st[3] = 0u; }
    __syncthreads();
    XcdBarrier bar = xcd_barrier_post(p.bar, st);
    const int bid = blockIdx.x, nb = gridDim.x;
#define RUNP(N, BAR) { unsigned long long t0_ = 0; if ((TPROBE >> N) & 1) t0_ = __builtin_amdgcn_s_memrealtime(); run_phase<N>(p, bid, nb, smem); \
        unsigned long long tw_ = 0; if (((TPROBE >> N) & 1) && TPSEL) tw_ = __builtin_amdgcn_s_memrealtime() - t0_; if (BAR) xcd_barrier(bar); \
        if ((TPROBE >> N) & 1) { const unsigned long long t1_ = __builtin_amdgcn_s_memrealtime(); const unsigned long long dt_ = TPSEL ? tw_ : t1_ - t0_; \
            if (!TPSEL || (TPSEL == 1 ? (bid < SCAN_BLOCKS) : (bid >= SCAN_BLOCKS))) while (__builtin_amdgcn_s_memrealtime() - t1_ < dt_) __builtin_amdgcn_s_sleep(8); if (TPSEL) xcd_barrier(bar); } }
    RUNP(0, 1) RUNP(1, 1) RUNP(2, 1) RUNP(3, 1) RUNP(12, 1) RUNP(4, 1) RUNP(5, 1) RUNP(6, 1) RUNP(7, 1) RUNP(9, 1) RUNP(10, 1) RUNP(11, 0)
}

extern "C" void kernel_launch(void* const* d_in, const int* in_sizes, int n_in,
                              void* d_out, int out_size, void* d_ws, size_t ws_size,
                              hipStream_t stream) {
    P p{};
    p.x = (const float*)d_in[0]; p.pos = (const int*)d_in[1]; p.g_mix = (const float*)d_in[2]; p.w_in = (const float*)d_in[3];
    p.pe_k = (const float*)d_in[4]; p.w1_k = (const float*)d_in[5]; p.b1_k = (const float*)d_in[6]; p.w2_k = (const float*)d_in[7]; p.b2_k = (const float*)d_in[8];
    p.pe_v = (const float*)d_in[9]; p.w1_v = (const float*)d_in[10]; p.b1_v = (const float*)d_in[11]; p.w2_v = (const float*)d_in[12]; p.b2_v = (const float*)d_in[13];
    p.mu = (const float*)d_in[14]; p.w0 = (const float*)d_in[15]; p.w2 = (const float*)d_in[16]; p.a0 = (const float*)d_in[17]; p.a2 = (const float*)d_in[18];
    p.g2 = (const float*)d_in[19]; p.k_k = (const float*)d_in[20]; p.k_a = (const float*)d_in[21]; p.r_k = (const float*)d_in[22]; p.ln_w = (const float*)d_in[23]; p.ln_b = (const float*)d_in[24];
    p.wpa = (const float*)d_in[25]; p.wpb = (const float*)d_in[26]; p.wout = (const float*)d_in[27]; p.g_ffn = (const float*)d_in[28];
    p.w_grp = (const float*)d_in[29]; p.b_grp = (const float*)d_in[30]; p.w_exp = (const float*)d_in[31]; p.b_exp = (const float*)d_in[32];
    p.e_w1 = (const float*)d_in[33]; p.e_w3 = (const float*)d_in[34]; p.e_w2 = (const float*)d_in[35]; p.g_final = (const float*)d_in[36];
    p.out = (float*)d_out;
    char* ws = (char*)d_ws;
    const size_t MiB = 1ull << 20;
    p.hbuf = (u16*)(ws + 0 * MiB);
    p.q    = (u16*)(ws + 64 * MiB);
    p.kc   = (u16*)(ws + 96 * MiB);  p.vc   = (u16*)(ws + 104 * MiB);
    p.ksl  = (u16*)(ws + 112 * MiB); p.vslT = (u16*)(ws + 120 * MiB);
    p.kwn  = (u16*)(ws + 128 * MiB); p.vwnT = (u16*)(ws + 136 * MiB);
    p.nsag = (float*)(ws + 144 * MiB);
    p.kcb  = (u16*)(ws + 148 * MiB); p.vcT  = (u16*)(ws + 149 * MiB);
    p.prw  = (u16*)(ws + 160 * MiB);
    p.cdat = (u16*)(ws + 272 * MiB);
    p.bon  = (float*)(ws + 150 * MiB);
    p.w2T  = (u16*)(ws + 151 * MiB); p.a2T = p.w2T + 512 * 64; p.g2T = p.a2T + 512 * 64;
    p.cw1Tk = (u16*)(ws + 152 * MiB); p.cw1Tv = (u16*)(ws + 153 * MiB);
    p.cw2Tk = (u16*)(ws + 154 * MiB); p.cw2Tv = p.cw2Tk + 128 * 256;
    p.chid = (u16*)(ws + 155 * MiB);
    p.xact = (u16*)(ws + 488 * MiB);
    p.oa   = (u16*)(ws + 400 * MiB);
    p.ob   = (u16*)(ws + 432 * MiB);
    p.merged = (u16*)(ws + 64 * MiB);
    p.x1   = (float*)(ws + 160 * MiB);
    char* rt = ws + 288 * MiB;
    p.tok_e = (int*)(rt);                        rt += NTOK * 2 * 4;
    p.tok_gate = (float*)(rt);                   rt += NTOK * 2 * 4;
    p.tokslot = (int*)(rt);                      rt += NTOK * 2 * 4;
    p.list_tok = (int*)(rt);                     rt += NTOK * 2 * 4;
    p.list_gate = (float*)(rt);                  rt += NTOK * 2 * 4;
    p.blk_e = (int*)(rt);                        rt += 2048 * 4;
    p.blk_r0 = (int*)(rt);                       rt += 2048 * 4;
    p.rsb = (float*)(rt);                        rt += NTOK * 4;
    p.hid  = (u16*)(ws + 296 * MiB);
    p.ybuf = (u16*)(ws + 336 * MiB);
    char* misc = ws + 470 * MiB;
    p.counts = (int*)(misc); p.cursor = (int*)(misc + 256); p.offs = (int*)(misc + 512); p.nblk = (int*)(misc + 1024);
    p.bar = (unsigned*)(ws + 471 * MiB);
    p.cb1k = (float*)(p.bar + XCD_BAR_WORDS); p.cb1v = p.cb1k + 256;
    {
        char* wa = ws + 472 * MiB;
        p.winT = (u16*)wa;  wa += (size_t)3328 * 1024 * 2;
        p.wgT  = (u16*)wa;  wa += (size_t)2048 * 1024 * 2;
        p.wpaT = (u16*)wa;  wa += (size_t)1024 * 512 * 2;
        p.wpbT = (u16*)wa;  wa += (size_t)1024 * 512 * 2;
        p.woutT = (u16*)wa; wa += (size_t)1024 * 1024 * 2;
        p.ew1T = (u16*)(ws + 64 * MiB);  p.ew3T = (u16*)(ws + 80 * MiB);  p.ew2T = (u16*)(ws + 96 * MiB);
    }
    if (ws_size < (size_t)505 * MiB) return;

#if MEGA
    {
        static int mgrid = 0;
        if (mgrid == 0) {
            int dev = 0, cus = 0, per_cu = 0;
            hipGetDevice(&dev);
            hipDeviceGetAttribute(&cus, hipDeviceAttributeMultiprocessorCount, dev);
            hipFuncSetAttribute((const void*)mega, hipFuncAttributeMaxDynamicSharedMemorySize, SMEM_BYTES);
            hipOccupancyMaxActiveBlocksPerMultiprocessor(&per_cu, (const void*)mega, NT, SMEM_BYTES);
            (void)hipGetLastError();
            mgrid = cus;
        }
        hipMemsetAsync(p.bar, 0, XCD_BAR_WORDS * sizeof(unsigned) + 512 * sizeof(float), stream);
        mega<<<mgrid, NT, SMEM_BYTES, stream>>>(p);
        return;
    }
#else
    const int grid = 512;
    hipMemsetAsync(p.bar, 0, XCD_BAR_WORDS * sizeof(unsigned) + 512 * sizeof(float), stream);
    hipFuncSetAttribute((const void*)kph<0>, hipFuncAttributeMaxDynamicSharedMemorySize, SMEM_BYTES);
    hipFuncSetAttribute((const void*)kph<1>, hipFuncAttributeMaxDynamicSharedMemorySize, SMEM_BYTES);
    hipFuncSetAttribute((const void*)kph<2>, hipFuncAttributeMaxDynamicSharedMemorySize, SMEM_BYTES);
    hipFuncSetAttribute((const void*)kph<3>, hipFuncAttributeMaxDynamicSharedMemorySize, SMEM_BYTES);
    hipFuncSetAttribute((const void*)kph<4>, hipFuncAttributeMaxDynamicSharedMemorySize, SMEM_BYTES);
    hipFuncSetAttribute((const void*)kph<5>, hipFuncAttributeMaxDynamicSharedMemorySize, SMEM_BYTES);
    hipFuncSetAttribute((const void*)kph<6>, hipFuncAttributeMaxDynamicSharedMemorySize, SMEM_BYTES);
    hipFuncSetAttribute((const void*)kph<7>, hipFuncAttributeMaxDynamicSharedMemorySize, SMEM_BYTES);
    hipFuncSetAttribute((const void*)kph<8>, hipFuncAttributeMaxDynamicSharedMemorySize, SMEM_BYTES);
    hipFuncSetAttribute((const void*)kph<9>, hipFuncAttributeMaxDynamicSharedMemorySize, SMEM_BYTES);
    hipFuncSetAttribute((const void*)kph<10>, hipFuncAttributeMaxDynamicSharedMemorySize, SMEM_BYTES);
    hipFuncSetAttribute((const void*)kph<11>, hipFuncAttributeMaxDynamicSharedMemorySize, SMEM_BYTES);
    kph<0><<<grid, NT, SMEM_BYTES, stream>>>(p);
    kph<1><<<grid, NT, SMEM_BYTES, stream>>>(p);
    kph<2><<<grid, NT, SMEM_BYTES, stream>>>(p);
    kph<3><<<grid, NT, SMEM_BYTES, stream>>>(p);
    kph<12><<<grid, NT, SMEM_BYTES, stream>>>(p);
    kph<4><<<grid, NT, SMEM_BYTES, stream>>>(p);
    kph<5><<<grid, NT, SMEM_BYTES, stream>>>(p);
    kph<6><<<grid, NT, SMEM_BYTES, stream>>>(p);
    kph<7><<<grid, NT, SMEM_BYTES, stream>>>(p);
    kph<8><<<grid, NT, SMEM_BYTES, stream>>>(p);
    kph<9><<<grid, NT, SMEM_BYTES, stream>>>(p);
    kph<10><<<grid, NT, SMEM_BYTES, stream>>>(p);
    kph<11><<<grid, NT, SMEM_BYTES, stream>>>(p);
#endif
}
```

```cpp
#include <hip/hip_runtime.h>
#include <stdint.h>

typedef unsigned short u16;
using bf16x8 = __attribute__((ext_vector_type(8))) short;
using f32x4  = __attribute__((ext_vector_type(4))) float;

#ifndef MEGA
#define MEGA 1
#endif

constexpr int B_ = 4, S_ = 8192, D_ = 1024, NTOK = B_ * S_;
constexpr int CIN = 5144;
constexpr int NCMP = 511;
constexpr int CRW = 1792;
constexpr int NEXP = 32;
constexpr int NT = 512;
constexpr int NW = NT / 64;
constexpr int SMEM_BYTES = 160 * 1024;
constexpr int SCAN_BLOCKS = 16;
#ifndef TPROBE
#define TPROBE 0
#define TPSEL 0
#endif
constexpr float QSCALE = 0.125f * 1.4426950408889634f;

struct P {
    const float* x; const int* pos; const float* g_mix; const float* w_in;
    const float *pe_k, *w1_k, *b1_k, *w2_k, *b2_k, *pe_v, *w1_v, *b1_v, *w2_v, *b2_v;
    const float *mu, *w0, *w2, *a0, *a2, *g2, *k_k, *k_a, *r_k, *ln_w, *ln_b;
    const float *wpa, *wpb, *wout, *g_ffn, *w_grp, *b_grp, *w_exp, *b_exp, *e_w1, *e_w3, *e_w2, *g_final;
    float* out;
    u16* hbuf; u16 *q, *kc, *vc, *ksl, *vslT, *kwn, *vwnT, *kcb, *vcT; float* nsag; u16* prw;
    u16* cdat; float* bon; u16 *w2T, *a2T, *g2T; u16 *oa, *ob; u16* merged; float* x1;
    int* tok_e; float* tok_gate; int* tokslot; int* list_tok; float* list_gate;
    int* counts; int* offs; int* cursor; int* blk_e; int* blk_r0; int* nblk; float* rsb;
    u16* hid; u16* ybuf; unsigned* bar;
    u16 *winT, *wgT, *wpaT, *wpbT, *woutT, *ew1T, *ew3T, *ew2T;
    u16 *cw1Tk, *cw1Tv, *cw2Tk, *cw2Tv, *chid, *xact; float *cb1k, *cb1v;
};

typedef __bf16 bf16x2_t __attribute__((ext_vector_type(2)));
typedef float f32x2_t __attribute__((ext_vector_type(2)));
__device__ __forceinline__ unsigned pack2(float a, float b) {
    f32x2_t f = {a, b};
    return __builtin_bit_cast(unsigned, __builtin_convertvector(f, bf16x2_t));
}
__device__ __forceinline__ u16 f2bf(float f) { return (u16)(pack2(f, f) & 0xFFFFu); }
__device__ __forceinline__ float bf2f(u16 h) { return __uint_as_float(((unsigned)h) << 16); }
__device__ __forceinline__ float sigmoidf_(float x) { return __builtin_amdgcn_rcpf(1.f + __expf(-x)); }
__device__ __forceinline__ int get_tid() { int t = threadIdx.x; asm volatile("" : "+v"(t)); return t; }
__device__ __forceinline__ uint2 pack4(const f32x4& v) { uint2 o; o.x = pack2(v[0], v[1]); o.y = pack2(v[2], v[3]); return o; }
__device__ __forceinline__ f32x4 unpack4(uint2 u) { return f32x4{__uint_as_float(u.x << 16), __uint_as_float(u.x & 0xFFFF0000u), __uint_as_float(u.y << 16), __uint_as_float(u.y & 0xFFFF0000u)}; }
#define LDS_BARRIER() do { asm volatile("s_waitcnt lgkmcnt(0)" ::: "memory"); __builtin_amdgcn_s_barrier(); asm volatile("" ::: "memory"); } while (0)
__device__ __forceinline__ int opaque(int x) { asm volatile("" : "+v"(x)); return x; }
template <int CTRL>
__device__ __forceinline__ float dppf(float x) { return __int_as_float(__builtin_amdgcn_update_dpp(0, __float_as_int(x), CTRL, 0xF, 0xF, true)); }
__device__ __forceinline__ float wave_sum(float v) {
    v += dppf<0xB1>(v);
    v += dppf<0x4E>(v);
    v += dppf<0x141>(v);
    v += dppf<0x140>(v);
    const int vi = __float_as_int(v);
    return (__int_as_float(__builtin_amdgcn_readlane(vi, 0)) + __int_as_float(__builtin_amdgcn_readlane(vi, 16)))
         + (__int_as_float(__builtin_amdgcn_readlane(vi, 32)) + __int_as_float(__builtin_amdgcn_readlane(vi, 48)));
}

__device__ __forceinline__ float xrow_sum(float v) {
    auto r = __builtin_amdgcn_permlane16_swap(__float_as_uint(v), __float_as_uint(v), false, false);
    v = __uint_as_float(r[0]) + __uint_as_float(r[1]);
    auto r2 = __builtin_amdgcn_permlane32_swap(__float_as_uint(v), __float_as_uint(v), false, false);
    return __uint_as_float(r2[0]) + __uint_as_float(r2[1]);
}
__device__ __forceinline__ float xrow_max(float v) {
    auto r = __builtin_amdgcn_permlane16_swap(__float_as_uint(v), __float_as_uint(v), false, false);
    v = fmaxf(__uint_as_float(r[0]), __uint_as_float(r[1]));
    auto r2 = __builtin_amdgcn_permlane32_swap(__float_as_uint(v), __float_as_uint(v), false, false);
    return fmaxf(__uint_as_float(r2[0]), __uint_as_float(r2[1]));
}
__constant__ double ROPE_FREQ[32] = {
    1.00000000000000000000e+00, 7.49894209332455874417e-01, 5.62341325190349072827e-01, 4.21696503428582225581e-01,
    3.16227766016837941176e-01, 2.37137370566165517349e-01, 1.77827941003892292526e-01, 1.33352143216332402753e-01,
    1.00000000000000005551e-01, 7.49894209332455791150e-02, 5.62341325190349114460e-02, 4.21696503428582239459e-02,
    3.16227766016837913421e-02, 2.37137370566165538166e-02, 1.77827941003892292526e-02, 1.33352143216332406223e-02,
    1.00000000000000002082e-02, 7.49894209332455791150e-03, 5.62341325190349097113e-03, 4.21696503428582291501e-03,
    3.16227766016837939442e-03, 2.37137370566165538166e-03, 1.77827941003892275179e-03, 1.33352143216332406223e-03,
    1.00000000000000002082e-03, 7.49894209332455856203e-04, 5.62341325190349097113e-04, 4.21696503428582237290e-04,
    3.16227766016837939442e-04, 2.37137370566165538166e-04, 1.77827941003892269758e-04, 1.33352143216332395381e-04};

constexpr int G_ABYTES = 256 * 64 * 2, G_BBYTES = 128 * 64 * 2, G_TILE = G_ABYTES + G_BBYTES;
#define LAS3 __attribute__((address_space(3)))
#define GAS1 __attribute__((address_space(1)))
__device__ __forceinline__ void glds16(const u16* g, char* l) {
    __builtin_amdgcn_global_load_lds((const GAS1 unsigned*)g, (LAS3 unsigned*)l, 16, 0, 0);
}
template <bool TR = false, class ARow>
__device__ __forceinline__ void gemm_core(int K, ARow arow, const u16* __restrict__ BT, int ldb, f32x4 (&acc)[4][4], u16* sm) {
    char* base = (char*)sm;
    const int tid = get_tid(), lane = tid & 63, wv = tid >> 6;
    const int wm = wv >> 1, wn = wv & 1, kr = lane & 15, qq = lane >> 4;
    const int lr = tid >> 3, lk = ((tid & 7) ^ ((lr >> 1) & 7)) * 8;
    const u16* ap0 = arow(lr) + lk; const u16* ap1 = arow(lr + 64) + lk;
    const u16* ap2 = arow(lr + 128) + lk; const u16* ap3 = arow(lr + 192) + lk;
    const u16* bp0 = BT + (size_t)lr * ldb + lk; const u16* bp1 = BT + (size_t)(lr + 64) * ldb + lk;
#pragma unroll
    for (int mt = 0; mt < 4; mt++)
#pragma unroll
        for (int nt = 0; nt < 4; nt++) acc[mt][nt] = f32x4{0.f, 0.f, 0.f, 0.f};
    const int nk = K >> 6;
#define G_ISSUE(t, b) { char* d = base + (b) * G_TILE + tid * 16; const int ko = (t) * 64; \
        glds16(ap0 + ko, d); glds16(ap1 + ko, d + 8192); glds16(ap2 + ko, d + 16384); glds16(ap3 + ko, d + 24576); \
        glds16(bp0 + ko, d + G_ABYTES); glds16(bp1 + ko, d + G_ABYTES + 8192); }
    const int sw = kr >> 1;
    const int po0 = ((0 * 4 + qq) ^ sw) * 16, po1 = ((1 * 4 + qq) ^ sw) * 16;
    const int aoff = (wm * 64 + kr) * 128, boff = G_ABYTES + (wn * 64 + kr) * 128;
#define G_READ(FA, FB, b) { const char* Ab = base + (b) * G_TILE + aoff; const char* Bb = base + (b) * G_TILE + boff; \
        _Pragma("unroll") for (int mt = 0; mt < 4; mt++) { FA[0][mt] = *(const bf16x8*)(Ab + mt * 2048 + po0); FA[1][mt] = *(const bf16x8*)(Ab + mt * 2048 + po1); } \
        _Pragma("unroll") for (int nt = 0; nt < 4; nt++) { FB[0][nt] = *(const bf16x8*)(Bb + nt * 2048 + po0); FB[1][nt] = *(const bf16x8*)(Bb + nt * 2048 + po1); } }
#define G_MMA(FA, FB) { __builtin_amdgcn_s_setprio(1); \
        _Pragma("unroll") for (int ks = 0; ks < 2; ks++) \
            _Pragma("unroll") for (int nt = 0; nt < 4; nt++) \
                _Pragma("unroll") for (int mt = 0; mt < 4; mt++) \
                    acc[mt][nt] = TR ? __builtin_amdgcn_mfma_f32_16x16x32_bf16(FA[ks][mt], FB[ks][nt], acc[mt][nt], 0, 0, 0) \
                                     : __builtin_amdgcn_mfma_f32_16x16x32_bf16(FB[ks][nt], FA[ks][mt], acc[mt][nt], 0, 0, 0); \
        __builtin_amdgcn_s_setprio(0); }
    bf16x8 fa0[2][4], fb0[2][4], fa1[2][4], fb1[2][4];
    G_ISSUE(0, 0)
    if (nk > 1) G_ISSUE(1, 1)
    if (nk > 2) G_ISSUE(2, 2)
    if (nk > 2) asm volatile("s_waitcnt vmcnt(12)" ::: "memory");
    else if (nk > 1) asm volatile("s_waitcnt vmcnt(6)" ::: "memory");
    else asm volatile("s_waitcnt vmcnt(0)" ::: "memory");
    __builtin_amdgcn_s_barrier();
    G_READ(fa0, fb0, 0)
    int bnext = 1, bfree = 0;
#define G_STEP(FAC, FBC, FAN, FBN, kt) { \
        if ((kt) + 1 < nk) { \
            if ((kt) + 2 < nk) asm volatile("s_waitcnt vmcnt(6) lgkmcnt(0)" ::: "memory"); else asm volatile("s_waitcnt vmcnt(0) lgkmcnt(0)" ::: "memory"); \
            __builtin_amdgcn_s_barrier();                   \
            if ((kt) + 3 < nk) G_ISSUE((kt) + 3, bfree) \
            G_READ(FAN, FBN, bnext) \
        } \
        G_MMA(FAC, FBC) \
        bfree = bnext; bnext = (bnext == 2) ? 0 : bnext + 1; }
    for (int kt = 0; kt < nk; kt += 2) {
        G_STEP(fa0, fb0, fa1, fb1, kt)
        G_STEP(fa1, fb1, fa0, fb0, kt + 1)
    }
    __builtin_amdgcn_s_barrier();
#undef G_READ
#undef G_MMA
#undef G_STEP
#undef G_ISSUE
}

__device__ __forceinline__ int xcd_item(int bid, int nb, int k, int nitems) {
    if (nb & 7) return bid + k * nb;
    const int per = nb >> 3, chunk = (nitems + 7) >> 3;
    const int j = k * per + (bid >> 3);
    return (j < chunk) ? (bid & 7) * chunk + j : nitems;
}
struct GUnit { int pm, pn; };
constexpr int G8_HTB = 128 * 64 * 2;
__device__ __forceinline__ int g8_lds_byte(int r, int c) { const int st = (r >> 4) * 2 + (c >> 5), rr = r & 15, cc = c & 31, ob = rr * 64 + cc * 2; return st * 1024 + (ob ^ (((ob >> 9) & 1) << 5)); }
__device__ __forceinline__ void g8_stage_rc(int b, int& R, int& C) { const int st = b / 1024, sb = b % 1024, swz = sb ^ (((sb >> 9) & 1) << 5); R = (st >> 1) * 16 + swz / 64; C = (st & 1) * 32 + (swz % 64) / 2; }
__host__ __device__ __forceinline__ int perm32(int rho) { const int n = rho >> 4, i = rho & 15; return 8 * (i >> 2) + 4 * n + (i & 3); }

template <class Epi, class Sched>
__device__ __forceinline__ void gemm256(char* smem, const char* Ab, int K, const Sched& S, const Epi& E) {
    LAS3 unsigned char* lds = (LAS3 unsigned char*)smem;
    const int tid = get_tid(), wid = __builtin_amdgcn_readfirstlane(tid >> 6), lane = tid & 63, wr = wid >> 2, wc = wid & 3, fr = lane & 15, fq = lane >> 4;
    int nt = K >> 6; asm volatile("" : "+s"(nt));
    unsigned voffB[2], voffA[2][2];
#pragma unroll
    for (int i = 0; i < 2; ++i) { int sR, sC; g8_stage_rc(tid * 16 + i * 8192, sR, sC); voffB[i] = (unsigned)(sR * K + sC) * 2u; }
#define G8_AOFFS(un) do { const int t3_ = get_tid(); _Pragma("unroll") for (int i = 0; i < 2; ++i) { int sR, sC; g8_stage_rc(t3_ * 16 + i * 8192, sR, sC); \
        _Pragma("unroll") for (int h = 0; h < 2; ++h) voffA[h][i] = S.a_off(un, h, sR) + (unsigned)sC * 2u; } } while (0)
    const size_t kstep = 128;
    const size_t hstep = (size_t)128 * K * 2;
    const unsigned ldsw = (unsigned)wid * 1024u;
    const int aoff = g8_lds_byte(wr * 64 + fr, fq * 8), boff = g8_lds_byte(wc * 32 + fr, fq * 8);
#define G8_SA(b, h) (((b) * 2 + (h)) * G8_HTB)
#define G8_SB(b, h) ((4 + (b) * 2 + (h)) * G8_HTB)
#define G8_STAGE2(bufoff, gbase, v0, v1) do { \
        __builtin_amdgcn_global_load_lds((const GAS1 unsigned*)((const char*)(gbase) + (v0)), (LAS3 unsigned*)(lds + (bufoff) + ldsw), 16, 0, 0); \
        __builtin_amdgcn_global_load_lds((const GAS1 unsigned*)((const char*)(gbase) + (v1)), (LAS3 unsigned*)(lds + (bufoff) + ldsw + 8192), 16, 0, 0); } while (0)
#define G8_STAGEB(bufoff, gbase) G8_STAGE2(bufoff, gbase, voffB[0], voffB[1])
#define G8_LDA(dst, b, h) do { _Pragma("unroll") for (int m = 0; m < 4; ++m) _Pragma("unroll") for (int k = 0; k < 2; ++k) dst[m][k] = *(const LAS3 bf16x8*)(lds + G8_SA(b, h) + aoff + m * 2048 + k * 1024); } while (0)
#define G8_LDB(dst, b, h) do { _Pragma("unroll") for (int n = 0; n < 2; ++n) _Pragma("unroll") for (int k = 0; k < 2; ++k) dst[n][k] = *(const LAS3 bf16x8*)(lds + G8_SB(b, h) + boff + n * 2048 + k * 1024); } while (0)
#define G8_MMA(ai, bj, At, Bt) do { __builtin_amdgcn_s_setprio(1); _Pragma("unroll") for (int m = 0; m < 4; ++m) _Pragma("unroll") for (int n = 0; n < 2; ++n) _Pragma("unroll") for (int k = 0; k < 2; ++k) \
        acc[ai][bj][m][n] = __builtin_amdgcn_mfma_f32_16x16x32_bf16(Bt[n][k], At[m][k], acc[ai][bj][m][n], 0, 0, 0); __builtin_amdgcn_s_setprio(0); } while (0)
#define G8_WAIT_V(n) asm volatile("s_waitcnt vmcnt(" #n ")" ::: "memory")
#define G8_WAIT_L(n) asm volatile("s_waitcnt lgkmcnt(" #n ")" ::: "memory")
#define G8_BAR __builtin_amdgcn_s_barrier()
#define G8_SCHED __builtin_amdgcn_sched_barrier(0)
    GUnit cur, nxt; int ui = 0;
    if (!S.next(0, cur)) return;
    f32x4 acc[2][2][4][2];
#pragma unroll
    for (int a = 0; a < 2; ++a)
#pragma unroll
        for (int b = 0; b < 2; ++b)
#pragma unroll
            for (int m = 0; m < 4; ++m)
#pragma unroll
                for (int n = 0; n < 2; ++n) acc[a][b][m][n] = (f32x4){0.f, 0.f, 0.f, 0.f};
    bf16x8 At[4][2], B0[2][2], B1[2][2];
    G8_AOFFS(cur);
    const char* cB = S.b_ptr(cur);
    G8_STAGEB(G8_SB(0, 0), cB); G8_STAGE2(G8_SA(0, 0), Ab, voffA[0][0], voffA[0][1]); G8_STAGEB(G8_SB(0, 1), cB + hstep); G8_STAGE2(G8_SA(0, 1), Ab, voffA[1][0], voffA[1][1]);
    if (wr == 1) G8_BAR;
    G8_WAIT_V(4); G8_BAR;
    G8_STAGEB(G8_SB(1, 0), cB + kstep); G8_STAGE2(G8_SA(1, 0), Ab + kstep, voffA[0][0], voffA[0][1]); G8_STAGEB(G8_SB(1, 1), cB + hstep + kstep);
    G8_WAIT_V(6); G8_BAR;
    for (;;) {
        const bool has_next = S.next(ui + 1, nxt);
        const char* nB = has_next ? S.b_ptr(nxt) : cB;
        for (int t = 0; t < nt; t += 2) {
            const bool last = (t == nt - 2);
            const char* a1 = Ab + (size_t)(t + 1) * kstep;
            const unsigned va10 = voffA[1][0], va11 = voffA[1][1];
            if (last && has_next) G8_AOFFS(nxt);
            const char* a2 = last ? Ab : Ab + (size_t)(t + 2) * kstep; const char* b2 = last ? nB : cB + (size_t)(t + 2) * kstep;
            const char* a3 = a2 + kstep; const char* b3 = b2 + kstep;
            G8_LDB(B0, 0, 0); G8_SCHED; G8_LDA(At, 0, 0); G8_STAGE2(G8_SA(1, 1), a1, va10, va11);
            G8_WAIT_L(8); G8_BAR; G8_WAIT_L(0); G8_MMA(0, 0, At, B0); G8_BAR; G8_SCHED;
            G8_LDB(B1, 0, 1); G8_STAGEB(G8_SB(0, 0), b2);
            G8_BAR; G8_WAIT_L(0); G8_MMA(0, 1, At, B1); G8_BAR;
            G8_LDA(At, 0, 1); G8_STAGE2(G8_SA(0, 0), a2, voffA[0][0], voffA[0][1]);
            G8_BAR; G8_WAIT_L(0); G8_MMA(1, 0, At, B0); G8_BAR; G8_SCHED;
            G8_STAGEB(G8_SB(0, 1), b2 + hstep);
            G8_WAIT_V(6); G8_BAR; G8_MMA(1, 1, At, B1); G8_BAR;
            G8_LDB(B0, 1, 0); G8_SCHED; G8_LDA(At, 1, 0); G8_STAGE2(G8_SA(0, 1), a2, voffA[1][0], voffA[1][1]);
            G8_WAIT_L(8); G8_BAR; G8_WAIT_L(0); G8_MMA(0, 0, At, B0); G8_BAR; G8_SCHED;
            G8_LDB(B1, 1, 1); G8_STAGEB(G8_SB(1, 0), b3);
            G8_BAR; G8_WAIT_L(0); G8_MMA(0, 1, At, B1); G8_BAR;
            G8_LDA(At, 1, 1); G8_STAGE2(G8_SA(1, 0), a3, voffA[0][0], voffA[0][1]);
            G8_BAR; G8_WAIT_L(0); G8_MMA(1, 0, At, B0); G8_BAR; G8_SCHED;
            G8_STAGEB(G8_SB(1, 1), b3 + hstep);
            G8_WAIT_V(6); G8_BAR; G8_MMA(1, 1, At, B1); G8_BAR;
        }
        E(acc, cur, wr, wc, fr, fq);
        if (!has_next) break;
#pragma unroll
        for (int a = 0; a < 2; ++a)
#pragma unroll
            for (int b = 0; b < 2; ++b)
#pragma unroll
                for (int m = 0; m < 4; ++m)
#pragma unroll
                    for (int n = 0; n < 2; ++n) acc[a][b][m][n] = (f32x4){0.f, 0.f, 0.f, 0.f};
        cur = nxt; cB = nB; ++ui;
    }
    G8_WAIT_V(0);
    if (wr == 0) G8_BAR;
    G8_BAR;
#undef G8_SA
#undef G8_AOFFS
#undef G8_SB
#undef G8_STAGE2
#undef G8_STAGEB
#undef G8_LDA
#undef G8_LDB
#undef G8_MMA
#undef G8_WAIT_V
#undef G8_WAIT_L
#undef G8_BAR
#undef G8_SCHED
}
struct DenseSched {
    int nM, nN, nwg, G, c, K; const char* Bt;
    __device__ __forceinline__ void init(int M, int N, int K_, const void* Bt_, int G_, int c_) { nM = M >> 8; nN = N >> 8; nwg = nM * nN; G = G_; c = c_; K = K_; Bt = (const char*)Bt_; }
    __device__ __forceinline__ bool next(int i, GUnit& u) const {
        const int L = i * G + c; if (L >= nwg) return false;
        int wgid = L; { const int q = nwg >> 3, r = nwg & 7, xcd = wgid & 7, off = wgid >> 3; wgid = (xcd < r ? xcd * (q + 1) : r * (q + 1) + (xcd - r) * q) + off; }
        const int nig = 8 * nN, gid = wgid / nig, fm = gid * 8, gsz = (nM - fm) < 8 ? (nM - fm) : 8, w = wgid - gid * nig;
        u.pn = w / gsz; u.pm = fm + (w - u.pn * gsz); return true;
    }
    __device__ __forceinline__ unsigned a_off(const GUnit& u, int h, int R) const { return (unsigned)((u.pm * 256 + h * 128 + R) * K) * 2u; }
    __device__ __forceinline__ const char* b_ptr(const GUnit& u) const { return Bt + (size_t)u.pn * 256 * K * 2; }
};

template <class SRC>
__device__ __forceinline__ void convert_wT(const float* __restrict__ W, int K, int N, u16* __restrict__ WT, int rows, SRC src, int gtid, int gnt) {
    const int kch = K >> 3;
    const int total = rows * kch;
    for (int i0 = gtid; i0 < total; i0 += 4 * gnt) {
        float f[4][8]; int sc[4];
#pragma unroll
        for (int u = 0; u < 4; u++) {
            const int i = i0 + u * gnt;
            sc[u] = -1;
            if (i < total) {
                const int kc = i / rows, j = i - kc * rows;
                sc[u] = src(j);
                if (sc[u] >= 0) {
                    const float* wp = W + (size_t)(kc * 8) * N + sc[u];
#pragma unroll
                    for (int q = 0; q < 8; q++) f[u][q] = wp[(size_t)q * N];
                }
            }
        }
#pragma unroll
        for (int u = 0; u < 4; u++) {
            const int i = i0 + u * gnt;
            if (i < total) {
                const int kc = i / rows, j = i - kc * rows;
                uint4 v = make_uint4(0u, 0u, 0u, 0u);
                if (sc[u] >= 0) { v.x = pack2(f[u][0], f[u][1]); v.y = pack2(f[u][2], f[u][3]); v.z = pack2(f[u][4], f[u][5]); v.w = pack2(f[u][6], f[u][7]); }
                *(uint4*)&WT[(size_t)j * K + kc * 8] = v;
            }
        }
    }
}

__device__ void ph_prologue(const P& p, int bid, int nb, char* smem) {
    const int tid = get_tid(), lane = tid & 63, wv = tid >> 6;
    if (bid >= 1 && bid <= 64) {
        const int j = tid & 255; const bool isv = tid >= 256;
        const float* pe = isv ? p.pe_v : p.pe_k; const float* w1 = isv ? p.w1_v : p.w1_k;
        const int kb = (bid - 1) * 32;
        float a0 = 0.f, a1 = 0.f;
#pragma unroll 4
        for (int k = kb; k < kb + 32; k += 2) { a0 += pe[k] * w1[(size_t)k * 256 + j]; a1 += pe[k + 1] * w1[(size_t)(k + 1) * 256 + j]; }
        atomicAdd(&(isv ? p.cb1v : p.cb1k)[j], a0 + a1);
    }
    if (bid == 0) {
        if (tid < 32) { p.counts[tid] = 0; p.cursor[tid] = 0; }
        for (int i = tid; i < 8 * 64; i += NT) {
            const int bg = i >> 6, d = i & 63;
            p.kcb[((size_t)bg * 512 + 511) * 64 + d] = 0;
            p.vcT[(((size_t)bg * 8 + 7) * 64 + d) * 64 + 63] = 0;
        }
    }
    {
        const int gtid = bid * NT + tid, gnt = nb * NT;
        convert_wT(p.w_in, D_, CIN, p.winT, 3328, [](int j) {
            const int t = j >> 8, s = j & 255;
            if (t < 5) {
                const int bj = s >> 7, wc = (s >> 5) & 3, n = (s >> 4) & 1, i = s & 15;
                const int dim = 32 * bj + 8 * (i >> 2) + 4 * n + (i & 3), hq = 4 * t + wc;
                int hb;
                if (hq < 8) hb = 64 * hq;
                else { const int k = (hq - 8) >> 1; hb = (k == 0 ? 512 : (k == 1 ? 640 : (k == 2 ? 768 : (k == 3 ? 1024 : (k == 4 ? 896 : 1152))))) + 64 * (hq & 1); }
                return hb + dim;
            }
            const int c = (s & ~31) + perm32(s & 31);
            if (t < 12) return 1304 + (t - 5) * 256 + c;
            return c < 24 ? 1280 + c : -1; }, gtid, gnt);
        convert_wT(p.w_in, D_, CIN, p.wgT, 2048, [](int j) { return 3096 + (j & ~31) + perm32(j & 31); }, gtid, gnt);
        convert_wT(p.wpa, 512, D_, p.wpaT, 1024, [](int j) { return (j & ~31) + perm32(j & 31); }, gtid, gnt);
        convert_wT(p.wpb, 512, D_, p.wpbT, 1024, [](int j) { return (j & ~31) + perm32(j & 31); }, gtid, gnt);
        convert_wT(p.wout, D_, D_, p.woutT, 1024, [](int j) { return j; }, gtid, gnt);
        convert_wT(p.w2, 64, 512, p.w2T, 512, [](int j) { return j; }, gtid, gnt);
        convert_wT(p.w1_k, 2048, 256, p.cw1Tk, 256, [](int j) { return j; }, gtid, gnt);
        convert_wT(p.w1_v, 2048, 256, p.cw1Tv, 256, [](int j) { return j; }, gtid, gnt);
        convert_wT(p.w2_k, 256, 64, p.cw2Tk, 128, [](int j) { return j < 64 ? j : -1; }, gtid, gnt);
        convert_wT(p.w2_v, 256, 64, p.cw2Tv, 128, [](int j) { return j < 64 ? j : -1; }, gtid, gnt);
        convert_wT(p.a2, 64, 512, p.a2T, 512, [](int j) { return j; }, gtid, gnt);
        convert_wT(p.g2, 128, 512, p.g2T, 512, [](int j) { return j; }, gtid, gnt);
    }
    for (int row = bid * NW + wv; row < NTOK; row += nb * NW) {
        const float* xr = p.x + (size_t)row * D_;
        float v[16];
        float ss = 0.f;
#pragma unroll
        for (int i = 0; i < 4; i++) {
            float4 t = *(const float4*)&xr[i * 256 + lane * 4];
            v[4 * i] = t.x; v[4 * i + 1] = t.y; v[4 * i + 2] = t.z; v[4 * i + 3] = t.w;
            ss += t.x * t.x + t.y * t.y + t.z * t.z + t.w * t.w;
        }
        ss = wave_sum(ss);
        const float rs = rsqrtf(ss * (1.f / D_) + 1e-6f);
#pragma unroll
        for (int i = 0; i < 4; i++) {
            const int c = i * 256 + lane * 4;
            float4 g = *(const float4*)&p.g_mix[c];
            uint2 o;
            o.x = pack2(v[4 * i] * rs * g.x, v[4 * i + 1] * rs * g.y);
            o.y = pack2(v[4 * i + 2] * rs * g.z, v[4 * i + 3] * rs * g.w);
            *(uint2*)&p.hbuf[(size_t)row * D_ + c] = o;
        }
    }
}

__device__ __forceinline__ uint4 pack8(const f32x4& a, const f32x4& b) { uint4 o; o.x = pack2(a[0], a[1]); o.y = pack2(a[2], a[3]); o.z = pack2(b[0], b[1]); o.w = pack2(b[2], b[3]); return o; }
struct EpiInproj {
    const P* pp;
    __device__ __forceinline__ void operator()(const f32x4 (&acc)[2][2][4][2], const GUnit& u, int, int, int, int) const {
        const int t2_ = get_tid(), wid_ = __builtin_amdgcn_readfirstlane(t2_ >> 6), wr = wid_ >> 2, wc = wid_ & 3, fr = t2_ & 15, fq = (t2_ >> 4) & 3;
        const P& p = *pp;
        const int pn = u.pn;
        const int rowb = u.pm * 256 + wr * 64;
        if (pn < 4) {
            const int hq = 4 * pn + wc;
            const bool rope = !(pn == 2 && wc >= 2);
            u16* dst; size_t rstride; int cofs;
            if (pn < 2) { dst = p.q; rstride = 512; cofs = hq * 64; }
            else { dst = (pn == 2) ? (wc < 2 ? p.kc : p.vc) : (wc < 2 ? p.ksl : p.kwn); rstride = 64; cofs = 0; }
            const int g = wc & 1;
#pragma unroll
            for (int ai = 0; ai < 2; ++ai)
#pragma unroll
                for (int m = 0; m < 4; ++m) {
                    const int row = rowb + ai * 128 + m * 16 + fr;
                    f32x4 o1[2], o2[2];
#pragma unroll
                    for (int n = 0; n < 2; ++n) { o1[n] = acc[ai][0][m][n]; o2[n] = acc[ai][1][m][n]; }
                    if (rope) {
                        const double posd = (double)p.pos[row];
#pragma unroll
                        for (int n = 0; n < 2; ++n)
#pragma unroll
                            for (int j = 0; j < 4; ++j) {
                                const double tr = posd * ROPE_FREQ[8 * fq + 4 * n + j] * 0.15915494309189535;
                                const float fr_ = (float)(tr - rint(tr));
                                const float cs = __builtin_amdgcn_cosf(fr_), sn = __builtin_amdgcn_sinf(fr_);
                                const float x1 = o1[n][j], x2 = o2[n][j];
                                o1[n][j] = x1 * cs - x2 * sn; o2[n][j] = x1 * sn + x2 * cs;
                            }
                    }
                    size_t ro;
                    if (pn < 2) {
#pragma unroll
                        for (int n = 0; n < 2; ++n)
#pragma unroll
                            for (int j = 0; j < 4; ++j) { o1[n][j] *= QSCALE; o2[n][j] *= QSCALE; }
                        ro = (size_t)row * 512 + cofs + 8 * fq;
                    } else {
                        const int bb = row >> 13, t = row & (S_ - 1);
                        ro = ((size_t)(bb * 2 + g) * S_ + t) * 64 + 8 * fq;
                    }
                    *(uint4*)&dst[ro] = pack8(o1[0], o1[1]);
                    *(uint4*)&dst[ro + 32] = pack8(o2[0], o2[1]);
                }
        } else if (pn == 4) {
            u16* dst = (wc < 2) ? p.vslT : p.vwnT;
            const int g = wc & 1;
#pragma unroll
            for (int ai = 0; ai < 2; ++ai) {
                const int r0 = rowb + ai * 128, bb = r0 >> 13, tb = r0 & (S_ - 1);
                u16* base = dst + ((size_t)(bb * 2 + g) * 128 + (tb >> 6)) * 4096;
#pragma unroll
                for (int m = 0; m < 4; ++m)
#pragma unroll
                    for (int bj = 0; bj < 2; ++bj)
#pragma unroll
                        for (int n = 0; n < 2; ++n)
#pragma unroll
                            for (int j = 0; j < 4; ++j)
                                base[(32 * bj + 8 * fq + 4 * n + j) * 64 + m * 16 + fr] = f2bf(acc[ai][bj][m][n][j]);
            }
        } else if (pn < 12) {
            const int cb = (pn - 5) * 256 + wc * 32 + 8 * fq;
#pragma unroll
            for (int ai = 0; ai < 2; ++ai)
#pragma unroll
                for (int m = 0; m < 4; ++m) {
                    const size_t ro = (size_t)(rowb + ai * 128 + m * 16 + fr) * CRW + cb;
#pragma unroll
                    for (int bj = 0; bj < 2; ++bj) *(uint4*)&p.prw[ro + bj * 128] = pack8(acc[ai][bj][m][0], acc[ai][bj][m][1]);
                }
        } else {
            if (wc == 0 && fq < 3) {
#pragma unroll
                for (int ai = 0; ai < 2; ++ai)
#pragma unroll
                    for (int m = 0; m < 4; ++m) {
                        const size_t ro = (size_t)(rowb + ai * 128 + m * 16 + fr) * 24 + 8 * fq;
#pragma unroll
                        for (int n = 0; n < 2; ++n) {
                            float4 o; o.x = sigmoidf_(acc[ai][0][m][n][0]); o.y = sigmoidf_(acc[ai][0][m][n][1]); o.z = sigmoidf_(acc[ai][0][m][n][2]); o.w = sigmoidf_(acc[ai][0][m][n][3]);
                            *(float4*)&p.nsag[ro + 4 * n] = o;
                        }
                    }
            }
        }
    }
};
__device__ void ph_inproj(const P& p, int bid, int nb, char* smem) {
    DenseSched S; S.init(NTOK, 3328, D_, p.winT, nb, bid);
    EpiInproj E{&p};
    gemm256(smem, (const char*)p.hbuf, D_, S, E);
}

__device__ __forceinline__ float gelu_tanh(float x) {
    const float c = 0.7978845608028654f;
    return 0.5f * x * (1.f + tanhf(c * (x + 0.044715f * x * x * x)));
}
__device__ void ph_compress(const P& p, int bid, int nb, char* smem) {
    u16* sm = (u16*)smem;
    const int tid = get_tid(), lane = tid & 63, wv = tid >> 6;
    const int wm = wv >> 1, wn = wv & 1;
    for (int it = bid; it < 32; it += nb) {
        const int rt = it & 1, g = (it >> 1) & 1, b = (it >> 2) & 3, kv = it >> 4;
        const int bg = b * 2 + g, i0 = rt * 256;
        const u16* src = (kv ? p.vc : p.kc) + (size_t)bg * S_ * 64;
        const u16* w1T = kv ? p.cw1Tv : p.cw1Tk;
        const u16* w2T = kv ? p.cw2Tv : p.cw2Tk;
        const float* cb1 = kv ? p.cb1v : p.cb1k;
        const float* b1 = kv ? p.b1_v : p.b1_k;
        const float* b2 = kv ? p.b2_v : p.b2_k;
        u16* hidp = p.chid + (size_t)it * 256 * 256;
        auto arow = [&](int r) { int i = i0 + r; if (i > 510) i = 510; return src + (size_t)i * 1024; };
#pragma unroll 1
        for (int ct = 0; ct < 2; ct++) {
            f32x4 acc[4][4];
            gemm_core<false>(2048, arow, w1T + (size_t)ct * 128 * 2048, 2048, acc, sm);
            const int le = get_tid() & 63;
#pragma unroll
            for (int mt = 0; mt < 4; mt++) {
                const int r = wm * 64 + mt * 16 + (le & 15);
#pragma unroll
                for (int nt = 0; nt < 4; nt++) {
                    const int col = ct * 128 + wn * 64 + nt * 16 + (le >> 4) * 4;
                    const float4 c1 = *(const float4*)&cb1[col], bb1 = *(const float4*)&b1[col];
                    f32x4 o;
                    o[0] = gelu_tanh(acc[mt][nt][0] + c1.x + bb1.x); o[1] = gelu_tanh(acc[mt][nt][1] + c1.y + bb1.y);
                    o[2] = gelu_tanh(acc[mt][nt][2] + c1.z + bb1.z); o[3] = gelu_tanh(acc[mt][nt][3] + c1.w + bb1.w);
                    *(uint2*)&hidp[r * 256 + col] = pack4(o);
                }
            }
        }
        __syncthreads();
        {
            f32x4 acc[4][4];
            gemm_core<true>(256, [&](int r) { return hidp + (size_t)r * 256; }, w2T, 256, acc, sm);
            if (wn == 0) {
#pragma unroll
                for (int mt = 0; mt < 4; mt++)
#pragma unroll
                    for (int nt = 0; nt < 4; nt++) {
                        const int d = nt * 16 + (lane & 15);
                        const int ib = i0 + wm * 64 + mt * 16 + (lane >> 4) * 4;
                        float o[4];
#pragma unroll
                        for (int j = 0; j < 4; j++) o[j] = (ib + j < NCMP) ? (acc[mt][nt][j] + b2[d]) : 0.f;
                        if (kv == 0) {
#pragma unroll
                            for (int j = 0; j < 4; j++) p.kcb[((size_t)bg * 512 + ib + j) * 64 + d] = f2bf(o[j]);
                        } else {
                            uint2 ov; ov.x = pack2(o[0], o[1]); ov.y = pack2(o[2], o[3]);
                            *(uint2*)&p.vcT[(((size_t)bg * 8 + (ib >> 6)) * 64 + d) * 64 + (ib & 63)] = ov;
                        }
                    }
            }
        }
        __syncthreads();
    }
}

#ifndef NSAPROBE
#define NSAPROBE 0
#endif
#define NSA_TS(k) if (NSAPROBE == k) ts_ = __builtin_amdgcn_s_memrealtime();
#define NSA_TE(k) if (NSAPROBE == k) tacc_ += __builtin_amdgcn_s_memrealtime() - ts_;
constexpr int KSTR = 72;
struct Sub { f32x4 O[4]; float m, l; };
#define NEG_BIG (-1.0e30f)

__device__ __forceinline__ float xq_max(float v) {
    return xrow_max(v);
}
__device__ __forceinline__ float xq_sum(float v) {
    return xrow_sum(v);
}
template <bool MASK, bool IMP, bool PV>
__device__ __forceinline__ void nsa_visit(const u16* Ks, const u16* Vs, const u16* qrow, Sub& s, int lo, int hi, int lane, float* e, float* p3) {
    const int kr = lane & 15, qq = lane >> 4;
    f32x4 S[4];
    const int qsw = ((kr & 3) >> 1) ^ ((kr >> 2) << 1);
    const bf16x8 qf0 = *(const bf16x8*)(qrow + ((qq ^ qsw) << 3)), qf1 = *(const bf16x8*)(qrow + (((4 + qq) ^ qsw) << 3));
    bf16x8 kf[4][2];
    const int swz = kr >> 1;
    {
        const char* kb_ = (const char*)Ks + kr * 128;
        const int ko0 = (qq ^ swz) << 4, ko1 = ko0 ^ 64;
#pragma unroll
        for (int kt = 0; kt < 4; kt++) { kf[kt][0] = *(const bf16x8*)(kb_ + kt * 2048 + ko0); kf[kt][1] = *(const bf16x8*)(kb_ + kt * 2048 + ko1); }
    }
    __builtin_amdgcn_sched_barrier(0);
#pragma unroll
    for (int kt = 0; kt < 4; kt++) {
        S[kt] = __builtin_amdgcn_mfma_f32_16x16x32_bf16(kf[kt][0], qf0, f32x4{0.f, 0.f, 0.f, 0.f}, 0, 0, 0);
        S[kt] = __builtin_amdgcn_mfma_f32_16x16x32_bf16(kf[kt][1], qf1, S[kt], 0, 0, 0);
    }
    union VF { bf16x8 v; uint2 h[2]; };
    float mx = NEG_BIG;
#pragma unroll
    for (int kt = 0; kt < 4; kt++)
#pragma unroll
        for (int r = 0; r < 4; r++) {
            if (MASK) { const int o = kt * 16 + qq * 4 + r; if (o < lo || o > hi) S[kt][r] = -INFINITY; }
            mx = fmaxf(mx, S[kt][r]);
        }
    mx = xq_max(mx);
    const float mnew = fmaxf(s.m, mx);
    const float alpha = __builtin_amdgcn_exp2f(s.m - mnew);
    s.m = mnew;
    float psum = 0.f;
#pragma unroll
    for (int kt = 0; kt < 4; kt++) {
#pragma unroll
        for (int r = 0; r < 4; r++) { S[kt][r] = __builtin_amdgcn_exp2f(S[kt][r] - mnew); }
        const float ee = (S[kt][0] + S[kt][1]) + (S[kt][2] + S[kt][3]);
        psum += ee;
        if (IMP) { e[kt] = ee; p3[kt] = S[kt][3]; }
    }
    s.l = s.l * alpha + psum;
    if (PV) {
        if (!__all(alpha == 1.f)) {
#pragma unroll
            for (int dt = 0; dt < 4; dt++)
#pragma unroll
                for (int r = 0; r < 4; r++) s.O[dt][r] *= alpha;
        }
        VF vf[4][2];
        {
            const char* vb_ = (const char*)Vs + kr * 128 + (qq & 1) * 8;
            const int vo = ((qq >> 1) ^ swz) << 4;
#pragma unroll
            for (int dt = 0; dt < 4; dt++)
#pragma unroll
                for (int k2 = 0; k2 < 2; k2++) {
                    vf[dt][k2].h[0] = *(const uint2*)(vb_ + dt * 2048 + (vo ^ (k2 * 64)));
                    vf[dt][k2].h[1] = *(const uint2*)(vb_ + dt * 2048 + (vo ^ (k2 * 64 + 32)));
                }
        }
        bf16x8 pb[2];
#pragma unroll
        for (int k2 = 0; k2 < 2; k2++) {
            union { bf16x8 v; unsigned u[4]; } t;
            t.u[0] = pack2(S[2 * k2][0], S[2 * k2][1]); t.u[1] = pack2(S[2 * k2][2], S[2 * k2][3]);
            t.u[2] = pack2(S[2 * k2 + 1][0], S[2 * k2 + 1][1]); t.u[3] = pack2(S[2 * k2 + 1][2], S[2 * k2 + 1][3]);
            pb[k2] = t.v;
        }
        __builtin_amdgcn_sched_barrier(0);
#pragma unroll
        for (int dt = 0; dt < 4; dt++)
#pragma unroll
            for (int k2 = 0; k2 < 2; k2++) s.O[dt] = __builtin_amdgcn_mfma_f32_16x16x32_bf16(vf[dt][k2].v, pb[k2], s.O[dt], 0, 0, 0);
    }
}
template <bool IMP, bool PV>
__device__ __forceinline__ void nsa_visit2(const u16* Ks, const u16* Vs, const u16* qrow0, const u16* qrow1, Sub (&st)[2], const int (&hi)[2], int lane, float (&e)[2][4], float (&p3)[2][4]) {
    const int kr = lane & 15, qq = lane >> 4;
    const int qsw = ((kr & 3) >> 1) ^ ((kr >> 2) << 1);
    bf16x8 qf0[2], qf1[2];
    qf0[0] = *(const bf16x8*)(qrow0 + ((qq ^ qsw) << 3)); qf1[0] = *(const bf16x8*)(qrow0 + (((4 + qq) ^ qsw) << 3));
    qf0[1] = *(const bf16x8*)(qrow1 + ((qq ^ qsw) << 3)); qf1[1] = *(const bf16x8*)(qrow1 + (((4 + qq) ^ qsw) << 3));
    bf16x8 kf[4][2];
    const int swz = kr >> 1;
    {
        const char* kb_ = (const char*)Ks + kr * 128;
        const int ko0 = (qq ^ swz) << 4, ko1 = ko0 ^ 64;
#pragma unroll
        for (int kt = 0; kt < 4; kt++) { kf[kt][0] = *(const bf16x8*)(kb_ + kt * 2048 + ko0); kf[kt][1] = *(const bf16x8*)(kb_ + kt * 2048 + ko1); }
    }
    __builtin_amdgcn_sched_barrier(0);
    f32x4 S[2][4];
#pragma unroll
    for (int kt = 0; kt < 4; kt++)
#pragma unroll
        for (int q = 0; q < 2; q++) {
            S[q][kt] = __builtin_amdgcn_mfma_f32_16x16x32_bf16(kf[kt][0], qf0[q], f32x4{0.f, 0.f, 0.f, 0.f}, 0, 0, 0);
            S[q][kt] = __builtin_amdgcn_mfma_f32_16x16x32_bf16(kf[kt][1], qf1[q], S[q][kt], 0, 0, 0);
        }
    union VF { bf16x8 v; uint2 h[2]; };
    VF vf[4][2];
    bf16x8 pb[2][2];
#pragma unroll
    for (int q = 0; q < 2; q++) {
        Sub& s = st[q];
        float mx = NEG_BIG;
#pragma unroll
        for (int kt = 0; kt < 4; kt++)
#pragma unroll
            for (int r = 0; r < 4; r++) {
                const int o = kt * 16 + qq * 4 + r; if (o > hi[q]) S[q][kt][r] = -INFINITY;
                mx = fmaxf(mx, S[q][kt][r]);
            }
        mx = xq_max(mx);
        const float mnew = fmaxf(s.m, mx);
        const float alpha = __builtin_amdgcn_exp2f(s.m - mnew);
        s.m = mnew;
        float psum = 0.f;
#pragma unroll
        for (int kt = 0; kt < 4; kt++) {
#pragma unroll
            for (int r = 0; r < 4; r++) { S[q][kt][r] = __builtin_amdgcn_exp2f(S[q][kt][r] - mnew); }
            const float ee = (S[q][kt][0] + S[q][kt][1]) + (S[q][kt][2] + S[q][kt][3]);
            psum += ee;
            if (IMP) { e[q][kt] = ee; p3[q][kt] = S[q][kt][3]; }
        }
        s.l = s.l * alpha + psum;
        if (PV) {
#pragma unroll
            for (int dt = 0; dt < 4; dt++)
#pragma unroll
                for (int r = 0; r < 4; r++) s.O[dt][r] *= alpha;
#pragma unroll
            for (int k2 = 0; k2 < 2; k2++) {
                union { bf16x8 v; unsigned u[4]; } t;
                t.u[0] = pack2(S[q][2 * k2][0], S[q][2 * k2][1]); t.u[1] = pack2(S[q][2 * k2][2], S[q][2 * k2][3]);
                t.u[2] = pack2(S[q][2 * k2 + 1][0], S[q][2 * k2 + 1][1]); t.u[3] = pack2(S[q][2 * k2 + 1][2], S[q][2 * k2 + 1][3]);
                pb[q][k2] = t.v;
            }
            if (q == 0) {
                const char* vb_ = (const char*)Vs + kr * 128 + (qq & 1) * 8;
                const int vo = ((qq >> 1) ^ swz) << 4;
#pragma unroll
                for (int dt = 0; dt < 4; dt++)
#pragma unroll
                    for (int k2 = 0; k2 < 2; k2++) {
                        vf[dt][k2].h[0] = *(const uint2*)(vb_ + dt * 2048 + (vo ^ (k2 * 64)));
                        vf[dt][k2].h[1] = *(const uint2*)(vb_ + dt * 2048 + (vo ^ (k2 * 64 + 32)));
                    }
            }
        }
    }
    if (PV) {
        __builtin_amdgcn_sched_barrier(0);
#pragma unroll
        for (int dt = 0; dt < 4; dt++)
#pragma unroll
            for (int k2 = 0; k2 < 2; k2++)
#pragma unroll
                for (int q = 0; q < 2; q++) st[q].O[dt] = __builtin_amdgcn_mfma_f32_16x16x32_bf16(vf[dt][k2].v, pb[q][k2], st[q].O[dt], 0, 0, 0);
    }
}
template <int MMODE, bool FIXM, int NQ>
__device__ __forceinline__ void nsa_visit_gn(const u16* Ks, const u16* Vs, const u16* qs, float* Os, float* Ms, float* Ls, const int (&tok)[NQ], const bool (&valid)[NQ], int lane) {
    const int kr = lane & 15, qq = lane >> 4, hh = kr & 3;
    int row[NQ], osw[NQ]; float* orow[NQ];
    f32x4 O[NQ][4]; float m_old[NQ], l_old[NQ]; bf16x8 qf0[NQ], qf1[NQ];
#pragma unroll
    for (int q = 0; q < NQ; q++) {
        row[q] = tok[q] * 4 + hh; orow[q] = Os + row[q] * 64;
        osw[q] = hh ^ ((tok[q] & 3) << 2);
#pragma unroll
        for (int dt = 0; dt < 4; dt++) O[q][dt] = *(const f32x4*)(orow[q] + (((dt * 4 + qq) ^ osw[q]) << 2));
        m_old[q] = Ms[row[q]]; l_old[q] = Ls[row[q]];
        const u16* qrow = qs + row[q] * 64;
        const int qsw = (hh >> 1) ^ ((tok[q] & 3) << 1);
        qf0[q] = *(const bf16x8*)(qrow + ((qq ^ qsw) << 3)); qf1[q] = *(const bf16x8*)(qrow + (((4 + qq) ^ qsw) << 3));
    }
    bf16x8 kf[4][2];
    const int swz = kr >> 1;
    {
        const char* kb_ = (const char*)Ks + kr * 128;
        const int ko0 = (qq ^ swz) << 4, ko1 = ko0 ^ 64;
#pragma unroll
        for (int kt = 0; kt < 4; kt++) { kf[kt][0] = *(const bf16x8*)(kb_ + kt * 2048 + ko0); kf[kt][1] = *(const bf16x8*)(kb_ + kt * 2048 + ko1); }
    }
    __builtin_amdgcn_sched_barrier(0);
    f32x4 S[NQ][4];
#pragma unroll
    for (int kt = 0; kt < 4; kt++)
#pragma unroll
        for (int q = 0; q < NQ; q++) {
            S[q][kt] = __builtin_amdgcn_mfma_f32_16x16x32_bf16(kf[kt][0], qf0[q], f32x4{0.f, 0.f, 0.f, 0.f}, 0, 0, 0);
            S[q][kt] = __builtin_amdgcn_mfma_f32_16x16x32_bf16(kf[kt][1], qf1[q], S[q][kt], 0, 0, 0);
        }
    union VF { bf16x8 v; uint2 h[2]; };
    VF vf[4][2];
#define NSA_LDV { const char* vb_ = (const char*)Vs + kr * 128 + (qq & 1) * 8; const int vo = ((qq >> 1) ^ swz) << 4; \
        _Pragma("unroll") for (int dt = 0; dt < 4; dt++) _Pragma("unroll") for (int k2 = 0; k2 < 2; k2++) { \
            vf[dt][k2].h[0] = *(const uint2*)(vb_ + dt * 2048 + (vo ^ (k2 * 64))); vf[dt][k2].h[1] = *(const uint2*)(vb_ + dt * 2048 + (vo ^ (k2 * 64 + 32))); } }
    if (NQ == 1) NSA_LDV
    bf16x8 pb[NQ][2];
#pragma unroll
    for (int q = 0; q < NQ; q++) {
        float mx = NEG_BIG;
#pragma unroll
        for (int kt = 0; kt < 4; kt++)
#pragma unroll
            for (int r = 0; r < 4; r++) {
                if (MMODE == 1) { const int o = kt * 16 + qq * 4 + r; if (o > tok[q]) S[q][kt][r] = -INFINITY; }
                if (MMODE == 2) { const int o = kt * 16 + qq * 4 + r; if (o <= tok[q]) S[q][kt][r] = -INFINITY; }
                if (FIXM) { if (!valid[q]) S[q][kt][r] = -INFINITY; } else mx = fmaxf(mx, S[q][kt][r]);
            }
        float mnew = m_old[q], alpha = 1.f;
        if (!FIXM) {
            if (!valid[q]) mx = NEG_BIG;
            mx = xq_max(mx);
            mnew = fmaxf(m_old[q], mx);
            alpha = __builtin_amdgcn_exp2f(m_old[q] - mnew);
        }
        float psum = 0.f;
#pragma unroll
        for (int kt = 0; kt < 4; kt++) {
#pragma unroll
            for (int r = 0; r < 4; r++) { S[q][kt][r] = __builtin_amdgcn_exp2f(S[q][kt][r] - mnew); }
            psum += (S[q][kt][0] + S[q][kt][1]) + (S[q][kt][2] + S[q][kt][3]);
        }
        psum = xq_sum(psum);
        if (FIXM) { if (valid[q] && qq == 0) Ls[row[q]] = l_old[q] + psum; }
        else {
            if (valid[q] && qq == 0) { Ms[row[q]] = mnew; Ls[row[q]] = l_old[q] * alpha + psum; }
#pragma unroll
            for (int dt = 0; dt < 4; dt++)
#pragma unroll
                for (int r = 0; r < 4; r++) O[q][dt][r] *= alpha;
        }
#pragma unroll
        for (int k2 = 0; k2 < 2; k2++) {
            union { bf16x8 v; unsigned u[4]; } t;
            t.u[0] = pack2(S[q][2 * k2][0], S[q][2 * k2][1]); t.u[1] = pack2(S[q][2 * k2][2], S[q][2 * k2][3]);
            t.u[2] = pack2(S[q][2 * k2 + 1][0], S[q][2 * k2 + 1][1]); t.u[3] = pack2(S[q][2 * k2 + 1][2], S[q][2 * k2 + 1][3]);
            pb[q][k2] = t.v;
        }
        if (NQ == 2 && q == 0) { asm volatile("" ::: "memory"); NSA_LDV }
    }
#undef NSA_LDV
    __builtin_amdgcn_sched_barrier(0);
#pragma unroll
    for (int dt = 0; dt < 4; dt++)
#pragma unroll
        for (int k2 = 0; k2 < 2; k2++)
#pragma unroll
            for (int q = 0; q < NQ; q++) O[q][dt] = __builtin_amdgcn_mfma_f32_16x16x32_bf16(vf[dt][k2].v, pb[q][k2], O[q][dt], 0, 0, 0);
#pragma unroll
    for (int q = 0; q < NQ; q++)
        if (valid[q]) {
#pragma unroll
            for (int dt = 0; dt < 4; dt++) *(f32x4*)(orow[q] + (((dt * 4 + qq) ^ osw[q]) << 2)) = O[q][dt];
        }
}
template <int MMODE, bool FIXM>
__device__ __forceinline__ void nsa_visit_g(const u16* Ks, const u16* Vs, const u16* qs, float* Os, float* Ms, float* Ls, int tok, bool valid, int lane) {
    const int tk[1] = {tok}; const bool vl[1] = {valid};
    nsa_visit_gn<MMODE, FIXM, 1>(Ks, Vs, qs, Os, Ms, Ls, tk, vl, lane);
}
__device__ __forceinline__ void nsa_fold_lds(float* Os, float* Ms, float* Ls, int row, int qq, int hh, f32x4 (&T)[4], float gate, bool reset) {
    const float lt = Ls[row];
    const float sc = (lt > 0.f) ? gate / lt : 0.f;
#pragma unroll
    for (int dt = 0; dt < 4; dt++) {
        float* op = Os + row * 64 + (((dt * 4 + qq) ^ hh ^ (((row >> 2) & 3) << 2)) << 2);
        const f32x4 o = *(const f32x4*)op;
#pragma unroll
        for (int r = 0; r < 4; r++) T[dt][r] += o[r] * sc;
        if (reset) *(f32x4*)op = f32x4{0.f, 0.f, 0.f, 0.f};
    }
    asm volatile("s_waitcnt lgkmcnt(0)" ::: "memory");
    if (reset && qq == 0) { Ms[row] = NEG_BIG; Ls[row] = 0.f; }
}
template <int MODE>
__device__ __forceinline__ void nsa_fold(Sub& s, f32x4 (&T)[4], float gate) {
    const float lt = xq_sum(s.l);
    const float sc = (lt > 0.f) ? gate / lt : 0.f;
#pragma unroll
    for (int dt = 0; dt < 4; dt++)
#pragma unroll
        for (int r = 0; r < 4; r++) {
            const float v = s.O[dt][r] * sc;
            T[dt][r] = (MODE == 1) ? T[dt][r] + v : v;
            s.O[dt][r] = 0.f;
        }
    s.m = NEG_BIG; s.l = 0.f;
}

constexpr int NSA_R = 3;
template <bool HASV, class KSrc, class VSrc, class Body>
__device__ __forceinline__ void nsa_stream(char* ring, int n, KSrc ksrc, VSrc vsrc, Body body) {
    const int t = get_tid();
    const int so = (t >> 3) * 64 + (((t & 7) ^ ((t >> 4) & 7)) << 3);
    char* dl = ring + t * 16;
#define NSA_ISSUE(i, slot) { glds16(ksrc(i) + so, dl + (slot) * 16384); if (HASV) glds16(vsrc(i) + so, dl + (slot) * 16384 + 8192); }
    asm volatile("s_waitcnt lgkmcnt(0)" ::: "memory");
    __builtin_amdgcn_s_barrier();
    if (n > 0) NSA_ISSUE(0, 0)
    if (n > 1) NSA_ISSUE(1, 1)
    int slot = 0;
    for (int i = 0; i < n; i++) {
        if (i + 1 < n) { if (HASV) asm volatile("s_waitcnt vmcnt(2)" ::: "memory"); else asm volatile("s_waitcnt vmcnt(1)" ::: "memory"); }
        else asm volatile("s_waitcnt vmcnt(0)" ::: "memory");
        asm volatile("s_waitcnt lgkmcnt(0)" ::: "memory");
        __builtin_amdgcn_s_barrier();
        asm volatile("" ::: "memory");
        const int sl2 = (slot == 0) ? 2 : slot - 1;
        if (i + 2 < n) NSA_ISSUE(i + 2, sl2)
        body(i, (const u16*)(ring + slot * 16384), (const u16*)(ring + slot * 16384 + 8192));
        slot = (slot == 2) ? 0 : slot + 1;
    }
#undef NSA_ISSUE
}
#define NSA_TOK(u) const int t3_ = get_tid(); const size_t ntk_ = (size_t)b * S_ + t0 + 8 * (t3_ >> 6) + 4 * (u) + ((t3_ & 15) >> 2); const int hd_ = g * 4 + (t3_ & 3);
__device__ void ph_nsa(const P& p, int bid, int nb, char* smem) {
    char* ring = smem;
    unsigned* selm = (unsigned*)(smem + NSA_R * 16384);
    int* blist = (int*)(selm + 256);
    int* nlistp = blist + 128;
    int* lcnt = nlistp + 4;
    unsigned char* lists = (unsigned char*)(lcnt + 128);
    float* Ms = (float*)(lists + 128 * 64);
    float* Ls = Ms + 256;
    float* Os = Ls + 256;
    float* impl = Os;
    u16* qs = (u16*)(Os + 64 * 4 * 64);
    unsigned long long ts_ = 0, tacc_ = 0;
    const int nitems = B_ * 2 * 128;
    for (int rr = 0;; rr++) {
        const int it = (rr & 1) ? (rr + 1) * nb - 1 - bid : rr * nb + bid;
        if (rr * nb >= nitems) break;
        if (it >= nitems) continue;
        const int tid = get_tid(), lane = tid & 63, wv = tid >> 6;
        const int kr = lane & 15, qq = lane >> 4, ts = kr >> 2, hh = kr & 3;
        float* myimp = impl + wv * (32 * 2 * 16);
        const int tt = 127 - (it >> 3);
        const int bg = it & 7, b = bg >> 1, g = bg & 1;
        const int t0 = tt * 64, cur = tt;
        const int head = g * 4 + hh;
        Sub st[2];
        f32x4 T[2][4];
        int tl[2]; size_t ntok[2];
        __syncthreads();
#pragma unroll
        for (int u = 0; u < 2; u++) {
            tl[u] = 8 * wv + 4 * u + ts;
            ntok[u] = (size_t)b * S_ + t0 + tl[u];
#pragma unroll
            for (int ks = 0; ks < 2; ks++) *(bf16x8*)&qs[(tl[u] * 4 + hh) * 64 + (((ks * 4 + qq) ^ (hh >> 1) ^ ((tl[u] & 3) << 1)) << 3)] = *(const bf16x8*)&p.q[ntok[u] * 512 + head * 64 + ks * 32 + qq * 8];
#pragma unroll
            for (int dt = 0; dt < 4; dt++) st[u].O[dt] = f32x4{0.f, 0.f, 0.f, 0.f};
            st[u].m = NEG_BIG; st[u].l = 0.f;
        }
        const u16* kcb = p.kcb + (size_t)bg * 512 * 64;
        const u16* vcT = p.vcT + (size_t)bg * 8 * 4096;
        int nv[2];
#pragma unroll
        for (int u = 0; u < 2; u++) { const int t = t0 + tl[u]; nv[u] = (t >= 31) ? min((t - 31) / 16 + 1, NCMP) : 0; }
        const int tmax = t0 + 63;
        const int nvmax = (tmax >= 31) ? min((tmax - 31) / 16 + 1, NCMP) : 0;
        const int nvb = (nvmax + 63) >> 6;
        NSA_TS(1)
        __syncthreads();
        nsa_stream<false>(ring, nvb, [&](int kb) { return kcb + (size_t)kb * 4096; }, [&](int kb) { return vcT + (size_t)kb * 4096; },
            [&](int kb, const u16* Ks, const u16* Vs) {
                const int hi2[2] = {nv[0] - kb * 64 - 1, nv[1] - kb * 64 - 1};
                float e_[2][4], p3_[2][4];
                nsa_visit2<false, false>(Ks, Vs, qs + (tl[0] * 4 + hh) * 64, qs + (tl[1] * 4 + hh) * 64, st, hi2, lane, e_, p3_);
            });
        float invl[2];
#pragma unroll
        for (int u = 0; u < 2; u++) { const float lt = xq_sum(st[u].l); invl[u] = (lt > 0.f) ? 1.f / lt : 0.f; st[u].l = 0.f; }
        float carry[2] = {0.f, 0.f};
        nsa_stream<true>(ring, nvb, [&](int kb) { return kcb + (size_t)kb * 4096; }, [&](int kb) { return vcT + (size_t)kb * 4096; },
            [&](int kb, const u16* Ks, const u16* Vs) {
            const int hi2[2] = {nv[0] - kb * 64 - 1, nv[1] - kb * 64 - 1};
            float e_[2][4], p3_[2][4];
            nsa_visit2<true, true>(Ks, Vs, qs + (tl[0] * 4 + hh) * 64, qs + (tl[1] * 4 + hh) * 64, st, hi2, lane, e_, p3_);
#pragma unroll
            for (int u = 0; u < 2; u++) {
#pragma unroll
                for (int kt = 0; kt < 4; kt++) {
                    float ev = e_[u][kt] * invl[u], pv = p3_[u][kt] * invl[u];
                    ev += dppf<0xB1>(ev); ev += dppf<0x4E>(ev);
                    pv += dppf<0xB1>(pv); pv += dppf<0x4E>(pv);
                    const float sh = __shfl(pv, (lane - 16) & 63, 64);
                    const float nbv = (qq == 0) ? carry[u] : sh;
                    carry[u] = sh;
                    myimp[((kb * 4 + kt) * 2 + u) * 16 + ts * 4 + qq] = ev + nbv;
                }
            }
            });
        NSA_TE(1)
        NSA_TS(2)
#pragma unroll
        for (int u = 0; u < 2; u++) {
            float mv[8];
#pragma unroll
            for (int i = 0; i < 8; i++) {
                const int kk = 8 * hh + i, j = 4 * kk + qq;
                const float v = myimp[(kk * 2 + u) * 16 + ts * 4 + qq];
                mv[i] = (j >= 1 && j <= cur - 2) ? v : -1.f;
            }
            unsigned sel = 0u;
            const int ncand = max(0, cur - 2);
            const int nforced = (cur >= 2) ? 3 : (cur + 1);
            const int need = 16 - nforced;
            if (ncand <= need) {
#pragma unroll
                for (int i = 0; i < 8; i++) if (mv[i] >= 0.f) sel |= (1u << i);
            } else {
                for (int rnd = 0; rnd < need; rnd++) {
                    const float b01 = fmaxf(mv[0], mv[1]), b23 = fmaxf(mv[2], mv[3]), b45 = fmaxf(mv[4], mv[5]), b67 = fmaxf(mv[6], mv[7]);
                    float best = fmaxf(fmaxf(b01, b23), fmaxf(b45, b67));
                    int bi = 7;
#pragma unroll
                    for (int i = 6; i >= 0; i--) bi = (mv[i] == best) ? i : bi;
                    int bj = (best >= 0.f) ? (4 * (8 * hh + bi) + qq) : 9999;
#define TK_MERGE(ov, oj) { const float v2_ = (ov); const int j2_ = (oj); const bool tk_ = (v2_ > best) || (v2_ == best && j2_ < bj); best = tk_ ? v2_ : best; bj = tk_ ? j2_ : bj; }
                    TK_MERGE(dppf<0xB1>(best), __builtin_amdgcn_update_dpp(0, bj, 0xB1, 0xF, 0xF, true))
                    TK_MERGE(dppf<0x4E>(best), __builtin_amdgcn_update_dpp(0, bj, 0x4E, 0xF, 0xF, true))
                    {
                        auto rv = __builtin_amdgcn_permlane16_swap(__float_as_uint(best), __float_as_uint(best), false, false);
                        auto rj = __builtin_amdgcn_permlane16_swap((unsigned)bj, (unsigned)bj, false, false);
                        float v0 = __uint_as_float(rv[0]), v1 = __uint_as_float(rv[1]); int j0 = (int)rj[0], j1 = (int)rj[1];
                        if (v1 > v0 || (v1 == v0 && j1 < j0)) { v0 = v1; j0 = j1; }
                        rv = __builtin_amdgcn_permlane32_swap(__float_as_uint(v0), __float_as_uint(v0), false, false);
                        rj = __builtin_amdgcn_permlane32_swap((unsigned)j0, (unsigned)j0, false, false);
                        best = __uint_as_float(rv[0]); bj = (int)rj[0];
                        const float v2 = __uint_as_float(rv[1]); const int j2 = (int)rj[1];
                        if (v2 > best || (v2 == best && j2 < bj)) { best = v2; bj = j2; }
                    }
#undef TK_MERGE
                    const bool mine = (bj < 512) && ((bj >> 5) == hh) && ((bj & 3) == qq);
                    const int li = (bj >> 2) & 7;
#pragma unroll
                    for (int i = 0; i < 8; i++) mv[i] = (mine && li == i) ? -1.f : mv[i];
                    if (mine) sel |= (1u << li);
                }
            }
            if (qq == 0 && hh == 0) sel |= 1u;
            if ((cur & 3) == qq && (cur >> 5) == hh) sel |= (1u << ((cur >> 2) & 7));
            if (cur >= 1 && ((cur - 1) & 3) == qq && ((cur - 1) >> 5) == hh) sel |= (1u << (((cur - 1) >> 2) & 7));
            unsigned w = sel << (8 * hh);
            w |= (unsigned)__builtin_amdgcn_update_dpp(0, (int)w, 0xB1, 0xF, 0xF, true);
            w |= (unsigned)__builtin_amdgcn_update_dpp(0, (int)w, 0x4E, 0xF, 0xF, true);
            if (hh == 0) selm[tl[u] * 4 + qq] = w;
        }
        NSA_TE(2)
        NSA_TS(3)
        __syncthreads();
#pragma unroll
        for (int u = 0; u < 2; u++) { NSA_TOK(u) nsa_fold<0>(st[u], T[u], p.nsag[ntk_ * 24 + hd_ * 3 + 0]); }
        {
            const int t2 = get_tid();
#pragma unroll
            for (int i = 0; i < 8; i++) *(f32x4*)&Os[(i * NT + t2) * 4] = f32x4{0.f, 0.f, 0.f, 0.f};
            if (t2 < 256) { Ms[t2] = NEG_BIG; Ls[t2] = 0.f; }
            unsigned long long tm = 0ull; int lrank = 0;
            if (t2 < 128) {
                const int j = t2;
                for (int tk = 0; tk < 64; tk++) tm |= (unsigned long long)((selm[tk * 4 + (j & 3)] >> (j >> 2)) & 1u) << tk;
                if (j > cur) tm = 0ull;
                const unsigned long long bal = __ballot(tm != 0ull);
                lrank = __popcll(bal & ((1ull << (t2 & 63)) - 1ull));
                if ((t2 & 63) == 0) nlistp[t2 >> 6] = __popcll(bal);
            }
            __syncthreads();
            if (t2 < 128 && tm != 0ull) {
                const int pos = lrank + ((t2 >= 64) ? nlistp[0] : 0);
                blist[pos] = t2; lcnt[pos] = __popcll(tm);
                int c = 0;
                while (tm) { lists[pos * 64 + c] = (unsigned char)(__ffsll((long long)tm) - 1); c++; tm &= tm - 1ull; }
            }
            __syncthreads();
        }
        const int nlist = nlistp[0] + nlistp[1];
        NSA_TE(3)
        NSA_TS(4)
        const u16* ksl = p.ksl + (size_t)bg * S_ * 64;
        const u16* vslT = p.vslT + (size_t)bg * 128 * 4096;
        {
            const int t4 = get_tid(), wv4 = __builtin_amdgcn_readfirstlane(t4 >> 6), ts4 = (t4 & 15) >> 2;
            const int td = t4 & 255;
            const int so = (td >> 3) * 64 + (((td & 7) ^ ((td >> 4) & 7)) << 3);
            char* dl = ring + td * 16;
#define NSA_RI(i) (nlist - 1 - (i))
#define NSA_ISSUE2(i, slot) if (wv4 >= 4) { const int jj_ = blist[NSA_RI(i)]; const u16* kp_ = ksl + (size_t)jj_ * 4096 + so; const u16* vp_ = vslT + (size_t)jj_ * 4096 + so; char* d_ = dl + (slot) * 16384; \
                glds16(kp_, d_); glds16(kp_ + 2048, d_ + 4096); glds16(vp_, d_ + 8192); glds16(vp_ + 2048, d_ + 12288); }
            asm volatile("s_waitcnt lgkmcnt(0)" ::: "memory");
            __builtin_amdgcn_s_barrier();
            if (nlist > 0) NSA_ISSUE2(0, 0)
            if (nlist > 1) NSA_ISSUE2(1, 1)
            int jn = 0, nn = 0, tokn = 0;
            if (nlist > 0) { jn = blist[NSA_RI(0)]; nn = lcnt[NSA_RI(0)]; tokn = lists[NSA_RI(0) * 64 + wv4 * 4 + ts4]; }
            int slot = 0;
            for (int i = 0; i < nlist; i++) {
                if (i + 1 < nlist) asm volatile("s_waitcnt vmcnt(4)" ::: "memory"); else asm volatile("s_waitcnt vmcnt(0)" ::: "memory");
                asm volatile("s_waitcnt lgkmcnt(0)" ::: "memory");
                __builtin_amdgcn_s_barrier();
                asm volatile("" ::: "memory");
                const int sl2 = (slot == 0) ? 2 : slot - 1;
                if (i + 2 < nlist) NSA_ISSUE2(i + 2, sl2)
                const int j = jn, n = nn, tok0 = tokn;
                if (i + 1 < nlist) { jn = blist[NSA_RI(i + 1)]; nn = lcnt[NSA_RI(i + 1)]; tokn = lists[NSA_RI(i + 1) * 64 + wv4 * 4 + ts4]; }
                const u16* Ks = (const u16*)(ring + slot * 16384); const u16* Vs = Ks + 4096;
                if ((wv4 + NW) * 4 < n) {
                    const int e1 = (wv4 + NW) * 4 + ts4;
                    const bool vl2[2] = {true, e1 < n};
                    const int tk2[2] = {tok0, vl2[1] ? (int)lists[NSA_RI(i) * 64 + (e1 & 63)] : 0};
                    if (j == cur) nsa_visit_gn<1, false, 2>(Ks, Vs, qs, Os, Ms, Ls, tk2, vl2, t4 & 63);
                    else nsa_visit_gn<0, true, 2>(Ks, Vs, qs, Os, Ms, Ls, tk2, vl2, t4 & 63);
                } else if (wv4 * 4 < n) {
                    const int e = wv4 * 4 + ts4;
                    const bool valid = e < n;
                    const int tok = valid ? tok0 : 0;
                    if (j == cur) nsa_visit_g<1, false>(Ks, Vs, qs, Os, Ms, Ls, tok, valid, t4 & 63);
                    else nsa_visit_g<0, true>(Ks, Vs, qs, Os, Ms, Ls, tok, valid, t4 & 63);
                }
                slot = (slot == 2) ? 0 : slot + 1;
            }
#undef NSA_RI
#undef NSA_ISSUE2
        }
        __syncthreads();
        NSA_TE(4)
        NSA_TS(5)
#pragma unroll
        for (int u = 0; u < 2; u++) {
            NSA_TOK(u)
            const int t5 = t3_ & 63;
            nsa_fold_lds(Os, Ms, Ls, (8 * (t3_ >> 6) + 4 * u + ((t5 & 15) >> 2)) * 4 + (t5 & 3), t5 >> 4, t5 & 3, T[u], p.nsag[ntk_ * 24 + hd_ * 3 + 1], true);
        }
        const u16* kwn = p.kwn + (size_t)bg * S_ * 64;
        const u16* vwnT = p.vwnT + (size_t)bg * 128 * 4096;
        uint2 Tp[2][4];
#pragma unroll
        for (int u = 0; u < 2; u++)
#pragma unroll
            for (int dt = 0; dt < 4; dt++) { Tp[u][dt] = pack4(T[u][dt]); asm volatile("" : "+v"(Tp[u][dt].x), "+v"(Tp[u][dt].y)); }
        {
            const int jlo = max(0, cur - 8);
            nsa_stream<true>(ring, cur - jlo + 1, [&](int i) { return kwn + (size_t)(cur - i) * 4096; }, [&](int i) { return vwnT + (size_t)(cur - i) * 4096; },
                [&](int i, const u16* Ks, const u16* Vs) {
                    const int j = cur - i;
                    const int t4 = get_tid();
                    const int tb_ = 8 * (t4 >> 6) + ((t4 & 15) >> 2);
                    const int tk2[2] = {tb_, tb_ + 4}; const bool vl2[2] = {true, true};
                    if (j == cur) nsa_visit_gn<1, false, 2>(Ks, Vs, qs, Os, Ms, Ls, tk2, vl2, t4 & 63);
                    else if (j == cur - 8) nsa_visit_gn<2, true, 2>(Ks, Vs, qs, Os, Ms, Ls, tk2, vl2, t4 & 63);
                    else nsa_visit_gn<0, true, 2>(Ks, Vs, qs, Os, Ms, Ls, tk2, vl2, t4 & 63);
                });
        }
#pragma unroll
        for (int u = 0; u < 2; u++) {
            NSA_TOK(u)
#pragma unroll
            for (int dt = 0; dt < 4; dt++) T[u][dt] = unpack4(Tp[u][dt]);
            { const int t5 = t3_ & 63; nsa_fold_lds(Os, Ms, Ls, (8 * (t3_ >> 6) + 4 * u + ((t5 & 15) >> 2)) * 4 + (t5 & 3), t5 >> 4, t5 & 3, T[u], p.nsag[ntk_ * 24 + hd_ * 3 + 2], false); }
#pragma unroll
            for (int dt = 0; dt < 4; dt++) *(uint2*)&p.oa[ntk_ * 512 + hd_ * 64 + dt * 16 + ((t3_ & 63) >> 4) * 4] = pack4(T[u][dt]);
        }
        NSA_TE(5)
    }
    if (NSAPROBE) { __syncthreads(); const unsigned long long t1_ = __builtin_amdgcn_s_memrealtime(); while (__builtin_amdgcn_s_memrealtime() - t1_ < tacc_) __builtin_amdgcn_s_sleep(8); }
}

constexpr int RS = 72;
constexpr int RSLOT = 64 * RS;
__device__ __forceinline__ void mm64(const u16* A, int lda, const u16* Bz, int ldb, f32x4 (&acc)[2], int lane, int wv) {
    const int mt = wv >> 1, nt0 = (wv & 1) * 2, kr = lane & 15, qq = lane >> 4;
    bf16x8 a[2], b[2][2];
#pragma unroll
    for (int ks = 0; ks < 2; ks++) {
        a[ks] = *(const bf16x8*)&A[(mt * 16 + kr) * lda + ks * 32 + qq * 8];
#pragma unroll
        for (int i = 0; i < 2; i++) b[ks][i] = *(const bf16x8*)&Bz[((nt0 + i) * 16 + kr) * ldb + ks * 32 + qq * 8];
    }
#pragma unroll
    for (int ks = 0; ks < 2; ks++)
#pragma unroll
        for (int i = 0; i < 2; i++) acc[i] = __builtin_amdgcn_mfma_f32_16x16x32_bf16(a[ks], b[ks][i], acc[i], 0, 0, 0);
}
__device__ __forceinline__ void st_t(u16* dst, int ld, const f32x4& v, int mt, int nt, int lane) {
    uint2 o; o.x = pack2(v[0], v[1]); o.y = pack2(v[2], v[3]);
    *(uint2*)&dst[(nt * 16 + (lane & 15)) * ld + mt * 16 + (lane >> 4) * 4] = o;
}
__device__ __forceinline__ void st_n(u16* dst, int ld, const f32x4& v, int mt, int nt, int lane) {
#pragma unroll
    for (int r = 0; r < 4; r++) dst[(mt * 16 + (lane >> 4) * 4 + r) * ld + nt * 16 + (lane & 15)] = f2bf(v[r]);
}
#define ZACC(a) { a[0] = f32x4{0.f, 0.f, 0.f, 0.f}; a[1] = f32x4{0.f, 0.f, 0.f, 0.f}; }

__device__ void ph_rwkv_chunk(const P& p, int bid, int nb, char* smem) {
    u16* sl = (u16*)smem;
    float* tot = (float*)(sl + 14 * RSLOT);
    float* gl = tot + 512;
#define RW_IDX const int tid = get_tid(), lane = tid & 63, wv = tid >> 6, mt = wv >> 1, nt0 = (wv & 1) * 2, kr = lane & 15, qq = lane >> 4; (void)mt; (void)nt0; (void)kr; (void)qq; (void)lane;
    const int nitems = B_ * 128;
    for (int it0 = bid; it0 < nitems; it0 += nb) {
      const int c = it0 & 127, b = it0 >> 7;
      const size_t n0 = (size_t)b * S_ + c * 64;
      __syncthreads();
      {
          RW_IDX
          const int t = tid >> 3, part = tid & 7;
          const size_t n = n0 + t;
          const bool hasprev = (c * 64 + t) > 0;
          u16* dst = p.xact + n * 256 + part * 32;
#pragma unroll
          for (int j = 0; j < 4; j++) {
              const int col = 1536 + part * 32 + j * 8;
              const uint4 cu = *(const uint4*)&p.prw[n * CRW + col];
              uint4 pv = make_uint4(0u, 0u, 0u, 0u);
              if (hasprev) pv = *(const uint4*)&p.prw[(n - 1) * CRW + col];
              const unsigned cw[4] = {cu.x, cu.y, cu.z, cu.w}, pw[4] = {pv.x, pv.y, pv.z, pv.w};
              unsigned ow[4];
#pragma unroll
              for (int e2 = 0; e2 < 4; e2++) {
                  float x0 = __uint_as_float(cw[e2] << 16), x1 = __uint_as_float(cw[e2] & 0xFFFF0000u);
                  const float q0 = __uint_as_float(pw[e2] << 16), q1 = __uint_as_float(pw[e2] & 0xFFFF0000u);
                  x0 = x0 + (q0 - x0) * p.mu[col + 2 * e2]; x1 = x1 + (q1 - x1) * p.mu[col + 2 * e2 + 1];
                  if (part < 2) { x0 = tanhf(x0); x1 = tanhf(x1); }
                  else if (part >= 4) { x0 = sigmoidf_(x0); x1 = sigmoidf_(x1); }
                  ow[e2] = pack2(x0, x1);
              }
              *(uint4*)&dst[j * 8] = make_uint4(ow[0], ow[1], ow[2], ow[3]);
          }
      }
      __syncthreads();
      const u16* xa = p.xact + n0 * 256;
#pragma unroll 1
      for (int h = 0; h < 8; h++) {
        u16* cd = p.cdat + ((size_t)((b * 8 + h) * 128 + c)) * 4 * 4096;
        LDS_BARRIER();
        float* LW = (float*)(sl + 8 * RSLOT); float* LA = (float*)(sl + 10 * RSLOT);
        {
            RW_IDX
            bf16x8 xa_[8], wb[2][2], ab[2][2], gb[2][4];
#pragma unroll
            for (int k8 = 0; k8 < 8; k8++) xa_[k8] = *(const bf16x8*)&xa[(mt * 16 + kr) * 256 + k8 * 32 + qq * 8];
#pragma unroll
            for (int i = 0; i < 2; i++) {
                const int cc = (nt0 + i) * 16 + kr;
#pragma unroll
                for (int ks = 0; ks < 2; ks++) {
                    wb[i][ks] = *(const bf16x8*)&p.w2T[((size_t)h * 64 + cc) * 64 + ks * 32 + qq * 8];
                    ab[i][ks] = *(const bf16x8*)&p.a2T[((size_t)h * 64 + cc) * 64 + ks * 32 + qq * 8];
                }
#pragma unroll
                for (int ks = 0; ks < 4; ks++) gb[i][ks] = *(const bf16x8*)&p.g2T[((size_t)h * 64 + cc) * 128 + ks * 32 + qq * 8];
            }
            f32x4 aw[2], aa2[2], ag[2];
#pragma unroll
            for (int i = 0; i < 2; i++) {
                aw[i] = f32x4{0.f, 0.f, 0.f, 0.f}; aa2[i] = aw[i]; ag[i] = aw[i];
#pragma unroll
                for (int ks = 0; ks < 2; ks++) {
                    aw[i] = __builtin_amdgcn_mfma_f32_16x16x32_bf16(xa_[ks], wb[i][ks], aw[i], 0, 0, 0);
                    aa2[i] = __builtin_amdgcn_mfma_f32_16x16x32_bf16(xa_[2 + ks], ab[i][ks], aa2[i], 0, 0, 0);
                }
#pragma unroll
                for (int ks = 0; ks < 4; ks++) ag[i] = __builtin_amdgcn_mfma_f32_16x16x32_bf16(xa_[4 + ks], gb[i][ks], ag[i], 0, 0, 0);
            }
#pragma unroll
            for (int i = 0; i < 2; i++)
#pragma unroll
                for (int r = 0; r < 4; r++) {
                    const int t = mt * 16 + qq * 4 + r, cc = (nt0 + i) * 16 + kr;
                    const float wl = p.w0[h * 64 + cc] + aw[i][r];
                    const float z = -wl;
                    const float sp = fmaxf(z, 0.f) + log1pf(__expf(-fabsf(z)));
                    LW[t * 64 + cc] = -__expf(-sp - 0.5f);
                    LA[t * 64 + cc] = sigmoidf_(p.a0[h * 64 + cc] + aa2[i][r]);
                    p.ob[(n0 + t) * 512 + h * 64 + cc] = f2bf(ag[i][r]);
                }
        }
        LDS_BARRIER();
        {
            RW_IDX
            const int ch = h * 64 + lane;
            const float mur = p.mu[ch], muk = p.mu[512 + ch], muv = p.mu[1024 + ch];
            const float kkw = p.k_k[ch], kaw = p.k_a[ch], rkw = p.r_k[ch];
            float rr[8], k2[8], vv[8], kkn[8], aa[8], lg[8], cs[8];
            float run = 0.f;
#pragma unroll
            for (int i = 0; i < 8; i++) {
                const int t = wv * 8 + i; const size_t n = n0 + t;
                const u16* cr = p.prw + n * CRW;
                float r = bf2f(cr[ch]), k = bf2f(cr[512 + ch]), v = bf2f(cr[1024 + ch]);
                float pr = 0.f, pk = 0.f, pv = 0.f;
                if (c * 64 + t > 0) { const u16* pp = cr - CRW; pr = bf2f(pp[ch]); pk = bf2f(pp[512 + ch]); pv = bf2f(pp[1024 + ch]); }
                r = r + (pr - r) * mur; k = k + (pk - k) * muk; v = v + (pv - v) * muv;
                const float a = LA[t * 64 + lane];
                lg[i] = LW[t * 64 + lane];
                float kk = k * kkw;
                const float nrm = fmaxf(sqrtf(wave_sum(kk * kk)), 1e-12f);
                kkn[i] = kk / nrm;
                k2[i] = k * (1.f + (a - 1.f) * kaw);
                const float bon = wave_sum(r * k2[i] * rkw);
                if (lane == 0) p.bon[n * 8 + h] = bon;
                rr[i] = r; vv[i] = v; aa[i] = a;
                run += lg[i]; cs[i] = run;
            }
            tot[wv * 64 + lane] = run;
            LDS_BARRIER();
            float off = 0.f, cumL = 0.f;
#pragma unroll
            for (int w2 = 0; w2 < 8; w2++) { const float tv = tot[w2 * 64 + lane]; cumL += tv; if (w2 < wv) off += tv; }
            if (wv == 0) gl[lane] = __expf(cumL);
            unsigned pa[4], pb[4], pk4[4], pv4[4];
#pragma unroll
            for (int i = 0; i < 8; i += 2) {
                float at[2], bt[2], kt[2], rt[2];
#pragma unroll
                for (int e2 = 0; e2 < 2; e2++) {
                    const int ii = i + e2; const int t = wv * 8 + ii;
                    const float cm = off + cs[ii];
                    const float g = __expf(cm), gp = __expf(cm - lg[ii]), gi = __expf(-cm);
                    at[e2] = -kkn[ii] * gp; bt[e2] = kkn[ii] * aa[ii] * gi; kt[e2] = k2[ii] * gi; rt[e2] = rr[ii] * g;
                    sl[0 * RSLOT + t * RS + lane] = f2bf(at[e2]);
                    sl[1 * RSLOT + t * RS + lane] = f2bf(bt[e2]);
                    sl[2 * RSLOT + t * RS + lane] = f2bf(kt[e2]);
                    sl[3 * RSLOT + t * RS + lane] = f2bf(rt[e2]);
                }
                pa[i >> 1] = pack2(at[0], at[1]); pb[i >> 1] = pack2(bt[0], bt[1]);
                pk4[i >> 1] = pack2(kt[0], kt[1]); pv4[i >> 1] = pack2(vv[i], vv[i + 1]);
            }
            *(uint4*)&sl[4 * RSLOT + lane * RS + wv * 8] = make_uint4(pa[0], pa[1], pa[2], pa[3]);
            *(uint4*)&sl[5 * RSLOT + lane * RS + wv * 8] = make_uint4(pb[0], pb[1], pb[2], pb[3]);
            *(uint4*)&sl[6 * RSLOT + lane * RS + wv * 8] = make_uint4(pk4[0], pk4[1], pk4[2], pk4[3]);
            *(uint4*)&sl[7 * RSLOT + lane * RS + wv * 8] = make_uint4(pv4[0], pv4[1], pv4[2], pv4[3]);
        }
        LDS_BARRIER();
        {
            RW_IDX
            f32x4 acc[2];
            ZACC(acc); mm64(sl + 1 * RSLOT, RS, sl + 0 * RSLOT, RS, acc, lane, wv);
#pragma unroll
            for (int i = 0; i < 2; i++) {
                f32x4 pm;
#pragma unroll
                for (int r = 0; r < 4; r++) {
                    const int m = mt * 16 + qq * 4 + r, n = (nt0 + i) * 16 + kr;
                    if (!(m < n)) acc[i][r] = 0.f;
                    pm[r] = acc[i][r] + ((m == n) ? 1.f : 0.f);
                }
                st_t(sl + 8 * RSLOT, RS, acc[i], mt, nt0 + i, lane);
                st_n(sl + 9 * RSLOT, RS, acc[i], mt, nt0 + i, lane);
                st_t(sl + 13 * RSLOT, RS, pm, mt, nt0 + i, lane);
            }
            ZACC(acc); mm64(sl + 0 * RSLOT, RS, sl + 2 * RSLOT, RS, acc, lane, wv);
#pragma unroll
            for (int i = 0; i < 2; i++) {
#pragma unroll
                for (int r = 0; r < 4; r++) { const int m = mt * 16 + qq * 4 + r, n = (nt0 + i) * 16 + kr; if (!(m > n)) acc[i][r] = 0.f; }
                st_t(sl + 10 * RSLOT, RS, acc[i], mt, nt0 + i, lane);
            }
            ZACC(acc); mm64(sl + 1 * RSLOT, RS, sl + 3 * RSLOT, RS, acc, lane, wv);
#pragma unroll
            for (int i = 0; i < 2; i++) {
#pragma unroll
                for (int r = 0; r < 4; r++) { const int m = mt * 16 + qq * 4 + r, n = (nt0 + i) * 16 + kr; if (m > n) acc[i][r] = 0.f; }
                st_t(sl + 11 * RSLOT, RS, acc[i], mt, nt0 + i, lane);
            }
            ZACC(acc); mm64(sl + 2 * RSLOT, RS, sl + 3 * RSLOT, RS, acc, lane, wv);
#pragma unroll
            for (int i = 0; i < 2; i++) {
#pragma unroll
                for (int r = 0; r < 4; r++) { const int m = mt * 16 + qq * 4 + r, n = (nt0 + i) * 16 + kr; if (m > n) acc[i][r] = 0.f; }
                st_t(sl + 12 * RSLOT, RS, acc[i], mt, nt0 + i, lane);
            }
        }
        LDS_BARRIER();
        u16* X = sl + 8 * RSLOT; u16* XT = sl + 9 * RSLOT; u16* X2 = sl + 0 * RSLOT; u16* X2T = sl + 1 * RSLOT;
        u16* Pc = sl + 13 * RSLOT; u16* Pn = sl + 2 * RSLOT;
#pragma unroll 1
        for (int j = 1; j <= 6; j++) {
            RW_IDX
            f32x4 acc[2];
            if (j <= 5) {
                ZACC(acc); mm64(X, RS, XT, RS, acc, lane, wv);
#pragma unroll
                for (int i = 0; i < 2; i++) { st_t(X2T, RS, acc[i], mt, nt0 + i, lane); st_n(X2, RS, acc[i], mt, nt0 + i, lane); }
            }
            if (j >= 2) {
                ZACC(acc); mm64(XT, RS, Pc, RS, acc, lane, wv);
#pragma unroll
                for (int i = 0; i < 2; i++) {
                    const uint2 pv = *(const uint2*)&Pc[((nt0 + i) * 16 + kr) * RS + mt * 16 + qq * 4];
                    acc[i][0] += __uint_as_float(pv.x << 16); acc[i][1] += __uint_as_float(pv.x & 0xFFFF0000u);
                    acc[i][2] += __uint_as_float(pv.y << 16); acc[i][3] += __uint_as_float(pv.y & 0xFFFF0000u);
                    st_t(Pn, RS, acc[i], mt, nt0 + i, lane);
                }
            }
            LDS_BARRIER();
            if (j >= 2) { u16* tp = Pc; Pc = Pn; Pn = tp; }
            if (j <= 5) { u16* tx = X; X = X2; X2 = tx; tx = XT; XT = X2T; X2T = tx; }
        }
        u16* TT = Pc;
        {
            RW_IDX
            f32x4 acc[2];
            ZACC(acc); mm64(TT, RS, sl + 4 * RSLOT, RS, acc, lane, wv);
#pragma unroll
            for (int i = 0; i < 2; i++) st_t(sl + 0 * RSLOT, RS, acc[i], mt, nt0 + i, lane);
            ZACC(acc); mm64(sl + 10 * RSLOT, RS, TT, RS, acc, lane, wv);
#pragma unroll
            for (int i = 0; i < 2; i++) st_t(sl + 8 * RSLOT, RS, acc[i], mt, nt0 + i, lane);
        }
        LDS_BARRIER();
        {
            RW_IDX
            f32x4 acc[2];
            ZACC(acc); mm64(sl + 8 * RSLOT, RS, sl + 7 * RSLOT, RS, acc, lane, wv);
#pragma unroll
            for (int i = 0; i < 2; i++) st_t(sl + 9 * RSLOT, RS, acc[i], mt, nt0 + i, lane);
            ZACC(acc); mm64(sl + 0 * RSLOT, RS, sl + 5 * RSLOT, RS, acc, lane, wv);
#pragma unroll
            for (int i = 0; i < 2; i++) {
                const int n = (nt0 + i) * 16 + kr; const float gn = gl[n];
#pragma unroll
                for (int r = 0; r < 4; r++) { const int m = mt * 16 + qq * 4 + r; acc[i][r] = acc[i][r] * gn + ((m == n) ? gn : 0.f); }
                st_t(cd, 64, acc[i], mt, nt0 + i, lane);
            }
            ZACC(acc); mm64(sl + 0 * RSLOT, RS, sl + 11 * RSLOT, RS, acc, lane, wv);
#pragma unroll
            for (int i = 0; i < 2; i++) {
                const uint2 rv = *(const uint2*)&sl[3 * RSLOT + ((nt0 + i) * 16 + kr) * RS + mt * 16 + qq * 4];
                acc[i][0] += __uint_as_float(rv.x << 16); acc[i][1] += __uint_as_float(rv.x & 0xFFFF0000u);
                acc[i][2] += __uint_as_float(rv.y << 16); acc[i][3] += __uint_as_float(rv.y & 0xFFFF0000u);
                st_t(cd + 2 * 4096, 64, acc[i], mt, nt0 + i, lane);
            }
        }
        LDS_BARRIER();
        {
            RW_IDX
            f32x4 acc[2];
            ZACC(acc);
            mm64(sl + 5 * RSLOT, RS, sl + 9 * RSLOT, RS, acc, lane, wv);
            mm64(sl + 6 * RSLOT, RS, sl + 7 * RSLOT, RS, acc, lane, wv);
#pragma unroll
            for (int i = 0; i < 2; i++) {
#pragma unroll
                for (int r = 0; r < 4; r++) acc[i][r] *= gl[mt * 16 + qq * 4 + r];
                st_t(cd + 1 * 4096, 64, acc[i], mt, nt0 + i, lane);
            }
            ZACC(acc);
            mm64(sl + 9 * RSLOT, RS, sl + 11 * RSLOT, RS, acc, lane, wv);
            mm64(sl + 7 * RSLOT, RS, sl + 12 * RSLOT, RS, acc, lane, wv);
#pragma unroll
            for (int i = 0; i < 2; i++) st_t(cd + 3 * 4096, 64, acc[i], mt, nt0 + i, lane);
        }
      }
    }
}

__device__ void ph_rwkv_seq(const P& p, int bid, int nb, char* smem) {
    u16* SL = (u16*)smem;
    const int tid = get_tid(), lane = tid & 63, wv = __builtin_amdgcn_readfirstlane(tid >> 6);
    const int kr = lane & 15, qq = lane >> 4, chn = wv >> 2, vt = wv & 3;
    for (int pair = bid; pair < B_ * 4; pair += nb) {
        const int bh = pair * 2 + chn;
        u16* mySL = SL + chn * RSLOT;
        __syncthreads();
#pragma unroll
        for (int ks = 0; ks < 2; ks++) *(uint4*)&mySL[(vt * 16 + kr) * RS + ks * 32 + qq * 8] = make_uint4(0u, 0u, 0u, 0u);
        u16* cbase = p.cdat + (size_t)bh * 128 * 4 * 4096;
        bf16x8 GA0[4][2], GA1[4][2], GA2[4][2], GA3[4][2]; uint2 H0[4], H1[4], H2[4], H3[4];
#define SEQ_LD(GAx, Hx, c) { const u16* cd_ = cbase + (size_t)(c) * 4 * 4096; \
            _Pragma("unroll") for (int m4 = 0; m4 < 4; m4++) { \
                _Pragma("unroll") for (int ks = 0; ks < 2; ks++) GAx[m4][ks] = *(const bf16x8*)&cd_[(m4 * 16 + kr) * 64 + ks * 32 + qq * 8]; \
                Hx[m4] = *(const uint2*)&cd_[1 * 4096 + (vt * 16 + kr) * 64 + m4 * 16 + qq * 4]; } }
#define SEQ_STEP(GAx, Hx, c) { \
            bf16x8 Z0[2]; \
            _Pragma("unroll") for (int ks = 0; ks < 2; ks++) Z0[ks] = *(const bf16x8*)&mySL[(vt * 16 + kr) * RS + ks * 32 + qq * 8]; \
            f32x4 zs[4]; \
            _Pragma("unroll") for (int m4 = 0; m4 < 4; m4++) { \
                zs[m4] = unpack4(Hx[m4]); \
                _Pragma("unroll") for (int ks = 0; ks < 2; ks++) zs[m4] = __builtin_amdgcn_mfma_f32_16x16x32_bf16(GAx[m4][ks], Z0[ks], zs[m4], 0, 0, 0); } \
            u16* sn_ = cbase + (size_t)(c) * 4 * 4096 + 1 * 4096 + (vt * 16 + kr) * 64 + qq * 4; \
            _Pragma("unroll") for (int m4 = 0; m4 < 4; m4++) { \
                const uint2 pk_ = pack4(zs[m4]); \
                *(uint2*)&mySL[(vt * 16 + kr) * RS + m4 * 16 + qq * 4] = pk_; \
                *(uint2*)&sn_[m4 * 16] = pk_; } \
            if ((c) + 4 < 128) SEQ_LD(GAx, Hx, (c) + 4) }
        SEQ_LD(GA0, H0, 0) SEQ_LD(GA1, H1, 1) SEQ_LD(GA2, H2, 2) SEQ_LD(GA3, H3, 3)
#pragma unroll 1
        for (int c = 0; c < 128; c += 4) {
            SEQ_STEP(GA0, H0, c)
            SEQ_STEP(GA1, H1, c + 1)
            SEQ_STEP(GA2, H2, c + 2)
            SEQ_STEP(GA3, H3, c + 3)
        }
#undef SEQ_LD
#undef SEQ_STEP
    }
}

__device__ void ph_rwkv_out(const P& p, int bid, int nb, char* smem) {
    const int tid = get_tid(), lane = tid & 63, wv = tid >> 6;
    const int kr = lane & 15, qq = lane >> 4;
    for (int it = bid * NW + wv; it < B_ * 8 * 128; it += nb * NW) {
        const int c = it & 127, bh = it >> 7, b = bh >> 3, h = bh & 7;
        const u16* cd = p.cdat + ((size_t)bh * 128 + c) * 4 * 4096;
        f32x4 ys[4][4];
#pragma unroll
        for (int mt = 0; mt < 4; mt++)
#pragma unroll
            for (int nt = 0; nt < 4; nt++) ys[mt][nt] = unpack4(*(const uint2*)&cd[3 * 4096 + (nt * 16 + kr) * 64 + mt * 16 + qq * 4]);
        if (c > 0) {
            const u16* s0 = cd - 4 * 4096 + 1 * 4096;
#pragma unroll
            for (int ks = 0; ks < 2; ks++) {
                bf16x8 af[4], bq[4];
#pragma unroll
                for (int mt = 0; mt < 4; mt++) af[mt] = *(const bf16x8*)&s0[(mt * 16 + kr) * 64 + ks * 32 + qq * 8];
#pragma unroll
                for (int nt = 0; nt < 4; nt++) bq[nt] = *(const bf16x8*)&cd[2 * 4096 + (nt * 16 + kr) * 64 + ks * 32 + qq * 8];
#pragma unroll
                for (int mt = 0; mt < 4; mt++)
#pragma unroll
                    for (int nt = 0; nt < 4; nt++) ys[mt][nt] = __builtin_amdgcn_mfma_f32_16x16x32_bf16(af[mt], bq[nt], ys[mt][nt], 0, 0, 0);
            }
        }
#pragma unroll
        for (int nt = 0; nt < 4; nt++) {
            float s1 = 0.f, s2 = 0.f;
#pragma unroll
            for (int mt = 0; mt < 4; mt++)
#pragma unroll
                for (int r = 0; r < 4; r++) { s1 += ys[mt][nt][r]; s2 += ys[mt][nt][r] * ys[mt][nt][r]; }
            s1 = xrow_sum(s1); s2 = xrow_sum(s2);
            const float mean = s1 * (1.f / 64.f);
            const float var = fmaxf(s2 * (1.f / 64.f) - mean * mean, 0.f);
            const float rstd = rsqrtf(var + 64e-5f);
            const int t = nt * 16 + kr;
            const size_t n = (size_t)b * S_ + c * 64 + t;
            const float bon = p.bon[n * 8 + h];
#pragma unroll
            for (int mt = 0; mt < 4; mt++) {
                const int vch = h * 64 + mt * 16 + qq * 4;
                const f32x4 vcf = unpack4(*(const uint2*)&p.prw[n * CRW + 1024 + vch]);
                const f32x4 vpf = (c * 64 + t > 0) ? unpack4(*(const uint2*)&p.prw[(n - 1) * CRW + 1024 + vch]) : f32x4{0.f, 0.f, 0.f, 0.f};
                const f32x4 ggf = unpack4(*(const uint2*)&p.ob[n * 512 + vch]);
                const float4 lw = *(const float4*)&p.ln_w[vch], lb = *(const float4*)&p.ln_b[vch], mv = *(const float4*)&p.mu[1024 + vch];
                const float lwa[4] = {lw.x, lw.y, lw.z, lw.w}, lba[4] = {lb.x, lb.y, lb.z, lb.w}, mva[4] = {mv.x, mv.y, mv.z, mv.w};
                f32x4 o;
#pragma unroll
                for (int r = 0; r < 4; r++) {
                    const float vsh = vcf[r] + (vpf[r] - vcf[r]) * mva[r];
                    o[r] = ((ys[mt][nt][r] - mean) * rstd * lwa[r] + lba[r] + bon * vsh) * ggf[r];
                }
                *(uint2*)&p.ob[n * 512 + vch] = pack4(o);
            }
        }
    }
}

__device__ __forceinline__ void unpack8(const uint4& u, f32x4& a, f32x4& b) {
    a = f32x4{__uint_as_float(u.x << 16), __uint_as_float(u.x & 0xFFFF0000u), __uint_as_float(u.y << 16), __uint_as_float(u.y & 0xFFFF0000u)};
    b = f32x4{__uint_as_float(u.z << 16), __uint_as_float(u.z & 0xFFFF0000u), __uint_as_float(u.w << 16), __uint_as_float(u.w & 0xFFFF0000u)};
}
struct EpiMerge {
    u16* merged; u16* tmp2; int pass;
    __device__ __forceinline__ void operator()(const f32x4 (&acc)[2][2][4][2], const GUnit& u, int, int, int, int) const {
        const int t2_ = get_tid(), wid_ = __builtin_amdgcn_readfirstlane(t2_ >> 6), wr = wid_ >> 2, wc = wid_ & 3, fr = t2_ & 15, fq = (t2_ >> 4) & 3;
        const int row0 = u.pm * 256 + wr * 64 + fr, col0 = u.pn * 256 + wc * 32 + 8 * fq;
#pragma unroll
        for (int ai = 0; ai < 2; ++ai)
#pragma unroll
            for (int m = 0; m < 4; ++m) {
                const size_t off = (size_t)(row0 + ai * 128 + m * 16) * D_ + col0;
                uint4 m1[2], m2[2];
                if (pass == 1 || pass == 3) {
#pragma unroll
                    for (int bj = 0; bj < 2; ++bj) { m1[bj] = *(const uint4*)&merged[off + bj * 128]; if (pass == 3) m2[bj] = *(const uint4*)&tmp2[off + bj * 128]; }
                }
#pragma unroll
                for (int bj = 0; bj < 2; ++bj) {
                    f32x4 v0 = acc[ai][bj][m][0], v1 = acc[ai][bj][m][1];
                    if (pass == 1) { f32x4 a0, a1; unpack8(m1[bj], a0, a1);
#pragma unroll
                        for (int r = 0; r < 4; r++) { v0[r] = a0[r] * sigmoidf_(v0[r]); v1[r] = a1[r] * sigmoidf_(v1[r]); } }
                    if (pass == 3) { f32x4 a0, a1, b0, b1; unpack8(m1[bj], a0, a1); unpack8(m2[bj], b0, b1);
#pragma unroll
                        for (int r = 0; r < 4; r++) { v0[r] = a0[r] + b0[r] * sigmoidf_(v0[r]); v1[r] = a1[r] + b1[r] * sigmoidf_(v1[r]); } }
                    *(uint4*)&((pass == 2) ? tmp2 : merged)[off + bj * 128] = pack8(v0, v1);
                }
                asm volatile("" ::: "memory");
            }
    }
};
__device__ void ph_merge(const P& p, int bid, int nb, char* smem) {
    u16* tmp2 = (u16*)p.x1;
#pragma unroll 1
    for (int pass = 0; pass < 4; ++pass) {
        const int K = (pass & 1) ? D_ : 512;
        const u16* A = (pass & 1) ? p.hbuf : (pass == 0 ? p.oa : p.ob);
        const u16* Bt = (pass == 0) ? p.wpaT : (pass == 1 ? p.wgT : (pass == 2 ? p.wpbT : p.wgT + (size_t)1024 * D_));
        DenseSched S; S.init(NTOK, D_, K, Bt, nb, bid);
        EpiMerge E{p.merged, tmp2, pass};
        gemm256(smem, (const char*)A, K, S, E);
    }
}

struct EpiOutproj {
    const float* x; float* x1;
    __device__ __forceinline__ void operator()(const f32x4 (&acc)[2][2][4][2], const GUnit& u, int, int, int, int) const {
        const int t2_ = get_tid(), wid_ = __builtin_amdgcn_readfirstlane(t2_ >> 6), wr = wid_ >> 2, wc = wid_ & 3, fr = t2_ & 15, fq = (t2_ >> 4) & 3;
        const int row0 = u.pm * 256 + wr * 64 + fr, col0 = u.pn * 256 + wc * 32 + 4 * fq;
#pragma unroll
        for (int ai = 0; ai < 2; ++ai)
#pragma unroll
            for (int m = 0; m < 4; ++m) {
                const size_t off = (size_t)(row0 + ai * 128 + m * 16) * D_ + col0;
                f32x4 xin[2][2];
#pragma unroll
                for (int bj = 0; bj < 2; ++bj)
#pragma unroll
                    for (int n = 0; n < 2; ++n) xin[bj][n] = *(const f32x4*)&x[off + bj * 128 + n * 16];
#pragma unroll
                for (int bj = 0; bj < 2; ++bj)
#pragma unroll
                    for (int n = 0; n < 2; ++n) *(f32x4*)&x1[off + bj * 128 + n * 16] = xin[bj][n] + acc[ai][bj][m][n];
                asm volatile("" ::: "memory");
            }
    }
};
__device__ void ph_outproj(const P& p, int bid, int nb, char* smem) {
    DenseSched S; S.init(NTOK, D_, D_, p.woutT, nb, bid);
    EpiOutproj E{p.x, p.x1};
    gemm256(smem, (const char*)p.merged, D_, S, E);
}

__device__ __forceinline__ float red8f(float x) {
    x += dppf<0xB1>(x);
    x += dppf<0x4E>(x);
    x += dppf<0x141>(x);
    return x;
}
__device__ void ph_route(const P& p, int bid, int nb, char* smem) {
    float* wr = (float*)smem;
    const int tid = get_tid(), lane = tid & 63, wv = tid >> 6;
    {
        u16* Tl = (u16*)smem;
        const int t = get_tid();
        const int lrow = t >> 3, lc8 = (t & 7) * 8;
        const int sslot = t >> 3, skc = t & 7;
        const int scol = (sslot & 32) + perm32(sslot & 31);
        constexpr int NT13 = NEXP * 2 * 4 * 16, NT2 = NEXP * 16 * 4;
        for (int tile = bid; tile < NT13 + NT2; tile += nb) {
            const float* src; u16* dst; int N, Kd;
            if (tile < NT13) {
                const int kt = tile & 15, sg = (tile >> 4) & 3, half = (tile >> 6) & 1, e = tile >> 7;
                const int sl0 = sg * 64;
                N = 256; Kd = D_;
                src = ((sl0 >> 7) ? p.e_w3 : p.e_w1) + (size_t)e * D_ * 256 + (size_t)(kt * 64) * 256 + half * 128 + (sl0 & 127);
                dst = p.ew1T + ((size_t)e * 512 + half * 256 + sl0) * D_ + kt * 64;
            } else {
                const int t2 = tile - NT13;
                const int kt = t2 & 3, sg = (t2 >> 2) & 15, e = t2 >> 6;
                N = D_; Kd = 256;
                src = p.e_w2 + (size_t)e * 256 * D_ + (size_t)(kt * 64) * D_ + sg * 64;
                dst = p.ew2T + ((size_t)e * D_ + sg * 64) * 256 + kt * 64;
            }
            const float4 f0 = *(const float4*)&src[(size_t)lrow * N + lc8], f1 = *(const float4*)&src[(size_t)lrow * N + lc8 + 4];
            __syncthreads();
            const unsigned h0 = pack2(f0.x, f0.y), h1 = pack2(f0.z, f0.w), h2 = pack2(f1.x, f1.y), h3 = pack2(f1.z, f1.w);
            Tl[(lc8 + 0) * 72 + lrow] = (u16)(h0 & 0xFFFFu); Tl[(lc8 + 1) * 72 + lrow] = (u16)(h0 >> 16);
            Tl[(lc8 + 2) * 72 + lrow] = (u16)(h1 & 0xFFFFu); Tl[(lc8 + 3) * 72 + lrow] = (u16)(h1 >> 16);
            Tl[(lc8 + 4) * 72 + lrow] = (u16)(h2 & 0xFFFFu); Tl[(lc8 + 5) * 72 + lrow] = (u16)(h2 >> 16);
            Tl[(lc8 + 6) * 72 + lrow] = (u16)(h3 & 0xFFFFu); Tl[(lc8 + 7) * 72 + lrow] = (u16)(h3 >> 16);
            __syncthreads();
            *(uint4*)&dst[(size_t)sslot * Kd + skc * 8] = *(const uint4*)&Tl[scol * 72 + skc * 8];
        }
        __syncthreads();
    }
    for (int i = tid; i < 1024 * 36; i += NT) {
        const int k = i / 36, j = i - k * 36;
        const int kp = (k & ~31) + ((k & 3) << 3) + ((k >> 2) & 7);
        wr[kp * 36 + j] = (j < 4) ? p.w_grp[k * 4 + j] : p.w_exp[k * 32 + (j - 4)];
    }
    int* lcount = (int*)(smem + 1024 * 36 * 4);
    if (tid < 32) lcount[tid] = 0;
    __syncthreads();
    const int sub = lane & 7, tk = lane >> 3;
    for (int n0 = (bid * NW + wv) * 16; n0 < NTOK; n0 += nb * NW * 16) {
        float acc[2][36]; float ss[2] = {0.f, 0.f};
#pragma unroll
        for (int t = 0; t < 2; t++)
#pragma unroll
            for (int j = 0; j < 36; j++) acc[t][j] = 0.f;
#pragma unroll 1
        for (int i0 = 0; i0 < 32; i0 += 4) {
            float4 xv[2][4];
#pragma unroll
            for (int t = 0; t < 2; t++)
#pragma unroll
                for (int i = 0; i < 4; i++) xv[t][i] = *(const float4*)&p.x1[(size_t)(n0 + 8 * t + tk) * D_ + (i0 + i) * 32 + sub * 4];
#pragma unroll
            for (int i = 0; i < 4; i++) {
                const int k0 = (i0 + i) * 32 + sub * 4;
                const float4 gf = *(const float4*)&p.g_ffn[k0];
                float hv[2][4];
#pragma unroll
                for (int t = 0; t < 2; t++) {
                    const float4 x = xv[t][i];
                    ss[t] += x.x * x.x + x.y * x.y + x.z * x.z + x.w * x.w;
                    hv[t][0] = x.x * gf.x; hv[t][1] = x.y * gf.y; hv[t][2] = x.z * gf.z; hv[t][3] = x.w * gf.w;
                    uint2 o; o.x = pack2(hv[t][0], hv[t][1]); o.y = pack2(hv[t][2], hv[t][3]);
                    *(uint2*)&p.hbuf[(size_t)(n0 + 8 * t + tk) * D_ + k0] = o;
                }
#pragma unroll
                for (int e2 = 0; e2 < 4; e2++) {
                    asm volatile("" ::: "memory");
                    const float* wrow = wr + ((i0 + i) * 32 + e2 * 8 + sub) * 36;
#pragma unroll
                    for (int j4 = 0; j4 < 9; j4++) {
                        const float4 wv4 = *(const float4*)&wrow[j4 * 4];
#pragma unroll
                        for (int t = 0; t < 2; t++) {
                            acc[t][j4 * 4 + 0] += hv[t][e2] * wv4.x; acc[t][j4 * 4 + 1] += hv[t][e2] * wv4.y;
                            acc[t][j4 * 4 + 2] += hv[t][e2] * wv4.z; acc[t][j4 * 4 + 3] += hv[t][e2] * wv4.w;
                        }
                    }
                }
            }
        }
#pragma unroll
        for (int t = 0; t < 2; t++) {
            const size_t n = (size_t)n0 + 8 * t + tk;
            const float sst = red8f(ss[t]);
#pragma unroll
            for (int j = 0; j < 36; j++) acc[t][j] = red8f(acc[t][j]);
            const float rs = rsqrtf(sst * (1.f / D_) + 1e-6f);
            if (sub == 0) {
                p.rsb[n] = rs;
                float gl[4]; int gs = 0;
#pragma unroll
                for (int j = 0; j < 4; j++) gl[j] = acc[t][j] * rs + p.b_grp[j];
                float gm = gl[0];
#pragma unroll
                for (int j = 1; j < 4; j++) if (gl[j] > gm) { gm = gl[j]; gs = j; }
                float gsum = 0.f;
#pragma unroll
                for (int j = 0; j < 4; j++) gsum += __expf(gl[j] - gm);
                const float pg = 1.f / gsum;
                float el[8]; float em = -3.0e38f;
#pragma unroll
                for (int j = 0; j < 8; j++) {
                    float a = (gs == 0) ? acc[t][4 + j] : ((gs == 1) ? acc[t][12 + j] : ((gs == 2) ? acc[t][20 + j] : acc[t][28 + j]));
                    a = a * rs + p.b_exp[gs * 8 + j];
                    el[j] = a; em = fmaxf(em, a);
                }
                int j0 = 0, j1 = -1; float v0 = -3.0e38f, v1 = -3.0e38f;
#pragma unroll
                for (int j = 0; j < 8; j++) { el[j] = __expf(el[j] - em); }
#pragma unroll
                for (int j = 0; j < 8; j++) { if (el[j] > v0) { v0 = el[j]; j0 = j; } }
#pragma unroll
                for (int j = 0; j < 8; j++) { if (j != j0 && el[j] > v1) { v1 = el[j]; j1 = j; } }
                const float den = v0 + v1;
                const int e0 = gs * 8 + j0, e1 = gs * 8 + j1;
                p.tok_e[n * 2] = e0; p.tok_e[n * 2 + 1] = e1;
                p.tok_gate[n * 2] = pg * v0 / den; p.tok_gate[n * 2 + 1] = pg * v1 / den;
                atomicAdd(&lcount[e0], 1); atomicAdd(&lcount[e1], 1);
            }
        }
    }
    __syncthreads();
    { const int t2 = get_tid(); if (t2 < 32) { const int c = lcount[t2]; if (c) atomicAdd(&p.counts[t2], c); } }
}

__device__ void ph_scatter(const P& p, int bid, int nb, char* smem) {
    int* offl = (int*)smem;
    int* hist = offl + 64;
    int* gbase = hist + 32;
    const int tid = get_tid();
    if (tid == 0) {
        int off = 0;
        for (int e = 0; e < NEXP; e++) { offl[e] = off; off += p.counts[e]; }
        offl[NEXP] = off;
    }
    if (bid == 0 && tid == 64) {
        int off = 0, nb_ = 0;
        for (int e = 0; e < NEXP; e++) {
            const int c = p.counts[e];
            p.offs[e] = off;
            for (int r = 0; r < c; r += 256) { p.blk_e[nb_] = e; p.blk_r0[nb_] = off + r; nb_++; }
            off += c;
        }
        p.offs[NEXP] = off;
        *p.nblk = nb_;
    }
    for (int base = bid * NT; base < NTOK * 2; base += nb * NT) {
        __syncthreads();
        if (tid < 32) hist[tid] = 0;
        __syncthreads();
        const int i = base + tid;
        const int e = p.tok_e[i];
        const int rl = atomicAdd(&hist[e], 1);
        __syncthreads();
        if (tid < 32) gbase[tid] = atomicAdd(&p.cursor[tid], hist[tid]);
        __syncthreads();
        const int slot = offl[e] + gbase[e] + rl;
        p.list_tok[slot] = i >> 1; p.list_gate[slot] = p.tok_gate[i]; p.tokslot[i] = slot;
    }
}
template <int CTS>
struct MoeSched {
    const P* pp; int nunits, G, c; unsigned rowbytes; const u16* Bt; size_t b_estride, b_tstride;
    bool gather;
    __device__ __forceinline__ bool next(int i, GUnit& u) const {
        const int L = i * G + c; if (L >= nunits) return false;
        int wgid = L; { const int q = nunits >> 3, r = nunits & 7, xcd = wgid & 7, off = wgid >> 3; wgid = (xcd < r ? xcd * (q + 1) : r * (q + 1) + (xcd - r) * q) + off; }
        u.pm = wgid / CTS; u.pn = wgid & (CTS - 1); return true;
    }
    __device__ __forceinline__ unsigned a_off(const GUnit& u, int h, int R) const {
        const P& p = *pp;
        const int e = __builtin_amdgcn_readfirstlane(p.blk_e[u.pm]), rend = __builtin_amdgcn_readfirstlane(p.offs[e + 1]);
        int sl = __builtin_amdgcn_readfirstlane(p.blk_r0[u.pm]) + h * 128 + R; if (sl >= rend) sl = rend - 1;
        return (unsigned)(gather ? p.list_tok[sl] : sl) * rowbytes;
    }
    __device__ __forceinline__ const char* b_ptr(const GUnit& u) const { return (const char*)(Bt + (size_t)__builtin_amdgcn_readfirstlane(pp->blk_e[u.pm]) * b_estride + (size_t)u.pn * b_tstride); }
};
struct EpiMoe1 {
    const P* pp;
    __device__ __forceinline__ void operator()(const f32x4 (&acc)[2][2][4][2], const GUnit& u, int, int, int, int) const {
        const int t2_ = get_tid(), wid_ = __builtin_amdgcn_readfirstlane(t2_ >> 6), wr = wid_ >> 2, wc = wid_ & 3, fr = t2_ & 15, fq = (t2_ >> 4) & 3;
        const P& p = *pp;
        const int e = __builtin_amdgcn_readfirstlane(p.blk_e[u.pm]), r0 = __builtin_amdgcn_readfirstlane(p.blk_r0[u.pm]), rend = __builtin_amdgcn_readfirstlane(p.offs[e + 1]);
#pragma unroll
        for (int ai = 0; ai < 2; ++ai)
#pragma unroll
            for (int m = 0; m < 4; ++m) {
                const int sl = r0 + ai * 128 + wr * 64 + m * 16 + fr;
                if (sl < rend) {
                    const float rs = p.rsb[p.list_tok[sl]];
                    f32x4 v[2];
#pragma unroll
                    for (int n = 0; n < 2; ++n)
#pragma unroll
                        for (int r = 0; r < 4; r++) { const float a = acc[ai][0][m][n][r] * rs; v[n][r] = a * sigmoidf_(a) * (acc[ai][1][m][n][r] * rs); }
                    *(uint4*)&p.hid[(size_t)sl * 256 + u.pn * 128 + wc * 32 + 8 * fq] = pack8(v[0], v[1]);
                }
            }
    }
};
__device__ void ph_moe1(const P& p, int bid, int nb, char* smem) {
    MoeSched<2> S{&p, __builtin_amdgcn_readfirstlane(*p.nblk) * 2, nb, bid, (unsigned)(D_ * 2), p.ew1T, (size_t)512 * D_, (size_t)256 * D_, true};
    EpiMoe1 E{&p};
    gemm256(smem, (const char*)p.hbuf, D_, S, E);
}
struct EpiMoe2 {
    const P* pp;
    __device__ __forceinline__ void operator()(const f32x4 (&acc)[2][2][4][2], const GUnit& u, int, int, int, int) const {
        const int t2_ = get_tid(), wid_ = __builtin_amdgcn_readfirstlane(t2_ >> 6), wr = wid_ >> 2, wc = wid_ & 3, fr = t2_ & 15, fq = (t2_ >> 4) & 3;
        const P& p = *pp;
        const int e = __builtin_amdgcn_readfirstlane(p.blk_e[u.pm]), r0 = __builtin_amdgcn_readfirstlane(p.blk_r0[u.pm]), rend = __builtin_amdgcn_readfirstlane(p.offs[e + 1]);
#pragma unroll
        for (int ai = 0; ai < 2; ++ai)
#pragma unroll
            for (int m = 0; m < 4; ++m) {
                const int sl = r0 + ai * 128 + wr * 64 + m * 16 + fr;
                if (sl < rend) {
                    const float gt = p.list_gate[sl];
                    u16* yp = p.ybuf + (size_t)sl * D_ + u.pn * 256 + wc * 32 + 8 * fq;
#pragma unroll
                    for (int bj = 0; bj < 2; ++bj) *(uint4*)&yp[bj * 128] = pack8(acc[ai][bj][m][0] * gt, acc[ai][bj][m][1] * gt);
                }
            }
    }
};
__device__ void ph_moe2(const P& p, int bid, int nb, char* smem) {
    MoeSched<4> S{&p, __builtin_amdgcn_readfirstlane(*p.nblk) * 4, nb, bid, 512u, p.ew2T, (size_t)D_ * 256, (size_t)256 * 256, false};
    EpiMoe2 E{&p};
    gemm256(smem, (const char*)p.hid, 256, S, E);
}
__device__ void ph_final(const P& p, int bid, int nb, char* smem) {
    const int tid = get_tid(), lane = tid & 63, wv = tid >> 6;
    for (int row = bid * NW + wv; row < NTOK; row += nb * NW) {
        const int s0 = p.tokslot[row * 2], s1 = p.tokslot[row * 2 + 1];
        float v[16]; float ss = 0.f;
#pragma unroll
        for (int i = 0; i < 4; i++) {
            const int c = i * 256 + lane * 4;
            const float4 t = *(const float4*)&p.x1[(size_t)row * D_ + c];
            const uint2 a = *(const uint2*)&p.ybuf[(size_t)s0 * D_ + c];
            const uint2 bq = *(const uint2*)&p.ybuf[(size_t)s1 * D_ + c];
            v[4 * i]     = t.x + __uint_as_float(a.x << 16) + __uint_as_float(bq.x << 16);
            v[4 * i + 1] = t.y + __uint_as_float(a.x & 0xFFFF0000u) + __uint_as_float(bq.x & 0xFFFF0000u);
            v[4 * i + 2] = t.z + __uint_as_float(a.y << 16) + __uint_as_float(bq.y << 16);
            v[4 * i + 3] = t.w + __uint_as_float(a.y & 0xFFFF0000u) + __uint_as_float(bq.y & 0xFFFF0000u);
            ss += v[4 * i] * v[4 * i] + v[4 * i + 1] * v[4 * i + 1] + v[4 * i + 2] * v[4 * i + 2] + v[4 * i + 3] * v[4 * i + 3];
        }
        ss = wave_sum(ss);
        const float rs = rsqrtf(ss * (1.f / D_) + 1e-6f);
#pragma unroll
        for (int i = 0; i < 4; i++) {
            const int c = i * 256 + lane * 4;
            const float4 g = *(const float4*)&p.g_final[c];
            float4 o; o.x = v[4 * i] * rs * g.x; o.y = v[4 * i + 1] * rs * g.y; o.z = v[4 * i + 2] * rs * g.z; o.w = v[4 * i + 3] * rs * g.w;
            *(float4*)&p.out[(size_t)row * D_ + c] = o;
        }
    }
}

#define XB_TMO      128
#define XB_XCNT(j)  (256  + 64 * (j))
#define XB_XSUB(j)  (1280 + 64 * (j))
#define XB_XGEN(j)  (2304 + 64 * (j))
#define XB_TOP      3328
#define XB_TOPGEN   3392
#define XCD_BAR_WORDS 3456
#define XB_SPIN_CAP (1u << 18)
#define LAS __attribute__((address_space(3)))

__device__ __forceinline__ unsigned xb_ld(unsigned* p)              { return __hip_atomic_load(p, __ATOMIC_RELAXED, __HIP_MEMORY_SCOPE_AGENT); }
__device__ __forceinline__ unsigned xb_add(unsigned* p, unsigned v) { return __hip_atomic_fetch_add(p, v, __ATOMIC_RELAXED, __HIP_MEMORY_SCOPE_AGENT); }
__device__ __forceinline__ unsigned xb_xcc_id() { return (unsigned)__builtin_amdgcn_s_getreg((3 << 11) | 20) & 0xFu; }
#define XB_SPIN(cond, bar) do { unsigned _sp = 0; while (cond) { __builtin_amdgcn_s_sleep(1); \
    if ((++_sp & 255u) == 0u) { if (xb_ld(&(bar)[XB_TMO])) break; if (_sp > XB_SPIN_CAP) { atomicAdd(&(bar)[XB_TMO], 1u); break; } } } } while (0)

struct XcdBarrier {
    unsigned* bar; unsigned x;
    volatile LAS unsigned* st;
};

__device__ __forceinline__ XcdBarrier xcd_barrier_post(unsigned* bar, volatile LAS unsigned* st) {
    XcdBarrier b; b.bar = bar; b.x = xb_xcc_id(); b.st = st;
    if (threadIdx.x == 0) (void)xb_add(&bar[XB_XCNT(b.x)], 1u);
    return b;
}
__device__ __forceinline__ void xcd_barrier_complete(unsigned* bar, unsigned x, unsigned& nloc, unsigned& nx) {
    const unsigned G = gridDim.x * gridDim.y * gridDim.z;
    unsigned sum, cnt, mine, sp = 0u;
    for (;;) {
        sum = 0u; cnt = 0u; mine = 0u;
#pragma unroll
        for (unsigned j = 0; j < 16; ++j) { const unsigned c = xb_ld(&bar[XB_XCNT(j)]); sum += c; cnt += (c > 0u) ? 1u : 0u; mine = (j == x) ? c : mine; }
        if (sum == G) break;
        __builtin_amdgcn_s_sleep(1);
        if ((++sp & 255u) == 0u) { if (xb_ld(&bar[XB_TMO])) break; if (sp > XB_SPIN_CAP) { atomicAdd(&bar[XB_TMO], 1u); break; } }
    }
    nloc = mine > 0u ? mine : 1u; nx = cnt > 0u ? cnt : 1u;
}

__device__ __forceinline__ void xcd_barrier(const XcdBarrier& b) {
    asm volatile("s_waitcnt vmcnt(0)" ::: "memory");
    __syncthreads();
    if (threadIdx.x == 0) {
        unsigned* bar = b.bar;
        __builtin_amdgcn_s_waitcnt(0);
        unsigned nloc = b.st[0], nx = b.st[1];
        if (nloc == 0u) { xcd_barrier_complete(bar, b.x, nloc, nx); b.st[0] = nloc; b.st[1] = nx; }
        const unsigned old = xb_add(&bar[XB_XSUB(b.x)], 1u);
        const unsigned gen = old / nloc;
        if (old + 1u == (gen + 1u) * nloc) {
            __builtin_amdgcn_fence(__ATOMIC_RELEASE, "agent");
            asm volatile("s_waitcnt vmcnt(0)" ::: "memory");
            const unsigned og = xb_add(&bar[XB_TOP], 1u);
            const unsigned tg = og / nx;
            if (og + 1u == (tg + 1u) * nx) xb_add(&bar[XB_TOPGEN], 1u);
            else XB_SPIN(xb_ld(&bar[XB_TOPGEN]) == tg, bar);
            __builtin_amdgcn_fence(__ATOMIC_ACQUIRE, "agent");
            xb_add(&bar[XB_XGEN(b.x)], 1u);
            asm volatile("s_waitcnt vmcnt(0)" ::: "memory");
        } else {
            XB_SPIN(xb_ld(&bar[XB_XGEN(b.x)]) == gen, bar);
            __builtin_amdgcn_fence(__ATOMIC_ACQUIRE, "agent");
            asm volatile("s_waitcnt vmcnt(0)" ::: "memory");
        }
    }
    __syncthreads();
}

template <int PH>
__device__ __forceinline__ void run_phase(const P& p, int bid, int nb, char* smem) {
    if constexpr (PH == 0) ph_prologue(p, bid, nb, smem);
    if constexpr (PH == 1) ph_inproj(p, bid, nb, smem);
    if constexpr (PH == 2) { ph_compress(p, bid, nb, smem); __syncthreads(); ph_rwkv_chunk(p, bid, nb, smem); }
    if constexpr (PH == 3) {
        if (bid < SCAN_BLOCKS) ph_rwkv_seq(p, bid, SCAN_BLOCKS, smem);
        else ph_nsa(p, bid - SCAN_BLOCKS, nb - SCAN_BLOCKS, smem);
    }
    if constexpr (PH == 12) ph_rwkv_out(p, bid, nb, smem);
    if constexpr (PH == 4) ph_merge(p, bid, nb, smem);
    if constexpr (PH == 5) ph_outproj(p, bid, nb, smem);
    if constexpr (PH == 6) ph_route(p, bid, nb, smem);
    if constexpr (PH == 7) ph_scatter(p, bid, nb, smem);
    if constexpr (PH == 9) ph_moe1(p, bid, nb, smem);
    if constexpr (PH == 10) ph_moe2(p, bid, nb, smem);
    if constexpr (PH == 11) ph_final(p, bid, nb, smem);
}

template <int PH>
__global__ void __launch_bounds__(NT) kph(P p) {
    extern __shared__ __attribute__((aligned(16))) char smem[];
    run_phase<PH>(p, blockIdx.x, gridDim.x, smem);
}

__global__ void __launch_bounds__(NT, 2) mega(P p) {
    extern __shared__ __attribute__((aligned(16))) char smem[];
    volatile LAS unsigned* st = (volatile LAS unsigned*)(smem + SMEM_BYTES - 16);
    if (threadIdx.x == 0) { st[0] = 0u; st[1] = 0u; st[2] = 0u; st[3] = 0u; }
    __syncthreads();
    XcdBarrier bar = xcd_barrier_post(p.bar, st);
    const int bid = blockIdx.x, nb = gridDim.x;
#define RUNP(N, BAR) { unsigned long long t0_ = 0; if ((TPROBE >> N) & 1) t0_ = __builtin_amdgcn_s_memrealtime(); run_phase<N>(p, bid, nb, smem); \
        unsigned long long tw_ = 0; if (((TPROBE >> N) & 1) && TPSEL) tw_ = __builtin_amdgcn_s_memrealtime() - t0_; if (BAR) xcd_barrier(bar); \
        if ((TPROBE >> N) & 1) { const unsigned long long t1_ = __builtin_amdgcn_s_memrealtime(); const unsigned long long dt_ = TPSEL ? tw_ : t1_ - t0_; \
            if (!TPSEL || (TPSEL == 1 ? (bid < SCAN_BLOCKS) : (bid >= SCAN_BLOCKS))) while (__builtin_amdgcn_s_memrealtime() - t1_ < dt_) __builtin_amdgcn_s_sleep(8); if (TPSEL) xcd_barrier(bar); } }
    RUNP(0, 1) RUNP(1, 1) RUNP(2, 1) RUNP(3, 1) RUNP(12, 1) RUNP(4, 1) RUNP(5, 1) RUNP(6, 1) RUNP(7, 1) RUNP(9, 1) RUNP(10, 1) RUNP(11, 0)
}

extern "C" void kernel_launch(void* const* d_in, const int* in_sizes, int n_in,
                              void* d_out, int out_size, void* d_ws, size_t ws_size,
                              hipStream_t stream) {
    P p{};
    p.x = (const float*)d_in[0]; p.pos = (const int*)d_in[1]; p.g_mix = (const float*)d_in[2]; p.w_in = (const float*)d_in[3];
    p.pe_k = (const float*)d_in[4]; p.w1_k = (const float*)d_in[5]; p.b1_k = (const float*)d_in[6]; p.w2_k = (const float*)d_in[7]; p.b2_k = (const float*)d_in[8];
    p.pe_v = (const float*)d_in[9]; p.w1_v = (const float*)d_in[10]; p.b1_v = (const float*)d_in[11]; p.w2_v = (const float*)d_in[12]; p.b2_v = (const float*)d_in[13];
    p.mu = (const float*)d_in[14]; p.w0 = (const float*)d_in[15]; p.w2 = (const float*)d_in[16]; p.a0 = (const float*)d_in[17]; p.a2 = (const float*)d_in[18];
    p.g2 = (const float*)d_in[19]; p.k_k = (const float*)d_in[20]; p.k_a = (const float*)d_in[21]; p.r_k = (const float*)d_in[22]; p.ln_w = (const float*)d_in[23]; p.ln_b = (const float*)d_in[24];
    p.wpa = (const float*)d_in[25]; p.wpb = (const float*)d_in[26]; p.wout = (const float*)d_in[27]; p.g_ffn = (const float*)d_in[28];
    p.w_grp = (const float*)d_in[29]; p.b_grp = (const float*)d_in[30]; p.w_exp = (const float*)d_in[31]; p.b_exp = (const float*)d_in[32];
    p.e_w1 = (const float*)d_in[33]; p.e_w3 = (const float*)d_in[34]; p.e_w2 = (const float*)d_in[35]; p.g_final = (const float*)d_in[36];
    p.out = (float*)d_out;
    char* ws = (char*)d_ws;
    const size_t MiB = 1ull << 20;
    p.hbuf = (u16*)(ws + 0 * MiB);
    p.q    = (u16*)(ws + 64 * MiB);
    p.kc   = (u16*)(ws + 96 * MiB);  p.vc   = (u16*)(ws + 104 * MiB);
    p.ksl  = (u16*)(ws + 112 * MiB); p.vslT = (u16*)(ws + 120 * MiB);
    p.kwn  = (u16*)(ws + 128 * MiB); p.vwnT = (u16*)(ws + 136 * MiB);
    p.nsag = (float*)(ws + 144 * MiB);
    p.kcb  = (u16*)(ws + 148 * MiB); p.vcT  = (u16*)(ws + 149 * MiB);
    p.prw  = (u16*)(ws + 160 * MiB);
    p.cdat = (u16*)(ws + 272 * MiB);
    p.bon  = (float*)(ws + 150 * MiB);
    p.w2T  = (u16*)(ws + 151 * MiB); p.a2T = p.w2T + 512 * 64; p.g2T = p.a2T + 512 * 64;
    p.cw1Tk = (u16*)(ws + 152 * MiB); p.cw1Tv = (u16*)(ws + 153 * MiB);
    p.cw2Tk = (u16*)(ws + 154 * MiB); p.cw2Tv = p.cw2Tk + 128 * 256;
    p.chid = (u16*)(ws + 155 * MiB);
    p.xact = (u16*)(ws + 488 * MiB);
    p.oa   = (u16*)(ws + 400 * MiB);
    p.ob   = (u16*)(ws + 432 * MiB);
    p.merged = (u16*)(ws + 64 * MiB);
    p.x1   = (float*)(ws + 160 * MiB);
    char* rt = ws + 288 * MiB;
    p.tok_e = (int*)(rt);                        rt += NTOK * 2 * 4;
    p.tok_gate = (float*)(rt);                   rt += NTOK * 2 * 4;
    p.tokslot = (int*)(rt);                      rt += NTOK * 2 * 4;
    p.list_tok = (int*)(rt);                     rt += NTOK * 2 * 4;
    p.list_gate = (float*)(rt);                  rt += NTOK * 2 * 4;
    p.blk_e = (int*)(rt);                        rt += 2048 * 4;
    p.blk_r0 = (int*)(rt);                       rt += 2048 * 4;
    p.rsb = (float*)(rt);                        rt += NTOK * 4;
    p.hid  = (u16*)(ws + 296 * MiB);
    p.ybuf = (u16*)(ws + 336 * MiB);
    char* misc = ws + 470 * MiB;
    p.counts = (int*)(misc); p.cursor = (int*)(misc + 256); p.offs = (int*)(misc + 512); p.nblk = (int*)(misc + 1024);
    p.bar = (unsigned*)(ws + 471 * MiB);
    p.cb1k = (float*)(p.bar + XCD_BAR_WORDS); p.cb1v = p.cb1k + 256;
    {
        char* wa = ws + 472 * MiB;
        p.winT = (u16*)wa;  wa += (size_t)3328 * 1024 * 2;
        p.wgT  = (u16*)wa;  wa += (size_t)2048 * 1024 * 2;
        p.wpaT = (u16*)wa;  wa += (size_t)1024 * 512 * 2;
        p.wpbT = (u16*)wa;  wa += (size_t)1024 * 512 * 2;
        p.woutT = (u16*)wa; wa += (size_t)1024 * 1024 * 2;
        p.ew1T = (u16*)(ws + 64 * MiB);  p.ew3T = (u16*)(ws + 80 * MiB);  p.ew2T = (u16*)(ws + 96 * MiB);
    }
    if (ws_size < (size_t)505 * MiB) return;

#if MEGA
    {
        static int mgrid = 0;
        if (mgrid == 0) {
            int dev = 0, cus = 0, per_cu = 0;
            hipGetDevice(&dev);
            hipDeviceGetAttribute(&cus, hipDeviceAttributeMultiprocessorCount, dev);
            hipFuncSetAttribute((const void*)mega, hipFuncAttributeMaxDynamicSharedMemorySize, SMEM_BYTES);
            hipOccupancyMaxActiveBlocksPerMultiprocessor(&per_cu, (const void*)mega, NT, SMEM_BYTES);
            (void)hipGetLastError();
            mgrid = cus;
        }
        hipMemsetAsync(p.bar, 0, XCD_BAR_WORDS * sizeof(unsigned) + 512 * sizeof(float), stream);
        mega<<<mgrid, NT, SMEM_BYTES, stream>>>(p);
        return;
    }
#else
    const int grid = 512;
    hipMemsetAsync(p.bar, 0, XCD_BAR_WORDS * sizeof(unsigned) + 512 * sizeof(float), stream);
    hipFuncSetAttribute((const void*)kph<0>, hipFuncAttributeMaxDynamicSharedMemorySize, SMEM_BYTES);
    hipFuncSetAttribute((const void*)kph<1>, hipFuncAttributeMaxDynamicSharedMemorySize, SMEM_BYTES);
    hipFuncSetAttribute((const void*)kph<2>, hipFuncAttributeMaxDynamicSharedMemorySize, SMEM_BYTES);
    hipFuncSetAttribute((const void*)kph<3>, hipFuncAttributeMaxDynamicSharedMemorySize, SMEM_BYTES);
    hipFuncSetAttribute((const void*)kph<4>, hipFuncAttributeMaxDynamicSharedMemorySize, SMEM_BYTES);
    hipFuncSetAttribute((const void*)kph<5>, hipFuncAttributeMaxDynamicSharedMemorySize, SMEM_BYTES);
    hipFuncSetAttribute((const void*)kph<6>, hipFuncAttributeMaxDynamicSharedMemorySize, SMEM_BYTES);
    hipFuncSetAttribute((const void*)kph<7>, hipFuncAttributeMaxDynamicSharedMemorySize, SMEM_BYTES);
    hipFuncSetAttribute((const void*)kph<8>, hipFuncAttributeMaxDynamicSharedMemorySize, SMEM_BYTES);
    hipFuncSetAttribute((const void*)kph<9>, hipFuncAttributeMaxDynamicSharedMemorySize, SMEM_BYTES);
    hipFuncSetAttribute((const void*)kph<10>, hipFuncAttributeMaxDynamicSharedMemorySize, SMEM_BYTES);
    hipFuncSetAttribute((const void*)kph<11>, hipFuncAttributeMaxDynamicSharedMemorySize, SMEM_BYTES);
    kph<0><<<grid, NT, SMEM_BYTES, stream>>>(p);
    kph<1><<<grid, NT, SMEM_BYTES, stream>>>(p);
    kph<2><<<grid, NT, SMEM_BYTES, stream>>>(p);
    kph<3><<<grid, NT, SMEM_BYTES, stream>>>(p);
    kph<12><<<grid, NT, SMEM_BYTES, stream>>>(p);
    kph<4><<<grid, NT, SMEM_BYTES, stream>>>(p);
    kph<5><<<grid, NT, SMEM_BYTES, stream>>>(p);
    kph<6><<<grid, NT, SMEM_BYTES, stream>>>(p);
    kph<7><<<grid, NT, SMEM_BYTES, stream>>>(p);
    kph<8><<<grid, NT, SMEM_BYTES, stream>>>(p);
    kph<9><<<grid, NT, SMEM_BYTES, stream>>>(p);
    kph<10><<<grid, NT, SMEM_BYTES, stream>>>(p);
    kph<11><<<grid, NT, SMEM_BYTES, stream>>>(p);
#endif
}
```

```cpp
#include <hip/hip_runtime.h>
#include <stdint.h>

typedef unsigned short u16;
using bf16x8 = __attribute__((ext_vector_type(8))) short;
using f32x4  = __attribute__((ext_vector_type(4))) float;

#ifndef MEGA
#define MEGA 1
#endif

constexpr int B_ = 4, S_ = 8192, D_ = 1024, NTOK = B_ * S_;
constexpr int CIN = 5144;
constexpr int NCMP = 511;
constexpr int CRW = 1792;
constexpr int NEXP = 32;
constexpr int NT = 512;
constexpr int NW = NT / 64;
constexpr int SMEM_BYTES = 160 * 1024;
constexpr int SCAN_BLOCKS = 16;
#ifndef TPROBE
#define TPROBE 0
#define TPSEL 0
#endif
constexpr float QSCALE = 0.125f * 1.4426950408889634f;

struct P {
    const float* x; const int* pos; const float* g_mix; const float* w_in;
    const float *pe_k, *w1_k, *b1_k, *w2_k, *b2_k, *pe_v, *w1_v, *b1_v, *w2_v, *b2_v;
    const float *mu, *w0, *w2, *a0, *a2, *g2, *k_k, *k_a, *r_k, *ln_w, *ln_b;
    const float *wpa, *wpb, *wout, *g_ffn, *w_grp, *b_grp, *w_exp, *b_exp, *e_w1, *e_w3, *e_w2, *g_final;
    float* out;
    u16* hbuf; u16 *q, *kc, *vc, *ksl, *vslT, *kwn, *vwnT, *kcb, *vcT; float* nsag; u16* prw;
    u16* cdat; float* bon; u16 *w2T, *a2T, *g2T; u16 *oa, *ob; u16* merged; float* x1;
    int* tok_e; float* tok_gate; int* tokslot; int* list_tok; float* list_gate;
    int* counts; int* offs; int* cursor; int* blk_e; int* blk_r0; int* nblk; float* rsb;
    u16* hid; u16* ybuf; unsigned* bar;
    u16 *winT, *wgT, *wpaT, *wpbT, *woutT, *ew1T, *ew3T, *ew2T;
    u16 *cw1Tk, *cw1Tv, *cw2Tk, *cw2Tv, *chid, *xact; float *cb1k, *cb1v;
};

typedef __bf16 bf16x2_t __attribute__((ext_vector_type(2)));
typedef float f32x2_t __attribute__((ext_vector_type(2)));
__device__ __forceinline__ unsigned pack2(float a, float b) {
    f32x2_t f = {a, b};
    return __builtin_bit_cast(unsigned, __builtin_convertvector(f, bf16x2_t));
}
__device__ __forceinline__ u16 f2bf(float f) { return (u16)(pack2(f, f) & 0xFFFFu); }
__device__ __forceinline__ float bf2f(u16 h) { return __uint_as_float(((unsigned)h) << 16); }
__device__ __forceinline__ float sigmoidf_(float x) { return __builtin_amdgcn_rcpf(1.f + __expf(-x)); }
__device__ __forceinline__ int get_tid() { int t = threadIdx.x; asm volatile("" : "+v"(t)); return t; }
__device__ __forceinline__ uint2 pack4(const f32x4& v) { uint2 o; o.x = pack2(v[0], v[1]); o.y = pack2(v[2], v[3]); return o; }
__device__ __forceinline__ f32x4 unpack4(uint2 u) { return f32x4{__uint_as_float(u.x << 16), __uint_as_float(u.x & 0xFFFF0000u), __uint_as_float(u.y << 16), __uint_as_float(u.y & 0xFFFF0000u)}; }
#define LDS_BARRIER() do { asm volatile("s_waitcnt lgkmcnt(0)" ::: "memory"); __builtin_amdgcn_s_barrier(); asm volatile("" ::: "memory"); } while (0)
__device__ __forceinline__ int opaque(int x) { asm volatile("" : "+v"(x)); return x; }
template <int CTRL>
__device__ __forceinline__ float dppf(float x) { return __int_as_float(__builtin_amdgcn_update_dpp(0, __float_as_int(x), CTRL, 0xF, 0xF, true)); }
__device__ __forceinline__ float wave_sum(float v) {
    v += dppf<0xB1>(v);
    v += dppf<0x4E>(v);
    v += dppf<0x141>(v);
    v += dppf<0x140>(v);
    const int vi = __float_as_int(v);
    return (__int_as_float(__builtin_amdgcn_readlane(vi, 0)) + __int_as_float(__builtin_amdgcn_readlane(vi, 16)))
         + (__int_as_float(__builtin_amdgcn_readlane(vi, 32)) + __int_as_float(__builtin_amdgcn_readlane(vi, 48)));
}

__device__ __forceinline__ float xrow_sum(float v) {
    auto r = __builtin_amdgcn_permlane16_swap(__float_as_uint(v), __float_as_uint(v), false, false);
    v = __uint_as_float(r[0]) + __uint_as_float(r[1]);
    auto r2 = __builtin_amdgcn_permlane32_swap(__float_as_uint(v), __float_as_uint(v), false, false);
    return __uint_as_float(r2[0]) + __uint_as_float(r2[1]);
}
__device__ __forceinline__ float xrow_max(float v) {
    auto r = __builtin_amdgcn_permlane16_swap(__float_as_uint(v), __float_as_uint(v), false, false);
    v = fmaxf(__uint_as_float(r[0]), __uint_as_float(r[1]));
    auto r2 = __builtin_amdgcn_permlane32_swap(__float_as_uint(v), __float_as_uint(v), false, false);
    return fmaxf(__uint_as_float(r2[0]), __uint_as_float(r2[1]));
}
__constant__ double ROPE_FREQ[32] = {
    1.00000000000000000000e+00, 7.49894209332455874417e-01, 5.62341325190349072827e-01, 4.21696503428582225581e-01,
    3.16227766016837941176e-01, 2.37137370566165517349e-01, 1.77827941003892292526e-01, 1.33352143216332402753e-01,
    1.00000000000000005551e-01, 7.49894209332455791150e-02, 5.62341325190349114460e-02, 4.21696503428582239459e-02,
    3.16227766016837913421e-02, 2.37137370566165538166e-02, 1.77827941003892292526e-02, 1.33352143216332406223e-02,
    1.00000000000000002082e-02, 7.49894209332455791150e-03, 5.62341325190349097113e-03, 4.21696503428582291501e-03,
    3.16227766016837939442e-03, 2.37137370566165538166e-03, 1.77827941003892275179e-03, 1.33352143216332406223e-03,
    1.00000000000000002082e-03, 7.49894209332455856203e-04, 5.62341325190349097113e-04, 4.21696503428582237290e-04,
    3.16227766016837939442e-04, 2.37137370566165538166e-04, 1.77827941003892269758e-04, 1.33352143216332395381e-04};

constexpr int G_ABYTES = 256 * 64 * 2, G_BBYTES = 128 * 64 * 2, G_TILE = G_ABYTES + G_BBYTES;
#define LAS3 __attribute__((address_space(3)))
#define GAS1 __attribute__((address_space(1)))
__device__ __forceinline__ void glds16(const u16* g, char* l) {
    __builtin_amdgcn_global_load_lds((const GAS1 unsigned*)g, (LAS3 unsigned*)l, 16, 0, 0);
}
template <bool TR = false, class ARow>
__device__ __forceinline__ void gemm_core(int K, ARow arow, const u16* __restrict__ BT, int ldb, f32x4 (&acc)[4][4], u16* sm) {
    char* base = (char*)sm;
    const int tid = get_tid(), lane = tid & 63, wv = tid >> 6;
    const int wm = wv >> 1, wn = wv & 1, kr = lane & 15, qq = lane >> 4;
    const int lr = tid >> 3, lk = ((tid & 7) ^ ((lr >> 1) & 7)) * 8;
    const u16* ap0 = arow(lr) + lk; const u16* ap1 = arow(lr + 64) + lk;
    const u16* ap2 = arow(lr + 128) + lk; const u16* ap3 = arow(lr + 192) + lk;
    const u16* bp0 = BT + (size_t)lr * ldb + lk; const u16* bp1 = BT + (size_t)(lr + 64) * ldb + lk;
#pragma unroll
    for (int mt = 0; mt < 4; mt++)
#pragma unroll
        for (int nt = 0; nt < 4; nt++) acc[mt][nt] = f32x4{0.f, 0.f, 0.f, 0.f};
    const int nk = K >> 6;
#define G_ISSUE(t, b) { char* d = base + (b) * G_TILE + tid * 16; const int ko = (t) * 64; \
        glds16(ap0 + ko, d); glds16(ap1 + ko, d + 8192); glds16(ap2 + ko, d + 16384); glds16(ap3 + ko, d + 24576); \
        glds16(bp0 + ko, d + G_ABYTES); glds16(bp1 + ko, d + G_ABYTES + 8192); }
    const int sw = kr >> 1;
    const int po0 = ((0 * 4 + qq) ^ sw) * 16, po1 = ((1 * 4 + qq) ^ sw) * 16;
    const int aoff = (wm * 64 + kr) * 128, boff = G_ABYTES + (wn * 64 + kr) * 128;
#define G_READ(FA, FB, b) { const char* Ab = base + (b) * G_TILE + aoff; const char* Bb = base + (b) * G_TILE + boff; \
        _Pragma("unroll") for (int mt = 0; mt < 4; mt++) { FA[0][mt] = *(const bf16x8*)(Ab + mt * 2048 + po0); FA[1][mt] = *(const bf16x8*)(Ab + mt * 2048 + po1); } \
        _Pragma("unroll") for (int nt = 0; nt < 4; nt++) { FB[0][nt] = *(const bf16x8*)(Bb + nt * 2048 + po0); FB[1][nt] = *(const bf16x8*)(Bb + nt * 2048 + po1); } }
#define G_MMA(FA, FB) { __builtin_amdgcn_s_setprio(1); \
        _Pragma("unroll") for (int ks = 0; ks < 2; ks++) \
            _Pragma("unroll") for (int nt = 0; nt < 4; nt++) \
                _Pragma("unroll") for (int mt = 0; mt < 4; mt++) \
                    acc[mt][nt] = TR ? __builtin_amdgcn_mfma_f32_16x16x32_bf16(FA[ks][mt], FB[ks][nt], acc[mt][nt], 0, 0, 0) \
                                     : __builtin_amdgcn_mfma_f32_16x16x32_bf16(FB[ks][nt], FA[ks][mt], acc[mt][nt], 0, 0, 0); \
        __builtin_amdgcn_s_setprio(0); }
    bf16x8 fa0[2][4], fb0[2][4], fa1[2][4], fb1[2][4];
    G_ISSUE(0, 0)
    if (nk > 1) G_ISSUE(1, 1)
    if (nk > 2) G_ISSUE(2, 2)
    if (nk > 2) asm volatile("s_waitcnt vmcnt(12)" ::: "memory");
    else if (nk > 1) asm volatile("s_waitcnt vmcnt(6)" ::: "memory");
    else asm volatile("s_waitcnt vmcnt(0)" ::: "memory");
    __builtin_amdgcn_s_barrier();
    G_READ(fa0, fb0, 0)
    int bnext = 1, bfree = 0;
#define G_STEP(FAC, FBC, FAN, FBN, kt) { \
        if ((kt) + 1 < nk) { \
            if ((kt) + 2 < nk) asm volatile("s_waitcnt vmcnt(6) lgkmcnt(0)" ::: "memory"); else asm volatile("s_waitcnt vmcnt(0) lgkmcnt(0)" ::: "memory"); \
            __builtin_amdgcn_s_barrier();                   \
            if ((kt) + 3 < nk) G_ISSUE((kt) + 3, bfree) \
            G_READ(FAN, FBN, bnext) \
        } \
        G_MMA(FAC, FBC) \
        bfree = bnext; bnext = (bnext == 2) ? 0 : bnext + 1; }
    for (int kt = 0; kt < nk; kt += 2) {
        G_STEP(fa0, fb0, fa1, fb1, kt)
        G_STEP(fa1, fb1, fa0, fb0, kt + 1)
    }
    __builtin_amdgcn_s_barrier();
#undef G_READ
#undef G_MMA
#undef G_STEP
#undef G_ISSUE
}

__device__ __forceinline__ int xcd_item(int bid, int nb, int k, int nitems) {
    if (nb & 7) return bid + k * nb;
    const int per = nb >> 3, chunk = (nitems + 7) >> 3;
    const int j = k * per + (bid >> 3);
    return (j < chunk) ? (bid & 7) * chunk + j : nitems;
}
struct GUnit { int pm, pn; };
constexpr int G8_HTB = 128 * 64 * 2;
__device__ __forceinline__ int g8_lds_byte(int r, int c) { const int st = (r >> 4) * 2 + (c >> 5), rr = r & 15, cc = c & 31, ob = rr * 64 + cc * 2; return st * 1024 + (ob ^ (((ob >> 9) & 1) << 5)); }
__device__ __forceinline__ void g8_stage_rc(int b, int& R, int& C) { const int st = b / 1024, sb = b % 1024, swz = sb ^ (((sb >> 9) & 1) << 5); R = (st >> 1) * 16 + swz / 64; C = (st & 1) * 32 + (swz % 64) / 2; }
__host__ __device__ __forceinline__ int perm32(int rho) { const int n = rho >> 4, i = rho & 15; return 8 * (i >> 2) + 4 * n + (i & 3); }

template <class Epi, class Sched>
__device__ __forceinline__ void gemm256(char* smem, const char* Ab, int K, const Sched& S, const Epi& E) {
    LAS3 unsigned char* lds = (LAS3 unsigned char*)smem;
    const int tid = get_tid(), wid = __builtin_amdgcn_readfirstlane(tid >> 6), lane = tid & 63, wr = wid >> 2, wc = wid & 3, fr = lane & 15, fq = lane >> 4;
    int nt = K >> 6; asm volatile("" : "+s"(nt));
    unsigned voffB[2], voffA[2][2];
#pragma unroll
    for (int i = 0; i < 2; ++i) { int sR, sC; g8_stage_rc(tid * 16 + i * 8192, sR, sC); voffB[i] = (unsigned)(sR * K + sC) * 2u; }
#define G8_AOFFS(un) do { const int t3_ = get_tid(); _Pragma("unroll") for (int i = 0; i < 2; ++i) { int sR, sC; g8_stage_rc(t3_ * 16 + i * 8192, sR, sC); \
        _Pragma("unroll") for (int h = 0; h < 2; ++h) voffA[h][i] = S.a_off(un, h, sR) + (unsigned)sC * 2u; } } while (0)
    const size_t kstep = 128;
    const size_t hstep = (size_t)128 * K * 2;
    const unsigned ldsw = (unsigned)wid * 1024u;
    const int aoff = g8_lds_byte(wr * 64 + fr, fq * 8), boff = g8_lds_byte(wc * 32 + fr, fq * 8);
#define G8_SA(b, h) (((b) * 2 + (h)) * G8_HTB)
#define G8_SB(b, h) ((4 + (b) * 2 + (h)) * G8_HTB)
#define G8_STAGE2(bufoff, gbase, v0, v1) do { \
        __builtin_amdgcn_global_load_lds((const GAS1 unsigned*)((const char*)(gbase) + (v0)), (LAS3 unsigned*)(lds + (bufoff) + ldsw), 16, 0, 0); \
        __builtin_amdgcn_global_load_lds((const GAS1 unsigned*)((const char*)(gbase) + (v1)), (LAS3 unsigned*)(lds + (bufoff) + ldsw + 8192), 16, 0, 0); } while (0)
#define G8_STAGEB(bufoff, gbase) G8_STAGE2(bufoff, gbase, voffB[0], voffB[1])
#define G8_LDA(dst, b, h) do { _Pragma("unroll") for (int m = 0; m < 4; ++m) _Pragma("unroll") for (int k = 0; k < 2; ++k) dst[m][k] = *(const LAS3 bf16x8*)(lds + G8_SA(b, h) + aoff + m * 2048 + k * 1024); } while (0)
#define G8_LDB(dst, b, h) do { _Pragma("unroll") for (int n = 0; n < 2; ++n) _Pragma("unroll") for (int k = 0; k < 2; ++k) dst[n][k] = *(const LAS3 bf16x8*)(lds + G8_SB(b, h) + boff + n * 2048 + k * 1024); } while (0)
#define G8_MMA(ai, bj, At, Bt) do { __builtin_amdgcn_s_setprio(1); _Pragma("unroll") for (int m = 0; m < 4; ++m) _Pragma("unroll") for (int n = 0; n < 2; ++n) _Pragma("unroll") for (int k = 0; k < 2; ++k) \
        acc[ai][bj][m][n] = __builtin_amdgcn_mfma_f32_16x16x32_bf16(Bt[n][k], At[m][k], acc[ai][bj][m][n], 0, 0, 0); __builtin_amdgcn_s_setprio(0); } while (0)
#define G8_WAIT_V(n) asm volatile("s_waitcnt vmcnt(" #n ")" ::: "memory")
#define G8_WAIT_L(n) asm volatile("s_waitcnt lgkmcnt(" #n ")" ::: "memory")
#define G8_BAR __builtin_amdgcn_s_barrier()
#define G8_SCHED __builtin_amdgcn_sched_barrier(0)
    GUnit cur, nxt; int ui = 0;
    if (!S.next(0, cur)) return;
    f32x4 acc[2][2][4][2];
#pragma unroll
    for (int a = 0; a < 2; ++a)
#pragma unroll
        for (int b = 0; b < 2; ++b)
#pragma unroll
            for (int m = 0; m < 4; ++m)
#pragma unroll
                for (int n = 0; n < 2; ++n) acc[a][b][m][n] = (f32x4){0.f, 0.f, 0.f, 0.f};
    bf16x8 At[4][2], B0[2][2], B1[2][2];
    G8_AOFFS(cur);
    const char* cB = S.b_ptr(cur);
    G8_STAGEB(G8_SB(0, 0), cB); G8_STAGE2(G8_SA(0, 0), Ab, voffA[0][0], voffA[0][1]); G8_STAGEB(G8_SB(0, 1), cB + hstep); G8_STAGE2(G8_SA(0, 1), Ab, voffA[1][0], voffA[1][1]);
    if (wr == 1) G8_BAR;
    G8_WAIT_V(4); G8_BAR;
    G8_STAGEB(G8_SB(1, 0), cB + kstep); G8_STAGE2(G8_SA(1, 0), Ab + kstep, voffA[0][0], voffA[0][1]); G8_STAGEB(G8_SB(1, 1), cB + hstep + kstep);
    G8_WAIT_V(6); G8_BAR;
    for (;;) {
        const bool has_next = S.next(ui + 1, nxt);
        const char* nB = has_next ? S.b_ptr(nxt) : cB;
        for (int t = 0; t < nt; t += 2) {
            const bool last = (t == nt - 2);
            const char* a1 = Ab + (size_t)(t + 1) * kstep;
            const unsigned va10 = voffA[1][0], va11 = voffA[1][1];
            if (last && has_next) G8_AOFFS(nxt);
            const char* a2 = last ? Ab : Ab + (size_t)(t + 2) * kstep; const char* b2 = last ? nB : cB + (size_t)(t + 2) * kstep;
            const char* a3 = a2 + kstep; const char* b3 = b2 + kstep;
            G8_LDB(B0, 0, 0); G8_SCHED; G8_LDA(At, 0, 0); G8_STAGE2(G8_SA(1, 1), a1, va10, va11);
            G8_WAIT_L(8); G8_BAR; G8_WAIT_L(0); G8_MMA(0, 0, At, B0); G8_BAR; G8_SCHED;
            G8_LDB(B1, 0, 1); G8_STAGEB(G8_SB(0, 0), b2);
            G8_BAR; G8_WAIT_L(0); G8_MMA(0, 1, At, B1); G8_BAR;
            G8_LDA(At, 0, 1); G8_STAGE2(G8_SA(0, 0), a2, voffA[0][0], voffA[0][1]);
            G8_BAR; G8_WAIT_L(0); G8_MMA(1, 0, At, B0); G8_BAR; G8_SCHED;
            G8_STAGEB(G8_SB(0, 1), b2 + hstep);
            G8_WAIT_V(6); G8_BAR; G8_MMA(1, 1, At, B1); G8_BAR;
            G8_LDB(B0, 1, 0); G8_SCHED; G8_LDA(At, 1, 0); G8_STAGE2(G8_SA(0, 1), a2, voffA[1][0], voffA[1][1]);
            G8_WAIT_L(8); G8_BAR; G8_WAIT_L(0); G8_MMA(0, 0, At, B0); G8_BAR; G8_SCHED;
            G8_LDB(B1, 1, 1); G8_STAGEB(G8_SB(1, 0), b3);
            G8_BAR; G8_WAIT_L(0); G8_MMA(0, 1, At, B1); G8_BAR;
            G8_LDA(At, 1, 1); G8_STAGE2(G8_SA(1, 0), a3, voffA[0][0], voffA[0][1]);
            G8_BAR; G8_WAIT_L(0); G8_MMA(1, 0, At, B0); G8_BAR; G8_SCHED;
            G8_STAGEB(G8_SB(1, 1), b3 + hstep);
            G8_WAIT_V(6); G8_BAR; G8_MMA(1, 1, At, B1); G8_BAR;
        }
        E(acc, cur, wr, wc, fr, fq);
        if (!has_next) break;
#pragma unroll
        for (int a = 0; a < 2; ++a)
#pragma unroll
            for (int b = 0; b < 2; ++b)
#pragma unroll
                for (int m = 0; m < 4; ++m)
#pragma unroll
                    for (int n = 0; n < 2; ++n) acc[a][b][m][n] = (f32x4){0.f, 0.f, 0.f, 0.f};
        cur = nxt; cB = nB; ++ui;
    }
    G8_WAIT_V(0);
    if (wr == 0) G8_BAR;
    G8_BAR;
#undef G8_SA
#undef G8_AOFFS
#undef G8_SB
#undef G8_STAGE2
#undef G8_STAGEB
#undef G8_LDA
#undef G8_LDB
#undef G8_MMA
#undef G8_WAIT_V
#undef G8_WAIT_L
#undef G8_BAR
#undef G8_SCHED
}
struct DenseSched {
    int nM, nN, nwg, G, c, K; const char* Bt;
    __device__ __forceinline__ void init(int M, int N, int K_, const void* Bt_, int G_, int c_) { nM = M >> 8; nN = N >> 8; nwg = nM * nN; G = G_; c = c_; K = K_; Bt = (const char*)Bt_; }
    __device__ __forceinline__ bool next(int i, GUnit& u) const {
        const int L = i * G + c; if (L >= nwg) return false;
        int wgid = L; { const int q = nwg >> 3, r = nwg & 7, xcd = wgid & 7, off = wgid >> 3; wgid = (xcd < r ? xcd * (q + 1) : r * (q + 1) + (xcd - r) * q) + off; }
        const int nig = 8 * nN, gid = wgid / nig, fm = gid * 8, gsz = (nM - fm) < 8 ? (nM - fm) : 8, w = wgid - gid * nig;
        u.pn = w / gsz; u.pm = fm + (w - u.pn * gsz); return true;
    }
    __device__ __forceinline__ unsigned a_off(const GUnit& u, int h, int R) const { return (unsigned)((u.pm * 256 + h * 128 + R) * K) * 2u; }
    __device__ __forceinline__ const char* b_ptr(const GUnit& u) const { return Bt + (size_t)u.pn * 256 * K * 2; }
};

template <class SRC>
__device__ __forceinline__ void convert_wT(const float* __restrict__ W, int K, int N, u16* __restrict__ WT, int rows, SRC src, int gtid, int gnt) {
    const int kch = K >> 3;
    const int total = rows * kch;
    for (int i0 = gtid; i0 < total; i0 += 4 * gnt) {
        float f[4][8]; int sc[4];
#pragma unroll
        for (int u = 0; u < 4; u++) {
            const int i = i0 + u * gnt;
            sc[u] = -1;
            if (i < total) {
                const int kc = i / rows, j = i - kc * rows;
                sc[u] = src(j);
                if (sc[u] >= 0) {
                    const float* wp = W + (size_t)(kc * 8) * N + sc[u];
#pragma unroll
                    for (int q = 0; q < 8; q++) f[u][q] = wp[(size_t)q * N];
                }
            }
        }
#pragma unroll
        for (int u = 0; u < 4; u++) {
            const int i = i0 + u * gnt;
            if (i < total) {
                const int kc = i / rows, j = i - kc * rows;
                uint4 v = make_uint4(0u, 0u, 0u, 0u);
                if (sc[u] >= 0) { v.x = pack2(f[u][0], f[u][1]); v.y = pack2(f[u][2], f[u][3]); v.z = pack2(f[u][4], f[u][5]); v.w = pack2(f[u][6], f[u][7]); }
                *(uint4*)&WT[(size_t)j * K + kc * 8] = v;
            }
        }
    }
}

__device__ void ph_prologue(const P& p, int bid, int nb, char* smem) {
    const int tid = get_tid(), lane = tid & 63, wv = tid >> 6;
    if (bid >= 1 && bid <= 64) {
        const int j = tid & 255; const bool isv = tid >= 256;
        const float* pe = isv ? p.pe_v : p.pe_k; const float* w1 = isv ? p.w1_v : p.w1_k;
        const int kb = (bid - 1) * 32;
        float a0 = 0.f, a1 = 0.f;
#pragma unroll 4
        for (int k = kb; k < kb + 32; k += 2) { a0 += pe[k] * w1[(size_t)k * 256 + j]; a1 += pe[k + 1] * w1[(size_t)(k + 1) * 256 + j]; }
        p.cb1k[(bid - 1) * 512 + (isv ? 256 : 0) + j] = a0 + a1;
    }
    if (bid == 0) {
        if (tid < 32) { p.counts[tid] = 0; p.cursor[tid] = 0; }
        for (int i = tid; i < 8 * 64; i += NT) {
            const int bg = i >> 6, d = i & 63;
            p.kcb[((size_t)bg * 512 + 511) * 64 + d] = 0;
            p.vcT[(((size_t)bg * 8 + 7) * 64 + d) * 64 + 63] = 0;
        }
    }
    {
        const int gtid = bid * NT + tid, gnt = nb * NT;
        convert_wT(p.w_in, D_, CIN, p.winT, 3328, [](int j) {
            const int t = j >> 8, s = j & 255;
            if (t < 5) {
                const int bj = s >> 7, wc = (s >> 5) & 3, n = (s >> 4) & 1, i = s & 15;
                const int dim = 32 * bj + 8 * (i >> 2) + 4 * n + (i & 3), hq = 4 * t + wc;
                int hb;
                if (hq < 8) hb = 64 * hq;
                else { const int k = (hq - 8) >> 1; hb = (k == 0 ? 512 : (k == 1 ? 640 : (k == 2 ? 768 : (k == 3 ? 1024 : (k == 4 ? 896 : 1152))))) + 64 * (hq & 1); }
                return hb + dim;
            }
            const int c = (s & ~31) + perm32(s & 31);
            if (t < 12) return 1304 + (t - 5) * 256 + c;
            return c < 24 ? 1280 + c : -1; }, gtid, gnt);
        convert_wT(p.w_in, D_, CIN, p.wgT, 2048, [](int j) { return 3096 + (j & ~31) + perm32(j & 31); }, gtid, gnt);
        convert_wT(p.wpa, 512, D_, p.wpaT, 1024, [](int j) { return (j & ~31) + perm32(j & 31); }, gtid, gnt);
        convert_wT(p.wpb, 512, D_, p.wpbT, 1024, [](int j) { return (j & ~31) + perm32(j & 31); }, gtid, gnt);
        convert_wT(p.wout, D_, D_, p.woutT, 1024, [](int j) { return j; }, gtid, gnt);
        convert_wT(p.w2, 64, 512, p.w2T, 512, [](int j) { return j; }, gtid, gnt);
        convert_wT(p.w1_k, 2048, 256, p.cw1Tk, 256, [](int j) { return j; }, gtid, gnt);
        convert_wT(p.w1_v, 2048, 256, p.cw1Tv, 256, [](int j) { return j; }, gtid, gnt);
        convert_wT(p.w2_k, 256, 64, p.cw2Tk, 128, [](int j) { return j < 64 ? j : -1; }, gtid, gnt);
        convert_wT(p.w2_v, 256, 64, p.cw2Tv, 128, [](int j) { return j < 64 ? j : -1; }, gtid, gnt);
        convert_wT(p.a2, 64, 512, p.a2T, 512, [](int j) { return j; }, gtid, gnt);
        convert_wT(p.g2, 128, 512, p.g2T, 512, [](int j) { return j; }, gtid, gnt);
    }
    for (int row = bid * NW + wv; row < NTOK; row += nb * NW) {
        const float* xr = p.x + (size_t)row * D_;
        float v[16];
        float ss = 0.f;
#pragma unroll
        for (int i = 0; i < 4; i++) {
            float4 t = *(const float4*)&xr[i * 256 + lane * 4];
            v[4 * i] = t.x; v[4 * i + 1] = t.y; v[4 * i + 2] = t.z; v[4 * i + 3] = t.w;
            ss += t.x * t.x + t.y * t.y + t.z * t.z + t.w * t.w;
        }
        ss = wave_sum(ss);
        const float rs = rsqrtf(ss * (1.f / D_) + 1e-6f);
#pragma unroll
        for (int i = 0; i < 4; i++) {
            const int c = i * 256 + lane * 4;
            float4 g = *(const float4*)&p.g_mix[c];
            uint2 o;
            o.x = pack2(v[4 * i] * rs * g.x, v[4 * i + 1] * rs * g.y);
            o.y = pack2(v[4 * i + 2] * rs * g.z, v[4 * i + 3] * rs * g.w);
            *(uint2*)&p.hbuf[(size_t)row * D_ + c] = o;
        }
    }
}

__device__ __forceinline__ uint4 pack8(const f32x4& a, const f32x4& b) { uint4 o; o.x = pack2(a[0], a[1]); o.y = pack2(a[2], a[3]); o.z = pack2(b[0], b[1]); o.w = pack2(b[2], b[3]); return o; }
struct EpiInproj {
    const P* pp;
    __device__ __forceinline__ void operator()(const f32x4 (&acc)[2][2][4][2], const GUnit& u, int, int, int, int) const {
        const int t2_ = get_tid(), wid_ = __builtin_amdgcn_readfirstlane(t2_ >> 6), wr = wid_ >> 2, wc = wid_ & 3, fr = t2_ & 15, fq = (t2_ >> 4) & 3;
        const P& p = *pp;
        const int pn = u.pn;
        const int rowb = u.pm * 256 + wr * 64;
        if (pn < 4) {
            const int hq = 4 * pn + wc;
            const bool rope = !(pn == 2 && wc >= 2);
            u16* dst; size_t rstride; int cofs;
            if (pn < 2) { dst = p.q; rstride = 512; cofs = hq * 64; }
            else { dst = (pn == 2) ? (wc < 2 ? p.kc : p.vc) : (wc < 2 ? p.ksl : p.kwn); rstride = 64; cofs = 0; }
            const int g = wc & 1;
#pragma unroll
            for (int ai = 0; ai < 2; ++ai)
#pragma unroll
                for (int m = 0; m < 4; ++m) {
                    const int row = rowb + ai * 128 + m * 16 + fr;
                    f32x4 o1[2], o2[2];
#pragma unroll
                    for (int n = 0; n < 2; ++n) { o1[n] = acc[ai][0][m][n]; o2[n] = acc[ai][1][m][n]; }
                    if (rope) {
                        const double posd = (double)p.pos[row];
#pragma unroll
                        for (int n = 0; n < 2; ++n)
#pragma unroll
                            for (int j = 0; j < 4; ++j) {
                                const double tr = posd * ROPE_FREQ[8 * fq + 4 * n + j] * 0.15915494309189535;
                                const float fr_ = (float)(tr - rint(tr));
                                const float cs = __builtin_amdgcn_cosf(fr_), sn = __builtin_amdgcn_sinf(fr_);
                                const float x1 = o1[n][j], x2 = o2[n][j];
                                o1[n][j] = x1 * cs - x2 * sn; o2[n][j] = x1 * sn + x2 * cs;
                            }
                    }
                    size_t ro;
                    if (pn < 2) {
#pragma unroll
                        for (int n = 0; n < 2; ++n)
#pragma unroll
                            for (int j = 0; j < 4; ++j) { o1[n][j] *= QSCALE; o2[n][j] *= QSCALE; }
                        ro = (size_t)row * 512 + cofs + 8 * fq;
                    } else {
                        const int bb = row >> 13, t = row & (S_ - 1);
                        ro = ((size_t)(bb * 2 + g) * S_ + t) * 64 + 8 * fq;
                    }
                    *(uint4*)&dst[ro] = pack8(o1[0], o1[1]);
                    *(uint4*)&dst[ro + 32] = pack8(o2[0], o2[1]);
                }
        } else if (pn == 4) {
            u16* dst = (wc < 2) ? p.vslT : p.vwnT;
            const int g = wc & 1;
#pragma unroll
            for (int ai = 0; ai < 2; ++ai) {
                const int r0 = rowb + ai * 128, bb = r0 >> 13, tb = r0 & (S_ - 1);
                u16* base = dst + ((size_t)(bb * 2 + g) * 128 + (tb >> 6)) * 4096;
#pragma unroll
                for (int m = 0; m < 4; ++m)
#pragma unroll
                    for (int bj = 0; bj < 2; ++bj)
#pragma unroll
                        for (int n = 0; n < 2; ++n)
#pragma unroll
                            for (int j = 0; j < 4; ++j)
                                base[(32 * bj + 8 * fq + 4 * n + j) * 64 + m * 16 + fr] = f2bf(acc[ai][bj][m][n][j]);
            }
        } else if (pn < 12) {
            const int cb = (pn - 5) * 256 + wc * 32 + 8 * fq;
#pragma unroll
            for (int ai = 0; ai < 2; ++ai)
#pragma unroll
                for (int m = 0; m < 4; ++m) {
                    const size_t ro = (size_t)(rowb + ai * 128 + m * 16 + fr) * CRW + cb;
#pragma unroll
                    for (int bj = 0; bj < 2; ++bj) *(uint4*)&p.prw[ro + bj * 128] = pack8(acc[ai][bj][m][0], acc[ai][bj][m][1]);
                }
        } else {
            if (wc == 0 && fq < 3) {
#pragma unroll
                for (int ai = 0; ai < 2; ++ai)
#pragma unroll
                    for (int m = 0; m < 4; ++m) {
                        const size_t ro = (size_t)(rowb + ai * 128 + m * 16 + fr) * 24 + 8 * fq;
#pragma unroll
                        for (int n = 0; n < 2; ++n) {
                            float4 o; o.x = sigmoidf_(acc[ai][0][m][n][0]); o.y = sigmoidf_(acc[ai][0][m][n][1]); o.z = sigmoidf_(acc[ai][0][m][n][2]); o.w = sigmoidf_(acc[ai][0][m][n][3]);
                            *(float4*)&p.nsag[ro + 4 * n] = o;
                        }
                    }
            }
        }
    }
};
__device__ void ph_inproj(const P& p, int bid, int nb, char* smem) {
    DenseSched S; S.init(NTOK, 3328, D_, p.winT, nb, bid);
    EpiInproj E{&p};
    gemm256(smem, (const char*)p.hbuf, D_, S, E);
}

__device__ __forceinline__ float gelu_tanh(float x) {
    const float c = 0.7978845608028654f;
    return 0.5f * x * (1.f + tanhf(c * (x + 0.044715f * x * x * x)));
}
__device__ void ph_compress(const P& p, int bid, int nb, char* smem) {
    u16* sm = (u16*)smem;
    const int tid = get_tid(), lane = tid & 63, wv = tid >> 6;
    const int wm = wv >> 1, wn = wv & 1;
    for (int it = bid; it < 32; it += nb) {
        const int rt = it & 1, g = (it >> 1) & 1, b = (it >> 2) & 3, kv = it >> 4;
        const int bg = b * 2 + g, i0 = rt * 256;
        const u16* src = (kv ? p.vc : p.kc) + (size_t)bg * S_ * 64;
        const u16* w1T = kv ? p.cw1Tv : p.cw1Tk;
        const u16* w2T = kv ? p.cw2Tv : p.cw2Tk;
        float* cb1 = (float*)(smem + 3 * G_TILE);
        __syncthreads();
        { const int t2 = get_tid(); if (t2 < 256) { float a = 0.f; for (int q = 0; q < 64; q++) a += p.cb1k[q * 512 + kv * 256 + t2]; cb1[t2] = a; } }
        __syncthreads();
        const float* b1 = kv ? p.b1_v : p.b1_k;
        const float* b2 = kv ? p.b2_v : p.b2_k;
        u16* hidp = p.chid + (size_t)it * 256 * 256;
        auto arow = [&](int r) { int i = i0 + r; if (i > 510) i = 510; return src + (size_t)i * 1024; };
#pragma unroll 1
        for (int ct = 0; ct < 2; ct++) {
            f32x4 acc[4][4];
            gemm_core<false>(2048, arow, w1T + (size_t)ct * 128 * 2048, 2048, acc, sm);
            const int le = get_tid() & 63;
#pragma unroll
            for (int mt = 0; mt < 4; mt++) {
                const int r = wm * 64 + mt * 16 + (le & 15);
#pragma unroll
                for (int nt = 0; nt < 4; nt++) {
                    const int col = ct * 128 + wn * 64 + nt * 16 + (le >> 4) * 4;
                    const float4 c1 = *(const float4*)&cb1[col], bb1 = *(const float4*)&b1[col];
                    f32x4 o;
                    o[0] = gelu_tanh(acc[mt][nt][0] + c1.x + bb1.x); o[1] = gelu_tanh(acc[mt][nt][1] + c1.y + bb1.y);
                    o[2] = gelu_tanh(acc[mt][nt][2] + c1.z + bb1.z); o[3] = gelu_tanh(acc[mt][nt][3] + c1.w + bb1.w);
                    *(uint2*)&hidp[r * 256 + col] = pack4(o);
                }
            }
        }
        __syncthreads();
        {
            f32x4 acc[4][4];
            gemm_core<true>(256, [&](int r) { return hidp + (size_t)r * 256; }, w2T, 256, acc, sm);
            if (wn == 0) {
#pragma unroll
                for (int mt = 0; mt < 4; mt++)
#pragma unroll
                    for (int nt = 0; nt < 4; nt++) {
                        const int d = nt * 16 + (lane & 15);
                        const int ib = i0 + wm * 64 + mt * 16 + (lane >> 4) * 4;
                        float o[4];
#pragma unroll
                        for (int j = 0; j < 4; j++) o[j] = (ib + j < NCMP) ? (acc[mt][nt][j] + b2[d]) : 0.f;
                        if (kv == 0) {
#pragma unroll
                            for (int j = 0; j < 4; j++) p.kcb[((size_t)bg * 512 + ib + j) * 64 + d] = f2bf(o[j]);
                        } else {
                            uint2 ov; ov.x = pack2(o[0], o[1]); ov.y = pack2(o[2], o[3]);
                            *(uint2*)&p.vcT[(((size_t)bg * 8 + (ib >> 6)) * 64 + d) * 64 + (ib & 63)] = ov;
                        }
                    }
            }
        }
        __syncthreads();
    }
}

#ifndef NSAPROBE
#define NSAPROBE 0
#endif
#define NSA_TS(k) if (NSAPROBE == k) ts_ = __builtin_amdgcn_s_memrealtime();
#define NSA_TE(k) if (NSAPROBE == k) tacc_ += __builtin_amdgcn_s_memrealtime() - ts_;
constexpr int KSTR = 72;
struct Sub { f32x4 O[4]; float m, l; };
#define NEG_BIG (-1.0e30f)

__device__ __forceinline__ float xq_max(float v) {
    return xrow_max(v);
}
__device__ __forceinline__ float xq_sum(float v) {
    return xrow_sum(v);
}
template <bool MASK, bool IMP, bool PV>
__device__ __forceinline__ void nsa_visit(const u16* Ks, const u16* Vs, const u16* qrow, Sub& s, int lo, int hi, int lane, float* e, float* p3) {
    const int kr = lane & 15, qq = lane >> 4;
    f32x4 S[4];
    const int qsw = ((kr & 3) >> 1) ^ ((kr >> 2) << 1);
    const bf16x8 qf0 = *(const bf16x8*)(qrow + ((qq ^ qsw) << 3)), qf1 = *(const bf16x8*)(qrow + (((4 + qq) ^ qsw) << 3));
    bf16x8 kf[4][2];
    const int swz = kr >> 1;
    {
        const char* kb_ = (const char*)Ks + kr * 128;
        const int ko0 = (qq ^ swz) << 4, ko1 = ko0 ^ 64;
#pragma unroll
        for (int kt = 0; kt < 4; kt++) { kf[kt][0] = *(const bf16x8*)(kb_ + kt * 2048 + ko0); kf[kt][1] = *(const bf16x8*)(kb_ + kt * 2048 + ko1); }
    }
    __builtin_amdgcn_sched_barrier(0);
#pragma unroll
    for (int kt = 0; kt < 4; kt++) {
        S[kt] = __builtin_amdgcn_mfma_f32_16x16x32_bf16(kf[kt][0], qf0, f32x4{0.f, 0.f, 0.f, 0.f}, 0, 0, 0);
        S[kt] = __builtin_amdgcn_mfma_f32_16x16x32_bf16(kf[kt][1], qf1, S[kt], 0, 0, 0);
    }
    union VF { bf16x8 v; uint2 h[2]; };
    float mx = NEG_BIG;
#pragma unroll
    for (int kt = 0; kt < 4; kt++)
#pragma unroll
        for (int r = 0; r < 4; r++) {
            if (MASK) { const int o = kt * 16 + qq * 4 + r; if (o < lo || o > hi) S[kt][r] = -INFINITY; }
            mx = fmaxf(mx, S[kt][r]);
        }
    mx = xq_max(mx);
    const float mnew = fmaxf(s.m, mx);
    const float alpha = __builtin_amdgcn_exp2f(s.m - mnew);
    s.m = mnew;
    float psum = 0.f;
#pragma unroll
    for (int kt = 0; kt < 4; kt++) {
#pragma unroll
        for (int r = 0; r < 4; r++) { S[kt][r] = __builtin_amdgcn_exp2f(S[kt][r] - mnew); }
        const float ee = (S[kt][0] + S[kt][1]) + (S[kt][2] + S[kt][3]);
        psum += ee;
        if (IMP) { e[kt] = ee; p3[kt] = S[kt][3]; }
    }
    s.l = s.l * alpha + psum;
    if (PV) {
        if (!__all(alpha == 1.f)) {
#pragma unroll
            for (int dt = 0; dt < 4; dt++)
#pragma unroll
                for (int r = 0; r < 4; r++) s.O[dt][r] *= alpha;
        }
        VF vf[4][2];
        {
            const char* vb_ = (const char*)Vs + kr * 128 + (qq & 1) * 8;
            const int vo = ((qq >> 1) ^ swz) << 4;
#pragma unroll
            for (int dt = 0; dt < 4; dt++)
#pragma unroll
                for (int k2 = 0; k2 < 2; k2++) {
                    vf[dt][k2].h[0] = *(const uint2*)(vb_ + dt * 2048 + (vo ^ (k2 * 64)));
                    vf[dt][k2].h[1] = *(const uint2*)(vb_ + dt * 2048 + (vo ^ (k2 * 64 + 32)));
                }
        }
        bf16x8 pb[2];
#pragma unroll
        for (int k2 = 0; k2 < 2; k2++) {
            union { bf16x8 v; unsigned u[4]; } t;
            t.u[0] = pack2(S[2 * k2][0], S[2 * k2][1]); t.u[1] = pack2(S[2 * k2][2], S[2 * k2][3]);
            t.u[2] = pack2(S[2 * k2 + 1][0], S[2 * k2 + 1][1]); t.u[3] = pack2(S[2 * k2 + 1][2], S[2 * k2 + 1][3]);
            pb[k2] = t.v;
        }
        __builtin_amdgcn_sched_barrier(0);
#pragma unroll
        for (int dt = 0; dt < 4; dt++)
#pragma unroll
            for (int k2 = 0; k2 < 2; k2++) s.O[dt] = __builtin_amdgcn_mfma_f32_16x16x32_bf16(vf[dt][k2].v, pb[k2], s.O[dt], 0, 0, 0);
    }
}
template <bool IMP, bool PV>
__device__ __forceinline__ void nsa_visit2(const u16* Ks, const u16* Vs, const u16* qrow0, const u16* qrow1, Sub (&st)[2], const int (&hi)[2], int lane, float (&e)[2][4], float (&p3)[2][4]) {
    const int kr = lane & 15, qq = lane >> 4;
    const int qsw = ((kr & 3) >> 1) ^ ((kr >> 2) << 1);
    bf16x8 qf0[2], qf1[2];
    qf0[0] = *(const bf16x8*)(qrow0 + ((qq ^ qsw) << 3)); qf1[0] = *(const bf16x8*)(qrow0 + (((4 + qq) ^ qsw) << 3));
    qf0[1] = *(const bf16x8*)(qrow1 + ((qq ^ qsw) << 3)); qf1[1] = *(const bf16x8*)(qrow1 + (((4 + qq) ^ qsw) << 3));
    bf16x8 kf[4][2];
    const int swz = kr >> 1;
    {
        const char* kb_ = (const char*)Ks + kr * 128;
        const int ko0 = (qq ^ swz) << 4, ko1 = ko0 ^ 64;
#pragma unroll
        for (int kt = 0; kt < 4; kt++) { kf[kt][0] = *(const bf16x8*)(kb_ + kt * 2048 + ko0); kf[kt][1] = *(const bf16x8*)(kb_ + kt * 2048 + ko1); }
    }
    __builtin_amdgcn_sched_barrier(0);
    f32x4 S[2][4];
#pragma unroll
    for (int kt = 0; kt < 4; kt++)
#pragma unroll
        for (int q = 0; q < 2; q++) {
            S[q][kt] = __builtin_amdgcn_mfma_f32_16x16x32_bf16(kf[kt][0], qf0[q], f32x4{0.f, 0.f, 0.f, 0.f}, 0, 0, 0);
            S[q][kt] = __builtin_amdgcn_mfma_f32_16x16x32_bf16(kf[kt][1], qf1[q], S[q][kt], 0, 0, 0);
        }
    union VF { bf16x8 v; uint2 h[2]; };
    VF vf[4][2];
    bf16x8 pb[2][2];
#pragma unroll
    for (int q = 0; q < 2; q++) {
        Sub& s = st[q];
        float mx = NEG_BIG;
#pragma unroll
        for (int kt = 0; kt < 4; kt++)
#pragma unroll
            for (int r = 0; r < 4; r++) {
                const int o = kt * 16 + qq * 4 + r; if (o > hi[q]) S[q][kt][r] = -INFINITY;
                mx = fmaxf(mx, S[q][kt][r]);
            }
        mx = xq_max(mx);
        const float mnew = fmaxf(s.m, mx);
        const float alpha = __builtin_amdgcn_exp2f(s.m - mnew);
        s.m = mnew;
        float psum = 0.f;
#pragma unroll
        for (int kt = 0; kt < 4; kt++) {
#pragma unroll
            for (int r = 0; r < 4; r++) { S[q][kt][r] = __builtin_amdgcn_exp2f(S[q][kt][r] - mnew); }
            const float ee = (S[q][kt][0] + S[q][kt][1]) + (S[q][kt][2] + S[q][kt][3]);
            psum += ee;
            if (IMP) { e[q][kt] = ee; p3[q][kt] = S[q][kt][3]; }
        }
        s.l = s.l * alpha + psum;
        if (PV) {
#pragma unroll
            for (int dt = 0; dt < 4; dt++)
#pragma unroll
                for (int r = 0; r < 4; r++) s.O[dt][r] *= alpha;
#pragma unroll
            for (int k2 = 0; k2 < 2; k2++) {
                union { bf16x8 v; unsigned u[4]; } t;
                t.u[0] = pack2(S[q][2 * k2][0], S[q][2 * k2][1]); t.u[1] = pack2(S[q][2 * k2][2], S[q][2 * k2][3]);
                t.u[2] = pack2(S[q][2 * k2 + 1][0], S[q][2 * k2 + 1][1]); t.u[3] = pack2(S[q][2 * k2 + 1][2], S[q][2 * k2 + 1][3]);
                pb[q][k2] = t.v;
            }
            if (q == 0) {
                const char* vb_ = (const char*)Vs + kr * 128 + (qq & 1) * 8;
                const int vo = ((qq >> 1) ^ swz) << 4;
#pragma unroll
                for (int dt = 0; dt < 4; dt++)
#pragma unroll
                    for (int k2 = 0; k2 < 2; k2++) {
                        vf[dt][k2].h[0] = *(const uint2*)(vb_ + dt * 2048 + (vo ^ (k2 * 64)));
                        vf[dt][k2].h[1] = *(const uint2*)(vb_ + dt * 2048 + (vo ^ (k2 * 64 + 32)));
                    }
            }
        }
    }
    if (PV) {
        __builtin_amdgcn_sched_barrier(0);
#pragma unroll
        for (int dt = 0; dt < 4; dt++)
#pragma unroll
            for (int k2 = 0; k2 < 2; k2++)
#pragma unroll
                for (int q = 0; q < 2; q++) st[q].O[dt] = __builtin_amdgcn_mfma_f32_16x16x32_bf16(vf[dt][k2].v, pb[q][k2], st[q].O[dt], 0, 0, 0);
    }
}
template <int MMODE, bool FIXM, int NQ>
__device__ __forceinline__ void nsa_visit_gn(const u16* Ks, const u16* Vs, const u16* qs, float* Os, float* Ms, float* Ls, const int (&tok)[NQ], const bool (&valid)[NQ], int lane) {
    const int kr = lane & 15, qq = lane >> 4, hh = kr & 3;
    int row[NQ], osw[NQ]; float* orow[NQ];
    f32x4 O[NQ][4]; float m_old[NQ], l_old[NQ]; bf16x8 qf0[NQ], qf1[NQ];
#pragma unroll
    for (int q = 0; q < NQ; q++) {
        row[q] = tok[q] * 4 + hh; orow[q] = Os + row[q] * 64;
        osw[q] = hh ^ ((tok[q] & 3) << 2);
#pragma unroll
        for (int dt = 0; dt < 4; dt++) O[q][dt] = *(const f32x4*)(orow[q] + (((dt * 4 + qq) ^ osw[q]) << 2));
        m_old[q] = Ms[row[q]]; l_old[q] = Ls[row[q]];
        const u16* qrow = qs + row[q] * 64;
        const int qsw = (hh >> 1) ^ ((tok[q] & 3) << 1);
        qf0[q] = *(const bf16x8*)(qrow + ((qq ^ qsw) << 3)); qf1[q] = *(const bf16x8*)(qrow + (((4 + qq) ^ qsw) << 3));
    }
    bf16x8 kf[4][2];
    const int swz = kr >> 1;
    {
        const char* kb_ = (const char*)Ks + kr * 128;
        const int ko0 = (qq ^ swz) << 4, ko1 = ko0 ^ 64;
#pragma unroll
        for (int kt = 0; kt < 4; kt++) { kf[kt][0] = *(const bf16x8*)(kb_ + kt * 2048 + ko0); kf[kt][1] = *(const bf16x8*)(kb_ + kt * 2048 + ko1); }
    }
    __builtin_amdgcn_sched_barrier(0);
    f32x4 S[NQ][4];
#pragma unroll
    for (int kt = 0; kt < 4; kt++)
#pragma unroll
        for (int q = 0; q < NQ; q++) {
            S[q][kt] = __builtin_amdgcn_mfma_f32_16x16x32_bf16(kf[kt][0], qf0[q], f32x4{0.f, 0.f, 0.f, 0.f}, 0, 0, 0);
            S[q][kt] = __builtin_amdgcn_mfma_f32_16x16x32_bf16(kf[kt][1], qf1[q], S[q][kt], 0, 0, 0);
        }
    union VF { bf16x8 v; uint2 h[2]; };
    VF vf[4][2];
#define NSA_LDV { const char* vb_ = (const char*)Vs + kr * 128 + (qq & 1) * 8; const int vo = ((qq >> 1) ^ swz) << 4; \
        _Pragma("unroll") for (int dt = 0; dt < 4; dt++) _Pragma("unroll") for (int k2 = 0; k2 < 2; k2++) { \
            vf[dt][k2].h[0] = *(const uint2*)(vb_ + dt * 2048 + (vo ^ (k2 * 64))); vf[dt][k2].h[1] = *(const uint2*)(vb_ + dt * 2048 + (vo ^ (k2 * 64 + 32))); } }
    if (NQ == 1) NSA_LDV
    bf16x8 pb[NQ][2];
#pragma unroll
    for (int q = 0; q < NQ; q++) {
        float mx = NEG_BIG;
#pragma unroll
        for (int kt = 0; kt < 4; kt++)
#pragma unroll
            for (int r = 0; r < 4; r++) {
                if (MMODE == 1) { const int o = kt * 16 + qq * 4 + r; if (o > tok[q]) S[q][kt][r] = -INFINITY; }
                if (MMODE == 2) { const int o = kt * 16 + qq * 4 + r; if (o <= tok[q]) S[q][kt][r] = -INFINITY; }
                if (FIXM) { if (!valid[q]) S[q][kt][r] = -INFINITY; } else mx = fmaxf(mx, S[q][kt][r]);
            }
        float mnew = m_old[q], alpha = 1.f;
        if (!FIXM) {
            if (!valid[q]) mx = NEG_BIG;
            mx = xq_max(mx);
            mnew = fmaxf(m_old[q], mx);
            alpha = __builtin_amdgcn_exp2f(m_old[q] - mnew);
        }
        float psum = 0.f;
#pragma unroll
        for (int kt = 0; kt < 4; kt++) {
#pragma unroll
            for (int r = 0; r < 4; r++) { S[q][kt][r] = __builtin_amdgcn_exp2f(S[q][kt][r] - mnew); }
            psum += (S[q][kt][0] + S[q][kt][1]) + (S[q][kt][2] + S[q][kt][3]);
        }
        psum = xq_sum(psum);
        if (FIXM) { if (valid[q] && qq == 0) Ls[row[q]] = l_old[q] + psum; }
        else {
            if (valid[q] && qq == 0) { Ms[row[q]] = mnew; Ls[row[q]] = l_old[q] * alpha + psum; }
#pragma unroll
            for (int dt = 0; dt < 4; dt++)
#pragma unroll
                for (int r = 0; r < 4; r++) O[q][dt][r] *= alpha;
        }
#pragma unroll
        for (int k2 = 0; k2 < 2; k2++) {
            union { bf16x8 v; unsigned u[4]; } t;
            t.u[0] = pack2(S[q][2 * k2][0], S[q][2 * k2][1]); t.u[1] = pack2(S[q][2 * k2][2], S[q][2 * k2][3]);
            t.u[2] = pack2(S[q][2 * k2 + 1][0], S[q][2 * k2 + 1][1]); t.u[3] = pack2(S[q][2 * k2 + 1][2], S[q][2 * k2 + 1][3]);
            pb[q][k2] = t.v;
        }
        if (NQ == 2 && q == 0) { asm volatile("" ::: "memory"); NSA_LDV }
    }
#undef NSA_LDV
    __builtin_amdgcn_sched_barrier(0);
#pragma unroll
    for (int dt = 0; dt < 4; dt++)
#pragma unroll
        for (int k2 = 0; k2 < 2; k2++)
#pragma unroll
            for (int q = 0; q < NQ; q++) O[q][dt] = __builtin_amdgcn_mfma_f32_16x16x32_bf16(vf[dt][k2].v, pb[q][k2], O[q][dt], 0, 0, 0);
#pragma unroll
    for (int q = 0; q < NQ; q++)
        if (valid[q]) {
#pragma unroll
            for (int dt = 0; dt < 4; dt++) *(f32x4*)(orow[q] + (((dt * 4 + qq) ^ osw[q]) << 2)) = O[q][dt];
        }
}
template <int MMODE, bool FIXM>
__device__ __forceinline__ void nsa_visit_g(const u16* Ks, const u16* Vs, const u16* qs, float* Os, float* Ms, float* Ls, int tok, bool valid, int lane) {
    const int tk[1] = {tok}; const bool vl[1] = {valid};
    nsa_visit_gn<MMODE, FIXM, 1>(Ks, Vs, qs, Os, Ms, Ls, tk, vl, lane);
}
__device__ __forceinline__ void nsa_fold_lds(float* Os, float* Ms, float* Ls, int row, int qq, int hh, f32x4 (&T)[4], float gate, bool reset) {
    const float lt = Ls[row];
    const float sc = (lt > 0.f) ? gate / lt : 0.f;
#pragma unroll
    for (int dt = 0; dt < 4; dt++) {
        float* op = Os + row * 64 + (((dt * 4 + qq) ^ hh ^ (((row >> 2) & 3) << 2)) << 2);
        const f32x4 o = *(const f32x4*)op;
#pragma unroll
        for (int r = 0; r < 4; r++) T[dt][r] += o[r] * sc;
        if (reset) *(f32x4*)op = f32x4{0.f, 0.f, 0.f, 0.f};
    }
    asm volatile("s_waitcnt lgkmcnt(0)" ::: "memory");
    if (reset && qq == 0) { Ms[row] = NEG_BIG; Ls[row] = 0.f; }
}
template <int MODE>
__device__ __forceinline__ void nsa_fold(Sub& s, f32x4 (&T)[4], float gate) {
    const float lt = xq_sum(s.l);
    const float sc = (lt > 0.f) ? gate / lt : 0.f;
#pragma unroll
    for (int dt = 0; dt < 4; dt++)
#pragma unroll
        for (int r = 0; r < 4; r++) {
            const float v = s.O[dt][r] * sc;
            T[dt][r] = (MODE == 1) ? T[dt][r] + v : v;
            s.O[dt][r] = 0.f;
        }
    s.m = NEG_BIG; s.l = 0.f;
}

constexpr int NSA_R = 3;
template <bool HASV, class KSrc, class VSrc, class Body>
__device__ __forceinline__ void nsa_stream(char* ring, int n, KSrc ksrc, VSrc vsrc, Body body) {
    const int t = get_tid();
    const int so = (t >> 3) * 64 + (((t & 7) ^ ((t >> 4) & 7)) << 3);
    char* dl = ring + t * 16;
#define NSA_ISSUE(i, slot) { glds16(ksrc(i) + so, dl + (slot) * 16384); if (HASV) glds16(vsrc(i) + so, dl + (slot) * 16384 + 8192); }
    asm volatile("s_waitcnt lgkmcnt(0)" ::: "memory");
    __builtin_amdgcn_s_barrier();
    if (n > 0) NSA_ISSUE(0, 0)
    if (n > 1) NSA_ISSUE(1, 1)
    int slot = 0;
    for (int i = 0; i < n; i++) {
        if (i + 1 < n) { if (HASV) asm volatile("s_waitcnt vmcnt(2)" ::: "memory"); else asm volatile("s_waitcnt vmcnt(1)" ::: "memory"); }
        else asm volatile("s_waitcnt vmcnt(0)" ::: "memory");
        asm volatile("s_waitcnt lgkmcnt(0)" ::: "memory");
        __builtin_amdgcn_s_barrier();
        asm volatile("" ::: "memory");
        const int sl2 = (slot == 0) ? 2 : slot - 1;
        if (i + 2 < n) NSA_ISSUE(i + 2, sl2)
        body(i, (const u16*)(ring + slot * 16384), (const u16*)(ring + slot * 16384 + 8192));
        slot = (slot == 2) ? 0 : slot + 1;
    }
#undef NSA_ISSUE
}
#define NSA_TOK(u) const int t3_ = get_tid(); const size_t ntk_ = (size_t)b * S_ + t0 + 8 * (t3_ >> 6) + 4 * (u) + ((t3_ & 15) >> 2); const int hd_ = g * 4 + (t3_ & 3);
__device__ void ph_nsa(const P& p, int bid, int nb, char* smem) {
    char* ring = smem;
    unsigned* selm = (unsigned*)(smem + NSA_R * 16384);
    int* blist = (int*)(selm + 256);
    int* nlistp = blist + 128;
    int* lcnt = nlistp + 4;
    unsigned char* lists = (unsigned char*)(lcnt + 128);
    float* Ms = (float*)(lists + 128 * 64);
    float* Ls = Ms + 256;
    float* Os = Ls + 256;
    float* impl = Os;
    u16* qs = (u16*)(Os + 64 * 4 * 64);
    unsigned long long ts_ = 0, tacc_ = 0;
    const int nitems = B_ * 2 * 128;
    for (int rr = 0;; rr++) {
        const int it = (rr & 1) ? (rr + 1) * nb - 1 - bid : rr * nb + bid;
        if (rr * nb >= nitems) break;
        if (it >= nitems) continue;
        const int tid = get_tid(), lane = tid & 63, wv = tid >> 6;
        const int kr = lane & 15, qq = lane >> 4, ts = kr >> 2, hh = kr & 3;
        float* myimp = impl + wv * (32 * 2 * 16);
        const int tt = 127 - (it >> 3);
        const int bg = it & 7, b = bg >> 1, g = bg & 1;
        const int t0 = tt * 64, cur = tt;
        const int head = g * 4 + hh;
        Sub st[2];
        f32x4 T[2][4];
        int tl[2]; size_t ntok[2];
        __syncthreads();
#pragma unroll
        for (int u = 0; u < 2; u++) {
            tl[u] = 8 * wv + 4 * u + ts;
            ntok[u] = (size_t)b * S_ + t0 + tl[u];
#pragma unroll
            for (int ks = 0; ks < 2; ks++) *(bf16x8*)&qs[(tl[u] * 4 + hh) * 64 + (((ks * 4 + qq) ^ (hh >> 1) ^ ((tl[u] & 3) << 1)) << 3)] = *(const bf16x8*)&p.q[ntok[u] * 512 + head * 64 + ks * 32 + qq * 8];
#pragma unroll
            for (int dt = 0; dt < 4; dt++) st[u].O[dt] = f32x4{0.f, 0.f, 0.f, 0.f};
            st[u].m = NEG_BIG; st[u].l = 0.f;
        }
        const u16* kcb = p.kcb + (size_t)bg * 512 * 64;
        const u16* vcT = p.vcT + (size_t)bg * 8 * 4096;
        int nv[2];
#pragma unroll
        for (int u = 0; u < 2; u++) { const int t = t0 + tl[u]; nv[u] = (t >= 31) ? min((t - 31) / 16 + 1, NCMP) : 0; }
        const int tmax = t0 + 63;
        const int nvmax = (tmax >= 31) ? min((tmax - 31) / 16 + 1, NCMP) : 0;
        const int nvb = (nvmax + 63) >> 6;
        NSA_TS(1)
        __syncthreads();
        nsa_stream<false>(ring, nvb, [&](int kb) { return kcb + (size_t)kb * 4096; }, [&](int kb) { return vcT + (size_t)kb * 4096; },
            [&](int kb, const u16* Ks, const u16* Vs) {
                const int hi2[2] = {nv[0] - kb * 64 - 1, nv[1] - kb * 64 - 1};
                float e_[2][4], p3_[2][4];
                nsa_visit2<false, false>(Ks, Vs, qs + (tl[0] * 4 + hh) * 64, qs + (tl[1] * 4 + hh) * 64, st, hi2, lane, e_, p3_);
            });
        float invl[2];
#pragma unroll
        for (int u = 0; u < 2; u++) { const float lt = xq_sum(st[u].l); invl[u] = (lt > 0.f) ? 1.f / lt : 0.f; st[u].l = 0.f; }
        float carry[2] = {0.f, 0.f};
        nsa_stream<true>(ring, nvb, [&](int kb) { return kcb + (size_t)kb * 4096; }, [&](int kb) { return vcT + (size_t)kb * 4096; },
            [&](int kb, const u16* Ks, const u16* Vs) {
            const int hi2[2] = {nv[0] - kb * 64 - 1, nv[1] - kb * 64 - 1};
            float e_[2][4], p3_[2][4];
            nsa_visit2<true, true>(Ks, Vs, qs + (tl[0] * 4 + hh) * 64, qs + (tl[1] * 4 + hh) * 64, st, hi2, lane, e_, p3_);
#pragma unroll
            for (int u = 0; u < 2; u++) {
#pragma unroll
                for (int kt = 0; kt < 4; kt++) {
                    float ev = e_[u][kt] * invl[u], pv = p3_[u][kt] * invl[u];
                    ev += dppf<0xB1>(ev); ev += dppf<0x4E>(ev);
                    pv += dppf<0xB1>(pv); pv += dppf<0x4E>(pv);
                    const float sh = __shfl(pv, (lane - 16) & 63, 64);
                    const float nbv = (qq == 0) ? carry[u] : sh;
                    carry[u] = sh;
                    myimp[((kb * 4 + kt) * 2 + u) * 16 + ts * 4 + qq] = ev + nbv;
                }
            }
            });
        NSA_TE(1)
        NSA_TS(2)
#pragma unroll
        for (int u = 0; u < 2; u++) {
            float mv[8];
#pragma unroll
            for (int i = 0; i < 8; i++) {
                const int kk = 8 * hh + i, j = 4 * kk + qq;
                const float v = myimp[(kk * 2 + u) * 16 + ts * 4 + qq];
                mv[i] = (j >= 1 && j <= cur - 2) ? v : -1.f;
            }
            unsigned sel = 0u;
            const int ncand = max(0, cur - 2);
            const int nforced = (cur >= 2) ? 3 : (cur + 1);
            const int need = 16 - nforced;
            if (ncand <= need) {
#pragma unroll
                for (int i = 0; i < 8; i++) if (mv[i] >= 0.f) sel |= (1u << i);
            } else {
                for (int rnd = 0; rnd < need; rnd++) {
                    const float b01 = fmaxf(mv[0], mv[1]), b23 = fmaxf(mv[2], mv[3]), b45 = fmaxf(mv[4], mv[5]), b67 = fmaxf(mv[6], mv[7]);
                    float best = fmaxf(fmaxf(b01, b23), fmaxf(b45, b67));
                    int bi = 7;
#pragma unroll
                    for (int i = 6; i >= 0; i--) bi = (mv[i] == best) ? i : bi;
                    int bj = (best >= 0.f) ? (4 * (8 * hh + bi) + qq) : 9999;
#define TK_MERGE(ov, oj) { const float v2_ = (ov); const int j2_ = (oj); const bool tk_ = (v2_ > best) || (v2_ == best && j2_ < bj); best = tk_ ? v2_ : best; bj = tk_ ? j2_ : bj; }
                    TK_MERGE(dppf<0xB1>(best), __builtin_amdgcn_update_dpp(0, bj, 0xB1, 0xF, 0xF, true))
                    TK_MERGE(dppf<0x4E>(best), __builtin_amdgcn_update_dpp(0, bj, 0x4E, 0xF, 0xF, true))
                    {
                        auto rv = __builtin_amdgcn_permlane16_swap(__float_as_uint(best), __float_as_uint(best), false, false);
                        auto rj = __builtin_amdgcn_permlane16_swap((unsigned)bj, (unsigned)bj, false, false);
                        float v0 = __uint_as_float(rv[0]), v1 = __uint_as_float(rv[1]); int j0 = (int)rj[0], j1 = (int)rj[1];
                        if (v1 > v0 || (v1 == v0 && j1 < j0)) { v0 = v1; j0 = j1; }
                        rv = __builtin_amdgcn_permlane32_swap(__float_as_uint(v0), __float_as_uint(v0), false, false);
                        rj = __builtin_amdgcn_permlane32_swap((unsigned)j0, (unsigned)j0, false, false);
                        best = __uint_as_float(rv[0]); bj = (int)rj[0];
                        const float v2 = __uint_as_float(rv[1]); const int j2 = (int)rj[1];
                        if (v2 > best || (v2 == best && j2 < bj)) { best = v2; bj = j2; }
                    }
#undef TK_MERGE
                    const bool mine = (bj < 512) && ((bj >> 5) == hh) && ((bj & 3) == qq);
                    const int li = (bj >> 2) & 7;
#pragma unroll
                    for (int i = 0; i < 8; i++) mv[i] = (mine && li == i) ? -1.f : mv[i];
                    if (mine) sel |= (1u << li);
                }
            }
            if (qq == 0 && hh == 0) sel |= 1u;
            if ((cur & 3) == qq && (cur >> 5) == hh) sel |= (1u << ((cur >> 2) & 7));
            if (cur >= 1 && ((cur - 1) & 3) == qq && ((cur - 1) >> 5) == hh) sel |= (1u << (((cur - 1) >> 2) & 7));
            unsigned w = sel << (8 * hh);
            w |= (unsigned)__builtin_amdgcn_update_dpp(0, (int)w, 0xB1, 0xF, 0xF, true);
            w |= (unsigned)__builtin_amdgcn_update_dpp(0, (int)w, 0x4E, 0xF, 0xF, true);
            if (hh == 0) selm[tl[u] * 4 + qq] = w;
        }
        NSA_TE(2)
        NSA_TS(3)
        __syncthreads();
#pragma unroll
        for (int u = 0; u < 2; u++) { NSA_TOK(u) nsa_fold<0>(st[u], T[u], p.nsag[ntk_ * 24 + hd_ * 3 + 0]); }
        {
            const int t2 = get_tid();
#pragma unroll
            for (int i = 0; i < 8; i++) *(f32x4*)&Os[(i * NT + t2) * 4] = f32x4{0.f, 0.f, 0.f, 0.f};
            if (t2 < 256) { Ms[t2] = NEG_BIG; Ls[t2] = 0.f; }
            unsigned long long tm = 0ull; int lrank = 0;
            if (t2 < 128) {
                const int j = t2;
                for (int tk = 0; tk < 64; tk++) tm |= (unsigned long long)((selm[tk * 4 + (j & 3)] >> (j >> 2)) & 1u) << tk;
                if (j > cur) tm = 0ull;
                const unsigned long long bal = __ballot(tm != 0ull);
                lrank = __popcll(bal & ((1ull << (t2 & 63)) - 1ull));
                if ((t2 & 63) == 0) nlistp[t2 >> 6] = __popcll(bal);
            }
            __syncthreads();
            if (t2 < 128 && tm != 0ull) {
                const int pos = lrank + ((t2 >= 64) ? nlistp[0] : 0);
                blist[pos] = t2; lcnt[pos] = __popcll(tm);
                int c = 0;
                while (tm) { lists[pos * 64 + c] = (unsigned char)(__ffsll((long long)tm) - 1); c++; tm &= tm - 1ull; }
            }
            __syncthreads();
        }
        const int nlist = nlistp[0] + nlistp[1];
        NSA_TE(3)
        NSA_TS(4)
        const u16* ksl = p.ksl + (size_t)bg * S_ * 64;
        const u16* vslT = p.vslT + (size_t)bg * 128 * 4096;
        {
            const int t4 = get_tid(), wv4 = __builtin_amdgcn_readfirstlane(t4 >> 6), ts4 = (t4 & 15) >> 2;
            const int td = t4 & 255;
            const int so = (td >> 3) * 64 + (((td & 7) ^ ((td >> 4) & 7)) << 3);
            char* dl = ring + td * 16;
#define NSA_RI(i) (nlist - 1 - (i))
#define NSA_ISSUE2(i, slot) if (wv4 >= 4) { const int jj_ = blist[NSA_RI(i)]; const u16* kp_ = ksl + (size_t)jj_ * 4096 + so; const u16* vp_ = vslT + (size_t)jj_ * 4096 + so; char* d_ = dl + (slot) * 16384; \
                glds16(kp_, d_); glds16(kp_ + 2048, d_ + 4096); glds16(vp_, d_ + 8192); glds16(vp_ + 2048, d_ + 12288); }
            asm volatile("s_waitcnt lgkmcnt(0)" ::: "memory");
            __builtin_amdgcn_s_barrier();
            if (nlist > 0) NSA_ISSUE2(0, 0)
            if (nlist > 1) NSA_ISSUE2(1, 1)
            int jn = 0, nn = 0, tokn = 0;
            if (nlist > 0) { jn = blist[NSA_RI(0)]; nn = lcnt[NSA_RI(0)]; tokn = lists[NSA_RI(0) * 64 + wv4 * 4 + ts4]; }
            int slot = 0;
            for (int i = 0; i < nlist; i++) {
                if (i + 1 < nlist) asm volatile("s_waitcnt vmcnt(4)" ::: "memory"); else asm volatile("s_waitcnt vmcnt(0)" ::: "memory");
                asm volatile("s_waitcnt lgkmcnt(0)" ::: "memory");
                __builtin_amdgcn_s_barrier();
                asm volatile("" ::: "memory");
                const int sl2 = (slot == 0) ? 2 : slot - 1;
                if (i + 2 < nlist) NSA_ISSUE2(i + 2, sl2)
                const int j = jn, n = nn, tok0 = tokn;
                if (i + 1 < nlist) { jn = blist[NSA_RI(i + 1)]; nn = lcnt[NSA_RI(i + 1)]; tokn = lists[NSA_RI(i + 1) * 64 + wv4 * 4 + ts4]; }
                const u16* Ks = (const u16*)(ring + slot * 16384); const u16* Vs = Ks + 4096;
                if ((wv4 + NW) * 4 < n) {
                    const int e1 = (wv4 + NW) * 4 + ts4;
                    const bool vl2[2] = {true, e1 < n};
                    const int tk2[2] = {tok0, vl2[1] ? (int)lists[NSA_RI(i) * 64 + (e1 & 63)] : 0};
                    if (j == cur) nsa_visit_gn<1, false, 2>(Ks, Vs, qs, Os, Ms, Ls, tk2, vl2, t4 & 63);
                    else nsa_visit_gn<0, true, 2>(Ks, Vs, qs, Os, Ms, Ls, tk2, vl2, t4 & 63);
                } else if (wv4 * 4 < n) {
                    const int e = wv4 * 4 + ts4;
                    const bool valid = e < n;
                    const int tok = valid ? tok0 : 0;
                    if (j == cur) nsa_visit_g<1, false>(Ks, Vs, qs, Os, Ms, Ls, tok, valid, t4 & 63);
                    else nsa_visit_g<0, true>(Ks, Vs, qs, Os, Ms, Ls, tok, valid, t4 & 63);
                }
                slot = (slot == 2) ? 0 : slot + 1;
            }
#undef NSA_RI
#undef NSA_ISSUE2
        }
        __syncthreads();
        NSA_TE(4)
        NSA_TS(5)
#pragma unroll
        for (int u = 0; u < 2; u++) {
            NSA_TOK(u)
            const int t5 = t3_ & 63;
            nsa_fold_lds(Os, Ms, Ls, (8 * (t3_ >> 6) + 4 * u + ((t5 & 15) >> 2)) * 4 + (t5 & 3), t5 >> 4, t5 & 3, T[u], p.nsag[ntk_ * 24 + hd_ * 3 + 1], true);
        }
        const u16* kwn = p.kwn + (size_t)bg * S_ * 64;
        const u16* vwnT = p.vwnT + (size_t)bg * 128 * 4096;
        uint2 Tp[2][4];
#pragma unroll
        for (int u = 0; u < 2; u++)
#pragma unroll
            for (int dt = 0; dt < 4; dt++) { Tp[u][dt] = pack4(T[u][dt]); asm volatile("" : "+v"(Tp[u][dt].x), "+v"(Tp[u][dt].y)); }
        {
            const int jlo = max(0, cur - 8);
            nsa_stream<true>(ring, cur - jlo + 1, [&](int i) { return kwn + (size_t)(cur - i) * 4096; }, [&](int i) { return vwnT + (size_t)(cur - i) * 4096; },
                [&](int i, const u16* Ks, const u16* Vs) {
                    const int j = cur - i;
                    const int t4 = get_tid();
                    const int tb_ = 8 * (t4 >> 6) + ((t4 & 15) >> 2);
                    const int tk2[2] = {tb_, tb_ + 4}; const bool vl2[2] = {true, true};
                    if (j == cur) nsa_visit_gn<1, false, 2>(Ks, Vs, qs, Os, Ms, Ls, tk2, vl2, t4 & 63);
                    else if (j == cur - 8) nsa_visit_gn<2, true, 2>(Ks, Vs, qs, Os, Ms, Ls, tk2, vl2, t4 & 63);
                    else nsa_visit_gn<0, true, 2>(Ks, Vs, qs, Os, Ms, Ls, tk2, vl2, t4 & 63);
                });
        }
#pragma unroll
        for (int u = 0; u < 2; u++) {
            NSA_TOK(u)
#pragma unroll
            for (int dt = 0; dt < 4; dt++) T[u][dt] = unpack4(Tp[u][dt]);
            { const int t5 = t3_ & 63; nsa_fold_lds(Os, Ms, Ls, (8 * (t3_ >> 6) + 4 * u + ((t5 & 15) >> 2)) * 4 + (t5 & 3), t5 >> 4, t5 & 3, T[u], p.nsag[ntk_ * 24 + hd_ * 3 + 2], false); }
#pragma unroll
            for (int dt = 0; dt < 4; dt++) *(uint2*)&p.oa[ntk_ * 512 + hd_ * 64 + dt * 16 + ((t3_ & 63) >> 4) * 4] = pack4(T[u][dt]);
        }
        NSA_TE(5)
    }
    if (NSAPROBE) { __syncthreads(); const unsigned long long t1_ = __builtin_amdgcn_s_memrealtime(); while (__builtin_amdgcn_s_memrealtime() - t1_ < tacc_) __builtin_amdgcn_s_sleep(8); }
}

#ifndef CHPROBE
#define CHPROBE 0
#endif
#define CH_TS(k) if (CHPROBE == k) cts_ = __builtin_amdgcn_s_memrealtime();
#define CH_TE(k) if (CHPROBE == k) ctacc_ += __builtin_amdgcn_s_memrealtime() - cts_;
constexpr int RS = 72;
constexpr int RSLOT = 64 * RS;
__device__ __forceinline__ void mm64(const u16* A, int lda, const u16* Bz, int ldb, f32x4 (&acc)[2], int lane, int wv) {
    const int mt = wv >> 1, nt0 = (wv & 1) * 2, kr = lane & 15, qq = lane >> 4;
    bf16x8 a[2], b[2][2];
#pragma unroll
    for (int ks = 0; ks < 2; ks++) {
        a[ks] = *(const bf16x8*)&A[(mt * 16 + kr) * lda + ks * 32 + qq * 8];
#pragma unroll
        for (int i = 0; i < 2; i++) b[ks][i] = *(const bf16x8*)&Bz[((nt0 + i) * 16 + kr) * ldb + ks * 32 + qq * 8];
    }
#pragma unroll
    for (int ks = 0; ks < 2; ks++)
#pragma unroll
        for (int i = 0; i < 2; i++) acc[i] = __builtin_amdgcn_mfma_f32_16x16x32_bf16(a[ks], b[ks][i], acc[i], 0, 0, 0);
}
__device__ __forceinline__ void st_t(u16* dst, int ld, const f32x4& v, int mt, int nt, int lane) {
    uint2 o; o.x = pack2(v[0], v[1]); o.y = pack2(v[2], v[3]);
    *(uint2*)&dst[(nt * 16 + (lane & 15)) * ld + mt * 16 + (lane >> 4) * 4] = o;
}
__device__ __forceinline__ void st_n(u16* dst, int ld, const f32x4& v, int mt, int nt, int lane) {
#pragma unroll
    for (int r = 0; r < 4; r++) dst[(mt * 16 + (lane >> 4) * 4 + r) * ld + nt * 16 + (lane & 15)] = f2bf(v[r]);
}
#define ZACC(a) { a[0] = f32x4{0.f, 0.f, 0.f, 0.f}; a[1] = f32x4{0.f, 0.f, 0.f, 0.f}; }

__device__ void ph_rwkv_chunk(const P& p, int bid, int nb, char* smem) {
    unsigned long long cts_ = 0, ctacc_ = 0;
    u16* sl = (u16*)smem;
    float* tot = (float*)(sl + 14 * RSLOT);
    float* gl = tot + 512;
#define RW_IDX const int tid = get_tid(), lane = tid & 63, wv = tid >> 6, mt = wv >> 1, nt0 = (wv & 1) * 2, kr = lane & 15, qq = lane >> 4; (void)mt; (void)nt0; (void)kr; (void)qq; (void)lane;
    const int nitems = B_ * 128;
    for (int it0 = bid; it0 < nitems; it0 += nb) {
      const int c = it0 & 127, b = it0 >> 7;
      const size_t n0 = (size_t)b * S_ + c * 64;
      __syncthreads();
      {
          RW_IDX
          const int t = tid >> 3, part = tid & 7;
          const size_t n = n0 + t;
          const bool hasprev = (c * 64 + t) > 0;
          u16* dst = p.xact + n * 256 + part * 32;
#pragma unroll
          for (int j = 0; j < 4; j++) {
              const int col = 1536 + part * 32 + j * 8;
              const uint4 cu = *(const uint4*)&p.prw[n * CRW + col];
              uint4 pv = make_uint4(0u, 0u, 0u, 0u);
              if (hasprev) pv = *(const uint4*)&p.prw[(n - 1) * CRW + col];
              const unsigned cw[4] = {cu.x, cu.y, cu.z, cu.w}, pw[4] = {pv.x, pv.y, pv.z, pv.w};
              unsigned ow[4];
#pragma unroll
              for (int e2 = 0; e2 < 4; e2++) {
                  float x0 = __uint_as_float(cw[e2] << 16), x1 = __uint_as_float(cw[e2] & 0xFFFF0000u);
                  const float q0 = __uint_as_float(pw[e2] << 16), q1 = __uint_as_float(pw[e2] & 0xFFFF0000u);
                  x0 = x0 + (q0 - x0) * p.mu[col + 2 * e2]; x1 = x1 + (q1 - x1) * p.mu[col + 2 * e2 + 1];
                  if (part < 2) { x0 = tanhf(x0); x1 = tanhf(x1); }
                  else if (part >= 4) { x0 = sigmoidf_(x0); x1 = sigmoidf_(x1); }
                  ow[e2] = pack2(x0, x1);
              }
              *(uint4*)&dst[j * 8] = make_uint4(ow[0], ow[1], ow[2], ow[3]);
          }
      }
      __syncthreads();
      const u16* xa = p.xact + n0 * 256;
      bf16x8 xa_[8], wb[2][2], ab[2][2], gb[2][4];
      u16 rc[8][3], rp[8][3];
      float w0c[2], a0c[2], hc_[6];
#define S1_LOADW(hh_) { RW_IDX \
          _Pragma("unroll") for (int i = 0; i < 2; i++) { const int cc = (nt0 + i) * 16 + kr; w0c[i] = p.w0[(hh_) * 64 + cc]; a0c[i] = p.a0[(hh_) * 64 + cc]; \
              _Pragma("unroll") for (int ks = 0; ks < 2; ks++) { wb[i][ks] = *(const bf16x8*)&p.w2T[((size_t)(hh_) * 64 + cc) * 64 + ks * 32 + qq * 8]; \
                                                                 ab[i][ks] = *(const bf16x8*)&p.a2T[((size_t)(hh_) * 64 + cc) * 64 + ks * 32 + qq * 8]; } \
              _Pragma("unroll") for (int ks = 0; ks < 4; ks++) gb[i][ks] = *(const bf16x8*)&p.g2T[((size_t)(hh_) * 64 + cc) * 128 + ks * 32 + qq * 8]; } }
#define S2_LOADX(hh_) { RW_IDX const int ch_ = (hh_) * 64 + lane; \
          hc_[0] = p.mu[ch_]; hc_[1] = p.mu[512 + ch_]; hc_[2] = p.mu[1024 + ch_]; hc_[3] = p.k_k[ch_]; hc_[4] = p.k_a[ch_]; hc_[5] = p.r_k[ch_]; \
          _Pragma("unroll") for (int i = 0; i < 8; i++) { const int t = wv * 8 + i; const u16* cr = p.prw + (n0 + t) * CRW; \
              rc[i][0] = cr[ch_]; rc[i][1] = cr[512 + ch_]; rc[i][2] = cr[1024 + ch_]; \
              rp[i][0] = 0; rp[i][1] = 0; rp[i][2] = 0; \
              if (c * 64 + t > 0) { const u16* pp = cr - CRW; rp[i][0] = pp[ch_]; rp[i][1] = pp[512 + ch_]; rp[i][2] = pp[1024 + ch_]; } } }
      {
          RW_IDX
#pragma unroll
          for (int k8 = 0; k8 < 8; k8++) xa_[k8] = *(const bf16x8*)&xa[(mt * 16 + kr) * 256 + k8 * 32 + qq * 8];
      }
      S1_LOADW(0)
      S2_LOADX(0)
#pragma unroll 1
      for (int h = 0; h < 8; h++) {
        u16* cd = p.cdat + ((size_t)((b * 8 + h) * 128 + c)) * 4 * 4096;
        LDS_BARRIER();
        CH_TS(1)
        float* LW = (float*)(sl + 8 * RSLOT); float* LA = (float*)(sl + 10 * RSLOT);
        {
            RW_IDX
            f32x4 aw[2], aa2[2], ag[2];
#pragma unroll
            for (int i = 0; i < 2; i++) {
                aw[i] = f32x4{0.f, 0.f, 0.f, 0.f}; aa2[i] = aw[i]; ag[i] = aw[i];
#pragma unroll
                for (int ks = 0; ks < 2; ks++) {
                    aw[i] = __builtin_amdgcn_mfma_f32_16x16x32_bf16(xa_[ks], wb[i][ks], aw[i], 0, 0, 0);
                    aa2[i] = __builtin_amdgcn_mfma_f32_16x16x32_bf16(xa_[2 + ks], ab[i][ks], aa2[i], 0, 0, 0);
                }
#pragma unroll
                for (int ks = 0; ks < 4; ks++) ag[i] = __builtin_amdgcn_mfma_f32_16x16x32_bf16(xa_[4 + ks], gb[i][ks], ag[i], 0, 0, 0);
            }
#pragma unroll
            for (int i = 0; i < 2; i++)
#pragma unroll
                for (int r = 0; r < 4; r++) {
                    const int t = mt * 16 + qq * 4 + r, cc = (nt0 + i) * 16 + kr;
                    const float wl = w0c[i] + aw[i][r];
                    const float z = -wl;
                    const float sp = fmaxf(z, 0.f) + __logf(1.f + __expf(-fabsf(z)));
                    LW[t * 64 + cc] = -__expf(-sp - 0.5f);
                    LA[t * 64 + cc] = sigmoidf_(a0c[i] + aa2[i][r]);
                    p.ob[(n0 + t) * 512 + h * 64 + cc] = f2bf(ag[i][r]);
                }
        }
        LDS_BARRIER();
        CH_TE(1) CH_TS(2)
        {
            RW_IDX
            const int ch = h * 64 + lane;
            const float mur = hc_[0], muk = hc_[1], muv = hc_[2];
            const float kkw = hc_[3], kaw = hc_[4], rkw = hc_[5];
            float rr[8], k2[8], vv[8], kkn[8], aa[8], lg[8], cs[8];
            float run = 0.f;
#pragma unroll
            for (int i = 0; i < 8; i++) {
                const int t = wv * 8 + i; const size_t n = n0 + t;
                float r = bf2f(rc[i][0]), k = bf2f(rc[i][1]), v = bf2f(rc[i][2]);
                const float pr = bf2f(rp[i][0]), pk = bf2f(rp[i][1]), pv = bf2f(rp[i][2]);
                r = r + (pr - r) * mur; k = k + (pk - k) * muk; v = v + (pv - v) * muv;
                const float a = LA[t * 64 + lane];
                lg[i] = LW[t * 64 + lane];
                float kk = k * kkw;
                kkn[i] = kk * __builtin_amdgcn_rsqf(fmaxf(wave_sum(kk * kk), 1e-24f));
                k2[i] = k * (1.f + (a - 1.f) * kaw);
                const float bon = wave_sum(r * k2[i] * rkw);
                if (lane == 0) p.bon[n * 8 + h] = bon;
                rr[i] = r; vv[i] = v; aa[i] = a;
                run += lg[i]; cs[i] = run;
            }
            tot[wv * 64 + lane] = run;
            LDS_BARRIER();
            float off = 0.f, cumL = 0.f;
#pragma unroll
            for (int w2 = 0; w2 < 8; w2++) { const float tv = tot[w2 * 64 + lane]; cumL += tv; if (w2 < wv) off += tv; }
            if (wv == 0) gl[lane] = __expf(cumL);
            unsigned pa[4], pb[4], pk4[4], pv4[4];
#pragma unroll
            for (int i = 0; i < 8; i += 2) {
                float at[2], bt[2], kt[2], rt[2];
#pragma unroll
                for (int e2 = 0; e2 < 2; e2++) {
                    const int ii = i + e2; const int t = wv * 8 + ii;
                    const float cm = off + cs[ii];
                    const float g = __expf(cm), gp = __expf(cm - lg[ii]), gi = __expf(-cm);
                    at[e2] = -kkn[ii] * gp; bt[e2] = kkn[ii] * aa[ii] * gi; kt[e2] = k2[ii] * gi; rt[e2] = rr[ii] * g;
                    sl[0 * RSLOT + t * RS + lane] = f2bf(at[e2]);
                    sl[1 * RSLOT + t * RS + lane] = f2bf(bt[e2]);
                    sl[2 * RSLOT + t * RS + lane] = f2bf(kt[e2]);
                    sl[3 * RSLOT + t * RS + lane] = f2bf(rt[e2]);
                }
                pa[i >> 1] = pack2(at[0], at[1]); pb[i >> 1] = pack2(bt[0], bt[1]);
                pk4[i >> 1] = pack2(kt[0], kt[1]); pv4[i >> 1] = pack2(vv[i], vv[i + 1]);
            }
            *(uint4*)&sl[4 * RSLOT + lane * RS + wv * 8] = make_uint4(pa[0], pa[1], pa[2], pa[3]);
            *(uint4*)&sl[5 * RSLOT + lane * RS + wv * 8] = make_uint4(pb[0], pb[1], pb[2], pb[3]);
            *(uint4*)&sl[6 * RSLOT + lane * RS + wv * 8] = make_uint4(pk4[0], pk4[1], pk4[2], pk4[3]);
            *(uint4*)&sl[7 * RSLOT + lane * RS + wv * 8] = make_uint4(pv4[0], pv4[1], pv4[2], pv4[3]);
        }
        LDS_BARRIER();
        if (h + 1 < 8) { S1_LOADW(h + 1) S2_LOADX(h + 1) }
        CH_TE(2) CH_TS(3)
        {
            RW_IDX
            f32x4 acc[2];
            ZACC(acc); mm64(sl + 1 * RSLOT, RS, sl + 0 * RSLOT, RS, acc, lane, wv);
#pragma unroll
            for (int i = 0; i < 2; i++) {
                f32x4 pm;
#pragma unroll
                for (int r = 0; r < 4; r++) {
                    const int m = mt * 16 + qq * 4 + r, n = (nt0 + i) * 16 + kr;
                    if (!(m < n)) acc[i][r] = 0.f;
                    pm[r] = acc[i][r] + ((m == n) ? 1.f : 0.f);
                }
                st_t(sl + 8 * RSLOT, RS, acc[i], mt, nt0 + i, lane);
                st_n(sl + 9 * RSLOT, RS, acc[i], mt, nt0 + i, lane);
                st_t(sl + 13 * RSLOT, RS, pm, mt, nt0 + i, lane);
            }
            ZACC(acc); mm64(sl + 0 * RSLOT, RS, sl + 2 * RSLOT, RS, acc, lane, wv);
#pragma unroll
            for (int i = 0; i < 2; i++) {
#pragma unroll
                for (int r = 0; r < 4; r++) { const int m = mt * 16 + qq * 4 + r, n = (nt0 + i) * 16 + kr; if (!(m > n)) acc[i][r] = 0.f; }
                st_t(sl + 10 * RSLOT, RS, acc[i], mt, nt0 + i, lane);
            }
            ZACC(acc); mm64(sl + 1 * RSLOT, RS, sl + 3 * RSLOT, RS, acc, lane, wv);
#pragma unroll
            for (int i = 0; i < 2; i++) {
#pragma unroll
                for (int r = 0; r < 4; r++) { const int m = mt * 16 + qq * 4 + r, n = (nt0 + i) * 16 + kr; if (m > n) acc[i][r] = 0.f; }
                st_t(sl + 11 * RSLOT, RS, acc[i], mt, nt0 + i, lane);
            }
            ZACC(acc); mm64(sl + 2 * RSLOT, RS, sl + 3 * RSLOT, RS, acc, lane, wv);
#pragma unroll
            for (int i = 0; i < 2; i++) {
#pragma unroll
                for (int r = 0; r < 4; r++) { const int m = mt * 16 + qq * 4 + r, n = (nt0 + i) * 16 + kr; if (m > n) acc[i][r] = 0.f; }
                st_t(sl + 12 * RSLOT, RS, acc[i], mt, nt0 + i, lane);
            }
        }
        LDS_BARRIER();
        CH_TE(3) CH_TS(4)
        u16* X = sl + 8 * RSLOT; u16* XT = sl + 9 * RSLOT; u16* X2 = sl + 0 * RSLOT; u16* X2T = sl + 1 * RSLOT;
        u16* Pc = sl + 13 * RSLOT; u16* Pn = sl + 2 * RSLOT;
#pragma unroll 1
        for (int j = 1; j <= 6; j++) {
            RW_IDX
            f32x4 acc[2];
            if (j <= 5) {
                ZACC(acc); mm64(X, RS, XT, RS, acc, lane, wv);
#pragma unroll
                for (int i = 0; i < 2; i++) { st_t(X2T, RS, acc[i], mt, nt0 + i, lane); st_n(X2, RS, acc[i], mt, nt0 + i, lane); }
            }
            if (j >= 2) {
                ZACC(acc); mm64(XT, RS, Pc, RS, acc, lane, wv);
#pragma unroll
                for (int i = 0; i < 2; i++) {
                    const uint2 pv = *(const uint2*)&Pc[((nt0 + i) * 16 + kr) * RS + mt * 16 + qq * 4];
                    acc[i][0] += __uint_as_float(pv.x << 16); acc[i][1] += __uint_as_float(pv.x & 0xFFFF0000u);
                    acc[i][2] += __uint_as_float(pv.y << 16); acc[i][3] += __uint_as_float(pv.y & 0xFFFF0000u);
                    st_t(Pn, RS, acc[i], mt, nt0 + i, lane);
                }
            }
            LDS_BARRIER();
            if (j >= 2) { u16* tp = Pc; Pc = Pn; Pn = tp; }
            if (j <= 5) { u16* tx = X; X = X2; X2 = tx; tx = XT; XT = X2T; X2T = tx; }
        }
        CH_TE(4) CH_TS(5)
        u16* TT = Pc;
        {
            RW_IDX
            f32x4 acc[2];
            ZACC(acc); mm64(TT, RS, sl + 4 * RSLOT, RS, acc, lane, wv);
#pragma unroll
            for (int i = 0; i < 2; i++) st_t(sl + 0 * RSLOT, RS, acc[i], mt, nt0 + i, lane);
            ZACC(acc); mm64(sl + 10 * RSLOT, RS, TT, RS, acc, lane, wv);
#pragma unroll
            for (int i = 0; i < 2; i++) st_t(sl + 8 * RSLOT, RS, acc[i], mt, nt0 + i, lane);
        }
        LDS_BARRIER();
        {
            RW_IDX
            f32x4 acc[2];
            ZACC(acc); mm64(sl + 8 * RSLOT, RS, sl + 7 * RSLOT, RS, acc, lane, wv);
#pragma unroll
            for (int i = 0; i < 2; i++) st_t(sl + 9 * RSLOT, RS, acc[i], mt, nt0 + i, lane);
            ZACC(acc); mm64(sl + 0 * RSLOT, RS, sl + 5 * RSLOT, RS, acc, lane, wv);
#pragma unroll
            for (int i = 0; i < 2; i++) {
                const int n = (nt0 + i) * 16 + kr; const float gn = gl[n];
#pragma unroll
                for (int r = 0; r < 4; r++) { const int m = mt * 16 + qq * 4 + r; acc[i][r] = acc[i][r] * gn + ((m == n) ? gn : 0.f); }
                st_t(cd, 64, acc[i], mt, nt0 + i, lane);
            }
            ZACC(acc); mm64(sl + 0 * RSLOT, RS, sl + 11 * RSLOT, RS, acc, lane, wv);
#pragma unroll
            for (int i = 0; i < 2; i++) {
                const uint2 rv = *(const uint2*)&sl[3 * RSLOT + ((nt0 + i) * 16 + kr) * RS + mt * 16 + qq * 4];
                acc[i][0] += __uint_as_float(rv.x << 16); acc[i][1] += __uint_as_float(rv.x & 0xFFFF0000u);
                acc[i][2] += __uint_as_float(rv.y << 16); acc[i][3] += __uint_as_float(rv.y & 0xFFFF0000u);
                st_t(cd + 2 * 4096, 64, acc[i], mt, nt0 + i, lane);
            }
        }
        LDS_BARRIER();
        {
            RW_IDX
            f32x4 acc[2];
            ZACC(acc);
            mm64(sl + 5 * RSLOT, RS, sl + 9 * RSLOT, RS, acc, lane, wv);
            mm64(sl + 6 * RSLOT, RS, sl + 7 * RSLOT, RS, acc, lane, wv);
#pragma unroll
            for (int i = 0; i < 2; i++) {
#pragma unroll
                for (int r = 0; r < 4; r++) acc[i][r] *= gl[mt * 16 + qq * 4 + r];
                st_t(cd + 1 * 4096, 64, acc[i], mt, nt0 + i, lane);
            }
            ZACC(acc);
            mm64(sl + 9 * RSLOT, RS, sl + 11 * RSLOT, RS, acc, lane, wv);
            mm64(sl + 7 * RSLOT, RS, sl + 12 * RSLOT, RS, acc, lane, wv);
#pragma unroll
            for (int i = 0; i < 2; i++) st_t(cd + 3 * 4096, 64, acc[i], mt, nt0 + i, lane);
        }
        CH_TE(5)
      }
    }
    if (CHPROBE) { __syncthreads(); const unsigned long long t1_ = __builtin_amdgcn_s_memrealtime(); while (__builtin_amdgcn_s_memrealtime() - t1_ < ctacc_) __builtin_amdgcn_s_sleep(8); }
}

__device__ void ph_rwkv_seq(const P& p, int bid, int nb, char* smem) {
    u16* SL = (u16*)smem;
    const int tid = get_tid(), lane = tid & 63, wv = __builtin_amdgcn_readfirstlane(tid >> 6);
    const int kr = lane & 15, qq = lane >> 4, chn = wv >> 2, vt = wv & 3;
    for (int pair = bid; pair < B_ * 4; pair += nb) {
        const int bh = pair * 2 + chn;
        u16* mySL = SL + chn * RSLOT;
        __syncthreads();
#pragma unroll
        for (int ks = 0; ks < 2; ks++) *(uint4*)&mySL[(vt * 16 + kr) * RS + ks * 32 + qq * 8] = make_uint4(0u, 0u, 0u, 0u);
        u16* cbase = p.cdat + (size_t)bh * 128 * 4 * 4096;
        bf16x8 GA0[4][2], GA1[4][2], GA2[4][2], GA3[4][2]; uint2 H0[4], H1[4], H2[4], H3[4];
#define SEQ_LD(GAx, Hx, c) { const u16* cd_ = cbase + (size_t)(c) * 4 * 4096; \
            _Pragma("unroll") for (int m4 = 0; m4 < 4; m4++) { \
                _Pragma("unroll") for (int ks = 0; ks < 2; ks++) GAx[m4][ks] = *(const bf16x8*)&cd_[(m4 * 16 + kr) * 64 + ks * 32 + qq * 8]; \
                Hx[m4] = *(const uint2*)&cd_[1 * 4096 + (vt * 16 + kr) * 64 + m4 * 16 + qq * 4]; } }
#define SEQ_STEP(GAx, Hx, c) { \
            bf16x8 Z0[2]; \
            _Pragma("unroll") for (int ks = 0; ks < 2; ks++) Z0[ks] = *(const bf16x8*)&mySL[(vt * 16 + kr) * RS + ks * 32 + qq * 8]; \
            f32x4 zs[4]; \
            _Pragma("unroll") for (int m4 = 0; m4 < 4; m4++) { \
                zs[m4] = unpack4(Hx[m4]); \
                _Pragma("unroll") for (int ks = 0; ks < 2; ks++) zs[m4] = __builtin_amdgcn_mfma_f32_16x16x32_bf16(GAx[m4][ks], Z0[ks], zs[m4], 0, 0, 0); } \
            u16* sn_ = cbase + (size_t)(c) * 4 * 4096 + 1 * 4096 + (vt * 16 + kr) * 64 + qq * 4; \
            _Pragma("unroll") for (int m4 = 0; m4 < 4; m4++) { \
                const uint2 pk_ = pack4(zs[m4]); \
                *(uint2*)&mySL[(vt * 16 + kr) * RS + m4 * 16 + qq * 4] = pk_; \
                *(uint2*)&sn_[m4 * 16] = pk_; } \
            if ((c) + 4 < 128) SEQ_LD(GAx, Hx, (c) + 4) }
        SEQ_LD(GA0, H0, 0) SEQ_LD(GA1, H1, 1) SEQ_LD(GA2, H2, 2) SEQ_LD(GA3, H3, 3)
#pragma unroll 1
        for (int c = 0; c < 128; c += 4) {
            SEQ_STEP(GA0, H0, c)
            SEQ_STEP(GA1, H1, c + 1)
            SEQ_STEP(GA2, H2, c + 2)
            SEQ_STEP(GA3, H3, c + 3)
        }
#undef SEQ_LD
#undef SEQ_STEP
    }
}

__device__ void ph_rwkv_out(const P& p, int bid, int nb, char* smem) {
    const int tid = get_tid(), lane = tid & 63, wv = tid >> 6;
    const int kr = lane & 15, qq = lane >> 4;
    for (int it = bid * NW + wv; it < B_ * 8 * 128; it += nb * NW) {
        const int c = it & 127, bh = it >> 7, b = bh >> 3, h = bh & 7;
        const u16* cd = p.cdat + ((size_t)bh * 128 + c) * 4 * 4096;
        f32x4 ys[4][4];
#pragma unroll
        for (int mt = 0; mt < 4; mt++)
#pragma unroll
            for (int nt = 0; nt < 4; nt++) ys[mt][nt] = unpack4(*(const uint2*)&cd[3 * 4096 + (nt * 16 + kr) * 64 + mt * 16 + qq * 4]);
        if (c > 0) {
            const u16* s0 = cd - 4 * 4096 + 1 * 4096;
#pragma unroll
            for (int ks = 0; ks < 2; ks++) {
                bf16x8 af[4], bq[4];
#pragma unroll
                for (int mt = 0; mt < 4; mt++) af[mt] = *(const bf16x8*)&s0[(mt * 16 + kr) * 64 + ks * 32 + qq * 8];
#pragma unroll
                for (int nt = 0; nt < 4; nt++) bq[nt] = *(const bf16x8*)&cd[2 * 4096 + (nt * 16 + kr) * 64 + ks * 32 + qq * 8];
#pragma unroll
                for (int mt = 0; mt < 4; mt++)
#pragma unroll
                    for (int nt = 0; nt < 4; nt++) ys[mt][nt] = __builtin_amdgcn_mfma_f32_16x16x32_bf16(af[mt], bq[nt], ys[mt][nt], 0, 0, 0);
            }
        }
#pragma unroll
        for (int nt = 0; nt < 4; nt++) {
            float s1 = 0.f, s2 = 0.f;
#pragma unroll
            for (int mt = 0; mt < 4; mt++)
#pragma unroll
                for (int r = 0; r < 4; r++) { s1 += ys[mt][nt][r]; s2 += ys[mt][nt][r] * ys[mt][nt][r]; }
            s1 = xrow_sum(s1); s2 = xrow_sum(s2);
            const float mean = s1 * (1.f / 64.f);
            const float var = fmaxf(s2 * (1.f / 64.f) - mean * mean, 0.f);
            const float rstd = rsqrtf(var + 64e-5f);
            const int t = nt * 16 + kr;
            const size_t n = (size_t)b * S_ + c * 64 + t;
            const float bon = p.bon[n * 8 + h];
#pragma unroll
            for (int mt = 0; mt < 4; mt++) {
                const int vch = h * 64 + mt * 16 + qq * 4;
                const f32x4 vcf = unpack4(*(const uint2*)&p.prw[n * CRW + 1024 + vch]);
                const f32x4 vpf = (c * 64 + t > 0) ? unpack4(*(const uint2*)&p.prw[(n - 1) * CRW + 1024 + vch]) : f32x4{0.f, 0.f, 0.f, 0.f};
                const f32x4 ggf = unpack4(*(const uint2*)&p.ob[n * 512 + vch]);
                const float4 lw = *(const float4*)&p.ln_w[vch], lb = *(const float4*)&p.ln_b[vch], mv = *(const float4*)&p.mu[1024 + vch];
                const float lwa[4] = {lw.x, lw.y, lw.z, lw.w}, lba[4] = {lb.x, lb.y, lb.z, lb.w}, mva[4] = {mv.x, mv.y, mv.z, mv.w};
                f32x4 o;
#pragma unroll
                for (int r = 0; r < 4; r++) {
                    const float vsh = vcf[r] + (vpf[r] - vcf[r]) * mva[r];
                    o[r] = ((ys[mt][nt][r] - mean) * rstd * lwa[r] + lba[r] + bon * vsh) * ggf[r];
                }
                *(uint2*)&p.ob[n * 512 + vch] = pack4(o);
            }
        }
    }
}

__device__ __forceinline__ void unpack8(const uint4& u, f32x4& a, f32x4& b) {
    a = f32x4{__uint_as_float(u.x << 16), __uint_as_float(u.x & 0xFFFF0000u), __uint_as_float(u.y << 16), __uint_as_float(u.y & 0xFFFF0000u)};
    b = f32x4{__uint_as_float(u.z << 16), __uint_as_float(u.z & 0xFFFF0000u), __uint_as_float(u.w << 16), __uint_as_float(u.w & 0xFFFF0000u)};
}
struct EpiMerge {
    u16* merged; u16* tmp2; int pass;
    __device__ __forceinline__ void operator()(const f32x4 (&acc)[2][2][4][2], const GUnit& u, int, int, int, int) const {
        const int t2_ = get_tid(), wid_ = __builtin_amdgcn_readfirstlane(t2_ >> 6), wr = wid_ >> 2, wc = wid_ & 3, fr = t2_ & 15, fq = (t2_ >> 4) & 3;
        const int row0 = u.pm * 256 + wr * 64 + fr, col0 = u.pn * 256 + wc * 32 + 8 * fq;
#pragma unroll
        for (int ai = 0; ai < 2; ++ai)
#pragma unroll
            for (int m = 0; m < 4; ++m) {
                const size_t off = (size_t)(row0 + ai * 128 + m * 16) * D_ + col0;
                uint4 m1[2], m2[2];
                if (pass == 1 || pass == 3) {
#pragma unroll
                    for (int bj = 0; bj < 2; ++bj) { m1[bj] = *(const uint4*)&merged[off + bj * 128]; if (pass == 3) m2[bj] = *(const uint4*)&tmp2[off + bj * 128]; }
                }
#pragma unroll
                for (int bj = 0; bj < 2; ++bj) {
                    f32x4 v0 = acc[ai][bj][m][0], v1 = acc[ai][bj][m][1];
                    if (pass == 1) { f32x4 a0, a1; unpack8(m1[bj], a0, a1);
#pragma unroll
                        for (int r = 0; r < 4; r++) { v0[r] = a0[r] * sigmoidf_(v0[r]); v1[r] = a1[r] * sigmoidf_(v1[r]); } }
                    if (pass == 3) { f32x4 a0, a1, b0, b1; unpack8(m1[bj], a0, a1); unpack8(m2[bj], b0, b1);
#pragma unroll
                        for (int r = 0; r < 4; r++) { v0[r] = a0[r] + b0[r] * sigmoidf_(v0[r]); v1[r] = a1[r] + b1[r] * sigmoidf_(v1[r]); } }
                    *(uint4*)&((pass == 2) ? tmp2 : merged)[off + bj * 128] = pack8(v0, v1);
                }
                asm volatile("" ::: "memory");
            }
    }
};
__device__ void ph_merge(const P& p, int bid, int nb, char* smem) {
    u16* tmp2 = (u16*)p.x1;
#pragma unroll 1
    for (int pass = 0; pass < 4; ++pass) {
        const int K = (pass & 1) ? D_ : 512;
        const u16* A = (pass & 1) ? p.hbuf : (pass == 0 ? p.oa : p.ob);
        const u16* Bt = (pass == 0) ? p.wpaT : (pass == 1 ? p.wgT : (pass == 2 ? p.wpbT : p.wgT + (size_t)1024 * D_));
        DenseSched S; S.init(NTOK, D_, K, Bt, nb, bid);
        EpiMerge E{p.merged, tmp2, pass};
        gemm256(smem, (const char*)A, K, S, E);
    }
}

struct EpiOutproj {
    const float* x; float* x1;
    __device__ __forceinline__ void operator()(const f32x4 (&acc)[2][2][4][2], const GUnit& u, int, int, int, int) const {
        const int t2_ = get_tid(), wid_ = __builtin_amdgcn_readfirstlane(t2_ >> 6), wr = wid_ >> 2, wc = wid_ & 3, fr = t2_ & 15, fq = (t2_ >> 4) & 3;
        const int row0 = u.pm * 256 + wr * 64 + fr, col0 = u.pn * 256 + wc * 32 + 4 * fq;
#pragma unroll
        for (int ai = 0; ai < 2; ++ai)
#pragma unroll
            for (int m = 0; m < 4; ++m) {
                const size_t off = (size_t)(row0 + ai * 128 + m * 16) * D_ + col0;
                f32x4 xin[2][2];
#pragma unroll
                for (int bj = 0; bj < 2; ++bj)
#pragma unroll
                    for (int n = 0; n < 2; ++n) xin[bj][n] = *(const f32x4*)&x[off + bj * 128 + n * 16];
#pragma unroll
                for (int bj = 0; bj < 2; ++bj)
#pragma unroll
                    for (int n = 0; n < 2; ++n) *(f32x4*)&x1[off + bj * 128 + n * 16] = xin[bj][n] + acc[ai][bj][m][n];
                asm volatile("" ::: "memory");
            }
    }
};
__device__ void ph_outproj(const P& p, int bid, int nb, char* smem) {
    DenseSched S; S.init(NTOK, D_, D_, p.woutT, nb, bid);
    EpiOutproj E{p.x, p.x1};
    gemm256(smem, (const char*)p.merged, D_, S, E);
}

__device__ __forceinline__ float red8f(float x) {
    x += dppf<0xB1>(x);
    x += dppf<0x4E>(x);
    x += dppf<0x141>(x);
    return x;
}
__device__ void ph_route(const P& p, int bid, int nb, char* smem) {
    float* wr = (float*)smem;
    const int tid = get_tid(), lane = tid & 63, wv = tid >> 6;
    {
        u16* Tl = (u16*)smem;
        const int t = get_tid();
        const int lrow = t >> 3, lc8 = (t & 7) * 8;
        const int sslot = t >> 3, skc = t & 7;
        const int scol = (sslot & 32) + perm32(sslot & 31);
        constexpr int NT13 = NEXP * 2 * 4 * 16, NT2 = NEXP * 16 * 4;
        for (int tile = bid; tile < NT13 + NT2; tile += nb) {
            const float* src; u16* dst; int N, Kd;
            if (tile < NT13) {
                const int kt = tile & 15, sg = (tile >> 4) & 3, half = (tile >> 6) & 1, e = tile >> 7;
                const int sl0 = sg * 64;
                N = 256; Kd = D_;
                src = ((sl0 >> 7) ? p.e_w3 : p.e_w1) + (size_t)e * D_ * 256 + (size_t)(kt * 64) * 256 + half * 128 + (sl0 & 127);
                dst = p.ew1T + ((size_t)e * 512 + half * 256 + sl0) * D_ + kt * 64;
            } else {
                const int t2 = tile - NT13;
                const int kt = t2 & 3, sg = (t2 >> 2) & 15, e = t2 >> 6;
                N = D_; Kd = 256;
                src = p.e_w2 + (size_t)e * 256 * D_ + (size_t)(kt * 64) * D_ + sg * 64;
                dst = p.ew2T + ((size_t)e * D_ + sg * 64) * 256 + kt * 64;
            }
            const float4 f0 = *(const float4*)&src[(size_t)lrow * N + lc8], f1 = *(const float4*)&src[(size_t)lrow * N + lc8 + 4];
            __syncthreads();
            const unsigned h0 = pack2(f0.x, f0.y), h1 = pack2(f0.z, f0.w), h2 = pack2(f1.x, f1.y), h3 = pack2(f1.z, f1.w);
            Tl[(lc8 + 0) * 72 + lrow] = (u16)(h0 & 0xFFFFu); Tl[(lc8 + 1) * 72 + lrow] = (u16)(h0 >> 16);
            Tl[(lc8 + 2) * 72 + lrow] = (u16)(h1 & 0xFFFFu); Tl[(lc8 + 3) * 72 + lrow] = (u16)(h1 >> 16);
            Tl[(lc8 + 4) * 72 + lrow] = (u16)(h2 & 0xFFFFu); Tl[(lc8 + 5) * 72 + lrow] = (u16)(h2 >> 16);
            Tl[(lc8 + 6) * 72 + lrow] = (u16)(h3 & 0xFFFFu); Tl[(lc8 + 7) * 72 + lrow] = (u16)(h3 >> 16);
            __syncthreads();
            *(uint4*)&dst[(size_t)sslot * Kd + skc * 8] = *(const uint4*)&Tl[scol * 72 + skc * 8];
        }
        __syncthreads();
    }
    for (int i = tid; i < 1024 * 36; i += NT) {
        const int k = i / 36, j = i - k * 36;
        const int kp = (k & ~31) + ((k & 3) << 3) + ((k >> 2) & 7);
        wr[kp * 36 + j] = (j < 4) ? p.w_grp[k * 4 + j] : p.w_exp[k * 32 + (j - 4)];
    }
    int* lcount = (int*)(smem + 1024 * 36 * 4);
    if (tid < 32) lcount[tid] = 0;
    __syncthreads();
    const int sub = lane & 7, tk = lane >> 3;
    for (int n0 = (bid * NW + wv) * 16; n0 < NTOK; n0 += nb * NW * 16) {
        float acc[2][36]; float ss[2] = {0.f, 0.f};
#pragma unroll
        for (int t = 0; t < 2; t++)
#pragma unroll
            for (int j = 0; j < 36; j++) acc[t][j] = 0.f;
#pragma unroll 1
        for (int i0 = 0; i0 < 32; i0 += 4) {
            float4 xv[2][4];
#pragma unroll
            for (int t = 0; t < 2; t++)
#pragma unroll
                for (int i = 0; i < 4; i++) xv[t][i] = *(const float4*)&p.x1[(size_t)(n0 + 8 * t + tk) * D_ + (i0 + i) * 32 + sub * 4];
#pragma unroll
            for (int i = 0; i < 4; i++) {
                const int k0 = (i0 + i) * 32 + sub * 4;
                const float4 gf = *(const float4*)&p.g_ffn[k0];
                float hv[2][4];
#pragma unroll
                for (int t = 0; t < 2; t++) {
                    const float4 x = xv[t][i];
                    ss[t] += x.x * x.x + x.y * x.y + x.z * x.z + x.w * x.w;
                    hv[t][0] = x.x * gf.x; hv[t][1] = x.y * gf.y; hv[t][2] = x.z * gf.z; hv[t][3] = x.w * gf.w;
                    uint2 o; o.x = pack2(hv[t][0], hv[t][1]); o.y = pack2(hv[t][2], hv[t][3]);
                    *(uint2*)&p.hbuf[(size_t)(n0 + 8 * t + tk) * D_ + k0] = o;
                }
#pragma unroll
                for (int e2 = 0; e2 < 4; e2++) {
                    asm volatile("" ::: "memory");
                    const float* wrow = wr + ((i0 + i) * 32 + e2 * 8 + sub) * 36;
#pragma unroll
                    for (int j4 = 0; j4 < 9; j4++) {
                        const float4 wv4 = *(const float4*)&wrow[j4 * 4];
#pragma unroll
                        for (int t = 0; t < 2; t++) {
                            acc[t][j4 * 4 + 0] += hv[t][e2] * wv4.x; acc[t][j4 * 4 + 1] += hv[t][e2] * wv4.y;
                            acc[t][j4 * 4 + 2] += hv[t][e2] * wv4.z; acc[t][j4 * 4 + 3] += hv[t][e2] * wv4.w;
                        }
                    }
                }
            }
        }
#pragma unroll
        for (int t = 0; t < 2; t++) {
            const size_t n = (size_t)n0 + 8 * t + tk;
            const float sst = red8f(ss[t]);
#pragma unroll
            for (int j = 0; j < 36; j++) acc[t][j] = red8f(acc[t][j]);
            const float rs = rsqrtf(sst * (1.f / D_) + 1e-6f);
            if (sub == 0) {
                p.rsb[n] = rs;
                float gl[4]; int gs = 0;
#pragma unroll
                for (int j = 0; j < 4; j++) gl[j] = acc[t][j] * rs + p.b_grp[j];
                float gm = gl[0];
#pragma unroll
                for (int j = 1; j < 4; j++) if (gl[j] > gm) { gm = gl[j]; gs = j; }
                float gsum = 0.f;
#pragma unroll
                for (int j = 0; j < 4; j++) gsum += __expf(gl[j] - gm);
                const float pg = 1.f / gsum;
                float el[8]; float em = -3.0e38f;
#pragma unroll
                for (int j = 0; j < 8; j++) {
                    float a = (gs == 0) ? acc[t][4 + j] : ((gs == 1) ? acc[t][12 + j] : ((gs == 2) ? acc[t][20 + j] : acc[t][28 + j]));
                    a = a * rs + p.b_exp[gs * 8 + j];
                    el[j] = a; em = fmaxf(em, a);
                }
                int j0 = 0, j1 = -1; float v0 = -3.0e38f, v1 = -3.0e38f;
#pragma unroll
                for (int j = 0; j < 8; j++) { el[j] = __expf(el[j] - em); }
#pragma unroll
                for (int j = 0; j < 8; j++) { if (el[j] > v0) { v0 = el[j]; j0 = j; } }
#pragma unroll
                for (int j = 0; j < 8; j++) { if (j != j0 && el[j] > v1) { v1 = el[j]; j1 = j; } }
                const float den = v0 + v1;
                const int e0 = gs * 8 + j0, e1 = gs * 8 + j1;
                p.tok_e[n * 2] = e0; p.tok_e[n * 2 + 1] = e1;
                p.tok_gate[n * 2] = pg * v0 / den; p.tok_gate[n * 2 + 1] = pg * v1 / den;
                atomicAdd(&lcount[e0], 1); atomicAdd(&lcount[e1], 1);
            }
        }
    }
    __syncthreads();
    { const int t2 = get_tid(); if (t2 < 32) { const int c = lcount[t2]; if (c) atomicAdd(&p.counts[t2], c); } }
}

__device__ void ph_scatter(const P& p, int bid, int nb, char* smem) {
    int* offl = (int*)smem;
    int* hist = offl + 64;
    int* gbase = hist + 32;
    const int tid = get_tid();
    if (tid == 0) {
        int off = 0;
        for (int e = 0; e < NEXP; e++) { offl[e] = off; off += p.counts[e]; }
        offl[NEXP] = off;
    }
    if (bid == 0 && tid == 64) {
        int off = 0, nb_ = 0;
        for (int e = 0; e < NEXP; e++) {
            const int c = p.counts[e];
            p.offs[e] = off;
            for (int r = 0; r < c; r += 256) { p.blk_e[nb_] = e; p.blk_r0[nb_] = off + r; nb_++; }
            off += c;
        }
        p.offs[NEXP] = off;
        *p.nblk = nb_;
    }
    for (int base = bid * NT; base < NTOK * 2; base += nb * NT) {
        __syncthreads();
        if (tid < 32) hist[tid] = 0;
        __syncthreads();
        const int i = base + tid;
        const int e = p.tok_e[i];
        const int rl = atomicAdd(&hist[e], 1);
        __syncthreads();
        if (tid < 32) gbase[tid] = atomicAdd(&p.cursor[tid], hist[tid]);
        __syncthreads();
        const int slot = offl[e] + gbase[e] + rl;
        p.list_tok[slot] = i >> 1; p.list_gate[slot] = p.tok_gate[i]; p.tokslot[i] = slot;
    }
}
template <int CTS>
struct MoeSched {
    const P* pp; int nunits, G, c; unsigned rowbytes; const u16* Bt; size_t b_estride, b_tstride;
    bool gather;
    __device__ __forceinline__ bool next(int i, GUnit& u) const {
        const int L = i * G + c; if (L >= nunits) return false;
        int wgid = L; { const int q = nunits >> 3, r = nunits & 7, xcd = wgid & 7, off = wgid >> 3; wgid = (xcd < r ? xcd * (q + 1) : r * (q + 1) + (xcd - r) * q) + off; }
        u.pm = wgid / CTS; u.pn = wgid & (CTS - 1); return true;
    }
    __device__ __forceinline__ unsigned a_off(const GUnit& u, int h, int R) const {
        const P& p = *pp;
        const int e = __builtin_amdgcn_readfirstlane(p.blk_e[u.pm]), rend = __builtin_amdgcn_readfirstlane(p.offs[e + 1]);
        int sl = __builtin_amdgcn_readfirstlane(p.blk_r0[u.pm]) + h * 128 + R; if (sl >= rend) sl = rend - 1;
        return (unsigned)(gather ? p.list_tok[sl] : sl) * rowbytes;
    }
    __device__ __forceinline__ const char* b_ptr(const GUnit& u) const { return (const char*)(Bt + (size_t)__builtin_amdgcn_readfirstlane(pp->blk_e[u.pm]) * b_estride + (size_t)u.pn * b_tstride); }
};
struct EpiMoe1 {
    const P* pp;
    __device__ __forceinline__ void operator()(const f32x4 (&acc)[2][2][4][2], const GUnit& u, int, int, int, int) const {
        const int t2_ = get_tid(), wid_ = __builtin_amdgcn_readfirstlane(t2_ >> 6), wr = wid_ >> 2, wc = wid_ & 3, fr = t2_ & 15, fq = (t2_ >> 4) & 3;
        const P& p = *pp;
        const int e = __builtin_amdgcn_readfirstlane(p.blk_e[u.pm]), r0 = __builtin_amdgcn_readfirstlane(p.blk_r0[u.pm]), rend = __builtin_amdgcn_readfirstlane(p.offs[e + 1]);
#pragma unroll
        for (int ai = 0; ai < 2; ++ai)
#pragma unroll
            for (int m = 0; m < 4; ++m) {
                const int sl = r0 + ai * 128 + wr * 64 + m * 16 + fr;
                if (sl < rend) {
                    const float rs = p.rsb[p.list_tok[sl]];
                    f32x4 v[2];
#pragma unroll
                    for (int n = 0; n < 2; ++n)
#pragma unroll
                        for (int r = 0; r < 4; r++) { const float a = acc[ai][0][m][n][r] * rs; v[n][r] = a * sigmoidf_(a) * (acc[ai][1][m][n][r] * rs); }
                    *(uint4*)&p.hid[(size_t)sl * 256 + u.pn * 128 + wc * 32 + 8 * fq] = pack8(v[0], v[1]);
                }
            }
    }
};
__device__ void ph_moe1(const P& p, int bid, int nb, char* smem) {
    MoeSched<2> S{&p, __builtin_amdgcn_readfirstlane(*p.nblk) * 2, nb, bid, (unsigned)(D_ * 2), p.ew1T, (size_t)512 * D_, (size_t)256 * D_, true};
    EpiMoe1 E{&p};
    gemm256(smem, (const char*)p.hbuf, D_, S, E);
}
struct EpiMoe2 {
    const P* pp;
    __device__ __forceinline__ void operator()(const f32x4 (&acc)[2][2][4][2], const GUnit& u, int, int, int, int) const {
        const int t2_ = get_tid(), wid_ = __builtin_amdgcn_readfirstlane(t2_ >> 6), wr = wid_ >> 2, wc = wid_ & 3, fr = t2_ & 15, fq = (t2_ >> 4) & 3;
        const P& p = *pp;
        const int e = __builtin_amdgcn_readfirstlane(p.blk_e[u.pm]), r0 = __builtin_amdgcn_readfirstlane(p.blk_r0[u.pm]), rend = __builtin_amdgcn_readfirstlane(p.offs[e + 1]);
#pragma unroll
        for (int ai = 0; ai < 2; ++ai)
#pragma unroll
            for (int m = 0; m < 4; ++m) {
                const int sl = r0 + ai * 128 + wr * 64 + m * 16 + fr;
                if (sl < rend) {
                    const float gt = p.list_gate[sl];
                    u16* yp = p.ybuf + (size_t)sl * D_ + u.pn * 256 + wc * 32 + 8 * fq;
#pragma unroll
                    for (int bj = 0; bj < 2; ++bj) *(uint4*)&yp[bj * 128] = pack8(acc[ai][bj][m][0] * gt, acc[ai][bj][m][1] * gt);
                }
            }
    }
};
__device__ void ph_moe2(const P& p, int bid, int nb, char* smem) {
    MoeSched<4> S{&p, __builtin_amdgcn_readfirstlane(*p.nblk) * 4, nb, bid, 512u, p.ew2T, (size_t)D_ * 256, (size_t)256 * 256, false};
    EpiMoe2 E{&p};
    gemm256(smem, (const char*)p.hid, 256, S, E);
}
__device__ void ph_final(const P& p, int bid, int nb, char* smem) {
    const int tid = get_tid(), lane = tid & 63, wv = tid >> 6;
    for (int row = bid * NW + wv; row < NTOK; row += nb * NW) {
        const int s0 = p.tokslot[row * 2], s1 = p.tokslot[row * 2 + 1];
        float v[16]; float ss = 0.f;
#pragma unroll
        for (int i = 0; i < 4; i++) {
            const int c = i * 256 + lane * 4;
            const float4 t = *(const float4*)&p.x1[(size_t)row * D_ + c];
            const uint2 a = *(const uint2*)&p.ybuf[(size_t)s0 * D_ + c];
            const uint2 bq = *(const uint2*)&p.ybuf[(size_t)s1 * D_ + c];
            v[4 * i]     = t.x + __uint_as_float(a.x << 16) + __uint_as_float(bq.x << 16);
            v[4 * i + 1] = t.y + __uint_as_float(a.x & 0xFFFF0000u) + __uint_as_float(bq.x & 0xFFFF0000u);
            v[4 * i + 2] = t.z + __uint_as_float(a.y << 16) + __uint_as_float(bq.y << 16);
            v[4 * i + 3] = t.w + __uint_as_float(a.y & 0xFFFF0000u) + __uint_as_float(bq.y & 0xFFFF0000u);
            ss += v[4 * i] * v[4 * i] + v[4 * i + 1] * v[4 * i + 1] + v[4 * i + 2] * v[4 * i + 2] + v[4 * i + 3] * v[4 * i + 3];
        }
        ss = wave_sum(ss);
        const float rs = rsqrtf(ss * (1.f / D_) + 1e-6f);
#pragma unroll
        for (int i = 0; i < 4; i++) {
            const int c = i * 256 + lane * 4;
            const float4 g = *(const float4*)&p.g_final[c];
            float4 o; o.x = v[4 * i] * rs * g.x; o.y = v[4 * i + 1] * rs * g.y; o.z = v[4 * i + 2] * rs * g.z; o.w = v[4 * i + 3] * rs * g.w;
            *(float4*)&p.out[(size_t)row * D_ + c] = o;
        }
    }
}

#define XB_TMO      128
#define XB_XCNT(j)  (256  + 64 * (j))
#define XB_XSUB(j)  (1280 + 64 * (j))
#define XB_XGEN(j)  (2304 + 64 * (j))
#define XB_TOP      3328
#define XB_TOPGEN   3392
#define XCD_BAR_WORDS 3456
#define XB_SPIN_CAP (1u << 18)
#define LAS __attribute__((address_space(3)))

__device__ __forceinline__ unsigned xb_ld(unsigned* p)              { return __hip_atomic_load(p, __ATOMIC_RELAXED, __HIP_MEMORY_SCOPE_AGENT); }
__device__ __forceinline__ unsigned xb_add(unsigned* p, unsigned v) { return __hip_atomic_fetch_add(p, v, __ATOMIC_RELAXED, __HIP_MEMORY_SCOPE_AGENT); }
__device__ __forceinline__ unsigned xb_xcc_id() { return (unsigned)__builtin_amdgcn_s_getreg((3 << 11) | 20) & 0xFu; }
#define XB_SPIN(cond, bar) do { unsigned _sp = 0; while (cond) { __builtin_amdgcn_s_sleep(1); \
    if ((++_sp & 255u) == 0u) { if (xb_ld(&(bar)[XB_TMO])) break; if (_sp > XB_SPIN_CAP) { atomicAdd(&(bar)[XB_TMO], 1u); break; } } } } while (0)

struct XcdBarrier {
    unsigned* bar; unsigned x;
    volatile LAS unsigned* st;
};

__device__ __forceinline__ XcdBarrier xcd_barrier_post(unsigned* bar, volatile LAS unsigned* st) {
    XcdBarrier b; b.bar = bar; b.x = xb_xcc_id(); b.st = st;
    if (threadIdx.x == 0) (void)xb_add(&bar[XB_XCNT(b.x)], 1u);
    return b;
}
__device__ __forceinline__ void xcd_barrier_complete(unsigned* bar, unsigned x, unsigned& nloc, unsigned& nx) {
    const unsigned G = gridDim.x * gridDim.y * gridDim.z;
    unsigned sum, cnt, mine, sp = 0u;
    for (;;) {
        sum = 0u; cnt = 0u; mine = 0u;
#pragma unroll
        for (unsigned j = 0; j < 16; ++j) { const unsigned c = xb_ld(&bar[XB_XCNT(j)]); sum += c; cnt += (c > 0u) ? 1u : 0u; mine = (j == x) ? c : mine; }
        if (sum == G) break;
        __builtin_amdgcn_s_sleep(1);
        if ((++sp & 255u) == 0u) { if (xb_ld(&bar[XB_TMO])) break; if (sp > XB_SPIN_CAP) { atomicAdd(&bar[XB_TMO], 1u); break; } }
    }
    nloc = mine > 0u ? mine : 1u; nx = cnt > 0u ? cnt : 1u;
}

__device__ __forceinline__ void xcd_barrier(const XcdBarrier& b) {
    asm volatile("s_waitcnt vmcnt(0)" ::: "memory");
    __syncthreads();
    if (threadIdx.x == 0) {
        unsigned* bar = b.bar;
        __builtin_amdgcn_s_waitcnt(0);
        unsigned nloc = b.st[0], nx = b.st[1];
        if (nloc == 0u) { xcd_barrier_complete(bar, b.x, nloc, nx); b.st[0] = nloc; b.st[1] = nx; }
        const unsigned old = xb_add(&bar[XB_XSUB(b.x)], 1u);
        const unsigned gen = old / nloc;
        if (old + 1u == (gen + 1u) * nloc) {
            __builtin_amdgcn_fence(__ATOMIC_RELEASE, "agent");
            asm volatile("s_waitcnt vmcnt(0)" ::: "memory");
            const unsigned og = xb_add(&bar[XB_TOP], 1u);
            const unsigned tg = og / nx;
            if (og + 1u == (tg + 1u) * nx) xb_add(&bar[XB_TOPGEN], 1u);
            else XB_SPIN(xb_ld(&bar[XB_TOPGEN]) == tg, bar);
            __builtin_amdgcn_fence(__ATOMIC_ACQUIRE, "agent");
            xb_add(&bar[XB_XGEN(b.x)], 1u);
            asm volatile("s_waitcnt vmcnt(0)" ::: "memory");
        } else {
            XB_SPIN(xb_ld(&bar[XB_XGEN(b.x)]) == gen, bar);
            __builtin_amdgcn_fence(__ATOMIC_ACQUIRE, "agent");
            asm volatile("s_waitcnt vmcnt(0)" ::: "memory");
        }
    }
    __syncthreads();
}

template <int PH>
__device__ __forceinline__ void run_phase(const P& p, int bid, int nb, char* smem) {
    if constexpr (PH == 0) ph_prologue(p, bid, nb, smem);
    if constexpr (PH == 1) ph_inproj(p, bid, nb, smem);
    if constexpr (PH == 2) { ph_compress(p, bid, nb, smem); __syncthreads(); ph_rwkv_chunk(p, bid, nb, smem); }
    if constexpr (PH == 3) {
        if (bid < SCAN_BLOCKS) ph_rwkv_seq(p, bid, SCAN_BLOCKS, smem);
        else ph_nsa(p, bid - SCAN_BLOCKS, nb - SCAN_BLOCKS, smem);
    }
    if constexpr (PH == 12) ph_rwkv_out(p, bid, nb, smem);
    if constexpr (PH == 4) ph_merge(p, bid, nb, smem);
    if constexpr (PH == 5) ph_outproj(p, bid, nb, smem);
    if constexpr (PH == 6) ph_route(p, bid, nb, smem);
    if constexpr (PH == 7) ph_scatter(p, bid, nb, smem);
    if constexpr (PH == 9) ph_moe1(p, bid, nb, smem);
    if constexpr (PH == 10) ph_moe2(p, bid, nb, smem);
    if constexpr (PH == 11) ph_final(p, bid, nb, smem);
}

template <int PH>
__global__ void __launch_bounds__(NT) kph(P p) {
    extern __shared__ __attribute__((aligned(16))) char smem[];
    run_phase<PH>(p, blockIdx.x, gridDim.x, smem);
}

__global__ void __launch_bounds__(NT, 2) mega(P p) {
    extern __shared__ __attribute__((aligned(16))) char smem[];
    volatile LAS unsigned* st = (volatile LAS unsigned*)(smem + SMEM_BYTES - 16);
    if (threadIdx.x == 0) { st[0] = 0u; st[1] = 0u; st[2] = 0u; st[3] = 0u; }
    __syncthreads();
    XcdBarrier bar = xcd_barrier_post(p.bar, st);
    const int bid = blockIdx.x, nb = gridDim.x;
#define RUNP(N, BAR) { unsigned long long t0_ = 0; if ((TPROBE >> N) & 1) t0_ = __builtin_amdgcn_s_memrealtime(); run_phase<N>(p, bid, nb, smem); \
        unsigned long long tw_ = 0; if (((TPROBE >> N) & 1) && TPSEL) tw_ = __builtin_amdgcn_s_memrealtime() - t0_; if (BAR) xcd_barrier(bar); \
        if ((TPROBE >> N) & 1) { const unsigned long long t1_ = __builtin_amdgcn_s_memrealtime(); const unsigned long long dt_ = TPSEL ? tw_ : t1_ - t0_; \
            if (!TPSEL || (TPSEL == 1 ? (bid < SCAN_BLOCKS) : (bid >= SCAN_BLOCKS))) while (__builtin_amdgcn_s_memrealtime() - t1_ < dt_) __builtin_amdgcn_s_sleep(8); if (TPSEL) xcd_barrier(bar); } }
    RUNP(0, 1) RUNP(1, 1) RUNP(2, 1) RUNP(3, 1) RUNP(12, 1) RUNP(4, 1) RUNP(5, 1) RUNP(6, 1) RUNP(7, 1) RUNP(9, 1) RUNP(10, 1) RUNP(11, 0)
}

extern "C" void kernel_launch(void* const* d_in, const int* in_sizes, int n_in,
                              void* d_out, int out_size, void* d_ws, size_t ws_size,
                              hipStream_t stream) {
    P p{};
    p.x = (const float*)d_in[0]; p.pos = (const int*)d_in[1]; p.g_mix = (const float*)d_in[2]; p.w_in = (const float*)d_in[3];
    p.pe_k = (const float*)d_in[4]; p.w1_k = (const float*)d_in[5]; p.b1_k = (const float*)d_in[6]; p.w2_k = (const float*)d_in[7]; p.b2_k = (const float*)d_in[8];
    p.pe_v = (const float*)d_in[9]; p.w1_v = (const float*)d_in[10]; p.b1_v = (const float*)d_in[11]; p.w2_v = (const float*)d_in[12]; p.b2_v = (const float*)d_in[13];
    p.mu = (const float*)d_in[14]; p.w0 = (const float*)d_in[15]; p.w2 = (const float*)d_in[16]; p.a0 = (const float*)d_in[17]; p.a2 = (const float*)d_in[18];
    p.g2 = (const float*)d_in[19]; p.k_k = (const float*)d_in[20]; p.k_a = (const float*)d_in[21]; p.r_k = (const float*)d_in[22]; p.ln_w = (const float*)d_in[23]; p.ln_b = (const float*)d_in[24];
    p.wpa = (const float*)d_in[25]; p.wpb = (const float*)d_in[26]; p.wout = (const float*)d_in[27]; p.g_ffn = (const float*)d_in[28];
    p.w_grp = (const float*)d_in[29]; p.b_grp = (const float*)d_in[30]; p.w_exp = (const float*)d_in[31]; p.b_exp = (const float*)d_in[32];
    p.e_w1 = (const float*)d_in[33]; p.e_w3 = (const float*)d_in[34]; p.e_w2 = (const float*)d_in[35]; p.g_final = (const float*)d_in[36];
    p.out = (float*)d_out;
    char* ws = (char*)d_ws;
    const size_t MiB = 1ull << 20;
    p.hbuf = (u16*)(ws + 0 * MiB);
    p.q    = (u16*)(ws + 64 * MiB);
    p.kc   = (u16*)(ws + 96 * MiB);  p.vc   = (u16*)(ws + 104 * MiB);
    p.ksl  = (u16*)(ws + 112 * MiB); p.vslT = (u16*)(ws + 120 * MiB);
    p.kwn  = (u16*)(ws + 128 * MiB); p.vwnT = (u16*)(ws + 136 * MiB);
    p.nsag = (float*)(ws + 144 * MiB);
    p.kcb  = (u16*)(ws + 148 * MiB); p.vcT  = (u16*)(ws + 149 * MiB);
    p.prw  = (u16*)(ws + 160 * MiB);
    p.cdat = (u16*)(ws + 272 * MiB);
    p.bon  = (float*)(ws + 150 * MiB);
    p.w2T  = (u16*)(ws + 151 * MiB); p.a2T = p.w2T + 512 * 64; p.g2T = p.a2T + 512 * 64;
    p.cw1Tk = (u16*)(ws + 152 * MiB); p.cw1Tv = (u16*)(ws + 153 * MiB);
    p.cw2Tk = (u16*)(ws + 154 * MiB); p.cw2Tv = p.cw2Tk + 128 * 256;
    p.chid = (u16*)(ws + 155 * MiB);
    p.xact = (u16*)(ws + 488 * MiB);
    p.oa   = (u16*)(ws + 400 * MiB);
    p.ob   = (u16*)(ws + 432 * MiB);
    p.merged = (u16*)(ws + 64 * MiB);
    p.x1   = (float*)(ws + 160 * MiB);
    char* rt = ws + 288 * MiB;
    p.tok_e = (int*)(rt);                        rt += NTOK * 2 * 4;
    p.tok_gate = (float*)(rt);                   rt += NTOK * 2 * 4;
    p.tokslot = (int*)(rt);                      rt += NTOK * 2 * 4;
    p.list_tok = (int*)(rt);                     rt += NTOK * 2 * 4;
    p.list_gate = (float*)(rt);                  rt += NTOK * 2 * 4;
    p.blk_e = (int*)(rt);                        rt += 2048 * 4;
    p.blk_r0 = (int*)(rt);                       rt += 2048 * 4;
    p.rsb = (float*)(rt);                        rt += NTOK * 4;
    p.hid  = (u16*)(ws + 296 * MiB);
    p.ybuf = (u16*)(ws + 336 * MiB);
    char* misc = ws + 470 * MiB;
    p.counts = (int*)(misc); p.cursor = (int*)(misc + 256); p.offs = (int*)(misc + 512); p.nblk = (int*)(misc + 1024);
    p.bar = (unsigned*)(ws + 471 * MiB);
    p.cb1k = (float*)(misc + 65536); p.cb1v = p.cb1k + 256;
    {
        char* wa = ws + 472 * MiB;
        p.winT = (u16*)wa;  wa += (size_t)3328 * 1024 * 2;
        p.wgT  = (u16*)wa;  wa += (size_t)2048 * 1024 * 2;
        p.wpaT = (u16*)wa;  wa += (size_t)1024 * 512 * 2;
        p.wpbT = (u16*)wa;  wa += (size_t)1024 * 512 * 2;
        p.woutT = (u16*)wa; wa += (size_t)1024 * 1024 * 2;
        p.ew1T = (u16*)(ws + 64 * MiB);  p.ew3T = (u16*)(ws + 80 * MiB);  p.ew2T = (u16*)(ws + 96 * MiB);
    }
    if (ws_size < (size_t)505 * MiB) return;

#if MEGA
    {
        static int mgrid = 0;
        if (mgrid == 0) {
            int dev = 0, cus = 0, per_cu = 0;
            hipGetDevice(&dev);
            hipDeviceGetAttribute(&cus, hipDeviceAttributeMultiprocessorCount, dev);
            hipFuncSetAttribute((const void*)mega, hipFuncAttributeMaxDynamicSharedMemorySize, SMEM_BYTES);
            hipOccupancyMaxActiveBlocksPerMultiprocessor(&per_cu, (const void*)mega, NT, SMEM_BYTES);
            (void)hipGetLastError();
            mgrid = cus;
        }
        hipMemsetAsync(p.bar, 0, XCD_BAR_WORDS * sizeof(unsigned) + 512 * sizeof(float), stream);
        mega<<<mgrid, NT, SMEM_BYTES, stream>>>(p);
        return;
    }
#else
    const int grid = 512;
    hipMemsetAsync(p.bar, 0, XCD_BAR_WORDS * sizeof(unsigned) + 512 * sizeof(float), stream);
    hipFuncSetAttribute((const void*)kph<0>, hipFuncAttributeMaxDynamicSharedMemorySize, SMEM_BYTES);
    hipFuncSetAttribute((const void*)kph<1>, hipFuncAttributeMaxDynamicSharedMemorySize, SMEM_BYTES);
    hipFuncSetAttribute((const void*)kph<2>, hipFuncAttributeMaxDynamicSharedMemorySize, SMEM_BYTES);
    hipFuncSetAttribute((const void*)kph<3>, hipFuncAttributeMaxDynamicSharedMemorySize, SMEM_BYTES);
    hipFuncSetAttribute((const void*)kph<4>, hipFuncAttributeMaxDynamicSharedMemorySize, SMEM_BYTES);
    hipFuncSetAttribute((const void*)kph<5>, hipFuncAttributeMaxDynamicSharedMemorySize, SMEM_BYTES);
    hipFuncSetAttribute((const void*)kph<6>, hipFuncAttributeMaxDynamicSharedMemorySize, SMEM_BYTES);
    hipFuncSetAttribute((const void*)kph<7>, hipFuncAttributeMaxDynamicSharedMemorySize, SMEM_BYTES);
    hipFuncSetAttribute((const void*)kph<8>, hipFuncAttributeMaxDynamicSharedMemorySize, SMEM_BYTES);
    hipFuncSetAttribute((const void*)kph<9>, hipFuncAttributeMaxDynamicSharedMemorySize, SMEM_BYTES);
    hipFuncSetAttribute((const void*)kph<10>, hipFuncAttributeMaxDynamicSharedMemorySize, SMEM_BYTES);
    hipFuncSetAttribute((const void*)kph<11>, hipFuncAttributeMaxDynamicSharedMemorySize, SMEM_BYTES);
    kph<0><<<grid, NT, SMEM_BYTES, stream>>>(p);
    kph<1><<<grid, NT, SMEM_BYTES, stream>>>(p);
    kph<2><<<grid, NT, SMEM_BYTES, stream>>>(p);
    kph<3><<<grid, NT, SMEM_BYTES, stream>>>(p);
    kph<12><<<grid, NT, SMEM_BYTES, stream>>>(p);
    kph<4><<<grid, NT, SMEM_BYTES, stream>>>(p);
    kph<5><<<grid, NT, SMEM_BYTES, stream>>>(p);
    kph<6><<<grid, NT, SMEM_BYTES, stream>>>(p);
    kph<7><<<grid, NT, SMEM_BYTES, stream>>>(p);
    kph<8><<<grid, NT, SMEM_BYTES, stream>>>(p);
    kph<9><<<grid, NT, SMEM_BYTES, stream>>>(p);
    kph<10><<<grid, NT, SMEM_BYTES, stream>>>(p);
    kph<11><<<grid, NT, SMEM_BYTES, stream>>>(p);
#endif
}
```

```cpp
#include <hip/hip_runtime.h>
#include <stdint.h>

typedef unsigned short u16;
using bf16x8 = __attribute__((ext_vector_type(8))) short;
using f32x4  = __attribute__((ext_vector_type(4))) float;

#ifndef MEGA
#define MEGA 1
#endif

constexpr int B_ = 4, S_ = 8192, D_ = 1024, NTOK = B_ * S_;
constexpr int CIN = 5144;
constexpr int NCMP = 511;
constexpr int CRW = 1792;
constexpr int NEXP = 32;
constexpr int NT = 512;
constexpr int NW = NT / 64;
constexpr int SMEM_BYTES = 160 * 1024;
constexpr int SCAN_BLOCKS = 16;
#ifndef TPROBE
#define TPROBE 0
#define TPSEL 0
#endif
constexpr float QSCALE = 0.125f * 1.4426950408889634f;

struct P {
    const float* x; const int* pos; const float* g_mix; const float* w_in;
    const float *pe_k, *w1_k, *b1_k, *w2_k, *b2_k, *pe_v, *w1_v, *b1_v, *w2_v, *b2_v;
    const float *mu, *w0, *w2, *a0, *a2, *g2, *k_k, *k_a, *r_k, *ln_w, *ln_b;
    const float *wpa, *wpb, *wout, *g_ffn, *w_grp, *b_grp, *w_exp, *b_exp, *e_w1, *e_w3, *e_w2, *g_final;
    float* out;
    u16* hbuf; u16 *q, *kc, *vc, *ksl, *vslT, *kwn, *vwnT, *kcb, *vcT; float* nsag; u16* prw;
    u16* cdat; float* bon; u16 *w2T, *a2T, *g2T; u16 *oa, *ob; u16* merged; float* x1;
    int* tok_e; float* tok_gate; int* tokslot; int* list_tok; float* list_gate;
    int* counts; int* offs; int* cursor; int* blk_e; int* blk_r0; int* nblk; float* rsb; int* nsactr;
    u16* hid; u16* ybuf; unsigned* bar;
    u16 *winT, *wgT, *wpaT, *wpbT, *woutT, *ew1T, *ew3T, *ew2T;
    u16 *cw1Tk, *cw1Tv, *cw2Tk, *cw2Tv, *chid, *xact; float *cb1k, *cb1v;
};

typedef __bf16 bf16x2_t __attribute__((ext_vector_type(2)));
typedef float f32x2_t __attribute__((ext_vector_type(2)));
__device__ __forceinline__ unsigned pack2(float a, float b) {
    f32x2_t f = {a, b};
    return __builtin_bit_cast(unsigned, __builtin_convertvector(f, bf16x2_t));
}
__device__ __forceinline__ u16 f2bf(float f) { return (u16)(pack2(f, f) & 0xFFFFu); }
__device__ __forceinline__ float bf2f(u16 h) { return __uint_as_float(((unsigned)h) << 16); }
__device__ __forceinline__ float sigmoidf_(float x) { return __builtin_amdgcn_rcpf(1.f + __expf(-x)); }
__device__ __forceinline__ int get_tid() { int t = threadIdx.x; asm volatile("" : "+v"(t)); return t; }
__device__ __forceinline__ uint2 pack4(const f32x4& v) { uint2 o; o.x = pack2(v[0], v[1]); o.y = pack2(v[2], v[3]); return o; }
__device__ __forceinline__ f32x4 unpack4(uint2 u) { return f32x4{__uint_as_float(u.x << 16), __uint_as_float(u.x & 0xFFFF0000u), __uint_as_float(u.y << 16), __uint_as_float(u.y & 0xFFFF0000u)}; }
#define LDS_BARRIER() do { asm volatile("s_waitcnt lgkmcnt(0)" ::: "memory"); __builtin_amdgcn_s_barrier(); asm volatile("" ::: "memory"); } while (0)
__device__ __forceinline__ int opaque(int x) { asm volatile("" : "+v"(x)); return x; }
template <int CTRL>
__device__ __forceinline__ float dppf(float x) { return __int_as_float(__builtin_amdgcn_update_dpp(0, __float_as_int(x), CTRL, 0xF, 0xF, true)); }
__device__ __forceinline__ float wave_sum(float v) {
    v += dppf<0xB1>(v);
    v += dppf<0x4E>(v);
    v += dppf<0x141>(v);
    v += dppf<0x140>(v);
    const int vi = __float_as_int(v);
    return (__int_as_float(__builtin_amdgcn_readlane(vi, 0)) + __int_as_float(__builtin_amdgcn_readlane(vi, 16)))
         + (__int_as_float(__builtin_amdgcn_readlane(vi, 32)) + __int_as_float(__builtin_amdgcn_readlane(vi, 48)));
}

__device__ __forceinline__ float xrow_sum(float v) {
    auto r = __builtin_amdgcn_permlane16_swap(__float_as_uint(v), __float_as_uint(v), false, false);
    v = __uint_as_float(r[0]) + __uint_as_float(r[1]);
    auto r2 = __builtin_amdgcn_permlane32_swap(__float_as_uint(v), __float_as_uint(v), false, false);
    return __uint_as_float(r2[0]) + __uint_as_float(r2[1]);
}
__device__ __forceinline__ float xrow_max(float v) {
    auto r = __builtin_amdgcn_permlane16_swap(__float_as_uint(v), __float_as_uint(v), false, false);
    v = fmaxf(__uint_as_float(r[0]), __uint_as_float(r[1]));
    auto r2 = __builtin_amdgcn_permlane32_swap(__float_as_uint(v), __float_as_uint(v), false, false);
    return fmaxf(__uint_as_float(r2[0]), __uint_as_float(r2[1]));
}
__constant__ double ROPE_FREQ[32] = {
    1.00000000000000000000e+00, 7.49894209332455874417e-01, 5.62341325190349072827e-01, 4.21696503428582225581e-01,
    3.16227766016837941176e-01, 2.37137370566165517349e-01, 1.77827941003892292526e-01, 1.33352143216332402753e-01,
    1.00000000000000005551e-01, 7.49894209332455791150e-02, 5.62341325190349114460e-02, 4.21696503428582239459e-02,
    3.16227766016837913421e-02, 2.37137370566165538166e-02, 1.77827941003892292526e-02, 1.33352143216332406223e-02,
    1.00000000000000002082e-02, 7.49894209332455791150e-03, 5.62341325190349097113e-03, 4.21696503428582291501e-03,
    3.16227766016837939442e-03, 2.37137370566165538166e-03, 1.77827941003892275179e-03, 1.33352143216332406223e-03,
    1.00000000000000002082e-03, 7.49894209332455856203e-04, 5.62341325190349097113e-04, 4.21696503428582237290e-04,
    3.16227766016837939442e-04, 2.37137370566165538166e-04, 1.77827941003892269758e-04, 1.33352143216332395381e-04};

constexpr int G_ABYTES = 256 * 64 * 2, G_BBYTES = 128 * 64 * 2, G_TILE = G_ABYTES + G_BBYTES;
#define LAS3 __attribute__((address_space(3)))
#define GAS1 __attribute__((address_space(1)))
__device__ __forceinline__ void glds16(const u16* g, char* l) {
    __builtin_amdgcn_global_load_lds((const GAS1 unsigned*)g, (LAS3 unsigned*)l, 16, 0, 0);
}
template <bool TR = false, class ARow>
__device__ __forceinline__ void gemm_core(int K, ARow arow, const u16* __restrict__ BT, int ldb, f32x4 (&acc)[4][4], u16* sm) {
    char* base = (char*)sm;
    const int tid = get_tid(), lane = tid & 63, wv = tid >> 6;
    const int wm = wv >> 1, wn = wv & 1, kr = lane & 15, qq = lane >> 4;
    const int lr = tid >> 3, lk = ((tid & 7) ^ ((lr >> 1) & 7)) * 8;
    const u16* ap0 = arow(lr) + lk; const u16* ap1 = arow(lr + 64) + lk;
    const u16* ap2 = arow(lr + 128) + lk; const u16* ap3 = arow(lr + 192) + lk;
    const u16* bp0 = BT + (size_t)lr * ldb + lk; const u16* bp1 = BT + (size_t)(lr + 64) * ldb + lk;
#pragma unroll
    for (int mt = 0; mt < 4; mt++)
#pragma unroll
        for (int nt = 0; nt < 4; nt++) acc[mt][nt] = f32x4{0.f, 0.f, 0.f, 0.f};
    const int nk = K >> 6;
#define G_ISSUE(t, b) { char* d = base + (b) * G_TILE + tid * 16; const int ko = (t) * 64; \
        glds16(ap0 + ko, d); glds16(ap1 + ko, d + 8192); glds16(ap2 + ko, d + 16384); glds16(ap3 + ko, d + 24576); \
        glds16(bp0 + ko, d + G_ABYTES); glds16(bp1 + ko, d + G_ABYTES + 8192); }
    const int sw = kr >> 1;
    const int po0 = ((0 * 4 + qq) ^ sw) * 16, po1 = ((1 * 4 + qq) ^ sw) * 16;
    const int aoff = (wm * 64 + kr) * 128, boff = G_ABYTES + (wn * 64 + kr) * 128;
#define G_READ(FA, FB, b) { const char* Ab = base + (b) * G_TILE + aoff; const char* Bb = base + (b) * G_TILE + boff; \
        _Pragma("unroll") for (int mt = 0; mt < 4; mt++) { FA[0][mt] = *(const bf16x8*)(Ab + mt * 2048 + po0); FA[1][mt] = *(const bf16x8*)(Ab + mt * 2048 + po1); } \
        _Pragma("unroll") for (int nt = 0; nt < 4; nt++) { FB[0][nt] = *(const bf16x8*)(Bb + nt * 2048 + po0); FB[1][nt] = *(const bf16x8*)(Bb + nt * 2048 + po1); } }
#define G_MMA(FA, FB) { __builtin_amdgcn_s_setprio(1); \
        _Pragma("unroll") for (int ks = 0; ks < 2; ks++) \
            _Pragma("unroll") for (int nt = 0; nt < 4; nt++) \
                _Pragma("unroll") for (int mt = 0; mt < 4; mt++) \
                    acc[mt][nt] = TR ? __builtin_amdgcn_mfma_f32_16x16x32_bf16(FA[ks][mt], FB[ks][nt], acc[mt][nt], 0, 0, 0) \
                                     : __builtin_amdgcn_mfma_f32_16x16x32_bf16(FB[ks][nt], FA[ks][mt], acc[mt][nt], 0, 0, 0); \
        __builtin_amdgcn_s_setprio(0); }
    bf16x8 fa0[2][4], fb0[2][4], fa1[2][4], fb1[2][4];
    G_ISSUE(0, 0)
    if (nk > 1) G_ISSUE(1, 1)
    if (nk > 2) G_ISSUE(2, 2)
    if (nk > 2) asm volatile("s_waitcnt vmcnt(12)" ::: "memory");
    else if (nk > 1) asm volatile("s_waitcnt vmcnt(6)" ::: "memory");
    else asm volatile("s_waitcnt vmcnt(0)" ::: "memory");
    __builtin_amdgcn_s_barrier();
    G_READ(fa0, fb0, 0)
    int bnext = 1, bfree = 0;
#define G_STEP(FAC, FBC, FAN, FBN, kt) { \
        if ((kt) + 1 < nk) { \
            if ((kt) + 2 < nk) asm volatile("s_waitcnt vmcnt(6) lgkmcnt(0)" ::: "memory"); else asm volatile("s_waitcnt vmcnt(0) lgkmcnt(0)" ::: "memory"); \
            __builtin_amdgcn_s_barrier();                   \
            if ((kt) + 3 < nk) G_ISSUE((kt) + 3, bfree) \
            G_READ(FAN, FBN, bnext) \
        } \
        G_MMA(FAC, FBC) \
        bfree = bnext; bnext = (bnext == 2) ? 0 : bnext + 1; }
    for (int kt = 0; kt < nk; kt += 2) {
        G_STEP(fa0, fb0, fa1, fb1, kt)
        G_STEP(fa1, fb1, fa0, fb0, kt + 1)
    }
    __builtin_amdgcn_s_barrier();
#undef G_READ
#undef G_MMA
#undef G_STEP
#undef G_ISSUE
}

__device__ __forceinline__ int xcd_item(int bid, int nb, int k, int nitems) {
    if (nb & 7) return bid + k * nb;
    const int per = nb >> 3, chunk = (nitems + 7) >> 3;
    const int j = k * per + (bid >> 3);
    return (j < chunk) ? (bid & 7) * chunk + j : nitems;
}
struct GUnit { int pm, pn; };
constexpr int G8_HTB = 128 * 64 * 2;
__device__ __forceinline__ int g8_lds_byte(int r, int c) { const int st = (r >> 4) * 2 + (c >> 5), rr = r & 15, cc = c & 31, ob = rr * 64 + cc * 2; return st * 1024 + (ob ^ (((ob >> 9) & 1) << 5)); }
__device__ __forceinline__ void g8_stage_rc(int b, int& R, int& C) { const int st = b / 1024, sb = b % 1024, swz = sb ^ (((sb >> 9) & 1) << 5); R = (st >> 1) * 16 + swz / 64; C = (st & 1) * 32 + (swz % 64) / 2; }
__host__ __device__ __forceinline__ int perm32(int rho) { const int n = rho >> 4, i = rho & 15; return 8 * (i >> 2) + 4 * n + (i & 3); }

template <class Epi, class Sched>
__device__ __forceinline__ void gemm256(char* smem, const char* Ab, int K, const Sched& S, const Epi& E) {
    LAS3 unsigned char* lds = (LAS3 unsigned char*)smem;
    const int tid = get_tid(), wid = __builtin_amdgcn_readfirstlane(tid >> 6), lane = tid & 63, wr = wid >> 2, wc = wid & 3, fr = lane & 15, fq = lane >> 4;
    int nt = K >> 6; asm volatile("" : "+s"(nt));
    unsigned voffB[2], voffA[2][2];
#pragma unroll
    for (int i = 0; i < 2; ++i) { int sR, sC; g8_stage_rc(tid * 16 + i * 8192, sR, sC); voffB[i] = (unsigned)(sR * K + sC) * 2u; }
#define G8_AOFFS(un) do { const int t3_ = get_tid(); _Pragma("unroll") for (int i = 0; i < 2; ++i) { int sR, sC; g8_stage_rc(t3_ * 16 + i * 8192, sR, sC); \
        _Pragma("unroll") for (int h = 0; h < 2; ++h) voffA[h][i] = S.a_off(un, h, sR) + (unsigned)sC * 2u; } } while (0)
    const size_t kstep = 128;
    const size_t hstep = (size_t)128 * K * 2;
    const unsigned ldsw = (unsigned)wid * 1024u;
    const int aoff = g8_lds_byte(wr * 64 + fr, fq * 8), boff = g8_lds_byte(wc * 32 + fr, fq * 8);
#define G8_SA(b, h) (((b) * 2 + (h)) * G8_HTB)
#define G8_SB(b, h) ((4 + (b) * 2 + (h)) * G8_HTB)
#define G8_STAGE2(bufoff, gbase, v0, v1) do { \
        __builtin_amdgcn_global_load_lds((const GAS1 unsigned*)((const char*)(gbase) + (v0)), (LAS3 unsigned*)(lds + (bufoff) + ldsw), 16, 0, 0); \
        __builtin_amdgcn_global_load_lds((const GAS1 unsigned*)((const char*)(gbase) + (v1)), (LAS3 unsigned*)(lds + (bufoff) + ldsw + 8192), 16, 0, 0); } while (0)
#define G8_STAGEB(bufoff, gbase) G8_STAGE2(bufoff, gbase, voffB[0], voffB[1])
#define G8_LDA(dst, b, h) do { _Pragma("unroll") for (int m = 0; m < 4; ++m) _Pragma("unroll") for (int k = 0; k < 2; ++k) dst[m][k] = *(const LAS3 bf16x8*)(lds + G8_SA(b, h) + aoff + m * 2048 + k * 1024); } while (0)
#define G8_LDB(dst, b, h) do { _Pragma("unroll") for (int n = 0; n < 2; ++n) _Pragma("unroll") for (int k = 0; k < 2; ++k) dst[n][k] = *(const LAS3 bf16x8*)(lds + G8_SB(b, h) + boff + n * 2048 + k * 1024); } while (0)
#define G8_MMA(ai, bj, At, Bt) do { __builtin_amdgcn_s_setprio(1); _Pragma("unroll") for (int m = 0; m < 4; ++m) _Pragma("unroll") for (int n = 0; n < 2; ++n) _Pragma("unroll") for (int k = 0; k < 2; ++k) \
        acc[ai][bj][m][n] = __builtin_amdgcn_mfma_f32_16x16x32_bf16(Bt[n][k], At[m][k], acc[ai][bj][m][n], 0, 0, 0); __builtin_amdgcn_s_setprio(0); } while (0)
#define G8_WAIT_V(n) asm volatile("s_waitcnt vmcnt(" #n ")" ::: "memory")
#define G8_WAIT_L(n) asm volatile("s_waitcnt lgkmcnt(" #n ")" ::: "memory")
#define G8_BAR __builtin_amdgcn_s_barrier()
#define G8_SCHED __builtin_amdgcn_sched_barrier(0)
    GUnit cur, nxt; int ui = 0;
    if (!S.next(0, cur)) return;
    f32x4 acc[2][2][4][2];
#pragma unroll
    for (int a = 0; a < 2; ++a)
#pragma unroll
        for (int b = 0; b < 2; ++b)
#pragma unroll
            for (int m = 0; m < 4; ++m)
#pragma unroll
                for (int n = 0; n < 2; ++n) acc[a][b][m][n] = (f32x4){0.f, 0.f, 0.f, 0.f};
    bf16x8 At[4][2], B0[2][2], B1[2][2];
    G8_AOFFS(cur);
    const char* cB = S.b_ptr(cur);
    G8_STAGEB(G8_SB(0, 0), cB); G8_STAGE2(G8_SA(0, 0), Ab, voffA[0][0], voffA[0][1]); G8_STAGEB(G8_SB(0, 1), cB + hstep); G8_STAGE2(G8_SA(0, 1), Ab, voffA[1][0], voffA[1][1]);
    if (wr == 1) G8_BAR;
    G8_WAIT_V(4); G8_BAR;
    G8_STAGEB(G8_SB(1, 0), cB + kstep); G8_STAGE2(G8_SA(1, 0), Ab + kstep, voffA[0][0], voffA[0][1]); G8_STAGEB(G8_SB(1, 1), cB + hstep + kstep);
    G8_WAIT_V(6); G8_BAR;
    for (;;) {
        const bool has_next = S.next(ui + 1, nxt);
        const char* nB = has_next ? S.b_ptr(nxt) : cB;
        for (int t = 0; t < nt; t += 2) {
            const bool last = (t == nt - 2);
            const char* a1 = Ab + (size_t)(t + 1) * kstep;
            const unsigned va10 = voffA[1][0], va11 = voffA[1][1];
            if (last && has_next) G8_AOFFS(nxt);
            const char* a2 = last ? Ab : Ab + (size_t)(t + 2) * kstep; const char* b2 = last ? nB : cB + (size_t)(t + 2) * kstep;
            const char* a3 = a2 + kstep; const char* b3 = b2 + kstep;
            G8_LDB(B0, 0, 0); G8_SCHED; G8_LDA(At, 0, 0); G8_STAGE2(G8_SA(1, 1), a1, va10, va11);
            G8_WAIT_L(8); G8_BAR; G8_WAIT_L(0); G8_MMA(0, 0, At, B0); G8_BAR; G8_SCHED;
            G8_LDB(B1, 0, 1); G8_STAGEB(G8_SB(0, 0), b2);
            G8_BAR; G8_WAIT_L(0); G8_MMA(0, 1, At, B1); G8_BAR;
            G8_LDA(At, 0, 1); G8_STAGE2(G8_SA(0, 0), a2, voffA[0][0], voffA[0][1]);
            G8_BAR; G8_WAIT_L(0); G8_MMA(1, 0, At, B0); G8_BAR; G8_SCHED;
            G8_STAGEB(G8_SB(0, 1), b2 + hstep);
            G8_WAIT_V(6); G8_BAR; G8_MMA(1, 1, At, B1); G8_BAR;
            G8_LDB(B0, 1, 0); G8_SCHED; G8_LDA(At, 1, 0); G8_STAGE2(G8_SA(0, 1), a2, voffA[1][0], voffA[1][1]);
            G8_WAIT_L(8); G8_BAR; G8_WAIT_L(0); G8_MMA(0, 0, At, B0); G8_BAR; G8_SCHED;
            G8_LDB(B1, 1, 1); G8_STAGEB(G8_SB(1, 0), b3);
            G8_BAR; G8_WAIT_L(0); G8_MMA(0, 1, At, B1); G8_BAR;
            G8_LDA(At, 1, 1); G8_STAGE2(G8_SA(1, 0), a3, voffA[0][0], voffA[0][1]);
            G8_BAR; G8_WAIT_L(0); G8_MMA(1, 0, At, B0); G8_BAR; G8_SCHED;
            G8_STAGEB(G8_SB(1, 1), b3 + hstep);
            G8_WAIT_V(6); G8_BAR; G8_MMA(1, 1, At, B1); G8_BAR;
        }
        E(acc, cur, wr, wc, fr, fq);
        if (!has_next) break;
#pragma unroll
        for (int a = 0; a < 2; ++a)
#pragma unroll
            for (int b = 0; b < 2; ++b)
#pragma unroll
                for (int m = 0; m < 4; ++m)
#pragma unroll
                    for (int n = 0; n < 2; ++n) acc[a][b][m][n] = (f32x4){0.f, 0.f, 0.f, 0.f};
        cur = nxt; cB = nB; ++ui;
    }
    G8_WAIT_V(0);
    if (wr == 0) G8_BAR;
    G8_BAR;
#undef G8_SA
#undef G8_AOFFS
#undef G8_SB
#undef G8_STAGE2
#undef G8_STAGEB
#undef G8_LDA
#undef G8_LDB
#undef G8_MMA
#undef G8_WAIT_V
#undef G8_WAIT_L
#undef G8_BAR
#undef G8_SCHED
}
struct DenseSched {
    int nM, nN, nwg, G, c, K; const char* Bt;
    __device__ __forceinline__ void init(int M, int N, int K_, const void* Bt_, int G_, int c_) { nM = M >> 8; nN = N >> 8; nwg = nM * nN; G = G_; c = c_; K = K_; Bt = (const char*)Bt_; }
    __device__ __forceinline__ bool next(int i, GUnit& u) const {
        const int L = i * G + c; if (L >= nwg) return false;
        int wgid = L; { const int q = nwg >> 3, r = nwg & 7, xcd = wgid & 7, off = wgid >> 3; wgid = (xcd < r ? xcd * (q + 1) : r * (q + 1) + (xcd - r) * q) + off; }
        const int nig = 8 * nN, gid = wgid / nig, fm = gid * 8, gsz = (nM - fm) < 8 ? (nM - fm) : 8, w = wgid - gid * nig;
        u.pn = w / gsz; u.pm = fm + (w - u.pn * gsz); return true;
    }
    __device__ __forceinline__ unsigned a_off(const GUnit& u, int h, int R) const { return (unsigned)((u.pm * 256 + h * 128 + R) * K) * 2u; }
    __device__ __forceinline__ const char* b_ptr(const GUnit& u) const { return Bt + (size_t)u.pn * 256 * K * 2; }
};

template <class SRC>
__device__ __forceinline__ void convert_wT(const float* __restrict__ W, int K, int N, u16* __restrict__ WT, int rows, SRC src, int gtid, int gnt) {
    const int kch = K >> 3;
    const int total = rows * kch;
    for (int i0 = gtid; i0 < total; i0 += 4 * gnt) {
        float f[4][8]; int sc[4];
#pragma unroll
        for (int u = 0; u < 4; u++) {
            const int i = i0 + u * gnt;
            sc[u] = -1;
            if (i < total) {
                const int kc = i / rows, j = i - kc * rows;
                sc[u] = src(j);
                if (sc[u] >= 0) {
                    const float* wp = W + (size_t)(kc * 8) * N + sc[u];
#pragma unroll
                    for (int q = 0; q < 8; q++) f[u][q] = wp[(size_t)q * N];
                }
            }
        }
#pragma unroll
        for (int u = 0; u < 4; u++) {
            const int i = i0 + u * gnt;
            if (i < total) {
                const int kc = i / rows, j = i - kc * rows;
                uint4 v = make_uint4(0u, 0u, 0u, 0u);
                if (sc[u] >= 0) { v.x = pack2(f[u][0], f[u][1]); v.y = pack2(f[u][2], f[u][3]); v.z = pack2(f[u][4], f[u][5]); v.w = pack2(f[u][6], f[u][7]); }
                *(uint4*)&WT[(size_t)j * K + kc * 8] = v;
            }
        }
    }
}

__device__ void ph_prologue(const P& p, int bid, int nb, char* smem) {
    const int tid = get_tid(), lane = tid & 63, wv = tid >> 6;
    if (bid >= 1 && bid <= 64) {
        const int j = tid & 255; const bool isv = tid >= 256;
        const float* pe = isv ? p.pe_v : p.pe_k; const float* w1 = isv ? p.w1_v : p.w1_k;
        const int kb = (bid - 1) * 32;
        float a0 = 0.f, a1 = 0.f;
#pragma unroll 4
        for (int k = kb; k < kb + 32; k += 2) { a0 += pe[k] * w1[(size_t)k * 256 + j]; a1 += pe[k + 1] * w1[(size_t)(k + 1) * 256 + j]; }
        p.cb1k[(bid - 1) * 512 + (isv ? 256 : 0) + j] = a0 + a1;
    }
    if (bid == 0) {
        if (tid < 32) { p.counts[tid] = 0; p.cursor[tid] = 0; }
        if (tid == 32) *p.nsactr = 0;
        for (int i = tid; i < 8 * 64; i += NT) {
            const int bg = i >> 6, d = i & 63;
            p.kcb[((size_t)bg * 512 + 511) * 64 + d] = 0;
            p.vcT[(((size_t)bg * 8 + 7) * 64 + d) * 64 + 63] = 0;
        }
    }
    {
        const int gtid = bid * NT + tid, gnt = nb * NT;
        convert_wT(p.w_in, D_, CIN, p.winT, 3328, [](int j) {
            const int t = j >> 8, s = j & 255;
            if (t < 5) {
                const int bj = s >> 7, wc = (s >> 5) & 3, n = (s >> 4) & 1, i = s & 15;
                const int dim = 32 * bj + 8 * (i >> 2) + 4 * n + (i & 3), hq = 4 * t + wc;
                int hb;
                if (hq < 8) hb = 64 * hq;
                else { const int k = (hq - 8) >> 1; hb = (k == 0 ? 512 : (k == 1 ? 640 : (k == 2 ? 768 : (k == 3 ? 1024 : (k == 4 ? 896 : 1152))))) + 64 * (hq & 1); }
                return hb + dim;
            }
            const int c = (s & ~31) + perm32(s & 31);
            if (t < 12) return 1304 + (t - 5) * 256 + c;
            return c < 24 ? 1280 + c : -1; }, gtid, gnt);
        convert_wT(p.w_in, D_, CIN, p.wgT, 2048, [](int j) { return 3096 + (j & ~31) + perm32(j & 31); }, gtid, gnt);
        convert_wT(p.wpa, 512, D_, p.wpaT, 1024, [](int j) { return (j & ~31) + perm32(j & 31); }, gtid, gnt);
        convert_wT(p.wpb, 512, D_, p.wpbT, 1024, [](int j) { return (j & ~31) + perm32(j & 31); }, gtid, gnt);
        convert_wT(p.wout, D_, D_, p.woutT, 1024, [](int j) { return j; }, gtid, gnt);
        convert_wT(p.w2, 64, 512, p.w2T, 512, [](int j) { return j; }, gtid, gnt);
        convert_wT(p.w1_k, 2048, 256, p.cw1Tk, 256, [](int j) { return j; }, gtid, gnt);
        convert_wT(p.w1_v, 2048, 256, p.cw1Tv, 256, [](int j) { return j; }, gtid, gnt);
        convert_wT(p.w2_k, 256, 64, p.cw2Tk, 128, [](int j) { return j < 64 ? j : -1; }, gtid, gnt);
        convert_wT(p.w2_v, 256, 64, p.cw2Tv, 128, [](int j) { return j < 64 ? j : -1; }, gtid, gnt);
        convert_wT(p.a2, 64, 512, p.a2T, 512, [](int j) { return j; }, gtid, gnt);
        convert_wT(p.g2, 128, 512, p.g2T, 512, [](int j) { return j; }, gtid, gnt);
    }
    for (int row = bid * NW + wv; row < NTOK; row += nb * NW) {
        const float* xr = p.x + (size_t)row * D_;
        float v[16];
        float ss = 0.f;
#pragma unroll
        for (int i = 0; i < 4; i++) {
            float4 t = *(const float4*)&xr[i * 256 + lane * 4];
            v[4 * i] = t.x; v[4 * i + 1] = t.y; v[4 * i + 2] = t.z; v[4 * i + 3] = t.w;
            ss += t.x * t.x + t.y * t.y + t.z * t.z + t.w * t.w;
        }
        ss = wave_sum(ss);
        const float rs = rsqrtf(ss * (1.f / D_) + 1e-6f);
#pragma unroll
        for (int i = 0; i < 4; i++) {
            const int c = i * 256 + lane * 4;
            float4 g = *(const float4*)&p.g_mix[c];
            uint2 o;
            o.x = pack2(v[4 * i] * rs * g.x, v[4 * i + 1] * rs * g.y);
            o.y = pack2(v[4 * i + 2] * rs * g.z, v[4 * i + 3] * rs * g.w);
            *(uint2*)&p.hbuf[(size_t)row * D_ + c] = o;
        }
    }
}

__device__ __forceinline__ uint4 pack8(const f32x4& a, const f32x4& b) { uint4 o; o.x = pack2(a[0], a[1]); o.y = pack2(a[2], a[3]); o.z = pack2(b[0], b[1]); o.w = pack2(b[2], b[3]); return o; }
struct EpiInproj {
    const P* pp;
    __device__ __forceinline__ void operator()(const f32x4 (&acc)[2][2][4][2], const GUnit& u, int, int, int, int) const {
        const int t2_ = get_tid(), wid_ = __builtin_amdgcn_readfirstlane(t2_ >> 6), wr = wid_ >> 2, wc = wid_ & 3, fr = t2_ & 15, fq = (t2_ >> 4) & 3;
        const P& p = *pp;
        const int pn = u.pn;
        const int rowb = u.pm * 256 + wr * 64;
        if (pn < 4) {
            const int hq = 4 * pn + wc;
            const bool rope = !(pn == 2 && wc >= 2);
            u16* dst; size_t rstride; int cofs;
            if (pn < 2) { dst = p.q; rstride = 512; cofs = hq * 64; }
            else { dst = (pn == 2) ? (wc < 2 ? p.kc : p.vc) : (wc < 2 ? p.ksl : p.kwn); rstride = 64; cofs = 0; }
            const int g = wc & 1;
#pragma unroll
            for (int ai = 0; ai < 2; ++ai)
#pragma unroll
                for (int m = 0; m < 4; ++m) {
                    const int row = rowb + ai * 128 + m * 16 + fr;
                    f32x4 o1[2], o2[2];
#pragma unroll
                    for (int n = 0; n < 2; ++n) { o1[n] = acc[ai][0][m][n]; o2[n] = acc[ai][1][m][n]; }
                    if (rope) {
                        const double posd = (double)p.pos[row];
#pragma unroll
                        for (int n = 0; n < 2; ++n)
#pragma unroll
                            for (int j = 0; j < 4; ++j) {
                                const double tr = posd * ROPE_FREQ[8 * fq + 4 * n + j] * 0.15915494309189535;
                                const float fr_ = (float)(tr - rint(tr));
                                const float cs = __builtin_amdgcn_cosf(fr_), sn = __builtin_amdgcn_sinf(fr_);
                                const float x1 = o1[n][j], x2 = o2[n][j];
                                o1[n][j] = x1 * cs - x2 * sn; o2[n][j] = x1 * sn + x2 * cs;
                            }
                    }
                    size_t ro;
                    if (pn < 2) {
#pragma unroll
                        for (int n = 0; n < 2; ++n)
#pragma unroll
                            for (int j = 0; j < 4; ++j) { o1[n][j] *= QSCALE; o2[n][j] *= QSCALE; }
                        ro = (size_t)row * 512 + cofs + 8 * fq;
                    } else {
                        const int bb = row >> 13, t = row & (S_ - 1);
                        ro = ((size_t)(bb * 2 + g) * S_ + t) * 64 + 8 * fq;
                    }
                    *(uint4*)&dst[ro] = pack8(o1[0], o1[1]);
                    *(uint4*)&dst[ro + 32] = pack8(o2[0], o2[1]);
                }
        } else if (pn == 4) {
            u16* dst = (wc < 2) ? p.vslT : p.vwnT;
            const int g = wc & 1;
#pragma unroll
            for (int ai = 0; ai < 2; ++ai) {
                const int r0 = rowb + ai * 128, bb = r0 >> 13, tb = r0 & (S_ - 1);
                u16* base = dst + ((size_t)(bb * 2 + g) * 128 + (tb >> 6)) * 4096;
#pragma unroll
                for (int m = 0; m < 4; ++m)
#pragma unroll
                    for (int bj = 0; bj < 2; ++bj)
#pragma unroll
                        for (int n = 0; n < 2; ++n)
#pragma unroll
                            for (int j = 0; j < 4; ++j)
                                base[(32 * bj + 8 * fq + 4 * n + j) * 64 + m * 16 + fr] = f2bf(acc[ai][bj][m][n][j]);
            }
        } else if (pn < 12) {
            const int cb = (pn - 5) * 256 + wc * 32 + 8 * fq;
#pragma unroll
            for (int ai = 0; ai < 2; ++ai)
#pragma unroll
                for (int m = 0; m < 4; ++m) {
                    const size_t ro = (size_t)(rowb + ai * 128 + m * 16 + fr) * CRW + cb;
#pragma unroll
                    for (int bj = 0; bj < 2; ++bj) *(uint4*)&p.prw[ro + bj * 128] = pack8(acc[ai][bj][m][0], acc[ai][bj][m][1]);
                }
        } else {
            if (wc == 0 && fq < 3) {
#pragma unroll
                for (int ai = 0; ai < 2; ++ai)
#pragma unroll
                    for (int m = 0; m < 4; ++m) {
                        const size_t ro = (size_t)(rowb + ai * 128 + m * 16 + fr) * 24 + 8 * fq;
#pragma unroll
                        for (int n = 0; n < 2; ++n) {
                            float4 o; o.x = sigmoidf_(acc[ai][0][m][n][0]); o.y = sigmoidf_(acc[ai][0][m][n][1]); o.z = sigmoidf_(acc[ai][0][m][n][2]); o.w = sigmoidf_(acc[ai][0][m][n][3]);
                            *(float4*)&p.nsag[ro + 4 * n] = o;
                        }
                    }
            }
        }
    }
};
__device__ void ph_inproj(const P& p, int bid, int nb, char* smem) {
    DenseSched S; S.init(NTOK, 3328, D_, p.winT, nb, bid);
    EpiInproj E{&p};
    gemm256(smem, (const char*)p.hbuf, D_, S, E);
}

__device__ __forceinline__ float gelu_tanh(float x) {
    const float c = 0.7978845608028654f;
    return 0.5f * x * (1.f + tanhf(c * (x + 0.044715f * x * x * x)));
}
__device__ void ph_compress(const P& p, int bid, int nb, char* smem) {
    u16* sm = (u16*)smem;
    const int tid = get_tid(), lane = tid & 63, wv = tid >> 6;
    const int wm = wv >> 1, wn = wv & 1;
    for (int it = bid; it < 32; it += nb) {
        const int rt = it & 1, g = (it >> 1) & 1, b = (it >> 2) & 3, kv = it >> 4;
        const int bg = b * 2 + g, i0 = rt * 256;
        const u16* src = (kv ? p.vc : p.kc) + (size_t)bg * S_ * 64;
        const u16* w1T = kv ? p.cw1Tv : p.cw1Tk;
        const u16* w2T = kv ? p.cw2Tv : p.cw2Tk;
        float* cb1 = (float*)(smem + 3 * G_TILE);
        __syncthreads();
        { const int t2 = get_tid(); if (t2 < 256) { float a = 0.f; for (int q = 0; q < 64; q++) a += p.cb1k[q * 512 + kv * 256 + t2]; cb1[t2] = a; } }
        __syncthreads();
        const float* b1 = kv ? p.b1_v : p.b1_k;
        const float* b2 = kv ? p.b2_v : p.b2_k;
        u16* hidp = p.chid + (size_t)it * 256 * 256;
        auto arow = [&](int r) { int i = i0 + r; if (i > 510) i = 510; return src + (size_t)i * 1024; };
#pragma unroll 1
        for (int ct = 0; ct < 2; ct++) {
            f32x4 acc[4][4];
            gemm_core<false>(2048, arow, w1T + (size_t)ct * 128 * 2048, 2048, acc, sm);
            const int le = get_tid() & 63;
#pragma unroll
            for (int mt = 0; mt < 4; mt++) {
                const int r = wm * 64 + mt * 16 + (le & 15);
#pragma unroll
                for (int nt = 0; nt < 4; nt++) {
                    const int col = ct * 128 + wn * 64 + nt * 16 + (le >> 4) * 4;
                    const float4 c1 = *(const float4*)&cb1[col], bb1 = *(const float4*)&b1[col];
                    f32x4 o;
                    o[0] = gelu_tanh(acc[mt][nt][0] + c1.x + bb1.x); o[1] = gelu_tanh(acc[mt][nt][1] + c1.y + bb1.y);
                    o[2] = gelu_tanh(acc[mt][nt][2] + c1.z + bb1.z); o[3] = gelu_tanh(acc[mt][nt][3] + c1.w + bb1.w);
                    *(uint2*)&hidp[r * 256 + col] = pack4(o);
                }
            }
        }
        __syncthreads();
        {
            f32x4 acc[4][4];
            gemm_core<true>(256, [&](int r) { return hidp + (size_t)r * 256; }, w2T, 256, acc, sm);
            if (wn == 0) {
#pragma unroll
                for (int mt = 0; mt < 4; mt++)
#pragma unroll
                    for (int nt = 0; nt < 4; nt++) {
                        const int d = nt * 16 + (lane & 15);
                        const int ib = i0 + wm * 64 + mt * 16 + (lane >> 4) * 4;
                        float o[4];
#pragma unroll
                        for (int j = 0; j < 4; j++) o[j] = (ib + j < NCMP) ? (acc[mt][nt][j] + b2[d]) : 0.f;
                        if (kv == 0) {
#pragma unroll
                            for (int j = 0; j < 4; j++) p.kcb[((size_t)bg * 512 + ib + j) * 64 + d] = f2bf(o[j]);
                        } else {
                            uint2 ov; ov.x = pack2(o[0], o[1]); ov.y = pack2(o[2], o[3]);
                            *(uint2*)&p.vcT[(((size_t)bg * 8 + (ib >> 6)) * 64 + d) * 64 + (ib & 63)] = ov;
                        }
                    }
            }
        }
        __syncthreads();
    }
}

#ifndef NSAPROBE
#define NSAPROBE 0
#endif
#define NSA_TS(k) if (NSAPROBE == k) ts_ = __builtin_amdgcn_s_memrealtime();
#define NSA_TE(k) if (NSAPROBE == k) tacc_ += __builtin_amdgcn_s_memrealtime() - ts_;
constexpr int KSTR = 72;
struct Sub { f32x4 O[4]; float m, l; };
#define NEG_BIG (-1.0e30f)

__device__ __forceinline__ float xq_max(float v) {
    return xrow_max(v);
}
__device__ __forceinline__ float xq_sum(float v) {
    return xrow_sum(v);
}
typedef unsigned u32x2 __attribute__((ext_vector_type(2)));
union VF { bf16x8 v; u32x2 h[2]; };
template <int OFF> __device__ __forceinline__ u32x2 lds_read_b64(unsigned addr) { u32x2 r; asm volatile("ds_read_b64 %0, %1 offset:%2" : "=v"(r) : "v"(addr), "n"(OFF)); return r; }
#define NSA_LDV_ASM(vf, Vs, kr, qq, swz) { const unsigned va_ = (unsigned)(size_t)(const LAS3 char*)((const char*)(Vs) + (kr) * 128 + ((qq) & 1) * 8); const int vo_ = (((qq) >> 1) ^ (swz)) << 4; \
        const unsigned a0_ = va_ + vo_, a1_ = va_ + (vo_ ^ 32), a2_ = va_ + (vo_ ^ 64), a3_ = va_ + (vo_ ^ 96); \
        vf[0][0].h[0] = lds_read_b64<0>(a0_);    vf[0][0].h[1] = lds_read_b64<0>(a1_);    vf[0][1].h[0] = lds_read_b64<0>(a2_);    vf[0][1].h[1] = lds_read_b64<0>(a3_); \
        vf[1][0].h[0] = lds_read_b64<2048>(a0_); vf[1][0].h[1] = lds_read_b64<2048>(a1_); vf[1][1].h[0] = lds_read_b64<2048>(a2_); vf[1][1].h[1] = lds_read_b64<2048>(a3_); \
        vf[2][0].h[0] = lds_read_b64<4096>(a0_); vf[2][0].h[1] = lds_read_b64<4096>(a1_); vf[2][1].h[0] = lds_read_b64<4096>(a2_); vf[2][1].h[1] = lds_read_b64<4096>(a3_); \
        vf[3][0].h[0] = lds_read_b64<6144>(a0_); vf[3][0].h[1] = lds_read_b64<6144>(a1_); vf[3][1].h[0] = lds_read_b64<6144>(a2_); vf[3][1].h[1] = lds_read_b64<6144>(a3_); }
#define NSA_VWAIT(vf) asm volatile("s_waitcnt lgkmcnt(0)" : "+v"(vf[0][0].v), "+v"(vf[0][1].v), "+v"(vf[1][0].v), "+v"(vf[1][1].v), "+v"(vf[2][0].v), "+v"(vf[2][1].v), "+v"(vf[3][0].v), "+v"(vf[3][1].v) :: "memory")
template <bool MASK, bool IMP, bool PV>
__device__ __forceinline__ void nsa_visit(const u16* Ks, const u16* Vs, const u16* qrow, Sub& s, int lo, int hi, int lane, float* e, float* p3) {
    const int kr = lane & 15, qq = lane >> 4;
    f32x4 S[4];
    const int qsw = ((kr & 3) >> 1) ^ ((kr >> 2) << 1);
    const bf16x8 qf0 = *(const bf16x8*)(qrow + ((qq ^ qsw) << 3)), qf1 = *(const bf16x8*)(qrow + (((4 + qq) ^ qsw) << 3));
    bf16x8 kf[4][2];
    const int swz = kr >> 1;
    {
        const char* kb_ = (const char*)Ks + kr * 128;
        const int ko0 = (qq ^ swz) << 4, ko1 = ko0 ^ 64;
#pragma unroll
        for (int kt = 0; kt < 4; kt++) { kf[kt][0] = *(const bf16x8*)(kb_ + kt * 2048 + ko0); kf[kt][1] = *(const bf16x8*)(kb_ + kt * 2048 + ko1); }
    }
    __builtin_amdgcn_sched_barrier(0);
#pragma unroll
    for (int kt = 0; kt < 4; kt++) {
        S[kt] = __builtin_amdgcn_mfma_f32_16x16x32_bf16(kf[kt][0], qf0, f32x4{0.f, 0.f, 0.f, 0.f}, 0, 0, 0);
        S[kt] = __builtin_amdgcn_mfma_f32_16x16x32_bf16(kf[kt][1], qf1, S[kt], 0, 0, 0);
    }
    float mx = NEG_BIG;
#pragma unroll
    for (int kt = 0; kt < 4; kt++)
#pragma unroll
        for (int r = 0; r < 4; r++) {
            if (MASK) { const int o = kt * 16 + qq * 4 + r; if (o < lo || o > hi) S[kt][r] = -INFINITY; }
            mx = fmaxf(mx, S[kt][r]);
        }
    mx = xq_max(mx);
    const float mnew = fmaxf(s.m, mx);
    const float alpha = __builtin_amdgcn_exp2f(s.m - mnew);
    s.m = mnew;
    float psum = 0.f;
#pragma unroll
    for (int kt = 0; kt < 4; kt++) {
#pragma unroll
        for (int r = 0; r < 4; r++) { S[kt][r] = __builtin_amdgcn_exp2f(S[kt][r] - mnew); }
        const float ee = (S[kt][0] + S[kt][1]) + (S[kt][2] + S[kt][3]);
        psum += ee;
        if (IMP) { e[kt] = ee; p3[kt] = S[kt][3]; }
    }
    s.l = s.l * alpha + psum;
    if (PV) {
        if (!__all(alpha == 1.f)) {
#pragma unroll
            for (int dt = 0; dt < 4; dt++)
#pragma unroll
                for (int r = 0; r < 4; r++) s.O[dt][r] *= alpha;
        }
        VF vf[4][2];
        NSA_LDV_ASM(vf, Vs, kr, qq, swz)
        bf16x8 pb[2];
#pragma unroll
        for (int k2 = 0; k2 < 2; k2++) {
            union { bf16x8 v; unsigned u[4]; } t;
            t.u[0] = pack2(S[2 * k2][0], S[2 * k2][1]); t.u[1] = pack2(S[2 * k2][2], S[2 * k2][3]);
            t.u[2] = pack2(S[2 * k2 + 1][0], S[2 * k2 + 1][1]); t.u[3] = pack2(S[2 * k2 + 1][2], S[2 * k2 + 1][3]);
            pb[k2] = t.v;
        }
        NSA_VWAIT(vf);
        __builtin_amdgcn_sched_barrier(0);
#pragma unroll
        for (int dt = 0; dt < 4; dt++)
#pragma unroll
            for (int k2 = 0; k2 < 2; k2++) s.O[dt] = __builtin_amdgcn_mfma_f32_16x16x32_bf16(vf[dt][k2].v, pb[k2], s.O[dt], 0, 0, 0);
    }
}
template <bool IMP, bool PV>
__device__ __forceinline__ void nsa_visit2(const u16* Ks, const u16* Vs, const u16* qrow0, const u16* qrow1, Sub (&st)[2], const int (&hi)[2], int lane, float (&e)[2][4], float (&p3)[2][4]) {
    const int kr = lane & 15, qq = lane >> 4;
    const int qsw = ((kr & 3) >> 1) ^ ((kr >> 2) << 1);
    bf16x8 qf0[2], qf1[2];
    qf0[0] = *(const bf16x8*)(qrow0 + ((qq ^ qsw) << 3)); qf1[0] = *(const bf16x8*)(qrow0 + (((4 + qq) ^ qsw) << 3));
    qf0[1] = *(const bf16x8*)(qrow1 + ((qq ^ qsw) << 3)); qf1[1] = *(const bf16x8*)(qrow1 + (((4 + qq) ^ qsw) << 3));
    bf16x8 kf[4][2];
    const int swz = kr >> 1;
    {
        const char* kb_ = (const char*)Ks + kr * 128;
        const int ko0 = (qq ^ swz) << 4, ko1 = ko0 ^ 64;
#pragma unroll
        for (int kt = 0; kt < 4; kt++) { kf[kt][0] = *(const bf16x8*)(kb_ + kt * 2048 + ko0); kf[kt][1] = *(const bf16x8*)(kb_ + kt * 2048 + ko1); }
    }
    __builtin_amdgcn_sched_barrier(0);
    f32x4 S[2][4];
#pragma unroll
    for (int kt = 0; kt < 4; kt++)
#pragma unroll
        for (int q = 0; q < 2; q++) {
            S[q][kt] = __builtin_amdgcn_mfma_f32_16x16x32_bf16(kf[kt][0], qf0[q], f32x4{0.f, 0.f, 0.f, 0.f}, 0, 0, 0);
            S[q][kt] = __builtin_amdgcn_mfma_f32_16x16x32_bf16(kf[kt][1], qf1[q], S[q][kt], 0, 0, 0);
        }
    VF vf[4][2];
    bf16x8 pb[2][2];
#pragma unroll
    for (int q = 0; q < 2; q++) {
        Sub& s = st[q];
        float mx = NEG_BIG;
#pragma unroll
        for (int kt = 0; kt < 4; kt++)
#pragma unroll
            for (int r = 0; r < 4; r++) {
                const int o = kt * 16 + qq * 4 + r; if (o > hi[q]) S[q][kt][r] = -INFINITY;
                mx = fmaxf(mx, S[q][kt][r]);
            }
        mx = xq_max(mx);
        const float mnew = fmaxf(s.m, mx);
        const float alpha = __builtin_amdgcn_exp2f(s.m - mnew);
        s.m = mnew;
        float psum = 0.f;
#pragma unroll
        for (int kt = 0; kt < 4; kt++) {
#pragma unroll
            for (int r = 0; r < 4; r++) { S[q][kt][r] = __builtin_amdgcn_exp2f(S[q][kt][r] - mnew); }
            const float ee = (S[q][kt][0] + S[q][kt][1]) + (S[q][kt][2] + S[q][kt][3]);
            psum += ee;
            if (IMP) { e[q][kt] = ee; p3[q][kt] = S[q][kt][3]; }
        }
        s.l = s.l * alpha + psum;
        if (PV) {
#pragma unroll
            for (int dt = 0; dt < 4; dt++)
#pragma unroll
                for (int r = 0; r < 4; r++) s.O[dt][r] *= alpha;
#pragma unroll
            for (int k2 = 0; k2 < 2; k2++) {
                union { bf16x8 v; unsigned u[4]; } t;
                t.u[0] = pack2(S[q][2 * k2][0], S[q][2 * k2][1]); t.u[1] = pack2(S[q][2 * k2][2], S[q][2 * k2][3]);
                t.u[2] = pack2(S[q][2 * k2 + 1][0], S[q][2 * k2 + 1][1]); t.u[3] = pack2(S[q][2 * k2 + 1][2], S[q][2 * k2 + 1][3]);
                pb[q][k2] = t.v;
            }
            if (q == 0) NSA_LDV_ASM(vf, Vs, kr, qq, swz)
        }
    }
    if (PV) {
        NSA_VWAIT(vf);
        __builtin_amdgcn_sched_barrier(0);
#pragma unroll
        for (int dt = 0; dt < 4; dt++)
#pragma unroll
            for (int k2 = 0; k2 < 2; k2++)
#pragma unroll
                for (int q = 0; q < 2; q++) st[q].O[dt] = __builtin_amdgcn_mfma_f32_16x16x32_bf16(vf[dt][k2].v, pb[q][k2], st[q].O[dt], 0, 0, 0);
    }
}
template <int MMODE, bool FIXM, int NQ>
__device__ __forceinline__ void nsa_visit_gn(const u16* Ks, const u16* Vs, const u16* qs, float* Os, float* Ms, float* Ls, const int (&tok)[NQ], const bool (&valid)[NQ], int lane) {
    const int kr = lane & 15, qq = lane >> 4, hh = kr & 3;
    int row[NQ], osw[NQ]; float* orow[NQ];
    f32x4 O[NQ][4]; float m_old[NQ], l_old[NQ]; bf16x8 qf0[NQ], qf1[NQ];
#pragma unroll
    for (int q = 0; q < NQ; q++) {
        row[q] = tok[q] * 4 + hh; orow[q] = Os + row[q] * 64;
        osw[q] = hh ^ ((tok[q] & 3) << 2);
#pragma unroll
        for (int dt = 0; dt < 4; dt++) O[q][dt] = *(const f32x4*)(orow[q] + (((dt * 4 + qq) ^ osw[q]) << 2));
        m_old[q] = Ms[row[q]]; l_old[q] = Ls[row[q]];
        const u16* qrow = qs + row[q] * 64;
        const int qsw = (hh >> 1) ^ ((tok[q] & 3) << 1);
        qf0[q] = *(const bf16x8*)(qrow + ((qq ^ qsw) << 3)); qf1[q] = *(const bf16x8*)(qrow + (((4 + qq) ^ qsw) << 3));
    }
    bf16x8 kf[4][2];
    const int swz = kr >> 1;
    {
        const char* kb_ = (const char*)Ks + kr * 128;
        const int ko0 = (qq ^ swz) << 4, ko1 = ko0 ^ 64;
#pragma unroll
        for (int kt = 0; kt < 4; kt++) { kf[kt][0] = *(const bf16x8*)(kb_ + kt * 2048 + ko0); kf[kt][1] = *(const bf16x8*)(kb_ + kt * 2048 + ko1); }
    }
    __builtin_amdgcn_sched_barrier(0);
    f32x4 S[NQ][4];
#pragma unroll
    for (int kt = 0; kt < 4; kt++)
#pragma unroll
        for (int q = 0; q < NQ; q++) {
            S[q][kt] = __builtin_amdgcn_mfma_f32_16x16x32_bf16(kf[kt][0], qf0[q], f32x4{0.f, 0.f, 0.f, 0.f}, 0, 0, 0);
            S[q][kt] = __builtin_amdgcn_mfma_f32_16x16x32_bf16(kf[kt][1], qf1[q], S[q][kt], 0, 0, 0);
        }
    VF vf[4][2];
#define NSA_LDV NSA_LDV_ASM(vf, Vs, kr, qq, swz)
    if (NQ == 1) NSA_LDV
    bf16x8 pb[NQ][2];
#pragma unroll
    for (int q = 0; q < NQ; q++) {
        float mx = NEG_BIG;
#pragma unroll
        for (int kt = 0; kt < 4; kt++)
#pragma unroll
            for (int r = 0; r < 4; r++) {
                if (MMODE == 1) { const int o = kt * 16 + qq * 4 + r; if (o > tok[q]) S[q][kt][r] = -INFINITY; }
                if (MMODE == 2) { const int o = kt * 16 + qq * 4 + r; if (o <= tok[q]) S[q][kt][r] = -INFINITY; }
                if (FIXM) { if (!valid[q]) S[q][kt][r] = -INFINITY; } else mx = fmaxf(mx, S[q][kt][r]);
            }
        float mnew = m_old[q], alpha = 1.f;
        if (!FIXM) {
            if (!valid[q]) mx = NEG_BIG;
            mx = xq_max(mx);
            mnew = fmaxf(m_old[q], mx);
            alpha = __builtin_amdgcn_exp2f(m_old[q] - mnew);
        }
        float psum = 0.f;
#pragma unroll
        for (int kt = 0; kt < 4; kt++) {
#pragma unroll
            for (int r = 0; r < 4; r++) { S[q][kt][r] = __builtin_amdgcn_exp2f(S[q][kt][r] - mnew); }
            psum += (S[q][kt][0] + S[q][kt][1]) + (S[q][kt][2] + S[q][kt][3]);
        }
        psum = xq_sum(psum);
        if (FIXM) { if (valid[q] && qq == 0) Ls[row[q]] = l_old[q] + psum; }
        else {
            if (valid[q] && qq == 0) { Ms[row[q]] = mnew; Ls[row[q]] = l_old[q] * alpha + psum; }
#pragma unroll
            for (int dt = 0; dt < 4; dt++)
#pragma unroll
                for (int r = 0; r < 4; r++) O[q][dt][r] *= alpha;
        }
#pragma unroll
        for (int k2 = 0; k2 < 2; k2++) {
            union { bf16x8 v; unsigned u[4]; } t;
            t.u[0] = pack2(S[q][2 * k2][0], S[q][2 * k2][1]); t.u[1] = pack2(S[q][2 * k2][2], S[q][2 * k2][3]);
            t.u[2] = pack2(S[q][2 * k2 + 1][0], S[q][2 * k2 + 1][1]); t.u[3] = pack2(S[q][2 * k2 + 1][2], S[q][2 * k2 + 1][3]);
            pb[q][k2] = t.v;
        }
        if (NQ == 2 && q == 0) { asm volatile("" ::: "memory"); NSA_LDV }
    }
#undef NSA_LDV
    NSA_VWAIT(vf);
    __builtin_amdgcn_sched_barrier(0);
#pragma unroll
    for (int dt = 0; dt < 4; dt++)
#pragma unroll
        for (int k2 = 0; k2 < 2; k2++)
#pragma unroll
            for (int q = 0; q < NQ; q++) O[q][dt] = __builtin_amdgcn_mfma_f32_16x16x32_bf16(vf[dt][k2].v, pb[q][k2], O[q][dt], 0, 0, 0);
#pragma unroll
    for (int q = 0; q < NQ; q++)
        if (valid[q]) {
#pragma unroll
            for (int dt = 0; dt < 4; dt++) *(f32x4*)(orow[q] + (((dt * 4 + qq) ^ osw[q]) << 2)) = O[q][dt];
        }
}
template <int MMODE, bool FIXM>
__device__ __forceinline__ void nsa_visit_g(const u16* Ks, const u16* Vs, const u16* qs, float* Os, float* Ms, float* Ls, int tok, bool valid, int lane) {
    const int tk[1] = {tok}; const bool vl[1] = {valid};
    nsa_visit_gn<MMODE, FIXM, 1>(Ks, Vs, qs, Os, Ms, Ls, tk, vl, lane);
}
__device__ __forceinline__ void nsa_fold_lds(float* Os, float* Ms, float* Ls, int row, int qq, int hh, f32x4 (&T)[4], float gate, bool reset) {
    const float lt = Ls[row];
    const float sc = (lt > 0.f) ? gate / lt : 0.f;
#pragma unroll
    for (int dt = 0; dt < 4; dt++) {
        float* op = Os + row * 64 + (((dt * 4 + qq) ^ hh ^ (((row >> 2) & 3) << 2)) << 2);
        const f32x4 o = *(const f32x4*)op;
#pragma unroll
        for (int r = 0; r < 4; r++) T[dt][r] += o[r] * sc;
        if (reset) *(f32x4*)op = f32x4{0.f, 0.f, 0.f, 0.f};
    }
    asm volatile("s_waitcnt lgkmcnt(0)" ::: "memory");
    if (reset && qq == 0) { Ms[row] = NEG_BIG; Ls[row] = 0.f; }
}
template <int MODE>
__device__ __forceinline__ void nsa_fold(Sub& s, f32x4 (&T)[4], float gate) {
    const float lt = xq_sum(s.l);
    const float sc = (lt > 0.f) ? gate / lt : 0.f;
#pragma unroll
    for (int dt = 0; dt < 4; dt++)
#pragma unroll
        for (int r = 0; r < 4; r++) {
            const float v = s.O[dt][r] * sc;
            T[dt][r] = (MODE == 1) ? T[dt][r] + v : v;
            s.O[dt][r] = 0.f;
        }
    s.m = NEG_BIG; s.l = 0.f;
}

constexpr int NSA_R = 3;
template <bool HASV, class KSrc, class VSrc, class Body>
__device__ __forceinline__ void nsa_stream(char* ring, int n, KSrc ksrc, VSrc vsrc, Body body) {
    const int t = get_tid();
    const int so = (t >> 3) * 64 + (((t & 7) ^ ((t >> 4) & 7)) << 3);
    char* dl = ring + t * 16;
#define NSA_ISSUE(i, slot) { glds16(ksrc(i) + so, dl + (slot) * 16384); if (HASV) glds16(vsrc(i) + so, dl + (slot) * 16384 + 8192); }
    asm volatile("s_waitcnt lgkmcnt(0)" ::: "memory");
    __builtin_amdgcn_s_barrier();
    if (n > 0) NSA_ISSUE(0, 0)
    if (n > 1) NSA_ISSUE(1, 1)
    int slot = 0;
    for (int i = 0; i < n; i++) {
        if (i + 1 < n) { if (HASV) asm volatile("s_waitcnt vmcnt(2)" ::: "memory"); else asm volatile("s_waitcnt vmcnt(1)" ::: "memory"); }
        else asm volatile("s_waitcnt vmcnt(0)" ::: "memory");
        asm volatile("s_waitcnt lgkmcnt(0)" ::: "memory");
        __builtin_amdgcn_s_barrier();
        asm volatile("" ::: "memory");
        const int sl2 = (slot == 0) ? 2 : slot - 1;
        if (i + 2 < n) NSA_ISSUE(i + 2, sl2)
        body(i, (const u16*)(ring + slot * 16384), (const u16*)(ring + slot * 16384 + 8192));
        slot = (slot == 2) ? 0 : slot + 1;
    }
#undef NSA_ISSUE
}
#define NSA_TOK(u) const int t3_ = get_tid(); const size_t ntk_ = (size_t)b * S_ + t0 + 8 * (t3_ >> 6) + 4 * (u) + ((t3_ & 15) >> 2); const int hd_ = g * 4 + (t3_ & 3);
__device__ void ph_nsa(const P& p, int bid, int nb, char* smem) {
    char* ring = smem;
    unsigned* selm = (unsigned*)(smem + NSA_R * 16384);
    int* blist = (int*)(selm + 256);
    int* nlistp = blist + 128;
    int* lcnt = nlistp + 4;
    unsigned char* lists = (unsigned char*)(lcnt + 128);
    float* Ms = (float*)(lists + 128 * 64);
    float* Ls = Ms + 256;
    float* Os = Ls + 256;
    float* impl = Os;
    u16* qs = (u16*)(Os + 64 * 4 * 64);
    unsigned long long ts_ = 0, tacc_ = 0;
    const int nitems = B_ * 2 * 128;
    for (int rr = 0;; rr++) {
        int it = bid;
        if (rr > 0) {
            __syncthreads();
            if (get_tid() == 0) nlistp[3] = nb + atomicAdd(p.nsactr, 1);
            __syncthreads();
            it = nlistp[3];
        }
        if (it >= nitems) break;
        const int tid = get_tid(), lane = tid & 63, wv = tid >> 6;
        const int kr = lane & 15, qq = lane >> 4, ts = kr >> 2, hh = kr & 3;
        float* myimp = impl + wv * (32 * 2 * 16);
        const int tt = 127 - (it >> 3);
        const int bg = it & 7, b = bg >> 1, g = bg & 1;
        const int t0 = tt * 64, cur = tt;
        const int head = g * 4 + hh;
        Sub st[2];
        f32x4 T[2][4];
        int tl[2]; size_t ntok[2];
        __syncthreads();
#pragma unroll
        for (int u = 0; u < 2; u++) {
            tl[u] = 8 * wv + 4 * u + ts;
            ntok[u] = (size_t)b * S_ + t0 + tl[u];
#pragma unroll
            for (int ks = 0; ks < 2; ks++) *(bf16x8*)&qs[(tl[u] * 4 + hh) * 64 + (((ks * 4 + qq) ^ (hh >> 1) ^ ((tl[u] & 3) << 1)) << 3)] = *(const bf16x8*)&p.q[ntok[u] * 512 + head * 64 + ks * 32 + qq * 8];
#pragma unroll
            for (int dt = 0; dt < 4; dt++) st[u].O[dt] = f32x4{0.f, 0.f, 0.f, 0.f};
            st[u].m = NEG_BIG; st[u].l = 0.f;
        }
        const u16* kcb = p.kcb + (size_t)bg * 512 * 64;
        const u16* vcT = p.vcT + (size_t)bg * 8 * 4096;
        int nv[2];
#pragma unroll
        for (int u = 0; u < 2; u++) { const int t = t0 + tl[u]; nv[u] = (t >= 31) ? min((t - 31) / 16 + 1, NCMP) : 0; }
        const int tmax = t0 + 63;
        const int nvmax = (tmax >= 31) ? min((tmax - 31) / 16 + 1, NCMP) : 0;
        const int nvb = (nvmax + 63) >> 6;
        NSA_TS(1)
        __syncthreads();
        nsa_stream<false>(ring, nvb, [&](int kb) { return kcb + (size_t)kb * 4096; }, [&](int kb) { return vcT + (size_t)kb * 4096; },
            [&](int kb, const u16* Ks, const u16* Vs) {
                const int hi2[2] = {nv[0] - kb * 64 - 1, nv[1] - kb * 64 - 1};
                float e_[2][4], p3_[2][4];
                nsa_visit2<false, false>(Ks, Vs, qs + (tl[0] * 4 + hh) * 64, qs + (tl[1] * 4 + hh) * 64, st, hi2, lane, e_, p3_);
            });
        float invl[2];
#pragma unroll
        for (int u = 0; u < 2; u++) { const float lt = xq_sum(st[u].l); invl[u] = (lt > 0.f) ? 1.f / lt : 0.f; st[u].l = 0.f; }
        float carry[2] = {0.f, 0.f};
        nsa_stream<true>(ring, nvb, [&](int kb) { return kcb + (size_t)kb * 4096; }, [&](int kb) { return vcT + (size_t)kb * 4096; },
            [&](int kb, const u16* Ks, const u16* Vs) {
            const int hi2[2] = {nv[0] - kb * 64 - 1, nv[1] - kb * 64 - 1};
            float e_[2][4], p3_[2][4];
            nsa_visit2<true, true>(Ks, Vs, qs + (tl[0] * 4 + hh) * 64, qs + (tl[1] * 4 + hh) * 64, st, hi2, lane, e_, p3_);
#pragma unroll
            for (int u = 0; u < 2; u++) {
#pragma unroll
                for (int kt = 0; kt < 4; kt++) {
                    float ev = e_[u][kt] * invl[u], pv = p3_[u][kt] * invl[u];
                    ev += dppf<0xB1>(ev); ev += dppf<0x4E>(ev);
                    pv += dppf<0xB1>(pv); pv += dppf<0x4E>(pv);
                    const float sh = __int_as_float(__builtin_amdgcn_ds_bpermute(((lane - 16) & 63) << 2, __float_as_int(pv)));
                    const float nbv = (qq == 0) ? carry[u] : sh;
                    carry[u] = sh;
                    myimp[((kb * 4 + kt) * 2 + u) * 16 + ts * 4 + qq] = ev + nbv;
                }
            }
            });
        NSA_TE(1)
        NSA_TS(2)
#pragma unroll
        for (int u = 0; u < 2; u++) {
            float mv[8];
#pragma unroll
            for (int i = 0; i < 8; i++) {
                const int kk = 8 * hh + i, j = 4 * kk + qq;
                const float v = myimp[(kk * 2 + u) * 16 + ts * 4 + qq];
                mv[i] = (j >= 1 && j <= cur - 2) ? v : -1.f;
            }
            unsigned sel = 0u;
            const int ncand = max(0, cur - 2);
            const int nforced = (cur >= 2) ? 3 : (cur + 1);
            const int need = 16 - nforced;
            if (ncand <= need) {
#pragma unroll
                for (int i = 0; i < 8; i++) if (mv[i] >= 0.f) sel |= (1u << i);
            } else {
                for (int rnd = 0; rnd < need; rnd++) {
                    const float b01 = fmaxf(mv[0], mv[1]), b23 = fmaxf(mv[2], mv[3]), b45 = fmaxf(mv[4], mv[5]), b67 = fmaxf(mv[6], mv[7]);
                    float best = fmaxf(fmaxf(b01, b23), fmaxf(b45, b67));
                    int bi = 7;
#pragma unroll
                    for (int i = 6; i >= 0; i--) bi = (mv[i] == best) ? i : bi;
                    int bj = (best >= 0.f) ? (4 * (8 * hh + bi) + qq) : 9999;
#define TK_MERGE(ov, oj) { const float v2_ = (ov); const int j2_ = (oj); const bool tk_ = (v2_ > best) || (v2_ == best && j2_ < bj); best = tk_ ? v2_ : best; bj = tk_ ? j2_ : bj; }
                    TK_MERGE(dppf<0xB1>(best), __builtin_amdgcn_update_dpp(0, bj, 0xB1, 0xF, 0xF, true))
                    TK_MERGE(dppf<0x4E>(best), __builtin_amdgcn_update_dpp(0, bj, 0x4E, 0xF, 0xF, true))
                    {
                        auto rv = __builtin_amdgcn_permlane16_swap(__float_as_uint(best), __float_as_uint(best), false, false);
                        auto rj = __builtin_amdgcn_permlane16_swap((unsigned)bj, (unsigned)bj, false, false);
                        float v0 = __uint_as_float(rv[0]), v1 = __uint_as_float(rv[1]); int j0 = (int)rj[0], j1 = (int)rj[1];
                        if (v1 > v0 || (v1 == v0 && j1 < j0)) { v0 = v1; j0 = j1; }
                        rv = __builtin_amdgcn_permlane32_swap(__float_as_uint(v0), __float_as_uint(v0), false, false);
                        rj = __builtin_amdgcn_permlane32_swap((unsigned)j0, (unsigned)j0, false, false);
                        best = __uint_as_float(rv[0]); bj = (int)rj[0];
                        const float v2 = __uint_as_float(rv[1]); const int j2 = (int)rj[1];
                        if (v2 > best || (v2 == best && j2 < bj)) { best = v2; bj = j2; }
                    }
#undef TK_MERGE
                    const bool mine = (bj < 512) && ((bj >> 5) == hh) && ((bj & 3) == qq);
                    const int li = (bj >> 2) & 7;
#pragma unroll
                    for (int i = 0; i < 8; i++) mv[i] = (mine && li == i) ? -1.f : mv[i];
                    if (mine) sel |= (1u << li);
                }
            }
            if (qq == 0 && hh == 0) sel |= 1u;
            if ((cur & 3) == qq && (cur >> 5) == hh) sel |= (1u << ((cur >> 2) & 7));
            if (cur >= 1 && ((cur - 1) & 3) == qq && ((cur - 1) >> 5) == hh) sel |= (1u << (((cur - 1) >> 2) & 7));
            unsigned w = sel << (8 * hh);
            w |= (unsigned)__builtin_amdgcn_update_dpp(0, (int)w, 0xB1, 0xF, 0xF, true);
            w |= (unsigned)__builtin_amdgcn_update_dpp(0, (int)w, 0x4E, 0xF, 0xF, true);
            if (hh == 0) selm[tl[u] * 4 + qq] = w;
        }
        NSA_TE(2)
        NSA_TS(3)
        __syncthreads();
#pragma unroll
        for (int u = 0; u < 2; u++) { NSA_TOK(u) nsa_fold<0>(st[u], T[u], p.nsag[ntk_ * 24 + hd_ * 3 + 0]); }
        {
            const int t2 = get_tid();
#pragma unroll
            for (int i = 0; i < 8; i++) *(f32x4*)&Os[(i * NT + t2) * 4] = f32x4{0.f, 0.f, 0.f, 0.f};
            if (t2 < 256) { Ms[t2] = NEG_BIG; Ls[t2] = 0.f; }
            unsigned long long tm = 0ull; int lrank = 0;
            if (t2 < 128) {
                const int j = t2;
                for (int tk = 0; tk < 64; tk++) tm |= (unsigned long long)((selm[tk * 4 + (j & 3)] >> (j >> 2)) & 1u) << tk;
                if (j > cur) tm = 0ull;
                const unsigned long long bal = __ballot(tm != 0ull);
                lrank = __popcll(bal & ((1ull << (t2 & 63)) - 1ull));
                if ((t2 & 63) == 0) nlistp[t2 >> 6] = __popcll(bal);
            }
            __syncthreads();
            if (t2 < 128 && tm != 0ull) {
                const int pos = lrank + ((t2 >= 64) ? nlistp[0] : 0);
                blist[pos] = t2; lcnt[pos] = __popcll(tm);
                int c = 0;
                while (tm) { lists[pos * 64 + c] = (unsigned char)(__ffsll((long long)tm) - 1); c++; tm &= tm - 1ull; }
            }
            __syncthreads();
        }
        const int nlist = nlistp[0] + nlistp[1];
        NSA_TE(3)
        NSA_TS(4)
        const u16* ksl = p.ksl + (size_t)bg * S_ * 64;
        const u16* vslT = p.vslT + (size_t)bg * 128 * 4096;
        {
            const int t4 = get_tid(), wv4 = __builtin_amdgcn_readfirstlane(t4 >> 6), ts4 = (t4 & 15) >> 2;
            const int td = t4 & 255;
            const int so = (td >> 3) * 64 + (((td & 7) ^ ((td >> 4) & 7)) << 3);
            char* dl = ring + td * 16;
#define NSA_RI(i) (nlist - 1 - (i))
#define NSA_ISSUE2(i, slot) if (wv4 >= 4) { const int jj_ = blist[NSA_RI(i)]; const u16* kp_ = ksl + (size_t)jj_ * 4096 + so; const u16* vp_ = vslT + (size_t)jj_ * 4096 + so; char* d_ = dl + (slot) * 16384; \
                glds16(kp_, d_); glds16(kp_ + 2048, d_ + 4096); glds16(vp_, d_ + 8192); glds16(vp_ + 2048, d_ + 12288); }
            asm volatile("s_waitcnt lgkmcnt(0)" ::: "memory");
            __builtin_amdgcn_s_barrier();
            if (nlist > 0) NSA_ISSUE2(0, 0)
            if (nlist > 1) NSA_ISSUE2(1, 1)
            int jn = 0, nn = 0, tokn = 0;
            if (nlist > 0) { jn = blist[NSA_RI(0)]; nn = lcnt[NSA_RI(0)]; tokn = lists[NSA_RI(0) * 64 + wv4 * 4 + ts4]; }
            int slot = 0;
            for (int i = 0; i < nlist; i++) {
                if (i + 1 < nlist) asm volatile("s_waitcnt vmcnt(4)" ::: "memory"); else asm volatile("s_waitcnt vmcnt(0)" ::: "memory");
                asm volatile("s_waitcnt lgkmcnt(0)" ::: "memory");
                __builtin_amdgcn_s_barrier();
                asm volatile("" ::: "memory");
                const int sl2 = (slot == 0) ? 2 : slot - 1;
                if (i + 2 < nlist) NSA_ISSUE2(i + 2, sl2)
                const int j = jn, n = nn, tok0 = tokn;
                if (i + 1 < nlist) { jn = blist[NSA_RI(i + 1)]; nn = lcnt[NSA_RI(i + 1)]; tokn = lists[NSA_RI(i + 1) * 64 + wv4 * 4 + ts4]; }
                const u16* Ks = (const u16*)(ring + slot * 16384); const u16* Vs = Ks + 4096;
                if ((wv4 + NW) * 4 < n) {
                    const int e1 = (wv4 + NW) * 4 + ts4;
                    const bool vl2[2] = {true, e1 < n};
                    const int tk2[2] = {tok0, vl2[1] ? (int)lists[NSA_RI(i) * 64 + (e1 & 63)] : 0};
                    if (j == cur) nsa_visit_gn<1, false, 2>(Ks, Vs, qs, Os, Ms, Ls, tk2, vl2, t4 & 63);
                    else nsa_visit_gn<0, true, 2>(Ks, Vs, qs, Os, Ms, Ls, tk2, vl2, t4 & 63);
                } else if (wv4 * 4 < n) {
                    const int e = wv4 * 4 + ts4;
                    const bool valid = e < n;
                    const int tok = valid ? tok0 : 0;
                    if (j == cur) nsa_visit_g<1, false>(Ks, Vs, qs, Os, Ms, Ls, tok, valid, t4 & 63);
                    else nsa_visit_g<0, true>(Ks, Vs, qs, Os, Ms, Ls, tok, valid, t4 & 63);
                }
                slot = (slot == 2) ? 0 : slot + 1;
            }
#undef NSA_RI
#undef NSA_ISSUE2
        }
        __syncthreads();
        NSA_TE(4)
        NSA_TS(5)
#pragma unroll
        for (int u = 0; u < 2; u++) {
            NSA_TOK(u)
            const int t5 = t3_ & 63;
            nsa_fold_lds(Os, Ms, Ls, (8 * (t3_ >> 6) + 4 * u + ((t5 & 15) >> 2)) * 4 + (t5 & 3), t5 >> 4, t5 & 3, T[u], p.nsag[ntk_ * 24 + hd_ * 3 + 1], true);
        }
        const u16* kwn = p.kwn + (size_t)bg * S_ * 64;
        const u16* vwnT = p.vwnT + (size_t)bg * 128 * 4096;
        uint2 Tp[2][4];
#pragma unroll
        for (int u = 0; u < 2; u++)
#pragma unroll
            for (int dt = 0; dt < 4; dt++) { Tp[u][dt] = pack4(T[u][dt]); asm volatile("" : "+v"(Tp[u][dt].x), "+v"(Tp[u][dt].y)); }
        {
            const int jlo = max(0, cur - 8);
            nsa_stream<true>(ring, cur - jlo + 1, [&](int i) { return kwn + (size_t)(cur - i) * 4096; }, [&](int i) { return vwnT + (size_t)(cur - i) * 4096; },
                [&](int i, const u16* Ks, const u16* Vs) {
                    const int j = cur - i;
                    const int t4 = get_tid();
                    const int tb_ = 8 * (t4 >> 6) + ((t4 & 15) >> 2);
                    const int tk2[2] = {tb_, tb_ + 4}; const bool vl2[2] = {true, true};
                    if (j == cur) nsa_visit_gn<1, false, 2>(Ks, Vs, qs, Os, Ms, Ls, tk2, vl2, t4 & 63);
                    else if (j == cur - 8) nsa_visit_gn<2, true, 2>(Ks, Vs, qs, Os, Ms, Ls, tk2, vl2, t4 & 63);
                    else nsa_visit_gn<0, true, 2>(Ks, Vs, qs, Os, Ms, Ls, tk2, vl2, t4 & 63);
                });
        }
#pragma unroll
        for (int u = 0; u < 2; u++) {
            NSA_TOK(u)
#pragma unroll
            for (int dt = 0; dt < 4; dt++) T[u][dt] = unpack4(Tp[u][dt]);
            { const int t5 = t3_ & 63; nsa_fold_lds(Os, Ms, Ls, (8 * (t3_ >> 6) + 4 * u + ((t5 & 15) >> 2)) * 4 + (t5 & 3), t5 >> 4, t5 & 3, T[u], p.nsag[ntk_ * 24 + hd_ * 3 + 2], false); }
#pragma unroll
            for (int dt = 0; dt < 4; dt++) *(uint2*)&p.oa[ntk_ * 512 + hd_ * 64 + dt * 16 + ((t3_ & 63) >> 4) * 4] = pack4(T[u][dt]);
        }
        NSA_TE(5)
    }
    if (NSAPROBE) { __syncthreads(); const unsigned long long t1_ = __builtin_amdgcn_s_memrealtime(); while (__builtin_amdgcn_s_memrealtime() - t1_ < tacc_) __builtin_amdgcn_s_sleep(8); }
}

#ifndef CHPROBE
#define CHPROBE 0
#endif
#define CH_TS(k) if (CHPROBE == k) cts_ = __builtin_amdgcn_s_memrealtime();
#define CH_TE(k) if (CHPROBE == k) ctacc_ += __builtin_amdgcn_s_memrealtime() - cts_;
constexpr int RS = 72;
constexpr int RSLOT = 64 * RS;
__device__ __forceinline__ void mm64(const u16* A, int lda, const u16* Bz, int ldb, f32x4 (&acc)[2], int lane, int wv) {
    const int mt = wv >> 1, nt0 = (wv & 1) * 2, kr = lane & 15, qq = lane >> 4;
    bf16x8 a[2], b[2][2];
#pragma unroll
    for (int ks = 0; ks < 2; ks++) {
        a[ks] = *(const bf16x8*)&A[(mt * 16 + kr) * lda + ks * 32 + qq * 8];
#pragma unroll
        for (int i = 0; i < 2; i++) b[ks][i] = *(const bf16x8*)&Bz[((nt0 + i) * 16 + kr) * ldb + ks * 32 + qq * 8];
    }
#pragma unroll
    for (int ks = 0; ks < 2; ks++)
#pragma unroll
        for (int i = 0; i < 2; i++) acc[i] = __builtin_amdgcn_mfma_f32_16x16x32_bf16(a[ks], b[ks][i], acc[i], 0, 0, 0);
}
__device__ __forceinline__ void st_t(u16* dst, int ld, const f32x4& v, int mt, int nt, int lane) {
    uint2 o; o.x = pack2(v[0], v[1]); o.y = pack2(v[2], v[3]);
    *(uint2*)&dst[(nt * 16 + (lane & 15)) * ld + mt * 16 + (lane >> 4) * 4] = o;
}
__device__ __forceinline__ void st_n(u16* dst, int ld, const f32x4& v, int mt, int nt, int lane) {
#pragma unroll
    for (int r = 0; r < 4; r++) dst[(mt * 16 + (lane >> 4) * 4 + r) * ld + nt * 16 + (lane & 15)] = f2bf(v[r]);
}
#define ZACC(a) { a[0] = f32x4{0.f, 0.f, 0.f, 0.f}; a[1] = f32x4{0.f, 0.f, 0.f, 0.f}; }

__device__ void ph_rwkv_chunk(const P& p, int bid, int nb, char* smem) {
    unsigned long long cts_ = 0, ctacc_ = 0;
    u16* sl = (u16*)smem;
    float* tot = (float*)(sl + 14 * RSLOT);
    float* gl = tot + 512;
#define RW_IDX const int tid = get_tid(), lane = tid & 63, wv = tid >> 6, mt = wv >> 1, nt0 = (wv & 1) * 2, kr = lane & 15, qq = lane >> 4; (void)mt; (void)nt0; (void)kr; (void)qq; (void)lane;
    const int nitems = B_ * 128;
    for (int it0 = bid; it0 < nitems; it0 += nb) {
      const int c = it0 & 127, b = it0 >> 7;
      const size_t n0 = (size_t)b * S_ + c * 64;
      __syncthreads();
      {
          RW_IDX
          const int t = tid >> 3, part = tid & 7;
          const size_t n = n0 + t;
          const bool hasprev = (c * 64 + t) > 0;
          u16* dst = p.xact + n * 256 + part * 32;
#pragma unroll
          for (int j = 0; j < 4; j++) {
              const int col = 1536 + part * 32 + j * 8;
              const uint4 cu = *(const uint4*)&p.prw[n * CRW + col];
              uint4 pv = make_uint4(0u, 0u, 0u, 0u);
              if (hasprev) pv = *(const uint4*)&p.prw[(n - 1) * CRW + col];
              const unsigned cw[4] = {cu.x, cu.y, cu.z, cu.w}, pw[4] = {pv.x, pv.y, pv.z, pv.w};
              unsigned ow[4];
#pragma unroll
              for (int e2 = 0; e2 < 4; e2++) {
                  float x0 = __uint_as_float(cw[e2] << 16), x1 = __uint_as_float(cw[e2] & 0xFFFF0000u);
                  const float q0 = __uint_as_float(pw[e2] << 16), q1 = __uint_as_float(pw[e2] & 0xFFFF0000u);
                  x0 = x0 + (q0 - x0) * p.mu[col + 2 * e2]; x1 = x1 + (q1 - x1) * p.mu[col + 2 * e2 + 1];
                  if (part < 2) { x0 = tanhf(x0); x1 = tanhf(x1); }
                  else if (part >= 4) { x0 = sigmoidf_(x0); x1 = sigmoidf_(x1); }
                  ow[e2] = pack2(x0, x1);
              }
              *(uint4*)&dst[j * 8] = make_uint4(ow[0], ow[1], ow[2], ow[3]);
          }
      }
      __syncthreads();
      const u16* xa = p.xact + n0 * 256;
      bf16x8 xa_[8], wb[2][2], ab[2][2], gb[2][4];
      u16 rc[8][3], rp[8][3];
      float w0c[2], a0c[2], hc_[6];
#define S1_LOADW(hh_) { RW_IDX \
          _Pragma("unroll") for (int i = 0; i < 2; i++) { const int cc = (nt0 + i) * 16 + kr; w0c[i] = p.w0[(hh_) * 64 + cc]; a0c[i] = p.a0[(hh_) * 64 + cc]; \
              _Pragma("unroll") for (int ks = 0; ks < 2; ks++) { wb[i][ks] = *(const bf16x8*)&p.w2T[((size_t)(hh_) * 64 + cc) * 64 + ks * 32 + qq * 8]; \
                                                                 ab[i][ks] = *(const bf16x8*)&p.a2T[((size_t)(hh_) * 64 + cc) * 64 + ks * 32 + qq * 8]; } \
              _Pragma("unroll") for (int ks = 0; ks < 4; ks++) gb[i][ks] = *(const bf16x8*)&p.g2T[((size_t)(hh_) * 64 + cc) * 128 + ks * 32 + qq * 8]; } }
#define S2_LOADX(hh_) { RW_IDX const int ch_ = (hh_) * 64 + lane; \
          hc_[0] = p.mu[ch_]; hc_[1] = p.mu[512 + ch_]; hc_[2] = p.mu[1024 + ch_]; hc_[3] = p.k_k[ch_]; hc_[4] = p.k_a[ch_]; hc_[5] = p.r_k[ch_]; \
          _Pragma("unroll") for (int i = 0; i < 8; i++) { const int t = wv * 8 + i; const u16* cr = p.prw + (n0 + t) * CRW; \
              rc[i][0] = cr[ch_]; rc[i][1] = cr[512 + ch_]; rc[i][2] = cr[1024 + ch_]; \
              rp[i][0] = 0; rp[i][1] = 0; rp[i][2] = 0; \
              if (c * 64 + t > 0) { const u16* pp = cr - CRW; rp[i][0] = pp[ch_]; rp[i][1] = pp[512 + ch_]; rp[i][2] = pp[1024 + ch_]; } } }
      {
          RW_IDX
#pragma unroll
          for (int k8 = 0; k8 < 8; k8++) xa_[k8] = *(const bf16x8*)&xa[(mt * 16 + kr) * 256 + k8 * 32 + qq * 8];
      }
      S1_LOADW(0)
      S2_LOADX(0)
#pragma unroll 1
      for (int h = 0; h < 8; h++) {
        u16* cd = p.cdat + ((size_t)((b * 8 + h) * 128 + c)) * 4 * 4096;
        LDS_BARRIER();
        CH_TS(1)
        float* LW = (float*)(sl + 8 * RSLOT); float* LA = (float*)(sl + 10 * RSLOT);
        {
            RW_IDX
            f32x4 aw[2], aa2[2], ag[2];
#pragma unroll
            for (int i = 0; i < 2; i++) {
                aw[i] = f32x4{0.f, 0.f, 0.f, 0.f}; aa2[i] = aw[i]; ag[i] = aw[i];
#pragma unroll
                for (int ks = 0; ks < 2; ks++) {
                    aw[i] = __builtin_amdgcn_mfma_f32_16x16x32_bf16(xa_[ks], wb[i][ks], aw[i], 0, 0, 0);
                    aa2[i] = __builtin_amdgcn_mfma_f32_16x16x32_bf16(xa_[2 + ks], ab[i][ks], aa2[i], 0, 0, 0);
                }
#pragma unroll
                for (int ks = 0; ks < 4; ks++) ag[i] = __builtin_amdgcn_mfma_f32_16x16x32_bf16(xa_[4 + ks], gb[i][ks], ag[i], 0, 0, 0);
            }
#pragma unroll
            for (int i = 0; i < 2; i++)
#pragma unroll
                for (int r = 0; r < 4; r++) {
                    const int t = mt * 16 + qq * 4 + r, cc = (nt0 + i) * 16 + kr;
                    const float wl = w0c[i] + aw[i][r];
                    const float z = -wl;
                    const float sp = fmaxf(z, 0.f) + __logf(1.f + __expf(-fabsf(z)));
                    LW[t * 64 + cc] = -__expf(-sp - 0.5f);
                    LA[t * 64 + cc] = sigmoidf_(a0c[i] + aa2[i][r]);
                    p.ob[(n0 + t) * 512 + h * 64 + cc] = f2bf(ag[i][r]);
                }
        }
        LDS_BARRIER();
        CH_TE(1) CH_TS(2)
        {
            RW_IDX
            const int ch = h * 64 + lane;
            const float mur = hc_[0], muk = hc_[1], muv = hc_[2];
            const float kkw = hc_[3], kaw = hc_[4], rkw = hc_[5];
            float rr[8], k2[8], vv[8], kkn[8], aa[8], lg[8], cs[8];
            float run = 0.f;
#pragma unroll
            for (int i = 0; i < 8; i++) {
                const int t = wv * 8 + i; const size_t n = n0 + t;
                float r = bf2f(rc[i][0]), k = bf2f(rc[i][1]), v = bf2f(rc[i][2]);
                const float pr = bf2f(rp[i][0]), pk = bf2f(rp[i][1]), pv = bf2f(rp[i][2]);
                r = r + (pr - r) * mur; k = k + (pk - k) * muk; v = v + (pv - v) * muv;
                const float a = LA[t * 64 + lane];
                lg[i] = LW[t * 64 + lane];
                float kk = k * kkw;
                kkn[i] = kk * __builtin_amdgcn_rsqf(fmaxf(wave_sum(kk * kk), 1e-24f));
                k2[i] = k * (1.f + (a - 1.f) * kaw);
                const float bon = wave_sum(r * k2[i] * rkw);
                if (lane == 0) p.bon[n * 8 + h] = bon;
                rr[i] = r; vv[i] = v; aa[i] = a;
                run += lg[i]; cs[i] = run;
            }
            tot[wv * 64 + lane] = run;
            LDS_BARRIER();
            float off = 0.f, cumL = 0.f;
#pragma unroll
            for (int w2 = 0; w2 < 8; w2++) { const float tv = tot[w2 * 64 + lane]; cumL += tv; if (w2 < wv) off += tv; }
            if (wv == 0) gl[lane] = __expf(cumL);
            unsigned pa[4], pb[4], pk4[4], pv4[4];
#pragma unroll
            for (int i = 0; i < 8; i += 2) {
                float at[2], bt[2], kt[2], rt[2];
#pragma unroll
                for (int e2 = 0; e2 < 2; e2++) {
                    const int ii = i + e2; const int t = wv * 8 + ii;
                    const float cm = off + cs[ii];
                    const float g = __expf(cm), gp = __expf(cm - lg[ii]), gi = __expf(-cm);
                    at[e2] = -kkn[ii] * gp; bt[e2] = kkn[ii] * aa[ii] * gi; kt[e2] = k2[ii] * gi; rt[e2] = rr[ii] * g;
                    sl[0 * RSLOT + t * RS + lane] = f2bf(at[e2]);
                    sl[1 * RSLOT + t * RS + lane] = f2bf(bt[e2]);
                    sl[2 * RSLOT + t * RS + lane] = f2bf(kt[e2]);
                    sl[3 * RSLOT + t * RS + lane] = f2bf(rt[e2]);
                }
                pa[i >> 1] = pack2(at[0], at[1]); pb[i >> 1] = pack2(bt[0], bt[1]);
                pk4[i >> 1] = pack2(kt[0], kt[1]); pv4[i >> 1] = pack2(vv[i], vv[i + 1]);
            }
            *(uint4*)&sl[4 * RSLOT + lane * RS + wv * 8] = make_uint4(pa[0], pa[1], pa[2], pa[3]);
            *(uint4*)&sl[5 * RSLOT + lane * RS + wv * 8] = make_uint4(pb[0], pb[1], pb[2], pb[3]);
            *(uint4*)&sl[6 * RSLOT + lane * RS + wv * 8] = make_uint4(pk4[0], pk4[1], pk4[2], pk4[3]);
            *(uint4*)&sl[7 * RSLOT + lane * RS + wv * 8] = make_uint4(pv4[0], pv4[1], pv4[2], pv4[3]);
        }
        LDS_BARRIER();
        if (h + 1 < 8) { S1_LOADW(h + 1) S2_LOADX(h + 1) }
        CH_TE(2) CH_TS(3)
        {
            RW_IDX
            f32x4 acc[2];
            ZACC(acc); mm64(sl + 1 * RSLOT, RS, sl + 0 * RSLOT, RS, acc, lane, wv);
#pragma unroll
            for (int i = 0; i < 2; i++) {
                f32x4 pm;
#pragma unroll
                for (int r = 0; r < 4; r++) {
                    const int m = mt * 16 + qq * 4 + r, n = (nt0 + i) * 16 + kr;
                    if (!(m < n)) acc[i][r] = 0.f;
                    pm[r] = acc[i][r] + ((m == n) ? 1.f : 0.f);
                }
                st_t(sl + 8 * RSLOT, RS, acc[i], mt, nt0 + i, lane);
                st_n(sl + 9 * RSLOT, RS, acc[i], mt, nt0 + i, lane);
                st_t(sl + 13 * RSLOT, RS, pm, mt, nt0 + i, lane);
            }
            ZACC(acc); mm64(sl + 0 * RSLOT, RS, sl + 2 * RSLOT, RS, acc, lane, wv);
#pragma unroll
            for (int i = 0; i < 2; i++) {
#pragma unroll
                for (int r = 0; r < 4; r++) { const int m = mt * 16 + qq * 4 + r, n = (nt0 + i) * 16 + kr; if (!(m > n)) acc[i][r] = 0.f; }
                st_t(sl + 10 * RSLOT, RS, acc[i], mt, nt0 + i, lane);
            }
            ZACC(acc); mm64(sl + 1 * RSLOT, RS, sl + 3 * RSLOT, RS, acc, lane, wv);
#pragma unroll
            for (int i = 0; i < 2; i++) {
#pragma unroll
                for (int r = 0; r < 4; r++) { const int m = mt * 16 + qq * 4 + r, n = (nt0 + i) * 16 + kr; if (m > n) acc[i][r] = 0.f; }
                st_t(sl + 11 * RSLOT, RS, acc[i], mt, nt0 + i, lane);
            }
            ZACC(acc); mm64(sl + 2 * RSLOT, RS, sl + 3 * RSLOT, RS, acc, lane, wv);
#pragma unroll
            for (int i = 0; i < 2; i++) {
#pragma unroll
                for (int r = 0; r < 4; r++) { const int m = mt * 16 + qq * 4 + r, n = (nt0 + i) * 16 + kr; if (m > n) acc[i][r] = 0.f; }
                st_t(sl + 12 * RSLOT, RS, acc[i], mt, nt0 + i, lane);
            }
        }
        LDS_BARRIER();
        CH_TE(3) CH_TS(4)
        u16* X = sl + 8 * RSLOT; u16* XT = sl + 9 * RSLOT; u16* X2 = sl + 0 * RSLOT; u16* X2T = sl + 1 * RSLOT;
        u16* Pc = sl + 13 * RSLOT; u16* Pn = sl + 2 * RSLOT;
#pragma unroll 1
        for (int j = 1; j <= 6; j++) {
            RW_IDX
            f32x4 acc[2];
            if (j <= 5) {
                ZACC(acc); mm64(X, RS, XT, RS, acc, lane, wv);
#pragma unroll
                for (int i = 0; i < 2; i++) { st_t(X2T, RS, acc[i], mt, nt0 + i, lane); st_n(X2, RS, acc[i], mt, nt0 + i, lane); }
            }
            if (j >= 2) {
                ZACC(acc); mm64(XT, RS, Pc, RS, acc, lane, wv);
#pragma unroll
                for (int i = 0; i < 2; i++) {
                    const uint2 pv = *(const uint2*)&Pc[((nt0 + i) * 16 + kr) * RS + mt * 16 + qq * 4];
                    acc[i][0] += __uint_as_float(pv.x << 16); acc[i][1] += __uint_as_float(pv.x & 0xFFFF0000u);
                    acc[i][2] += __uint_as_float(pv.y << 16); acc[i][3] += __uint_as_float(pv.y & 0xFFFF0000u);
                    st_t(Pn, RS, acc[i], mt, nt0 + i, lane);
                }
            }
            LDS_BARRIER();
            if (j >= 2) { u16* tp = Pc; Pc = Pn; Pn = tp; }
            if (j <= 5) { u16* tx = X; X = X2; X2 = tx; tx = XT; XT = X2T; X2T = tx; }
        }
        CH_TE(4) CH_TS(5)
        u16* TT = Pc;
        {
            RW_IDX
            f32x4 acc[2];
            ZACC(acc); mm64(TT, RS, sl + 4 * RSLOT, RS, acc, lane, wv);
#pragma unroll
            for (int i = 0; i < 2; i++) st_t(sl + 0 * RSLOT, RS, acc[i], mt, nt0 + i, lane);
            ZACC(acc); mm64(sl + 10 * RSLOT, RS, TT, RS, acc, lane, wv);
#pragma unroll
            for (int i = 0; i < 2; i++) st_t(sl + 8 * RSLOT, RS, acc[i], mt, nt0 + i, lane);
        }
        LDS_BARRIER();
        {
            RW_IDX
            f32x4 acc[2];
            ZACC(acc); mm64(sl + 8 * RSLOT, RS, sl + 7 * RSLOT, RS, acc, lane, wv);
#pragma unroll
            for (int i = 0; i < 2; i++) st_t(sl + 9 * RSLOT, RS, acc[i], mt, nt0 + i, lane);
            ZACC(acc); mm64(sl + 0 * RSLOT, RS, sl + 5 * RSLOT, RS, acc, lane, wv);
#pragma unroll
            for (int i = 0; i < 2; i++) {
                const int n = (nt0 + i) * 16 + kr; const float gn = gl[n];
#pragma unroll
                for (int r = 0; r < 4; r++) { const int m = mt * 16 + qq * 4 + r; acc[i][r] = acc[i][r] * gn + ((m == n) ? gn : 0.f); }
                st_t(cd, 64, acc[i], mt, nt0 + i, lane);
            }
            ZACC(acc); mm64(sl + 0 * RSLOT, RS, sl + 11 * RSLOT, RS, acc, lane, wv);
#pragma unroll
            for (int i = 0; i < 2; i++) {
                const uint2 rv = *(const uint2*)&sl[3 * RSLOT + ((nt0 + i) * 16 + kr) * RS + mt * 16 + qq * 4];
                acc[i][0] += __uint_as_float(rv.x << 16); acc[i][1] += __uint_as_float(rv.x & 0xFFFF0000u);
                acc[i][2] += __uint_as_float(rv.y << 16); acc[i][3] += __uint_as_float(rv.y & 0xFFFF0000u);
                st_t(cd + 2 * 4096, 64, acc[i], mt, nt0 + i, lane);
            }
        }
        LDS_BARRIER();
        {
            RW_IDX
            f32x4 acc[2];
            ZACC(acc);
            mm64(sl + 5 * RSLOT, RS, sl + 9 * RSLOT, RS, acc, lane, wv);
            mm64(sl + 6 * RSLOT, RS, sl + 7 * RSLOT, RS, acc, lane, wv);
#pragma unroll
            for (int i = 0; i < 2; i++) {
#pragma unroll
                for (int r = 0; r < 4; r++) acc[i][r] *= gl[mt * 16 + qq * 4 + r];
                st_t(cd + 1 * 4096, 64, acc[i], mt, nt0 + i, lane);
            }
            ZACC(acc);
            mm64(sl + 9 * RSLOT, RS, sl + 11 * RSLOT, RS, acc, lane, wv);
            mm64(sl + 7 * RSLOT, RS, sl + 12 * RSLOT, RS, acc, lane, wv);
#pragma unroll
            for (int i = 0; i < 2; i++) st_t(cd + 3 * 4096, 64, acc[i], mt, nt0 + i, lane);
        }
        CH_TE(5)
      }
    }
    if (CHPROBE) { __syncthreads(); const unsigned long long t1_ = __builtin_amdgcn_s_memrealtime(); while (__builtin_amdgcn_s_memrealtime() - t1_ < ctacc_) __builtin_amdgcn_s_sleep(8); }
}

__device__ void ph_rwkv_seq(const P& p, int bid, int nb, char* smem) {
    u16* SL = (u16*)smem;
    const int tid = get_tid(), lane = tid & 63, wv = __builtin_amdgcn_readfirstlane(tid >> 6);
    const int kr = lane & 15, qq = lane >> 4, chn = wv >> 2, vt = wv & 3;
    for (int pair = bid; pair < B_ * 4; pair += nb) {
        const int bh = pair * 2 + chn;
        u16* mySL = SL + chn * RSLOT;
        __syncthreads();
#pragma unroll
        for (int ks = 0; ks < 2; ks++) *(uint4*)&mySL[(vt * 16 + kr) * RS + ks * 32 + qq * 8] = make_uint4(0u, 0u, 0u, 0u);
        u16* cbase = p.cdat + (size_t)bh * 128 * 4 * 4096;
        bf16x8 GA0[4][2], GA1[4][2], GA2[4][2], GA3[4][2]; uint2 H0[4], H1[4], H2[4], H3[4];
#define SEQ_LD(GAx, Hx, c) { const u16* cd_ = cbase + (size_t)(c) * 4 * 4096; \
            _Pragma("unroll") for (int m4 = 0; m4 < 4; m4++) { \
                _Pragma("unroll") for (int ks = 0; ks < 2; ks++) GAx[m4][ks] = *(const bf16x8*)&cd_[(m4 * 16 + kr) * 64 + ks * 32 + qq * 8]; \
                Hx[m4] = *(const uint2*)&cd_[1 * 4096 + (vt * 16 + kr) * 64 + m4 * 16 + qq * 4]; } }
#define SEQ_STEP(GAx, Hx, c) { \
            bf16x8 Z0[2]; \
            _Pragma("unroll") for (int ks = 0; ks < 2; ks++) Z0[ks] = *(const bf16x8*)&mySL[(vt * 16 + kr) * RS + ks * 32 + qq * 8]; \
            f32x4 zs[4]; \
            _Pragma("unroll") for (int m4 = 0; m4 < 4; m4++) { \
                zs[m4] = unpack4(Hx[m4]); \
                _Pragma("unroll") for (int ks = 0; ks < 2; ks++) zs[m4] = __builtin_amdgcn_mfma_f32_16x16x32_bf16(GAx[m4][ks], Z0[ks], zs[m4], 0, 0, 0); } \
            u16* sn_ = cbase + (size_t)(c) * 4 * 4096 + 1 * 4096 + (vt * 16 + kr) * 64 + qq * 4; \
            _Pragma("unroll") for (int m4 = 0; m4 < 4; m4++) { \
                const uint2 pk_ = pack4(zs[m4]); \
                *(uint2*)&mySL[(vt * 16 + kr) * RS + m4 * 16 + qq * 4] = pk_; \
                *(uint2*)&sn_[m4 * 16] = pk_; } \
            if ((c) + 4 < 128) SEQ_LD(GAx, Hx, (c) + 4) }
        SEQ_LD(GA0, H0, 0) SEQ_LD(GA1, H1, 1) SEQ_LD(GA2, H2, 2) SEQ_LD(GA3, H3, 3)
#pragma unroll 1
        for (int c = 0; c < 128; c += 4) {
            SEQ_STEP(GA0, H0, c)
            SEQ_STEP(GA1, H1, c + 1)
            SEQ_STEP(GA2, H2, c + 2)
            SEQ_STEP(GA3, H3, c + 3)
        }
#undef SEQ_LD
#undef SEQ_STEP
    }
}

__device__ void ph_rwkv_out(const P& p, int bid, int nb, char* smem) {
    const int tid = get_tid(), lane = tid & 63, wv = tid >> 6;
    const int kr = lane & 15, qq = lane >> 4;
    for (int it = bid * NW + wv; it < B_ * 8 * 128; it += nb * NW) {
        const int c = it & 127, bh = it >> 7, b = bh >> 3, h = bh & 7;
        const u16* cd = p.cdat + ((size_t)bh * 128 + c) * 4 * 4096;
        f32x4 ys[4][4];
#pragma unroll
        for (int mt = 0; mt < 4; mt++)
#pragma unroll
            for (int nt = 0; nt < 4; nt++) ys[mt][nt] = unpack4(*(const uint2*)&cd[3 * 4096 + (nt * 16 + kr) * 64 + mt * 16 + qq * 4]);
        if (c > 0) {
            const u16* s0 = cd - 4 * 4096 + 1 * 4096;
#pragma unroll
            for (int ks = 0; ks < 2; ks++) {
                bf16x8 af[4], bq[4];
#pragma unroll
                for (int mt = 0; mt < 4; mt++) af[mt] = *(const bf16x8*)&s0[(mt * 16 + kr) * 64 + ks * 32 + qq * 8];
#pragma unroll
                for (int nt = 0; nt < 4; nt++) bq[nt] = *(const bf16x8*)&cd[2 * 4096 + (nt * 16 + kr) * 64 + ks * 32 + qq * 8];
#pragma unroll
                for (int mt = 0; mt < 4; mt++)
#pragma unroll
                    for (int nt = 0; nt < 4; nt++) ys[mt][nt] = __builtin_amdgcn_mfma_f32_16x16x32_bf16(af[mt], bq[nt], ys[mt][nt], 0, 0, 0);
            }
        }
#pragma unroll
        for (int nt = 0; nt < 4; nt++) {
            float s1 = 0.f, s2 = 0.f;
#pragma unroll
            for (int mt = 0; mt < 4; mt++)
#pragma unroll
                for (int r = 0; r < 4; r++) { s1 += ys[mt][nt][r]; s2 += ys[mt][nt][r] * ys[mt][nt][r]; }
            s1 = xrow_sum(s1); s2 = xrow_sum(s2);
            const float mean = s1 * (1.f / 64.f);
            const float var = fmaxf(s2 * (1.f / 64.f) - mean * mean, 0.f);
            const float rstd = rsqrtf(var + 64e-5f);
            const int t = nt * 16 + kr;
            const size_t n = (size_t)b * S_ + c * 64 + t;
            const float bon = p.bon[n * 8 + h];
#pragma unroll
            for (int mt = 0; mt < 4; mt++) {
                const int vch = h * 64 + mt * 16 + qq * 4;
                const f32x4 vcf = unpack4(*(const uint2*)&p.prw[n * CRW + 1024 + vch]);
                const f32x4 vpf = (c * 64 + t > 0) ? unpack4(*(const uint2*)&p.prw[(n - 1) * CRW + 1024 + vch]) : f32x4{0.f, 0.f, 0.f, 0.f};
                const f32x4 ggf = unpack4(*(const uint2*)&p.ob[n * 512 + vch]);
                const float4 lw = *(const float4*)&p.ln_w[vch], lb = *(const float4*)&p.ln_b[vch], mv = *(const float4*)&p.mu[1024 + vch];
                const float lwa[4] = {lw.x, lw.y, lw.z, lw.w}, lba[4] = {lb.x, lb.y, lb.z, lb.w}, mva[4] = {mv.x, mv.y, mv.z, mv.w};
                f32x4 o;
#pragma unroll
                for (int r = 0; r < 4; r++) {
                    const float vsh = vcf[r] + (vpf[r] - vcf[r]) * mva[r];
                    o[r] = ((ys[mt][nt][r] - mean) * rstd * lwa[r] + lba[r] + bon * vsh) * ggf[r];
                }
                *(uint2*)&p.ob[n * 512 + vch] = pack4(o);
            }
        }
    }
}

__device__ __forceinline__ void unpack8(const uint4& u, f32x4& a, f32x4& b) {
    a = f32x4{__uint_as_float(u.x << 16), __uint_as_float(u.x & 0xFFFF0000u), __uint_as_float(u.y << 16), __uint_as_float(u.y & 0xFFFF0000u)};
    b = f32x4{__uint_as_float(u.z << 16), __uint_as_float(u.z & 0xFFFF0000u), __uint_as_float(u.w << 16), __uint_as_float(u.w & 0xFFFF0000u)};
}
struct EpiMerge {
    u16* merged; u16* tmp2; int pass;
    __device__ __forceinline__ void operator()(const f32x4 (&acc)[2][2][4][2], const GUnit& u, int, int, int, int) const {
        const int t2_ = get_tid(), wid_ = __builtin_amdgcn_readfirstlane(t2_ >> 6), wr = wid_ >> 2, wc = wid_ & 3, fr = t2_ & 15, fq = (t2_ >> 4) & 3;
        const int row0 = u.pm * 256 + wr * 64 + fr, col0 = u.pn * 256 + wc * 32 + 8 * fq;
#pragma unroll
        for (int ai = 0; ai < 2; ++ai)
#pragma unroll
            for (int m = 0; m < 4; ++m) {
                const size_t off = (size_t)(row0 + ai * 128 + m * 16) * D_ + col0;
                uint4 m1[2], m2[2];
                if (pass == 1 || pass == 3) {
#pragma unroll
                    for (int bj = 0; bj < 2; ++bj) { m1[bj] = *(const uint4*)&merged[off + bj * 128]; if (pass == 3) m2[bj] = *(const uint4*)&tmp2[off + bj * 128]; }
                }
#pragma unroll
                for (int bj = 0; bj < 2; ++bj) {
                    f32x4 v0 = acc[ai][bj][m][0], v1 = acc[ai][bj][m][1];
                    if (pass == 1) { f32x4 a0, a1; unpack8(m1[bj], a0, a1);
#pragma unroll
                        for (int r = 0; r < 4; r++) { v0[r] = a0[r] * sigmoidf_(v0[r]); v1[r] = a1[r] * sigmoidf_(v1[r]); } }
                    if (pass == 3) { f32x4 a0, a1, b0, b1; unpack8(m1[bj], a0, a1); unpack8(m2[bj], b0, b1);
#pragma unroll
                        for (int r = 0; r < 4; r++) { v0[r] = a0[r] + b0[r] * sigmoidf_(v0[r]); v1[r] = a1[r] + b1[r] * sigmoidf_(v1[r]); } }
                    *(uint4*)&((pass == 2) ? tmp2 : merged)[off + bj * 128] = pack8(v0, v1);
                }
                asm volatile("" ::: "memory");
            }
    }
};
__device__ void ph_merge(const P& p, int bid, int nb, char* smem) {
    u16* tmp2 = (u16*)p.x1;
#pragma unroll 1
    for (int pass = 0; pass < 4; ++pass) {
        const int K = (pass & 1) ? D_ : 512;
        const u16* A = (pass & 1) ? p.hbuf : (pass == 0 ? p.oa : p.ob);
        const u16* Bt = (pass == 0) ? p.wpaT : (pass == 1 ? p.wgT : (pass == 2 ? p.wpbT : p.wgT + (size_t)1024 * D_));
        DenseSched S; S.init(NTOK, D_, K, Bt, nb, bid);
        EpiMerge E{p.merged, tmp2, pass};
        gemm256(smem, (const char*)A, K, S, E);
    }
}

struct EpiOutproj {
    const float* x; float* x1;
    __device__ __forceinline__ void operator()(const f32x4 (&acc)[2][2][4][2], const GUnit& u, int, int, int, int) const {
        const int t2_ = get_tid(), wid_ = __builtin_amdgcn_readfirstlane(t2_ >> 6), wr = wid_ >> 2, wc = wid_ & 3, fr = t2_ & 15, fq = (t2_ >> 4) & 3;
        const int row0 = u.pm * 256 + wr * 64 + fr, col0 = u.pn * 256 + wc * 32 + 4 * fq;
#pragma unroll
        for (int ai = 0; ai < 2; ++ai)
#pragma unroll
            for (int m = 0; m < 4; ++m) {
                const size_t off = (size_t)(row0 + ai * 128 + m * 16) * D_ + col0;
                f32x4 xin[2][2];
#pragma unroll
                for (int bj = 0; bj < 2; ++bj)
#pragma unroll
                    for (int n = 0; n < 2; ++n) xin[bj][n] = *(const f32x4*)&x[off + bj * 128 + n * 16];
#pragma unroll
                for (int bj = 0; bj < 2; ++bj)
#pragma unroll
                    for (int n = 0; n < 2; ++n) *(f32x4*)&x1[off + bj * 128 + n * 16] = xin[bj][n] + acc[ai][bj][m][n];
                asm volatile("" ::: "memory");
            }
    }
};
__device__ void ph_outproj(const P& p, int bid, int nb, char* smem) {
    DenseSched S; S.init(NTOK, D_, D_, p.woutT, nb, bid);
    EpiOutproj E{p.x, p.x1};
    gemm256(smem, (const char*)p.merged, D_, S, E);
}

__device__ __forceinline__ float red8f(float x) {
    x += dppf<0xB1>(x);
    x += dppf<0x4E>(x);
    x += dppf<0x141>(x);
    return x;
}
__device__ void ph_route(const P& p, int bid, int nb, char* smem) {
    float* wr = (float*)smem;
    const int tid = get_tid(), lane = tid & 63, wv = tid >> 6;
    {
        u16* Tl = (u16*)smem;
        const int t = get_tid();
        const int lrow = t >> 3, lc8 = (t & 7) * 8;
        const int sslot = t >> 3, skc = t & 7;
        const int scol = (sslot & 32) + perm32(sslot & 31);
        constexpr int NT13 = NEXP * 2 * 4 * 16, NT2 = NEXP * 16 * 4;
        for (int tile = bid; tile < NT13 + NT2; tile += nb) {
            const float* src; u16* dst; int N, Kd;
            if (tile < NT13) {
                const int kt = tile & 15, sg = (tile >> 4) & 3, half = (tile >> 6) & 1, e = tile >> 7;
                const int sl0 = sg * 64;
                N = 256; Kd = D_;
                src = ((sl0 >> 7) ? p.e_w3 : p.e_w1) + (size_t)e * D_ * 256 + (size_t)(kt * 64) * 256 + half * 128 + (sl0 & 127);
                dst = p.ew1T + ((size_t)e * 512 + half * 256 + sl0) * D_ + kt * 64;
            } else {
                const int t2 = tile - NT13;
                const int kt = t2 & 3, sg = (t2 >> 2) & 15, e = t2 >> 6;
                N = D_; Kd = 256;
                src = p.e_w2 + (size_t)e * 256 * D_ + (size_t)(kt * 64) * D_ + sg * 64;
                dst = p.ew2T + ((size_t)e * D_ + sg * 64) * 256 + kt * 64;
            }
            const float4 f0 = *(const float4*)&src[(size_t)lrow * N + lc8], f1 = *(const float4*)&src[(size_t)lrow * N + lc8 + 4];
            __syncthreads();
            const unsigned h0 = pack2(f0.x, f0.y), h1 = pack2(f0.z, f0.w), h2 = pack2(f1.x, f1.y), h3 = pack2(f1.z, f1.w);
            Tl[(lc8 + 0) * 72 + lrow] = (u16)(h0 & 0xFFFFu); Tl[(lc8 + 1) * 72 + lrow] = (u16)(h0 >> 16);
            Tl[(lc8 + 2) * 72 + lrow] = (u16)(h1 & 0xFFFFu); Tl[(lc8 + 3) * 72 + lrow] = (u16)(h1 >> 16);
            Tl[(lc8 + 4) * 72 + lrow] = (u16)(h2 & 0xFFFFu); Tl[(lc8 + 5) * 72 + lrow] = (u16)(h2 >> 16);
            Tl[(lc8 + 6) * 72 + lrow] = (u16)(h3 & 0xFFFFu); Tl[(lc8 + 7) * 72 + lrow] = (u16)(h3 >> 16);
            __syncthreads();
            *(uint4*)&dst[(size_t)sslot * Kd + skc * 8] = *(const uint4*)&Tl[scol * 72 + skc * 8];
        }
        __syncthreads();
    }
    for (int i = tid; i < 1024 * 36; i += NT) {
        const int k = i / 36, j = i - k * 36;
        const int kp = (k & ~31) + ((k & 3) << 3) + ((k >> 2) & 7);
        wr[kp * 36 + j] = (j < 4) ? p.w_grp[k * 4 + j] : p.w_exp[k * 32 + (j - 4)];
    }
    int* lcount = (int*)(smem + 1024 * 36 * 4);
    if (tid < 32) lcount[tid] = 0;
    __syncthreads();
    const int sub = lane & 7, tk = lane >> 3;
    for (int n0 = (bid * NW + wv) * 16; n0 < NTOK; n0 += nb * NW * 16) {
        float acc[2][36]; float ss[2] = {0.f, 0.f};
#pragma unroll
        for (int t = 0; t < 2; t++)
#pragma unroll
            for (int j = 0; j < 36; j++) acc[t][j] = 0.f;
#pragma unroll 1
        for (int i0 = 0; i0 < 32; i0 += 4) {
            float4 xv[2][4];
#pragma unroll
            for (int t = 0; t < 2; t++)
#pragma unroll
                for (int i = 0; i < 4; i++) xv[t][i] = *(const float4*)&p.x1[(size_t)(n0 + 8 * t + tk) * D_ + (i0 + i) * 32 + sub * 4];
#pragma unroll
            for (int i = 0; i < 4; i++) {
                const int k0 = (i0 + i) * 32 + sub * 4;
                const float4 gf = *(const float4*)&p.g_ffn[k0];
                float hv[2][4];
#pragma unroll
                for (int t = 0; t < 2; t++) {
                    const float4 x = xv[t][i];
                    ss[t] += x.x * x.x + x.y * x.y + x.z * x.z + x.w * x.w;
                    hv[t][0] = x.x * gf.x; hv[t][1] = x.y * gf.y; hv[t][2] = x.z * gf.z; hv[t][3] = x.w * gf.w;
                    uint2 o; o.x = pack2(hv[t][0], hv[t][1]); o.y = pack2(hv[t][2], hv[t][3]);
                    *(uint2*)&p.hbuf[(size_t)(n0 + 8 * t + tk) * D_ + k0] = o;
                }
#pragma unroll
                for (int e2 = 0; e2 < 4; e2++) {
                    asm volatile("" ::: "memory");
                    const float* wrow = wr + ((i0 + i) * 32 + e2 * 8 + sub) * 36;
#pragma unroll
                    for (int j4 = 0; j4 < 9; j4++) {
                        const float4 wv4 = *(const float4*)&wrow[j4 * 4];
#pragma unroll
                        for (int t = 0; t < 2; t++) {
                            acc[t][j4 * 4 + 0] += hv[t][e2] * wv4.x; acc[t][j4 * 4 + 1] += hv[t][e2] * wv4.y;
                            acc[t][j4 * 4 + 2] += hv[t][e2] * wv4.z; acc[t][j4 * 4 + 3] += hv[t][e2] * wv4.w;
                        }
                    }
                }
            }
        }
#pragma unroll
        for (int t = 0; t < 2; t++) {
            const size_t n = (size_t)n0 + 8 * t + tk;
            const float sst = red8f(ss[t]);
#pragma unroll
            for (int j = 0; j < 36; j++) acc[t][j] = red8f(acc[t][j]);
            const float rs = rsqrtf(sst * (1.f / D_) + 1e-6f);
            if (sub == 0) {
                p.rsb[n] = rs;
                float gl[4]; int gs = 0;
#pragma unroll
                for (int j = 0; j < 4; j++) gl[j] = acc[t][j] * rs + p.b_grp[j];
                float gm = gl[0];
#pragma unroll
                for (int j = 1; j < 4; j++) if (gl[j] > gm) { gm = gl[j]; gs = j; }
                float gsum = 0.f;
#pragma unroll
                for (int j = 0; j < 4; j++) gsum += __expf(gl[j] - gm);
                const float pg = 1.f / gsum;
                float el[8]; float em = -3.0e38f;
#pragma unroll
                for (int j = 0; j < 8; j++) {
                    float a = (gs == 0) ? acc[t][4 + j] : ((gs == 1) ? acc[t][12 + j] : ((gs == 2) ? acc[t][20 + j] : acc[t][28 + j]));
                    a = a * rs + p.b_exp[gs * 8 + j];
                    el[j] = a; em = fmaxf(em, a);
                }
                int j0 = 0, j1 = -1; float v0 = -3.0e38f, v1 = -3.0e38f;
#pragma unroll
                for (int j = 0; j < 8; j++) { el[j] = __expf(el[j] - em); }
#pragma unroll
                for (int j = 0; j < 8; j++) { if (el[j] > v0) { v0 = el[j]; j0 = j; } }
#pragma unroll
                for (int j = 0; j < 8; j++) { if (j != j0 && el[j] > v1) { v1 = el[j]; j1 = j; } }
                const float den = v0 + v1;
                const int e0 = gs * 8 + j0, e1 = gs * 8 + j1;
                p.tok_e[n * 2] = e0; p.tok_e[n * 2 + 1] = e1;
                p.tok_gate[n * 2] = pg * v0 / den; p.tok_gate[n * 2 + 1] = pg * v1 / den;
                atomicAdd(&lcount[e0], 1); atomicAdd(&lcount[e1], 1);
            }
        }
    }
    __syncthreads();
    { const int t2 = get_tid(); if (t2 < 32) { const int c = lcount[t2]; if (c) atomicAdd(&p.counts[t2], c); } }
}

__device__ void ph_scatter(const P& p, int bid, int nb, char* smem) {
    int* offl = (int*)smem;
    int* hist = offl + 64;
    int* gbase = hist + 32;
    const int tid = get_tid();
    if (tid == 0) {
        int off = 0;
        for (int e = 0; e < NEXP; e++) { offl[e] = off; off += p.counts[e]; }
        offl[NEXP] = off;
    }
    if (bid == 0 && tid == 64) {
        int off = 0, nb_ = 0;
        for (int e = 0; e < NEXP; e++) {
            const int c = p.counts[e];
            p.offs[e] = off;
            for (int r = 0; r < c; r += 256) { p.blk_e[nb_] = e; p.blk_r0[nb_] = off + r; nb_++; }
            off += c;
        }
        p.offs[NEXP] = off;
        *p.nblk = nb_;
    }
    for (int base = bid * NT; base < NTOK * 2; base += nb * NT) {
        __syncthreads();
        if (tid < 32) hist[tid] = 0;
        __syncthreads();
        const int i = base + tid;
        const int e = p.tok_e[i];
        const int rl = atomicAdd(&hist[e], 1);
        __syncthreads();
        if (tid < 32) gbase[tid] = atomicAdd(&p.cursor[tid], hist[tid]);
        __syncthreads();
        const int slot = offl[e] + gbase[e] + rl;
        p.list_tok[slot] = i >> 1; p.list_gate[slot] = p.tok_gate[i]; p.tokslot[i] = slot;
    }
}
template <int CTS>
struct MoeSched {
    const P* pp; int nunits, G, c; unsigned rowbytes; const u16* Bt; size_t b_estride, b_tstride;
    bool gather;
    __device__ __forceinline__ bool next(int i, GUnit& u) const {
        const int L = i * G + c; if (L >= nunits) return false;
        int wgid = L; { const int q = nunits >> 3, r = nunits & 7, xcd = wgid & 7, off = wgid >> 3; wgid = (xcd < r ? xcd * (q + 1) : r * (q + 1) + (xcd - r) * q) + off; }
        u.pm = wgid / CTS; u.pn = wgid & (CTS - 1); return true;
    }
    __device__ __forceinline__ unsigned a_off(const GUnit& u, int h, int R) const {
        const P& p = *pp;
        const int e = __builtin_amdgcn_readfirstlane(p.blk_e[u.pm]), rend = __builtin_amdgcn_readfirstlane(p.offs[e + 1]);
        int sl = __builtin_amdgcn_readfirstlane(p.blk_r0[u.pm]) + h * 128 + R; if (sl >= rend) sl = rend - 1;
        return (unsigned)(gather ? p.list_tok[sl] : sl) * rowbytes;
    }
    __device__ __forceinline__ const char* b_ptr(const GUnit& u) const { return (const char*)(Bt + (size_t)__builtin_amdgcn_readfirstlane(pp->blk_e[u.pm]) * b_estride + (size_t)u.pn * b_tstride); }
};
struct EpiMoe1 {
    const P* pp;
    __device__ __forceinline__ void operator()(const f32x4 (&acc)[2][2][4][2], const GUnit& u, int, int, int, int) const {
        const int t2_ = get_tid(), wid_ = __builtin_amdgcn_readfirstlane(t2_ >> 6), wr = wid_ >> 2, wc = wid_ & 3, fr = t2_ & 15, fq = (t2_ >> 4) & 3;
        const P& p = *pp;
        const int e = __builtin_amdgcn_readfirstlane(p.blk_e[u.pm]), r0 = __builtin_amdgcn_readfirstlane(p.blk_r0[u.pm]), rend = __builtin_amdgcn_readfirstlane(p.offs[e + 1]);
#pragma unroll
        for (int ai = 0; ai < 2; ++ai)
#pragma unroll
            for (int m = 0; m < 4; ++m) {
                const int sl = r0 + ai * 128 + wr * 64 + m * 16 + fr;
                if (sl < rend) {
                    const float rs = p.rsb[p.list_tok[sl]];
                    f32x4 v[2];
#pragma unroll
                    for (int n = 0; n < 2; ++n)
#pragma unroll
                        for (int r = 0; r < 4; r++) { const float a = acc[ai][0][m][n][r] * rs; v[n][r] = a * sigmoidf_(a) * (acc[ai][1][m][n][r] * rs); }
                    *(uint4*)&p.hid[(size_t)sl * 256 + u.pn * 128 + wc * 32 + 8 * fq] = pack8(v[0], v[1]);
                }
            }
    }
};
__device__ void ph_moe1(const P& p, int bid, int nb, char* smem) {
    MoeSched<2> S{&p, __builtin_amdgcn_readfirstlane(*p.nblk) * 2, nb, bid, (unsigned)(D_ * 2), p.ew1T, (size_t)512 * D_, (size_t)256 * D_, true};
    EpiMoe1 E{&p};
    gemm256(smem, (const char*)p.hbuf, D_, S, E);
}
struct EpiMoe2 {
    const P* pp;
    __device__ __forceinline__ void operator()(const f32x4 (&acc)[2][2][4][2], const GUnit& u, int, int, int, int) const {
        const int t2_ = get_tid(), wid_ = __builtin_amdgcn_readfirstlane(t2_ >> 6), wr = wid_ >> 2, wc = wid_ & 3, fr = t2_ & 15, fq = (t2_ >> 4) & 3;
        const P& p = *pp;
        const int e = __builtin_amdgcn_readfirstlane(p.blk_e[u.pm]), r0 = __builtin_amdgcn_readfirstlane(p.blk_r0[u.pm]), rend = __builtin_amdgcn_readfirstlane(p.offs[e + 1]);
#pragma unroll
        for (int ai = 0; ai < 2; ++ai)
#pragma unroll
            for (int m = 0; m < 4; ++m) {
                const int sl = r0 + ai * 128 + wr * 64 + m * 16 + fr;
                if (sl < rend) {
                    const float gt = p.list_gate[sl];
                    u16* yp = p.ybuf + (size_t)sl * D_ + u.pn * 256 + wc * 32 + 8 * fq;
#pragma unroll
                    for (int bj = 0; bj < 2; ++bj) *(uint4*)&yp[bj * 128] = pack8(acc[ai][bj][m][0] * gt, acc[ai][bj][m][1] * gt);
                }
            }
    }
};
__device__ void ph_moe2(const P& p, int bid, int nb, char* smem) {
    MoeSched<4> S{&p, __builtin_amdgcn_readfirstlane(*p.nblk) * 4, nb, bid, 512u, p.ew2T, (size_t)D_ * 256, (size_t)256 * 256, false};
    EpiMoe2 E{&p};
    gemm256(smem, (const char*)p.hid, 256, S, E);
}
__device__ void ph_final(const P& p, int bid, int nb, char* smem) {
    const int tid = get_tid(), lane = tid & 63, wv = tid >> 6;
    for (int row = bid * NW + wv; row < NTOK; row += nb * NW) {
        const int s0 = p.tokslot[row * 2], s1 = p.tokslot[row * 2 + 1];
        float v[16]; float ss = 0.f;
#pragma unroll
        for (int i = 0; i < 4; i++) {
            const int c = i * 256 + lane * 4;
            const float4 t = *(const float4*)&p.x1[(size_t)row * D_ + c];
            const uint2 a = *(const uint2*)&p.ybuf[(size_t)s0 * D_ + c];
            const uint2 bq = *(const uint2*)&p.ybuf[(size_t)s1 * D_ + c];
            v[4 * i]     = t.x + __uint_as_float(a.x << 16) + __uint_as_float(bq.x << 16);
            v[4 * i + 1] = t.y + __uint_as_float(a.x & 0xFFFF0000u) + __uint_as_float(bq.x & 0xFFFF0000u);
            v[4 * i + 2] = t.z + __uint_as_float(a.y << 16) + __uint_as_float(bq.y << 16);
            v[4 * i + 3] = t.w + __uint_as_float(a.y & 0xFFFF0000u) + __uint_as_float(bq.y & 0xFFFF0000u);
            ss += v[4 * i] * v[4 * i] + v[4 * i + 1] * v[4 * i + 1] + v[4 * i + 2] * v[4 * i + 2] + v[4 * i + 3] * v[4 * i + 3];
        }
        ss = wave_sum(ss);
        const float rs = rsqrtf(ss * (1.f / D_) + 1e-6f);
#pragma unroll
        for (int i = 0; i < 4; i++) {
            const int c = i * 256 + lane * 4;
            const float4 g = *(const float4*)&p.g_final[c];
            float4 o; o.x = v[4 * i] * rs * g.x; o.y = v[4 * i + 1] * rs * g.y; o.z = v[4 * i + 2] * rs * g.z; o.w = v[4 * i + 3] * rs * g.w;
            *(float4*)&p.out[(size_t)row * D_ + c] = o;
        }
    }
}

#define XB_TMO      128
#define XB_XCNT(j)  (256  + 64 * (j))
#define XB_XSUB(j)  (1280 + 64 * (j))
#define XB_XGEN(j)  (2304 + 64 * (j))
#define XB_TOP      3328
#define XB_TOPGEN   3392
#define XCD_BAR_WORDS 3456
#define XB_SPIN_CAP (1u << 18)
#define LAS __attribute__((address_space(3)))

__device__ __forceinline__ unsigned xb_ld(unsigned* p)              { return __hip_atomic_load(p, __ATOMIC_RELAXED, __HIP_MEMORY_SCOPE_AGENT); }
__device__ __forceinline__ unsigned xb_add(unsigned* p, unsigned v) { return __hip_atomic_fetch_add(p, v, __ATOMIC_RELAXED, __HIP_MEMORY_SCOPE_AGENT); }
__device__ __forceinline__ unsigned xb_xcc_id() { return (unsigned)__builtin_amdgcn_s_getreg((3 << 11) | 20) & 0xFu; }
#define XB_SPIN(cond, bar) do { unsigned _sp = 0; while (cond) { __builtin_amdgcn_s_sleep(1); \
    if ((++_sp & 255u) == 0u) { if (xb_ld(&(bar)[XB_TMO])) break; if (_sp > XB_SPIN_CAP) { atomicAdd(&(bar)[XB_TMO], 1u); break; } } } } while (0)

struct XcdBarrier {
    unsigned* bar; unsigned x;
    volatile LAS unsigned* st;
};

__device__ __forceinline__ XcdBarrier xcd_barrier_post(unsigned* bar, volatile LAS unsigned* st) {
    XcdBarrier b; b.bar = bar; b.x = xb_xcc_id(); b.st = st;
    if (threadIdx.x == 0) (void)xb_add(&bar[XB_XCNT(b.x)], 1u);
    return b;
}
__device__ __forceinline__ void xcd_barrier_complete(unsigned* bar, unsigned x, unsigned& nloc, unsigned& nx) {
    const unsigned G = gridDim.x * gridDim.y * gridDim.z;
    unsigned sum, cnt, mine, sp = 0u;
    for (;;) {
        sum = 0u; cnt = 0u; mine = 0u;
#pragma unroll
        for (unsigned j = 0; j < 16; ++j) { const unsigned c = xb_ld(&bar[XB_XCNT(j)]); sum += c; cnt += (c > 0u) ? 1u : 0u; mine = (j == x) ? c : mine; }
        if (sum == G) break;
        __builtin_amdgcn_s_sleep(1);
        if ((++sp & 255u) == 0u) { if (xb_ld(&bar[XB_TMO])) break; if (sp > XB_SPIN_CAP) { atomicAdd(&bar[XB_TMO], 1u); break; } }
    }
    nloc = mine > 0u ? mine : 1u; nx = cnt > 0u ? cnt : 1u;
}

__device__ __forceinline__ void xcd_barrier(const XcdBarrier& b) {
    asm volatile("s_waitcnt vmcnt(0)" ::: "memory");
    __syncthreads();
    if (threadIdx.x == 0) {
        unsigned* bar = b.bar;
        __builtin_amdgcn_s_waitcnt(0);
        unsigned nloc = b.st[0], nx = b.st[1];
        if (nloc == 0u) { xcd_barrier_complete(bar, b.x, nloc, nx); b.st[0] = nloc; b.st[1] = nx; }
        const unsigned old = xb_add(&bar[XB_XSUB(b.x)], 1u);
        const unsigned gen = old / nloc;
        if (old + 1u == (gen + 1u) * nloc) {
            __builtin_amdgcn_fence(__ATOMIC_RELEASE, "agent");
            asm volatile("s_waitcnt vmcnt(0)" ::: "memory");
            const unsigned og = xb_add(&bar[XB_TOP], 1u);
            const unsigned tg = og / nx;
            if (og + 1u == (tg + 1u) * nx) xb_add(&bar[XB_TOPGEN], 1u);
            else XB_SPIN(xb_ld(&bar[XB_TOPGEN]) == tg, bar);
            __builtin_amdgcn_fence(__ATOMIC_ACQUIRE, "agent");
            xb_add(&bar[XB_XGEN(b.x)], 1u);
            asm volatile("s_waitcnt vmcnt(0)" ::: "memory");
        } else {
            XB_SPIN(xb_ld(&bar[XB_XGEN(b.x)]) == gen, bar);
            __builtin_amdgcn_fence(__ATOMIC_ACQUIRE, "agent");
            asm volatile("s_waitcnt vmcnt(0)" ::: "memory");
        }
    }
    __syncthreads();
}

template <int PH>
__device__ __forceinline__ void run_phase(const P& p, int bid, int nb, char* smem) {
    if constexpr (PH == 0) ph_prologue(p, bid, nb, smem);
    if constexpr (PH == 1) ph_inproj(p, bid, nb, smem);
    if constexpr (PH == 2) { ph_compress(p, bid, nb, smem); __syncthreads(); ph_rwkv_chunk(p, bid, nb, smem); }
    if constexpr (PH == 3) {
        if (bid < SCAN_BLOCKS) ph_rwkv_seq(p, bid, SCAN_BLOCKS, smem);
        else ph_nsa(p, bid - SCAN_BLOCKS, nb - SCAN_BLOCKS, smem);
    }
    if constexpr (PH == 12) ph_rwkv_out(p, bid, nb, smem);
    if constexpr (PH == 4) ph_merge(p, bid, nb, smem);
    if constexpr (PH == 5) ph_outproj(p, bid, nb, smem);
    if constexpr (PH == 6) ph_route(p, bid, nb, smem);
    if constexpr (PH == 7) ph_scatter(p, bid, nb, smem);
    if constexpr (PH == 9) ph_moe1(p, bid, nb, smem);
    if constexpr (PH == 10) ph_moe2(p, bid, nb, smem);
    if constexpr (PH == 11) ph_final(p, bid, nb, smem);
}

template <int PH>
__global__ void __launch_bounds__(NT) kph(P p) {
    extern __shared__ __attribute__((aligned(16))) char smem[];
    run_phase<PH>(p, blockIdx.x, gridDim.x, smem);
}

__global__ void __launch_bounds__(NT, 2) mega(P p) {
    extern __shared__ __attribute__((aligned(16))) char smem[];
    volatile LAS unsigned* st = (volatile LAS unsigned*)(smem + SMEM_BYTES - 16);
    if (threadIdx.x == 0) { st[0] = 0u; st[1] = 0u; st[2] = 0u; st[3] = 0u; }
    __syncthreads();
    XcdBarrier bar = xcd_barrier_post(p.bar, st);
    const int bid = blockIdx.x, nb = gridDim.x;
#define RUNP(N, BAR) { unsigned long long t0_ = 0; if ((TPROBE >> N) & 1) t0_ = __builtin_amdgcn_s_memrealtime(); run_phase<N>(p, bid, nb, smem); \
        unsigned long long tw_ = 0; if (((TPROBE >> N) & 1) && TPSEL) tw_ = __builtin_amdgcn_s_memrealtime() - t0_; if (BAR) xcd_barrier(bar); \
        if ((TPROBE >> N) & 1) { const unsigned long long t1_ = __builtin_amdgcn_s_memrealtime(); const unsigned long long dt_ = TPSEL ? tw_ : t1_ - t0_; \
            if (!TPSEL || (TPSEL == 1 ? (bid < SCAN_BLOCKS) : (bid >= SCAN_BLOCKS))) while (__builtin_amdgcn_s_memrealtime() - t1_ < dt_) __builtin_amdgcn_s_sleep(8); if (TPSEL) xcd_barrier(bar); } }
    RUNP(0, 1) RUNP(1, 1) RUNP(2, 1) RUNP(3, 1) RUNP(12, 1) RUNP(4, 1) RUNP(5, 1) RUNP(6, 1) RUNP(7, 1) RUNP(9, 1) RUNP(10, 1) RUNP(11, 0)
}

extern "C" void kernel_launch(void* const* d_in, const int* in_sizes, int n_in,
                              void* d_out, int out_size, void* d_ws, size_t ws_size,
                              hipStream_t stream) {
    P p{};
    p.x = (const float*)d_in[0]; p.pos = (const int*)d_in[1]; p.g_mix = (const float*)d_in[2]; p.w_in = (const float*)d_in[3];
    p.pe_k = (const float*)d_in[4]; p.w1_k = (const float*)d_in[5]; p.b1_k = (const float*)d_in[6]; p.w2_k = (const float*)d_in[7]; p.b2_k = (const float*)d_in[8];
    p.pe_v = (const float*)d_in[9]; p.w1_v = (const float*)d_in[10]; p.b1_v = (const float*)d_in[11]; p.w2_v = (const float*)d_in[12]; p.b2_v = (const float*)d_in[13];
    p.mu = (const float*)d_in[14]; p.w0 = (const float*)d_in[15]; p.w2 = (const float*)d_in[16]; p.a0 = (const float*)d_in[17]; p.a2 = (const float*)d_in[18];
    p.g2 = (const float*)d_in[19]; p.k_k = (const float*)d_in[20]; p.k_a = (const float*)d_in[21]; p.r_k = (const float*)d_in[22]; p.ln_w = (const float*)d_in[23]; p.ln_b = (const float*)d_in[24];
    p.wpa = (const float*)d_in[25]; p.wpb = (const float*)d_in[26]; p.wout = (const float*)d_in[27]; p.g_ffn = (const float*)d_in[28];
    p.w_grp = (const float*)d_in[29]; p.b_grp = (const float*)d_in[30]; p.w_exp = (const float*)d_in[31]; p.b_exp = (const float*)d_in[32];
    p.e_w1 = (const float*)d_in[33]; p.e_w3 = (const float*)d_in[34]; p.e_w2 = (const float*)d_in[35]; p.g_final = (const float*)d_in[36];
    p.out = (float*)d_out;
    char* ws = (char*)d_ws;
    const size_t MiB = 1ull << 20;
    p.hbuf = (u16*)(ws + 0 * MiB);
    p.q    = (u16*)(ws + 64 * MiB);
    p.kc   = (u16*)(ws + 96 * MiB);  p.vc   = (u16*)(ws + 104 * MiB);
    p.ksl  = (u16*)(ws + 112 * MiB); p.vslT = (u16*)(ws + 120 * MiB);
    p.kwn  = (u16*)(ws + 128 * MiB); p.vwnT = (u16*)(ws + 136 * MiB);
    p.nsag = (float*)(ws + 144 * MiB);
    p.kcb  = (u16*)(ws + 148 * MiB); p.vcT  = (u16*)(ws + 149 * MiB);
    p.prw  = (u16*)(ws + 160 * MiB);
    p.cdat = (u16*)(ws + 272 * MiB);
    p.bon  = (float*)(ws + 150 * MiB);
    p.w2T  = (u16*)(ws + 151 * MiB); p.a2T = p.w2T + 512 * 64; p.g2T = p.a2T + 512 * 64;
    p.cw1Tk = (u16*)(ws + 152 * MiB); p.cw1Tv = (u16*)(ws + 153 * MiB);
    p.cw2Tk = (u16*)(ws + 154 * MiB); p.cw2Tv = p.cw2Tk + 128 * 256;
    p.chid = (u16*)(ws + 155 * MiB);
    p.xact = (u16*)(ws + 488 * MiB);
    p.oa   = (u16*)(ws + 400 * MiB);
    p.ob   = (u16*)(ws + 432 * MiB);
    p.merged = (u16*)(ws + 64 * MiB);
    p.x1   = (float*)(ws + 160 * MiB);
    char* rt = ws + 288 * MiB;
    p.tok_e = (int*)(rt);                        rt += NTOK * 2 * 4;
    p.tok_gate = (float*)(rt);                   rt += NTOK * 2 * 4;
    p.tokslot = (int*)(rt);                      rt += NTOK * 2 * 4;
    p.list_tok = (int*)(rt);                     rt += NTOK * 2 * 4;
    p.list_gate = (float*)(rt);                  rt += NTOK * 2 * 4;
    p.blk_e = (int*)(rt);                        rt += 2048 * 4;
    p.blk_r0 = (int*)(rt);                       rt += 2048 * 4;
    p.rsb = (float*)(rt);                        rt += NTOK * 4;
    p.hid  = (u16*)(ws + 296 * MiB);
    p.ybuf = (u16*)(ws + 336 * MiB);
    char* misc = ws + 470 * MiB;
    p.counts = (int*)(misc); p.cursor = (int*)(misc + 256); p.offs = (int*)(misc + 512); p.nblk = (int*)(misc + 1024); p.nsactr = (int*)(misc + 2048);
    p.bar = (unsigned*)(ws + 471 * MiB);
    p.cb1k = (float*)(misc + 65536); p.cb1v = p.cb1k + 256;
    {
        char* wa = ws + 472 * MiB;
        p.winT = (u16*)wa;  wa += (size_t)3328 * 1024 * 2;
        p.wgT  = (u16*)wa;  wa += (size_t)2048 * 1024 * 2;
        p.wpaT = (u16*)wa;  wa += (size_t)1024 * 512 * 2;
        p.wpbT = (u16*)wa;  wa += (size_t)1024 * 512 * 2;
        p.woutT = (u16*)wa; wa += (size_t)1024 * 1024 * 2;
        p.ew1T = (u16*)(ws + 64 * MiB);  p.ew3T = (u16*)(ws + 80 * MiB);  p.ew2T = (u16*)(ws + 96 * MiB);
    }
    if (ws_size < (size_t)505 * MiB) return;

#if MEGA
    {
        static int mgrid = 0;
        if (mgrid == 0) {
            int dev = 0, cus = 0, per_cu = 0;
            hipGetDevice(&dev);
            hipDeviceGetAttribute(&cus, hipDeviceAttributeMultiprocessorCount, dev);
            hipFuncSetAttribute((const void*)mega, hipFuncAttributeMaxDynamicSharedMemorySize, SMEM_BYTES);
            hipOccupancyMaxActiveBlocksPerMultiprocessor(&per_cu, (const void*)mega, NT, SMEM_BYTES);
            (void)hipGetLastError();
            mgrid = cus;
        }
        hipMemsetAsync(p.bar, 0, XCD_BAR_WORDS * sizeof(unsigned) + 512 * sizeof(float), stream);
        mega<<<mgrid, NT, SMEM_BYTES, stream>>>(p);
        return;
    }
#else
    const int grid = 512;
    hipMemsetAsync(p.bar, 0, XCD_BAR_WORDS * sizeof(unsigned) + 512 * sizeof(float), stream);
    hipFuncSetAttribute((const void*)kph<0>, hipFuncAttributeMaxDynamicSharedMemorySize, SMEM_BYTES);
    hipFuncSetAttribute((const void*)kph<1>, hipFuncAttributeMaxDynamicSharedMemorySize, SMEM_BYTES);
    hipFuncSetAttribute((const void*)kph<2>, hipFuncAttributeMaxDynamicSharedMemorySize, SMEM_BYTES);
    hipFuncSetAttribute((const void*)kph<3>, hipFuncAttributeMaxDynamicSharedMemorySize, SMEM_BYTES);
    hipFuncSetAttribute((const void*)kph<4>, hipFuncAttributeMaxDynamicSharedMemorySize, SMEM_BYTES);
    hipFuncSetAttribute((const void*)kph<5>, hipFuncAttributeMaxDynamicSharedMemorySize, SMEM_BYTES);
    hipFuncSetAttribute((const void*)kph<6>, hipFuncAttributeMaxDynamicSharedMemorySize, SMEM_BYTES);
    hipFuncSetAttribute((const void*)kph<7>, hipFuncAttributeMaxDynamicSharedMemorySize, SMEM_BYTES);
    hipFuncSetAttribute((const void*)kph<8>, hipFuncAttributeMaxDynamicSharedMemorySize, SMEM_BYTES);
    hipFuncSetAttribute((const void*)kph<9>, hipFuncAttributeMaxDynamicSharedMemorySize, SMEM_BYTES);
    hipFuncSetAttribute((const void*)kph<10>, hipFuncAttributeMaxDynamicSharedMemorySize, SMEM_BYTES);
    hipFuncSetAttribute((const void*)kph<11>, hipFuncAttributeMaxDynamicSharedMemorySize, SMEM_BYTES);
    kph<0><<<grid, NT, SMEM_BYTES, stream>>>(p);
    kph<1><<<grid, NT, SMEM_BYTES, stream>>>(p);
    kph<2><<<grid, NT, SMEM_BYTES, stream>>>(p);
    kph<3><<<grid, NT, SMEM_BYTES, stream>>>(p);
    kph<12><<<grid, NT, SMEM_BYTES, stream>>>(p);
    kph<4><<<grid, NT, SMEM_BYTES, stream>>>(p);
    kph<5><<<grid, NT, SMEM_BYTES, stream>>>(p);
    kph<6><<<grid, NT, SMEM_BYTES, stream>>>(p);
    kph<7><<<grid, NT, SMEM_BYTES, stream>>>(p);
    kph<8><<<grid, NT, SMEM_BYTES, stream>>>(p);
    kph<9><<<grid, NT, SMEM_BYTES, stream>>>(p);
    kph<10><<<grid, NT, SMEM_BYTES, stream>>>(p);
    kph<11><<<grid, NT, SMEM_BYTES, stream>>>(p);
#endif
}
```

```cpp
#include <hip/hip_runtime.h>
#include <stdint.h>

typedef unsigned short u16;
using bf16x8 = __attribute__((ext_vector_type(8))) short;
using f32x4  = __attribute__((ext_vector_type(4))) float;

#ifndef MEGA
#define MEGA 1
#endif

constexpr int B_ = 4, S_ = 8192, D_ = 1024, NTOK = B_ * S_;
constexpr int CIN = 5144;
constexpr int NCMP = 511;
constexpr int CRW = 1792;
constexpr int NEXP = 32;
constexpr int NT = 512;
constexpr int NW = NT / 64;
constexpr int SMEM_BYTES = 160 * 1024;
constexpr int SCAN_BLOCKS = 16;
#ifndef TPROBE
#define TPROBE 0
#define TPSEL 0
#endif
constexpr float QSCALE = 0.125f * 1.4426950408889634f;

struct P {
    const float* x; const int* pos; const float* g_mix; const float* w_in;
    const float *pe_k, *w1_k, *b1_k, *w2_k, *b2_k, *pe_v, *w1_v, *b1_v, *w2_v, *b2_v;
    const float *mu, *w0, *w2, *a0, *a2, *g2, *k_k, *k_a, *r_k, *ln_w, *ln_b;
    const float *wpa, *wpb, *wout, *g_ffn, *w_grp, *b_grp, *w_exp, *b_exp, *e_w1, *e_w3, *e_w2, *g_final;
    float* out;
    u16* hbuf; u16 *q, *kc, *vc, *ksl, *vslT, *kwn, *vwnT, *kcb, *vcT; float* nsag; u16* prw;
    u16* cdat; float* bon; u16 *w2T, *a2T, *g2T; u16 *oa, *ob; u16* merged; float* x1;
    int* tok_e; float* tok_gate; int* tokslot; int* list_tok; float* list_gate;
    int* counts; int* offs; int* cursor; int* blk_e; int* blk_r0; int* nblk; float* rsb; int* nsactr;
    u16* hid; u16* ybuf; unsigned* bar;
    u16 *winT, *wgT, *wpaT, *wpbT, *woutT, *ew1T, *ew3T, *ew2T;
    u16 *cw1Tk, *cw1Tv, *cw2Tk, *cw2Tv, *chid, *xact; float *cb1k, *cb1v;
};

typedef __bf16 bf16x2_t __attribute__((ext_vector_type(2)));
typedef float f32x2_t __attribute__((ext_vector_type(2)));
__device__ __forceinline__ unsigned pack2(float a, float b) {
    f32x2_t f = {a, b};
    return __builtin_bit_cast(unsigned, __builtin_convertvector(f, bf16x2_t));
}
__device__ __forceinline__ u16 f2bf(float f) { return (u16)(pack2(f, f) & 0xFFFFu); }
__device__ __forceinline__ float bf2f(u16 h) { return __uint_as_float(((unsigned)h) << 16); }
__device__ __forceinline__ float sigmoidf_(float x) { return __builtin_amdgcn_rcpf(1.f + __expf(-x)); }
__device__ __forceinline__ int get_tid() { int t = threadIdx.x; asm volatile("" : "+v"(t)); return t; }
__device__ __forceinline__ uint2 pack4(const f32x4& v) { uint2 o; o.x = pack2(v[0], v[1]); o.y = pack2(v[2], v[3]); return o; }
__device__ __forceinline__ f32x4 unpack4(uint2 u) { return f32x4{__uint_as_float(u.x << 16), __uint_as_float(u.x & 0xFFFF0000u), __uint_as_float(u.y << 16), __uint_as_float(u.y & 0xFFFF0000u)}; }
#define LDS_BARRIER() do { asm volatile("s_waitcnt lgkmcnt(0)" ::: "memory"); __builtin_amdgcn_s_barrier(); asm volatile("" ::: "memory"); } while (0)
__device__ __forceinline__ int opaque(int x) { asm volatile("" : "+v"(x)); return x; }
template <int CTRL>
__device__ __forceinline__ float dppf(float x) { return __int_as_float(__builtin_amdgcn_update_dpp(0, __float_as_int(x), CTRL, 0xF, 0xF, true)); }
__device__ __forceinline__ float wave_sum(float v) {
    v += dppf<0xB1>(v);
    v += dppf<0x4E>(v);
    v += dppf<0x141>(v);
    v += dppf<0x140>(v);
    const int vi = __float_as_int(v);
    return (__int_as_float(__builtin_amdgcn_readlane(vi, 0)) + __int_as_float(__builtin_amdgcn_readlane(vi, 16)))
         + (__int_as_float(__builtin_amdgcn_readlane(vi, 32)) + __int_as_float(__builtin_amdgcn_readlane(vi, 48)));
}

__device__ __forceinline__ float xrow_sum(float v) {
    auto r = __builtin_amdgcn_permlane16_swap(__float_as_uint(v), __float_as_uint(v), false, false);
    v = __uint_as_float(r[0]) + __uint_as_float(r[1]);
    auto r2 = __builtin_amdgcn_permlane32_swap(__float_as_uint(v), __float_as_uint(v), false, false);
    return __uint_as_float(r2[0]) + __uint_as_float(r2[1]);
}
__device__ __forceinline__ float xrow_max(float v) {
    auto r = __builtin_amdgcn_permlane16_swap(__float_as_uint(v), __float_as_uint(v), false, false);
    v = fmaxf(__uint_as_float(r[0]), __uint_as_float(r[1]));
    auto r2 = __builtin_amdgcn_permlane32_swap(__float_as_uint(v), __float_as_uint(v), false, false);
    return fmaxf(__uint_as_float(r2[0]), __uint_as_float(r2[1]));
}
__constant__ double ROPE_FREQ[32] = {
    1.00000000000000000000e+00, 7.49894209332455874417e-01, 5.62341325190349072827e-01, 4.21696503428582225581e-01,
    3.16227766016837941176e-01, 2.37137370566165517349e-01, 1.77827941003892292526e-01, 1.33352143216332402753e-01,
    1.00000000000000005551e-01, 7.49894209332455791150e-02, 5.62341325190349114460e-02, 4.21696503428582239459e-02,
    3.16227766016837913421e-02, 2.37137370566165538166e-02, 1.77827941003892292526e-02, 1.33352143216332406223e-02,
    1.00000000000000002082e-02, 7.49894209332455791150e-03, 5.62341325190349097113e-03, 4.21696503428582291501e-03,
    3.16227766016837939442e-03, 2.37137370566165538166e-03, 1.77827941003892275179e-03, 1.33352143216332406223e-03,
    1.00000000000000002082e-03, 7.49894209332455856203e-04, 5.62341325190349097113e-04, 4.21696503428582237290e-04,
    3.16227766016837939442e-04, 2.37137370566165538166e-04, 1.77827941003892269758e-04, 1.33352143216332395381e-04};

constexpr int G_ABYTES = 256 * 64 * 2, G_BBYTES = 128 * 64 * 2, G_TILE = G_ABYTES + G_BBYTES;
#define LAS3 __attribute__((address_space(3)))
#define GAS1 __attribute__((address_space(1)))
__device__ __forceinline__ void glds16(const u16* g, char* l) {
    __builtin_amdgcn_global_load_lds((const GAS1 unsigned*)g, (LAS3 unsigned*)l, 16, 0, 0);
}
template <bool TR = false, class ARow>
__device__ __forceinline__ void gemm_core(int K, ARow arow, const u16* __restrict__ BT, int ldb, f32x4 (&acc)[4][4], u16* sm) {
    char* base = (char*)sm;
    const int tid = get_tid(), lane = tid & 63, wv = tid >> 6;
    const int wm = wv >> 1, wn = wv & 1, kr = lane & 15, qq = lane >> 4;
    const int lr = tid >> 3, lk = ((tid & 7) ^ ((lr >> 1) & 7)) * 8;
    const u16* ap0 = arow(lr) + lk; const u16* ap1 = arow(lr + 64) + lk;
    const u16* ap2 = arow(lr + 128) + lk; const u16* ap3 = arow(lr + 192) + lk;
    const u16* bp0 = BT + (size_t)lr * ldb + lk; const u16* bp1 = BT + (size_t)(lr + 64) * ldb + lk;
#pragma unroll
    for (int mt = 0; mt < 4; mt++)
#pragma unroll
        for (int nt = 0; nt < 4; nt++) acc[mt][nt] = f32x4{0.f, 0.f, 0.f, 0.f};
    const int nk = K >> 6;
#define G_ISSUE(t, b) { char* d = base + (b) * G_TILE + tid * 16; const int ko = (t) * 64; \
        glds16(ap0 + ko, d); glds16(ap1 + ko, d + 8192); glds16(ap2 + ko, d + 16384); glds16(ap3 + ko, d + 24576); \
        glds16(bp0 + ko, d + G_ABYTES); glds16(bp1 + ko, d + G_ABYTES + 8192); }
    const int sw = kr >> 1;
    const int po0 = ((0 * 4 + qq) ^ sw) * 16, po1 = ((1 * 4 + qq) ^ sw) * 16;
    const int aoff = (wm * 64 + kr) * 128, boff = G_ABYTES + (wn * 64 + kr) * 128;
#define G_READ(FA, FB, b) { const char* Ab = base + (b) * G_TILE + aoff; const char* Bb = base + (b) * G_TILE + boff; \
        _Pragma("unroll") for (int mt = 0; mt < 4; mt++) { FA[0][mt] = *(const bf16x8*)(Ab + mt * 2048 + po0); FA[1][mt] = *(const bf16x8*)(Ab + mt * 2048 + po1); } \
        _Pragma("unroll") for (int nt = 0; nt < 4; nt++) { FB[0][nt] = *(const bf16x8*)(Bb + nt * 2048 + po0); FB[1][nt] = *(const bf16x8*)(Bb + nt * 2048 + po1); } }
#define G_MMA(FA, FB) { __builtin_amdgcn_s_setprio(1); \
        _Pragma("unroll") for (int ks = 0; ks < 2; ks++) \
            _Pragma("unroll") for (int nt = 0; nt < 4; nt++) \
                _Pragma("unroll") for (int mt = 0; mt < 4; mt++) \
                    acc[mt][nt] = TR ? __builtin_amdgcn_mfma_f32_16x16x32_bf16(FA[ks][mt], FB[ks][nt], acc[mt][nt], 0, 0, 0) \
                                     : __builtin_amdgcn_mfma_f32_16x16x32_bf16(FB[ks][nt], FA[ks][mt], acc[mt][nt], 0, 0, 0); \
        __builtin_amdgcn_s_setprio(0); }
    bf16x8 fa0[2][4], fb0[2][4], fa1[2][4], fb1[2][4];
    G_ISSUE(0, 0)
    if (nk > 1) G_ISSUE(1, 1)
    if (nk > 2) G_ISSUE(2, 2)
    if (nk > 2) asm volatile("s_waitcnt vmcnt(12)" ::: "memory");
    else if (nk > 1) asm volatile("s_waitcnt vmcnt(6)" ::: "memory");
    else asm volatile("s_waitcnt vmcnt(0)" ::: "memory");
    __builtin_amdgcn_s_barrier();
    G_READ(fa0, fb0, 0)
    int bnext = 1, bfree = 0;
#define G_STEP(FAC, FBC, FAN, FBN, kt) { \
        if ((kt) + 1 < nk) { \
            if ((kt) + 2 < nk) asm volatile("s_waitcnt vmcnt(6) lgkmcnt(0)" ::: "memory"); else asm volatile("s_waitcnt vmcnt(0) lgkmcnt(0)" ::: "memory"); \
            __builtin_amdgcn_s_barrier();                   \
            if ((kt) + 3 < nk) G_ISSUE((kt) + 3, bfree) \
            G_READ(FAN, FBN, bnext) \
        } \
        G_MMA(FAC, FBC) \
        bfree = bnext; bnext = (bnext == 2) ? 0 : bnext + 1; }
    for (int kt = 0; kt < nk; kt += 2) {
        G_STEP(fa0, fb0, fa1, fb1, kt)
        G_STEP(fa1, fb1, fa0, fb0, kt + 1)
    }
    __builtin_amdgcn_s_barrier();
#undef G_READ
#undef G_MMA
#undef G_STEP
#undef G_ISSUE
}

__device__ __forceinline__ int xcd_item(int bid, int nb, int k, int nitems) {
    if (nb & 7) return bid + k * nb;
    const int per = nb >> 3, chunk = (nitems + 7) >> 3;
    const int j = k * per + (bid >> 3);
    return (j < chunk) ? (bid & 7) * chunk + j : nitems;
}
struct GUnit { int pm, pn; };
constexpr int G8_HTB = 128 * 64 * 2;
__device__ __forceinline__ int g8_lds_byte(int r, int c) { const int st = (r >> 4) * 2 + (c >> 5), rr = r & 15, cc = c & 31, ob = rr * 64 + cc * 2; return st * 1024 + (ob ^ (((ob >> 9) & 1) << 5)); }
__device__ __forceinline__ void g8_stage_rc(int b, int& R, int& C) { const int st = b / 1024, sb = b % 1024, swz = sb ^ (((sb >> 9) & 1) << 5); R = (st >> 1) * 16 + swz / 64; C = (st & 1) * 32 + (swz % 64) / 2; }
__host__ __device__ __forceinline__ int perm32(int rho) { const int n = rho >> 4, i = rho & 15; return 8 * (i >> 2) + 4 * n + (i & 3); }

template <class Epi, class Sched>
__device__ __forceinline__ void gemm256(char* smem, const char* Ab, int K, const Sched& S, const Epi& E) {
    LAS3 unsigned char* lds = (LAS3 unsigned char*)smem;
    const int tid = get_tid(), wid = __builtin_amdgcn_readfirstlane(tid >> 6), lane = tid & 63, wr = wid >> 2, wc = wid & 3, fr = lane & 15, fq = lane >> 4;
    int nt = K >> 6; asm volatile("" : "+s"(nt));
    unsigned voffB[2], voffA[2][2];
#pragma unroll
    for (int i = 0; i < 2; ++i) { int sR, sC; g8_stage_rc(tid * 16 + i * 8192, sR, sC); voffB[i] = (unsigned)(sR * K + sC) * 2u; }
#define G8_AOFFS(un) do { const int t3_ = get_tid(); _Pragma("unroll") for (int i = 0; i < 2; ++i) { int sR, sC; g8_stage_rc(t3_ * 16 + i * 8192, sR, sC); \
        _Pragma("unroll") for (int h = 0; h < 2; ++h) voffA[h][i] = S.a_off(un, h, sR) + (unsigned)sC * 2u; } } while (0)
    const size_t kstep = 128;
    const size_t hstep = (size_t)128 * K * 2;
    const unsigned ldsw = (unsigned)wid * 1024u;
    const int aoff = g8_lds_byte(wr * 64 + fr, fq * 8), boff = g8_lds_byte(wc * 32 + fr, fq * 8);
#define G8_SA(b, h) (((b) * 2 + (h)) * G8_HTB)
#define G8_SB(b, h) ((4 + (b) * 2 + (h)) * G8_HTB)
#define G8_STAGE2(bufoff, gbase, v0, v1) do { \
        __builtin_amdgcn_global_load_lds((const GAS1 unsigned*)((const char*)(gbase) + (v0)), (LAS3 unsigned*)(lds + (bufoff) + ldsw), 16, 0, 0); \
        __builtin_amdgcn_global_load_lds((const GAS1 unsigned*)((const char*)(gbase) + (v1)), (LAS3 unsigned*)(lds + (bufoff) + ldsw + 8192), 16, 0, 0); } while (0)
#define G8_STAGEB(bufoff, gbase) G8_STAGE2(bufoff, gbase, voffB[0], voffB[1])
#define G8_LDA(dst, b, h) do { _Pragma("unroll") for (int m = 0; m < 4; ++m) _Pragma("unroll") for (int k = 0; k < 2; ++k) dst[m][k] = *(const LAS3 bf16x8*)(lds + G8_SA(b, h) + aoff + m * 2048 + k * 1024); } while (0)
#define G8_LDB(dst, b, h) do { _Pragma("unroll") for (int n = 0; n < 2; ++n) _Pragma("unroll") for (int k = 0; k < 2; ++k) dst[n][k] = *(const LAS3 bf16x8*)(lds + G8_SB(b, h) + boff + n * 2048 + k * 1024); } while (0)
#define G8_MMA(ai, bj, At, Bt) do { __builtin_amdgcn_s_setprio(1); _Pragma("unroll") for (int m = 0; m < 4; ++m) _Pragma("unroll") for (int n = 0; n < 2; ++n) _Pragma("unroll") for (int k = 0; k < 2; ++k) \
        acc[ai][bj][m][n] = __builtin_amdgcn_mfma_f32_16x16x32_bf16(Bt[n][k], At[m][k], acc[ai][bj][m][n], 0, 0, 0); __builtin_amdgcn_s_setprio(0); } while (0)
#define G8_WAIT_V(n) asm volatile("s_waitcnt vmcnt(" #n ")" ::: "memory")
#define G8_WAIT_L(n) asm volatile("s_waitcnt lgkmcnt(" #n ")" ::: "memory")
#define G8_BAR __builtin_amdgcn_s_barrier()
#define G8_SCHED __builtin_amdgcn_sched_barrier(0)
    GUnit cur, nxt; int ui = 0;
    if (!S.next(0, cur)) return;
    f32x4 acc[2][2][4][2];
#pragma unroll
    for (int a = 0; a < 2; ++a)
#pragma unroll
        for (int b = 0; b < 2; ++b)
#pragma unroll
            for (int m = 0; m < 4; ++m)
#pragma unroll
                for (int n = 0; n < 2; ++n) acc[a][b][m][n] = (f32x4){0.f, 0.f, 0.f, 0.f};
    bf16x8 At[4][2], B0[2][2], B1[2][2];
    G8_AOFFS(cur);
    const char* cB = S.b_ptr(cur);
    G8_STAGEB(G8_SB(0, 0), cB); G8_STAGE2(G8_SA(0, 0), Ab, voffA[0][0], voffA[0][1]); G8_STAGEB(G8_SB(0, 1), cB + hstep); G8_STAGE2(G8_SA(0, 1), Ab, voffA[1][0], voffA[1][1]);
    if (wr == 1) G8_BAR;
    G8_WAIT_V(4); G8_BAR;
    G8_STAGEB(G8_SB(1, 0), cB + kstep); G8_STAGE2(G8_SA(1, 0), Ab + kstep, voffA[0][0], voffA[0][1]); G8_STAGEB(G8_SB(1, 1), cB + hstep + kstep);
    G8_WAIT_V(6); G8_BAR;
    for (;;) {
        const bool has_next = S.next(ui + 1, nxt);
        const char* nB = has_next ? S.b_ptr(nxt) : cB;
        for (int t = 0; t < nt; t += 2) {
            const bool last = (t == nt - 2);
            const char* a1 = Ab + (size_t)(t + 1) * kstep;
            const unsigned va10 = voffA[1][0], va11 = voffA[1][1];
            if (last && has_next) G8_AOFFS(nxt);
            const char* a2 = last ? Ab : Ab + (size_t)(t + 2) * kstep; const char* b2 = last ? nB : cB + (size_t)(t + 2) * kstep;
            const char* a3 = a2 + kstep; const char* b3 = b2 + kstep;
            G8_LDB(B0, 0, 0); G8_SCHED; G8_LDA(At, 0, 0); G8_STAGE2(G8_SA(1, 1), a1, va10, va11);
            G8_WAIT_L(8); G8_BAR; G8_WAIT_L(0); G8_MMA(0, 0, At, B0); G8_BAR; G8_SCHED;
            G8_LDB(B1, 0, 1); G8_STAGEB(G8_SB(0, 0), b2);
            G8_BAR; G8_WAIT_L(0); G8_MMA(0, 1, At, B1); G8_BAR;
            G8_LDA(At, 0, 1); G8_STAGE2(G8_SA(0, 0), a2, voffA[0][0], voffA[0][1]);
            G8_BAR; G8_WAIT_L(0); G8_MMA(1, 0, At, B0); G8_BAR; G8_SCHED;
            G8_STAGEB(G8_SB(0, 1), b2 + hstep);
            G8_WAIT_V(6); G8_BAR; G8_MMA(1, 1, At, B1); G8_BAR;
            G8_LDB(B0, 1, 0); G8_SCHED; G8_LDA(At, 1, 0); G8_STAGE2(G8_SA(0, 1), a2, voffA[1][0], voffA[1][1]);
            G8_WAIT_L(8); G8_BAR; G8_WAIT_L(0); G8_MMA(0, 0, At, B0); G8_BAR; G8_SCHED;
            G8_LDB(B1, 1, 1); G8_STAGEB(G8_SB(1, 0), b3);
            G8_BAR; G8_WAIT_L(0); G8_MMA(0, 1, At, B1); G8_BAR;
            G8_LDA(At, 1, 1); G8_STAGE2(G8_SA(1, 0), a3, voffA[0][0], voffA[0][1]);
            G8_BAR; G8_WAIT_L(0); G8_MMA(1, 0, At, B0); G8_BAR; G8_SCHED;
            G8_STAGEB(G8_SB(1, 1), b3 + hstep);
            G8_WAIT_V(6); G8_BAR; G8_MMA(1, 1, At, B1); G8_BAR;
        }
        E(acc, cur, wr, wc, fr, fq);
        if (!has_next) break;
#pragma unroll
        for (int a = 0; a < 2; ++a)
#pragma unroll
            for (int b = 0; b < 2; ++b)
#pragma unroll
                for (int m = 0; m < 4; ++m)
#pragma unroll
                    for (int n = 0; n < 2; ++n) acc[a][b][m][n] = (f32x4){0.f, 0.f, 0.f, 0.f};
        cur = nxt; cB = nB; ++ui;
    }
    G8_WAIT_V(0);
    if (wr == 0) G8_BAR;
    G8_BAR;
#undef G8_SA
#undef G8_AOFFS
#undef G8_SB
#undef G8_STAGE2
#undef G8_STAGEB
#undef G8_LDA
#undef G8_LDB
#undef G8_MMA
#undef G8_WAIT_V
#undef G8_WAIT_L
#undef G8_BAR
#undef G8_SCHED
}
struct DenseSched {
    int nM, nN, nwg, G, c, K; const char* Bt;
    __device__ __forceinline__ void init(int M, int N, int K_, const void* Bt_, int G_, int c_) { nM = M >> 8; nN = N >> 8; nwg = nM * nN; G = G_; c = c_; K = K_; Bt = (const char*)Bt_; }
    __device__ __forceinline__ bool next(int i, GUnit& u) const {
        const int L = i * G + c; if (L >= nwg) return false;
        int wgid = L; { const int q = nwg >> 3, r = nwg & 7, xcd = wgid & 7, off = wgid >> 3; wgid = (xcd < r ? xcd * (q + 1) : r * (q + 1) + (xcd - r) * q) + off; }
        const int nig = 8 * nN, gid = wgid / nig, fm = gid * 8, gsz = (nM - fm) < 8 ? (nM - fm) : 8, w = wgid - gid * nig;
        u.pn = w / gsz; u.pm = fm + (w - u.pn * gsz); return true;
    }
    __device__ __forceinline__ unsigned a_off(const GUnit& u, int h, int R) const { return (unsigned)((u.pm * 256 + h * 128 + R) * K) * 2u; }
    __device__ __forceinline__ const char* b_ptr(const GUnit& u) const { return Bt + (size_t)u.pn * 256 * K * 2; }
};

template <class SRC>
__device__ __forceinline__ void convert_wT(const float* __restrict__ W, int K, int N, u16* __restrict__ WT, int rows, SRC src, int gtid, int gnt) {
    const int kch = K >> 3;
    const int total = rows * kch;
    for (int i0 = gtid; i0 < total; i0 += 4 * gnt) {
        float f[4][8]; int sc[4];
#pragma unroll
        for (int u = 0; u < 4; u++) {
            const int i = i0 + u * gnt;
            sc[u] = -1;
            if (i < total) {
                const int kc = i / rows, j = i - kc * rows;
                sc[u] = src(j);
                if (sc[u] >= 0) {
                    const float* wp = W + (size_t)(kc * 8) * N + sc[u];
#pragma unroll
                    for (int q = 0; q < 8; q++) f[u][q] = wp[(size_t)q * N];
                }
            }
        }
#pragma unroll
        for (int u = 0; u < 4; u++) {
            const int i = i0 + u * gnt;
            if (i < total) {
                const int kc = i / rows, j = i - kc * rows;
                uint4 v = make_uint4(0u, 0u, 0u, 0u);
                if (sc[u] >= 0) { v.x = pack2(f[u][0], f[u][1]); v.y = pack2(f[u][2], f[u][3]); v.z = pack2(f[u][4], f[u][5]); v.w = pack2(f[u][6], f[u][7]); }
                *(uint4*)&WT[(size_t)j * K + kc * 8] = v;
            }
        }
    }
}

__device__ void ph_prologue(const P& p, int bid, int nb, char* smem) {
    const int tid = get_tid(), lane = tid & 63, wv = tid >> 6;
    if (bid >= 1 && bid <= 64) {
        const int j = tid & 255; const bool isv = tid >= 256;
        const float* pe = isv ? p.pe_v : p.pe_k; const float* w1 = isv ? p.w1_v : p.w1_k;
        const int kb = (bid - 1) * 32;
        float a0 = 0.f, a1 = 0.f;
#pragma unroll 4
        for (int k = kb; k < kb + 32; k += 2) { a0 += pe[k] * w1[(size_t)k * 256 + j]; a1 += pe[k + 1] * w1[(size_t)(k + 1) * 256 + j]; }
        p.cb1k[(bid - 1) * 512 + (isv ? 256 : 0) + j] = a0 + a1;
    }
    if (bid == 0) {
        if (tid < 32) { p.counts[tid] = 0; p.cursor[tid] = 0; }
        if (tid == 32) *p.nsactr = 0;
        for (int i = tid; i < 8 * 64; i += NT) {
            const int bg = i >> 6, d = i & 63;
            p.kcb[((size_t)bg * 512 + 511) * 64 + d] = 0;
            p.vcT[(((size_t)bg * 8 + 7) * 64 + d) * 64 + 63] = 0;
        }
    }
    {
        const int gtid = bid * NT + tid, gnt = nb * NT;
        convert_wT(p.w_in, D_, CIN, p.winT, 3328, [](int j) {
            const int t = j >> 8, s = j & 255;
            if (t < 5) {
                const int bj = s >> 7, wc = (s >> 5) & 3, n = (s >> 4) & 1, i = s & 15;
                const int dim = 32 * bj + 8 * (i >> 2) + 4 * n + (i & 3), hq = 4 * t + wc;
                int hb;
                if (hq < 8) hb = 64 * hq;
                else { const int k = (hq - 8) >> 1; hb = (k == 0 ? 512 : (k == 1 ? 640 : (k == 2 ? 768 : (k == 3 ? 1024 : (k == 4 ? 896 : 1152))))) + 64 * (hq & 1); }
                return hb + dim;
            }
            const int c = (s & ~31) + perm32(s & 31);
            if (t < 12) return 1304 + (t - 5) * 256 + c;
            return c < 24 ? 1280 + c : -1; }, gtid, gnt);
        convert_wT(p.w_in, D_, CIN, p.wgT, 2048, [](int j) { return 3096 + (j & ~31) + perm32(j & 31); }, gtid, gnt);
        convert_wT(p.wpa, 512, D_, p.wpaT, 1024, [](int j) { return (j & ~31) + perm32(j & 31); }, gtid, gnt);
        convert_wT(p.wpb, 512, D_, p.wpbT, 1024, [](int j) { return (j & ~31) + perm32(j & 31); }, gtid, gnt);
        convert_wT(p.wout, D_, D_, p.woutT, 1024, [](int j) { return j; }, gtid, gnt);
        convert_wT(p.w2, 64, 512, p.w2T, 512, [](int j) { return j; }, gtid, gnt);
        convert_wT(p.w1_k, 2048, 256, p.cw1Tk, 256, [](int j) { return j; }, gtid, gnt);
        convert_wT(p.w1_v, 2048, 256, p.cw1Tv, 256, [](int j) { return j; }, gtid, gnt);
        convert_wT(p.w2_k, 256, 64, p.cw2Tk, 128, [](int j) { return j < 64 ? j : -1; }, gtid, gnt);
        convert_wT(p.w2_v, 256, 64, p.cw2Tv, 128, [](int j) { return j < 64 ? j : -1; }, gtid, gnt);
        convert_wT(p.a2, 64, 512, p.a2T, 512, [](int j) { return j; }, gtid, gnt);
        convert_wT(p.g2, 128, 512, p.g2T, 512, [](int j) { return j; }, gtid, gnt);
    }
    for (int row = bid * NW + wv; row < NTOK; row += nb * NW) {
        const float* xr = p.x + (size_t)row * D_;
        float v[16];
        float ss = 0.f;
#pragma unroll
        for (int i = 0; i < 4; i++) {
            float4 t = *(const float4*)&xr[i * 256 + lane * 4];
            v[4 * i] = t.x; v[4 * i + 1] = t.y; v[4 * i + 2] = t.z; v[4 * i + 3] = t.w;
            ss += t.x * t.x + t.y * t.y + t.z * t.z + t.w * t.w;
        }
        ss = wave_sum(ss);
        const float rs = rsqrtf(ss * (1.f / D_) + 1e-6f);
#pragma unroll
        for (int i = 0; i < 4; i++) {
            const int c = i * 256 + lane * 4;
            float4 g = *(const float4*)&p.g_mix[c];
            uint2 o;
            o.x = pack2(v[4 * i] * rs * g.x, v[4 * i + 1] * rs * g.y);
            o.y = pack2(v[4 * i + 2] * rs * g.z, v[4 * i + 3] * rs * g.w);
            *(uint2*)&p.hbuf[(size_t)row * D_ + c] = o;
        }
    }
}

__device__ __forceinline__ uint4 pack8(const f32x4& a, const f32x4& b) { uint4 o; o.x = pack2(a[0], a[1]); o.y = pack2(a[2], a[3]); o.z = pack2(b[0], b[1]); o.w = pack2(b[2], b[3]); return o; }
struct EpiInproj {
    const P* pp;
    __device__ __forceinline__ void operator()(const f32x4 (&acc)[2][2][4][2], const GUnit& u, int, int, int, int) const {
        const int t2_ = get_tid(), wid_ = __builtin_amdgcn_readfirstlane(t2_ >> 6), wr = wid_ >> 2, wc = wid_ & 3, fr = t2_ & 15, fq = (t2_ >> 4) & 3;
        const P& p = *pp;
        const int pn = u.pn;
        const int rowb = u.pm * 256 + wr * 64;
        if (pn < 4) {
            const int hq = 4 * pn + wc;
            const bool rope = !(pn == 2 && wc >= 2);
            u16* dst; size_t rstride; int cofs;
            if (pn < 2) { dst = p.q; rstride = 512; cofs = hq * 64; }
            else { dst = (pn == 2) ? (wc < 2 ? p.kc : p.vc) : (wc < 2 ? p.ksl : p.kwn); rstride = 64; cofs = 0; }
            const int g = wc & 1;
#pragma unroll
            for (int ai = 0; ai < 2; ++ai)
#pragma unroll
                for (int m = 0; m < 4; ++m) {
                    const int row = rowb + ai * 128 + m * 16 + fr;
                    f32x4 o1[2], o2[2];
#pragma unroll
                    for (int n = 0; n < 2; ++n) { o1[n] = acc[ai][0][m][n]; o2[n] = acc[ai][1][m][n]; }
                    if (rope) {
                        const double posd = (double)p.pos[row];
#pragma unroll
                        for (int n = 0; n < 2; ++n)
#pragma unroll
                            for (int j = 0; j < 4; ++j) {
                                const double tr = posd * ROPE_FREQ[8 * fq + 4 * n + j] * 0.15915494309189535;
                                const float fr_ = (float)(tr - rint(tr));
                                const float cs = __builtin_amdgcn_cosf(fr_), sn = __builtin_amdgcn_sinf(fr_);
                                const float x1 = o1[n][j], x2 = o2[n][j];
                                o1[n][j] = x1 * cs - x2 * sn; o2[n][j] = x1 * sn + x2 * cs;
                            }
                    }
                    size_t ro;
                    if (pn < 2) {
#pragma unroll
                        for (int n = 0; n < 2; ++n)
#pragma unroll
                            for (int j = 0; j < 4; ++j) { o1[n][j] *= QSCALE; o2[n][j] *= QSCALE; }
                        ro = (size_t)row * 512 + cofs + 8 * fq;
                    } else {
                        const int bb = row >> 13, t = row & (S_ - 1);
                        ro = ((size_t)(bb * 2 + g) * S_ + t) * 64 + 8 * fq;
                    }
                    *(uint4*)&dst[ro] = pack8(o1[0], o1[1]);
                    *(uint4*)&dst[ro + 32] = pack8(o2[0], o2[1]);
                }
        } else if (pn == 4) {
            u16* dst = (wc < 2) ? p.vslT : p.vwnT;
            const int g = wc & 1;
#pragma unroll
            for (int ai = 0; ai < 2; ++ai) {
                const int r0 = rowb + ai * 128, bb = r0 >> 13, tb = r0 & (S_ - 1);
                u16* base = dst + ((size_t)(bb * 2 + g) * 128 + (tb >> 6)) * 4096;
#pragma unroll
                for (int m = 0; m < 4; ++m)
#pragma unroll
                    for (int bj = 0; bj < 2; ++bj)
#pragma unroll
                        for (int n = 0; n < 2; ++n)
#pragma unroll
                            for (int j = 0; j < 4; ++j)
                                base[(32 * bj + 8 * fq + 4 * n + j) * 64 + m * 16 + fr] = f2bf(acc[ai][bj][m][n][j]);
            }
        } else if (pn < 12) {
            const int cb = (pn - 5) * 256 + wc * 32 + 8 * fq;
#pragma unroll
            for (int ai = 0; ai < 2; ++ai)
#pragma unroll
                for (int m = 0; m < 4; ++m) {
                    const size_t ro = (size_t)(rowb + ai * 128 + m * 16 + fr) * CRW + cb;
#pragma unroll
                    for (int bj = 0; bj < 2; ++bj) *(uint4*)&p.prw[ro + bj * 128] = pack8(acc[ai][bj][m][0], acc[ai][bj][m][1]);
                }
        } else {
            if (wc == 0 && fq < 3) {
#pragma unroll
                for (int ai = 0; ai < 2; ++ai)
#pragma unroll
                    for (int m = 0; m < 4; ++m) {
                        const size_t ro = (size_t)(rowb + ai * 128 + m * 16 + fr) * 24 + 8 * fq;
#pragma unroll
                        for (int n = 0; n < 2; ++n) {
                            float4 o; o.x = sigmoidf_(acc[ai][0][m][n][0]); o.y = sigmoidf_(acc[ai][0][m][n][1]); o.z = sigmoidf_(acc[ai][0][m][n][2]); o.w = sigmoidf_(acc[ai][0][m][n][3]);
                            *(float4*)&p.nsag[ro + 4 * n] = o;
                        }
                    }
            }
        }
    }
};
__device__ void ph_inproj(const P& p, int bid, int nb, char* smem) {
    DenseSched S; S.init(NTOK, 3328, D_, p.winT, nb, bid);
    EpiInproj E{&p};
    gemm256(smem, (const char*)p.hbuf, D_, S, E);
}

__device__ __forceinline__ float gelu_tanh(float x) {
    const float c = 0.7978845608028654f;
    return 0.5f * x * (1.f + tanhf(c * (x + 0.044715f * x * x * x)));
}
__device__ void ph_compress(const P& p, int bid, int nb, char* smem) {
    u16* sm = (u16*)smem;
    const int tid = get_tid(), lane = tid & 63, wv = tid >> 6;
    const int wm = wv >> 1, wn = wv & 1;
    for (int it = bid; it < 32; it += nb) {
        const int rt = it & 1, g = (it >> 1) & 1, b = (it >> 2) & 3, kv = it >> 4;
        const int bg = b * 2 + g, i0 = rt * 256;
        const u16* src = (kv ? p.vc : p.kc) + (size_t)bg * S_ * 64;
        const u16* w1T = kv ? p.cw1Tv : p.cw1Tk;
        const u16* w2T = kv ? p.cw2Tv : p.cw2Tk;
        float* cb1 = (float*)(smem + 3 * G_TILE);
        __syncthreads();
        { const int t2 = get_tid(); if (t2 < 256) { float a = 0.f; for (int q = 0; q < 64; q++) a += p.cb1k[q * 512 + kv * 256 + t2]; cb1[t2] = a; } }
        __syncthreads();
        const float* b1 = kv ? p.b1_v : p.b1_k;
        const float* b2 = kv ? p.b2_v : p.b2_k;
        u16* hidp = p.chid + (size_t)it * 256 * 256;
        auto arow = [&](int r) { int i = i0 + r; if (i > 510) i = 510; return src + (size_t)i * 1024; };
#pragma unroll 1
        for (int ct = 0; ct < 2; ct++) {
            f32x4 acc[4][4];
            gemm_core<false>(2048, arow, w1T + (size_t)ct * 128 * 2048, 2048, acc, sm);
            const int le = get_tid() & 63;
#pragma unroll
            for (int mt = 0; mt < 4; mt++) {
                const int r = wm * 64 + mt * 16 + (le & 15);
#pragma unroll
                for (int nt = 0; nt < 4; nt++) {
                    const int col = ct * 128 + wn * 64 + nt * 16 + (le >> 4) * 4;
                    const float4 c1 = *(const float4*)&cb1[col], bb1 = *(const float4*)&b1[col];
                    f32x4 o;
                    o[0] = gelu_tanh(acc[mt][nt][0] + c1.x + bb1.x); o[1] = gelu_tanh(acc[mt][nt][1] + c1.y + bb1.y);
                    o[2] = gelu_tanh(acc[mt][nt][2] + c1.z + bb1.z); o[3] = gelu_tanh(acc[mt][nt][3] + c1.w + bb1.w);
                    *(uint2*)&hidp[r * 256 + col] = pack4(o);
                }
            }
        }
        __syncthreads();
        {
            f32x4 acc[4][4];
            gemm_core<true>(256, [&](int r) { return hidp + (size_t)r * 256; }, w2T, 256, acc, sm);
            if (wn == 0) {
#pragma unroll
                for (int mt = 0; mt < 4; mt++)
#pragma unroll
                    for (int nt = 0; nt < 4; nt++) {
                        const int d = nt * 16 + (lane & 15);
                        const int ib = i0 + wm * 64 + mt * 16 + (lane >> 4) * 4;
                        float o[4];
#pragma unroll
                        for (int j = 0; j < 4; j++) o[j] = (ib + j < NCMP) ? (acc[mt][nt][j] + b2[d]) : 0.f;
                        if (kv == 0) {
#pragma unroll
                            for (int j = 0; j < 4; j++) p.kcb[((size_t)bg * 512 + ib + j) * 64 + d] = f2bf(o[j]);
                        } else {
                            uint2 ov; ov.x = pack2(o[0], o[1]); ov.y = pack2(o[2], o[3]);
                            *(uint2*)&p.vcT[(((size_t)bg * 8 + (ib >> 6)) * 64 + d) * 64 + (ib & 63)] = ov;
                        }
                    }
            }
        }
        __syncthreads();
    }
}

#ifndef NSAPROBE
#define NSAPROBE 0
#endif
#define NSA_TS(k) if (NSAPROBE == k) ts_ = __builtin_amdgcn_s_memrealtime();
#define NSA_TE(k) if (NSAPROBE == k) tacc_ += __builtin_amdgcn_s_memrealtime() - ts_;
constexpr int KSTR = 72;
struct Sub { f32x4 O[4]; float m, l; };
#define NEG_BIG (-1.0e30f)

__device__ __forceinline__ float xq_max(float v) {
    return xrow_max(v);
}
__device__ __forceinline__ float xq_sum(float v) {
    return xrow_sum(v);
}
typedef unsigned u32x2 __attribute__((ext_vector_type(2)));
union VF { bf16x8 v; u32x2 h[2]; };
template <int OFF> __device__ __forceinline__ u32x2 lds_read_b64(unsigned addr) { u32x2 r; asm volatile("ds_read_b64 %0, %1 offset:%2" : "=v"(r) : "v"(addr), "n"(OFF)); return r; }
#define NSA_LDV_ASM(vf, Vs, kr, qq, swz) { const unsigned va_ = (unsigned)(size_t)(const LAS3 char*)((const char*)(Vs) + (kr) * 128 + ((qq) & 1) * 8); const int vo_ = (((qq) >> 1) ^ (swz)) << 4; \
        const unsigned a0_ = va_ + vo_, a1_ = va_ + (vo_ ^ 32), a2_ = va_ + (vo_ ^ 64), a3_ = va_ + (vo_ ^ 96); \
        vf[0][0].h[0] = lds_read_b64<0>(a0_);    vf[0][0].h[1] = lds_read_b64<0>(a1_);    vf[0][1].h[0] = lds_read_b64<0>(a2_);    vf[0][1].h[1] = lds_read_b64<0>(a3_); \
        vf[1][0].h[0] = lds_read_b64<2048>(a0_); vf[1][0].h[1] = lds_read_b64<2048>(a1_); vf[1][1].h[0] = lds_read_b64<2048>(a2_); vf[1][1].h[1] = lds_read_b64<2048>(a3_); \
        vf[2][0].h[0] = lds_read_b64<4096>(a0_); vf[2][0].h[1] = lds_read_b64<4096>(a1_); vf[2][1].h[0] = lds_read_b64<4096>(a2_); vf[2][1].h[1] = lds_read_b64<4096>(a3_); \
        vf[3][0].h[0] = lds_read_b64<6144>(a0_); vf[3][0].h[1] = lds_read_b64<6144>(a1_); vf[3][1].h[0] = lds_read_b64<6144>(a2_); vf[3][1].h[1] = lds_read_b64<6144>(a3_); }
#define NSA_VWAIT(vf) asm volatile("s_waitcnt lgkmcnt(0)" : "+v"(vf[0][0].v), "+v"(vf[0][1].v), "+v"(vf[1][0].v), "+v"(vf[1][1].v), "+v"(vf[2][0].v), "+v"(vf[2][1].v), "+v"(vf[3][0].v), "+v"(vf[3][1].v) :: "memory")
template <bool MASK, bool IMP, bool PV>
__device__ __forceinline__ void nsa_visit(const u16* Ks, const u16* Vs, const u16* qrow, Sub& s, int lo, int hi, int lane, float* e, float* p3) {
    const int kr = lane & 15, qq = lane >> 4;
    f32x4 S[4];
    const int qsw = ((kr & 3) >> 1) ^ ((kr >> 2) << 1);
    const bf16x8 qf0 = *(const bf16x8*)(qrow + ((qq ^ qsw) << 3)), qf1 = *(const bf16x8*)(qrow + (((4 + qq) ^ qsw) << 3));
    bf16x8 kf[4][2];
    const int swz = kr >> 1;
    {
        const char* kb_ = (const char*)Ks + kr * 128;
        const int ko0 = (qq ^ swz) << 4, ko1 = ko0 ^ 64;
#pragma unroll
        for (int kt = 0; kt < 4; kt++) { kf[kt][0] = *(const bf16x8*)(kb_ + kt * 2048 + ko0); kf[kt][1] = *(const bf16x8*)(kb_ + kt * 2048 + ko1); }
    }
    __builtin_amdgcn_sched_barrier(0);
#pragma unroll
    for (int kt = 0; kt < 4; kt++) {
        S[kt] = __builtin_amdgcn_mfma_f32_16x16x32_bf16(kf[kt][0], qf0, f32x4{0.f, 0.f, 0.f, 0.f}, 0, 0, 0);
        S[kt] = __builtin_amdgcn_mfma_f32_16x16x32_bf16(kf[kt][1], qf1, S[kt], 0, 0, 0);
    }
    float mx = NEG_BIG;
#pragma unroll
    for (int kt = 0; kt < 4; kt++)
#pragma unroll
        for (int r = 0; r < 4; r++) {
            if (MASK) { const int o = kt * 16 + qq * 4 + r; if (o < lo || o > hi) S[kt][r] = -INFINITY; }
            mx = fmaxf(mx, S[kt][r]);
        }
    mx = xq_max(mx);
    const float mnew = fmaxf(s.m, mx);
    const float alpha = __builtin_amdgcn_exp2f(s.m - mnew);
    s.m = mnew;
    float psum = 0.f;
#pragma unroll
    for (int kt = 0; kt < 4; kt++) {
#pragma unroll
        for (int r = 0; r < 4; r++) { S[kt][r] = __builtin_amdgcn_exp2f(S[kt][r] - mnew); }
        const float ee = (S[kt][0] + S[kt][1]) + (S[kt][2] + S[kt][3]);
        psum += ee;
        if (IMP) { e[kt] = ee; p3[kt] = S[kt][3]; }
    }
    s.l = s.l * alpha + psum;
    if (PV) {
        if (!__all(alpha == 1.f)) {
#pragma unroll
            for (int dt = 0; dt < 4; dt++)
#pragma unroll
                for (int r = 0; r < 4; r++) s.O[dt][r] *= alpha;
        }
        VF vf[4][2];
        NSA_LDV_ASM(vf, Vs, kr, qq, swz)
        bf16x8 pb[2];
#pragma unroll
        for (int k2 = 0; k2 < 2; k2++) {
            union { bf16x8 v; unsigned u[4]; } t;
            t.u[0] = pack2(S[2 * k2][0], S[2 * k2][1]); t.u[1] = pack2(S[2 * k2][2], S[2 * k2][3]);
            t.u[2] = pack2(S[2 * k2 + 1][0], S[2 * k2 + 1][1]); t.u[3] = pack2(S[2 * k2 + 1][2], S[2 * k2 + 1][3]);
            pb[k2] = t.v;
        }
        NSA_VWAIT(vf);
        __builtin_amdgcn_sched_barrier(0);
#pragma unroll
        for (int dt = 0; dt < 4; dt++)
#pragma unroll
            for (int k2 = 0; k2 < 2; k2++) s.O[dt] = __builtin_amdgcn_mfma_f32_16x16x32_bf16(vf[dt][k2].v, pb[k2], s.O[dt], 0, 0, 0);
    }
}
template <bool IMP, bool PV>
__device__ __forceinline__ void nsa_visit2(const u16* Ks, const u16* Vs, const u16* qrow0, const u16* qrow1, Sub (&st)[2], const int (&hi)[2], int lane, float (&e)[2][4], float (&p3)[2][4]) {
    const int kr = lane & 15, qq = lane >> 4;
    const int qsw = ((kr & 3) >> 1) ^ ((kr >> 2) << 1);
    bf16x8 qf0[2], qf1[2];
    qf0[0] = *(const bf16x8*)(qrow0 + ((qq ^ qsw) << 3)); qf1[0] = *(const bf16x8*)(qrow0 + (((4 + qq) ^ qsw) << 3));
    qf0[1] = *(const bf16x8*)(qrow1 + ((qq ^ qsw) << 3)); qf1[1] = *(const bf16x8*)(qrow1 + (((4 + qq) ^ qsw) << 3));
    bf16x8 kf[4][2];
    const int swz = kr >> 1;
    {
        const char* kb_ = (const char*)Ks + kr * 128;
        const int ko0 = (qq ^ swz) << 4, ko1 = ko0 ^ 64;
#pragma unroll
        for (int kt = 0; kt < 4; kt++) { kf[kt][0] = *(const bf16x8*)(kb_ + kt * 2048 + ko0); kf[kt][1] = *(const bf16x8*)(kb_ + kt * 2048 + ko1); }
    }
    __builtin_amdgcn_sched_barrier(0);
    f32x4 S[2][4];
#pragma unroll
    for (int kt = 0; kt < 4; kt++)
#pragma unroll
        for (int q = 0; q < 2; q++) {
            S[q][kt] = __builtin_amdgcn_mfma_f32_16x16x32_bf16(kf[kt][0], qf0[q], f32x4{0.f, 0.f, 0.f, 0.f}, 0, 0, 0);
            S[q][kt] = __builtin_amdgcn_mfma_f32_16x16x32_bf16(kf[kt][1], qf1[q], S[q][kt], 0, 0, 0);
        }
    VF vf[4][2];
    bf16x8 pb[2][2];
#pragma unroll
    for (int q = 0; q < 2; q++) {
        Sub& s = st[q];
        float mx = NEG_BIG;
#pragma unroll
        for (int kt = 0; kt < 4; kt++)
#pragma unroll
            for (int r = 0; r < 4; r++) {
                const int o = kt * 16 + qq * 4 + r; if (o > hi[q]) S[q][kt][r] = -INFINITY;
                mx = fmaxf(mx, S[q][kt][r]);
            }
        mx = xq_max(mx);
        const float mnew = fmaxf(s.m, mx);
        const float alpha = __builtin_amdgcn_exp2f(s.m - mnew);
        s.m = mnew;
        float psum = 0.f;
#pragma unroll
        for (int kt = 0; kt < 4; kt++) {
#pragma unroll
            for (int r = 0; r < 4; r++) { S[q][kt][r] = __builtin_amdgcn_exp2f(S[q][kt][r] - mnew); }
            const float ee = (S[q][kt][0] + S[q][kt][1]) + (S[q][kt][2] + S[q][kt][3]);
            psum += ee;
            if (IMP) { e[q][kt] = ee; p3[q][kt] = S[q][kt][3]; }
        }
        s.l = s.l * alpha + psum;
        if (PV) {
#pragma unroll
            for (int dt = 0; dt < 4; dt++)
#pragma unroll
                for (int r = 0; r < 4; r++) s.O[dt][r] *= alpha;
#pragma unroll
            for (int k2 = 0; k2 < 2; k2++) {
                union { bf16x8 v; unsigned u[4]; } t;
                t.u[0] = pack2(S[q][2 * k2][0], S[q][2 * k2][1]); t.u[1] = pack2(S[q][2 * k2][2], S[q][2 * k2][3]);
                t.u[2] = pack2(S[q][2 * k2 + 1][0], S[q][2 * k2 + 1][1]); t.u[3] = pack2(S[q][2 * k2 + 1][2], S[q][2 * k2 + 1][3]);
                pb[q][k2] = t.v;
            }
            if (q == 0) NSA_LDV_ASM(vf, Vs, kr, qq, swz)
        }
    }
    if (PV) {
        NSA_VWAIT(vf);
        __builtin_amdgcn_sched_barrier(0);
#pragma unroll
        for (int dt = 0; dt < 4; dt++)
#pragma unroll
            for (int k2 = 0; k2 < 2; k2++)
#pragma unroll
                for (int q = 0; q < 2; q++) st[q].O[dt] = __builtin_amdgcn_mfma_f32_16x16x32_bf16(vf[dt][k2].v, pb[q][k2], st[q].O[dt], 0, 0, 0);
    }
}
template <int MMODE, bool FIXM, int NQ>
__device__ __forceinline__ void nsa_visit_gn(const u16* Ks, const u16* Vs, const u16* qs, float* Os, float* Ms, float* Ls, const int (&tok)[NQ], const bool (&valid)[NQ], int lane) {
    const int kr = lane & 15, qq = lane >> 4, hh = kr & 3;
    int row[NQ], osw[NQ]; float* orow[NQ];
    f32x4 O[NQ][4]; float m_old[NQ], l_old[NQ]; bf16x8 qf0[NQ], qf1[NQ];
#pragma unroll
    for (int q = 0; q < NQ; q++) {
        row[q] = tok[q] * 4 + hh; orow[q] = Os + row[q] * 64;
        osw[q] = hh ^ ((tok[q] & 3) << 2);
#pragma unroll
        for (int dt = 0; dt < 4; dt++) O[q][dt] = *(const f32x4*)(orow[q] + (((dt * 4 + qq) ^ osw[q]) << 2));
        m_old[q] = Ms[row[q]]; l_old[q] = Ls[row[q]];
        const u16* qrow = qs + row[q] * 64;
        const int qsw = (hh >> 1) ^ ((tok[q] & 3) << 1);
        qf0[q] = *(const bf16x8*)(qrow + ((qq ^ qsw) << 3)); qf1[q] = *(const bf16x8*)(qrow + (((4 + qq) ^ qsw) << 3));
    }
    bf16x8 kf[4][2];
    const int swz = kr >> 1;
    {
        const char* kb_ = (const char*)Ks + kr * 128;
        const int ko0 = (qq ^ swz) << 4, ko1 = ko0 ^ 64;
#pragma unroll
        for (int kt = 0; kt < 4; kt++) { kf[kt][0] = *(const bf16x8*)(kb_ + kt * 2048 + ko0); kf[kt][1] = *(const bf16x8*)(kb_ + kt * 2048 + ko1); }
    }
    __builtin_amdgcn_sched_barrier(0);
    f32x4 S[NQ][4];
#pragma unroll
    for (int kt = 0; kt < 4; kt++)
#pragma unroll
        for (int q = 0; q < NQ; q++) {
            S[q][kt] = __builtin_amdgcn_mfma_f32_16x16x32_bf16(kf[kt][0], qf0[q], f32x4{0.f, 0.f, 0.f, 0.f}, 0, 0, 0);
            S[q][kt] = __builtin_amdgcn_mfma_f32_16x16x32_bf16(kf[kt][1], qf1[q], S[q][kt], 0, 0, 0);
        }
    VF vf[4][2];
#define NSA_LDV NSA_LDV_ASM(vf, Vs, kr, qq, swz)
    if (NQ == 1) NSA_LDV
    bf16x8 pb[NQ][2];
#pragma unroll
    for (int q = 0; q < NQ; q++) {
        float mx = NEG_BIG;
#pragma unroll
        for (int kt = 0; kt < 4; kt++)
#pragma unroll
            for (int r = 0; r < 4; r++) {
                if (MMODE == 1) { const int o = kt * 16 + qq * 4 + r; if (o > tok[q]) S[q][kt][r] = -INFINITY; }
                if (MMODE == 2) { const int o = kt * 16 + qq * 4 + r; if (o <= tok[q]) S[q][kt][r] = -INFINITY; }
                if (FIXM) { if (!valid[q]) S[q][kt][r] = -INFINITY; } else mx = fmaxf(mx, S[q][kt][r]);
            }
        float mnew = m_old[q], alpha = 1.f;
        if (!FIXM) {
            if (!valid[q]) mx = NEG_BIG;
            mx = xq_max(mx);
            mnew = fmaxf(m_old[q], mx);
            alpha = __builtin_amdgcn_exp2f(m_old[q] - mnew);
        }
        float psum = 0.f;
#pragma unroll
        for (int kt = 0; kt < 4; kt++) {
#pragma unroll
            for (int r = 0; r < 4; r++) { S[q][kt][r] = __builtin_amdgcn_exp2f(S[q][kt][r] - mnew); }
            psum += (S[q][kt][0] + S[q][kt][1]) + (S[q][kt][2] + S[q][kt][3]);
        }
        psum = xq_sum(psum);
        if (FIXM) { if (valid[q] && qq == 0) Ls[row[q]] = l_old[q] + psum; }
        else {
            if (valid[q] && qq == 0) { Ms[row[q]] = mnew; Ls[row[q]] = l_old[q] * alpha + psum; }
#pragma unroll
            for (int dt = 0; dt < 4; dt++)
#pragma unroll
                for (int r = 0; r < 4; r++) O[q][dt][r] *= alpha;
        }
#pragma unroll
        for (int k2 = 0; k2 < 2; k2++) {
            union { bf16x8 v; unsigned u[4]; } t;
            t.u[0] = pack2(S[q][2 * k2][0], S[q][2 * k2][1]); t.u[1] = pack2(S[q][2 * k2][2], S[q][2 * k2][3]);
            t.u[2] = pack2(S[q][2 * k2 + 1][0], S[q][2 * k2 + 1][1]); t.u[3] = pack2(S[q][2 * k2 + 1][2], S[q][2 * k2 + 1][3]);
            pb[q][k2] = t.v;
        }
        if (NQ == 2 && q == 0) { asm volatile("" ::: "memory"); NSA_LDV }
    }
#undef NSA_LDV
    NSA_VWAIT(vf);
    __builtin_amdgcn_sched_barrier(0);
#pragma unroll
    for (int dt = 0; dt < 4; dt++)
#pragma unroll
        for (int k2 = 0; k2 < 2; k2++)
#pragma unroll
            for (int q = 0; q < NQ; q++) O[q][dt] = __builtin_amdgcn_mfma_f32_16x16x32_bf16(vf[dt][k2].v, pb[q][k2], O[q][dt], 0, 0, 0);
#pragma unroll
    for (int q = 0; q < NQ; q++)
        if (valid[q]) {
#pragma unroll
            for (int dt = 0; dt < 4; dt++) *(f32x4*)(orow[q] + (((dt * 4 + qq) ^ osw[q]) << 2)) = O[q][dt];
        }
}
template <int MMODE, bool FIXM>
__device__ __forceinline__ void nsa_visit_g(const u16* Ks, const u16* Vs, const u16* qs, float* Os, float* Ms, float* Ls, int tok, bool valid, int lane) {
    const int tk[1] = {tok}; const bool vl[1] = {valid};
    nsa_visit_gn<MMODE, FIXM, 1>(Ks, Vs, qs, Os, Ms, Ls, tk, vl, lane);
}
__device__ __forceinline__ void nsa_fold_lds(float* Os, float* Ms, float* Ls, int row, int qq, int hh, f32x4 (&T)[4], float gate, bool reset) {
    const float lt = Ls[row];
    const float sc = (lt > 0.f) ? gate / lt : 0.f;
#pragma unroll
    for (int dt = 0; dt < 4; dt++) {
        float* op = Os + row * 64 + (((dt * 4 + qq) ^ hh ^ (((row >> 2) & 3) << 2)) << 2);
        const f32x4 o = *(const f32x4*)op;
#pragma unroll
        for (int r = 0; r < 4; r++) T[dt][r] += o[r] * sc;
        if (reset) *(f32x4*)op = f32x4{0.f, 0.f, 0.f, 0.f};
    }
    asm volatile("s_waitcnt lgkmcnt(0)" ::: "memory");
    if (reset && qq == 0) { Ms[row] = NEG_BIG; Ls[row] = 0.f; }
}
template <int MODE>
__device__ __forceinline__ void nsa_fold(Sub& s, f32x4 (&T)[4], float gate) {
    const float lt = xq_sum(s.l);
    const float sc = (lt > 0.f) ? gate / lt : 0.f;
#pragma unroll
    for (int dt = 0; dt < 4; dt++)
#pragma unroll
        for (int r = 0; r < 4; r++) {
            const float v = s.O[dt][r] * sc;
            T[dt][r] = (MODE == 1) ? T[dt][r] + v : v;
            s.O[dt][r] = 0.f;
        }
    s.m = NEG_BIG; s.l = 0.f;
}

constexpr int NSA_R = 3;
template <bool HASV, class KSrc, class VSrc, class Body>
__device__ __forceinline__ void nsa_stream(char* ring, int n, KSrc ksrc, VSrc vsrc, Body body) {
    const int t = get_tid();
    const int so = (t >> 3) * 64 + (((t & 7) ^ ((t >> 4) & 7)) << 3);
    char* dl = ring + t * 16;
#define NSA_ISSUE(i, slot) { glds16(ksrc(i) + so, dl + (slot) * 16384); if (HASV) glds16(vsrc(i) + so, dl + (slot) * 16384 + 8192); }
    asm volatile("s_waitcnt lgkmcnt(0)" ::: "memory");
    __builtin_amdgcn_s_barrier();
    if (n > 0) NSA_ISSUE(0, 0)
    if (n > 1) NSA_ISSUE(1, 1)
    int slot = 0;
    for (int i = 0; i < n; i++) {
        if (i + 1 < n) { if (HASV) asm volatile("s_waitcnt vmcnt(2)" ::: "memory"); else asm volatile("s_waitcnt vmcnt(1)" ::: "memory"); }
        else asm volatile("s_waitcnt vmcnt(0)" ::: "memory");
        asm volatile("s_waitcnt lgkmcnt(0)" ::: "memory");
        __builtin_amdgcn_s_barrier();
        asm volatile("" ::: "memory");
        const int sl2 = (slot == 0) ? 2 : slot - 1;
        if (i + 2 < n) NSA_ISSUE(i + 2, sl2)
        body(i, (const u16*)(ring + slot * 16384), (const u16*)(ring + slot * 16384 + 8192));
        slot = (slot == 2) ? 0 : slot + 1;
    }
#undef NSA_ISSUE
}
#define NSA_TOK(u) const int t3_ = get_tid(); const size_t ntk_ = (size_t)b * S_ + t0 + 8 * (t3_ >> 6) + 4 * (u) + ((t3_ & 15) >> 2); const int hd_ = g * 4 + (t3_ & 3);
__device__ void ph_nsa(const P& p, int bid, int nb, char* smem) {
    char* ring = smem;
    unsigned* selm = (unsigned*)(smem + NSA_R * 16384);
    int* blist = (int*)(selm + 256);
    int* nlistp = blist + 128;
    int* lcnt = nlistp + 4;
    unsigned char* lists = (unsigned char*)(lcnt + 128);
    float* Ms = (float*)(lists + 128 * 64);
    float* Ls = Ms + 256;
    float* Os = Ls + 256;
    float* impl = Os;
    u16* qs = (u16*)(Os + 64 * 4 * 64);
    unsigned long long ts_ = 0, tacc_ = 0;
    const int nitems = B_ * 2 * 128;
    for (int rr = 0;; rr++) {
        int it = bid;
        if (rr > 0) {
            __syncthreads();
            if (get_tid() == 0) nlistp[3] = nb + atomicAdd(p.nsactr, 1);
            __syncthreads();
            it = nlistp[3];
        }
        if (it >= nitems) break;
        const int tid = get_tid(), lane = tid & 63, wv = tid >> 6;
        const int kr = lane & 15, qq = lane >> 4, ts = kr >> 2, hh = kr & 3;
        float* myimp = impl + wv * (32 * 2 * 16);
        const int tt = 127 - (it >> 3);
        const int bg = it & 7, b = bg >> 1, g = bg & 1;
        const int t0 = tt * 64, cur = tt;
        const int head = g * 4 + hh;
        Sub st[2];
        f32x4 T[2][4];
        int tl[2]; size_t ntok[2];
        __syncthreads();
#pragma unroll
        for (int u = 0; u < 2; u++) {
            tl[u] = 8 * wv + 4 * u + ts;
            ntok[u] = (size_t)b * S_ + t0 + tl[u];
#pragma unroll
            for (int ks = 0; ks < 2; ks++) *(bf16x8*)&qs[(tl[u] * 4 + hh) * 64 + (((ks * 4 + qq) ^ (hh >> 1) ^ ((tl[u] & 3) << 1)) << 3)] = *(const bf16x8*)&p.q[ntok[u] * 512 + head * 64 + ks * 32 + qq * 8];
#pragma unroll
            for (int dt = 0; dt < 4; dt++) st[u].O[dt] = f32x4{0.f, 0.f, 0.f, 0.f};
            st[u].m = NEG_BIG; st[u].l = 0.f;
        }
        const u16* kcb = p.kcb + (size_t)bg * 512 * 64;
        const u16* vcT = p.vcT + (size_t)bg * 8 * 4096;
        int nv[2];
#pragma unroll
        for (int u = 0; u < 2; u++) { const int t = t0 + tl[u]; nv[u] = (t >= 31) ? min((t - 31) / 16 + 1, NCMP) : 0; }
        const int tmax = t0 + 63;
        const int nvmax = (tmax >= 31) ? min((tmax - 31) / 16 + 1, NCMP) : 0;
        const int nvb = (nvmax + 63) >> 6;
        NSA_TS(1)
        __syncthreads();
        nsa_stream<false>(ring, nvb, [&](int kb) { return kcb + (size_t)kb * 4096; }, [&](int kb) { return vcT + (size_t)kb * 4096; },
            [&](int kb, const u16* Ks, const u16* Vs) {
                const int hi2[2] = {nv[0] - kb * 64 - 1, nv[1] - kb * 64 - 1};
                float e_[2][4], p3_[2][4];
                nsa_visit2<false, false>(Ks, Vs, qs + (tl[0] * 4 + hh) * 64, qs + (tl[1] * 4 + hh) * 64, st, hi2, lane, e_, p3_);
            });
        float invl[2];
#pragma unroll
        for (int u = 0; u < 2; u++) { const float lt = xq_sum(st[u].l); invl[u] = (lt > 0.f) ? 1.f / lt : 0.f; st[u].l = 0.f; }
        float carry[2] = {0.f, 0.f};
        nsa_stream<true>(ring, nvb, [&](int kb) { return kcb + (size_t)kb * 4096; }, [&](int kb) { return vcT + (size_t)kb * 4096; },
            [&](int kb, const u16* Ks, const u16* Vs) {
            const int hi2[2] = {nv[0] - kb * 64 - 1, nv[1] - kb * 64 - 1};
            float e_[2][4], p3_[2][4];
            nsa_visit2<true, true>(Ks, Vs, qs + (tl[0] * 4 + hh) * 64, qs + (tl[1] * 4 + hh) * 64, st, hi2, lane, e_, p3_);
#pragma unroll
            for (int u = 0; u < 2; u++) {
#pragma unroll
                for (int kt = 0; kt < 4; kt++) {
                    float ev = e_[u][kt] * invl[u], pv = p3_[u][kt] * invl[u];
                    ev += dppf<0xB1>(ev); ev += dppf<0x4E>(ev);
                    pv += dppf<0xB1>(pv); pv += dppf<0x4E>(pv);
                    const float sh = __int_as_float(__builtin_amdgcn_ds_bpermute(((lane - 16) & 63) << 2, __float_as_int(pv)));
                    const float nbv = (qq == 0) ? carry[u] : sh;
                    carry[u] = sh;
                    myimp[((kb * 4 + kt) * 2 + u) * 16 + ts * 4 + qq] = ev + nbv;
                }
            }
            });
        NSA_TE(1)
        NSA_TS(2)
#pragma unroll
        for (int u = 0; u < 2; u++) {
            float mv[8];
#pragma unroll
            for (int i = 0; i < 8; i++) {
                const int kk = 8 * hh + i, j = 4 * kk + qq;
                const float v = myimp[(kk * 2 + u) * 16 + ts * 4 + qq];
                mv[i] = (j >= 1 && j <= cur - 2) ? v : -1.f;
            }
            unsigned sel = 0u;
            const int ncand = max(0, cur - 2);
            const int nforced = (cur >= 2) ? 3 : (cur + 1);
            const int need = 16 - nforced;
            if (ncand <= need) {
#pragma unroll
                for (int i = 0; i < 8; i++) if (mv[i] >= 0.f) sel |= (1u << i);
            } else {
                for (int rnd = 0; rnd < need; rnd++) {
                    const float b01 = fmaxf(mv[0], mv[1]), b23 = fmaxf(mv[2], mv[3]), b45 = fmaxf(mv[4], mv[5]), b67 = fmaxf(mv[6], mv[7]);
                    float best = fmaxf(fmaxf(b01, b23), fmaxf(b45, b67));
                    int bi = 7;
#pragma unroll
                    for (int i = 6; i >= 0; i--) bi = (mv[i] == best) ? i : bi;
                    int bj = (best >= 0.f) ? (4 * (8 * hh + bi) + qq) : 9999;
#define TK_MERGE(ov, oj) { const float v2_ = (ov); const int j2_ = (oj); const bool tk_ = (v2_ > best) || (v2_ == best && j2_ < bj); best = tk_ ? v2_ : best; bj = tk_ ? j2_ : bj; }
                    TK_MERGE(dppf<0xB1>(best), __builtin_amdgcn_update_dpp(0, bj, 0xB1, 0xF, 0xF, true))
                    TK_MERGE(dppf<0x4E>(best), __builtin_amdgcn_update_dpp(0, bj, 0x4E, 0xF, 0xF, true))
                    {
                        auto rv = __builtin_amdgcn_permlane16_swap(__float_as_uint(best), __float_as_uint(best), false, false);
                        auto rj = __builtin_amdgcn_permlane16_swap((unsigned)bj, (unsigned)bj, false, false);
                        float v0 = __uint_as_float(rv[0]), v1 = __uint_as_float(rv[1]); int j0 = (int)rj[0], j1 = (int)rj[1];
                        if (v1 > v0 || (v1 == v0 && j1 < j0)) { v0 = v1; j0 = j1; }
                        rv = __builtin_amdgcn_permlane32_swap(__float_as_uint(v0), __float_as_uint(v0), false, false);
                        rj = __builtin_amdgcn_permlane32_swap((unsigned)j0, (unsigned)j0, false, false);
                        best = __uint_as_float(rv[0]); bj = (int)rj[0];
                        const float v2 = __uint_as_float(rv[1]); const int j2 = (int)rj[1];
                        if (v2 > best || (v2 == best && j2 < bj)) { best = v2; bj = j2; }
                    }
#undef TK_MERGE
                    const bool mine = (bj < 512) && ((bj >> 5) == hh) && ((bj & 3) == qq);
                    const int li = (bj >> 2) & 7;
#pragma unroll
                    for (int i = 0; i < 8; i++) mv[i] = (mine && li == i) ? -1.f : mv[i];
                    if (mine) sel |= (1u << li);
                }
            }
            if (qq == 0 && hh == 0) sel |= 1u;
            if ((cur & 3) == qq && (cur >> 5) == hh) sel |= (1u << ((cur >> 2) & 7));
            if (cur >= 1 && ((cur - 1) & 3) == qq && ((cur - 1) >> 5) == hh) sel |= (1u << (((cur - 1) >> 2) & 7));
            unsigned w = sel << (8 * hh);
            w |= (unsigned)__builtin_amdgcn_update_dpp(0, (int)w, 0xB1, 0xF, 0xF, true);
            w |= (unsigned)__builtin_amdgcn_update_dpp(0, (int)w, 0x4E, 0xF, 0xF, true);
            if (hh == 0) selm[tl[u] * 4 + qq] = w;
        }
        NSA_TE(2)
        NSA_TS(3)
        __syncthreads();
#pragma unroll
        for (int u = 0; u < 2; u++) { NSA_TOK(u) nsa_fold<0>(st[u], T[u], p.nsag[ntk_ * 24 + hd_ * 3 + 0]); }
        {
            const int t2 = get_tid();
#pragma unroll
            for (int i = 0; i < 8; i++) *(f32x4*)&Os[(i * NT + t2) * 4] = f32x4{0.f, 0.f, 0.f, 0.f};
            if (t2 < 256) { Ms[t2] = NEG_BIG; Ls[t2] = 0.f; }
            unsigned long long tm = 0ull; int lrank = 0;
            if (t2 < 128) {
                const int j = t2;
                for (int tk = 0; tk < 64; tk++) tm |= (unsigned long long)((selm[tk * 4 + (j & 3)] >> (j >> 2)) & 1u) << tk;
                if (j > cur) tm = 0ull;
                const unsigned long long bal = __ballot(tm != 0ull);
                lrank = __popcll(bal & ((1ull << (t2 & 63)) - 1ull));
                if ((t2 & 63) == 0) nlistp[t2 >> 6] = __popcll(bal);
            }
            __syncthreads();
            if (t2 < 128 && tm != 0ull) {
                const int pos = lrank + ((t2 >= 64) ? nlistp[0] : 0);
                blist[pos] = t2; lcnt[pos] = __popcll(tm);
                int c = 0;
                while (tm) { lists[pos * 64 + c] = (unsigned char)(__ffsll((long long)tm) - 1); c++; tm &= tm - 1ull; }
            }
            __syncthreads();
        }
        const int nlist = nlistp[0] + nlistp[1];
        NSA_TE(3)
        NSA_TS(4)
        const u16* ksl = p.ksl + (size_t)bg * S_ * 64;
        const u16* vslT = p.vslT + (size_t)bg * 128 * 4096;
        {
            const int t4 = get_tid(), wv4 = __builtin_amdgcn_readfirstlane(t4 >> 6), ts4 = (t4 & 15) >> 2;
            const int td = t4 & 255;
            const int so = (td >> 3) * 64 + (((td & 7) ^ ((td >> 4) & 7)) << 3);
            char* dl = ring + td * 16;
#define NSA_RI(i) (nlist - 1 - (i))
#define NSA_ISSUE2(i, slot) if (wv4 >= 4) { const int jj_ = blist[NSA_RI(i)]; const u16* kp_ = ksl + (size_t)jj_ * 4096 + so; const u16* vp_ = vslT + (size_t)jj_ * 4096 + so; char* d_ = dl + (slot) * 16384; \
                glds16(kp_, d_); glds16(kp_ + 2048, d_ + 4096); glds16(vp_, d_ + 8192); glds16(vp_ + 2048, d_ + 12288); }
            asm volatile("s_waitcnt lgkmcnt(0)" ::: "memory");
            __builtin_amdgcn_s_barrier();
            if (nlist > 0) NSA_ISSUE2(0, 0)
            if (nlist > 1) NSA_ISSUE2(1, 1)
            int jn = 0, nn = 0, tokn = 0;
            if (nlist > 0) { jn = blist[NSA_RI(0)]; nn = lcnt[NSA_RI(0)]; tokn = lists[NSA_RI(0) * 64 + wv4 * 4 + ts4]; }
            int slot = 0;
            for (int i = 0; i < nlist; i++) {
                if (i + 1 < nlist) asm volatile("s_waitcnt vmcnt(4)" ::: "memory"); else asm volatile("s_waitcnt vmcnt(0)" ::: "memory");
                asm volatile("s_waitcnt lgkmcnt(0)" ::: "memory");
                __builtin_amdgcn_s_barrier();
                asm volatile("" ::: "memory");
                const int sl2 = (slot == 0) ? 2 : slot - 1;
                if (i + 2 < nlist) NSA_ISSUE2(i + 2, sl2)
                const int j = jn, n = nn, tok0 = tokn;
                if (i + 1 < nlist) { jn = blist[NSA_RI(i + 1)]; nn = lcnt[NSA_RI(i + 1)]; tokn = lists[NSA_RI(i + 1) * 64 + wv4 * 4 + ts4]; }
                const u16* Ks = (const u16*)(ring + slot * 16384); const u16* Vs = Ks + 4096;
                if ((wv4 + NW) * 4 < n) {
                    const int e1 = (wv4 + NW) * 4 + ts4;
                    const bool vl2[2] = {true, e1 < n};
                    const int tk2[2] = {tok0, vl2[1] ? (int)lists[NSA_RI(i) * 64 + (e1 & 63)] : 0};
                    if (j == cur) nsa_visit_gn<1, false, 2>(Ks, Vs, qs, Os, Ms, Ls, tk2, vl2, t4 & 63);
                    else nsa_visit_gn<0, true, 2>(Ks, Vs, qs, Os, Ms, Ls, tk2, vl2, t4 & 63);
                } else if (wv4 * 4 < n) {
                    const int e = wv4 * 4 + ts4;
                    const bool valid = e < n;
                    const int tok = valid ? tok0 : 0;
                    if (j == cur) nsa_visit_g<1, false>(Ks, Vs, qs, Os, Ms, Ls, tok, valid, t4 & 63);
                    else nsa_visit_g<0, true>(Ks, Vs, qs, Os, Ms, Ls, tok, valid, t4 & 63);
                }
                slot = (slot == 2) ? 0 : slot + 1;
            }
#undef NSA_RI
#undef NSA_ISSUE2
        }
        __syncthreads();
        NSA_TE(4)
        NSA_TS(5)
#pragma unroll
        for (int u = 0; u < 2; u++) {
            NSA_TOK(u)
            const int t5 = t3_ & 63;
            nsa_fold_lds(Os, Ms, Ls, (8 * (t3_ >> 6) + 4 * u + ((t5 & 15) >> 2)) * 4 + (t5 & 3), t5 >> 4, t5 & 3, T[u], p.nsag[ntk_ * 24 + hd_ * 3 + 1], true);
        }
        const u16* kwn = p.kwn + (size_t)bg * S_ * 64;
        const u16* vwnT = p.vwnT + (size_t)bg * 128 * 4096;
        uint2 Tp[2][4];
#pragma unroll
        for (int u = 0; u < 2; u++)
#pragma unroll
            for (int dt = 0; dt < 4; dt++) { Tp[u][dt] = pack4(T[u][dt]); asm volatile("" : "+v"(Tp[u][dt].x), "+v"(Tp[u][dt].y)); }
        {
            const int jlo = max(0, cur - 8);
            nsa_stream<true>(ring, cur - jlo + 1, [&](int i) { return kwn + (size_t)(cur - i) * 4096; }, [&](int i) { return vwnT + (size_t)(cur - i) * 4096; },
                [&](int i, const u16* Ks, const u16* Vs) {
                    const int j = cur - i;
                    const int t4 = get_tid();
                    const int tb_ = 8 * (t4 >> 6) + ((t4 & 15) >> 2);
                    const int tk2[2] = {tb_, tb_ + 4}; const bool vl2[2] = {true, true};
                    if (j == cur) nsa_visit_gn<1, false, 2>(Ks, Vs, qs, Os, Ms, Ls, tk2, vl2, t4 & 63);
                    else if (j == cur - 8) nsa_visit_gn<2, true, 2>(Ks, Vs, qs, Os, Ms, Ls, tk2, vl2, t4 & 63);
                    else nsa_visit_gn<0, true, 2>(Ks, Vs, qs, Os, Ms, Ls, tk2, vl2, t4 & 63);
                });
        }
#pragma unroll
        for (int u = 0; u < 2; u++) {
            NSA_TOK(u)
#pragma unroll
            for (int dt = 0; dt < 4; dt++) T[u][dt] = unpack4(Tp[u][dt]);
            { const int t5 = t3_ & 63; nsa_fold_lds(Os, Ms, Ls, (8 * (t3_ >> 6) + 4 * u + ((t5 & 15) >> 2)) * 4 + (t5 & 3), t5 >> 4, t5 & 3, T[u], p.nsag[ntk_ * 24 + hd_ * 3 + 2], false); }
#pragma unroll
            for (int dt = 0; dt < 4; dt++) *(uint2*)&p.oa[ntk_ * 512 + hd_ * 64 + dt * 16 + ((t3_ & 63) >> 4) * 4] = pack4(T[u][dt]);
        }
        NSA_TE(5)
    }
    if (NSAPROBE) { __syncthreads(); const unsigned long long t1_ = __builtin_amdgcn_s_memrealtime(); while (__builtin_amdgcn_s_memrealtime() - t1_ < tacc_) __builtin_amdgcn_s_sleep(8); }
}

#ifndef CHPROBE
#define CHPROBE 0
#endif
#define CH_TS(k) if (CHPROBE == k) cts_ = __builtin_amdgcn_s_memrealtime();
#define CH_TE(k) if (CHPROBE == k) ctacc_ += __builtin_amdgcn_s_memrealtime() - cts_;
constexpr int RS = 72;
constexpr int RSLOT = 64 * RS;
__device__ __forceinline__ void mm64(const u16* A, int lda, const u16* Bz, int ldb, f32x4 (&acc)[2], int lane, int wv) {
    const int mt = wv >> 1, nt0 = (wv & 1) * 2, kr = lane & 15, qq = lane >> 4;
    bf16x8 a[2], b[2][2];
#pragma unroll
    for (int ks = 0; ks < 2; ks++) {
        a[ks] = *(const bf16x8*)&A[(mt * 16 + kr) * lda + ks * 32 + qq * 8];
#pragma unroll
        for (int i = 0; i < 2; i++) b[ks][i] = *(const bf16x8*)&Bz[((nt0 + i) * 16 + kr) * ldb + ks * 32 + qq * 8];
    }
#pragma unroll
    for (int ks = 0; ks < 2; ks++)
#pragma unroll
        for (int i = 0; i < 2; i++) acc[i] = __builtin_amdgcn_mfma_f32_16x16x32_bf16(a[ks], b[ks][i], acc[i], 0, 0, 0);
}
__device__ __forceinline__ void st_t(u16* dst, int ld, const f32x4& v, int mt, int nt, int lane) {
    uint2 o; o.x = pack2(v[0], v[1]); o.y = pack2(v[2], v[3]);
    *(uint2*)&dst[(nt * 16 + (lane & 15)) * ld + mt * 16 + (lane >> 4) * 4] = o;
}
__device__ __forceinline__ void st_n(u16* dst, int ld, const f32x4& v, int mt, int nt, int lane) {
#pragma unroll
    for (int r = 0; r < 4; r++) dst[(mt * 16 + (lane >> 4) * 4 + r) * ld + nt * 16 + (lane & 15)] = f2bf(v[r]);
}
#define ZACC(a) { a[0] = f32x4{0.f, 0.f, 0.f, 0.f}; a[1] = f32x4{0.f, 0.f, 0.f, 0.f}; }

__device__ void ph_rwkv_chunk(const P& p, int bid, int nb, char* smem) {
    unsigned long long cts_ = 0, ctacc_ = 0;
    u16* sl = (u16*)smem;
    float* tot = (float*)(sl + 14 * RSLOT);
    float* gl = tot + 512;
#define RW_IDX const int tid = get_tid(), lane = tid & 63, wv = tid >> 6, mt = wv >> 1, nt0 = (wv & 1) * 2, kr = lane & 15, qq = lane >> 4; (void)mt; (void)nt0; (void)kr; (void)qq; (void)lane;
    const int nitems = B_ * 128;
    for (int it0 = bid; it0 < nitems; it0 += nb) {
      const int c = it0 & 127, b = it0 >> 7;
      const size_t n0 = (size_t)b * S_ + c * 64;
      __syncthreads();
      {
          RW_IDX
          const int t = tid >> 3, part = tid & 7;
          const size_t n = n0 + t;
          const bool hasprev = (c * 64 + t) > 0;
          u16* dst = p.xact + n * 256 + part * 32;
#pragma unroll
          for (int j = 0; j < 4; j++) {
              const int col = 1536 + part * 32 + j * 8;
              const uint4 cu = *(const uint4*)&p.prw[n * CRW + col];
              uint4 pv = make_uint4(0u, 0u, 0u, 0u);
              if (hasprev) pv = *(const uint4*)&p.prw[(n - 1) * CRW + col];
              const unsigned cw[4] = {cu.x, cu.y, cu.z, cu.w}, pw[4] = {pv.x, pv.y, pv.z, pv.w};
              unsigned ow[4];
#pragma unroll
              for (int e2 = 0; e2 < 4; e2++) {
                  float x0 = __uint_as_float(cw[e2] << 16), x1 = __uint_as_float(cw[e2] & 0xFFFF0000u);
                  const float q0 = __uint_as_float(pw[e2] << 16), q1 = __uint_as_float(pw[e2] & 0xFFFF0000u);
                  x0 = x0 + (q0 - x0) * p.mu[col + 2 * e2]; x1 = x1 + (q1 - x1) * p.mu[col + 2 * e2 + 1];
                  if (part < 2) { x0 = tanhf(x0); x1 = tanhf(x1); }
                  else if (part >= 4) { x0 = sigmoidf_(x0); x1 = sigmoidf_(x1); }
                  ow[e2] = pack2(x0, x1);
              }
              *(uint4*)&dst[j * 8] = make_uint4(ow[0], ow[1], ow[2], ow[3]);
          }
      }
      __syncthreads();
      const u16* xa = p.xact + n0 * 256;
      bf16x8 xa_[8], wb[2][2], ab[2][2], gb[2][4];
      u16 rc[8][3], rp0[3];
      float w0c[2], a0c[2], hc_[6];
#define S1_LOADW(hh_) { RW_IDX \
          _Pragma("unroll") for (int i = 0; i < 2; i++) { const int cc = (nt0 + i) * 16 + kr; w0c[i] = p.w0[(hh_) * 64 + cc]; a0c[i] = p.a0[(hh_) * 64 + cc]; \
              _Pragma("unroll") for (int ks = 0; ks < 2; ks++) { wb[i][ks] = *(const bf16x8*)&p.w2T[((size_t)(hh_) * 64 + cc) * 64 + ks * 32 + qq * 8]; \
                                                                 ab[i][ks] = *(const bf16x8*)&p.a2T[((size_t)(hh_) * 64 + cc) * 64 + ks * 32 + qq * 8]; } \
              _Pragma("unroll") for (int ks = 0; ks < 4; ks++) gb[i][ks] = *(const bf16x8*)&p.g2T[((size_t)(hh_) * 64 + cc) * 128 + ks * 32 + qq * 8]; } }
#define S2_LOADX(hh_) { RW_IDX const int ch_ = (hh_) * 64 + lane; \
          hc_[0] = p.mu[ch_]; hc_[1] = p.mu[512 + ch_]; hc_[2] = p.mu[1024 + ch_]; hc_[3] = p.k_k[ch_]; hc_[4] = p.k_a[ch_]; hc_[5] = p.r_k[ch_]; \
          _Pragma("unroll") for (int i = 0; i < 8; i++) { const int t = wv * 8 + i; const u16* cr = p.prw + (n0 + t) * CRW; \
              rc[i][0] = cr[ch_]; rc[i][1] = cr[512 + ch_]; rc[i][2] = cr[1024 + ch_]; } \
          rp0[0] = 0; rp0[1] = 0; rp0[2] = 0;     \
          if (c * 64 + wv * 8 > 0) { const u16* pp = p.prw + (n0 + wv * 8 - 1) * CRW; rp0[0] = pp[ch_]; rp0[1] = pp[512 + ch_]; rp0[2] = pp[1024 + ch_]; } }
      {
          RW_IDX
#pragma unroll
          for (int k8 = 0; k8 < 8; k8++) xa_[k8] = *(const bf16x8*)&xa[(mt * 16 + kr) * 256 + k8 * 32 + qq * 8];
      }
      S1_LOADW(0)
      S2_LOADX(0)
#pragma unroll 1
      for (int h = 0; h < 8; h++) {
        u16* cd = p.cdat + ((size_t)((b * 8 + h) * 128 + c)) * 4 * 4096;
        LDS_BARRIER();
        CH_TS(1)
        float* LW = (float*)(sl + 8 * RSLOT); float* LA = (float*)(sl + 10 * RSLOT);
        {
            RW_IDX
            f32x4 aw[2], aa2[2], ag[2];
#pragma unroll
            for (int i = 0; i < 2; i++) {
                aw[i] = f32x4{0.f, 0.f, 0.f, 0.f}; aa2[i] = aw[i]; ag[i] = aw[i];
#pragma unroll
                for (int ks = 0; ks < 2; ks++) {
                    aw[i] = __builtin_amdgcn_mfma_f32_16x16x32_bf16(xa_[ks], wb[i][ks], aw[i], 0, 0, 0);
                    aa2[i] = __builtin_amdgcn_mfma_f32_16x16x32_bf16(xa_[2 + ks], ab[i][ks], aa2[i], 0, 0, 0);
                }
#pragma unroll
                for (int ks = 0; ks < 4; ks++) ag[i] = __builtin_amdgcn_mfma_f32_16x16x32_bf16(xa_[4 + ks], gb[i][ks], ag[i], 0, 0, 0);
            }
#pragma unroll
            for (int i = 0; i < 2; i++)
#pragma unroll
                for (int r = 0; r < 4; r++) {
                    const int t = mt * 16 + qq * 4 + r, cc = (nt0 + i) * 16 + kr;
                    const float wl = w0c[i] + aw[i][r];
                    const float z = -wl;
                    const float sp = fmaxf(z, 0.f) + __logf(1.f + __expf(-fabsf(z)));
                    LW[t * 64 + cc] = -__expf(-sp - 0.5f);
                    LA[t * 64 + cc] = sigmoidf_(a0c[i] + aa2[i][r]);
                    p.ob[(n0 + t) * 512 + h * 64 + cc] = f2bf(ag[i][r]);
                }
        }
        LDS_BARRIER();
        CH_TE(1) CH_TS(2)
        {
            RW_IDX
            const int ch = h * 64 + lane;
            const float mur = hc_[0], muk = hc_[1], muv = hc_[2];
            const float kkw = hc_[3], kaw = hc_[4], rkw = hc_[5];
            float rr[8], k2[8], vv[8], kkn[8], aa[8], lg[8], cs[8];
            float run = 0.f;
#pragma unroll
            for (int i = 0; i < 8; i++) {
                const int t = wv * 8 + i; const size_t n = n0 + t;
                float r = bf2f(rc[i][0]), k = bf2f(rc[i][1]), v = bf2f(rc[i][2]);
                const float pr = bf2f(i ? rc[i - 1][0] : rp0[0]), pk = bf2f(i ? rc[i - 1][1] : rp0[1]), pv = bf2f(i ? rc[i - 1][2] : rp0[2]);
                r = r + (pr - r) * mur; k = k + (pk - k) * muk; v = v + (pv - v) * muv;
                const float a = LA[t * 64 + lane];
                lg[i] = LW[t * 64 + lane];
                float kk = k * kkw;
                kkn[i] = kk * __builtin_amdgcn_rsqf(fmaxf(wave_sum(kk * kk), 1e-24f));
                k2[i] = k * (1.f + (a - 1.f) * kaw);
                const float bon = wave_sum(r * k2[i] * rkw);
                if (lane == 0) p.bon[n * 8 + h] = bon;
                rr[i] = r; vv[i] = v; aa[i] = a;
                run += lg[i]; cs[i] = run;
            }
            tot[wv * 64 + lane] = run;
            LDS_BARRIER();
            float off = 0.f, cumL = 0.f;
#pragma unroll
            for (int w2 = 0; w2 < 8; w2++) { const float tv = tot[w2 * 64 + lane]; cumL += tv; if (w2 < wv) off += tv; }
            if (wv == 0) gl[lane] = __expf(cumL);
            unsigned pa[4], pb[4], pk4[4], pv4[4];
#pragma unroll
            for (int i = 0; i < 8; i += 2) {
                float at[2], bt[2], kt[2], rt[2];
#pragma unroll
                for (int e2 = 0; e2 < 2; e2++) {
                    const int ii = i + e2; const int t = wv * 8 + ii;
                    const float cm = off + cs[ii];
                    const float g = __expf(cm), gp = __expf(cm - lg[ii]), gi = __expf(-cm);
                    at[e2] = -kkn[ii] * gp; bt[e2] = kkn[ii] * aa[ii] * gi; kt[e2] = k2[ii] * gi; rt[e2] = rr[ii] * g;
                    sl[0 * RSLOT + t * RS + lane] = f2bf(at[e2]);
                    sl[1 * RSLOT + t * RS + lane] = f2bf(bt[e2]);
                    sl[2 * RSLOT + t * RS + lane] = f2bf(kt[e2]);
                    sl[3 * RSLOT + t * RS + lane] = f2bf(rt[e2]);
                }
                pa[i >> 1] = pack2(at[0], at[1]); pb[i >> 1] = pack2(bt[0], bt[1]);
                pk4[i >> 1] = pack2(kt[0], kt[1]); pv4[i >> 1] = pack2(vv[i], vv[i + 1]);
            }
            *(uint4*)&sl[4 * RSLOT + lane * RS + wv * 8] = make_uint4(pa[0], pa[1], pa[2], pa[3]);
            *(uint4*)&sl[5 * RSLOT + lane * RS + wv * 8] = make_uint4(pb[0], pb[1], pb[2], pb[3]);
            *(uint4*)&sl[6 * RSLOT + lane * RS + wv * 8] = make_uint4(pk4[0], pk4[1], pk4[2], pk4[3]);
            *(uint4*)&sl[7 * RSLOT + lane * RS + wv * 8] = make_uint4(pv4[0], pv4[1], pv4[2], pv4[3]);
        }
        LDS_BARRIER();
        if (h + 1 < 8) { S1_LOADW(h + 1) S2_LOADX(h + 1) }
        CH_TE(2) CH_TS(3)
        {
            RW_IDX
            f32x4 acc[2];
            ZACC(acc); mm64(sl + 1 * RSLOT, RS, sl + 0 * RSLOT, RS, acc, lane, wv);
#pragma unroll
            for (int i = 0; i < 2; i++) {
                f32x4 pm;
#pragma unroll
                for (int r = 0; r < 4; r++) {
                    const int m = mt * 16 + qq * 4 + r, n = (nt0 + i) * 16 + kr;
                    if (!(m < n)) acc[i][r] = 0.f;
                    pm[r] = acc[i][r] + ((m == n) ? 1.f : 0.f);
                }
                st_t(sl + 8 * RSLOT, RS, acc[i], mt, nt0 + i, lane);
                st_n(sl + 9 * RSLOT, RS, acc[i], mt, nt0 + i, lane);
                st_t(sl + 13 * RSLOT, RS, pm, mt, nt0 + i, lane);
            }
            ZACC(acc); mm64(sl + 0 * RSLOT, RS, sl + 2 * RSLOT, RS, acc, lane, wv);
#pragma unroll
            for (int i = 0; i < 2; i++) {
#pragma unroll
                for (int r = 0; r < 4; r++) { const int m = mt * 16 + qq * 4 + r, n = (nt0 + i) * 16 + kr; if (!(m > n)) acc[i][r] = 0.f; }
                st_t(sl + 10 * RSLOT, RS, acc[i], mt, nt0 + i, lane);
            }
            ZACC(acc); mm64(sl + 1 * RSLOT, RS, sl + 3 * RSLOT, RS, acc, lane, wv);
#pragma unroll
            for (int i = 0; i < 2; i++) {
#pragma unroll
                for (int r = 0; r < 4; r++) { const int m = mt * 16 + qq * 4 + r, n = (nt0 + i) * 16 + kr; if (m > n) acc[i][r] = 0.f; }
                st_t(sl + 11 * RSLOT, RS, acc[i], mt, nt0 + i, lane);
            }
            ZACC(acc); mm64(sl + 2 * RSLOT, RS, sl + 3 * RSLOT, RS, acc, lane, wv);
#pragma unroll
            for (int i = 0; i < 2; i++) {
#pragma unroll
                for (int r = 0; r < 4; r++) { const int m = mt * 16 + qq * 4 + r, n = (nt0 + i) * 16 + kr; if (m > n) acc[i][r] = 0.f; }
                st_t(sl + 12 * RSLOT, RS, acc[i], mt, nt0 + i, lane);
            }
        }
        LDS_BARRIER();
        CH_TE(3) CH_TS(4)
        u16* X = sl + 8 * RSLOT; u16* XT = sl + 9 * RSLOT; u16* X2 = sl + 0 * RSLOT; u16* X2T = sl + 1 * RSLOT;
        u16* Pc = sl + 13 * RSLOT; u16* Pn = sl + 2 * RSLOT;
#pragma unroll 1
        for (int j = 1; j <= 6; j++) {
            RW_IDX
            f32x4 acc[2];
            if (j <= 5) {
                ZACC(acc); mm64(X, RS, XT, RS, acc, lane, wv);
#pragma unroll
                for (int i = 0; i < 2; i++) { st_t(X2T, RS, acc[i], mt, nt0 + i, lane); st_n(X2, RS, acc[i], mt, nt0 + i, lane); }
            }
            if (j >= 2) {
                ZACC(acc); mm64(XT, RS, Pc, RS, acc, lane, wv);
#pragma unroll
                for (int i = 0; i < 2; i++) {
                    const uint2 pv = *(const uint2*)&Pc[((nt0 + i) * 16 + kr) * RS + mt * 16 + qq * 4];
                    acc[i][0] += __uint_as_float(pv.x << 16); acc[i][1] += __uint_as_float(pv.x & 0xFFFF0000u);
                    acc[i][2] += __uint_as_float(pv.y << 16); acc[i][3] += __uint_as_float(pv.y & 0xFFFF0000u);
                    st_t(Pn, RS, acc[i], mt, nt0 + i, lane);
                }
            }
            LDS_BARRIER();
            if (j >= 2) { u16* tp = Pc; Pc = Pn; Pn = tp; }
            if (j <= 5) { u16* tx = X; X = X2; X2 = tx; tx = XT; XT = X2T; X2T = tx; }
        }
        CH_TE(4) CH_TS(5)
        u16* TT = Pc;
        {
            RW_IDX
            f32x4 acc[2];
            ZACC(acc); mm64(TT, RS, sl + 4 * RSLOT, RS, acc, lane, wv);
#pragma unroll
            for (int i = 0; i < 2; i++) st_t(sl + 0 * RSLOT, RS, acc[i], mt, nt0 + i, lane);
            ZACC(acc); mm64(sl + 10 * RSLOT, RS, TT, RS, acc, lane, wv);
#pragma unroll
            for (int i = 0; i < 2; i++) st_t(sl + 8 * RSLOT, RS, acc[i], mt, nt0 + i, lane);
        }
        LDS_BARRIER();
        {
            RW_IDX
            f32x4 acc[2];
            ZACC(acc); mm64(sl + 8 * RSLOT, RS, sl + 7 * RSLOT, RS, acc, lane, wv);
#pragma unroll
            for (int i = 0; i < 2; i++) st_t(sl + 9 * RSLOT, RS, acc[i], mt, nt0 + i, lane);
            ZACC(acc); mm64(sl + 0 * RSLOT, RS, sl + 5 * RSLOT, RS, acc, lane, wv);
#pragma unroll
            for (int i = 0; i < 2; i++) {
                const int n = (nt0 + i) * 16 + kr; const float gn = gl[n];
#pragma unroll
                for (int r = 0; r < 4; r++) { const int m = mt * 16 + qq * 4 + r; acc[i][r] = acc[i][r] * gn + ((m == n) ? gn : 0.f); }
                st_t(cd, 64, acc[i], mt, nt0 + i, lane);
            }
            ZACC(acc); mm64(sl + 0 * RSLOT, RS, sl + 11 * RSLOT, RS, acc, lane, wv);
#pragma unroll
            for (int i = 0; i < 2; i++) {
                const uint2 rv = *(const uint2*)&sl[3 * RSLOT + ((nt0 + i) * 16 + kr) * RS + mt * 16 + qq * 4];
                acc[i][0] += __uint_as_float(rv.x << 16); acc[i][1] += __uint_as_float(rv.x & 0xFFFF0000u);
                acc[i][2] += __uint_as_float(rv.y << 16); acc[i][3] += __uint_as_float(rv.y & 0xFFFF0000u);
                st_t(cd + 2 * 4096, 64, acc[i], mt, nt0 + i, lane);
            }
        }
        LDS_BARRIER();
        {
            RW_IDX
            f32x4 acc[2];
            ZACC(acc);
            mm64(sl + 5 * RSLOT, RS, sl + 9 * RSLOT, RS, acc, lane, wv);
            mm64(sl + 6 * RSLOT, RS, sl + 7 * RSLOT, RS, acc, lane, wv);
#pragma unroll
            for (int i = 0; i < 2; i++) {
#pragma unroll
                for (int r = 0; r < 4; r++) acc[i][r] *= gl[mt * 16 + qq * 4 + r];
                st_t(cd + 1 * 4096, 64, acc[i], mt, nt0 + i, lane);
            }
            ZACC(acc);
            mm64(sl + 9 * RSLOT, RS, sl + 11 * RSLOT, RS, acc, lane, wv);
            mm64(sl + 7 * RSLOT, RS, sl + 12 * RSLOT, RS, acc, lane, wv);
#pragma unroll
            for (int i = 0; i < 2; i++) st_t(cd + 3 * 4096, 64, acc[i], mt, nt0 + i, lane);
        }
        CH_TE(5)
      }
    }
    if (CHPROBE) { __syncthreads(); const unsigned long long t1_ = __builtin_amdgcn_s_memrealtime(); while (__builtin_amdgcn_s_memrealtime() - t1_ < ctacc_) __builtin_amdgcn_s_sleep(8); }
}

__device__ void ph_rwkv_seq(const P& p, int bid, int nb, char* smem) {
    u16* SL = (u16*)smem;
    const int tid = get_tid(), lane = tid & 63, wv = __builtin_amdgcn_readfirstlane(tid >> 6);
    const int kr = lane & 15, qq = lane >> 4, chn = wv >> 2, vt = wv & 3;
    for (int pair = bid; pair < B_ * 4; pair += nb) {
        const int bh = pair * 2 + chn;
        u16* mySL = SL + chn * RSLOT;
        __syncthreads();
#pragma unroll
        for (int ks = 0; ks < 2; ks++) *(uint4*)&mySL[(vt * 16 + kr) * RS + ks * 32 + qq * 8] = make_uint4(0u, 0u, 0u, 0u);
        u16* cbase = p.cdat + (size_t)bh * 128 * 4 * 4096;
        bf16x8 GA0[4][2], GA1[4][2], GA2[4][2], GA3[4][2]; uint2 H0[4], H1[4], H2[4], H3[4];
#define SEQ_LD(GAx, Hx, c) { const u16* cd_ = cbase + (size_t)(c) * 4 * 4096; \
            _Pragma("unroll") for (int m4 = 0; m4 < 4; m4++) { \
                _Pragma("unroll") for (int ks = 0; ks < 2; ks++) GAx[m4][ks] = *(const bf16x8*)&cd_[(m4 * 16 + kr) * 64 + ks * 32 + qq * 8]; \
                Hx[m4] = *(const uint2*)&cd_[1 * 4096 + (vt * 16 + kr) * 64 + m4 * 16 + qq * 4]; } }
#define SEQ_STEP(GAx, Hx, c) { \
            bf16x8 Z0[2]; \
            _Pragma("unroll") for (int ks = 0; ks < 2; ks++) Z0[ks] = *(const bf16x8*)&mySL[(vt * 16 + kr) * RS + ks * 32 + qq * 8]; \
            f32x4 zs[4]; \
            _Pragma("unroll") for (int m4 = 0; m4 < 4; m4++) { \
                zs[m4] = unpack4(Hx[m4]); \
                _Pragma("unroll") for (int ks = 0; ks < 2; ks++) zs[m4] = __builtin_amdgcn_mfma_f32_16x16x32_bf16(GAx[m4][ks], Z0[ks], zs[m4], 0, 0, 0); } \
            u16* sn_ = cbase + (size_t)(c) * 4 * 4096 + 1 * 4096 + (vt * 16 + kr) * 64 + qq * 4; \
            _Pragma("unroll") for (int m4 = 0; m4 < 4; m4++) { \
                const uint2 pk_ = pack4(zs[m4]); \
                *(uint2*)&mySL[(vt * 16 + kr) * RS + m4 * 16 + qq * 4] = pk_; \
                *(uint2*)&sn_[m4 * 16] = pk_; } \
            if ((c) + 4 < 128) SEQ_LD(GAx, Hx, (c) + 4) }
        SEQ_LD(GA0, H0, 0) SEQ_LD(GA1, H1, 1) SEQ_LD(GA2, H2, 2) SEQ_LD(GA3, H3, 3)
#pragma unroll 1
        for (int c = 0; c < 128; c += 4) {
            SEQ_STEP(GA0, H0, c)
            SEQ_STEP(GA1, H1, c + 1)
            SEQ_STEP(GA2, H2, c + 2)
            SEQ_STEP(GA3, H3, c + 3)
        }
#undef SEQ_LD
#undef SEQ_STEP
    }
}

__device__ void ph_rwkv_out(const P& p, int bid, int nb, char* smem) {
    const int tid = get_tid(), lane = tid & 63, wv = tid >> 6;
    const int kr = lane & 15, qq = lane >> 4;
    for (int it = bid * NW + wv; it < B_ * 8 * 128; it += nb * NW) {
        const int c = it & 127, bh = it >> 7, b = bh >> 3, h = bh & 7;
        const u16* cd = p.cdat + ((size_t)bh * 128 + c) * 4 * 4096;
        f32x4 ys[4][4];
#pragma unroll
        for (int mt = 0; mt < 4; mt++)
#pragma unroll
            for (int nt = 0; nt < 4; nt++) ys[mt][nt] = unpack4(*(const uint2*)&cd[3 * 4096 + (nt * 16 + kr) * 64 + mt * 16 + qq * 4]);
        if (c > 0) {
            const u16* s0 = cd - 4 * 4096 + 1 * 4096;
#pragma unroll
            for (int ks = 0; ks < 2; ks++) {
                bf16x8 af[4], bq[4];
#pragma unroll
                for (int mt = 0; mt < 4; mt++) af[mt] = *(const bf16x8*)&s0[(mt * 16 + kr) * 64 + ks * 32 + qq * 8];
#pragma unroll
                for (int nt = 0; nt < 4; nt++) bq[nt] = *(const bf16x8*)&cd[2 * 4096 + (nt * 16 + kr) * 64 + ks * 32 + qq * 8];
#pragma unroll
                for (int mt = 0; mt < 4; mt++)
#pragma unroll
                    for (int nt = 0; nt < 4; nt++) ys[mt][nt] = __builtin_amdgcn_mfma_f32_16x16x32_bf16(af[mt], bq[nt], ys[mt][nt], 0, 0, 0);
            }
        }
#pragma unroll
        for (int nt = 0; nt < 4; nt++) {
            float s1 = 0.f, s2 = 0.f;
#pragma unroll
            for (int mt = 0; mt < 4; mt++)
#pragma unroll
                for (int r = 0; r < 4; r++) { s1 += ys[mt][nt][r]; s2 += ys[mt][nt][r] * ys[mt][nt][r]; }
            s1 = xrow_sum(s1); s2 = xrow_sum(s2);
            const float mean = s1 * (1.f / 64.f);
            const float var = fmaxf(s2 * (1.f / 64.f) - mean * mean, 0.f);
            const float rstd = rsqrtf(var + 64e-5f);
            const int t = nt * 16 + kr;
            const size_t n = (size_t)b * S_ + c * 64 + t;
            const float bon = p.bon[n * 8 + h];
#pragma unroll
            for (int mt = 0; mt < 4; mt++) {
                const int vch = h * 64 + mt * 16 + qq * 4;
                const f32x4 vcf = unpack4(*(const uint2*)&p.prw[n * CRW + 1024 + vch]);
                const f32x4 vpf = (c * 64 + t > 0) ? unpack4(*(const uint2*)&p.prw[(n - 1) * CRW + 1024 + vch]) : f32x4{0.f, 0.f, 0.f, 0.f};
                const f32x4 ggf = unpack4(*(const uint2*)&p.ob[n * 512 + vch]);
                const float4 lw = *(const float4*)&p.ln_w[vch], lb = *(const float4*)&p.ln_b[vch], mv = *(const float4*)&p.mu[1024 + vch];
                const float lwa[4] = {lw.x, lw.y, lw.z, lw.w}, lba[4] = {lb.x, lb.y, lb.z, lb.w}, mva[4] = {mv.x, mv.y, mv.z, mv.w};
                f32x4 o;
#pragma unroll
                for (int r = 0; r < 4; r++) {
                    const float vsh = vcf[r] + (vpf[r] - vcf[r]) * mva[r];
                    o[r] = ((ys[mt][nt][r] - mean) * rstd * lwa[r] + lba[r] + bon * vsh) * ggf[r];
                }
                *(uint2*)&p.ob[n * 512 + vch] = pack4(o);
            }
        }
    }
}

__device__ __forceinline__ void unpack8(const uint4& u, f32x4& a, f32x4& b) {
    a = f32x4{__uint_as_float(u.x << 16), __uint_as_float(u.x & 0xFFFF0000u), __uint_as_float(u.y << 16), __uint_as_float(u.y & 0xFFFF0000u)};
    b = f32x4{__uint_as_float(u.z << 16), __uint_as_float(u.z & 0xFFFF0000u), __uint_as_float(u.w << 16), __uint_as_float(u.w & 0xFFFF0000u)};
}
struct EpiMerge {
    u16* merged; u16* tmp2; int pass;
    __device__ __forceinline__ void operator()(const f32x4 (&acc)[2][2][4][2], const GUnit& u, int, int, int, int) const {
        const int t2_ = get_tid(), wid_ = __builtin_amdgcn_readfirstlane(t2_ >> 6), wr = wid_ >> 2, wc = wid_ & 3, fr = t2_ & 15, fq = (t2_ >> 4) & 3;
        const int row0 = u.pm * 256 + wr * 64 + fr, col0 = u.pn * 256 + wc * 32 + 8 * fq;
#pragma unroll
        for (int ai = 0; ai < 2; ++ai)
#pragma unroll
            for (int m = 0; m < 4; ++m) {
                const size_t off = (size_t)(row0 + ai * 128 + m * 16) * D_ + col0;
                uint4 m1[2], m2[2];
                if (pass == 1 || pass == 3) {
#pragma unroll
                    for (int bj = 0; bj < 2; ++bj) { m1[bj] = *(const uint4*)&merged[off + bj * 128]; if (pass == 3) m2[bj] = *(const uint4*)&tmp2[off + bj * 128]; }
                }
#pragma unroll
                for (int bj = 0; bj < 2; ++bj) {
                    f32x4 v0 = acc[ai][bj][m][0], v1 = acc[ai][bj][m][1];
                    if (pass == 1) { f32x4 a0, a1; unpack8(m1[bj], a0, a1);
#pragma unroll
                        for (int r = 0; r < 4; r++) { v0[r] = a0[r] * sigmoidf_(v0[r]); v1[r] = a1[r] * sigmoidf_(v1[r]); } }
                    if (pass == 3) { f32x4 a0, a1, b0, b1; unpack8(m1[bj], a0, a1); unpack8(m2[bj], b0, b1);
#pragma unroll
                        for (int r = 0; r < 4; r++) { v0[r] = a0[r] + b0[r] * sigmoidf_(v0[r]); v1[r] = a1[r] + b1[r] * sigmoidf_(v1[r]); } }
                    *(uint4*)&((pass == 2) ? tmp2 : merged)[off + bj * 128] = pack8(v0, v1);
                }
                asm volatile("" ::: "memory");
            }
    }
};
__device__ void ph_merge(const P& p, int bid, int nb, char* smem) {
    u16* tmp2 = (u16*)p.x1;
#pragma unroll 1
    for (int pass = 0; pass < 4; ++pass) {
        const int K = (pass & 1) ? D_ : 512;
        const u16* A = (pass & 1) ? p.hbuf : (pass == 0 ? p.oa : p.ob);
        const u16* Bt = (pass == 0) ? p.wpaT : (pass == 1 ? p.wgT : (pass == 2 ? p.wpbT : p.wgT + (size_t)1024 * D_));
        DenseSched S; S.init(NTOK, D_, K, Bt, nb, bid);
        EpiMerge E{p.merged, tmp2, pass};
        gemm256(smem, (const char*)A, K, S, E);
    }
}

struct EpiOutproj {
    const float* x; float* x1;
    __device__ __forceinline__ void operator()(const f32x4 (&acc)[2][2][4][2], const GUnit& u, int, int, int, int) const {
        const int t2_ = get_tid(), wid_ = __builtin_amdgcn_readfirstlane(t2_ >> 6), wr = wid_ >> 2, wc = wid_ & 3, fr = t2_ & 15, fq = (t2_ >> 4) & 3;
        const int row0 = u.pm * 256 + wr * 64 + fr, col0 = u.pn * 256 + wc * 32 + 4 * fq;
#pragma unroll
        for (int ai = 0; ai < 2; ++ai)
#pragma unroll
            for (int m = 0; m < 4; ++m) {
                const size_t off = (size_t)(row0 + ai * 128 + m * 16) * D_ + col0;
                f32x4 xin[2][2];
#pragma unroll
                for (int bj = 0; bj < 2; ++bj)
#pragma unroll
                    for (int n = 0; n < 2; ++n) xin[bj][n] = *(const f32x4*)&x[off + bj * 128 + n * 16];
#pragma unroll
                for (int bj = 0; bj < 2; ++bj)
#pragma unroll
                    for (int n = 0; n < 2; ++n) *(f32x4*)&x1[off + bj * 128 + n * 16] = xin[bj][n] + acc[ai][bj][m][n];
                asm volatile("" ::: "memory");
            }
    }
};
__device__ void ph_outproj(const P& p, int bid, int nb, char* smem) {
    DenseSched S; S.init(NTOK, D_, D_, p.woutT, nb, bid);
    EpiOutproj E{p.x, p.x1};
    gemm256(smem, (const char*)p.merged, D_, S, E);
}

__device__ __forceinline__ float red8f(float x) {
    x += dppf<0xB1>(x);
    x += dppf<0x4E>(x);
    x += dppf<0x141>(x);
    return x;
}
__device__ void ph_route(const P& p, int bid, int nb, char* smem) {
    float* wr = (float*)smem;
    const int tid = get_tid(), lane = tid & 63, wv = tid >> 6;
    {
        u16* Tl = (u16*)smem;
        const int t = get_tid();
        const int lrow = t >> 3, lc8 = (t & 7) * 8;
        const int sslot = t >> 3, skc = t & 7;
        const int scol = (sslot & 32) + perm32(sslot & 31);
        constexpr int NT13 = NEXP * 2 * 4 * 16, NT2 = NEXP * 16 * 4;
        for (int tile = bid; tile < NT13 + NT2; tile += nb) {
            const float* src; u16* dst; int N, Kd;
            if (tile < NT13) {
                const int kt = tile & 15, sg = (tile >> 4) & 3, half = (tile >> 6) & 1, e = tile >> 7;
                const int sl0 = sg * 64;
                N = 256; Kd = D_;
                src = ((sl0 >> 7) ? p.e_w3 : p.e_w1) + (size_t)e * D_ * 256 + (size_t)(kt * 64) * 256 + half * 128 + (sl0 & 127);
                dst = p.ew1T + ((size_t)e * 512 + half * 256 + sl0) * D_ + kt * 64;
            } else {
                const int t2 = tile - NT13;
                const int kt = t2 & 3, sg = (t2 >> 2) & 15, e = t2 >> 6;
                N = D_; Kd = 256;
                src = p.e_w2 + (size_t)e * 256 * D_ + (size_t)(kt * 64) * D_ + sg * 64;
                dst = p.ew2T + ((size_t)e * D_ + sg * 64) * 256 + kt * 64;
            }
            const float4 f0 = *(const float4*)&src[(size_t)lrow * N + lc8], f1 = *(const float4*)&src[(size_t)lrow * N + lc8 + 4];
            __syncthreads();
            const unsigned h0 = pack2(f0.x, f0.y), h1 = pack2(f0.z, f0.w), h2 = pack2(f1.x, f1.y), h3 = pack2(f1.z, f1.w);
            Tl[(lc8 + 0) * 72 + lrow] = (u16)(h0 & 0xFFFFu); Tl[(lc8 + 1) * 72 + lrow] = (u16)(h0 >> 16);
            Tl[(lc8 + 2) * 72 + lrow] = (u16)(h1 & 0xFFFFu); Tl[(lc8 + 3) * 72 + lrow] = (u16)(h1 >> 16);
            Tl[(lc8 + 4) * 72 + lrow] = (u16)(h2 & 0xFFFFu); Tl[(lc8 + 5) * 72 + lrow] = (u16)(h2 >> 16);
            Tl[(lc8 + 6) * 72 + lrow] = (u16)(h3 & 0xFFFFu); Tl[(lc8 + 7) * 72 + lrow] = (u16)(h3 >> 16);
            __syncthreads();
            *(uint4*)&dst[(size_t)sslot * Kd + skc * 8] = *(const uint4*)&Tl[scol * 72 + skc * 8];
        }
        __syncthreads();
    }
    for (int i = tid; i < 1024 * 36; i += NT) {
        const int k = i / 36, j = i - k * 36;
        const int kp = (k & ~31) + ((k & 3) << 3) + ((k >> 2) & 7);
        wr[kp * 36 + j] = (j < 4) ? p.w_grp[k * 4 + j] : p.w_exp[k * 32 + (j - 4)];
    }
    int* lcount = (int*)(smem + 1024 * 36 * 4);
    if (tid < 32) lcount[tid] = 0;
    __syncthreads();
    const int sub = lane & 7, tk = lane >> 3;
    for (int n0 = (bid * NW + wv) * 16; n0 < NTOK; n0 += nb * NW * 16) {
        float acc[2][36]; float ss[2] = {0.f, 0.f};
#pragma unroll
        for (int t = 0; t < 2; t++)
#pragma unroll
            for (int j = 0; j < 36; j++) acc[t][j] = 0.f;
#pragma unroll 1
        for (int i0 = 0; i0 < 32; i0 += 4) {
            float4 xv[2][4];
#pragma unroll
            for (int t = 0; t < 2; t++)
#pragma unroll
                for (int i = 0; i < 4; i++) xv[t][i] = *(const float4*)&p.x1[(size_t)(n0 + 8 * t + tk) * D_ + (i0 + i) * 32 + sub * 4];
#pragma unroll
            for (int i = 0; i < 4; i++) {
                const int k0 = (i0 + i) * 32 + sub * 4;
                const float4 gf = *(const float4*)&p.g_ffn[k0];
                float hv[2][4];
#pragma unroll
                for (int t = 0; t < 2; t++) {
                    const float4 x = xv[t][i];
                    ss[t] += x.x * x.x + x.y * x.y + x.z * x.z + x.w * x.w;
                    hv[t][0] = x.x * gf.x; hv[t][1] = x.y * gf.y; hv[t][2] = x.z * gf.z; hv[t][3] = x.w * gf.w;
                    uint2 o; o.x = pack2(hv[t][0], hv[t][1]); o.y = pack2(hv[t][2], hv[t][3]);
                    *(uint2*)&p.hbuf[(size_t)(n0 + 8 * t + tk) * D_ + k0] = o;
                }
#pragma unroll
                for (int e2 = 0; e2 < 4; e2++) {
                    asm volatile("" ::: "memory");
                    const float* wrow = wr + ((i0 + i) * 32 + e2 * 8 + sub) * 36;
#pragma unroll
                    for (int j4 = 0; j4 < 9; j4++) {
                        const float4 wv4 = *(const float4*)&wrow[j4 * 4];
#pragma unroll
                        for (int t = 0; t < 2; t++) {
                            acc[t][j4 * 4 + 0] += hv[t][e2] * wv4.x; acc[t][j4 * 4 + 1] += hv[t][e2] * wv4.y;
                            acc[t][j4 * 4 + 2] += hv[t][e2] * wv4.z; acc[t][j4 * 4 + 3] += hv[t][e2] * wv4.w;
                        }
                    }
                }
            }
        }
#pragma unroll
        for (int t = 0; t < 2; t++) {
            const size_t n = (size_t)n0 + 8 * t + tk;
            const float sst = red8f(ss[t]);
#pragma unroll
            for (int j = 0; j < 36; j++) acc[t][j] = red8f(acc[t][j]);
            const float rs = rsqrtf(sst * (1.f / D_) + 1e-6f);
            if (sub == 0) {
                p.rsb[n] = rs;
                float gl[4]; int gs = 0;
#pragma unroll
                for (int j = 0; j < 4; j++) gl[j] = acc[t][j] * rs + p.b_grp[j];
                float gm = gl[0];
#pragma unroll
                for (int j = 1; j < 4; j++) if (gl[j] > gm) { gm = gl[j]; gs = j; }
                float gsum = 0.f;
#pragma unroll
                for (int j = 0; j < 4; j++) gsum += __expf(gl[j] - gm);
                const float pg = 1.f / gsum;
                float el[8]; float em = -3.0e38f;
#pragma unroll
                for (int j = 0; j < 8; j++) {
                    float a = (gs == 0) ? acc[t][4 + j] : ((gs == 1) ? acc[t][12 + j] : ((gs == 2) ? acc[t][20 + j] : acc[t][28 + j]));
                    a = a * rs + p.b_exp[gs * 8 + j];
                    el[j] = a; em = fmaxf(em, a);
                }
                int j0 = 0, j1 = -1; float v0 = -3.0e38f, v1 = -3.0e38f;
#pragma unroll
                for (int j = 0; j < 8; j++) { el[j] = __expf(el[j] - em); }
#pragma unroll
                for (int j = 0; j < 8; j++) { if (el[j] > v0) { v0 = el[j]; j0 = j; } }
#pragma unroll
                for (int j = 0; j < 8; j++) { if (j != j0 && el[j] > v1) { v1 = el[j]; j1 = j; } }
                const float den = v0 + v1;
                const int e0 = gs * 8 + j0, e1 = gs * 8 + j1;
                p.tok_e[n * 2] = e0; p.tok_e[n * 2 + 1] = e1;
                p.tok_gate[n * 2] = pg * v0 / den; p.tok_gate[n * 2 + 1] = pg * v1 / den;
                atomicAdd(&lcount[e0], 1); atomicAdd(&lcount[e1], 1);
            }
        }
    }
    __syncthreads();
    { const int t2 = get_tid(); if (t2 < 32) { const int c = lcount[t2]; if (c) atomicAdd(&p.counts[t2], c); } }
}

__device__ void ph_scatter(const P& p, int bid, int nb, char* smem) {
    int* offl = (int*)smem;
    int* hist = offl + 64;
    int* gbase = hist + 32;
    const int tid = get_tid();
    if (tid == 0) {
        int off = 0;
        for (int e = 0; e < NEXP; e++) { offl[e] = off; off += p.counts[e]; }
        offl[NEXP] = off;
    }
    if (bid == 0 && tid == 64) {
        int off = 0, nb_ = 0;
        for (int e = 0; e < NEXP; e++) {
            const int c = p.counts[e];
            p.offs[e] = off;
            for (int r = 0; r < c; r += 256) { p.blk_e[nb_] = e; p.blk_r0[nb_] = off + r; nb_++; }
            off += c;
        }
        p.offs[NEXP] = off;
        *p.nblk = nb_;
    }
    for (int base = bid * NT; base < NTOK * 2; base += nb * NT) {
        __syncthreads();
        if (tid < 32) hist[tid] = 0;
        __syncthreads();
        const int i = base + tid;
        const int e = p.tok_e[i];
        const int rl = atomicAdd(&hist[e], 1);
        __syncthreads();
        if (tid < 32) gbase[tid] = atomicAdd(&p.cursor[tid], hist[tid]);
        __syncthreads();
        const int slot = offl[e] + gbase[e] + rl;
        p.list_tok[slot] = i >> 1; p.list_gate[slot] = p.tok_gate[i]; p.tokslot[i] = slot;
    }
}
template <int CTS>
struct MoeSched {
    const P* pp; int nunits, G, c; unsigned rowbytes; const u16* Bt; size_t b_estride, b_tstride;
    bool gather;
    __device__ __forceinline__ bool next(int i, GUnit& u) const {
        const int L = i * G + c; if (L >= nunits) return false;
        int wgid = L; { const int q = nunits >> 3, r = nunits & 7, xcd = wgid & 7, off = wgid >> 3; wgid = (xcd < r ? xcd * (q + 1) : r * (q + 1) + (xcd - r) * q) + off; }
        u.pm = wgid / CTS; u.pn = wgid & (CTS - 1); return true;
    }
    __device__ __forceinline__ unsigned a_off(const GUnit& u, int h, int R) const {
        const P& p = *pp;
        const int e = __builtin_amdgcn_readfirstlane(p.blk_e[u.pm]), rend = __builtin_amdgcn_readfirstlane(p.offs[e + 1]);
        int sl = __builtin_amdgcn_readfirstlane(p.blk_r0[u.pm]) + h * 128 + R; if (sl >= rend) sl = rend - 1;
        return (unsigned)(gather ? p.list_tok[sl] : sl) * rowbytes;
    }
    __device__ __forceinline__ const char* b_ptr(const GUnit& u) const { return (const char*)(Bt + (size_t)__builtin_amdgcn_readfirstlane(pp->blk_e[u.pm]) * b_estride + (size_t)u.pn * b_tstride); }
};
struct EpiMoe1 {
    const P* pp;
    __device__ __forceinline__ void operator()(const f32x4 (&acc)[2][2][4][2], const GUnit& u, int, int, int, int) const {
        const int t2_ = get_tid(), wid_ = __builtin_amdgcn_readfirstlane(t2_ >> 6), wr = wid_ >> 2, wc = wid_ & 3, fr = t2_ & 15, fq = (t2_ >> 4) & 3;
        const P& p = *pp;
        const int e = __builtin_amdgcn_readfirstlane(p.blk_e[u.pm]), r0 = __builtin_amdgcn_readfirstlane(p.blk_r0[u.pm]), rend = __builtin_amdgcn_readfirstlane(p.offs[e + 1]);
#pragma unroll
        for (int ai = 0; ai < 2; ++ai)
#pragma unroll
            for (int m = 0; m < 4; ++m) {
                const int sl = r0 + ai * 128 + wr * 64 + m * 16 + fr;
                if (sl < rend) {
                    const float rs = p.rsb[p.list_tok[sl]];
                    f32x4 v[2];
#pragma unroll
                    for (int n = 0; n < 2; ++n)
#pragma unroll
                        for (int r = 0; r < 4; r++) { const float a = acc[ai][0][m][n][r] * rs; v[n][r] = a * sigmoidf_(a) * (acc[ai][1][m][n][r] * rs); }
                    *(uint4*)&p.hid[(size_t)sl * 256 + u.pn * 128 + wc * 32 + 8 * fq] = pack8(v[0], v[1]);
                }
            }
    }
};
__device__ void ph_moe1(const P& p, int bid, int nb, char* smem) {
    MoeSched<2> S{&p, __builtin_amdgcn_readfirstlane(*p.nblk) * 2, nb, bid, (unsigned)(D_ * 2), p.ew1T, (size_t)512 * D_, (size_t)256 * D_, true};
    EpiMoe1 E{&p};
    gemm256(smem, (const char*)p.hbuf, D_, S, E);
}
struct EpiMoe2 {
    const P* pp;
    __device__ __forceinline__ void operator()(const f32x4 (&acc)[2][2][4][2], const GUnit& u, int, int, int, int) const {
        const int t2_ = get_tid(), wid_ = __builtin_amdgcn_readfirstlane(t2_ >> 6), wr = wid_ >> 2, wc = wid_ & 3, fr = t2_ & 15, fq = (t2_ >> 4) & 3;
        const P& p = *pp;
        const int e = __builtin_amdgcn_readfirstlane(p.blk_e[u.pm]), r0 = __builtin_amdgcn_readfirstlane(p.blk_r0[u.pm]), rend = __builtin_amdgcn_readfirstlane(p.offs[e + 1]);
#pragma unroll
        for (int ai = 0; ai < 2; ++ai)
#pragma unroll
            for (int m = 0; m < 4; ++m) {
                const int sl = r0 + ai * 128 + wr * 64 + m * 16 + fr;
                if (sl < rend) {
                    const float gt = p.list_gate[sl];
                    u16* yp = p.ybuf + (size_t)sl * D_ + u.pn * 256 + wc * 32 + 8 * fq;
#pragma unroll
                    for (int bj = 0; bj < 2; ++bj) *(uint4*)&yp[bj * 128] = pack8(acc[ai][bj][m][0] * gt, acc[ai][bj][m][1] * gt);
                }
            }
    }
};
__device__ void ph_moe2(const P& p, int bid, int nb, char* smem) {
    MoeSched<4> S{&p, __builtin_amdgcn_readfirstlane(*p.nblk) * 4, nb, bid, 512u, p.ew2T, (size_t)D_ * 256, (size_t)256 * 256, false};
    EpiMoe2 E{&p};
    gemm256(smem, (const char*)p.hid, 256, S, E);
}
__device__ void ph_final(const P& p, int bid, int nb, char* smem) {
    const int tid = get_tid(), lane = tid & 63, wv = tid >> 6;
    for (int row = bid * NW + wv; row < NTOK; row += nb * NW) {
        const int s0 = p.tokslot[row * 2], s1 = p.tokslot[row * 2 + 1];
        float v[16]; float ss = 0.f;
#pragma unroll
        for (int i = 0; i < 4; i++) {
            const int c = i * 256 + lane * 4;
            const float4 t = *(const float4*)&p.x1[(size_t)row * D_ + c];
            const uint2 a = *(const uint2*)&p.ybuf[(size_t)s0 * D_ + c];
            const uint2 bq = *(const uint2*)&p.ybuf[(size_t)s1 * D_ + c];
            v[4 * i]     = t.x + __uint_as_float(a.x << 16) + __uint_as_float(bq.x << 16);
            v[4 * i + 1] = t.y + __uint_as_float(a.x & 0xFFFF0000u) + __uint_as_float(bq.x & 0xFFFF0000u);
            v[4 * i + 2] = t.z + __uint_as_float(a.y << 16) + __uint_as_float(bq.y << 16);
            v[4 * i + 3] = t.w + __uint_as_float(a.y & 0xFFFF0000u) + __uint_as_float(bq.y & 0xFFFF0000u);
            ss += v[4 * i] * v[4 * i] + v[4 * i + 1] * v[4 * i + 1] + v[4 * i + 2] * v[4 * i + 2] + v[4 * i + 3] * v[4 * i + 3];
        }
        ss = wave_sum(ss);
        const float rs = rsqrtf(ss * (1.f / D_) + 1e-6f);
#pragma unroll
        for (int i = 0; i < 4; i++) {
            const int c = i * 256 + lane * 4;
            const float4 g = *(const float4*)&p.g_final[c];
            float4 o; o.x = v[4 * i] * rs * g.x; o.y = v[4 * i + 1] * rs * g.y; o.z = v[4 * i + 2] * rs * g.z; o.w = v[4 * i + 3] * rs * g.w;
            *(float4*)&p.out[(size_t)row * D_ + c] = o;
        }
    }
}

#define XB_TMO      128
#define XB_XCNT(j)  (256  + 64 * (j))
#define XB_XSUB(j)  (1280 + 64 * (j))
#define XB_XGEN(j)  (2304 + 64 * (j))
#define XB_TOP      3328
#define XB_TOPGEN   3392
#define XCD_BAR_WORDS 3456
#define XB_SPIN_CAP (1u << 18)
#define LAS __attribute__((address_space(3)))

__device__ __forceinline__ unsigned xb_ld(unsigned* p)              { return __hip_atomic_load(p, __ATOMIC_RELAXED, __HIP_MEMORY_SCOPE_AGENT); }
__device__ __forceinline__ unsigned xb_add(unsigned* p, unsigned v) { return __hip_atomic_fetch_add(p, v, __ATOMIC_RELAXED, __HIP_MEMORY_SCOPE_AGENT); }
__device__ __forceinline__ unsigned xb_xcc_id() { return (unsigned)__builtin_amdgcn_s_getreg((3 << 11) | 20) & 0xFu; }
#define XB_SPIN(cond, bar) do { unsigned _sp = 0; while (cond) { __builtin_amdgcn_s_sleep(1); \
    if ((++_sp & 255u) == 0u) { if (xb_ld(&(bar)[XB_TMO])) break; if (_sp > XB_SPIN_CAP) { atomicAdd(&(bar)[XB_TMO], 1u); break; } } } } while (0)

struct XcdBarrier {
    unsigned* bar; unsigned x;
    volatile LAS unsigned* st;
};

__device__ __forceinline__ XcdBarrier xcd_barrier_post(unsigned* bar, volatile LAS unsigned* st) {
    XcdBarrier b; b.bar = bar; b.x = xb_xcc_id(); b.st = st;
    if (threadIdx.x == 0) (void)xb_add(&bar[XB_XCNT(b.x)], 1u);
    return b;
}
__device__ __forceinline__ void xcd_barrier_complete(unsigned* bar, unsigned x, unsigned& nloc, unsigned& nx) {
    const unsigned G = gridDim.x * gridDim.y * gridDim.z;
    unsigned sum, cnt, mine, sp = 0u;
    for (;;) {
        sum = 0u; cnt = 0u; mine = 0u;
#pragma unroll
        for (unsigned j = 0; j < 16; ++j) { const unsigned c = xb_ld(&bar[XB_XCNT(j)]); sum += c; cnt += (c > 0u) ? 1u : 0u; mine = (j == x) ? c : mine; }
        if (sum == G) break;
        __builtin_amdgcn_s_sleep(1);
        if ((++sp & 255u) == 0u) { if (xb_ld(&bar[XB_TMO])) break; if (sp > XB_SPIN_CAP) { atomicAdd(&bar[XB_TMO], 1u); break; } }
    }
    nloc = mine > 0u ? mine : 1u; nx = cnt > 0u ? cnt : 1u;
}

__device__ __forceinline__ void xcd_barrier(const XcdBarrier& b) {
    asm volatile("s_waitcnt vmcnt(0)" ::: "memory");
    __syncthreads();
    if (threadIdx.x == 0) {
        unsigned* bar = b.bar;
        __builtin_amdgcn_s_waitcnt(0);
        unsigned nloc = b.st[0], nx = b.st[1];
        if (nloc == 0u) { xcd_barrier_complete(bar, b.x, nloc, nx); b.st[0] = nloc; b.st[1] = nx; }
        const unsigned old = xb_add(&bar[XB_XSUB(b.x)], 1u);
        const unsigned gen = old / nloc;
        if (old + 1u == (gen + 1u) * nloc) {
            __builtin_amdgcn_fence(__ATOMIC_RELEASE, "agent");
            asm volatile("s_waitcnt vmcnt(0)" ::: "memory");
            const unsigned og = xb_add(&bar[XB_TOP], 1u);
            const unsigned tg = og / nx;
            if (og + 1u == (tg + 1u) * nx) xb_add(&bar[XB_TOPGEN], 1u);
            else XB_SPIN(xb_ld(&bar[XB_TOPGEN]) == tg, bar);
            __builtin_amdgcn_fence(__ATOMIC_ACQUIRE, "agent");
            xb_add(&bar[XB_XGEN(b.x)], 1u);
            asm volatile("s_waitcnt vmcnt(0)" ::: "memory");
        } else {
            XB_SPIN(xb_ld(&bar[XB_XGEN(b.x)]) == gen, bar);
            __builtin_amdgcn_fence(__ATOMIC_ACQUIRE, "agent");
            asm volatile("s_waitcnt vmcnt(0)" ::: "memory");
        }
    }
    __syncthreads();
}

template <int PH>
__device__ __forceinline__ void run_phase(const P& p, int bid, int nb, char* smem) {
    if constexpr (PH == 0) ph_prologue(p, bid, nb, smem);
    if constexpr (PH == 1) ph_inproj(p, bid, nb, smem);
    if constexpr (PH == 2) { ph_compress(p, bid, nb, smem); __syncthreads(); ph_rwkv_chunk(p, bid, nb, smem); }
    if constexpr (PH == 3) {
        if (bid < SCAN_BLOCKS) ph_rwkv_seq(p, bid, SCAN_BLOCKS, smem);
        else ph_nsa(p, bid - SCAN_BLOCKS, nb - SCAN_BLOCKS, smem);
    }
    if constexpr (PH == 12) ph_rwkv_out(p, bid, nb, smem);
    if constexpr (PH == 4) ph_merge(p, bid, nb, smem);
    if constexpr (PH == 5) ph_outproj(p, bid, nb, smem);
    if constexpr (PH == 6) ph_route(p, bid, nb, smem);
    if constexpr (PH == 7) ph_scatter(p, bid, nb, smem);
    if constexpr (PH == 9) ph_moe1(p, bid, nb, smem);
    if constexpr (PH == 10) ph_moe2(p, bid, nb, smem);
    if constexpr (PH == 11) ph_final(p, bid, nb, smem);
}

template <int PH>
__global__ void __launch_bounds__(NT) kph(P p) {
    extern __shared__ __attribute__((aligned(16))) char smem[];
    run_phase<PH>(p, blockIdx.x, gridDim.x, smem);
}

__global__ void __launch_bounds__(NT, 2) mega(P p) {
    extern __shared__ __attribute__((aligned(16))) char smem[];
    volatile LAS unsigned* st = (volatile LAS unsigned*)(smem + SMEM_BYTES - 16);
    if (threadIdx.x == 0) { st[0] = 0u; st[1] = 0u; st[2] = 0u; st[3] = 0u; }
    __syncthreads();
    XcdBarrier bar = xcd_barrier_post(p.bar, st);
    const int bid = blockIdx.x, nb = gridDim.x;
#define RUNP(N, BAR) { unsigned long long t0_ = 0; if ((TPROBE >> N) & 1) t0_ = __builtin_amdgcn_s_memrealtime(); run_phase<N>(p, bid, nb, smem); \
        unsigned long long tw_ = 0; if (((TPROBE >> N) & 1) && TPSEL) tw_ = __builtin_amdgcn_s_memrealtime() - t0_; if (BAR) xcd_barrier(bar); \
        if ((TPROBE >> N) & 1) { const unsigned long long t1_ = __builtin_amdgcn_s_memrealtime(); const unsigned long long dt_ = TPSEL ? tw_ : t1_ - t0_; \
            if (!TPSEL || (TPSEL == 1 ? (bid < SCAN_BLOCKS) : (bid >= SCAN_BLOCKS))) while (__builtin_amdgcn_s_memrealtime() - t1_ < dt_) __builtin_amdgcn_s_sleep(8); if (TPSEL) xcd_barrier(bar); } }
    RUNP(0, 1) RUNP(1, 1) RUNP(2, 1) RUNP(3, 1) RUNP(12, 1) RUNP(4, 1) RUNP(5, 1) RUNP(6, 1) RUNP(7, 1) RUNP(9, 1) RUNP(10, 1) RUNP(11, 0)
}

extern "C" void kernel_launch(void* const* d_in, const int* in_sizes, int n_in,
                              void* d_out, int out_size, void* d_ws, size_t ws_size,
                              hipStream_t stream) {
    P p{};
    p.x = (const float*)d_in[0]; p.pos = (const int*)d_in[1]; p.g_mix = (const float*)d_in[2]; p.w_in = (const float*)d_in[3];
    p.pe_k = (const float*)d_in[4]; p.w1_k = (const float*)d_in[5]; p.b1_k = (const float*)d_in[6]; p.w2_k = (const float*)d_in[7]; p.b2_k = (const float*)d_in[8];
    p.pe_v = (const float*)d_in[9]; p.w1_v = (const float*)d_in[10]; p.b1_v = (const float*)d_in[11]; p.w2_v = (const float*)d_in[12]; p.b2_v = (const float*)d_in[13];
    p.mu = (const float*)d_in[14]; p.w0 = (const float*)d_in[15]; p.w2 = (const float*)d_in[16]; p.a0 = (const float*)d_in[17]; p.a2 = (const float*)d_in[18];
    p.g2 = (const float*)d_in[19]; p.k_k = (const float*)d_in[20]; p.k_a = (const float*)d_in[21]; p.r_k = (const float*)d_in[22]; p.ln_w = (const float*)d_in[23]; p.ln_b = (const float*)d_in[24];
    p.wpa = (const float*)d_in[25]; p.wpb = (const float*)d_in[26]; p.wout = (const float*)d_in[27]; p.g_ffn = (const float*)d_in[28];
    p.w_grp = (const float*)d_in[29]; p.b_grp = (const float*)d_in[30]; p.w_exp = (const float*)d_in[31]; p.b_exp = (const float*)d_in[32];
    p.e_w1 = (const float*)d_in[33]; p.e_w3 = (const float*)d_in[34]; p.e_w2 = (const float*)d_in[35]; p.g_final = (const float*)d_in[36];
    p.out = (float*)d_out;
    char* ws = (char*)d_ws;
    const size_t MiB = 1ull << 20;
    p.hbuf = (u16*)(ws + 0 * MiB);
    p.q    = (u16*)(ws + 64 * MiB);
    p.kc   = (u16*)(ws + 96 * MiB);  p.vc   = (u16*)(ws + 104 * MiB);
    p.ksl  = (u16*)(ws + 112 * MiB); p.vslT = (u16*)(ws + 120 * MiB);
    p.kwn  = (u16*)(ws + 128 * MiB); p.vwnT = (u16*)(ws + 136 * MiB);
    p.nsag = (float*)(ws + 144 * MiB);
    p.kcb  = (u16*)(ws + 148 * MiB); p.vcT  = (u16*)(ws + 149 * MiB);
    p.prw  = (u16*)(ws + 160 * MiB);
    p.cdat = (u16*)(ws + 272 * MiB);
    p.bon  = (float*)(ws + 150 * MiB);
    p.w2T  = (u16*)(ws + 151 * MiB); p.a2T = p.w2T + 512 * 64; p.g2T = p.a2T + 512 * 64;
    p.cw1Tk = (u16*)(ws + 152 * MiB); p.cw1Tv = (u16*)(ws + 153 * MiB);
    p.cw2Tk = (u16*)(ws + 154 * MiB); p.cw2Tv = p.cw2Tk + 128 * 256;
    p.chid = (u16*)(ws + 155 * MiB);
    p.xact = (u16*)(ws + 488 * MiB);
    p.oa   = (u16*)(ws + 400 * MiB);
    p.ob   = (u16*)(ws + 432 * MiB);
    p.merged = (u16*)(ws + 64 * MiB);
    p.x1   = (float*)(ws + 160 * MiB);
    char* rt = ws + 288 * MiB;
    p.tok_e = (int*)(rt);                        rt += NTOK * 2 * 4;
    p.tok_gate = (float*)(rt);                   rt += NTOK * 2 * 4;
    p.tokslot = (int*)(rt);                      rt += NTOK * 2 * 4;
    p.list_tok = (int*)(rt);                     rt += NTOK * 2 * 4;
    p.list_gate = (float*)(rt);                  rt += NTOK * 2 * 4;
    p.blk_e = (int*)(rt);                        rt += 2048 * 4;
    p.blk_r0 = (int*)(rt);                       rt += 2048 * 4;
    p.rsb = (float*)(rt);                        rt += NTOK * 4;
    p.hid  = (u16*)(ws + 296 * MiB);
    p.ybuf = (u16*)(ws + 336 * MiB);
    char* misc = ws + 470 * MiB;
    p.counts = (int*)(misc); p.cursor = (int*)(misc + 256); p.offs = (int*)(misc + 512); p.nblk = (int*)(misc + 1024); p.nsactr = (int*)(misc + 2048);
    p.bar = (unsigned*)(ws + 471 * MiB);
    p.cb1k = (float*)(misc + 65536); p.cb1v = p.cb1k + 256;
    {
        char* wa = ws + 472 * MiB;
        p.winT = (u16*)wa;  wa += (size_t)3328 * 1024 * 2;
        p.wgT  = (u16*)wa;  wa += (size_t)2048 * 1024 * 2;
        p.wpaT = (u16*)wa;  wa += (size_t)1024 * 512 * 2;
        p.wpbT = (u16*)wa;  wa += (size_t)1024 * 512 * 2;
        p.woutT = (u16*)wa; wa += (size_t)1024 * 1024 * 2;
        p.ew1T = (u16*)(ws + 64 * MiB);  p.ew3T = (u16*)(ws + 80 * MiB);  p.ew2T = (u16*)(ws + 96 * MiB);
    }
    if (ws_size < (size_t)505 * MiB) return;

#if MEGA
    {
        static int mgrid = 0;
        if (mgrid == 0) {
            int dev = 0, cus = 0, per_cu = 0;
            hipGetDevice(&dev);
            hipDeviceGetAttribute(&cus, hipDeviceAttributeMultiprocessorCount, dev);
            hipFuncSetAttribute((const void*)mega, hipFuncAttributeMaxDynamicSharedMemorySize, SMEM_BYTES);
            hipOccupancyMaxActiveBlocksPerMultiprocessor(&per_cu, (const void*)mega, NT, SMEM_BYTES);
            (void)hipGetLastError();
            mgrid = cus;
        }
        hipMemsetAsync(p.bar, 0, XCD_BAR_WORDS * sizeof(unsigned) + 512 * sizeof(float), stream);
        mega<<<mgrid, NT, SMEM_BYTES, stream>>>(p);
        return;
    }
#else
    const int grid = 512;
    hipMemsetAsync(p.bar, 0, XCD_BAR_WORDS * sizeof(unsigned) + 512 * sizeof(float), stream);
    hipFuncSetAttribute((const void*)kph<0>, hipFuncAttributeMaxDynamicSharedMemorySize, SMEM_BYTES);
    hipFuncSetAttribute((const void*)kph<1>, hipFuncAttributeMaxDynamicSharedMemorySize, SMEM_BYTES);
    hipFuncSetAttribute((const void*)kph<2>, hipFuncAttributeMaxDynamicSharedMemorySize, SMEM_BYTES);
    hipFuncSetAttribute((const void*)kph<3>, hipFuncAttributeMaxDynamicSharedMemorySize, SMEM_BYTES);
    hipFuncSetAttribute((const void*)kph<4>, hipFuncAttributeMaxDynamicSharedMemorySize, SMEM_BYTES);
    hipFuncSetAttribute((const void*)kph<5>, hipFuncAttributeMaxDynamicSharedMemorySize, SMEM_BYTES);
    hipFuncSetAttribute((const void*)kph<6>, hipFuncAttributeMaxDynamicSharedMemorySize, SMEM_BYTES);
    hipFuncSetAttribute((const void*)kph<7>, hipFuncAttributeMaxDynamicSharedMemorySize, SMEM_BYTES);
    hipFuncSetAttribute((const void*)kph<8>, hipFuncAttributeMaxDynamicSharedMemorySize, SMEM_BYTES);
    hipFuncSetAttribute((const void*)kph<9>, hipFuncAttributeMaxDynamicSharedMemorySize, SMEM_BYTES);
    hipFuncSetAttribute((const void*)kph<10>, hipFuncAttributeMaxDynamicSharedMemorySize, SMEM_BYTES);
    hipFuncSetAttribute((const void*)kph<11>, hipFuncAttributeMaxDynamicSharedMemorySize, SMEM_BYTES);
    kph<0><<<grid, NT, SMEM_BYTES, stream>>>(p);
    kph<1><<<grid, NT, SMEM_BYTES, stream>>>(p);
    kph<2><<<grid, NT, SMEM_BYTES, stream>>>(p);
    kph<3><<<grid, NT, SMEM_BYTES, stream>>>(p);
    kph<12><<<grid, NT, SMEM_BYTES, stream>>>(p);
    kph<4><<<grid, NT, SMEM_BYTES, stream>>>(p);
    kph<5><<<grid, NT, SMEM_BYTES, stream>>>(p);
    kph<6><<<grid, NT, SMEM_BYTES, stream>>>(p);
    kph<7><<<grid, NT, SMEM_BYTES, stream>>>(p);
    kph<8><<<grid, NT, SMEM_BYTES, stream>>>(p);
    kph<9><<<grid, NT, SMEM_BYTES, stream>>>(p);
    kph<10><<<grid, NT, SMEM_BYTES, stream>>>(p);
    kph<11><<<grid, NT, SMEM_BYTES, stream>>>(p);
#endif
}
```

```cpp
#include <hip/hip_runtime.h>
#include <stdint.h>

typedef unsigned short u16;
using bf16x8 = __attribute__((ext_vector_type(8))) short;
using f32x4  = __attribute__((ext_vector_type(4))) float;

#ifndef MEGA
#define MEGA 1
#endif

constexpr int B_ = 4, S_ = 8192, D_ = 1024, NTOK = B_ * S_;
constexpr int CIN = 5144;
constexpr int NCMP = 511;
constexpr int CRW = 1792;
constexpr int NEXP = 32;
constexpr int NT = 512;
constexpr int NW = NT / 64;
constexpr int SMEM_BYTES = 160 * 1024;
constexpr int SCAN_BLOCKS = 16;
#ifndef TPROBE
#define TPROBE 0
#define TPSEL 0
#endif
constexpr float QSCALE = 0.125f * 1.4426950408889634f;

struct P {
    const float* x; const int* pos; const float* g_mix; const float* w_in;
    const float *pe_k, *w1_k, *b1_k, *w2_k, *b2_k, *pe_v, *w1_v, *b1_v, *w2_v, *b2_v;
    const float *mu, *w0, *w2, *a0, *a2, *g2, *k_k, *k_a, *r_k, *ln_w, *ln_b;
    const float *wpa, *wpb, *wout, *g_ffn, *w_grp, *b_grp, *w_exp, *b_exp, *e_w1, *e_w3, *e_w2, *g_final;
    float* out;
    u16* hbuf; u16 *q, *kc, *vc, *ksl, *vslT, *kwn, *vwnT, *kcb, *vcT; float* nsag; u16* prw;
    u16* cdat; float* bon; u16 *w2T, *a2T, *g2T; u16 *oa, *ob; u16* merged; float* x1;
    int* tok_e; float* tok_gate; int* tokslot; int* list_tok; float* list_gate;
    int* counts; int* offs; int* cursor; int* blk_e; int* blk_r0; int* nblk; float* rsb; int* nsactr;
    u16* hid; u16* ybuf; unsigned* bar;
    u16 *winT, *wgT, *wpaT, *wpbT, *woutT, *ew1T, *ew3T, *ew2T;
    u16 *cw1Tk, *cw1Tv, *cw2Tk, *cw2Tv, *chid, *xact; float *cb1k, *cb1v;
};

typedef __bf16 bf16x2_t __attribute__((ext_vector_type(2)));
typedef float f32x2_t __attribute__((ext_vector_type(2)));
__device__ __forceinline__ unsigned pack2(float a, float b) {
    f32x2_t f = {a, b};
    return __builtin_bit_cast(unsigned, __builtin_convertvector(f, bf16x2_t));
}
__device__ __forceinline__ u16 f2bf(float f) { return (u16)(pack2(f, f) & 0xFFFFu); }
__device__ __forceinline__ float bf2f(u16 h) { return __uint_as_float(((unsigned)h) << 16); }
__device__ __forceinline__ float sigmoidf_(float x) { return __builtin_amdgcn_rcpf(1.f + __expf(-x)); }
__device__ __forceinline__ int get_tid() { int t = threadIdx.x; asm volatile("" : "+v"(t)); return t; }
__device__ __forceinline__ uint2 pack4(const f32x4& v) { uint2 o; o.x = pack2(v[0], v[1]); o.y = pack2(v[2], v[3]); return o; }
__device__ __forceinline__ f32x4 unpack4(uint2 u) { return f32x4{__uint_as_float(u.x << 16), __uint_as_float(u.x & 0xFFFF0000u), __uint_as_float(u.y << 16), __uint_as_float(u.y & 0xFFFF0000u)}; }
#define LDS_BARRIER() do { asm volatile("s_waitcnt lgkmcnt(0)" ::: "memory"); __builtin_amdgcn_s_barrier(); asm volatile("" ::: "memory"); } while (0)
__device__ __forceinline__ int opaque(int x) { asm volatile("" : "+v"(x)); return x; }
template <int CTRL>
__device__ __forceinline__ float dppf(float x) { return __int_as_float(__builtin_amdgcn_update_dpp(0, __float_as_int(x), CTRL, 0xF, 0xF, true)); }
__device__ __forceinline__ float wave_sum(float v) {
    v += dppf<0xB1>(v);
    v += dppf<0x4E>(v);
    v += dppf<0x141>(v);
    v += dppf<0x140>(v);
    const int vi = __float_as_int(v);
    return (__int_as_float(__builtin_amdgcn_readlane(vi, 0)) + __int_as_float(__builtin_amdgcn_readlane(vi, 16)))
         + (__int_as_float(__builtin_amdgcn_readlane(vi, 32)) + __int_as_float(__builtin_amdgcn_readlane(vi, 48)));
}

__device__ __forceinline__ float xrow_sum(float v) {
    auto r = __builtin_amdgcn_permlane16_swap(__float_as_uint(v), __float_as_uint(v), false, false);
    v = __uint_as_float(r[0]) + __uint_as_float(r[1]);
    auto r2 = __builtin_amdgcn_permlane32_swap(__float_as_uint(v), __float_as_uint(v), false, false);
    return __uint_as_float(r2[0]) + __uint_as_float(r2[1]);
}
__device__ __forceinline__ float xrow_max(float v) {
    auto r = __builtin_amdgcn_permlane16_swap(__float_as_uint(v), __float_as_uint(v), false, false);
    v = fmaxf(__uint_as_float(r[0]), __uint_as_float(r[1]));
    auto r2 = __builtin_amdgcn_permlane32_swap(__float_as_uint(v), __float_as_uint(v), false, false);
    return fmaxf(__uint_as_float(r2[0]), __uint_as_float(r2[1]));
}
__constant__ double ROPE_FREQ[32] = {
    1.00000000000000000000e+00, 7.49894209332455874417e-01, 5.62341325190349072827e-01, 4.21696503428582225581e-01,
    3.16227766016837941176e-01, 2.37137370566165517349e-01, 1.77827941003892292526e-01, 1.33352143216332402753e-01,
    1.00000000000000005551e-01, 7.49894209332455791150e-02, 5.62341325190349114460e-02, 4.21696503428582239459e-02,
    3.16227766016837913421e-02, 2.37137370566165538166e-02, 1.77827941003892292526e-02, 1.33352143216332406223e-02,
    1.00000000000000002082e-02, 7.49894209332455791150e-03, 5.62341325190349097113e-03, 4.21696503428582291501e-03,
    3.16227766016837939442e-03, 2.37137370566165538166e-03, 1.77827941003892275179e-03, 1.33352143216332406223e-03,
    1.00000000000000002082e-03, 7.49894209332455856203e-04, 5.62341325190349097113e-04, 4.21696503428582237290e-04,
    3.16227766016837939442e-04, 2.37137370566165538166e-04, 1.77827941003892269758e-04, 1.33352143216332395381e-04};

constexpr int G_ABYTES = 256 * 64 * 2, G_BBYTES = 128 * 64 * 2, G_TILE = G_ABYTES + G_BBYTES;
#define LAS3 __attribute__((address_space(3)))
#define GAS1 __attribute__((address_space(1)))
__device__ __forceinline__ void glds16(const u16* g, char* l) {
    __builtin_amdgcn_global_load_lds((const GAS1 unsigned*)g, (LAS3 unsigned*)l, 16, 0, 0);
}
template <bool TR = false, class ARow>
__device__ __forceinline__ void gemm_core(int K, ARow arow, const u16* __restrict__ BT, int ldb, f32x4 (&acc)[4][4], u16* sm) {
    char* base = (char*)sm;
    const int tid = get_tid(), lane = tid & 63, wv = tid >> 6;
    const int wm = wv >> 1, wn = wv & 1, kr = lane & 15, qq = lane >> 4;
    const int lr = tid >> 3, lk = ((tid & 7) ^ ((lr >> 1) & 7)) * 8;
    const u16* ap0 = arow(lr) + lk; const u16* ap1 = arow(lr + 64) + lk;
    const u16* ap2 = arow(lr + 128) + lk; const u16* ap3 = arow(lr + 192) + lk;
    const u16* bp0 = BT + (size_t)lr * ldb + lk; const u16* bp1 = BT + (size_t)(lr + 64) * ldb + lk;
#pragma unroll
    for (int mt = 0; mt < 4; mt++)
#pragma unroll
        for (int nt = 0; nt < 4; nt++) acc[mt][nt] = f32x4{0.f, 0.f, 0.f, 0.f};
    const int nk = K >> 6;
#define G_ISSUE(t, b) { char* d = base + (b) * G_TILE + tid * 16; const int ko = (t) * 64; \
        glds16(ap0 + ko, d); glds16(ap1 + ko, d + 8192); glds16(ap2 + ko, d + 16384); glds16(ap3 + ko, d + 24576); \
        glds16(bp0 + ko, d + G_ABYTES); glds16(bp1 + ko, d + G_ABYTES + 8192); }
    const int sw = kr >> 1;
    const int po0 = ((0 * 4 + qq) ^ sw) * 16, po1 = ((1 * 4 + qq) ^ sw) * 16;
    const int aoff = (wm * 64 + kr) * 128, boff = G_ABYTES + (wn * 64 + kr) * 128;
#define G_READ(FA, FB, b) { const char* Ab = base + (b) * G_TILE + aoff; const char* Bb = base + (b) * G_TILE + boff; \
        _Pragma("unroll") for (int mt = 0; mt < 4; mt++) { FA[0][mt] = *(const bf16x8*)(Ab + mt * 2048 + po0); FA[1][mt] = *(const bf16x8*)(Ab + mt * 2048 + po1); } \
        _Pragma("unroll") for (int nt = 0; nt < 4; nt++) { FB[0][nt] = *(const bf16x8*)(Bb + nt * 2048 + po0); FB[1][nt] = *(const bf16x8*)(Bb + nt * 2048 + po1); } }
#define G_MMA(FA, FB) { __builtin_amdgcn_s_setprio(1); \
        _Pragma("unroll") for (int ks = 0; ks < 2; ks++) \
            _Pragma("unroll") for (int nt = 0; nt < 4; nt++) \
                _Pragma("unroll") for (int mt = 0; mt < 4; mt++) \
                    acc[mt][nt] = TR ? __builtin_amdgcn_mfma_f32_16x16x32_bf16(FA[ks][mt], FB[ks][nt], acc[mt][nt], 0, 0, 0) \
                                     : __builtin_amdgcn_mfma_f32_16x16x32_bf16(FB[ks][nt], FA[ks][mt], acc[mt][nt], 0, 0, 0); \
        __builtin_amdgcn_s_setprio(0); }
    bf16x8 fa0[2][4], fb0[2][4], fa1[2][4], fb1[2][4];
    G_ISSUE(0, 0)
    if (nk > 1) G_ISSUE(1, 1)
    if (nk > 2) G_ISSUE(2, 2)
    if (nk > 2) asm volatile("s_waitcnt vmcnt(12)" ::: "memory");
    else if (nk > 1) asm volatile("s_waitcnt vmcnt(6)" ::: "memory");
    else asm volatile("s_waitcnt vmcnt(0)" ::: "memory");
    __builtin_amdgcn_s_barrier();
    G_READ(fa0, fb0, 0)
    int bnext = 1, bfree = 0;
#define G_STEP(FAC, FBC, FAN, FBN, kt) { \
        if ((kt) + 1 < nk) { \
            if ((kt) + 2 < nk) asm volatile("s_waitcnt vmcnt(6) lgkmcnt(0)" ::: "memory"); else asm volatile("s_waitcnt vmcnt(0) lgkmcnt(0)" ::: "memory"); \
            __builtin_amdgcn_s_barrier();                   \
            if ((kt) + 3 < nk) G_ISSUE((kt) + 3, bfree) \
            G_READ(FAN, FBN, bnext) \
        } \
        G_MMA(FAC, FBC) \
        bfree = bnext; bnext = (bnext == 2) ? 0 : bnext + 1; }
    for (int kt = 0; kt < nk; kt += 2) {
        G_STEP(fa0, fb0, fa1, fb1, kt)
        G_STEP(fa1, fb1, fa0, fb0, kt + 1)
    }
    __builtin_amdgcn_s_barrier();
#undef G_READ
#undef G_MMA
#undef G_STEP
#undef G_ISSUE
}

__device__ __forceinline__ int xcd_item(int bid, int nb, int k, int nitems) {
    if (nb & 7) return bid + k * nb;
    const int per = nb >> 3, chunk = (nitems + 7) >> 3;
    const int j = k * per + (bid >> 3);
    return (j < chunk) ? (bid & 7) * chunk + j : nitems;
}
struct GUnit { int pm, pn; };
constexpr int G8_HTB = 128 * 64 * 2;
__device__ __forceinline__ int g8_lds_byte(int r, int c) { const int st = (r >> 4) * 2 + (c >> 5), rr = r & 15, cc = c & 31, ob = rr * 64 + cc * 2; return st * 1024 + (ob ^ (((ob >> 9) & 1) << 5)); }
__device__ __forceinline__ void g8_stage_rc(int b, int& R, int& C) { const int st = b / 1024, sb = b % 1024, swz = sb ^ (((sb >> 9) & 1) << 5); R = (st >> 1) * 16 + swz / 64; C = (st & 1) * 32 + (swz % 64) / 2; }
__host__ __device__ __forceinline__ int perm32(int rho) { const int n = rho >> 4, i = rho & 15; return 8 * (i >> 2) + 4 * n + (i & 3); }

template <class Epi, class Sched>
__device__ __forceinline__ void gemm256(char* smem, const char* Ab, int K, const Sched& S, const Epi& E) {
    LAS3 unsigned char* lds = (LAS3 unsigned char*)smem;
    const int tid = get_tid(), wid = __builtin_amdgcn_readfirstlane(tid >> 6), lane = tid & 63, wr = wid >> 2, wc = wid & 3, fr = lane & 15, fq = lane >> 4;
    int nt = K >> 6; asm volatile("" : "+s"(nt));
    unsigned voffB[2], voffA[2][2];
#pragma unroll
    for (int i = 0; i < 2; ++i) { int sR, sC; g8_stage_rc(tid * 16 + i * 8192, sR, sC); voffB[i] = (unsigned)(sR * K + sC) * 2u; }
#define G8_AOFFS(un) do { const int t3_ = get_tid(); _Pragma("unroll") for (int i = 0; i < 2; ++i) { int sR, sC; g8_stage_rc(t3_ * 16 + i * 8192, sR, sC); \
        _Pragma("unroll") for (int h = 0; h < 2; ++h) voffA[h][i] = S.a_off(un, h, sR) + (unsigned)sC * 2u; } } while (0)
    const size_t kstep = 128;
    const size_t hstep = (size_t)128 * K * 2;
    const unsigned ldsw = (unsigned)wid * 1024u;
    const int aoff = g8_lds_byte(wr * 64 + fr, fq * 8), boff = g8_lds_byte(wc * 32 + fr, fq * 8);
#define G8_SA(b, h) (((b) * 2 + (h)) * G8_HTB)
#define G8_SB(b, h) ((4 + (b) * 2 + (h)) * G8_HTB)
#define G8_STAGE2(bufoff, gbase, v0, v1) do { \
        __builtin_amdgcn_global_load_lds((const GAS1 unsigned*)((const char*)(gbase) + (v0)), (LAS3 unsigned*)(lds + (bufoff) + ldsw), 16, 0, 0); \
        __builtin_amdgcn_global_load_lds((const GAS1 unsigned*)((const char*)(gbase) + (v1)), (LAS3 unsigned*)(lds + (bufoff) + ldsw + 8192), 16, 0, 0); } while (0)
#define G8_STAGEB(bufoff, gbase) G8_STAGE2(bufoff, gbase, voffB[0], voffB[1])
#define G8_LDA(dst, b, h) do { _Pragma("unroll") for (int m = 0; m < 4; ++m) _Pragma("unroll") for (int k = 0; k < 2; ++k) dst[m][k] = *(const LAS3 bf16x8*)(lds + G8_SA(b, h) + aoff + m * 2048 + k * 1024); } while (0)
#define G8_LDB(dst, b, h) do { _Pragma("unroll") for (int n = 0; n < 2; ++n) _Pragma("unroll") for (int k = 0; k < 2; ++k) dst[n][k] = *(const LAS3 bf16x8*)(lds + G8_SB(b, h) + boff + n * 2048 + k * 1024); } while (0)
#define G8_MMA(ai, bj, At, Bt) do { __builtin_amdgcn_s_setprio(1); _Pragma("unroll") for (int m = 0; m < 4; ++m) _Pragma("unroll") for (int n = 0; n < 2; ++n) _Pragma("unroll") for (int k = 0; k < 2; ++k) \
        acc[ai][bj][m][n] = __builtin_amdgcn_mfma_f32_16x16x32_bf16(Bt[n][k], At[m][k], acc[ai][bj][m][n], 0, 0, 0); __builtin_amdgcn_s_setprio(0); } while (0)
#define G8_WAIT_V(n) asm volatile("s_waitcnt vmcnt(" #n ")" ::: "memory")
#define G8_WAIT_L(n) asm volatile("s_waitcnt lgkmcnt(" #n ")" ::: "memory")
#define G8_BAR __builtin_amdgcn_s_barrier()
#define G8_SCHED __builtin_amdgcn_sched_barrier(0)
    GUnit cur, nxt; int ui = 0;
    if (!S.next(0, cur)) return;
    f32x4 acc[2][2][4][2];
#pragma unroll
    for (int a = 0; a < 2; ++a)
#pragma unroll
        for (int b = 0; b < 2; ++b)
#pragma unroll
            for (int m = 0; m < 4; ++m)
#pragma unroll
                for (int n = 0; n < 2; ++n) acc[a][b][m][n] = (f32x4){0.f, 0.f, 0.f, 0.f};
    bf16x8 At[4][2], B0[2][2], B1[2][2];
    G8_AOFFS(cur);
    const char* cB = S.b_ptr(cur);
    G8_STAGEB(G8_SB(0, 0), cB); G8_STAGE2(G8_SA(0, 0), Ab, voffA[0][0], voffA[0][1]); G8_STAGEB(G8_SB(0, 1), cB + hstep); G8_STAGE2(G8_SA(0, 1), Ab, voffA[1][0], voffA[1][1]);
    if (wr == 1) G8_BAR;
    G8_WAIT_V(4); G8_BAR;
    G8_STAGEB(G8_SB(1, 0), cB + kstep); G8_STAGE2(G8_SA(1, 0), Ab + kstep, voffA[0][0], voffA[0][1]); G8_STAGEB(G8_SB(1, 1), cB + hstep + kstep);
    G8_WAIT_V(6); G8_BAR;
    for (;;) {
        const bool has_next = S.next(ui + 1, nxt);
        const char* nB = has_next ? S.b_ptr(nxt) : cB;
        for (int t = 0; t < nt; t += 2) {
            const bool last = (t == nt - 2);
            const char* a1 = Ab + (size_t)(t + 1) * kstep;
            const unsigned va10 = voffA[1][0], va11 = voffA[1][1];
            if (last && has_next) G8_AOFFS(nxt);
            const char* a2 = last ? Ab : Ab + (size_t)(t + 2) * kstep; const char* b2 = last ? nB : cB + (size_t)(t + 2) * kstep;
            const char* a3 = a2 + kstep; const char* b3 = b2 + kstep;
            G8_LDB(B0, 0, 0); G8_SCHED; G8_LDA(At, 0, 0); G8_STAGE2(G8_SA(1, 1), a1, va10, va11);
            G8_WAIT_L(8); G8_BAR; G8_WAIT_L(0); G8_MMA(0, 0, At, B0); G8_BAR; G8_SCHED;
            G8_LDB(B1, 0, 1); G8_STAGEB(G8_SB(0, 0), b2);
            G8_BAR; G8_WAIT_L(0); G8_MMA(0, 1, At, B1); G8_BAR;
            G8_LDA(At, 0, 1); G8_STAGE2(G8_SA(0, 0), a2, voffA[0][0], voffA[0][1]);
            G8_BAR; G8_WAIT_L(0); G8_MMA(1, 0, At, B0); G8_BAR; G8_SCHED;
            G8_STAGEB(G8_SB(0, 1), b2 + hstep);
            G8_WAIT_V(6); G8_BAR; G8_MMA(1, 1, At, B1); G8_BAR;
            G8_LDB(B0, 1, 0); G8_SCHED; G8_LDA(At, 1, 0); G8_STAGE2(G8_SA(0, 1), a2, voffA[1][0], voffA[1][1]);
            G8_WAIT_L(8); G8_BAR; G8_WAIT_L(0); G8_MMA(0, 0, At, B0); G8_BAR; G8_SCHED;
            G8_LDB(B1, 1, 1); G8_STAGEB(G8_SB(1, 0), b3);
            G8_BAR; G8_WAIT_L(0); G8_MMA(0, 1, At, B1); G8_BAR;
            G8_LDA(At, 1, 1); G8_STAGE2(G8_SA(1, 0), a3, voffA[0][0], voffA[0][1]);
            G8_BAR; G8_WAIT_L(0); G8_MMA(1, 0, At, B0); G8_BAR; G8_SCHED;
            G8_STAGEB(G8_SB(1, 1), b3 + hstep);
            G8_WAIT_V(6); G8_BAR; G8_MMA(1, 1, At, B1); G8_BAR;
        }
        E(acc, cur, wr, wc, fr, fq);
        if (!has_next) break;
#pragma unroll
        for (int a = 0; a < 2; ++a)
#pragma unroll
            for (int b = 0; b < 2; ++b)
#pragma unroll
                for (int m = 0; m < 4; ++m)
#pragma unroll
                    for (int n = 0; n < 2; ++n) acc[a][b][m][n] = (f32x4){0.f, 0.f, 0.f, 0.f};
        cur = nxt; cB = nB; ++ui;
    }
    G8_WAIT_V(0);
    if (wr == 0) G8_BAR;
    G8_BAR;
#undef G8_SA
#undef G8_AOFFS
#undef G8_SB
#undef G8_STAGE2
#undef G8_STAGEB
#undef G8_LDA
#undef G8_LDB
#undef G8_MMA
#undef G8_WAIT_V
#undef G8_WAIT_L
#undef G8_BAR
#undef G8_SCHED
}
struct DenseSched {
    int nM, nN, nwg, G, c, K; const char* Bt;
    __device__ __forceinline__ void init(int M, int N, int K_, const void* Bt_, int G_, int c_) { nM = M >> 8; nN = N >> 8; nwg = nM * nN; G = G_; c = c_; K = K_; Bt = (const char*)Bt_; }
    __device__ __forceinline__ bool next(int i, GUnit& u) const {
        const int L = i * G + c; if (L >= nwg) return false;
        int wgid = L; { const int q = nwg >> 3, r = nwg & 7, xcd = wgid & 7, off = wgid >> 3; wgid = (xcd < r ? xcd * (q + 1) : r * (q + 1) + (xcd - r) * q) + off; }
        const int nig = 8 * nN, gid = wgid / nig, fm = gid * 8, gsz = (nM - fm) < 8 ? (nM - fm) : 8, w = wgid - gid * nig;
        u.pn = w / gsz; u.pm = fm + (w - u.pn * gsz); return true;
    }
    __device__ __forceinline__ unsigned a_off(const GUnit& u, int h, int R) const { return (unsigned)((u.pm * 256 + h * 128 + R) * K) * 2u; }
    __device__ __forceinline__ const char* b_ptr(const GUnit& u) const { return Bt + (size_t)u.pn * 256 * K * 2; }
};

template <class SRC>
__device__ __forceinline__ void convert_wT(const float* __restrict__ W, int K, int N, u16* __restrict__ WT, int rows, SRC src, int gtid, int gnt) {
    const int kch = K >> 3;
    const int total = rows * kch;
    for (int i0 = gtid; i0 < total; i0 += 4 * gnt) {
        float f[4][8]; int sc[4];
#pragma unroll
        for (int u = 0; u < 4; u++) {
            const int i = i0 + u * gnt;
            sc[u] = -1;
            if (i < total) {
                const int kc = i / rows, j = i - kc * rows;
                sc[u] = src(j);
                if (sc[u] >= 0) {
                    const float* wp = W + (size_t)(kc * 8) * N + sc[u];
#pragma unroll
                    for (int q = 0; q < 8; q++) f[u][q] = wp[(size_t)q * N];
                }
            }
        }
#pragma unroll
        for (int u = 0; u < 4; u++) {
            const int i = i0 + u * gnt;
            if (i < total) {
                const int kc = i / rows, j = i - kc * rows;
                uint4 v = make_uint4(0u, 0u, 0u, 0u);
                if (sc[u] >= 0) { v.x = pack2(f[u][0], f[u][1]); v.y = pack2(f[u][2], f[u][3]); v.z = pack2(f[u][4], f[u][5]); v.w = pack2(f[u][6], f[u][7]); }
                *(uint4*)&WT[(size_t)j * K + kc * 8] = v;
            }
        }
    }
}

__device__ __forceinline__ void convert_later_weights(const P& p, int gtid, int gnt) {
    convert_wT(p.w_in, D_, CIN, p.wgT, 2048, [](int j) { return 3096 + (j & ~31) + perm32(j & 31); }, gtid, gnt);
    convert_wT(p.wpa, 512, D_, p.wpaT, 1024, [](int j) { return (j & ~31) + perm32(j & 31); }, gtid, gnt);
    convert_wT(p.wpb, 512, D_, p.wpbT, 1024, [](int j) { return (j & ~31) + perm32(j & 31); }, gtid, gnt);
    convert_wT(p.wout, D_, D_, p.woutT, 1024, [](int j) { return j; }, gtid, gnt);
    convert_wT(p.w2, 64, 512, p.w2T, 512, [](int j) { return j; }, gtid, gnt);
    convert_wT(p.w1_k, 2048, 256, p.cw1Tk, 256, [](int j) { return j; }, gtid, gnt);
    convert_wT(p.w1_v, 2048, 256, p.cw1Tv, 256, [](int j) { return j; }, gtid, gnt);
    convert_wT(p.w2_k, 256, 64, p.cw2Tk, 128, [](int j) { return j < 64 ? j : -1; }, gtid, gnt);
    convert_wT(p.w2_v, 256, 64, p.cw2Tv, 128, [](int j) { return j < 64 ? j : -1; }, gtid, gnt);
    convert_wT(p.a2, 64, 512, p.a2T, 512, [](int j) { return j; }, gtid, gnt);
    convert_wT(p.g2, 128, 512, p.g2T, 512, [](int j) { return j; }, gtid, gnt);
}
__device__ void ph_prologue(const P& p, int bid, int nb, char* smem) {
    const int tid = get_tid(), lane = tid & 63, wv = tid >> 6;
    if (bid >= 1 && bid <= 64) {
        const int j = tid & 255; const bool isv = tid >= 256;
        const float* pe = isv ? p.pe_v : p.pe_k; const float* w1 = isv ? p.w1_v : p.w1_k;
        const int kb = (bid - 1) * 32;
        float a0 = 0.f, a1 = 0.f;
#pragma unroll 4
        for (int k = kb; k < kb + 32; k += 2) { a0 += pe[k] * w1[(size_t)k * 256 + j]; a1 += pe[k + 1] * w1[(size_t)(k + 1) * 256 + j]; }
        p.cb1k[(bid - 1) * 512 + (isv ? 256 : 0) + j] = a0 + a1;
    }
    if (bid == 0) {
        if (tid < 32) { p.counts[tid] = 0; p.cursor[tid] = 0; }
        if (tid == 32) *p.nsactr = 0;
        for (int i = tid; i < 8 * 64; i += NT) {
            const int bg = i >> 6, d = i & 63;
            p.kcb[((size_t)bg * 512 + 511) * 64 + d] = 0;
            p.vcT[(((size_t)bg * 8 + 7) * 64 + d) * 64 + 63] = 0;
        }
    }
    {
        const int gtid = bid * NT + tid, gnt = nb * NT;
        convert_wT(p.w_in, D_, CIN, p.winT, 3328, [](int j) {
            const int t = j >> 8, s = j & 255;
            if (t < 5) {
                const int bj = s >> 7, wc = (s >> 5) & 3, n = (s >> 4) & 1, i = s & 15;
                const int dim = 32 * bj + 8 * (i >> 2) + 4 * n + (i & 3), hq = 4 * t + wc;
                int hb;
                if (hq < 8) hb = 64 * hq;
                else { const int k = (hq - 8) >> 1; hb = (k == 0 ? 512 : (k == 1 ? 640 : (k == 2 ? 768 : (k == 3 ? 1024 : (k == 4 ? 896 : 1152))))) + 64 * (hq & 1); }
                return hb + dim;
            }
            const int c = (s & ~31) + perm32(s & 31);
            if (t < 12) return 1304 + (t - 5) * 256 + c;
            return c < 24 ? 1280 + c : -1; }, gtid, gnt);
        if (nb != 256) convert_later_weights(p, gtid, gnt);
    }
    for (int row = bid * NW + wv; row < NTOK; row += nb * NW) {
        const float* xr = p.x + (size_t)row * D_;
        float v[16];
        float ss = 0.f;
#pragma unroll
        for (int i = 0; i < 4; i++) {
            float4 t = *(const float4*)&xr[i * 256 + lane * 4];
            v[4 * i] = t.x; v[4 * i + 1] = t.y; v[4 * i + 2] = t.z; v[4 * i + 3] = t.w;
            ss += t.x * t.x + t.y * t.y + t.z * t.z + t.w * t.w;
        }
        ss = wave_sum(ss);
        const float rs = rsqrtf(ss * (1.f / D_) + 1e-6f);
#pragma unroll
        for (int i = 0; i < 4; i++) {
            const int c = i * 256 + lane * 4;
            float4 g = *(const float4*)&p.g_mix[c];
            uint2 o;
            o.x = pack2(v[4 * i] * rs * g.x, v[4 * i + 1] * rs * g.y);
            o.y = pack2(v[4 * i + 2] * rs * g.z, v[4 * i + 3] * rs * g.w);
            *(uint2*)&p.hbuf[(size_t)row * D_ + c] = o;
        }
    }
}

__device__ __forceinline__ uint4 pack8(const f32x4& a, const f32x4& b) { uint4 o; o.x = pack2(a[0], a[1]); o.y = pack2(a[2], a[3]); o.z = pack2(b[0], b[1]); o.w = pack2(b[2], b[3]); return o; }
struct EpiInproj {
    const P* pp;
    __device__ __forceinline__ void operator()(const f32x4 (&acc)[2][2][4][2], const GUnit& u, int, int, int, int) const {
        const int t2_ = get_tid(), wid_ = __builtin_amdgcn_readfirstlane(t2_ >> 6), wr = wid_ >> 2, wc = wid_ & 3, fr = t2_ & 15, fq = (t2_ >> 4) & 3;
        const P& p = *pp;
        const int pn = u.pn;
        const int rowb = u.pm * 256 + wr * 64;
        if (pn < 4) {
            const int hq = 4 * pn + wc;
            const bool rope = !(pn == 2 && wc >= 2);
            u16* dst; size_t rstride; int cofs;
            if (pn < 2) { dst = p.q; rstride = 512; cofs = hq * 64; }
            else { dst = (pn == 2) ? (wc < 2 ? p.kc : p.vc) : (wc < 2 ? p.ksl : p.kwn); rstride = 64; cofs = 0; }
            const int g = wc & 1;
#pragma unroll
            for (int ai = 0; ai < 2; ++ai)
#pragma unroll
                for (int m = 0; m < 4; ++m) {
                    const int row = rowb + ai * 128 + m * 16 + fr;
                    f32x4 o1[2], o2[2];
#pragma unroll
                    for (int n = 0; n < 2; ++n) { o1[n] = acc[ai][0][m][n]; o2[n] = acc[ai][1][m][n]; }
                    if (rope) {
                        const double posd = (double)p.pos[row];
#pragma unroll
                        for (int n = 0; n < 2; ++n)
#pragma unroll
                            for (int j = 0; j < 4; ++j) {
                                const double tr = posd * ROPE_FREQ[8 * fq + 4 * n + j] * 0.15915494309189535;
                                const float fr_ = (float)(tr - rint(tr));
                                const float cs = __builtin_amdgcn_cosf(fr_), sn = __builtin_amdgcn_sinf(fr_);
                                const float x1 = o1[n][j], x2 = o2[n][j];
                                o1[n][j] = x1 * cs - x2 * sn; o2[n][j] = x1 * sn + x2 * cs;
                            }
                    }
                    size_t ro;
                    if (pn < 2) {
#pragma unroll
                        for (int n = 0; n < 2; ++n)
#pragma unroll
                            for (int j = 0; j < 4; ++j) { o1[n][j] *= QSCALE; o2[n][j] *= QSCALE; }
                        ro = (size_t)row * 512 + cofs + 8 * fq;
                    } else {
                        const int bb = row >> 13, t = row & (S_ - 1);
                        ro = ((size_t)(bb * 2 + g) * S_ + t) * 64 + 8 * fq;
                    }
                    *(uint4*)&dst[ro] = pack8(o1[0], o1[1]);
                    *(uint4*)&dst[ro + 32] = pack8(o2[0], o2[1]);
                }
        } else if (pn == 4) {
            u16* dst = (wc < 2) ? p.vslT : p.vwnT;
            const int g = wc & 1;
#pragma unroll
            for (int ai = 0; ai < 2; ++ai) {
                const int r0 = rowb + ai * 128, bb = r0 >> 13, tb = r0 & (S_ - 1);
                u16* base = dst + ((size_t)(bb * 2 + g) * 128 + (tb >> 6)) * 4096;
#pragma unroll
                for (int m = 0; m < 4; ++m)
#pragma unroll
                    for (int bj = 0; bj < 2; ++bj)
#pragma unroll
                        for (int n = 0; n < 2; ++n)
#pragma unroll
                            for (int j = 0; j < 4; ++j)
                                base[(32 * bj + 8 * fq + 4 * n + j) * 64 + m * 16 + fr] = f2bf(acc[ai][bj][m][n][j]);
            }
        } else if (pn < 12) {
            const int cb = (pn - 5) * 256 + wc * 32 + 8 * fq;
#pragma unroll
            for (int ai = 0; ai < 2; ++ai)
#pragma unroll
                for (int m = 0; m < 4; ++m) {
                    const size_t ro = (size_t)(rowb + ai * 128 + m * 16 + fr) * CRW + cb;
#pragma unroll
                    for (int bj = 0; bj < 2; ++bj) *(uint4*)&p.prw[ro + bj * 128] = pack8(acc[ai][bj][m][0], acc[ai][bj][m][1]);
                }
        } else {
            if (wc == 0 && fq < 3) {
#pragma unroll
                for (int ai = 0; ai < 2; ++ai)
#pragma unroll
                    for (int m = 0; m < 4; ++m) {
                        const size_t ro = (size_t)(rowb + ai * 128 + m * 16 + fr) * 24 + 8 * fq;
#pragma unroll
                        for (int n = 0; n < 2; ++n) {
                            float4 o; o.x = sigmoidf_(acc[ai][0][m][n][0]); o.y = sigmoidf_(acc[ai][0][m][n][1]); o.z = sigmoidf_(acc[ai][0][m][n][2]); o.w = sigmoidf_(acc[ai][0][m][n][3]);
                            *(float4*)&p.nsag[ro + 4 * n] = o;
                        }
                    }
            }
        }
    }
};
__device__ void ph_inproj(const P& p, int bid, int nb, char* smem) {
    DenseSched S; S.init(NTOK, 3328, D_, p.winT, nb, bid);
    EpiInproj E{&p};
    gemm256(smem, (const char*)p.hbuf, D_, S, E);
    if (nb == 256 && bid >= 128) convert_later_weights(p, (bid - 128) * NT + get_tid(), 128 * NT);
}

__device__ __forceinline__ float gelu_tanh(float x) {
    const float c = 0.7978845608028654f;
    return 0.5f * x * (1.f + tanhf(c * (x + 0.044715f * x * x * x)));
}
__device__ void ph_compress(const P& p, int bid, int nb, char* smem) {
    u16* sm = (u16*)smem;
    const int tid = get_tid(), lane = tid & 63, wv = tid >> 6;
    const int wm = wv >> 1, wn = wv & 1;
    for (int it = bid; it < 32; it += nb) {
        const int rt = it & 1, g = (it >> 1) & 1, b = (it >> 2) & 3, kv = it >> 4;
        const int bg = b * 2 + g, i0 = rt * 256;
        const u16* src = (kv ? p.vc : p.kc) + (size_t)bg * S_ * 64;
        const u16* w1T = kv ? p.cw1Tv : p.cw1Tk;
        const u16* w2T = kv ? p.cw2Tv : p.cw2Tk;
        float* cb1 = (float*)(smem + 3 * G_TILE);
        __syncthreads();
        { const int t2 = get_tid(); if (t2 < 256) { float a = 0.f; for (int q = 0; q < 64; q++) a += p.cb1k[q * 512 + kv * 256 + t2]; cb1[t2] = a; } }
        __syncthreads();
        const float* b1 = kv ? p.b1_v : p.b1_k;
        const float* b2 = kv ? p.b2_v : p.b2_k;
        u16* hidp = p.chid + (size_t)it * 256 * 256;
        auto arow = [&](int r) { int i = i0 + r; if (i > 510) i = 510; return src + (size_t)i * 1024; };
#pragma unroll 1
        for (int ct = 0; ct < 2; ct++) {
            f32x4 acc[4][4];
            gemm_core<false>(2048, arow, w1T + (size_t)ct * 128 * 2048, 2048, acc, sm);
            const int le = get_tid() & 63;
#pragma unroll
            for (int mt = 0; mt < 4; mt++) {
                const int r = wm * 64 + mt * 16 + (le & 15);
#pragma unroll
                for (int nt = 0; nt < 4; nt++) {
                    const int col = ct * 128 + wn * 64 + nt * 16 + (le >> 4) * 4;
                    const float4 c1 = *(const float4*)&cb1[col], bb1 = *(const float4*)&b1[col];
                    f32x4 o;
                    o[0] = gelu_tanh(acc[mt][nt][0] + c1.x + bb1.x); o[1] = gelu_tanh(acc[mt][nt][1] + c1.y + bb1.y);
                    o[2] = gelu_tanh(acc[mt][nt][2] + c1.z + bb1.z); o[3] = gelu_tanh(acc[mt][nt][3] + c1.w + bb1.w);
                    *(uint2*)&hidp[r * 256 + col] = pack4(o);
                }
            }
        }
        __syncthreads();
        {
            f32x4 acc[4][4];
            gemm_core<true>(256, [&](int r) { return hidp + (size_t)r * 256; }, w2T, 256, acc, sm);
            if (wn == 0) {
#pragma unroll
                for (int mt = 0; mt < 4; mt++)
#pragma unroll
                    for (int nt = 0; nt < 4; nt++) {
                        const int d = nt * 16 + (lane & 15);
                        const int ib = i0 + wm * 64 + mt * 16 + (lane >> 4) * 4;
                        float o[4];
#pragma unroll
                        for (int j = 0; j < 4; j++) o[j] = (ib + j < NCMP) ? (acc[mt][nt][j] + b2[d]) : 0.f;
                        if (kv == 0) {
#pragma unroll
                            for (int j = 0; j < 4; j++) p.kcb[((size_t)bg * 512 + ib + j) * 64 + d] = f2bf(o[j]);
                        } else {
                            uint2 ov; ov.x = pack2(o[0], o[1]); ov.y = pack2(o[2], o[3]);
                            *(uint2*)&p.vcT[(((size_t)bg * 8 + (ib >> 6)) * 64 + d) * 64 + (ib & 63)] = ov;
                        }
                    }
            }
        }
        __syncthreads();
    }
}

#ifndef NSAPROBE
#define NSAPROBE 0
#endif
#define NSA_TS(k) if (NSAPROBE == k) ts_ = __builtin_amdgcn_s_memrealtime();
#define NSA_TE(k) if (NSAPROBE == k) tacc_ += __builtin_amdgcn_s_memrealtime() - ts_;
constexpr int KSTR = 72;
struct Sub { f32x4 O[4]; float m, l; };
#define NEG_BIG (-1.0e30f)

__device__ __forceinline__ float xq_max(float v) {
    return xrow_max(v);
}
__device__ __forceinline__ float xq_sum(float v) {
    return xrow_sum(v);
}
typedef unsigned u32x2 __attribute__((ext_vector_type(2)));
union VF { bf16x8 v; u32x2 h[2]; };
template <int OFF> __device__ __forceinline__ u32x2 lds_read_b64(unsigned addr) { u32x2 r; asm volatile("ds_read_b64 %0, %1 offset:%2" : "=v"(r) : "v"(addr), "n"(OFF)); return r; }
#define NSA_LDV_ASM(vf, Vs, kr, qq, swz) { const unsigned va_ = (unsigned)(size_t)(const LAS3 char*)((const char*)(Vs) + (kr) * 128 + ((qq) & 1) * 8); const int vo_ = (((qq) >> 1) ^ (swz)) << 4; \
        const unsigned a0_ = va_ + vo_, a1_ = va_ + (vo_ ^ 32), a2_ = va_ + (vo_ ^ 64), a3_ = va_ + (vo_ ^ 96); \
        vf[0][0].h[0] = lds_read_b64<0>(a0_);    vf[0][0].h[1] = lds_read_b64<0>(a1_);    vf[0][1].h[0] = lds_read_b64<0>(a2_);    vf[0][1].h[1] = lds_read_b64<0>(a3_); \
        vf[1][0].h[0] = lds_read_b64<2048>(a0_); vf[1][0].h[1] = lds_read_b64<2048>(a1_); vf[1][1].h[0] = lds_read_b64<2048>(a2_); vf[1][1].h[1] = lds_read_b64<2048>(a3_); \
        vf[2][0].h[0] = lds_read_b64<4096>(a0_); vf[2][0].h[1] = lds_read_b64<4096>(a1_); vf[2][1].h[0] = lds_read_b64<4096>(a2_); vf[2][1].h[1] = lds_read_b64<4096>(a3_); \
        vf[3][0].h[0] = lds_read_b64<6144>(a0_); vf[3][0].h[1] = lds_read_b64<6144>(a1_); vf[3][1].h[0] = lds_read_b64<6144>(a2_); vf[3][1].h[1] = lds_read_b64<6144>(a3_); }
#define NSA_VWAIT(vf) asm volatile("s_waitcnt lgkmcnt(0)" : "+v"(vf[0][0].v), "+v"(vf[0][1].v), "+v"(vf[1][0].v), "+v"(vf[1][1].v), "+v"(vf[2][0].v), "+v"(vf[2][1].v), "+v"(vf[3][0].v), "+v"(vf[3][1].v) :: "memory")
template <bool MASK, bool IMP, bool PV>
__device__ __forceinline__ void nsa_visit(const u16* Ks, const u16* Vs, const u16* qrow, Sub& s, int lo, int hi, int lane, float* e, float* p3) {
    const int kr = lane & 15, qq = lane >> 4;
    f32x4 S[4];
    const int qsw = ((kr & 3) >> 1) ^ ((kr >> 2) << 1);
    const bf16x8 qf0 = *(const bf16x8*)(qrow + ((qq ^ qsw) << 3)), qf1 = *(const bf16x8*)(qrow + (((4 + qq) ^ qsw) << 3));
    bf16x8 kf[4][2];
    const int swz = kr >> 1;
    {
        const char* kb_ = (const char*)Ks + kr * 128;
        const int ko0 = (qq ^ swz) << 4, ko1 = ko0 ^ 64;
#pragma unroll
        for (int kt = 0; kt < 4; kt++) { kf[kt][0] = *(const bf16x8*)(kb_ + kt * 2048 + ko0); kf[kt][1] = *(const bf16x8*)(kb_ + kt * 2048 + ko1); }
    }
    __builtin_amdgcn_sched_barrier(0);
#pragma unroll
    for (int kt = 0; kt < 4; kt++) {
        S[kt] = __builtin_amdgcn_mfma_f32_16x16x32_bf16(kf[kt][0], qf0, f32x4{0.f, 0.f, 0.f, 0.f}, 0, 0, 0);
        S[kt] = __builtin_amdgcn_mfma_f32_16x16x32_bf16(kf[kt][1], qf1, S[kt], 0, 0, 0);
    }
    float mx = NEG_BIG;
#pragma unroll
    for (int kt = 0; kt < 4; kt++)
#pragma unroll
        for (int r = 0; r < 4; r++) {
            if (MASK) { const int o = kt * 16 + qq * 4 + r; if (o < lo || o > hi) S[kt][r] = -INFINITY; }
            mx = fmaxf(mx, S[kt][r]);
        }
    mx = xq_max(mx);
    const float mnew = fmaxf(s.m, mx);
    const float alpha = __builtin_amdgcn_exp2f(s.m - mnew);
    s.m = mnew;
    float psum = 0.f;
#pragma unroll
    for (int kt = 0; kt < 4; kt++) {
#pragma unroll
        for (int r = 0; r < 4; r++) { S[kt][r] = __builtin_amdgcn_exp2f(S[kt][r] - mnew); }
        const float ee = (S[kt][0] + S[kt][1]) + (S[kt][2] + S[kt][3]);
        psum += ee;
        if (IMP) { e[kt] = ee; p3[kt] = S[kt][3]; }
    }
    s.l = s.l * alpha + psum;
    if (PV) {
        if (!__all(alpha == 1.f)) {
#pragma unroll
            for (int dt = 0; dt < 4; dt++)
#pragma unroll
                for (int r = 0; r < 4; r++) s.O[dt][r] *= alpha;
        }
        VF vf[4][2];
        NSA_LDV_ASM(vf, Vs, kr, qq, swz)
        bf16x8 pb[2];
#pragma unroll
        for (int k2 = 0; k2 < 2; k2++) {
            union { bf16x8 v; unsigned u[4]; } t;
            t.u[0] = pack2(S[2 * k2][0], S[2 * k2][1]); t.u[1] = pack2(S[2 * k2][2], S[2 * k2][3]);
            t.u[2] = pack2(S[2 * k2 + 1][0], S[2 * k2 + 1][1]); t.u[3] = pack2(S[2 * k2 + 1][2], S[2 * k2 + 1][3]);
            pb[k2] = t.v;
        }
        NSA_VWAIT(vf);
        __builtin_amdgcn_sched_barrier(0);
#pragma unroll
        for (int dt = 0; dt < 4; dt++)
#pragma unroll
            for (int k2 = 0; k2 < 2; k2++) s.O[dt] = __builtin_amdgcn_mfma_f32_16x16x32_bf16(vf[dt][k2].v, pb[k2], s.O[dt], 0, 0, 0);
    }
}
template <bool IMP, bool PV>
__device__ __forceinline__ void nsa_visit2(const u16* Ks, const u16* Vs, const u16* qrow0, const u16* qrow1, Sub (&st)[2], const int (&hi)[2], int lane, float (&e)[2][4], float (&p3)[2][4]) {
    const int kr = lane & 15, qq = lane >> 4;
    const int qsw = ((kr & 3) >> 1) ^ ((kr >> 2) << 1);
    bf16x8 qf0[2], qf1[2];
    qf0[0] = *(const bf16x8*)(qrow0 + ((qq ^ qsw) << 3)); qf1[0] = *(const bf16x8*)(qrow0 + (((4 + qq) ^ qsw) << 3));
    qf0[1] = *(const bf16x8*)(qrow1 + ((qq ^ qsw) << 3)); qf1[1] = *(const bf16x8*)(qrow1 + (((4 + qq) ^ qsw) << 3));
    bf16x8 kf[4][2];
    const int swz = kr >> 1;
    {
        const char* kb_ = (const char*)Ks + kr * 128;
        const int ko0 = (qq ^ swz) << 4, ko1 = ko0 ^ 64;
#pragma unroll
        for (int kt = 0; kt < 4; kt++) { kf[kt][0] = *(const bf16x8*)(kb_ + kt * 2048 + ko0); kf[kt][1] = *(const bf16x8*)(kb_ + kt * 2048 + ko1); }
    }
    __builtin_amdgcn_sched_barrier(0);
    f32x4 S[2][4];
#pragma unroll
    for (int kt = 0; kt < 4; kt++)
#pragma unroll
        for (int q = 0; q < 2; q++) {
            S[q][kt] = __builtin_amdgcn_mfma_f32_16x16x32_bf16(kf[kt][0], qf0[q], f32x4{0.f, 0.f, 0.f, 0.f}, 0, 0, 0);
            S[q][kt] = __builtin_amdgcn_mfma_f32_16x16x32_bf16(kf[kt][1], qf1[q], S[q][kt], 0, 0, 0);
        }
    VF vf[4][2];
    bf16x8 pb[2][2];
#pragma unroll
    for (int q = 0; q < 2; q++) {
        Sub& s = st[q];
        float mx = NEG_BIG;
#pragma unroll
        for (int kt = 0; kt < 4; kt++)
#pragma unroll
            for (int r = 0; r < 4; r++) {
                const int o = kt * 16 + qq * 4 + r; if (o > hi[q]) S[q][kt][r] = -INFINITY;
                mx = fmaxf(mx, S[q][kt][r]);
            }
        mx = xq_max(mx);
        const float mnew = fmaxf(s.m, mx);
        const float alpha = __builtin_amdgcn_exp2f(s.m - mnew);
        s.m = mnew;
        float psum = 0.f;
#pragma unroll
        for (int kt = 0; kt < 4; kt++) {
#pragma unroll
            for (int r = 0; r < 4; r++) { S[q][kt][r] = __builtin_amdgcn_exp2f(S[q][kt][r] - mnew); }
            const float ee = (S[q][kt][0] + S[q][kt][1]) + (S[q][kt][2] + S[q][kt][3]);
            psum += ee;
            if (IMP) { e[q][kt] = ee; p3[q][kt] = S[q][kt][3]; }
        }
        s.l = s.l * alpha + psum;
        if (PV) {
#pragma unroll
            for (int dt = 0; dt < 4; dt++)
#pragma unroll
                for (int r = 0; r < 4; r++) s.O[dt][r] *= alpha;
#pragma unroll
            for (int k2 = 0; k2 < 2; k2++) {
                union { bf16x8 v; unsigned u[4]; } t;
                t.u[0] = pack2(S[q][2 * k2][0], S[q][2 * k2][1]); t.u[1] = pack2(S[q][2 * k2][2], S[q][2 * k2][3]);
                t.u[2] = pack2(S[q][2 * k2 + 1][0], S[q][2 * k2 + 1][1]); t.u[3] = pack2(S[q][2 * k2 + 1][2], S[q][2 * k2 + 1][3]);
                pb[q][k2] = t.v;
            }
            if (q == 0) NSA_LDV_ASM(vf, Vs, kr, qq, swz)
        }
    }
    if (PV) {
        NSA_VWAIT(vf);
        __builtin_amdgcn_sched_barrier(0);
#pragma unroll
        for (int dt = 0; dt < 4; dt++)
#pragma unroll
            for (int k2 = 0; k2 < 2; k2++)
#pragma unroll
                for (int q = 0; q < 2; q++) st[q].O[dt] = __builtin_amdgcn_mfma_f32_16x16x32_bf16(vf[dt][k2].v, pb[q][k2], st[q].O[dt], 0, 0, 0);
    }
}
template <int MMODE, bool FIXM, int NQ>
__device__ __forceinline__ void nsa_visit_gn(const u16* Ks, const u16* Vs, const u16* qs, float* Os, float* Ms, float* Ls, const int (&tok)[NQ], const bool (&valid)[NQ], int lane) {
    const int kr = lane & 15, qq = lane >> 4, hh = kr & 3;
    int row[NQ], osw[NQ]; float* orow[NQ];
    f32x4 O[NQ][4]; float m_old[NQ], l_old[NQ]; bf16x8 qf0[NQ], qf1[NQ];
#pragma unroll
    for (int q = 0; q < NQ; q++) {
        row[q] = tok[q] * 4 + hh; orow[q] = Os + row[q] * 64;
        osw[q] = hh ^ ((tok[q] & 3) << 2);
#pragma unroll
        for (int dt = 0; dt < 4; dt++) O[q][dt] = *(const f32x4*)(orow[q] + (((dt * 4 + qq) ^ osw[q]) << 2));
        m_old[q] = Ms[row[q]]; l_old[q] = Ls[row[q]];
        const u16* qrow = qs + row[q] * 64;
        const int qsw = (hh >> 1) ^ ((tok[q] & 3) << 1);
        qf0[q] = *(const bf16x8*)(qrow + ((qq ^ qsw) << 3)); qf1[q] = *(const bf16x8*)(qrow + (((4 + qq) ^ qsw) << 3));
    }
    bf16x8 kf[4][2];
    const int swz = kr >> 1;
    {
        const char* kb_ = (const char*)Ks + kr * 128;
        const int ko0 = (qq ^ swz) << 4, ko1 = ko0 ^ 64;
#pragma unroll
        for (int kt = 0; kt < 4; kt++) { kf[kt][0] = *(const bf16x8*)(kb_ + kt * 2048 + ko0); kf[kt][1] = *(const bf16x8*)(kb_ + kt * 2048 + ko1); }
    }
    __builtin_amdgcn_sched_barrier(0);
    f32x4 S[NQ][4];
#pragma unroll
    for (int kt = 0; kt < 4; kt++)
#pragma unroll
        for (int q = 0; q < NQ; q++) {
            S[q][kt] = __builtin_amdgcn_mfma_f32_16x16x32_bf16(kf[kt][0], qf0[q], f32x4{0.f, 0.f, 0.f, 0.f}, 0, 0, 0);
            S[q][kt] = __builtin_amdgcn_mfma_f32_16x16x32_bf16(kf[kt][1], qf1[q], S[q][kt], 0, 0, 0);
        }
    VF vf[4][2];
#define NSA_LDV NSA_LDV_ASM(vf, Vs, kr, qq, swz)
    if (NQ == 1) NSA_LDV
    bf16x8 pb[NQ][2];
#pragma unroll
    for (int q = 0; q < NQ; q++) {
        float mx = NEG_BIG;
#pragma unroll
        for (int kt = 0; kt < 4; kt++)
#pragma unroll
            for (int r = 0; r < 4; r++) {
                if (MMODE == 1) { const int o = kt * 16 + qq * 4 + r; if (o > tok[q]) S[q][kt][r] = -INFINITY; }
                if (MMODE == 2) { const int o = kt * 16 + qq * 4 + r; if (o <= tok[q]) S[q][kt][r] = -INFINITY; }
                if (FIXM) { if (!valid[q]) S[q][kt][r] = -INFINITY; } else mx = fmaxf(mx, S[q][kt][r]);
            }
        float mnew = m_old[q], alpha = 1.f;
        if (!FIXM) {
            if (!valid[q]) mx = NEG_BIG;
            mx = xq_max(mx);
            mnew = fmaxf(m_old[q], mx);
            alpha = __builtin_amdgcn_exp2f(m_old[q] - mnew);
        }
        float psum = 0.f;
#pragma unroll
        for (int kt = 0; kt < 4; kt++) {
#pragma unroll
            for (int r = 0; r < 4; r++) { S[q][kt][r] = __builtin_amdgcn_exp2f(S[q][kt][r] - mnew); }
            psum += (S[q][kt][0] + S[q][kt][1]) + (S[q][kt][2] + S[q][kt][3]);
        }
        psum = xq_sum(psum);
        if (FIXM) { if (valid[q] && qq == 0) Ls[row[q]] = l_old[q] + psum; }
        else {
            if (valid[q] && qq == 0) { Ms[row[q]] = mnew; Ls[row[q]] = l_old[q] * alpha + psum; }
#pragma unroll
            for (int dt = 0; dt < 4; dt++)
#pragma unroll
                for (int r = 0; r < 4; r++) O[q][dt][r] *= alpha;
        }
#pragma unroll
        for (int k2 = 0; k2 < 2; k2++) {
            union { bf16x8 v; unsigned u[4]; } t;
            t.u[0] = pack2(S[q][2 * k2][0], S[q][2 * k2][1]); t.u[1] = pack2(S[q][2 * k2][2], S[q][2 * k2][3]);
            t.u[2] = pack2(S[q][2 * k2 + 1][0], S[q][2 * k2 + 1][1]); t.u[3] = pack2(S[q][2 * k2 + 1][2], S[q][2 * k2 + 1][3]);
            pb[q][k2] = t.v;
        }
        if (NQ == 2 && q == 0) { asm volatile("" ::: "memory"); NSA_LDV }
    }
#undef NSA_LDV
    NSA_VWAIT(vf);
    __builtin_amdgcn_sched_barrier(0);
#pragma unroll
    for (int dt = 0; dt < 4; dt++)
#pragma unroll
        for (int k2 = 0; k2 < 2; k2++)
#pragma unroll
            for (int q = 0; q < NQ; q++) O[q][dt] = __builtin_amdgcn_mfma_f32_16x16x32_bf16(vf[dt][k2].v, pb[q][k2], O[q][dt], 0, 0, 0);
#pragma unroll
    for (int q = 0; q < NQ; q++)
        if (valid[q]) {
#pragma unroll
            for (int dt = 0; dt < 4; dt++) *(f32x4*)(orow[q] + (((dt * 4 + qq) ^ osw[q]) << 2)) = O[q][dt];
        }
}
template <int MMODE, bool FIXM>
__device__ __forceinline__ void nsa_visit_g(const u16* Ks, const u16* Vs, const u16* qs, float* Os, float* Ms, float* Ls, int tok, bool valid, int lane) {
    const int tk[1] = {tok}; const bool vl[1] = {valid};
    nsa_visit_gn<MMODE, FIXM, 1>(Ks, Vs, qs, Os, Ms, Ls, tk, vl, lane);
}
__device__ __forceinline__ void nsa_fold_lds(float* Os, float* Ms, float* Ls, int row, int qq, int hh, f32x4 (&T)[4], float gate, bool reset) {
    const float lt = Ls[row];
    const float sc = (lt > 0.f) ? gate / lt : 0.f;
#pragma unroll
    for (int dt = 0; dt < 4; dt++) {
        float* op = Os + row * 64 + (((dt * 4 + qq) ^ hh ^ (((row >> 2) & 3) << 2)) << 2);
        const f32x4 o = *(const f32x4*)op;
#pragma unroll
        for (int r = 0; r < 4; r++) T[dt][r] += o[r] * sc;
        if (reset) *(f32x4*)op = f32x4{0.f, 0.f, 0.f, 0.f};
    }
    asm volatile("s_waitcnt lgkmcnt(0)" ::: "memory");
    if (reset && qq == 0) { Ms[row] = NEG_BIG; Ls[row] = 0.f; }
}
template <int MODE>
__device__ __forceinline__ void nsa_fold(Sub& s, f32x4 (&T)[4], float gate) {
    const float lt = xq_sum(s.l);
    const float sc = (lt > 0.f) ? gate / lt : 0.f;
#pragma unroll
    for (int dt = 0; dt < 4; dt++)
#pragma unroll
        for (int r = 0; r < 4; r++) {
            const float v = s.O[dt][r] * sc;
            T[dt][r] = (MODE == 1) ? T[dt][r] + v : v;
            s.O[dt][r] = 0.f;
        }
    s.m = NEG_BIG; s.l = 0.f;
}

constexpr int NSA_R = 3;
template <bool HASV, class KSrc, class VSrc, class Body>
__device__ __forceinline__ void nsa_stream(char* ring, int n, KSrc ksrc, VSrc vsrc, Body body) {
    const int t = get_tid();
    const int so = (t >> 3) * 64 + (((t & 7) ^ ((t >> 4) & 7)) << 3);
    char* dl = ring + t * 16;
#define NSA_ISSUE(i, slot) { glds16(ksrc(i) + so, dl + (slot) * 16384); if (HASV) glds16(vsrc(i) + so, dl + (slot) * 16384 + 8192); }
    asm volatile("s_waitcnt lgkmcnt(0)" ::: "memory");
    __builtin_amdgcn_s_barrier();
    if (n > 0) NSA_ISSUE(0, 0)
    if (n > 1) NSA_ISSUE(1, 1)
    int slot = 0;
    for (int i = 0; i < n; i++) {
        if (i + 1 < n) { if (HASV) asm volatile("s_waitcnt vmcnt(2)" ::: "memory"); else asm volatile("s_waitcnt vmcnt(1)" ::: "memory"); }
        else asm volatile("s_waitcnt vmcnt(0)" ::: "memory");
        asm volatile("s_waitcnt lgkmcnt(0)" ::: "memory");
        __builtin_amdgcn_s_barrier();
        asm volatile("" ::: "memory");
        const int sl2 = (slot == 0) ? 2 : slot - 1;
        if (i + 2 < n) NSA_ISSUE(i + 2, sl2)
        body(i, (const u16*)(ring + slot * 16384), (const u16*)(ring + slot * 16384 + 8192));
        slot = (slot == 2) ? 0 : slot + 1;
    }
#undef NSA_ISSUE
}
#define NSA_TOK(u) const int t3_ = get_tid(); const size_t ntk_ = (size_t)b * S_ + t0 + 8 * (t3_ >> 6) + 4 * (u) + ((t3_ & 15) >> 2); const int hd_ = g * 4 + (t3_ & 3);
__device__ void ph_nsa(const P& p, int bid, int nb, char* smem) {
    char* ring = smem;
    unsigned* selm = (unsigned*)(smem + NSA_R * 16384);
    int* blist = (int*)(selm + 256);
    int* nlistp = blist + 128;
    int* lcnt = nlistp + 4;
    unsigned char* lists = (unsigned char*)(lcnt + 128);
    float* Ms = (float*)(lists + 128 * 64);
    float* Ls = Ms + 256;
    float* Os = Ls + 256;
    float* impl = Os;
    u16* qs = (u16*)(Os + 64 * 4 * 64);
    unsigned long long ts_ = 0, tacc_ = 0;
    const int nitems = B_ * 2 * 128;
    for (int rr = 0;; rr++) {
        int it = bid;
        if (rr > 0) {
            __syncthreads();
            if (get_tid() == 0) nlistp[3] = nb + atomicAdd(p.nsactr, 1);
            __syncthreads();
            it = nlistp[3];
        }
        if (it >= nitems) break;
        const int tid = get_tid(), lane = tid & 63, wv = tid >> 6;
        const int kr = lane & 15, qq = lane >> 4, ts = kr >> 2, hh = kr & 3;
        float* myimp = impl + wv * (32 * 2 * 16);
        const int tt = 127 - (it >> 3);
        const int bg = it & 7, b = bg >> 1, g = bg & 1;
        const int t0 = tt * 64, cur = tt;
        const int head = g * 4 + hh;
        Sub st[2];
        f32x4 T[2][4];
        int tl[2]; size_t ntok[2];
        __syncthreads();
#pragma unroll
        for (int u = 0; u < 2; u++) {
            tl[u] = 8 * wv + 4 * u + ts;
            ntok[u] = (size_t)b * S_ + t0 + tl[u];
#pragma unroll
            for (int ks = 0; ks < 2; ks++) *(bf16x8*)&qs[(tl[u] * 4 + hh) * 64 + (((ks * 4 + qq) ^ (hh >> 1) ^ ((tl[u] & 3) << 1)) << 3)] = *(const bf16x8*)&p.q[ntok[u] * 512 + head * 64 + ks * 32 + qq * 8];
#pragma unroll
            for (int dt = 0; dt < 4; dt++) st[u].O[dt] = f32x4{0.f, 0.f, 0.f, 0.f};
            st[u].m = NEG_BIG; st[u].l = 0.f;
        }
        const u16* kcb = p.kcb + (size_t)bg * 512 * 64;
        const u16* vcT = p.vcT + (size_t)bg * 8 * 4096;
        int nv[2];
#pragma unroll
        for (int u = 0; u < 2; u++) { const int t = t0 + tl[u]; nv[u] = (t >= 31) ? min((t - 31) / 16 + 1, NCMP) : 0; }
        const int tmax = t0 + 63;
        const int nvmax = (tmax >= 31) ? min((tmax - 31) / 16 + 1, NCMP) : 0;
        const int nvb = (nvmax + 63) >> 6;
        NSA_TS(1)
        __syncthreads();
        nsa_stream<false>(ring, nvb, [&](int kb) { return kcb + (size_t)kb * 4096; }, [&](int kb) { return vcT + (size_t)kb * 4096; },
            [&](int kb, const u16* Ks, const u16* Vs) {
                const int hi2[2] = {nv[0] - kb * 64 - 1, nv[1] - kb * 64 - 1};
                float e_[2][4], p3_[2][4];
                nsa_visit2<false, false>(Ks, Vs, qs + (tl[0] * 4 + hh) * 64, qs + (tl[1] * 4 + hh) * 64, st, hi2, lane, e_, p3_);
            });
        float invl[2];
#pragma unroll
        for (int u = 0; u < 2; u++) { const float lt = xq_sum(st[u].l); invl[u] = (lt > 0.f) ? 1.f / lt : 0.f; st[u].l = 0.f; }
        float carry[2] = {0.f, 0.f};
        nsa_stream<true>(ring, nvb, [&](int kb) { return kcb + (size_t)kb * 4096; }, [&](int kb) { return vcT + (size_t)kb * 4096; },
            [&](int kb, const u16* Ks, const u16* Vs) {
            const int hi2[2] = {nv[0] - kb * 64 - 1, nv[1] - kb * 64 - 1};
            float e_[2][4], p3_[2][4];
            nsa_visit2<true, true>(Ks, Vs, qs + (tl[0] * 4 + hh) * 64, qs + (tl[1] * 4 + hh) * 64, st, hi2, lane, e_, p3_);
#pragma unroll
            for (int u = 0; u < 2; u++) {
#pragma unroll
                for (int kt = 0; kt < 4; kt++) {
                    float ev = e_[u][kt] * invl[u], pv = p3_[u][kt] * invl[u];
                    ev += dppf<0xB1>(ev); ev += dppf<0x4E>(ev);
                    pv += dppf<0xB1>(pv); pv += dppf<0x4E>(pv);
                    const float sh = __int_as_float(__builtin_amdgcn_ds_bpermute(((lane - 16) & 63) << 2, __float_as_int(pv)));
                    const float nbv = (qq == 0) ? carry[u] : sh;
                    carry[u] = sh;
                    myimp[((kb * 4 + kt) * 2 + u) * 16 + ts * 4 + qq] = ev + nbv;
                }
            }
            });
        NSA_TE(1)
        NSA_TS(2)
#pragma unroll
        for (int u = 0; u < 2; u++) {
            float mv[8];
#pragma unroll
            for (int i = 0; i < 8; i++) {
                const int kk = 8 * hh + i, j = 4 * kk + qq;
                const float v = myimp[(kk * 2 + u) * 16 + ts * 4 + qq];
                mv[i] = (j >= 1 && j <= cur - 2) ? v : -1.f;
            }
            unsigned sel = 0u;
            const int ncand = max(0, cur - 2);
            const int nforced = (cur >= 2) ? 3 : (cur + 1);
            const int need = 16 - nforced;
            if (ncand <= need) {
#pragma unroll
                for (int i = 0; i < 8; i++) if (mv[i] >= 0.f) sel |= (1u << i);
            } else {
                for (int rnd = 0; rnd < need; rnd++) {
                    const float b01 = fmaxf(mv[0], mv[1]), b23 = fmaxf(mv[2], mv[3]), b45 = fmaxf(mv[4], mv[5]), b67 = fmaxf(mv[6], mv[7]);
                    float best = fmaxf(fmaxf(b01, b23), fmaxf(b45, b67));
                    int bi = 7;
#pragma unroll
                    for (int i = 6; i >= 0; i--) bi = (mv[i] == best) ? i : bi;
                    int bj = (best >= 0.f) ? (4 * (8 * hh + bi) + qq) : 9999;
#define TK_MERGE(ov, oj) { const float v2_ = (ov); const int j2_ = (oj); const bool tk_ = (v2_ > best) || (v2_ == best && j2_ < bj); best = tk_ ? v2_ : best; bj = tk_ ? j2_ : bj; }
                    TK_MERGE(dppf<0xB1>(best), __builtin_amdgcn_update_dpp(0, bj, 0xB1, 0xF, 0xF, true))
                    TK_MERGE(dppf<0x4E>(best), __builtin_amdgcn_update_dpp(0, bj, 0x4E, 0xF, 0xF, true))
                    {
                        auto rv = __builtin_amdgcn_permlane16_swap(__float_as_uint(best), __float_as_uint(best), false, false);
                        auto rj = __builtin_amdgcn_permlane16_swap((unsigned)bj, (unsigned)bj, false, false);
                        float v0 = __uint_as_float(rv[0]), v1 = __uint_as_float(rv[1]); int j0 = (int)rj[0], j1 = (int)rj[1];
                        if (v1 > v0 || (v1 == v0 && j1 < j0)) { v0 = v1; j0 = j1; }
                        rv = __builtin_amdgcn_permlane32_swap(__float_as_uint(v0), __float_as_uint(v0), false, false);
                        rj = __builtin_amdgcn_permlane32_swap((unsigned)j0, (unsigned)j0, false, false);
                        best = __uint_as_float(rv[0]); bj = (int)rj[0];
                        const float v2 = __uint_as_float(rv[1]); const int j2 = (int)rj[1];
                        if (v2 > best || (v2 == best && j2 < bj)) { best = v2; bj = j2; }
                    }
#undef TK_MERGE
                    const bool mine = (bj < 512) && ((bj >> 5) == hh) && ((bj & 3) == qq);
                    const int li = (bj >> 2) & 7;
#pragma unroll
                    for (int i = 0; i < 8; i++) mv[i] = (mine && li == i) ? -1.f : mv[i];
                    if (mine) sel |= (1u << li);
                }
            }
            if (qq == 0 && hh == 0) sel |= 1u;
            if ((cur & 3) == qq && (cur >> 5) == hh) sel |= (1u << ((cur >> 2) & 7));
            if (cur >= 1 && ((cur - 1) & 3) == qq && ((cur - 1) >> 5) == hh) sel |= (1u << (((cur - 1) >> 2) & 7));
            unsigned w = sel << (8 * hh);
            w |= (unsigned)__builtin_amdgcn_update_dpp(0, (int)w, 0xB1, 0xF, 0xF, true);
            w |= (unsigned)__builtin_amdgcn_update_dpp(0, (int)w, 0x4E, 0xF, 0xF, true);
            if (hh == 0) selm[tl[u] * 4 + qq] = w;
        }
        NSA_TE(2)
        NSA_TS(3)
        __syncthreads();
#pragma unroll
        for (int u = 0; u < 2; u++) { NSA_TOK(u) nsa_fold<0>(st[u], T[u], p.nsag[ntk_ * 24 + hd_ * 3 + 0]); }
        {
            const int t2 = get_tid();
#pragma unroll
            for (int i = 0; i < 8; i++) *(f32x4*)&Os[(i * NT + t2) * 4] = f32x4{0.f, 0.f, 0.f, 0.f};
            if (t2 < 256) { Ms[t2] = NEG_BIG; Ls[t2] = 0.f; }
            unsigned long long tm = 0ull; int lrank = 0;
            if (t2 < 128) {
                const int j = t2;
                for (int tk = 0; tk < 64; tk++) tm |= (unsigned long long)((selm[tk * 4 + (j & 3)] >> (j >> 2)) & 1u) << tk;
                if (j > cur) tm = 0ull;
                const unsigned long long bal = __ballot(tm != 0ull);
                lrank = __popcll(bal & ((1ull << (t2 & 63)) - 1ull));
                if ((t2 & 63) == 0) nlistp[t2 >> 6] = __popcll(bal);
            }
            __syncthreads();
            if (t2 < 128 && tm != 0ull) {
                const int pos = lrank + ((t2 >= 64) ? nlistp[0] : 0);
                blist[pos] = t2; lcnt[pos] = __popcll(tm);
                int c = 0;
                while (tm) { lists[pos * 64 + c] = (unsigned char)(__ffsll((long long)tm) - 1); c++; tm &= tm - 1ull; }
            }
            __syncthreads();
        }
        const int nlist = nlistp[0] + nlistp[1];
        NSA_TE(3)
        NSA_TS(4)
        const u16* ksl = p.ksl + (size_t)bg * S_ * 64;
        const u16* vslT = p.vslT + (size_t)bg * 128 * 4096;
        {
            const int t4 = get_tid(), wv4 = __builtin_amdgcn_readfirstlane(t4 >> 6), ts4 = (t4 & 15) >> 2;
            const int td = t4 & 255;
            const int so = (td >> 3) * 64 + (((td & 7) ^ ((td >> 4) & 7)) << 3);
            char* dl = ring + td * 16;
#define NSA_RI(i) (nlist - 1 - (i))
#define NSA_ISSUE2(i, slot) if (wv4 >= 4) { const int jj_ = blist[NSA_RI(i)]; const u16* kp_ = ksl + (size_t)jj_ * 4096 + so; const u16* vp_ = vslT + (size_t)jj_ * 4096 + so; char* d_ = dl + (slot) * 16384; \
                glds16(kp_, d_); glds16(kp_ + 2048, d_ + 4096); glds16(vp_, d_ + 8192); glds16(vp_ + 2048, d_ + 12288); }
            asm volatile("s_waitcnt lgkmcnt(0)" ::: "memory");
            __builtin_amdgcn_s_barrier();
            if (nlist > 0) NSA_ISSUE2(0, 0)
            if (nlist > 1) NSA_ISSUE2(1, 1)
            int jn = 0, nn = 0, tokn = 0;
            if (nlist > 0) { jn = blist[NSA_RI(0)]; nn = lcnt[NSA_RI(0)]; tokn = lists[NSA_RI(0) * 64 + wv4 * 4 + ts4]; }
            int slot = 0;
            for (int i = 0; i < nlist; i++) {
                if (i + 1 < nlist) asm volatile("s_waitcnt vmcnt(4)" ::: "memory"); else asm volatile("s_waitcnt vmcnt(0)" ::: "memory");
                asm volatile("s_waitcnt lgkmcnt(0)" ::: "memory");
                __builtin_amdgcn_s_barrier();
                asm volatile("" ::: "memory");
                const int sl2 = (slot == 0) ? 2 : slot - 1;
                if (i + 2 < nlist) NSA_ISSUE2(i + 2, sl2)
                const int j = jn, n = nn, tok0 = tokn;
                if (i + 1 < nlist) { jn = blist[NSA_RI(i + 1)]; nn = lcnt[NSA_RI(i + 1)]; tokn = lists[NSA_RI(i + 1) * 64 + wv4 * 4 + ts4]; }
                const u16* Ks = (const u16*)(ring + slot * 16384); const u16* Vs = Ks + 4096;
                if ((wv4 + NW) * 4 < n) {
                    const int e1 = (wv4 + NW) * 4 + ts4;
                    const bool vl2[2] = {true, e1 < n};
                    const int tk2[2] = {tok0, vl2[1] ? (int)lists[NSA_RI(i) * 64 + (e1 & 63)] : 0};
                    if (j == cur) nsa_visit_gn<1, false, 2>(Ks, Vs, qs, Os, Ms, Ls, tk2, vl2, t4 & 63);
                    else nsa_visit_gn<0, true, 2>(Ks, Vs, qs, Os, Ms, Ls, tk2, vl2, t4 & 63);
                } else if (wv4 * 4 < n) {
                    const int e = wv4 * 4 + ts4;
                    const bool valid = e < n;
                    const int tok = valid ? tok0 : 0;
                    if (j == cur) nsa_visit_g<1, false>(Ks, Vs, qs, Os, Ms, Ls, tok, valid, t4 & 63);
                    else nsa_visit_g<0, true>(Ks, Vs, qs, Os, Ms, Ls, tok, valid, t4 & 63);
                }
                slot = (slot == 2) ? 0 : slot + 1;
            }
#undef NSA_RI
#undef NSA_ISSUE2
        }
        __syncthreads();
        NSA_TE(4)
        NSA_TS(5)
#pragma unroll
        for (int u = 0; u < 2; u++) {
            NSA_TOK(u)
            const int t5 = t3_ & 63;
            nsa_fold_lds(Os, Ms, Ls, (8 * (t3_ >> 6) + 4 * u + ((t5 & 15) >> 2)) * 4 + (t5 & 3), t5 >> 4, t5 & 3, T[u], p.nsag[ntk_ * 24 + hd_ * 3 + 1], true);
        }
        const u16* kwn = p.kwn + (size_t)bg * S_ * 64;
        const u16* vwnT = p.vwnT + (size_t)bg * 128 * 4096;
        uint2 Tp[2][4];
#pragma unroll
        for (int u = 0; u < 2; u++)
#pragma unroll
            for (int dt = 0; dt < 4; dt++) { Tp[u][dt] = pack4(T[u][dt]); asm volatile("" : "+v"(Tp[u][dt].x), "+v"(Tp[u][dt].y)); }
        {
            const int jlo = max(0, cur - 8);
            nsa_stream<true>(ring, cur - jlo + 1, [&](int i) { return kwn + (size_t)(cur - i) * 4096; }, [&](int i) { return vwnT + (size_t)(cur - i) * 4096; },
                [&](int i, const u16* Ks, const u16* Vs) {
                    const int j = cur - i;
                    const int t4 = get_tid();
                    const int tb_ = 8 * (t4 >> 6) + ((t4 & 15) >> 2);
                    const int tk2[2] = {tb_, tb_ + 4}; const bool vl2[2] = {true, true};
                    if (j == cur) nsa_visit_gn<1, false, 2>(Ks, Vs, qs, Os, Ms, Ls, tk2, vl2, t4 & 63);
                    else if (j == cur - 8) nsa_visit_gn<2, true, 2>(Ks, Vs, qs, Os, Ms, Ls, tk2, vl2, t4 & 63);
                    else nsa_visit_gn<0, true, 2>(Ks, Vs, qs, Os, Ms, Ls, tk2, vl2, t4 & 63);
                });
        }
#pragma unroll
        for (int u = 0; u < 2; u++) {
            NSA_TOK(u)
#pragma unroll
            for (int dt = 0; dt < 4; dt++) T[u][dt] = unpack4(Tp[u][dt]);
            { const int t5 = t3_ & 63; nsa_fold_lds(Os, Ms, Ls, (8 * (t3_ >> 6) + 4 * u + ((t5 & 15) >> 2)) * 4 + (t5 & 3), t5 >> 4, t5 & 3, T[u], p.nsag[ntk_ * 24 + hd_ * 3 + 2], false); }
#pragma unroll
            for (int dt = 0; dt < 4; dt++) *(uint2*)&p.oa[ntk_ * 512 + hd_ * 64 + dt * 16 + ((t3_ & 63) >> 4) * 4] = pack4(T[u][dt]);
        }
        NSA_TE(5)
    }
    if (NSAPROBE) { __syncthreads(); const unsigned long long t1_ = __builtin_amdgcn_s_memrealtime(); while (__builtin_amdgcn_s_memrealtime() - t1_ < tacc_) __builtin_amdgcn_s_sleep(8); }
}

#ifndef CHPROBE
#define CHPROBE 0
#endif
#define CH_TS(k) if (CHPROBE == k) cts_ = __builtin_amdgcn_s_memrealtime();
#define CH_TE(k) if (CHPROBE == k) ctacc_ += __builtin_amdgcn_s_memrealtime() - cts_;
constexpr int RS = 72;
constexpr int RSLOT = 64 * RS;
__device__ __forceinline__ void mm64(const u16* A, int lda, const u16* Bz, int ldb, f32x4 (&acc)[2], int lane, int wv) {
    const int mt = wv >> 1, nt0 = (wv & 1) * 2, kr = lane & 15, qq = lane >> 4;
    bf16x8 a[2], b[2][2];
#pragma unroll
    for (int ks = 0; ks < 2; ks++) {
        a[ks] = *(const bf16x8*)&A[(mt * 16 + kr) * lda + ks * 32 + qq * 8];
#pragma unroll
        for (int i = 0; i < 2; i++) b[ks][i] = *(const bf16x8*)&Bz[((nt0 + i) * 16 + kr) * ldb + ks * 32 + qq * 8];
    }
#pragma unroll
    for (int ks = 0; ks < 2; ks++)
#pragma unroll
        for (int i = 0; i < 2; i++) acc[i] = __builtin_amdgcn_mfma_f32_16x16x32_bf16(a[ks], b[ks][i], acc[i], 0, 0, 0);
}
__device__ __forceinline__ void st_t(u16* dst, int ld, const f32x4& v, int mt, int nt, int lane) {
    uint2 o; o.x = pack2(v[0], v[1]); o.y = pack2(v[2], v[3]);
    *(uint2*)&dst[(nt * 16 + (lane & 15)) * ld + mt * 16 + (lane >> 4) * 4] = o;
}
__device__ __forceinline__ void st_n(u16* dst, int ld, const f32x4& v, int mt, int nt, int lane) {
#pragma unroll
    for (int r = 0; r < 4; r++) dst[(mt * 16 + (lane >> 4) * 4 + r) * ld + nt * 16 + (lane & 15)] = f2bf(v[r]);
}
#define ZACC(a) { a[0] = f32x4{0.f, 0.f, 0.f, 0.f}; a[1] = f32x4{0.f, 0.f, 0.f, 0.f}; }

__device__ void ph_rwkv_chunk(const P& p, int bid, int nb, char* smem) {
    unsigned long long cts_ = 0, ctacc_ = 0;
    u16* sl = (u16*)smem;
    float* tot = (float*)(sl + 14 * RSLOT);
    float* gl = tot + 512;
#define RW_IDX const int tid = get_tid(), lane = tid & 63, wv = tid >> 6, mt = wv >> 1, nt0 = (wv & 1) * 2, kr = lane & 15, qq = lane >> 4; (void)mt; (void)nt0; (void)kr; (void)qq; (void)lane;
    const int nitems = B_ * 128;
    for (int it0 = bid; it0 < nitems; it0 += nb) {
      const int c = it0 & 127, b = it0 >> 7;
      const size_t n0 = (size_t)b * S_ + c * 64;
      __syncthreads();
      {
          RW_IDX
          const int t = tid >> 3, part = tid & 7;
          const size_t n = n0 + t;
          const bool hasprev = (c * 64 + t) > 0;
          u16* dst = p.xact + n * 256 + part * 32;
#pragma unroll
          for (int j = 0; j < 4; j++) {
              const int col = 1536 + part * 32 + j * 8;
              const uint4 cu = *(const uint4*)&p.prw[n * CRW + col];
              uint4 pv = make_uint4(0u, 0u, 0u, 0u);
              if (hasprev) pv = *(const uint4*)&p.prw[(n - 1) * CRW + col];
              const unsigned cw[4] = {cu.x, cu.y, cu.z, cu.w}, pw[4] = {pv.x, pv.y, pv.z, pv.w};
              unsigned ow[4];
#pragma unroll
              for (int e2 = 0; e2 < 4; e2++) {
                  float x0 = __uint_as_float(cw[e2] << 16), x1 = __uint_as_float(cw[e2] & 0xFFFF0000u);
                  const float q0 = __uint_as_float(pw[e2] << 16), q1 = __uint_as_float(pw[e2] & 0xFFFF0000u);
                  x0 = x0 + (q0 - x0) * p.mu[col + 2 * e2]; x1 = x1 + (q1 - x1) * p.mu[col + 2 * e2 + 1];
                  if (part < 2) { x0 = tanhf(x0); x1 = tanhf(x1); }
                  else if (part >= 4) { x0 = sigmoidf_(x0); x1 = sigmoidf_(x1); }
                  ow[e2] = pack2(x0, x1);
              }
              *(uint4*)&dst[j * 8] = make_uint4(ow[0], ow[1], ow[2], ow[3]);
          }
      }
      __syncthreads();
      const u16* xa = p.xact + n0 * 256;
      bf16x8 xa_[8], wb[2][2], ab[2][2], gb[2][4];
      u16 rc[8][3], rp0[3];
      float w0c[2], a0c[2], hc_[6];
#define S1_LOADW(hh_) { RW_IDX \
          _Pragma("unroll") for (int i = 0; i < 2; i++) { const int cc = (nt0 + i) * 16 + kr; w0c[i] = p.w0[(hh_) * 64 + cc]; a0c[i] = p.a0[(hh_) * 64 + cc]; \
              _Pragma("unroll") for (int ks = 0; ks < 2; ks++) { wb[i][ks] = *(const bf16x8*)&p.w2T[((size_t)(hh_) * 64 + cc) * 64 + ks * 32 + qq * 8]; \
                                                                 ab[i][ks] = *(const bf16x8*)&p.a2T[((size_t)(hh_) * 64 + cc) * 64 + ks * 32 + qq * 8]; } \
              _Pragma("unroll") for (int ks = 0; ks < 4; ks++) gb[i][ks] = *(const bf16x8*)&p.g2T[((size_t)(hh_) * 64 + cc) * 128 + ks * 32 + qq * 8]; } }
#define S2_LOADX(hh_) { RW_IDX const int ch_ = (hh_) * 64 + lane; \
          hc_[0] = p.mu[ch_]; hc_[1] = p.mu[512 + ch_]; hc_[2] = p.mu[1024 + ch_]; hc_[3] = p.k_k[ch_]; hc_[4] = p.k_a[ch_]; hc_[5] = p.r_k[ch_]; \
          _Pragma("unroll") for (int i = 0; i < 8; i++) { const int t = wv * 8 + i; const u16* cr = p.prw + (n0 + t) * CRW; \
              rc[i][0] = cr[ch_]; rc[i][1] = cr[512 + ch_]; rc[i][2] = cr[1024 + ch_]; } \
          rp0[0] = 0; rp0[1] = 0; rp0[2] = 0;     \
          if (c * 64 + wv * 8 > 0) { const u16* pp = p.prw + (n0 + wv * 8 - 1) * CRW; rp0[0] = pp[ch_]; rp0[1] = pp[512 + ch_]; rp0[2] = pp[1024 + ch_]; } }
      {
          RW_IDX
#pragma unroll
          for (int k8 = 0; k8 < 8; k8++) xa_[k8] = *(const bf16x8*)&xa[(mt * 16 + kr) * 256 + k8 * 32 + qq * 8];
      }
      S1_LOADW(0)
      S2_LOADX(0)
#pragma unroll 1
      for (int h = 0; h < 8; h++) {
        u16* cd = p.cdat + ((size_t)((b * 8 + h) * 128 + c)) * 4 * 4096;
        LDS_BARRIER();
        CH_TS(1)
        float* LW = (float*)(sl + 8 * RSLOT); float* LA = (float*)(sl + 10 * RSLOT);
        {
            RW_IDX
            f32x4 aw[2], aa2[2], ag[2];
#pragma unroll
            for (int i = 0; i < 2; i++) {
                aw[i] = f32x4{0.f, 0.f, 0.f, 0.f}; aa2[i] = aw[i]; ag[i] = aw[i];
#pragma unroll
                for (int ks = 0; ks < 2; ks++) {
                    aw[i] = __builtin_amdgcn_mfma_f32_16x16x32_bf16(xa_[ks], wb[i][ks], aw[i], 0, 0, 0);
                    aa2[i] = __builtin_amdgcn_mfma_f32_16x16x32_bf16(xa_[2 + ks], ab[i][ks], aa2[i], 0, 0, 0);
                }
#pragma unroll
                for (int ks = 0; ks < 4; ks++) ag[i] = __builtin_amdgcn_mfma_f32_16x16x32_bf16(xa_[4 + ks], gb[i][ks], ag[i], 0, 0, 0);
            }
#pragma unroll
            for (int i = 0; i < 2; i++)
#pragma unroll
                for (int r = 0; r < 4; r++) {
                    const int t = mt * 16 + qq * 4 + r, cc = (nt0 + i) * 16 + kr;
                    const float wl = w0c[i] + aw[i][r];
                    const float z = -wl;
                    const float sp = fmaxf(z, 0.f) + __logf(1.f + __expf(-fabsf(z)));
                    LW[t * 64 + cc] = -__expf(-sp - 0.5f);
                    LA[t * 64 + cc] = sigmoidf_(a0c[i] + aa2[i][r]);
                    p.ob[(n0 + t) * 512 + h * 64 + cc] = f2bf(ag[i][r]);
                }
        }
        LDS_BARRIER();
        CH_TE(1) CH_TS(2)
        {
            RW_IDX
            const int ch = h * 64 + lane;
            const float mur = hc_[0], muk = hc_[1], muv = hc_[2];
            const float kkw = hc_[3], kaw = hc_[4], rkw = hc_[5];
            float rr[8], k2[8], vv[8], kkn[8], aa[8], lg[8], cs[8];
            float run = 0.f;
#pragma unroll
            for (int i = 0; i < 8; i++) {
                const int t = wv * 8 + i; const size_t n = n0 + t;
                float r = bf2f(rc[i][0]), k = bf2f(rc[i][1]), v = bf2f(rc[i][2]);
                const float pr = bf2f(i ? rc[i - 1][0] : rp0[0]), pk = bf2f(i ? rc[i - 1][1] : rp0[1]), pv = bf2f(i ? rc[i - 1][2] : rp0[2]);
                r = r + (pr - r) * mur; k = k + (pk - k) * muk; v = v + (pv - v) * muv;
                const float a = LA[t * 64 + lane];
                lg[i] = LW[t * 64 + lane];
                float kk = k * kkw;
                kkn[i] = kk * __builtin_amdgcn_rsqf(fmaxf(wave_sum(kk * kk), 1e-24f));
                k2[i] = k * (1.f + (a - 1.f) * kaw);
                const float bon = wave_sum(r * k2[i] * rkw);
                if (lane == 0) p.bon[n * 8 + h] = bon;
                rr[i] = r; vv[i] = v; aa[i] = a;
                run += lg[i]; cs[i] = run;
            }
            tot[wv * 64 + lane] = run;
            LDS_BARRIER();
            float off = 0.f, cumL = 0.f;
#pragma unroll
            for (int w2 = 0; w2 < 8; w2++) { const float tv = tot[w2 * 64 + lane]; cumL += tv; if (w2 < wv) off += tv; }
            if (wv == 0) gl[lane] = __expf(cumL);
            unsigned pa[4], pb[4], pk4[4], pv4[4];
#pragma unroll
            for (int i = 0; i < 8; i += 2) {
                float at[2], bt[2], kt[2], rt[2];
#pragma unroll
                for (int e2 = 0; e2 < 2; e2++) {
                    const int ii = i + e2; const int t = wv * 8 + ii;
                    const float cm = off + cs[ii];
                    const float g = __expf(cm), gp = __expf(cm - lg[ii]), gi = __expf(-cm);
                    at[e2] = -kkn[ii] * gp; bt[e2] = kkn[ii] * aa[ii] * gi; kt[e2] = k2[ii] * gi; rt[e2] = rr[ii] * g;
                    sl[0 * RSLOT + t * RS + lane] = f2bf(at[e2]);
                    sl[1 * RSLOT + t * RS + lane] = f2bf(bt[e2]);
                    sl[2 * RSLOT + t * RS + lane] = f2bf(kt[e2]);
                    sl[3 * RSLOT + t * RS + lane] = f2bf(rt[e2]);
                }
                pa[i >> 1] = pack2(at[0], at[1]); pb[i >> 1] = pack2(bt[0], bt[1]);
                pk4[i >> 1] = pack2(kt[0], kt[1]); pv4[i >> 1] = pack2(vv[i], vv[i + 1]);
            }
            *(uint4*)&sl[4 * RSLOT + lane * RS + wv * 8] = make_uint4(pa[0], pa[1], pa[2], pa[3]);
            *(uint4*)&sl[5 * RSLOT + lane * RS + wv * 8] = make_uint4(pb[0], pb[1], pb[2], pb[3]);
            *(uint4*)&sl[6 * RSLOT + lane * RS + wv * 8] = make_uint4(pk4[0], pk4[1], pk4[2], pk4[3]);
            *(uint4*)&sl[7 * RSLOT + lane * RS + wv * 8] = make_uint4(pv4[0], pv4[1], pv4[2], pv4[3]);
        }
        LDS_BARRIER();
        if (h + 1 < 8) { S1_LOADW(h + 1) S2_LOADX(h + 1) }
        CH_TE(2) CH_TS(3)
        {
            RW_IDX
            f32x4 acc[2];
            ZACC(acc); mm64(sl + 1 * RSLOT, RS, sl + 0 * RSLOT, RS, acc, lane, wv);
#pragma unroll
            for (int i = 0; i < 2; i++) {
                f32x4 pm;
#pragma unroll
                for (int r = 0; r < 4; r++) {
                    const int m = mt * 16 + qq * 4 + r, n = (nt0 + i) * 16 + kr;
                    if (!(m < n)) acc[i][r] = 0.f;
                    pm[r] = acc[i][r] + ((m == n) ? 1.f : 0.f);
                }
                st_t(sl + 8 * RSLOT, RS, acc[i], mt, nt0 + i, lane);
                st_n(sl + 9 * RSLOT, RS, acc[i], mt, nt0 + i, lane);
                st_t(sl + 13 * RSLOT, RS, pm, mt, nt0 + i, lane);
            }
            ZACC(acc); mm64(sl + 0 * RSLOT, RS, sl + 2 * RSLOT, RS, acc, lane, wv);
#pragma unroll
            for (int i = 0; i < 2; i++) {
#pragma unroll
                for (int r = 0; r < 4; r++) { const int m = mt * 16 + qq * 4 + r, n = (nt0 + i) * 16 + kr; if (!(m > n)) acc[i][r] = 0.f; }
                st_t(sl + 10 * RSLOT, RS, acc[i], mt, nt0 + i, lane);
            }
            ZACC(acc); mm64(sl + 1 * RSLOT, RS, sl + 3 * RSLOT, RS, acc, lane, wv);
#pragma unroll
            for (int i = 0; i < 2; i++) {
#pragma unroll
                for (int r = 0; r < 4; r++) { const int m = mt * 16 + qq * 4 + r, n = (nt0 + i) * 16 + kr; if (m > n) acc[i][r] = 0.f; }
                st_t(sl + 11 * RSLOT, RS, acc[i], mt, nt0 + i, lane);
            }
            ZACC(acc); mm64(sl + 2 * RSLOT, RS, sl + 3 * RSLOT, RS, acc, lane, wv);
#pragma unroll
            for (int i = 0; i < 2; i++) {
#pragma unroll
                for (int r = 0; r < 4; r++) { const int m = mt * 16 + qq * 4 + r, n = (nt0 + i) * 16 + kr; if (m > n) acc[i][r] = 0.f; }
                st_t(sl + 12 * RSLOT, RS, acc[i], mt, nt0 + i, lane);
            }
        }
        LDS_BARRIER();
        CH_TE(3) CH_TS(4)
        u16* X = sl + 8 * RSLOT; u16* XT = sl + 9 * RSLOT; u16* X2 = sl + 0 * RSLOT; u16* X2T = sl + 1 * RSLOT;
        u16* Pc = sl + 13 * RSLOT; u16* Pn = sl + 2 * RSLOT;
#pragma unroll 1
        for (int j = 1; j <= 6; j++) {
            RW_IDX
            f32x4 acc[2];
            if (j <= 5) {
                ZACC(acc); mm64(X, RS, XT, RS, acc, lane, wv);
#pragma unroll
                for (int i = 0; i < 2; i++) { st_t(X2T, RS, acc[i], mt, nt0 + i, lane); st_n(X2, RS, acc[i], mt, nt0 + i, lane); }
            }
            if (j >= 2) {
                ZACC(acc); mm64(XT, RS, Pc, RS, acc, lane, wv);
#pragma unroll
                for (int i = 0; i < 2; i++) {
                    const uint2 pv = *(const uint2*)&Pc[((nt0 + i) * 16 + kr) * RS + mt * 16 + qq * 4];
                    acc[i][0] += __uint_as_float(pv.x << 16); acc[i][1] += __uint_as_float(pv.x & 0xFFFF0000u);
                    acc[i][2] += __uint_as_float(pv.y << 16); acc[i][3] += __uint_as_float(pv.y & 0xFFFF0000u);
                    st_t(Pn, RS, acc[i], mt, nt0 + i, lane);
                }
            }
            LDS_BARRIER();
            if (j >= 2) { u16* tp = Pc; Pc = Pn; Pn = tp; }
            if (j <= 5) { u16* tx = X; X = X2; X2 = tx; tx = XT; XT = X2T; X2T = tx; }
        }
        CH_TE(4) CH_TS(5)
        u16* TT = Pc;
        {
            RW_IDX
            f32x4 acc[2];
            ZACC(acc); mm64(TT, RS, sl + 4 * RSLOT, RS, acc, lane, wv);
#pragma unroll
            for (int i = 0; i < 2; i++) st_t(sl + 0 * RSLOT, RS, acc[i], mt, nt0 + i, lane);
            ZACC(acc); mm64(sl + 10 * RSLOT, RS, TT, RS, acc, lane, wv);
#pragma unroll
            for (int i = 0; i < 2; i++) st_t(sl + 8 * RSLOT, RS, acc[i], mt, nt0 + i, lane);
        }
        LDS_BARRIER();
        {
            RW_IDX
            f32x4 acc[2];
            ZACC(acc); mm64(sl + 8 * RSLOT, RS, sl + 7 * RSLOT, RS, acc, lane, wv);
#pragma unroll
            for (int i = 0; i < 2; i++) st_t(sl + 9 * RSLOT, RS, acc[i], mt, nt0 + i, lane);
            ZACC(acc); mm64(sl + 0 * RSLOT, RS, sl + 5 * RSLOT, RS, acc, lane, wv);
#pragma unroll
            for (int i = 0; i < 2; i++) {
                const int n = (nt0 + i) * 16 + kr; const float gn = gl[n];
#pragma unroll
                for (int r = 0; r < 4; r++) { const int m = mt * 16 + qq * 4 + r; acc[i][r] = acc[i][r] * gn + ((m == n) ? gn : 0.f); }
                st_t(cd, 64, acc[i], mt, nt0 + i, lane);
            }
            ZACC(acc); mm64(sl + 0 * RSLOT, RS, sl + 11 * RSLOT, RS, acc, lane, wv);
#pragma unroll
            for (int i = 0; i < 2; i++) {
                const uint2 rv = *(const uint2*)&sl[3 * RSLOT + ((nt0 + i) * 16 + kr) * RS + mt * 16 + qq * 4];
                acc[i][0] += __uint_as_float(rv.x << 16); acc[i][1] += __uint_as_float(rv.x & 0xFFFF0000u);
                acc[i][2] += __uint_as_float(rv.y << 16); acc[i][3] += __uint_as_float(rv.y & 0xFFFF0000u);
                st_t(cd + 2 * 4096, 64, acc[i], mt, nt0 + i, lane);
            }
        }
        LDS_BARRIER();
        {
            RW_IDX
            f32x4 acc[2];
            ZACC(acc);
            mm64(sl + 5 * RSLOT, RS, sl + 9 * RSLOT, RS, acc, lane, wv);
            mm64(sl + 6 * RSLOT, RS, sl + 7 * RSLOT, RS, acc, lane, wv);
#pragma unroll
            for (int i = 0; i < 2; i++) {
#pragma unroll
                for (int r = 0; r < 4; r++) acc[i][r] *= gl[mt * 16 + qq * 4 + r];
                st_t(cd + 1 * 4096, 64, acc[i], mt, nt0 + i, lane);
            }
            ZACC(acc);
            mm64(sl + 9 * RSLOT, RS, sl + 11 * RSLOT, RS, acc, lane, wv);
            mm64(sl + 7 * RSLOT, RS, sl + 12 * RSLOT, RS, acc, lane, wv);
#pragma unroll
            for (int i = 0; i < 2; i++) st_t(cd + 3 * 4096, 64, acc[i], mt, nt0 + i, lane);
        }
        CH_TE(5)
      }
    }
    if (CHPROBE) { __syncthreads(); const unsigned long long t1_ = __builtin_amdgcn_s_memrealtime(); while (__builtin_amdgcn_s_memrealtime() - t1_ < ctacc_) __builtin_amdgcn_s_sleep(8); }
}

__device__ void ph_rwkv_seq(const P& p, int bid, int nb, char* smem) {
    u16* SL = (u16*)smem;
    const int tid = get_tid(), lane = tid & 63, wv = __builtin_amdgcn_readfirstlane(tid >> 6);
    const int kr = lane & 15, qq = lane >> 4, chn = wv >> 2, vt = wv & 3;
    for (int pair = bid; pair < B_ * 4; pair += nb) {
        const int bh = pair * 2 + chn;
        u16* mySL = SL + chn * RSLOT;
        __syncthreads();
#pragma unroll
        for (int ks = 0; ks < 2; ks++) *(uint4*)&mySL[(vt * 16 + kr) * RS + ks * 32 + qq * 8] = make_uint4(0u, 0u, 0u, 0u);
        u16* cbase = p.cdat + (size_t)bh * 128 * 4 * 4096;
        bf16x8 GA0[4][2], GA1[4][2], GA2[4][2], GA3[4][2]; uint2 H0[4], H1[4], H2[4], H3[4];
#define SEQ_LD(GAx, Hx, c) { const u16* cd_ = cbase + (size_t)(c) * 4 * 4096; \
            _Pragma("unroll") for (int m4 = 0; m4 < 4; m4++) { \
                _Pragma("unroll") for (int ks = 0; ks < 2; ks++) GAx[m4][ks] = *(const bf16x8*)&cd_[(m4 * 16 + kr) * 64 + ks * 32 + qq * 8]; \
                Hx[m4] = *(const uint2*)&cd_[1 * 4096 + (vt * 16 + kr) * 64 + m4 * 16 + qq * 4]; } }
#define SEQ_STEP(GAx, Hx, c) { \
            bf16x8 Z0[2]; \
            _Pragma("unroll") for (int ks = 0; ks < 2; ks++) Z0[ks] = *(const bf16x8*)&mySL[(vt * 16 + kr) * RS + ks * 32 + qq * 8]; \
            f32x4 zs[4]; \
            _Pragma("unroll") for (int m4 = 0; m4 < 4; m4++) { \
                zs[m4] = unpack4(Hx[m4]); \
                _Pragma("unroll") for (int ks = 0; ks < 2; ks++) zs[m4] = __builtin_amdgcn_mfma_f32_16x16x32_bf16(GAx[m4][ks], Z0[ks], zs[m4], 0, 0, 0); } \
            u16* sn_ = cbase + (size_t)(c) * 4 * 4096 + 1 * 4096 + (vt * 16 + kr) * 64 + qq * 4; \
            _Pragma("unroll") for (int m4 = 0; m4 < 4; m4++) { \
                const uint2 pk_ = pack4(zs[m4]); \
                *(uint2*)&mySL[(vt * 16 + kr) * RS + m4 * 16 + qq * 4] = pk_; \
                *(uint2*)&sn_[m4 * 16] = pk_; } \
            if ((c) + 4 < 128) SEQ_LD(GAx, Hx, (c) + 4) }
        SEQ_LD(GA0, H0, 0) SEQ_LD(GA1, H1, 1) SEQ_LD(GA2, H2, 2) SEQ_LD(GA3, H3, 3)
#pragma unroll 1
        for (int c = 0; c < 128; c += 4) {
            SEQ_STEP(GA0, H0, c)
            SEQ_STEP(GA1, H1, c + 1)
            SEQ_STEP(GA2, H2, c + 2)
            SEQ_STEP(GA3, H3, c + 3)
        }
#undef SEQ_LD
#undef SEQ_STEP
    }
}

__device__ void ph_rwkv_out(const P& p, int bid, int nb, char* smem) {
    const int tid = get_tid(), lane = tid & 63, wv = tid >> 6;
    const int kr = lane & 15, qq = lane >> 4;
    for (int it = bid * NW + wv; it < B_ * 8 * 128; it += nb * NW) {
        const int c = it & 127, bh = it >> 7, b = bh >> 3, h = bh & 7;
        const u16* cd = p.cdat + ((size_t)bh * 128 + c) * 4 * 4096;
        f32x4 ys[4][4];
#pragma unroll
        for (int mt = 0; mt < 4; mt++)
#pragma unroll
            for (int nt = 0; nt < 4; nt++) ys[mt][nt] = unpack4(*(const uint2*)&cd[3 * 4096 + (nt * 16 + kr) * 64 + mt * 16 + qq * 4]);
        if (c > 0) {
            const u16* s0 = cd - 4 * 4096 + 1 * 4096;
#pragma unroll
            for (int ks = 0; ks < 2; ks++) {
                bf16x8 af[4], bq[4];
#pragma unroll
                for (int mt = 0; mt < 4; mt++) af[mt] = *(const bf16x8*)&s0[(mt * 16 + kr) * 64 + ks * 32 + qq * 8];
#pragma unroll
                for (int nt = 0; nt < 4; nt++) bq[nt] = *(const bf16x8*)&cd[2 * 4096 + (nt * 16 + kr) * 64 + ks * 32 + qq * 8];
#pragma unroll
                for (int mt = 0; mt < 4; mt++)
#pragma unroll
                    for (int nt = 0; nt < 4; nt++) ys[mt][nt] = __builtin_amdgcn_mfma_f32_16x16x32_bf16(af[mt], bq[nt], ys[mt][nt], 0, 0, 0);
            }
        }
#pragma unroll
        for (int nt = 0; nt < 4; nt++) {
            float s1 = 0.f, s2 = 0.f;
#pragma unroll
            for (int mt = 0; mt < 4; mt++)
#pragma unroll
                for (int r = 0; r < 4; r++) { s1 += ys[mt][nt][r]; s2 += ys[mt][nt][r] * ys[mt][nt][r]; }
            s1 = xrow_sum(s1); s2 = xrow_sum(s2);
            const float mean = s1 * (1.f / 64.f);
            const float var = fmaxf(s2 * (1.f / 64.f) - mean * mean, 0.f);
            const float rstd = rsqrtf(var + 64e-5f);
            const int t = nt * 16 + kr;
            const size_t n = (size_t)b * S_ + c * 64 + t;
            const float bon = p.bon[n * 8 + h];
#pragma unroll
            for (int mt = 0; mt < 4; mt++) {
                const int vch = h * 64 + mt * 16 + qq * 4;
                const f32x4 vcf = unpack4(*(const uint2*)&p.prw[n * CRW + 1024 + vch]);
                const f32x4 vpf = (c * 64 + t > 0) ? unpack4(*(const uint2*)&p.prw[(n - 1) * CRW + 1024 + vch]) : f32x4{0.f, 0.f, 0.f, 0.f};
                const f32x4 ggf = unpack4(*(const uint2*)&p.ob[n * 512 + vch]);
                const float4 lw = *(const float4*)&p.ln_w[vch], lb = *(const float4*)&p.ln_b[vch], mv = *(const float4*)&p.mu[1024 + vch];
                const float lwa[4] = {lw.x, lw.y, lw.z, lw.w}, lba[4] = {lb.x, lb.y, lb.z, lb.w}, mva[4] = {mv.x, mv.y, mv.z, mv.w};
                f32x4 o;
#pragma unroll
                for (int r = 0; r < 4; r++) {
                    const float vsh = vcf[r] + (vpf[r] - vcf[r]) * mva[r];
                    o[r] = ((ys[mt][nt][r] - mean) * rstd * lwa[r] + lba[r] + bon * vsh) * ggf[r];
                }
                *(uint2*)&p.ob[n * 512 + vch] = pack4(o);
            }
        }
    }
}

__device__ __forceinline__ void unpack8(const uint4& u, f32x4& a, f32x4& b) {
    a = f32x4{__uint_as_float(u.x << 16), __uint_as_float(u.x & 0xFFFF0000u), __uint_as_float(u.y << 16), __uint_as_float(u.y & 0xFFFF0000u)};
    b = f32x4{__uint_as_float(u.z << 16), __uint_as_float(u.z & 0xFFFF0000u), __uint_as_float(u.w << 16), __uint_as_float(u.w & 0xFFFF0000u)};
}
struct EpiMerge {
    u16* merged; u16* tmp2; int pass;
    __device__ __forceinline__ void operator()(const f32x4 (&acc)[2][2][4][2], const GUnit& u, int, int, int, int) const {
        const int t2_ = get_tid(), wid_ = __builtin_amdgcn_readfirstlane(t2_ >> 6), wr = wid_ >> 2, wc = wid_ & 3, fr = t2_ & 15, fq = (t2_ >> 4) & 3;
        const int row0 = u.pm * 256 + wr * 64 + fr, col0 = u.pn * 256 + wc * 32 + 8 * fq;
#pragma unroll
        for (int ai = 0; ai < 2; ++ai)
#pragma unroll
            for (int m = 0; m < 4; ++m) {
                const size_t off = (size_t)(row0 + ai * 128 + m * 16) * D_ + col0;
                uint4 m1[2], m2[2];
                if (pass == 1 || pass == 3) {
#pragma unroll
                    for (int bj = 0; bj < 2; ++bj) { m1[bj] = *(const uint4*)&merged[off + bj * 128]; if (pass == 3) m2[bj] = *(const uint4*)&tmp2[off + bj * 128]; }
                }
#pragma unroll
                for (int bj = 0; bj < 2; ++bj) {
                    f32x4 v0 = acc[ai][bj][m][0], v1 = acc[ai][bj][m][1];
                    if (pass == 1) { f32x4 a0, a1; unpack8(m1[bj], a0, a1);
#pragma unroll
                        for (int r = 0; r < 4; r++) { v0[r] = a0[r] * sigmoidf_(v0[r]); v1[r] = a1[r] * sigmoidf_(v1[r]); } }
                    if (pass == 3) { f32x4 a0, a1, b0, b1; unpack8(m1[bj], a0, a1); unpack8(m2[bj], b0, b1);
#pragma unroll
                        for (int r = 0; r < 4; r++) { v0[r] = a0[r] + b0[r] * sigmoidf_(v0[r]); v1[r] = a1[r] + b1[r] * sigmoidf_(v1[r]); } }
                    *(uint4*)&((pass == 2) ? tmp2 : merged)[off + bj * 128] = pack8(v0, v1);
                }
                asm volatile("" ::: "memory");
            }
    }
};
__device__ void ph_merge(const P& p, int bid, int nb, char* smem) {
    u16* tmp2 = (u16*)p.x1;
#pragma unroll 1
    for (int pass = 0; pass < 4; ++pass) {
        const int K = (pass & 1) ? D_ : 512;
        const u16* A = (pass & 1) ? p.hbuf : (pass == 0 ? p.oa : p.ob);
        const u16* Bt = (pass == 0) ? p.wpaT : (pass == 1 ? p.wgT : (pass == 2 ? p.wpbT : p.wgT + (size_t)1024 * D_));
        DenseSched S; S.init(NTOK, D_, K, Bt, nb, bid);
        EpiMerge E{p.merged, tmp2, pass};
        gemm256(smem, (const char*)A, K, S, E);
    }
}

struct EpiOutproj {
    const float* x; float* x1;
    __device__ __forceinline__ void operator()(const f32x4 (&acc)[2][2][4][2], const GUnit& u, int, int, int, int) const {
        const int t2_ = get_tid(), wid_ = __builtin_amdgcn_readfirstlane(t2_ >> 6), wr = wid_ >> 2, wc = wid_ & 3, fr = t2_ & 15, fq = (t2_ >> 4) & 3;
        const int row0 = u.pm * 256 + wr * 64 + fr, col0 = u.pn * 256 + wc * 32 + 4 * fq;
#pragma unroll
        for (int ai = 0; ai < 2; ++ai)
#pragma unroll
            for (int m = 0; m < 4; ++m) {
                const size_t off = (size_t)(row0 + ai * 128 + m * 16) * D_ + col0;
                f32x4 xin[2][2];
#pragma unroll
                for (int bj = 0; bj < 2; ++bj)
#pragma unroll
                    for (int n = 0; n < 2; ++n) xin[bj][n] = *(const f32x4*)&x[off + bj * 128 + n * 16];
#pragma unroll
                for (int bj = 0; bj < 2; ++bj)
#pragma unroll
                    for (int n = 0; n < 2; ++n) *(f32x4*)&x1[off + bj * 128 + n * 16] = xin[bj][n] + acc[ai][bj][m][n];
                asm volatile("" ::: "memory");
            }
    }
};
__device__ void ph_outproj(const P& p, int bid, int nb, char* smem) {
    DenseSched S; S.init(NTOK, D_, D_, p.woutT, nb, bid);
    EpiOutproj E{p.x, p.x1};
    gemm256(smem, (const char*)p.merged, D_, S, E);
}

__device__ __forceinline__ float red8f(float x) {
    x += dppf<0xB1>(x);
    x += dppf<0x4E>(x);
    x += dppf<0x141>(x);
    return x;
}
__device__ void ph_route(const P& p, int bid, int nb, char* smem) {
    float* wr = (float*)smem;
    const int tid = get_tid(), lane = tid & 63, wv = tid >> 6;
    {
        u16* Tl = (u16*)smem;
        const int t = get_tid();
        const int lrow = t >> 3, lc8 = (t & 7) * 8;
        const int sslot = t >> 3, skc = t & 7;
        const int scol = (sslot & 32) + perm32(sslot & 31);
        constexpr int NT13 = NEXP * 2 * 4 * 16, NT2 = NEXP * 16 * 4;
        for (int tile = bid; tile < NT13 + NT2; tile += nb) {
            const float* src; u16* dst; int N, Kd;
            if (tile < NT13) {
                const int kt = tile & 15, sg = (tile >> 4) & 3, half = (tile >> 6) & 1, e = tile >> 7;
                const int sl0 = sg * 64;
                N = 256; Kd = D_;
                src = ((sl0 >> 7) ? p.e_w3 : p.e_w1) + (size_t)e * D_ * 256 + (size_t)(kt * 64) * 256 + half * 128 + (sl0 & 127);
                dst = p.ew1T + ((size_t)e * 512 + half * 256 + sl0) * D_ + kt * 64;
            } else {
                const int t2 = tile - NT13;
                const int kt = t2 & 3, sg = (t2 >> 2) & 15, e = t2 >> 6;
                N = D_; Kd = 256;
                src = p.e_w2 + (size_t)e * 256 * D_ + (size_t)(kt * 64) * D_ + sg * 64;
                dst = p.ew2T + ((size_t)e * D_ + sg * 64) * 256 + kt * 64;
            }
            const float4 f0 = *(const float4*)&src[(size_t)lrow * N + lc8], f1 = *(const float4*)&src[(size_t)lrow * N + lc8 + 4];
            __syncthreads();
            const unsigned h0 = pack2(f0.x, f0.y), h1 = pack2(f0.z, f0.w), h2 = pack2(f1.x, f1.y), h3 = pack2(f1.z, f1.w);
            Tl[(lc8 + 0) * 72 + lrow] = (u16)(h0 & 0xFFFFu); Tl[(lc8 + 1) * 72 + lrow] = (u16)(h0 >> 16);
            Tl[(lc8 + 2) * 72 + lrow] = (u16)(h1 & 0xFFFFu); Tl[(lc8 + 3) * 72 + lrow] = (u16)(h1 >> 16);
            Tl[(lc8 + 4) * 72 + lrow] = (u16)(h2 & 0xFFFFu); Tl[(lc8 + 5) * 72 + lrow] = (u16)(h2 >> 16);
            Tl[(lc8 + 6) * 72 + lrow] = (u16)(h3 & 0xFFFFu); Tl[(lc8 + 7) * 72 + lrow] = (u16)(h3 >> 16);
            __syncthreads();
            *(uint4*)&dst[(size_t)sslot * Kd + skc * 8] = *(const uint4*)&Tl[scol * 72 + skc * 8];
        }
        __syncthreads();
    }
    for (int i = tid; i < 1024 * 36; i += NT) {
        const int k = i / 36, j = i - k * 36;
        const int kp = (k & ~31) + ((k & 3) << 3) + ((k >> 2) & 7);
        wr[kp * 36 + j] = (j < 4) ? p.w_grp[k * 4 + j] : p.w_exp[k * 32 + (j - 4)];
    }
    int* lcount = (int*)(smem + 1024 * 36 * 4);
    if (tid < 32) lcount[tid] = 0;
    __syncthreads();
    const int sub = lane & 7, tk = lane >> 3;
    for (int n0 = (bid * NW + wv) * 16; n0 < NTOK; n0 += nb * NW * 16) {
        float acc[2][36]; float ss[2] = {0.f, 0.f};
#pragma unroll
        for (int t = 0; t < 2; t++)
#pragma unroll
            for (int j = 0; j < 36; j++) acc[t][j] = 0.f;
#pragma unroll 1
        for (int i0 = 0; i0 < 32; i0 += 4) {
            float4 xv[2][4];
#pragma unroll
            for (int t = 0; t < 2; t++)
#pragma unroll
                for (int i = 0; i < 4; i++) xv[t][i] = *(const float4*)&p.x1[(size_t)(n0 + 8 * t + tk) * D_ + (i0 + i) * 32 + sub * 4];
#pragma unroll
            for (int i = 0; i < 4; i++) {
                const int k0 = (i0 + i) * 32 + sub * 4;
                const float4 gf = *(const float4*)&p.g_ffn[k0];
                float hv[2][4];
#pragma unroll
                for (int t = 0; t < 2; t++) {
                    const float4 x = xv[t][i];
                    ss[t] += x.x * x.x + x.y * x.y + x.z * x.z + x.w * x.w;
                    hv[t][0] = x.x * gf.x; hv[t][1] = x.y * gf.y; hv[t][2] = x.z * gf.z; hv[t][3] = x.w * gf.w;
                    uint2 o; o.x = pack2(hv[t][0], hv[t][1]); o.y = pack2(hv[t][2], hv[t][3]);
                    *(uint2*)&p.hbuf[(size_t)(n0 + 8 * t + tk) * D_ + k0] = o;
                }
#pragma unroll
                for (int e2 = 0; e2 < 4; e2++) {
                    asm volatile("" ::: "memory");
                    const float* wrow = wr + ((i0 + i) * 32 + e2 * 8 + sub) * 36;
#pragma unroll
                    for (int j4 = 0; j4 < 9; j4++) {
                        const float4 wv4 = *(const float4*)&wrow[j4 * 4];
#pragma unroll
                        for (int t = 0; t < 2; t++) {
                            acc[t][j4 * 4 + 0] += hv[t][e2] * wv4.x; acc[t][j4 * 4 + 1] += hv[t][e2] * wv4.y;
                            acc[t][j4 * 4 + 2] += hv[t][e2] * wv4.z; acc[t][j4 * 4 + 3] += hv[t][e2] * wv4.w;
                        }
                    }
                }
            }
        }
#pragma unroll
        for (int t = 0; t < 2; t++) {
            const size_t n = (size_t)n0 + 8 * t + tk;
            const float sst = red8f(ss[t]);
#pragma unroll
            for (int j = 0; j < 36; j++) acc[t][j] = red8f(acc[t][j]);
            const float rs = rsqrtf(sst * (1.f / D_) + 1e-6f);
            if (sub == 0) {
                p.rsb[n] = rs;
                float gl[4]; int gs = 0;
#pragma unroll
                for (int j = 0; j < 4; j++) gl[j] = acc[t][j] * rs + p.b_grp[j];
                float gm = gl[0];
#pragma unroll
                for (int j = 1; j < 4; j++) if (gl[j] > gm) { gm = gl[j]; gs = j; }
                float gsum = 0.f;
#pragma unroll
                for (int j = 0; j < 4; j++) gsum += __expf(gl[j] - gm);
                const float pg = 1.f / gsum;
                float el[8]; float em = -3.0e38f;
#pragma unroll
                for (int j = 0; j < 8; j++) {
                    float a = (gs == 0) ? acc[t][4 + j] : ((gs == 1) ? acc[t][12 + j] : ((gs == 2) ? acc[t][20 + j] : acc[t][28 + j]));
                    a = a * rs + p.b_exp[gs * 8 + j];
                    el[j] = a; em = fmaxf(em, a);
                }
                int j0 = 0, j1 = -1; float v0 = -3.0e38f, v1 = -3.0e38f;
#pragma unroll
                for (int j = 0; j < 8; j++) { el[j] = __expf(el[j] - em); }
#pragma unroll
                for (int j = 0; j < 8; j++) { if (el[j] > v0) { v0 = el[j]; j0 = j; } }
#pragma unroll
                for (int j = 0; j < 8; j++) { if (j != j0 && el[j] > v1) { v1 = el[j]; j1 = j; } }
                const float den = v0 + v1;
                const int e0 = gs * 8 + j0, e1 = gs * 8 + j1;
                p.tok_e[n * 2] = e0; p.tok_e[n * 2 + 1] = e1;
                p.tok_gate[n * 2] = pg * v0 / den; p.tok_gate[n * 2 + 1] = pg * v1 / den;
                atomicAdd(&lcount[e0], 1); atomicAdd(&lcount[e1], 1);
            }
        }
    }
    __syncthreads();
    { const int t2 = get_tid(); if (t2 < 32) { const int c = lcount[t2]; if (c) atomicAdd(&p.counts[t2], c); } }
}

__device__ void ph_scatter(const P& p, int bid, int nb, char* smem) {
    int* offl = (int*)smem;
    int* hist = offl + 64;
    int* gbase = hist + 32;
    const int tid = get_tid();
    if (tid == 0) {
        int off = 0;
        for (int e = 0; e < NEXP; e++) { offl[e] = off; off += p.counts[e]; }
        offl[NEXP] = off;
    }
    if (bid == 0 && tid == 64) {
        int off = 0, nb_ = 0;
        for (int e = 0; e < NEXP; e++) {
            const int c = p.counts[e];
            p.offs[e] = off;
            for (int r = 0; r < c; r += 256) { p.blk_e[nb_] = e; p.blk_r0[nb_] = off + r; nb_++; }
            off += c;
        }
        p.offs[NEXP] = off;
        *p.nblk = nb_;
    }
    for (int base = bid * NT; base < NTOK * 2; base += nb * NT) {
        __syncthreads();
        if (tid < 32) hist[tid] = 0;
        __syncthreads();
        const int i = base + tid;
        const int e = p.tok_e[i];
        const int rl = atomicAdd(&hist[e], 1);
        __syncthreads();
        if (tid < 32) gbase[tid] = atomicAdd(&p.cursor[tid], hist[tid]);
        __syncthreads();
        const int slot = offl[e] + gbase[e] + rl;
        p.list_tok[slot] = i >> 1; p.list_gate[slot] = p.tok_gate[i]; p.tokslot[i] = slot;
    }
}
template <int CTS>
struct MoeSched {
    const P* pp; int nunits, G, c; unsigned rowbytes; const u16* Bt; size_t b_estride, b_tstride;
    bool gather;
    __device__ __forceinline__ bool next(int i, GUnit& u) const {
        const int L = i * G + c; if (L >= nunits) return false;
        int wgid = L; { const int q = nunits >> 3, r = nunits & 7, xcd = wgid & 7, off = wgid >> 3; wgid = (xcd < r ? xcd * (q + 1) : r * (q + 1) + (xcd - r) * q) + off; }
        u.pm = wgid / CTS; u.pn = wgid & (CTS - 1); return true;
    }
    __device__ __forceinline__ unsigned a_off(const GUnit& u, int h, int R) const {
        const P& p = *pp;
        const int e = __builtin_amdgcn_readfirstlane(p.blk_e[u.pm]), rend = __builtin_amdgcn_readfirstlane(p.offs[e + 1]);
        int sl = __builtin_amdgcn_readfirstlane(p.blk_r0[u.pm]) + h * 128 + R; if (sl >= rend) sl = rend - 1;
        return (unsigned)(gather ? p.list_tok[sl] : sl) * rowbytes;
    }
    __device__ __forceinline__ const char* b_ptr(const GUnit& u) const { return (const char*)(Bt + (size_t)__builtin_amdgcn_readfirstlane(pp->blk_e[u.pm]) * b_estride + (size_t)u.pn * b_tstride); }
};
struct EpiMoe1 {
    const P* pp;
    __device__ __forceinline__ void operator()(const f32x4 (&acc)[2][2][4][2], const GUnit& u, int, int, int, int) const {
        const int t2_ = get_tid(), wid_ = __builtin_amdgcn_readfirstlane(t2_ >> 6), wr = wid_ >> 2, wc = wid_ & 3, fr = t2_ & 15, fq = (t2_ >> 4) & 3;
        const P& p = *pp;
        const int e = __builtin_amdgcn_readfirstlane(p.blk_e[u.pm]), r0 = __builtin_amdgcn_readfirstlane(p.blk_r0[u.pm]), rend = __builtin_amdgcn_readfirstlane(p.offs[e + 1]);
#pragma unroll
        for (int ai = 0; ai < 2; ++ai)
#pragma unroll
            for (int m = 0; m < 4; ++m) {
                const int sl = r0 + ai * 128 + wr * 64 + m * 16 + fr;
                if (sl < rend) {
                    const float rs = p.rsb[p.list_tok[sl]];
                    f32x4 v[2];
#pragma unroll
                    for (int n = 0; n < 2; ++n)
#pragma unroll
                        for (int r = 0; r < 4; r++) { const float a = acc[ai][0][m][n][r] * rs; v[n][r] = a * sigmoidf_(a) * (acc[ai][1][m][n][r] * rs); }
                    *(uint4*)&p.hid[(size_t)sl * 256 + u.pn * 128 + wc * 32 + 8 * fq] = pack8(v[0], v[1]);
                }
            }
    }
};
__device__ void ph_moe1(const P& p, int bid, int nb, char* smem) {
    MoeSched<2> S{&p, __builtin_amdgcn_readfirstlane(*p.nblk) * 2, nb, bid, (unsigned)(D_ * 2), p.ew1T, (size_t)512 * D_, (size_t)256 * D_, true};
    EpiMoe1 E{&p};
    gemm256(smem, (const char*)p.hbuf, D_, S, E);
}
struct EpiMoe2 {
    const P* pp;
    __device__ __forceinline__ void operator()(const f32x4 (&acc)[2][2][4][2], const GUnit& u, int, int, int, int) const {
        const int t2_ = get_tid(), wid_ = __builtin_amdgcn_readfirstlane(t2_ >> 6), wr = wid_ >> 2, wc = wid_ & 3, fr = t2_ & 15, fq = (t2_ >> 4) & 3;
        const P& p = *pp;
        const int e = __builtin_amdgcn_readfirstlane(p.blk_e[u.pm]), r0 = __builtin_amdgcn_readfirstlane(p.blk_r0[u.pm]), rend = __builtin_amdgcn_readfirstlane(p.offs[e + 1]);
#pragma unroll
        for (int ai = 0; ai < 2; ++ai)
#pragma unroll
            for (int m = 0; m < 4; ++m) {
                const int sl = r0 + ai * 128 + wr * 64 + m * 16 + fr;
                if (sl < rend) {
                    const float gt = p.list_gate[sl];
                    u16* yp = p.ybuf + (size_t)sl * D_ + u.pn * 256 + wc * 32 + 8 * fq;
#pragma unroll
                    for (int bj = 0; bj < 2; ++bj) *(uint4*)&yp[bj * 128] = pack8(acc[ai][bj][m][0] * gt, acc[ai][bj][m][1] * gt);
                }
            }
    }
};
__device__ void ph_moe2(const P& p, int bid, int nb, char* smem) {
    MoeSched<4> S{&p, __builtin_amdgcn_readfirstlane(*p.nblk) * 4, nb, bid, 512u, p.ew2T, (size_t)D_ * 256, (size_t)256 * 256, false};
    EpiMoe2 E{&p};
    gemm256(smem, (const char*)p.hid, 256, S, E);
}
__device__ void ph_final(const P& p, int bid, int nb, char* smem) {
    const int tid = get_tid(), lane = tid & 63, wv = tid >> 6;
    for (int row = bid * NW + wv; row < NTOK; row += nb * NW) {
        const int s0 = p.tokslot[row * 2], s1 = p.tokslot[row * 2 + 1];
        float v[16]; float ss = 0.f;
#pragma unroll
        for (int i = 0; i < 4; i++) {
            const int c = i * 256 + lane * 4;
            const float4 t = *(const float4*)&p.x1[(size_t)row * D_ + c];
            const uint2 a = *(const uint2*)&p.ybuf[(size_t)s0 * D_ + c];
            const uint2 bq = *(const uint2*)&p.ybuf[(size_t)s1 * D_ + c];
            v[4 * i]     = t.x + __uint_as_float(a.x << 16) + __uint_as_float(bq.x << 16);
            v[4 * i + 1] = t.y + __uint_as_float(a.x & 0xFFFF0000u) + __uint_as_float(bq.x & 0xFFFF0000u);
            v[4 * i + 2] = t.z + __uint_as_float(a.y << 16) + __uint_as_float(bq.y << 16);
            v[4 * i + 3] = t.w + __uint_as_float(a.y & 0xFFFF0000u) + __uint_as_float(bq.y & 0xFFFF0000u);
            ss += v[4 * i] * v[4 * i] + v[4 * i + 1] * v[4 * i + 1] + v[4 * i + 2] * v[4 * i + 2] + v[4 * i + 3] * v[4 * i + 3];
        }
        ss = wave_sum(ss);
        const float rs = rsqrtf(ss * (1.f / D_) + 1e-6f);
#pragma unroll
        for (int i = 0; i < 4; i++) {
            const int c = i * 256 + lane * 4;
            const float4 g = *(const float4*)&p.g_final[c];
            float4 o; o.x = v[4 * i] * rs * g.x; o.y = v[4 * i + 1] * rs * g.y; o.z = v[4 * i + 2] * rs * g.z; o.w = v[4 * i + 3] * rs * g.w;
            *(float4*)&p.out[(size_t)row * D_ + c] = o;
        }
    }
}

#define XB_TMO      128
#define XB_XCNT(j)  (256  + 64 * (j))
#define XB_XSUB(j)  (1280 + 64 * (j))
#define XB_XGEN(j)  (2304 + 64 * (j))
#define XB_TOP      3328
#define XB_TOPGEN   3392
#define XCD_BAR_WORDS 3456
#define XB_SPIN_CAP (1u << 18)
#define LAS __attribute__((address_space(3)))

__device__ __forceinline__ unsigned xb_ld(unsigned* p)              { return __hip_atomic_load(p, __ATOMIC_RELAXED, __HIP_MEMORY_SCOPE_AGENT); }
__device__ __forceinline__ unsigned xb_add(unsigned* p, unsigned v) { return __hip_atomic_fetch_add(p, v, __ATOMIC_RELAXED, __HIP_MEMORY_SCOPE_AGENT); }
__device__ __forceinline__ unsigned xb_xcc_id() { return (unsigned)__builtin_amdgcn_s_getreg((3 << 11) | 20) & 0xFu; }
#define XB_SPIN(cond, bar) do { unsigned _sp = 0; while (cond) { __builtin_amdgcn_s_sleep(1); \
    if ((++_sp & 255u) == 0u) { if (xb_ld(&(bar)[XB_TMO])) break; if (_sp > XB_SPIN_CAP) { atomicAdd(&(bar)[XB_TMO], 1u); break; } } } } while (0)

struct XcdBarrier {
    unsigned* bar; unsigned x;
    volatile LAS unsigned* st;
};

__device__ __forceinline__ XcdBarrier xcd_barrier_post(unsigned* bar, volatile LAS unsigned* st) {
    XcdBarrier b; b.bar = bar; b.x = xb_xcc_id(); b.st = st;
    if (threadIdx.x == 0) (void)xb_add(&bar[XB_XCNT(b.x)], 1u);
    return b;
}
__device__ __forceinline__ void xcd_barrier_complete(unsigned* bar, unsigned x, unsigned& nloc, unsigned& nx) {
    const unsigned G = gridDim.x * gridDim.y * gridDim.z;
    unsigned sum, cnt, mine, sp = 0u;
    for (;;) {
        sum = 0u; cnt = 0u; mine = 0u;
#pragma unroll
        for (unsigned j = 0; j < 16; ++j) { const unsigned c = xb_ld(&bar[XB_XCNT(j)]); sum += c; cnt += (c > 0u) ? 1u : 0u; mine = (j == x) ? c : mine; }
        if (sum == G) break;
        __builtin_amdgcn_s_sleep(1);
        if ((++sp & 255u) == 0u) { if (xb_ld(&bar[XB_TMO])) break; if (sp > XB_SPIN_CAP) { atomicAdd(&bar[XB_TMO], 1u); break; } }
    }
    nloc = mine > 0u ? mine : 1u; nx = cnt > 0u ? cnt : 1u;
}

__device__ __forceinline__ void xcd_barrier(const XcdBarrier& b) {
    asm volatile("s_waitcnt vmcnt(0)" ::: "memory");
    __syncthreads();
    if (threadIdx.x == 0) {
        unsigned* bar = b.bar;
        __builtin_amdgcn_s_waitcnt(0);
        unsigned nloc = b.st[0], nx = b.st[1];
        if (nloc == 0u) { xcd_barrier_complete(bar, b.x, nloc, nx); b.st[0] = nloc; b.st[1] = nx; }
        const unsigned old = xb_add(&bar[XB_XSUB(b.x)], 1u);
        const unsigned gen = old / nloc;
        if (old + 1u == (gen + 1u) * nloc) {
            __builtin_amdgcn_fence(__ATOMIC_RELEASE, "agent");
            asm volatile("s_waitcnt vmcnt(0)" ::: "memory");
            const unsigned og = xb_add(&bar[XB_TOP], 1u);
            const unsigned tg = og / nx;
            if (og + 1u == (tg + 1u) * nx) xb_add(&bar[XB_TOPGEN], 1u);
            else XB_SPIN(xb_ld(&bar[XB_TOPGEN]) == tg, bar);
            __builtin_amdgcn_fence(__ATOMIC_ACQUIRE, "agent");
            xb_add(&bar[XB_XGEN(b.x)], 1u);
            asm volatile("s_waitcnt vmcnt(0)" ::: "memory");
        } else {
            XB_SPIN(xb_ld(&bar[XB_XGEN(b.x)]) == gen, bar);
            __builtin_amdgcn_fence(__ATOMIC_ACQUIRE, "agent");
            asm volatile("s_waitcnt vmcnt(0)" ::: "memory");
        }
    }
    __syncthreads();
}

template <int PH>
__device__ __forceinline__ void run_phase(const P& p, int bid, int nb, char* smem) {
    if constexpr (PH == 0) ph_prologue(p, bid, nb, smem);
    if constexpr (PH == 1) ph_inproj(p, bid, nb, smem);
    if constexpr (PH == 2) { ph_compress(p, bid, nb, smem); __syncthreads(); ph_rwkv_chunk(p, bid, nb, smem); }
    if constexpr (PH == 3) {
        if (bid < SCAN_BLOCKS) ph_rwkv_seq(p, bid, SCAN_BLOCKS, smem);
        else ph_nsa(p, bid - SCAN_BLOCKS, nb - SCAN_BLOCKS, smem);
    }
    if constexpr (PH == 12) ph_rwkv_out(p, bid, nb, smem);
    if constexpr (PH == 4) ph_merge(p, bid, nb, smem);
    if constexpr (PH == 5) ph_outproj(p, bid, nb, smem);
    if constexpr (PH == 6) ph_route(p, bid, nb, smem);
    if constexpr (PH == 7) ph_scatter(p, bid, nb, smem);
    if constexpr (PH == 9) ph_moe1(p, bid, nb, smem);
    if constexpr (PH == 10) ph_moe2(p, bid, nb, smem);
    if constexpr (PH == 11) ph_final(p, bid, nb, smem);
}

template <int PH>
__global__ void __launch_bounds__(NT) kph(P p) {
    extern __shared__ __attribute__((aligned(16))) char smem[];
    run_phase<PH>(p, blockIdx.x, gridDim.x, smem);
}

__global__ void __launch_bounds__(NT, 2) mega(P p) {
    extern __shared__ __attribute__((aligned(16))) char smem[];
    volatile LAS unsigned* st = (volatile LAS unsigned*)(smem + SMEM_BYTES - 16);
    if (threadIdx.x == 0) { st[0] = 0u; st[1] = 0u; st[2] = 0u; st[3] = 0u; }
    __syncthreads();
    XcdBarrier bar = xcd_barrier_post(p.bar, st);
    const int bid = blockIdx.x, nb = gridDim.x;
#define RUNP(N, BAR) { unsigned long long t0_ = 0; if ((TPROBE >> N) & 1) t0_ = __builtin_amdgcn_s_memrealtime(); run_phase<N>(p, bid, nb, smem); \
        unsigned long long tw_ = 0; if (((TPROBE >> N) & 1) && TPSEL) tw_ = __builtin_amdgcn_s_memrealtime() - t0_; if (BAR) xcd_barrier(bar); \
        if ((TPROBE >> N) & 1) { const unsigned long long t1_ = __builtin_amdgcn_s_memrealtime(); const unsigned long long dt_ = TPSEL ? tw_ : t1_ - t0_; \
            if (!TPSEL || (TPSEL == 1 ? (bid < SCAN_BLOCKS) : (bid >= SCAN_BLOCKS))) while (__builtin_amdgcn_s_memrealtime() - t1_ < dt_) __builtin_amdgcn_s_sleep(8); if (TPSEL) xcd_barrier(bar); } }
    RUNP(0, 1) RUNP(1, 1) RUNP(2, 1) RUNP(3, 1) RUNP(12, 1) RUNP(4, 1) RUNP(5, 1) RUNP(6, 1) RUNP(7, 1) RUNP(9, 1) RUNP(10, 1) RUNP(11, 0)
}

extern "C" void kernel_launch(void* const* d_in, const int* in_sizes, int n_in,
                              void* d_out, int out_size, void* d_ws, size_t ws_size,
                              hipStream_t stream) {
    P p{};
    p.x = (const float*)d_in[0]; p.pos = (const int*)d_in[1]; p.g_mix = (const float*)d_in[2]; p.w_in = (const float*)d_in[3];
    p.pe_k = (const float*)d_in[4]; p.w1_k = (const float*)d_in[5]; p.b1_k = (const float*)d_in[6]; p.w2_k = (const float*)d_in[7]; p.b2_k = (const float*)d_in[8];
    p.pe_v = (const float*)d_in[9]; p.w1_v = (const float*)d_in[10]; p.b1_v = (const float*)d_in[11]; p.w2_v = (const float*)d_in[12]; p.b2_v = (const float*)d_in[13];
    p.mu = (const float*)d_in[14]; p.w0 = (const float*)d_in[15]; p.w2 = (const float*)d_in[16]; p.a0 = (const float*)d_in[17]; p.a2 = (const float*)d_in[18];
    p.g2 = (const float*)d_in[19]; p.k_k = (const float*)d_in[20]; p.k_a = (const float*)d_in[21]; p.r_k = (const float*)d_in[22]; p.ln_w = (const float*)d_in[23]; p.ln_b = (const float*)d_in[24];
    p.wpa = (const float*)d_in[25]; p.wpb = (const float*)d_in[26]; p.wout = (const float*)d_in[27]; p.g_ffn = (const float*)d_in[28];
    p.w_grp = (const float*)d_in[29]; p.b_grp = (const float*)d_in[30]; p.w_exp = (const float*)d_in[31]; p.b_exp = (const float*)d_in[32];
    p.e_w1 = (const float*)d_in[33]; p.e_w3 = (const float*)d_in[34]; p.e_w2 = (const float*)d_in[35]; p.g_final = (const float*)d_in[36];
    p.out = (float*)d_out;
    char* ws = (char*)d_ws;
    const size_t MiB = 1ull << 20;
    p.hbuf = (u16*)(ws + 0 * MiB);
    p.q    = (u16*)(ws + 64 * MiB);
    p.kc   = (u16*)(ws + 96 * MiB);  p.vc   = (u16*)(ws + 104 * MiB);
    p.ksl  = (u16*)(ws + 112 * MiB); p.vslT = (u16*)(ws + 120 * MiB);
    p.kwn  = (u16*)(ws + 128 * MiB); p.vwnT = (u16*)(ws + 136 * MiB);
    p.nsag = (float*)(ws + 144 * MiB);
    p.kcb  = (u16*)(ws + 148 * MiB); p.vcT  = (u16*)(ws + 149 * MiB);
    p.prw  = (u16*)(ws + 160 * MiB);
    p.cdat = (u16*)(ws + 272 * MiB);
    p.bon  = (float*)(ws + 150 * MiB);
    p.w2T  = (u16*)(ws + 151 * MiB); p.a2T = p.w2T + 512 * 64; p.g2T = p.a2T + 512 * 64;
    p.cw1Tk = (u16*)(ws + 152 * MiB); p.cw1Tv = (u16*)(ws + 153 * MiB);
    p.cw2Tk = (u16*)(ws + 154 * MiB); p.cw2Tv = p.cw2Tk + 128 * 256;
    p.chid = (u16*)(ws + 155 * MiB);
    p.xact = (u16*)(ws + 488 * MiB);
    p.oa   = (u16*)(ws + 400 * MiB);
    p.ob   = (u16*)(ws + 432 * MiB);
    p.merged = (u16*)(ws + 64 * MiB);
    p.x1   = (float*)(ws + 160 * MiB);
    char* rt = ws + 288 * MiB;
    p.tok_e = (int*)(rt);                        rt += NTOK * 2 * 4;
    p.tok_gate = (float*)(rt);                   rt += NTOK * 2 * 4;
    p.tokslot = (int*)(rt);                      rt += NTOK * 2 * 4;
    p.list_tok = (int*)(rt);                     rt += NTOK * 2 * 4;
    p.list_gate = (float*)(rt);                  rt += NTOK * 2 * 4;
    p.blk_e = (int*)(rt);                        rt += 2048 * 4;
    p.blk_r0 = (int*)(rt);                       rt += 2048 * 4;
    p.rsb = (float*)(rt);                        rt += NTOK * 4;
    p.hid  = (u16*)(ws + 296 * MiB);
    p.ybuf = (u16*)(ws + 336 * MiB);
    char* misc = ws + 470 * MiB;
    p.counts = (int*)(misc); p.cursor = (int*)(misc + 256); p.offs = (int*)(misc + 512); p.nblk = (int*)(misc + 1024); p.nsactr = (int*)(misc + 2048);
    p.bar = (unsigned*)(ws + 471 * MiB);
    p.cb1k = (float*)(misc + 65536); p.cb1v = p.cb1k + 256;
    {
        char* wa = ws + 472 * MiB;
        p.winT = (u16*)wa;  wa += (size_t)3328 * 1024 * 2;
        p.wgT  = (u16*)wa;  wa += (size_t)2048 * 1024 * 2;
        p.wpaT = (u16*)wa;  wa += (size_t)1024 * 512 * 2;
        p.wpbT = (u16*)wa;  wa += (size_t)1024 * 512 * 2;
        p.woutT = (u16*)wa; wa += (size_t)1024 * 1024 * 2;
        p.ew1T = (u16*)(ws + 64 * MiB);  p.ew3T = (u16*)(ws + 80 * MiB);  p.ew2T = (u16*)(ws + 96 * MiB);
    }
    if (ws_size < (size_t)505 * MiB) return;

#if MEGA
    {
        static int mgrid = 0;
        if (mgrid == 0) {
            int dev = 0, cus = 0, per_cu = 0;
            hipGetDevice(&dev);
            hipDeviceGetAttribute(&cus, hipDeviceAttributeMultiprocessorCount, dev);
            hipFuncSetAttribute((const void*)mega, hipFuncAttributeMaxDynamicSharedMemorySize, SMEM_BYTES);
            hipOccupancyMaxActiveBlocksPerMultiprocessor(&per_cu, (const void*)mega, NT, SMEM_BYTES);
            (void)hipGetLastError();
            mgrid = cus;
        }
        hipMemsetAsync(p.bar, 0, XCD_BAR_WORDS * sizeof(unsigned) + 512 * sizeof(float), stream);
        mega<<<mgrid, NT, SMEM_BYTES, stream>>>(p);
        return;
    }
#else
    const int grid = 512;
    hipMemsetAsync(p.bar, 0, XCD_BAR_WORDS * sizeof(unsigned) + 512 * sizeof(float), stream);
    hipFuncSetAttribute((const void*)kph<0>, hipFuncAttributeMaxDynamicSharedMemorySize, SMEM_BYTES);
    hipFuncSetAttribute((const void*)kph<1>, hipFuncAttributeMaxDynamicSharedMemorySize, SMEM_BYTES);
    hipFuncSetAttribute((const void*)kph<2>, hipFuncAttributeMaxDynamicSharedMemorySize, SMEM_BYTES);
    hipFuncSetAttribute((const void*)kph<3>, hipFuncAttributeMaxDynamicSharedMemorySize, SMEM_BYTES);
    hipFuncSetAttribute((const void*)kph<4>, hipFuncAttributeMaxDynamicSharedMemorySize, SMEM_BYTES);
    hipFuncSetAttribute((const void*)kph<5>, hipFuncAttributeMaxDynamicSharedMemorySize, SMEM_BYTES);
    hipFuncSetAttribute((const void*)kph<6>, hipFuncAttributeMaxDynamicSharedMemorySize, SMEM_BYTES);
    hipFuncSetAttribute((const void*)kph<7>, hipFuncAttributeMaxDynamicSharedMemorySize, SMEM_BYTES);
    hipFuncSetAttribute((const void*)kph<8>, hipFuncAttributeMaxDynamicSharedMemorySize, SMEM_BYTES);
    hipFuncSetAttribute((const void*)kph<9>, hipFuncAttributeMaxDynamicSharedMemorySize, SMEM_BYTES);
    hipFuncSetAttribute((const void*)kph<10>, hipFuncAttributeMaxDynamicSharedMemorySize, SMEM_BYTES);
    hipFuncSetAttribute((const void*)kph<11>, hipFuncAttributeMaxDynamicSharedMemorySize, SMEM_BYTES);
    kph<0><<<grid, NT, SMEM_BYTES, stream>>>(p);
    kph<1><<<grid, NT, SMEM_BYTES, stream>>>(p);
    kph<2><<<grid, NT, SMEM_BYTES, stream>>>(p);
    kph<3><<<grid, NT, SMEM_BYTES, stream>>>(p);
    kph<12><<<grid, NT, SMEM_BYTES, stream>>>(p);
    kph<4><<<grid, NT, SMEM_BYTES, stream>>>(p);
    kph<5><<<grid, NT, SMEM_BYTES, stream>>>(p);
    kph<6><<<grid, NT, SMEM_BYTES, stream>>>(p);
    kph<7><<<grid, NT, SMEM_BYTES, stream>>>(p);
    kph<8><<<grid, NT, SMEM_BYTES, stream>>>(p);
    kph<9><<<grid, NT, SMEM_BYTES, stream>>>(p);
    kph<10><<<grid, NT, SMEM_BYTES, stream>>>(p);
    kph<11><<<grid, NT, SMEM_BYTES, stream>>>(p);
#endif
}
```

```cpp
#include <hip/hip_runtime.h>
#include <stdint.h>

typedef unsigned short u16;
using bf16x8 = __attribute__((ext_vector_type(8))) short;
using f32x4  = __attribute__((ext_vector_type(4))) float;

#ifndef MEGA
#define MEGA 1
#endif

constexpr int B_ = 4, S_ = 8192, D_ = 1024, NTOK = B_ * S_;
constexpr int CIN = 5144;
constexpr int NCMP = 511;
constexpr int CRW = 1792;
constexpr int NEXP = 32;
constexpr int NT = 512;
constexpr int NW = NT / 64;
constexpr int SMEM_BYTES = 160 * 1024;
constexpr int SCAN_BLOCKS = 16;
#ifndef TPROBE
#define TPROBE 0
#define TPSEL 0
#endif
constexpr float QSCALE = 0.125f * 1.4426950408889634f;

struct P {
    const float* x; const int* pos; const float* g_mix; const float* w_in;
    const float *pe_k, *w1_k, *b1_k, *w2_k, *b2_k, *pe_v, *w1_v, *b1_v, *w2_v, *b2_v;
    const float *mu, *w0, *w2, *a0, *a2, *g2, *k_k, *k_a, *r_k, *ln_w, *ln_b;
    const float *wpa, *wpb, *wout, *g_ffn, *w_grp, *b_grp, *w_exp, *b_exp, *e_w1, *e_w3, *e_w2, *g_final;
    float* out;
    u16* hbuf; u16 *q, *kc, *vc, *ksl, *vslT, *kwn, *vwnT, *kcb, *vcT; float* nsag; u16* prw;
    u16* cdat; float* bon; u16 *w2T, *a2T, *g2T; u16 *oa, *ob; u16* merged; float* x1;
    int* tok_e; float* tok_gate; int* tokslot; int* list_tok; float* list_gate;
    int* counts; int* offs; int* cursor; int* blk_e; int* blk_r0; int* nblk; float* rsb; int* nsactr;
    u16* hid; u16* ybuf; unsigned* bar;
    u16 *winT, *wgT, *wpaT, *wpbT, *woutT, *ew1T, *ew3T, *ew2T;
    u16 *cw1Tk, *cw1Tv, *cw2Tk, *cw2Tv, *chid, *xact; float *cb1k, *cb1v;
};

typedef __bf16 bf16x2_t __attribute__((ext_vector_type(2)));
typedef float f32x2_t __attribute__((ext_vector_type(2)));
__device__ __forceinline__ unsigned pack2(float a, float b) {
    f32x2_t f = {a, b};
    return __builtin_bit_cast(unsigned, __builtin_convertvector(f, bf16x2_t));
}
__device__ __forceinline__ u16 f2bf(float f) { return (u16)(pack2(f, f) & 0xFFFFu); }
__device__ __forceinline__ float bf2f(u16 h) { return __uint_as_float(((unsigned)h) << 16); }
__device__ __forceinline__ float sigmoidf_(float x) { return __builtin_amdgcn_rcpf(1.f + __expf(-x)); }
__device__ __forceinline__ int get_tid() { int t = threadIdx.x; asm volatile("" : "+v"(t)); return t; }
__device__ __forceinline__ uint2 pack4(const f32x4& v) { uint2 o; o.x = pack2(v[0], v[1]); o.y = pack2(v[2], v[3]); return o; }
__device__ __forceinline__ f32x4 unpack4(uint2 u) { return f32x4{__uint_as_float(u.x << 16), __uint_as_float(u.x & 0xFFFF0000u), __uint_as_float(u.y << 16), __uint_as_float(u.y & 0xFFFF0000u)}; }
#define LDS_BARRIER() do { asm volatile("s_waitcnt lgkmcnt(0)" ::: "memory"); __builtin_amdgcn_s_barrier(); asm volatile("" ::: "memory"); } while (0)
__device__ __forceinline__ int opaque(int x) { asm volatile("" : "+v"(x)); return x; }
template <int CTRL>
__device__ __forceinline__ float dppf(float x) { return __int_as_float(__builtin_amdgcn_update_dpp(0, __float_as_int(x), CTRL, 0xF, 0xF, true)); }
__device__ __forceinline__ float wave_sum(float v) {
    v += dppf<0xB1>(v);
    v += dppf<0x4E>(v);
    v += dppf<0x141>(v);
    v += dppf<0x140>(v);
    const int vi = __float_as_int(v);
    return (__int_as_float(__builtin_amdgcn_readlane(vi, 0)) + __int_as_float(__builtin_amdgcn_readlane(vi, 16)))
         + (__int_as_float(__builtin_amdgcn_readlane(vi, 32)) + __int_as_float(__builtin_amdgcn_readlane(vi, 48)));
}

__device__ __forceinline__ float xrow_sum(float v) {
    auto r = __builtin_amdgcn_permlane16_swap(__float_as_uint(v), __float_as_uint(v), false, false);
    v = __uint_as_float(r[0]) + __uint_as_float(r[1]);
    auto r2 = __builtin_amdgcn_permlane32_swap(__float_as_uint(v), __float_as_uint(v), false, false);
    return __uint_as_float(r2[0]) + __uint_as_float(r2[1]);
}
__device__ __forceinline__ float xrow_max(float v) {
    auto r = __builtin_amdgcn_permlane16_swap(__float_as_uint(v), __float_as_uint(v), false, false);
    v = fmaxf(__uint_as_float(r[0]), __uint_as_float(r[1]));
    auto r2 = __builtin_amdgcn_permlane32_swap(__float_as_uint(v), __float_as_uint(v), false, false);
    return fmaxf(__uint_as_float(r2[0]), __uint_as_float(r2[1]));
}
__constant__ double ROPE_FREQ[32] = {
    1.00000000000000000000e+00, 7.49894209332455874417e-01, 5.62341325190349072827e-01, 4.21696503428582225581e-01,
    3.16227766016837941176e-01, 2.37137370566165517349e-01, 1.77827941003892292526e-01, 1.33352143216332402753e-01,
    1.00000000000000005551e-01, 7.49894209332455791150e-02, 5.62341325190349114460e-02, 4.21696503428582239459e-02,
    3.16227766016837913421e-02, 2.37137370566165538166e-02, 1.77827941003892292526e-02, 1.33352143216332406223e-02,
    1.00000000000000002082e-02, 7.49894209332455791150e-03, 5.62341325190349097113e-03, 4.21696503428582291501e-03,
    3.16227766016837939442e-03, 2.37137370566165538166e-03, 1.77827941003892275179e-03, 1.33352143216332406223e-03,
    1.00000000000000002082e-03, 7.49894209332455856203e-04, 5.62341325190349097113e-04, 4.21696503428582237290e-04,
    3.16227766016837939442e-04, 2.37137370566165538166e-04, 1.77827941003892269758e-04, 1.33352143216332395381e-04};

constexpr int G_ABYTES = 256 * 64 * 2, G_BBYTES = 128 * 64 * 2, G_TILE = G_ABYTES + G_BBYTES;
#define LAS3 __attribute__((address_space(3)))
#define GAS1 __attribute__((address_space(1)))
__device__ __forceinline__ void glds16(const u16* g, char* l) {
    __builtin_amdgcn_global_load_lds((const GAS1 unsigned*)g, (LAS3 unsigned*)l, 16, 0, 0);
}
template <bool TR = false, class ARow>
__device__ __forceinline__ void gemm_core(int K, ARow arow, const u16* __restrict__ BT, int ldb, f32x4 (&acc)[4][4], u16* sm) {
    char* base = (char*)sm;
    const int tid = get_tid(), lane = tid & 63, wv = tid >> 6;
    const int wm = wv >> 1, wn = wv & 1, kr = lane & 15, qq = lane >> 4;
    const int lr = tid >> 3, lk = ((tid & 7) ^ ((lr >> 1) & 7)) * 8;
    const u16* ap0 = arow(lr) + lk; const u16* ap1 = arow(lr + 64) + lk;
    const u16* ap2 = arow(lr + 128) + lk; const u16* ap3 = arow(lr + 192) + lk;
    const u16* bp0 = BT + (size_t)lr * ldb + lk; const u16* bp1 = BT + (size_t)(lr + 64) * ldb + lk;
#pragma unroll
    for (int mt = 0; mt < 4; mt++)
#pragma unroll
        for (int nt = 0; nt < 4; nt++) acc[mt][nt] = f32x4{0.f, 0.f, 0.f, 0.f};
    const int nk = K >> 6;
#define G_ISSUE(t, b) { char* d = base + (b) * G_TILE + tid * 16; const int ko = (t) * 64; \
        glds16(ap0 + ko, d); glds16(ap1 + ko, d + 8192); glds16(ap2 + ko, d + 16384); glds16(ap3 + ko, d + 24576); \
        glds16(bp0 + ko, d + G_ABYTES); glds16(bp1 + ko, d + G_ABYTES + 8192); }
    const int sw = kr >> 1;
    const int po0 = ((0 * 4 + qq) ^ sw) * 16, po1 = ((1 * 4 + qq) ^ sw) * 16;
    const int aoff = (wm * 64 + kr) * 128, boff = G_ABYTES + (wn * 64 + kr) * 128;
#define G_READ(FA, FB, b) { const char* Ab = base + (b) * G_TILE + aoff; const char* Bb = base + (b) * G_TILE + boff; \
        _Pragma("unroll") for (int mt = 0; mt < 4; mt++) { FA[0][mt] = *(const bf16x8*)(Ab + mt * 2048 + po0); FA[1][mt] = *(const bf16x8*)(Ab + mt * 2048 + po1); } \
        _Pragma("unroll") for (int nt = 0; nt < 4; nt++) { FB[0][nt] = *(const bf16x8*)(Bb + nt * 2048 + po0); FB[1][nt] = *(const bf16x8*)(Bb + nt * 2048 + po1); } }
#define G_MMA(FA, FB) { __builtin_amdgcn_s_setprio(1); \
        _Pragma("unroll") for (int ks = 0; ks < 2; ks++) \
            _Pragma("unroll") for (int nt = 0; nt < 4; nt++) \
                _Pragma("unroll") for (int mt = 0; mt < 4; mt++) \
                    acc[mt][nt] = TR ? __builtin_amdgcn_mfma_f32_16x16x32_bf16(FA[ks][mt], FB[ks][nt], acc[mt][nt], 0, 0, 0) \
                                     : __builtin_amdgcn_mfma_f32_16x16x32_bf16(FB[ks][nt], FA[ks][mt], acc[mt][nt], 0, 0, 0); \
        __builtin_amdgcn_s_setprio(0); }
    bf16x8 fa0[2][4], fb0[2][4], fa1[2][4], fb1[2][4];
    G_ISSUE(0, 0)
    if (nk > 1) G_ISSUE(1, 1)
    if (nk > 2) G_ISSUE(2, 2)
    if (nk > 2) asm volatile("s_waitcnt vmcnt(12)" ::: "memory");
    else if (nk > 1) asm volatile("s_waitcnt vmcnt(6)" ::: "memory");
    else asm volatile("s_waitcnt vmcnt(0)" ::: "memory");
    __builtin_amdgcn_s_barrier();
    G_READ(fa0, fb0, 0)
    int bnext = 1, bfree = 0;
#define G_STEP(FAC, FBC, FAN, FBN, kt) { \
        if ((kt) + 1 < nk) { \
            if ((kt) + 2 < nk) asm volatile("s_waitcnt vmcnt(6) lgkmcnt(0)" ::: "memory"); else asm volatile("s_waitcnt vmcnt(0) lgkmcnt(0)" ::: "memory"); \
            __builtin_amdgcn_s_barrier();                   \
            if ((kt) + 3 < nk) G_ISSUE((kt) + 3, bfree) \
            G_READ(FAN, FBN, bnext) \
        } \
        G_MMA(FAC, FBC) \
        bfree = bnext; bnext = (bnext == 2) ? 0 : bnext + 1; }
    for (int kt = 0; kt < nk; kt += 2) {
        G_STEP(fa0, fb0, fa1, fb1, kt)
        G_STEP(fa1, fb1, fa0, fb0, kt + 1)
    }
    __builtin_amdgcn_s_barrier();
#undef G_READ
#undef G_MMA
#undef G_STEP
#undef G_ISSUE
}

__device__ __forceinline__ int xcd_item(int bid, int nb, int k, int nitems) {
    if (nb & 7) return bid + k * nb;
    const int per = nb >> 3, chunk = (nitems + 7) >> 3;
    const int j = k * per + (bid >> 3);
    return (j < chunk) ? (bid & 7) * chunk + j : nitems;
}
struct GUnit { int pm, pn; };
constexpr int G8_HTB = 128 * 64 * 2;
__device__ __forceinline__ int g8_lds_byte(int r, int c) { const int st = (r >> 4) * 2 + (c >> 5), rr = r & 15, cc = c & 31, ob = rr * 64 + cc * 2; return st * 1024 + (ob ^ (((ob >> 9) & 1) << 5)); }
__device__ __forceinline__ void g8_stage_rc(int b, int& R, int& C) { const int st = b / 1024, sb = b % 1024, swz = sb ^ (((sb >> 9) & 1) << 5); R = (st >> 1) * 16 + swz / 64; C = (st & 1) * 32 + (swz % 64) / 2; }
__host__ __device__ __forceinline__ int perm32(int rho) { const int n = rho >> 4, i = rho & 15; return 8 * (i >> 2) + 4 * n + (i & 3); }

template <class Epi, class Sched>
__device__ __forceinline__ void gemm256(char* smem, const char* Ab, int K, const Sched& S, const Epi& E) {
    LAS3 unsigned char* lds = (LAS3 unsigned char*)smem;
    const int tid = get_tid(), wid = __builtin_amdgcn_readfirstlane(tid >> 6), lane = tid & 63, wr = wid >> 2, wc = wid & 3, fr = lane & 15, fq = lane >> 4;
    int nt = K >> 6; asm volatile("" : "+s"(nt));
    unsigned voffB[2], voffA[2][2];
#pragma unroll
    for (int i = 0; i < 2; ++i) { int sR, sC; g8_stage_rc(tid * 16 + i * 8192, sR, sC); voffB[i] = (unsigned)(sR * K + sC) * 2u; }
#define G8_AOFFS(un) do { const int t3_ = get_tid(); _Pragma("unroll") for (int i = 0; i < 2; ++i) { int sR, sC; g8_stage_rc(t3_ * 16 + i * 8192, sR, sC); \
        _Pragma("unroll") for (int h = 0; h < 2; ++h) voffA[h][i] = S.a_off(un, h, sR) + (unsigned)sC * 2u; } } while (0)
    const size_t kstep = 128;
    const size_t hstep = (size_t)128 * K * 2;
    const unsigned ldsw = (unsigned)wid * 1024u;
    const int aoff = g8_lds_byte(wr * 64 + fr, fq * 8), boff = g8_lds_byte(wc * 32 + fr, fq * 8);
#define G8_SA(b, h) (((b) * 2 + (h)) * G8_HTB)
#define G8_SB(b, h) ((4 + (b) * 2 + (h)) * G8_HTB)
#define G8_STAGE2(bufoff, gbase, v0, v1) do { \
        __builtin_amdgcn_global_load_lds((const GAS1 unsigned*)((const char*)(gbase) + (v0)), (LAS3 unsigned*)(lds + (bufoff) + ldsw), 16, 0, 0); \
        __builtin_amdgcn_global_load_lds((const GAS1 unsigned*)((const char*)(gbase) + (v1)), (LAS3 unsigned*)(lds + (bufoff) + ldsw + 8192), 16, 0, 0); } while (0)
#define G8_STAGEB(bufoff, gbase) G8_STAGE2(bufoff, gbase, voffB[0], voffB[1])
#define G8_LDA(dst, b, h) do { _Pragma("unroll") for (int m = 0; m < 4; ++m) _Pragma("unroll") for (int k = 0; k < 2; ++k) dst[m][k] = *(const LAS3 bf16x8*)(lds + G8_SA(b, h) + aoff + m * 2048 + k * 1024); } while (0)
#define G8_LDB(dst, b, h) do { _Pragma("unroll") for (int n = 0; n < 2; ++n) _Pragma("unroll") for (int k = 0; k < 2; ++k) dst[n][k] = *(const LAS3 bf16x8*)(lds + G8_SB(b, h) + boff + n * 2048 + k * 1024); } while (0)
#define G8_MMA(ai, bj, At, Bt) do { __builtin_amdgcn_s_setprio(1); _Pragma("unroll") for (int m = 0; m < 4; ++m) _Pragma("unroll") for (int n = 0; n < 2; ++n) _Pragma("unroll") for (int k = 0; k < 2; ++k) \
        acc[ai][bj][m][n] = __builtin_amdgcn_mfma_f32_16x16x32_bf16(Bt[n][k], At[m][k], acc[ai][bj][m][n], 0, 0, 0); __builtin_amdgcn_s_setprio(0); } while (0)
#define G8_WAIT_V(n) asm volatile("s_waitcnt vmcnt(" #n ")" ::: "memory")
#define G8_WAIT_L(n) asm volatile("s_waitcnt lgkmcnt(" #n ")" ::: "memory")
#define G8_BAR __builtin_amdgcn_s_barrier()
#define G8_SCHED __builtin_amdgcn_sched_barrier(0)
    GUnit cur, nxt; int ui = 0;
    if (!S.next(0, cur)) return;
    f32x4 acc[2][2][4][2];
#pragma unroll
    for (int a = 0; a < 2; ++a)
#pragma unroll
        for (int b = 0; b < 2; ++b)
#pragma unroll
            for (int m = 0; m < 4; ++m)
#pragma unroll
                for (int n = 0; n < 2; ++n) acc[a][b][m][n] = (f32x4){0.f, 0.f, 0.f, 0.f};
    bf16x8 At[4][2], B0[2][2], B1[2][2];
    G8_AOFFS(cur);
    const char* cB = S.b_ptr(cur);
    G8_STAGEB(G8_SB(0, 0), cB); G8_STAGE2(G8_SA(0, 0), Ab, voffA[0][0], voffA[0][1]); G8_STAGEB(G8_SB(0, 1), cB + hstep); G8_STAGE2(G8_SA(0, 1), Ab, voffA[1][0], voffA[1][1]);
    if (wr == 1) G8_BAR;
    G8_WAIT_V(4); G8_BAR;
    G8_STAGEB(G8_SB(1, 0), cB + kstep); G8_STAGE2(G8_SA(1, 0), Ab + kstep, voffA[0][0], voffA[0][1]); G8_STAGEB(G8_SB(1, 1), cB + hstep + kstep);
    G8_WAIT_V(6); G8_BAR;
    for (;;) {
        const bool has_next = S.next(ui + 1, nxt);
        const char* nB = has_next ? S.b_ptr(nxt) : cB;
        for (int t = 0; t < nt; t += 2) {
            const bool last = (t == nt - 2);
            const char* a1 = Ab + (size_t)(t + 1) * kstep;
            const unsigned va10 = voffA[1][0], va11 = voffA[1][1];
            if (last && has_next) G8_AOFFS(nxt);
            const char* a2 = last ? Ab : Ab + (size_t)(t + 2) * kstep; const char* b2 = last ? nB : cB + (size_t)(t + 2) * kstep;
            const char* a3 = a2 + kstep; const char* b3 = b2 + kstep;
            G8_LDB(B0, 0, 0); G8_SCHED; G8_LDA(At, 0, 0); G8_STAGE2(G8_SA(1, 1), a1, va10, va11);
            G8_WAIT_L(8); G8_BAR; G8_WAIT_L(0); G8_MMA(0, 0, At, B0); G8_BAR; G8_SCHED;
            G8_LDB(B1, 0, 1); G8_STAGEB(G8_SB(0, 0), b2);
            G8_BAR; G8_WAIT_L(0); G8_MMA(0, 1, At, B1); G8_BAR;
            G8_LDA(At, 0, 1); G8_STAGE2(G8_SA(0, 0), a2, voffA[0][0], voffA[0][1]);
            G8_BAR; G8_WAIT_L(0); G8_MMA(1, 0, At, B0); G8_BAR; G8_SCHED;
            G8_STAGEB(G8_SB(0, 1), b2 + hstep);
            G8_WAIT_V(6); G8_BAR; G8_MMA(1, 1, At, B1); G8_BAR;
            G8_LDB(B0, 1, 0); G8_SCHED; G8_LDA(At, 1, 0); G8_STAGE2(G8_SA(0, 1), a2, voffA[1][0], voffA[1][1]);
            G8_WAIT_L(8); G8_BAR; G8_WAIT_L(0); G8_MMA(0, 0, At, B0); G8_BAR; G8_SCHED;
            G8_LDB(B1, 1, 1); G8_STAGEB(G8_SB(1, 0), b3);
            G8_BAR; G8_WAIT_L(0); G8_MMA(0, 1, At, B1); G8_BAR;
            G8_LDA(At, 1, 1); G8_STAGE2(G8_SA(1, 0), a3, voffA[0][0], voffA[0][1]);
            G8_BAR; G8_WAIT_L(0); G8_MMA(1, 0, At, B0); G8_BAR; G8_SCHED;
            G8_STAGEB(G8_SB(1, 1), b3 + hstep);
            G8_WAIT_V(6); G8_BAR; G8_MMA(1, 1, At, B1); G8_BAR;
        }
        E(acc, cur, wr, wc, fr, fq);
        if (!has_next) break;
#pragma unroll
        for (int a = 0; a < 2; ++a)
#pragma unroll
            for (int b = 0; b < 2; ++b)
#pragma unroll
                for (int m = 0; m < 4; ++m)
#pragma unroll
                    for (int n = 0; n < 2; ++n) acc[a][b][m][n] = (f32x4){0.f, 0.f, 0.f, 0.f};
        cur = nxt; cB = nB; ++ui;
    }
    G8_WAIT_V(0);
    if (wr == 0) G8_BAR;
    G8_BAR;
#undef G8_SA
#undef G8_AOFFS
#undef G8_SB
#undef G8_STAGE2
#undef G8_STAGEB
#undef G8_LDA
#undef G8_LDB
#undef G8_MMA
#undef G8_WAIT_V
#undef G8_WAIT_L
#undef G8_BAR
#undef G8_SCHED
}
struct DenseSched {
    int nM, nN, nwg, G, c, K; const char* Bt;
    __device__ __forceinline__ void init(int M, int N, int K_, const void* Bt_, int G_, int c_) { nM = M >> 8; nN = N >> 8; nwg = nM * nN; G = G_; c = c_; K = K_; Bt = (const char*)Bt_; }
    __device__ __forceinline__ bool next(int i, GUnit& u) const {
        const int L = i * G + c; if (L >= nwg) return false;
        int wgid = L; { const int q = nwg >> 3, r = nwg & 7, xcd = wgid & 7, off = wgid >> 3; wgid = (xcd < r ? xcd * (q + 1) : r * (q + 1) + (xcd - r) * q) + off; }
        const int nig = 8 * nN, gid = wgid / nig, fm = gid * 8, gsz = (nM - fm) < 8 ? (nM - fm) : 8, w = wgid - gid * nig;
        u.pn = w / gsz; u.pm = fm + (w - u.pn * gsz); return true;
    }
    __device__ __forceinline__ unsigned a_off(const GUnit& u, int h, int R) const { return (unsigned)((u.pm * 256 + h * 128 + R) * K) * 2u; }
    __device__ __forceinline__ const char* b_ptr(const GUnit& u) const { return Bt + (size_t)u.pn * 256 * K * 2; }
};

template <class SRC>
__device__ __forceinline__ void convert_wT(const float* __restrict__ W, int K, int N, u16* __restrict__ WT, int rows, SRC src, int gtid, int gnt) {
    const int kch = K >> 3;
    const int total = rows * kch;
    for (int i0 = gtid; i0 < total; i0 += 4 * gnt) {
        float f[4][8]; int sc[4];
#pragma unroll
        for (int u = 0; u < 4; u++) {
            const int i = i0 + u * gnt;
            sc[u] = -1;
            if (i < total) {
                const int kc = i / rows, j = i - kc * rows;
                sc[u] = src(j);
                if (sc[u] >= 0) {
                    const float* wp = W + (size_t)(kc * 8) * N + sc[u];
#pragma unroll
                    for (int q = 0; q < 8; q++) f[u][q] = wp[(size_t)q * N];
                }
            }
        }
#pragma unroll
        for (int u = 0; u < 4; u++) {
            const int i = i0 + u * gnt;
            if (i < total) {
                const int kc = i / rows, j = i - kc * rows;
                uint4 v = make_uint4(0u, 0u, 0u, 0u);
                if (sc[u] >= 0) { v.x = pack2(f[u][0], f[u][1]); v.y = pack2(f[u][2], f[u][3]); v.z = pack2(f[u][4], f[u][5]); v.w = pack2(f[u][6], f[u][7]); }
                *(uint4*)&WT[(size_t)j * K + kc * 8] = v;
            }
        }
    }
}

__device__ __forceinline__ void convert_later_weights(const P& p, int gtid, int gnt) {
    convert_wT(p.w_in, D_, CIN, p.wgT, 2048, [](int j) { return 3096 + (j & ~31) + perm32(j & 31); }, gtid, gnt);
    convert_wT(p.wpa, 512, D_, p.wpaT, 1024, [](int j) { return (j & ~31) + perm32(j & 31); }, gtid, gnt);
    convert_wT(p.wpb, 512, D_, p.wpbT, 1024, [](int j) { return (j & ~31) + perm32(j & 31); }, gtid, gnt);
    convert_wT(p.wout, D_, D_, p.woutT, 1024, [](int j) { return j; }, gtid, gnt);
    convert_wT(p.w2, 64, 512, p.w2T, 512, [](int j) { return j; }, gtid, gnt);
    convert_wT(p.w1_k, 2048, 256, p.cw1Tk, 256, [](int j) { return j; }, gtid, gnt);
    convert_wT(p.w1_v, 2048, 256, p.cw1Tv, 256, [](int j) { return j; }, gtid, gnt);
    convert_wT(p.w2_k, 256, 64, p.cw2Tk, 128, [](int j) { return j < 64 ? j : -1; }, gtid, gnt);
    convert_wT(p.w2_v, 256, 64, p.cw2Tv, 128, [](int j) { return j < 64 ? j : -1; }, gtid, gnt);
    convert_wT(p.a2, 64, 512, p.a2T, 512, [](int j) { return j; }, gtid, gnt);
    convert_wT(p.g2, 128, 512, p.g2T, 512, [](int j) { return j; }, gtid, gnt);
}
__device__ void ph_prologue(const P& p, int bid, int nb, char* smem) {
    const int tid = get_tid(), lane = tid & 63, wv = tid >> 6;
    if (bid >= 1 && bid <= 64) {
        const int j = tid & 255; const bool isv = tid >= 256;
        const float* pe = isv ? p.pe_v : p.pe_k; const float* w1 = isv ? p.w1_v : p.w1_k;
        const int kb = (bid - 1) * 32;
        float a0 = 0.f, a1 = 0.f;
#pragma unroll 4
        for (int k = kb; k < kb + 32; k += 2) { a0 += pe[k] * w1[(size_t)k * 256 + j]; a1 += pe[k + 1] * w1[(size_t)(k + 1) * 256 + j]; }
        p.cb1k[(bid - 1) * 512 + (isv ? 256 : 0) + j] = a0 + a1;
    }
    if (bid == 0) {
        if (tid < 32) { p.counts[tid] = 0; p.cursor[tid] = 0; }
        if (tid == 32) *p.nsactr = 0;
        for (int i = tid; i < 8 * 64; i += NT) {
            const int bg = i >> 6, d = i & 63;
            p.kcb[((size_t)bg * 512 + 511) * 64 + d] = 0;
            p.vcT[(((size_t)bg * 8 + 7) * 64 + d) * 64 + 63] = 0;
        }
    }
    {
        const int gtid = bid * NT + tid, gnt = nb * NT;
        convert_wT(p.w_in, D_, CIN, p.winT, 3328, [](int j) {
            const int t = j >> 8, s = j & 255;
            if (t < 5) {
                const int bj = s >> 7, wc = (s >> 5) & 3, n = (s >> 4) & 1, i = s & 15;
                const int dim = 32 * bj + 8 * (i >> 2) + 4 * n + (i & 3), hq = 4 * t + wc;
                int hb;
                if (hq < 8) hb = 64 * hq;
                else { const int k = (hq - 8) >> 1; hb = (k == 0 ? 512 : (k == 1 ? 640 : (k == 2 ? 768 : (k == 3 ? 1024 : (k == 4 ? 896 : 1152))))) + 64 * (hq & 1); }
                return hb + dim;
            }
            const int c = (s & ~31) + perm32(s & 31);
            if (t < 12) return 1304 + (t - 5) * 256 + c;
            return c < 24 ? 1280 + c : -1; }, gtid, gnt);
        if (nb != 256) convert_later_weights(p, gtid, gnt);
    }
    for (int row = bid * NW + wv; row < NTOK; row += nb * NW) {
        const float* xr = p.x + (size_t)row * D_;
        float v[16];
        float ss = 0.f;
#pragma unroll
        for (int i = 0; i < 4; i++) {
            float4 t = *(const float4*)&xr[i * 256 + lane * 4];
            v[4 * i] = t.x; v[4 * i + 1] = t.y; v[4 * i + 2] = t.z; v[4 * i + 3] = t.w;
            ss += t.x * t.x + t.y * t.y + t.z * t.z + t.w * t.w;
        }
        ss = wave_sum(ss);
        const float rs = rsqrtf(ss * (1.f / D_) + 1e-6f);
#pragma unroll
        for (int i = 0; i < 4; i++) {
            const int c = i * 256 + lane * 4;
            float4 g = *(const float4*)&p.g_mix[c];
            uint2 o;
            o.x = pack2(v[4 * i] * rs * g.x, v[4 * i + 1] * rs * g.y);
            o.y = pack2(v[4 * i + 2] * rs * g.z, v[4 * i + 3] * rs * g.w);
            *(uint2*)&p.hbuf[(size_t)row * D_ + c] = o;
        }
    }
}

__device__ __forceinline__ uint4 pack8(const f32x4& a, const f32x4& b) { uint4 o; o.x = pack2(a[0], a[1]); o.y = pack2(a[2], a[3]); o.z = pack2(b[0], b[1]); o.w = pack2(b[2], b[3]); return o; }
struct EpiInproj {
    const P* pp;
    __device__ __forceinline__ void operator()(const f32x4 (&acc)[2][2][4][2], const GUnit& u, int, int, int, int) const {
        const int t2_ = get_tid(), wid_ = __builtin_amdgcn_readfirstlane(t2_ >> 6), wr = wid_ >> 2, wc = wid_ & 3, fr = t2_ & 15, fq = (t2_ >> 4) & 3;
        const P& p = *pp;
        const int pn = u.pn;
        const int rowb = u.pm * 256 + wr * 64;
        if (pn < 4) {
            const int hq = 4 * pn + wc;
            const bool rope = !(pn == 2 && wc >= 2);
            u16* dst; size_t rstride; int cofs;
            if (pn < 2) { dst = p.q; rstride = 512; cofs = hq * 64; }
            else { dst = (pn == 2) ? (wc < 2 ? p.kc : p.vc) : (wc < 2 ? p.ksl : p.kwn); rstride = 64; cofs = 0; }
            const int g = wc & 1;
#pragma unroll
            for (int ai = 0; ai < 2; ++ai)
#pragma unroll
                for (int m = 0; m < 4; ++m) {
                    const int row = rowb + ai * 128 + m * 16 + fr;
                    f32x4 o1[2], o2[2];
#pragma unroll
                    for (int n = 0; n < 2; ++n) { o1[n] = acc[ai][0][m][n]; o2[n] = acc[ai][1][m][n]; }
                    if (rope) {
                        const double posd = (double)p.pos[row];
#pragma unroll
                        for (int n = 0; n < 2; ++n)
#pragma unroll
                            for (int j = 0; j < 4; ++j) {
                                const double tr = posd * ROPE_FREQ[8 * fq + 4 * n + j] * 0.15915494309189535;
                                const float fr_ = (float)(tr - rint(tr));
                                const float cs = __builtin_amdgcn_cosf(fr_), sn = __builtin_amdgcn_sinf(fr_);
                                const float x1 = o1[n][j], x2 = o2[n][j];
                                o1[n][j] = x1 * cs - x2 * sn; o2[n][j] = x1 * sn + x2 * cs;
                            }
                    }
                    size_t ro;
                    if (pn < 2) {
#pragma unroll
                        for (int n = 0; n < 2; ++n)
#pragma unroll
                            for (int j = 0; j < 4; ++j) { o1[n][j] *= QSCALE; o2[n][j] *= QSCALE; }
                        ro = (size_t)row * 512 + cofs + 8 * fq;
                    } else {
                        const int bb = row >> 13, t = row & (S_ - 1);
                        ro = ((size_t)(bb * 2 + g) * S_ + t) * 64 + 8 * fq;
                    }
                    *(uint4*)&dst[ro] = pack8(o1[0], o1[1]);
                    *(uint4*)&dst[ro + 32] = pack8(o2[0], o2[1]);
                }
        } else if (pn == 4) {
            u16* dst = (wc < 2) ? p.vslT : p.vwnT;
            const int g = wc & 1;
#pragma unroll
            for (int ai = 0; ai < 2; ++ai) {
                const int r0 = rowb + ai * 128, bb = r0 >> 13, tb = r0 & (S_ - 1);
                u16* base = dst + ((size_t)(bb * 2 + g) * 128 + (tb >> 6)) * 4096;
#pragma unroll
                for (int m = 0; m < 4; ++m)
#pragma unroll
                    for (int bj = 0; bj < 2; ++bj)
#pragma unroll
                        for (int n = 0; n < 2; ++n)
#pragma unroll
                            for (int j = 0; j < 4; ++j)
                                base[(32 * bj + 8 * fq + 4 * n + j) * 64 + m * 16 + fr] = f2bf(acc[ai][bj][m][n][j]);
            }
        } else if (pn < 12) {
            const int cb = (pn - 5) * 256 + wc * 32 + 8 * fq;
#pragma unroll
            for (int ai = 0; ai < 2; ++ai)
#pragma unroll
                for (int m = 0; m < 4; ++m) {
                    const size_t ro = (size_t)(rowb + ai * 128 + m * 16 + fr) * CRW + cb;
#pragma unroll
                    for (int bj = 0; bj < 2; ++bj) *(uint4*)&p.prw[ro + bj * 128] = pack8(acc[ai][bj][m][0], acc[ai][bj][m][1]);
                }
        } else {
            if (wc == 0 && fq < 3) {
#pragma unroll
                for (int ai = 0; ai < 2; ++ai)
#pragma unroll
                    for (int m = 0; m < 4; ++m) {
                        const size_t ro = (size_t)(rowb + ai * 128 + m * 16 + fr) * 24 + 8 * fq;
#pragma unroll
                        for (int n = 0; n < 2; ++n) {
                            float4 o; o.x = sigmoidf_(acc[ai][0][m][n][0]); o.y = sigmoidf_(acc[ai][0][m][n][1]); o.z = sigmoidf_(acc[ai][0][m][n][2]); o.w = sigmoidf_(acc[ai][0][m][n][3]);
                            *(float4*)&p.nsag[ro + 4 * n] = o;
                        }
                    }
            }
        }
    }
};
__device__ void ph_inproj(const P& p, int bid, int nb, char* smem) {
    DenseSched S; S.init(NTOK, 3328, D_, p.winT, nb, bid);
    EpiInproj E{&p};
    gemm256(smem, (const char*)p.hbuf, D_, S, E);
    if (nb == 256 && bid >= 128) convert_later_weights(p, (bid - 128) * NT + get_tid(), 128 * NT);
}

__device__ __forceinline__ float gelu_tanh(float x) {
    const float c = 0.7978845608028654f;
    return 0.5f * x * (1.f + tanhf(c * (x + 0.044715f * x * x * x)));
}
__device__ void ph_compress(const P& p, int bid, int nb, char* smem) {
    u16* sm = (u16*)smem;
    const int tid = get_tid(), lane = tid & 63, wv = tid >> 6;
    const int wm = wv >> 1, wn = wv & 1;
    for (int it = bid; it < 32; it += nb) {
        const int rt = it & 1, g = (it >> 1) & 1, b = (it >> 2) & 3, kv = it >> 4;
        const int bg = b * 2 + g, i0 = rt * 256;
        const u16* src = (kv ? p.vc : p.kc) + (size_t)bg * S_ * 64;
        const u16* w1T = kv ? p.cw1Tv : p.cw1Tk;
        const u16* w2T = kv ? p.cw2Tv : p.cw2Tk;
        float* cb1 = (float*)(smem + 3 * G_TILE);
        __syncthreads();
        { const int t2 = get_tid(); if (t2 < 256) { float a = 0.f; for (int q = 0; q < 64; q++) a += p.cb1k[q * 512 + kv * 256 + t2]; cb1[t2] = a; } }
        __syncthreads();
        const float* b1 = kv ? p.b1_v : p.b1_k;
        const float* b2 = kv ? p.b2_v : p.b2_k;
        u16* hidp = p.chid + (size_t)it * 256 * 256;
        auto arow = [&](int r) { int i = i0 + r; if (i > 510) i = 510; return src + (size_t)i * 1024; };
#pragma unroll 1
        for (int ct = 0; ct < 2; ct++) {
            f32x4 acc[4][4];
            gemm_core<false>(2048, arow, w1T + (size_t)ct * 128 * 2048, 2048, acc, sm);
            const int le = get_tid() & 63;
#pragma unroll
            for (int mt = 0; mt < 4; mt++) {
                const int r = wm * 64 + mt * 16 + (le & 15);
#pragma unroll
                for (int nt = 0; nt < 4; nt++) {
                    const int col = ct * 128 + wn * 64 + nt * 16 + (le >> 4) * 4;
                    const float4 c1 = *(const float4*)&cb1[col], bb1 = *(const float4*)&b1[col];
                    f32x4 o;
                    o[0] = gelu_tanh(acc[mt][nt][0] + c1.x + bb1.x); o[1] = gelu_tanh(acc[mt][nt][1] + c1.y + bb1.y);
                    o[2] = gelu_tanh(acc[mt][nt][2] + c1.z + bb1.z); o[3] = gelu_tanh(acc[mt][nt][3] + c1.w + bb1.w);
                    *(uint2*)&hidp[r * 256 + col] = pack4(o);
                }
            }
        }
        __syncthreads();
        {
            f32x4 acc[4][4];
            gemm_core<true>(256, [&](int r) { return hidp + (size_t)r * 256; }, w2T, 256, acc, sm);
            if (wn == 0) {
#pragma unroll
                for (int mt = 0; mt < 4; mt++)
#pragma unroll
                    for (int nt = 0; nt < 4; nt++) {
                        const int d = nt * 16 + (lane & 15);
                        const int ib = i0 + wm * 64 + mt * 16 + (lane >> 4) * 4;
                        float o[4];
#pragma unroll
                        for (int j = 0; j < 4; j++) o[j] = (ib + j < NCMP) ? (acc[mt][nt][j] + b2[d]) : 0.f;
                        if (kv == 0) {
#pragma unroll
                            for (int j = 0; j < 4; j++) p.kcb[((size_t)bg * 512 + ib + j) * 64 + d] = f2bf(o[j]);
                        } else {
                            uint2 ov; ov.x = pack2(o[0], o[1]); ov.y = pack2(o[2], o[3]);
                            *(uint2*)&p.vcT[(((size_t)bg * 8 + (ib >> 6)) * 64 + d) * 64 + (ib & 63)] = ov;
                        }
                    }
            }
        }
        __syncthreads();
    }
}

#ifndef NSAPROBE
#define NSAPROBE 0
#endif
#define NSA_TS(k) if (NSAPROBE == k) ts_ = __builtin_amdgcn_s_memrealtime();
#define NSA_TE(k) if (NSAPROBE == k) tacc_ += __builtin_amdgcn_s_memrealtime() - ts_;
constexpr int KSTR = 72;
struct Sub { f32x4 O[4]; float m, l; };
#define NEG_BIG (-1.0e30f)

__device__ __forceinline__ float xq_max(float v) {
    return xrow_max(v);
}
__device__ __forceinline__ float xq_sum(float v) {
    return xrow_sum(v);
}
typedef unsigned u32x2 __attribute__((ext_vector_type(2)));
union VF { bf16x8 v; u32x2 h[2]; };
template <int OFF> __device__ __forceinline__ u32x2 lds_read_b64(unsigned addr) { u32x2 r; asm volatile("ds_read_b64 %0, %1 offset:%2" : "=v"(r) : "v"(addr), "n"(OFF)); return r; }
#define NSA_LDV_ASM(vf, Vs, kr, qq, swz) { const unsigned va_ = (unsigned)(size_t)(const LAS3 char*)((const char*)(Vs) + (kr) * 128 + ((qq) & 1) * 8); const int vo_ = (((qq) >> 1) ^ (swz)) << 4; \
        const unsigned a0_ = va_ + vo_, a1_ = va_ + (vo_ ^ 32), a2_ = va_ + (vo_ ^ 64), a3_ = va_ + (vo_ ^ 96); \
        vf[0][0].h[0] = lds_read_b64<0>(a0_);    vf[0][0].h[1] = lds_read_b64<0>(a1_);    vf[0][1].h[0] = lds_read_b64<0>(a2_);    vf[0][1].h[1] = lds_read_b64<0>(a3_); \
        vf[1][0].h[0] = lds_read_b64<2048>(a0_); vf[1][0].h[1] = lds_read_b64<2048>(a1_); vf[1][1].h[0] = lds_read_b64<2048>(a2_); vf[1][1].h[1] = lds_read_b64<2048>(a3_); \
        vf[2][0].h[0] = lds_read_b64<4096>(a0_); vf[2][0].h[1] = lds_read_b64<4096>(a1_); vf[2][1].h[0] = lds_read_b64<4096>(a2_); vf[2][1].h[1] = lds_read_b64<4096>(a3_); \
        vf[3][0].h[0] = lds_read_b64<6144>(a0_); vf[3][0].h[1] = lds_read_b64<6144>(a1_); vf[3][1].h[0] = lds_read_b64<6144>(a2_); vf[3][1].h[1] = lds_read_b64<6144>(a3_); }
#define NSA_VWAIT(vf) asm volatile("s_waitcnt lgkmcnt(0)" : "+v"(vf[0][0].v), "+v"(vf[0][1].v), "+v"(vf[1][0].v), "+v"(vf[1][1].v), "+v"(vf[2][0].v), "+v"(vf[2][1].v), "+v"(vf[3][0].v), "+v"(vf[3][1].v) :: "memory")
template <bool MASK, bool IMP, bool PV>
__device__ __forceinline__ void nsa_visit(const u16* Ks, const u16* Vs, const u16* qrow, Sub& s, int lo, int hi, int lane, float* e, float* p3) {
    const int kr = lane & 15, qq = lane >> 4;
    f32x4 S[4];
    const int qsw = ((kr & 3) >> 1) ^ ((kr >> 2) << 1);
    const bf16x8 qf0 = *(const bf16x8*)(qrow + ((qq ^ qsw) << 3)), qf1 = *(const bf16x8*)(qrow + (((4 + qq) ^ qsw) << 3));
    bf16x8 kf[4][2];
    const int swz = kr >> 1;
    {
        const char* kb_ = (const char*)Ks + kr * 128;
        const int ko0 = (qq ^ swz) << 4, ko1 = ko0 ^ 64;
#pragma unroll
        for (int kt = 0; kt < 4; kt++) { kf[kt][0] = *(const bf16x8*)(kb_ + kt * 2048 + ko0); kf[kt][1] = *(const bf16x8*)(kb_ + kt * 2048 + ko1); }
    }
    __builtin_amdgcn_sched_barrier(0);
#pragma unroll
    for (int kt = 0; kt < 4; kt++) {
        S[kt] = __builtin_amdgcn_mfma_f32_16x16x32_bf16(kf[kt][0], qf0, f32x4{0.f, 0.f, 0.f, 0.f}, 0, 0, 0);
        S[kt] = __builtin_amdgcn_mfma_f32_16x16x32_bf16(kf[kt][1], qf1, S[kt], 0, 0, 0);
    }
    float mx = NEG_BIG;
#pragma unroll
    for (int kt = 0; kt < 4; kt++)
#pragma unroll
        for (int r = 0; r < 4; r++) {
            if (MASK) { const int o = kt * 16 + qq * 4 + r; if (o < lo || o > hi) S[kt][r] = -INFINITY; }
            mx = fmaxf(mx, S[kt][r]);
        }
    mx = xq_max(mx);
    const float mnew = fmaxf(s.m, mx);
    const float alpha = __builtin_amdgcn_exp2f(s.m - mnew);
    s.m = mnew;
    float psum = 0.f;
#pragma unroll
    for (int kt = 0; kt < 4; kt++) {
#pragma unroll
        for (int r = 0; r < 4; r++) { S[kt][r] = __builtin_amdgcn_exp2f(S[kt][r] - mnew); }
        const float ee = (S[kt][0] + S[kt][1]) + (S[kt][2] + S[kt][3]);
        psum += ee;
        if (IMP) { e[kt] = ee; p3[kt] = S[kt][3]; }
    }
    s.l = s.l * alpha + psum;
    if (PV) {
        if (!__all(alpha == 1.f)) {
#pragma unroll
            for (int dt = 0; dt < 4; dt++)
#pragma unroll
                for (int r = 0; r < 4; r++) s.O[dt][r] *= alpha;
        }
        VF vf[4][2];
        NSA_LDV_ASM(vf, Vs, kr, qq, swz)
        bf16x8 pb[2];
#pragma unroll
        for (int k2 = 0; k2 < 2; k2++) {
            union { bf16x8 v; unsigned u[4]; } t;
            t.u[0] = pack2(S[2 * k2][0], S[2 * k2][1]); t.u[1] = pack2(S[2 * k2][2], S[2 * k2][3]);
            t.u[2] = pack2(S[2 * k2 + 1][0], S[2 * k2 + 1][1]); t.u[3] = pack2(S[2 * k2 + 1][2], S[2 * k2 + 1][3]);
            pb[k2] = t.v;
        }
        NSA_VWAIT(vf);
        __builtin_amdgcn_sched_barrier(0);
#pragma unroll
        for (int dt = 0; dt < 4; dt++)
#pragma unroll
            for (int k2 = 0; k2 < 2; k2++) s.O[dt] = __builtin_amdgcn_mfma_f32_16x16x32_bf16(vf[dt][k2].v, pb[k2], s.O[dt], 0, 0, 0);
    }
}
template <bool IMP, bool PV>
__device__ __forceinline__ void nsa_visit2(const u16* Ks, const u16* Vs, const u16* qrow0, const u16* qrow1, Sub (&st)[2], const int (&hi)[2], int lane, float (&e)[2][4], float (&p3)[2][4]) {
    const int kr = lane & 15, qq = lane >> 4;
    const int qsw = ((kr & 3) >> 1) ^ ((kr >> 2) << 1);
    bf16x8 qf0[2], qf1[2];
    qf0[0] = *(const bf16x8*)(qrow0 + ((qq ^ qsw) << 3)); qf1[0] = *(const bf16x8*)(qrow0 + (((4 + qq) ^ qsw) << 3));
    qf0[1] = *(const bf16x8*)(qrow1 + ((qq ^ qsw) << 3)); qf1[1] = *(const bf16x8*)(qrow1 + (((4 + qq) ^ qsw) << 3));
    bf16x8 kf[4][2];
    const int swz = kr >> 1;
    {
        const char* kb_ = (const char*)Ks + kr * 128;
        const int ko0 = (qq ^ swz) << 4, ko1 = ko0 ^ 64;
#pragma unroll
        for (int kt = 0; kt < 4; kt++) { kf[kt][0] = *(const bf16x8*)(kb_ + kt * 2048 + ko0); kf[kt][1] = *(const bf16x8*)(kb_ + kt * 2048 + ko1); }
    }
    __builtin_amdgcn_sched_barrier(0);
    f32x4 S[2][4];
#pragma unroll
    for (int kt = 0; kt < 4; kt++)
#pragma unroll
        for (int q = 0; q < 2; q++) {
            S[q][kt] = __builtin_amdgcn_mfma_f32_16x16x32_bf16(kf[kt][0], qf0[q], f32x4{0.f, 0.f, 0.f, 0.f}, 0, 0, 0);
            S[q][kt] = __builtin_amdgcn_mfma_f32_16x16x32_bf16(kf[kt][1], qf1[q], S[q][kt], 0, 0, 0);
        }
    VF vf[4][2];
    bf16x8 pb[2][2];
#pragma unroll
    for (int q = 0; q < 2; q++) {
        Sub& s = st[q];
        float mx = NEG_BIG;
#pragma unroll
        for (int kt = 0; kt < 4; kt++)
#pragma unroll
            for (int r = 0; r < 4; r++) {
                const int o = kt * 16 + qq * 4 + r; if (o > hi[q]) S[q][kt][r] = -INFINITY;
                mx = fmaxf(mx, S[q][kt][r]);
            }
        mx = xq_max(mx);
        const float mnew = fmaxf(s.m, mx);
        const float alpha = __builtin_amdgcn_exp2f(s.m - mnew);
        s.m = mnew;
        float psum = 0.f;
#pragma unroll
        for (int kt = 0; kt < 4; kt++) {
#pragma unroll
            for (int r = 0; r < 4; r++) { S[q][kt][r] = __builtin_amdgcn_exp2f(S[q][kt][r] - mnew); }
            const float ee = (S[q][kt][0] + S[q][kt][1]) + (S[q][kt][2] + S[q][kt][3]);
            psum += ee;
            if (IMP) { e[q][kt] = ee; p3[q][kt] = S[q][kt][3]; }
        }
        s.l = s.l * alpha + psum;
        if (PV) {
#pragma unroll
            for (int dt = 0; dt < 4; dt++)
#pragma unroll
                for (int r = 0; r < 4; r++) s.O[dt][r] *= alpha;
#pragma unroll
            for (int k2 = 0; k2 < 2; k2++) {
                union { bf16x8 v; unsigned u[4]; } t;
                t.u[0] = pack2(S[q][2 * k2][0], S[q][2 * k2][1]); t.u[1] = pack2(S[q][2 * k2][2], S[q][2 * k2][3]);
                t.u[2] = pack2(S[q][2 * k2 + 1][0], S[q][2 * k2 + 1][1]); t.u[3] = pack2(S[q][2 * k2 + 1][2], S[q][2 * k2 + 1][3]);
                pb[q][k2] = t.v;
            }
            if (q == 0) NSA_LDV_ASM(vf, Vs, kr, qq, swz)
        }
    }
    if (PV) {
        NSA_VWAIT(vf);
        __builtin_amdgcn_sched_barrier(0);
#pragma unroll
        for (int dt = 0; dt < 4; dt++)
#pragma unroll
            for (int k2 = 0; k2 < 2; k2++)
#pragma unroll
                for (int q = 0; q < 2; q++) st[q].O[dt] = __builtin_amdgcn_mfma_f32_16x16x32_bf16(vf[dt][k2].v, pb[q][k2], st[q].O[dt], 0, 0, 0);
    }
}
template <int MMODE, bool FIXM, int NQ>
__device__ __forceinline__ void nsa_visit_gn(const u16* Ks, const u16* Vs, const u16* qs, float* Os, float* Ms, float* Ls, const int (&tok)[NQ], const bool (&valid)[NQ], int lane) {
    const int kr = lane & 15, qq = lane >> 4, hh = kr & 3;
    int row[NQ], osw[NQ]; float* orow[NQ];
    f32x4 O[NQ][4]; float m_old[NQ], l_old[NQ]; bf16x8 qf0[NQ], qf1[NQ];
#pragma unroll
    for (int q = 0; q < NQ; q++) {
        row[q] = tok[q] * 4 + hh; orow[q] = Os + row[q] * 64;
        osw[q] = hh ^ ((tok[q] & 3) << 2);
#pragma unroll
        for (int dt = 0; dt < 4; dt++) O[q][dt] = *(const f32x4*)(orow[q] + (((dt * 4 + qq) ^ osw[q]) << 2));
        m_old[q] = Ms[row[q]]; l_old[q] = Ls[row[q]];
        const u16* qrow = qs + row[q] * 64;
        const int qsw = (hh >> 1) ^ ((tok[q] & 3) << 1);
        qf0[q] = *(const bf16x8*)(qrow + ((qq ^ qsw) << 3)); qf1[q] = *(const bf16x8*)(qrow + (((4 + qq) ^ qsw) << 3));
    }
    bf16x8 kf[4][2];
    const int swz = kr >> 1;
    {
        const char* kb_ = (const char*)Ks + kr * 128;
        const int ko0 = (qq ^ swz) << 4, ko1 = ko0 ^ 64;
#pragma unroll
        for (int kt = 0; kt < 4; kt++) { kf[kt][0] = *(const bf16x8*)(kb_ + kt * 2048 + ko0); kf[kt][1] = *(const bf16x8*)(kb_ + kt * 2048 + ko1); }
    }
    __builtin_amdgcn_sched_barrier(0);
    f32x4 S[NQ][4];
#pragma unroll
    for (int kt = 0; kt < 4; kt++)
#pragma unroll
        for (int q = 0; q < NQ; q++) {
            S[q][kt] = __builtin_amdgcn_mfma_f32_16x16x32_bf16(kf[kt][0], qf0[q], f32x4{0.f, 0.f, 0.f, 0.f}, 0, 0, 0);
            S[q][kt] = __builtin_amdgcn_mfma_f32_16x16x32_bf16(kf[kt][1], qf1[q], S[q][kt], 0, 0, 0);
        }
    VF vf[4][2];
#define NSA_LDV NSA_LDV_ASM(vf, Vs, kr, qq, swz)
    if (NQ == 1) NSA_LDV
    bf16x8 pb[NQ][2];
#pragma unroll
    for (int q = 0; q < NQ; q++) {
        float mx = NEG_BIG;
#pragma unroll
        for (int kt = 0; kt < 4; kt++)
#pragma unroll
            for (int r = 0; r < 4; r++) {
                if (MMODE == 1) { const int o = kt * 16 + qq * 4 + r; if (o > tok[q]) S[q][kt][r] = -INFINITY; }
                if (MMODE == 2) { const int o = kt * 16 + qq * 4 + r; if (o <= tok[q]) S[q][kt][r] = -INFINITY; }
                if (FIXM) { if (!valid[q]) S[q][kt][r] = -INFINITY; } else mx = fmaxf(mx, S[q][kt][r]);
            }
        float mnew = m_old[q], alpha = 1.f;
        if (!FIXM) {
            if (!valid[q]) mx = NEG_BIG;
            mx = xq_max(mx);
            mnew = fmaxf(m_old[q], mx);
            alpha = __builtin_amdgcn_exp2f(m_old[q] - mnew);
        }
        float psum = 0.f;
#pragma unroll
        for (int kt = 0; kt < 4; kt++) {
#pragma unroll
            for (int r = 0; r < 4; r++) { S[q][kt][r] = __builtin_amdgcn_exp2f(S[q][kt][r] - mnew); }
            psum += (S[q][kt][0] + S[q][kt][1]) + (S[q][kt][2] + S[q][kt][3]);
        }
        psum = xq_sum(psum);
        if (FIXM) { if (valid[q] && qq == 0) Ls[row[q]] = l_old[q] + psum; }
        else {
            if (valid[q] && qq == 0) { Ms[row[q]] = mnew; Ls[row[q]] = l_old[q] * alpha + psum; }
#pragma unroll
            for (int dt = 0; dt < 4; dt++)
#pragma unroll
                for (int r = 0; r < 4; r++) O[q][dt][r] *= alpha;
        }
#pragma unroll
        for (int k2 = 0; k2 < 2; k2++) {
            union { bf16x8 v; unsigned u[4]; } t;
            t.u[0] = pack2(S[q][2 * k2][0], S[q][2 * k2][1]); t.u[1] = pack2(S[q][2 * k2][2], S[q][2 * k2][3]);
            t.u[2] = pack2(S[q][2 * k2 + 1][0], S[q][2 * k2 + 1][1]); t.u[3] = pack2(S[q][2 * k2 + 1][2], S[q][2 * k2 + 1][3]);
            pb[q][k2] = t.v;
        }
        if (NQ == 2 && q == 0) { asm volatile("" ::: "memory"); NSA_LDV }
    }
#undef NSA_LDV
    NSA_VWAIT(vf);
    __builtin_amdgcn_sched_barrier(0);
#pragma unroll
    for (int dt = 0; dt < 4; dt++)
#pragma unroll
        for (int k2 = 0; k2 < 2; k2++)
#pragma unroll
            for (int q = 0; q < NQ; q++) O[q][dt] = __builtin_amdgcn_mfma_f32_16x16x32_bf16(vf[dt][k2].v, pb[q][k2], O[q][dt], 0, 0, 0);
#pragma unroll
    for (int q = 0; q < NQ; q++)
        if (valid[q]) {
#pragma unroll
            for (int dt = 0; dt < 4; dt++) *(f32x4*)(orow[q] + (((dt * 4 + qq) ^ osw[q]) << 2)) = O[q][dt];
        }
}
template <int MMODE, bool FIXM>
__device__ __forceinline__ void nsa_visit_g(const u16* Ks, const u16* Vs, const u16* qs, float* Os, float* Ms, float* Ls, int tok, bool valid, int lane) {
    const int tk[1] = {tok}; const bool vl[1] = {valid};
    nsa_visit_gn<MMODE, FIXM, 1>(Ks, Vs, qs, Os, Ms, Ls, tk, vl, lane);
}
__device__ __forceinline__ void nsa_fold_lds(float* Os, float* Ms, float* Ls, int row, int qq, int hh, f32x4 (&T)[4], float gate, bool reset) {
    const float lt = Ls[row];
    const float sc = (lt > 0.f) ? gate / lt : 0.f;
#pragma unroll
    for (int dt = 0; dt < 4; dt++) {
        float* op = Os + row * 64 + (((dt * 4 + qq) ^ hh ^ (((row >> 2) & 3) << 2)) << 2);
        const f32x4 o = *(const f32x4*)op;
#pragma unroll
        for (int r = 0; r < 4; r++) T[dt][r] += o[r] * sc;
        if (reset) *(f32x4*)op = f32x4{0.f, 0.f, 0.f, 0.f};
    }
    asm volatile("s_waitcnt lgkmcnt(0)" ::: "memory");
    if (reset && qq == 0) { Ms[row] = NEG_BIG; Ls[row] = 0.f; }
}
template <int MODE>
__device__ __forceinline__ void nsa_fold(Sub& s, f32x4 (&T)[4], float gate) {
    const float lt = xq_sum(s.l);
    const float sc = (lt > 0.f) ? gate / lt : 0.f;
#pragma unroll
    for (int dt = 0; dt < 4; dt++)
#pragma unroll
        for (int r = 0; r < 4; r++) {
            const float v = s.O[dt][r] * sc;
            T[dt][r] = (MODE == 1) ? T[dt][r] + v : v;
            s.O[dt][r] = 0.f;
        }
    s.m = NEG_BIG; s.l = 0.f;
}

constexpr int NSA_R = 3;
template <bool HASV, class KSrc, class VSrc, class Body>
__device__ __forceinline__ void nsa_stream(char* ring, int n, KSrc ksrc, VSrc vsrc, Body body) {
    const int t = get_tid();
    const int so = (t >> 3) * 64 + (((t & 7) ^ ((t >> 4) & 7)) << 3);
    char* dl = ring + t * 16;
#define NSA_ISSUE(i, slot) { glds16(ksrc(i) + so, dl + (slot) * 16384); if (HASV) glds16(vsrc(i) + so, dl + (slot) * 16384 + 8192); }
    asm volatile("s_waitcnt lgkmcnt(0)" ::: "memory");
    __builtin_amdgcn_s_barrier();
    if (n > 0) NSA_ISSUE(0, 0)
    if (n > 1) NSA_ISSUE(1, 1)
    int slot = 0;
    for (int i = 0; i < n; i++) {
        if (i + 1 < n) { if (HASV) asm volatile("s_waitcnt vmcnt(2)" ::: "memory"); else asm volatile("s_waitcnt vmcnt(1)" ::: "memory"); }
        else asm volatile("s_waitcnt vmcnt(0)" ::: "memory");
        asm volatile("s_waitcnt lgkmcnt(0)" ::: "memory");
        __builtin_amdgcn_s_barrier();
        asm volatile("" ::: "memory");
        const int sl2 = (slot == 0) ? 2 : slot - 1;
        if (i + 2 < n) NSA_ISSUE(i + 2, sl2)
        body(i, (const u16*)(ring + slot * 16384), (const u16*)(ring + slot * 16384 + 8192));
        slot = (slot == 2) ? 0 : slot + 1;
    }
#undef NSA_ISSUE
}
#define NSA_TOK(u) const int t3_ = get_tid(); const size_t ntk_ = (size_t)b * S_ + t0 + 8 * (t3_ >> 6) + 4 * (u) + ((t3_ & 15) >> 2); const int hd_ = g * 4 + (t3_ & 3);
__device__ void ph_nsa(const P& p, int bid, int nb, char* smem) {
    char* ring = smem;
    unsigned* selm = (unsigned*)(smem + NSA_R * 16384);
    int* blist = (int*)(selm + 256);
    int* nlistp = blist + 128;
    int* lcnt = nlistp + 4;
    unsigned char* lists = (unsigned char*)(lcnt + 128);
    float* Ms = (float*)(lists + 128 * 64);
    float* Ls = Ms + 256;
    float* Os = Ls + 256;
    float* impl = Os;
    u16* qs = (u16*)(Os + 64 * 4 * 64);
    unsigned long long ts_ = 0, tacc_ = 0;
    const int nitems = B_ * 2 * 128;
    for (int rr = 0;; rr++) {
        int it = bid;
        if (rr > 0) {
            __syncthreads();
            if (get_tid() == 0) nlistp[3] = nb + atomicAdd(p.nsactr, 1);
            __syncthreads();
            it = nlistp[3];
        }
        if (it >= nitems) break;
        const int tid = get_tid(), lane = tid & 63, wv = tid >> 6;
        const int kr = lane & 15, qq = lane >> 4, ts = kr >> 2, hh = kr & 3;
        float* myimp = impl + wv * (32 * 2 * 16);
        const int tt = 127 - (it >> 3);
        const int bg = it & 7, b = bg >> 1, g = bg & 1;
        const int t0 = tt * 64, cur = tt;
        const int head = g * 4 + hh;
        Sub st[2];
        f32x4 T[2][4];
        int tl[2]; size_t ntok[2];
        __syncthreads();
#pragma unroll
        for (int u = 0; u < 2; u++) {
            tl[u] = 8 * wv + 4 * u + ts;
            ntok[u] = (size_t)b * S_ + t0 + tl[u];
#pragma unroll
            for (int ks = 0; ks < 2; ks++) *(bf16x8*)&qs[(tl[u] * 4 + hh) * 64 + (((ks * 4 + qq) ^ (hh >> 1) ^ ((tl[u] & 3) << 1)) << 3)] = *(const bf16x8*)&p.q[ntok[u] * 512 + head * 64 + ks * 32 + qq * 8];
#pragma unroll
            for (int dt = 0; dt < 4; dt++) st[u].O[dt] = f32x4{0.f, 0.f, 0.f, 0.f};
            st[u].m = NEG_BIG; st[u].l = 0.f;
        }
        const u16* kcb = p.kcb + (size_t)bg * 512 * 64;
        const u16* vcT = p.vcT + (size_t)bg * 8 * 4096;
        int nv[2];
#pragma unroll
        for (int u = 0; u < 2; u++) { const int t = t0 + tl[u]; nv[u] = (t >= 31) ? min((t - 31) / 16 + 1, NCMP) : 0; }
        const int tmax = t0 + 63;
        const int nvmax = (tmax >= 31) ? min((tmax - 31) / 16 + 1, NCMP) : 0;
        const int nvb = (nvmax + 63) >> 6;
        NSA_TS(1)
        __syncthreads();
        nsa_stream<false>(ring, nvb, [&](int kb) { return kcb + (size_t)kb * 4096; }, [&](int kb) { return vcT + (size_t)kb * 4096; },
            [&](int kb, const u16* Ks, const u16* Vs) {
                const int hi2[2] = {nv[0] - kb * 64 - 1, nv[1] - kb * 64 - 1};
                float e_[2][4], p3_[2][4];
                nsa_visit2<false, false>(Ks, Vs, qs + (tl[0] * 4 + hh) * 64, qs + (tl[1] * 4 + hh) * 64, st, hi2, lane, e_, p3_);
            });
        float invl[2];
#pragma unroll
        for (int u = 0; u < 2; u++) { const float lt = xq_sum(st[u].l); invl[u] = (lt > 0.f) ? 1.f / lt : 0.f; st[u].l = 0.f; }
        float carry[2] = {0.f, 0.f};
        nsa_stream<true>(ring, nvb, [&](int kb) { return kcb + (size_t)kb * 4096; }, [&](int kb) { return vcT + (size_t)kb * 4096; },
            [&](int kb, const u16* Ks, const u16* Vs) {
            const int hi2[2] = {nv[0] - kb * 64 - 1, nv[1] - kb * 64 - 1};
            float e_[2][4], p3_[2][4];
            nsa_visit2<true, true>(Ks, Vs, qs + (tl[0] * 4 + hh) * 64, qs + (tl[1] * 4 + hh) * 64, st, hi2, lane, e_, p3_);
#pragma unroll
            for (int u = 0; u < 2; u++) {
#pragma unroll
                for (int kt = 0; kt < 4; kt++) {
                    float ev = e_[u][kt] * invl[u], pv = p3_[u][kt] * invl[u];
                    ev += dppf<0xB1>(ev); ev += dppf<0x4E>(ev);
                    pv += dppf<0xB1>(pv); pv += dppf<0x4E>(pv);
                    const float sh = __int_as_float(__builtin_amdgcn_ds_bpermute(((lane - 16) & 63) << 2, __float_as_int(pv)));
                    const float nbv = (qq == 0) ? carry[u] : sh;
                    carry[u] = sh;
                    myimp[((kb * 4 + kt) * 2 + u) * 16 + ts * 4 + qq] = ev + nbv;
                }
            }
            });
        NSA_TE(1)
        NSA_TS(2)
#pragma unroll
        for (int u = 0; u < 2; u++) {
            float mv[8];
#pragma unroll
            for (int i = 0; i < 8; i++) {
                const int kk = 8 * hh + i, j = 4 * kk + qq;
                const float v = myimp[(kk * 2 + u) * 16 + ts * 4 + qq];
                mv[i] = (j >= 1 && j <= cur - 2) ? v : -1.f;
            }
            unsigned sel = 0u;
            const int ncand = max(0, cur - 2);
            const int nforced = (cur >= 2) ? 3 : (cur + 1);
            const int need = 16 - nforced;
            if (ncand <= need) {
#pragma unroll
                for (int i = 0; i < 8; i++) if (mv[i] >= 0.f) sel |= (1u << i);
            } else {
                for (int rnd = 0; rnd < need; rnd++) {
                    const float b01 = fmaxf(mv[0], mv[1]), b23 = fmaxf(mv[2], mv[3]), b45 = fmaxf(mv[4], mv[5]), b67 = fmaxf(mv[6], mv[7]);
                    float best = fmaxf(fmaxf(b01, b23), fmaxf(b45, b67));
                    int bi = 7;
#pragma unroll
                    for (int i = 6; i >= 0; i--) bi = (mv[i] == best) ? i : bi;
                    int bj = (best >= 0.f) ? (4 * (8 * hh + bi) + qq) : 9999;
#define TK_MERGE(ov, oj) { const float v2_ = (ov); const int j2_ = (oj); const bool tk_ = (v2_ > best) || (v2_ == best && j2_ < bj); best = tk_ ? v2_ : best; bj = tk_ ? j2_ : bj; }
                    TK_MERGE(dppf<0xB1>(best), __builtin_amdgcn_update_dpp(0, bj, 0xB1, 0xF, 0xF, true))
                    TK_MERGE(dppf<0x4E>(best), __builtin_amdgcn_update_dpp(0, bj, 0x4E, 0xF, 0xF, true))
                    {
                        auto rv = __builtin_amdgcn_permlane16_swap(__float_as_uint(best), __float_as_uint(best), false, false);
                        auto rj = __builtin_amdgcn_permlane16_swap((unsigned)bj, (unsigned)bj, false, false);
                        float v0 = __uint_as_float(rv[0]), v1 = __uint_as_float(rv[1]); int j0 = (int)rj[0], j1 = (int)rj[1];
                        if (v1 > v0 || (v1 == v0 && j1 < j0)) { v0 = v1; j0 = j1; }
                        rv = __builtin_amdgcn_permlane32_swap(__float_as_uint(v0), __float_as_uint(v0), false, false);
                        rj = __builtin_amdgcn_permlane32_swap((unsigned)j0, (unsigned)j0, false, false);
                        best = __uint_as_float(rv[0]); bj = (int)rj[0];
                        const float v2 = __uint_as_float(rv[1]); const int j2 = (int)rj[1];
                        if (v2 > best || (v2 == best && j2 < bj)) { best = v2; bj = j2; }
                    }
#undef TK_MERGE
                    const bool mine = (bj < 512) && ((bj >> 5) == hh) && ((bj & 3) == qq);
                    const int li = (bj >> 2) & 7;
#pragma unroll
                    for (int i = 0; i < 8; i++) mv[i] = (mine && li == i) ? -1.f : mv[i];
                    if (mine) sel |= (1u << li);
                }
            }
            if (qq == 0 && hh == 0) sel |= 1u;
            if ((cur & 3) == qq && (cur >> 5) == hh) sel |= (1u << ((cur >> 2) & 7));
            if (cur >= 1 && ((cur - 1) & 3) == qq && ((cur - 1) >> 5) == hh) sel |= (1u << (((cur - 1) >> 2) & 7));
            unsigned w = sel << (8 * hh);
            w |= (unsigned)__builtin_amdgcn_update_dpp(0, (int)w, 0xB1, 0xF, 0xF, true);
            w |= (unsigned)__builtin_amdgcn_update_dpp(0, (int)w, 0x4E, 0xF, 0xF, true);
            if (hh == 0) selm[tl[u] * 4 + qq] = w;
        }
        NSA_TE(2)
        NSA_TS(3)
        __syncthreads();
#pragma unroll
        for (int u = 0; u < 2; u++) { NSA_TOK(u) nsa_fold<0>(st[u], T[u], p.nsag[ntk_ * 24 + hd_ * 3 + 0]); }
        {
            const int t2 = get_tid();
#pragma unroll
            for (int i = 0; i < 8; i++) *(f32x4*)&Os[(i * NT + t2) * 4] = f32x4{0.f, 0.f, 0.f, 0.f};
            if (t2 < 256) { Ms[t2] = NEG_BIG; Ls[t2] = 0.f; }
            unsigned long long tm = 0ull; int lrank = 0;
            if (t2 < 128) {
                const int j = t2;
                for (int tk = 0; tk < 64; tk++) tm |= (unsigned long long)((selm[tk * 4 + (j & 3)] >> (j >> 2)) & 1u) << tk;
                if (j > cur) tm = 0ull;
                const unsigned long long bal = __ballot(tm != 0ull);
                lrank = __popcll(bal & ((1ull << (t2 & 63)) - 1ull));
                if ((t2 & 63) == 0) nlistp[t2 >> 6] = __popcll(bal);
            }
            __syncthreads();
            if (t2 < 128 && tm != 0ull) {
                const int pos = lrank + ((t2 >= 64) ? nlistp[0] : 0);
                blist[pos] = t2; lcnt[pos] = __popcll(tm);
                int c = 0;
                while (tm) { lists[pos * 64 + c] = (unsigned char)(__ffsll((long long)tm) - 1); c++; tm &= tm - 1ull; }
            }
            __syncthreads();
        }
        const int nlist = nlistp[0] + nlistp[1];
        NSA_TE(3)
        NSA_TS(4)
        const u16* ksl = p.ksl + (size_t)bg * S_ * 64;
        const u16* vslT = p.vslT + (size_t)bg * 128 * 4096;
        {
            const int t4 = get_tid(), wv4 = __builtin_amdgcn_readfirstlane(t4 >> 6), ts4 = (t4 & 15) >> 2;
            const int td = t4 & 255;
            const int so = (td >> 3) * 64 + (((td & 7) ^ ((td >> 4) & 7)) << 3);
            char* dl = ring + td * 16;
#define NSA_RI(i) (nlist - 1 - (i))
#define NSA_ISSUE2(i, slot) if (wv4 >= 4) { const int jj_ = blist[NSA_RI(i)]; const u16* kp_ = ksl + (size_t)jj_ * 4096 + so; const u16* vp_ = vslT + (size_t)jj_ * 4096 + so; char* d_ = dl + (slot) * 16384; \
                glds16(kp_, d_); glds16(kp_ + 2048, d_ + 4096); glds16(vp_, d_ + 8192); glds16(vp_ + 2048, d_ + 12288); }
            asm volatile("s_waitcnt lgkmcnt(0)" ::: "memory");
            __builtin_amdgcn_s_barrier();
            if (nlist > 0) NSA_ISSUE2(0, 0)
            if (nlist > 1) NSA_ISSUE2(1, 1)
            int jn = 0, nn = 0, tokn = 0;
            if (nlist > 0) { jn = blist[NSA_RI(0)]; nn = lcnt[NSA_RI(0)]; tokn = lists[NSA_RI(0) * 64 + wv4 * 4 + ts4]; }
            int slot = 0;
            for (int i = 0; i < nlist; i++) {
                if (i + 1 < nlist) asm volatile("s_waitcnt vmcnt(4)" ::: "memory"); else asm volatile("s_waitcnt vmcnt(0)" ::: "memory");
                asm volatile("s_waitcnt lgkmcnt(0)" ::: "memory");
                __builtin_amdgcn_s_barrier();
                asm volatile("" ::: "memory");
                const int sl2 = (slot == 0) ? 2 : slot - 1;
                if (i + 2 < nlist) NSA_ISSUE2(i + 2, sl2)
                const int j = jn, n = nn, tok0 = tokn;
                if (i + 1 < nlist) { jn = blist[NSA_RI(i + 1)]; nn = lcnt[NSA_RI(i + 1)]; tokn = lists[NSA_RI(i + 1) * 64 + wv4 * 4 + ts4]; }
                const u16* Ks = (const u16*)(ring + slot * 16384); const u16* Vs = Ks + 4096;
                if ((wv4 + NW) * 4 < n) {
                    const int e1 = (wv4 + NW) * 4 + ts4;
                    const bool vl2[2] = {true, e1 < n};
                    const int tk2[2] = {tok0, vl2[1] ? (int)lists[NSA_RI(i) * 64 + (e1 & 63)] : 0};
                    if (j == cur) nsa_visit_gn<1, false, 2>(Ks, Vs, qs, Os, Ms, Ls, tk2, vl2, t4 & 63);
                    else nsa_visit_gn<0, true, 2>(Ks, Vs, qs, Os, Ms, Ls, tk2, vl2, t4 & 63);
                } else if (wv4 * 4 < n) {
                    const int e = wv4 * 4 + ts4;
                    const bool valid = e < n;
                    const int tok = valid ? tok0 : 0;
                    if (j == cur) nsa_visit_g<1, false>(Ks, Vs, qs, Os, Ms, Ls, tok, valid, t4 & 63);
                    else nsa_visit_g<0, true>(Ks, Vs, qs, Os, Ms, Ls, tok, valid, t4 & 63);
                }
                slot = (slot == 2) ? 0 : slot + 1;
            }
#undef NSA_RI
#undef NSA_ISSUE2
        }
        __syncthreads();
        NSA_TE(4)
        NSA_TS(5)
#pragma unroll
        for (int u = 0; u < 2; u++) {
            NSA_TOK(u)
            const int t5 = t3_ & 63;
            nsa_fold_lds(Os, Ms, Ls, (8 * (t3_ >> 6) + 4 * u + ((t5 & 15) >> 2)) * 4 + (t5 & 3), t5 >> 4, t5 & 3, T[u], p.nsag[ntk_ * 24 + hd_ * 3 + 1], true);
        }
        const u16* kwn = p.kwn + (size_t)bg * S_ * 64;
        const u16* vwnT = p.vwnT + (size_t)bg * 128 * 4096;
        uint2 Tp[2][4];
#pragma unroll
        for (int u = 0; u < 2; u++)
#pragma unroll
            for (int dt = 0; dt < 4; dt++) { Tp[u][dt] = pack4(T[u][dt]); asm volatile("" : "+v"(Tp[u][dt].x), "+v"(Tp[u][dt].y)); }
        {
            const int jlo = max(0, cur - 8);
            nsa_stream<true>(ring, cur - jlo + 1, [&](int i) { return kwn + (size_t)(cur - i) * 4096; }, [&](int i) { return vwnT + (size_t)(cur - i) * 4096; },
                [&](int i, const u16* Ks, const u16* Vs) {
                    const int j = cur - i;
                    const int t4 = get_tid();
                    const int tb_ = 8 * (t4 >> 6) + ((t4 & 15) >> 2);
                    const int tk2[2] = {tb_, tb_ + 4}; const bool vl2[2] = {true, true};
                    if (j == cur) nsa_visit_gn<1, false, 2>(Ks, Vs, qs, Os, Ms, Ls, tk2, vl2, t4 & 63);
                    else if (j == cur - 8) nsa_visit_gn<2, true, 2>(Ks, Vs, qs, Os, Ms, Ls, tk2, vl2, t4 & 63);
                    else nsa_visit_gn<0, true, 2>(Ks, Vs, qs, Os, Ms, Ls, tk2, vl2, t4 & 63);
                });
        }
#pragma unroll
        for (int u = 0; u < 2; u++) {
            NSA_TOK(u)
#pragma unroll
            for (int dt = 0; dt < 4; dt++) T[u][dt] = unpack4(Tp[u][dt]);
            { const int t5 = t3_ & 63; nsa_fold_lds(Os, Ms, Ls, (8 * (t3_ >> 6) + 4 * u + ((t5 & 15) >> 2)) * 4 + (t5 & 3), t5 >> 4, t5 & 3, T[u], p.nsag[ntk_ * 24 + hd_ * 3 + 2], false); }
#pragma unroll
            for (int dt = 0; dt < 4; dt++) *(uint2*)&p.oa[ntk_ * 512 + hd_ * 64 + dt * 16 + ((t3_ & 63) >> 4) * 4] = pack4(T[u][dt]);
        }
        NSA_TE(5)
    }
    if (NSAPROBE) { __syncthreads(); const unsigned long long t1_ = __builtin_amdgcn_s_memrealtime(); while (__builtin_amdgcn_s_memrealtime() - t1_ < tacc_) __builtin_amdgcn_s_sleep(8); }
}

#ifndef CHPROBE
#define CHPROBE 0
#endif
#define CH_TS(k) if (CHPROBE == k) cts_ = __builtin_amdgcn_s_memrealtime();
#define CH_TE(k) if (CHPROBE == k) ctacc_ += __builtin_amdgcn_s_memrealtime() - cts_;
constexpr int RS = 72;
constexpr int RSLOT = 64 * RS;
__device__ __forceinline__ void mm64(const u16* A, int lda, const u16* Bz, int ldb, f32x4 (&acc)[2], int lane, int wv) {
    const int mt = wv >> 1, nt0 = (wv & 1) * 2, kr = lane & 15, qq = lane >> 4;
    bf16x8 a[2], b[2][2];
#pragma unroll
    for (int ks = 0; ks < 2; ks++) {
        a[ks] = *(const bf16x8*)&A[(mt * 16 + kr) * lda + ks * 32 + qq * 8];
#pragma unroll
        for (int i = 0; i < 2; i++) b[ks][i] = *(const bf16x8*)&Bz[((nt0 + i) * 16 + kr) * ldb + ks * 32 + qq * 8];
    }
#pragma unroll
    for (int ks = 0; ks < 2; ks++)
#pragma unroll
        for (int i = 0; i < 2; i++) acc[i] = __builtin_amdgcn_mfma_f32_16x16x32_bf16(a[ks], b[ks][i], acc[i], 0, 0, 0);
}
__device__ __forceinline__ void st_t(u16* dst, int ld, const f32x4& v, int mt, int nt, int lane) {
    uint2 o; o.x = pack2(v[0], v[1]); o.y = pack2(v[2], v[3]);
    *(uint2*)&dst[(nt * 16 + (lane & 15)) * ld + mt * 16 + (lane >> 4) * 4] = o;
}
__device__ __forceinline__ void st_n(u16* dst, int ld, const f32x4& v, int mt, int nt, int lane) {
#pragma unroll
    for (int r = 0; r < 4; r++) dst[(mt * 16 + (lane >> 4) * 4 + r) * ld + nt * 16 + (lane & 15)] = f2bf(v[r]);
}
#define ZACC(a) { a[0] = f32x4{0.f, 0.f, 0.f, 0.f}; a[1] = f32x4{0.f, 0.f, 0.f, 0.f}; }

__device__ void ph_rwkv_chunk(const P& p, int bid, int nb, char* smem) {
    unsigned long long cts_ = 0, ctacc_ = 0;
    u16* sl = (u16*)smem;
    float* tot = (float*)(sl + 14 * RSLOT);
    float* gl = tot + 512;
#define RW_IDX const int tid = get_tid(), lane = tid & 63, wv = tid >> 6, mt = wv >> 1, nt0 = (wv & 1) * 2, kr = lane & 15, qq = lane >> 4; (void)mt; (void)nt0; (void)kr; (void)qq; (void)lane;
    const int nitems = B_ * 128;
    for (int it0 = bid; it0 < nitems; it0 += nb) {
      const int c = it0 & 127, b = it0 >> 7;
      const size_t n0 = (size_t)b * S_ + c * 64;
      __syncthreads();
      bf16x8 xa_[8], wb[2][2], ab[2][2], gb[2][4];
      u16 rc[8][3], rp0[3];
      float w0c[2], a0c[2], hc_[6];
#define S1_LOADW(hh_) { RW_IDX \
          _Pragma("unroll") for (int i = 0; i < 2; i++) { const int cc = (nt0 + i) * 16 + kr; w0c[i] = p.w0[(hh_) * 64 + cc]; a0c[i] = p.a0[(hh_) * 64 + cc]; \
              _Pragma("unroll") for (int ks = 0; ks < 2; ks++) { wb[i][ks] = *(const bf16x8*)&p.w2T[((size_t)(hh_) * 64 + cc) * 64 + ks * 32 + qq * 8]; \
                                                                 ab[i][ks] = *(const bf16x8*)&p.a2T[((size_t)(hh_) * 64 + cc) * 64 + ks * 32 + qq * 8]; } \
              _Pragma("unroll") for (int ks = 0; ks < 4; ks++) gb[i][ks] = *(const bf16x8*)&p.g2T[((size_t)(hh_) * 64 + cc) * 128 + ks * 32 + qq * 8]; } }
#define S2_LOADX(hh_) { RW_IDX const int ch_ = (hh_) * 64 + lane; \
          hc_[0] = p.mu[ch_]; hc_[1] = p.mu[512 + ch_]; hc_[2] = p.mu[1024 + ch_]; hc_[3] = p.k_k[ch_]; hc_[4] = p.k_a[ch_]; hc_[5] = p.r_k[ch_]; \
          _Pragma("unroll") for (int i = 0; i < 8; i++) { const int t = wv * 8 + i; const u16* cr = p.prw + (n0 + t) * CRW; \
              rc[i][0] = cr[ch_]; rc[i][1] = cr[512 + ch_]; rc[i][2] = cr[1024 + ch_]; } \
          rp0[0] = 0; rp0[1] = 0; rp0[2] = 0;     \
          if (c * 64 + wv * 8 > 0) { const u16* pp = p.prw + (n0 + wv * 8 - 1) * CRW; rp0[0] = pp[ch_]; rp0[1] = pp[512 + ch_]; rp0[2] = pp[1024 + ch_]; } }
      S2_LOADX(0)
      {
          RW_IDX
          const int t = tid >> 3, part = tid & 7;
          const size_t n = n0 + t;
          const bool hasprev = (c * 64 + t) > 0;
          u16* dst = p.xact + n * 256 + part * 32;
#pragma unroll
          for (int j = 0; j < 4; j++) {
              const int col = 1536 + part * 32 + j * 8;
              const uint4 cu = *(const uint4*)&p.prw[n * CRW + col];
              uint4 pv = make_uint4(0u, 0u, 0u, 0u);
              if (hasprev) pv = *(const uint4*)&p.prw[(n - 1) * CRW + col];
              const unsigned cw[4] = {cu.x, cu.y, cu.z, cu.w}, pw[4] = {pv.x, pv.y, pv.z, pv.w};
              unsigned ow[4];
#pragma unroll
              for (int e2 = 0; e2 < 4; e2++) {
                  float x0 = __uint_as_float(cw[e2] << 16), x1 = __uint_as_float(cw[e2] & 0xFFFF0000u);
                  const float q0 = __uint_as_float(pw[e2] << 16), q1 = __uint_as_float(pw[e2] & 0xFFFF0000u);
                  x0 = x0 + (q0 - x0) * p.mu[col + 2 * e2]; x1 = x1 + (q1 - x1) * p.mu[col + 2 * e2 + 1];
                  if (part < 2) { x0 = tanhf(x0); x1 = tanhf(x1); }
                  else if (part >= 4) { x0 = sigmoidf_(x0); x1 = sigmoidf_(x1); }
                  ow[e2] = pack2(x0, x1);
              }
              *(uint4*)&dst[j * 8] = make_uint4(ow[0], ow[1], ow[2], ow[3]);
          }
      }
      __syncthreads();
      const u16* xa = p.xact + n0 * 256;
      {
          RW_IDX
#pragma unroll
          for (int k8 = 0; k8 < 8; k8++) xa_[k8] = *(const bf16x8*)&xa[(mt * 16 + kr) * 256 + k8 * 32 + qq * 8];
      }
      S1_LOADW(0)
#pragma unroll 1
      for (int h = 0; h < 8; h++) {
        u16* cd = p.cdat + ((size_t)((b * 8 + h) * 128 + c)) * 4 * 4096;
        LDS_BARRIER();
        CH_TS(1)
        float* LW = (float*)(sl + 8 * RSLOT); float* LA = (float*)(sl + 10 * RSLOT);
        {
            RW_IDX
            f32x4 aw[2], aa2[2], ag[2];
#pragma unroll
            for (int i = 0; i < 2; i++) {
                aw[i] = f32x4{0.f, 0.f, 0.f, 0.f}; aa2[i] = aw[i]; ag[i] = aw[i];
#pragma unroll
                for (int ks = 0; ks < 2; ks++) {
                    aw[i] = __builtin_amdgcn_mfma_f32_16x16x32_bf16(xa_[ks], wb[i][ks], aw[i], 0, 0, 0);
                    aa2[i] = __builtin_amdgcn_mfma_f32_16x16x32_bf16(xa_[2 + ks], ab[i][ks], aa2[i], 0, 0, 0);
                }
#pragma unroll
                for (int ks = 0; ks < 4; ks++) ag[i] = __builtin_amdgcn_mfma_f32_16x16x32_bf16(xa_[4 + ks], gb[i][ks], ag[i], 0, 0, 0);
            }
#pragma unroll
            for (int i = 0; i < 2; i++)
#pragma unroll
                for (int r = 0; r < 4; r++) {
                    const int t = mt * 16 + qq * 4 + r, cc = (nt0 + i) * 16 + kr;
                    const float wl = w0c[i] + aw[i][r];
                    const float z = -wl;
                    const float sp = fmaxf(z, 0.f) + __logf(1.f + __expf(-fabsf(z)));
                    LW[t * 64 + cc] = -__expf(-sp - 0.5f);
                    LA[t * 64 + cc] = sigmoidf_(a0c[i] + aa2[i][r]);
                    p.ob[(n0 + t) * 512 + h * 64 + cc] = f2bf(ag[i][r]);
                }
        }
        LDS_BARRIER();
        CH_TE(1) CH_TS(2)
        {
            RW_IDX
            const int ch = h * 64 + lane;
            const float mur = hc_[0], muk = hc_[1], muv = hc_[2];
            const float kkw = hc_[3], kaw = hc_[4], rkw = hc_[5];
            float rr[8], k2[8], vv[8], kkn[8], aa[8], lg[8], cs[8];
            float run = 0.f;
#pragma unroll
            for (int i = 0; i < 8; i++) {
                const int t = wv * 8 + i; const size_t n = n0 + t;
                float r = bf2f(rc[i][0]), k = bf2f(rc[i][1]), v = bf2f(rc[i][2]);
                const float pr = bf2f(i ? rc[i - 1][0] : rp0[0]), pk = bf2f(i ? rc[i - 1][1] : rp0[1]), pv = bf2f(i ? rc[i - 1][2] : rp0[2]);
                r = r + (pr - r) * mur; k = k + (pk - k) * muk; v = v + (pv - v) * muv;
                const float a = LA[t * 64 + lane];
                lg[i] = LW[t * 64 + lane];
                float kk = k * kkw;
                kkn[i] = kk * __builtin_amdgcn_rsqf(fmaxf(wave_sum(kk * kk), 1e-24f));
                k2[i] = k * (1.f + (a - 1.f) * kaw);
                const float bon = wave_sum(r * k2[i] * rkw);
                if (lane == 0) p.bon[n * 8 + h] = bon;
                rr[i] = r; vv[i] = v; aa[i] = a;
                run += lg[i]; cs[i] = run;
            }
            tot[wv * 64 + lane] = run;
            LDS_BARRIER();
            float off = 0.f, cumL = 0.f;
#pragma unroll
            for (int w2 = 0; w2 < 8; w2++) { const float tv = tot[w2 * 64 + lane]; cumL += tv; if (w2 < wv) off += tv; }
            if (wv == 0) gl[lane] = __expf(cumL);
            unsigned pa[4], pb[4], pk4[4], pv4[4];
#pragma unroll
            for (int i = 0; i < 8; i += 2) {
                float at[2], bt[2], kt[2], rt[2];
#pragma unroll
                for (int e2 = 0; e2 < 2; e2++) {
                    const int ii = i + e2; const int t = wv * 8 + ii;
                    const float cm = off + cs[ii];
                    const float g = __expf(cm), gp = __expf(cm - lg[ii]), gi = __expf(-cm);
                    at[e2] = -kkn[ii] * gp; bt[e2] = kkn[ii] * aa[ii] * gi; kt[e2] = k2[ii] * gi; rt[e2] = rr[ii] * g;
                    sl[0 * RSLOT + t * RS + lane] = f2bf(at[e2]);
                    sl[1 * RSLOT + t * RS + lane] = f2bf(bt[e2]);
                    sl[2 * RSLOT + t * RS + lane] = f2bf(kt[e2]);
                    sl[3 * RSLOT + t * RS + lane] = f2bf(rt[e2]);
                }
                pa[i >> 1] = pack2(at[0], at[1]); pb[i >> 1] = pack2(bt[0], bt[1]);
                pk4[i >> 1] = pack2(kt[0], kt[1]); pv4[i >> 1] = pack2(vv[i], vv[i + 1]);
            }
            *(uint4*)&sl[4 * RSLOT + lane * RS + wv * 8] = make_uint4(pa[0], pa[1], pa[2], pa[3]);
            *(uint4*)&sl[5 * RSLOT + lane * RS + wv * 8] = make_uint4(pb[0], pb[1], pb[2], pb[3]);
            *(uint4*)&sl[6 * RSLOT + lane * RS + wv * 8] = make_uint4(pk4[0], pk4[1], pk4[2], pk4[3]);
            *(uint4*)&sl[7 * RSLOT + lane * RS + wv * 8] = make_uint4(pv4[0], pv4[1], pv4[2], pv4[3]);
        }
        LDS_BARRIER();
        if (h + 1 < 8) { asm volatile("s_waitcnt vmcnt(0)" ::: "memory");
                         S1_LOADW(h + 1) S2_LOADX(h + 1) }
        CH_TE(2) CH_TS(3)
        {
            RW_IDX
            f32x4 acc[2];
            ZACC(acc); mm64(sl + 1 * RSLOT, RS, sl + 0 * RSLOT, RS, acc, lane, wv);
#pragma unroll
            for (int i = 0; i < 2; i++) {
                f32x4 pm;
#pragma unroll
                for (int r = 0; r < 4; r++) {
                    const int m = mt * 16 + qq * 4 + r, n = (nt0 + i) * 16 + kr;
                    if (!(m < n)) acc[i][r] = 0.f;
                    pm[r] = acc[i][r] + ((m == n) ? 1.f : 0.f);
                }
                st_t(sl + 8 * RSLOT, RS, acc[i], mt, nt0 + i, lane);
                st_n(sl + 9 * RSLOT, RS, acc[i], mt, nt0 + i, lane);
                st_t(sl + 13 * RSLOT, RS, pm, mt, nt0 + i, lane);
            }
            ZACC(acc); mm64(sl + 0 * RSLOT, RS, sl + 2 * RSLOT, RS, acc, lane, wv);
#pragma unroll
            for (int i = 0; i < 2; i++) {
#pragma unroll
                for (int r = 0; r < 4; r++) { const int m = mt * 16 + qq * 4 + r, n = (nt0 + i) * 16 + kr; if (!(m > n)) acc[i][r] = 0.f; }
                st_t(sl + 10 * RSLOT, RS, acc[i], mt, nt0 + i, lane);
            }
            ZACC(acc); mm64(sl + 1 * RSLOT, RS, sl + 3 * RSLOT, RS, acc, lane, wv);
#pragma unroll
            for (int i = 0; i < 2; i++) {
#pragma unroll
                for (int r = 0; r < 4; r++) { const int m = mt * 16 + qq * 4 + r, n = (nt0 + i) * 16 + kr; if (m > n) acc[i][r] = 0.f; }
                st_t(sl + 11 * RSLOT, RS, acc[i], mt, nt0 + i, lane);
            }
            ZACC(acc); mm64(sl + 2 * RSLOT, RS, sl + 3 * RSLOT, RS, acc, lane, wv);
#pragma unroll
            for (int i = 0; i < 2; i++) {
#pragma unroll
                for (int r = 0; r < 4; r++) { const int m = mt * 16 + qq * 4 + r, n = (nt0 + i) * 16 + kr; if (m > n) acc[i][r] = 0.f; }
                st_t(sl + 12 * RSLOT, RS, acc[i], mt, nt0 + i, lane);
            }
        }
        LDS_BARRIER();
        CH_TE(3) CH_TS(4)
        u16* X = sl + 8 * RSLOT; u16* XT = sl + 9 * RSLOT; u16* X2 = sl + 0 * RSLOT; u16* X2T = sl + 1 * RSLOT;
        u16* Pc = sl + 13 * RSLOT; u16* Pn = sl + 2 * RSLOT;
#pragma unroll 1
        for (int j = 1; j <= 6; j++) {
            RW_IDX
            f32x4 acc[2];
            if (j <= 5) {
                ZACC(acc); mm64(X, RS, XT, RS, acc, lane, wv);
#pragma unroll
                for (int i = 0; i < 2; i++) { st_t(X2T, RS, acc[i], mt, nt0 + i, lane); st_n(X2, RS, acc[i], mt, nt0 + i, lane); }
            }
            if (j >= 2) {
                ZACC(acc); mm64(XT, RS, Pc, RS, acc, lane, wv);
#pragma unroll
                for (int i = 0; i < 2; i++) {
                    const uint2 pv = *(const uint2*)&Pc[((nt0 + i) * 16 + kr) * RS + mt * 16 + qq * 4];
                    acc[i][0] += __uint_as_float(pv.x << 16); acc[i][1] += __uint_as_float(pv.x & 0xFFFF0000u);
                    acc[i][2] += __uint_as_float(pv.y << 16); acc[i][3] += __uint_as_float(pv.y & 0xFFFF0000u);
                    st_t(Pn, RS, acc[i], mt, nt0 + i, lane);
                }
            }
            LDS_BARRIER();
            if (j >= 2) { u16* tp = Pc; Pc = Pn; Pn = tp; }
            if (j <= 5) { u16* tx = X; X = X2; X2 = tx; tx = XT; XT = X2T; X2T = tx; }
        }
        CH_TE(4) CH_TS(5)
        u16* TT = Pc;
        {
            RW_IDX
            f32x4 acc[2];
            ZACC(acc); mm64(TT, RS, sl + 4 * RSLOT, RS, acc, lane, wv);
#pragma unroll
            for (int i = 0; i < 2; i++) st_t(sl + 0 * RSLOT, RS, acc[i], mt, nt0 + i, lane);
            ZACC(acc); mm64(sl + 10 * RSLOT, RS, TT, RS, acc, lane, wv);
#pragma unroll
            for (int i = 0; i < 2; i++) st_t(sl + 8 * RSLOT, RS, acc[i], mt, nt0 + i, lane);
        }
        LDS_BARRIER();
        {
            RW_IDX
            f32x4 acc[2];
            ZACC(acc); mm64(sl + 8 * RSLOT, RS, sl + 7 * RSLOT, RS, acc, lane, wv);
#pragma unroll
            for (int i = 0; i < 2; i++) st_t(sl + 9 * RSLOT, RS, acc[i], mt, nt0 + i, lane);
            ZACC(acc); mm64(sl + 0 * RSLOT, RS, sl + 5 * RSLOT, RS, acc, lane, wv);
#pragma unroll
            for (int i = 0; i < 2; i++) {
                const int n = (nt0 + i) * 16 + kr; const float gn = gl[n];
#pragma unroll
                for (int r = 0; r < 4; r++) { const int m = mt * 16 + qq * 4 + r; acc[i][r] = acc[i][r] * gn + ((m == n) ? gn : 0.f); }
                st_t(cd, 64, acc[i], mt, nt0 + i, lane);
            }
            ZACC(acc); mm64(sl + 0 * RSLOT, RS, sl + 11 * RSLOT, RS, acc, lane, wv);
#pragma unroll
            for (int i = 0; i < 2; i++) {
                const uint2 rv = *(const uint2*)&sl[3 * RSLOT + ((nt0 + i) * 16 + kr) * RS + mt * 16 + qq * 4];
                acc[i][0] += __uint_as_float(rv.x << 16); acc[i][1] += __uint_as_float(rv.x & 0xFFFF0000u);
                acc[i][2] += __uint_as_float(rv.y << 16); acc[i][3] += __uint_as_float(rv.y & 0xFFFF0000u);
                st_t(cd + 2 * 4096, 64, acc[i], mt, nt0 + i, lane);
            }
        }
        LDS_BARRIER();
        {
            RW_IDX
            f32x4 acc[2];
            ZACC(acc);
            mm64(sl + 5 * RSLOT, RS, sl + 9 * RSLOT, RS, acc, lane, wv);
            mm64(sl + 6 * RSLOT, RS, sl + 7 * RSLOT, RS, acc, lane, wv);
#pragma unroll
            for (int i = 0; i < 2; i++) {
#pragma unroll
                for (int r = 0; r < 4; r++) acc[i][r] *= gl[mt * 16 + qq * 4 + r];
                st_t(cd + 1 * 4096, 64, acc[i], mt, nt0 + i, lane);
            }
            ZACC(acc);
            mm64(sl + 9 * RSLOT, RS, sl + 11 * RSLOT, RS, acc, lane, wv);
            mm64(sl + 7 * RSLOT, RS, sl + 12 * RSLOT, RS, acc, lane, wv);
#pragma unroll
            for (int i = 0; i < 2; i++) st_t(cd + 3 * 4096, 64, acc[i], mt, nt0 + i, lane);
        }
        CH_TE(5)
      }
    }
    if (CHPROBE) { __syncthreads(); const unsigned long long t1_ = __builtin_amdgcn_s_memrealtime(); while (__builtin_amdgcn_s_memrealtime() - t1_ < ctacc_) __builtin_amdgcn_s_sleep(8); }
}

__device__ void ph_rwkv_seq(const P& p, int bid, int nb, char* smem) {
    u16* SL = (u16*)smem;
    const int tid = get_tid(), lane = tid & 63, wv = __builtin_amdgcn_readfirstlane(tid >> 6);
    const int kr = lane & 15, qq = lane >> 4, chn = wv >> 2, vt = wv & 3;
    for (int pair = bid; pair < B_ * 4; pair += nb) {
        const int bh = pair * 2 + chn;
        u16* mySL = SL + chn * RSLOT;
        __syncthreads();
#pragma unroll
        for (int ks = 0; ks < 2; ks++) *(uint4*)&mySL[(vt * 16 + kr) * RS + ks * 32 + qq * 8] = make_uint4(0u, 0u, 0u, 0u);
        u16* cbase = p.cdat + (size_t)bh * 128 * 4 * 4096;
        bf16x8 GA0[4][2], GA1[4][2], GA2[4][2], GA3[4][2]; uint2 H0[4], H1[4], H2[4], H3[4];
#define SEQ_LD(GAx, Hx, c) { const u16* cd_ = cbase + (size_t)(c) * 4 * 4096; \
            _Pragma("unroll") for (int m4 = 0; m4 < 4; m4++) { \
                _Pragma("unroll") for (int ks = 0; ks < 2; ks++) GAx[m4][ks] = *(const bf16x8*)&cd_[(m4 * 16 + kr) * 64 + ks * 32 + qq * 8]; \
                Hx[m4] = *(const uint2*)&cd_[1 * 4096 + (vt * 16 + kr) * 64 + m4 * 16 + qq * 4]; } }
#define SEQ_STEP(GAx, Hx, c) { \
            bf16x8 Z0[2]; \
            _Pragma("unroll") for (int ks = 0; ks < 2; ks++) Z0[ks] = *(const bf16x8*)&mySL[(vt * 16 + kr) * RS + ks * 32 + qq * 8]; \
            f32x4 zs[4]; \
            _Pragma("unroll") for (int m4 = 0; m4 < 4; m4++) { \
                zs[m4] = unpack4(Hx[m4]); \
                _Pragma("unroll") for (int ks = 0; ks < 2; ks++) zs[m4] = __builtin_amdgcn_mfma_f32_16x16x32_bf16(GAx[m4][ks], Z0[ks], zs[m4], 0, 0, 0); } \
            u16* sn_ = cbase + (size_t)(c) * 4 * 4096 + 1 * 4096 + (vt * 16 + kr) * 64 + qq * 4; \
            _Pragma("unroll") for (int m4 = 0; m4 < 4; m4++) { \
                const uint2 pk_ = pack4(zs[m4]); \
                *(uint2*)&mySL[(vt * 16 + kr) * RS + m4 * 16 + qq * 4] = pk_; \
                *(uint2*)&sn_[m4 * 16] = pk_; } \
            if ((c) + 4 < 128) SEQ_LD(GAx, Hx, (c) + 4) }
        SEQ_LD(GA0, H0, 0) SEQ_LD(GA1, H1, 1) SEQ_LD(GA2, H2, 2) SEQ_LD(GA3, H3, 3)
#pragma unroll 1
        for (int c = 0; c < 128; c += 4) {
            SEQ_STEP(GA0, H0, c)
            SEQ_STEP(GA1, H1, c + 1)
            SEQ_STEP(GA2, H2, c + 2)
            SEQ_STEP(GA3, H3, c + 3)
        }
#undef SEQ_LD
#undef SEQ_STEP
    }
}

__device__ void ph_rwkv_out(const P& p, int bid, int nb, char* smem) {
    const int tid = get_tid(), lane = tid & 63, wv = tid >> 6;
    const int kr = lane & 15, qq = lane >> 4;
    for (int it = bid * NW + wv; it < B_ * 8 * 128; it += nb * NW) {
        const int c = it & 127, bh = it >> 7, b = bh >> 3, h = bh & 7;
        const u16* cd = p.cdat + ((size_t)bh * 128 + c) * 4 * 4096;
        f32x4 ys[4][4];
#pragma unroll
        for (int mt = 0; mt < 4; mt++)
#pragma unroll
            for (int nt = 0; nt < 4; nt++) ys[mt][nt] = unpack4(*(const uint2*)&cd[3 * 4096 + (nt * 16 + kr) * 64 + mt * 16 + qq * 4]);
        if (c > 0) {
            const u16* s0 = cd - 4 * 4096 + 1 * 4096;
#pragma unroll
            for (int ks = 0; ks < 2; ks++) {
                bf16x8 af[4], bq[4];
#pragma unroll
                for (int mt = 0; mt < 4; mt++) af[mt] = *(const bf16x8*)&s0[(mt * 16 + kr) * 64 + ks * 32 + qq * 8];
#pragma unroll
                for (int nt = 0; nt < 4; nt++) bq[nt] = *(const bf16x8*)&cd[2 * 4096 + (nt * 16 + kr) * 64 + ks * 32 + qq * 8];
#pragma unroll
                for (int mt = 0; mt < 4; mt++)
#pragma unroll
                    for (int nt = 0; nt < 4; nt++) ys[mt][nt] = __builtin_amdgcn_mfma_f32_16x16x32_bf16(af[mt], bq[nt], ys[mt][nt], 0, 0, 0);
            }
        }
#pragma unroll
        for (int nt = 0; nt < 4; nt++) {
            float s1 = 0.f, s2 = 0.f;
#pragma unroll
            for (int mt = 0; mt < 4; mt++)
#pragma unroll
                for (int r = 0; r < 4; r++) { s1 += ys[mt][nt][r]; s2 += ys[mt][nt][r] * ys[mt][nt][r]; }
            s1 = xrow_sum(s1); s2 = xrow_sum(s2);
            const float mean = s1 * (1.f / 64.f);
            const float var = fmaxf(s2 * (1.f / 64.f) - mean * mean, 0.f);
            const float rstd = rsqrtf(var + 64e-5f);
            const int t = nt * 16 + kr;
            const size_t n = (size_t)b * S_ + c * 64 + t;
            const float bon = p.bon[n * 8 + h];
#pragma unroll
            for (int mt = 0; mt < 4; mt++) {
                const int vch = h * 64 + mt * 16 + qq * 4;
                const f32x4 vcf = unpack4(*(const uint2*)&p.prw[n * CRW + 1024 + vch]);
                const f32x4 vpf = (c * 64 + t > 0) ? unpack4(*(const uint2*)&p.prw[(n - 1) * CRW + 1024 + vch]) : f32x4{0.f, 0.f, 0.f, 0.f};
                const f32x4 ggf = unpack4(*(const uint2*)&p.ob[n * 512 + vch]);
                const float4 lw = *(const float4*)&p.ln_w[vch], lb = *(const float4*)&p.ln_b[vch], mv = *(const float4*)&p.mu[1024 + vch];
                const float lwa[4] = {lw.x, lw.y, lw.z, lw.w}, lba[4] = {lb.x, lb.y, lb.z, lb.w}, mva[4] = {mv.x, mv.y, mv.z, mv.w};
                f32x4 o;
#pragma unroll
                for (int r = 0; r < 4; r++) {
                    const float vsh = vcf[r] + (vpf[r] - vcf[r]) * mva[r];
                    o[r] = ((ys[mt][nt][r] - mean) * rstd * lwa[r] + lba[r] + bon * vsh) * ggf[r];
                }
                *(uint2*)&p.ob[n * 512 + vch] = pack4(o);
            }
        }
    }
}

__device__ __forceinline__ void unpack8(const uint4& u, f32x4& a, f32x4& b) {
    a = f32x4{__uint_as_float(u.x << 16), __uint_as_float(u.x & 0xFFFF0000u), __uint_as_float(u.y << 16), __uint_as_float(u.y & 0xFFFF0000u)};
    b = f32x4{__uint_as_float(u.z << 16), __uint_as_float(u.z & 0xFFFF0000u), __uint_as_float(u.w << 16), __uint_as_float(u.w & 0xFFFF0000u)};
}
struct EpiMerge {
    u16* merged; u16* tmp2; int pass;
    __device__ __forceinline__ void operator()(const f32x4 (&acc)[2][2][4][2], const GUnit& u, int, int, int, int) const {
        const int t2_ = get_tid(), wid_ = __builtin_amdgcn_readfirstlane(t2_ >> 6), wr = wid_ >> 2, wc = wid_ & 3, fr = t2_ & 15, fq = (t2_ >> 4) & 3;
        const int row0 = u.pm * 256 + wr * 64 + fr, col0 = u.pn * 256 + wc * 32 + 8 * fq;
#pragma unroll
        for (int ai = 0; ai < 2; ++ai)
#pragma unroll
            for (int m = 0; m < 4; ++m) {
                const size_t off = (size_t)(row0 + ai * 128 + m * 16) * D_ + col0;
                uint4 m1[2], m2[2];
                if (pass == 1 || pass == 3) {
#pragma unroll
                    for (int bj = 0; bj < 2; ++bj) { m1[bj] = *(const uint4*)&merged[off + bj * 128]; if (pass == 3) m2[bj] = *(const uint4*)&tmp2[off + bj * 128]; }
                }
#pragma unroll
                for (int bj = 0; bj < 2; ++bj) {
                    f32x4 v0 = acc[ai][bj][m][0], v1 = acc[ai][bj][m][1];
                    if (pass == 1) { f32x4 a0, a1; unpack8(m1[bj], a0, a1);
#pragma unroll
                        for (int r = 0; r < 4; r++) { v0[r] = a0[r] * sigmoidf_(v0[r]); v1[r] = a1[r] * sigmoidf_(v1[r]); } }
                    if (pass == 3) { f32x4 a0, a1, b0, b1; unpack8(m1[bj], a0, a1); unpack8(m2[bj], b0, b1);
#pragma unroll
                        for (int r = 0; r < 4; r++) { v0[r] = a0[r] + b0[r] * sigmoidf_(v0[r]); v1[r] = a1[r] + b1[r] * sigmoidf_(v1[r]); } }
                    *(uint4*)&((pass == 2) ? tmp2 : merged)[off + bj * 128] = pack8(v0, v1);
                }
                asm volatile("" ::: "memory");
            }
    }
};
__device__ void ph_merge(const P& p, int bid, int nb, char* smem) {
    u16* tmp2 = (u16*)p.x1;
#pragma unroll 1
    for (int pass = 0; pass < 4; ++pass) {
        const int K = (pass & 1) ? D_ : 512;
        const u16* A = (pass & 1) ? p.hbuf : (pass == 0 ? p.oa : p.ob);
        const u16* Bt = (pass == 0) ? p.wpaT : (pass == 1 ? p.wgT : (pass == 2 ? p.wpbT : p.wgT + (size_t)1024 * D_));
        DenseSched S; S.init(NTOK, D_, K, Bt, nb, bid);
        EpiMerge E{p.merged, tmp2, pass};
        gemm256(smem, (const char*)A, K, S, E);
    }
}

struct EpiOutproj {
    const float* x; float* x1;
    __device__ __forceinline__ void operator()(const f32x4 (&acc)[2][2][4][2], const GUnit& u, int, int, int, int) const {
        const int t2_ = get_tid(), wid_ = __builtin_amdgcn_readfirstlane(t2_ >> 6), wr = wid_ >> 2, wc = wid_ & 3, fr = t2_ & 15, fq = (t2_ >> 4) & 3;
        const int row0 = u.pm * 256 + wr * 64 + fr, col0 = u.pn * 256 + wc * 32 + 4 * fq;
#pragma unroll
        for (int ai = 0; ai < 2; ++ai)
#pragma unroll
            for (int m = 0; m < 4; ++m) {
                const size_t off = (size_t)(row0 + ai * 128 + m * 16) * D_ + col0;
                f32x4 xin[2][2];
#pragma unroll
                for (int bj = 0; bj < 2; ++bj)
#pragma unroll
                    for (int n = 0; n < 2; ++n) xin[bj][n] = *(const f32x4*)&x[off + bj * 128 + n * 16];
#pragma unroll
                for (int bj = 0; bj < 2; ++bj)
#pragma unroll
                    for (int n = 0; n < 2; ++n) *(f32x4*)&x1[off + bj * 128 + n * 16] = xin[bj][n] + acc[ai][bj][m][n];
                asm volatile("" ::: "memory");
            }
    }
};
__device__ void ph_outproj(const P& p, int bid, int nb, char* smem) {
    DenseSched S; S.init(NTOK, D_, D_, p.woutT, nb, bid);
    EpiOutproj E{p.x, p.x1};
    gemm256(smem, (const char*)p.merged, D_, S, E);
}

__device__ __forceinline__ float red8f(float x) {
    x += dppf<0xB1>(x);
    x += dppf<0x4E>(x);
    x += dppf<0x141>(x);
    return x;
}
__device__ void ph_route(const P& p, int bid, int nb, char* smem) {
    float* wr = (float*)smem;
    const int tid = get_tid(), lane = tid & 63, wv = tid >> 6;
    {
        u16* Tl = (u16*)smem;
        const int t = get_tid();
        const int lrow = t >> 3, lc8 = (t & 7) * 8;
        const int sslot = t >> 3, skc = t & 7;
        const int scol = (sslot & 32) + perm32(sslot & 31);
        constexpr int NT13 = NEXP * 2 * 4 * 16, NT2 = NEXP * 16 * 4;
        for (int tile = bid; tile < NT13 + NT2; tile += nb) {
            const float* src; u16* dst; int N, Kd;
            if (tile < NT13) {
                const int kt = tile & 15, sg = (tile >> 4) & 3, half = (tile >> 6) & 1, e = tile >> 7;
                const int sl0 = sg * 64;
                N = 256; Kd = D_;
                src = ((sl0 >> 7) ? p.e_w3 : p.e_w1) + (size_t)e * D_ * 256 + (size_t)(kt * 64) * 256 + half * 128 + (sl0 & 127);
                dst = p.ew1T + ((size_t)e * 512 + half * 256 + sl0) * D_ + kt * 64;
            } else {
                const int t2 = tile - NT13;
                const int kt = t2 & 3, sg = (t2 >> 2) & 15, e = t2 >> 6;
                N = D_; Kd = 256;
                src = p.e_w2 + (size_t)e * 256 * D_ + (size_t)(kt * 64) * D_ + sg * 64;
                dst = p.ew2T + ((size_t)e * D_ + sg * 64) * 256 + kt * 64;
            }
            const float4 f0 = *(const float4*)&src[(size_t)lrow * N + lc8], f1 = *(const float4*)&src[(size_t)lrow * N + lc8 + 4];
            __syncthreads();
            const unsigned h0 = pack2(f0.x, f0.y), h1 = pack2(f0.z, f0.w), h2 = pack2(f1.x, f1.y), h3 = pack2(f1.z, f1.w);
            Tl[(lc8 + 0) * 72 + lrow] = (u16)(h0 & 0xFFFFu); Tl[(lc8 + 1) * 72 + lrow] = (u16)(h0 >> 16);
            Tl[(lc8 + 2) * 72 + lrow] = (u16)(h1 & 0xFFFFu); Tl[(lc8 + 3) * 72 + lrow] = (u16)(h1 >> 16);
            Tl[(lc8 + 4) * 72 + lrow] = (u16)(h2 & 0xFFFFu); Tl[(lc8 + 5) * 72 + lrow] = (u16)(h2 >> 16);
            Tl[(lc8 + 6) * 72 + lrow] = (u16)(h3 & 0xFFFFu); Tl[(lc8 + 7) * 72 + lrow] = (u16)(h3 >> 16);
            __syncthreads();
            *(uint4*)&dst[(size_t)sslot * Kd + skc * 8] = *(const uint4*)&Tl[scol * 72 + skc * 8];
        }
        __syncthreads();
    }
    for (int i = tid; i < 1024 * 36; i += NT) {
        const int k = i / 36, j = i - k * 36;
        const int kp = (k & ~31) + ((k & 3) << 3) + ((k >> 2) & 7);
        wr[kp * 36 + j] = (j < 4) ? p.w_grp[k * 4 + j] : p.w_exp[k * 32 + (j - 4)];
    }
    int* lcount = (int*)(smem + 1024 * 36 * 4);
    if (tid < 32) lcount[tid] = 0;
    __syncthreads();
    const int sub = lane & 7, tk = lane >> 3;
    for (int n0 = (bid * NW + wv) * 16; n0 < NTOK; n0 += nb * NW * 16) {
        float acc[2][36]; float ss[2] = {0.f, 0.f};
#pragma unroll
        for (int t = 0; t < 2; t++)
#pragma unroll
            for (int j = 0; j < 36; j++) acc[t][j] = 0.f;
#pragma unroll 1
        for (int i0 = 0; i0 < 32; i0 += 4) {
            float4 xv[2][4];
#pragma unroll
            for (int t = 0; t < 2; t++)
#pragma unroll
                for (int i = 0; i < 4; i++) xv[t][i] = *(const float4*)&p.x1[(size_t)(n0 + 8 * t + tk) * D_ + (i0 + i) * 32 + sub * 4];
#pragma unroll
            for (int i = 0; i < 4; i++) {
                const int k0 = (i0 + i) * 32 + sub * 4;
                const float4 gf = *(const float4*)&p.g_ffn[k0];
                float hv[2][4];
#pragma unroll
                for (int t = 0; t < 2; t++) {
                    const float4 x = xv[t][i];
                    ss[t] += x.x * x.x + x.y * x.y + x.z * x.z + x.w * x.w;
                    hv[t][0] = x.x * gf.x; hv[t][1] = x.y * gf.y; hv[t][2] = x.z * gf.z; hv[t][3] = x.w * gf.w;
                    uint2 o; o.x = pack2(hv[t][0], hv[t][1]); o.y = pack2(hv[t][2], hv[t][3]);
                    *(uint2*)&p.hbuf[(size_t)(n0 + 8 * t + tk) * D_ + k0] = o;
                }
#pragma unroll
                for (int e2 = 0; e2 < 4; e2++) {
                    asm volatile("" ::: "memory");
                    const float* wrow = wr + ((i0 + i) * 32 + e2 * 8 + sub) * 36;
#pragma unroll
                    for (int j4 = 0; j4 < 9; j4++) {
                        const float4 wv4 = *(const float4*)&wrow[j4 * 4];
#pragma unroll
                        for (int t = 0; t < 2; t++) {
                            acc[t][j4 * 4 + 0] += hv[t][e2] * wv4.x; acc[t][j4 * 4 + 1] += hv[t][e2] * wv4.y;
                            acc[t][j4 * 4 + 2] += hv[t][e2] * wv4.z; acc[t][j4 * 4 + 3] += hv[t][e2] * wv4.w;
                        }
                    }
                }
            }
        }
#pragma unroll
        for (int t = 0; t < 2; t++) {
            const size_t n = (size_t)n0 + 8 * t + tk;
            const float sst = red8f(ss[t]);
#pragma unroll
            for (int j = 0; j < 36; j++) acc[t][j] = red8f(acc[t][j]);
            const float rs = rsqrtf(sst * (1.f / D_) + 1e-6f);
            if (sub == 0) {
                p.rsb[n] = rs;
                float gl[4]; int gs = 0;
#pragma unroll
                for (int j = 0; j < 4; j++) gl[j] = acc[t][j] * rs + p.b_grp[j];
                float gm = gl[0];
#pragma unroll
                for (int j = 1; j < 4; j++) if (gl[j] > gm) { gm = gl[j]; gs = j; }
                float gsum = 0.f;
#pragma unroll
                for (int j = 0; j < 4; j++) gsum += __expf(gl[j] - gm);
                const float pg = 1.f / gsum;
                float el[8]; float em = -3.0e38f;
#pragma unroll
                for (int j = 0; j < 8; j++) {
                    float a = (gs == 0) ? acc[t][4 + j] : ((gs == 1) ? acc[t][12 + j] : ((gs == 2) ? acc[t][20 + j] : acc[t][28 + j]));
                    a = a * rs + p.b_exp[gs * 8 + j];
                    el[j] = a; em = fmaxf(em, a);
                }
                int j0 = 0, j1 = -1; float v0 = -3.0e38f, v1 = -3.0e38f;
#pragma unroll
                for (int j = 0; j < 8; j++) { el[j] = __expf(el[j] - em); }
#pragma unroll
                for (int j = 0; j < 8; j++) { if (el[j] > v0) { v0 = el[j]; j0 = j; } }
#pragma unroll
                for (int j = 0; j < 8; j++) { if (j != j0 && el[j] > v1) { v1 = el[j]; j1 = j; } }
                const float den = v0 + v1;
                const int e0 = gs * 8 + j0, e1 = gs * 8 + j1;
                p.tok_e[n * 2] = e0; p.tok_e[n * 2 + 1] = e1;
                p.tok_gate[n * 2] = pg * v0 / den; p.tok_gate[n * 2 + 1] = pg * v1 / den;
                atomicAdd(&lcount[e0], 1); atomicAdd(&lcount[e1], 1);
            }
        }
    }
    __syncthreads();
    { const int t2 = get_tid(); if (t2 < 32) { const int c = lcount[t2]; if (c) atomicAdd(&p.counts[t2], c); } }
}

__device__ void ph_scatter(const P& p, int bid, int nb, char* smem) {
    int* offl = (int*)smem;
    int* hist = offl + 64;
    int* gbase = hist + 32;
    const int tid = get_tid();
    if (tid == 0) {
        int off = 0;
        for (int e = 0; e < NEXP; e++) { offl[e] = off; off += p.counts[e]; }
        offl[NEXP] = off;
    }
    if (bid == 0 && tid == 64) {
        int off = 0, nb_ = 0;
        for (int e = 0; e < NEXP; e++) {
            const int c = p.counts[e];
            p.offs[e] = off;
            for (int r = 0; r < c; r += 256) { p.blk_e[nb_] = e; p.blk_r0[nb_] = off + r; nb_++; }
            off += c;
        }
        p.offs[NEXP] = off;
        *p.nblk = nb_;
    }
    for (int base = bid * NT; base < NTOK * 2; base += nb * NT) {
        __syncthreads();
        if (tid < 32) hist[tid] = 0;
        __syncthreads();
        const int i = base + tid;
        const int e = p.tok_e[i];
        const int rl = atomicAdd(&hist[e], 1);
        __syncthreads();
        if (tid < 32) gbase[tid] = atomicAdd(&p.cursor[tid], hist[tid]);
        __syncthreads();
        const int slot = offl[e] + gbase[e] + rl;
        p.list_tok[slot] = i >> 1; p.list_gate[slot] = p.tok_gate[i]; p.tokslot[i] = slot;
    }
}
template <int CTS>
struct MoeSched {
    const P* pp; int nunits, G, c; unsigned rowbytes; const u16* Bt; size_t b_estride, b_tstride;
    bool gather;
    __device__ __forceinline__ bool next(int i, GUnit& u) const {
        const int L = i * G + c; if (L >= nunits) return false;
        int wgid = L; { const int q = nunits >> 3, r = nunits & 7, xcd = wgid & 7, off = wgid >> 3; wgid = (xcd < r ? xcd * (q + 1) : r * (q + 1) + (xcd - r) * q) + off; }
        u.pm = wgid / CTS; u.pn = wgid & (CTS - 1); return true;
    }
    __device__ __forceinline__ unsigned a_off(const GUnit& u, int h, int R) const {
        const P& p = *pp;
        const int e = __builtin_amdgcn_readfirstlane(p.blk_e[u.pm]), rend = __builtin_amdgcn_readfirstlane(p.offs[e + 1]);
        int sl = __builtin_amdgcn_readfirstlane(p.blk_r0[u.pm]) + h * 128 + R; if (sl >= rend) sl = rend - 1;
        return (unsigned)(gather ? p.list_tok[sl] : sl) * rowbytes;
    }
    __device__ __forceinline__ const char* b_ptr(const GUnit& u) const { return (const char*)(Bt + (size_t)__builtin_amdgcn_readfirstlane(pp->blk_e[u.pm]) * b_estride + (size_t)u.pn * b_tstride); }
};
struct EpiMoe1 {
    const P* pp;
    __device__ __forceinline__ void operator()(const f32x4 (&acc)[2][2][4][2], const GUnit& u, int, int, int, int) const {
        const int t2_ = get_tid(), wid_ = __builtin_amdgcn_readfirstlane(t2_ >> 6), wr = wid_ >> 2, wc = wid_ & 3, fr = t2_ & 15, fq = (t2_ >> 4) & 3;
        const P& p = *pp;
        const int e = __builtin_amdgcn_readfirstlane(p.blk_e[u.pm]), r0 = __builtin_amdgcn_readfirstlane(p.blk_r0[u.pm]), rend = __builtin_amdgcn_readfirstlane(p.offs[e + 1]);
#pragma unroll
        for (int ai = 0; ai < 2; ++ai)
#pragma unroll
            for (int m = 0; m < 4; ++m) {
                const int sl = r0 + ai * 128 + wr * 64 + m * 16 + fr;
                if (sl < rend) {
                    const float rs = p.rsb[p.list_tok[sl]];
                    f32x4 v[2];
#pragma unroll
                    for (int n = 0; n < 2; ++n)
#pragma unroll
                        for (int r = 0; r < 4; r++) { const float a = acc[ai][0][m][n][r] * rs; v[n][r] = a * sigmoidf_(a) * (acc[ai][1][m][n][r] * rs); }
                    *(uint4*)&p.hid[(size_t)sl * 256 + u.pn * 128 + wc * 32 + 8 * fq] = pack8(v[0], v[1]);
                }
            }
    }
};
__device__ void ph_moe1(const P& p, int bid, int nb, char* smem) {
    MoeSched<2> S{&p, __builtin_amdgcn_readfirstlane(*p.nblk) * 2, nb, bid, (unsigned)(D_ * 2), p.ew1T, (size_t)512 * D_, (size_t)256 * D_, true};
    EpiMoe1 E{&p};
    gemm256(smem, (const char*)p.hbuf, D_, S, E);
}
struct EpiMoe2 {
    const P* pp;
    __device__ __forceinline__ void operator()(const f32x4 (&acc)[2][2][4][2], const GUnit& u, int, int, int, int) const {
        const int t2_ = get_tid(), wid_ = __builtin_amdgcn_readfirstlane(t2_ >> 6), wr = wid_ >> 2, wc = wid_ & 3, fr = t2_ & 15, fq = (t2_ >> 4) & 3;
        const P& p = *pp;
        const int e = __builtin_amdgcn_readfirstlane(p.blk_e[u.pm]), r0 = __builtin_amdgcn_readfirstlane(p.blk_r0[u.pm]), rend = __builtin_amdgcn_readfirstlane(p.offs[e + 1]);
#pragma unroll
        for (int ai = 0; ai < 2; ++ai)
#pragma unroll
            for (int m = 0; m < 4; ++m) {
                const int sl = r0 + ai * 128 + wr * 64 + m * 16 + fr;
                if (sl < rend) {
                    const float gt = p.list_gate[sl];
                    u16* yp = p.ybuf + (size_t)sl * D_ + u.pn * 256 + wc * 32 + 8 * fq;
#pragma unroll
                    for (int bj = 0; bj < 2; ++bj) *(uint4*)&yp[bj * 128] = pack8(acc[ai][bj][m][0] * gt, acc[ai][bj][m][1] * gt);
                }
            }
    }
};
__device__ void ph_moe2(const P& p, int bid, int nb, char* smem) {
    MoeSched<4> S{&p, __builtin_amdgcn_readfirstlane(*p.nblk) * 4, nb, bid, 512u, p.ew2T, (size_t)D_ * 256, (size_t)256 * 256, false};
    EpiMoe2 E{&p};
    gemm256(smem, (const char*)p.hid, 256, S, E);
}
__device__ void ph_final(const P& p, int bid, int nb, char* smem) {
    const int tid = get_tid(), lane = tid & 63, wv = tid >> 6;
    for (int row = bid * NW + wv; row < NTOK; row += nb * NW) {
        const int s0 = p.tokslot[row * 2], s1 = p.tokslot[row * 2 + 1];
        float v[16]; float ss = 0.f;
#pragma unroll
        for (int i = 0; i < 4; i++) {
            const int c = i * 256 + lane * 4;
            const float4 t = *(const float4*)&p.x1[(size_t)row * D_ + c];
            const uint2 a = *(const uint2*)&p.ybuf[(size_t)s0 * D_ + c];
            const uint2 bq = *(const uint2*)&p.ybuf[(size_t)s1 * D_ + c];
            v[4 * i]     = t.x + __uint_as_float(a.x << 16) + __uint_as_float(bq.x << 16);
            v[4 * i + 1] = t.y + __uint_as_float(a.x & 0xFFFF0000u) + __uint_as_float(bq.x & 0xFFFF0000u);
            v[4 * i + 2] = t.z + __uint_as_float(a.y << 16) + __uint_as_float(bq.y << 16);
            v[4 * i + 3] = t.w + __uint_as_float(a.y & 0xFFFF0000u) + __uint_as_float(bq.y & 0xFFFF0000u);
            ss += v[4 * i] * v[4 * i] + v[4 * i + 1] * v[4 * i + 1] + v[4 * i + 2] * v[4 * i + 2] + v[4 * i + 3] * v[4 * i + 3];
        }
        ss = wave_sum(ss);
        const float rs = rsqrtf(ss * (1.f / D_) + 1e-6f);
#pragma unroll
        for (int i = 0; i < 4; i++) {
            const int c = i * 256 + lane * 4;
            const float4 g = *(const float4*)&p.g_final[c];
            float4 o; o.x = v[4 * i] * rs * g.x; o.y = v[4 * i + 1] * rs * g.y; o.z = v[4 * i + 2] * rs * g.z; o.w = v[4 * i + 3] * rs * g.w;
            *(float4*)&p.out[(size_t)row * D_ + c] = o;
        }
    }
}

#define XB_TMO      128
#define XB_XCNT(j)  (256  + 64 * (j))
#define XB_XSUB(j)  (1280 + 64 * (j))
#define XB_XGEN(j)  (2304 + 64 * (j))
#define XB_TOP      3328
#define XB_TOPGEN   3392
#define XCD_BAR_WORDS 3456
#define XB_SPIN_CAP (1u << 18)
#define LAS __attribute__((address_space(3)))

__device__ __forceinline__ unsigned xb_ld(unsigned* p)              { return __hip_atomic_load(p, __ATOMIC_RELAXED, __HIP_MEMORY_SCOPE_AGENT); }
__device__ __forceinline__ unsigned xb_add(unsigned* p, unsigned v) { return __hip_atomic_fetch_add(p, v, __ATOMIC_RELAXED, __HIP_MEMORY_SCOPE_AGENT); }
__device__ __forceinline__ unsigned xb_xcc_id() { return (unsigned)__builtin_amdgcn_s_getreg((3 << 11) | 20) & 0xFu; }
#define XB_SPIN(cond, bar) do { unsigned _sp = 0; while (cond) { __builtin_amdgcn_s_sleep(1); \
    if ((++_sp & 255u) == 0u) { if (xb_ld(&(bar)[XB_TMO])) break; if (_sp > XB_SPIN_CAP) { atomicAdd(&(bar)[XB_TMO], 1u); break; } } } } while (0)

struct XcdBarrier {
    unsigned* bar; unsigned x;
    volatile LAS unsigned* st;
};

__device__ __forceinline__ XcdBarrier xcd_barrier_post(unsigned* bar, volatile LAS unsigned* st) {
    XcdBarrier b; b.bar = bar; b.x = xb_xcc_id(); b.st = st;
    if (threadIdx.x == 0) (void)xb_add(&bar[XB_XCNT(b.x)], 1u);
    return b;
}
__device__ __forceinline__ void xcd_barrier_complete(unsigned* bar, unsigned x, unsigned& nloc, unsigned& nx) {
    const unsigned G = gridDim.x * gridDim.y * gridDim.z;
    unsigned sum, cnt, mine, sp = 0u;
    for (;;) {
        sum = 0u; cnt = 0u; mine = 0u;
#pragma unroll
        for (unsigned j = 0; j < 16; ++j) { const unsigned c = xb_ld(&bar[XB_XCNT(j)]); sum += c; cnt += (c > 0u) ? 1u : 0u; mine = (j == x) ? c : mine; }
        if (sum == G) break;
        __builtin_amdgcn_s_sleep(1);
        if ((++sp & 255u) == 0u) { if (xb_ld(&bar[XB_TMO])) break; if (sp > XB_SPIN_CAP) { atomicAdd(&bar[XB_TMO], 1u); break; } }
    }
    nloc = mine > 0u ? mine : 1u; nx = cnt > 0u ? cnt : 1u;
}

__device__ __forceinline__ void xcd_barrier(const XcdBarrier& b) {
    asm volatile("s_waitcnt vmcnt(0)" ::: "memory");
    __syncthreads();
    if (threadIdx.x == 0) {
        unsigned* bar = b.bar;
        __builtin_amdgcn_s_waitcnt(0);
        unsigned nloc = b.st[0], nx = b.st[1];
        if (nloc == 0u) { xcd_barrier_complete(bar, b.x, nloc, nx); b.st[0] = nloc; b.st[1] = nx; }
        const unsigned old = xb_add(&bar[XB_XSUB(b.x)], 1u);
        const unsigned gen = old / nloc;
        if (old + 1u == (gen + 1u) * nloc) {
            __builtin_amdgcn_fence(__ATOMIC_RELEASE, "agent");
            asm volatile("s_waitcnt vmcnt(0)" ::: "memory");
            const unsigned og = xb_add(&bar[XB_TOP], 1u);
            const unsigned tg = og / nx;
            if (og + 1u == (tg + 1u) * nx) xb_add(&bar[XB_TOPGEN], 1u);
            else XB_SPIN(xb_ld(&bar[XB_TOPGEN]) == tg, bar);
            __builtin_amdgcn_fence(__ATOMIC_ACQUIRE, "agent");
            xb_add(&bar[XB_XGEN(b.x)], 1u);
            asm volatile("s_waitcnt vmcnt(0)" ::: "memory");
        } else {
            XB_SPIN(xb_ld(&bar[XB_XGEN(b.x)]) == gen, bar);
            __builtin_amdgcn_fence(__ATOMIC_ACQUIRE, "agent");
            asm volatile("s_waitcnt vmcnt(0)" ::: "memory");
        }
    }
    __syncthreads();
}

template <int PH>
__device__ __forceinline__ void run_phase(const P& p, int bid, int nb, char* smem) {
    if constexpr (PH == 0) ph_prologue(p, bid, nb, smem);
    if constexpr (PH == 1) ph_inproj(p, bid, nb, smem);
    if constexpr (PH == 2) { ph_compress(p, bid, nb, smem); __syncthreads(); ph_rwkv_chunk(p, bid, nb, smem); }
    if constexpr (PH == 3) {
        if (bid < SCAN_BLOCKS) ph_rwkv_seq(p, bid, SCAN_BLOCKS, smem);
        else ph_nsa(p, bid - SCAN_BLOCKS, nb - SCAN_BLOCKS, smem);
    }
    if constexpr (PH == 12) ph_rwkv_out(p, bid, nb, smem);
    if constexpr (PH == 4) ph_merge(p, bid, nb, smem);
    if constexpr (PH == 5) ph_outproj(p, bid, nb, smem);
    if constexpr (PH == 6) ph_route(p, bid, nb, smem);
    if constexpr (PH == 7) ph_scatter(p, bid, nb, smem);
    if constexpr (PH == 9) ph_moe1(p, bid, nb, smem);
    if constexpr (PH == 10) ph_moe2(p, bid, nb, smem);
    if constexpr (PH == 11) ph_final(p, bid, nb, smem);
}

template <int PH>
__global__ void __launch_bounds__(NT) kph(P p) {
    extern __shared__ __attribute__((aligned(16))) char smem[];
    run_phase<PH>(p, blockIdx.x, gridDim.x, smem);
}

__global__ void __launch_bounds__(NT, 2) mega(P p) {
    extern __shared__ __attribute__((aligned(16))) char smem[];
    volatile LAS unsigned* st = (volatile LAS unsigned*)(smem + SMEM_BYTES - 16);
    if (threadIdx.x == 0) { st[0] = 0u; st[1] = 0u; st[2] = 0u; st[3] = 0u; }
    __syncthreads();
    XcdBarrier bar = xcd_barrier_post(p.bar, st);
    const int bid = blockIdx.x, nb = gridDim.x;
#define RUNP(N, BAR) { unsigned long long t0_ = 0; if ((TPROBE >> N) & 1) t0_ = __builtin_amdgcn_s_memrealtime(); run_phase<N>(p, bid, nb, smem); \
        unsigned long long tw_ = 0; if (((TPROBE >> N) & 1) && TPSEL) tw_ = __builtin_amdgcn_s_memrealtime() - t0_; if (BAR) xcd_barrier(bar); \
        if ((TPROBE >> N) & 1) { const unsigned long long t1_ = __builtin_amdgcn_s_memrealtime(); const unsigned long long dt_ = TPSEL ? tw_ : t1_ - t0_; \
            if (!TPSEL || (TPSEL == 1 ? (bid < SCAN_BLOCKS) : (bid >= SCAN_BLOCKS))) while (__builtin_amdgcn_s_memrealtime() - t1_ < dt_) __builtin_amdgcn_s_sleep(8); if (TPSEL) xcd_barrier(bar); } }
    RUNP(0, 1) RUNP(1, 1) RUNP(2, 1) RUNP(3, 1) RUNP(12, 1) RUNP(4, 1) RUNP(5, 1) RUNP(6, 1) RUNP(7, 1) RUNP(9, 1) RUNP(10, 1) RUNP(11, 0)
}

extern "C" void kernel_launch(void* const* d_in, const int* in_sizes, int n_in,
                              void* d_out, int out_size, void* d_ws, size_t ws_size,
                              hipStream_t stream) {
    P p{};
    p.x = (const float*)d_in[0]; p.pos = (const int*)d_in[1]; p.g_mix = (const float*)d_in[2]; p.w_in = (const float*)d_in[3];
    p.pe_k = (const float*)d_in[4]; p.w1_k = (const float*)d_in[5]; p.b1_k = (const float*)d_in[6]; p.w2_k = (const float*)d_in[7]; p.b2_k = (const float*)d_in[8];
    p.pe_v = (const float*)d_in[9]; p.w1_v = (const float*)d_in[10]; p.b1_v = (const float*)d_in[11]; p.w2_v = (const float*)d_in[12]; p.b2_v = (const float*)d_in[13];
    p.mu = (const float*)d_in[14]; p.w0 = (const float*)d_in[15]; p.w2 = (const float*)d_in[16]; p.a0 = (const float*)d_in[17]; p.a2 = (const float*)d_in[18];
    p.g2 = (const float*)d_in[19]; p.k_k = (const float*)d_in[20]; p.k_a = (const float*)d_in[21]; p.r_k = (const float*)d_in[22]; p.ln_w = (const float*)d_in[23]; p.ln_b = (const float*)d_in[24];
    p.wpa = (const float*)d_in[25]; p.wpb = (const float*)d_in[26]; p.wout = (const float*)d_in[27]; p.g_ffn = (const float*)d_in[28];
    p.w_grp = (const float*)d_in[29]; p.b_grp = (const float*)d_in[30]; p.w_exp = (const float*)d_in[31]; p.b_exp = (const float*)d_in[32];
    p.e_w1 = (const float*)d_in[33]; p.e_w3 = (const float*)d_in[34]; p.e_w2 = (const float*)d_in[35]; p.g_final = (const float*)d_in[36];
    p.out = (float*)d_out;
    char* ws = (char*)d_ws;
    const size_t MiB = 1ull << 20;
    p.hbuf = (u16*)(ws + 0 * MiB);
    p.q    = (u16*)(ws + 64 * MiB);
    p.kc   = (u16*)(ws + 96 * MiB);  p.vc   = (u16*)(ws + 104 * MiB);
    p.ksl  = (u16*)(ws + 112 * MiB); p.vslT = (u16*)(ws + 120 * MiB);
    p.kwn  = (u16*)(ws + 128 * MiB); p.vwnT = (u16*)(ws + 136 * MiB);
    p.nsag = (float*)(ws + 144 * MiB);
    p.kcb  = (u16*)(ws + 148 * MiB); p.vcT  = (u16*)(ws + 149 * MiB);
    p.prw  = (u16*)(ws + 160 * MiB);
    p.cdat = (u16*)(ws + 272 * MiB);
    p.bon  = (float*)(ws + 150 * MiB);
    p.w2T  = (u16*)(ws + 151 * MiB); p.a2T = p.w2T + 512 * 64; p.g2T = p.a2T + 512 * 64;
    p.cw1Tk = (u16*)(ws + 152 * MiB); p.cw1Tv = (u16*)(ws + 153 * MiB);
    p.cw2Tk = (u16*)(ws + 154 * MiB); p.cw2Tv = p.cw2Tk + 128 * 256;
    p.chid = (u16*)(ws + 155 * MiB);
    p.xact = (u16*)(ws + 488 * MiB);
    p.oa   = (u16*)(ws + 400 * MiB);
    p.ob   = (u16*)(ws + 432 * MiB);
    p.merged = (u16*)(ws + 64 * MiB);
    p.x1   = (float*)(ws + 160 * MiB);
    char* rt = ws + 288 * MiB;
    p.tok_e = (int*)(rt);                        rt += NTOK * 2 * 4;
    p.tok_gate = (float*)(rt);                   rt += NTOK * 2 * 4;
    p.tokslot = (int*)(rt);                      rt += NTOK * 2 * 4;
    p.list_tok = (int*)(rt);                     rt += NTOK * 2 * 4;
    p.list_gate = (float*)(rt);                  rt += NTOK * 2 * 4;
    p.blk_e = (int*)(rt);                        rt += 2048 * 4;
    p.blk_r0 = (int*)(rt);                       rt += 2048 * 4;
    p.rsb = (float*)(rt);                        rt += NTOK * 4;
    p.hid  = (u16*)(ws + 296 * MiB);
    p.ybuf = (u16*)(ws + 336 * MiB);
    char* misc = ws + 470 * MiB;
    p.counts = (int*)(misc); p.cursor = (int*)(misc + 256); p.offs = (int*)(misc + 512); p.nblk = (int*)(misc + 1024); p.nsactr = (int*)(misc + 2048);
    p.bar = (unsigned*)(ws + 471 * MiB);
    p.cb1k = (float*)(misc + 65536); p.cb1v = p.cb1k + 256;
    {
        char* wa = ws + 472 * MiB;
        p.winT = (u16*)wa;  wa += (size_t)3328 * 1024 * 2;
        p.wgT  = (u16*)wa;  wa += (size_t)2048 * 1024 * 2;
        p.wpaT = (u16*)wa;  wa += (size_t)1024 * 512 * 2;
        p.wpbT = (u16*)wa;  wa += (size_t)1024 * 512 * 2;
        p.woutT = (u16*)wa; wa += (size_t)1024 * 1024 * 2;
        p.ew1T = (u16*)(ws + 64 * MiB);  p.ew3T = (u16*)(ws + 80 * MiB);  p.ew2T = (u16*)(ws + 96 * MiB);
    }
    if (ws_size < (size_t)505 * MiB) return;

#if MEGA
    {
        static int mgrid = 0;
        if (mgrid == 0) {
            int dev = 0, cus = 0, per_cu = 0;
            hipGetDevice(&dev);
            hipDeviceGetAttribute(&cus, hipDeviceAttributeMultiprocessorCount, dev);
            hipFuncSetAttribute((const void*)mega, hipFuncAttributeMaxDynamicSharedMemorySize, SMEM_BYTES);
            hipOccupancyMaxActiveBlocksPerMultiprocessor(&per_cu, (const void*)mega, NT, SMEM_BYTES);
            (void)hipGetLastError();
            mgrid = cus;
        }
        hipMemsetAsync(p.bar, 0, XCD_BAR_WORDS * sizeof(unsigned) + 512 * sizeof(float), stream);
        mega<<<mgrid, NT, SMEM_BYTES, stream>>>(p);
        return;
    }
#else
    const int grid = 512;
    hipMemsetAsync(p.bar, 0, XCD_BAR_WORDS * sizeof(unsigned) + 512 * sizeof(float), stream);
    hipFuncSetAttribute((const void*)kph<0>, hipFuncAttributeMaxDynamicSharedMemorySize, SMEM_BYTES);
    hipFuncSetAttribute((const void*)kph<1>, hipFuncAttributeMaxDynamicSharedMemorySize, SMEM_BYTES);
    hipFuncSetAttribute((const void*)kph<2>, hipFuncAttributeMaxDynamicSharedMemorySize, SMEM_BYTES);
    hipFuncSetAttribute((const void*)kph<3>, hipFuncAttributeMaxDynamicSharedMemorySize, SMEM_BYTES);
    hipFuncSetAttribute((const void*)kph<4>, hipFuncAttributeMaxDynamicSharedMemorySize, SMEM_BYTES);
    hipFuncSetAttribute((const void*)kph<5>, hipFuncAttributeMaxDynamicSharedMemorySize, SMEM_BYTES);
    hipFuncSetAttribute((const void*)kph<6>, hipFuncAttributeMaxDynamicSharedMemorySize, SMEM_BYTES);
    hipFuncSetAttribute((const void*)kph<7>, hipFuncAttributeMaxDynamicSharedMemorySize, SMEM_BYTES);
    hipFuncSetAttribute((const void*)kph<8>, hipFuncAttributeMaxDynamicSharedMemorySize, SMEM_BYTES);
    hipFuncSetAttribute((const void*)kph<9>, hipFuncAttributeMaxDynamicSharedMemorySize, SMEM_BYTES);
    hipFuncSetAttribute((const void*)kph<10>, hipFuncAttributeMaxDynamicSharedMemorySize, SMEM_BYTES);
    hipFuncSetAttribute((const void*)kph<11>, hipFuncAttributeMaxDynamicSharedMemorySize, SMEM_BYTES);
    kph<0><<<grid, NT, SMEM_BYTES, stream>>>(p);
    kph<1><<<grid, NT, SMEM_BYTES, stream>>>(p);
    kph<2><<<grid, NT, SMEM_BYTES, stream>>>(p);
    kph<3><<<grid, NT, SMEM_BYTES, stream>>>(p);
    kph<12><<<grid, NT, SMEM_BYTES, stream>>>(p);
    kph<4><<<grid, NT, SMEM_BYTES, stream>>>(p);
    kph<5><<<grid, NT, SMEM_BYTES, stream>>>(p);
    kph<6><<<grid, NT, SMEM_BYTES, stream>>>(p);
    kph<7><<<grid, NT, SMEM_BYTES, stream>>>(p);
    kph<8><<<grid, NT, SMEM_BYTES, stream>>>(p);
    kph<9><<<grid, NT, SMEM_BYTES, stream>>>(p);
    kph<10><<<grid, NT, SMEM_BYTES, stream>>>(p);
    kph<11><<<grid, NT, SMEM_BYTES, stream>>>(p);
#endif
}
```

```cpp
#include <hip/hip_runtime.h>
#include <stdint.h>

typedef unsigned short u16;
using bf16x8 = __attribute__((ext_vector_type(8))) short;
using f32x4  = __attribute__((ext_vector_type(4))) float;

#ifndef MEGA
#define MEGA 1
#endif

constexpr int B_ = 4, S_ = 8192, D_ = 1024, NTOK = B_ * S_;
constexpr int CIN = 5144;
constexpr int NCMP = 511;
constexpr int CRW = 1792;
constexpr int NEXP = 32;
constexpr int NT = 512;
constexpr int NW = NT / 64;
constexpr int SMEM_BYTES = 160 * 1024;
constexpr int SCAN_BLOCKS = 16;
#ifndef TPROBE
#define TPROBE 0
#define TPSEL 0
#endif
constexpr float QSCALE = 0.125f * 1.4426950408889634f;

struct P {
    const float* x; const int* pos; const float* g_mix; const float* w_in;
    const float *pe_k, *w1_k, *b1_k, *w2_k, *b2_k, *pe_v, *w1_v, *b1_v, *w2_v, *b2_v;
    const float *mu, *w0, *w2, *a0, *a2, *g2, *k_k, *k_a, *r_k, *ln_w, *ln_b;
    const float *wpa, *wpb, *wout, *g_ffn, *w_grp, *b_grp, *w_exp, *b_exp, *e_w1, *e_w3, *e_w2, *g_final;
    float* out;
    u16* hbuf; u16 *q, *kc, *vc, *ksl, *vslT, *kwn, *vwnT, *kcb, *vcT; float* nsag; u16* prw;
    u16* cdat; float* bon; u16 *w2T, *a2T, *g2T; u16 *oa, *ob; u16* merged; float* x1;
    int* tok_e; float* tok_gate; int* tokslot; int* list_tok; float* list_gate;
    int* counts; int* offs; int* cursor; int* blk_e; int* blk_r0; int* nblk; float* rsb; int* nsactr;
    u16* hid; u16* ybuf; unsigned* bar;
    u16 *winT, *wgT, *wpaT, *wpbT, *woutT, *ew1T, *ew3T, *ew2T;
    u16 *cw1Tk, *cw1Tv, *cw2Tk, *cw2Tv, *chid, *xact; float *cb1k, *cb1v;
};

typedef __bf16 bf16x2_t __attribute__((ext_vector_type(2)));
typedef float f32x2_t __attribute__((ext_vector_type(2)));
__device__ __forceinline__ unsigned pack2(float a, float b) {
    f32x2_t f = {a, b};
    return __builtin_bit_cast(unsigned, __builtin_convertvector(f, bf16x2_t));
}
__device__ __forceinline__ u16 f2bf(float f) { return (u16)(pack2(f, f) & 0xFFFFu); }
__device__ __forceinline__ float bf2f(u16 h) { return __uint_as_float(((unsigned)h) << 16); }
__device__ __forceinline__ float sigmoidf_(float x) { return __builtin_amdgcn_rcpf(1.f + __expf(-x)); }
__device__ __forceinline__ int get_tid() { int t = threadIdx.x; asm volatile("" : "+v"(t)); return t; }
__device__ __forceinline__ uint2 pack4(const f32x4& v) { uint2 o; o.x = pack2(v[0], v[1]); o.y = pack2(v[2], v[3]); return o; }
__device__ __forceinline__ f32x4 unpack4(uint2 u) { return f32x4{__uint_as_float(u.x << 16), __uint_as_float(u.x & 0xFFFF0000u), __uint_as_float(u.y << 16), __uint_as_float(u.y & 0xFFFF0000u)}; }
#define LDS_BARRIER() do { asm volatile("s_waitcnt lgkmcnt(0)" ::: "memory"); __builtin_amdgcn_s_barrier(); asm volatile("" ::: "memory"); } while (0)
__device__ __forceinline__ int opaque(int x) { asm volatile("" : "+v"(x)); return x; }
template <int CTRL>
__device__ __forceinline__ float dppf(float x) { return __int_as_float(__builtin_amdgcn_update_dpp(0, __float_as_int(x), CTRL, 0xF, 0xF, true)); }
__device__ __forceinline__ float wave_sum(float v) {
    v += dppf<0xB1>(v);
    v += dppf<0x4E>(v);
    v += dppf<0x141>(v);
    v += dppf<0x140>(v);
    const int vi = __float_as_int(v);
    return (__int_as_float(__builtin_amdgcn_readlane(vi, 0)) + __int_as_float(__builtin_amdgcn_readlane(vi, 16)))
         + (__int_as_float(__builtin_amdgcn_readlane(vi, 32)) + __int_as_float(__builtin_amdgcn_readlane(vi, 48)));
}

__device__ __forceinline__ float xrow_sum(float v) {
    auto r = __builtin_amdgcn_permlane16_swap(__float_as_uint(v), __float_as_uint(v), false, false);
    v = __uint_as_float(r[0]) + __uint_as_float(r[1]);
    auto r2 = __builtin_amdgcn_permlane32_swap(__float_as_uint(v), __float_as_uint(v), false, false);
    return __uint_as_float(r2[0]) + __uint_as_float(r2[1]);
}
__device__ __forceinline__ float xrow_max(float v) {
    auto r = __builtin_amdgcn_permlane16_swap(__float_as_uint(v), __float_as_uint(v), false, false);
    v = fmaxf(__uint_as_float(r[0]), __uint_as_float(r[1]));
    auto r2 = __builtin_amdgcn_permlane32_swap(__float_as_uint(v), __float_as_uint(v), false, false);
    return fmaxf(__uint_as_float(r2[0]), __uint_as_float(r2[1]));
}
__constant__ double ROPE_FREQ[32] = {
    1.00000000000000000000e+00, 7.49894209332455874417e-01, 5.62341325190349072827e-01, 4.21696503428582225581e-01,
    3.16227766016837941176e-01, 2.37137370566165517349e-01, 1.77827941003892292526e-01, 1.33352143216332402753e-01,
    1.00000000000000005551e-01, 7.49894209332455791150e-02, 5.62341325190349114460e-02, 4.21696503428582239459e-02,
    3.16227766016837913421e-02, 2.37137370566165538166e-02, 1.77827941003892292526e-02, 1.33352143216332406223e-02,
    1.00000000000000002082e-02, 7.49894209332455791150e-03, 5.62341325190349097113e-03, 4.21696503428582291501e-03,
    3.16227766016837939442e-03, 2.37137370566165538166e-03, 1.77827941003892275179e-03, 1.33352143216332406223e-03,
    1.00000000000000002082e-03, 7.49894209332455856203e-04, 5.62341325190349097113e-04, 4.21696503428582237290e-04,
    3.16227766016837939442e-04, 2.37137370566165538166e-04, 1.77827941003892269758e-04, 1.33352143216332395381e-04};

constexpr int G_ABYTES = 256 * 64 * 2, G_BBYTES = 128 * 64 * 2, G_TILE = G_ABYTES + G_BBYTES;
#define LAS3 __attribute__((address_space(3)))
#define GAS1 __attribute__((address_space(1)))
__device__ __forceinline__ void glds16(const u16* g, char* l) {
    __builtin_amdgcn_global_load_lds((const GAS1 unsigned*)g, (LAS3 unsigned*)l, 16, 0, 0);
}
template <bool TR = false, class ARow>
__device__ __forceinline__ void gemm_core(int K, ARow arow, const u16* __restrict__ BT, int ldb, f32x4 (&acc)[4][4], u16* sm) {
    char* base = (char*)sm;
    const int tid = get_tid(), lane = tid & 63, wv = tid >> 6;
    const int wm = wv >> 1, wn = wv & 1, kr = lane & 15, qq = lane >> 4;
    const int lr = tid >> 3, lk = ((tid & 7) ^ ((lr >> 1) & 7)) * 8;
    const u16* ap0 = arow(lr) + lk; const u16* ap1 = arow(lr + 64) + lk;
    const u16* ap2 = arow(lr + 128) + lk; const u16* ap3 = arow(lr + 192) + lk;
    const u16* bp0 = BT + (size_t)lr * ldb + lk; const u16* bp1 = BT + (size_t)(lr + 64) * ldb + lk;
#pragma unroll
    for (int mt = 0; mt < 4; mt++)
#pragma unroll
        for (int nt = 0; nt < 4; nt++) acc[mt][nt] = f32x4{0.f, 0.f, 0.f, 0.f};
    const int nk = K >> 6;
#define G_ISSUE(t, b) { char* d = base + (b) * G_TILE + tid * 16; const int ko = (t) * 64; \
        glds16(ap0 + ko, d); glds16(ap1 + ko, d + 8192); glds16(ap2 + ko, d + 16384); glds16(ap3 + ko, d + 24576); \
        glds16(bp0 + ko, d + G_ABYTES); glds16(bp1 + ko, d + G_ABYTES + 8192); }
    const int sw = kr >> 1;
    const int po0 = ((0 * 4 + qq) ^ sw) * 16, po1 = ((1 * 4 + qq) ^ sw) * 16;
    const int aoff = (wm * 64 + kr) * 128, boff = G_ABYTES + (wn * 64 + kr) * 128;
#define G_READ(FA, FB, b) { const char* Ab = base + (b) * G_TILE + aoff; const char* Bb = base + (b) * G_TILE + boff; \
        _Pragma("unroll") for (int mt = 0; mt < 4; mt++) { FA[0][mt] = *(const bf16x8*)(Ab + mt * 2048 + po0); FA[1][mt] = *(const bf16x8*)(Ab + mt * 2048 + po1); } \
        _Pragma("unroll") for (int nt = 0; nt < 4; nt++) { FB[0][nt] = *(const bf16x8*)(Bb + nt * 2048 + po0); FB[1][nt] = *(const bf16x8*)(Bb + nt * 2048 + po1); } }
#define G_MMA(FA, FB) { __builtin_amdgcn_s_setprio(1); \
        _Pragma("unroll") for (int ks = 0; ks < 2; ks++) \
            _Pragma("unroll") for (int nt = 0; nt < 4; nt++) \
                _Pragma("unroll") for (int mt = 0; mt < 4; mt++) \
                    acc[mt][nt] = TR ? __builtin_amdgcn_mfma_f32_16x16x32_bf16(FA[ks][mt], FB[ks][nt], acc[mt][nt], 0, 0, 0) \
                                     : __builtin_amdgcn_mfma_f32_16x16x32_bf16(FB[ks][nt], FA[ks][mt], acc[mt][nt], 0, 0, 0); \
        __builtin_amdgcn_s_setprio(0); }
    bf16x8 fa0[2][4], fb0[2][4], fa1[2][4], fb1[2][4];
    G_ISSUE(0, 0)
    if (nk > 1) G_ISSUE(1, 1)
    if (nk > 2) G_ISSUE(2, 2)
    if (nk > 2) asm volatile("s_waitcnt vmcnt(12)" ::: "memory");
    else if (nk > 1) asm volatile("s_waitcnt vmcnt(6)" ::: "memory");
    else asm volatile("s_waitcnt vmcnt(0)" ::: "memory");
    __builtin_amdgcn_s_barrier();
    G_READ(fa0, fb0, 0)
    int bnext = 1, bfree = 0;
#define G_STEP(FAC, FBC, FAN, FBN, kt) { \
        if ((kt) + 1 < nk) { \
            if ((kt) + 2 < nk) asm volatile("s_waitcnt vmcnt(6) lgkmcnt(0)" ::: "memory"); else asm volatile("s_waitcnt vmcnt(0) lgkmcnt(0)" ::: "memory"); \
            __builtin_amdgcn_s_barrier();                   \
            if ((kt) + 3 < nk) G_ISSUE((kt) + 3, bfree) \
            G_READ(FAN, FBN, bnext) \
        } \
        G_MMA(FAC, FBC) \
        bfree = bnext; bnext = (bnext == 2) ? 0 : bnext + 1; }
    for (int kt = 0; kt < nk; kt += 2) {
        G_STEP(fa0, fb0, fa1, fb1, kt)
        G_STEP(fa1, fb1, fa0, fb0, kt + 1)
    }
    __builtin_amdgcn_s_barrier();
#undef G_READ
#undef G_MMA
#undef G_STEP
#undef G_ISSUE
}

__device__ __forceinline__ int xcd_item(int bid, int nb, int k, int nitems) {
    if (nb & 7) return bid + k * nb;
    const int per = nb >> 3, chunk = (nitems + 7) >> 3;
    const int j = k * per + (bid >> 3);
    return (j < chunk) ? (bid & 7) * chunk + j : nitems;
}
struct GUnit { int pm, pn; };
constexpr int G8_HTB = 128 * 64 * 2;
__device__ __forceinline__ int g8_lds_byte(int r, int c) { const int st = (r >> 4) * 2 + (c >> 5), rr = r & 15, cc = c & 31, ob = rr * 64 + cc * 2; return st * 1024 + (ob ^ (((ob >> 9) & 1) << 5)); }
__device__ __forceinline__ void g8_stage_rc(int b, int& R, int& C) { const int st = b / 1024, sb = b % 1024, swz = sb ^ (((sb >> 9) & 1) << 5); R = (st >> 1) * 16 + swz / 64; C = (st & 1) * 32 + (swz % 64) / 2; }
__host__ __device__ __forceinline__ int perm32(int rho) { const int n = rho >> 4, i = rho & 15; return 8 * (i >> 2) + 4 * n + (i & 3); }

template <class Epi, class Sched>
__device__ __forceinline__ void gemm256(char* smem, const char* Ab, int K, const Sched& S, const Epi& E) {
    LAS3 unsigned char* lds = (LAS3 unsigned char*)smem;
    const int tid = get_tid(), wid = __builtin_amdgcn_readfirstlane(tid >> 6), lane = tid & 63, wr = wid >> 2, wc = wid & 3, fr = lane & 15, fq = lane >> 4;
    int nt = K >> 6; asm volatile("" : "+s"(nt));
    unsigned voffB[2], voffA[2][2];
#pragma unroll
    for (int i = 0; i < 2; ++i) { int sR, sC; g8_stage_rc(tid * 16 + i * 8192, sR, sC); voffB[i] = (unsigned)(sR * K + sC) * 2u; }
#define G8_AOFFS(un) do { const int t3_ = get_tid(); _Pragma("unroll") for (int i = 0; i < 2; ++i) { int sR, sC; g8_stage_rc(t3_ * 16 + i * 8192, sR, sC); \
        _Pragma("unroll") for (int h = 0; h < 2; ++h) voffA[h][i] = S.a_off(un, h, sR) + (unsigned)sC * 2u; } } while (0)
    const size_t kstep = 128;
    const size_t hstep = (size_t)128 * K * 2;
    const unsigned ldsw = (unsigned)wid * 1024u;
    const int aoff = g8_lds_byte(wr * 64 + fr, fq * 8), boff = g8_lds_byte(wc * 32 + fr, fq * 8);
#define G8_SA(b, h) (((b) * 2 + (h)) * G8_HTB)
#define G8_SB(b, h) ((4 + (b) * 2 + (h)) * G8_HTB)
#define G8_STAGE2(bufoff, gbase, v0, v1) do { \
        __builtin_amdgcn_global_load_lds((const GAS1 unsigned*)((const char*)(gbase) + (v0)), (LAS3 unsigned*)(lds + (bufoff) + ldsw), 16, 0, 0); \
        __builtin_amdgcn_global_load_lds((const GAS1 unsigned*)((const char*)(gbase) + (v1)), (LAS3 unsigned*)(lds + (bufoff) + ldsw + 8192), 16, 0, 0); } while (0)
#define G8_STAGEB(bufoff, gbase) G8_STAGE2(bufoff, gbase, voffB[0], voffB[1])
#define G8_LDA(dst, b, h) do { _Pragma("unroll") for (int m = 0; m < 4; ++m) _Pragma("unroll") for (int k = 0; k < 2; ++k) dst[m][k] = *(const LAS3 bf16x8*)(lds + G8_SA(b, h) + aoff + m * 2048 + k * 1024); } while (0)
#define G8_LDB(dst, b, h) do { _Pragma("unroll") for (int n = 0; n < 2; ++n) _Pragma("unroll") for (int k = 0; k < 2; ++k) dst[n][k] = *(const LAS3 bf16x8*)(lds + G8_SB(b, h) + boff + n * 2048 + k * 1024); } while (0)
#define G8_MMA(ai, bj, At, Bt) do { __builtin_amdgcn_s_setprio(1); _Pragma("unroll") for (int m = 0; m < 4; ++m) _Pragma("unroll") for (int n = 0; n < 2; ++n) _Pragma("unroll") for (int k = 0; k < 2; ++k) \
        acc[ai][bj][m][n] = __builtin_amdgcn_mfma_f32_16x16x32_bf16(Bt[n][k], At[m][k], acc[ai][bj][m][n], 0, 0, 0); __builtin_amdgcn_s_setprio(0); } while (0)
#define G8_WAIT_V(n) asm volatile("s_waitcnt vmcnt(" #n ")" ::: "memory")
#define G8_WAIT_L(n) asm volatile("s_waitcnt lgkmcnt(" #n ")" ::: "memory")
#define G8_BAR __builtin_amdgcn_s_barrier()
#define G8_SCHED __builtin_amdgcn_sched_barrier(0)
    GUnit cur, nxt; int ui = 0;
    if (!S.next(0, cur)) return;
    f32x4 acc[2][2][4][2];
#pragma unroll
    for (int a = 0; a < 2; ++a)
#pragma unroll
        for (int b = 0; b < 2; ++b)
#pragma unroll
            for (int m = 0; m < 4; ++m)
#pragma unroll
                for (int n = 0; n < 2; ++n) acc[a][b][m][n] = (f32x4){0.f, 0.f, 0.f, 0.f};
    bf16x8 At[4][2], B0[2][2], B1[2][2];
    G8_AOFFS(cur);
    const char* cB = S.b_ptr(cur);
    G8_STAGEB(G8_SB(0, 0), cB); G8_STAGE2(G8_SA(0, 0), Ab, voffA[0][0], voffA[0][1]); G8_STAGEB(G8_SB(0, 1), cB + hstep); G8_STAGE2(G8_SA(0, 1), Ab, voffA[1][0], voffA[1][1]);
    if (wr == 1) G8_BAR;
    G8_WAIT_V(4); G8_BAR;
    G8_STAGEB(G8_SB(1, 0), cB + kstep); G8_STAGE2(G8_SA(1, 0), Ab + kstep, voffA[0][0], voffA[0][1]); G8_STAGEB(G8_SB(1, 1), cB + hstep + kstep);
    G8_WAIT_V(6); G8_BAR;
    for (;;) {
        const bool has_next = S.next(ui + 1, nxt);
        const char* nB = has_next ? S.b_ptr(nxt) : cB;
        for (int t = 0; t < nt; t += 2) {
            const bool last = (t == nt - 2);
            const char* a1 = Ab + (size_t)(t + 1) * kstep;
            const unsigned va10 = voffA[1][0], va11 = voffA[1][1];
            if (last && has_next) G8_AOFFS(nxt);
            const char* a2 = last ? Ab : Ab + (size_t)(t + 2) * kstep; const char* b2 = last ? nB : cB + (size_t)(t + 2) * kstep;
            const char* a3 = a2 + kstep; const char* b3 = b2 + kstep;
            G8_LDB(B0, 0, 0); G8_SCHED; G8_LDA(At, 0, 0); G8_STAGE2(G8_SA(1, 1), a1, va10, va11);
            G8_WAIT_L(8); G8_BAR; G8_WAIT_L(0); G8_MMA(0, 0, At, B0); G8_BAR; G8_SCHED;
            G8_LDB(B1, 0, 1); G8_STAGEB(G8_SB(0, 0), b2);
            G8_BAR; G8_WAIT_L(0); G8_MMA(0, 1, At, B1); G8_BAR;
            G8_LDA(At, 0, 1); G8_STAGE2(G8_SA(0, 0), a2, voffA[0][0], voffA[0][1]);
            G8_BAR; G8_WAIT_L(0); G8_MMA(1, 0, At, B0); G8_BAR; G8_SCHED;
            G8_STAGEB(G8_SB(0, 1), b2 + hstep);
            G8_WAIT_V(6); G8_BAR; G8_MMA(1, 1, At, B1); G8_BAR;
            G8_LDB(B0, 1, 0); G8_SCHED; G8_LDA(At, 1, 0); G8_STAGE2(G8_SA(0, 1), a2, voffA[1][0], voffA[1][1]);
            G8_WAIT_L(8); G8_BAR; G8_WAIT_L(0); G8_MMA(0, 0, At, B0); G8_BAR; G8_SCHED;
            G8_LDB(B1, 1, 1); G8_STAGEB(G8_SB(1, 0), b3);
            G8_BAR; G8_WAIT_L(0); G8_MMA(0, 1, At, B1); G8_BAR;
            G8_LDA(At, 1, 1); G8_STAGE2(G8_SA(1, 0), a3, voffA[0][0], voffA[0][1]);
            G8_BAR; G8_WAIT_L(0); G8_MMA(1, 0, At, B0); G8_BAR; G8_SCHED;
            G8_STAGEB(G8_SB(1, 1), b3 + hstep);
            G8_WAIT_V(6); G8_BAR; G8_MMA(1, 1, At, B1); G8_BAR;
        }
        E(acc, cur, wr, wc, fr, fq);
        if (!has_next) break;
#pragma unroll
        for (int a = 0; a < 2; ++a)
#pragma unroll
            for (int b = 0; b < 2; ++b)
#pragma unroll
                for (int m = 0; m < 4; ++m)
#pragma unroll
                    for (int n = 0; n < 2; ++n) acc[a][b][m][n] = (f32x4){0.f, 0.f, 0.f, 0.f};
        cur = nxt; cB = nB; ++ui;
    }
    G8_WAIT_V(0);
    if (wr == 0) G8_BAR;
    G8_BAR;
#undef G8_SA
#undef G8_AOFFS
#undef G8_SB
#undef G8_STAGE2
#undef G8_STAGEB
#undef G8_LDA
#undef G8_LDB
#undef G8_MMA
#undef G8_WAIT_V
#undef G8_WAIT_L
#undef G8_BAR
#undef G8_SCHED
}
struct DenseSched {
    int nM, nN, nwg, G, c, K; const char* Bt;
    __device__ __forceinline__ void init(int M, int N, int K_, const void* Bt_, int G_, int c_) { nM = M >> 8; nN = N >> 8; nwg = nM * nN; G = G_; c = c_; K = K_; Bt = (const char*)Bt_; }
    __device__ __forceinline__ bool next(int i, GUnit& u) const {
        const int L = i * G + c; if (L >= nwg) return false;
        int wgid = L; { const int q = nwg >> 3, r = nwg & 7, xcd = wgid & 7, off = wgid >> 3; wgid = (xcd < r ? xcd * (q + 1) : r * (q + 1) + (xcd - r) * q) + off; }
        const int nig = 8 * nN, gid = wgid / nig, fm = gid * 8, gsz = (nM - fm) < 8 ? (nM - fm) : 8, w = wgid - gid * nig;
        u.pn = w / gsz; u.pm = fm + (w - u.pn * gsz); return true;
    }
    __device__ __forceinline__ unsigned a_off(const GUnit& u, int h, int R) const { return (unsigned)((u.pm * 256 + h * 128 + R) * K) * 2u; }
    __device__ __forceinline__ const char* b_ptr(const GUnit& u) const { return Bt + (size_t)u.pn * 256 * K * 2; }
};

template <class SRC>
__device__ __forceinline__ void convert_wT(const float* __restrict__ W, int K, int N, u16* __restrict__ WT, int rows, SRC src, int gtid, int gnt) {
    const int kch = K >> 3;
    const int total = rows * kch;
    for (int i0 = gtid; i0 < total; i0 += 4 * gnt) {
        float f[4][8]; int sc[4];
#pragma unroll
        for (int u = 0; u < 4; u++) {
            const int i = i0 + u * gnt;
            sc[u] = -1;
            if (i < total) {
                const int kc = i / rows, j = i - kc * rows;
                sc[u] = src(j);
                if (sc[u] >= 0) {
                    const float* wp = W + (size_t)(kc * 8) * N + sc[u];
#pragma unroll
                    for (int q = 0; q < 8; q++) f[u][q] = wp[(size_t)q * N];
                }
            }
        }
#pragma unroll
        for (int u = 0; u < 4; u++) {
            const int i = i0 + u * gnt;
            if (i < total) {
                const int kc = i / rows, j = i - kc * rows;
                uint4 v = make_uint4(0u, 0u, 0u, 0u);
                if (sc[u] >= 0) { v.x = pack2(f[u][0], f[u][1]); v.y = pack2(f[u][2], f[u][3]); v.z = pack2(f[u][4], f[u][5]); v.w = pack2(f[u][6], f[u][7]); }
                *(uint4*)&WT[(size_t)j * K + kc * 8] = v;
            }
        }
    }
}

__device__ __forceinline__ void convert_later_weights(const P& p, int gtid, int gnt) {
    convert_wT(p.w_in, D_, CIN, p.wgT, 2048, [](int j) { return 3096 + (j & ~31) + perm32(j & 31); }, gtid, gnt);
    convert_wT(p.wpa, 512, D_, p.wpaT, 1024, [](int j) { return (j & ~31) + perm32(j & 31); }, gtid, gnt);
    convert_wT(p.wpb, 512, D_, p.wpbT, 1024, [](int j) { return (j & ~31) + perm32(j & 31); }, gtid, gnt);
    convert_wT(p.wout, D_, D_, p.woutT, 1024, [](int j) { return j; }, gtid, gnt);
    convert_wT(p.w2, 64, 512, p.w2T, 512, [](int j) { return j; }, gtid, gnt);
    convert_wT(p.w1_k, 2048, 256, p.cw1Tk, 256, [](int j) { return j; }, gtid, gnt);
    convert_wT(p.w1_v, 2048, 256, p.cw1Tv, 256, [](int j) { return j; }, gtid, gnt);
    convert_wT(p.w2_k, 256, 64, p.cw2Tk, 128, [](int j) { return j < 64 ? j : -1; }, gtid, gnt);
    convert_wT(p.w2_v, 256, 64, p.cw2Tv, 128, [](int j) { return j < 64 ? j : -1; }, gtid, gnt);
    convert_wT(p.a2, 64, 512, p.a2T, 512, [](int j) { return j; }, gtid, gnt);
    convert_wT(p.g2, 128, 512, p.g2T, 512, [](int j) { return j; }, gtid, gnt);
}
__device__ void ph_prologue(const P& p, int bid, int nb, char* smem) {
    const int tid = get_tid(), lane = tid & 63, wv = tid >> 6;
    if (bid >= 1 && bid <= 64) {
        const int j = tid & 255; const bool isv = tid >= 256;
        const float* pe = isv ? p.pe_v : p.pe_k; const float* w1 = isv ? p.w1_v : p.w1_k;
        const int kb = (bid - 1) * 32;
        float a0 = 0.f, a1 = 0.f;
#pragma unroll 4
        for (int k = kb; k < kb + 32; k += 2) { a0 += pe[k] * w1[(size_t)k * 256 + j]; a1 += pe[k + 1] * w1[(size_t)(k + 1) * 256 + j]; }
        p.cb1k[(bid - 1) * 512 + (isv ? 256 : 0) + j] = a0 + a1;
    }
    if (bid == 0) {
        if (tid < 32) { p.counts[tid] = 0; p.cursor[tid] = 0; }
        if (tid == 32) *p.nsactr = 0;
        for (int i = tid; i < 8 * 64; i += NT) {
            const int bg = i >> 6, d = i & 63;
            p.kcb[((size_t)bg * 512 + 511) * 64 + d] = 0;
            p.vcT[(((size_t)bg * 8 + 7) * 64 + d) * 64 + 63] = 0;
        }
    }
    {
        const int gtid = bid * NT + tid, gnt = nb * NT;
        convert_wT(p.w_in, D_, CIN, p.winT, 3328, [](int j) {
            const int t = j >> 8, s = j & 255;
            if (t < 5) {
                const int bj = s >> 7, wc = (s >> 5) & 3, n = (s >> 4) & 1, i = s & 15;
                const int dim = 32 * bj + 8 * (i >> 2) + 4 * n + (i & 3), hq = 4 * t + wc;
                int hb;
                if (hq < 8) hb = 64 * hq;
                else { const int k = (hq - 8) >> 1; hb = (k == 0 ? 512 : (k == 1 ? 640 : (k == 2 ? 768 : (k == 3 ? 1024 : (k == 4 ? 896 : 1152))))) + 64 * (hq & 1); }
                return hb + dim;
            }
            const int c = (s & ~31) + perm32(s & 31);
            if (t < 12) return 1304 + (t - 5) * 256 + c;
            return c < 24 ? 1280 + c : -1; }, gtid, gnt);
        if (nb != 256) convert_later_weights(p, gtid, gnt);
    }
    for (int row = bid * NW + wv; row < NTOK; row += nb * NW) {
        const float* xr = p.x + (size_t)row * D_;
        float v[16];
        float ss = 0.f;
#pragma unroll
        for (int i = 0; i < 4; i++) {
            float4 t = *(const float4*)&xr[i * 256 + lane * 4];
            v[4 * i] = t.x; v[4 * i + 1] = t.y; v[4 * i + 2] = t.z; v[4 * i + 3] = t.w;
            ss += t.x * t.x + t.y * t.y + t.z * t.z + t.w * t.w;
        }
        ss = wave_sum(ss);
        const float rs = rsqrtf(ss * (1.f / D_) + 1e-6f);
#pragma unroll
        for (int i = 0; i < 4; i++) {
            const int c = i * 256 + lane * 4;
            float4 g = *(const float4*)&p.g_mix[c];
            uint2 o;
            o.x = pack2(v[4 * i] * rs * g.x, v[4 * i + 1] * rs * g.y);
            o.y = pack2(v[4 * i + 2] * rs * g.z, v[4 * i + 3] * rs * g.w);
            *(uint2*)&p.hbuf[(size_t)row * D_ + c] = o;
        }
    }
}

__device__ __forceinline__ uint4 pack8(const f32x4& a, const f32x4& b) { uint4 o; o.x = pack2(a[0], a[1]); o.y = pack2(a[2], a[3]); o.z = pack2(b[0], b[1]); o.w = pack2(b[2], b[3]); return o; }
struct EpiInproj {
    const P* pp;
    __device__ __forceinline__ void operator()(const f32x4 (&acc)[2][2][4][2], const GUnit& u, int, int, int, int) const {
        const int t2_ = get_tid(), wid_ = __builtin_amdgcn_readfirstlane(t2_ >> 6), wr = wid_ >> 2, wc = wid_ & 3, fr = t2_ & 15, fq = (t2_ >> 4) & 3;
        const P& p = *pp;
        const int pn = u.pn;
        const int rowb = u.pm * 256 + wr * 64;
        if (pn < 4) {
            const int hq = 4 * pn + wc;
            const bool rope = !(pn == 2 && wc >= 2);
            u16* dst; size_t rstride; int cofs;
            if (pn < 2) { dst = p.q; rstride = 512; cofs = hq * 64; }
            else { dst = (pn == 2) ? (wc < 2 ? p.kc : p.vc) : (wc < 2 ? p.ksl : p.kwn); rstride = 64; cofs = 0; }
            const int g = wc & 1;
#pragma unroll
            for (int ai = 0; ai < 2; ++ai)
#pragma unroll
                for (int m = 0; m < 4; ++m) {
                    const int row = rowb + ai * 128 + m * 16 + fr;
                    f32x4 o1[2], o2[2];
#pragma unroll
                    for (int n = 0; n < 2; ++n) { o1[n] = acc[ai][0][m][n]; o2[n] = acc[ai][1][m][n]; }
                    if (rope) {
                        const double posd = (double)p.pos[row];
#pragma unroll
                        for (int n = 0; n < 2; ++n)
#pragma unroll
                            for (int j = 0; j < 4; ++j) {
                                const double tr = posd * ROPE_FREQ[8 * fq + 4 * n + j] * 0.15915494309189535;
                                const float fr_ = (float)(tr - rint(tr));
                                const float cs = __builtin_amdgcn_cosf(fr_), sn = __builtin_amdgcn_sinf(fr_);
                                const float x1 = o1[n][j], x2 = o2[n][j];
                                o1[n][j] = x1 * cs - x2 * sn; o2[n][j] = x1 * sn + x2 * cs;
                            }
                    }
                    size_t ro;
                    if (pn < 2) {
#pragma unroll
                        for (int n = 0; n < 2; ++n)
#pragma unroll
                            for (int j = 0; j < 4; ++j) { o1[n][j] *= QSCALE; o2[n][j] *= QSCALE; }
                        ro = (size_t)row * 512 + cofs + 8 * fq;
                    } else {
                        const int bb = row >> 13, t = row & (S_ - 1);
                        ro = ((size_t)(bb * 2 + g) * S_ + t) * 64 + 8 * fq;
                    }
                    *(uint4*)&dst[ro] = pack8(o1[0], o1[1]);
                    *(uint4*)&dst[ro + 32] = pack8(o2[0], o2[1]);
                }
        } else if (pn == 4) {
            u16* dst = (wc < 2) ? p.vslT : p.vwnT;
            const int g = wc & 1;
#pragma unroll
            for (int ai = 0; ai < 2; ++ai) {
                const int r0 = rowb + ai * 128, bb = r0 >> 13, tb = r0 & (S_ - 1);
                u16* base = dst + ((size_t)(bb * 2 + g) * 128 + (tb >> 6)) * 4096;
#pragma unroll
                for (int m = 0; m < 4; ++m)
#pragma unroll
                    for (int bj = 0; bj < 2; ++bj)
#pragma unroll
                        for (int n = 0; n < 2; ++n)
#pragma unroll
                            for (int j = 0; j < 4; ++j)
                                base[(32 * bj + 8 * fq + 4 * n + j) * 64 + m * 16 + fr] = f2bf(acc[ai][bj][m][n][j]);
            }
        } else if (pn < 12) {
            const int cb = (pn - 5) * 256 + wc * 32 + 8 * fq;
#pragma unroll
            for (int ai = 0; ai < 2; ++ai)
#pragma unroll
                for (int m = 0; m < 4; ++m) {
                    const size_t ro = (size_t)(rowb + ai * 128 + m * 16 + fr) * CRW + cb;
#pragma unroll
                    for (int bj = 0; bj < 2; ++bj) *(uint4*)&p.prw[ro + bj * 128] = pack8(acc[ai][bj][m][0], acc[ai][bj][m][1]);
                }
        } else {
            if (wc == 0 && fq < 3) {
#pragma unroll
                for (int ai = 0; ai < 2; ++ai)
#pragma unroll
                    for (int m = 0; m < 4; ++m) {
                        const size_t ro = (size_t)(rowb + ai * 128 + m * 16 + fr) * 24 + 8 * fq;
#pragma unroll
                        for (int n = 0; n < 2; ++n) {
                            float4 o; o.x = sigmoidf_(acc[ai][0][m][n][0]); o.y = sigmoidf_(acc[ai][0][m][n][1]); o.z = sigmoidf_(acc[ai][0][m][n][2]); o.w = sigmoidf_(acc[ai][0][m][n][3]);
                            *(float4*)&p.nsag[ro + 4 * n] = o;
                        }
                    }
            }
        }
    }
};
__device__ void ph_inproj(const P& p, int bid, int nb, char* smem) {
    DenseSched S; S.init(NTOK, 3328, D_, p.winT, nb, bid);
    EpiInproj E{&p};
    gemm256(smem, (const char*)p.hbuf, D_, S, E);
    if (nb == 256 && bid >= 128) convert_later_weights(p, (bid - 128) * NT + get_tid(), 128 * NT);
}

__device__ __forceinline__ float gelu_tanh(float x) {
    const float c = 0.7978845608028654f;
    return 0.5f * x * (1.f + tanhf(c * (x + 0.044715f * x * x * x)));
}
__device__ void ph_compress(const P& p, int bid, int nb, char* smem) {
    u16* sm = (u16*)smem;
    const int tid = get_tid(), lane = tid & 63, wv = tid >> 6;
    const int wm = wv >> 1, wn = wv & 1;
    for (int it = bid; it < 32; it += nb) {
        const int rt = it & 1, g = (it >> 1) & 1, b = (it >> 2) & 3, kv = it >> 4;
        const int bg = b * 2 + g, i0 = rt * 256;
        const u16* src = (kv ? p.vc : p.kc) + (size_t)bg * S_ * 64;
        const u16* w1T = kv ? p.cw1Tv : p.cw1Tk;
        const u16* w2T = kv ? p.cw2Tv : p.cw2Tk;
        float* cb1 = (float*)(smem + 3 * G_TILE);
        __syncthreads();
        { const int t2 = get_tid(); if (t2 < 256) { float a = 0.f; for (int q = 0; q < 64; q++) a += p.cb1k[q * 512 + kv * 256 + t2]; cb1[t2] = a; } }
        __syncthreads();
        const float* b1 = kv ? p.b1_v : p.b1_k;
        const float* b2 = kv ? p.b2_v : p.b2_k;
        u16* hidp = p.chid + (size_t)it * 256 * 256;
        auto arow = [&](int r) { int i = i0 + r; if (i > 510) i = 510; return src + (size_t)i * 1024; };
#pragma unroll 1
        for (int ct = 0; ct < 2; ct++) {
            f32x4 acc[4][4];
            gemm_core<false>(2048, arow, w1T + (size_t)ct * 128 * 2048, 2048, acc, sm);
            const int le = get_tid() & 63;
#pragma unroll
            for (int mt = 0; mt < 4; mt++) {
                const int r = wm * 64 + mt * 16 + (le & 15);
#pragma unroll
                for (int nt = 0; nt < 4; nt++) {
                    const int col = ct * 128 + wn * 64 + nt * 16 + (le >> 4) * 4;
                    const float4 c1 = *(const float4*)&cb1[col], bb1 = *(const float4*)&b1[col];
                    f32x4 o;
                    o[0] = gelu_tanh(acc[mt][nt][0] + c1.x + bb1.x); o[1] = gelu_tanh(acc[mt][nt][1] + c1.y + bb1.y);
                    o[2] = gelu_tanh(acc[mt][nt][2] + c1.z + bb1.z); o[3] = gelu_tanh(acc[mt][nt][3] + c1.w + bb1.w);
                    *(uint2*)&hidp[r * 256 + col] = pack4(o);
                }
            }
        }
        __syncthreads();
        {
            f32x4 acc[4][4];
            gemm_core<true>(256, [&](int r) { return hidp + (size_t)r * 256; }, w2T, 256, acc, sm);
            if (wn == 0) {
#pragma unroll
                for (int mt = 0; mt < 4; mt++)
#pragma unroll
                    for (int nt = 0; nt < 4; nt++) {
                        const int d = nt * 16 + (lane & 15);
                        const int ib = i0 + wm * 64 + mt * 16 + (lane >> 4) * 4;
                        float o[4];
#pragma unroll
                        for (int j = 0; j < 4; j++) o[j] = (ib + j < NCMP) ? (acc[mt][nt][j] + b2[d]) : 0.f;
                        if (kv == 0) {
#pragma unroll
                            for (int j = 0; j < 4; j++) p.kcb[((size_t)bg * 512 + ib + j) * 64 + d] = f2bf(o[j]);
                        } else {
                            uint2 ov; ov.x = pack2(o[0], o[1]); ov.y = pack2(o[2], o[3]);
                            *(uint2*)&p.vcT[(((size_t)bg * 8 + (ib >> 6)) * 64 + d) * 64 + (ib & 63)] = ov;
                        }
                    }
            }
        }
        __syncthreads();
    }
}

#ifndef NSAPROBE
#define NSAPROBE 0
#endif
#define NSA_TS(k) if (NSAPROBE == k) ts_ = __builtin_amdgcn_s_memrealtime();
#define NSA_TE(k) if (NSAPROBE == k) tacc_ += __builtin_amdgcn_s_memrealtime() - ts_;
constexpr int KSTR = 72;
struct Sub { f32x4 O[4]; float m, l; };
#define NEG_BIG (-1.0e30f)

__device__ __forceinline__ float xq_max(float v) {
    return xrow_max(v);
}
__device__ __forceinline__ float xq_sum(float v) {
    return xrow_sum(v);
}
template <int OFF> __device__ __forceinline__ bf16x8 gload_b128(const u16* p) { bf16x8 r; asm volatile("global_load_dwordx4 %0, %1, off offset:%2" : "=v"(r) : "v"(p), "n"(OFF) : "memory"); return r; }
typedef unsigned u32x2 __attribute__((ext_vector_type(2)));
template <int OFF> __device__ __forceinline__ u32x2 gload_b64(const u16* p) { u32x2 r; asm volatile("global_load_dwordx2 %0, %1, off offset:%2" : "=v"(r) : "v"(p), "n"(OFF) : "memory"); return r; }
union VF { bf16x8 v; u32x2 h[2]; };
template <int OFF> __device__ __forceinline__ u32x2 lds_read_b64(unsigned addr) { u32x2 r; asm volatile("ds_read_b64 %0, %1 offset:%2" : "=v"(r) : "v"(addr), "n"(OFF)); return r; }
#define NSA_LDV_ASM(vf, Vs, kr, qq, swz) { const unsigned va_ = (unsigned)(size_t)(const LAS3 char*)((const char*)(Vs) + (kr) * 128 + ((qq) & 1) * 8); const int vo_ = (((qq) >> 1) ^ (swz)) << 4; \
        const unsigned a0_ = va_ + vo_, a1_ = va_ + (vo_ ^ 32), a2_ = va_ + (vo_ ^ 64), a3_ = va_ + (vo_ ^ 96); \
        vf[0][0].h[0] = lds_read_b64<0>(a0_);    vf[0][0].h[1] = lds_read_b64<0>(a1_);    vf[0][1].h[0] = lds_read_b64<0>(a2_);    vf[0][1].h[1] = lds_read_b64<0>(a3_); \
        vf[1][0].h[0] = lds_read_b64<2048>(a0_); vf[1][0].h[1] = lds_read_b64<2048>(a1_); vf[1][1].h[0] = lds_read_b64<2048>(a2_); vf[1][1].h[1] = lds_read_b64<2048>(a3_); \
        vf[2][0].h[0] = lds_read_b64<4096>(a0_); vf[2][0].h[1] = lds_read_b64<4096>(a1_); vf[2][1].h[0] = lds_read_b64<4096>(a2_); vf[2][1].h[1] = lds_read_b64<4096>(a3_); \
        vf[3][0].h[0] = lds_read_b64<6144>(a0_); vf[3][0].h[1] = lds_read_b64<6144>(a1_); vf[3][1].h[0] = lds_read_b64<6144>(a2_); vf[3][1].h[1] = lds_read_b64<6144>(a3_); }
#define NSA_VWAIT(vf) asm volatile("s_waitcnt lgkmcnt(0)" : "+v"(vf[0][0].v), "+v"(vf[0][1].v), "+v"(vf[1][0].v), "+v"(vf[1][1].v), "+v"(vf[2][0].v), "+v"(vf[2][1].v), "+v"(vf[3][0].v), "+v"(vf[3][1].v) :: "memory")
template <bool MASK, bool IMP, bool PV>
__device__ __forceinline__ void nsa_visit(const u16* Ks, const u16* Vs, const u16* qrow, Sub& s, int lo, int hi, int lane, float* e, float* p3) {
    const int kr = lane & 15, qq = lane >> 4;
    f32x4 S[4];
    const int qsw = ((kr & 3) >> 1) ^ ((kr >> 2) << 1);
    const bf16x8 qf0 = *(const bf16x8*)(qrow + ((qq ^ qsw) << 3)), qf1 = *(const bf16x8*)(qrow + (((4 + qq) ^ qsw) << 3));
    bf16x8 kf[4][2];
    const int swz = kr >> 1;
    {
        const char* kb_ = (const char*)Ks + kr * 128;
        const int ko0 = (qq ^ swz) << 4, ko1 = ko0 ^ 64;
#pragma unroll
        for (int kt = 0; kt < 4; kt++) { kf[kt][0] = *(const bf16x8*)(kb_ + kt * 2048 + ko0); kf[kt][1] = *(const bf16x8*)(kb_ + kt * 2048 + ko1); }
    }
    __builtin_amdgcn_sched_barrier(0);
#pragma unroll
    for (int kt = 0; kt < 4; kt++) {
        S[kt] = __builtin_amdgcn_mfma_f32_16x16x32_bf16(kf[kt][0], qf0, f32x4{0.f, 0.f, 0.f, 0.f}, 0, 0, 0);
        S[kt] = __builtin_amdgcn_mfma_f32_16x16x32_bf16(kf[kt][1], qf1, S[kt], 0, 0, 0);
    }
    float mx = NEG_BIG;
#pragma unroll
    for (int kt = 0; kt < 4; kt++)
#pragma unroll
        for (int r = 0; r < 4; r++) {
            if (MASK) { const int o = kt * 16 + qq * 4 + r; if (o < lo || o > hi) S[kt][r] = -INFINITY; }
            mx = fmaxf(mx, S[kt][r]);
        }
    mx = xq_max(mx);
    const float mnew = fmaxf(s.m, mx);
    const float alpha = __builtin_amdgcn_exp2f(s.m - mnew);
    s.m = mnew;
    float psum = 0.f;
#pragma unroll
    for (int kt = 0; kt < 4; kt++) {
#pragma unroll
        for (int r = 0; r < 4; r++) { S[kt][r] = __builtin_amdgcn_exp2f(S[kt][r] - mnew); }
        const float ee = (S[kt][0] + S[kt][1]) + (S[kt][2] + S[kt][3]);
        psum += ee;
        if (IMP) { e[kt] = ee; p3[kt] = S[kt][3]; }
    }
    s.l = s.l * alpha + psum;
    if (PV) {
        if (!__all(alpha == 1.f)) {
#pragma unroll
            for (int dt = 0; dt < 4; dt++)
#pragma unroll
                for (int r = 0; r < 4; r++) s.O[dt][r] *= alpha;
        }
        VF vf[4][2];
        NSA_LDV_ASM(vf, Vs, kr, qq, swz)
        bf16x8 pb[2];
#pragma unroll
        for (int k2 = 0; k2 < 2; k2++) {
            union { bf16x8 v; unsigned u[4]; } t;
            t.u[0] = pack2(S[2 * k2][0], S[2 * k2][1]); t.u[1] = pack2(S[2 * k2][2], S[2 * k2][3]);
            t.u[2] = pack2(S[2 * k2 + 1][0], S[2 * k2 + 1][1]); t.u[3] = pack2(S[2 * k2 + 1][2], S[2 * k2 + 1][3]);
            pb[k2] = t.v;
        }
        NSA_VWAIT(vf);
        __builtin_amdgcn_sched_barrier(0);
#pragma unroll
        for (int dt = 0; dt < 4; dt++)
#pragma unroll
            for (int k2 = 0; k2 < 2; k2++) s.O[dt] = __builtin_amdgcn_mfma_f32_16x16x32_bf16(vf[dt][k2].v, pb[k2], s.O[dt], 0, 0, 0);
    }
}
template <bool IMP, bool PV>
__device__ __forceinline__ void nsa_visit2(const u16* Ks, const u16* Vs, const u16* qrow0, const u16* qrow1, Sub (&st)[2], const int (&hi)[2], int lane, float (&e)[2][4], float (&p3)[2][4]) {
    const int kr = lane & 15, qq = lane >> 4;
    const int qsw = ((kr & 3) >> 1) ^ ((kr >> 2) << 1);
    bf16x8 qf0[2], qf1[2];
    qf0[0] = *(const bf16x8*)(qrow0 + ((qq ^ qsw) << 3)); qf1[0] = *(const bf16x8*)(qrow0 + (((4 + qq) ^ qsw) << 3));
    qf0[1] = *(const bf16x8*)(qrow1 + ((qq ^ qsw) << 3)); qf1[1] = *(const bf16x8*)(qrow1 + (((4 + qq) ^ qsw) << 3));
    bf16x8 kf[4][2];
    const int swz = kr >> 1;
    {
        const char* kb_ = (const char*)Ks + kr * 128;
        const int ko0 = (qq ^ swz) << 4, ko1 = ko0 ^ 64;
#pragma unroll
        for (int kt = 0; kt < 4; kt++) { kf[kt][0] = *(const bf16x8*)(kb_ + kt * 2048 + ko0); kf[kt][1] = *(const bf16x8*)(kb_ + kt * 2048 + ko1); }
    }
    __builtin_amdgcn_sched_barrier(0);
    f32x4 S[2][4];
#pragma unroll
    for (int kt = 0; kt < 4; kt++)
#pragma unroll
        for (int q = 0; q < 2; q++) {
            S[q][kt] = __builtin_amdgcn_mfma_f32_16x16x32_bf16(kf[kt][0], qf0[q], f32x4{0.f, 0.f, 0.f, 0.f}, 0, 0, 0);
            S[q][kt] = __builtin_amdgcn_mfma_f32_16x16x32_bf16(kf[kt][1], qf1[q], S[q][kt], 0, 0, 0);
        }
    VF vf[4][2];
    bf16x8 pb[2][2];
#pragma unroll
    for (int q = 0; q < 2; q++) {
        Sub& s = st[q];
        float mx = NEG_BIG;
#pragma unroll
        for (int kt = 0; kt < 4; kt++)
#pragma unroll
            for (int r = 0; r < 4; r++) {
                const int o = kt * 16 + qq * 4 + r; if (o > hi[q]) S[q][kt][r] = -INFINITY;
                mx = fmaxf(mx, S[q][kt][r]);
            }
        mx = xq_max(mx);
        const float mnew = fmaxf(s.m, mx);
        const float alpha = __builtin_amdgcn_exp2f(s.m - mnew);
        s.m = mnew;
        float psum = 0.f;
#pragma unroll
        for (int kt = 0; kt < 4; kt++) {
#pragma unroll
            for (int r = 0; r < 4; r++) { S[q][kt][r] = __builtin_amdgcn_exp2f(S[q][kt][r] - mnew); }
            const float ee = (S[q][kt][0] + S[q][kt][1]) + (S[q][kt][2] + S[q][kt][3]);
            psum += ee;
            if (IMP) { e[q][kt] = ee; p3[q][kt] = S[q][kt][3]; }
        }
        s.l = s.l * alpha + psum;
        if (PV) {
#pragma unroll
            for (int dt = 0; dt < 4; dt++)
#pragma unroll
                for (int r = 0; r < 4; r++) s.O[dt][r] *= alpha;
#pragma unroll
            for (int k2 = 0; k2 < 2; k2++) {
                union { bf16x8 v; unsigned u[4]; } t;
                t.u[0] = pack2(S[q][2 * k2][0], S[q][2 * k2][1]); t.u[1] = pack2(S[q][2 * k2][2], S[q][2 * k2][3]);
                t.u[2] = pack2(S[q][2 * k2 + 1][0], S[q][2 * k2 + 1][1]); t.u[3] = pack2(S[q][2 * k2 + 1][2], S[q][2 * k2 + 1][3]);
                pb[q][k2] = t.v;
            }
            if (q == 0) NSA_LDV_ASM(vf, Vs, kr, qq, swz)
        }
    }
    if (PV) {
        NSA_VWAIT(vf);
        __builtin_amdgcn_sched_barrier(0);
#pragma unroll
        for (int dt = 0; dt < 4; dt++)
#pragma unroll
            for (int k2 = 0; k2 < 2; k2++)
#pragma unroll
                for (int q = 0; q < 2; q++) st[q].O[dt] = __builtin_amdgcn_mfma_f32_16x16x32_bf16(vf[dt][k2].v, pb[q][k2], st[q].O[dt], 0, 0, 0);
    }
}
template <int MMODE, bool FIXM, int NQ>
__device__ __forceinline__ void nsa_visit_gn(const u16* Ks, const u16* Vs, const u16* qs, float* Os, float* Ms, float* Ls, const int (&tok)[NQ], const bool (&valid)[NQ], int lane) {
    const int kr = lane & 15, qq = lane >> 4, hh = kr & 3;
    int row[NQ], osw[NQ]; float* orow[NQ];
    f32x4 O[NQ][4]; float m_old[NQ], l_old[NQ]; bf16x8 qf0[NQ], qf1[NQ];
#pragma unroll
    for (int q = 0; q < NQ; q++) {
        row[q] = tok[q] * 4 + hh; orow[q] = Os + row[q] * 64;
        osw[q] = hh ^ ((tok[q] & 3) << 2);
#pragma unroll
        for (int dt = 0; dt < 4; dt++) O[q][dt] = *(const f32x4*)(orow[q] + (((dt * 4 + qq) ^ osw[q]) << 2));
        m_old[q] = Ms[row[q]]; l_old[q] = Ls[row[q]];
        const u16* qrow = qs + row[q] * 64;
        const int qsw = (hh >> 1) ^ ((tok[q] & 3) << 1);
        qf0[q] = *(const bf16x8*)(qrow + ((qq ^ qsw) << 3)); qf1[q] = *(const bf16x8*)(qrow + (((4 + qq) ^ qsw) << 3));
    }
    bf16x8 kf[4][2];
    const int swz = kr >> 1;
    {
        const char* kb_ = (const char*)Ks + kr * 128;
        const int ko0 = (qq ^ swz) << 4, ko1 = ko0 ^ 64;
#pragma unroll
        for (int kt = 0; kt < 4; kt++) { kf[kt][0] = *(const bf16x8*)(kb_ + kt * 2048 + ko0); kf[kt][1] = *(const bf16x8*)(kb_ + kt * 2048 + ko1); }
    }
    __builtin_amdgcn_sched_barrier(0);
    f32x4 S[NQ][4];
#pragma unroll
    for (int kt = 0; kt < 4; kt++)
#pragma unroll
        for (int q = 0; q < NQ; q++) {
            S[q][kt] = __builtin_amdgcn_mfma_f32_16x16x32_bf16(kf[kt][0], qf0[q], f32x4{0.f, 0.f, 0.f, 0.f}, 0, 0, 0);
            S[q][kt] = __builtin_amdgcn_mfma_f32_16x16x32_bf16(kf[kt][1], qf1[q], S[q][kt], 0, 0, 0);
        }
    VF vf[4][2];
#define NSA_LDV NSA_LDV_ASM(vf, Vs, kr, qq, swz)
    if (NQ == 1) NSA_LDV
    bf16x8 pb[NQ][2];
#pragma unroll
    for (int q = 0; q < NQ; q++) {
        float mx = NEG_BIG;
#pragma unroll
        for (int kt = 0; kt < 4; kt++)
#pragma unroll
            for (int r = 0; r < 4; r++) {
                if (MMODE == 1) { const int o = kt * 16 + qq * 4 + r; if (o > tok[q]) S[q][kt][r] = -INFINITY; }
                if (MMODE == 2) { const int o = kt * 16 + qq * 4 + r; if (o <= tok[q]) S[q][kt][r] = -INFINITY; }
                if (FIXM) { if (!valid[q]) S[q][kt][r] = -INFINITY; } else mx = fmaxf(mx, S[q][kt][r]);
            }
        float mnew = m_old[q], alpha = 1.f;
        if (!FIXM) {
            if (!valid[q]) mx = NEG_BIG;
            mx = xq_max(mx);
            mnew = fmaxf(m_old[q], mx);
            alpha = __builtin_amdgcn_exp2f(m_old[q] - mnew);
        }
        float psum = 0.f;
#pragma unroll
        for (int kt = 0; kt < 4; kt++) {
#pragma unroll
            for (int r = 0; r < 4; r++) { S[q][kt][r] = __builtin_amdgcn_exp2f(S[q][kt][r] - mnew); }
            psum += (S[q][kt][0] + S[q][kt][1]) + (S[q][kt][2] + S[q][kt][3]);
        }
        psum = xq_sum(psum);
        if (FIXM) { if (valid[q] && qq == 0) Ls[row[q]] = l_old[q] + psum; }
        else {
            if (valid[q] && qq == 0) { Ms[row[q]] = mnew; Ls[row[q]] = l_old[q] * alpha + psum; }
#pragma unroll
            for (int dt = 0; dt < 4; dt++)
#pragma unroll
                for (int r = 0; r < 4; r++) O[q][dt][r] *= alpha;
        }
#pragma unroll
        for (int k2 = 0; k2 < 2; k2++) {
            union { bf16x8 v; unsigned u[4]; } t;
            t.u[0] = pack2(S[q][2 * k2][0], S[q][2 * k2][1]); t.u[1] = pack2(S[q][2 * k2][2], S[q][2 * k2][3]);
            t.u[2] = pack2(S[q][2 * k2 + 1][0], S[q][2 * k2 + 1][1]); t.u[3] = pack2(S[q][2 * k2 + 1][2], S[q][2 * k2 + 1][3]);
            pb[q][k2] = t.v;
        }
        if (NQ == 2 && q == 0) { asm volatile("" ::: "memory"); NSA_LDV }
    }
#undef NSA_LDV
    NSA_VWAIT(vf);
    __builtin_amdgcn_sched_barrier(0);
#pragma unroll
    for (int dt = 0; dt < 4; dt++)
#pragma unroll
        for (int k2 = 0; k2 < 2; k2++)
#pragma unroll
            for (int q = 0; q < NQ; q++) O[q][dt] = __builtin_amdgcn_mfma_f32_16x16x32_bf16(vf[dt][k2].v, pb[q][k2], O[q][dt], 0, 0, 0);
#pragma unroll
    for (int q = 0; q < NQ; q++)
        if (valid[q]) {
#pragma unroll
            for (int dt = 0; dt < 4; dt++) *(f32x4*)(orow[q] + (((dt * 4 + qq) ^ osw[q]) << 2)) = O[q][dt];
        }
}
template <int MMODE, bool FIXM>
__device__ __forceinline__ void nsa_visit_g(const u16* Ks, const u16* Vs, const u16* qs, float* Os, float* Ms, float* Ls, int tok, bool valid, int lane) {
    const int tk[1] = {tok}; const bool vl[1] = {valid};
    nsa_visit_gn<MMODE, FIXM, 1>(Ks, Vs, qs, Os, Ms, Ls, tk, vl, lane);
}
__device__ __forceinline__ void nsa_fold_lds(float* Os, float* Ms, float* Ls, int row, int qq, int hh, f32x4 (&T)[4], float gate, bool reset) {
    const float lt = Ls[row];
    const float sc = (lt > 0.f) ? gate / lt : 0.f;
#pragma unroll
    for (int dt = 0; dt < 4; dt++) {
        float* op = Os + row * 64 + (((dt * 4 + qq) ^ hh ^ (((row >> 2) & 3) << 2)) << 2);
        const f32x4 o = *(const f32x4*)op;
#pragma unroll
        for (int r = 0; r < 4; r++) T[dt][r] += o[r] * sc;
        if (reset) *(f32x4*)op = f32x4{0.f, 0.f, 0.f, 0.f};
    }
    asm volatile("s_waitcnt lgkmcnt(0)" ::: "memory");
    if (reset && qq == 0) { Ms[row] = NEG_BIG; Ls[row] = 0.f; }
}
template <int MODE>
__device__ __forceinline__ void nsa_fold(Sub& s, f32x4 (&T)[4], float gate) {
    const float lt = xq_sum(s.l);
    const float sc = (lt > 0.f) ? gate / lt : 0.f;
#pragma unroll
    for (int dt = 0; dt < 4; dt++)
#pragma unroll
        for (int r = 0; r < 4; r++) {
            const float v = s.O[dt][r] * sc;
            T[dt][r] = (MODE == 1) ? T[dt][r] + v : v;
            s.O[dt][r] = 0.f;
        }
    s.m = NEG_BIG; s.l = 0.f;
}

constexpr int NSA_R = 3;
template <bool HASV, class KSrc, class VSrc, class Body>
__device__ __forceinline__ void nsa_stream(char* ring, int n, KSrc ksrc, VSrc vsrc, Body body) {
    const int t = get_tid();
    const int so = (t >> 3) * 64 + (((t & 7) ^ ((t >> 4) & 7)) << 3);
    char* dl = ring + t * 16;
#define NSA_ISSUE(i, slot) { glds16(ksrc(i) + so, dl + (slot) * 16384); if (HASV) glds16(vsrc(i) + so, dl + (slot) * 16384 + 8192); }
    asm volatile("s_waitcnt lgkmcnt(0)" ::: "memory");
    __builtin_amdgcn_s_barrier();
    if (n > 0) NSA_ISSUE(0, 0)
    if (n > 1) NSA_ISSUE(1, 1)
    int slot = 0;
    for (int i = 0; i < n; i++) {
        if (i + 1 < n) { if (HASV) asm volatile("s_waitcnt vmcnt(2)" ::: "memory"); else asm volatile("s_waitcnt vmcnt(1)" ::: "memory"); }
        else asm volatile("s_waitcnt vmcnt(0)" ::: "memory");
        asm volatile("s_waitcnt lgkmcnt(0)" ::: "memory");
        __builtin_amdgcn_s_barrier();
        asm volatile("" ::: "memory");
        const int sl2 = (slot == 0) ? 2 : slot - 1;
        if (i + 2 < n) NSA_ISSUE(i + 2, sl2)
        body(i, (const u16*)(ring + slot * 16384), (const u16*)(ring + slot * 16384 + 8192));
        slot = (slot == 2) ? 0 : slot + 1;
    }
#undef NSA_ISSUE
}
#define NSA_TOK(u) const int t3_ = get_tid(); const size_t ntk_ = (size_t)b * S_ + t0 + 8 * (t3_ >> 6) + 4 * (u) + ((t3_ & 15) >> 2); const int hd_ = g * 4 + (t3_ & 3);
__device__ void ph_nsa(const P& p, int bid, int nb, char* smem) {
    char* ring = smem;
    unsigned* selm = (unsigned*)(smem + NSA_R * 16384);
    int* blist = (int*)(selm + 256);
    int* nlistp = blist + 128;
    int* lcnt = nlistp + 4;
    unsigned char* lists = (unsigned char*)(lcnt + 128);
    float* Ms = (float*)(lists + 128 * 64);
    float* Ls = Ms + 256;
    float* Os = Ls + 256;
    float* impl = Os;
    u16* qs = (u16*)(Os + 64 * 4 * 64);
    unsigned long long ts_ = 0, tacc_ = 0;
    const int nitems = B_ * 2 * 128;
    for (int rr = 0;; rr++) {
        int it = bid;
        if (rr > 0 || bid < 0) {
            __syncthreads();
            if (get_tid() == 0) nlistp[3] = nb + atomicAdd(p.nsactr, 1);
            __syncthreads();
            it = nlistp[3];
        }
        if (it >= nitems) break;
        const int tid = get_tid(), lane = tid & 63, wv = tid >> 6;
        const int kr = lane & 15, qq = lane >> 4, ts = kr >> 2, hh = kr & 3;
        float* myimp = impl + wv * (32 * 2 * 16);
        const int tt = 127 - (it >> 3);
        const int bg = it & 7, b = bg >> 1, g = bg & 1;
        const int t0 = tt * 64, cur = tt;
        const int head = g * 4 + hh;
        Sub st[2];
        f32x4 T[2][4];
        int tl[2]; size_t ntok[2];
        __syncthreads();
#pragma unroll
        for (int u = 0; u < 2; u++) {
            tl[u] = 8 * wv + 4 * u + ts;
            ntok[u] = (size_t)b * S_ + t0 + tl[u];
#pragma unroll
            for (int ks = 0; ks < 2; ks++) *(bf16x8*)&qs[(tl[u] * 4 + hh) * 64 + (((ks * 4 + qq) ^ (hh >> 1) ^ ((tl[u] & 3) << 1)) << 3)] = *(const bf16x8*)&p.q[ntok[u] * 512 + head * 64 + ks * 32 + qq * 8];
#pragma unroll
            for (int dt = 0; dt < 4; dt++) st[u].O[dt] = f32x4{0.f, 0.f, 0.f, 0.f};
            st[u].m = NEG_BIG; st[u].l = 0.f;
        }
        const u16* kcb = p.kcb + (size_t)bg * 512 * 64;
        const u16* vcT = p.vcT + (size_t)bg * 8 * 4096;
        int nv[2];
#pragma unroll
        for (int u = 0; u < 2; u++) { const int t = t0 + tl[u]; nv[u] = (t >= 31) ? min((t - 31) / 16 + 1, NCMP) : 0; }
        const int tmax = t0 + 63;
        const int nvmax = (tmax >= 31) ? min((tmax - 31) / 16 + 1, NCMP) : 0;
        const int nvb = (nvmax + 63) >> 6;
        NSA_TS(1)
        __syncthreads();
        nsa_stream<false>(ring, nvb, [&](int kb) { return kcb + (size_t)kb * 4096; }, [&](int kb) { return vcT + (size_t)kb * 4096; },
            [&](int kb, const u16* Ks, const u16* Vs) {
                const int hi2[2] = {nv[0] - kb * 64 - 1, nv[1] - kb * 64 - 1};
                float e_[2][4], p3_[2][4];
                nsa_visit2<false, false>(Ks, Vs, qs + (tl[0] * 4 + hh) * 64, qs + (tl[1] * 4 + hh) * 64, st, hi2, lane, e_, p3_);
            });
        float invl[2];
#pragma unroll
        for (int u = 0; u < 2; u++) { const float lt = xq_sum(st[u].l); invl[u] = (lt > 0.f) ? 1.f / lt : 0.f; st[u].l = 0.f; }
        float carry[2] = {0.f, 0.f};
        nsa_stream<true>(ring, nvb, [&](int kb) { return kcb + (size_t)kb * 4096; }, [&](int kb) { return vcT + (size_t)kb * 4096; },
            [&](int kb, const u16* Ks, const u16* Vs) {
            const int hi2[2] = {nv[0] - kb * 64 - 1, nv[1] - kb * 64 - 1};
            float e_[2][4], p3_[2][4];
            nsa_visit2<true, true>(Ks, Vs, qs + (tl[0] * 4 + hh) * 64, qs + (tl[1] * 4 + hh) * 64, st, hi2, lane, e_, p3_);
#pragma unroll
            for (int u = 0; u < 2; u++) {
#pragma unroll
                for (int kt = 0; kt < 4; kt++) {
                    float ev = e_[u][kt] * invl[u], pv = p3_[u][kt] * invl[u];
                    ev += dppf<0xB1>(ev); ev += dppf<0x4E>(ev);
                    pv += dppf<0xB1>(pv); pv += dppf<0x4E>(pv);
                    const float sh = __int_as_float(__builtin_amdgcn_ds_bpermute(((lane - 16) & 63) << 2, __float_as_int(pv)));
                    const float nbv = (qq == 0) ? carry[u] : sh;
                    carry[u] = sh;
                    myimp[((kb * 4 + kt) * 2 + u) * 16 + ts * 4 + qq] = ev + nbv;
                }
            }
            });
        NSA_TE(1)
        NSA_TS(2)
#pragma unroll
        for (int u = 0; u < 2; u++) {
            float mv[8];
#pragma unroll
            for (int i = 0; i < 8; i++) {
                const int kk = 8 * hh + i, j = 4 * kk + qq;
                const float v = myimp[(kk * 2 + u) * 16 + ts * 4 + qq];
                mv[i] = (j >= 1 && j <= cur - 2) ? v : -1.f;
            }
            unsigned sel = 0u;
            const int ncand = max(0, cur - 2);
            const int nforced = (cur >= 2) ? 3 : (cur + 1);
            const int need = 16 - nforced;
            if (ncand <= need) {
#pragma unroll
                for (int i = 0; i < 8; i++) if (mv[i] >= 0.f) sel |= (1u << i);
            } else {
                for (int rnd = 0; rnd < need; rnd++) {
                    const float b01 = fmaxf(mv[0], mv[1]), b23 = fmaxf(mv[2], mv[3]), b45 = fmaxf(mv[4], mv[5]), b67 = fmaxf(mv[6], mv[7]);
                    float best = fmaxf(fmaxf(b01, b23), fmaxf(b45, b67));
                    int bi = 7;
#pragma unroll
                    for (int i = 6; i >= 0; i--) bi = (mv[i] == best) ? i : bi;
                    int bj = (best >= 0.f) ? (4 * (8 * hh + bi) + qq) : 9999;
#define TK_MERGE(ov, oj) { const float v2_ = (ov); const int j2_ = (oj); const bool tk_ = (v2_ > best) || (v2_ == best && j2_ < bj); best = tk_ ? v2_ : best; bj = tk_ ? j2_ : bj; }
                    TK_MERGE(dppf<0xB1>(best), __builtin_amdgcn_update_dpp(0, bj, 0xB1, 0xF, 0xF, true))
                    TK_MERGE(dppf<0x4E>(best), __builtin_amdgcn_update_dpp(0, bj, 0x4E, 0xF, 0xF, true))
                    {
                        auto rv = __builtin_amdgcn_permlane16_swap(__float_as_uint(best), __float_as_uint(best), false, false);
                        auto rj = __builtin_amdgcn_permlane16_swap((unsigned)bj, (unsigned)bj, false, false);
                        float v0 = __uint_as_float(rv[0]), v1 = __uint_as_float(rv[1]); int j0 = (int)rj[0], j1 = (int)rj[1];
                        if (v1 > v0 || (v1 == v0 && j1 < j0)) { v0 = v1; j0 = j1; }
                        rv = __builtin_amdgcn_permlane32_swap(__float_as_uint(v0), __float_as_uint(v0), false, false);
                        rj = __builtin_amdgcn_permlane32_swap((unsigned)j0, (unsigned)j0, false, false);
                        best = __uint_as_float(rv[0]); bj = (int)rj[0];
                        const float v2 = __uint_as_float(rv[1]); const int j2 = (int)rj[1];
                        if (v2 > best || (v2 == best && j2 < bj)) { best = v2; bj = j2; }
                    }
#undef TK_MERGE
                    const bool mine = (bj < 512) && ((bj >> 5) == hh) && ((bj & 3) == qq);
                    const int li = (bj >> 2) & 7;
#pragma unroll
                    for (int i = 0; i < 8; i++) mv[i] = (mine && li == i) ? -1.f : mv[i];
                    if (mine) sel |= (1u << li);
                }
            }
            if (qq == 0 && hh == 0) sel |= 1u;
            if ((cur & 3) == qq && (cur >> 5) == hh) sel |= (1u << ((cur >> 2) & 7));
            if (cur >= 1 && ((cur - 1) & 3) == qq && ((cur - 1) >> 5) == hh) sel |= (1u << (((cur - 1) >> 2) & 7));
            unsigned w = sel << (8 * hh);
            w |= (unsigned)__builtin_amdgcn_update_dpp(0, (int)w, 0xB1, 0xF, 0xF, true);
            w |= (unsigned)__builtin_amdgcn_update_dpp(0, (int)w, 0x4E, 0xF, 0xF, true);
            if (hh == 0) selm[tl[u] * 4 + qq] = w;
        }
        NSA_TE(2)
        NSA_TS(3)
        __syncthreads();
#pragma unroll
        for (int u = 0; u < 2; u++) { NSA_TOK(u) nsa_fold<0>(st[u], T[u], p.nsag[ntk_ * 24 + hd_ * 3 + 0]); }
        {
            const int t2 = get_tid();
#pragma unroll
            for (int i = 0; i < 8; i++) *(f32x4*)&Os[(i * NT + t2) * 4] = f32x4{0.f, 0.f, 0.f, 0.f};
            if (t2 < 256) { Ms[t2] = NEG_BIG; Ls[t2] = 0.f; }
            unsigned long long tm = 0ull; int lrank = 0;
            if (t2 < 128) {
                const int j = t2;
                for (int tk = 0; tk < 64; tk++) tm |= (unsigned long long)((selm[tk * 4 + (j & 3)] >> (j >> 2)) & 1u) << tk;
                if (j > cur) tm = 0ull;
                const unsigned long long bal = __ballot(tm != 0ull);
                lrank = __popcll(bal & ((1ull << (t2 & 63)) - 1ull));
                if ((t2 & 63) == 0) nlistp[t2 >> 6] = __popcll(bal);
            }
            __syncthreads();
            if (t2 < 128 && tm != 0ull) {
                const int pos = lrank + ((t2 >= 64) ? nlistp[0] : 0);
                blist[pos] = t2; lcnt[pos] = __popcll(tm);
                int c = 0;
                while (tm) { lists[pos * 64 + c] = (unsigned char)(__ffsll((long long)tm) - 1); c++; tm &= tm - 1ull; }
            }
            __syncthreads();
        }
        const int nlist = nlistp[0] + nlistp[1];
        NSA_TE(3)
        NSA_TS(4)
        const u16* ksl = p.ksl + (size_t)bg * S_ * 64;
        const u16* vslT = p.vslT + (size_t)bg * 128 * 4096;
        {
            const int t4 = get_tid(), wv4 = __builtin_amdgcn_readfirstlane(t4 >> 6), ts4 = (t4 & 15) >> 2;
            const int td = t4 & 255;
            const int so = (td >> 3) * 64 + (((td & 7) ^ ((td >> 4) & 7)) << 3);
            char* dl = ring + td * 16;
#define NSA_RI(i) (nlist - 1 - (i))
#define NSA_ISSUE2(i, slot) if (wv4 >= 4) { const int jj_ = blist[NSA_RI(i)]; const u16* kp_ = ksl + (size_t)jj_ * 4096 + so; const u16* vp_ = vslT + (size_t)jj_ * 4096 + so; char* d_ = dl + (slot) * 16384; \
                glds16(kp_, d_); glds16(kp_ + 2048, d_ + 4096); glds16(vp_, d_ + 8192); glds16(vp_ + 2048, d_ + 12288); }
            asm volatile("s_waitcnt lgkmcnt(0)" ::: "memory");
            __builtin_amdgcn_s_barrier();
            if (nlist > 0) NSA_ISSUE2(0, 0)
            if (nlist > 1) NSA_ISSUE2(1, 1)
            int jn = 0, nn = 0, tokn = 0;
            if (nlist > 0) { jn = blist[NSA_RI(0)]; nn = lcnt[NSA_RI(0)]; tokn = lists[NSA_RI(0) * 64 + wv4 * 4 + ts4]; }
            int slot = 0;
            for (int i = 0; i < nlist; i++) {
                if (i + 1 < nlist) asm volatile("s_waitcnt vmcnt(4)" ::: "memory"); else asm volatile("s_waitcnt vmcnt(0)" ::: "memory");
                asm volatile("s_waitcnt lgkmcnt(0)" ::: "memory");
                __builtin_amdgcn_s_barrier();
                asm volatile("" ::: "memory");
                const int sl2 = (slot == 0) ? 2 : slot - 1;
                if (i + 2 < nlist) NSA_ISSUE2(i + 2, sl2)
                const int j = jn, n = nn, tok0 = tokn;
                if (i + 1 < nlist) { jn = blist[NSA_RI(i + 1)]; nn = lcnt[NSA_RI(i + 1)]; tokn = lists[NSA_RI(i + 1) * 64 + wv4 * 4 + ts4]; }
                const u16* Ks = (const u16*)(ring + slot * 16384); const u16* Vs = Ks + 4096;
                if ((wv4 + NW) * 4 < n) {
                    const int e1 = (wv4 + NW) * 4 + ts4;
                    const bool vl2[2] = {true, e1 < n};
                    const int tk2[2] = {tok0, vl2[1] ? (int)lists[NSA_RI(i) * 64 + (e1 & 63)] : 0};
                    if (j == cur) nsa_visit_gn<1, false, 2>(Ks, Vs, qs, Os, Ms, Ls, tk2, vl2, t4 & 63);
                    else nsa_visit_gn<0, true, 2>(Ks, Vs, qs, Os, Ms, Ls, tk2, vl2, t4 & 63);
                } else if (wv4 * 4 < n) {
                    const int e = wv4 * 4 + ts4;
                    const bool valid = e < n;
                    const int tok = valid ? tok0 : 0;
                    if (j == cur) nsa_visit_g<1, false>(Ks, Vs, qs, Os, Ms, Ls, tok, valid, t4 & 63);
                    else nsa_visit_g<0, true>(Ks, Vs, qs, Os, Ms, Ls, tok, valid, t4 & 63);
                }
                slot = (slot == 2) ? 0 : slot + 1;
            }
#undef NSA_RI
#undef NSA_ISSUE2
        }
        __syncthreads();
        NSA_TE(4)
        NSA_TS(5)
#pragma unroll
        for (int u = 0; u < 2; u++) {
            NSA_TOK(u)
            const int t5 = t3_ & 63;
            nsa_fold_lds(Os, Ms, Ls, (8 * (t3_ >> 6) + 4 * u + ((t5 & 15) >> 2)) * 4 + (t5 & 3), t5 >> 4, t5 & 3, T[u], p.nsag[ntk_ * 24 + hd_ * 3 + 1], true);
        }
        const u16* kwn = p.kwn + (size_t)bg * S_ * 64;
        const u16* vwnT = p.vwnT + (size_t)bg * 128 * 4096;
        uint2 Tp[2][4];
#pragma unroll
        for (int u = 0; u < 2; u++)
#pragma unroll
            for (int dt = 0; dt < 4; dt++) { Tp[u][dt] = pack4(T[u][dt]); asm volatile("" : "+v"(Tp[u][dt].x), "+v"(Tp[u][dt].y)); }
        {
            const int jlo = max(0, cur - 8);
            nsa_stream<true>(ring, cur - jlo + 1, [&](int i) { return kwn + (size_t)(cur - i) * 4096; }, [&](int i) { return vwnT + (size_t)(cur - i) * 4096; },
                [&](int i, const u16* Ks, const u16* Vs) {
                    const int j = cur - i;
                    const int t4 = get_tid();
                    const int tb_ = 8 * (t4 >> 6) + ((t4 & 15) >> 2);
                    const int tk2[2] = {tb_, tb_ + 4}; const bool vl2[2] = {true, true};
                    if (j == cur) nsa_visit_gn<1, false, 2>(Ks, Vs, qs, Os, Ms, Ls, tk2, vl2, t4 & 63);
                    else if (j == cur - 8) nsa_visit_gn<2, true, 2>(Ks, Vs, qs, Os, Ms, Ls, tk2, vl2, t4 & 63);
                    else nsa_visit_gn<0, true, 2>(Ks, Vs, qs, Os, Ms, Ls, tk2, vl2, t4 & 63);
                });
        }
#pragma unroll
        for (int u = 0; u < 2; u++) {
            NSA_TOK(u)
#pragma unroll
            for (int dt = 0; dt < 4; dt++) T[u][dt] = unpack4(Tp[u][dt]);
            { const int t5 = t3_ & 63; nsa_fold_lds(Os, Ms, Ls, (8 * (t3_ >> 6) + 4 * u + ((t5 & 15) >> 2)) * 4 + (t5 & 3), t5 >> 4, t5 & 3, T[u], p.nsag[ntk_ * 24 + hd_ * 3 + 2], false); }
#pragma unroll
            for (int dt = 0; dt < 4; dt++) *(uint2*)&p.oa[ntk_ * 512 + hd_ * 64 + dt * 16 + ((t3_ & 63) >> 4) * 4] = pack4(T[u][dt]);
        }
        NSA_TE(5)
    }
    if (NSAPROBE) { __syncthreads(); const unsigned long long t1_ = __builtin_amdgcn_s_memrealtime(); while (__builtin_amdgcn_s_memrealtime() - t1_ < tacc_) __builtin_amdgcn_s_sleep(8); }
}

#ifndef CHPROBE
#define CHPROBE 0
#endif
#define CH_TS(k) if (CHPROBE == k) cts_ = __builtin_amdgcn_s_memrealtime();
#define CH_TE(k) if (CHPROBE == k) ctacc_ += __builtin_amdgcn_s_memrealtime() - cts_;
constexpr int RS = 72;
constexpr int RSLOT = 64 * RS;
__device__ __forceinline__ void mm64(const u16* A, int lda, const u16* Bz, int ldb, f32x4 (&acc)[2], int lane, int wv) {
    const int mt = wv >> 1, nt0 = (wv & 1) * 2, kr = lane & 15, qq = lane >> 4;
    bf16x8 a[2], b[2][2];
#pragma unroll
    for (int ks = 0; ks < 2; ks++) {
        a[ks] = *(const bf16x8*)&A[(mt * 16 + kr) * lda + ks * 32 + qq * 8];
#pragma unroll
        for (int i = 0; i < 2; i++) b[ks][i] = *(const bf16x8*)&Bz[((nt0 + i) * 16 + kr) * ldb + ks * 32 + qq * 8];
    }
#pragma unroll
    for (int ks = 0; ks < 2; ks++)
#pragma unroll
        for (int i = 0; i < 2; i++) acc[i] = __builtin_amdgcn_mfma_f32_16x16x32_bf16(a[ks], b[ks][i], acc[i], 0, 0, 0);
}
__device__ __forceinline__ void st_t(u16* dst, int ld, const f32x4& v, int mt, int nt, int lane) {
    uint2 o; o.x = pack2(v[0], v[1]); o.y = pack2(v[2], v[3]);
    *(uint2*)&dst[(nt * 16 + (lane & 15)) * ld + mt * 16 + (lane >> 4) * 4] = o;
}
__device__ __forceinline__ void st_n(u16* dst, int ld, const f32x4& v, int mt, int nt, int lane) {
#pragma unroll
    for (int r = 0; r < 4; r++) dst[(mt * 16 + (lane >> 4) * 4 + r) * ld + nt * 16 + (lane & 15)] = f2bf(v[r]);
}
#define ZACC(a) { a[0] = f32x4{0.f, 0.f, 0.f, 0.f}; a[1] = f32x4{0.f, 0.f, 0.f, 0.f}; }

__device__ void ph_rwkv_chunk(const P& p, int bid, int nb, char* smem) {
    unsigned long long cts_ = 0, ctacc_ = 0;
    u16* sl = (u16*)smem;
    float* tot = (float*)(sl + 14 * RSLOT);
    float* gl = tot + 512;
#define RW_IDX const int tid = get_tid(), lane = tid & 63, wv = tid >> 6, mt = wv >> 1, nt0 = (wv & 1) * 2, kr = lane & 15, qq = lane >> 4; (void)mt; (void)nt0; (void)kr; (void)qq; (void)lane;
    const int nitems = B_ * 128;
    for (int it0 = bid; it0 < nitems; it0 += nb) {
      const int c = it0 & 127, b = it0 >> 7;
      const size_t n0 = (size_t)b * S_ + c * 64;
      __syncthreads();
      bf16x8 xa_[8], wb[2][2], ab[2][2], gb[2][4];
      u16 rc[8][3], rp0[3];
      float w0c[2], a0c[2], hc_[6];
#define S1_LOADW(hh_) { RW_IDX \
          _Pragma("unroll") for (int i = 0; i < 2; i++) { const int cc = (nt0 + i) * 16 + kr; w0c[i] = p.w0[(hh_) * 64 + cc]; a0c[i] = p.a0[(hh_) * 64 + cc]; \
              _Pragma("unroll") for (int ks = 0; ks < 2; ks++) { wb[i][ks] = *(const bf16x8*)&p.w2T[((size_t)(hh_) * 64 + cc) * 64 + ks * 32 + qq * 8]; \
                                                                 ab[i][ks] = *(const bf16x8*)&p.a2T[((size_t)(hh_) * 64 + cc) * 64 + ks * 32 + qq * 8]; } \
              _Pragma("unroll") for (int ks = 0; ks < 4; ks++) gb[i][ks] = *(const bf16x8*)&p.g2T[((size_t)(hh_) * 64 + cc) * 128 + ks * 32 + qq * 8]; } }
#define S2_LOADX(hh_) { RW_IDX const int ch_ = (hh_) * 64 + lane; \
          hc_[0] = p.mu[ch_]; hc_[1] = p.mu[512 + ch_]; hc_[2] = p.mu[1024 + ch_]; hc_[3] = p.k_k[ch_]; hc_[4] = p.k_a[ch_]; hc_[5] = p.r_k[ch_]; \
          _Pragma("unroll") for (int i = 0; i < 8; i++) { const int t = wv * 8 + i; const u16* cr = p.prw + (n0 + t) * CRW; \
              rc[i][0] = cr[ch_]; rc[i][1] = cr[512 + ch_]; rc[i][2] = cr[1024 + ch_]; } \
          rp0[0] = 0; rp0[1] = 0; rp0[2] = 0;     \
          if (c * 64 + wv * 8 > 0) { const u16* pp = p.prw + (n0 + wv * 8 - 1) * CRW; rp0[0] = pp[ch_]; rp0[1] = pp[512 + ch_]; rp0[2] = pp[1024 + ch_]; } }
      S2_LOADX(0)
      {
          RW_IDX
          const int t = tid >> 3, part = tid & 7;
          const size_t n = n0 + t;
          const bool hasprev = (c * 64 + t) > 0;
          u16* dst = p.xact + n * 256 + part * 32;
#pragma unroll
          for (int j = 0; j < 4; j++) {
              const int col = 1536 + part * 32 + j * 8;
              const uint4 cu = *(const uint4*)&p.prw[n * CRW + col];
              uint4 pv = make_uint4(0u, 0u, 0u, 0u);
              if (hasprev) pv = *(const uint4*)&p.prw[(n - 1) * CRW + col];
              const unsigned cw[4] = {cu.x, cu.y, cu.z, cu.w}, pw[4] = {pv.x, pv.y, pv.z, pv.w};
              unsigned ow[4];
#pragma unroll
              for (int e2 = 0; e2 < 4; e2++) {
                  float x0 = __uint_as_float(cw[e2] << 16), x1 = __uint_as_float(cw[e2] & 0xFFFF0000u);
                  const float q0 = __uint_as_float(pw[e2] << 16), q1 = __uint_as_float(pw[e2] & 0xFFFF0000u);
                  x0 = x0 + (q0 - x0) * p.mu[col + 2 * e2]; x1 = x1 + (q1 - x1) * p.mu[col + 2 * e2 + 1];
                  if (part < 2) { x0 = tanhf(x0); x1 = tanhf(x1); }
                  else if (part >= 4) { x0 = sigmoidf_(x0); x1 = sigmoidf_(x1); }
                  ow[e2] = pack2(x0, x1);
              }
              *(uint4*)&dst[j * 8] = make_uint4(ow[0], ow[1], ow[2], ow[3]);
          }
      }
      __syncthreads();
      const u16* xa = p.xact + n0 * 256;
      {
          RW_IDX
#pragma unroll
          for (int k8 = 0; k8 < 8; k8++) xa_[k8] = *(const bf16x8*)&xa[(mt * 16 + kr) * 256 + k8 * 32 + qq * 8];
      }
      S1_LOADW(0)
#pragma unroll 1
      for (int h = 0; h < 8; h++) {
        u16* cd = p.cdat + ((size_t)((b * 8 + h) * 128 + c)) * 4 * 4096;
        LDS_BARRIER();
        CH_TS(1)
        float* LW = (float*)(sl + 8 * RSLOT); float* LA = (float*)(sl + 10 * RSLOT);
        {
            RW_IDX
            f32x4 aw[2], aa2[2], ag[2];
#pragma unroll
            for (int i = 0; i < 2; i++) {
                aw[i] = f32x4{0.f, 0.f, 0.f, 0.f}; aa2[i] = aw[i]; ag[i] = aw[i];
#pragma unroll
                for (int ks = 0; ks < 2; ks++) {
                    aw[i] = __builtin_amdgcn_mfma_f32_16x16x32_bf16(xa_[ks], wb[i][ks], aw[i], 0, 0, 0);
                    aa2[i] = __builtin_amdgcn_mfma_f32_16x16x32_bf16(xa_[2 + ks], ab[i][ks], aa2[i], 0, 0, 0);
                }
#pragma unroll
                for (int ks = 0; ks < 4; ks++) ag[i] = __builtin_amdgcn_mfma_f32_16x16x32_bf16(xa_[4 + ks], gb[i][ks], ag[i], 0, 0, 0);
            }
#pragma unroll
            for (int i = 0; i < 2; i++)
#pragma unroll
                for (int r = 0; r < 4; r++) {
                    const int t = mt * 16 + qq * 4 + r, cc = (nt0 + i) * 16 + kr;
                    const float wl = w0c[i] + aw[i][r];
                    const float z = -wl;
                    const float sp = fmaxf(z, 0.f) + __logf(1.f + __expf(-fabsf(z)));
                    LW[t * 64 + cc] = -__expf(-sp - 0.5f);
                    LA[t * 64 + cc] = sigmoidf_(a0c[i] + aa2[i][r]);
                    p.ob[(n0 + t) * 512 + h * 64 + cc] = f2bf(ag[i][r]);
                }
        }
        LDS_BARRIER();
        CH_TE(1) CH_TS(2)
        {
            RW_IDX
            const int ch = h * 64 + lane;
            const float mur = hc_[0], muk = hc_[1], muv = hc_[2];
            const float kkw = hc_[3], kaw = hc_[4], rkw = hc_[5];
            float rr[8], k2[8], vv[8], kkn[8], aa[8], lg[8], cs[8];
            float run = 0.f;
#pragma unroll
            for (int i = 0; i < 8; i++) {
                const int t = wv * 8 + i; const size_t n = n0 + t;
                float r = bf2f(rc[i][0]), k = bf2f(rc[i][1]), v = bf2f(rc[i][2]);
                const float pr = bf2f(i ? rc[i - 1][0] : rp0[0]), pk = bf2f(i ? rc[i - 1][1] : rp0[1]), pv = bf2f(i ? rc[i - 1][2] : rp0[2]);
                r = r + (pr - r) * mur; k = k + (pk - k) * muk; v = v + (pv - v) * muv;
                const float a = LA[t * 64 + lane];
                lg[i] = LW[t * 64 + lane];
                float kk = k * kkw;
                kkn[i] = kk * __builtin_amdgcn_rsqf(fmaxf(wave_sum(kk * kk), 1e-24f));
                k2[i] = k * (1.f + (a - 1.f) * kaw);
                const float bon = wave_sum(r * k2[i] * rkw);
                if (lane == 0) p.bon[n * 8 + h] = bon;
                rr[i] = r; vv[i] = v; aa[i] = a;
                run += lg[i]; cs[i] = run;
            }
            tot[wv * 64 + lane] = run;
            LDS_BARRIER();
            float off = 0.f, cumL = 0.f;
#pragma unroll
            for (int w2 = 0; w2 < 8; w2++) { const float tv = tot[w2 * 64 + lane]; cumL += tv; if (w2 < wv) off += tv; }
            if (wv == 0) gl[lane] = __expf(cumL);
            unsigned pa[4], pb[4], pk4[4], pv4[4];
#pragma unroll
            for (int i = 0; i < 8; i += 2) {
                float at[2], bt[2], kt[2], rt[2];
#pragma unroll
                for (int e2 = 0; e2 < 2; e2++) {
                    const int ii = i + e2; const int t = wv * 8 + ii;
                    const float cm = off + cs[ii];
                    const float g = __expf(cm), gp = __expf(cm - lg[ii]), gi = __expf(-cm);
                    at[e2] = -kkn[ii] * gp; bt[e2] = kkn[ii] * aa[ii] * gi; kt[e2] = k2[ii] * gi; rt[e2] = rr[ii] * g;
                    sl[0 * RSLOT + t * RS + lane] = f2bf(at[e2]);
                    sl[1 * RSLOT + t * RS + lane] = f2bf(bt[e2]);
                    sl[2 * RSLOT + t * RS + lane] = f2bf(kt[e2]);
                    sl[3 * RSLOT + t * RS + lane] = f2bf(rt[e2]);
                }
                pa[i >> 1] = pack2(at[0], at[1]); pb[i >> 1] = pack2(bt[0], bt[1]);
                pk4[i >> 1] = pack2(kt[0], kt[1]); pv4[i >> 1] = pack2(vv[i], vv[i + 1]);
            }
            *(uint4*)&sl[4 * RSLOT + lane * RS + wv * 8] = make_uint4(pa[0], pa[1], pa[2], pa[3]);
            *(uint4*)&sl[5 * RSLOT + lane * RS + wv * 8] = make_uint4(pb[0], pb[1], pb[2], pb[3]);
            *(uint4*)&sl[6 * RSLOT + lane * RS + wv * 8] = make_uint4(pk4[0], pk4[1], pk4[2], pk4[3]);
            *(uint4*)&sl[7 * RSLOT + lane * RS + wv * 8] = make_uint4(pv4[0], pv4[1], pv4[2], pv4[3]);
        }
        LDS_BARRIER();
        if (h + 1 < 8) { asm volatile("s_waitcnt vmcnt(0)" ::: "memory");
                         S1_LOADW(h + 1) S2_LOADX(h + 1) }
        CH_TE(2) CH_TS(3)
        {
            RW_IDX
            f32x4 acc[2];
            ZACC(acc); mm64(sl + 1 * RSLOT, RS, sl + 0 * RSLOT, RS, acc, lane, wv);
#pragma unroll
            for (int i = 0; i < 2; i++) {
                f32x4 pm;
#pragma unroll
                for (int r = 0; r < 4; r++) {
                    const int m = mt * 16 + qq * 4 + r, n = (nt0 + i) * 16 + kr;
                    if (!(m < n)) acc[i][r] = 0.f;
                    pm[r] = acc[i][r] + ((m == n) ? 1.f : 0.f);
                }
                st_t(sl + 8 * RSLOT, RS, acc[i], mt, nt0 + i, lane);
                st_n(sl + 9 * RSLOT, RS, acc[i], mt, nt0 + i, lane);
                st_t(sl + 13 * RSLOT, RS, pm, mt, nt0 + i, lane);
            }
            ZACC(acc); mm64(sl + 0 * RSLOT, RS, sl + 2 * RSLOT, RS, acc, lane, wv);
#pragma unroll
            for (int i = 0; i < 2; i++) {
#pragma unroll
                for (int r = 0; r < 4; r++) { const int m = mt * 16 + qq * 4 + r, n = (nt0 + i) * 16 + kr; if (!(m > n)) acc[i][r] = 0.f; }
                st_t(sl + 10 * RSLOT, RS, acc[i], mt, nt0 + i, lane);
            }
            ZACC(acc); mm64(sl + 1 * RSLOT, RS, sl + 3 * RSLOT, RS, acc, lane, wv);
#pragma unroll
            for (int i = 0; i < 2; i++) {
#pragma unroll
                for (int r = 0; r < 4; r++) { const int m = mt * 16 + qq * 4 + r, n = (nt0 + i) * 16 + kr; if (m > n) acc[i][r] = 0.f; }
                st_t(sl + 11 * RSLOT, RS, acc[i], mt, nt0 + i, lane);
            }
            ZACC(acc); mm64(sl + 2 * RSLOT, RS, sl + 3 * RSLOT, RS, acc, lane, wv);
#pragma unroll
            for (int i = 0; i < 2; i++) {
#pragma unroll
                for (int r = 0; r < 4; r++) { const int m = mt * 16 + qq * 4 + r, n = (nt0 + i) * 16 + kr; if (m > n) acc[i][r] = 0.f; }
                st_t(sl + 12 * RSLOT, RS, acc[i], mt, nt0 + i, lane);
            }
        }
        LDS_BARRIER();
        CH_TE(3) CH_TS(4)
        u16* X = sl + 8 * RSLOT; u16* XT = sl + 9 * RSLOT; u16* X2 = sl + 0 * RSLOT; u16* X2T = sl + 1 * RSLOT;
        u16* Pc = sl + 13 * RSLOT; u16* Pn = sl + 2 * RSLOT;
#pragma unroll 1
        for (int j = 1; j <= 6; j++) {
            RW_IDX
            f32x4 acc[2];
            if (j <= 5) {
                ZACC(acc); mm64(X, RS, XT, RS, acc, lane, wv);
#pragma unroll
                for (int i = 0; i < 2; i++) { st_t(X2T, RS, acc[i], mt, nt0 + i, lane); st_n(X2, RS, acc[i], mt, nt0 + i, lane); }
            }
            if (j >= 2) {
                ZACC(acc); mm64(XT, RS, Pc, RS, acc, lane, wv);
#pragma unroll
                for (int i = 0; i < 2; i++) {
                    const uint2 pv = *(const uint2*)&Pc[((nt0 + i) * 16 + kr) * RS + mt * 16 + qq * 4];
                    acc[i][0] += __uint_as_float(pv.x << 16); acc[i][1] += __uint_as_float(pv.x & 0xFFFF0000u);
                    acc[i][2] += __uint_as_float(pv.y << 16); acc[i][3] += __uint_as_float(pv.y & 0xFFFF0000u);
                    st_t(Pn, RS, acc[i], mt, nt0 + i, lane);
                }
            }
            LDS_BARRIER();
            if (j >= 2) { u16* tp = Pc; Pc = Pn; Pn = tp; }
            if (j <= 5) { u16* tx = X; X = X2; X2 = tx; tx = XT; XT = X2T; X2T = tx; }
        }
        CH_TE(4) CH_TS(5)
        u16* TT = Pc;
        {
            RW_IDX
            f32x4 acc[2];
            ZACC(acc); mm64(TT, RS, sl + 4 * RSLOT, RS, acc, lane, wv);
#pragma unroll
            for (int i = 0; i < 2; i++) st_t(sl + 0 * RSLOT, RS, acc[i], mt, nt0 + i, lane);
            ZACC(acc); mm64(sl + 10 * RSLOT, RS, TT, RS, acc, lane, wv);
#pragma unroll
            for (int i = 0; i < 2; i++) st_t(sl + 8 * RSLOT, RS, acc[i], mt, nt0 + i, lane);
        }
        LDS_BARRIER();
        {
            RW_IDX
            f32x4 acc[2];
            ZACC(acc); mm64(sl + 8 * RSLOT, RS, sl + 7 * RSLOT, RS, acc, lane, wv);
#pragma unroll
            for (int i = 0; i < 2; i++) st_t(sl + 9 * RSLOT, RS, acc[i], mt, nt0 + i, lane);
            ZACC(acc); mm64(sl + 0 * RSLOT, RS, sl + 5 * RSLOT, RS, acc, lane, wv);
#pragma unroll
            for (int i = 0; i < 2; i++) {
                const int n = (nt0 + i) * 16 + kr; const float gn = gl[n];
#pragma unroll
                for (int r = 0; r < 4; r++) { const int m = mt * 16 + qq * 4 + r; acc[i][r] = acc[i][r] * gn + ((m == n) ? gn : 0.f); }
                st_t(cd, 64, acc[i], mt, nt0 + i, lane);
            }
            ZACC(acc); mm64(sl + 0 * RSLOT, RS, sl + 11 * RSLOT, RS, acc, lane, wv);
#pragma unroll
            for (int i = 0; i < 2; i++) {
                const uint2 rv = *(const uint2*)&sl[3 * RSLOT + ((nt0 + i) * 16 + kr) * RS + mt * 16 + qq * 4];
                acc[i][0] += __uint_as_float(rv.x << 16); acc[i][1] += __uint_as_float(rv.x & 0xFFFF0000u);
                acc[i][2] += __uint_as_float(rv.y << 16); acc[i][3] += __uint_as_float(rv.y & 0xFFFF0000u);
                st_t(cd + 2 * 4096, 64, acc[i], mt, nt0 + i, lane);
            }
        }
        LDS_BARRIER();
        {
            RW_IDX
            f32x4 acc[2];
            ZACC(acc);
            mm64(sl + 5 * RSLOT, RS, sl + 9 * RSLOT, RS, acc, lane, wv);
            mm64(sl + 6 * RSLOT, RS, sl + 7 * RSLOT, RS, acc, lane, wv);
#pragma unroll
            for (int i = 0; i < 2; i++) {
#pragma unroll
                for (int r = 0; r < 4; r++) acc[i][r] *= gl[mt * 16 + qq * 4 + r];
                st_t(cd + 1 * 4096, 64, acc[i], mt, nt0 + i, lane);
            }
            ZACC(acc);
            mm64(sl + 9 * RSLOT, RS, sl + 11 * RSLOT, RS, acc, lane, wv);
            mm64(sl + 7 * RSLOT, RS, sl + 12 * RSLOT, RS, acc, lane, wv);
#pragma unroll
            for (int i = 0; i < 2; i++) st_t(cd + 3 * 4096, 64, acc[i], mt, nt0 + i, lane);
        }
        CH_TE(5)
      }
    }
    if (CHPROBE) { __syncthreads(); const unsigned long long t1_ = __builtin_amdgcn_s_memrealtime(); while (__builtin_amdgcn_s_memrealtime() - t1_ < ctacc_) __builtin_amdgcn_s_sleep(8); }
}

__device__ void ph_rwkv_seq(const P& p, int bid, int nb, char* smem) {
    u16* SL = (u16*)smem;
    const int tid = get_tid(), lane = tid & 63, wv = __builtin_amdgcn_readfirstlane(tid >> 6);
    const int kr = lane & 15, qq = lane >> 4, chn = wv >> 2, vt = wv & 3;
    for (int pair = bid; pair < B_ * 4; pair += nb) {
        const int bh = pair * 2 + chn;
        u16* mySL = SL + chn * RSLOT;
        __syncthreads();
#pragma unroll
        for (int ks = 0; ks < 2; ks++) *(uint4*)&mySL[(vt * 16 + kr) * RS + ks * 32 + qq * 8] = make_uint4(0u, 0u, 0u, 0u);
        u16* cbase = p.cdat + (size_t)bh * 128 * 4 * 4096;
        bf16x8 GA0[4][2], GA1[4][2], GA2[4][2], GA3[4][2]; u32x2 H0[4], H1[4], H2[4], H3[4];
#define SEQ_LD(GAx, Hx, c) { const u16* g0_ = cbase + (size_t)(c) * 4 * 4096 + kr * 64 + qq * 8; const u16* g1_ = g0_ + 2048; \
            const u16* hp_ = cbase + (size_t)(c) * 4 * 4096 + 4096 + (vt * 16 + kr) * 64 + qq * 4; \
            GAx[0][0] = gload_b128<0>(g0_); GAx[0][1] = gload_b128<64>(g0_); GAx[1][0] = gload_b128<2048>(g0_); GAx[1][1] = gload_b128<2112>(g0_); \
            GAx[2][0] = gload_b128<0>(g1_); GAx[2][1] = gload_b128<64>(g1_); GAx[3][0] = gload_b128<2048>(g1_); GAx[3][1] = gload_b128<2112>(g1_); \
            Hx[0] = gload_b64<0>(hp_); Hx[1] = gload_b64<32>(hp_); Hx[2] = gload_b64<64>(hp_); Hx[3] = gload_b64<96>(hp_); }
#define SEQ_STEP(GAx, Hx, c, nw) { \
            if ((nw) == 48) asm volatile("s_waitcnt vmcnt(48)" ::: "memory"); else if ((nw) == 36) asm volatile("s_waitcnt vmcnt(36)" ::: "memory"); \
            else if ((nw) == 24) asm volatile("s_waitcnt vmcnt(24)" ::: "memory"); else asm volatile("s_waitcnt vmcnt(12)" ::: "memory"); \
              \
            asm volatile("" : "+v"(GAx[0][0]), "+v"(GAx[0][1]), "+v"(GAx[1][0]), "+v"(GAx[1][1]), "+v"(GAx[2][0]), "+v"(GAx[2][1]), "+v"(GAx[3][0]), "+v"(GAx[3][1]), \
                              "+v"(Hx[0]), "+v"(Hx[1]), "+v"(Hx[2]), "+v"(Hx[3]) :: "memory"); \
            bf16x8 Z0[2]; \
            _Pragma("unroll") for (int ks = 0; ks < 2; ks++) Z0[ks] = *(const bf16x8*)&mySL[(vt * 16 + kr) * RS + ks * 32 + qq * 8]; \
            f32x4 zs[4]; \
            _Pragma("unroll") for (int m4 = 0; m4 < 4; m4++) { \
                zs[m4] = unpack4(make_uint2(Hx[m4].x, Hx[m4].y)); \
                _Pragma("unroll") for (int ks = 0; ks < 2; ks++) zs[m4] = __builtin_amdgcn_mfma_f32_16x16x32_bf16(GAx[m4][ks], Z0[ks], zs[m4], 0, 0, 0); } \
            u16* sn_ = cbase + (size_t)(c) * 4 * 4096 + 1 * 4096 + (vt * 16 + kr) * 64 + qq * 4; \
            _Pragma("unroll") for (int m4 = 0; m4 < 4; m4++) { \
                const uint2 pk_ = pack4(zs[m4]); \
                *(uint2*)&mySL[(vt * 16 + kr) * RS + m4 * 16 + qq * 4] = pk_; \
                *(uint2*)&sn_[m4 * 16] = pk_; } \
            asm volatile("" ::: "memory"); \
            if ((c) + 4 < 128) SEQ_LD(GAx, Hx, (c) + 4) }
        asm volatile("s_waitcnt vmcnt(0)" ::: "memory");
        SEQ_LD(GA0, H0, 0) SEQ_LD(GA1, H1, 1) SEQ_LD(GA2, H2, 2) SEQ_LD(GA3, H3, 3)
#pragma unroll 1
        for (int c = 0; c < 128; c += 4) {
            const bool first = (c == 0), lastt = (c == 124);
            SEQ_STEP(GA0, H0, c, first ? 36 : 48)
            SEQ_STEP(GA1, H1, c + 1, (first || lastt) ? 36 : 48)
            SEQ_STEP(GA2, H2, c + 2, first ? 36 : (lastt ? 24 : 48))
            SEQ_STEP(GA3, H3, c + 3, lastt ? 12 : 48)
        }
        asm volatile("s_waitcnt vmcnt(0)" ::: "memory");
#undef SEQ_LD
#undef SEQ_STEP
    }
}

__device__ void ph_rwkv_out(const P& p, int bid, int nb, char* smem) {
    const int tid = get_tid(), lane = tid & 63, wv = tid >> 6;
    const int kr = lane & 15, qq = lane >> 4;
    for (int it = bid * NW + wv; it < B_ * 8 * 128; it += nb * NW) {
        const int c = it & 127, bh = it >> 7, b = bh >> 3, h = bh & 7;
        const u16* cd = p.cdat + ((size_t)bh * 128 + c) * 4 * 4096;
        f32x4 ys[4][4];
#pragma unroll
        for (int mt = 0; mt < 4; mt++)
#pragma unroll
            for (int nt = 0; nt < 4; nt++) ys[mt][nt] = unpack4(*(const uint2*)&cd[3 * 4096 + (nt * 16 + kr) * 64 + mt * 16 + qq * 4]);
        if (c > 0) {
            const u16* s0 = cd - 4 * 4096 + 1 * 4096;
#pragma unroll
            for (int ks = 0; ks < 2; ks++) {
                bf16x8 af[4], bq[4];
#pragma unroll
                for (int mt = 0; mt < 4; mt++) af[mt] = *(const bf16x8*)&s0[(mt * 16 + kr) * 64 + ks * 32 + qq * 8];
#pragma unroll
                for (int nt = 0; nt < 4; nt++) bq[nt] = *(const bf16x8*)&cd[2 * 4096 + (nt * 16 + kr) * 64 + ks * 32 + qq * 8];
#pragma unroll
                for (int mt = 0; mt < 4; mt++)
#pragma unroll
                    for (int nt = 0; nt < 4; nt++) ys[mt][nt] = __builtin_amdgcn_mfma_f32_16x16x32_bf16(af[mt], bq[nt], ys[mt][nt], 0, 0, 0);
            }
        }
#pragma unroll
        for (int nt = 0; nt < 4; nt++) {
            float s1 = 0.f, s2 = 0.f;
#pragma unroll
            for (int mt = 0; mt < 4; mt++)
#pragma unroll
                for (int r = 0; r < 4; r++) { s1 += ys[mt][nt][r]; s2 += ys[mt][nt][r] * ys[mt][nt][r]; }
            s1 = xrow_sum(s1); s2 = xrow_sum(s2);
            const float mean = s1 * (1.f / 64.f);
            const float var = fmaxf(s2 * (1.f / 64.f) - mean * mean, 0.f);
            const float rstd = rsqrtf(var + 64e-5f);
            const int t = nt * 16 + kr;
            const size_t n = (size_t)b * S_ + c * 64 + t;
            const float bon = p.bon[n * 8 + h];
#pragma unroll
            for (int mt = 0; mt < 4; mt++) {
                const int vch = h * 64 + mt * 16 + qq * 4;
                const f32x4 vcf = unpack4(*(const uint2*)&p.prw[n * CRW + 1024 + vch]);
                const f32x4 vpf = (c * 64 + t > 0) ? unpack4(*(const uint2*)&p.prw[(n - 1) * CRW + 1024 + vch]) : f32x4{0.f, 0.f, 0.f, 0.f};
                const f32x4 ggf = unpack4(*(const uint2*)&p.ob[n * 512 + vch]);
                const float4 lw = *(const float4*)&p.ln_w[vch], lb = *(const float4*)&p.ln_b[vch], mv = *(const float4*)&p.mu[1024 + vch];
                const float lwa[4] = {lw.x, lw.y, lw.z, lw.w}, lba[4] = {lb.x, lb.y, lb.z, lb.w}, mva[4] = {mv.x, mv.y, mv.z, mv.w};
                f32x4 o;
#pragma unroll
                for (int r = 0; r < 4; r++) {
                    const float vsh = vcf[r] + (vpf[r] - vcf[r]) * mva[r];
                    o[r] = ((ys[mt][nt][r] - mean) * rstd * lwa[r] + lba[r] + bon * vsh) * ggf[r];
                }
                *(uint2*)&p.ob[n * 512 + vch] = pack4(o);
            }
        }
    }
}

__device__ __forceinline__ void unpack8(const uint4& u, f32x4& a, f32x4& b) {
    a = f32x4{__uint_as_float(u.x << 16), __uint_as_float(u.x & 0xFFFF0000u), __uint_as_float(u.y << 16), __uint_as_float(u.y & 0xFFFF0000u)};
    b = f32x4{__uint_as_float(u.z << 16), __uint_as_float(u.z & 0xFFFF0000u), __uint_as_float(u.w << 16), __uint_as_float(u.w & 0xFFFF0000u)};
}
struct EpiMerge {
    u16* merged; u16* tmp2; int pass;
    __device__ __forceinline__ void operator()(const f32x4 (&acc)[2][2][4][2], const GUnit& u, int, int, int, int) const {
        const int t2_ = get_tid(), wid_ = __builtin_amdgcn_readfirstlane(t2_ >> 6), wr = wid_ >> 2, wc = wid_ & 3, fr = t2_ & 15, fq = (t2_ >> 4) & 3;
        const int row0 = u.pm * 256 + wr * 64 + fr, col0 = u.pn * 256 + wc * 32 + 8 * fq;
#pragma unroll
        for (int ai = 0; ai < 2; ++ai)
#pragma unroll
            for (int m = 0; m < 4; ++m) {
                const size_t off = (size_t)(row0 + ai * 128 + m * 16) * D_ + col0;
                uint4 m1[2], m2[2];
                if (pass == 1 || pass == 3) {
#pragma unroll
                    for (int bj = 0; bj < 2; ++bj) { m1[bj] = *(const uint4*)&merged[off + bj * 128]; if (pass == 3) m2[bj] = *(const uint4*)&tmp2[off + bj * 128]; }
                }
#pragma unroll
                for (int bj = 0; bj < 2; ++bj) {
                    f32x4 v0 = acc[ai][bj][m][0], v1 = acc[ai][bj][m][1];
                    if (pass == 1) { f32x4 a0, a1; unpack8(m1[bj], a0, a1);
#pragma unroll
                        for (int r = 0; r < 4; r++) { v0[r] = a0[r] * sigmoidf_(v0[r]); v1[r] = a1[r] * sigmoidf_(v1[r]); } }
                    if (pass == 3) { f32x4 a0, a1, b0, b1; unpack8(m1[bj], a0, a1); unpack8(m2[bj], b0, b1);
#pragma unroll
                        for (int r = 0; r < 4; r++) { v0[r] = a0[r] + b0[r] * sigmoidf_(v0[r]); v1[r] = a1[r] + b1[r] * sigmoidf_(v1[r]); } }
                    *(uint4*)&((pass == 2) ? tmp2 : merged)[off + bj * 128] = pack8(v0, v1);
                }
                asm volatile("" ::: "memory");
            }
    }
};
__device__ void ph_merge(const P& p, int bid, int nb, char* smem) {
    u16* tmp2 = (u16*)p.x1;
#pragma unroll 1
    for (int pass = 0; pass < 4; ++pass) {
        const int K = (pass & 1) ? D_ : 512;
        const u16* A = (pass & 1) ? p.hbuf : (pass == 0 ? p.oa : p.ob);
        const u16* Bt = (pass == 0) ? p.wpaT : (pass == 1 ? p.wgT : (pass == 2 ? p.wpbT : p.wgT + (size_t)1024 * D_));
        DenseSched S; S.init(NTOK, D_, K, Bt, nb, bid);
        EpiMerge E{p.merged, tmp2, pass};
        gemm256(smem, (const char*)A, K, S, E);
    }
}

struct EpiOutproj {
    const float* x; float* x1;
    __device__ __forceinline__ void operator()(const f32x4 (&acc)[2][2][4][2], const GUnit& u, int, int, int, int) const {
        const int t2_ = get_tid(), wid_ = __builtin_amdgcn_readfirstlane(t2_ >> 6), wr = wid_ >> 2, wc = wid_ & 3, fr = t2_ & 15, fq = (t2_ >> 4) & 3;
        const int row0 = u.pm * 256 + wr * 64 + fr, col0 = u.pn * 256 + wc * 32 + 4 * fq;
#pragma unroll
        for (int ai = 0; ai < 2; ++ai)
#pragma unroll
            for (int m = 0; m < 4; ++m) {
                const size_t off = (size_t)(row0 + ai * 128 + m * 16) * D_ + col0;
                f32x4 xin[2][2];
#pragma unroll
                for (int bj = 0; bj < 2; ++bj)
#pragma unroll
                    for (int n = 0; n < 2; ++n) xin[bj][n] = *(const f32x4*)&x[off + bj * 128 + n * 16];
#pragma unroll
                for (int bj = 0; bj < 2; ++bj)
#pragma unroll
                    for (int n = 0; n < 2; ++n) *(f32x4*)&x1[off + bj * 128 + n * 16] = xin[bj][n] + acc[ai][bj][m][n];
                asm volatile("" ::: "memory");
            }
    }
};
__device__ void ph_outproj(const P& p, int bid, int nb, char* smem) {
    DenseSched S; S.init(NTOK, D_, D_, p.woutT, nb, bid);
    EpiOutproj E{p.x, p.x1};
    gemm256(smem, (const char*)p.merged, D_, S, E);
}

__device__ __forceinline__ float red8f(float x) {
    x += dppf<0xB1>(x);
    x += dppf<0x4E>(x);
    x += dppf<0x141>(x);
    return x;
}
__device__ void ph_route(const P& p, int bid, int nb, char* smem) {
    float* wr = (float*)smem;
    const int tid = get_tid(), lane = tid & 63, wv = tid >> 6;
    {
        u16* Tl = (u16*)smem;
        const int t = get_tid();
        const int lrow = t >> 3, lc8 = (t & 7) * 8;
        const int sslot = t >> 3, skc = t & 7;
        const int scol = (sslot & 32) + perm32(sslot & 31);
        constexpr int NT13 = NEXP * 2 * 4 * 16, NT2 = NEXP * 16 * 4;
        for (int tile = bid; tile < NT13 + NT2; tile += nb) {
            const float* src; u16* dst; int N, Kd;
            if (tile < NT13) {
                const int kt = tile & 15, sg = (tile >> 4) & 3, half = (tile >> 6) & 1, e = tile >> 7;
                const int sl0 = sg * 64;
                N = 256; Kd = D_;
                src = ((sl0 >> 7) ? p.e_w3 : p.e_w1) + (size_t)e * D_ * 256 + (size_t)(kt * 64) * 256 + half * 128 + (sl0 & 127);
                dst = p.ew1T + ((size_t)e * 512 + half * 256 + sl0) * D_ + kt * 64;
            } else {
                const int t2 = tile - NT13;
                const int kt = t2 & 3, sg = (t2 >> 2) & 15, e = t2 >> 6;
                N = D_; Kd = 256;
                src = p.e_w2 + (size_t)e * 256 * D_ + (size_t)(kt * 64) * D_ + sg * 64;
                dst = p.ew2T + ((size_t)e * D_ + sg * 64) * 256 + kt * 64;
            }
            const float4 f0 = *(const float4*)&src[(size_t)lrow * N + lc8], f1 = *(const float4*)&src[(size_t)lrow * N + lc8 + 4];
            __syncthreads();
            const unsigned h0 = pack2(f0.x, f0.y), h1 = pack2(f0.z, f0.w), h2 = pack2(f1.x, f1.y), h3 = pack2(f1.z, f1.w);
            Tl[(lc8 + 0) * 72 + lrow] = (u16)(h0 & 0xFFFFu); Tl[(lc8 + 1) * 72 + lrow] = (u16)(h0 >> 16);
            Tl[(lc8 + 2) * 72 + lrow] = (u16)(h1 & 0xFFFFu); Tl[(lc8 + 3) * 72 + lrow] = (u16)(h1 >> 16);
            Tl[(lc8 + 4) * 72 + lrow] = (u16)(h2 & 0xFFFFu); Tl[(lc8 + 5) * 72 + lrow] = (u16)(h2 >> 16);
            Tl[(lc8 + 6) * 72 + lrow] = (u16)(h3 & 0xFFFFu); Tl[(lc8 + 7) * 72 + lrow] = (u16)(h3 >> 16);
            __syncthreads();
            *(uint4*)&dst[(size_t)sslot * Kd + skc * 8] = *(const uint4*)&Tl[scol * 72 + skc * 8];
        }
        __syncthreads();
    }
    for (int i = tid; i < 1024 * 36; i += NT) {
        const int k = i / 36, j = i - k * 36;
        const int kp = (k & ~31) + ((k & 3) << 3) + ((k >> 2) & 7);
        wr[kp * 36 + j] = (j < 4) ? p.w_grp[k * 4 + j] : p.w_exp[k * 32 + (j - 4)];
    }
    int* lcount = (int*)(smem + 1024 * 36 * 4);
    if (tid < 32) lcount[tid] = 0;
    __syncthreads();
    const int sub = lane & 7, tk = lane >> 3;
    for (int n0 = (bid * NW + wv) * 16; n0 < NTOK; n0 += nb * NW * 16) {
        float acc[2][36]; float ss[2] = {0.f, 0.f};
#pragma unroll
        for (int t = 0; t < 2; t++)
#pragma unroll
            for (int j = 0; j < 36; j++) acc[t][j] = 0.f;
#pragma unroll 1
        for (int i0 = 0; i0 < 32; i0 += 4) {
            float4 xv[2][4];
#pragma unroll
            for (int t = 0; t < 2; t++)
#pragma unroll
                for (int i = 0; i < 4; i++) xv[t][i] = *(const float4*)&p.x1[(size_t)(n0 + 8 * t + tk) * D_ + (i0 + i) * 32 + sub * 4];
#pragma unroll
            for (int i = 0; i < 4; i++) {
                const int k0 = (i0 + i) * 32 + sub * 4;
                const float4 gf = *(const float4*)&p.g_ffn[k0];
                float hv[2][4];
#pragma unroll
                for (int t = 0; t < 2; t++) {
                    const float4 x = xv[t][i];
                    ss[t] += x.x * x.x + x.y * x.y + x.z * x.z + x.w * x.w;
                    hv[t][0] = x.x * gf.x; hv[t][1] = x.y * gf.y; hv[t][2] = x.z * gf.z; hv[t][3] = x.w * gf.w;
                    uint2 o; o.x = pack2(hv[t][0], hv[t][1]); o.y = pack2(hv[t][2], hv[t][3]);
                    *(uint2*)&p.hbuf[(size_t)(n0 + 8 * t + tk) * D_ + k0] = o;
                }
#pragma unroll
                for (int e2 = 0; e2 < 4; e2++) {
                    asm volatile("" ::: "memory");
                    const float* wrow = wr + ((i0 + i) * 32 + e2 * 8 + sub) * 36;
#pragma unroll
                    for (int j4 = 0; j4 < 9; j4++) {
                        const float4 wv4 = *(const float4*)&wrow[j4 * 4];
#pragma unroll
                        for (int t = 0; t < 2; t++) {
                            acc[t][j4 * 4 + 0] += hv[t][e2] * wv4.x; acc[t][j4 * 4 + 1] += hv[t][e2] * wv4.y;
                            acc[t][j4 * 4 + 2] += hv[t][e2] * wv4.z; acc[t][j4 * 4 + 3] += hv[t][e2] * wv4.w;
                        }
                    }
                }
            }
        }
#pragma unroll
        for (int t = 0; t < 2; t++) {
            const size_t n = (size_t)n0 + 8 * t + tk;
            const float sst = red8f(ss[t]);
#pragma unroll
            for (int j = 0; j < 36; j++) acc[t][j] = red8f(acc[t][j]);
            const float rs = rsqrtf(sst * (1.f / D_) + 1e-6f);
            if (sub == 0) {
                p.rsb[n] = rs;
                float gl[4]; int gs = 0;
#pragma unroll
                for (int j = 0; j < 4; j++) gl[j] = acc[t][j] * rs + p.b_grp[j];
                float gm = gl[0];
#pragma unroll
                for (int j = 1; j < 4; j++) if (gl[j] > gm) { gm = gl[j]; gs = j; }
                float gsum = 0.f;
#pragma unroll
                for (int j = 0; j < 4; j++) gsum += __expf(gl[j] - gm);
                const float pg = 1.f / gsum;
                float el[8]; float em = -3.0e38f;
#pragma unroll
                for (int j = 0; j < 8; j++) {
                    float a = (gs == 0) ? acc[t][4 + j] : ((gs == 1) ? acc[t][12 + j] : ((gs == 2) ? acc[t][20 + j] : acc[t][28 + j]));
                    a = a * rs + p.b_exp[gs * 8 + j];
                    el[j] = a; em = fmaxf(em, a);
                }
                int j0 = 0, j1 = -1; float v0 = -3.0e38f, v1 = -3.0e38f;
#pragma unroll
                for (int j = 0; j < 8; j++) { el[j] = __expf(el[j] - em); }
#pragma unroll
                for (int j = 0; j < 8; j++) { if (el[j] > v0) { v0 = el[j]; j0 = j; } }
#pragma unroll
                for (int j = 0; j < 8; j++) { if (j != j0 && el[j] > v1) { v1 = el[j]; j1 = j; } }
                const float den = v0 + v1;
                const int e0 = gs * 8 + j0, e1 = gs * 8 + j1;
                p.tok_e[n * 2] = e0; p.tok_e[n * 2 + 1] = e1;
                p.tok_gate[n * 2] = pg * v0 / den; p.tok_gate[n * 2 + 1] = pg * v1 / den;
                atomicAdd(&lcount[e0], 1); atomicAdd(&lcount[e1], 1);
            }
        }
    }
    __syncthreads();
    { const int t2 = get_tid(); if (t2 < 32) { const int c = lcount[t2]; if (c) atomicAdd(&p.counts[t2], c); } }
}

__device__ void ph_scatter(const P& p, int bid, int nb, char* smem) {
    int* offl = (int*)smem;
    int* hist = offl + 64;
    int* gbase = hist + 32;
    const int tid = get_tid();
    if (tid == 0) {
        int off = 0;
        for (int e = 0; e < NEXP; e++) { offl[e] = off; off += p.counts[e]; }
        offl[NEXP] = off;
    }
    if (bid == 0 && tid == 64) {
        int off = 0, nb_ = 0;
        for (int e = 0; e < NEXP; e++) {
            const int c = p.counts[e];
            p.offs[e] = off;
            for (int r = 0; r < c; r += 256) { p.blk_e[nb_] = e; p.blk_r0[nb_] = off + r; nb_++; }
            off += c;
        }
        p.offs[NEXP] = off;
        *p.nblk = nb_;
    }
    for (int base = bid * NT; base < NTOK * 2; base += nb * NT) {
        __syncthreads();
        if (tid < 32) hist[tid] = 0;
        __syncthreads();
        const int i = base + tid;
        const int e = p.tok_e[i];
        const int rl = atomicAdd(&hist[e], 1);
        __syncthreads();
        if (tid < 32) gbase[tid] = atomicAdd(&p.cursor[tid], hist[tid]);
        __syncthreads();
        const int slot = offl[e] + gbase[e] + rl;
        p.list_tok[slot] = i >> 1; p.list_gate[slot] = p.tok_gate[i]; p.tokslot[i] = slot;
    }
}
template <int CTS>
struct MoeSched {
    const P* pp; int nunits, G, c; unsigned rowbytes; const u16* Bt; size_t b_estride, b_tstride;
    bool gather;
    __device__ __forceinline__ bool next(int i, GUnit& u) const {
        const int L = i * G + c; if (L >= nunits) return false;
        int wgid = L; { const int q = nunits >> 3, r = nunits & 7, xcd = wgid & 7, off = wgid >> 3; wgid = (xcd < r ? xcd * (q + 1) : r * (q + 1) + (xcd - r) * q) + off; }
        u.pm = wgid / CTS; u.pn = wgid & (CTS - 1); return true;
    }
    __device__ __forceinline__ unsigned a_off(const GUnit& u, int h, int R) const {
        const P& p = *pp;
        const int e = __builtin_amdgcn_readfirstlane(p.blk_e[u.pm]), rend = __builtin_amdgcn_readfirstlane(p.offs[e + 1]);
        int sl = __builtin_amdgcn_readfirstlane(p.blk_r0[u.pm]) + h * 128 + R; if (sl >= rend) sl = rend - 1;
        return (unsigned)(gather ? p.list_tok[sl] : sl) * rowbytes;
    }
    __device__ __forceinline__ const char* b_ptr(const GUnit& u) const { return (const char*)(Bt + (size_t)__builtin_amdgcn_readfirstlane(pp->blk_e[u.pm]) * b_estride + (size_t)u.pn * b_tstride); }
};
struct EpiMoe1 {
    const P* pp;
    __device__ __forceinline__ void operator()(const f32x4 (&acc)[2][2][4][2], const GUnit& u, int, int, int, int) const {
        const int t2_ = get_tid(), wid_ = __builtin_amdgcn_readfirstlane(t2_ >> 6), wr = wid_ >> 2, wc = wid_ & 3, fr = t2_ & 15, fq = (t2_ >> 4) & 3;
        const P& p = *pp;
        const int e = __builtin_amdgcn_readfirstlane(p.blk_e[u.pm]), r0 = __builtin_amdgcn_readfirstlane(p.blk_r0[u.pm]), rend = __builtin_amdgcn_readfirstlane(p.offs[e + 1]);
#pragma unroll
        for (int ai = 0; ai < 2; ++ai)
#pragma unroll
            for (int m = 0; m < 4; ++m) {
                const int sl = r0 + ai * 128 + wr * 64 + m * 16 + fr;
                if (sl < rend) {
                    const float rs = p.rsb[p.list_tok[sl]];
                    f32x4 v[2];
#pragma unroll
                    for (int n = 0; n < 2; ++n)
#pragma unroll
                        for (int r = 0; r < 4; r++) { const float a = acc[ai][0][m][n][r] * rs; v[n][r] = a * sigmoidf_(a) * (acc[ai][1][m][n][r] * rs); }
                    *(uint4*)&p.hid[(size_t)sl * 256 + u.pn * 128 + wc * 32 + 8 * fq] = pack8(v[0], v[1]);
                }
            }
    }
};
__device__ void ph_moe1(const P& p, int bid, int nb, char* smem) {
    MoeSched<2> S{&p, __builtin_amdgcn_readfirstlane(*p.nblk) * 2, nb, bid, (unsigned)(D_ * 2), p.ew1T, (size_t)512 * D_, (size_t)256 * D_, true};
    EpiMoe1 E{&p};
    gemm256(smem, (const char*)p.hbuf, D_, S, E);
}
struct EpiMoe2 {
    const P* pp;
    __device__ __forceinline__ void operator()(const f32x4 (&acc)[2][2][4][2], const GUnit& u, int, int, int, int) const {
        const int t2_ = get_tid(), wid_ = __builtin_amdgcn_readfirstlane(t2_ >> 6), wr = wid_ >> 2, wc = wid_ & 3, fr = t2_ & 15, fq = (t2_ >> 4) & 3;
        const P& p = *pp;
        const int e = __builtin_amdgcn_readfirstlane(p.blk_e[u.pm]), r0 = __builtin_amdgcn_readfirstlane(p.blk_r0[u.pm]), rend = __builtin_amdgcn_readfirstlane(p.offs[e + 1]);
#pragma unroll
        for (int ai = 0; ai < 2; ++ai)
#pragma unroll
            for (int m = 0; m < 4; ++m) {
                const int sl = r0 + ai * 128 + wr * 64 + m * 16 + fr;
                if (sl < rend) {
                    const float gt = p.list_gate[sl];
                    u16* yp = p.ybuf + (size_t)sl * D_ + u.pn * 256 + wc * 32 + 8 * fq;
#pragma unroll
                    for (int bj = 0; bj < 2; ++bj) *(uint4*)&yp[bj * 128] = pack8(acc[ai][bj][m][0] * gt, acc[ai][bj][m][1] * gt);
                }
            }
    }
};
__device__ void ph_moe2(const P& p, int bid, int nb, char* smem) {
    MoeSched<4> S{&p, __builtin_amdgcn_readfirstlane(*p.nblk) * 4, nb, bid, 512u, p.ew2T, (size_t)D_ * 256, (size_t)256 * 256, false};
    EpiMoe2 E{&p};
    gemm256(smem, (const char*)p.hid, 256, S, E);
}
__device__ void ph_final(const P& p, int bid, int nb, char* smem) {
    const int tid = get_tid(), lane = tid & 63, wv = tid >> 6;
    for (int row = bid * NW + wv; row < NTOK; row += nb * NW) {
        const int s0 = p.tokslot[row * 2], s1 = p.tokslot[row * 2 + 1];
        float v[16]; float ss = 0.f;
#pragma unroll
        for (int i = 0; i < 4; i++) {
            const int c = i * 256 + lane * 4;
            const float4 t = *(const float4*)&p.x1[(size_t)row * D_ + c];
            const uint2 a = *(const uint2*)&p.ybuf[(size_t)s0 * D_ + c];
            const uint2 bq = *(const uint2*)&p.ybuf[(size_t)s1 * D_ + c];
            v[4 * i]     = t.x + __uint_as_float(a.x << 16) + __uint_as_float(bq.x << 16);
            v[4 * i + 1] = t.y + __uint_as_float(a.x & 0xFFFF0000u) + __uint_as_float(bq.x & 0xFFFF0000u);
            v[4 * i + 2] = t.z + __uint_as_float(a.y << 16) + __uint_as_float(bq.y << 16);
            v[4 * i + 3] = t.w + __uint_as_float(a.y & 0xFFFF0000u) + __uint_as_float(bq.y & 0xFFFF0000u);
            ss += v[4 * i] * v[4 * i] + v[4 * i + 1] * v[4 * i + 1] + v[4 * i + 2] * v[4 * i + 2] + v[4 * i + 3] * v[4 * i + 3];
        }
        ss = wave_sum(ss);
        const float rs = rsqrtf(ss * (1.f / D_) + 1e-6f);
#pragma unroll
        for (int i = 0; i < 4; i++) {
            const int c = i * 256 + lane * 4;
            const float4 g = *(const float4*)&p.g_final[c];
            float4 o; o.x = v[4 * i] * rs * g.x; o.y = v[4 * i + 1] * rs * g.y; o.z = v[4 * i + 2] * rs * g.z; o.w = v[4 * i + 3] * rs * g.w;
            *(float4*)&p.out[(size_t)row * D_ + c] = o;
        }
    }
}

#define XB_TMO      128
#define XB_XCNT(j)  (256  + 64 * (j))
#define XB_XSUB(j)  (1280 + 64 * (j))
#define XB_XGEN(j)  (2304 + 64 * (j))
#define XB_TOP      3328
#define XB_TOPGEN   3392
#define XCD_BAR_WORDS 3456
#define XB_SPIN_CAP (1u << 18)
#define LAS __attribute__((address_space(3)))

__device__ __forceinline__ unsigned xb_ld(unsigned* p)              { return __hip_atomic_load(p, __ATOMIC_RELAXED, __HIP_MEMORY_SCOPE_AGENT); }
__device__ __forceinline__ unsigned xb_add(unsigned* p, unsigned v) { return __hip_atomic_fetch_add(p, v, __ATOMIC_RELAXED, __HIP_MEMORY_SCOPE_AGENT); }
__device__ __forceinline__ unsigned xb_xcc_id() { return (unsigned)__builtin_amdgcn_s_getreg((3 << 11) | 20) & 0xFu; }
#define XB_SPIN(cond, bar) do { unsigned _sp = 0; while (cond) { __builtin_amdgcn_s_sleep(1); \
    if ((++_sp & 255u) == 0u) { if (xb_ld(&(bar)[XB_TMO])) break; if (_sp > XB_SPIN_CAP) { atomicAdd(&(bar)[XB_TMO], 1u); break; } } } } while (0)

struct XcdBarrier {
    unsigned* bar; unsigned x;
    volatile LAS unsigned* st;
};

__device__ __forceinline__ XcdBarrier xcd_barrier_post(unsigned* bar, volatile LAS unsigned* st) {
    XcdBarrier b; b.bar = bar; b.x = xb_xcc_id(); b.st = st;
    if (threadIdx.x == 0) (void)xb_add(&bar[XB_XCNT(b.x)], 1u);
    return b;
}
__device__ __forceinline__ void xcd_barrier_complete(unsigned* bar, unsigned x, unsigned& nloc, unsigned& nx) {
    const unsigned G = gridDim.x * gridDim.y * gridDim.z;
    unsigned sum, cnt, mine, sp = 0u;
    for (;;) {
        sum = 0u; cnt = 0u; mine = 0u;
#pragma unroll
        for (unsigned j = 0; j < 16; ++j) { const unsigned c = xb_ld(&bar[XB_XCNT(j)]); sum += c; cnt += (c > 0u) ? 1u : 0u; mine = (j == x) ? c : mine; }
        if (sum == G) break;
        __builtin_amdgcn_s_sleep(1);
        if ((++sp & 255u) == 0u) { if (xb_ld(&bar[XB_TMO])) break; if (sp > XB_SPIN_CAP) { atomicAdd(&bar[XB_TMO], 1u); break; } }
    }
    nloc = mine > 0u ? mine : 1u; nx = cnt > 0u ? cnt : 1u;
}

__device__ __forceinline__ void xcd_barrier(const XcdBarrier& b) {
    asm volatile("s_waitcnt vmcnt(0)" ::: "memory");
    __syncthreads();
    if (threadIdx.x == 0) {
        unsigned* bar = b.bar;
        __builtin_amdgcn_s_waitcnt(0);
        unsigned nloc = b.st[0], nx = b.st[1];
        if (nloc == 0u) { xcd_barrier_complete(bar, b.x, nloc, nx); b.st[0] = nloc; b.st[1] = nx; }
        const unsigned old = xb_add(&bar[XB_XSUB(b.x)], 1u);
        const unsigned gen = old / nloc;
        if (old + 1u == (gen + 1u) * nloc) {
            __builtin_amdgcn_fence(__ATOMIC_RELEASE, "agent");
            asm volatile("s_waitcnt vmcnt(0)" ::: "memory");
            const unsigned og = xb_add(&bar[XB_TOP], 1u);
            const unsigned tg = og / nx;
            if (og + 1u == (tg + 1u) * nx) xb_add(&bar[XB_TOPGEN], 1u);
            else XB_SPIN(xb_ld(&bar[XB_TOPGEN]) == tg, bar);
            __builtin_amdgcn_fence(__ATOMIC_ACQUIRE, "agent");
            xb_add(&bar[XB_XGEN(b.x)], 1u);
            asm volatile("s_waitcnt vmcnt(0)" ::: "memory");
        } else {
            XB_SPIN(xb_ld(&bar[XB_XGEN(b.x)]) == gen, bar);
            __builtin_amdgcn_fence(__ATOMIC_ACQUIRE, "agent");
            asm volatile("s_waitcnt vmcnt(0)" ::: "memory");
        }
    }
    __syncthreads();
}

template <int PH>
__device__ __forceinline__ void run_phase(const P& p, int bid, int nb, char* smem) {
    if constexpr (PH == 0) ph_prologue(p, bid, nb, smem);
    if constexpr (PH == 1) ph_inproj(p, bid, nb, smem);
    if constexpr (PH == 2) { ph_compress(p, bid, nb, smem); __syncthreads(); ph_rwkv_chunk(p, bid, nb, smem); }
    if constexpr (PH == 3) {
        if (bid < SCAN_BLOCKS) ph_rwkv_seq(p, bid, SCAN_BLOCKS, smem);
        ph_nsa(p, bid - SCAN_BLOCKS, nb - SCAN_BLOCKS, smem);
    }
    if constexpr (PH == 12) ph_rwkv_out(p, bid, nb, smem);
    if constexpr (PH == 4) ph_merge(p, bid, nb, smem);
    if constexpr (PH == 5) ph_outproj(p, bid, nb, smem);
    if constexpr (PH == 6) ph_route(p, bid, nb, smem);
    if constexpr (PH == 7) ph_scatter(p, bid, nb, smem);
    if constexpr (PH == 9) ph_moe1(p, bid, nb, smem);
    if constexpr (PH == 10) ph_moe2(p, bid, nb, smem);
    if constexpr (PH == 11) ph_final(p, bid, nb, smem);
}

template <int PH>
__global__ void __launch_bounds__(NT) kph(P p) {
    extern __shared__ __attribute__((aligned(16))) char smem[];
    run_phase<PH>(p, blockIdx.x, gridDim.x, smem);
}

__global__ void __launch_bounds__(NT, 2) mega(P p) {
    extern __shared__ __attribute__((aligned(16))) char smem[];
    volatile LAS unsigned* st = (volatile LAS unsigned*)(smem + SMEM_BYTES - 16);
    if (threadIdx.x == 0) { st[0] = 0u; st[1] = 0u; st[2] = 0u; st[3] = 0u; }
    __syncthreads();
    XcdBarrier bar = xcd_barrier_post(p.bar, st);
    const int bid = blockIdx.x, nb = gridDim.x;
#define RUNP(N, BAR) { unsigned long long t0_ = 0; if ((TPROBE >> N) & 1) t0_ = __builtin_amdgcn_s_memrealtime(); run_phase<N>(p, bid, nb, smem); \
        unsigned long long tw_ = 0; if (((TPROBE >> N) & 1) && TPSEL) tw_ = __builtin_amdgcn_s_memrealtime() - t0_; if (BAR) xcd_barrier(bar); \
        if ((TPROBE >> N) & 1) { const unsigned long long t1_ = __builtin_amdgcn_s_memrealtime(); const unsigned long long dt_ = TPSEL ? tw_ : t1_ - t0_; \
            if (!TPSEL || (TPSEL == 1 ? (bid < SCAN_BLOCKS) : (bid >= SCAN_BLOCKS))) while (__builtin_amdgcn_s_memrealtime() - t1_ < dt_) __builtin_amdgcn_s_sleep(8); if (TPSEL) xcd_barrier(bar); } }
    RUNP(0, 1) RUNP(1, 1) RUNP(2, 1) RUNP(3, 1) RUNP(12, 1) RUNP(4, 1) RUNP(5, 1) RUNP(6, 1) RUNP(7, 1) RUNP(9, 1) RUNP(10, 1) RUNP(11, 0)
}

extern "C" void kernel_launch(void* const* d_in, const int* in_sizes, int n_in,
                              void* d_out, int out_size, void* d_ws, size_t ws_size,
                              hipStream_t stream) {
    P p{};
    p.x = (const float*)d_in[0]; p.pos = (const int*)d_in[1]; p.g_mix = (const float*)d_in[2]; p.w_in = (const float*)d_in[3];
    p.pe_k = (const float*)d_in[4]; p.w1_k = (const float*)d_in[5]; p.b1_k = (const float*)d_in[6]; p.w2_k = (const float*)d_in[7]; p.b2_k = (const float*)d_in[8];
    p.pe_v = (const float*)d_in[9]; p.w1_v = (const float*)d_in[10]; p.b1_v = (const float*)d_in[11]; p.w2_v = (const float*)d_in[12]; p.b2_v = (const float*)d_in[13];
    p.mu = (const float*)d_in[14]; p.w0 = (const float*)d_in[15]; p.w2 = (const float*)d_in[16]; p.a0 = (const float*)d_in[17]; p.a2 = (const float*)d_in[18];
    p.g2 = (const float*)d_in[19]; p.k_k = (const float*)d_in[20]; p.k_a = (const float*)d_in[21]; p.r_k = (const float*)d_in[22]; p.ln_w = (const float*)d_in[23]; p.ln_b = (const float*)d_in[24];
    p.wpa = (const float*)d_in[25]; p.wpb = (const float*)d_in[26]; p.wout = (const float*)d_in[27]; p.g_ffn = (const float*)d_in[28];
    p.w_grp = (const float*)d_in[29]; p.b_grp = (const float*)d_in[30]; p.w_exp = (const float*)d_in[31]; p.b_exp = (const float*)d_in[32];
    p.e_w1 = (const float*)d_in[33]; p.e_w3 = (const float*)d_in[34]; p.e_w2 = (const float*)d_in[35]; p.g_final = (const float*)d_in[36];
    p.out = (float*)d_out;
    char* ws = (char*)d_ws;
    const size_t MiB = 1ull << 20;
    p.hbuf = (u16*)(ws + 0 * MiB);
    p.q    = (u16*)(ws + 64 * MiB);
    p.kc   = (u16*)(ws + 96 * MiB);  p.vc   = (u16*)(ws + 104 * MiB);
    p.ksl  = (u16*)(ws + 112 * MiB); p.vslT = (u16*)(ws + 120 * MiB);
    p.kwn  = (u16*)(ws + 128 * MiB); p.vwnT = (u16*)(ws + 136 * MiB);
    p.nsag = (float*)(ws + 144 * MiB);
    p.kcb  = (u16*)(ws + 148 * MiB); p.vcT  = (u16*)(ws + 149 * MiB);
    p.prw  = (u16*)(ws + 160 * MiB);
    p.cdat = (u16*)(ws + 272 * MiB);
    p.bon  = (float*)(ws + 150 * MiB);
    p.w2T  = (u16*)(ws + 151 * MiB); p.a2T = p.w2T + 512 * 64; p.g2T = p.a2T + 512 * 64;
    p.cw1Tk = (u16*)(ws + 152 * MiB); p.cw1Tv = (u16*)(ws + 153 * MiB);
    p.cw2Tk = (u16*)(ws + 154 * MiB); p.cw2Tv = p.cw2Tk + 128 * 256;
    p.chid = (u16*)(ws + 155 * MiB);
    p.xact = (u16*)(ws + 488 * MiB);
    p.oa   = (u16*)(ws + 400 * MiB);
    p.ob   = (u16*)(ws + 432 * MiB);
    p.merged = (u16*)(ws + 64 * MiB);
    p.x1   = (float*)(ws + 160 * MiB);
    char* rt = ws + 288 * MiB;
    p.tok_e = (int*)(rt);                        rt += NTOK * 2 * 4;
    p.tok_gate = (float*)(rt);                   rt += NTOK * 2 * 4;
    p.tokslot = (int*)(rt);                      rt += NTOK * 2 * 4;
    p.list_tok = (int*)(rt);                     rt += NTOK * 2 * 4;
    p.list_gate = (float*)(rt);                  rt += NTOK * 2 * 4;
    p.blk_e = (int*)(rt);                        rt += 2048 * 4;
    p.blk_r0 = (int*)(rt);                       rt += 2048 * 4;
    p.rsb = (float*)(rt);                        rt += NTOK * 4;
    p.hid  = (u16*)(ws + 296 * MiB);
    p.ybuf = (u16*)(ws + 336 * MiB);
    char* misc = ws + 470 * MiB;
    p.counts = (int*)(misc); p.cursor = (int*)(misc + 256); p.offs = (int*)(misc + 512); p.nblk = (int*)(misc + 1024); p.nsactr = (int*)(misc + 2048);
    p.bar = (unsigned*)(ws + 471 * MiB);
    p.cb1k = (float*)(misc + 65536); p.cb1v = p.cb1k + 256;
    {
        char* wa = ws + 472 * MiB;
        p.winT = (u16*)wa;  wa += (size_t)3328 * 1024 * 2;
        p.wgT  = (u16*)wa;  wa += (size_t)2048 * 1024 * 2;
        p.wpaT = (u16*)wa;  wa += (size_t)1024 * 512 * 2;
        p.wpbT = (u16*)wa;  wa += (size_t)1024 * 512 * 2;
        p.woutT = (u16*)wa; wa += (size_t)1024 * 1024 * 2;
        p.ew1T = (u16*)(ws + 64 * MiB);  p.ew3T = (u16*)(ws + 80 * MiB);  p.ew2T = (u16*)(ws + 96 * MiB);
    }
    if (ws_size < (size_t)505 * MiB) return;

#if MEGA
    {
        static int mgrid = 0;
        if (mgrid == 0) {
            int dev = 0, cus = 0, per_cu = 0;
            hipGetDevice(&dev);
            hipDeviceGetAttribute(&cus, hipDeviceAttributeMultiprocessorCount, dev);
            hipFuncSetAttribute((const void*)mega, hipFuncAttributeMaxDynamicSharedMemorySize, SMEM_BYTES);
            hipOccupancyMaxActiveBlocksPerMultiprocessor(&per_cu, (const void*)mega, NT, SMEM_BYTES);
            (void)hipGetLastError();
            mgrid = cus;
        }
        hipMemsetAsync(p.bar, 0, XCD_BAR_WORDS * sizeof(unsigned) + 512 * sizeof(float), stream);
        mega<<<mgrid, NT, SMEM_BYTES, stream>>>(p);
        return;
    }
#else
    const int grid = 512;
    hipMemsetAsync(p.bar, 0, XCD_BAR_WORDS * sizeof(unsigned) + 512 * sizeof(float), stream);
    hipFuncSetAttribute((const void*)kph<0>, hipFuncAttributeMaxDynamicSharedMemorySize, SMEM_BYTES);
    hipFuncSetAttribute((const void*)kph<1>, hipFuncAttributeMaxDynamicSharedMemorySize, SMEM_BYTES);
    hipFuncSetAttribute((const void*)kph<2>, hipFuncAttributeMaxDynamicSharedMemorySize, SMEM_BYTES);
    hipFuncSetAttribute((const void*)kph<3>, hipFuncAttributeMaxDynamicSharedMemorySize, SMEM_BYTES);
    hipFuncSetAttribute((const void*)kph<4>, hipFuncAttributeMaxDynamicSharedMemorySize, SMEM_BYTES);
    hipFuncSetAttribute((const void*)kph<5>, hipFuncAttributeMaxDynamicSharedMemorySize, SMEM_BYTES);
    hipFuncSetAttribute((const void*)kph<6>, hipFuncAttributeMaxDynamicSharedMemorySize, SMEM_BYTES);
    hipFuncSetAttribute((const void*)kph<7>, hipFuncAttributeMaxDynamicSharedMemorySize, SMEM_BYTES);
    hipFuncSetAttribute((const void*)kph<8>, hipFuncAttributeMaxDynamicSharedMemorySize, SMEM_BYTES);
    hipFuncSetAttribute((const void*)kph<9>, hipFuncAttributeMaxDynamicSharedMemorySize, SMEM_BYTES);
    hipFuncSetAttribute((const void*)kph<10>, hipFuncAttributeMaxDynamicSharedMemorySize, SMEM_BYTES);
    hipFuncSetAttribute((const void*)kph<11>, hipFuncAttributeMaxDynamicSharedMemorySize, SMEM_BYTES);
    kph<0><<<grid, NT, SMEM_BYTES, stream>>>(p);
    kph<1><<<grid, NT, SMEM_BYTES, stream>>>(p);
    kph<2><<<grid, NT, SMEM_BYTES, stream>>>(p);
    kph<3><<<grid, NT, SMEM_BYTES, stream>>>(p);
    kph<12><<<grid, NT, SMEM_BYTES, stream>>>(p);
    kph<4><<<grid, NT, SMEM_BYTES, stream>>>(p);
    kph<5><<<grid, NT, SMEM_BYTES, stream>>>(p);
    kph<6><<<grid, NT, SMEM_BYTES, stream>>>(p);
    kph<7><<<grid, NT, SMEM_BYTES, stream>>>(p);
    kph<8><<<grid, NT, SMEM_BYTES, stream>>>(p);
    kph<9><<<grid, NT, SMEM_BYTES, stream>>>(p);
    kph<10><<<grid, NT, SMEM_BYTES, stream>>>(p);
    kph<11><<<grid, NT, SMEM_BYTES, stream>>>(p);
#endif
}
```

```cpp
#include <hip/hip_runtime.h>
#include <stdint.h>

typedef unsigned short u16;
using bf16x8 = __attribute__((ext_vector_type(8))) short;
using f32x4  = __attribute__((ext_vector_type(4))) float;

#ifndef MEGA
#define MEGA 1
#endif

constexpr int B_ = 4, S_ = 8192, D_ = 1024, NTOK = B_ * S_;
constexpr int CIN = 5144;
constexpr int NCMP = 511;
constexpr int CRW = 1792;
constexpr int NEXP = 32;
constexpr int NT = 512;
constexpr int NW = NT / 64;
constexpr int SMEM_BYTES = 160 * 1024;
constexpr int SCAN_BLOCKS = 16;
#ifndef TPROBE
#define TPROBE 0
#define TPSEL 0
#endif
constexpr float QSCALE = 0.125f * 1.4426950408889634f;

struct P {
    const float* x; const int* pos; const float* g_mix; const float* w_in;
    const float *pe_k, *w1_k, *b1_k, *w2_k, *b2_k, *pe_v, *w1_v, *b1_v, *w2_v, *b2_v;
    const float *mu, *w0, *w2, *a0, *a2, *g2, *k_k, *k_a, *r_k, *ln_w, *ln_b;
    const float *wpa, *wpb, *wout, *g_ffn, *w_grp, *b_grp, *w_exp, *b_exp, *e_w1, *e_w3, *e_w2, *g_final;
    float* out;
    u16* hbuf; u16 *q, *kc, *vc, *ksl, *vslT, *kwn, *vwnT, *kcb, *vcT; float* nsag; u16* prw;
    u16* cdat; float* bon; u16 *w2T, *a2T, *g2T; u16 *oa, *ob; u16* merged; float* x1;
    int* tok_e; float* tok_gate; int* tokslot; int* list_tok; float* list_gate;
    int* counts; int* offs; int* cursor; int* blk_e; int* blk_r0; int* nblk; float* rsb; int* nsactr;
    u16* hid; u16* ybuf; unsigned* bar;
    u16 *winT, *wgT, *wpaT, *wpbT, *woutT, *ew1T, *ew3T, *ew2T;
    u16 *cw1Tk, *cw1Tv, *cw2Tk, *cw2Tv, *chid, *xact; float *cb1k, *cb1v;
};

typedef __bf16 bf16x2_t __attribute__((ext_vector_type(2)));
typedef float f32x2_t __attribute__((ext_vector_type(2)));
__device__ __forceinline__ unsigned pack2(float a, float b) {
    f32x2_t f = {a, b};
    return __builtin_bit_cast(unsigned, __builtin_convertvector(f, bf16x2_t));
}
__device__ __forceinline__ u16 f2bf(float f) { return (u16)(pack2(f, f) & 0xFFFFu); }
__device__ __forceinline__ float bf2f(u16 h) { return __uint_as_float(((unsigned)h) << 16); }
__device__ __forceinline__ float sigmoidf_(float x) { return __builtin_amdgcn_rcpf(1.f + __expf(-x)); }
__device__ __forceinline__ int get_tid() { int t = threadIdx.x; asm volatile("" : "+v"(t)); return t; }
__device__ __forceinline__ uint2 pack4(const f32x4& v) { uint2 o; o.x = pack2(v[0], v[1]); o.y = pack2(v[2], v[3]); return o; }
__device__ __forceinline__ f32x4 unpack4(uint2 u) { return f32x4{__uint_as_float(u.x << 16), __uint_as_float(u.x & 0xFFFF0000u), __uint_as_float(u.y << 16), __uint_as_float(u.y & 0xFFFF0000u)}; }
#define LDS_BARRIER() do { asm volatile("s_waitcnt lgkmcnt(0)" ::: "memory"); __builtin_amdgcn_s_barrier(); asm volatile("" ::: "memory"); } while (0)
__device__ __forceinline__ int opaque(int x) { asm volatile("" : "+v"(x)); return x; }
template <int CTRL>
__device__ __forceinline__ float dppf(float x) { return __int_as_float(__builtin_amdgcn_update_dpp(0, __float_as_int(x), CTRL, 0xF, 0xF, true)); }
__device__ __forceinline__ float wave_sum(float v) {
    v += dppf<0xB1>(v);
    v += dppf<0x4E>(v);
    v += dppf<0x141>(v);
    v += dppf<0x140>(v);
    const int vi = __float_as_int(v);
    return (__int_as_float(__builtin_amdgcn_readlane(vi, 0)) + __int_as_float(__builtin_amdgcn_readlane(vi, 16)))
         + (__int_as_float(__builtin_amdgcn_readlane(vi, 32)) + __int_as_float(__builtin_amdgcn_readlane(vi, 48)));
}

__device__ __forceinline__ float xrow_sum(float v) {
    auto r = __builtin_amdgcn_permlane16_swap(__float_as_uint(v), __float_as_uint(v), false, false);
    v = __uint_as_float(r[0]) + __uint_as_float(r[1]);
    auto r2 = __builtin_amdgcn_permlane32_swap(__float_as_uint(v), __float_as_uint(v), false, false);
    return __uint_as_float(r2[0]) + __uint_as_float(r2[1]);
}
__device__ __forceinline__ float xrow_max(float v) {
    auto r = __builtin_amdgcn_permlane16_swap(__float_as_uint(v), __float_as_uint(v), false, false);
    v = fmaxf(__uint_as_float(r[0]), __uint_as_float(r[1]));
    auto r2 = __builtin_amdgcn_permlane32_swap(__float_as_uint(v), __float_as_uint(v), false, false);
    return fmaxf(__uint_as_float(r2[0]), __uint_as_float(r2[1]));
}
__constant__ double ROPE_FREQ[32] = {
    1.00000000000000000000e+00, 7.49894209332455874417e-01, 5.62341325190349072827e-01, 4.21696503428582225581e-01,
    3.16227766016837941176e-01, 2.37137370566165517349e-01, 1.77827941003892292526e-01, 1.33352143216332402753e-01,
    1.00000000000000005551e-01, 7.49894209332455791150e-02, 5.62341325190349114460e-02, 4.21696503428582239459e-02,
    3.16227766016837913421e-02, 2.37137370566165538166e-02, 1.77827941003892292526e-02, 1.33352143216332406223e-02,
    1.00000000000000002082e-02, 7.49894209332455791150e-03, 5.62341325190349097113e-03, 4.21696503428582291501e-03,
    3.16227766016837939442e-03, 2.37137370566165538166e-03, 1.77827941003892275179e-03, 1.33352143216332406223e-03,
    1.00000000000000002082e-03, 7.49894209332455856203e-04, 5.62341325190349097113e-04, 4.21696503428582237290e-04,
    3.16227766016837939442e-04, 2.37137370566165538166e-04, 1.77827941003892269758e-04, 1.33352143216332395381e-04};

constexpr int G_ABYTES = 256 * 64 * 2, G_BBYTES = 128 * 64 * 2, G_TILE = G_ABYTES + G_BBYTES;
#define LAS3 __attribute__((address_space(3)))
#define GAS1 __attribute__((address_space(1)))
__device__ __forceinline__ void glds16(const u16* g, char* l) {
    __builtin_amdgcn_global_load_lds((const GAS1 unsigned*)g, (LAS3 unsigned*)l, 16, 0, 0);
}
template <bool TR = false, class ARow>
__device__ __forceinline__ void gemm_core(int K, ARow arow, const u16* __restrict__ BT, int ldb, f32x4 (&acc)[4][4], u16* sm) {
    char* base = (char*)sm;
    const int tid = get_tid(), lane = tid & 63, wv = tid >> 6;
    const int wm = wv >> 1, wn = wv & 1, kr = lane & 15, qq = lane >> 4;
    const int lr = tid >> 3, lk = ((tid & 7) ^ ((lr >> 1) & 7)) * 8;
    const u16* ap0 = arow(lr) + lk; const u16* ap1 = arow(lr + 64) + lk;
    const u16* ap2 = arow(lr + 128) + lk; const u16* ap3 = arow(lr + 192) + lk;
    const u16* bp0 = BT + (size_t)lr * ldb + lk; const u16* bp1 = BT + (size_t)(lr + 64) * ldb + lk;
#pragma unroll
    for (int mt = 0; mt < 4; mt++)
#pragma unroll
        for (int nt = 0; nt < 4; nt++) acc[mt][nt] = f32x4{0.f, 0.f, 0.f, 0.f};
    const int nk = K >> 6;
#define G_ISSUE(t, b) { char* d = base + (b) * G_TILE + tid * 16; const int ko = (t) * 64; \
        glds16(ap0 + ko, d); glds16(ap1 + ko, d + 8192); glds16(ap2 + ko, d + 16384); glds16(ap3 + ko, d + 24576); \
        glds16(bp0 + ko, d + G_ABYTES); glds16(bp1 + ko, d + G_ABYTES + 8192); }
    const int sw = kr >> 1;
    const int po0 = ((0 * 4 + qq) ^ sw) * 16, po1 = ((1 * 4 + qq) ^ sw) * 16;
    const int aoff = (wm * 64 + kr) * 128, boff = G_ABYTES + (wn * 64 + kr) * 128;
#define G_READ(FA, FB, b) { const char* Ab = base + (b) * G_TILE + aoff; const char* Bb = base + (b) * G_TILE + boff; \
        _Pragma("unroll") for (int mt = 0; mt < 4; mt++) { FA[0][mt] = *(const bf16x8*)(Ab + mt * 2048 + po0); FA[1][mt] = *(const bf16x8*)(Ab + mt * 2048 + po1); } \
        _Pragma("unroll") for (int nt = 0; nt < 4; nt++) { FB[0][nt] = *(const bf16x8*)(Bb + nt * 2048 + po0); FB[1][nt] = *(const bf16x8*)(Bb + nt * 2048 + po1); } }
#define G_MMA(FA, FB) { __builtin_amdgcn_s_setprio(1); \
        _Pragma("unroll") for (int ks = 0; ks < 2; ks++) \
            _Pragma("unroll") for (int nt = 0; nt < 4; nt++) \
                _Pragma("unroll") for (int mt = 0; mt < 4; mt++) \
                    acc[mt][nt] = TR ? __builtin_amdgcn_mfma_f32_16x16x32_bf16(FA[ks][mt], FB[ks][nt], acc[mt][nt], 0, 0, 0) \
                                     : __builtin_amdgcn_mfma_f32_16x16x32_bf16(FB[ks][nt], FA[ks][mt], acc[mt][nt], 0, 0, 0); \
        __builtin_amdgcn_s_setprio(0); }
    bf16x8 fa0[2][4], fb0[2][4], fa1[2][4], fb1[2][4];
    G_ISSUE(0, 0)
    if (nk > 1) G_ISSUE(1, 1)
    if (nk > 2) G_ISSUE(2, 2)
    if (nk > 2) asm volatile("s_waitcnt vmcnt(12)" ::: "memory");
    else if (nk > 1) asm volatile("s_waitcnt vmcnt(6)" ::: "memory");
    else asm volatile("s_waitcnt vmcnt(0)" ::: "memory");
    __builtin_amdgcn_s_barrier();
    G_READ(fa0, fb0, 0)
    int bnext = 1, bfree = 0;
#define G_STEP(FAC, FBC, FAN, FBN, kt) { \
        if ((kt) + 1 < nk) { \
            if ((kt) + 2 < nk) asm volatile("s_waitcnt vmcnt(6) lgkmcnt(0)" ::: "memory"); else asm volatile("s_waitcnt vmcnt(0) lgkmcnt(0)" ::: "memory"); \
            __builtin_amdgcn_s_barrier();                   \
            if ((kt) + 3 < nk) G_ISSUE((kt) + 3, bfree) \
            G_READ(FAN, FBN, bnext) \
        } \
        G_MMA(FAC, FBC) \
        bfree = bnext; bnext = (bnext == 2) ? 0 : bnext + 1; }
    for (int kt = 0; kt < nk; kt += 2) {
        G_STEP(fa0, fb0, fa1, fb1, kt)
        G_STEP(fa1, fb1, fa0, fb0, kt + 1)
    }
    __builtin_amdgcn_s_barrier();
#undef G_READ
#undef G_MMA
#undef G_STEP
#undef G_ISSUE
}

__device__ __forceinline__ int xcd_item(int bid, int nb, int k, int nitems) {
    if (nb & 7) return bid + k * nb;
    const int per = nb >> 3, chunk = (nitems + 7) >> 3;
    const int j = k * per + (bid >> 3);
    return (j < chunk) ? (bid & 7) * chunk + j : nitems;
}
struct GUnit { int pm, pn; };
constexpr int G8_HTB = 128 * 64 * 2;
__device__ __forceinline__ int g8_lds_byte(int r, int c) { const int st = (r >> 4) * 2 + (c >> 5), rr = r & 15, cc = c & 31, ob = rr * 64 + cc * 2; return st * 1024 + (ob ^ (((ob >> 9) & 1) << 5)); }
__device__ __forceinline__ void g8_stage_rc(int b, int& R, int& C) { const int st = b / 1024, sb = b % 1024, swz = sb ^ (((sb >> 9) & 1) << 5); R = (st >> 1) * 16 + swz / 64; C = (st & 1) * 32 + (swz % 64) / 2; }
__host__ __device__ __forceinline__ int perm32(int rho) { const int n = rho >> 4, i = rho & 15; return 8 * (i >> 2) + 4 * n + (i & 3); }

template <class Epi, class Sched>
__device__ __forceinline__ void gemm256(char* smem, const char* Ab, int K, const Sched& S, const Epi& E) {
    LAS3 unsigned char* lds = (LAS3 unsigned char*)smem;
    const int tid = get_tid(), wid = __builtin_amdgcn_readfirstlane(tid >> 6), lane = tid & 63, wr = wid >> 2, wc = wid & 3, fr = lane & 15, fq = lane >> 4;
    int nt = K >> 6; asm volatile("" : "+s"(nt));
    unsigned voffB[2], voffA[2][2];
#pragma unroll
    for (int i = 0; i < 2; ++i) { int sR, sC; g8_stage_rc(tid * 16 + i * 8192, sR, sC); voffB[i] = (unsigned)(sR * K + sC) * 2u; }
#define G8_AOFFS(un) do { const int t3_ = get_tid(); _Pragma("unroll") for (int i = 0; i < 2; ++i) { int sR, sC; g8_stage_rc(t3_ * 16 + i * 8192, sR, sC); \
        _Pragma("unroll") for (int h = 0; h < 2; ++h) voffA[h][i] = S.a_off(un, h, sR) + (unsigned)sC * 2u; } } while (0)
    const size_t kstep = 128;
    const size_t hstep = (size_t)128 * K * 2;
    const unsigned ldsw = (unsigned)wid * 1024u;
    const int aoff = g8_lds_byte(wr * 64 + fr, fq * 8), boff = g8_lds_byte(wc * 32 + fr, fq * 8);
#define G8_SA(b, h) (((b) * 2 + (h)) * G8_HTB)
#define G8_SB(b, h) ((4 + (b) * 2 + (h)) * G8_HTB)
#define G8_STAGE2(bufoff, gbase, v0, v1) do { \
        __builtin_amdgcn_global_load_lds((const GAS1 unsigned*)((const char*)(gbase) + (v0)), (LAS3 unsigned*)(lds + (bufoff) + ldsw), 16, 0, 0); \
        __builtin_amdgcn_global_load_lds((const GAS1 unsigned*)((const char*)(gbase) + (v1)), (LAS3 unsigned*)(lds + (bufoff) + ldsw + 8192), 16, 0, 0); } while (0)
#define G8_STAGEB(bufoff, gbase) G8_STAGE2(bufoff, gbase, voffB[0], voffB[1])
#define G8_LDA(dst, b, h) do { _Pragma("unroll") for (int m = 0; m < 4; ++m) _Pragma("unroll") for (int k = 0; k < 2; ++k) dst[m][k] = *(const LAS3 bf16x8*)(lds + G8_SA(b, h) + aoff + m * 2048 + k * 1024); } while (0)
#define G8_LDB(dst, b, h) do { _Pragma("unroll") for (int n = 0; n < 2; ++n) _Pragma("unroll") for (int k = 0; k < 2; ++k) dst[n][k] = *(const LAS3 bf16x8*)(lds + G8_SB(b, h) + boff + n * 2048 + k * 1024); } while (0)
#define G8_MMA(ai, bj, At, Bt) do { __builtin_amdgcn_s_setprio(1); _Pragma("unroll") for (int m = 0; m < 4; ++m) _Pragma("unroll") for (int n = 0; n < 2; ++n) _Pragma("unroll") for (int k = 0; k < 2; ++k) \
        acc[ai][bj][m][n] = __builtin_amdgcn_mfma_f32_16x16x32_bf16(Bt[n][k], At[m][k], acc[ai][bj][m][n], 0, 0, 0); __builtin_amdgcn_s_setprio(0); } while (0)
#define G8_WAIT_V(n) asm volatile("s_waitcnt vmcnt(" #n ")" ::: "memory")
#define G8_WAIT_L(n) asm volatile("s_waitcnt lgkmcnt(" #n ")" ::: "memory")
#define G8_BAR __builtin_amdgcn_s_barrier()
#define G8_SCHED __builtin_amdgcn_sched_barrier(0)
    GUnit cur, nxt; int ui = 0;
    if (!S.next(0, cur)) return;
    f32x4 acc[2][2][4][2];
#pragma unroll
    for (int a = 0; a < 2; ++a)
#pragma unroll
        for (int b = 0; b < 2; ++b)
#pragma unroll
            for (int m = 0; m < 4; ++m)
#pragma unroll
                for (int n = 0; n < 2; ++n) acc[a][b][m][n] = (f32x4){0.f, 0.f, 0.f, 0.f};
    bf16x8 At[4][2], B0[2][2], B1[2][2];
    G8_AOFFS(cur);
    const char* cB = S.b_ptr(cur);
    G8_STAGEB(G8_SB(0, 0), cB); G8_STAGE2(G8_SA(0, 0), Ab, voffA[0][0], voffA[0][1]); G8_STAGEB(G8_SB(0, 1), cB + hstep); G8_STAGE2(G8_SA(0, 1), Ab, voffA[1][0], voffA[1][1]);
    if (wr == 1) G8_BAR;
    G8_WAIT_V(4); G8_BAR;
    G8_STAGEB(G8_SB(1, 0), cB + kstep); G8_STAGE2(G8_SA(1, 0), Ab + kstep, voffA[0][0], voffA[0][1]); G8_STAGEB(G8_SB(1, 1), cB + hstep + kstep);
    G8_WAIT_V(6); G8_BAR;
    for (;;) {
        const bool has_next = S.next(ui + 1, nxt);
        const char* nB = has_next ? S.b_ptr(nxt) : cB;
        for (int t = 0; t < nt; t += 2) {
            const bool last = (t == nt - 2);
            const char* a1 = Ab + (size_t)(t + 1) * kstep;
            const unsigned va10 = voffA[1][0], va11 = voffA[1][1];
            if (last && has_next) G8_AOFFS(nxt);
            const char* a2 = last ? Ab : Ab + (size_t)(t + 2) * kstep; const char* b2 = last ? nB : cB + (size_t)(t + 2) * kstep;
            const char* a3 = a2 + kstep; const char* b3 = b2 + kstep;
            G8_LDB(B0, 0, 0); G8_SCHED; G8_LDA(At, 0, 0); G8_STAGE2(G8_SA(1, 1), a1, va10, va11);
            G8_WAIT_L(8); G8_BAR; G8_WAIT_L(0); G8_MMA(0, 0, At, B0); G8_BAR; G8_SCHED;
            G8_LDB(B1, 0, 1); G8_STAGEB(G8_SB(0, 0), b2);
            G8_BAR; G8_WAIT_L(0); G8_MMA(0, 1, At, B1); G8_BAR;
            G8_LDA(At, 0, 1); G8_STAGE2(G8_SA(0, 0), a2, voffA[0][0], voffA[0][1]);
            G8_BAR; G8_WAIT_L(0); G8_MMA(1, 0, At, B0); G8_BAR; G8_SCHED;
            G8_STAGEB(G8_SB(0, 1), b2 + hstep);
            G8_WAIT_V(6); G8_BAR; G8_MMA(1, 1, At, B1); G8_BAR;
            G8_LDB(B0, 1, 0); G8_SCHED; G8_LDA(At, 1, 0); G8_STAGE2(G8_SA(0, 1), a2, voffA[1][0], voffA[1][1]);
            G8_WAIT_L(8); G8_BAR; G8_WAIT_L(0); G8_MMA(0, 0, At, B0); G8_BAR; G8_SCHED;
            G8_LDB(B1, 1, 1); G8_STAGEB(G8_SB(1, 0), b3);
            G8_BAR; G8_WAIT_L(0); G8_MMA(0, 1, At, B1); G8_BAR;
            G8_LDA(At, 1, 1); G8_STAGE2(G8_SA(1, 0), a3, voffA[0][0], voffA[0][1]);
            G8_BAR; G8_WAIT_L(0); G8_MMA(1, 0, At, B0); G8_BAR; G8_SCHED;
            G8_STAGEB(G8_SB(1, 1), b3 + hstep);
            G8_WAIT_V(6); G8_BAR; G8_MMA(1, 1, At, B1); G8_BAR;
        }
        E(acc, cur, wr, wc, fr, fq);
        if (!has_next) break;
#pragma unroll
        for (int a = 0; a < 2; ++a)
#pragma unroll
            for (int b = 0; b < 2; ++b)
#pragma unroll
                for (int m = 0; m < 4; ++m)
#pragma unroll
                    for (int n = 0; n < 2; ++n) acc[a][b][m][n] = (f32x4){0.f, 0.f, 0.f, 0.f};
        cur = nxt; cB = nB; ++ui;
    }
    G8_WAIT_V(0);
    if (wr == 0) G8_BAR;
    G8_BAR;
#undef G8_SA
#undef G8_AOFFS
#undef G8_SB
#undef G8_STAGE2
#undef G8_STAGEB
#undef G8_LDA
#undef G8_LDB
#undef G8_MMA
#undef G8_WAIT_V
#undef G8_WAIT_L
#undef G8_BAR
#undef G8_SCHED
}
struct DenseSched {
    int nM, nN, nwg, G, c, K; const char* Bt;
    __device__ __forceinline__ void init(int M, int N, int K_, const void* Bt_, int G_, int c_) { nM = M >> 8; nN = N >> 8; nwg = nM * nN; G = G_; c = c_; K = K_; Bt = (const char*)Bt_; }
    __device__ __forceinline__ bool next(int i, GUnit& u) const {
        const int L = i * G + c; if (L >= nwg) return false;
        int wgid = L; { const int q = nwg >> 3, r = nwg & 7, xcd = wgid & 7, off = wgid >> 3; wgid = (xcd < r ? xcd * (q + 1) : r * (q + 1) + (xcd - r) * q) + off; }
        const int nig = 8 * nN, gid = wgid / nig, fm = gid * 8, gsz = (nM - fm) < 8 ? (nM - fm) : 8, w = wgid - gid * nig;
        u.pn = w / gsz; u.pm = fm + (w - u.pn * gsz); return true;
    }
    __device__ __forceinline__ unsigned a_off(const GUnit& u, int h, int R) const { return (unsigned)((u.pm * 256 + h * 128 + R) * K) * 2u; }
    __device__ __forceinline__ const char* b_ptr(const GUnit& u) const { return Bt + (size_t)u.pn * 256 * K * 2; }
};

template <class SRC>
__device__ __forceinline__ void convert_wT(const float* __restrict__ W, int K, int N, u16* __restrict__ WT, int rows, SRC src, int gtid, int gnt) {
    const int kch = K >> 3;
    const int total = rows * kch;
    for (int i0 = gtid; i0 < total; i0 += 4 * gnt) {
        float f[4][8]; int sc[4];
#pragma unroll
        for (int u = 0; u < 4; u++) {
            const int i = i0 + u * gnt;
            sc[u] = -1;
            if (i < total) {
                const int kc = i / rows, j = i - kc * rows;
                sc[u] = src(j);
                if (sc[u] >= 0) {
                    const float* wp = W + (size_t)(kc * 8) * N + sc[u];
#pragma unroll
                    for (int q = 0; q < 8; q++) f[u][q] = wp[(size_t)q * N];
                }
            }
        }
#pragma unroll
        for (int u = 0; u < 4; u++) {
            const int i = i0 + u * gnt;
            if (i < total) {
                const int kc = i / rows, j = i - kc * rows;
                uint4 v = make_uint4(0u, 0u, 0u, 0u);
                if (sc[u] >= 0) { v.x = pack2(f[u][0], f[u][1]); v.y = pack2(f[u][2], f[u][3]); v.z = pack2(f[u][4], f[u][5]); v.w = pack2(f[u][6], f[u][7]); }
                *(uint4*)&WT[(size_t)j * K + kc * 8] = v;
            }
        }
    }
}

__device__ __forceinline__ void convert_later_weights(const P& p, int gtid, int gnt) {
    convert_wT(p.w_in, D_, CIN, p.wgT, 2048, [](int j) { const int t = j >> 8, r = j & 255, cl = r & 127; return 3096 + (r >> 7) * 1024 + t * 128 + (cl & ~31) + perm32(cl & 31); }, gtid, gnt);
    convert_wT(p.wpa, 512, D_, p.wpaT, 1024, [](int j) { return (j & ~31) + perm32(j & 31); }, gtid, gnt);
    convert_wT(p.wpb, 512, D_, p.wpbT, 1024, [](int j) { return (j & ~31) + perm32(j & 31); }, gtid, gnt);
    convert_wT(p.wout, D_, D_, p.woutT, 1024, [](int j) { return j; }, gtid, gnt);
    convert_wT(p.w2, 64, 512, p.w2T, 512, [](int j) { return j; }, gtid, gnt);
    convert_wT(p.w1_k, 2048, 256, p.cw1Tk, 256, [](int j) { return j; }, gtid, gnt);
    convert_wT(p.w1_v, 2048, 256, p.cw1Tv, 256, [](int j) { return j; }, gtid, gnt);
    convert_wT(p.w2_k, 256, 64, p.cw2Tk, 128, [](int j) { return j < 64 ? j : -1; }, gtid, gnt);
    convert_wT(p.w2_v, 256, 64, p.cw2Tv, 128, [](int j) { return j < 64 ? j : -1; }, gtid, gnt);
    convert_wT(p.a2, 64, 512, p.a2T, 512, [](int j) { return j; }, gtid, gnt);
    convert_wT(p.g2, 128, 512, p.g2T, 512, [](int j) { return j; }, gtid, gnt);
}
__device__ void ph_prologue(const P& p, int bid, int nb, char* smem) {
    const int tid = get_tid(), lane = tid & 63, wv = tid >> 6;
    if (bid >= 1 && bid <= 64) {
        const int j = tid & 255; const bool isv = tid >= 256;
        const float* pe = isv ? p.pe_v : p.pe_k; const float* w1 = isv ? p.w1_v : p.w1_k;
        const int kb = (bid - 1) * 32;
        float a0 = 0.f, a1 = 0.f;
#pragma unroll 4
        for (int k = kb; k < kb + 32; k += 2) { a0 += pe[k] * w1[(size_t)k * 256 + j]; a1 += pe[k + 1] * w1[(size_t)(k + 1) * 256 + j]; }
        p.cb1k[(bid - 1) * 512 + (isv ? 256 : 0) + j] = a0 + a1;
    }
    if (bid == 0) {
        if (tid < 32) { p.counts[tid] = 0; p.cursor[tid] = 0; }
        if (tid == 32) *p.nsactr = 0;
        for (int i = tid; i < 8 * 64; i += NT) {
            const int bg = i >> 6, d = i & 63;
            p.kcb[((size_t)bg * 512 + 511) * 64 + d] = 0;
            p.vcT[(((size_t)bg * 8 + 7) * 64 + d) * 64 + 63] = 0;
        }
    }
    {
        const int gtid = bid * NT + tid, gnt = nb * NT;
        convert_wT(p.w_in, D_, CIN, p.winT, 3328, [](int j) {
            const int t = j >> 8, s = j & 255;
            if (t < 5) {
                const int bj = s >> 7, wc = (s >> 5) & 3, n = (s >> 4) & 1, i = s & 15;
                const int dim = 32 * bj + 8 * (i >> 2) + 4 * n + (i & 3), hq = 4 * t + wc;
                int hb;
                if (hq < 8) hb = 64 * hq;
                else { const int k = (hq - 8) >> 1; hb = (k == 0 ? 512 : (k == 1 ? 640 : (k == 2 ? 768 : (k == 3 ? 1024 : (k == 4 ? 896 : 1152))))) + 64 * (hq & 1); }
                return hb + dim;
            }
            const int c = (s & ~31) + perm32(s & 31);
            if (t < 12) return 1304 + (t - 5) * 256 + c;
            return c < 24 ? 1280 + c : -1; }, gtid, gnt);
        if (nb != 256) convert_later_weights(p, gtid, gnt);
    }
    for (int row = bid * NW + wv; row < NTOK; row += nb * NW) {
        const float* xr = p.x + (size_t)row * D_;
        float v[16];
        float ss = 0.f;
#pragma unroll
        for (int i = 0; i < 4; i++) {
            float4 t = *(const float4*)&xr[i * 256 + lane * 4];
            v[4 * i] = t.x; v[4 * i + 1] = t.y; v[4 * i + 2] = t.z; v[4 * i + 3] = t.w;
            ss += t.x * t.x + t.y * t.y + t.z * t.z + t.w * t.w;
        }
        ss = wave_sum(ss);
        const float rs = rsqrtf(ss * (1.f / D_) + 1e-6f);
#pragma unroll
        for (int i = 0; i < 4; i++) {
            const int c = i * 256 + lane * 4;
            float4 g = *(const float4*)&p.g_mix[c];
            uint2 o;
            o.x = pack2(v[4 * i] * rs * g.x, v[4 * i + 1] * rs * g.y);
            o.y = pack2(v[4 * i + 2] * rs * g.z, v[4 * i + 3] * rs * g.w);
            *(uint2*)&p.hbuf[(size_t)row * D_ + c] = o;
        }
    }
}

__device__ __forceinline__ uint4 pack8(const f32x4& a, const f32x4& b) { uint4 o; o.x = pack2(a[0], a[1]); o.y = pack2(a[2], a[3]); o.z = pack2(b[0], b[1]); o.w = pack2(b[2], b[3]); return o; }
struct EpiInproj {
    const P* pp;
    __device__ __forceinline__ void operator()(const f32x4 (&acc)[2][2][4][2], const GUnit& u, int, int, int, int) const {
        const int t2_ = get_tid(), wid_ = __builtin_amdgcn_readfirstlane(t2_ >> 6), wr = wid_ >> 2, wc = wid_ & 3, fr = t2_ & 15, fq = (t2_ >> 4) & 3;
        const P& p = *pp;
        const int pn = u.pn;
        const int rowb = u.pm * 256 + wr * 64;
        if (pn < 4) {
            const int hq = 4 * pn + wc;
            const bool rope = !(pn == 2 && wc >= 2);
            u16* dst; size_t rstride; int cofs;
            if (pn < 2) { dst = p.q; rstride = 512; cofs = hq * 64; }
            else { dst = (pn == 2) ? (wc < 2 ? p.kc : p.vc) : (wc < 2 ? p.ksl : p.kwn); rstride = 64; cofs = 0; }
            const int g = wc & 1;
#pragma unroll
            for (int ai = 0; ai < 2; ++ai)
#pragma unroll
                for (int m = 0; m < 4; ++m) {
                    const int row = rowb + ai * 128 + m * 16 + fr;
                    f32x4 o1[2], o2[2];
#pragma unroll
                    for (int n = 0; n < 2; ++n) { o1[n] = acc[ai][0][m][n]; o2[n] = acc[ai][1][m][n]; }
                    if (rope) {
                        const double posd = (double)p.pos[row];
#pragma unroll
                        for (int n = 0; n < 2; ++n)
#pragma unroll
                            for (int j = 0; j < 4; ++j) {
                                const double tr = posd * ROPE_FREQ[8 * fq + 4 * n + j] * 0.15915494309189535;
                                const float fr_ = (float)(tr - rint(tr));
                                const float cs = __builtin_amdgcn_cosf(fr_), sn = __builtin_amdgcn_sinf(fr_);
                                const float x1 = o1[n][j], x2 = o2[n][j];
                                o1[n][j] = x1 * cs - x2 * sn; o2[n][j] = x1 * sn + x2 * cs;
                            }
                    }
                    size_t ro;
                    if (pn < 2) {
#pragma unroll
                        for (int n = 0; n < 2; ++n)
#pragma unroll
                            for (int j = 0; j < 4; ++j) { o1[n][j] *= QSCALE; o2[n][j] *= QSCALE; }
                        ro = (size_t)row * 512 + cofs + 8 * fq;
                    } else {
                        const int bb = row >> 13, t = row & (S_ - 1);
                        ro = ((size_t)(bb * 2 + g) * S_ + t) * 64 + 8 * fq;
                    }
                    *(uint4*)&dst[ro] = pack8(o1[0], o1[1]);
                    *(uint4*)&dst[ro + 32] = pack8(o2[0], o2[1]);
                }
        } else if (pn == 4) {
            u16* dst = (wc < 2) ? p.vslT : p.vwnT;
            const int g = wc & 1;
#pragma unroll
            for (int ai = 0; ai < 2; ++ai) {
                const int r0 = rowb + ai * 128, bb = r0 >> 13, tb = r0 & (S_ - 1);
                u16* base = dst + ((size_t)(bb * 2 + g) * 128 + (tb >> 6)) * 4096;
#pragma unroll
                for (int m = 0; m < 4; ++m)
#pragma unroll
                    for (int bj = 0; bj < 2; ++bj)
#pragma unroll
                        for (int n = 0; n < 2; ++n)
#pragma unroll
                            for (int j = 0; j < 4; ++j)
                                base[(32 * bj + 8 * fq + 4 * n + j) * 64 + m * 16 + fr] = f2bf(acc[ai][bj][m][n][j]);
            }
        } else if (pn < 12) {
            const int cb = (pn - 5) * 256 + wc * 32 + 8 * fq;
#pragma unroll
            for (int ai = 0; ai < 2; ++ai)
#pragma unroll
                for (int m = 0; m < 4; ++m) {
                    const size_t ro = (size_t)(rowb + ai * 128 + m * 16 + fr) * CRW + cb;
#pragma unroll
                    for (int bj = 0; bj < 2; ++bj) *(uint4*)&p.prw[ro + bj * 128] = pack8(acc[ai][bj][m][0], acc[ai][bj][m][1]);
                }
        } else {
            if (wc == 0 && fq < 3) {
#pragma unroll
                for (int ai = 0; ai < 2; ++ai)
#pragma unroll
                    for (int m = 0; m < 4; ++m) {
                        const size_t ro = (size_t)(rowb + ai * 128 + m * 16 + fr) * 24 + 8 * fq;
#pragma unroll
                        for (int n = 0; n < 2; ++n) {
                            float4 o; o.x = sigmoidf_(acc[ai][0][m][n][0]); o.y = sigmoidf_(acc[ai][0][m][n][1]); o.z = sigmoidf_(acc[ai][0][m][n][2]); o.w = sigmoidf_(acc[ai][0][m][n][3]);
                            *(float4*)&p.nsag[ro + 4 * n] = o;
                        }
                    }
            }
        }
    }
};
__device__ void ph_inproj(const P& p, int bid, int nb, char* smem) {
    DenseSched S; S.init(NTOK, 3328, D_, p.winT, nb, bid);
    EpiInproj E{&p};
    gemm256(smem, (const char*)p.hbuf, D_, S, E);
    if (nb == 256 && bid >= 128) convert_later_weights(p, (bid - 128) * NT + get_tid(), 128 * NT);
}

__device__ __forceinline__ float gelu_tanh(float x) {
    const float c = 0.7978845608028654f;
    return 0.5f * x * (1.f + tanhf(c * (x + 0.044715f * x * x * x)));
}
__device__ void ph_compress(const P& p, int bid, int nb, char* smem) {
    u16* sm = (u16*)smem;
    const int tid = get_tid(), lane = tid & 63, wv = tid >> 6;
    const int wm = wv >> 1, wn = wv & 1;
    for (int it = bid; it < 32; it += nb) {
        const int rt = it & 1, g = (it >> 1) & 1, b = (it >> 2) & 3, kv = it >> 4;
        const int bg = b * 2 + g, i0 = rt * 256;
        const u16* src = (kv ? p.vc : p.kc) + (size_t)bg * S_ * 64;
        const u16* w1T = kv ? p.cw1Tv : p.cw1Tk;
        const u16* w2T = kv ? p.cw2Tv : p.cw2Tk;
        float* cb1 = (float*)(smem + 3 * G_TILE);
        __syncthreads();
        { const int t2 = get_tid(); if (t2 < 256) { float a = 0.f; for (int q = 0; q < 64; q++) a += p.cb1k[q * 512 + kv * 256 + t2]; cb1[t2] = a; } }
        __syncthreads();
        const float* b1 = kv ? p.b1_v : p.b1_k;
        const float* b2 = kv ? p.b2_v : p.b2_k;
        u16* hidp = p.chid + (size_t)it * 256 * 256;
        auto arow = [&](int r) { int i = i0 + r; if (i > 510) i = 510; return src + (size_t)i * 1024; };
#pragma unroll 1
        for (int ct = 0; ct < 2; ct++) {
            f32x4 acc[4][4];
            gemm_core<false>(2048, arow, w1T + (size_t)ct * 128 * 2048, 2048, acc, sm);
            const int le = get_tid() & 63;
#pragma unroll
            for (int mt = 0; mt < 4; mt++) {
                const int r = wm * 64 + mt * 16 + (le & 15);
#pragma unroll
                for (int nt = 0; nt < 4; nt++) {
                    const int col = ct * 128 + wn * 64 + nt * 16 + (le >> 4) * 4;
                    const float4 c1 = *(const float4*)&cb1[col], bb1 = *(const float4*)&b1[col];
                    f32x4 o;
                    o[0] = gelu_tanh(acc[mt][nt][0] + c1.x + bb1.x); o[1] = gelu_tanh(acc[mt][nt][1] + c1.y + bb1.y);
                    o[2] = gelu_tanh(acc[mt][nt][2] + c1.z + bb1.z); o[3] = gelu_tanh(acc[mt][nt][3] + c1.w + bb1.w);
                    *(uint2*)&hidp[r * 256 + col] = pack4(o);
                }
            }
        }
        __syncthreads();
        {
            f32x4 acc[4][4];
            gemm_core<true>(256, [&](int r) { return hidp + (size_t)r * 256; }, w2T, 256, acc, sm);
            if (wn == 0) {
#pragma unroll
                for (int mt = 0; mt < 4; mt++)
#pragma unroll
                    for (int nt = 0; nt < 4; nt++) {
                        const int d = nt * 16 + (lane & 15);
                        const int ib = i0 + wm * 64 + mt * 16 + (lane >> 4) * 4;
                        float o[4];
#pragma unroll
                        for (int j = 0; j < 4; j++) o[j] = (ib + j < NCMP) ? (acc[mt][nt][j] + b2[d]) : 0.f;
                        if (kv == 0) {
#pragma unroll
                            for (int j = 0; j < 4; j++) p.kcb[((size_t)bg * 512 + ib + j) * 64 + d] = f2bf(o[j]);
                        } else {
                            uint2 ov; ov.x = pack2(o[0], o[1]); ov.y = pack2(o[2], o[3]);
                            *(uint2*)&p.vcT[(((size_t)bg * 8 + (ib >> 6)) * 64 + d) * 64 + (ib & 63)] = ov;
                        }
                    }
            }
        }
        __syncthreads();
    }
}

#ifndef NSAPROBE
#define NSAPROBE 0
#endif
#define NSA_TS(k) if (NSAPROBE == k) ts_ = __builtin_amdgcn_s_memrealtime();
#define NSA_TE(k) if (NSAPROBE == k) tacc_ += __builtin_amdgcn_s_memrealtime() - ts_;
constexpr int KSTR = 72;
struct Sub { f32x4 O[4]; float m, l; };
#define NEG_BIG (-1.0e30f)

__device__ __forceinline__ float xq_max(float v) {
    return xrow_max(v);
}
__device__ __forceinline__ float xq_sum(float v) {
    return xrow_sum(v);
}
template <int OFF> __device__ __forceinline__ bf16x8 gload_b128(const u16* p) { bf16x8 r; asm volatile("global_load_dwordx4 %0, %1, off offset:%2" : "=v"(r) : "v"(p), "n"(OFF) : "memory"); return r; }
typedef unsigned u32x2 __attribute__((ext_vector_type(2)));
template <int OFF> __device__ __forceinline__ u32x2 gload_b64(const u16* p) { u32x2 r; asm volatile("global_load_dwordx2 %0, %1, off offset:%2" : "=v"(r) : "v"(p), "n"(OFF) : "memory"); return r; }
union VF { bf16x8 v; u32x2 h[2]; };
template <int OFF> __device__ __forceinline__ u32x2 lds_read_b64(unsigned addr) { u32x2 r; asm volatile("ds_read_b64 %0, %1 offset:%2" : "=v"(r) : "v"(addr), "n"(OFF)); return r; }
#define NSA_LDV_ASM(vf, Vs, kr, qq, swz) { const unsigned va_ = (unsigned)(size_t)(const LAS3 char*)((const char*)(Vs) + (kr) * 128 + ((qq) & 1) * 8); const int vo_ = (((qq) >> 1) ^ (swz)) << 4; \
        const unsigned a0_ = va_ + vo_, a1_ = va_ + (vo_ ^ 32), a2_ = va_ + (vo_ ^ 64), a3_ = va_ + (vo_ ^ 96); \
        vf[0][0].h[0] = lds_read_b64<0>(a0_);    vf[0][0].h[1] = lds_read_b64<0>(a1_);    vf[0][1].h[0] = lds_read_b64<0>(a2_);    vf[0][1].h[1] = lds_read_b64<0>(a3_); \
        vf[1][0].h[0] = lds_read_b64<2048>(a0_); vf[1][0].h[1] = lds_read_b64<2048>(a1_); vf[1][1].h[0] = lds_read_b64<2048>(a2_); vf[1][1].h[1] = lds_read_b64<2048>(a3_); \
        vf[2][0].h[0] = lds_read_b64<4096>(a0_); vf[2][0].h[1] = lds_read_b64<4096>(a1_); vf[2][1].h[0] = lds_read_b64<4096>(a2_); vf[2][1].h[1] = lds_read_b64<4096>(a3_); \
        vf[3][0].h[0] = lds_read_b64<6144>(a0_); vf[3][0].h[1] = lds_read_b64<6144>(a1_); vf[3][1].h[0] = lds_read_b64<6144>(a2_); vf[3][1].h[1] = lds_read_b64<6144>(a3_); }
#define NSA_VWAIT(vf) asm volatile("s_waitcnt lgkmcnt(0)" : "+v"(vf[0][0].v), "+v"(vf[0][1].v), "+v"(vf[1][0].v), "+v"(vf[1][1].v), "+v"(vf[2][0].v), "+v"(vf[2][1].v), "+v"(vf[3][0].v), "+v"(vf[3][1].v) :: "memory")
template <bool MASK, bool IMP, bool PV>
__device__ __forceinline__ void nsa_visit(const u16* Ks, const u16* Vs, const u16* qrow, Sub& s, int lo, int hi, int lane, float* e, float* p3) {
    const int kr = lane & 15, qq = lane >> 4;
    f32x4 S[4];
    const int qsw = ((kr & 3) >> 1) ^ ((kr >> 2) << 1);
    const bf16x8 qf0 = *(const bf16x8*)(qrow + ((qq ^ qsw) << 3)), qf1 = *(const bf16x8*)(qrow + (((4 + qq) ^ qsw) << 3));
    bf16x8 kf[4][2];
    const int swz = kr >> 1;
    {
        const char* kb_ = (const char*)Ks + kr * 128;
        const int ko0 = (qq ^ swz) << 4, ko1 = ko0 ^ 64;
#pragma unroll
        for (int kt = 0; kt < 4; kt++) { kf[kt][0] = *(const bf16x8*)(kb_ + kt * 2048 + ko0); kf[kt][1] = *(const bf16x8*)(kb_ + kt * 2048 + ko1); }
    }
    __builtin_amdgcn_sched_barrier(0);
#pragma unroll
    for (int kt = 0; kt < 4; kt++) {
        S[kt] = __builtin_amdgcn_mfma_f32_16x16x32_bf16(kf[kt][0], qf0, f32x4{0.f, 0.f, 0.f, 0.f}, 0, 0, 0);
        S[kt] = __builtin_amdgcn_mfma_f32_16x16x32_bf16(kf[kt][1], qf1, S[kt], 0, 0, 0);
    }
    float mx = NEG_BIG;
#pragma unroll
    for (int kt = 0; kt < 4; kt++)
#pragma unroll
        for (int r = 0; r < 4; r++) {
            if (MASK) { const int o = kt * 16 + qq * 4 + r; if (o < lo || o > hi) S[kt][r] = -INFINITY; }
            mx = fmaxf(mx, S[kt][r]);
        }
    mx = xq_max(mx);
    const float mnew = fmaxf(s.m, mx);
    const float alpha = __builtin_amdgcn_exp2f(s.m - mnew);
    s.m = mnew;
    float psum = 0.f;
#pragma unroll
    for (int kt = 0; kt < 4; kt++) {
#pragma unroll
        for (int r = 0; r < 4; r++) { S[kt][r] = __builtin_amdgcn_exp2f(S[kt][r] - mnew); }
        const float ee = (S[kt][0] + S[kt][1]) + (S[kt][2] + S[kt][3]);
        psum += ee;
        if (IMP) { e[kt] = ee; p3[kt] = S[kt][3]; }
    }
    s.l = s.l * alpha + psum;
    if (PV) {
        if (!__all(alpha == 1.f)) {
#pragma unroll
            for (int dt = 0; dt < 4; dt++)
#pragma unroll
                for (int r = 0; r < 4; r++) s.O[dt][r] *= alpha;
        }
        VF vf[4][2];
        NSA_LDV_ASM(vf, Vs, kr, qq, swz)
        bf16x8 pb[2];
#pragma unroll
        for (int k2 = 0; k2 < 2; k2++) {
            union { bf16x8 v; unsigned u[4]; } t;
            t.u[0] = pack2(S[2 * k2][0], S[2 * k2][1]); t.u[1] = pack2(S[2 * k2][2], S[2 * k2][3]);
            t.u[2] = pack2(S[2 * k2 + 1][0], S[2 * k2 + 1][1]); t.u[3] = pack2(S[2 * k2 + 1][2], S[2 * k2 + 1][3]);
            pb[k2] = t.v;
        }
        NSA_VWAIT(vf);
        __builtin_amdgcn_sched_barrier(0);
#pragma unroll
        for (int dt = 0; dt < 4; dt++)
#pragma unroll
            for (int k2 = 0; k2 < 2; k2++) s.O[dt] = __builtin_amdgcn_mfma_f32_16x16x32_bf16(vf[dt][k2].v, pb[k2], s.O[dt], 0, 0, 0);
    }
}
template <bool IMP, bool PV>
__device__ __forceinline__ void nsa_visit2(const u16* Ks, const u16* Vs, const u16* qrow0, const u16* qrow1, Sub (&st)[2], const int (&hi)[2], int lane, float (&e)[2][4], float (&p3)[2][4]) {
    const int kr = lane & 15, qq = lane >> 4;
    const int qsw = ((kr & 3) >> 1) ^ ((kr >> 2) << 1);
    bf16x8 qf0[2], qf1[2];
    qf0[0] = *(const bf16x8*)(qrow0 + ((qq ^ qsw) << 3)); qf1[0] = *(const bf16x8*)(qrow0 + (((4 + qq) ^ qsw) << 3));
    qf0[1] = *(const bf16x8*)(qrow1 + ((qq ^ qsw) << 3)); qf1[1] = *(const bf16x8*)(qrow1 + (((4 + qq) ^ qsw) << 3));
    bf16x8 kf[4][2];
    const int swz = kr >> 1;
    {
        const char* kb_ = (const char*)Ks + kr * 128;
        const int ko0 = (qq ^ swz) << 4, ko1 = ko0 ^ 64;
#pragma unroll
        for (int kt = 0; kt < 4; kt++) { kf[kt][0] = *(const bf16x8*)(kb_ + kt * 2048 + ko0); kf[kt][1] = *(const bf16x8*)(kb_ + kt * 2048 + ko1); }
    }
    __builtin_amdgcn_sched_barrier(0);
    f32x4 S[2][4];
#pragma unroll
    for (int kt = 0; kt < 4; kt++)
#pragma unroll
        for (int q = 0; q < 2; q++) {
            S[q][kt] = __builtin_amdgcn_mfma_f32_16x16x32_bf16(kf[kt][0], qf0[q], f32x4{0.f, 0.f, 0.f, 0.f}, 0, 0, 0);
            S[q][kt] = __builtin_amdgcn_mfma_f32_16x16x32_bf16(kf[kt][1], qf1[q], S[q][kt], 0, 0, 0);
        }
    VF vf[4][2];
    bf16x8 pb[2][2];
#pragma unroll
    for (int q = 0; q < 2; q++) {
        Sub& s = st[q];
        float mx = NEG_BIG;
#pragma unroll
        for (int kt = 0; kt < 4; kt++)
#pragma unroll
            for (int r = 0; r < 4; r++) {
                const int o = kt * 16 + qq * 4 + r; if (o > hi[q]) S[q][kt][r] = -INFINITY;
                mx = fmaxf(mx, S[q][kt][r]);
            }
        mx = xq_max(mx);
        const float mnew = fmaxf(s.m, mx);
        const float alpha = __builtin_amdgcn_exp2f(s.m - mnew);
        s.m = mnew;
        float psum = 0.f;
#pragma unroll
        for (int kt = 0; kt < 4; kt++) {
#pragma unroll
            for (int r = 0; r < 4; r++) { S[q][kt][r] = __builtin_amdgcn_exp2f(S[q][kt][r] - mnew); }
            const float ee = (S[q][kt][0] + S[q][kt][1]) + (S[q][kt][2] + S[q][kt][3]);
            psum += ee;
            if (IMP) { e[q][kt] = ee; p3[q][kt] = S[q][kt][3]; }
        }
        s.l = s.l * alpha + psum;
        if (PV) {
#pragma unroll
            for (int dt = 0; dt < 4; dt++)
#pragma unroll
                for (int r = 0; r < 4; r++) s.O[dt][r] *= alpha;
#pragma unroll
            for (int k2 = 0; k2 < 2; k2++) {
                union { bf16x8 v; unsigned u[4]; } t;
                t.u[0] = pack2(S[q][2 * k2][0], S[q][2 * k2][1]); t.u[1] = pack2(S[q][2 * k2][2], S[q][2 * k2][3]);
                t.u[2] = pack2(S[q][2 * k2 + 1][0], S[q][2 * k2 + 1][1]); t.u[3] = pack2(S[q][2 * k2 + 1][2], S[q][2 * k2 + 1][3]);
                pb[q][k2] = t.v;
            }
            if (q == 0) NSA_LDV_ASM(vf, Vs, kr, qq, swz)
        }
    }
    if (PV) {
        NSA_VWAIT(vf);
        __builtin_amdgcn_sched_barrier(0);
#pragma unroll
        for (int dt = 0; dt < 4; dt++)
#pragma unroll
            for (int k2 = 0; k2 < 2; k2++)
#pragma unroll
                for (int q = 0; q < 2; q++) st[q].O[dt] = __builtin_amdgcn_mfma_f32_16x16x32_bf16(vf[dt][k2].v, pb[q][k2], st[q].O[dt], 0, 0, 0);
    }
}
template <int MMODE, bool FIXM, int NQ>
__device__ __forceinline__ void nsa_visit_gn(const u16* Ks, const u16* Vs, const u16* qs, float* Os, float* Ms, float* Ls, const int (&tok)[NQ], const bool (&valid)[NQ], int lane) {
    const int kr = lane & 15, qq = lane >> 4, hh = kr & 3;
    int row[NQ], osw[NQ]; float* orow[NQ];
    f32x4 O[NQ][4]; float m_old[NQ], l_old[NQ]; bf16x8 qf0[NQ], qf1[NQ];
#pragma unroll
    for (int q = 0; q < NQ; q++) {
        row[q] = tok[q] * 4 + hh; orow[q] = Os + row[q] * 64;
        osw[q] = hh ^ ((tok[q] & 3) << 2);
#pragma unroll
        for (int dt = 0; dt < 4; dt++) O[q][dt] = *(const f32x4*)(orow[q] + (((dt * 4 + qq) ^ osw[q]) << 2));
        m_old[q] = Ms[row[q]]; l_old[q] = Ls[row[q]];
        const u16* qrow = qs + row[q] * 64;
        const int qsw = (hh >> 1) ^ ((tok[q] & 3) << 1);
        qf0[q] = *(const bf16x8*)(qrow + ((qq ^ qsw) << 3)); qf1[q] = *(const bf16x8*)(qrow + (((4 + qq) ^ qsw) << 3));
    }
    bf16x8 kf[4][2];
    const int swz = kr >> 1;
    {
        const char* kb_ = (const char*)Ks + kr * 128;
        const int ko0 = (qq ^ swz) << 4, ko1 = ko0 ^ 64;
#pragma unroll
        for (int kt = 0; kt < 4; kt++) { kf[kt][0] = *(const bf16x8*)(kb_ + kt * 2048 + ko0); kf[kt][1] = *(const bf16x8*)(kb_ + kt * 2048 + ko1); }
    }
    __builtin_amdgcn_sched_barrier(0);
    f32x4 S[NQ][4];
#pragma unroll
    for (int kt = 0; kt < 4; kt++)
#pragma unroll
        for (int q = 0; q < NQ; q++) {
            S[q][kt] = __builtin_amdgcn_mfma_f32_16x16x32_bf16(kf[kt][0], qf0[q], f32x4{0.f, 0.f, 0.f, 0.f}, 0, 0, 0);
            S[q][kt] = __builtin_amdgcn_mfma_f32_16x16x32_bf16(kf[kt][1], qf1[q], S[q][kt], 0, 0, 0);
        }
    VF vf[4][2];
#define NSA_LDV NSA_LDV_ASM(vf, Vs, kr, qq, swz)
    if (NQ == 1) NSA_LDV
    bf16x8 pb[NQ][2];
#pragma unroll
    for (int q = 0; q < NQ; q++) {
        float mx = NEG_BIG;
#pragma unroll
        for (int kt = 0; kt < 4; kt++)
#pragma unroll
            for (int r = 0; r < 4; r++) {
                if (MMODE == 1) { const int o = kt * 16 + qq * 4 + r; if (o > tok[q]) S[q][kt][r] = -INFINITY; }
                if (MMODE == 2) { const int o = kt * 16 + qq * 4 + r; if (o <= tok[q]) S[q][kt][r] = -INFINITY; }
                if (FIXM) { if (!valid[q]) S[q][kt][r] = -INFINITY; } else mx = fmaxf(mx, S[q][kt][r]);
            }
        float mnew = m_old[q], alpha = 1.f;
        if (!FIXM) {
            if (!valid[q]) mx = NEG_BIG;
            mx = xq_max(mx);
            mnew = fmaxf(m_old[q], mx);
            alpha = __builtin_amdgcn_exp2f(m_old[q] - mnew);
        }
        float psum = 0.f;
#pragma unroll
        for (int kt = 0; kt < 4; kt++) {
#pragma unroll
            for (int r = 0; r < 4; r++) { S[q][kt][r] = __builtin_amdgcn_exp2f(S[q][kt][r] - mnew); }
            psum += (S[q][kt][0] + S[q][kt][1]) + (S[q][kt][2] + S[q][kt][3]);
        }
        psum = xq_sum(psum);
        if (FIXM) { if (valid[q] && qq == 0) Ls[row[q]] = l_old[q] + psum; }
        else {
            if (valid[q] && qq == 0) { Ms[row[q]] = mnew; Ls[row[q]] = l_old[q] * alpha + psum; }
#pragma unroll
            for (int dt = 0; dt < 4; dt++)
#pragma unroll
                for (int r = 0; r < 4; r++) O[q][dt][r] *= alpha;
        }
#pragma unroll
        for (int k2 = 0; k2 < 2; k2++) {
            union { bf16x8 v; unsigned u[4]; } t;
            t.u[0] = pack2(S[q][2 * k2][0], S[q][2 * k2][1]); t.u[1] = pack2(S[q][2 * k2][2], S[q][2 * k2][3]);
            t.u[2] = pack2(S[q][2 * k2 + 1][0], S[q][2 * k2 + 1][1]); t.u[3] = pack2(S[q][2 * k2 + 1][2], S[q][2 * k2 + 1][3]);
            pb[q][k2] = t.v;
        }
        if (NQ == 2 && q == 0) { asm volatile("" ::: "memory"); NSA_LDV }
    }
#undef NSA_LDV
    NSA_VWAIT(vf);
    __builtin_amdgcn_sched_barrier(0);
#pragma unroll
    for (int dt = 0; dt < 4; dt++)
#pragma unroll
        for (int k2 = 0; k2 < 2; k2++)
#pragma unroll
            for (int q = 0; q < NQ; q++) O[q][dt] = __builtin_amdgcn_mfma_f32_16x16x32_bf16(vf[dt][k2].v, pb[q][k2], O[q][dt], 0, 0, 0);
#pragma unroll
    for (int q = 0; q < NQ; q++)
        if (valid[q]) {
#pragma unroll
            for (int dt = 0; dt < 4; dt++) *(f32x4*)(orow[q] + (((dt * 4 + qq) ^ osw[q]) << 2)) = O[q][dt];
        }
}
template <int MMODE, bool FIXM>
__device__ __forceinline__ void nsa_visit_g(const u16* Ks, const u16* Vs, const u16* qs, float* Os, float* Ms, float* Ls, int tok, bool valid, int lane) {
    const int tk[1] = {tok}; const bool vl[1] = {valid};
    nsa_visit_gn<MMODE, FIXM, 1>(Ks, Vs, qs, Os, Ms, Ls, tk, vl, lane);
}
__device__ __forceinline__ void nsa_fold_lds(float* Os, float* Ms, float* Ls, int row, int qq, int hh, f32x4 (&T)[4], float gate, bool reset) {
    const float lt = Ls[row];
    const float sc = (lt > 0.f) ? gate / lt : 0.f;
#pragma unroll
    for (int dt = 0; dt < 4; dt++) {
        float* op = Os + row * 64 + (((dt * 4 + qq) ^ hh ^ (((row >> 2) & 3) << 2)) << 2);
        const f32x4 o = *(const f32x4*)op;
#pragma unroll
        for (int r = 0; r < 4; r++) T[dt][r] += o[r] * sc;
        if (reset) *(f32x4*)op = f32x4{0.f, 0.f, 0.f, 0.f};
    }
    asm volatile("s_waitcnt lgkmcnt(0)" ::: "memory");
    if (reset && qq == 0) { Ms[row] = NEG_BIG; Ls[row] = 0.f; }
}
template <int MODE>
__device__ __forceinline__ void nsa_fold(Sub& s, f32x4 (&T)[4], float gate) {
    const float lt = xq_sum(s.l);
    const float sc = (lt > 0.f) ? gate / lt : 0.f;
#pragma unroll
    for (int dt = 0; dt < 4; dt++)
#pragma unroll
        for (int r = 0; r < 4; r++) {
            const float v = s.O[dt][r] * sc;
            T[dt][r] = (MODE == 1) ? T[dt][r] + v : v;
            s.O[dt][r] = 0.f;
        }
    s.m = NEG_BIG; s.l = 0.f;
}

constexpr int NSA_R = 3;
template <bool HASV, class KSrc, class VSrc, class Body>
__device__ __forceinline__ void nsa_stream(char* ring, int n, KSrc ksrc, VSrc vsrc, Body body) {
    const int t = get_tid();
    const int so = (t >> 3) * 64 + (((t & 7) ^ ((t >> 4) & 7)) << 3);
    char* dl = ring + t * 16;
#define NSA_ISSUE(i, slot) { glds16(ksrc(i) + so, dl + (slot) * 16384); if (HASV) glds16(vsrc(i) + so, dl + (slot) * 16384 + 8192); }
    asm volatile("s_waitcnt lgkmcnt(0)" ::: "memory");
    __builtin_amdgcn_s_barrier();
    if (n > 0) NSA_ISSUE(0, 0)
    if (n > 1) NSA_ISSUE(1, 1)
    int slot = 0;
    for (int i = 0; i < n; i++) {
        if (i + 1 < n) { if (HASV) asm volatile("s_waitcnt vmcnt(2)" ::: "memory"); else asm volatile("s_waitcnt vmcnt(1)" ::: "memory"); }
        else asm volatile("s_waitcnt vmcnt(0)" ::: "memory");
        asm volatile("s_waitcnt lgkmcnt(0)" ::: "memory");
        __builtin_amdgcn_s_barrier();
        asm volatile("" ::: "memory");
        const int sl2 = (slot == 0) ? 2 : slot - 1;
        if (i + 2 < n) NSA_ISSUE(i + 2, sl2)
        body(i, (const u16*)(ring + slot * 16384), (const u16*)(ring + slot * 16384 + 8192));
        slot = (slot == 2) ? 0 : slot + 1;
    }
#undef NSA_ISSUE
}
#define NSA_TOK(u) const int t3_ = get_tid(); const size_t ntk_ = (size_t)b * S_ + t0 + 8 * (t3_ >> 6) + 4 * (u) + ((t3_ & 15) >> 2); const int hd_ = g * 4 + (t3_ & 3);
__device__ void ph_nsa(const P& p, int bid, int nb, char* smem) {
    char* ring = smem;
    unsigned* selm = (unsigned*)(smem + NSA_R * 16384);
    int* blist = (int*)(selm + 256);
    int* nlistp = blist + 128;
    int* lcnt = nlistp + 4;
    unsigned char* lists = (unsigned char*)(lcnt + 128);
    float* Ms = (float*)(lists + 128 * 64);
    float* Ls = Ms + 256;
    float* Os = Ls + 256;
    float* impl = Os;
    u16* qs = (u16*)(Os + 64 * 4 * 64);
    unsigned long long ts_ = 0, tacc_ = 0;
    const int nitems = B_ * 2 * 128;
    for (int rr = 0;; rr++) {
        int it = bid;
        if (rr > 0 || bid < 0) {
            __syncthreads();
            if (get_tid() == 0) nlistp[3] = nb + atomicAdd(p.nsactr, 1);
            __syncthreads();
            it = nlistp[3];
        }
        if (it >= nitems) break;
        const int tid = get_tid(), lane = tid & 63, wv = tid >> 6;
        const int kr = lane & 15, qq = lane >> 4, ts = kr >> 2, hh = kr & 3;
        float* myimp = impl + wv * (32 * 2 * 16);
        const int tt = 127 - (it >> 3);
        const int bg = it & 7, b = bg >> 1, g = bg & 1;
        const int t0 = tt * 64, cur = tt;
        const int head = g * 4 + hh;
        Sub st[2];
        f32x4 T[2][4];
        int tl[2]; size_t ntok[2];
        __syncthreads();
#pragma unroll
        for (int u = 0; u < 2; u++) {
            tl[u] = 8 * wv + 4 * u + ts;
            ntok[u] = (size_t)b * S_ + t0 + tl[u];
#pragma unroll
            for (int ks = 0; ks < 2; ks++) *(bf16x8*)&qs[(tl[u] * 4 + hh) * 64 + (((ks * 4 + qq) ^ (hh >> 1) ^ ((tl[u] & 3) << 1)) << 3)] = *(const bf16x8*)&p.q[ntok[u] * 512 + head * 64 + ks * 32 + qq * 8];
#pragma unroll
            for (int dt = 0; dt < 4; dt++) st[u].O[dt] = f32x4{0.f, 0.f, 0.f, 0.f};
            st[u].m = NEG_BIG; st[u].l = 0.f;
        }
        const u16* kcb = p.kcb + (size_t)bg * 512 * 64;
        const u16* vcT = p.vcT + (size_t)bg * 8 * 4096;
        int nv[2];
#pragma unroll
        for (int u = 0; u < 2; u++) { const int t = t0 + tl[u]; nv[u] = (t >= 31) ? min((t - 31) / 16 + 1, NCMP) : 0; }
        const int tmax = t0 + 63;
        const int nvmax = (tmax >= 31) ? min((tmax - 31) / 16 + 1, NCMP) : 0;
        const int nvb = (nvmax + 63) >> 6;
        NSA_TS(1)
        __syncthreads();
        nsa_stream<false>(ring, nvb, [&](int kb) { return kcb + (size_t)kb * 4096; }, [&](int kb) { return vcT + (size_t)kb * 4096; },
            [&](int kb, const u16* Ks, const u16* Vs) {
                const int hi2[2] = {nv[0] - kb * 64 - 1, nv[1] - kb * 64 - 1};
                float e_[2][4], p3_[2][4];
                nsa_visit2<false, false>(Ks, Vs, qs + (tl[0] * 4 + hh) * 64, qs + (tl[1] * 4 + hh) * 64, st, hi2, lane, e_, p3_);
            });
        float invl[2];
#pragma unroll
        for (int u = 0; u < 2; u++) { const float lt = xq_sum(st[u].l); invl[u] = (lt > 0.f) ? 1.f / lt : 0.f; st[u].l = 0.f; }
        float carry[2] = {0.f, 0.f};
        nsa_stream<true>(ring, nvb, [&](int kb) { return kcb + (size_t)kb * 4096; }, [&](int kb) { return vcT + (size_t)kb * 4096; },
            [&](int kb, const u16* Ks, const u16* Vs) {
            const int hi2[2] = {nv[0] - kb * 64 - 1, nv[1] - kb * 64 - 1};
            float e_[2][4], p3_[2][4];
            nsa_visit2<true, true>(Ks, Vs, qs + (tl[0] * 4 + hh) * 64, qs + (tl[1] * 4 + hh) * 64, st, hi2, lane, e_, p3_);
#pragma unroll
            for (int u = 0; u < 2; u++) {
#pragma unroll
                for (int kt = 0; kt < 4; kt++) {
                    float ev = e_[u][kt] * invl[u], pv = p3_[u][kt] * invl[u];
                    ev += dppf<0xB1>(ev); ev += dppf<0x4E>(ev);
                    pv += dppf<0xB1>(pv); pv += dppf<0x4E>(pv);
                    const float sh = __int_as_float(__builtin_amdgcn_ds_bpermute(((lane - 16) & 63) << 2, __float_as_int(pv)));
                    const float nbv = (qq == 0) ? carry[u] : sh;
                    carry[u] = sh;
                    myimp[((kb * 4 + kt) * 2 + u) * 16 + ts * 4 + qq] = ev + nbv;
                }
            }
            });
        NSA_TE(1)
        NSA_TS(2)
#pragma unroll
        for (int u = 0; u < 2; u++) {
            float mv[8];
#pragma unroll
            for (int i = 0; i < 8; i++) {
                const int kk = 8 * hh + i, j = 4 * kk + qq;
                const float v = myimp[(kk * 2 + u) * 16 + ts * 4 + qq];
                mv[i] = (j >= 1 && j <= cur - 2) ? v : -1.f;
            }
            unsigned sel = 0u;
            const int ncand = max(0, cur - 2);
            const int nforced = (cur >= 2) ? 3 : (cur + 1);
            const int need = 16 - nforced;
            if (ncand <= need) {
#pragma unroll
                for (int i = 0; i < 8; i++) if (mv[i] >= 0.f) sel |= (1u << i);
            } else {
                for (int rnd = 0; rnd < need; rnd++) {
                    const float b01 = fmaxf(mv[0], mv[1]), b23 = fmaxf(mv[2], mv[3]), b45 = fmaxf(mv[4], mv[5]), b67 = fmaxf(mv[6], mv[7]);
                    float best = fmaxf(fmaxf(b01, b23), fmaxf(b45, b67));
                    int bi = 7;
#pragma unroll
                    for (int i = 6; i >= 0; i--) bi = (mv[i] == best) ? i : bi;
                    int bj = (best >= 0.f) ? (4 * (8 * hh + bi) + qq) : 9999;
#define TK_MERGE(ov, oj) { const float v2_ = (ov); const int j2_ = (oj); const bool tk_ = (v2_ > best) || (v2_ == best && j2_ < bj); best = tk_ ? v2_ : best; bj = tk_ ? j2_ : bj; }
                    TK_MERGE(dppf<0xB1>(best), __builtin_amdgcn_update_dpp(0, bj, 0xB1, 0xF, 0xF, true))
                    TK_MERGE(dppf<0x4E>(best), __builtin_amdgcn_update_dpp(0, bj, 0x4E, 0xF, 0xF, true))
                    {
                        auto rv = __builtin_amdgcn_permlane16_swap(__float_as_uint(best), __float_as_uint(best), false, false);
                        auto rj = __builtin_amdgcn_permlane16_swap((unsigned)bj, (unsigned)bj, false, false);
                        float v0 = __uint_as_float(rv[0]), v1 = __uint_as_float(rv[1]); int j0 = (int)rj[0], j1 = (int)rj[1];
                        if (v1 > v0 || (v1 == v0 && j1 < j0)) { v0 = v1; j0 = j1; }
                        rv = __builtin_amdgcn_permlane32_swap(__float_as_uint(v0), __float_as_uint(v0), false, false);
                        rj = __builtin_amdgcn_permlane32_swap((unsigned)j0, (unsigned)j0, false, false);
                        best = __uint_as_float(rv[0]); bj = (int)rj[0];
                        const float v2 = __uint_as_float(rv[1]); const int j2 = (int)rj[1];
                        if (v2 > best || (v2 == best && j2 < bj)) { best = v2; bj = j2; }
                    }
#undef TK_MERGE
                    const bool mine = (bj < 512) && ((bj >> 5) == hh) && ((bj & 3) == qq);
                    const int li = (bj >> 2) & 7;
#pragma unroll
                    for (int i = 0; i < 8; i++) mv[i] = (mine && li == i) ? -1.f : mv[i];
                    if (mine) sel |= (1u << li);
                }
            }
            if (qq == 0 && hh == 0) sel |= 1u;
            if ((cur & 3) == qq && (cur >> 5) == hh) sel |= (1u << ((cur >> 2) & 7));
            if (cur >= 1 && ((cur - 1) & 3) == qq && ((cur - 1) >> 5) == hh) sel |= (1u << (((cur - 1) >> 2) & 7));
            unsigned w = sel << (8 * hh);
            w |= (unsigned)__builtin_amdgcn_update_dpp(0, (int)w, 0xB1, 0xF, 0xF, true);
            w |= (unsigned)__builtin_amdgcn_update_dpp(0, (int)w, 0x4E, 0xF, 0xF, true);
            if (hh == 0) selm[tl[u] * 4 + qq] = w;
        }
        NSA_TE(2)
        NSA_TS(3)
        __syncthreads();
#pragma unroll
        for (int u = 0; u < 2; u++) { NSA_TOK(u) nsa_fold<0>(st[u], T[u], p.nsag[ntk_ * 24 + hd_ * 3 + 0]); }
        {
            const int t2 = get_tid();
#pragma unroll
            for (int i = 0; i < 8; i++) *(f32x4*)&Os[(i * NT + t2) * 4] = f32x4{0.f, 0.f, 0.f, 0.f};
            if (t2 < 256) { Ms[t2] = NEG_BIG; Ls[t2] = 0.f; }
            unsigned long long tm = 0ull; int lrank = 0;
            if (t2 < 128) {
                const int j = t2;
                for (int tk = 0; tk < 64; tk++) tm |= (unsigned long long)((selm[tk * 4 + (j & 3)] >> (j >> 2)) & 1u) << tk;
                if (j > cur) tm = 0ull;
                const unsigned long long bal = __ballot(tm != 0ull);
                lrank = __popcll(bal & ((1ull << (t2 & 63)) - 1ull));
                if ((t2 & 63) == 0) nlistp[t2 >> 6] = __popcll(bal);
            }
            __syncthreads();
            if (t2 < 128 && tm != 0ull) {
                const int pos = lrank + ((t2 >= 64) ? nlistp[0] : 0);
                blist[pos] = t2; lcnt[pos] = __popcll(tm);
                int c = 0;
                while (tm) { lists[pos * 64 + c] = (unsigned char)(__ffsll((long long)tm) - 1); c++; tm &= tm - 1ull; }
            }
            __syncthreads();
        }
        const int nlist = nlistp[0] + nlistp[1];
        NSA_TE(3)
        NSA_TS(4)
        const u16* ksl = p.ksl + (size_t)bg * S_ * 64;
        const u16* vslT = p.vslT + (size_t)bg * 128 * 4096;
        {
            const int t4 = get_tid(), wv4 = __builtin_amdgcn_readfirstlane(t4 >> 6), ts4 = (t4 & 15) >> 2;
            const int td = t4 & 255;
            const int so = (td >> 3) * 64 + (((td & 7) ^ ((td >> 4) & 7)) << 3);
            char* dl = ring + td * 16;
#define NSA_RI(i) (nlist - 1 - (i))
#define NSA_ISSUE2(i, slot) if (wv4 >= 4) { const int jj_ = blist[NSA_RI(i)]; const u16* kp_ = ksl + (size_t)jj_ * 4096 + so; const u16* vp_ = vslT + (size_t)jj_ * 4096 + so; char* d_ = dl + (slot) * 16384; \
                glds16(kp_, d_); glds16(kp_ + 2048, d_ + 4096); glds16(vp_, d_ + 8192); glds16(vp_ + 2048, d_ + 12288); }
            asm volatile("s_waitcnt lgkmcnt(0)" ::: "memory");
            __builtin_amdgcn_s_barrier();
            if (nlist > 0) NSA_ISSUE2(0, 0)
            if (nlist > 1) NSA_ISSUE2(1, 1)
            int jn = 0, nn = 0, tokn = 0;
            if (nlist > 0) { jn = blist[NSA_RI(0)]; nn = lcnt[NSA_RI(0)]; tokn = lists[NSA_RI(0) * 64 + wv4 * 4 + ts4]; }
            int slot = 0;
            for (int i = 0; i < nlist; i++) {
                if (i + 1 < nlist) asm volatile("s_waitcnt vmcnt(4)" ::: "memory"); else asm volatile("s_waitcnt vmcnt(0)" ::: "memory");
                asm volatile("s_waitcnt lgkmcnt(0)" ::: "memory");
                __builtin_amdgcn_s_barrier();
                asm volatile("" ::: "memory");
                const int sl2 = (slot == 0) ? 2 : slot - 1;
                if (i + 2 < nlist) NSA_ISSUE2(i + 2, sl2)
                const int j = jn, n = nn, tok0 = tokn;
                if (i + 1 < nlist) { jn = blist[NSA_RI(i + 1)]; nn = lcnt[NSA_RI(i + 1)]; tokn = lists[NSA_RI(i + 1) * 64 + wv4 * 4 + ts4]; }
                const u16* Ks = (const u16*)(ring + slot * 16384); const u16* Vs = Ks + 4096;
                if ((wv4 + NW) * 4 < n) {
                    const int e1 = (wv4 + NW) * 4 + ts4;
                    const bool vl2[2] = {true, e1 < n};
                    const int tk2[2] = {tok0, vl2[1] ? (int)lists[NSA_RI(i) * 64 + (e1 & 63)] : 0};
                    if (j == cur) nsa_visit_gn<1, false, 2>(Ks, Vs, qs, Os, Ms, Ls, tk2, vl2, t4 & 63);
                    else nsa_visit_gn<0, true, 2>(Ks, Vs, qs, Os, Ms, Ls, tk2, vl2, t4 & 63);
                } else if (wv4 * 4 < n) {
                    const int e = wv4 * 4 + ts4;
                    const bool valid = e < n;
                    const int tok = valid ? tok0 : 0;
                    if (j == cur) nsa_visit_g<1, false>(Ks, Vs, qs, Os, Ms, Ls, tok, valid, t4 & 63);
                    else nsa_visit_g<0, true>(Ks, Vs, qs, Os, Ms, Ls, tok, valid, t4 & 63);
                }
                slot = (slot == 2) ? 0 : slot + 1;
            }
#undef NSA_RI
#undef NSA_ISSUE2
        }
        __syncthreads();
        NSA_TE(4)
        NSA_TS(5)
#pragma unroll
        for (int u = 0; u < 2; u++) {
            NSA_TOK(u)
            const int t5 = t3_ & 63;
            nsa_fold_lds(Os, Ms, Ls, (8 * (t3_ >> 6) + 4 * u + ((t5 & 15) >> 2)) * 4 + (t5 & 3), t5 >> 4, t5 & 3, T[u], p.nsag[ntk_ * 24 + hd_ * 3 + 1], true);
        }
        const u16* kwn = p.kwn + (size_t)bg * S_ * 64;
        const u16* vwnT = p.vwnT + (size_t)bg * 128 * 4096;
        uint2 Tp[2][4];
#pragma unroll
        for (int u = 0; u < 2; u++)
#pragma unroll
            for (int dt = 0; dt < 4; dt++) { Tp[u][dt] = pack4(T[u][dt]); asm volatile("" : "+v"(Tp[u][dt].x), "+v"(Tp[u][dt].y)); }
        {
            const int jlo = max(0, cur - 8);
            nsa_stream<true>(ring, cur - jlo + 1, [&](int i) { return kwn + (size_t)(cur - i) * 4096; }, [&](int i) { return vwnT + (size_t)(cur - i) * 4096; },
                [&](int i, const u16* Ks, const u16* Vs) {
                    const int j = cur - i;
                    const int t4 = get_tid();
                    const int tb_ = 8 * (t4 >> 6) + ((t4 & 15) >> 2);
                    const int tk2[2] = {tb_, tb_ + 4}; const bool vl2[2] = {true, true};
                    if (j == cur) nsa_visit_gn<1, false, 2>(Ks, Vs, qs, Os, Ms, Ls, tk2, vl2, t4 & 63);
                    else if (j == cur - 8) nsa_visit_gn<2, true, 2>(Ks, Vs, qs, Os, Ms, Ls, tk2, vl2, t4 & 63);
                    else nsa_visit_gn<0, true, 2>(Ks, Vs, qs, Os, Ms, Ls, tk2, vl2, t4 & 63);
                });
        }
#pragma unroll
        for (int u = 0; u < 2; u++) {
            NSA_TOK(u)
#pragma unroll
            for (int dt = 0; dt < 4; dt++) T[u][dt] = unpack4(Tp[u][dt]);
            { const int t5 = t3_ & 63; nsa_fold_lds(Os, Ms, Ls, (8 * (t3_ >> 6) + 4 * u + ((t5 & 15) >> 2)) * 4 + (t5 & 3), t5 >> 4, t5 & 3, T[u], p.nsag[ntk_ * 24 + hd_ * 3 + 2], false); }
#pragma unroll
            for (int dt = 0; dt < 4; dt++) *(uint2*)&p.oa[ntk_ * 512 + hd_ * 64 + dt * 16 + ((t3_ & 63) >> 4) * 4] = pack4(T[u][dt]);
        }
        NSA_TE(5)
    }
    if (NSAPROBE) { __syncthreads(); const unsigned long long t1_ = __builtin_amdgcn_s_memrealtime(); while (__builtin_amdgcn_s_memrealtime() - t1_ < tacc_) __builtin_amdgcn_s_sleep(8); }
}

#ifndef CHPROBE
#define CHPROBE 0
#endif
#define CH_TS(k) if (CHPROBE == k) cts_ = __builtin_amdgcn_s_memrealtime();
#define CH_TE(k) if (CHPROBE == k) ctacc_ += __builtin_amdgcn_s_memrealtime() - cts_;
constexpr int RS = 72;
constexpr int RSLOT = 64 * RS;
__device__ __forceinline__ void mm64(const u16* A, int lda, const u16* Bz, int ldb, f32x4 (&acc)[2], int lane, int wv) {
    const int mt = wv >> 1, nt0 = (wv & 1) * 2, kr = lane & 15, qq = lane >> 4;
    bf16x8 a[2], b[2][2];
#pragma unroll
    for (int ks = 0; ks < 2; ks++) {
        a[ks] = *(const bf16x8*)&A[(mt * 16 + kr) * lda + ks * 32 + qq * 8];
#pragma unroll
        for (int i = 0; i < 2; i++) b[ks][i] = *(const bf16x8*)&Bz[((nt0 + i) * 16 + kr) * ldb + ks * 32 + qq * 8];
    }
#pragma unroll
    for (int ks = 0; ks < 2; ks++)
#pragma unroll
        for (int i = 0; i < 2; i++) acc[i] = __builtin_amdgcn_mfma_f32_16x16x32_bf16(a[ks], b[ks][i], acc[i], 0, 0, 0);
}
__device__ __forceinline__ void st_t(u16* dst, int ld, const f32x4& v, int mt, int nt, int lane) {
    uint2 o; o.x = pack2(v[0], v[1]); o.y = pack2(v[2], v[3]);
    *(uint2*)&dst[(nt * 16 + (lane & 15)) * ld + mt * 16 + (lane >> 4) * 4] = o;
}
__device__ __forceinline__ void st_n(u16* dst, int ld, const f32x4& v, int mt, int nt, int lane) {
#pragma unroll
    for (int r = 0; r < 4; r++) dst[(mt * 16 + (lane >> 4) * 4 + r) * ld + nt * 16 + (lane & 15)] = f2bf(v[r]);
}
#define ZACC(a) { a[0] = f32x4{0.f, 0.f, 0.f, 0.f}; a[1] = f32x4{0.f, 0.f, 0.f, 0.f}; }

__device__ void ph_rwkv_chunk(const P& p, int bid, int nb, char* smem) {
    unsigned long long cts_ = 0, ctacc_ = 0;
    u16* sl = (u16*)smem;
    float* tot = (float*)(sl + 14 * RSLOT);
    float* gl = tot + 512;
#define RW_IDX const int tid = get_tid(), lane = tid & 63, wv = tid >> 6, mt = wv >> 1, nt0 = (wv & 1) * 2, kr = lane & 15, qq = lane >> 4; (void)mt; (void)nt0; (void)kr; (void)qq; (void)lane;
    const int nitems = B_ * 128;
    for (int it0 = bid; it0 < nitems; it0 += nb) {
      const int c = it0 & 127, b = it0 >> 7;
      const size_t n0 = (size_t)b * S_ + c * 64;
      __syncthreads();
      bf16x8 xa_[8], wb[2][2], ab[2][2], gb[2][4];
      u16 rc[8][3], rp0[3];
      float w0c[2], a0c[2], hc_[6];
#define S1_LOADW(hh_) { RW_IDX \
          _Pragma("unroll") for (int i = 0; i < 2; i++) { const int cc = (nt0 + i) * 16 + kr; w0c[i] = p.w0[(hh_) * 64 + cc]; a0c[i] = p.a0[(hh_) * 64 + cc]; \
              _Pragma("unroll") for (int ks = 0; ks < 2; ks++) { wb[i][ks] = *(const bf16x8*)&p.w2T[((size_t)(hh_) * 64 + cc) * 64 + ks * 32 + qq * 8]; \
                                                                 ab[i][ks] = *(const bf16x8*)&p.a2T[((size_t)(hh_) * 64 + cc) * 64 + ks * 32 + qq * 8]; } \
              _Pragma("unroll") for (int ks = 0; ks < 4; ks++) gb[i][ks] = *(const bf16x8*)&p.g2T[((size_t)(hh_) * 64 + cc) * 128 + ks * 32 + qq * 8]; } }
#define S2_LOADX(hh_) { RW_IDX const int ch_ = (hh_) * 64 + lane; \
          hc_[0] = p.mu[ch_]; hc_[1] = p.mu[512 + ch_]; hc_[2] = p.mu[1024 + ch_]; hc_[3] = p.k_k[ch_]; hc_[4] = p.k_a[ch_]; hc_[5] = p.r_k[ch_]; \
          _Pragma("unroll") for (int i = 0; i < 8; i++) { const int t = wv * 8 + i; const u16* cr = p.prw + (n0 + t) * CRW; \
              rc[i][0] = cr[ch_]; rc[i][1] = cr[512 + ch_]; rc[i][2] = cr[1024 + ch_]; } \
          rp0[0] = 0; rp0[1] = 0; rp0[2] = 0;     \
          if (c * 64 + wv * 8 > 0) { const u16* pp = p.prw + (n0 + wv * 8 - 1) * CRW; rp0[0] = pp[ch_]; rp0[1] = pp[512 + ch_]; rp0[2] = pp[1024 + ch_]; } }
      S2_LOADX(0)
      {
          RW_IDX
          const int t = tid >> 3, part = tid & 7;
          const size_t n = n0 + t;
          const bool hasprev = (c * 64 + t) > 0;
          u16* dst = p.xact + n * 256 + part * 32;
#pragma unroll
          for (int j = 0; j < 4; j++) {
              const int col = 1536 + part * 32 + j * 8;
              const uint4 cu = *(const uint4*)&p.prw[n * CRW + col];
              uint4 pv = make_uint4(0u, 0u, 0u, 0u);
              if (hasprev) pv = *(const uint4*)&p.prw[(n - 1) * CRW + col];
              const unsigned cw[4] = {cu.x, cu.y, cu.z, cu.w}, pw[4] = {pv.x, pv.y, pv.z, pv.w};
              unsigned ow[4];
#pragma unroll
              for (int e2 = 0; e2 < 4; e2++) {
                  float x0 = __uint_as_float(cw[e2] << 16), x1 = __uint_as_float(cw[e2] & 0xFFFF0000u);
                  const float q0 = __uint_as_float(pw[e2] << 16), q1 = __uint_as_float(pw[e2] & 0xFFFF0000u);
                  x0 = x0 + (q0 - x0) * p.mu[col + 2 * e2]; x1 = x1 + (q1 - x1) * p.mu[col + 2 * e2 + 1];
                  if (part < 2) { x0 = tanhf(x0); x1 = tanhf(x1); }
                  else if (part >= 4) { x0 = sigmoidf_(x0); x1 = sigmoidf_(x1); }
                  ow[e2] = pack2(x0, x1);
              }
              *(uint4*)&dst[j * 8] = make_uint4(ow[0], ow[1], ow[2], ow[3]);
          }
      }
      __syncthreads();
      const u16* xa = p.xact + n0 * 256;
      {
          RW_IDX
#pragma unroll
          for (int k8 = 0; k8 < 8; k8++) xa_[k8] = *(const bf16x8*)&xa[(mt * 16 + kr) * 256 + k8 * 32 + qq * 8];
      }
      S1_LOADW(0)
#pragma unroll 1
      for (int h = 0; h < 8; h++) {
        u16* cd = p.cdat + ((size_t)((b * 8 + h) * 128 + c)) * 4 * 4096;
        LDS_BARRIER();
        CH_TS(1)
        float* LW = (float*)(sl + 8 * RSLOT); float* LA = (float*)(sl + 10 * RSLOT);
        {
            RW_IDX
            f32x4 aw[2], aa2[2], ag[2];
#pragma unroll
            for (int i = 0; i < 2; i++) {
                aw[i] = f32x4{0.f, 0.f, 0.f, 0.f}; aa2[i] = aw[i]; ag[i] = aw[i];
#pragma unroll
                for (int ks = 0; ks < 2; ks++) {
                    aw[i] = __builtin_amdgcn_mfma_f32_16x16x32_bf16(xa_[ks], wb[i][ks], aw[i], 0, 0, 0);
                    aa2[i] = __builtin_amdgcn_mfma_f32_16x16x32_bf16(xa_[2 + ks], ab[i][ks], aa2[i], 0, 0, 0);
                }
#pragma unroll
                for (int ks = 0; ks < 4; ks++) ag[i] = __builtin_amdgcn_mfma_f32_16x16x32_bf16(xa_[4 + ks], gb[i][ks], ag[i], 0, 0, 0);
            }
#pragma unroll
            for (int i = 0; i < 2; i++)
#pragma unroll
                for (int r = 0; r < 4; r++) {
                    const int t = mt * 16 + qq * 4 + r, cc = (nt0 + i) * 16 + kr;
                    const float wl = w0c[i] + aw[i][r];
                    const float z = -wl;
                    const float sp = fmaxf(z, 0.f) + __logf(1.f + __expf(-fabsf(z)));
                    LW[t * 64 + cc] = -__expf(-sp - 0.5f);
                    LA[t * 64 + cc] = sigmoidf_(a0c[i] + aa2[i][r]);
                    p.ob[(n0 + t) * 512 + h * 64 + cc] = f2bf(ag[i][r]);
                }
        }
        LDS_BARRIER();
        CH_TE(1) CH_TS(2)
        {
            RW_IDX
            const int ch = h * 64 + lane;
            const float mur = hc_[0], muk = hc_[1], muv = hc_[2];
            const float kkw = hc_[3], kaw = hc_[4], rkw = hc_[5];
            float rr[8], k2[8], vv[8], kkn[8], aa[8], lg[8], cs[8];
            float run = 0.f;
#pragma unroll
            for (int i = 0; i < 8; i++) {
                const int t = wv * 8 + i; const size_t n = n0 + t;
                float r = bf2f(rc[i][0]), k = bf2f(rc[i][1]), v = bf2f(rc[i][2]);
                const float pr = bf2f(i ? rc[i - 1][0] : rp0[0]), pk = bf2f(i ? rc[i - 1][1] : rp0[1]), pv = bf2f(i ? rc[i - 1][2] : rp0[2]);
                r = r + (pr - r) * mur; k = k + (pk - k) * muk; v = v + (pv - v) * muv;
                const float a = LA[t * 64 + lane];
                lg[i] = LW[t * 64 + lane];
                float kk = k * kkw;
                kkn[i] = kk * __builtin_amdgcn_rsqf(fmaxf(wave_sum(kk * kk), 1e-24f));
                k2[i] = k * (1.f + (a - 1.f) * kaw);
                const float bon = wave_sum(r * k2[i] * rkw);
                if (lane == 0) p.bon[n * 8 + h] = bon;
                rr[i] = r; vv[i] = v; aa[i] = a;
                run += lg[i]; cs[i] = run;
            }
            tot[wv * 64 + lane] = run;
            LDS_BARRIER();
            float off = 0.f, cumL = 0.f;
#pragma unroll
            for (int w2 = 0; w2 < 8; w2++) { const float tv = tot[w2 * 64 + lane]; cumL += tv; if (w2 < wv) off += tv; }
            if (wv == 0) gl[lane] = __expf(cumL);
            unsigned pa[4], pb[4], pk4[4], pv4[4];
#pragma unroll
            for (int i = 0; i < 8; i += 2) {
                float at[2], bt[2], kt[2], rt[2];
#pragma unroll
                for (int e2 = 0; e2 < 2; e2++) {
                    const int ii = i + e2; const int t = wv * 8 + ii;
                    const float cm = off + cs[ii];
                    const float g = __expf(cm), gp = __expf(cm - lg[ii]), gi = __expf(-cm);
                    at[e2] = -kkn[ii] * gp; bt[e2] = kkn[ii] * aa[ii] * gi; kt[e2] = k2[ii] * gi; rt[e2] = rr[ii] * g;
                    sl[0 * RSLOT + t * RS + lane] = f2bf(at[e2]);
                    sl[1 * RSLOT + t * RS + lane] = f2bf(bt[e2]);
                    sl[2 * RSLOT + t * RS + lane] = f2bf(kt[e2]);
                    sl[3 * RSLOT + t * RS + lane] = f2bf(rt[e2]);
                }
                pa[i >> 1] = pack2(at[0], at[1]); pb[i >> 1] = pack2(bt[0], bt[1]);
                pk4[i >> 1] = pack2(kt[0], kt[1]); pv4[i >> 1] = pack2(vv[i], vv[i + 1]);
            }
            *(uint4*)&sl[4 * RSLOT + lane * RS + wv * 8] = make_uint4(pa[0], pa[1], pa[2], pa[3]);
            *(uint4*)&sl[5 * RSLOT + lane * RS + wv * 8] = make_uint4(pb[0], pb[1], pb[2], pb[3]);
            *(uint4*)&sl[6 * RSLOT + lane * RS + wv * 8] = make_uint4(pk4[0], pk4[1], pk4[2], pk4[3]);
            *(uint4*)&sl[7 * RSLOT + lane * RS + wv * 8] = make_uint4(pv4[0], pv4[1], pv4[2], pv4[3]);
        }
        LDS_BARRIER();
        if (h + 1 < 8) { asm volatile("s_waitcnt vmcnt(0)" ::: "memory");
                         S1_LOADW(h + 1) S2_LOADX(h + 1) }
        CH_TE(2) CH_TS(3)
        {
            RW_IDX
            f32x4 acc[2];
            ZACC(acc); mm64(sl + 1 * RSLOT, RS, sl + 0 * RSLOT, RS, acc, lane, wv);
#pragma unroll
            for (int i = 0; i < 2; i++) {
                f32x4 pm;
#pragma unroll
                for (int r = 0; r < 4; r++) {
                    const int m = mt * 16 + qq * 4 + r, n = (nt0 + i) * 16 + kr;
                    if (!(m < n)) acc[i][r] = 0.f;
                    pm[r] = acc[i][r] + ((m == n) ? 1.f : 0.f);
                }
                st_t(sl + 8 * RSLOT, RS, acc[i], mt, nt0 + i, lane);
                st_n(sl + 9 * RSLOT, RS, acc[i], mt, nt0 + i, lane);
                st_t(sl + 13 * RSLOT, RS, pm, mt, nt0 + i, lane);
            }
            ZACC(acc); mm64(sl + 0 * RSLOT, RS, sl + 2 * RSLOT, RS, acc, lane, wv);
#pragma unroll
            for (int i = 0; i < 2; i++) {
#pragma unroll
                for (int r = 0; r < 4; r++) { const int m = mt * 16 + qq * 4 + r, n = (nt0 + i) * 16 + kr; if (!(m > n)) acc[i][r] = 0.f; }
                st_t(sl + 10 * RSLOT, RS, acc[i], mt, nt0 + i, lane);
            }
            ZACC(acc); mm64(sl + 1 * RSLOT, RS, sl + 3 * RSLOT, RS, acc, lane, wv);
#pragma unroll
            for (int i = 0; i < 2; i++) {
#pragma unroll
                for (int r = 0; r < 4; r++) { const int m = mt * 16 + qq * 4 + r, n = (nt0 + i) * 16 + kr; if (m > n) acc[i][r] = 0.f; }
                st_t(sl + 11 * RSLOT, RS, acc[i], mt, nt0 + i, lane);
            }
            ZACC(acc); mm64(sl + 2 * RSLOT, RS, sl + 3 * RSLOT, RS, acc, lane, wv);
#pragma unroll
            for (int i = 0; i < 2; i++) {
#pragma unroll
                for (int r = 0; r < 4; r++) { const int m = mt * 16 + qq * 4 + r, n = (nt0 + i) * 16 + kr; if (m > n) acc[i][r] = 0.f; }
                st_t(sl + 12 * RSLOT, RS, acc[i], mt, nt0 + i, lane);
            }
        }
        LDS_BARRIER();
        CH_TE(3) CH_TS(4)
        u16* X = sl + 8 * RSLOT; u16* XT = sl + 9 * RSLOT; u16* X2 = sl + 0 * RSLOT; u16* X2T = sl + 1 * RSLOT;
        u16* Pc = sl + 13 * RSLOT; u16* Pn = sl + 2 * RSLOT;
#pragma unroll 1
        for (int j = 1; j <= 6; j++) {
            RW_IDX
            f32x4 acc[2];
            if (j <= 5) {
                ZACC(acc); mm64(X, RS, XT, RS, acc, lane, wv);
#pragma unroll
                for (int i = 0; i < 2; i++) { st_t(X2T, RS, acc[i], mt, nt0 + i, lane); st_n(X2, RS, acc[i], mt, nt0 + i, lane); }
            }
            if (j >= 2) {
                ZACC(acc); mm64(XT, RS, Pc, RS, acc, lane, wv);
#pragma unroll
                for (int i = 0; i < 2; i++) {
                    const uint2 pv = *(const uint2*)&Pc[((nt0 + i) * 16 + kr) * RS + mt * 16 + qq * 4];
                    acc[i][0] += __uint_as_float(pv.x << 16); acc[i][1] += __uint_as_float(pv.x & 0xFFFF0000u);
                    acc[i][2] += __uint_as_float(pv.y << 16); acc[i][3] += __uint_as_float(pv.y & 0xFFFF0000u);
                    st_t(Pn, RS, acc[i], mt, nt0 + i, lane);
                }
            }
            LDS_BARRIER();
            if (j >= 2) { u16* tp = Pc; Pc = Pn; Pn = tp; }
            if (j <= 5) { u16* tx = X; X = X2; X2 = tx; tx = XT; XT = X2T; X2T = tx; }
        }
        CH_TE(4) CH_TS(5)
        u16* TT = Pc;
        {
            RW_IDX
            f32x4 acc[2];
            ZACC(acc); mm64(TT, RS, sl + 4 * RSLOT, RS, acc, lane, wv);
#pragma unroll
            for (int i = 0; i < 2; i++) st_t(sl + 0 * RSLOT, RS, acc[i], mt, nt0 + i, lane);
            ZACC(acc); mm64(sl + 10 * RSLOT, RS, TT, RS, acc, lane, wv);
#pragma unroll
            for (int i = 0; i < 2; i++) st_t(sl + 8 * RSLOT, RS, acc[i], mt, nt0 + i, lane);
        }
        LDS_BARRIER();
        {
            RW_IDX
            f32x4 acc[2];
            ZACC(acc); mm64(sl + 8 * RSLOT, RS, sl + 7 * RSLOT, RS, acc, lane, wv);
#pragma unroll
            for (int i = 0; i < 2; i++) st_t(sl + 9 * RSLOT, RS, acc[i], mt, nt0 + i, lane);
            ZACC(acc); mm64(sl + 0 * RSLOT, RS, sl + 5 * RSLOT, RS, acc, lane, wv);
#pragma unroll
            for (int i = 0; i < 2; i++) {
                const int n = (nt0 + i) * 16 + kr; const float gn = gl[n];
#pragma unroll
                for (int r = 0; r < 4; r++) { const int m = mt * 16 + qq * 4 + r; acc[i][r] = acc[i][r] * gn + ((m == n) ? gn : 0.f); }
                st_t(cd, 64, acc[i], mt, nt0 + i, lane);
            }
            ZACC(acc); mm64(sl + 0 * RSLOT, RS, sl + 11 * RSLOT, RS, acc, lane, wv);
#pragma unroll
            for (int i = 0; i < 2; i++) {
                const uint2 rv = *(const uint2*)&sl[3 * RSLOT + ((nt0 + i) * 16 + kr) * RS + mt * 16 + qq * 4];
                acc[i][0] += __uint_as_float(rv.x << 16); acc[i][1] += __uint_as_float(rv.x & 0xFFFF0000u);
                acc[i][2] += __uint_as_float(rv.y << 16); acc[i][3] += __uint_as_float(rv.y & 0xFFFF0000u);
                st_t(cd + 2 * 4096, 64, acc[i], mt, nt0 + i, lane);
            }
        }
        LDS_BARRIER();
        {
            RW_IDX
            f32x4 acc[2];
            ZACC(acc);
            mm64(sl + 5 * RSLOT, RS, sl + 9 * RSLOT, RS, acc, lane, wv);
            mm64(sl + 6 * RSLOT, RS, sl + 7 * RSLOT, RS, acc, lane, wv);
#pragma unroll
            for (int i = 0; i < 2; i++) {
#pragma unroll
                for (int r = 0; r < 4; r++) acc[i][r] *= gl[mt * 16 + qq * 4 + r];
                st_t(cd + 1 * 4096, 64, acc[i], mt, nt0 + i, lane);
            }
            ZACC(acc);
            mm64(sl + 9 * RSLOT, RS, sl + 11 * RSLOT, RS, acc, lane, wv);
            mm64(sl + 7 * RSLOT, RS, sl + 12 * RSLOT, RS, acc, lane, wv);
#pragma unroll
            for (int i = 0; i < 2; i++) st_t(cd + 3 * 4096, 64, acc[i], mt, nt0 + i, lane);
        }
        CH_TE(5)
      }
    }
    if (CHPROBE) { __syncthreads(); const unsigned long long t1_ = __builtin_amdgcn_s_memrealtime(); while (__builtin_amdgcn_s_memrealtime() - t1_ < ctacc_) __builtin_amdgcn_s_sleep(8); }
}

__device__ void ph_rwkv_seq(const P& p, int bid, int nb, char* smem) {
    u16* SL = (u16*)smem;
    const int tid = get_tid(), lane = tid & 63, wv = __builtin_amdgcn_readfirstlane(tid >> 6);
    const int kr = lane & 15, qq = lane >> 4, chn = wv >> 2, vt = wv & 3;
    for (int pair = bid; pair < B_ * 4; pair += nb) {
        const int bh = pair * 2 + chn;
        u16* mySL = SL + chn * RSLOT;
        __syncthreads();
#pragma unroll
        for (int ks = 0; ks < 2; ks++) *(uint4*)&mySL[(vt * 16 + kr) * RS + ks * 32 + qq * 8] = make_uint4(0u, 0u, 0u, 0u);
        u16* cbase = p.cdat + (size_t)bh * 128 * 4 * 4096;
        bf16x8 GA0[4][2], GA1[4][2], GA2[4][2], GA3[4][2]; u32x2 H0[4], H1[4], H2[4], H3[4];
#define SEQ_LD(GAx, Hx, c) { const u16* g0_ = cbase + (size_t)(c) * 4 * 4096 + kr * 64 + qq * 8; const u16* g1_ = g0_ + 2048; \
            const u16* hp_ = cbase + (size_t)(c) * 4 * 4096 + 4096 + (vt * 16 + kr) * 64 + qq * 4; \
            GAx[0][0] = gload_b128<0>(g0_); GAx[0][1] = gload_b128<64>(g0_); GAx[1][0] = gload_b128<2048>(g0_); GAx[1][1] = gload_b128<2112>(g0_); \
            GAx[2][0] = gload_b128<0>(g1_); GAx[2][1] = gload_b128<64>(g1_); GAx[3][0] = gload_b128<2048>(g1_); GAx[3][1] = gload_b128<2112>(g1_); \
            Hx[0] = gload_b64<0>(hp_); Hx[1] = gload_b64<32>(hp_); Hx[2] = gload_b64<64>(hp_); Hx[3] = gload_b64<96>(hp_); }
#define SEQ_STEP(GAx, Hx, c, nw) { \
            if ((nw) == 48) asm volatile("s_waitcnt vmcnt(48)" ::: "memory"); else if ((nw) == 36) asm volatile("s_waitcnt vmcnt(36)" ::: "memory"); \
            else if ((nw) == 24) asm volatile("s_waitcnt vmcnt(24)" ::: "memory"); else asm volatile("s_waitcnt vmcnt(12)" ::: "memory"); \
              \
            asm volatile("" : "+v"(GAx[0][0]), "+v"(GAx[0][1]), "+v"(GAx[1][0]), "+v"(GAx[1][1]), "+v"(GAx[2][0]), "+v"(GAx[2][1]), "+v"(GAx[3][0]), "+v"(GAx[3][1]), \
                              "+v"(Hx[0]), "+v"(Hx[1]), "+v"(Hx[2]), "+v"(Hx[3]) :: "memory"); \
            bf16x8 Z0[2]; \
            _Pragma("unroll") for (int ks = 0; ks < 2; ks++) Z0[ks] = *(const bf16x8*)&mySL[(vt * 16 + kr) * RS + ks * 32 + qq * 8]; \
            f32x4 zs[4]; \
            _Pragma("unroll") for (int m4 = 0; m4 < 4; m4++) { \
                zs[m4] = unpack4(make_uint2(Hx[m4].x, Hx[m4].y)); \
                _Pragma("unroll") for (int ks = 0; ks < 2; ks++) zs[m4] = __builtin_amdgcn_mfma_f32_16x16x32_bf16(GAx[m4][ks], Z0[ks], zs[m4], 0, 0, 0); } \
            u16* sn_ = cbase + (size_t)(c) * 4 * 4096 + 1 * 4096 + (vt * 16 + kr) * 64 + qq * 4; \
            _Pragma("unroll") for (int m4 = 0; m4 < 4; m4++) { \
                const uint2 pk_ = pack4(zs[m4]); \
                *(uint2*)&mySL[(vt * 16 + kr) * RS + m4 * 16 + qq * 4] = pk_; \
                *(uint2*)&sn_[m4 * 16] = pk_; } \
            asm volatile("" ::: "memory"); \
            if ((c) + 4 < 128) SEQ_LD(GAx, Hx, (c) + 4) }
        asm volatile("s_waitcnt vmcnt(0)" ::: "memory");
        SEQ_LD(GA0, H0, 0) SEQ_LD(GA1, H1, 1) SEQ_LD(GA2, H2, 2) SEQ_LD(GA3, H3, 3)
#pragma unroll 1
        for (int c = 0; c < 128; c += 4) {
            const bool first = (c == 0), lastt = (c == 124);
            SEQ_STEP(GA0, H0, c, first ? 36 : 48)
            SEQ_STEP(GA1, H1, c + 1, (first || lastt) ? 36 : 48)
            SEQ_STEP(GA2, H2, c + 2, first ? 36 : (lastt ? 24 : 48))
            SEQ_STEP(GA3, H3, c + 3, lastt ? 12 : 48)
        }
        asm volatile("s_waitcnt vmcnt(0)" ::: "memory");
#undef SEQ_LD
#undef SEQ_STEP
    }
}

__device__ void ph_rwkv_out(const P& p, int bid, int nb, char* smem) {
    const int tid = get_tid(), lane = tid & 63, wv = tid >> 6;
    const int kr = lane & 15, qq = lane >> 4;
    for (int it = bid * NW + wv; it < B_ * 8 * 128; it += nb * NW) {
        const int c = it & 127, bh = it >> 7, b = bh >> 3, h = bh & 7;
        const u16* cd = p.cdat + ((size_t)bh * 128 + c) * 4 * 4096;
        f32x4 ys[4][4];
#pragma unroll
        for (int mt = 0; mt < 4; mt++)
#pragma unroll
            for (int nt = 0; nt < 4; nt++) ys[mt][nt] = unpack4(*(const uint2*)&cd[3 * 4096 + (nt * 16 + kr) * 64 + mt * 16 + qq * 4]);
        if (c > 0) {
            const u16* s0 = cd - 4 * 4096 + 1 * 4096;
#pragma unroll
            for (int ks = 0; ks < 2; ks++) {
                bf16x8 af[4], bq[4];
#pragma unroll
                for (int mt = 0; mt < 4; mt++) af[mt] = *(const bf16x8*)&s0[(mt * 16 + kr) * 64 + ks * 32 + qq * 8];
#pragma unroll
                for (int nt = 0; nt < 4; nt++) bq[nt] = *(const bf16x8*)&cd[2 * 4096 + (nt * 16 + kr) * 64 + ks * 32 + qq * 8];
#pragma unroll
                for (int mt = 0; mt < 4; mt++)
#pragma unroll
                    for (int nt = 0; nt < 4; nt++) ys[mt][nt] = __builtin_amdgcn_mfma_f32_16x16x32_bf16(af[mt], bq[nt], ys[mt][nt], 0, 0, 0);
            }
        }
#pragma unroll
        for (int nt = 0; nt < 4; nt++) {
            float s1 = 0.f, s2 = 0.f;
#pragma unroll
            for (int mt = 0; mt < 4; mt++)
#pragma unroll
                for (int r = 0; r < 4; r++) { s1 += ys[mt][nt][r]; s2 += ys[mt][nt][r] * ys[mt][nt][r]; }
            s1 = xrow_sum(s1); s2 = xrow_sum(s2);
            const float mean = s1 * (1.f / 64.f);
            const float var = fmaxf(s2 * (1.f / 64.f) - mean * mean, 0.f);
            const float rstd = rsqrtf(var + 64e-5f);
            const int t = nt * 16 + kr;
            const size_t n = (size_t)b * S_ + c * 64 + t;
            const float bon = p.bon[n * 8 + h];
#pragma unroll
            for (int mt = 0; mt < 4; mt++) {
                const int vch = h * 64 + mt * 16 + qq * 4;
                const f32x4 vcf = unpack4(*(const uint2*)&p.prw[n * CRW + 1024 + vch]);
                const f32x4 vpf = (c * 64 + t > 0) ? unpack4(*(const uint2*)&p.prw[(n - 1) * CRW + 1024 + vch]) : f32x4{0.f, 0.f, 0.f, 0.f};
                const f32x4 ggf = unpack4(*(const uint2*)&p.ob[n * 512 + vch]);
                const float4 lw = *(const float4*)&p.ln_w[vch], lb = *(const float4*)&p.ln_b[vch], mv = *(const float4*)&p.mu[1024 + vch];
                const float lwa[4] = {lw.x, lw.y, lw.z, lw.w}, lba[4] = {lb.x, lb.y, lb.z, lb.w}, mva[4] = {mv.x, mv.y, mv.z, mv.w};
                f32x4 o;
#pragma unroll
                for (int r = 0; r < 4; r++) {
                    const float vsh = vcf[r] + (vpf[r] - vcf[r]) * mva[r];
                    o[r] = ((ys[mt][nt][r] - mean) * rstd * lwa[r] + lba[r] + bon * vsh) * ggf[r];
                }
                *(uint2*)&p.ob[n * 512 + vch] = pack4(o);
            }
        }
    }
}

__device__ __forceinline__ void unpack8(const uint4& u, f32x4& a, f32x4& b) {
    a = f32x4{__uint_as_float(u.x << 16), __uint_as_float(u.x & 0xFFFF0000u), __uint_as_float(u.y << 16), __uint_as_float(u.y & 0xFFFF0000u)};
    b = f32x4{__uint_as_float(u.z << 16), __uint_as_float(u.z & 0xFFFF0000u), __uint_as_float(u.w << 16), __uint_as_float(u.w & 0xFFFF0000u)};
}
struct EpiMerge {
    u16* merged; u16* tmp2; int pass;
    __device__ __forceinline__ void operator()(const f32x4 (&acc)[2][2][4][2], const GUnit& u, int, int, int, int) const {
        const int t2_ = get_tid(), wid_ = __builtin_amdgcn_readfirstlane(t2_ >> 6), wr = wid_ >> 2, wc = wid_ & 3, fr = t2_ & 15, fq = (t2_ >> 4) & 3;
        const int row0 = u.pm * 256 + wr * 64 + fr;
        if (pass < 2) {
            u16* dst = pass ? tmp2 : merged;
            const int col0 = u.pn * 256 + wc * 32 + 8 * fq;
#pragma unroll
            for (int ai = 0; ai < 2; ++ai)
#pragma unroll
                for (int m = 0; m < 4; ++m) {
                    const size_t off = (size_t)(row0 + ai * 128 + m * 16) * D_ + col0;
#pragma unroll
                    for (int bj = 0; bj < 2; ++bj) *(uint4*)&dst[off + bj * 128] = pack8(acc[ai][bj][m][0], acc[ai][bj][m][1]);
                }
        } else {
            const int col0 = u.pn * 128 + wc * 32 + 8 * fq;
#pragma unroll
            for (int ai = 0; ai < 2; ++ai)
#pragma unroll
                for (int m = 0; m < 4; ++m) {
                    const size_t off = (size_t)(row0 + ai * 128 + m * 16) * D_ + col0;
                    const uint4 ma = *(const uint4*)&merged[off], mb = *(const uint4*)&tmp2[off];
                    f32x4 a0, a1, b0, b1; unpack8(ma, a0, a1); unpack8(mb, b0, b1);
                    f32x4 v0, v1;
#pragma unroll
                    for (int r = 0; r < 4; r++) {
                        v0[r] = a0[r] * sigmoidf_(acc[ai][0][m][0][r]) + b0[r] * sigmoidf_(acc[ai][1][m][0][r]);
                        v1[r] = a1[r] * sigmoidf_(acc[ai][0][m][1][r]) + b1[r] * sigmoidf_(acc[ai][1][m][1][r]);
                    }
                    *(uint4*)&merged[off] = pack8(v0, v1);
                    asm volatile("" ::: "memory");
                }
        }
    }
};
struct MergeSched {
    DenseSched d; bool split;
    __device__ __forceinline__ bool next(int i, GUnit& u) const {
        if (!split) return d.next(i, u);
        if (!d.next(i >> 1, u)) return false;
        u.pn = 2 * u.pn + (i & 1); return true;
    }
    __device__ __forceinline__ unsigned a_off(const GUnit& u, int h, int R) const { return d.a_off(u, h, R); }
    __device__ __forceinline__ const char* b_ptr(const GUnit& u) const { return d.b_ptr(u); }
};
__device__ void ph_merge(const P& p, int bid, int nb, char* smem) {
    u16* tmp2 = (u16*)p.x1;
#pragma unroll 1
    for (int pass = 0; pass < 3; ++pass) {
        const int K = (pass == 2) ? D_ : 512;
        const u16* A = (pass == 2) ? p.hbuf : (pass == 0 ? p.oa : p.ob);
        const u16* Bt = (pass == 0) ? p.wpaT : (pass == 1 ? p.wpbT : p.wgT);
        MergeSched S; S.d.init(NTOK, D_, K, Bt, nb, bid); S.split = (pass == 2);
        EpiMerge E{p.merged, tmp2, pass};
        gemm256(smem, (const char*)A, K, S, E);
    }
}

struct EpiOutproj {
    const float* x; float* x1;
    __device__ __forceinline__ void operator()(const f32x4 (&acc)[2][2][4][2], const GUnit& u, int, int, int, int) const {
        const int t2_ = get_tid(), wid_ = __builtin_amdgcn_readfirstlane(t2_ >> 6), wr = wid_ >> 2, wc = wid_ & 3, fr = t2_ & 15, fq = (t2_ >> 4) & 3;
        const int row0 = u.pm * 256 + wr * 64 + fr, col0 = u.pn * 256 + wc * 32 + 4 * fq;
#pragma unroll
        for (int ai = 0; ai < 2; ++ai)
#pragma unroll
            for (int m = 0; m < 4; ++m) {
                const size_t off = (size_t)(row0 + ai * 128 + m * 16) * D_ + col0;
                f32x4 xin[2][2];
#pragma unroll
                for (int bj = 0; bj < 2; ++bj)
#pragma unroll
                    for (int n = 0; n < 2; ++n) xin[bj][n] = *(const f32x4*)&x[off + bj * 128 + n * 16];
#pragma unroll
                for (int bj = 0; bj < 2; ++bj)
#pragma unroll
                    for (int n = 0; n < 2; ++n) *(f32x4*)&x1[off + bj * 128 + n * 16] = xin[bj][n] + acc[ai][bj][m][n];
                asm volatile("" ::: "memory");
            }
    }
};
__device__ void ph_outproj(const P& p, int bid, int nb, char* smem) {
    DenseSched S; S.init(NTOK, D_, D_, p.woutT, nb, bid);
    EpiOutproj E{p.x, p.x1};
    gemm256(smem, (const char*)p.merged, D_, S, E);
}

__device__ __forceinline__ float red8f(float x) {
    x += dppf<0xB1>(x);
    x += dppf<0x4E>(x);
    x += dppf<0x141>(x);
    return x;
}
__device__ void ph_route(const P& p, int bid, int nb, char* smem) {
    float* wr = (float*)smem;
    const int tid = get_tid(), lane = tid & 63, wv = tid >> 6;
    {
        u16* Tl = (u16*)smem;
        const int t = get_tid();
        const int lrow = t >> 3, lc8 = (t & 7) * 8;
        const int sslot = t >> 3, skc = t & 7;
        const int scol = (sslot & 32) + perm32(sslot & 31);
        constexpr int NT13 = NEXP * 2 * 4 * 16, NT2 = NEXP * 16 * 4;
        for (int tile = bid; tile < NT13 + NT2; tile += nb) {
            const float* src; u16* dst; int N, Kd;
            if (tile < NT13) {
                const int kt = tile & 15, sg = (tile >> 4) & 3, half = (tile >> 6) & 1, e = tile >> 7;
                const int sl0 = sg * 64;
                N = 256; Kd = D_;
                src = ((sl0 >> 7) ? p.e_w3 : p.e_w1) + (size_t)e * D_ * 256 + (size_t)(kt * 64) * 256 + half * 128 + (sl0 & 127);
                dst = p.ew1T + ((size_t)e * 512 + half * 256 + sl0) * D_ + kt * 64;
            } else {
                const int t2 = tile - NT13;
                const int kt = t2 & 3, sg = (t2 >> 2) & 15, e = t2 >> 6;
                N = D_; Kd = 256;
                src = p.e_w2 + (size_t)e * 256 * D_ + (size_t)(kt * 64) * D_ + sg * 64;
                dst = p.ew2T + ((size_t)e * D_ + sg * 64) * 256 + kt * 64;
            }
            const float4 f0 = *(const float4*)&src[(size_t)lrow * N + lc8], f1 = *(const float4*)&src[(size_t)lrow * N + lc8 + 4];
            __syncthreads();
            const unsigned h0 = pack2(f0.x, f0.y), h1 = pack2(f0.z, f0.w), h2 = pack2(f1.x, f1.y), h3 = pack2(f1.z, f1.w);
            Tl[(lc8 + 0) * 72 + lrow] = (u16)(h0 & 0xFFFFu); Tl[(lc8 + 1) * 72 + lrow] = (u16)(h0 >> 16);
            Tl[(lc8 + 2) * 72 + lrow] = (u16)(h1 & 0xFFFFu); Tl[(lc8 + 3) * 72 + lrow] = (u16)(h1 >> 16);
            Tl[(lc8 + 4) * 72 + lrow] = (u16)(h2 & 0xFFFFu); Tl[(lc8 + 5) * 72 + lrow] = (u16)(h2 >> 16);
            Tl[(lc8 + 6) * 72 + lrow] = (u16)(h3 & 0xFFFFu); Tl[(lc8 + 7) * 72 + lrow] = (u16)(h3 >> 16);
            __syncthreads();
            *(uint4*)&dst[(size_t)sslot * Kd + skc * 8] = *(const uint4*)&Tl[scol * 72 + skc * 8];
        }
        __syncthreads();
    }
    for (int i = tid; i < 1024 * 36; i += NT) {
        const int k = i / 36, j = i - k * 36;
        const int kp = (k & ~31) + ((k & 3) << 3) + ((k >> 2) & 7);
        wr[kp * 36 + j] = (j < 4) ? p.w_grp[k * 4 + j] : p.w_exp[k * 32 + (j - 4)];
    }
    int* lcount = (int*)(smem + 1024 * 36 * 4);
    if (tid < 32) lcount[tid] = 0;
    __syncthreads();
    const int sub = lane & 7, tk = lane >> 3;
    for (int n0 = (bid * NW + wv) * 16; n0 < NTOK; n0 += nb * NW * 16) {
        float acc[2][36]; float ss[2] = {0.f, 0.f};
#pragma unroll
        for (int t = 0; t < 2; t++)
#pragma unroll
            for (int j = 0; j < 36; j++) acc[t][j] = 0.f;
#pragma unroll 1
        for (int i0 = 0; i0 < 32; i0 += 4) {
            float4 xv[2][4];
#pragma unroll
            for (int t = 0; t < 2; t++)
#pragma unroll
                for (int i = 0; i < 4; i++) xv[t][i] = *(const float4*)&p.x1[(size_t)(n0 + 8 * t + tk) * D_ + (i0 + i) * 32 + sub * 4];
#pragma unroll
            for (int i = 0; i < 4; i++) {
                const int k0 = (i0 + i) * 32 + sub * 4;
                const float4 gf = *(const float4*)&p.g_ffn[k0];
                float hv[2][4];
#pragma unroll
                for (int t = 0; t < 2; t++) {
                    const float4 x = xv[t][i];
                    ss[t] += x.x * x.x + x.y * x.y + x.z * x.z + x.w * x.w;
                    hv[t][0] = x.x * gf.x; hv[t][1] = x.y * gf.y; hv[t][2] = x.z * gf.z; hv[t][3] = x.w * gf.w;
                    uint2 o; o.x = pack2(hv[t][0], hv[t][1]); o.y = pack2(hv[t][2], hv[t][3]);
                    *(uint2*)&p.hbuf[(size_t)(n0 + 8 * t + tk) * D_ + k0] = o;
                }
#pragma unroll
                for (int e2 = 0; e2 < 4; e2++) {
                    asm volatile("" ::: "memory");
                    const float* wrow = wr + ((i0 + i) * 32 + e2 * 8 + sub) * 36;
#pragma unroll
                    for (int j4 = 0; j4 < 9; j4++) {
                        const float4 wv4 = *(const float4*)&wrow[j4 * 4];
#pragma unroll
                        for (int t = 0; t < 2; t++) {
                            acc[t][j4 * 4 + 0] += hv[t][e2] * wv4.x; acc[t][j4 * 4 + 1] += hv[t][e2] * wv4.y;
                            acc[t][j4 * 4 + 2] += hv[t][e2] * wv4.z; acc[t][j4 * 4 + 3] += hv[t][e2] * wv4.w;
                        }
                    }
                }
            }
        }
#pragma unroll
        for (int t = 0; t < 2; t++) {
            const size_t n = (size_t)n0 + 8 * t + tk;
            const float sst = red8f(ss[t]);
#pragma unroll
            for (int j = 0; j < 36; j++) acc[t][j] = red8f(acc[t][j]);
            const float rs = rsqrtf(sst * (1.f / D_) + 1e-6f);
            if (sub == 0) {
                p.rsb[n] = rs;
                float gl[4]; int gs = 0;
#pragma unroll
                for (int j = 0; j < 4; j++) gl[j] = acc[t][j] * rs + p.b_grp[j];
                float gm = gl[0];
#pragma unroll
                for (int j = 1; j < 4; j++) if (gl[j] > gm) { gm = gl[j]; gs = j; }
                float gsum = 0.f;
#pragma unroll
                for (int j = 0; j < 4; j++) gsum += __expf(gl[j] - gm);
                const float pg = 1.f / gsum;
                float el[8]; float em = -3.0e38f;
#pragma unroll
                for (int j = 0; j < 8; j++) {
                    float a = (gs == 0) ? acc[t][4 + j] : ((gs == 1) ? acc[t][12 + j] : ((gs == 2) ? acc[t][20 + j] : acc[t][28 + j]));
                    a = a * rs + p.b_exp[gs * 8 + j];
                    el[j] = a; em = fmaxf(em, a);
                }
                int j0 = 0, j1 = -1; float v0 = -3.0e38f, v1 = -3.0e38f;
#pragma unroll
                for (int j = 0; j < 8; j++) { el[j] = __expf(el[j] - em); }
#pragma unroll
                for (int j = 0; j < 8; j++) { if (el[j] > v0) { v0 = el[j]; j0 = j; } }
#pragma unroll
                for (int j = 0; j < 8; j++) { if (j != j0 && el[j] > v1) { v1 = el[j]; j1 = j; } }
                const float den = v0 + v1;
                const int e0 = gs * 8 + j0, e1 = gs * 8 + j1;
                p.tok_e[n * 2] = e0; p.tok_e[n * 2 + 1] = e1;
                p.tok_gate[n * 2] = pg * v0 / den; p.tok_gate[n * 2 + 1] = pg * v1 / den;
                atomicAdd(&lcount[e0], 1); atomicAdd(&lcount[e1], 1);
            }
        }
    }
    __syncthreads();
    { const int t2 = get_tid(); if (t2 < 32) { const int c = lcount[t2]; if (c) atomicAdd(&p.counts[t2], c); } }
}

__device__ void ph_scatter(const P& p, int bid, int nb, char* smem) {
    int* offl = (int*)smem;
    int* hist = offl + 64;
    int* gbase = hist + 32;
    const int tid = get_tid();
    if (tid == 0) {
        int off = 0;
        for (int e = 0; e < NEXP; e++) { offl[e] = off; off += p.counts[e]; }
        offl[NEXP] = off;
    }
    if (bid == 0 && tid == 64) {
        int off = 0, nb_ = 0;
        for (int e = 0; e < NEXP; e++) {
            const int c = p.counts[e];
            p.offs[e] = off;
            for (int r = 0; r < c; r += 256) { p.blk_e[nb_] = e; p.blk_r0[nb_] = off + r; nb_++; }
            off += c;
        }
        p.offs[NEXP] = off;
        *p.nblk = nb_;
    }
    for (int base = bid * NT; base < NTOK * 2; base += nb * NT) {
        __syncthreads();
        if (tid < 32) hist[tid] = 0;
        __syncthreads();
        const int i = base + tid;
        const int e = p.tok_e[i];
        const int rl = atomicAdd(&hist[e], 1);
        __syncthreads();
        if (tid < 32) gbase[tid] = atomicAdd(&p.cursor[tid], hist[tid]);
        __syncthreads();
        const int slot = offl[e] + gbase[e] + rl;
        p.list_tok[slot] = i >> 1; p.list_gate[slot] = p.tok_gate[i]; p.tokslot[i] = slot;
    }
}
template <int CTS>
struct MoeSched {
    const P* pp; int nunits, G, c; unsigned rowbytes; const u16* Bt; size_t b_estride, b_tstride;
    bool gather;
    __device__ __forceinline__ bool next(int i, GUnit& u) const {
        const int L = i * G + c; if (L >= nunits) return false;
        int wgid = L; { const int q = nunits >> 3, r = nunits & 7, xcd = wgid & 7, off = wgid >> 3; wgid = (xcd < r ? xcd * (q + 1) : r * (q + 1) + (xcd - r) * q) + off; }
        u.pm = wgid / CTS; u.pn = wgid & (CTS - 1); return true;
    }
    __device__ __forceinline__ unsigned a_off(const GUnit& u, int h, int R) const {
        const P& p = *pp;
        const int e = __builtin_amdgcn_readfirstlane(p.blk_e[u.pm]), rend = __builtin_amdgcn_readfirstlane(p.offs[e + 1]);
        int sl = __builtin_amdgcn_readfirstlane(p.blk_r0[u.pm]) + h * 128 + R; if (sl >= rend) sl = rend - 1;
        return (unsigned)(gather ? p.list_tok[sl] : sl) * rowbytes;
    }
    __device__ __forceinline__ const char* b_ptr(const GUnit& u) const { return (const char*)(Bt + (size_t)__builtin_amdgcn_readfirstlane(pp->blk_e[u.pm]) * b_estride + (size_t)u.pn * b_tstride); }
};
struct EpiMoe1 {
    const P* pp;
    __device__ __forceinline__ void operator()(const f32x4 (&acc)[2][2][4][2], const GUnit& u, int, int, int, int) const {
        const int t2_ = get_tid(), wid_ = __builtin_amdgcn_readfirstlane(t2_ >> 6), wr = wid_ >> 2, wc = wid_ & 3, fr = t2_ & 15, fq = (t2_ >> 4) & 3;
        const P& p = *pp;
        const int e = __builtin_amdgcn_readfirstlane(p.blk_e[u.pm]), r0 = __builtin_amdgcn_readfirstlane(p.blk_r0[u.pm]), rend = __builtin_amdgcn_readfirstlane(p.offs[e + 1]);
#pragma unroll
        for (int ai = 0; ai < 2; ++ai)
#pragma unroll
            for (int m = 0; m < 4; ++m) {
                const int sl = r0 + ai * 128 + wr * 64 + m * 16 + fr;
                if (sl < rend) {
                    const float rs = p.rsb[p.list_tok[sl]];
                    f32x4 v[2];
#pragma unroll
                    for (int n = 0; n < 2; ++n)
#pragma unroll
                        for (int r = 0; r < 4; r++) { const float a = acc[ai][0][m][n][r] * rs; v[n][r] = a * sigmoidf_(a) * (acc[ai][1][m][n][r] * rs); }
                    *(uint4*)&p.hid[(size_t)sl * 256 + u.pn * 128 + wc * 32 + 8 * fq] = pack8(v[0], v[1]);
                }
            }
    }
};
__device__ void ph_moe1(const P& p, int bid, int nb, char* smem) {
    MoeSched<2> S{&p, __builtin_amdgcn_readfirstlane(*p.nblk) * 2, nb, bid, (unsigned)(D_ * 2), p.ew1T, (size_t)512 * D_, (size_t)256 * D_, true};
    EpiMoe1 E{&p};
    gemm256(smem, (const char*)p.hbuf, D_, S, E);
}
struct EpiMoe2 {
    const P* pp;
    __device__ __forceinline__ void operator()(const f32x4 (&acc)[2][2][4][2], const GUnit& u, int, int, int, int) const {
        const int t2_ = get_tid(), wid_ = __builtin_amdgcn_readfirstlane(t2_ >> 6), wr = wid_ >> 2, wc = wid_ & 3, fr = t2_ & 15, fq = (t2_ >> 4) & 3;
        const P& p = *pp;
        const int e = __builtin_amdgcn_readfirstlane(p.blk_e[u.pm]), r0 = __builtin_amdgcn_readfirstlane(p.blk_r0[u.pm]), rend = __builtin_amdgcn_readfirstlane(p.offs[e + 1]);
#pragma unroll
        for (int ai = 0; ai < 2; ++ai)
#pragma unroll
            for (int m = 0; m < 4; ++m) {
                const int sl = r0 + ai * 128 + wr * 64 + m * 16 + fr;
                if (sl < rend) {
                    const float gt = p.list_gate[sl];
                    u16* yp = p.ybuf + (size_t)sl * D_ + u.pn * 256 + wc * 32 + 8 * fq;
#pragma unroll
                    for (int bj = 0; bj < 2; ++bj) *(uint4*)&yp[bj * 128] = pack8(acc[ai][bj][m][0] * gt, acc[ai][bj][m][1] * gt);
                }
            }
    }
};
__device__ void ph_moe2(const P& p, int bid, int nb, char* smem) {
    MoeSched<4> S{&p, __builtin_amdgcn_readfirstlane(*p.nblk) * 4, nb, bid, 512u, p.ew2T, (size_t)D_ * 256, (size_t)256 * 256, false};
    EpiMoe2 E{&p};
    gemm256(smem, (const char*)p.hid, 256, S, E);
}
__device__ void ph_final(const P& p, int bid, int nb, char* smem) {
    const int tid = get_tid(), lane = tid & 63, wv = tid >> 6;
    for (int row = bid * NW + wv; row < NTOK; row += nb * NW) {
        const int s0 = p.tokslot[row * 2], s1 = p.tokslot[row * 2 + 1];
        float v[16]; float ss = 0.f;
#pragma unroll
        for (int i = 0; i < 4; i++) {
            const int c = i * 256 + lane * 4;
            const float4 t = *(const float4*)&p.x1[(size_t)row * D_ + c];
            const uint2 a = *(const uint2*)&p.ybuf[(size_t)s0 * D_ + c];
            const uint2 bq = *(const uint2*)&p.ybuf[(size_t)s1 * D_ + c];
            v[4 * i]     = t.x + __uint_as_float(a.x << 16) + __uint_as_float(bq.x << 16);
            v[4 * i + 1] = t.y + __uint_as_float(a.x & 0xFFFF0000u) + __uint_as_float(bq.x & 0xFFFF0000u);
            v[4 * i + 2] = t.z + __uint_as_float(a.y << 16) + __uint_as_float(bq.y << 16);
            v[4 * i + 3] = t.w + __uint_as_float(a.y & 0xFFFF0000u) + __uint_as_float(bq.y & 0xFFFF0000u);
            ss += v[4 * i] * v[4 * i] + v[4 * i + 1] * v[4 * i + 1] + v[4 * i + 2] * v[4 * i + 2] + v[4 * i + 3] * v[4 * i + 3];
        }
        ss = wave_sum(ss);
        const float rs = rsqrtf(ss * (1.f / D_) + 1e-6f);
#pragma unroll
        for (int i = 0; i < 4; i++) {
            const int c = i * 256 + lane * 4;
            const float4 g = *(const float4*)&p.g_final[c];
            float4 o; o.x = v[4 * i] * rs * g.x; o.y = v[4 * i + 1] * rs * g.y; o.z = v[4 * i + 2] * rs * g.z; o.w = v[4 * i + 3] * rs * g.w;
            *(float4*)&p.out[(size_t)row * D_ + c] = o;
        }
    }
}

#define XB_TMO      128
#define XB_XCNT(j)  (256  + 64 * (j))
#define XB_XSUB(j)  (1280 + 64 * (j))
#define XB_XGEN(j)  (2304 + 64 * (j))
#define XB_TOP      3328
#define XB_TOPGEN   3392
#define XCD_BAR_WORDS 3456
#define XB_SPIN_CAP (1u << 18)
#define LAS __attribute__((address_space(3)))

__device__ __forceinline__ unsigned xb_ld(unsigned* p)              { return __hip_atomic_load(p, __ATOMIC_RELAXED, __HIP_MEMORY_SCOPE_AGENT); }
__device__ __forceinline__ unsigned xb_add(unsigned* p, unsigned v) { return __hip_atomic_fetch_add(p, v, __ATOMIC_RELAXED, __HIP_MEMORY_SCOPE_AGENT); }
__device__ __forceinline__ unsigned xb_xcc_id() { return (unsigned)__builtin_amdgcn_s_getreg((3 << 11) | 20) & 0xFu; }
#define XB_SPIN(cond, bar) do { unsigned _sp = 0; while (cond) { __builtin_amdgcn_s_sleep(1); \
    if ((++_sp & 255u) == 0u) { if (xb_ld(&(bar)[XB_TMO])) break; if (_sp > XB_SPIN_CAP) { atomicAdd(&(bar)[XB_TMO], 1u); break; } } } } while (0)

struct XcdBarrier {
    unsigned* bar; unsigned x;
    volatile LAS unsigned* st;
};

__device__ __forceinline__ XcdBarrier xcd_barrier_post(unsigned* bar, volatile LAS unsigned* st) {
    XcdBarrier b; b.bar = bar; b.x = xb_xcc_id(); b.st = st;
    if (threadIdx.x == 0) (void)xb_add(&bar[XB_XCNT(b.x)], 1u);
    return b;
}
__device__ __forceinline__ void xcd_barrier_complete(unsigned* bar, unsigned x, unsigned& nloc, unsigned& nx) {
    const unsigned G = gridDim.x * gridDim.y * gridDim.z;
    unsigned sum, cnt, mine, sp = 0u;
    for (;;) {
        sum = 0u; cnt = 0u; mine = 0u;
#pragma unroll
        for (unsigned j = 0; j < 16; ++j) { const unsigned c = xb_ld(&bar[XB_XCNT(j)]); sum += c; cnt += (c > 0u) ? 1u : 0u; mine = (j == x) ? c : mine; }
        if (sum == G) break;
        __builtin_amdgcn_s_sleep(1);
        if ((++sp & 255u) == 0u) { if (xb_ld(&bar[XB_TMO])) break; if (sp > XB_SPIN_CAP) { atomicAdd(&bar[XB_TMO], 1u); break; } }
    }
    nloc = mine > 0u ? mine : 1u; nx = cnt > 0u ? cnt : 1u;
}

__device__ __forceinline__ void xcd_barrier(const XcdBarrier& b) {
    asm volatile("s_waitcnt vmcnt(0)" ::: "memory");
    __syncthreads();
    if (threadIdx.x == 0) {
        unsigned* bar = b.bar;
        __builtin_amdgcn_s_waitcnt(0);
        unsigned nloc = b.st[0], nx = b.st[1];
        if (nloc == 0u) { xcd_barrier_complete(bar, b.x, nloc, nx); b.st[0] = nloc; b.st[1] = nx; }
        const unsigned old = xb_add(&bar[XB_XSUB(b.x)], 1u);
        const unsigned gen = old / nloc;
        if (old + 1u == (gen + 1u) * nloc) {
            __builtin_amdgcn_fence(__ATOMIC_RELEASE, "agent");
            asm volatile("s_waitcnt vmcnt(0)" ::: "memory");
            const unsigned og = xb_add(&bar[XB_TOP], 1u);
            const unsigned tg = og / nx;
            if (og + 1u == (tg + 1u) * nx) xb_add(&bar[XB_TOPGEN], 1u);
            else XB_SPIN(xb_ld(&bar[XB_TOPGEN]) == tg, bar);
            __builtin_amdgcn_fence(__ATOMIC_ACQUIRE, "agent");
            xb_add(&bar[XB_XGEN(b.x)], 1u);
            asm volatile("s_waitcnt vmcnt(0)" ::: "memory");
        } else {
            XB_SPIN(xb_ld(&bar[XB_XGEN(b.x)]) == gen, bar);
            __builtin_amdgcn_fence(__ATOMIC_ACQUIRE, "agent");
            asm volatile("s_waitcnt vmcnt(0)" ::: "memory");
        }
    }
    __syncthreads();
}

template <int PH>
__device__ __forceinline__ void run_phase(const P& p, int bid, int nb, char* smem) {
    if constexpr (PH == 0) ph_prologue(p, bid, nb, smem);
    if constexpr (PH == 1) ph_inproj(p, bid, nb, smem);
    if constexpr (PH == 2) { ph_compress(p, bid, nb, smem); __syncthreads(); ph_rwkv_chunk(p, bid, nb, smem); }
    if constexpr (PH == 3) {
        if (bid < SCAN_BLOCKS) ph_rwkv_seq(p, bid, SCAN_BLOCKS, smem);
        ph_nsa(p, bid - SCAN_BLOCKS, nb - SCAN_BLOCKS, smem);
    }
    if constexpr (PH == 12) ph_rwkv_out(p, bid, nb, smem);
    if constexpr (PH == 4) ph_merge(p, bid, nb, smem);
    if constexpr (PH == 5) ph_outproj(p, bid, nb, smem);
    if constexpr (PH == 6) ph_route(p, bid, nb, smem);
    if constexpr (PH == 7) ph_scatter(p, bid, nb, smem);
    if constexpr (PH == 9) ph_moe1(p, bid, nb, smem);
    if constexpr (PH == 10) ph_moe2(p, bid, nb, smem);
    if constexpr (PH == 11) ph_final(p, bid, nb, smem);
}

template <int PH>
__global__ void __launch_bounds__(NT) kph(P p) {
    extern __shared__ __attribute__((aligned(16))) char smem[];
    run_phase<PH>(p, blockIdx.x, gridDim.x, smem);
}

__global__ void __launch_bounds__(NT, 2) mega(P p) {
    extern __shared__ __attribute__((aligned(16))) char smem[];
    volatile LAS unsigned* st = (volatile LAS unsigned*)(smem + SMEM_BYTES - 16);
    if (threadIdx.x == 0) { st[0] = 0u; st[1] = 0u; st[2] = 0u; st[3] = 0u; }
    __syncthreads();
    XcdBarrier bar = xcd_barrier_post(p.bar, st);
    const int bid = blockIdx.x, nb = gridDim.x;
#define RUNP(N, BAR) { unsigned long long t0_ = 0; if ((TPROBE >> N) & 1) t0_ = __builtin_amdgcn_s_memrealtime(); run_phase<N>(p, bid, nb, smem); \
        unsigned long long tw_ = 0; if (((TPROBE >> N) & 1) && TPSEL) tw_ = __builtin_amdgcn_s_memrealtime() - t0_; if (BAR) xcd_barrier(bar); \
        if ((TPROBE >> N) & 1) { const unsigned long long t1_ = __builtin_amdgcn_s_memrealtime(); const unsigned long long dt_ = TPSEL ? tw_ : t1_ - t0_; \
            if (!TPSEL || (TPSEL == 1 ? (bid < SCAN_BLOCKS) : (bid >= SCAN_BLOCKS))) while (__builtin_amdgcn_s_memrealtime() - t1_ < dt_) __builtin_amdgcn_s_sleep(8); if (TPSEL) xcd_barrier(bar); } }
    RUNP(0, 1) RUNP(1, 1) RUNP(2, 1) RUNP(3, 1) RUNP(12, 1) RUNP(4, 1) RUNP(5, 1) RUNP(6, 1) RUNP(7, 1) RUNP(9, 1) RUNP(10, 1) RUNP(11, 0)
}

extern "C" void kernel_launch(void* const* d_in, const int* in_sizes, int n_in,
                              void* d_out, int out_size, void* d_ws, size_t ws_size,
                              hipStream_t stream) {
    P p{};
    p.x = (const float*)d_in[0]; p.pos = (const int*)d_in[1]; p.g_mix = (const float*)d_in[2]; p.w_in = (const float*)d_in[3];
    p.pe_k = (const float*)d_in[4]; p.w1_k = (const float*)d_in[5]; p.b1_k = (const float*)d_in[6]; p.w2_k = (const float*)d_in[7]; p.b2_k = (const float*)d_in[8];
    p.pe_v = (const float*)d_in[9]; p.w1_v = (const float*)d_in[10]; p.b1_v = (const float*)d_in[11]; p.w2_v = (const float*)d_in[12]; p.b2_v = (const float*)d_in[13];
    p.mu = (const float*)d_in[14]; p.w0 = (const float*)d_in[15]; p.w2 = (const float*)d_in[16]; p.a0 = (const float*)d_in[17]; p.a2 = (const float*)d_in[18];
    p.g2 = (const float*)d_in[19]; p.k_k = (const float*)d_in[20]; p.k_a = (const float*)d_in[21]; p.r_k = (const float*)d_in[22]; p.ln_w = (const float*)d_in[23]; p.ln_b = (const float*)d_in[24];
    p.wpa = (const float*)d_in[25]; p.wpb = (const float*)d_in[26]; p.wout = (const float*)d_in[27]; p.g_ffn = (const float*)d_in[28];
    p.w_grp = (const float*)d_in[29]; p.b_grp = (const float*)d_in[30]; p.w_exp = (const float*)d_in[31]; p.b_exp = (const float*)d_in[32];
    p.e_w1 = (const float*)d_in[33]; p.e_w3 = (const float*)d_in[34]; p.e_w2 = (const float*)d_in[35]; p.g_final = (const float*)d_in[36];
    p.out = (float*)d_out;
    char* ws = (char*)d_ws;
    const size_t MiB = 1ull << 20;
    p.hbuf = (u16*)(ws + 0 * MiB);
    p.q    = (u16*)(ws + 64 * MiB);
    p.kc   = (u16*)(ws + 96 * MiB);  p.vc   = (u16*)(ws + 104 * MiB);
    p.ksl  = (u16*)(ws + 112 * MiB); p.vslT = (u16*)(ws + 120 * MiB);
    p.kwn  = (u16*)(ws + 128 * MiB); p.vwnT = (u16*)(ws + 136 * MiB);
    p.nsag = (float*)(ws + 144 * MiB);
    p.kcb  = (u16*)(ws + 148 * MiB); p.vcT  = (u16*)(ws + 149 * MiB);
    p.prw  = (u16*)(ws + 160 * MiB);
    p.cdat = (u16*)(ws + 272 * MiB);
    p.bon  = (float*)(ws + 150 * MiB);
    p.w2T  = (u16*)(ws + 151 * MiB); p.a2T = p.w2T + 512 * 64; p.g2T = p.a2T + 512 * 64;
    p.cw1Tk = (u16*)(ws + 152 * MiB); p.cw1Tv = (u16*)(ws + 153 * MiB);
    p.cw2Tk = (u16*)(ws + 154 * MiB); p.cw2Tv = p.cw2Tk + 128 * 256;
    p.chid = (u16*)(ws + 155 * MiB);
    p.xact = (u16*)(ws + 488 * MiB);
    p.oa   = (u16*)(ws + 400 * MiB);
    p.ob   = (u16*)(ws + 432 * MiB);
    p.merged = (u16*)(ws + 64 * MiB);
    p.x1   = (float*)(ws + 160 * MiB);
    char* rt = ws + 288 * MiB;
    p.tok_e = (int*)(rt);                        rt += NTOK * 2 * 4;
    p.tok_gate = (float*)(rt);                   rt += NTOK * 2 * 4;
    p.tokslot = (int*)(rt);                      rt += NTOK * 2 * 4;
    p.list_tok = (int*)(rt);                     rt += NTOK * 2 * 4;
    p.list_gate = (float*)(rt);                  rt += NTOK * 2 * 4;
    p.blk_e = (int*)(rt);                        rt += 2048 * 4;
    p.blk_r0 = (int*)(rt);                       rt += 2048 * 4;
    p.rsb = (float*)(rt);                        rt += NTOK * 4;
    p.hid  = (u16*)(ws + 296 * MiB);
    p.ybuf = (u16*)(ws + 336 * MiB);
    char* misc = ws + 470 * MiB;
    p.counts = (int*)(misc); p.cursor = (int*)(misc + 256); p.offs = (int*)(misc + 512); p.nblk = (int*)(misc + 1024); p.nsactr = (int*)(misc + 2048);
    p.bar = (unsigned*)(ws + 471 * MiB);
    p.cb1k = (float*)(misc + 65536); p.cb1v = p.cb1k + 256;
    {
        char* wa = ws + 472 * MiB;
        p.winT = (u16*)wa;  wa += (size_t)3328 * 1024 * 2;
        p.wgT  = (u16*)wa;  wa += (size_t)2048 * 1024 * 2;
        p.wpaT = (u16*)wa;  wa += (size_t)1024 * 512 * 2;
        p.wpbT = (u16*)wa;  wa += (size_t)1024 * 512 * 2;
        p.woutT = (u16*)wa; wa += (size_t)1024 * 1024 * 2;
        p.ew1T = (u16*)(ws + 64 * MiB);  p.ew3T = (u16*)(ws + 80 * MiB);  p.ew2T = (u16*)(ws + 96 * MiB);
    }
    if (ws_size < (size_t)505 * MiB) return;

#if MEGA
    {
        static int mgrid = 0;
        if (mgrid == 0) {
            int dev = 0, cus = 0, per_cu = 0;
            hipGetDevice(&dev);
            hipDeviceGetAttribute(&cus, hipDeviceAttributeMultiprocessorCount, dev);
            hipFuncSetAttribute((const void*)mega, hipFuncAttributeMaxDynamicSharedMemorySize, SMEM_BYTES);
            hipOccupancyMaxActiveBlocksPerMultiprocessor(&per_cu, (const void*)mega, NT, SMEM_BYTES);
            (void)hipGetLastError();
            mgrid = cus;
        }
        hipMemsetAsync(p.bar, 0, XCD_BAR_WORDS * sizeof(unsigned) + 512 * sizeof(float), stream);
        mega<<<mgrid, NT, SMEM_BYTES, stream>>>(p);
        return;
    }
#else
    const int grid = 512;
    hipMemsetAsync(p.bar, 0, XCD_BAR_WORDS * sizeof(unsigned) + 512 * sizeof(float), stream);
    hipFuncSetAttribute((const void*)kph<0>, hipFuncAttributeMaxDynamicSharedMemorySize, SMEM_BYTES);
    hipFuncSetAttribute((const void*)kph<1>, hipFuncAttributeMaxDynamicSharedMemorySize, SMEM_BYTES);
    hipFuncSetAttribute((const void*)kph<2>, hipFuncAttributeMaxDynamicSharedMemorySize, SMEM_BYTES);
    hipFuncSetAttribute((const void*)kph<3>, hipFuncAttributeMaxDynamicSharedMemorySize, SMEM_BYTES);
    hipFuncSetAttribute((const void*)kph<4>, hipFuncAttributeMaxDynamicSharedMemorySize, SMEM_BYTES);
    hipFuncSetAttribute((const void*)kph<5>, hipFuncAttributeMaxDynamicSharedMemorySize, SMEM_BYTES);
    hipFuncSetAttribute((const void*)kph<6>, hipFuncAttributeMaxDynamicSharedMemorySize, SMEM_BYTES);
    hipFuncSetAttribute((const void*)kph<7>, hipFuncAttributeMaxDynamicSharedMemorySize, SMEM_BYTES);
    hipFuncSetAttribute((const void*)kph<8>, hipFuncAttributeMaxDynamicSharedMemorySize, SMEM_BYTES);
    hipFuncSetAttribute((const void*)kph<9>, hipFuncAttributeMaxDynamicSharedMemorySize, SMEM_BYTES);
    hipFuncSetAttribute((const void*)kph<10>, hipFuncAttributeMaxDynamicSharedMemorySize, SMEM_BYTES);
    hipFuncSetAttribute((const void*)kph<11>, hipFuncAttributeMaxDynamicSharedMemorySize, SMEM_BYTES);
    kph<0><<<grid, NT, SMEM_BYTES, stream>>>(p);
    kph<1><<<grid, NT, SMEM_BYTES, stream>>>(p);
    kph<2><<<grid, NT, SMEM_BYTES, stream>>>(p);
    kph<3><<<grid, NT, SMEM_BYTES, stream>>>(p);
    kph<12><<<grid, NT, SMEM_BYTES, stream>>>(p);
    kph<4><<<grid, NT, SMEM_BYTES, stream>>>(p);
    kph<5><<<grid, NT, SMEM_BYTES, stream>>>(p);
    kph<6><<<grid, NT, SMEM_BYTES, stream>>>(p);
    kph<7><<<grid, NT, SMEM_BYTES, stream>>>(p);
    kph<8><<<grid, NT, SMEM_BYTES, stream>>>(p);
    kph<9><<<grid, NT, SMEM_BYTES, stream>>>(p);
    kph<10><<<grid, NT, SMEM_BYTES, stream>>>(p);
    kph<11><<<grid, NT, SMEM_BYTES, stream>>>(p);
#endif
}
```

```cpp
#include <hip/hip_runtime.h>
#include <stdint.h>

typedef unsigned short u16;
using bf16x8 = __attribute__((ext_vector_type(8))) short;
using f32x4  = __attribute__((ext_vector_type(4))) float;

#ifndef MEGA
#define MEGA 1
#endif

constexpr int B_ = 4, S_ = 8192, D_ = 1024, NTOK = B_ * S_;
constexpr int CIN = 5144;
constexpr int NCMP = 511;
constexpr int CRW = 1792;
constexpr int NEXP = 32;
constexpr int NT = 512;
constexpr int NW = NT / 64;
constexpr int SMEM_BYTES = 160 * 1024;
constexpr int SCAN_BLOCKS = 16;
#ifndef TPROBE
#define TPROBE 0
#define TPSEL 0
#endif
constexpr float QSCALE = 0.125f * 1.4426950408889634f;

struct P {
    const float* x; const int* pos; const float* g_mix; const float* w_in;
    const float *pe_k, *w1_k, *b1_k, *w2_k, *b2_k, *pe_v, *w1_v, *b1_v, *w2_v, *b2_v;
    const float *mu, *w0, *w2, *a0, *a2, *g2, *k_k, *k_a, *r_k, *ln_w, *ln_b;
    const float *wpa, *wpb, *wout, *g_ffn, *w_grp, *b_grp, *w_exp, *b_exp, *e_w1, *e_w3, *e_w2, *g_final;
    float* out;
    u16* hbuf; u16 *q, *kc, *vc, *ksl, *vslT, *kwn, *vwnT, *kcb, *vcT; float* nsag; u16* prw;
    u16* cdat; float* bon; u16 *w2T, *a2T, *g2T; u16 *oa, *ob; u16* merged; float* x1;
    int* tok_e; float* tok_gate; int* tokslot; int* list_tok; float* list_gate;
    int* counts; int* offs; int* cursor; int* blk_e; int* blk_r0; int* nblk; float* rsb; int* nsactr;
    u16* hid; u16* ybuf; unsigned* bar;
    u16 *winT, *wgT, *wpaT, *wpbT, *woutT, *ew1T, *ew3T, *ew2T;
    u16 *cw1Tk, *cw1Tv, *cw2Tk, *cw2Tv, *chid, *xact; float *cb1k, *cb1v;
};

typedef __bf16 bf16x2_t __attribute__((ext_vector_type(2)));
typedef float f32x2_t __attribute__((ext_vector_type(2)));
__device__ __forceinline__ unsigned pack2(float a, float b) {
    f32x2_t f = {a, b};
    return __builtin_bit_cast(unsigned, __builtin_convertvector(f, bf16x2_t));
}
__device__ __forceinline__ u16 f2bf(float f) { return (u16)(pack2(f, f) & 0xFFFFu); }
__device__ __forceinline__ float bf2f(u16 h) { return __uint_as_float(((unsigned)h) << 16); }
__device__ __forceinline__ float sigmoidf_(float x) { return __builtin_amdgcn_rcpf(1.f + __expf(-x)); }
__device__ __forceinline__ int get_tid() { int t = threadIdx.x; asm volatile("" : "+v"(t)); return t; }
__device__ __forceinline__ uint2 pack4(const f32x4& v) { uint2 o; o.x = pack2(v[0], v[1]); o.y = pack2(v[2], v[3]); return o; }
__device__ __forceinline__ f32x4 unpack4(uint2 u) { return f32x4{__uint_as_float(u.x << 16), __uint_as_float(u.x & 0xFFFF0000u), __uint_as_float(u.y << 16), __uint_as_float(u.y & 0xFFFF0000u)}; }
#define LDS_BARRIER() do { asm volatile("s_waitcnt lgkmcnt(0)" ::: "memory"); __builtin_amdgcn_s_barrier(); asm volatile("" ::: "memory"); } while (0)
__device__ __forceinline__ int opaque(int x) { asm volatile("" : "+v"(x)); return x; }
template <int CTRL>
__device__ __forceinline__ float dppf(float x) { return __int_as_float(__builtin_amdgcn_update_dpp(0, __float_as_int(x), CTRL, 0xF, 0xF, true)); }
__device__ __forceinline__ float wave_sum(float v) {
    v += dppf<0xB1>(v);
    v += dppf<0x4E>(v);
    v += dppf<0x141>(v);
    v += dppf<0x140>(v);
    const int vi = __float_as_int(v);
    return (__int_as_float(__builtin_amdgcn_readlane(vi, 0)) + __int_as_float(__builtin_amdgcn_readlane(vi, 16)))
         + (__int_as_float(__builtin_amdgcn_readlane(vi, 32)) + __int_as_float(__builtin_amdgcn_readlane(vi, 48)));
}

__device__ __forceinline__ float xrow_sum(float v) {
    auto r = __builtin_amdgcn_permlane16_swap(__float_as_uint(v), __float_as_uint(v), false, false);
    v = __uint_as_float(r[0]) + __uint_as_float(r[1]);
    auto r2 = __builtin_amdgcn_permlane32_swap(__float_as_uint(v), __float_as_uint(v), false, false);
    return __uint_as_float(r2[0]) + __uint_as_float(r2[1]);
}
__device__ __forceinline__ float xrow_max(float v) {
    auto r = __builtin_amdgcn_permlane16_swap(__float_as_uint(v), __float_as_uint(v), false, false);
    v = fmaxf(__uint_as_float(r[0]), __uint_as_float(r[1]));
    auto r2 = __builtin_amdgcn_permlane32_swap(__float_as_uint(v), __float_as_uint(v), false, false);
    return fmaxf(__uint_as_float(r2[0]), __uint_as_float(r2[1]));
}
__constant__ double ROPE_FREQ[32] = {
    1.00000000000000000000e+00, 7.49894209332455874417e-01, 5.62341325190349072827e-01, 4.21696503428582225581e-01,
    3.16227766016837941176e-01, 2.37137370566165517349e-01, 1.77827941003892292526e-01, 1.33352143216332402753e-01,
    1.00000000000000005551e-01, 7.49894209332455791150e-02, 5.62341325190349114460e-02, 4.21696503428582239459e-02,
    3.16227766016837913421e-02, 2.37137370566165538166e-02, 1.77827941003892292526e-02, 1.33352143216332406223e-02,
    1.00000000000000002082e-02, 7.49894209332455791150e-03, 5.62341325190349097113e-03, 4.21696503428582291501e-03,
    3.16227766016837939442e-03, 2.37137370566165538166e-03, 1.77827941003892275179e-03, 1.33352143216332406223e-03,
    1.00000000000000002082e-03, 7.49894209332455856203e-04, 5.62341325190349097113e-04, 4.21696503428582237290e-04,
    3.16227766016837939442e-04, 2.37137370566165538166e-04, 1.77827941003892269758e-04, 1.33352143216332395381e-04};

constexpr int G_ABYTES = 256 * 64 * 2, G_BBYTES = 128 * 64 * 2, G_TILE = G_ABYTES + G_BBYTES;
#define LAS3 __attribute__((address_space(3)))
#define GAS1 __attribute__((address_space(1)))
__device__ __forceinline__ void glds16(const u16* g, char* l) {
    __builtin_amdgcn_global_load_lds((const GAS1 unsigned*)g, (LAS3 unsigned*)l, 16, 0, 0);
}
template <bool TR = false, class ARow>
__device__ __forceinline__ void gemm_core(int K, ARow arow, const u16* __restrict__ BT, int ldb, f32x4 (&acc)[4][4], u16* sm) {
    char* base = (char*)sm;
    const int tid = get_tid(), lane = tid & 63, wv = tid >> 6;
    const int wm = wv >> 1, wn = wv & 1, kr = lane & 15, qq = lane >> 4;
    const int lr = tid >> 3, lk = ((tid & 7) ^ ((lr >> 1) & 7)) * 8;
    const u16* ap0 = arow(lr) + lk; const u16* ap1 = arow(lr + 64) + lk;
    const u16* ap2 = arow(lr + 128) + lk; const u16* ap3 = arow(lr + 192) + lk;
    const u16* bp0 = BT + (size_t)lr * ldb + lk; const u16* bp1 = BT + (size_t)(lr + 64) * ldb + lk;
#pragma unroll
    for (int mt = 0; mt < 4; mt++)
#pragma unroll
        for (int nt = 0; nt < 4; nt++) acc[mt][nt] = f32x4{0.f, 0.f, 0.f, 0.f};
    const int nk = K >> 6;
#define G_ISSUE(t, b) { char* d = base + (b) * G_TILE + tid * 16; const int ko = (t) * 64; \
        glds16(ap0 + ko, d); glds16(ap1 + ko, d + 8192); glds16(ap2 + ko, d + 16384); glds16(ap3 + ko, d + 24576); \
        glds16(bp0 + ko, d + G_ABYTES); glds16(bp1 + ko, d + G_ABYTES + 8192); }
    const int sw = kr >> 1;
    const int po0 = ((0 * 4 + qq) ^ sw) * 16, po1 = ((1 * 4 + qq) ^ sw) * 16;
    const int aoff = (wm * 64 + kr) * 128, boff = G_ABYTES + (wn * 64 + kr) * 128;
#define G_READ(FA, FB, b) { const char* Ab = base + (b) * G_TILE + aoff; const char* Bb = base + (b) * G_TILE + boff; \
        _Pragma("unroll") for (int mt = 0; mt < 4; mt++) { FA[0][mt] = *(const bf16x8*)(Ab + mt * 2048 + po0); FA[1][mt] = *(const bf16x8*)(Ab + mt * 2048 + po1); } \
        _Pragma("unroll") for (int nt = 0; nt < 4; nt++) { FB[0][nt] = *(const bf16x8*)(Bb + nt * 2048 + po0); FB[1][nt] = *(const bf16x8*)(Bb + nt * 2048 + po1); } }
#define G_MMA(FA, FB) { __builtin_amdgcn_s_setprio(1); \
        _Pragma("unroll") for (int ks = 0; ks < 2; ks++) \
            _Pragma("unroll") for (int nt = 0; nt < 4; nt++) \
                _Pragma("unroll") for (int mt = 0; mt < 4; mt++) \
                    acc[mt][nt] = TR ? __builtin_amdgcn_mfma_f32_16x16x32_bf16(FA[ks][mt], FB[ks][nt], acc[mt][nt], 0, 0, 0) \
                                     : __builtin_amdgcn_mfma_f32_16x16x32_bf16(FB[ks][nt], FA[ks][mt], acc[mt][nt], 0, 0, 0); \
        __builtin_amdgcn_s_setprio(0); }
    bf16x8 fa0[2][4], fb0[2][4], fa1[2][4], fb1[2][4];
    G_ISSUE(0, 0)
    if (nk > 1) G_ISSUE(1, 1)
    if (nk > 2) G_ISSUE(2, 2)
    if (nk > 2) asm volatile("s_waitcnt vmcnt(12)" ::: "memory");
    else if (nk > 1) asm volatile("s_waitcnt vmcnt(6)" ::: "memory");
    else asm volatile("s_waitcnt vmcnt(0)" ::: "memory");
    __builtin_amdgcn_s_barrier();
    G_READ(fa0, fb0, 0)
    int bnext = 1, bfree = 0;
#define G_STEP(FAC, FBC, FAN, FBN, kt) { \
        if ((kt) + 1 < nk) { \
            if ((kt) + 2 < nk) asm volatile("s_waitcnt vmcnt(6) lgkmcnt(0)" ::: "memory"); else asm volatile("s_waitcnt vmcnt(0) lgkmcnt(0)" ::: "memory"); \
            __builtin_amdgcn_s_barrier();                   \
            if ((kt) + 3 < nk) G_ISSUE((kt) + 3, bfree) \
            G_READ(FAN, FBN, bnext) \
        } \
        G_MMA(FAC, FBC) \
        bfree = bnext; bnext = (bnext == 2) ? 0 : bnext + 1; }
    for (int kt = 0; kt < nk; kt += 2) {
        G_STEP(fa0, fb0, fa1, fb1, kt)
        G_STEP(fa1, fb1, fa0, fb0, kt + 1)
    }
    __builtin_amdgcn_s_barrier();
#undef G_READ
#undef G_MMA
#undef G_STEP
#undef G_ISSUE
}

__device__ __forceinline__ int xcd_item(int bid, int nb, int k, int nitems) {
    if (nb & 7) return bid + k * nb;
    const int per = nb >> 3, chunk = (nitems + 7) >> 3;
    const int j = k * per + (bid >> 3);
    return (j < chunk) ? (bid & 7) * chunk + j : nitems;
}
struct GUnit { int pm, pn; };
constexpr int G8_HTB = 128 * 64 * 2;
__device__ __forceinline__ int g8_lds_byte(int r, int c) { const int st = (r >> 4) * 2 + (c >> 5), rr = r & 15, cc = c & 31, ob = rr * 64 + cc * 2; return st * 1024 + (ob ^ (((ob >> 9) & 1) << 5)); }
__device__ __forceinline__ void g8_stage_rc(int b, int& R, int& C) { const int st = b / 1024, sb = b % 1024, swz = sb ^ (((sb >> 9) & 1) << 5); R = (st >> 1) * 16 + swz / 64; C = (st & 1) * 32 + (swz % 64) / 2; }
__host__ __device__ __forceinline__ int perm32(int rho) { const int n = rho >> 4, i = rho & 15; return 8 * (i >> 2) + 4 * n + (i & 3); }

template <class Epi, class Sched>
__device__ __forceinline__ void gemm256(char* smem, const char* Ab, int K, const Sched& S, const Epi& E) {
    LAS3 unsigned char* lds = (LAS3 unsigned char*)smem;
    const int tid = get_tid(), wid = __builtin_amdgcn_readfirstlane(tid >> 6), lane = tid & 63, wr = wid >> 2, wc = wid & 3, fr = lane & 15, fq = lane >> 4;
    int nt = K >> 6; asm volatile("" : "+s"(nt));
    unsigned voffB[2], voffA[2][2];
#pragma unroll
    for (int i = 0; i < 2; ++i) { int sR, sC; g8_stage_rc(tid * 16 + i * 8192, sR, sC); voffB[i] = (unsigned)(sR * K + sC) * 2u; }
#define G8_AOFFS(un) do { const int t3_ = get_tid(); _Pragma("unroll") for (int i = 0; i < 2; ++i) { int sR, sC; g8_stage_rc(t3_ * 16 + i * 8192, sR, sC); \
        _Pragma("unroll") for (int h = 0; h < 2; ++h) voffA[h][i] = S.a_off(un, h, sR) + (unsigned)sC * 2u; } } while (0)
    const size_t kstep = 128;
    const size_t hstep = (size_t)128 * K * 2;
    const unsigned ldsw = (unsigned)wid * 1024u;
    const int aoff = g8_lds_byte(wr * 64 + fr, fq * 8), boff = g8_lds_byte(wc * 32 + fr, fq * 8);
#define G8_SA(b, h) (((b) * 2 + (h)) * G8_HTB)
#define G8_SB(b, h) ((4 + (b) * 2 + (h)) * G8_HTB)
#define G8_STAGE2(bufoff, gbase, v0, v1) do { \
        __builtin_amdgcn_global_load_lds((const GAS1 unsigned*)((const char*)(gbase) + (v0)), (LAS3 unsigned*)(lds + (bufoff) + ldsw), 16, 0, 0); \
        __builtin_amdgcn_global_load_lds((const GAS1 unsigned*)((const char*)(gbase) + (v1)), (LAS3 unsigned*)(lds + (bufoff) + ldsw + 8192), 16, 0, 0); } while (0)
#define G8_STAGEB(bufoff, gbase) G8_STAGE2(bufoff, gbase, voffB[0], voffB[1])
#define G8_LDA(dst, b, h) do { _Pragma("unroll") for (int m = 0; m < 4; ++m) _Pragma("unroll") for (int k = 0; k < 2; ++k) dst[m][k] = *(const LAS3 bf16x8*)(lds + G8_SA(b, h) + aoff + m * 2048 + k * 1024); } while (0)
#define G8_LDB(dst, b, h) do { _Pragma("unroll") for (int n = 0; n < 2; ++n) _Pragma("unroll") for (int k = 0; k < 2; ++k) dst[n][k] = *(const LAS3 bf16x8*)(lds + G8_SB(b, h) + boff + n * 2048 + k * 1024); } while (0)
#define G8_MMA(ai, bj, At, Bt) do { __builtin_amdgcn_s_setprio(1); _Pragma("unroll") for (int m = 0; m < 4; ++m) _Pragma("unroll") for (int n = 0; n < 2; ++n) _Pragma("unroll") for (int k = 0; k < 2; ++k) \
        acc[ai][bj][m][n] = __builtin_amdgcn_mfma_f32_16x16x32_bf16(Bt[n][k], At[m][k], acc[ai][bj][m][n], 0, 0, 0); __builtin_amdgcn_s_setprio(0); } while (0)
#define G8_WAIT_V(n) asm volatile("s_waitcnt vmcnt(" #n ")" ::: "memory")
#define G8_WAIT_L(n) asm volatile("s_waitcnt lgkmcnt(" #n ")" ::: "memory")
#define G8_BAR __builtin_amdgcn_s_barrier()
#define G8_SCHED __builtin_amdgcn_sched_barrier(0)
    GUnit cur, nxt; int ui = 0;
    if (!S.next(0, cur)) return;
    f32x4 acc[2][2][4][2];
#pragma unroll
    for (int a = 0; a < 2; ++a)
#pragma unroll
        for (int b = 0; b < 2; ++b)
#pragma unroll
            for (int m = 0; m < 4; ++m)
#pragma unroll
                for (int n = 0; n < 2; ++n) acc[a][b][m][n] = (f32x4){0.f, 0.f, 0.f, 0.f};
    bf16x8 At[4][2], B0[2][2], B1[2][2];
    G8_AOFFS(cur);
    const char* cB = S.b_ptr(cur);
    G8_STAGEB(G8_SB(0, 0), cB); G8_STAGE2(G8_SA(0, 0), Ab, voffA[0][0], voffA[0][1]); G8_STAGEB(G8_SB(0, 1), cB + hstep); G8_STAGE2(G8_SA(0, 1), Ab, voffA[1][0], voffA[1][1]);
    if (wr == 1) G8_BAR;
    G8_WAIT_V(4); G8_BAR;
    G8_STAGEB(G8_SB(1, 0), cB + kstep); G8_STAGE2(G8_SA(1, 0), Ab + kstep, voffA[0][0], voffA[0][1]); G8_STAGEB(G8_SB(1, 1), cB + hstep + kstep);
    G8_WAIT_V(6); G8_BAR;
    for (;;) {
        const bool has_next = S.next(ui + 1, nxt);
        const char* nB = has_next ? S.b_ptr(nxt) : cB;
        for (int t = 0; t < nt; t += 2) {
            const bool last = (t == nt - 2);
            const char* a1 = Ab + (size_t)(t + 1) * kstep;
            const unsigned va10 = voffA[1][0], va11 = voffA[1][1];
            if (last && has_next) G8_AOFFS(nxt);
            const char* a2 = last ? Ab : Ab + (size_t)(t + 2) * kstep; const char* b2 = last ? nB : cB + (size_t)(t + 2) * kstep;
            const char* a3 = a2 + kstep; const char* b3 = b2 + kstep;
            G8_LDB(B0, 0, 0); G8_SCHED; G8_LDA(At, 0, 0); G8_STAGE2(G8_SA(1, 1), a1, va10, va11);
            G8_WAIT_L(8); G8_BAR; G8_WAIT_L(0); G8_MMA(0, 0, At, B0); G8_BAR; G8_SCHED;
            G8_LDB(B1, 0, 1); G8_STAGEB(G8_SB(0, 0), b2);
            G8_BAR; G8_WAIT_L(0); G8_MMA(0, 1, At, B1); G8_BAR;
            G8_LDA(At, 0, 1); G8_STAGE2(G8_SA(0, 0), a2, voffA[0][0], voffA[0][1]);
            G8_BAR; G8_WAIT_L(0); G8_MMA(1, 0, At, B0); G8_BAR; G8_SCHED;
            G8_STAGEB(G8_SB(0, 1), b2 + hstep);
            G8_WAIT_V(6); G8_BAR; G8_MMA(1, 1, At, B1); G8_BAR;
            G8_LDB(B0, 1, 0); G8_SCHED; G8_LDA(At, 1, 0); G8_STAGE2(G8_SA(0, 1), a2, voffA[1][0], voffA[1][1]);
            G8_WAIT_L(8); G8_BAR; G8_WAIT_L(0); G8_MMA(0, 0, At, B0); G8_BAR; G8_SCHED;
            G8_LDB(B1, 1, 1); G8_STAGEB(G8_SB(1, 0), b3);
            G8_BAR; G8_WAIT_L(0); G8_MMA(0, 1, At, B1); G8_BAR;
            G8_LDA(At, 1, 1); G8_STAGE2(G8_SA(1, 0), a3, voffA[0][0], voffA[0][1]);
            G8_BAR; G8_WAIT_L(0); G8_MMA(1, 0, At, B0); G8_BAR; G8_SCHED;
            G8_STAGEB(G8_SB(1, 1), b3 + hstep);
            G8_WAIT_V(6); G8_BAR; G8_MMA(1, 1, At, B1); G8_BAR;
        }
        E(acc, cur, wr, wc, fr, fq);
        if (!has_next) break;
#pragma unroll
        for (int a = 0; a < 2; ++a)
#pragma unroll
            for (int b = 0; b < 2; ++b)
#pragma unroll
                for (int m = 0; m < 4; ++m)
#pragma unroll
                    for (int n = 0; n < 2; ++n) acc[a][b][m][n] = (f32x4){0.f, 0.f, 0.f, 0.f};
        cur = nxt; cB = nB; ++ui;
    }
    G8_WAIT_V(0);
    if (wr == 0) G8_BAR;
    G8_BAR;
#undef G8_SA
#undef G8_AOFFS
#undef G8_SB
#undef G8_STAGE2
#undef G8_STAGEB
#undef G8_LDA
#undef G8_LDB
#undef G8_MMA
#undef G8_WAIT_V
#undef G8_WAIT_L
#undef G8_BAR
#undef G8_SCHED
}
struct DenseSched {
    int nM, nN, nwg, G, c, K; const char* Bt;
    __device__ __forceinline__ void init(int M, int N, int K_, const void* Bt_, int G_, int c_) { nM = M >> 8; nN = N >> 8; nwg = nM * nN; G = G_; c = c_; K = K_; Bt = (const char*)Bt_; }
    __device__ __forceinline__ bool next(int i, GUnit& u) const {
        const int L = i * G + c; if (L >= nwg) return false;
        int wgid = L; { const int q = nwg >> 3, r = nwg & 7, xcd = wgid & 7, off = wgid >> 3; wgid = (xcd < r ? xcd * (q + 1) : r * (q + 1) + (xcd - r) * q) + off; }
        const int nig = 8 * nN, gid = wgid / nig, fm = gid * 8, gsz = (nM - fm) < 8 ? (nM - fm) : 8, w = wgid - gid * nig;
        u.pn = w / gsz; u.pm = fm + (w - u.pn * gsz); return true;
    }
    __device__ __forceinline__ unsigned a_off(const GUnit& u, int h, int R) const { return (unsigned)((u.pm * 256 + h * 128 + R) * K) * 2u; }
    __device__ __forceinline__ const char* b_ptr(const GUnit& u) const { return Bt + (size_t)u.pn * 256 * K * 2; }
};

template <class SRC>
__device__ __forceinline__ void convert_wT(const float* __restrict__ W, int K, int N, u16* __restrict__ WT, int rows, SRC src, int gtid, int gnt) {
    const int kch = K >> 3;
    const int total = rows * kch;
    for (int i0 = gtid; i0 < total; i0 += 4 * gnt) {
        float f[4][8]; int sc[4];
#pragma unroll
        for (int u = 0; u < 4; u++) {
            const int i = i0 + u * gnt;
            sc[u] = -1;
            if (i < total) {
                const int kc = i / rows, j = i - kc * rows;
                sc[u] = src(j);
                if (sc[u] >= 0) {
                    const float* wp = W + (size_t)(kc * 8) * N + sc[u];
#pragma unroll
                    for (int q = 0; q < 8; q++) f[u][q] = wp[(size_t)q * N];
                }
            }
        }
#pragma unroll
        for (int u = 0; u < 4; u++) {
            const int i = i0 + u * gnt;
            if (i < total) {
                const int kc = i / rows, j = i - kc * rows;
                uint4 v = make_uint4(0u, 0u, 0u, 0u);
                if (sc[u] >= 0) { v.x = pack2(f[u][0], f[u][1]); v.y = pack2(f[u][2], f[u][3]); v.z = pack2(f[u][4], f[u][5]); v.w = pack2(f[u][6], f[u][7]); }
                *(uint4*)&WT[(size_t)j * K + kc * 8] = v;
            }
        }
    }
}

__device__ __forceinline__ void convert_later_weights(const P& p, int gtid, int gnt) {
    convert_wT(p.w_in, D_, CIN, p.wgT, 2048, [](int j) { const int t = j >> 8, r = j & 255, cl = r & 127; return 3096 + (r >> 7) * 1024 + t * 128 + (cl & ~31) + perm32(cl & 31); }, gtid, gnt);
    convert_wT(p.wpa, 512, D_, p.wpaT, 1024, [](int j) { return (j & ~31) + perm32(j & 31); }, gtid, gnt);
    convert_wT(p.wpb, 512, D_, p.wpbT, 1024, [](int j) { return (j & ~31) + perm32(j & 31); }, gtid, gnt);
    convert_wT(p.wout, D_, D_, p.woutT, 1024, [](int j) { return j; }, gtid, gnt);
    convert_wT(p.w2, 64, 512, p.w2T, 512, [](int j) { return j; }, gtid, gnt);
    convert_wT(p.w1_k, 2048, 256, p.cw1Tk, 256, [](int j) { return j; }, gtid, gnt);
    convert_wT(p.w1_v, 2048, 256, p.cw1Tv, 256, [](int j) { return j; }, gtid, gnt);
    convert_wT(p.w2_k, 256, 64, p.cw2Tk, 128, [](int j) { return j < 64 ? j : -1; }, gtid, gnt);
    convert_wT(p.w2_v, 256, 64, p.cw2Tv, 128, [](int j) { return j < 64 ? j : -1; }, gtid, gnt);
    convert_wT(p.a2, 64, 512, p.a2T, 512, [](int j) { return j; }, gtid, gnt);
    convert_wT(p.g2, 128, 512, p.g2T, 512, [](int j) { return j; }, gtid, gnt);
}
__device__ void ph_prologue(const P& p, int bid, int nb, char* smem) {
    const int tid = get_tid(), lane = tid & 63, wv = tid >> 6;
    if (bid >= 1 && bid <= 64) {
        const int j = tid & 255; const bool isv = tid >= 256;
        const float* pe = isv ? p.pe_v : p.pe_k; const float* w1 = isv ? p.w1_v : p.w1_k;
        const int kb = (bid - 1) * 32;
        float a0 = 0.f, a1 = 0.f;
#pragma unroll 4
        for (int k = kb; k < kb + 32; k += 2) { a0 += pe[k] * w1[(size_t)k * 256 + j]; a1 += pe[k + 1] * w1[(size_t)(k + 1) * 256 + j]; }
        p.cb1k[(bid - 1) * 512 + (isv ? 256 : 0) + j] = a0 + a1;
    }
    if (bid == 0) {
        if (tid < 32) { p.counts[tid] = 0; p.cursor[tid] = 0; }
        if (tid == 32) *p.nsactr = 0;
        for (int i = tid; i < 8 * 64; i += NT) {
            const int bg = i >> 6, d = i & 63;
            p.kcb[((size_t)bg * 512 + 511) * 64 + d] = 0;
            p.vcT[(((size_t)bg * 8 + 7) * 64 + d) * 64 + 63] = 0;
        }
    }
    {
        const int gtid = bid * NT + tid, gnt = nb * NT;
        convert_wT(p.w_in, D_, CIN, p.winT, 3328, [](int j) {
            const int t = j >> 8, s = j & 255;
            if (t < 5) {
                const int bj = s >> 7, wc = (s >> 5) & 3, n = (s >> 4) & 1, i = s & 15;
                const int dim = 32 * bj + 8 * (i >> 2) + 4 * n + (i & 3), hq = 4 * t + wc;
                int hb;
                if (hq < 8) hb = 64 * hq;
                else { const int k = (hq - 8) >> 1; hb = (k == 0 ? 512 : (k == 1 ? 640 : (k == 2 ? 768 : (k == 3 ? 1024 : (k == 4 ? 896 : 1152))))) + 64 * (hq & 1); }
                return hb + dim;
            }
            const int c = (s & ~31) + perm32(s & 31);
            if (t < 12) return 1304 + (t - 5) * 256 + c;
            return c < 24 ? 1280 + c : -1; }, gtid, gnt);
        if (nb != 256) convert_later_weights(p, gtid, gnt);
    }
    for (int row = bid * NW + wv; row < NTOK; row += nb * NW) {
        const float* xr = p.x + (size_t)row * D_;
        float v[16];
        float ss = 0.f;
#pragma unroll
        for (int i = 0; i < 4; i++) {
            float4 t = *(const float4*)&xr[i * 256 + lane * 4];
            v[4 * i] = t.x; v[4 * i + 1] = t.y; v[4 * i + 2] = t.z; v[4 * i + 3] = t.w;
            ss += t.x * t.x + t.y * t.y + t.z * t.z + t.w * t.w;
        }
        ss = wave_sum(ss);
        const float rs = rsqrtf(ss * (1.f / D_) + 1e-6f);
#pragma unroll
        for (int i = 0; i < 4; i++) {
            const int c = i * 256 + lane * 4;
            float4 g = *(const float4*)&p.g_mix[c];
            uint2 o;
            o.x = pack2(v[4 * i] * rs * g.x, v[4 * i + 1] * rs * g.y);
            o.y = pack2(v[4 * i + 2] * rs * g.z, v[4 * i + 3] * rs * g.w);
            *(uint2*)&p.hbuf[(size_t)row * D_ + c] = o;
        }
    }
}

__device__ __forceinline__ uint4 pack8(const f32x4& a, const f32x4& b) { uint4 o; o.x = pack2(a[0], a[1]); o.y = pack2(a[2], a[3]); o.z = pack2(b[0], b[1]); o.w = pack2(b[2], b[3]); return o; }
struct EpiInproj {
    const P* pp;
    __device__ __forceinline__ void operator()(const f32x4 (&acc)[2][2][4][2], const GUnit& u, int, int, int, int) const {
        const int t2_ = get_tid(), wid_ = __builtin_amdgcn_readfirstlane(t2_ >> 6), wr = wid_ >> 2, wc = wid_ & 3, fr = t2_ & 15, fq = (t2_ >> 4) & 3;
        const P& p = *pp;
        const int pn = u.pn;
        const int rowb = u.pm * 256 + wr * 64;
        if (pn < 4) {
            const int hq = 4 * pn + wc;
            const bool rope = !(pn == 2 && wc >= 2);
            u16* dst; size_t rstride; int cofs;
            if (pn < 2) { dst = p.q; rstride = 512; cofs = hq * 64; }
            else { dst = (pn == 2) ? (wc < 2 ? p.kc : p.vc) : (wc < 2 ? p.ksl : p.kwn); rstride = 64; cofs = 0; }
            const int g = wc & 1;
#pragma unroll
            for (int ai = 0; ai < 2; ++ai)
#pragma unroll
                for (int m = 0; m < 4; ++m) {
                    const int row = rowb + ai * 128 + m * 16 + fr;
                    f32x4 o1[2], o2[2];
#pragma unroll
                    for (int n = 0; n < 2; ++n) { o1[n] = acc[ai][0][m][n]; o2[n] = acc[ai][1][m][n]; }
                    if (rope) {
                        const double posd = (double)p.pos[row];
#pragma unroll
                        for (int n = 0; n < 2; ++n)
#pragma unroll
                            for (int j = 0; j < 4; ++j) {
                                const double tr = posd * ROPE_FREQ[8 * fq + 4 * n + j] * 0.15915494309189535;
                                const float fr_ = (float)(tr - rint(tr));
                                const float cs = __builtin_amdgcn_cosf(fr_), sn = __builtin_amdgcn_sinf(fr_);
                                const float x1 = o1[n][j], x2 = o2[n][j];
                                o1[n][j] = x1 * cs - x2 * sn; o2[n][j] = x1 * sn + x2 * cs;
                            }
                    }
                    size_t ro;
                    if (pn < 2) {
#pragma unroll
                        for (int n = 0; n < 2; ++n)
#pragma unroll
                            for (int j = 0; j < 4; ++j) { o1[n][j] *= QSCALE; o2[n][j] *= QSCALE; }
                        ro = (size_t)row * 512 + cofs + 8 * fq;
                    } else {
                        const int bb = row >> 13, t = row & (S_ - 1);
                        ro = ((size_t)(bb * 2 + g) * S_ + t) * 64 + 8 * fq;
                    }
                    *(uint4*)&dst[ro] = pack8(o1[0], o1[1]);
                    *(uint4*)&dst[ro + 32] = pack8(o2[0], o2[1]);
                }
        } else if (pn == 4) {
            u16* dst = (wc < 2) ? p.vslT : p.vwnT;
            const int g = wc & 1;
#pragma unroll
            for (int ai = 0; ai < 2; ++ai) {
                const int r0 = rowb + ai * 128, bb = r0 >> 13, tb = r0 & (S_ - 1);
                u16* base = dst + ((size_t)(bb * 2 + g) * 128 + (tb >> 6)) * 4096;
#pragma unroll
                for (int m = 0; m < 4; ++m)
#pragma unroll
                    for (int bj = 0; bj < 2; ++bj)
#pragma unroll
                        for (int n = 0; n < 2; ++n)
#pragma unroll
                            for (int j = 0; j < 4; ++j)
                                base[(32 * bj + 8 * fq + 4 * n + j) * 64 + m * 16 + fr] = f2bf(acc[ai][bj][m][n][j]);
            }
        } else if (pn < 12) {
            const int cb = (pn - 5) * 256 + wc * 32 + 8 * fq;
#pragma unroll
            for (int ai = 0; ai < 2; ++ai)
#pragma unroll
                for (int m = 0; m < 4; ++m) {
                    const size_t ro = (size_t)(rowb + ai * 128 + m * 16 + fr) * CRW + cb;
#pragma unroll
                    for (int bj = 0; bj < 2; ++bj) *(uint4*)&p.prw[ro + bj * 128] = pack8(acc[ai][bj][m][0], acc[ai][bj][m][1]);
                }
        } else {
            if (wc == 0 && fq < 3) {
#pragma unroll
                for (int ai = 0; ai < 2; ++ai)
#pragma unroll
                    for (int m = 0; m < 4; ++m) {
                        const size_t ro = (size_t)(rowb + ai * 128 + m * 16 + fr) * 24 + 8 * fq;
#pragma unroll
                        for (int n = 0; n < 2; ++n) {
                            float4 o; o.x = sigmoidf_(acc[ai][0][m][n][0]); o.y = sigmoidf_(acc[ai][0][m][n][1]); o.z = sigmoidf_(acc[ai][0][m][n][2]); o.w = sigmoidf_(acc[ai][0][m][n][3]);
                            *(float4*)&p.nsag[ro + 4 * n] = o;
                        }
                    }
            }
        }
    }
};
__device__ void ph_inproj(const P& p, int bid, int nb, char* smem) {
    DenseSched S; S.init(NTOK, 3328, D_, p.winT, nb, bid);
    EpiInproj E{&p};
    gemm256(smem, (const char*)p.hbuf, D_, S, E);
    if (nb == 256 && bid >= 128) convert_later_weights(p, (bid - 128) * NT + get_tid(), 128 * NT);
}

__device__ __forceinline__ float gelu_tanh(float x) {
    const float c = 0.7978845608028654f;
    return 0.5f * x * (1.f + tanhf(c * (x + 0.044715f * x * x * x)));
}
__device__ void ph_compress(const P& p, int bid, int nb, char* smem) {
    u16* sm = (u16*)smem;
    const int tid = get_tid(), lane = tid & 63, wv = tid >> 6;
    const int wm = wv >> 1, wn = wv & 1;
    for (int it = bid; it < 32; it += nb) {
        const int rt = it & 1, g = (it >> 1) & 1, b = (it >> 2) & 3, kv = it >> 4;
        const int bg = b * 2 + g, i0 = rt * 256;
        const u16* src = (kv ? p.vc : p.kc) + (size_t)bg * S_ * 64;
        const u16* w1T = kv ? p.cw1Tv : p.cw1Tk;
        const u16* w2T = kv ? p.cw2Tv : p.cw2Tk;
        float* cb1 = (float*)(smem + 3 * G_TILE);
        __syncthreads();
        { const int t2 = get_tid(); if (t2 < 256) { float a = 0.f; for (int q = 0; q < 64; q++) a += p.cb1k[q * 512 + kv * 256 + t2]; cb1[t2] = a; } }
        __syncthreads();
        const float* b1 = kv ? p.b1_v : p.b1_k;
        const float* b2 = kv ? p.b2_v : p.b2_k;
        u16* hidp = p.chid + (size_t)it * 256 * 256;
        auto arow = [&](int r) { int i = i0 + r; if (i > 510) i = 510; return src + (size_t)i * 1024; };
#pragma unroll 1
        for (int ct = 0; ct < 2; ct++) {
            f32x4 acc[4][4];
            gemm_core<false>(2048, arow, w1T + (size_t)ct * 128 * 2048, 2048, acc, sm);
            const int le = get_tid() & 63;
#pragma unroll
            for (int mt = 0; mt < 4; mt++) {
                const int r = wm * 64 + mt * 16 + (le & 15);
#pragma unroll
                for (int nt = 0; nt < 4; nt++) {
                    const int col = ct * 128 + wn * 64 + nt * 16 + (le >> 4) * 4;
                    const float4 c1 = *(const float4*)&cb1[col], bb1 = *(const float4*)&b1[col];
                    f32x4 o;
                    o[0] = gelu_tanh(acc[mt][nt][0] + c1.x + bb1.x); o[1] = gelu_tanh(acc[mt][nt][1] + c1.y + bb1.y);
                    o[2] = gelu_tanh(acc[mt][nt][2] + c1.z + bb1.z); o[3] = gelu_tanh(acc[mt][nt][3] + c1.w + bb1.w);
                    *(uint2*)&hidp[r * 256 + col] = pack4(o);
                }
            }
        }
        __syncthreads();
        {
            f32x4 acc[4][4];
            gemm_core<true>(256, [&](int r) { return hidp + (size_t)r * 256; }, w2T, 256, acc, sm);
            if (wn == 0) {
#pragma unroll
                for (int mt = 0; mt < 4; mt++)
#pragma unroll
                    for (int nt = 0; nt < 4; nt++) {
                        const int d = nt * 16 + (lane & 15);
                        const int ib = i0 + wm * 64 + mt * 16 + (lane >> 4) * 4;
                        float o[4];
#pragma unroll
                        for (int j = 0; j < 4; j++) o[j] = (ib + j < NCMP) ? (acc[mt][nt][j] + b2[d]) : 0.f;
                        if (kv == 0) {
#pragma unroll
                            for (int j = 0; j < 4; j++) p.kcb[((size_t)bg * 512 + ib + j) * 64 + d] = f2bf(o[j]);
                        } else {
                            uint2 ov; ov.x = pack2(o[0], o[1]); ov.y = pack2(o[2], o[3]);
                            *(uint2*)&p.vcT[(((size_t)bg * 8 + (ib >> 6)) * 64 + d) * 64 + (ib & 63)] = ov;
                        }
                    }
            }
        }
        __syncthreads();
    }
}

#ifndef NSAPROBE
#define NSAPROBE 0
#endif
#define NSA_TS(k) if (NSAPROBE == k) ts_ = __builtin_amdgcn_s_memrealtime();
#define NSA_TE(k) if (NSAPROBE == k) tacc_ += __builtin_amdgcn_s_memrealtime() - ts_;
constexpr int KSTR = 72;
struct Sub { f32x4 O[4]; float m, l; };
#define NEG_BIG (-1.0e30f)

__device__ __forceinline__ float xq_max(float v) {
    return xrow_max(v);
}
__device__ __forceinline__ float xq_sum(float v) {
    return xrow_sum(v);
}
template <int OFF> __device__ __forceinline__ bf16x8 gload_b128(const u16* p) { bf16x8 r; asm volatile("global_load_dwordx4 %0, %1, off offset:%2" : "=v"(r) : "v"(p), "n"(OFF) : "memory"); return r; }
typedef unsigned u32x2 __attribute__((ext_vector_type(2)));
template <int OFF> __device__ __forceinline__ u32x2 gload_b64(const u16* p) { u32x2 r; asm volatile("global_load_dwordx2 %0, %1, off offset:%2" : "=v"(r) : "v"(p), "n"(OFF) : "memory"); return r; }
union VF { bf16x8 v; u32x2 h[2]; };
template <int OFF> __device__ __forceinline__ u32x2 lds_read_b64(unsigned addr) { u32x2 r; asm volatile("ds_read_b64 %0, %1 offset:%2" : "=v"(r) : "v"(addr), "n"(OFF)); return r; }
#define NSA_LDV_ASM(vf, Vs, kr, qq, swz) { const unsigned va_ = (unsigned)(size_t)(const LAS3 char*)((const char*)(Vs) + (kr) * 128 + ((qq) & 1) * 8); const int vo_ = (((qq) >> 1) ^ (swz)) << 4; \
        const unsigned a0_ = va_ + vo_, a1_ = va_ + (vo_ ^ 32), a2_ = va_ + (vo_ ^ 64), a3_ = va_ + (vo_ ^ 96); \
        vf[0][0].h[0] = lds_read_b64<0>(a0_);    vf[0][0].h[1] = lds_read_b64<0>(a1_);    vf[0][1].h[0] = lds_read_b64<0>(a2_);    vf[0][1].h[1] = lds_read_b64<0>(a3_); \
        vf[1][0].h[0] = lds_read_b64<2048>(a0_); vf[1][0].h[1] = lds_read_b64<2048>(a1_); vf[1][1].h[0] = lds_read_b64<2048>(a2_); vf[1][1].h[1] = lds_read_b64<2048>(a3_); \
        vf[2][0].h[0] = lds_read_b64<4096>(a0_); vf[2][0].h[1] = lds_read_b64<4096>(a1_); vf[2][1].h[0] = lds_read_b64<4096>(a2_); vf[2][1].h[1] = lds_read_b64<4096>(a3_); \
        vf[3][0].h[0] = lds_read_b64<6144>(a0_); vf[3][0].h[1] = lds_read_b64<6144>(a1_); vf[3][1].h[0] = lds_read_b64<6144>(a2_); vf[3][1].h[1] = lds_read_b64<6144>(a3_); }
#define NSA_VWAIT(vf) asm volatile("s_waitcnt lgkmcnt(0)" : "+v"(vf[0][0].v), "+v"(vf[0][1].v), "+v"(vf[1][0].v), "+v"(vf[1][1].v), "+v"(vf[2][0].v), "+v"(vf[2][1].v), "+v"(vf[3][0].v), "+v"(vf[3][1].v) :: "memory")
template <bool MASK, bool IMP, bool PV>
__device__ __forceinline__ void nsa_visit(const u16* Ks, const u16* Vs, const u16* qrow, Sub& s, int lo, int hi, int lane, float* e, float* p3) {
    const int kr = lane & 15, qq = lane >> 4;
    f32x4 S[4];
    const int qsw = ((kr & 3) >> 1) ^ ((kr >> 2) << 1);
    const bf16x8 qf0 = *(const bf16x8*)(qrow + ((qq ^ qsw) << 3)), qf1 = *(const bf16x8*)(qrow + (((4 + qq) ^ qsw) << 3));
    bf16x8 kf[4][2];
    const int swz = kr >> 1;
    {
        const char* kb_ = (const char*)Ks + kr * 128;
        const int ko0 = (qq ^ swz) << 4, ko1 = ko0 ^ 64;
#pragma unroll
        for (int kt = 0; kt < 4; kt++) { kf[kt][0] = *(const bf16x8*)(kb_ + kt * 2048 + ko0); kf[kt][1] = *(const bf16x8*)(kb_ + kt * 2048 + ko1); }
    }
    __builtin_amdgcn_sched_barrier(0);
#pragma unroll
    for (int kt = 0; kt < 4; kt++) {
        S[kt] = __builtin_amdgcn_mfma_f32_16x16x32_bf16(kf[kt][0], qf0, f32x4{0.f, 0.f, 0.f, 0.f}, 0, 0, 0);
        S[kt] = __builtin_amdgcn_mfma_f32_16x16x32_bf16(kf[kt][1], qf1, S[kt], 0, 0, 0);
    }
    float mx = NEG_BIG;
#pragma unroll
    for (int kt = 0; kt < 4; kt++)
#pragma unroll
        for (int r = 0; r < 4; r++) {
            if (MASK) { const int o = kt * 16 + qq * 4 + r; if (o < lo || o > hi) S[kt][r] = -INFINITY; }
            mx = fmaxf(mx, S[kt][r]);
        }
    mx = xq_max(mx);
    const float mnew = fmaxf(s.m, mx);
    const float alpha = __builtin_amdgcn_exp2f(s.m - mnew);
    s.m = mnew;
    float psum = 0.f;
#pragma unroll
    for (int kt = 0; kt < 4; kt++) {
#pragma unroll
        for (int r = 0; r < 4; r++) { S[kt][r] = __builtin_amdgcn_exp2f(S[kt][r] - mnew); }
        const float ee = (S[kt][0] + S[kt][1]) + (S[kt][2] + S[kt][3]);
        psum += ee;
        if (IMP) { e[kt] = ee; p3[kt] = S[kt][3]; }
    }
    s.l = s.l * alpha + psum;
    if (PV) {
        if (!__all(alpha == 1.f)) {
#pragma unroll
            for (int dt = 0; dt < 4; dt++)
#pragma unroll
                for (int r = 0; r < 4; r++) s.O[dt][r] *= alpha;
        }
        VF vf[4][2];
        NSA_LDV_ASM(vf, Vs, kr, qq, swz)
        bf16x8 pb[2];
#pragma unroll
        for (int k2 = 0; k2 < 2; k2++) {
            union { bf16x8 v; unsigned u[4]; } t;
            t.u[0] = pack2(S[2 * k2][0], S[2 * k2][1]); t.u[1] = pack2(S[2 * k2][2], S[2 * k2][3]);
            t.u[2] = pack2(S[2 * k2 + 1][0], S[2 * k2 + 1][1]); t.u[3] = pack2(S[2 * k2 + 1][2], S[2 * k2 + 1][3]);
            pb[k2] = t.v;
        }
        NSA_VWAIT(vf);
        __builtin_amdgcn_sched_barrier(0);
#pragma unroll
        for (int dt = 0; dt < 4; dt++)
#pragma unroll
            for (int k2 = 0; k2 < 2; k2++) s.O[dt] = __builtin_amdgcn_mfma_f32_16x16x32_bf16(vf[dt][k2].v, pb[k2], s.O[dt], 0, 0, 0);
    }
}
template <bool IMP, bool PV>
__device__ __forceinline__ void nsa_visit2(const u16* Ks, const u16* Vs, const u16* qrow0, const u16* qrow1, Sub (&st)[2], const int (&hi)[2], int lane, float (&e)[2][4], float (&p3)[2][4]) {
    const int kr = lane & 15, qq = lane >> 4;
    const int qsw = ((kr & 3) >> 1) ^ ((kr >> 2) << 1);
    bf16x8 qf0[2], qf1[2];
    qf0[0] = *(const bf16x8*)(qrow0 + ((qq ^ qsw) << 3)); qf1[0] = *(const bf16x8*)(qrow0 + (((4 + qq) ^ qsw) << 3));
    qf0[1] = *(const bf16x8*)(qrow1 + ((qq ^ qsw) << 3)); qf1[1] = *(const bf16x8*)(qrow1 + (((4 + qq) ^ qsw) << 3));
    bf16x8 kf[4][2];
    const int swz = kr >> 1;
    {
        const char* kb_ = (const char*)Ks + kr * 128;
        const int ko0 = (qq ^ swz) << 4, ko1 = ko0 ^ 64;
#pragma unroll
        for (int kt = 0; kt < 4; kt++) { kf[kt][0] = *(const bf16x8*)(kb_ + kt * 2048 + ko0); kf[kt][1] = *(const bf16x8*)(kb_ + kt * 2048 + ko1); }
    }
    __builtin_amdgcn_sched_barrier(0);
    f32x4 S[2][4];
#pragma unroll
    for (int kt = 0; kt < 4; kt++)
#pragma unroll
        for (int q = 0; q < 2; q++) {
            S[q][kt] = __builtin_amdgcn_mfma_f32_16x16x32_bf16(kf[kt][0], qf0[q], f32x4{0.f, 0.f, 0.f, 0.f}, 0, 0, 0);
            S[q][kt] = __builtin_amdgcn_mfma_f32_16x16x32_bf16(kf[kt][1], qf1[q], S[q][kt], 0, 0, 0);
        }
    VF vf[4][2];
    bf16x8 pb[2][2];
#pragma unroll
    for (int q = 0; q < 2; q++) {
        Sub& s = st[q];
        float mx = NEG_BIG;
#pragma unroll
        for (int kt = 0; kt < 4; kt++)
#pragma unroll
            for (int r = 0; r < 4; r++) {
                const int o = kt * 16 + qq * 4 + r; if (o > hi[q]) S[q][kt][r] = -INFINITY;
                mx = fmaxf(mx, S[q][kt][r]);
            }
        mx = xq_max(mx);
        const float mnew = fmaxf(s.m, mx);
        const float alpha = __builtin_amdgcn_exp2f(s.m - mnew);
        s.m = mnew;
        float psum = 0.f;
#pragma unroll
        for (int kt = 0; kt < 4; kt++) {
#pragma unroll
            for (int r = 0; r < 4; r++) { S[q][kt][r] = __builtin_amdgcn_exp2f(S[q][kt][r] - mnew); }
            const float ee = (S[q][kt][0] + S[q][kt][1]) + (S[q][kt][2] + S[q][kt][3]);
            psum += ee;
            if (IMP) { e[q][kt] = ee; p3[q][kt] = S[q][kt][3]; }
        }
        s.l = s.l * alpha + psum;
        if (PV) {
#pragma unroll
            for (int dt = 0; dt < 4; dt++)
#pragma unroll
                for (int r = 0; r < 4; r++) s.O[dt][r] *= alpha;
#pragma unroll
            for (int k2 = 0; k2 < 2; k2++) {
                union { bf16x8 v; unsigned u[4]; } t;
                t.u[0] = pack2(S[q][2 * k2][0], S[q][2 * k2][1]); t.u[1] = pack2(S[q][2 * k2][2], S[q][2 * k2][3]);
                t.u[2] = pack2(S[q][2 * k2 + 1][0], S[q][2 * k2 + 1][1]); t.u[3] = pack2(S[q][2 * k2 + 1][2], S[q][2 * k2 + 1][3]);
                pb[q][k2] = t.v;
            }
            if (q == 0) NSA_LDV_ASM(vf, Vs, kr, qq, swz)
        }
    }
    if (PV) {
        NSA_VWAIT(vf);
        __builtin_amdgcn_sched_barrier(0);
#pragma unroll
        for (int dt = 0; dt < 4; dt++)
#pragma unroll
            for (int k2 = 0; k2 < 2; k2++)
#pragma unroll
                for (int q = 0; q < 2; q++) st[q].O[dt] = __builtin_amdgcn_mfma_f32_16x16x32_bf16(vf[dt][k2].v, pb[q][k2], st[q].O[dt], 0, 0, 0);
    }
}
template <int MMODE, bool FIXM, int NQ>
__device__ __forceinline__ void nsa_visit_gn(const u16* Ks, const u16* Vs, const u16* qs, float* Os, float* Ms, float* Ls, const int (&tok)[NQ], const bool (&valid)[NQ], int lane) {
    const int kr = lane & 15, qq = lane >> 4, hh = kr & 3;
    int row[NQ], osw[NQ]; float* orow[NQ];
    f32x4 O[NQ][4]; float m_old[NQ], l_old[NQ]; bf16x8 qf0[NQ], qf1[NQ];
#pragma unroll
    for (int q = 0; q < NQ; q++) {
        row[q] = tok[q] * 4 + hh; orow[q] = Os + row[q] * 64;
        osw[q] = hh ^ ((tok[q] & 3) << 2);
#pragma unroll
        for (int dt = 0; dt < 4; dt++) O[q][dt] = *(const f32x4*)(orow[q] + (((dt * 4 + qq) ^ osw[q]) << 2));
        m_old[q] = Ms[row[q]]; l_old[q] = Ls[row[q]];
        const u16* qrow = qs + row[q] * 64;
        const int qsw = (hh >> 1) ^ ((tok[q] & 3) << 1);
        qf0[q] = *(const bf16x8*)(qrow + ((qq ^ qsw) << 3)); qf1[q] = *(const bf16x8*)(qrow + (((4 + qq) ^ qsw) << 3));
    }
    bf16x8 kf[4][2];
    const int swz = kr >> 1;
    {
        const char* kb_ = (const char*)Ks + kr * 128;
        const int ko0 = (qq ^ swz) << 4, ko1 = ko0 ^ 64;
#pragma unroll
        for (int kt = 0; kt < 4; kt++) { kf[kt][0] = *(const bf16x8*)(kb_ + kt * 2048 + ko0); kf[kt][1] = *(const bf16x8*)(kb_ + kt * 2048 + ko1); }
    }
    __builtin_amdgcn_sched_barrier(0);
    f32x4 S[NQ][4];
#pragma unroll
    for (int kt = 0; kt < 4; kt++)
#pragma unroll
        for (int q = 0; q < NQ; q++) {
            const float s0 = FIXM ? (valid[q] ? -m_old[q] : -INFINITY) : 0.f;
            S[q][kt] = __builtin_amdgcn_mfma_f32_16x16x32_bf16(kf[kt][0], qf0[q], f32x4{s0, s0, s0, s0}, 0, 0, 0);
            S[q][kt] = __builtin_amdgcn_mfma_f32_16x16x32_bf16(kf[kt][1], qf1[q], S[q][kt], 0, 0, 0);
        }
    VF vf[4][2];
#define NSA_LDV NSA_LDV_ASM(vf, Vs, kr, qq, swz)
    if (NQ == 1) NSA_LDV
    bf16x8 pb[NQ][2];
#pragma unroll
    for (int q = 0; q < NQ; q++) {
        float mx = NEG_BIG;
#pragma unroll
        for (int kt = 0; kt < 4; kt++)
#pragma unroll
            for (int r = 0; r < 4; r++) {
                if (MMODE == 1) { const int o = kt * 16 + qq * 4 + r; if (o > tok[q]) S[q][kt][r] = -INFINITY; }
                if (MMODE == 2) { const int o = kt * 16 + qq * 4 + r; if (o <= tok[q]) S[q][kt][r] = -INFINITY; }
                if (!FIXM) mx = fmaxf(mx, S[q][kt][r]);
            }
        float mnew = m_old[q], alpha = 1.f;
        if (!FIXM) {
            if (!valid[q]) mx = NEG_BIG;
            mx = xq_max(mx);
            mnew = fmaxf(m_old[q], mx);
            alpha = __builtin_amdgcn_exp2f(m_old[q] - mnew);
        }
#pragma unroll
        for (int kt = 0; kt < 4; kt++)
#pragma unroll
            for (int r = 0; r < 4; r++) { S[q][kt][r] = __builtin_amdgcn_exp2f(FIXM ? S[q][kt][r] : S[q][kt][r] - mnew); }
#pragma unroll
        for (int k2 = 0; k2 < 2; k2++) {
            union { bf16x8 v; unsigned u[4]; } t;
            t.u[0] = pack2(S[q][2 * k2][0], S[q][2 * k2][1]); t.u[1] = pack2(S[q][2 * k2][2], S[q][2 * k2][3]);
            t.u[2] = pack2(S[q][2 * k2 + 1][0], S[q][2 * k2 + 1][1]); t.u[3] = pack2(S[q][2 * k2 + 1][2], S[q][2 * k2 + 1][3]);
            pb[q][k2] = t.v;
        }
        float psum;
        {
            const bf16x8 ones = {0x3F80, 0x3F80, 0x3F80, 0x3F80, 0x3F80, 0x3F80, 0x3F80, 0x3F80};
            f32x4 ps = __builtin_amdgcn_mfma_f32_16x16x32_bf16(ones, pb[q][0], f32x4{0.f, 0.f, 0.f, 0.f}, 0, 0, 0);
            ps = __builtin_amdgcn_mfma_f32_16x16x32_bf16(ones, pb[q][1], ps, 0, 0, 0);
            psum = ps[0];
        }
        if (FIXM) { if (valid[q] && qq == 0) Ls[row[q]] = l_old[q] + psum; }
        else {
            if (valid[q] && qq == 0) { Ms[row[q]] = mnew; Ls[row[q]] = l_old[q] * alpha + psum; }
#pragma unroll
            for (int dt = 0; dt < 4; dt++)
#pragma unroll
                for (int r = 0; r < 4; r++) O[q][dt][r] *= alpha;
        }
        if (NQ == 2 && q == 0) { asm volatile("" ::: "memory"); NSA_LDV }
    }
#undef NSA_LDV
    NSA_VWAIT(vf);
    __builtin_amdgcn_sched_barrier(0);
#pragma unroll
    for (int dt = 0; dt < 4; dt++)
#pragma unroll
        for (int k2 = 0; k2 < 2; k2++)
#pragma unroll
            for (int q = 0; q < NQ; q++) O[q][dt] = __builtin_amdgcn_mfma_f32_16x16x32_bf16(vf[dt][k2].v, pb[q][k2], O[q][dt], 0, 0, 0);
#pragma unroll
    for (int q = 0; q < NQ; q++)
        if (valid[q]) {
#pragma unroll
            for (int dt = 0; dt < 4; dt++) *(f32x4*)(orow[q] + (((dt * 4 + qq) ^ osw[q]) << 2)) = O[q][dt];
        }
}
template <int MMODE, bool FIXM>
__device__ __forceinline__ void nsa_visit_g(const u16* Ks, const u16* Vs, const u16* qs, float* Os, float* Ms, float* Ls, int tok, bool valid, int lane) {
    const int tk[1] = {tok}; const bool vl[1] = {valid};
    nsa_visit_gn<MMODE, FIXM, 1>(Ks, Vs, qs, Os, Ms, Ls, tk, vl, lane);
}
__device__ __forceinline__ void nsa_fold_lds(float* Os, float* Ms, float* Ls, int row, int qq, int hh, f32x4 (&T)[4], float gate, bool reset) {
    const float lt = Ls[row];
    const float sc = (lt > 0.f) ? gate / lt : 0.f;
#pragma unroll
    for (int dt = 0; dt < 4; dt++) {
        float* op = Os + row * 64 + (((dt * 4 + qq) ^ hh ^ (((row >> 2) & 3) << 2)) << 2);
        const f32x4 o = *(const f32x4*)op;
#pragma unroll
        for (int r = 0; r < 4; r++) T[dt][r] += o[r] * sc;
        if (reset) *(f32x4*)op = f32x4{0.f, 0.f, 0.f, 0.f};
    }
    asm volatile("s_waitcnt lgkmcnt(0)" ::: "memory");
    if (reset && qq == 0) { Ms[row] = NEG_BIG; Ls[row] = 0.f; }
}
template <int MODE>
__device__ __forceinline__ void nsa_fold(Sub& s, f32x4 (&T)[4], float gate) {
    const float lt = xq_sum(s.l);
    const float sc = (lt > 0.f) ? gate / lt : 0.f;
#pragma unroll
    for (int dt = 0; dt < 4; dt++)
#pragma unroll
        for (int r = 0; r < 4; r++) {
            const float v = s.O[dt][r] * sc;
            T[dt][r] = (MODE == 1) ? T[dt][r] + v : v;
            s.O[dt][r] = 0.f;
        }
    s.m = NEG_BIG; s.l = 0.f;
}

constexpr int NSA_R = 3;
template <bool HASV, class KSrc, class VSrc, class Body>
__device__ __forceinline__ void nsa_stream(char* ring, int n, KSrc ksrc, VSrc vsrc, Body body) {
    const int t = get_tid();
    const int so = (t >> 3) * 64 + (((t & 7) ^ ((t >> 4) & 7)) << 3);
    char* dl = ring + t * 16;
#define NSA_ISSUE(i, slot) { glds16(ksrc(i) + so, dl + (slot) * 16384); if (HASV) glds16(vsrc(i) + so, dl + (slot) * 16384 + 8192); }
    asm volatile("s_waitcnt lgkmcnt(0)" ::: "memory");
    __builtin_amdgcn_s_barrier();
    if (n > 0) NSA_ISSUE(0, 0)
    if (n > 1) NSA_ISSUE(1, 1)
    int slot = 0;
    for (int i = 0; i < n; i++) {
        if (i + 1 < n) { if (HASV) asm volatile("s_waitcnt vmcnt(2)" ::: "memory"); else asm volatile("s_waitcnt vmcnt(1)" ::: "memory"); }
        else asm volatile("s_waitcnt vmcnt(0)" ::: "memory");
        asm volatile("s_waitcnt lgkmcnt(0)" ::: "memory");
        __builtin_amdgcn_s_barrier();
        asm volatile("" ::: "memory");
        const int sl2 = (slot == 0) ? 2 : slot - 1;
        if (i + 2 < n) NSA_ISSUE(i + 2, sl2)
        body(i, (const u16*)(ring + slot * 16384), (const u16*)(ring + slot * 16384 + 8192));
        slot = (slot == 2) ? 0 : slot + 1;
    }
#undef NSA_ISSUE
}
#define NSA_TOK(u) const int t3_ = get_tid(); const size_t ntk_ = (size_t)b * S_ + t0 + 8 * (t3_ >> 6) + 4 * (u) + ((t3_ & 15) >> 2); const int hd_ = g * 4 + (t3_ & 3);
__device__ void ph_nsa(const P& p, int bid, int nb, char* smem) {
    char* ring = smem;
    unsigned* selm = (unsigned*)(smem + NSA_R * 16384);
    int* blist = (int*)(selm + 256);
    int* nlistp = blist + 128;
    int* lcnt = nlistp + 4;
    unsigned char* lists = (unsigned char*)(lcnt + 128);
    float* Ms = (float*)(lists + 128 * 64);
    float* Ls = Ms + 256;
    float* Os = Ls + 256;
    float* impl = Os;
    u16* qs = (u16*)(Os + 64 * 4 * 64);
    unsigned long long ts_ = 0, tacc_ = 0;
    const int nitems = B_ * 2 * 128;
    for (int rr = 0;; rr++) {
        int it = bid;
        if (rr > 0 || bid < 0) {
            __syncthreads();
            if (get_tid() == 0) nlistp[3] = nb + atomicAdd(p.nsactr, 1);
            __syncthreads();
            it = nlistp[3];
        }
        if (it >= nitems) break;
        const int tid = get_tid(), lane = tid & 63, wv = tid >> 6;
        const int kr = lane & 15, qq = lane >> 4, ts = kr >> 2, hh = kr & 3;
        float* myimp = impl + wv * (32 * 2 * 16);
        const int tt = 127 - (it >> 3);
        const int bg = it & 7, b = bg >> 1, g = bg & 1;
        const int t0 = tt * 64, cur = tt;
        const int head = g * 4 + hh;
        Sub st[2];
        f32x4 T[2][4];
        int tl[2]; size_t ntok[2];
        __syncthreads();
#pragma unroll
        for (int u = 0; u < 2; u++) {
            tl[u] = 8 * wv + 4 * u + ts;
            ntok[u] = (size_t)b * S_ + t0 + tl[u];
#pragma unroll
            for (int ks = 0; ks < 2; ks++) *(bf16x8*)&qs[(tl[u] * 4 + hh) * 64 + (((ks * 4 + qq) ^ (hh >> 1) ^ ((tl[u] & 3) << 1)) << 3)] = *(const bf16x8*)&p.q[ntok[u] * 512 + head * 64 + ks * 32 + qq * 8];
#pragma unroll
            for (int dt = 0; dt < 4; dt++) st[u].O[dt] = f32x4{0.f, 0.f, 0.f, 0.f};
            st[u].m = NEG_BIG; st[u].l = 0.f;
        }
        const u16* kcb = p.kcb + (size_t)bg * 512 * 64;
        const u16* vcT = p.vcT + (size_t)bg * 8 * 4096;
        int nv[2];
#pragma unroll
        for (int u = 0; u < 2; u++) { const int t = t0 + tl[u]; nv[u] = (t >= 31) ? min((t - 31) / 16 + 1, NCMP) : 0; }
        const int tmax = t0 + 63;
        const int nvmax = (tmax >= 31) ? min((tmax - 31) / 16 + 1, NCMP) : 0;
        const int nvb = (nvmax + 63) >> 6;
        NSA_TS(1)
        __syncthreads();
        nsa_stream<false>(ring, nvb, [&](int kb) { return kcb + (size_t)kb * 4096; }, [&](int kb) { return vcT + (size_t)kb * 4096; },
            [&](int kb, const u16* Ks, const u16* Vs) {
                const int hi2[2] = {nv[0] - kb * 64 - 1, nv[1] - kb * 64 - 1};
                float e_[2][4], p3_[2][4];
                nsa_visit2<false, false>(Ks, Vs, qs + (tl[0] * 4 + hh) * 64, qs + (tl[1] * 4 + hh) * 64, st, hi2, lane, e_, p3_);
            });
        float invl[2];
#pragma unroll
        for (int u = 0; u < 2; u++) { const float lt = xq_sum(st[u].l); invl[u] = (lt > 0.f) ? 1.f / lt : 0.f; st[u].l = 0.f; }
        float carry[2] = {0.f, 0.f};
        nsa_stream<true>(ring, nvb, [&](int kb) { return kcb + (size_t)kb * 4096; }, [&](int kb) { return vcT + (size_t)kb * 4096; },
            [&](int kb, const u16* Ks, const u16* Vs) {
            const int hi2[2] = {nv[0] - kb * 64 - 1, nv[1] - kb * 64 - 1};
            float e_[2][4], p3_[2][4];
            nsa_visit2<true, true>(Ks, Vs, qs + (tl[0] * 4 + hh) * 64, qs + (tl[1] * 4 + hh) * 64, st, hi2, lane, e_, p3_);
#pragma unroll
            for (int u = 0; u < 2; u++) {
#pragma unroll
                for (int kt = 0; kt < 4; kt++) {
                    float ev = e_[u][kt] * invl[u], pv = p3_[u][kt] * invl[u];
                    ev += dppf<0xB1>(ev); ev += dppf<0x4E>(ev);
                    pv += dppf<0xB1>(pv); pv += dppf<0x4E>(pv);
                    const float sh = __int_as_float(__builtin_amdgcn_ds_bpermute(((lane - 16) & 63) << 2, __float_as_int(pv)));
                    const float nbv = (qq == 0) ? carry[u] : sh;
                    carry[u] = sh;
                    myimp[((kb * 4 + kt) * 2 + u) * 16 + ts * 4 + qq] = ev + nbv;
                }
            }
            });
        NSA_TE(1)
        NSA_TS(2)
#pragma unroll
        for (int u = 0; u < 2; u++) {
            float mv[8];
#pragma unroll
            for (int i = 0; i < 8; i++) {
                const int kk = 8 * hh + i, j = 4 * kk + qq;
                const float v = myimp[(kk * 2 + u) * 16 + ts * 4 + qq];
                mv[i] = (j >= 1 && j <= cur - 2) ? v : -1.f;
            }
            unsigned sel = 0u;
            const int ncand = max(0, cur - 2);
            const int nforced = (cur >= 2) ? 3 : (cur + 1);
            const int need = 16 - nforced;
            if (ncand <= need) {
#pragma unroll
                for (int i = 0; i < 8; i++) if (mv[i] >= 0.f) sel |= (1u << i);
            } else {
                for (int rnd = 0; rnd < need; rnd++) {
                    const float b01 = fmaxf(mv[0], mv[1]), b23 = fmaxf(mv[2], mv[3]), b45 = fmaxf(mv[4], mv[5]), b67 = fmaxf(mv[6], mv[7]);
                    float best = fmaxf(fmaxf(b01, b23), fmaxf(b45, b67));
                    int bi = 7;
#pragma unroll
                    for (int i = 6; i >= 0; i--) bi = (mv[i] == best) ? i : bi;
                    int bj = (best >= 0.f) ? (4 * (8 * hh + bi) + qq) : 9999;
#define TK_MERGE(ov, oj) { const float v2_ = (ov); const int j2_ = (oj); const bool tk_ = (v2_ > best) || (v2_ == best && j2_ < bj); best = tk_ ? v2_ : best; bj = tk_ ? j2_ : bj; }
                    TK_MERGE(dppf<0xB1>(best), __builtin_amdgcn_update_dpp(0, bj, 0xB1, 0xF, 0xF, true))
                    TK_MERGE(dppf<0x4E>(best), __builtin_amdgcn_update_dpp(0, bj, 0x4E, 0xF, 0xF, true))
                    {
                        auto rv = __builtin_amdgcn_permlane16_swap(__float_as_uint(best), __float_as_uint(best), false, false);
                        auto rj = __builtin_amdgcn_permlane16_swap((unsigned)bj, (unsigned)bj, false, false);
                        float v0 = __uint_as_float(rv[0]), v1 = __uint_as_float(rv[1]); int j0 = (int)rj[0], j1 = (int)rj[1];
                        if (v1 > v0 || (v1 == v0 && j1 < j0)) { v0 = v1; j0 = j1; }
                        rv = __builtin_amdgcn_permlane32_swap(__float_as_uint(v0), __float_as_uint(v0), false, false);
                        rj = __builtin_amdgcn_permlane32_swap((unsigned)j0, (unsigned)j0, false, false);
                        best = __uint_as_float(rv[0]); bj = (int)rj[0];
                        const float v2 = __uint_as_float(rv[1]); const int j2 = (int)rj[1];
                        if (v2 > best || (v2 == best && j2 < bj)) { best = v2; bj = j2; }
                    }
#undef TK_MERGE
                    const bool mine = (bj < 512) && ((bj >> 5) == hh) && ((bj & 3) == qq);
                    const int li = (bj >> 2) & 7;
#pragma unroll
                    for (int i = 0; i < 8; i++) mv[i] = (mine && li == i) ? -1.f : mv[i];
                    if (mine) sel |= (1u << li);
                }
            }
            if (qq == 0 && hh == 0) sel |= 1u;
            if ((cur & 3) == qq && (cur >> 5) == hh) sel |= (1u << ((cur >> 2) & 7));
            if (cur >= 1 && ((cur - 1) & 3) == qq && ((cur - 1) >> 5) == hh) sel |= (1u << (((cur - 1) >> 2) & 7));
            unsigned w = sel << (8 * hh);
            w |= (unsigned)__builtin_amdgcn_update_dpp(0, (int)w, 0xB1, 0xF, 0xF, true);
            w |= (unsigned)__builtin_amdgcn_update_dpp(0, (int)w, 0x4E, 0xF, 0xF, true);
            if (hh == 0) selm[tl[u] * 4 + qq] = w;
        }
        NSA_TE(2)
        NSA_TS(3)
        __syncthreads();
#pragma unroll
        for (int u = 0; u < 2; u++) { NSA_TOK(u) nsa_fold<0>(st[u], T[u], p.nsag[ntk_ * 24 + hd_ * 3 + 0]); }
        {
            const int t2 = get_tid();
#pragma unroll
            for (int i = 0; i < 8; i++) *(f32x4*)&Os[(i * NT + t2) * 4] = f32x4{0.f, 0.f, 0.f, 0.f};
            if (t2 < 256) { Ms[t2] = NEG_BIG; Ls[t2] = 0.f; }
            unsigned long long tm = 0ull; int lrank = 0;
            if (t2 < 128) {
                const int j = t2;
                for (int tk = 0; tk < 64; tk++) tm |= (unsigned long long)((selm[tk * 4 + (j & 3)] >> (j >> 2)) & 1u) << tk;
                if (j > cur) tm = 0ull;
                const unsigned long long bal = __ballot(tm != 0ull);
                lrank = __popcll(bal & ((1ull << (t2 & 63)) - 1ull));
                if ((t2 & 63) == 0) nlistp[t2 >> 6] = __popcll(bal);
            }
            __syncthreads();
            if (t2 < 128 && tm != 0ull) {
                const int pos = lrank + ((t2 >= 64) ? nlistp[0] : 0);
                blist[pos] = t2; lcnt[pos] = __popcll(tm);
                int c = 0;
                while (tm) { lists[pos * 64 + c] = (unsigned char)(__ffsll((long long)tm) - 1); c++; tm &= tm - 1ull; }
            }
            __syncthreads();
        }
        const int nlist = nlistp[0] + nlistp[1];
        NSA_TE(3)
        NSA_TS(4)
        const u16* ksl = p.ksl + (size_t)bg * S_ * 64;
        const u16* vslT = p.vslT + (size_t)bg * 128 * 4096;
        {
            const int t4 = get_tid(), wv4 = __builtin_amdgcn_readfirstlane(t4 >> 6), ts4 = (t4 & 15) >> 2;
            const int td = t4 & 255;
            const int so = (td >> 3) * 64 + (((td & 7) ^ ((td >> 4) & 7)) << 3);
            char* dl = ring + td * 16;
#define NSA_RI(i) (nlist - 1 - (i))
#define NSA_ISSUE2(i, slot) if (wv4 >= 4) { const int jj_ = blist[NSA_RI(i)]; const u16* kp_ = ksl + (size_t)jj_ * 4096 + so; const u16* vp_ = vslT + (size_t)jj_ * 4096 + so; char* d_ = dl + (slot) * 16384; \
                glds16(kp_, d_); glds16(kp_ + 2048, d_ + 4096); glds16(vp_, d_ + 8192); glds16(vp_ + 2048, d_ + 12288); }
            asm volatile("s_waitcnt lgkmcnt(0)" ::: "memory");
            __builtin_amdgcn_s_barrier();
            if (nlist > 0) NSA_ISSUE2(0, 0)
            if (nlist > 1) NSA_ISSUE2(1, 1)
            int jn = 0, nn = 0, tokn = 0;
            if (nlist > 0) { jn = blist[NSA_RI(0)]; nn = lcnt[NSA_RI(0)]; tokn = lists[NSA_RI(0) * 64 + wv4 * 4 + ts4]; }
            int slot = 0;
            for (int i = 0; i < nlist; i++) {
                if (i + 1 < nlist) asm volatile("s_waitcnt vmcnt(4)" ::: "memory"); else asm volatile("s_waitcnt vmcnt(0)" ::: "memory");
                asm volatile("s_waitcnt lgkmcnt(0)" ::: "memory");
                __builtin_amdgcn_s_barrier();
                asm volatile("" ::: "memory");
                const int sl2 = (slot == 0) ? 2 : slot - 1;
                if (i + 2 < nlist) NSA_ISSUE2(i + 2, sl2)
                const int j = jn, n = nn, tok0 = tokn;
                if (i + 1 < nlist) { jn = blist[NSA_RI(i + 1)]; nn = lcnt[NSA_RI(i + 1)]; tokn = lists[NSA_RI(i + 1) * 64 + wv4 * 4 + ts4]; }
                const u16* Ks = (const u16*)(ring + slot * 16384); const u16* Vs = Ks + 4096;
                if ((wv4 + NW) * 4 < n) {
                    const int e1 = (wv4 + NW) * 4 + ts4;
                    const bool vl2[2] = {true, e1 < n};
                    const int tk2[2] = {tok0, vl2[1] ? (int)lists[NSA_RI(i) * 64 + (e1 & 63)] : 0};
                    if (j == cur) nsa_visit_gn<1, false, 2>(Ks, Vs, qs, Os, Ms, Ls, tk2, vl2, t4 & 63);
                    else nsa_visit_gn<0, true, 2>(Ks, Vs, qs, Os, Ms, Ls, tk2, vl2, t4 & 63);
                } else if (wv4 * 4 < n) {
                    const int e = wv4 * 4 + ts4;
                    const bool valid = e < n;
                    const int tok = valid ? tok0 : 0;
                    if (j == cur) nsa_visit_g<1, false>(Ks, Vs, qs, Os, Ms, Ls, tok, valid, t4 & 63);
                    else nsa_visit_g<0, true>(Ks, Vs, qs, Os, Ms, Ls, tok, valid, t4 & 63);
                }
                slot = (slot == 2) ? 0 : slot + 1;
            }
#undef NSA_RI
#undef NSA_ISSUE2
        }
        __syncthreads();
        NSA_TE(4)
        NSA_TS(5)
#pragma unroll
        for (int u = 0; u < 2; u++) {
            NSA_TOK(u)
            const int t5 = t3_ & 63;
            nsa_fold_lds(Os, Ms, Ls, (8 * (t3_ >> 6) + 4 * u + ((t5 & 15) >> 2)) * 4 + (t5 & 3), t5 >> 4, t5 & 3, T[u], p.nsag[ntk_ * 24 + hd_ * 3 + 1], true);
        }
        const u16* kwn = p.kwn + (size_t)bg * S_ * 64;
        const u16* vwnT = p.vwnT + (size_t)bg * 128 * 4096;
        uint2 Tp[2][4];
#pragma unroll
        for (int u = 0; u < 2; u++)
#pragma unroll
            for (int dt = 0; dt < 4; dt++) { Tp[u][dt] = pack4(T[u][dt]); asm volatile("" : "+v"(Tp[u][dt].x), "+v"(Tp[u][dt].y)); }
        {
            const int jlo = max(0, cur - 8);
            nsa_stream<true>(ring, cur - jlo + 1, [&](int i) { return kwn + (size_t)(cur - i) * 4096; }, [&](int i) { return vwnT + (size_t)(cur - i) * 4096; },
                [&](int i, const u16* Ks, const u16* Vs) {
                    const int j = cur - i;
                    const int t4 = get_tid();
                    const int tb_ = 8 * (t4 >> 6) + ((t4 & 15) >> 2);
                    const int tk2[2] = {tb_, tb_ + 4}; const bool vl2[2] = {true, true};
                    if (j == cur) nsa_visit_gn<1, false, 2>(Ks, Vs, qs, Os, Ms, Ls, tk2, vl2, t4 & 63);
                    else if (j == cur - 8) nsa_visit_gn<2, true, 2>(Ks, Vs, qs, Os, Ms, Ls, tk2, vl2, t4 & 63);
                    else nsa_visit_gn<0, true, 2>(Ks, Vs, qs, Os, Ms, Ls, tk2, vl2, t4 & 63);
                });
        }
#pragma unroll
        for (int u = 0; u < 2; u++) {
            NSA_TOK(u)
#pragma unroll
            for (int dt = 0; dt < 4; dt++) T[u][dt] = unpack4(Tp[u][dt]);
            { const int t5 = t3_ & 63; nsa_fold_lds(Os, Ms, Ls, (8 * (t3_ >> 6) + 4 * u + ((t5 & 15) >> 2)) * 4 + (t5 & 3), t5 >> 4, t5 & 3, T[u], p.nsag[ntk_ * 24 + hd_ * 3 + 2], false); }
#pragma unroll
            for (int dt = 0; dt < 4; dt++) *(uint2*)&p.oa[ntk_ * 512 + hd_ * 64 + dt * 16 + ((t3_ & 63) >> 4) * 4] = pack4(T[u][dt]);
        }
        NSA_TE(5)
    }
    if (NSAPROBE) { __syncthreads(); const unsigned long long t1_ = __builtin_amdgcn_s_memrealtime(); while (__builtin_amdgcn_s_memrealtime() - t1_ < tacc_) __builtin_amdgcn_s_sleep(8); }
}

#ifndef CHPROBE
#define CHPROBE 0
#endif
#define CH_TS(k) if (CHPROBE == k) cts_ = __builtin_amdgcn_s_memrealtime();
#define CH_TE(k) if (CHPROBE == k) ctacc_ += __builtin_amdgcn_s_memrealtime() - cts_;
constexpr int RS = 72;
constexpr int RSLOT = 64 * RS;
__device__ __forceinline__ void mm64(const u16* A, int lda, const u16* Bz, int ldb, f32x4 (&acc)[2], int lane, int wv) {
    const int mt = wv >> 1, nt0 = (wv & 1) * 2, kr = lane & 15, qq = lane >> 4;
    bf16x8 a[2], b[2][2];
#pragma unroll
    for (int ks = 0; ks < 2; ks++) {
        a[ks] = *(const bf16x8*)&A[(mt * 16 + kr) * lda + ks * 32 + qq * 8];
#pragma unroll
        for (int i = 0; i < 2; i++) b[ks][i] = *(const bf16x8*)&Bz[((nt0 + i) * 16 + kr) * ldb + ks * 32 + qq * 8];
    }
#pragma unroll
    for (int ks = 0; ks < 2; ks++)
#pragma unroll
        for (int i = 0; i < 2; i++) acc[i] = __builtin_amdgcn_mfma_f32_16x16x32_bf16(a[ks], b[ks][i], acc[i], 0, 0, 0);
}
__device__ __forceinline__ void st_t(u16* dst, int ld, const f32x4& v, int mt, int nt, int lane) {
    uint2 o; o.x = pack2(v[0], v[1]); o.y = pack2(v[2], v[3]);
    *(uint2*)&dst[(nt * 16 + (lane & 15)) * ld + mt * 16 + (lane >> 4) * 4] = o;
}
__device__ __forceinline__ void st_n(u16* dst, int ld, const f32x4& v, int mt, int nt, int lane) {
#pragma unroll
    for (int r = 0; r < 4; r++) dst[(mt * 16 + (lane >> 4) * 4 + r) * ld + nt * 16 + (lane & 15)] = f2bf(v[r]);
}
#define ZACC(a) { a[0] = f32x4{0.f, 0.f, 0.f, 0.f}; a[1] = f32x4{0.f, 0.f, 0.f, 0.f}; }

__device__ void ph_rwkv_chunk(const P& p, int bid, int nb, char* smem) {
    unsigned long long cts_ = 0, ctacc_ = 0;
    u16* sl = (u16*)smem;
    float* tot = (float*)(sl + 14 * RSLOT);
    float* gl = tot + 512;
#define RW_IDX const int tid = get_tid(), lane = tid & 63, wv = tid >> 6, mt = wv >> 1, nt0 = (wv & 1) * 2, kr = lane & 15, qq = lane >> 4; (void)mt; (void)nt0; (void)kr; (void)qq; (void)lane;
    const int nitems = B_ * 128;
    for (int it0 = bid; it0 < nitems; it0 += nb) {
      const int c = it0 & 127, b = it0 >> 7;
      const size_t n0 = (size_t)b * S_ + c * 64;
      __syncthreads();
      bf16x8 xa_[8], wb[2][2], ab[2][2], gb[2][4];
      u16 rc[8][3], rp0[3];
      float w0c[2], a0c[2], hc_[6];
#define S1_LOADW(hh_) { RW_IDX \
          _Pragma("unroll") for (int i = 0; i < 2; i++) { const int cc = (nt0 + i) * 16 + kr; w0c[i] = p.w0[(hh_) * 64 + cc]; a0c[i] = p.a0[(hh_) * 64 + cc]; \
              _Pragma("unroll") for (int ks = 0; ks < 2; ks++) { wb[i][ks] = *(const bf16x8*)&p.w2T[((size_t)(hh_) * 64 + cc) * 64 + ks * 32 + qq * 8]; \
                                                                 ab[i][ks] = *(const bf16x8*)&p.a2T[((size_t)(hh_) * 64 + cc) * 64 + ks * 32 + qq * 8]; } \
              _Pragma("unroll") for (int ks = 0; ks < 4; ks++) gb[i][ks] = *(const bf16x8*)&p.g2T[((size_t)(hh_) * 64 + cc) * 128 + ks * 32 + qq * 8]; } }
#define S2_LOADX(hh_) { RW_IDX const int ch_ = (hh_) * 64 + lane; \
          hc_[0] = p.mu[ch_]; hc_[1] = p.mu[512 + ch_]; hc_[2] = p.mu[1024 + ch_]; hc_[3] = p.k_k[ch_]; hc_[4] = p.k_a[ch_]; hc_[5] = p.r_k[ch_]; \
          _Pragma("unroll") for (int i = 0; i < 8; i++) { const int t = wv * 8 + i; const u16* cr = p.prw + (n0 + t) * CRW; \
              rc[i][0] = cr[ch_]; rc[i][1] = cr[512 + ch_]; rc[i][2] = cr[1024 + ch_]; } \
          rp0[0] = 0; rp0[1] = 0; rp0[2] = 0;     \
          if (c * 64 + wv * 8 > 0) { const u16* pp = p.prw + (n0 + wv * 8 - 1) * CRW; rp0[0] = pp[ch_]; rp0[1] = pp[512 + ch_]; rp0[2] = pp[1024 + ch_]; } }
      S2_LOADX(0)
      {
          RW_IDX
          const int t = tid >> 3, part = tid & 7;
          const size_t n = n0 + t;
          const bool hasprev = (c * 64 + t) > 0;
          u16* dst = p.xact + n * 256 + part * 32;
#pragma unroll
          for (int j = 0; j < 4; j++) {
              const int col = 1536 + part * 32 + j * 8;
              const uint4 cu = *(const uint4*)&p.prw[n * CRW + col];
              uint4 pv = make_uint4(0u, 0u, 0u, 0u);
              if (hasprev) pv = *(const uint4*)&p.prw[(n - 1) * CRW + col];
              const unsigned cw[4] = {cu.x, cu.y, cu.z, cu.w}, pw[4] = {pv.x, pv.y, pv.z, pv.w};
              unsigned ow[4];
#pragma unroll
              for (int e2 = 0; e2 < 4; e2++) {
                  float x0 = __uint_as_float(cw[e2] << 16), x1 = __uint_as_float(cw[e2] & 0xFFFF0000u);
                  const float q0 = __uint_as_float(pw[e2] << 16), q1 = __uint_as_float(pw[e2] & 0xFFFF0000u);
                  x0 = x0 + (q0 - x0) * p.mu[col + 2 * e2]; x1 = x1 + (q1 - x1) * p.mu[col + 2 * e2 + 1];
                  if (part < 2) { x0 = tanhf(x0); x1 = tanhf(x1); }
                  else if (part >= 4) { x0 = sigmoidf_(x0); x1 = sigmoidf_(x1); }
                  ow[e2] = pack2(x0, x1);
              }
              *(uint4*)&dst[j * 8] = make_uint4(ow[0], ow[1], ow[2], ow[3]);
          }
      }
      __syncthreads();
      const u16* xa = p.xact + n0 * 256;
      {
          RW_IDX
#pragma unroll
          for (int k8 = 0; k8 < 8; k8++) xa_[k8] = *(const bf16x8*)&xa[(mt * 16 + kr) * 256 + k8 * 32 + qq * 8];
      }
      S1_LOADW(0)
#pragma unroll 1
      for (int h = 0; h < 8; h++) {
        u16* cd = p.cdat + ((size_t)((b * 8 + h) * 128 + c)) * 4 * 4096;
        LDS_BARRIER();
        CH_TS(1)
        float* LW = (float*)(sl + 8 * RSLOT); float* LA = (float*)(sl + 10 * RSLOT);
        {
            RW_IDX
            f32x4 aw[2], aa2[2], ag[2];
#pragma unroll
            for (int i = 0; i < 2; i++) {
                aw[i] = f32x4{0.f, 0.f, 0.f, 0.f}; aa2[i] = aw[i]; ag[i] = aw[i];
#pragma unroll
                for (int ks = 0; ks < 2; ks++) {
                    aw[i] = __builtin_amdgcn_mfma_f32_16x16x32_bf16(xa_[ks], wb[i][ks], aw[i], 0, 0, 0);
                    aa2[i] = __builtin_amdgcn_mfma_f32_16x16x32_bf16(xa_[2 + ks], ab[i][ks], aa2[i], 0, 0, 0);
                }
#pragma unroll
                for (int ks = 0; ks < 4; ks++) ag[i] = __builtin_amdgcn_mfma_f32_16x16x32_bf16(xa_[4 + ks], gb[i][ks], ag[i], 0, 0, 0);
            }
#pragma unroll
            for (int i = 0; i < 2; i++)
#pragma unroll
                for (int r = 0; r < 4; r++) {
                    const int t = mt * 16 + qq * 4 + r, cc = (nt0 + i) * 16 + kr;
                    const float wl = w0c[i] + aw[i][r];
                    const float z = -wl;
                    const float sp = fmaxf(z, 0.f) + __logf(1.f + __expf(-fabsf(z)));
                    LW[t * 64 + cc] = -__expf(-sp - 0.5f);
                    LA[t * 64 + cc] = sigmoidf_(a0c[i] + aa2[i][r]);
                    p.ob[(n0 + t) * 512 + h * 64 + cc] = f2bf(ag[i][r]);
                }
        }
        LDS_BARRIER();
        CH_TE(1) CH_TS(2)
        {
            RW_IDX
            const int ch = h * 64 + lane;
            const float mur = hc_[0], muk = hc_[1], muv = hc_[2];
            const float kkw = hc_[3], kaw = hc_[4], rkw = hc_[5];
            float rr[8], k2[8], vv[8], kkn[8], aa[8], lg[8], cs[8];
            float run = 0.f;
#pragma unroll
            for (int i = 0; i < 8; i++) {
                const int t = wv * 8 + i; const size_t n = n0 + t;
                float r = bf2f(rc[i][0]), k = bf2f(rc[i][1]), v = bf2f(rc[i][2]);
                const float pr = bf2f(i ? rc[i - 1][0] : rp0[0]), pk = bf2f(i ? rc[i - 1][1] : rp0[1]), pv = bf2f(i ? rc[i - 1][2] : rp0[2]);
                r = r + (pr - r) * mur; k = k + (pk - k) * muk; v = v + (pv - v) * muv;
                const float a = LA[t * 64 + lane];
                lg[i] = LW[t * 64 + lane];
                float kk = k * kkw;
                kkn[i] = kk * __builtin_amdgcn_rsqf(fmaxf(wave_sum(kk * kk), 1e-24f));
                k2[i] = k * (1.f + (a - 1.f) * kaw);
                const float bon = wave_sum(r * k2[i] * rkw);
                if (lane == 0) p.bon[n * 8 + h] = bon;
                rr[i] = r; vv[i] = v; aa[i] = a;
                run += lg[i]; cs[i] = run;
            }
            tot[wv * 64 + lane] = run;
            LDS_BARRIER();
            float off = 0.f, cumL = 0.f;
#pragma unroll
            for (int w2 = 0; w2 < 8; w2++) { const float tv = tot[w2 * 64 + lane]; cumL += tv; if (w2 < wv) off += tv; }
            if (wv == 0) gl[lane] = __expf(cumL);
            unsigned pa[4], pb[4], pk4[4], pv4[4];
#pragma unroll
            for (int i = 0; i < 8; i += 2) {
                float at[2], bt[2], kt[2], rt[2];
#pragma unroll
                for (int e2 = 0; e2 < 2; e2++) {
                    const int ii = i + e2; const int t = wv * 8 + ii;
                    const float cm = off + cs[ii];
                    const float g = __expf(cm), gp = __expf(cm - lg[ii]), gi = __expf(-cm);
                    at[e2] = -kkn[ii] * gp; bt[e2] = kkn[ii] * aa[ii] * gi; kt[e2] = k2[ii] * gi; rt[e2] = rr[ii] * g;
                    sl[0 * RSLOT + t * RS + lane] = f2bf(at[e2]);
                    sl[1 * RSLOT + t * RS + lane] = f2bf(bt[e2]);
                    sl[2 * RSLOT + t * RS + lane] = f2bf(kt[e2]);
                    sl[3 * RSLOT + t * RS + lane] = f2bf(rt[e2]);
                }
                pa[i >> 1] = pack2(at[0], at[1]); pb[i >> 1] = pack2(bt[0], bt[1]);
                pk4[i >> 1] = pack2(kt[0], kt[1]); pv4[i >> 1] = pack2(vv[i], vv[i + 1]);
            }
            *(uint4*)&sl[4 * RSLOT + lane * RS + wv * 8] = make_uint4(pa[0], pa[1], pa[2], pa[3]);
            *(uint4*)&sl[5 * RSLOT + lane * RS + wv * 8] = make_uint4(pb[0], pb[1], pb[2], pb[3]);
            *(uint4*)&sl[6 * RSLOT + lane * RS + wv * 8] = make_uint4(pk4[0], pk4[1], pk4[2], pk4[3]);
            *(uint4*)&sl[7 * RSLOT + lane * RS + wv * 8] = make_uint4(pv4[0], pv4[1], pv4[2], pv4[3]);
        }
        LDS_BARRIER();
        if (h + 1 < 8) { asm volatile("s_waitcnt vmcnt(0)" ::: "memory");
                         S1_LOADW(h + 1) S2_LOADX(h + 1) }
        CH_TE(2) CH_TS(3)
        {
            RW_IDX
            f32x4 acc[2];
            ZACC(acc); mm64(sl + 1 * RSLOT, RS, sl + 0 * RSLOT, RS, acc, lane, wv);
#pragma unroll
            for (int i = 0; i < 2; i++) {
                f32x4 pm;
#pragma unroll
                for (int r = 0; r < 4; r++) {
                    const int m = mt * 16 + qq * 4 + r, n = (nt0 + i) * 16 + kr;
                    if (!(m < n)) acc[i][r] = 0.f;
                    pm[r] = acc[i][r] + ((m == n) ? 1.f : 0.f);
                }
                st_t(sl + 8 * RSLOT, RS, acc[i], mt, nt0 + i, lane);
                st_n(sl + 9 * RSLOT, RS, acc[i], mt, nt0 + i, lane);
                st_t(sl + 13 * RSLOT, RS, pm, mt, nt0 + i, lane);
            }
            ZACC(acc); mm64(sl + 0 * RSLOT, RS, sl + 2 * RSLOT, RS, acc, lane, wv);
#pragma unroll
            for (int i = 0; i < 2; i++) {
#pragma unroll
                for (int r = 0; r < 4; r++) { const int m = mt * 16 + qq * 4 + r, n = (nt0 + i) * 16 + kr; if (!(m > n)) acc[i][r] = 0.f; }
                st_t(sl + 10 * RSLOT, RS, acc[i], mt, nt0 + i, lane);
            }
            ZACC(acc); mm64(sl + 1 * RSLOT, RS, sl + 3 * RSLOT, RS, acc, lane, wv);
#pragma unroll
            for (int i = 0; i < 2; i++) {
#pragma unroll
                for (int r = 0; r < 4; r++) { const int m = mt * 16 + qq * 4 + r, n = (nt0 + i) * 16 + kr; if (m > n) acc[i][r] = 0.f; }
                st_t(sl + 11 * RSLOT, RS, acc[i], mt, nt0 + i, lane);
            }
            ZACC(acc); mm64(sl + 2 * RSLOT, RS, sl + 3 * RSLOT, RS, acc, lane, wv);
#pragma unroll
            for (int i = 0; i < 2; i++) {
#pragma unroll
                for (int r = 0; r < 4; r++) { const int m = mt * 16 + qq * 4 + r, n = (nt0 + i) * 16 + kr; if (m > n) acc[i][r] = 0.f; }
                st_t(sl + 12 * RSLOT, RS, acc[i], mt, nt0 + i, lane);
            }
        }
        LDS_BARRIER();
        CH_TE(3) CH_TS(4)
        u16* X = sl + 8 * RSLOT; u16* XT = sl + 9 * RSLOT; u16* X2 = sl + 0 * RSLOT; u16* X2T = sl + 1 * RSLOT;
        u16* Pc = sl + 13 * RSLOT; u16* Pn = sl + 2 * RSLOT;
#pragma unroll 1
        for (int j = 1; j <= 6; j++) {
            RW_IDX
            f32x4 acc[2];
            if (j <= 5) {
                ZACC(acc); mm64(X, RS, XT, RS, acc, lane, wv);
#pragma unroll
                for (int i = 0; i < 2; i++) { st_t(X2T, RS, acc[i], mt, nt0 + i, lane); st_n(X2, RS, acc[i], mt, nt0 + i, lane); }
            }
            if (j >= 2) {
                ZACC(acc); mm64(XT, RS, Pc, RS, acc, lane, wv);
#pragma unroll
                for (int i = 0; i < 2; i++) {
                    const uint2 pv = *(const uint2*)&Pc[((nt0 + i) * 16 + kr) * RS + mt * 16 + qq * 4];
                    acc[i][0] += __uint_as_float(pv.x << 16); acc[i][1] += __uint_as_float(pv.x & 0xFFFF0000u);
                    acc[i][2] += __uint_as_float(pv.y << 16); acc[i][3] += __uint_as_float(pv.y & 0xFFFF0000u);
                    st_t(Pn, RS, acc[i], mt, nt0 + i, lane);
                }
            }
            LDS_BARRIER();
            if (j >= 2) { u16* tp = Pc; Pc = Pn; Pn = tp; }
            if (j <= 5) { u16* tx = X; X = X2; X2 = tx; tx = XT; XT = X2T; X2T = tx; }
        }
        CH_TE(4) CH_TS(5)
        u16* TT = Pc;
        {
            RW_IDX
            f32x4 acc[2];
            ZACC(acc); mm64(TT, RS, sl + 4 * RSLOT, RS, acc, lane, wv);
#pragma unroll
            for (int i = 0; i < 2; i++) st_t(sl + 0 * RSLOT, RS, acc[i], mt, nt0 + i, lane);
            ZACC(acc); mm64(sl + 10 * RSLOT, RS, TT, RS, acc, lane, wv);
#pragma unroll
            for (int i = 0; i < 2; i++) st_t(sl + 8 * RSLOT, RS, acc[i], mt, nt0 + i, lane);
        }
        LDS_BARRIER();
        {
            RW_IDX
            f32x4 acc[2];
            ZACC(acc); mm64(sl + 8 * RSLOT, RS, sl + 7 * RSLOT, RS, acc, lane, wv);
#pragma unroll
            for (int i = 0; i < 2; i++) st_t(sl + 9 * RSLOT, RS, acc[i], mt, nt0 + i, lane);
            ZACC(acc); mm64(sl + 0 * RSLOT, RS, sl + 5 * RSLOT, RS, acc, lane, wv);
#pragma unroll
            for (int i = 0; i < 2; i++) {
                const int n = (nt0 + i) * 16 + kr; const float gn = gl[n];
#pragma unroll
                for (int r = 0; r < 4; r++) { const int m = mt * 16 + qq * 4 + r; acc[i][r] = acc[i][r] * gn + ((m == n) ? gn : 0.f); }
                st_t(cd, 64, acc[i], mt, nt0 + i, lane);
            }
            ZACC(acc); mm64(sl + 0 * RSLOT, RS, sl + 11 * RSLOT, RS, acc, lane, wv);
#pragma unroll
            for (int i = 0; i < 2; i++) {
                const uint2 rv = *(const uint2*)&sl[3 * RSLOT + ((nt0 + i) * 16 + kr) * RS + mt * 16 + qq * 4];
                acc[i][0] += __uint_as_float(rv.x << 16); acc[i][1] += __uint_as_float(rv.x & 0xFFFF0000u);
                acc[i][2] += __uint_as_float(rv.y << 16); acc[i][3] += __uint_as_float(rv.y & 0xFFFF0000u);
                st_t(cd + 2 * 4096, 64, acc[i], mt, nt0 + i, lane);
            }
        }
        LDS_BARRIER();
        {
            RW_IDX
            f32x4 acc[2];
            ZACC(acc);
            mm64(sl + 5 * RSLOT, RS, sl + 9 * RSLOT, RS, acc, lane, wv);
            mm64(sl + 6 * RSLOT, RS, sl + 7 * RSLOT, RS, acc, lane, wv);
#pragma unroll
            for (int i = 0; i < 2; i++) {
#pragma unroll
                for (int r = 0; r < 4; r++) acc[i][r] *= gl[mt * 16 + qq * 4 + r];
                st_t(cd + 1 * 4096, 64, acc[i], mt, nt0 + i, lane);
            }
            ZACC(acc);
            mm64(sl + 9 * RSLOT, RS, sl + 11 * RSLOT, RS, acc, lane, wv);
            mm64(sl + 7 * RSLOT, RS, sl + 12 * RSLOT, RS, acc, lane, wv);
#pragma unroll
            for (int i = 0; i < 2; i++) st_t(cd + 3 * 4096, 64, acc[i], mt, nt0 + i, lane);
        }
        CH_TE(5)
      }
    }
    if (CHPROBE) { __syncthreads(); const unsigned long long t1_ = __builtin_amdgcn_s_memrealtime(); while (__builtin_amdgcn_s_memrealtime() - t1_ < ctacc_) __builtin_amdgcn_s_sleep(8); }
}

__device__ void ph_rwkv_seq(const P& p, int bid, int nb, char* smem) {
    u16* SL = (u16*)smem;
    const int tid = get_tid(), lane = tid & 63, wv = __builtin_amdgcn_readfirstlane(tid >> 6);
    const int kr = lane & 15, qq = lane >> 4, chn = wv >> 2, vt = wv & 3;
    for (int pair = bid; pair < B_ * 4; pair += nb) {
        const int bh = pair * 2 + chn;
        u16* mySL = SL + chn * RSLOT;
        __syncthreads();
#pragma unroll
        for (int ks = 0; ks < 2; ks++) *(uint4*)&mySL[(vt * 16 + kr) * RS + ks * 32 + qq * 8] = make_uint4(0u, 0u, 0u, 0u);
        u16* cbase = p.cdat + (size_t)bh * 128 * 4 * 4096;
        bf16x8 GA0[4][2], GA1[4][2], GA2[4][2], GA3[4][2]; u32x2 H0[4], H1[4], H2[4], H3[4];
#define SEQ_LD(GAx, Hx, c) { const u16* g0_ = cbase + (size_t)(c) * 4 * 4096 + kr * 64 + qq * 8; const u16* g1_ = g0_ + 2048; \
            const u16* hp_ = cbase + (size_t)(c) * 4 * 4096 + 4096 + (vt * 16 + kr) * 64 + qq * 4; \
            GAx[0][0] = gload_b128<0>(g0_); GAx[0][1] = gload_b128<64>(g0_); GAx[1][0] = gload_b128<2048>(g0_); GAx[1][1] = gload_b128<2112>(g0_); \
            GAx[2][0] = gload_b128<0>(g1_); GAx[2][1] = gload_b128<64>(g1_); GAx[3][0] = gload_b128<2048>(g1_); GAx[3][1] = gload_b128<2112>(g1_); \
            Hx[0] = gload_b64<0>(hp_); Hx[1] = gload_b64<32>(hp_); Hx[2] = gload_b64<64>(hp_); Hx[3] = gload_b64<96>(hp_); }
#define SEQ_STEP(GAx, Hx, c, nw) { \
            if ((nw) == 48) asm volatile("s_waitcnt vmcnt(48)" ::: "memory"); else if ((nw) == 36) asm volatile("s_waitcnt vmcnt(36)" ::: "memory"); \
            else if ((nw) == 24) asm volatile("s_waitcnt vmcnt(24)" ::: "memory"); else asm volatile("s_waitcnt vmcnt(12)" ::: "memory"); \
              \
            asm volatile("" : "+v"(GAx[0][0]), "+v"(GAx[0][1]), "+v"(GAx[1][0]), "+v"(GAx[1][1]), "+v"(GAx[2][0]), "+v"(GAx[2][1]), "+v"(GAx[3][0]), "+v"(GAx[3][1]), \
                              "+v"(Hx[0]), "+v"(Hx[1]), "+v"(Hx[2]), "+v"(Hx[3]) :: "memory"); \
            bf16x8 Z0[2]; \
            _Pragma("unroll") for (int ks = 0; ks < 2; ks++) Z0[ks] = *(const bf16x8*)&mySL[(vt * 16 + kr) * RS + ks * 32 + qq * 8]; \
            f32x4 zs[4]; \
            _Pragma("unroll") for (int m4 = 0; m4 < 4; m4++) { \
                zs[m4] = unpack4(make_uint2(Hx[m4].x, Hx[m4].y)); \
                _Pragma("unroll") for (int ks = 0; ks < 2; ks++) zs[m4] = __builtin_amdgcn_mfma_f32_16x16x32_bf16(GAx[m4][ks], Z0[ks], zs[m4], 0, 0, 0); } \
            u16* sn_ = cbase + (size_t)(c) * 4 * 4096 + 1 * 4096 + (vt * 16 + kr) * 64 + qq * 4; \
            _Pragma("unroll") for (int m4 = 0; m4 < 4; m4++) { \
                const uint2 pk_ = pack4(zs[m4]); \
                *(uint2*)&mySL[(vt * 16 + kr) * RS + m4 * 16 + qq * 4] = pk_; \
                *(uint2*)&sn_[m4 * 16] = pk_; } \
            asm volatile("" ::: "memory"); \
            if ((c) + 4 < 128) SEQ_LD(GAx, Hx, (c) + 4) }
        asm volatile("s_waitcnt vmcnt(0)" ::: "memory");
        SEQ_LD(GA0, H0, 0) SEQ_LD(GA1, H1, 1) SEQ_LD(GA2, H2, 2) SEQ_LD(GA3, H3, 3)
#pragma unroll 1
        for (int c = 0; c < 128; c += 4) {
            const bool first = (c == 0), lastt = (c == 124);
            SEQ_STEP(GA0, H0, c, first ? 36 : 48)
            SEQ_STEP(GA1, H1, c + 1, (first || lastt) ? 36 : 48)
            SEQ_STEP(GA2, H2, c + 2, first ? 36 : (lastt ? 24 : 48))
            SEQ_STEP(GA3, H3, c + 3, lastt ? 12 : 48)
        }
        asm volatile("s_waitcnt vmcnt(0)" ::: "memory");
#undef SEQ_LD
#undef SEQ_STEP
    }
}

__device__ void ph_rwkv_out(const P& p, int bid, int nb, char* smem) {
    const int tid = get_tid(), lane = tid & 63, wv = tid >> 6;
    const int kr = lane & 15, qq = lane >> 4;
    for (int it = bid * NW + wv; it < B_ * 8 * 128; it += nb * NW) {
        const int c = it & 127, bh = it >> 7, b = bh >> 3, h = bh & 7;
        const u16* cd = p.cdat + ((size_t)bh * 128 + c) * 4 * 4096;
        f32x4 ys[4][4];
#pragma unroll
        for (int mt = 0; mt < 4; mt++)
#pragma unroll
            for (int nt = 0; nt < 4; nt++) ys[mt][nt] = unpack4(*(const uint2*)&cd[3 * 4096 + (nt * 16 + kr) * 64 + mt * 16 + qq * 4]);
        if (c > 0) {
            const u16* s0 = cd - 4 * 4096 + 1 * 4096;
#pragma unroll
            for (int ks = 0; ks < 2; ks++) {
                bf16x8 af[4], bq[4];
#pragma unroll
                for (int mt = 0; mt < 4; mt++) af[mt] = *(const bf16x8*)&s0[(mt * 16 + kr) * 64 + ks * 32 + qq * 8];
#pragma unroll
                for (int nt = 0; nt < 4; nt++) bq[nt] = *(const bf16x8*)&cd[2 * 4096 + (nt * 16 + kr) * 64 + ks * 32 + qq * 8];
#pragma unroll
                for (int mt = 0; mt < 4; mt++)
#pragma unroll
                    for (int nt = 0; nt < 4; nt++) ys[mt][nt] = __builtin_amdgcn_mfma_f32_16x16x32_bf16(af[mt], bq[nt], ys[mt][nt], 0, 0, 0);
            }
        }
#pragma unroll
        for (int nt = 0; nt < 4; nt++) {
            float s1 = 0.f, s2 = 0.f;
#pragma unroll
            for (int mt = 0; mt < 4; mt++)
#pragma unroll
                for (int r = 0; r < 4; r++) { s1 += ys[mt][nt][r]; s2 += ys[mt][nt][r] * ys[mt][nt][r]; }
            s1 = xrow_sum(s1); s2 = xrow_sum(s2);
            const float mean = s1 * (1.f / 64.f);
            const float var = fmaxf(s2 * (1.f / 64.f) - mean * mean, 0.f);
            const float rstd = rsqrtf(var + 64e-5f);
            const int t = nt * 16 + kr;
            const size_t n = (size_t)b * S_ + c * 64 + t;
            const float bon = p.bon[n * 8 + h];
#pragma unroll
            for (int mt = 0; mt < 4; mt++) {
                const int vch = h * 64 + mt * 16 + qq * 4;
                const f32x4 vcf = unpack4(*(const uint2*)&p.prw[n * CRW + 1024 + vch]);
                const f32x4 vpf = (c * 64 + t > 0) ? unpack4(*(const uint2*)&p.prw[(n - 1) * CRW + 1024 + vch]) : f32x4{0.f, 0.f, 0.f, 0.f};
                const f32x4 ggf = unpack4(*(const uint2*)&p.ob[n * 512 + vch]);
                const float4 lw = *(const float4*)&p.ln_w[vch], lb = *(const float4*)&p.ln_b[vch], mv = *(const float4*)&p.mu[1024 + vch];
                const float lwa[4] = {lw.x, lw.y, lw.z, lw.w}, lba[4] = {lb.x, lb.y, lb.z, lb.w}, mva[4] = {mv.x, mv.y, mv.z, mv.w};
                f32x4 o;
#pragma unroll
                for (int r = 0; r < 4; r++) {
                    const float vsh = vcf[r] + (vpf[r] - vcf[r]) * mva[r];
                    o[r] = ((ys[mt][nt][r] - mean) * rstd * lwa[r] + lba[r] + bon * vsh) * ggf[r];
                }
                *(uint2*)&p.ob[n * 512 + vch] = pack4(o);
            }
        }
    }
}

__device__ __forceinline__ void unpack8(const uint4& u, f32x4& a, f32x4& b) {
    a = f32x4{__uint_as_float(u.x << 16), __uint_as_float(u.x & 0xFFFF0000u), __uint_as_float(u.y << 16), __uint_as_float(u.y & 0xFFFF0000u)};
    b = f32x4{__uint_as_float(u.z << 16), __uint_as_float(u.z & 0xFFFF0000u), __uint_as_float(u.w << 16), __uint_as_float(u.w & 0xFFFF0000u)};
}
struct EpiMerge {
    u16* merged; u16* tmp2; int pass;
    __device__ __forceinline__ void operator()(const f32x4 (&acc)[2][2][4][2], const GUnit& u, int, int, int, int) const {
        const int t2_ = get_tid(), wid_ = __builtin_amdgcn_readfirstlane(t2_ >> 6), wr = wid_ >> 2, wc = wid_ & 3, fr = t2_ & 15, fq = (t2_ >> 4) & 3;
        const int row0 = u.pm * 256 + wr * 64 + fr;
        if (pass < 2) {
            u16* dst = pass ? tmp2 : merged;
            const int col0 = u.pn * 256 + wc * 32 + 8 * fq;
#pragma unroll
            for (int ai = 0; ai < 2; ++ai)
#pragma unroll
                for (int m = 0; m < 4; ++m) {
                    const size_t off = (size_t)(row0 + ai * 128 + m * 16) * D_ + col0;
#pragma unroll
                    for (int bj = 0; bj < 2; ++bj) *(uint4*)&dst[off + bj * 128] = pack8(acc[ai][bj][m][0], acc[ai][bj][m][1]);
                }
        } else {
            const int col0 = u.pn * 128 + wc * 32 + 8 * fq;
#pragma unroll
            for (int ai = 0; ai < 2; ++ai)
#pragma unroll
                for (int m = 0; m < 4; ++m) {
                    const size_t off = (size_t)(row0 + ai * 128 + m * 16) * D_ + col0;
                    const uint4 ma = *(const uint4*)&merged[off], mb = *(const uint4*)&tmp2[off];
                    f32x4 a0, a1, b0, b1; unpack8(ma, a0, a1); unpack8(mb, b0, b1);
                    f32x4 v0, v1;
#pragma unroll
                    for (int r = 0; r < 4; r++) {
                        v0[r] = a0[r] * sigmoidf_(acc[ai][0][m][0][r]) + b0[r] * sigmoidf_(acc[ai][1][m][0][r]);
                        v1[r] = a1[r] * sigmoidf_(acc[ai][0][m][1][r]) + b1[r] * sigmoidf_(acc[ai][1][m][1][r]);
                    }
                    *(uint4*)&merged[off] = pack8(v0, v1);
                    asm volatile("" ::: "memory");
                }
        }
    }
};
struct MergeSched {
    DenseSched d; bool split;
    __device__ __forceinline__ bool next(int i, GUnit& u) const {
        if (!split) return d.next(i, u);
        if (!d.next(i >> 1, u)) return false;
        u.pn = 2 * u.pn + (i & 1); return true;
    }
    __device__ __forceinline__ unsigned a_off(const GUnit& u, int h, int R) const { return d.a_off(u, h, R); }
    __device__ __forceinline__ const char* b_ptr(const GUnit& u) const { return d.b_ptr(u); }
};
__device__ void ph_merge(const P& p, int bid, int nb, char* smem) {
    u16* tmp2 = (u16*)p.x1;
#pragma unroll 1
    for (int pass = 0; pass < 3; ++pass) {
        const int K = (pass == 2) ? D_ : 512;
        const u16* A = (pass == 2) ? p.hbuf : (pass == 0 ? p.oa : p.ob);
        const u16* Bt = (pass == 0) ? p.wpaT : (pass == 1 ? p.wpbT : p.wgT);
        MergeSched S; S.d.init(NTOK, D_, K, Bt, nb, bid); S.split = (pass == 2);
        EpiMerge E{p.merged, tmp2, pass};
        gemm256(smem, (const char*)A, K, S, E);
    }
}

struct EpiOutproj {
    const float* x; float* x1;
    __device__ __forceinline__ void operator()(const f32x4 (&acc)[2][2][4][2], const GUnit& u, int, int, int, int) const {
        const int t2_ = get_tid(), wid_ = __builtin_amdgcn_readfirstlane(t2_ >> 6), wr = wid_ >> 2, wc = wid_ & 3, fr = t2_ & 15, fq = (t2_ >> 4) & 3;
        const int row0 = u.pm * 256 + wr * 64 + fr, col0 = u.pn * 256 + wc * 32 + 4 * fq;
#pragma unroll
        for (int ai = 0; ai < 2; ++ai)
#pragma unroll
            for (int m = 0; m < 4; ++m) {
                const size_t off = (size_t)(row0 + ai * 128 + m * 16) * D_ + col0;
                f32x4 xin[2][2];
#pragma unroll
                for (int bj = 0; bj < 2; ++bj)
#pragma unroll
                    for (int n = 0; n < 2; ++n) xin[bj][n] = *(const f32x4*)&x[off + bj * 128 + n * 16];
#pragma unroll
                for (int bj = 0; bj < 2; ++bj)
#pragma unroll
                    for (int n = 0; n < 2; ++n) *(f32x4*)&x1[off + bj * 128 + n * 16] = xin[bj][n] + acc[ai][bj][m][n];
                asm volatile("" ::: "memory");
            }
    }
};
__device__ void ph_outproj(const P& p, int bid, int nb, char* smem) {
    DenseSched S; S.init(NTOK, D_, D_, p.woutT, nb, bid);
    EpiOutproj E{p.x, p.x1};
    gemm256(smem, (const char*)p.merged, D_, S, E);
}

__device__ __forceinline__ float red8f(float x) {
    x += dppf<0xB1>(x);
    x += dppf<0x4E>(x);
    x += dppf<0x141>(x);
    return x;
}
__device__ void ph_route(const P& p, int bid, int nb, char* smem) {
    float* wr = (float*)smem;
    const int tid = get_tid(), lane = tid & 63, wv = tid >> 6;
    {
        u16* Tl = (u16*)smem;
        const int t = get_tid();
        const int lrow = t >> 3, lc8 = (t & 7) * 8;
        const int sslot = t >> 3, skc = t & 7;
        const int scol = (sslot & 32) + perm32(sslot & 31);
        constexpr int NT13 = NEXP * 2 * 4 * 16, NT2 = NEXP * 16 * 4;
        for (int tile = bid; tile < NT13 + NT2; tile += nb) {
            const float* src; u16* dst; int N, Kd;
            if (tile < NT13) {
                const int kt = tile & 15, sg = (tile >> 4) & 3, half = (tile >> 6) & 1, e = tile >> 7;
                const int sl0 = sg * 64;
                N = 256; Kd = D_;
                src = ((sl0 >> 7) ? p.e_w3 : p.e_w1) + (size_t)e * D_ * 256 + (size_t)(kt * 64) * 256 + half * 128 + (sl0 & 127);
                dst = p.ew1T + ((size_t)e * 512 + half * 256 + sl0) * D_ + kt * 64;
            } else {
                const int t2 = tile - NT13;
                const int kt = t2 & 3, sg = (t2 >> 2) & 15, e = t2 >> 6;
                N = D_; Kd = 256;
                src = p.e_w2 + (size_t)e * 256 * D_ + (size_t)(kt * 64) * D_ + sg * 64;
                dst = p.ew2T + ((size_t)e * D_ + sg * 64) * 256 + kt * 64;
            }
            const float4 f0 = *(const float4*)&src[(size_t)lrow * N + lc8], f1 = *(const float4*)&src[(size_t)lrow * N + lc8 + 4];
            __syncthreads();
            const unsigned h0 = pack2(f0.x, f0.y), h1 = pack2(f0.z, f0.w), h2 = pack2(f1.x, f1.y), h3 = pack2(f1.z, f1.w);
            Tl[(lc8 + 0) * 72 + lrow] = (u16)(h0 & 0xFFFFu); Tl[(lc8 + 1) * 72 + lrow] = (u16)(h0 >> 16);
            Tl[(lc8 + 2) * 72 + lrow] = (u16)(h1 & 0xFFFFu); Tl[(lc8 + 3) * 72 + lrow] = (u16)(h1 >> 16);
            Tl[(lc8 + 4) * 72 + lrow] = (u16)(h2 & 0xFFFFu); Tl[(lc8 + 5) * 72 + lrow] = (u16)(h2 >> 16);
            Tl[(lc8 + 6) * 72 + lrow] = (u16)(h3 & 0xFFFFu); Tl[(lc8 + 7) * 72 + lrow] = (u16)(h3 >> 16);
            __syncthreads();
            *(uint4*)&dst[(size_t)sslot * Kd + skc * 8] = *(const uint4*)&Tl[scol * 72 + skc * 8];
        }
        __syncthreads();
    }
    for (int i = tid; i < 1024 * 36; i += NT) {
        const int k = i / 36, j = i - k * 36;
        const int kp = (k & ~31) + ((k & 3) << 3) + ((k >> 2) & 7);
        wr[kp * 36 + j] = (j < 4) ? p.w_grp[k * 4 + j] : p.w_exp[k * 32 + (j - 4)];
    }
    int* lcount = (int*)(smem + 1024 * 36 * 4);
    if (tid < 32) lcount[tid] = 0;
    __syncthreads();
    const int sub = lane & 7, tk = lane >> 3;
    for (int n0 = (bid * NW + wv) * 16; n0 < NTOK; n0 += nb * NW * 16) {
        float acc[2][36]; float ss[2] = {0.f, 0.f};
#pragma unroll
        for (int t = 0; t < 2; t++)
#pragma unroll
            for (int j = 0; j < 36; j++) acc[t][j] = 0.f;
#pragma unroll 1
        for (int i0 = 0; i0 < 32; i0 += 4) {
            float4 xv[2][4];
#pragma unroll
            for (int t = 0; t < 2; t++)
#pragma unroll
                for (int i = 0; i < 4; i++) xv[t][i] = *(const float4*)&p.x1[(size_t)(n0 + 8 * t + tk) * D_ + (i0 + i) * 32 + sub * 4];
#pragma unroll
            for (int i = 0; i < 4; i++) {
                const int k0 = (i0 + i) * 32 + sub * 4;
                const float4 gf = *(const float4*)&p.g_ffn[k0];
                float hv[2][4];
#pragma unroll
                for (int t = 0; t < 2; t++) {
                    const float4 x = xv[t][i];
                    ss[t] += x.x * x.x + x.y * x.y + x.z * x.z + x.w * x.w;
                    hv[t][0] = x.x * gf.x; hv[t][1] = x.y * gf.y; hv[t][2] = x.z * gf.z; hv[t][3] = x.w * gf.w;
                    uint2 o; o.x = pack2(hv[t][0], hv[t][1]); o.y = pack2(hv[t][2], hv[t][3]);
                    *(uint2*)&p.hbuf[(size_t)(n0 + 8 * t + tk) * D_ + k0] = o;
                }
#pragma unroll
                for (int e2 = 0; e2 < 4; e2++) {
                    asm volatile("" ::: "memory");
                    const float* wrow = wr + ((i0 + i) * 32 + e2 * 8 + sub) * 36;
#pragma unroll
                    for (int j4 = 0; j4 < 9; j4++) {
                        const float4 wv4 = *(const float4*)&wrow[j4 * 4];
#pragma unroll
                        for (int t = 0; t < 2; t++) {
                            acc[t][j4 * 4 + 0] += hv[t][e2] * wv4.x; acc[t][j4 * 4 + 1] += hv[t][e2] * wv4.y;
                            acc[t][j4 * 4 + 2] += hv[t][e2] * wv4.z; acc[t][j4 * 4 + 3] += hv[t][e2] * wv4.w;
                        }
                    }
                }
            }
        }
#pragma unroll
        for (int t = 0; t < 2; t++) {
            const size_t n = (size_t)n0 + 8 * t + tk;
            const float sst = red8f(ss[t]);
#pragma unroll
            for (int j = 0; j < 36; j++) acc[t][j] = red8f(acc[t][j]);
            const float rs = rsqrtf(sst * (1.f / D_) + 1e-6f);
            if (sub == 0) {
                p.rsb[n] = rs;
                float gl[4]; int gs = 0;
#pragma unroll
                for (int j = 0; j < 4; j++) gl[j] = acc[t][j] * rs + p.b_grp[j];
                float gm = gl[0];
#pragma unroll
                for (int j = 1; j < 4; j++) if (gl[j] > gm) { gm = gl[j]; gs = j; }
                float gsum = 0.f;
#pragma unroll
                for (int j = 0; j < 4; j++) gsum += __expf(gl[j] - gm);
                const float pg = 1.f / gsum;
                float el[8]; float em = -3.0e38f;
#pragma unroll
                for (int j = 0; j < 8; j++) {
                    float a = (gs == 0) ? acc[t][4 + j] : ((gs == 1) ? acc[t][12 + j] : ((gs == 2) ? acc[t][20 + j] : acc[t][28 + j]));
                    a = a * rs + p.b_exp[gs * 8 + j];
                    el[j] = a; em = fmaxf(em, a);
                }
                int j0 = 0, j1 = -1; float v0 = -3.0e38f, v1 = -3.0e38f;
#pragma unroll
                for (int j = 0; j < 8; j++) { el[j] = __expf(el[j] - em); }
#pragma unroll
                for (int j = 0; j < 8; j++) { if (el[j] > v0) { v0 = el[j]; j0 = j; } }
#pragma unroll
                for (int j = 0; j < 8; j++) { if (j != j0 && el[j] > v1) { v1 = el[j]; j1 = j; } }
                const float den = v0 + v1;
                const int e0 = gs * 8 + j0, e1 = gs * 8 + j1;
                p.tok_e[n * 2] = e0; p.tok_e[n * 2 + 1] = e1;
                p.tok_gate[n * 2] = pg * v0 / den; p.tok_gate[n * 2 + 1] = pg * v1 / den;
                atomicAdd(&lcount[e0], 1); atomicAdd(&lcount[e1], 1);
            }
        }
    }
    __syncthreads();
    { const int t2 = get_tid(); if (t2 < 32) { const int c = lcount[t2]; if (c) atomicAdd(&p.counts[t2], c); } }
}

__device__ void ph_scatter(const P& p, int bid, int nb, char* smem) {
    int* offl = (int*)smem;
    int* hist = offl + 64;
    int* gbase = hist + 32;
    const int tid = get_tid();
    if (tid == 0) {
        int off = 0;
        for (int e = 0; e < NEXP; e++) { offl[e] = off; off += p.counts[e]; }
        offl[NEXP] = off;
    }
    if (bid == 0 && tid == 64) {
        int off = 0, nb_ = 0;
        for (int e = 0; e < NEXP; e++) {
            const int c = p.counts[e];
            p.offs[e] = off;
            for (int r = 0; r < c; r += 256) { p.blk_e[nb_] = e; p.blk_r0[nb_] = off + r; nb_++; }
            off += c;
        }
        p.offs[NEXP] = off;
        *p.nblk = nb_;
    }
    for (int base = bid * NT; base < NTOK * 2; base += nb * NT) {
        __syncthreads();
        if (tid < 32) hist[tid] = 0;
        __syncthreads();
        const int i = base + tid;
        const int e = p.tok_e[i];
        const int rl = atomicAdd(&hist[e], 1);
        __syncthreads();
        if (tid < 32) gbase[tid] = atomicAdd(&p.cursor[tid], hist[tid]);
        __syncthreads();
        const int slot = offl[e] + gbase[e] + rl;
        p.list_tok[slot] = i >> 1; p.list_gate[slot] = p.tok_gate[i]; p.tokslot[i] = slot;
    }
}
template <int CTS>
struct MoeSched {
    const P* pp; int nunits, G, c; unsigned rowbytes; const u16* Bt; size_t b_estride, b_tstride;
    bool gather;
    __device__ __forceinline__ bool next(int i, GUnit& u) const {
        const int L = i * G + c; if (L >= nunits) return false;
        int wgid = L; { const int q = nunits >> 3, r = nunits & 7, xcd = wgid & 7, off = wgid >> 3; wgid = (xcd < r ? xcd * (q + 1) : r * (q + 1) + (xcd - r) * q) + off; }
        u.pm = wgid / CTS; u.pn = wgid & (CTS - 1); return true;
    }
    __device__ __forceinline__ unsigned a_off(const GUnit& u, int h, int R) const {
        const P& p = *pp;
        const int e = __builtin_amdgcn_readfirstlane(p.blk_e[u.pm]), rend = __builtin_amdgcn_readfirstlane(p.offs[e + 1]);
        int sl = __builtin_amdgcn_readfirstlane(p.blk_r0[u.pm]) + h * 128 + R; if (sl >= rend) sl = rend - 1;
        return (unsigned)(gather ? p.list_tok[sl] : sl) * rowbytes;
    }
    __device__ __forceinline__ const char* b_ptr(const GUnit& u) const { return (const char*)(Bt + (size_t)__builtin_amdgcn_readfirstlane(pp->blk_e[u.pm]) * b_estride + (size_t)u.pn * b_tstride); }
};
struct EpiMoe1 {
    const P* pp;
    __device__ __forceinline__ void operator()(const f32x4 (&acc)[2][2][4][2], const GUnit& u, int, int, int, int) const {
        const int t2_ = get_tid(), wid_ = __builtin_amdgcn_readfirstlane(t2_ >> 6), wr = wid_ >> 2, wc = wid_ & 3, fr = t2_ & 15, fq = (t2_ >> 4) & 3;
        const P& p = *pp;
        const int e = __builtin_amdgcn_readfirstlane(p.blk_e[u.pm]), r0 = __builtin_amdgcn_readfirstlane(p.blk_r0[u.pm]), rend = __builtin_amdgcn_readfirstlane(p.offs[e + 1]);
#pragma unroll
        for (int ai = 0; ai < 2; ++ai)
#pragma unroll
            for (int m = 0; m < 4; ++m) {
                const int sl = r0 + ai * 128 + wr * 64 + m * 16 + fr;
                if (sl < rend) {
                    const float rs = p.rsb[p.list_tok[sl]];
                    f32x4 v[2];
#pragma unroll
                    for (int n = 0; n < 2; ++n)
#pragma unroll
                        for (int r = 0; r < 4; r++) { const float a = acc[ai][0][m][n][r] * rs; v[n][r] = a * sigmoidf_(a) * (acc[ai][1][m][n][r] * rs); }
                    *(uint4*)&p.hid[(size_t)sl * 256 + u.pn * 128 + wc * 32 + 8 * fq] = pack8(v[0], v[1]);
                }
            }
    }
};
__device__ void ph_moe1(const P& p, int bid, int nb, char* smem) {
    MoeSched<2> S{&p, __builtin_amdgcn_readfirstlane(*p.nblk) * 2, nb, bid, (unsigned)(D_ * 2), p.ew1T, (size_t)512 * D_, (size_t)256 * D_, true};
    EpiMoe1 E{&p};
    gemm256(smem, (const char*)p.hbuf, D_, S, E);
}
struct EpiMoe2 {
    const P* pp;
    __device__ __forceinline__ void operator()(const f32x4 (&acc)[2][2][4][2], const GUnit& u, int, int, int, int) const {
        const int t2_ = get_tid(), wid_ = __builtin_amdgcn_readfirstlane(t2_ >> 6), wr = wid_ >> 2, wc = wid_ & 3, fr = t2_ & 15, fq = (t2_ >> 4) & 3;
        const P& p = *pp;
        const int e = __builtin_amdgcn_readfirstlane(p.blk_e[u.pm]), r0 = __builtin_amdgcn_readfirstlane(p.blk_r0[u.pm]), rend = __builtin_amdgcn_readfirstlane(p.offs[e + 1]);
#pragma unroll
        for (int ai = 0; ai < 2; ++ai)
#pragma unroll
            for (int m = 0; m < 4; ++m) {
                const int sl = r0 + ai * 128 + wr * 64 + m * 16 + fr;
                if (sl < rend) {
                    const float gt = p.list_gate[sl];
                    u16* yp = p.ybuf + (size_t)sl * D_ + u.pn * 256 + wc * 32 + 8 * fq;
#pragma unroll
                    for (int bj = 0; bj < 2; ++bj) *(uint4*)&yp[bj * 128] = pack8(acc[ai][bj][m][0] * gt, acc[ai][bj][m][1] * gt);
                }
            }
    }
};
__device__ void ph_moe2(const P& p, int bid, int nb, char* smem) {
    MoeSched<4> S{&p, __builtin_amdgcn_readfirstlane(*p.nblk) * 4, nb, bid, 512u, p.ew2T, (size_t)D_ * 256, (size_t)256 * 256, false};
    EpiMoe2 E{&p};
    gemm256(smem, (const char*)p.hid, 256, S, E);
}
__device__ void ph_final(const P& p, int bid, int nb, char* smem) {
    const int tid = get_tid(), lane = tid & 63, wv = tid >> 6;
    for (int row = bid * NW + wv; row < NTOK; row += nb * NW) {
        const int s0 = p.tokslot[row * 2], s1 = p.tokslot[row * 2 + 1];
        float v[16]; float ss = 0.f;
#pragma unroll
        for (int i = 0; i < 4; i++) {
            const int c = i * 256 + lane * 4;
            const float4 t = *(const float4*)&p.x1[(size_t)row * D_ + c];
            const uint2 a = *(const uint2*)&p.ybuf[(size_t)s0 * D_ + c];
            const uint2 bq = *(const uint2*)&p.ybuf[(size_t)s1 * D_ + c];
            v[4 * i]     = t.x + __uint_as_float(a.x << 16) + __uint_as_float(bq.x << 16);
            v[4 * i + 1] = t.y + __uint_as_float(a.x & 0xFFFF0000u) + __uint_as_float(bq.x & 0xFFFF0000u);
            v[4 * i + 2] = t.z + __uint_as_float(a.y << 16) + __uint_as_float(bq.y << 16);
            v[4 * i + 3] = t.w + __uint_as_float(a.y & 0xFFFF0000u) + __uint_as_float(bq.y & 0xFFFF0000u);
            ss += v[4 * i] * v[4 * i] + v[4 * i + 1] * v[4 * i + 1] + v[4 * i + 2] * v[4 * i + 2] + v[4 * i + 3] * v[4 * i + 3];
        }
        ss = wave_sum(ss);
        const float rs = rsqrtf(ss * (1.f / D_) + 1e-6f);
#pragma unroll
        for (int i = 0; i < 4; i++) {
            const int c = i * 256 + lane * 4;
            const float4 g = *(const float4*)&p.g_final[c];
            float4 o; o.x = v[4 * i] * rs * g.x; o.y = v[4 * i + 1] * rs * g.y; o.z = v[4 * i + 2] * rs * g.z; o.w = v[4 * i + 3] * rs * g.w;
            *(float4*)&p.out[(size_t)row * D_ + c] = o;
        }
    }
}

#define XB_TMO      128
#define XB_XCNT(j)  (256  + 64 * (j))
#define XB_XSUB(j)  (1280 + 64 * (j))
#define XB_XGEN(j)  (2304 + 64 * (j))
#define XB_TOP      3328
#define XB_TOPGEN   3392
#define XCD_BAR_WORDS 3456
#define XB_SPIN_CAP (1u << 18)
#define LAS __attribute__((address_space(3)))

__device__ __forceinline__ unsigned xb_ld(unsigned* p)              { return __hip_atomic_load(p, __ATOMIC_RELAXED, __HIP_MEMORY_SCOPE_AGENT); }
__device__ __forceinline__ unsigned xb_add(unsigned* p, unsigned v) { return __hip_atomic_fetch_add(p, v, __ATOMIC_RELAXED, __HIP_MEMORY_SCOPE_AGENT); }
__device__ __forceinline__ unsigned xb_xcc_id() { return (unsigned)__builtin_amdgcn_s_getreg((3 << 11) | 20) & 0xFu; }
#define XB_SPIN(cond, bar) do { unsigned _sp = 0; while (cond) { __builtin_amdgcn_s_sleep(1); \
    if ((++_sp & 255u) == 0u) { if (xb_ld(&(bar)[XB_TMO])) break; if (_sp > XB_SPIN_CAP) { atomicAdd(&(bar)[XB_TMO], 1u); break; } } } } while (0)

struct XcdBarrier {
    unsigned* bar; unsigned x;
    volatile LAS unsigned* st;
};

__device__ __forceinline__ XcdBarrier xcd_barrier_post(unsigned* bar, volatile LAS unsigned* st) {
    XcdBarrier b; b.bar = bar; b.x = xb_xcc_id(); b.st = st;
    if (threadIdx.x == 0) (void)xb_add(&bar[XB_XCNT(b.x)], 1u);
    return b;
}
__device__ __forceinline__ void xcd_barrier_complete(unsigned* bar, unsigned x, unsigned& nloc, unsigned& nx) {
    const unsigned G = gridDim.x * gridDim.y * gridDim.z;
    unsigned sum, cnt, mine, sp = 0u;
    for (;;) {
        sum = 0u; cnt = 0u; mine = 0u;
#pragma unroll
        for (unsigned j = 0; j < 16; ++j) { const unsigned c = xb_ld(&bar[XB_XCNT(j)]); sum += c; cnt += (c > 0u) ? 1u : 0u; mine = (j == x) ? c : mine; }
        if (sum == G) break;
        __builtin_amdgcn_s_sleep(1);
        if ((++sp & 255u) == 0u) { if (xb_ld(&bar[XB_TMO])) break; if (sp > XB_SPIN_CAP) { atomicAdd(&bar[XB_TMO], 1u); break; } }
    }
    nloc = mine > 0u ? mine : 1u; nx = cnt > 0u ? cnt : 1u;
}

__device__ __forceinline__ void xcd_barrier(const XcdBarrier& b) {
    asm volatile("s_waitcnt vmcnt(0)" ::: "memory");
    __syncthreads();
    if (threadIdx.x == 0) {
        unsigned* bar = b.bar;
        __builtin_amdgcn_s_waitcnt(0);
        unsigned nloc = b.st[0], nx = b.st[1];
        if (nloc == 0u) { xcd_barrier_complete(bar, b.x, nloc, nx); b.st[0] = nloc; b.st[1] = nx; }
        const unsigned old = xb_add(&bar[XB_XSUB(b.x)], 1u);
        const unsigned gen = old / nloc;
        if (old + 1u == (gen + 1u) * nloc) {
            __builtin_amdgcn_fence(__ATOMIC_RELEASE, "agent");
            asm volatile("s_waitcnt vmcnt(0)" ::: "memory");
            const unsigned og = xb_add(&bar[XB_TOP], 1u);
            const unsigned tg = og / nx;
            if (og + 1u == (tg + 1u) * nx) xb_add(&bar[XB_TOPGEN], 1u);
            else XB_SPIN(xb_ld(&bar[XB_TOPGEN]) == tg, bar);
            __builtin_amdgcn_fence(__ATOMIC_ACQUIRE, "agent");
            xb_add(&bar[XB_XGEN(b.x)], 1u);
            asm volatile("s_waitcnt vmcnt(0)" ::: "memory");
        } else {
            XB_SPIN(xb_ld(&bar[XB_XGEN(b.x)]) == gen, bar);
            __builtin_amdgcn_fence(__ATOMIC_ACQUIRE, "agent");
            asm volatile("s_waitcnt vmcnt(0)" ::: "memory");
        }
    }
    __syncthreads();
}

template <int PH>
__device__ __forceinline__ void run_phase(const P& p, int bid, int nb, char* smem) {
    if constexpr (PH == 0) ph_prologue(p, bid, nb, smem);
    if constexpr (PH == 1) ph_inproj(p, bid, nb, smem);
    if constexpr (PH == 2) { ph_compress(p, bid, nb, smem); __syncthreads(); ph_rwkv_chunk(p, bid, nb, smem); }
    if constexpr (PH == 3) {
        if (bid < SCAN_BLOCKS) ph_rwkv_seq(p, bid, SCAN_BLOCKS, smem);
        ph_nsa(p, bid - SCAN_BLOCKS, nb - SCAN_BLOCKS, smem);
    }
    if constexpr (PH == 12) ph_rwkv_out(p, bid, nb, smem);
    if constexpr (PH == 4) ph_merge(p, bid, nb, smem);
    if constexpr (PH == 5) ph_outproj(p, bid, nb, smem);
    if constexpr (PH == 6) ph_route(p, bid, nb, smem);
    if constexpr (PH == 7) ph_scatter(p, bid, nb, smem);
    if constexpr (PH == 9) ph_moe1(p, bid, nb, smem);
    if constexpr (PH == 10) ph_moe2(p, bid, nb, smem);
    if constexpr (PH == 11) ph_final(p, bid, nb, smem);
}

template <int PH>
__global__ void __launch_bounds__(NT) kph(P p) {
    extern __shared__ __attribute__((aligned(16))) char smem[];
    run_phase<PH>(p, blockIdx.x, gridDim.x, smem);
}

__global__ void __launch_bounds__(NT, 2) mega(P p) {
    extern __shared__ __attribute__((aligned(16))) char smem[];
    volatile LAS unsigned* st = (volatile LAS unsigned*)(smem + SMEM_BYTES - 16);
    if (threadIdx.x == 0) { st[0] = 0u; st[1] = 0u; st[2] = 0u; st[3] = 0u; }
    __syncthreads();
    XcdBarrier bar = xcd_barrier_post(p.bar, st);
    const int bid = blockIdx.x, nb = gridDim.x;
#define RUNP(N, BAR) { unsigned long long t0_ = 0; if ((TPROBE >> N) & 1) t0_ = __builtin_amdgcn_s_memrealtime(); run_phase<N>(p, bid, nb, smem); \
        unsigned long long tw_ = 0; if (((TPROBE >> N) & 1) && TPSEL) tw_ = __builtin_amdgcn_s_memrealtime() - t0_; if (BAR) xcd_barrier(bar); \
        if ((TPROBE >> N) & 1) { const unsigned long long t1_ = __builtin_amdgcn_s_memrealtime(); const unsigned long long dt_ = TPSEL ? tw_ : t1_ - t0_; \
            if (!TPSEL || (TPSEL == 1 ? (bid < SCAN_BLOCKS) : (bid >= SCAN_BLOCKS))) while (__builtin_amdgcn_s_memrealtime() - t1_ < dt_) __builtin_amdgcn_s_sleep(8); if (TPSEL) xcd_barrier(bar); } }
    RUNP(0, 1) RUNP(1, 1) RUNP(2, 1) RUNP(3, 1) RUNP(12, 1) RUNP(4, 1) RUNP(5, 1) RUNP(6, 1) RUNP(7, 1) RUNP(9, 1) RUNP(10, 1) RUNP(11, 0)
}

extern "C" void kernel_launch(void* const* d_in, const int* in_sizes, int n_in,
                              void* d_out, int out_size, void* d_ws, size_t ws_size,
                              hipStream_t stream) {
    P p{};
    p.x = (const float*)d_in[0]; p.pos = (const int*)d_in[1]; p.g_mix = (const float*)d_in[2]; p.w_in = (const float*)d_in[3];
    p.pe_k = (const float*)d_in[4]; p.w1_k = (const float*)d_in[5]; p.b1_k = (const float*)d_in[6]; p.w2_k = (const float*)d_in[7]; p.b2_k = (const float*)d_in[8];
    p.pe_v = (const float*)d_in[9]; p.w1_v = (const float*)d_in[10]; p.b1_v = (const float*)d_in[11]; p.w2_v = (const float*)d_in[12]; p.b2_v = (const float*)d_in[13];
    p.mu = (const float*)d_in[14]; p.w0 = (const float*)d_in[15]; p.w2 = (const float*)d_in[16]; p.a0 = (const float*)d_in[17]; p.a2 = (const float*)d_in[18];
    p.g2 = (const float*)d_in[19]; p.k_k = (const float*)d_in[20]; p.k_a = (const float*)d_in[21]; p.r_k = (const float*)d_in[22]; p.ln_w = (const float*)d_in[23]; p.ln_b = (const float*)d_in[24];
    p.wpa = (const float*)d_in[25]; p.wpb = (const float*)d_in[26]; p.wout = (const float*)d_in[27]; p.g_ffn = (const float*)d_in[28];
    p.w_grp = (const float*)d_in[29]; p.b_grp = (const float*)d_in[30]; p.w_exp = (const float*)d_in[31]; p.b_exp = (const float*)d_in[32];
    p.e_w1 = (const float*)d_in[33]; p.e_w3 = (const float*)d_in[34]; p.e_w2 = (const float*)d_in[35]; p.g_final = (const float*)d_in[36];
    p.out = (float*)d_out;
    char* ws = (char*)d_ws;
    const size_t MiB = 1ull << 20;
    p.hbuf = (u16*)(ws + 0 * MiB);
    p.q    = (u16*)(ws + 64 * MiB);
    p.kc   = (u16*)(ws + 96 * MiB);  p.vc   = (u16*)(ws + 104 * MiB);
    p.ksl  = (u16*)(ws + 112 * MiB); p.vslT = (u16*)(ws + 120 * MiB);
    p.kwn  = (u16*)(ws + 128 * MiB); p.vwnT = (u16*)(ws + 136 * MiB);
    p.nsag = (float*)(ws + 144 * MiB);
    p.kcb  = (u16*)(ws + 148 * MiB); p.vcT  = (u16*)(ws + 149 * MiB);
    p.prw  = (u16*)(ws + 160 * MiB);
    p.cdat = (u16*)(ws + 272 * MiB);
    p.bon  = (float*)(ws + 150 * MiB);
    p.w2T  = (u16*)(ws + 151 * MiB); p.a2T = p.w2T + 512 * 64; p.g2T = p.a2T + 512 * 64;
    p.cw1Tk = (u16*)(ws + 152 * MiB); p.cw1Tv = (u16*)(ws + 153 * MiB);
    p.cw2Tk = (u16*)(ws + 154 * MiB); p.cw2Tv = p.cw2Tk + 128 * 256;
    p.chid = (u16*)(ws + 155 * MiB);
    p.xact = (u16*)(ws + 488 * MiB);
    p.oa   = (u16*)(ws + 400 * MiB);
    p.ob   = (u16*)(ws + 432 * MiB);
    p.merged = (u16*)(ws + 64 * MiB);
    p.x1   = (float*)(ws + 160 * MiB);
    char* rt = ws + 288 * MiB;
    p.tok_e = (int*)(rt);                        rt += NTOK * 2 * 4;
    p.tok_gate = (float*)(rt);                   rt += NTOK * 2 * 4;
    p.tokslot = (int*)(rt);                      rt += NTOK * 2 * 4;
    p.list_tok = (int*)(rt);                     rt += NTOK * 2 * 4;
    p.list_gate = (float*)(rt);                  rt += NTOK * 2 * 4;
    p.blk_e = (int*)(rt);                        rt += 2048 * 4;
    p.blk_r0 = (int*)(rt);                       rt += 2048 * 4;
    p.rsb = (float*)(rt);                        rt += NTOK * 4;
    p.hid  = (u16*)(ws + 296 * MiB);
    p.ybuf = (u16*)(ws + 336 * MiB);
    char* misc = ws + 470 * MiB;
    p.counts = (int*)(misc); p.cursor = (int*)(misc + 256); p.offs = (int*)(misc + 512); p.nblk = (int*)(misc + 1024); p.nsactr = (int*)(misc + 2048);
    p.bar = (unsigned*)(ws + 471 * MiB);
    p.cb1k = (float*)(misc + 65536); p.cb1v = p.cb1k + 256;
    {
        char* wa = ws + 472 * MiB;
        p.winT = (u16*)wa;  wa += (size_t)3328 * 1024 * 2;
        p.wgT  = (u16*)wa;  wa += (size_t)2048 * 1024 * 2;
        p.wpaT = (u16*)wa;  wa += (size_t)1024 * 512 * 2;
        p.wpbT = (u16*)wa;  wa += (size_t)1024 * 512 * 2;
        p.woutT = (u16*)wa; wa += (size_t)1024 * 1024 * 2;
        p.ew1T = (u16*)(ws + 64 * MiB);  p.ew3T = (u16*)(ws + 80 * MiB);  p.ew2T = (u16*)(ws + 96 * MiB);
    }
    if (ws_size < (size_t)505 * MiB) return;

#if MEGA
    {
        static int mgrid = 0;
        if (mgrid == 0) {
            int dev = 0, cus = 0, per_cu = 0;
            hipGetDevice(&dev);
            hipDeviceGetAttribute(&cus, hipDeviceAttributeMultiprocessorCount, dev);
            hipFuncSetAttribute((const void*)mega, hipFuncAttributeMaxDynamicSharedMemorySize, SMEM_BYTES);
            hipOccupancyMaxActiveBlocksPerMultiprocessor(&per_cu, (const void*)mega, NT, SMEM_BYTES);
            (void)hipGetLastError();
            mgrid = cus;
        }
        hipMemsetAsync(p.bar, 0, XCD_BAR_WORDS * sizeof(unsigned) + 512 * sizeof(float), stream);
        mega<<<mgrid, NT, SMEM_BYTES, stream>>>(p);
        return;
    }
#else
    const int grid = 512;
    hipMemsetAsync(p.bar, 0, XCD_BAR_WORDS * sizeof(unsigned) + 512 * sizeof(float), stream);
    hipFuncSetAttribute((const void*)kph<0>, hipFuncAttributeMaxDynamicSharedMemorySize, SMEM_BYTES);
    hipFuncSetAttribute((const void*)kph<1>, hipFuncAttributeMaxDynamicSharedMemorySize, SMEM_BYTES);
    hipFuncSetAttribute((const void*)kph<2>, hipFuncAttributeMaxDynamicSharedMemorySize, SMEM_BYTES);
    hipFuncSetAttribute((const void*)kph<3>, hipFuncAttributeMaxDynamicSharedMemorySize, SMEM_BYTES);
    hipFuncSetAttribute((const void*)kph<4>, hipFuncAttributeMaxDynamicSharedMemorySize, SMEM_BYTES);
    hipFuncSetAttribute((const void*)kph<5>, hipFuncAttributeMaxDynamicSharedMemorySize, SMEM_BYTES);
    hipFuncSetAttribute((const void*)kph<6>, hipFuncAttributeMaxDynamicSharedMemorySize, SMEM_BYTES);
    hipFuncSetAttribute((const void*)kph<7>, hipFuncAttributeMaxDynamicSharedMemorySize, SMEM_BYTES);
    hipFuncSetAttribute((const void*)kph<8>, hipFuncAttributeMaxDynamicSharedMemorySize, SMEM_BYTES);
    hipFuncSetAttribute((const void*)kph<9>, hipFuncAttributeMaxDynamicSharedMemorySize, SMEM_BYTES);
    hipFuncSetAttribute((const void*)kph<10>, hipFuncAttributeMaxDynamicSharedMemorySize, SMEM_BYTES);
    hipFuncSetAttribute((const void*)kph<11>, hipFuncAttributeMaxDynamicSharedMemorySize, SMEM_BYTES);
    kph<0><<<grid, NT, SMEM_BYTES, stream>>>(p);
    kph<1><<<grid, NT, SMEM_BYTES, stream>>>(p);
    kph<2><<<grid, NT, SMEM_BYTES, stream>>>(p);
    kph<3><<<grid, NT, SMEM_BYTES, stream>>>(p);
    kph<12><<<grid, NT, SMEM_BYTES, stream>>>(p);
    kph<4><<<grid, NT, SMEM_BYTES, stream>>>(p);
    kph<5><<<grid, NT, SMEM_BYTES, stream>>>(p);
    kph<6><<<grid, NT, SMEM_BYTES, stream>>>(p);
    kph<7><<<grid, NT, SMEM_BYTES, stream>>>(p);
    kph<8><<<grid, NT, SMEM_BYTES, stream>>>(p);
    kph<9><<<grid, NT, SMEM_BYTES, stream>>>(p);
    kph<10><<<grid, NT, SMEM_BYTES, stream>>>(p);
    kph<11><<<grid, NT, SMEM_BYTES, stream>>>(p);
#endif
}
```

```cpp
#include <hip/hip_runtime.h>
#include <stdint.h>

typedef unsigned short u16;
using bf16x8 = __attribute__((ext_vector_type(8))) short;
using f32x4  = __attribute__((ext_vector_type(4))) float;

#ifndef MEGA
#define MEGA 1
#endif

constexpr int B_ = 4, S_ = 8192, D_ = 1024, NTOK = B_ * S_;
constexpr int CIN = 5144;
constexpr int NCMP = 511;
constexpr int CRW = 1792;
constexpr int NEXP = 32;
constexpr int NT = 512;
constexpr int NW = NT / 64;
constexpr int SMEM_BYTES = 160 * 1024;
constexpr int SCAN_BLOCKS = 16;
#ifndef TPROBE
#define TPROBE 0
#define TPSEL 0
#endif
constexpr float QSCALE = 0.125f * 1.4426950408889634f;

struct P {
    const float* x; const int* pos; const float* g_mix; const float* w_in;
    const float *pe_k, *w1_k, *b1_k, *w2_k, *b2_k, *pe_v, *w1_v, *b1_v, *w2_v, *b2_v;
    const float *mu, *w0, *w2, *a0, *a2, *g2, *k_k, *k_a, *r_k, *ln_w, *ln_b;
    const float *wpa, *wpb, *wout, *g_ffn, *w_grp, *b_grp, *w_exp, *b_exp, *e_w1, *e_w3, *e_w2, *g_final;
    float* out;
    u16* hbuf; u16 *q, *kc, *vc, *ksl, *vslT, *kwn, *vwnT, *kcb, *vcT; float* nsag; u16* prw;
    u16* cdat; float* bon; u16 *w2T, *a2T, *g2T; u16 *oa, *ob; u16* merged; float* x1;
    int* tok_e; float* tok_gate; int* tokslot; int* list_tok; float* list_gate;
    int* counts; int* offs; int* cursor; int* blk_e; int* blk_r0; int* nblk; float* rsb; int* nsactr;
    u16* hid; u16* ybuf; unsigned* bar;
    u16 *winT, *wgT, *wpaT, *wpbT, *woutT, *ew1T, *ew3T, *ew2T;
    u16 *cw1Tk, *cw1Tv, *cw2Tk, *cw2Tv, *chid, *xact; float *cb1k, *cb1v;
};

typedef __bf16 bf16x2_t __attribute__((ext_vector_type(2)));
typedef float f32x2_t __attribute__((ext_vector_type(2)));
__device__ __forceinline__ unsigned pack2(float a, float b) {
    f32x2_t f = {a, b};
    return __builtin_bit_cast(unsigned, __builtin_convertvector(f, bf16x2_t));
}
__device__ __forceinline__ u16 f2bf(float f) { return (u16)(pack2(f, f) & 0xFFFFu); }
__device__ __forceinline__ float bf2f(u16 h) { return __uint_as_float(((unsigned)h) << 16); }
__device__ __forceinline__ float sigmoidf_(float x) { return __builtin_amdgcn_rcpf(1.f + __expf(-x)); }
__device__ __forceinline__ int get_tid() { int t = threadIdx.x; asm volatile("" : "+v"(t)); return t; }
__device__ __forceinline__ uint2 pack4(const f32x4& v) { uint2 o; o.x = pack2(v[0], v[1]); o.y = pack2(v[2], v[3]); return o; }
__device__ __forceinline__ f32x4 unpack4(uint2 u) { return f32x4{__uint_as_float(u.x << 16), __uint_as_float(u.x & 0xFFFF0000u), __uint_as_float(u.y << 16), __uint_as_float(u.y & 0xFFFF0000u)}; }
#define LDS_BARRIER() do { asm volatile("s_waitcnt lgkmcnt(0)" ::: "memory"); __builtin_amdgcn_s_barrier(); asm volatile("" ::: "memory"); } while (0)
__device__ __forceinline__ int opaque(int x) { asm volatile("" : "+v"(x)); return x; }
template <int CTRL>
__device__ __forceinline__ float dppf(float x) { return __int_as_float(__builtin_amdgcn_update_dpp(0, __float_as_int(x), CTRL, 0xF, 0xF, true)); }
__device__ __forceinline__ float wave_sum(float v) {
    v += dppf<0xB1>(v);
    v += dppf<0x4E>(v);
    v += dppf<0x141>(v);
    v += dppf<0x140>(v);
    const int vi = __float_as_int(v);
    return (__int_as_float(__builtin_amdgcn_readlane(vi, 0)) + __int_as_float(__builtin_amdgcn_readlane(vi, 16)))
         + (__int_as_float(__builtin_amdgcn_readlane(vi, 32)) + __int_as_float(__builtin_amdgcn_readlane(vi, 48)));
}

__device__ __forceinline__ float xrow_sum(float v) {
    auto r = __builtin_amdgcn_permlane16_swap(__float_as_uint(v), __float_as_uint(v), false, false);
    v = __uint_as_float(r[0]) + __uint_as_float(r[1]);
    auto r2 = __builtin_amdgcn_permlane32_swap(__float_as_uint(v), __float_as_uint(v), false, false);
    return __uint_as_float(r2[0]) + __uint_as_float(r2[1]);
}
__device__ __forceinline__ float xrow_max(float v) {
    auto r = __builtin_amdgcn_permlane16_swap(__float_as_uint(v), __float_as_uint(v), false, false);
    v = fmaxf(__uint_as_float(r[0]), __uint_as_float(r[1]));
    auto r2 = __builtin_amdgcn_permlane32_swap(__float_as_uint(v), __float_as_uint(v), false, false);
    return fmaxf(__uint_as_float(r2[0]), __uint_as_float(r2[1]));
}
__constant__ double ROPE_FREQ[32] = {
    1.00000000000000000000e+00, 7.49894209332455874417e-01, 5.62341325190349072827e-01, 4.21696503428582225581e-01,
    3.16227766016837941176e-01, 2.37137370566165517349e-01, 1.77827941003892292526e-01, 1.33352143216332402753e-01,
    1.00000000000000005551e-01, 7.49894209332455791150e-02, 5.62341325190349114460e-02, 4.21696503428582239459e-02,
    3.16227766016837913421e-02, 2.37137370566165538166e-02, 1.77827941003892292526e-02, 1.33352143216332406223e-02,
    1.00000000000000002082e-02, 7.49894209332455791150e-03, 5.62341325190349097113e-03, 4.21696503428582291501e-03,
    3.16227766016837939442e-03, 2.37137370566165538166e-03, 1.77827941003892275179e-03, 1.33352143216332406223e-03,
    1.00000000000000002082e-03, 7.49894209332455856203e-04, 5.62341325190349097113e-04, 4.21696503428582237290e-04,
    3.16227766016837939442e-04, 2.37137370566165538166e-04, 1.77827941003892269758e-04, 1.33352143216332395381e-04};

constexpr int G_ABYTES = 256 * 64 * 2, G_BBYTES = 128 * 64 * 2, G_TILE = G_ABYTES + G_BBYTES;
#define LAS3 __attribute__((address_space(3)))
#define GAS1 __attribute__((address_space(1)))
__device__ __forceinline__ void glds16(const u16* g, char* l) {
    __builtin_amdgcn_global_load_lds((const GAS1 unsigned*)g, (LAS3 unsigned*)l, 16, 0, 0);
}
template <bool TR = false, class ARow>
__device__ __forceinline__ void gemm_core(int K, ARow arow, const u16* __restrict__ BT, int ldb, f32x4 (&acc)[4][4], u16* sm) {
    char* base = (char*)sm;
    const int tid = get_tid(), lane = tid & 63, wv = tid >> 6;
    const int wm = wv >> 1, wn = wv & 1, kr = lane & 15, qq = lane >> 4;
    const int lr = tid >> 3, lk = ((tid & 7) ^ ((lr >> 1) & 7)) * 8;
    const u16* ap0 = arow(lr) + lk; const u16* ap1 = arow(lr + 64) + lk;
    const u16* ap2 = arow(lr + 128) + lk; const u16* ap3 = arow(lr + 192) + lk;
    const u16* bp0 = BT + (size_t)lr * ldb + lk; const u16* bp1 = BT + (size_t)(lr + 64) * ldb + lk;
#pragma unroll
    for (int mt = 0; mt < 4; mt++)
#pragma unroll
        for (int nt = 0; nt < 4; nt++) acc[mt][nt] = f32x4{0.f, 0.f, 0.f, 0.f};
    const int nk = K >> 6;
#define G_ISSUE(t, b) { char* d = base + (b) * G_TILE + tid * 16; const int ko = (t) * 64; \
        glds16(ap0 + ko, d); glds16(ap1 + ko, d + 8192); glds16(ap2 + ko, d + 16384); glds16(ap3 + ko, d + 24576); \
        glds16(bp0 + ko, d + G_ABYTES); glds16(bp1 + ko, d + G_ABYTES + 8192); }
    const int sw = kr >> 1;
    const int po0 = ((0 * 4 + qq) ^ sw) * 16, po1 = ((1 * 4 + qq) ^ sw) * 16;
    const int aoff = (wm * 64 + kr) * 128, boff = G_ABYTES + (wn * 64 + kr) * 128;
#define G_READ(FA, FB, b) { const char* Ab = base + (b) * G_TILE + aoff; const char* Bb = base + (b) * G_TILE + boff; \
        _Pragma("unroll") for (int mt = 0; mt < 4; mt++) { FA[0][mt] = *(const bf16x8*)(Ab + mt * 2048 + po0); FA[1][mt] = *(const bf16x8*)(Ab + mt * 2048 + po1); } \
        _Pragma("unroll") for (int nt = 0; nt < 4; nt++) { FB[0][nt] = *(const bf16x8*)(Bb + nt * 2048 + po0); FB[1][nt] = *(const bf16x8*)(Bb + nt * 2048 + po1); } }
#define G_MMA(FA, FB) { __builtin_amdgcn_s_setprio(1); \
        _Pragma("unroll") for (int ks = 0; ks < 2; ks++) \
            _Pragma("unroll") for (int nt = 0; nt < 4; nt++) \
                _Pragma("unroll") for (int mt = 0; mt < 4; mt++) \
                    acc[mt][nt] = TR ? __builtin_amdgcn_mfma_f32_16x16x32_bf16(FA[ks][mt], FB[ks][nt], acc[mt][nt], 0, 0, 0) \
                                     : __builtin_amdgcn_mfma_f32_16x16x32_bf16(FB[ks][nt], FA[ks][mt], acc[mt][nt], 0, 0, 0); \
        __builtin_amdgcn_s_setprio(0); }
    bf16x8 fa0[2][4], fb0[2][4], fa1[2][4], fb1[2][4];
    G_ISSUE(0, 0)
    if (nk > 1) G_ISSUE(1, 1)
    if (nk > 2) G_ISSUE(2, 2)
    if (nk > 2) asm volatile("s_waitcnt vmcnt(12)" ::: "memory");
    else if (nk > 1) asm volatile("s_waitcnt vmcnt(6)" ::: "memory");
    else asm volatile("s_waitcnt vmcnt(0)" ::: "memory");
    __builtin_amdgcn_s_barrier();
    G_READ(fa0, fb0, 0)
    int bnext = 1, bfree = 0;
#define G_STEP(FAC, FBC, FAN, FBN, kt) { \
        if ((kt) + 1 < nk) { \
            if ((kt) + 2 < nk) asm volatile("s_waitcnt vmcnt(6) lgkmcnt(0)" ::: "memory"); else asm volatile("s_waitcnt vmcnt(0) lgkmcnt(0)" ::: "memory"); \
            __builtin_amdgcn_s_barrier();                   \
            if ((kt) + 3 < nk) G_ISSUE((kt) + 3, bfree) \
            G_READ(FAN, FBN, bnext) \
        } \
        G_MMA(FAC, FBC) \
        bfree = bnext; bnext = (bnext == 2) ? 0 : bnext + 1; }
    for (int kt = 0; kt < nk; kt += 2) {
        G_STEP(fa0, fb0, fa1, fb1, kt)
        G_STEP(fa1, fb1, fa0, fb0, kt + 1)
    }
    __builtin_amdgcn_s_barrier();
#undef G_READ
#undef G_MMA
#undef G_STEP
#undef G_ISSUE
}

__device__ __forceinline__ int xcd_item(int bid, int nb, int k, int nitems) {
    if (nb & 7) return bid + k * nb;
    const int per = nb >> 3, chunk = (nitems + 7) >> 3;
    const int j = k * per + (bid >> 3);
    return (j < chunk) ? (bid & 7) * chunk + j : nitems;
}
struct GUnit { int pm, pn; };
constexpr int G8_HTB = 128 * 64 * 2;
__device__ __forceinline__ int g8_lds_byte(int r, int c) { const int st = (r >> 4) * 2 + (c >> 5), rr = r & 15, cc = c & 31, ob = rr * 64 + cc * 2; return st * 1024 + (ob ^ (((ob >> 9) & 1) << 5)); }
__device__ __forceinline__ void g8_stage_rc(int b, int& R, int& C) { const int st = b / 1024, sb = b % 1024, swz = sb ^ (((sb >> 9) & 1) << 5); R = (st >> 1) * 16 + swz / 64; C = (st & 1) * 32 + (swz % 64) / 2; }
__host__ __device__ __forceinline__ int perm32(int rho) { const int n = rho >> 4, i = rho & 15; return 8 * (i >> 2) + 4 * n + (i & 3); }

template <class Epi, class Sched>
__device__ __forceinline__ void gemm256(char* smem, const char* Ab, int K, const Sched& S, const Epi& E) {
    LAS3 unsigned char* lds = (LAS3 unsigned char*)smem;
    const int tid = get_tid(), wid = __builtin_amdgcn_readfirstlane(tid >> 6), lane = tid & 63, wr = wid >> 2, wc = wid & 3, fr = lane & 15, fq = lane >> 4;
    int nt = K >> 6; asm volatile("" : "+s"(nt));
    unsigned voffB[2], voffA[2][2];
#pragma unroll
    for (int i = 0; i < 2; ++i) { int sR, sC; g8_stage_rc(tid * 16 + i * 8192, sR, sC); voffB[i] = (unsigned)(sR * K + sC) * 2u; }
#define G8_AOFFS(un) do { const int t3_ = get_tid(); _Pragma("unroll") for (int i = 0; i < 2; ++i) { int sR, sC; g8_stage_rc(t3_ * 16 + i * 8192, sR, sC); \
        _Pragma("unroll") for (int h = 0; h < 2; ++h) voffA[h][i] = S.a_off(un, h, sR) + (unsigned)sC * 2u; } } while (0)
    const size_t kstep = 128;
    const size_t hstep = (size_t)128 * K * 2;
    const unsigned ldsw = (unsigned)wid * 1024u;
    const int aoff = g8_lds_byte(wr * 64 + fr, fq * 8), boff = g8_lds_byte(wc * 32 + fr, fq * 8);
#define G8_SA(b, h) (((b) * 2 + (h)) * G8_HTB)
#define G8_SB(b, h) ((4 + (b) * 2 + (h)) * G8_HTB)
#define G8_STAGE2(bufoff, gbase, v0, v1) do { \
        __builtin_amdgcn_global_load_lds((const GAS1 unsigned*)((const char*)(gbase) + (v0)), (LAS3 unsigned*)(lds + (bufoff) + ldsw), 16, 0, 0); \
        __builtin_amdgcn_global_load_lds((const GAS1 unsigned*)((const char*)(gbase) + (v1)), (LAS3 unsigned*)(lds + (bufoff) + ldsw + 8192), 16, 0, 0); } while (0)
#define G8_STAGEB(bufoff, gbase) G8_STAGE2(bufoff, gbase, voffB[0], voffB[1])
#define G8_LDA(dst, b, h) do { _Pragma("unroll") for (int m = 0; m < 4; ++m) _Pragma("unroll") for (int k = 0; k < 2; ++k) dst[m][k] = *(const LAS3 bf16x8*)(lds + G8_SA(b, h) + aoff + m * 2048 + k * 1024); } while (0)
#define G8_LDB(dst, b, h) do { _Pragma("unroll") for (int n = 0; n < 2; ++n) _Pragma("unroll") for (int k = 0; k < 2; ++k) dst[n][k] = *(const LAS3 bf16x8*)(lds + G8_SB(b, h) + boff + n * 2048 + k * 1024); } while (0)
#define G8_MMA(ai, bj, At, Bt) do { __builtin_amdgcn_s_setprio(1); _Pragma("unroll") for (int m = 0; m < 4; ++m) _Pragma("unroll") for (int n = 0; n < 2; ++n) _Pragma("unroll") for (int k = 0; k < 2; ++k) \
        acc[ai][bj][m][n] = __builtin_amdgcn_mfma_f32_16x16x32_bf16(Bt[n][k], At[m][k], acc[ai][bj][m][n], 0, 0, 0); __builtin_amdgcn_s_setprio(0); } while (0)
#define G8_WAIT_V(n) asm volatile("s_waitcnt vmcnt(" #n ")" ::: "memory")
#define G8_WAIT_L(n) asm volatile("s_waitcnt lgkmcnt(" #n ")" ::: "memory")
#define G8_BAR __builtin_amdgcn_s_barrier()
#define G8_SCHED __builtin_amdgcn_sched_barrier(0)
    GUnit cur, nxt; int ui = 0;
    if (!S.next(0, cur)) return;
    f32x4 acc[2][2][4][2];
#pragma unroll
    for (int a = 0; a < 2; ++a)
#pragma unroll
        for (int b = 0; b < 2; ++b)
#pragma unroll
            for (int m = 0; m < 4; ++m)
#pragma unroll
                for (int n = 0; n < 2; ++n) acc[a][b][m][n] = (f32x4){0.f, 0.f, 0.f, 0.f};
    bf16x8 At[4][2], B0[2][2], B1[2][2];
    G8_AOFFS(cur);
    const char* cB = S.b_ptr(cur);
    G8_STAGEB(G8_SB(0, 0), cB); G8_STAGE2(G8_SA(0, 0), Ab, voffA[0][0], voffA[0][1]); G8_STAGEB(G8_SB(0, 1), cB + hstep); G8_STAGE2(G8_SA(0, 1), Ab, voffA[1][0], voffA[1][1]);
    if (wr == 1) G8_BAR;
    G8_WAIT_V(4); G8_BAR;
    G8_STAGEB(G8_SB(1, 0), cB + kstep); G8_STAGE2(G8_SA(1, 0), Ab + kstep, voffA[0][0], voffA[0][1]); G8_STAGEB(G8_SB(1, 1), cB + hstep + kstep);
    G8_WAIT_V(6); G8_BAR;
    for (;;) {
        const bool has_next = S.next(ui + 1, nxt);
        const char* nB = has_next ? S.b_ptr(nxt) : cB;
        for (int t = 0; t < nt; t += 2) {
            const bool last = (t == nt - 2);
            const char* a1 = Ab + (size_t)(t + 1) * kstep;
            const unsigned va10 = voffA[1][0], va11 = voffA[1][1];
            if (last && has_next) G8_AOFFS(nxt);
            const char* a2 = last ? Ab : Ab + (size_t)(t + 2) * kstep; const char* b2 = last ? nB : cB + (size_t)(t + 2) * kstep;
            const char* a3 = a2 + kstep; const char* b3 = b2 + kstep;
            G8_LDB(B0, 0, 0); G8_SCHED; G8_LDA(At, 0, 0); G8_STAGE2(G8_SA(1, 1), a1, va10, va11);
            G8_WAIT_L(8); G8_BAR; G8_WAIT_L(0); G8_MMA(0, 0, At, B0); G8_BAR; G8_SCHED;
            G8_LDB(B1, 0, 1); G8_STAGEB(G8_SB(0, 0), b2);
            G8_BAR; G8_WAIT_L(0); G8_MMA(0, 1, At, B1); G8_BAR;
            G8_LDA(At, 0, 1); G8_STAGE2(G8_SA(0, 0), a2, voffA[0][0], voffA[0][1]);
            G8_BAR; G8_WAIT_L(0); G8_MMA(1, 0, At, B0); G8_BAR; G8_SCHED;
            G8_STAGEB(G8_SB(0, 1), b2 + hstep);
            G8_WAIT_V(6); G8_BAR; G8_MMA(1, 1, At, B1); G8_BAR;
            G8_LDB(B0, 1, 0); G8_SCHED; G8_LDA(At, 1, 0); G8_STAGE2(G8_SA(0, 1), a2, voffA[1][0], voffA[1][1]);
            G8_WAIT_L(8); G8_BAR; G8_WAIT_L(0); G8_MMA(0, 0, At, B0); G8_BAR; G8_SCHED;
            G8_LDB(B1, 1, 1); G8_STAGEB(G8_SB(1, 0), b3);
            G8_BAR; G8_WAIT_L(0); G8_MMA(0, 1, At, B1); G8_BAR;
            G8_LDA(At, 1, 1); G8_STAGE2(G8_SA(1, 0), a3, voffA[0][0], voffA[0][1]);
            G8_BAR; G8_WAIT_L(0); G8_MMA(1, 0, At, B0); G8_BAR; G8_SCHED;
            G8_STAGEB(G8_SB(1, 1), b3 + hstep);
            G8_WAIT_V(6); G8_BAR; G8_MMA(1, 1, At, B1); G8_BAR;
        }
        E(acc, cur, wr, wc, fr, fq);
        if (!has_next) break;
#pragma unroll
        for (int a = 0; a < 2; ++a)
#pragma unroll
            for (int b = 0; b < 2; ++b)
#pragma unroll
                for (int m = 0; m < 4; ++m)
#pragma unroll
                    for (int n = 0; n < 2; ++n) acc[a][b][m][n] = (f32x4){0.f, 0.f, 0.f, 0.f};
        cur = nxt; cB = nB; ++ui;
    }
    G8_WAIT_V(0);
    if (wr == 0) G8_BAR;
    G8_BAR;
#undef G8_SA
#undef G8_AOFFS
#undef G8_SB
#undef G8_STAGE2
#undef G8_STAGEB
#undef G8_LDA
#undef G8_LDB
#undef G8_MMA
#undef G8_WAIT_V
#undef G8_WAIT_L
#undef G8_BAR
#undef G8_SCHED
}
struct DenseSched {
    int nM, nN, nwg, G, c, K; const char* Bt;
    __device__ __forceinline__ void init(int M, int N, int K_, const void* Bt_, int G_, int c_) { nM = M >> 8; nN = N >> 8; nwg = nM * nN; G = G_; c = c_; K = K_; Bt = (const char*)Bt_; }
    __device__ __forceinline__ bool next(int i, GUnit& u) const {
        const int L = i * G + c; if (L >= nwg) return false;
        int wgid = L; { const int q = nwg >> 3, r = nwg & 7, xcd = wgid & 7, off = wgid >> 3; wgid = (xcd < r ? xcd * (q + 1) : r * (q + 1) + (xcd - r) * q) + off; }
        const int nig = 8 * nN, gid = wgid / nig, fm = gid * 8, gsz = (nM - fm) < 8 ? (nM - fm) : 8, w = wgid - gid * nig;
        u.pn = w / gsz; u.pm = fm + (w - u.pn * gsz); return true;
    }
    __device__ __forceinline__ unsigned a_off(const GUnit& u, int h, int R) const { return (unsigned)((u.pm * 256 + h * 128 + R) * K) * 2u; }
    __device__ __forceinline__ const char* b_ptr(const GUnit& u) const { return Bt + (size_t)u.pn * 256 * K * 2; }
};

template <class SRC>
__device__ __forceinline__ void convert_wT(const float* __restrict__ W, int K, int N, u16* __restrict__ WT, int rows, SRC src, int gtid, int gnt) {
    const int kch = K >> 3;
    const int total = rows * kch;
    for (int i0 = gtid; i0 < total; i0 += 4 * gnt) {
        float f[4][8]; int sc[4];
#pragma unroll
        for (int u = 0; u < 4; u++) {
            const int i = i0 + u * gnt;
            sc[u] = -1;
            if (i < total) {
                const int kc = i / rows, j = i - kc * rows;
                sc[u] = src(j);
                if (sc[u] >= 0) {
                    const float* wp = W + (size_t)(kc * 8) * N + sc[u];
#pragma unroll
                    for (int q = 0; q < 8; q++) f[u][q] = wp[(size_t)q * N];
                }
            }
        }
#pragma unroll
        for (int u = 0; u < 4; u++) {
            const int i = i0 + u * gnt;
            if (i < total) {
                const int kc = i / rows, j = i - kc * rows;
                uint4 v = make_uint4(0u, 0u, 0u, 0u);
                if (sc[u] >= 0) { v.x = pack2(f[u][0], f[u][1]); v.y = pack2(f[u][2], f[u][3]); v.z = pack2(f[u][4], f[u][5]); v.w = pack2(f[u][6], f[u][7]); }
                *(uint4*)&WT[(size_t)j * K + kc * 8] = v;
            }
        }
    }
}

__device__ __forceinline__ void convert_later_weights(const P& p, int gtid, int gnt) {
    convert_wT(p.w_in, D_, CIN, p.wgT, 2048, [](int j) { const int t = j >> 8, r = j & 255, cl = r & 127; return 3096 + (r >> 7) * 1024 + t * 128 + (cl & ~31) + perm32(cl & 31); }, gtid, gnt);
    convert_wT(p.wpa, 512, D_, p.wpaT, 1024, [](int j) { return (j & ~31) + perm32(j & 31); }, gtid, gnt);
    convert_wT(p.wpb, 512, D_, p.wpbT, 1024, [](int j) { return (j & ~31) + perm32(j & 31); }, gtid, gnt);
    convert_wT(p.wout, D_, D_, p.woutT, 1024, [](int j) { return j; }, gtid, gnt);
    convert_wT(p.w2, 64, 512, p.w2T, 512, [](int j) { return j; }, gtid, gnt);
    convert_wT(p.w1_k, 2048, 256, p.cw1Tk, 256, [](int j) { return j; }, gtid, gnt);
    convert_wT(p.w1_v, 2048, 256, p.cw1Tv, 256, [](int j) { return j; }, gtid, gnt);
    convert_wT(p.w2_k, 256, 64, p.cw2Tk, 128, [](int j) { return j < 64 ? j : -1; }, gtid, gnt);
    convert_wT(p.w2_v, 256, 64, p.cw2Tv, 128, [](int j) { return j < 64 ? j : -1; }, gtid, gnt);
    convert_wT(p.a2, 64, 512, p.a2T, 512, [](int j) { return j; }, gtid, gnt);
    convert_wT(p.g2, 128, 512, p.g2T, 512, [](int j) { return j; }, gtid, gnt);
}
__device__ void ph_prologue(const P& p, int bid, int nb, char* smem) {
    const int tid = get_tid(), lane = tid & 63, wv = tid >> 6;
    if (bid >= 1 && bid <= 64) {
        const int j = tid & 255; const bool isv = tid >= 256;
        const float* pe = isv ? p.pe_v : p.pe_k; const float* w1 = isv ? p.w1_v : p.w1_k;
        const int kb = (bid - 1) * 32;
        float a0 = 0.f, a1 = 0.f;
#pragma unroll 4
        for (int k = kb; k < kb + 32; k += 2) { a0 += pe[k] * w1[(size_t)k * 256 + j]; a1 += pe[k + 1] * w1[(size_t)(k + 1) * 256 + j]; }
        p.cb1k[(bid - 1) * 512 + (isv ? 256 : 0) + j] = a0 + a1;
    }
    if (bid == 0) {
        if (tid < 32) { p.counts[tid] = 0; p.cursor[tid] = 0; }
        if (tid == 32) *p.nsactr = 0;
        for (int i = tid; i < 8 * 64; i += NT) {
            const int bg = i >> 6, d = i & 63;
            p.kcb[((size_t)bg * 512 + 511) * 64 + d] = 0;
            p.vcT[(((size_t)bg * 8 + 7) * 64 + d) * 64 + 63] = 0;
        }
    }
    {
        const int gtid = bid * NT + tid, gnt = nb * NT;
        convert_wT(p.w_in, D_, CIN, p.winT, 3328, [](int j) {
            const int t = j >> 8, s = j & 255;
            if (t < 5) {
                const int bj = s >> 7, wc = (s >> 5) & 3, n = (s >> 4) & 1, i = s & 15;
                const int dim = 32 * bj + 8 * (i >> 2) + 4 * n + (i & 3), hq = 4 * t + wc;
                int hb;
                if (hq < 8) hb = 64 * hq;
                else { const int k = (hq - 8) >> 1; hb = (k == 0 ? 512 : (k == 1 ? 640 : (k == 2 ? 768 : (k == 3 ? 1024 : (k == 4 ? 896 : 1152))))) + 64 * (hq & 1); }
                return hb + dim;
            }
            const int c = (s & ~31) + perm32(s & 31);
            if (t < 12) return 1304 + (t - 5) * 256 + c;
            return c < 24 ? 1280 + c : -1; }, gtid, gnt);
        if (nb != 256) convert_later_weights(p, gtid, gnt);
    }
    for (int row = bid * NW + wv; row < NTOK; row += nb * NW) {
        const float* xr = p.x + (size_t)row * D_;
        float v[16];
        float ss = 0.f;
#pragma unroll
        for (int i = 0; i < 4; i++) {
            float4 t = *(const float4*)&xr[i * 256 + lane * 4];
            v[4 * i] = t.x; v[4 * i + 1] = t.y; v[4 * i + 2] = t.z; v[4 * i + 3] = t.w;
            ss += t.x * t.x + t.y * t.y + t.z * t.z + t.w * t.w;
        }
        ss = wave_sum(ss);
        const float rs = rsqrtf(ss * (1.f / D_) + 1e-6f);
#pragma unroll
        for (int i = 0; i < 4; i++) {
            const int c = i * 256 + lane * 4;
            float4 g = *(const float4*)&p.g_mix[c];
            uint2 o;
            o.x = pack2(v[4 * i] * rs * g.x, v[4 * i + 1] * rs * g.y);
            o.y = pack2(v[4 * i + 2] * rs * g.z, v[4 * i + 3] * rs * g.w);
            *(uint2*)&p.hbuf[(size_t)row * D_ + c] = o;
        }
    }
}

__device__ __forceinline__ uint4 pack8(const f32x4& a, const f32x4& b) { uint4 o; o.x = pack2(a[0], a[1]); o.y = pack2(a[2], a[3]); o.z = pack2(b[0], b[1]); o.w = pack2(b[2], b[3]); return o; }
struct EpiInproj {
    const P* pp;
    __device__ __forceinline__ void operator()(const f32x4 (&acc)[2][2][4][2], const GUnit& u, int, int, int, int) const {
        const int t2_ = get_tid(), wid_ = __builtin_amdgcn_readfirstlane(t2_ >> 6), wr = wid_ >> 2, wc = wid_ & 3, fr = t2_ & 15, fq = (t2_ >> 4) & 3;
        const P& p = *pp;
        const int pn = u.pn;
        const int rowb = u.pm * 256 + wr * 64;
        if (pn < 4) {
            const int hq = 4 * pn + wc;
            const bool rope = !(pn == 2 && wc >= 2);
            u16* dst; size_t rstride; int cofs;
            if (pn < 2) { dst = p.q; rstride = 512; cofs = hq * 64; }
            else { dst = (pn == 2) ? (wc < 2 ? p.kc : p.vc) : (wc < 2 ? p.ksl : p.kwn); rstride = 64; cofs = 0; }
            const int g = wc & 1;
#pragma unroll
            for (int ai = 0; ai < 2; ++ai)
#pragma unroll
                for (int m = 0; m < 4; ++m) {
                    const int row = rowb + ai * 128 + m * 16 + fr;
                    f32x4 o1[2], o2[2];
#pragma unroll
                    for (int n = 0; n < 2; ++n) { o1[n] = acc[ai][0][m][n]; o2[n] = acc[ai][1][m][n]; }
                    if (rope) {
                        const double posd = (double)p.pos[row];
#pragma unroll
                        for (int n = 0; n < 2; ++n)
#pragma unroll
                            for (int j = 0; j < 4; ++j) {
                                const double tr = posd * ROPE_FREQ[8 * fq + 4 * n + j] * 0.15915494309189535;
                                const float fr_ = (float)(tr - rint(tr));
                                const float cs = __builtin_amdgcn_cosf(fr_), sn = __builtin_amdgcn_sinf(fr_);
                                const float x1 = o1[n][j], x2 = o2[n][j];
                                o1[n][j] = x1 * cs - x2 * sn; o2[n][j] = x1 * sn + x2 * cs;
                            }
                    }
                    size_t ro;
                    if (pn < 2) {
#pragma unroll
                        for (int n = 0; n < 2; ++n)
#pragma unroll
                            for (int j = 0; j < 4; ++j) { o1[n][j] *= QSCALE; o2[n][j] *= QSCALE; }
                        ro = (size_t)row * 512 + cofs + 8 * fq;
                    } else {
                        const int bb = row >> 13, t = row & (S_ - 1);
                        ro = ((size_t)(bb * 2 + g) * S_ + t) * 64 + 8 * fq;
                    }
                    *(uint4*)&dst[ro] = pack8(o1[0], o1[1]);
                    *(uint4*)&dst[ro + 32] = pack8(o2[0], o2[1]);
                }
        } else if (pn == 4) {
            u16* dst = (wc < 2) ? p.vslT : p.vwnT;
            const int g = wc & 1;
#pragma unroll
            for (int ai = 0; ai < 2; ++ai) {
                const int r0 = rowb + ai * 128, bb = r0 >> 13, tb = r0 & (S_ - 1);
                u16* base = dst + ((size_t)(bb * 2 + g) * 128 + (tb >> 6)) * 4096;
#pragma unroll
                for (int m = 0; m < 4; ++m)
#pragma unroll
                    for (int bj = 0; bj < 2; ++bj)
#pragma unroll
                        for (int n = 0; n < 2; ++n)
#pragma unroll
                            for (int j = 0; j < 4; ++j)
                                base[(32 * bj + 8 * fq + 4 * n + j) * 64 + m * 16 + fr] = f2bf(acc[ai][bj][m][n][j]);
            }
        } else if (pn < 12) {
            const int cb = (pn - 5) * 256 + wc * 32 + 8 * fq;
#pragma unroll
            for (int ai = 0; ai < 2; ++ai)
#pragma unroll
                for (int m = 0; m < 4; ++m) {
                    const size_t ro = (size_t)(rowb + ai * 128 + m * 16 + fr) * CRW + cb;
#pragma unroll
                    for (int bj = 0; bj < 2; ++bj) *(uint4*)&p.prw[ro + bj * 128] = pack8(acc[ai][bj][m][0], acc[ai][bj][m][1]);
                }
        } else {
            if (wc == 0 && fq < 3) {
#pragma unroll
                for (int ai = 0; ai < 2; ++ai)
#pragma unroll
                    for (int m = 0; m < 4; ++m) {
                        const size_t ro = (size_t)(rowb + ai * 128 + m * 16 + fr) * 24 + 8 * fq;
#pragma unroll
                        for (int n = 0; n < 2; ++n) {
                            float4 o; o.x = sigmoidf_(acc[ai][0][m][n][0]); o.y = sigmoidf_(acc[ai][0][m][n][1]); o.z = sigmoidf_(acc[ai][0][m][n][2]); o.w = sigmoidf_(acc[ai][0][m][n][3]);
                            *(float4*)&p.nsag[ro + 4 * n] = o;
                        }
                    }
            }
        }
    }
};
__device__ void ph_inproj(const P& p, int bid, int nb, char* smem) {
    DenseSched S; S.init(NTOK, 3328, D_, p.winT, nb, bid);
    EpiInproj E{&p};
    gemm256(smem, (const char*)p.hbuf, D_, S, E);
    if (nb == 256 && bid >= 128) convert_later_weights(p, (bid - 128) * NT + get_tid(), 128 * NT);
}

__device__ __forceinline__ float gelu_tanh(float x) {
    const float c = 0.7978845608028654f;
    return 0.5f * x * (1.f + tanhf(c * (x + 0.044715f * x * x * x)));
}
__device__ void ph_compress(const P& p, int bid, int nb, char* smem) {
    u16* sm = (u16*)smem;
    const int tid = get_tid(), lane = tid & 63, wv = tid >> 6;
    const int wm = wv >> 1, wn = wv & 1;
    for (int it = bid; it < 32; it += nb) {
        const int rt = it & 1, g = (it >> 1) & 1, b = (it >> 2) & 3, kv = it >> 4;
        const int bg = b * 2 + g, i0 = rt * 256;
        const u16* src = (kv ? p.vc : p.kc) + (size_t)bg * S_ * 64;
        const u16* w1T = kv ? p.cw1Tv : p.cw1Tk;
        const u16* w2T = kv ? p.cw2Tv : p.cw2Tk;
        float* cb1 = (float*)(smem + 3 * G_TILE);
        __syncthreads();
        { const int t2 = get_tid(); if (t2 < 256) { float a = 0.f; for (int q = 0; q < 64; q++) a += p.cb1k[q * 512 + kv * 256 + t2]; cb1[t2] = a; } }
        __syncthreads();
        const float* b1 = kv ? p.b1_v : p.b1_k;
        const float* b2 = kv ? p.b2_v : p.b2_k;
        u16* hidp = p.chid + (size_t)it * 256 * 256;
        auto arow = [&](int r) { int i = i0 + r; if (i > 510) i = 510; return src + (size_t)i * 1024; };
#pragma unroll 1
        for (int ct = 0; ct < 2; ct++) {
            f32x4 acc[4][4];
            gemm_core<false>(2048, arow, w1T + (size_t)ct * 128 * 2048, 2048, acc, sm);
            const int le = get_tid() & 63;
#pragma unroll
            for (int mt = 0; mt < 4; mt++) {
                const int r = wm * 64 + mt * 16 + (le & 15);
#pragma unroll
                for (int nt = 0; nt < 4; nt++) {
                    const int col = ct * 128 + wn * 64 + nt * 16 + (le >> 4) * 4;
                    const float4 c1 = *(const float4*)&cb1[col], bb1 = *(const float4*)&b1[col];
                    f32x4 o;
                    o[0] = gelu_tanh(acc[mt][nt][0] + c1.x + bb1.x); o[1] = gelu_tanh(acc[mt][nt][1] + c1.y + bb1.y);
                    o[2] = gelu_tanh(acc[mt][nt][2] + c1.z + bb1.z); o[3] = gelu_tanh(acc[mt][nt][3] + c1.w + bb1.w);
                    *(uint2*)&hidp[r * 256 + col] = pack4(o);
                }
            }
        }
        __syncthreads();
        {
            f32x4 acc[4][4];
            gemm_core<true>(256, [&](int r) { return hidp + (size_t)r * 256; }, w2T, 256, acc, sm);
            if (wn == 0) {
#pragma unroll
                for (int mt = 0; mt < 4; mt++)
#pragma unroll
                    for (int nt = 0; nt < 4; nt++) {
                        const int d = nt * 16 + (lane & 15);
                        const int ib = i0 + wm * 64 + mt * 16 + (lane >> 4) * 4;
                        float o[4];
#pragma unroll
                        for (int j = 0; j < 4; j++) o[j] = (ib + j < NCMP) ? (acc[mt][nt][j] + b2[d]) : 0.f;
                        if (kv == 0) {
#pragma unroll
                            for (int j = 0; j < 4; j++) p.kcb[((size_t)bg * 512 + ib + j) * 64 + d] = f2bf(o[j]);
                        } else {
                            uint2 ov; ov.x = pack2(o[0], o[1]); ov.y = pack2(o[2], o[3]);
                            *(uint2*)&p.vcT[(((size_t)bg * 8 + (ib >> 6)) * 64 + d) * 64 + (ib & 63)] = ov;
                        }
                    }
            }
        }
        __syncthreads();
    }
}

#ifndef NSAPROBE
#define NSAPROBE 0
#endif
#define NSA_TS(k) if (NSAPROBE == k) ts_ = __builtin_amdgcn_s_memrealtime();
#define NSA_TE(k) if (NSAPROBE == k) tacc_ += __builtin_amdgcn_s_memrealtime() - ts_;
constexpr int KSTR = 72;
struct Sub { f32x4 O[4]; float m, l; };
#define NEG_BIG (-1.0e30f)

__device__ __forceinline__ float xq_max(float v) {
    return xrow_max(v);
}
__device__ __forceinline__ float xq_sum(float v) {
    return xrow_sum(v);
}
template <int OFF> __device__ __forceinline__ bf16x8 gload_b128(const u16* p) { bf16x8 r; asm volatile("global_load_dwordx4 %0, %1, off offset:%2" : "=v"(r) : "v"(p), "n"(OFF) : "memory"); return r; }
typedef unsigned u32x2 __attribute__((ext_vector_type(2)));
template <int OFF> __device__ __forceinline__ u32x2 gload_b64(const u16* p) { u32x2 r; asm volatile("global_load_dwordx2 %0, %1, off offset:%2" : "=v"(r) : "v"(p), "n"(OFF) : "memory"); return r; }
union VF { bf16x8 v; u32x2 h[2]; };
template <int OFF> __device__ __forceinline__ u32x2 lds_read_b64(unsigned addr) { u32x2 r; asm volatile("ds_read_b64 %0, %1 offset:%2" : "=v"(r) : "v"(addr), "n"(OFF)); return r; }
#define NSA_LDV_ASM(vf, Vs, kr, qq, swz) { const unsigned va_ = (unsigned)(size_t)(const LAS3 char*)((const char*)(Vs) + (kr) * 128 + ((qq) & 1) * 8); const int vo_ = (((qq) >> 1) ^ (swz)) << 4; \
        const unsigned a0_ = va_ + vo_, a1_ = va_ + (vo_ ^ 32), a2_ = va_ + (vo_ ^ 64), a3_ = va_ + (vo_ ^ 96); \
        vf[0][0].h[0] = lds_read_b64<0>(a0_);    vf[0][0].h[1] = lds_read_b64<0>(a1_);    vf[0][1].h[0] = lds_read_b64<0>(a2_);    vf[0][1].h[1] = lds_read_b64<0>(a3_); \
        vf[1][0].h[0] = lds_read_b64<2048>(a0_); vf[1][0].h[1] = lds_read_b64<2048>(a1_); vf[1][1].h[0] = lds_read_b64<2048>(a2_); vf[1][1].h[1] = lds_read_b64<2048>(a3_); \
        vf[2][0].h[0] = lds_read_b64<4096>(a0_); vf[2][0].h[1] = lds_read_b64<4096>(a1_); vf[2][1].h[0] = lds_read_b64<4096>(a2_); vf[2][1].h[1] = lds_read_b64<4096>(a3_); \
        vf[3][0].h[0] = lds_read_b64<6144>(a0_); vf[3][0].h[1] = lds_read_b64<6144>(a1_); vf[3][1].h[0] = lds_read_b64<6144>(a2_); vf[3][1].h[1] = lds_read_b64<6144>(a3_); }
#define NSA_VWAIT(vf) asm volatile("s_waitcnt lgkmcnt(0)" : "+v"(vf[0][0].v), "+v"(vf[0][1].v), "+v"(vf[1][0].v), "+v"(vf[1][1].v), "+v"(vf[2][0].v), "+v"(vf[2][1].v), "+v"(vf[3][0].v), "+v"(vf[3][1].v) :: "memory")
template <bool MASK, bool IMP, bool PV>
__device__ __forceinline__ void nsa_visit(const u16* Ks, const u16* Vs, const u16* qrow, Sub& s, int lo, int hi, int lane, float* e, float* p3) {
    const int kr = lane & 15, qq = lane >> 4;
    f32x4 S[4];
    const int qsw = ((kr & 3) >> 1) ^ ((kr >> 2) << 1);
    const bf16x8 qf0 = *(const bf16x8*)(qrow + ((qq ^ qsw) << 3)), qf1 = *(const bf16x8*)(qrow + (((4 + qq) ^ qsw) << 3));
    bf16x8 kf[4][2];
    const int swz = kr >> 1;
    {
        const char* kb_ = (const char*)Ks + kr * 128;
        const int ko0 = (qq ^ swz) << 4, ko1 = ko0 ^ 64;
#pragma unroll
        for (int kt = 0; kt < 4; kt++) { kf[kt][0] = *(const bf16x8*)(kb_ + kt * 2048 + ko0); kf[kt][1] = *(const bf16x8*)(kb_ + kt * 2048 + ko1); }
    }
    __builtin_amdgcn_sched_barrier(0);
#pragma unroll
    for (int kt = 0; kt < 4; kt++) {
        S[kt] = __builtin_amdgcn_mfma_f32_16x16x32_bf16(kf[kt][0], qf0, f32x4{0.f, 0.f, 0.f, 0.f}, 0, 0, 0);
        S[kt] = __builtin_amdgcn_mfma_f32_16x16x32_bf16(kf[kt][1], qf1, S[kt], 0, 0, 0);
    }
    float mx = NEG_BIG;
#pragma unroll
    for (int kt = 0; kt < 4; kt++)
#pragma unroll
        for (int r = 0; r < 4; r++) {
            if (MASK) { const int o = kt * 16 + qq * 4 + r; if (o < lo || o > hi) S[kt][r] = -INFINITY; }
            mx = fmaxf(mx, S[kt][r]);
        }
    mx = xq_max(mx);
    const float mnew = fmaxf(s.m, mx);
    const float alpha = __builtin_amdgcn_exp2f(s.m - mnew);
    s.m = mnew;
    float psum = 0.f;
#pragma unroll
    for (int kt = 0; kt < 4; kt++) {
#pragma unroll
        for (int r = 0; r < 4; r++) { S[kt][r] = __builtin_amdgcn_exp2f(S[kt][r] - mnew); }
        const float ee = (S[kt][0] + S[kt][1]) + (S[kt][2] + S[kt][3]);
        psum += ee;
        if (IMP) { e[kt] = ee; p3[kt] = S[kt][3]; }
    }
    s.l = s.l * alpha + psum;
    if (PV) {
        if (!__all(alpha == 1.f)) {
#pragma unroll
            for (int dt = 0; dt < 4; dt++)
#pragma unroll
                for (int r = 0; r < 4; r++) s.O[dt][r] *= alpha;
        }
        VF vf[4][2];
        NSA_LDV_ASM(vf, Vs, kr, qq, swz)
        bf16x8 pb[2];
#pragma unroll
        for (int k2 = 0; k2 < 2; k2++) {
            union { bf16x8 v; unsigned u[4]; } t;
            t.u[0] = pack2(S[2 * k2][0], S[2 * k2][1]); t.u[1] = pack2(S[2 * k2][2], S[2 * k2][3]);
            t.u[2] = pack2(S[2 * k2 + 1][0], S[2 * k2 + 1][1]); t.u[3] = pack2(S[2 * k2 + 1][2], S[2 * k2 + 1][3]);
            pb[k2] = t.v;
        }
        NSA_VWAIT(vf);
        __builtin_amdgcn_sched_barrier(0);
#pragma unroll
        for (int dt = 0; dt < 4; dt++)
#pragma unroll
            for (int k2 = 0; k2 < 2; k2++) s.O[dt] = __builtin_amdgcn_mfma_f32_16x16x32_bf16(vf[dt][k2].v, pb[k2], s.O[dt], 0, 0, 0);
    }
}
template <bool IMP, bool PV, bool MASK>
__device__ __forceinline__ void nsa_visit2(const u16* Ks, const u16* Vs, const u16* qrow0, const u16* qrow1, Sub (&st)[2], const int (&hi)[2], int lane, float (&e)[2][4], float (&p3)[2][4]) {
    const int kr = lane & 15, qq = lane >> 4;
    const int qsw = ((kr & 3) >> 1) ^ ((kr >> 2) << 1);
    bf16x8 qf0[2], qf1[2];
    qf0[0] = *(const bf16x8*)(qrow0 + ((qq ^ qsw) << 3)); qf1[0] = *(const bf16x8*)(qrow0 + (((4 + qq) ^ qsw) << 3));
    qf0[1] = *(const bf16x8*)(qrow1 + ((qq ^ qsw) << 3)); qf1[1] = *(const bf16x8*)(qrow1 + (((4 + qq) ^ qsw) << 3));
    bf16x8 kf[4][2];
    const int swz = kr >> 1;
    {
        const char* kb_ = (const char*)Ks + kr * 128;
        const int ko0 = (qq ^ swz) << 4, ko1 = ko0 ^ 64;
#pragma unroll
        for (int kt = 0; kt < 4; kt++) { kf[kt][0] = *(const bf16x8*)(kb_ + kt * 2048 + ko0); kf[kt][1] = *(const bf16x8*)(kb_ + kt * 2048 + ko1); }
    }
    __builtin_amdgcn_sched_barrier(0);
    f32x4 S[2][4];
#pragma unroll
    for (int kt = 0; kt < 4; kt++)
#pragma unroll
        for (int q = 0; q < 2; q++) {
            const float s0 = PV ? -st[q].m : 0.f;
            S[q][kt] = __builtin_amdgcn_mfma_f32_16x16x32_bf16(kf[kt][0], qf0[q], f32x4{s0, s0, s0, s0}, 0, 0, 0);
            S[q][kt] = __builtin_amdgcn_mfma_f32_16x16x32_bf16(kf[kt][1], qf1[q], S[q][kt], 0, 0, 0);
        }
    VF vf[4][2];
    bf16x8 pb[2][2];
#pragma unroll
    for (int q = 0; q < 2; q++) {
        Sub& s = st[q];
        float mnew = 0.f;
        if (MASK) {
#pragma unroll
            for (int kt = 0; kt < 4; kt++)
#pragma unroll
                for (int r = 0; r < 4; r++) { const int o = kt * 16 + qq * 4 + r; if (o > hi[q]) S[q][kt][r] = -INFINITY; }
        }
        if (!PV) {
            float mx = NEG_BIG;
#pragma unroll
            for (int kt = 0; kt < 4; kt++)
#pragma unroll
                for (int r = 0; r < 4; r++) mx = fmaxf(mx, S[q][kt][r]);
            mx = xq_max(mx);
            mnew = fmaxf(s.m, mx);
            const float alpha = __builtin_amdgcn_exp2f(s.m - mnew);
            s.m = mnew;
            s.l *= alpha;
        }
        float psum = 0.f;
#pragma unroll
        for (int kt = 0; kt < 4; kt++) {
#pragma unroll
            for (int r = 0; r < 4; r++) { S[q][kt][r] = __builtin_amdgcn_exp2f(PV ? S[q][kt][r] : S[q][kt][r] - mnew); }
            const float ee = (S[q][kt][0] + S[q][kt][1]) + (S[q][kt][2] + S[q][kt][3]);
            psum += ee;
            if (IMP) { e[q][kt] = ee; p3[q][kt] = S[q][kt][3]; }
        }
        s.l += psum;
        if (PV) {
#pragma unroll
            for (int k2 = 0; k2 < 2; k2++) {
                union { bf16x8 v; unsigned u[4]; } t;
                t.u[0] = pack2(S[q][2 * k2][0], S[q][2 * k2][1]); t.u[1] = pack2(S[q][2 * k2][2], S[q][2 * k2][3]);
                t.u[2] = pack2(S[q][2 * k2 + 1][0], S[q][2 * k2 + 1][1]); t.u[3] = pack2(S[q][2 * k2 + 1][2], S[q][2 * k2 + 1][3]);
                pb[q][k2] = t.v;
            }
            if (q == 0) NSA_LDV_ASM(vf, Vs, kr, qq, swz)
        }
    }
    if (PV) {
        NSA_VWAIT(vf);
        __builtin_amdgcn_sched_barrier(0);
#pragma unroll
        for (int dt = 0; dt < 4; dt++)
#pragma unroll
            for (int k2 = 0; k2 < 2; k2++)
#pragma unroll
                for (int q = 0; q < 2; q++) st[q].O[dt] = __builtin_amdgcn_mfma_f32_16x16x32_bf16(vf[dt][k2].v, pb[q][k2], st[q].O[dt], 0, 0, 0);
    }
}
template <int MMODE, bool FIXM, int NQ>
__device__ __forceinline__ void nsa_visit_gn(const u16* Ks, const u16* Vs, const u16* qs, float* Os, float* Ms, float* Ls, const int (&tok)[NQ], const bool (&valid)[NQ], int lane) {
    const int kr = lane & 15, qq = lane >> 4, hh = kr & 3;
    int row[NQ], osw[NQ]; float* orow[NQ];
    f32x4 O[NQ][4]; float m_old[NQ], l_old[NQ]; bf16x8 qf0[NQ], qf1[NQ];
#pragma unroll
    for (int q = 0; q < NQ; q++) {
        row[q] = tok[q] * 4 + hh; orow[q] = Os + row[q] * 64;
        osw[q] = hh ^ ((tok[q] & 3) << 2);
        if (FIXM) {
#pragma unroll
            for (int dt = 0; dt < 4; dt++) O[q][dt] = *(const f32x4*)(orow[q] + (((dt * 4 + qq) ^ osw[q]) << 2));
            m_old[q] = Ms[row[q]]; l_old[q] = Ls[row[q]];
        } else {
#pragma unroll
            for (int dt = 0; dt < 4; dt++) O[q][dt] = f32x4{0.f, 0.f, 0.f, 0.f};
            m_old[q] = NEG_BIG; l_old[q] = 0.f;
        }
        const u16* qrow = qs + row[q] * 64;
        const int qsw = (hh >> 1) ^ ((tok[q] & 3) << 1);
        qf0[q] = *(const bf16x8*)(qrow + ((qq ^ qsw) << 3)); qf1[q] = *(const bf16x8*)(qrow + (((4 + qq) ^ qsw) << 3));
    }
    bf16x8 kf[4][2];
    const int swz = kr >> 1;
    {
        const char* kb_ = (const char*)Ks + kr * 128;
        const int ko0 = (qq ^ swz) << 4, ko1 = ko0 ^ 64;
#pragma unroll
        for (int kt = 0; kt < 4; kt++) { kf[kt][0] = *(const bf16x8*)(kb_ + kt * 2048 + ko0); kf[kt][1] = *(const bf16x8*)(kb_ + kt * 2048 + ko1); }
    }
    __builtin_amdgcn_sched_barrier(0);
    f32x4 S[NQ][4];
#pragma unroll
    for (int kt = 0; kt < 4; kt++)
#pragma unroll
        for (int q = 0; q < NQ; q++) {
            const float s0 = FIXM ? (valid[q] ? -m_old[q] : -INFINITY) : 0.f;
            S[q][kt] = __builtin_amdgcn_mfma_f32_16x16x32_bf16(kf[kt][0], qf0[q], f32x4{s0, s0, s0, s0}, 0, 0, 0);
            S[q][kt] = __builtin_amdgcn_mfma_f32_16x16x32_bf16(kf[kt][1], qf1[q], S[q][kt], 0, 0, 0);
        }
    VF vf[4][2];
#define NSA_LDV NSA_LDV_ASM(vf, Vs, kr, qq, swz)
    if (NQ == 1) NSA_LDV
    bf16x8 pb[NQ][2];
#pragma unroll
    for (int q = 0; q < NQ; q++) {
        float mx = NEG_BIG;
#pragma unroll
        for (int kt = 0; kt < 4; kt++)
#pragma unroll
            for (int r = 0; r < 4; r++) {
                if (MMODE == 1) { const int o = kt * 16 + qq * 4 + r; if (o > tok[q]) S[q][kt][r] = -INFINITY; }
                if (MMODE == 2) { const int o = kt * 16 + qq * 4 + r; if (o <= tok[q]) S[q][kt][r] = -INFINITY; }
                if (!FIXM) mx = fmaxf(mx, S[q][kt][r]);
            }
        float mnew = m_old[q], alpha = 1.f;
        if (!FIXM) {
            if (!valid[q]) mx = NEG_BIG;
            mx = xq_max(mx);
            mnew = fmaxf(m_old[q], mx);
            alpha = __builtin_amdgcn_exp2f(m_old[q] - mnew);
        }
#pragma unroll
        for (int kt = 0; kt < 4; kt++)
#pragma unroll
            for (int r = 0; r < 4; r++) { S[q][kt][r] = __builtin_amdgcn_exp2f(FIXM ? S[q][kt][r] : S[q][kt][r] - mnew); }
#pragma unroll
        for (int k2 = 0; k2 < 2; k2++) {
            union { bf16x8 v; unsigned u[4]; } t;
            t.u[0] = pack2(S[q][2 * k2][0], S[q][2 * k2][1]); t.u[1] = pack2(S[q][2 * k2][2], S[q][2 * k2][3]);
            t.u[2] = pack2(S[q][2 * k2 + 1][0], S[q][2 * k2 + 1][1]); t.u[3] = pack2(S[q][2 * k2 + 1][2], S[q][2 * k2 + 1][3]);
            pb[q][k2] = t.v;
        }
        float psum;
        {
            const bf16x8 ones = {0x3F80, 0x3F80, 0x3F80, 0x3F80, 0x3F80, 0x3F80, 0x3F80, 0x3F80};
            f32x4 ps = __builtin_amdgcn_mfma_f32_16x16x32_bf16(ones, pb[q][0], f32x4{0.f, 0.f, 0.f, 0.f}, 0, 0, 0);
            ps = __builtin_amdgcn_mfma_f32_16x16x32_bf16(ones, pb[q][1], ps, 0, 0, 0);
            psum = ps[0];
        }
        if (FIXM) { if (valid[q] && qq == 0) Ls[row[q]] = l_old[q] + psum; }
        else { if (valid[q] && qq == 0) { Ms[row[q]] = mnew; Ls[row[q]] = psum; } }
        if (NQ == 2 && q == 0) { asm volatile("" ::: "memory"); NSA_LDV }
    }
#undef NSA_LDV
    NSA_VWAIT(vf);
    __builtin_amdgcn_sched_barrier(0);
#pragma unroll
    for (int dt = 0; dt < 4; dt++)
#pragma unroll
        for (int k2 = 0; k2 < 2; k2++)
#pragma unroll
            for (int q = 0; q < NQ; q++) O[q][dt] = __builtin_amdgcn_mfma_f32_16x16x32_bf16(vf[dt][k2].v, pb[q][k2], O[q][dt], 0, 0, 0);
#pragma unroll
    for (int q = 0; q < NQ; q++)
        if (valid[q]) {
#pragma unroll
            for (int dt = 0; dt < 4; dt++) *(f32x4*)(orow[q] + (((dt * 4 + qq) ^ osw[q]) << 2)) = O[q][dt];
        }
}
template <int MMODE, bool FIXM>
__device__ __forceinline__ void nsa_visit_g(const u16* Ks, const u16* Vs, const u16* qs, float* Os, float* Ms, float* Ls, int tok, bool valid, int lane) {
    const int tk[1] = {tok}; const bool vl[1] = {valid};
    nsa_visit_gn<MMODE, FIXM, 1>(Ks, Vs, qs, Os, Ms, Ls, tk, vl, lane);
}
__device__ __forceinline__ void nsa_fold_lds(float* Os, float* Ms, float* Ls, int row, int qq, int hh, f32x4 (&T)[4], float gate, bool reset) {
    const float lt = Ls[row];
    const float sc = (lt > 0.f) ? gate / lt : 0.f;
#pragma unroll
    for (int dt = 0; dt < 4; dt++) {
        float* op = Os + row * 64 + (((dt * 4 + qq) ^ hh ^ (((row >> 2) & 3) << 2)) << 2);
        const f32x4 o = *(const f32x4*)op;
#pragma unroll
        for (int r = 0; r < 4; r++) T[dt][r] += o[r] * sc;
    }
    (void)reset; (void)Ms;
}
template <int MODE>
__device__ __forceinline__ void nsa_fold(Sub& s, f32x4 (&T)[4], float gate) {
    const float lt = xq_sum(s.l);
    const float sc = (lt > 0.f) ? gate / lt : 0.f;
#pragma unroll
    for (int dt = 0; dt < 4; dt++)
#pragma unroll
        for (int r = 0; r < 4; r++) {
            const float v = s.O[dt][r] * sc;
            T[dt][r] = (MODE == 1) ? T[dt][r] + v : v;
            s.O[dt][r] = 0.f;
        }
    s.m = NEG_BIG; s.l = 0.f;
}

constexpr int NSA_R = 3;
template <bool HASV, class KSrc, class VSrc, class Body>
__device__ __forceinline__ void nsa_stream(char* ring, int n, KSrc ksrc, VSrc vsrc, Body body) {
    const int t = get_tid();
    const int so = (t >> 3) * 64 + (((t & 7) ^ ((t >> 4) & 7)) << 3);
    char* dl = ring + t * 16;
#define NSA_ISSUE(i, slot) { glds16(ksrc(i) + so, dl + (slot) * 16384); if (HASV) glds16(vsrc(i) + so, dl + (slot) * 16384 + 8192); }
    asm volatile("s_waitcnt lgkmcnt(0)" ::: "memory");
    __builtin_amdgcn_s_barrier();
    if (n > 0) NSA_ISSUE(0, 0)
    if (n > 1) NSA_ISSUE(1, 1)
    int slot = 0;
    for (int i = 0; i < n; i++) {
        if (i + 1 < n) { if (HASV) asm volatile("s_waitcnt vmcnt(2)" ::: "memory"); else asm volatile("s_waitcnt vmcnt(1)" ::: "memory"); }
        else asm volatile("s_waitcnt vmcnt(0)" ::: "memory");
        asm volatile("s_waitcnt lgkmcnt(0)" ::: "memory");
        __builtin_amdgcn_s_barrier();
        asm volatile("" ::: "memory");
        const int sl2 = (slot == 0) ? 2 : slot - 1;
        if (i + 2 < n) NSA_ISSUE(i + 2, sl2)
        body(i, (const u16*)(ring + slot * 16384), (const u16*)(ring + slot * 16384 + 8192));
        slot = (slot == 2) ? 0 : slot + 1;
    }
#undef NSA_ISSUE
}
#define NSA_TOK(u) const int t3_ = get_tid(); const size_t ntk_ = (size_t)b * S_ + t0 + 8 * (t3_ >> 6) + 4 * (u) + ((t3_ & 15) >> 2); const int hd_ = g * 4 + (t3_ & 3);
__device__ void ph_nsa(const P& p, int bid, int nb, char* smem) {
    char* ring = smem;
    unsigned* selm = (unsigned*)(smem + NSA_R * 16384);
    int* blist = (int*)(selm + 256);
    int* nlistp = blist + 128;
    int* lcnt = nlistp + 4;
    unsigned char* lists = (unsigned char*)(lcnt + 128);
    float* Ms = (float*)(lists + 128 * 64);
    float* Ls = Ms + 256;
    float* Os = Ls + 256;
    float* impl = Os;
    u16* qs = (u16*)(Os + 64 * 4 * 64);
    unsigned long long ts_ = 0, tacc_ = 0;
    const int nitems = B_ * 2 * 128;
    for (int rr = 0;; rr++) {
        int it = bid;
        if (rr > 0 || bid < 0) {
            __syncthreads();
            if (get_tid() == 0) nlistp[3] = nb + atomicAdd(p.nsactr, 1);
            __syncthreads();
            it = nlistp[3];
        }
        if (it >= nitems) break;
        const int tid = get_tid(), lane = tid & 63, wv = tid >> 6;
        const int kr = lane & 15, qq = lane >> 4, ts = kr >> 2, hh = kr & 3;
        float* myimp = impl + wv * (32 * 2 * 16);
        const int tt = 127 - (it >> 3);
        const int bg = it & 7, b = bg >> 1, g = bg & 1;
        const int t0 = tt * 64, cur = tt;
        const int head = g * 4 + hh;
        Sub st[2];
        f32x4 T[2][4];
        int tl[2]; size_t ntok[2];
        __syncthreads();
#pragma unroll
        for (int u = 0; u < 2; u++) {
            tl[u] = 8 * wv + 4 * u + ts;
            ntok[u] = (size_t)b * S_ + t0 + tl[u];
#pragma unroll
            for (int ks = 0; ks < 2; ks++) *(bf16x8*)&qs[(tl[u] * 4 + hh) * 64 + (((ks * 4 + qq) ^ (hh >> 1) ^ ((tl[u] & 3) << 1)) << 3)] = *(const bf16x8*)&p.q[ntok[u] * 512 + head * 64 + ks * 32 + qq * 8];
#pragma unroll
            for (int dt = 0; dt < 4; dt++) st[u].O[dt] = f32x4{0.f, 0.f, 0.f, 0.f};
            st[u].m = NEG_BIG; st[u].l = 0.f;
        }
        const u16* kcb = p.kcb + (size_t)bg * 512 * 64;
        const u16* vcT = p.vcT + (size_t)bg * 8 * 4096;
        int nv[2];
#pragma unroll
        for (int u = 0; u < 2; u++) { const int t = t0 + tl[u]; nv[u] = (t >= 31) ? min((t - 31) / 16 + 1, NCMP) : 0; }
        const int tmax = t0 + 63;
        const int nvmax = (tmax >= 31) ? min((tmax - 31) / 16 + 1, NCMP) : 0;
        const int nvb = (nvmax + 63) >> 6;
        NSA_TS(1)
        __syncthreads();
        nsa_stream<false>(ring, nvb, [&](int kb) { return kcb + (size_t)kb * 4096; }, [&](int kb) { return vcT + (size_t)kb * 4096; },
            [&](int kb, const u16* Ks, const u16* Vs) {
                const int hi2[2] = {nv[0] - kb * 64 - 1, nv[1] - kb * 64 - 1};
                float e_[2][4], p3_[2][4];
                if (__all(hi2[0] >= 63 && hi2[1] >= 63)) nsa_visit2<false, false, false>(Ks, Vs, qs + (tl[0] * 4 + hh) * 64, qs + (tl[1] * 4 + hh) * 64, st, hi2, lane, e_, p3_);
                else nsa_visit2<false, false, true>(Ks, Vs, qs + (tl[0] * 4 + hh) * 64, qs + (tl[1] * 4 + hh) * 64, st, hi2, lane, e_, p3_);
            });
        float invl[2];
#pragma unroll
        for (int u = 0; u < 2; u++) { const float lt = xq_sum(st[u].l); invl[u] = (lt > 0.f) ? 1.f / lt : 0.f; st[u].l = 0.f; }
        float carry[2] = {0.f, 0.f};
        nsa_stream<true>(ring, nvb, [&](int kb) { return kcb + (size_t)kb * 4096; }, [&](int kb) { return vcT + (size_t)kb * 4096; },
            [&](int kb, const u16* Ks, const u16* Vs) {
            const int hi2[2] = {nv[0] - kb * 64 - 1, nv[1] - kb * 64 - 1};
            float e_[2][4], p3_[2][4];
            if (__all(hi2[0] >= 63 && hi2[1] >= 63)) nsa_visit2<true, true, false>(Ks, Vs, qs + (tl[0] * 4 + hh) * 64, qs + (tl[1] * 4 + hh) * 64, st, hi2, lane, e_, p3_);
            else nsa_visit2<true, true, true>(Ks, Vs, qs + (tl[0] * 4 + hh) * 64, qs + (tl[1] * 4 + hh) * 64, st, hi2, lane, e_, p3_);
#pragma unroll
            for (int u = 0; u < 2; u++) {
#pragma unroll
                for (int kt = 0; kt < 4; kt++) {
                    float ev = e_[u][kt] * invl[u], pv = p3_[u][kt] * invl[u];
                    ev += dppf<0xB1>(ev); ev += dppf<0x4E>(ev);
                    pv += dppf<0xB1>(pv); pv += dppf<0x4E>(pv);
                    const float sh = __int_as_float(__builtin_amdgcn_ds_bpermute(((lane - 16) & 63) << 2, __float_as_int(pv)));
                    const float nbv = (qq == 0) ? carry[u] : sh;
                    carry[u] = sh;
                    myimp[((kb * 4 + kt) * 2 + u) * 16 + ts * 4 + qq] = ev + nbv;
                }
            }
            });
        NSA_TE(1)
        NSA_TS(2)
#pragma unroll
        for (int u = 0; u < 2; u++) {
            float mv[8];
#pragma unroll
            for (int i = 0; i < 8; i++) {
                const int kk = 8 * hh + i, j = 4 * kk + qq;
                const float v = myimp[(kk * 2 + u) * 16 + ts * 4 + qq];
                mv[i] = (j >= 1 && j <= cur - 2) ? v : -1.f;
            }
            unsigned sel = 0u;
            const int ncand = max(0, cur - 2);
            const int nforced = (cur >= 2) ? 3 : (cur + 1);
            const int need = 16 - nforced;
            if (ncand <= need) {
#pragma unroll
                for (int i = 0; i < 8; i++) if (mv[i] >= 0.f) sel |= (1u << i);
            } else {
                for (int rnd = 0; rnd < need; rnd++) {
                    const float b01 = fmaxf(mv[0], mv[1]), b23 = fmaxf(mv[2], mv[3]), b45 = fmaxf(mv[4], mv[5]), b67 = fmaxf(mv[6], mv[7]);
                    float best = fmaxf(fmaxf(b01, b23), fmaxf(b45, b67));
                    int bi = 7;
#pragma unroll
                    for (int i = 6; i >= 0; i--) bi = (mv[i] == best) ? i : bi;
                    int bj = (best >= 0.f) ? (4 * (8 * hh + bi) + qq) : 9999;
#define TK_MERGE(ov, oj) { const float v2_ = (ov); const int j2_ = (oj); const bool tk_ = (v2_ > best) || (v2_ == best && j2_ < bj); best = tk_ ? v2_ : best; bj = tk_ ? j2_ : bj; }
                    TK_MERGE(dppf<0xB1>(best), __builtin_amdgcn_update_dpp(0, bj, 0xB1, 0xF, 0xF, true))
                    TK_MERGE(dppf<0x4E>(best), __builtin_amdgcn_update_dpp(0, bj, 0x4E, 0xF, 0xF, true))
                    {
                        auto rv = __builtin_amdgcn_permlane16_swap(__float_as_uint(best), __float_as_uint(best), false, false);
                        auto rj = __builtin_amdgcn_permlane16_swap((unsigned)bj, (unsigned)bj, false, false);
                        float v0 = __uint_as_float(rv[0]), v1 = __uint_as_float(rv[1]); int j0 = (int)rj[0], j1 = (int)rj[1];
                        if (v1 > v0 || (v1 == v0 && j1 < j0)) { v0 = v1; j0 = j1; }
                        rv = __builtin_amdgcn_permlane32_swap(__float_as_uint(v0), __float_as_uint(v0), false, false);
                        rj = __builtin_amdgcn_permlane32_swap((unsigned)j0, (unsigned)j0, false, false);
                        best = __uint_as_float(rv[0]); bj = (int)rj[0];
                        const float v2 = __uint_as_float(rv[1]); const int j2 = (int)rj[1];
                        if (v2 > best || (v2 == best && j2 < bj)) { best = v2; bj = j2; }
                    }
#undef TK_MERGE
                    const bool mine = (bj < 512) && ((bj >> 5) == hh) && ((bj & 3) == qq);
                    const int li = (bj >> 2) & 7;
#pragma unroll
                    for (int i = 0; i < 8; i++) mv[i] = (mine && li == i) ? -1.f : mv[i];
                    if (mine) sel |= (1u << li);
                }
            }
            if (qq == 0 && hh == 0) sel |= 1u;
            if ((cur & 3) == qq && (cur >> 5) == hh) sel |= (1u << ((cur >> 2) & 7));
            if (cur >= 1 && ((cur - 1) & 3) == qq && ((cur - 1) >> 5) == hh) sel |= (1u << (((cur - 1) >> 2) & 7));
            unsigned w = sel << (8 * hh);
            w |= (unsigned)__builtin_amdgcn_update_dpp(0, (int)w, 0xB1, 0xF, 0xF, true);
            w |= (unsigned)__builtin_amdgcn_update_dpp(0, (int)w, 0x4E, 0xF, 0xF, true);
            if (hh == 0) selm[tl[u] * 4 + qq] = w;
        }
        NSA_TE(2)
        NSA_TS(3)
        __syncthreads();
#pragma unroll
        for (int u = 0; u < 2; u++) { NSA_TOK(u) nsa_fold<0>(st[u], T[u], p.nsag[ntk_ * 24 + hd_ * 3 + 0]); }
        {
            const int t2 = get_tid();
            unsigned long long tm = 0ull; int lrank = 0;
            if (t2 < 128) {
                const int j = t2;
                for (int tk = 0; tk < 64; tk++) tm |= (unsigned long long)((selm[tk * 4 + (j & 3)] >> (j >> 2)) & 1u) << tk;
                if (j > cur) tm = 0ull;
                const unsigned long long bal = __ballot(tm != 0ull);
                lrank = __popcll(bal & ((1ull << (t2 & 63)) - 1ull));
                if ((t2 & 63) == 0) nlistp[t2 >> 6] = __popcll(bal);
            }
            __syncthreads();
            if (t2 < 128 && tm != 0ull) {
                const int pos = lrank + ((t2 >= 64) ? nlistp[0] : 0);
                blist[pos] = t2; lcnt[pos] = __popcll(tm);
                int c = 0;
                while (tm) { lists[pos * 64 + c] = (unsigned char)(__ffsll((long long)tm) - 1); c++; tm &= tm - 1ull; }
            }
            __syncthreads();
        }
        const int nlist = nlistp[0] + nlistp[1];
        NSA_TE(3)
        NSA_TS(4)
        const u16* ksl = p.ksl + (size_t)bg * S_ * 64;
        const u16* vslT = p.vslT + (size_t)bg * 128 * 4096;
        {
            const int t4 = get_tid(), wv4 = __builtin_amdgcn_readfirstlane(t4 >> 6), ts4 = (t4 & 15) >> 2;
            const int td = t4 & 255;
            const int so = (td >> 3) * 64 + (((td & 7) ^ ((td >> 4) & 7)) << 3);
            char* dl = ring + td * 16;
#define NSA_RI(i) (nlist - 1 - (i))
#define NSA_ISSUE2(i, slot) if (wv4 >= 4) { const int jj_ = blist[NSA_RI(i)]; const u16* kp_ = ksl + (size_t)jj_ * 4096 + so; const u16* vp_ = vslT + (size_t)jj_ * 4096 + so; char* d_ = dl + (slot) * 16384; \
                glds16(kp_, d_); glds16(kp_ + 2048, d_ + 4096); glds16(vp_, d_ + 8192); glds16(vp_ + 2048, d_ + 12288); }
            asm volatile("s_waitcnt lgkmcnt(0)" ::: "memory");
            __builtin_amdgcn_s_barrier();
            if (nlist > 0) NSA_ISSUE2(0, 0)
            if (nlist > 1) NSA_ISSUE2(1, 1)
            int jn = 0, nn = 0, tokn = 0;
            if (nlist > 0) { jn = blist[NSA_RI(0)]; nn = lcnt[NSA_RI(0)]; tokn = lists[NSA_RI(0) * 64 + wv4 * 4 + ts4]; }
            int slot = 0;
            for (int i = 0; i < nlist; i++) {
                if (i + 1 < nlist) asm volatile("s_waitcnt vmcnt(4)" ::: "memory"); else asm volatile("s_waitcnt vmcnt(0)" ::: "memory");
                asm volatile("s_waitcnt lgkmcnt(0)" ::: "memory");
                __builtin_amdgcn_s_barrier();
                asm volatile("" ::: "memory");
                const int sl2 = (slot == 0) ? 2 : slot - 1;
                if (i + 2 < nlist) NSA_ISSUE2(i + 2, sl2)
                const int j = jn, n = nn, tok0 = tokn;
                if (i + 1 < nlist) { jn = blist[NSA_RI(i + 1)]; nn = lcnt[NSA_RI(i + 1)]; tokn = lists[NSA_RI(i + 1) * 64 + wv4 * 4 + ts4]; }
                const u16* Ks = (const u16*)(ring + slot * 16384); const u16* Vs = Ks + 4096;
                if ((wv4 + NW) * 4 < n) {
                    const int e1 = (wv4 + NW) * 4 + ts4;
                    const bool vl2[2] = {true, e1 < n};
                    const int tk2[2] = {tok0, vl2[1] ? (int)lists[NSA_RI(i) * 64 + (e1 & 63)] : 0};
                    if (j == cur) nsa_visit_gn<1, false, 2>(Ks, Vs, qs, Os, Ms, Ls, tk2, vl2, t4 & 63);
                    else nsa_visit_gn<0, true, 2>(Ks, Vs, qs, Os, Ms, Ls, tk2, vl2, t4 & 63);
                } else if (wv4 * 4 < n) {
                    const int e = wv4 * 4 + ts4;
                    const bool valid = e < n;
                    const int tok = valid ? tok0 : 0;
                    if (j == cur) nsa_visit_g<1, false>(Ks, Vs, qs, Os, Ms, Ls, tok, valid, t4 & 63);
                    else nsa_visit_g<0, true>(Ks, Vs, qs, Os, Ms, Ls, tok, valid, t4 & 63);
                }
                slot = (slot == 2) ? 0 : slot + 1;
            }
#undef NSA_RI
#undef NSA_ISSUE2
        }
        __syncthreads();
        NSA_TE(4)
        NSA_TS(5)
#pragma unroll
        for (int u = 0; u < 2; u++) {
            NSA_TOK(u)
            const int t5 = t3_ & 63;
            nsa_fold_lds(Os, Ms, Ls, (8 * (t3_ >> 6) + 4 * u + ((t5 & 15) >> 2)) * 4 + (t5 & 3), t5 >> 4, t5 & 3, T[u], p.nsag[ntk_ * 24 + hd_ * 3 + 1], true);
        }
        const u16* kwn = p.kwn + (size_t)bg * S_ * 64;
        const u16* vwnT = p.vwnT + (size_t)bg * 128 * 4096;
        uint2 Tp[2][4];
#pragma unroll
        for (int u = 0; u < 2; u++)
#pragma unroll
            for (int dt = 0; dt < 4; dt++) { Tp[u][dt] = pack4(T[u][dt]); asm volatile("" : "+v"(Tp[u][dt].x), "+v"(Tp[u][dt].y)); }
        {
            const int jlo = max(0, cur - 8);
            nsa_stream<true>(ring, cur - jlo + 1, [&](int i) { return kwn + (size_t)(cur - i) * 4096; }, [&](int i) { return vwnT + (size_t)(cur - i) * 4096; },
                [&](int i, const u16* Ks, const u16* Vs) {
                    const int j = cur - i;
                    const int t4 = get_tid();
                    const int tb_ = 8 * (t4 >> 6) + ((t4 & 15) >> 2);
                    const int tk2[2] = {tb_, tb_ + 4}; const bool vl2[2] = {true, true};
                    if (j == cur) nsa_visit_gn<1, false, 2>(Ks, Vs, qs, Os, Ms, Ls, tk2, vl2, t4 & 63);
                    else if (j == cur - 8) nsa_visit_gn<2, true, 2>(Ks, Vs, qs, Os, Ms, Ls, tk2, vl2, t4 & 63);
                    else nsa_visit_gn<0, true, 2>(Ks, Vs, qs, Os, Ms, Ls, tk2, vl2, t4 & 63);
                });
        }
#pragma unroll
        for (int u = 0; u < 2; u++) {
            NSA_TOK(u)
#pragma unroll
            for (int dt = 0; dt < 4; dt++) T[u][dt] = unpack4(Tp[u][dt]);
            { const int t5 = t3_ & 63; nsa_fold_lds(Os, Ms, Ls, (8 * (t3_ >> 6) + 4 * u + ((t5 & 15) >> 2)) * 4 + (t5 & 3), t5 >> 4, t5 & 3, T[u], p.nsag[ntk_ * 24 + hd_ * 3 + 2], false); }
#pragma unroll
            for (int dt = 0; dt < 4; dt++) *(uint2*)&p.oa[ntk_ * 512 + hd_ * 64 + dt * 16 + ((t3_ & 63) >> 4) * 4] = pack4(T[u][dt]);
        }
        NSA_TE(5)
    }
    if (NSAPROBE) { __syncthreads(); const unsigned long long t1_ = __builtin_amdgcn_s_memrealtime(); while (__builtin_amdgcn_s_memrealtime() - t1_ < tacc_) __builtin_amdgcn_s_sleep(8); }
}

#ifndef CHPROBE
#define CHPROBE 0
#endif
#define CH_TS(k) if (CHPROBE == k) cts_ = __builtin_amdgcn_s_memrealtime();
#define CH_TE(k) if (CHPROBE == k) ctacc_ += __builtin_amdgcn_s_memrealtime() - cts_;
constexpr int RS = 72;
constexpr int RSLOT = 64 * RS;
__device__ __forceinline__ void mm64(const u16* A, int lda, const u16* Bz, int ldb, f32x4 (&acc)[2], int lane, int wv) {
    const int mt = wv >> 1, nt0 = (wv & 1) * 2, kr = lane & 15, qq = lane >> 4;
    bf16x8 a[2], b[2][2];
#pragma unroll
    for (int ks = 0; ks < 2; ks++) {
        a[ks] = *(const bf16x8*)&A[(mt * 16 + kr) * lda + ks * 32 + qq * 8];
#pragma unroll
        for (int i = 0; i < 2; i++) b[ks][i] = *(const bf16x8*)&Bz[((nt0 + i) * 16 + kr) * ldb + ks * 32 + qq * 8];
    }
#pragma unroll
    for (int ks = 0; ks < 2; ks++)
#pragma unroll
        for (int i = 0; i < 2; i++) acc[i] = __builtin_amdgcn_mfma_f32_16x16x32_bf16(a[ks], b[ks][i], acc[i], 0, 0, 0);
}
__device__ __forceinline__ void st_t(u16* dst, int ld, const f32x4& v, int mt, int nt, int lane) {
    uint2 o; o.x = pack2(v[0], v[1]); o.y = pack2(v[2], v[3]);
    *(uint2*)&dst[(nt * 16 + (lane & 15)) * ld + mt * 16 + (lane >> 4) * 4] = o;
}
__device__ __forceinline__ void st_n(u16* dst, int ld, const f32x4& v, int mt, int nt, int lane) {
#pragma unroll
    for (int r = 0; r < 4; r++) dst[(mt * 16 + (lane >> 4) * 4 + r) * ld + nt * 16 + (lane & 15)] = f2bf(v[r]);
}
#define ZACC(a) { a[0] = f32x4{0.f, 0.f, 0.f, 0.f}; a[1] = f32x4{0.f, 0.f, 0.f, 0.f}; }

__device__ void ph_rwkv_chunk(const P& p, int bid, int nb, char* smem) {
    unsigned long long cts_ = 0, ctacc_ = 0;
    u16* sl = (u16*)smem;
    float* tot = (float*)(sl + 14 * RSLOT);
    float* gl = tot + 512;
#define RW_IDX const int tid = get_tid(), lane = tid & 63, wv = tid >> 6, mt = wv >> 1, nt0 = (wv & 1) * 2, kr = lane & 15, qq = lane >> 4; (void)mt; (void)nt0; (void)kr; (void)qq; (void)lane;
    const int nitems = B_ * 128;
    for (int it0 = bid; it0 < nitems; it0 += nb) {
      const int c = it0 & 127, b = it0 >> 7;
      const size_t n0 = (size_t)b * S_ + c * 64;
      __syncthreads();
      bf16x8 xa_[8], wb[2][2], ab[2][2], gb[2][4];
      u16 rc[8][3], rp0[3];
      float w0c[2], a0c[2], hc_[6];
#define S1_LOADW(hh_) { RW_IDX \
          _Pragma("unroll") for (int i = 0; i < 2; i++) { const int cc = (nt0 + i) * 16 + kr; w0c[i] = p.w0[(hh_) * 64 + cc]; a0c[i] = p.a0[(hh_) * 64 + cc]; \
              _Pragma("unroll") for (int ks = 0; ks < 2; ks++) { wb[i][ks] = *(const bf16x8*)&p.w2T[((size_t)(hh_) * 64 + cc) * 64 + ks * 32 + qq * 8]; \
                                                                 ab[i][ks] = *(const bf16x8*)&p.a2T[((size_t)(hh_) * 64 + cc) * 64 + ks * 32 + qq * 8]; } \
              _Pragma("unroll") for (int ks = 0; ks < 4; ks++) gb[i][ks] = *(const bf16x8*)&p.g2T[((size_t)(hh_) * 64 + cc) * 128 + ks * 32 + qq * 8]; } }
#define S2_LOADX(hh_) { RW_IDX const int ch_ = (hh_) * 64 + lane; \
          hc_[0] = p.mu[ch_]; hc_[1] = p.mu[512 + ch_]; hc_[2] = p.mu[1024 + ch_]; hc_[3] = p.k_k[ch_]; hc_[4] = p.k_a[ch_]; hc_[5] = p.r_k[ch_]; \
          _Pragma("unroll") for (int i = 0; i < 8; i++) { const int t = wv * 8 + i; const u16* cr = p.prw + (n0 + t) * CRW; \
              rc[i][0] = cr[ch_]; rc[i][1] = cr[512 + ch_]; rc[i][2] = cr[1024 + ch_]; } \
          rp0[0] = 0; rp0[1] = 0; rp0[2] = 0;     \
          if (c * 64 + wv * 8 > 0) { const u16* pp = p.prw + (n0 + wv * 8 - 1) * CRW; rp0[0] = pp[ch_]; rp0[1] = pp[512 + ch_]; rp0[2] = pp[1024 + ch_]; } }
      S2_LOADX(0)
      {
          RW_IDX
          const int t = tid >> 3, part = tid & 7;
          const size_t n = n0 + t;
          const bool hasprev = (c * 64 + t) > 0;
          u16* dst = p.xact + n * 256 + part * 32;
#pragma unroll
          for (int j = 0; j < 4; j++) {
              const int col = 1536 + part * 32 + j * 8;
              const uint4 cu = *(const uint4*)&p.prw[n * CRW + col];
              uint4 pv = make_uint4(0u, 0u, 0u, 0u);
              if (hasprev) pv = *(const uint4*)&p.prw[(n - 1) * CRW + col];
              const unsigned cw[4] = {cu.x, cu.y, cu.z, cu.w}, pw[4] = {pv.x, pv.y, pv.z, pv.w};
              unsigned ow[4];
#pragma unroll
              for (int e2 = 0; e2 < 4; e2++) {
                  float x0 = __uint_as_float(cw[e2] << 16), x1 = __uint_as_float(cw[e2] & 0xFFFF0000u);
                  const float q0 = __uint_as_float(pw[e2] << 16), q1 = __uint_as_float(pw[e2] & 0xFFFF0000u);
                  x0 = x0 + (q0 - x0) * p.mu[col + 2 * e2]; x1 = x1 + (q1 - x1) * p.mu[col + 2 * e2 + 1];
                  if (part < 2) { x0 = tanhf(x0); x1 = tanhf(x1); }
                  else if (part >= 4) { x0 = sigmoidf_(x0); x1 = sigmoidf_(x1); }
                  ow[e2] = pack2(x0, x1);
              }
              *(uint4*)&dst[j * 8] = make_uint4(ow[0], ow[1], ow[2], ow[3]);
          }
      }
      __syncthreads();
      const u16* xa = p.xact + n0 * 256;
      {
          RW_IDX
#pragma unroll
          for (int k8 = 0; k8 < 8; k8++) xa_[k8] = *(const bf16x8*)&xa[(mt * 16 + kr) * 256 + k8 * 32 + qq * 8];
      }
      S1_LOADW(0)
#pragma unroll 1
      for (int h = 0; h < 8; h++) {
        u16* cd = p.cdat + ((size_t)((b * 8 + h) * 128 + c)) * 4 * 4096;
        LDS_BARRIER();
        CH_TS(1)
        float* LW = (float*)(sl + 8 * RSLOT); float* LA = (float*)(sl + 10 * RSLOT);
        {
            RW_IDX
            f32x4 aw[2], aa2[2], ag[2];
#pragma unroll
            for (int i = 0; i < 2; i++) {
                aw[i] = f32x4{0.f, 0.f, 0.f, 0.f}; aa2[i] = aw[i]; ag[i] = aw[i];
#pragma unroll
                for (int ks = 0; ks < 2; ks++) {
                    aw[i] = __builtin_amdgcn_mfma_f32_16x16x32_bf16(xa_[ks], wb[i][ks], aw[i], 0, 0, 0);
                    aa2[i] = __builtin_amdgcn_mfma_f32_16x16x32_bf16(xa_[2 + ks], ab[i][ks], aa2[i], 0, 0, 0);
                }
#pragma unroll
                for (int ks = 0; ks < 4; ks++) ag[i] = __builtin_amdgcn_mfma_f32_16x16x32_bf16(xa_[4 + ks], gb[i][ks], ag[i], 0, 0, 0);
            }
#pragma unroll
            for (int i = 0; i < 2; i++)
#pragma unroll
                for (int r = 0; r < 4; r++) {
                    const int t = mt * 16 + qq * 4 + r, cc = (nt0 + i) * 16 + kr;
                    const float wl = w0c[i] + aw[i][r];
                    const float z = -wl;
                    const float sp = fmaxf(z, 0.f) + __logf(1.f + __expf(-fabsf(z)));
                    LW[t * 64 + cc] = -__expf(-sp - 0.5f);
                    LA[t * 64 + cc] = sigmoidf_(a0c[i] + aa2[i][r]);
                    p.ob[(n0 + t) * 512 + h * 64 + cc] = f2bf(ag[i][r]);
                }
        }
        LDS_BARRIER();
        CH_TE(1) CH_TS(2)
        {
            RW_IDX
            const int ch = h * 64 + lane;
            const float mur = hc_[0], muk = hc_[1], muv = hc_[2];
            const float kkw = hc_[3], kaw = hc_[4], rkw = hc_[5];
            float rr[8], k2[8], vv[8], kkn[8], aa[8], lg[8], cs[8];
            float run = 0.f;
#pragma unroll
            for (int i = 0; i < 8; i++) {
                const int t = wv * 8 + i; const size_t n = n0 + t;
                float r = bf2f(rc[i][0]), k = bf2f(rc[i][1]), v = bf2f(rc[i][2]);
                const float pr = bf2f(i ? rc[i - 1][0] : rp0[0]), pk = bf2f(i ? rc[i - 1][1] : rp0[1]), pv = bf2f(i ? rc[i - 1][2] : rp0[2]);
                r = r + (pr - r) * mur; k = k + (pk - k) * muk; v = v + (pv - v) * muv;
                const float a = LA[t * 64 + lane];
                lg[i] = LW[t * 64 + lane];
                float kk = k * kkw;
                kkn[i] = kk * __builtin_amdgcn_rsqf(fmaxf(wave_sum(kk * kk), 1e-24f));
                k2[i] = k * (1.f + (a - 1.f) * kaw);
                const float bon = wave_sum(r * k2[i] * rkw);
                if (lane == 0) p.bon[n * 8 + h] = bon;
                rr[i] = r; vv[i] = v; aa[i] = a;
                run += lg[i]; cs[i] = run;
            }
            tot[wv * 64 + lane] = run;
            LDS_BARRIER();
            float off = 0.f, cumL = 0.f;
#pragma unroll
            for (int w2 = 0; w2 < 8; w2++) { const float tv = tot[w2 * 64 + lane]; cumL += tv; if (w2 < wv) off += tv; }
            if (wv == 0) gl[lane] = __expf(cumL);
            unsigned pa[4], pb[4], pk4[4], pv4[4];
#pragma unroll
            for (int i = 0; i < 8; i += 2) {
                float at[2], bt[2], kt[2], rt[2];
#pragma unroll
                for (int e2 = 0; e2 < 2; e2++) {
                    const int ii = i + e2; const int t = wv * 8 + ii;
                    const float cm = off + cs[ii];
                    const float g = __expf(cm), gp = __expf(cm - lg[ii]), gi = __expf(-cm);
                    at[e2] = -kkn[ii] * gp; bt[e2] = kkn[ii] * aa[ii] * gi; kt[e2] = k2[ii] * gi; rt[e2] = rr[ii] * g;
                    sl[0 * RSLOT + t * RS + lane] = f2bf(at[e2]);
                    sl[1 * RSLOT + t * RS + lane] = f2bf(bt[e2]);
                    sl[2 * RSLOT + t * RS + lane] = f2bf(kt[e2]);
                    sl[3 * RSLOT + t * RS + lane] = f2bf(rt[e2]);
                }
                pa[i >> 1] = pack2(at[0], at[1]); pb[i >> 1] = pack2(bt[0], bt[1]);
                pk4[i >> 1] = pack2(kt[0], kt[1]); pv4[i >> 1] = pack2(vv[i], vv[i + 1]);
            }
            *(uint4*)&sl[4 * RSLOT + lane * RS + wv * 8] = make_uint4(pa[0], pa[1], pa[2], pa[3]);
            *(uint4*)&sl[5 * RSLOT + lane * RS + wv * 8] = make_uint4(pb[0], pb[1], pb[2], pb[3]);
            *(uint4*)&sl[6 * RSLOT + lane * RS + wv * 8] = make_uint4(pk4[0], pk4[1], pk4[2], pk4[3]);
            *(uint4*)&sl[7 * RSLOT + lane * RS + wv * 8] = make_uint4(pv4[0], pv4[1], pv4[2], pv4[3]);
        }
        LDS_BARRIER();
        if (h + 1 < 8) { asm volatile("s_waitcnt vmcnt(0)" ::: "memory");
                         S1_LOADW(h + 1) S2_LOADX(h + 1) }
        CH_TE(2) CH_TS(3)
        {
            RW_IDX
            f32x4 acc[2];
            ZACC(acc); mm64(sl + 1 * RSLOT, RS, sl + 0 * RSLOT, RS, acc, lane, wv);
#pragma unroll
            for (int i = 0; i < 2; i++) {
                f32x4 pm;
#pragma unroll
                for (int r = 0; r < 4; r++) {
                    const int m = mt * 16 + qq * 4 + r, n = (nt0 + i) * 16 + kr;
                    if (!(m < n)) acc[i][r] = 0.f;
                    pm[r] = acc[i][r] + ((m == n) ? 1.f : 0.f);
                }
                st_t(sl + 8 * RSLOT, RS, acc[i], mt, nt0 + i, lane);
                st_n(sl + 9 * RSLOT, RS, acc[i], mt, nt0 + i, lane);
                st_t(sl + 13 * RSLOT, RS, pm, mt, nt0 + i, lane);
            }
            ZACC(acc); mm64(sl + 0 * RSLOT, RS, sl + 2 * RSLOT, RS, acc, lane, wv);
#pragma unroll
            for (int i = 0; i < 2; i++) {
#pragma unroll
                for (int r = 0; r < 4; r++) { const int m = mt * 16 + qq * 4 + r, n = (nt0 + i) * 16 + kr; if (!(m > n)) acc[i][r] = 0.f; }
                st_t(sl + 10 * RSLOT, RS, acc[i], mt, nt0 + i, lane);
            }
            ZACC(acc); mm64(sl + 1 * RSLOT, RS, sl + 3 * RSLOT, RS, acc, lane, wv);
#pragma unroll
            for (int i = 0; i < 2; i++) {
#pragma unroll
                for (int r = 0; r < 4; r++) { const int m = mt * 16 + qq * 4 + r, n = (nt0 + i) * 16 + kr; if (m > n) acc[i][r] = 0.f; }
                st_t(sl + 11 * RSLOT, RS, acc[i], mt, nt0 + i, lane);
            }
            ZACC(acc); mm64(sl + 2 * RSLOT, RS, sl + 3 * RSLOT, RS, acc, lane, wv);
#pragma unroll
            for (int i = 0; i < 2; i++) {
#pragma unroll
                for (int r = 0; r < 4; r++) { const int m = mt * 16 + qq * 4 + r, n = (nt0 + i) * 16 + kr; if (m > n) acc[i][r] = 0.f; }
                st_t(sl + 12 * RSLOT, RS, acc[i], mt, nt0 + i, lane);
            }
        }
        LDS_BARRIER();
        CH_TE(3) CH_TS(4)
        u16* X = sl + 8 * RSLOT; u16* XT = sl + 9 * RSLOT; u16* X2 = sl + 0 * RSLOT; u16* X2T = sl + 1 * RSLOT;
        u16* Pc = sl + 13 * RSLOT; u16* Pn = sl + 2 * RSLOT;
#pragma unroll 1
        for (int j = 1; j <= 6; j++) {
            RW_IDX
            f32x4 acc[2];
            if (j <= 5) {
                ZACC(acc); mm64(X, RS, XT, RS, acc, lane, wv);
#pragma unroll
                for (int i = 0; i < 2; i++) { st_t(X2T, RS, acc[i], mt, nt0 + i, lane); st_n(X2, RS, acc[i], mt, nt0 + i, lane); }
            }
            if (j >= 2) {
                ZACC(acc); mm64(XT, RS, Pc, RS, acc, lane, wv);
#pragma unroll
                for (int i = 0; i < 2; i++) {
                    const uint2 pv = *(const uint2*)&Pc[((nt0 + i) * 16 + kr) * RS + mt * 16 + qq * 4];
                    acc[i][0] += __uint_as_float(pv.x << 16); acc[i][1] += __uint_as_float(pv.x & 0xFFFF0000u);
                    acc[i][2] += __uint_as_float(pv.y << 16); acc[i][3] += __uint_as_float(pv.y & 0xFFFF0000u);
                    st_t(Pn, RS, acc[i], mt, nt0 + i, lane);
                }
            }
            LDS_BARRIER();
            if (j >= 2) { u16* tp = Pc; Pc = Pn; Pn = tp; }
            if (j <= 5) { u16* tx = X; X = X2; X2 = tx; tx = XT; XT = X2T; X2T = tx; }
        }
        CH_TE(4) CH_TS(5)
        u16* TT = Pc;
        {
            RW_IDX
            f32x4 acc[2];
            ZACC(acc); mm64(TT, RS, sl + 4 * RSLOT, RS, acc, lane, wv);
#pragma unroll
            for (int i = 0; i < 2; i++) st_t(sl + 0 * RSLOT, RS, acc[i], mt, nt0 + i, lane);
            ZACC(acc); mm64(sl + 10 * RSLOT, RS, TT, RS, acc, lane, wv);
#pragma unroll
            for (int i = 0; i < 2; i++) st_t(sl + 8 * RSLOT, RS, acc[i], mt, nt0 + i, lane);
        }
        LDS_BARRIER();
        {
            RW_IDX
            f32x4 acc[2];
            ZACC(acc); mm64(sl + 8 * RSLOT, RS, sl + 7 * RSLOT, RS, acc, lane, wv);
#pragma unroll
            for (int i = 0; i < 2; i++) st_t(sl + 9 * RSLOT, RS, acc[i], mt, nt0 + i, lane);
            ZACC(acc); mm64(sl + 0 * RSLOT, RS, sl + 5 * RSLOT, RS, acc, lane, wv);
#pragma unroll
            for (int i = 0; i < 2; i++) {
                const int n = (nt0 + i) * 16 + kr; const float gn = gl[n];
#pragma unroll
                for (int r = 0; r < 4; r++) { const int m = mt * 16 + qq * 4 + r; acc[i][r] = acc[i][r] * gn + ((m == n) ? gn : 0.f); }
                st_t(cd, 64, acc[i], mt, nt0 + i, lane);
            }
            ZACC(acc); mm64(sl + 0 * RSLOT, RS, sl + 11 * RSLOT, RS, acc, lane, wv);
#pragma unroll
            for (int i = 0; i < 2; i++) {
                const uint2 rv = *(const uint2*)&sl[3 * RSLOT + ((nt0 + i) * 16 + kr) * RS + mt * 16 + qq * 4];
                acc[i][0] += __uint_as_float(rv.x << 16); acc[i][1] += __uint_as_float(rv.x & 0xFFFF0000u);
                acc[i][2] += __uint_as_float(rv.y << 16); acc[i][3] += __uint_as_float(rv.y & 0xFFFF0000u);
                st_t(cd + 2 * 4096, 64, acc[i], mt, nt0 + i, lane);
            }
        }
        LDS_BARRIER();
        {
            RW_IDX
            f32x4 acc[2];
            ZACC(acc);
            mm64(sl + 5 * RSLOT, RS, sl + 9 * RSLOT, RS, acc, lane, wv);
            mm64(sl + 6 * RSLOT, RS, sl + 7 * RSLOT, RS, acc, lane, wv);
#pragma unroll
            for (int i = 0; i < 2; i++) {
#pragma unroll
                for (int r = 0; r < 4; r++) acc[i][r] *= gl[mt * 16 + qq * 4 + r];
                st_t(cd + 1 * 4096, 64, acc[i], mt, nt0 + i, lane);
            }
            ZACC(acc);
            mm64(sl + 9 * RSLOT, RS, sl + 11 * RSLOT, RS, acc, lane, wv);
            mm64(sl + 7 * RSLOT, RS, sl + 12 * RSLOT, RS, acc, lane, wv);
#pragma unroll
            for (int i = 0; i < 2; i++) st_t(cd + 3 * 4096, 64, acc[i], mt, nt0 + i, lane);
        }
        CH_TE(5)
      }
    }
    if (CHPROBE) { __syncthreads(); const unsigned long long t1_ = __builtin_amdgcn_s_memrealtime(); while (__builtin_amdgcn_s_memrealtime() - t1_ < ctacc_) __builtin_amdgcn_s_sleep(8); }
}

__device__ void ph_rwkv_seq(const P& p, int bid, int nb, char* smem) {
    u16* SL = (u16*)smem;
    const int tid = get_tid(), lane = tid & 63, wv = __builtin_amdgcn_readfirstlane(tid >> 6);
    const int kr = lane & 15, qq = lane >> 4, chn = wv >> 2, vt = wv & 3;
    for (int pair = bid; pair < B_ * 4; pair += nb) {
        const int bh = pair * 2 + chn;
        u16* mySL = SL + chn * RSLOT;
        __syncthreads();
#pragma unroll
        for (int ks = 0; ks < 2; ks++) *(uint4*)&mySL[(vt * 16 + kr) * RS + ks * 32 + qq * 8] = make_uint4(0u, 0u, 0u, 0u);
        u16* cbase = p.cdat + (size_t)bh * 128 * 4 * 4096;
        bf16x8 GA0[4][2], GA1[4][2], GA2[4][2], GA3[4][2]; u32x2 H0[4], H1[4], H2[4], H3[4];
#define SEQ_LD(GAx, Hx, c) { const u16* g0_ = cbase + (size_t)(c) * 4 * 4096 + kr * 64 + qq * 8; const u16* g1_ = g0_ + 2048; \
            const u16* hp_ = cbase + (size_t)(c) * 4 * 4096 + 4096 + (vt * 16 + kr) * 64 + qq * 4; \
            GAx[0][0] = gload_b128<0>(g0_); GAx[0][1] = gload_b128<64>(g0_); GAx[1][0] = gload_b128<2048>(g0_); GAx[1][1] = gload_b128<2112>(g0_); \
            GAx[2][0] = gload_b128<0>(g1_); GAx[2][1] = gload_b128<64>(g1_); GAx[3][0] = gload_b128<2048>(g1_); GAx[3][1] = gload_b128<2112>(g1_); \
            Hx[0] = gload_b64<0>(hp_); Hx[1] = gload_b64<32>(hp_); Hx[2] = gload_b64<64>(hp_); Hx[3] = gload_b64<96>(hp_); }
#define SEQ_STEP(GAx, Hx, c, nw) { \
            if ((nw) == 48) asm volatile("s_waitcnt vmcnt(48)" ::: "memory"); else if ((nw) == 36) asm volatile("s_waitcnt vmcnt(36)" ::: "memory"); \
            else if ((nw) == 24) asm volatile("s_waitcnt vmcnt(24)" ::: "memory"); else asm volatile("s_waitcnt vmcnt(12)" ::: "memory"); \
              \
            asm volatile("" : "+v"(GAx[0][0]), "+v"(GAx[0][1]), "+v"(GAx[1][0]), "+v"(GAx[1][1]), "+v"(GAx[2][0]), "+v"(GAx[2][1]), "+v"(GAx[3][0]), "+v"(GAx[3][1]), \
                              "+v"(Hx[0]), "+v"(Hx[1]), "+v"(Hx[2]), "+v"(Hx[3]) :: "memory"); \
            bf16x8 Z0[2]; \
            _Pragma("unroll") for (int ks = 0; ks < 2; ks++) Z0[ks] = *(const bf16x8*)&mySL[(vt * 16 + kr) * RS + ks * 32 + qq * 8]; \
            f32x4 zs[4]; \
            _Pragma("unroll") for (int m4 = 0; m4 < 4; m4++) { \
                zs[m4] = unpack4(make_uint2(Hx[m4].x, Hx[m4].y)); \
                _Pragma("unroll") for (int ks = 0; ks < 2; ks++) zs[m4] = __builtin_amdgcn_mfma_f32_16x16x32_bf16(GAx[m4][ks], Z0[ks], zs[m4], 0, 0, 0); } \
            u16* sn_ = cbase + (size_t)(c) * 4 * 4096 + 1 * 4096 + (vt * 16 + kr) * 64 + qq * 4; \
            _Pragma("unroll") for (int m4 = 0; m4 < 4; m4++) { \
                const uint2 pk_ = pack4(zs[m4]); \
                *(uint2*)&mySL[(vt * 16 + kr) * RS + m4 * 16 + qq * 4] = pk_; \
                *(uint2*)&sn_[m4 * 16] = pk_; } \
            asm volatile("" ::: "memory"); \
            if ((c) + 4 < 128) SEQ_LD(GAx, Hx, (c) + 4) }
        asm volatile("s_waitcnt vmcnt(0)" ::: "memory");
        SEQ_LD(GA0, H0, 0) SEQ_LD(GA1, H1, 1) SEQ_LD(GA2, H2, 2) SEQ_LD(GA3, H3, 3)
#pragma unroll 1
        for (int c = 0; c < 128; c += 4) {
            const bool first = (c == 0), lastt = (c == 124);
            SEQ_STEP(GA0, H0, c, first ? 36 : 48)
            SEQ_STEP(GA1, H1, c + 1, (first || lastt) ? 36 : 48)
            SEQ_STEP(GA2, H2, c + 2, first ? 36 : (lastt ? 24 : 48))
            SEQ_STEP(GA3, H3, c + 3, lastt ? 12 : 48)
        }
        asm volatile("s_waitcnt vmcnt(0)" ::: "memory");
#undef SEQ_LD
#undef SEQ_STEP
    }
}

__device__ void ph_rwkv_out(const P& p, int bid, int nb, char* smem) {
    const int tid = get_tid(), lane = tid & 63, wv = tid >> 6;
    const int kr = lane & 15, qq = lane >> 4;
    for (int it = bid * NW + wv; it < B_ * 8 * 128; it += nb * NW) {
        const int c = it & 127, bh = it >> 7, b = bh >> 3, h = bh & 7;
        const u16* cd = p.cdat + ((size_t)bh * 128 + c) * 4 * 4096;
        f32x4 ys[4][4];
#pragma unroll
        for (int mt = 0; mt < 4; mt++)
#pragma unroll
            for (int nt = 0; nt < 4; nt++) ys[mt][nt] = unpack4(*(const uint2*)&cd[3 * 4096 + (nt * 16 + kr) * 64 + mt * 16 + qq * 4]);
        if (c > 0) {
            const u16* s0 = cd - 4 * 4096 + 1 * 4096;
#pragma unroll
            for (int ks = 0; ks < 2; ks++) {
                bf16x8 af[4], bq[4];
#pragma unroll
                for (int mt = 0; mt < 4; mt++) af[mt] = *(const bf16x8*)&s0[(mt * 16 + kr) * 64 + ks * 32 + qq * 8];
#pragma unroll
                for (int nt = 0; nt < 4; nt++) bq[nt] = *(const bf16x8*)&cd[2 * 4096 + (nt * 16 + kr) * 64 + ks * 32 + qq * 8];
#pragma unroll
                for (int mt = 0; mt < 4; mt++)
#pragma unroll
                    for (int nt = 0; nt < 4; nt++) ys[mt][nt] = __builtin_amdgcn_mfma_f32_16x16x32_bf16(af[mt], bq[nt], ys[mt][nt], 0, 0, 0);
            }
        }
#pragma unroll
        for (int nt = 0; nt < 4; nt++) {
            float s1 = 0.f, s2 = 0.f;
#pragma unroll
            for (int mt = 0; mt < 4; mt++)
#pragma unroll
                for (int r = 0; r < 4; r++) { s1 += ys[mt][nt][r]; s2 += ys[mt][nt][r] * ys[mt][nt][r]; }
            s1 = xrow_sum(s1); s2 = xrow_sum(s2);
            const float mean = s1 * (1.f / 64.f);
            const float var = fmaxf(s2 * (1.f / 64.f) - mean * mean, 0.f);
            const float rstd = rsqrtf(var + 64e-5f);
            const int t = nt * 16 + kr;
            const size_t n = (size_t)b * S_ + c * 64 + t;
            const float bon = p.bon[n * 8 + h];
#pragma unroll
            for (int mt = 0; mt < 4; mt++) {
                const int vch = h * 64 + mt * 16 + qq * 4;
                const f32x4 vcf = unpack4(*(const uint2*)&p.prw[n * CRW + 1024 + vch]);
                const f32x4 vpf = (c * 64 + t > 0) ? unpack4(*(const uint2*)&p.prw[(n - 1) * CRW + 1024 + vch]) : f32x4{0.f, 0.f, 0.f, 0.f};
                const f32x4 ggf = unpack4(*(const uint2*)&p.ob[n * 512 + vch]);
                const float4 lw = *(const float4*)&p.ln_w[vch], lb = *(const float4*)&p.ln_b[vch], mv = *(const float4*)&p.mu[1024 + vch];
                const float lwa[4] = {lw.x, lw.y, lw.z, lw.w}, lba[4] = {lb.x, lb.y, lb.z, lb.w}, mva[4] = {mv.x, mv.y, mv.z, mv.w};
                f32x4 o;
#pragma unroll
                for (int r = 0; r < 4; r++) {
                    const float vsh = vcf[r] + (vpf[r] - vcf[r]) * mva[r];
                    o[r] = ((ys[mt][nt][r] - mean) * rstd * lwa[r] + lba[r] + bon * vsh) * ggf[r];
                }
                *(uint2*)&p.ob[n * 512 + vch] = pack4(o);
            }
        }
    }
}

__device__ __forceinline__ void unpack8(const uint4& u, f32x4& a, f32x4& b) {
    a = f32x4{__uint_as_float(u.x << 16), __uint_as_float(u.x & 0xFFFF0000u), __uint_as_float(u.y << 16), __uint_as_float(u.y & 0xFFFF0000u)};
    b = f32x4{__uint_as_float(u.z << 16), __uint_as_float(u.z & 0xFFFF0000u), __uint_as_float(u.w << 16), __uint_as_float(u.w & 0xFFFF0000u)};
}
struct EpiMerge {
    u16* merged; u16* tmp2; int pass;
    __device__ __forceinline__ void operator()(const f32x4 (&acc)[2][2][4][2], const GUnit& u, int, int, int, int) const {
        const int t2_ = get_tid(), wid_ = __builtin_amdgcn_readfirstlane(t2_ >> 6), wr = wid_ >> 2, wc = wid_ & 3, fr = t2_ & 15, fq = (t2_ >> 4) & 3;
        const int row0 = u.pm * 256 + wr * 64 + fr;
        if (pass < 2) {
            u16* dst = pass ? tmp2 : merged;
            const int col0 = u.pn * 256 + wc * 32 + 8 * fq;
#pragma unroll
            for (int ai = 0; ai < 2; ++ai)
#pragma unroll
                for (int m = 0; m < 4; ++m) {
                    const size_t off = (size_t)(row0 + ai * 128 + m * 16) * D_ + col0;
#pragma unroll
                    for (int bj = 0; bj < 2; ++bj) *(uint4*)&dst[off + bj * 128] = pack8(acc[ai][bj][m][0], acc[ai][bj][m][1]);
                }
        } else {
            const int col0 = u.pn * 128 + wc * 32 + 8 * fq;
#pragma unroll
            for (int ai = 0; ai < 2; ++ai)
#pragma unroll
                for (int m = 0; m < 4; ++m) {
                    const size_t off = (size_t)(row0 + ai * 128 + m * 16) * D_ + col0;
                    const uint4 ma = *(const uint4*)&merged[off], mb = *(const uint4*)&tmp2[off];
                    f32x4 a0, a1, b0, b1; unpack8(ma, a0, a1); unpack8(mb, b0, b1);
                    f32x4 v0, v1;
#pragma unroll
                    for (int r = 0; r < 4; r++) {
                        v0[r] = a0[r] * sigmoidf_(acc[ai][0][m][0][r]) + b0[r] * sigmoidf_(acc[ai][1][m][0][r]);
                        v1[r] = a1[r] * sigmoidf_(acc[ai][0][m][1][r]) + b1[r] * sigmoidf_(acc[ai][1][m][1][r]);
                    }
                    *(uint4*)&merged[off] = pack8(v0, v1);
                    asm volatile("" ::: "memory");
                }
        }
    }
};
struct MergeSched {
    DenseSched d; bool split;
    __device__ __forceinline__ bool next(int i, GUnit& u) const {
        if (!split) return d.next(i, u);
        if (!d.next(i >> 1, u)) return false;
        u.pn = 2 * u.pn + (i & 1); return true;
    }
    __device__ __forceinline__ unsigned a_off(const GUnit& u, int h, int R) const { return d.a_off(u, h, R); }
    __device__ __forceinline__ const char* b_ptr(const GUnit& u) const { return d.b_ptr(u); }
};
__device__ void ph_merge(const P& p, int bid, int nb, char* smem) {
    u16* tmp2 = (u16*)p.x1;
#pragma unroll 1
    for (int pass = 0; pass < 3; ++pass) {
        const int K = (pass == 2) ? D_ : 512;
        const u16* A = (pass == 2) ? p.hbuf : (pass == 0 ? p.oa : p.ob);
        const u16* Bt = (pass == 0) ? p.wpaT : (pass == 1 ? p.wpbT : p.wgT);
        MergeSched S; S.d.init(NTOK, D_, K, Bt, nb, bid); S.split = (pass == 2);
        EpiMerge E{p.merged, tmp2, pass};
        gemm256(smem, (const char*)A, K, S, E);
    }
}

struct EpiOutproj {
    const float* x; float* x1;
    __device__ __forceinline__ void operator()(const f32x4 (&acc)[2][2][4][2], const GUnit& u, int, int, int, int) const {
        const int t2_ = get_tid(), wid_ = __builtin_amdgcn_readfirstlane(t2_ >> 6), wr = wid_ >> 2, wc = wid_ & 3, fr = t2_ & 15, fq = (t2_ >> 4) & 3;
        const int row0 = u.pm * 256 + wr * 64 + fr, col0 = u.pn * 256 + wc * 32 + 4 * fq;
#pragma unroll
        for (int ai = 0; ai < 2; ++ai)
#pragma unroll
            for (int m = 0; m < 4; ++m) {
                const size_t off = (size_t)(row0 + ai * 128 + m * 16) * D_ + col0;
                f32x4 xin[2][2];
#pragma unroll
                for (int bj = 0; bj < 2; ++bj)
#pragma unroll
                    for (int n = 0; n < 2; ++n) xin[bj][n] = *(const f32x4*)&x[off + bj * 128 + n * 16];
#pragma unroll
                for (int bj = 0; bj < 2; ++bj)
#pragma unroll
                    for (int n = 0; n < 2; ++n) *(f32x4*)&x1[off + bj * 128 + n * 16] = xin[bj][n] + acc[ai][bj][m][n];
                asm volatile("" ::: "memory");
            }
    }
};
__device__ void ph_outproj(const P& p, int bid, int nb, char* smem) {
    DenseSched S; S.init(NTOK, D_, D_, p.woutT, nb, bid);
    EpiOutproj E{p.x, p.x1};
    gemm256(smem, (const char*)p.merged, D_, S, E);
}

__device__ __forceinline__ float red8f(float x) {
    x += dppf<0xB1>(x);
    x += dppf<0x4E>(x);
    x += dppf<0x141>(x);
    return x;
}
__device__ void ph_route(const P& p, int bid, int nb, char* smem) {
    float* wr = (float*)smem;
    const int tid = get_tid(), lane = tid & 63, wv = tid >> 6;
    {
        u16* Tl = (u16*)smem;
        const int t = get_tid();
        const int lrow = t >> 3, lc8 = (t & 7) * 8;
        const int sslot = t >> 3, skc = t & 7;
        const int scol = (sslot & 32) + perm32(sslot & 31);
        constexpr int NT13 = NEXP * 2 * 4 * 16, NT2 = NEXP * 16 * 4;
        for (int tile = bid; tile < NT13 + NT2; tile += nb) {
            const float* src; u16* dst; int N, Kd;
            if (tile < NT13) {
                const int kt = tile & 15, sg = (tile >> 4) & 3, half = (tile >> 6) & 1, e = tile >> 7;
                const int sl0 = sg * 64;
                N = 256; Kd = D_;
                src = ((sl0 >> 7) ? p.e_w3 : p.e_w1) + (size_t)e * D_ * 256 + (size_t)(kt * 64) * 256 + half * 128 + (sl0 & 127);
                dst = p.ew1T + ((size_t)e * 512 + half * 256 + sl0) * D_ + kt * 64;
            } else {
                const int t2 = tile - NT13;
                const int kt = t2 & 3, sg = (t2 >> 2) & 15, e = t2 >> 6;
                N = D_; Kd = 256;
                src = p.e_w2 + (size_t)e * 256 * D_ + (size_t)(kt * 64) * D_ + sg * 64;
                dst = p.ew2T + ((size_t)e * D_ + sg * 64) * 256 + kt * 64;
            }
            const float4 f0 = *(const float4*)&src[(size_t)lrow * N + lc8], f1 = *(const float4*)&src[(size_t)lrow * N + lc8 + 4];
            __syncthreads();
            const unsigned h0 = pack2(f0.x, f0.y), h1 = pack2(f0.z, f0.w), h2 = pack2(f1.x, f1.y), h3 = pack2(f1.z, f1.w);
            Tl[(lc8 + 0) * 72 + lrow] = (u16)(h0 & 0xFFFFu); Tl[(lc8 + 1) * 72 + lrow] = (u16)(h0 >> 16);
            Tl[(lc8 + 2) * 72 + lrow] = (u16)(h1 & 0xFFFFu); Tl[(lc8 + 3) * 72 + lrow] = (u16)(h1 >> 16);
            Tl[(lc8 + 4) * 72 + lrow] = (u16)(h2 & 0xFFFFu); Tl[(lc8 + 5) * 72 + lrow] = (u16)(h2 >> 16);
            Tl[(lc8 + 6) * 72 + lrow] = (u16)(h3 & 0xFFFFu); Tl[(lc8 + 7) * 72 + lrow] = (u16)(h3 >> 16);
            __syncthreads();
            *(uint4*)&dst[(size_t)sslot * Kd + skc * 8] = *(const uint4*)&Tl[scol * 72 + skc * 8];
        }
        __syncthreads();
    }
    for (int i = tid; i < 1024 * 36; i += NT) {
        const int k = i / 36, j = i - k * 36;
        const int kp = (k & ~31) + ((k & 3) << 3) + ((k >> 2) & 7);
        wr[kp * 36 + j] = (j < 4) ? p.w_grp[k * 4 + j] : p.w_exp[k * 32 + (j - 4)];
    }
    int* lcount = (int*)(smem + 1024 * 36 * 4);
    if (tid < 32) lcount[tid] = 0;
    __syncthreads();
    const int sub = lane & 7, tk = lane >> 3;
    for (int n0 = (bid * NW + wv) * 16; n0 < NTOK; n0 += nb * NW * 16) {
        float acc[2][36]; float ss[2] = {0.f, 0.f};
#pragma unroll
        for (int t = 0; t < 2; t++)
#pragma unroll
            for (int j = 0; j < 36; j++) acc[t][j] = 0.f;
#pragma unroll 1
        for (int i0 = 0; i0 < 32; i0 += 4) {
            float4 xv[2][4];
#pragma unroll
            for (int t = 0; t < 2; t++)
#pragma unroll
                for (int i = 0; i < 4; i++) xv[t][i] = *(const float4*)&p.x1[(size_t)(n0 + 8 * t + tk) * D_ + (i0 + i) * 32 + sub * 4];
#pragma unroll
            for (int i = 0; i < 4; i++) {
                const int k0 = (i0 + i) * 32 + sub * 4;
                const float4 gf = *(const float4*)&p.g_ffn[k0];
                float hv[2][4];
#pragma unroll
                for (int t = 0; t < 2; t++) {
                    const float4 x = xv[t][i];
                    ss[t] += x.x * x.x + x.y * x.y + x.z * x.z + x.w * x.w;
                    hv[t][0] = x.x * gf.x; hv[t][1] = x.y * gf.y; hv[t][2] = x.z * gf.z; hv[t][3] = x.w * gf.w;
                    uint2 o; o.x = pack2(hv[t][0], hv[t][1]); o.y = pack2(hv[t][2], hv[t][3]);
                    *(uint2*)&p.hbuf[(size_t)(n0 + 8 * t + tk) * D_ + k0] = o;
                }
#pragma unroll
                for (int e2 = 0; e2 < 4; e2++) {
                    asm volatile("" ::: "memory");
                    const float* wrow = wr + ((i0 + i) * 32 + e2 * 8 + sub) * 36;
#pragma unroll
                    for (int j4 = 0; j4 < 9; j4++) {
                        const float4 wv4 = *(const float4*)&wrow[j4 * 4];
#pragma unroll
                        for (int t = 0; t < 2; t++) {
                            acc[t][j4 * 4 + 0] += hv[t][e2] * wv4.x; acc[t][j4 * 4 + 1] += hv[t][e2] * wv4.y;
                            acc[t][j4 * 4 + 2] += hv[t][e2] * wv4.z; acc[t][j4 * 4 + 3] += hv[t][e2] * wv4.w;
                        }
                    }
                }
            }
        }
#pragma unroll
        for (int t = 0; t < 2; t++) {
            const size_t n = (size_t)n0 + 8 * t + tk;
            const float sst = red8f(ss[t]);
#pragma unroll
            for (int j = 0; j < 36; j++) acc[t][j] = red8f(acc[t][j]);
            const float rs = rsqrtf(sst * (1.f / D_) + 1e-6f);
            if (sub == 0) {
                p.rsb[n] = rs;
                float gl[4]; int gs = 0;
#pragma unroll
                for (int j = 0; j < 4; j++) gl[j] = acc[t][j] * rs + p.b_grp[j];
                float gm = gl[0];
#pragma unroll
                for (int j = 1; j < 4; j++) if (gl[j] > gm) { gm = gl[j]; gs = j; }
                float gsum = 0.f;
#pragma unroll
                for (int j = 0; j < 4; j++) gsum += __expf(gl[j] - gm);
                const float pg = 1.f / gsum;
                float el[8]; float em = -3.0e38f;
#pragma unroll
                for (int j = 0; j < 8; j++) {
                    float a = (gs == 0) ? acc[t][4 + j] : ((gs == 1) ? acc[t][12 + j] : ((gs == 2) ? acc[t][20 + j] : acc[t][28 + j]));
                    a = a * rs + p.b_exp[gs * 8 + j];
                    el[j] = a; em = fmaxf(em, a);
                }
                int j0 = 0, j1 = -1; float v0 = -3.0e38f, v1 = -3.0e38f;
#pragma unroll
                for (int j = 0; j < 8; j++) { el[j] = __expf(el[j] - em); }
#pragma unroll
                for (int j = 0; j < 8; j++) { if (el[j] > v0) { v0 = el[j]; j0 = j; } }
#pragma unroll
                for (int j = 0; j < 8; j++) { if (j != j0 && el[j] > v1) { v1 = el[j]; j1 = j; } }
                const float den = v0 + v1;
                const int e0 = gs * 8 + j0, e1 = gs * 8 + j1;
                p.tok_e[n * 2] = e0; p.tok_e[n * 2 + 1] = e1;
                p.tok_gate[n * 2] = pg * v0 / den; p.tok_gate[n * 2 + 1] = pg * v1 / den;
                atomicAdd(&lcount[e0], 1); atomicAdd(&lcount[e1], 1);
            }
        }
    }
    __syncthreads();
    { const int t2 = get_tid(); if (t2 < 32) { const int c = lcount[t2]; if (c) atomicAdd(&p.counts[t2], c); } }
}

__device__ void ph_scatter(const P& p, int bid, int nb, char* smem) {
    int* offl = (int*)smem;
    int* hist = offl + 64;
    int* gbase = hist + 32;
    const int tid = get_tid();
    if (tid == 0) {
        int off = 0;
        for (int e = 0; e < NEXP; e++) { offl[e] = off; off += p.counts[e]; }
        offl[NEXP] = off;
    }
    if (bid == 0 && tid == 64) {
        int off = 0, nb_ = 0;
        for (int e = 0; e < NEXP; e++) {
            const int c = p.counts[e];
            p.offs[e] = off;
            for (int r = 0; r < c; r += 256) { p.blk_e[nb_] = e; p.blk_r0[nb_] = off + r; nb_++; }
            off += c;
        }
        p.offs[NEXP] = off;
        *p.nblk = nb_;
    }
    for (int base = bid * NT; base < NTOK * 2; base += nb * NT) {
        __syncthreads();
        if (tid < 32) hist[tid] = 0;
        __syncthreads();
        const int i = base + tid;
        const int e = p.tok_e[i];
        const int rl = atomicAdd(&hist[e], 1);
        __syncthreads();
        if (tid < 32) gbase[tid] = atomicAdd(&p.cursor[tid], hist[tid]);
        __syncthreads();
        const int slot = offl[e] + gbase[e] + rl;
        p.list_tok[slot] = i >> 1; p.list_gate[slot] = p.tok_gate[i]; p.tokslot[i] = slot;
    }
}
template <int CTS>
struct MoeSched {
    const P* pp; int nunits, G, c; unsigned rowbytes; const u16* Bt; size_t b_estride, b_tstride;
    bool gather;
    __device__ __forceinline__ bool next(int i, GUnit& u) const {
        const int L = i * G + c; if (L >= nunits) return false;
        int wgid = L; { const int q = nunits >> 3, r = nunits & 7, xcd = wgid & 7, off = wgid >> 3; wgid = (xcd < r ? xcd * (q + 1) : r * (q + 1) + (xcd - r) * q) + off; }
        u.pm = wgid / CTS; u.pn = wgid & (CTS - 1); return true;
    }
    __device__ __forceinline__ unsigned a_off(const GUnit& u, int h, int R) const {
        const P& p = *pp;
        const int e = __builtin_amdgcn_readfirstlane(p.blk_e[u.pm]), rend = __builtin_amdgcn_readfirstlane(p.offs[e + 1]);
        int sl = __builtin_amdgcn_readfirstlane(p.blk_r0[u.pm]) + h * 128 + R; if (sl >= rend) sl = rend - 1;
        return (unsigned)(gather ? p.list_tok[sl] : sl) * rowbytes;
    }
    __device__ __forceinline__ const char* b_ptr(const GUnit& u) const { return (const char*)(Bt + (size_t)__builtin_amdgcn_readfirstlane(pp->blk_e[u.pm]) * b_estride + (size_t)u.pn * b_tstride); }
};
struct EpiMoe1 {
    const P* pp;
    __device__ __forceinline__ void operator()(const f32x4 (&acc)[2][2][4][2], const GUnit& u, int, int, int, int) const {
        const int t2_ = get_tid(), wid_ = __builtin_amdgcn_readfirstlane(t2_ >> 6), wr = wid_ >> 2, wc = wid_ & 3, fr = t2_ & 15, fq = (t2_ >> 4) & 3;
        const P& p = *pp;
        const int e = __builtin_amdgcn_readfirstlane(p.blk_e[u.pm]), r0 = __builtin_amdgcn_readfirstlane(p.blk_r0[u.pm]), rend = __builtin_amdgcn_readfirstlane(p.offs[e + 1]);
#pragma unroll
        for (int ai = 0; ai < 2; ++ai)
#pragma unroll
            for (int m = 0; m < 4; ++m) {
                const int sl = r0 + ai * 128 + wr * 64 + m * 16 + fr;
                if (sl < rend) {
                    const float rs = p.rsb[p.list_tok[sl]];
                    f32x4 v[2];
#pragma unroll
                    for (int n = 0; n < 2; ++n)
#pragma unroll
                        for (int r = 0; r < 4; r++) { const float a = acc[ai][0][m][n][r] * rs; v[n][r] = a * sigmoidf_(a) * (acc[ai][1][m][n][r] * rs); }
                    *(uint4*)&p.hid[(size_t)sl * 256 + u.pn * 128 + wc * 32 + 8 * fq] = pack8(v[0], v[1]);
                }
            }
    }
};
__device__ void ph_moe1(const P& p, int bid, int nb, char* smem) {
    MoeSched<2> S{&p, __builtin_amdgcn_readfirstlane(*p.nblk) * 2, nb, bid, (unsigned)(D_ * 2), p.ew1T, (size_t)512 * D_, (size_t)256 * D_, true};
    EpiMoe1 E{&p};
    gemm256(smem, (const char*)p.hbuf, D_, S, E);
}
struct EpiMoe2 {
    const P* pp;
    __device__ __forceinline__ void operator()(const f32x4 (&acc)[2][2][4][2], const GUnit& u, int, int, int, int) const {
        const int t2_ = get_tid(), wid_ = __builtin_amdgcn_readfirstlane(t2_ >> 6), wr = wid_ >> 2, wc = wid_ & 3, fr = t2_ & 15, fq = (t2_ >> 4) & 3;
        const P& p = *pp;
        const int e = __builtin_amdgcn_readfirstlane(p.blk_e[u.pm]), r0 = __builtin_amdgcn_readfirstlane(p.blk_r0[u.pm]), rend = __builtin_amdgcn_readfirstlane(p.offs[e + 1]);
#pragma unroll
        for (int ai = 0; ai < 2; ++ai)
#pragma unroll
            for (int m = 0; m < 4; ++m) {
                const int sl = r0 + ai * 128 + wr * 64 + m * 16 + fr;
                if (sl < rend) {
                    const float gt = p.list_gate[sl];
                    u16* yp = p.ybuf + (size_t)sl * D_ + u.pn * 256 + wc * 32 + 8 * fq;
#pragma unroll
                    for (int bj = 0; bj < 2; ++bj) *(uint4*)&yp[bj * 128] = pack8(acc[ai][bj][m][0] * gt, acc[ai][bj][m][1] * gt);
                }
            }
    }
};
__device__ void ph_moe2(const P& p, int bid, int nb, char* smem) {
    MoeSched<4> S{&p, __builtin_amdgcn_readfirstlane(*p.nblk) * 4, nb, bid, 512u, p.ew2T, (size_t)D_ * 256, (size_t)256 * 256, false};
    EpiMoe2 E{&p};
    gemm256(smem, (const char*)p.hid, 256, S, E);
}
__device__ void ph_final(const P& p, int bid, int nb, char* smem) {
    const int tid = get_tid(), lane = tid & 63, wv = tid >> 6;
    for (int row = bid * NW + wv; row < NTOK; row += nb * NW) {
        const int s0 = p.tokslot[row * 2], s1 = p.tokslot[row * 2 + 1];
        float v[16]; float ss = 0.f;
#pragma unroll
        for (int i = 0; i < 4; i++) {
            const int c = i * 256 + lane * 4;
            const float4 t = *(const float4*)&p.x1[(size_t)row * D_ + c];
            const uint2 a = *(const uint2*)&p.ybuf[(size_t)s0 * D_ + c];
            const uint2 bq = *(const uint2*)&p.ybuf[(size_t)s1 * D_ + c];
            v[4 * i]     = t.x + __uint_as_float(a.x << 16) + __uint_as_float(bq.x << 16);
            v[4 * i + 1] = t.y + __uint_as_float(a.x & 0xFFFF0000u) + __uint_as_float(bq.x & 0xFFFF0000u);
            v[4 * i + 2] = t.z + __uint_as_float(a.y << 16) + __uint_as_float(bq.y << 16);
            v[4 * i + 3] = t.w + __uint_as_float(a.y & 0xFFFF0000u) + __uint_as_float(bq.y & 0xFFFF0000u);
            ss += v[4 * i] * v[4 * i] + v[4 * i + 1] * v[4 * i + 1] + v[4 * i + 2] * v[4 * i + 2] + v[4 * i + 3] * v[4 * i + 3];
        }
        ss = wave_sum(ss);
        const float rs = rsqrtf(ss * (1.f / D_) + 1e-6f);
#pragma unroll
        for (int i = 0; i < 4; i++) {
            const int c = i * 256 + lane * 4;
            const float4 g = *(const float4*)&p.g_final[c];
            float4 o; o.x = v[4 * i] * rs * g.x; o.y = v[4 * i + 1] * rs * g.y; o.z = v[4 * i + 2] * rs * g.z; o.w = v[4 * i + 3] * rs * g.w;
            *(float4*)&p.out[(size_t)row * D_ + c] = o;
        }
    }
}

#define XB_TMO      128
#define XB_XCNT(j)  (256  + 64 * (j))
#define XB_XSUB(j)  (1280 + 64 * (j))
#define XB_XGEN(j)  (2304 + 64 * (j))
#define XB_TOP      3328
#define XB_TOPGEN   3392
#define XCD_BAR_WORDS 3456
#define XB_SPIN_CAP (1u << 18)
#define LAS __attribute__((address_space(3)))

__device__ __forceinline__ unsigned xb_ld(unsigned* p)              { return __hip_atomic_load(p, __ATOMIC_RELAXED, __HIP_MEMORY_SCOPE_AGENT); }
__device__ __forceinline__ unsigned xb_add(unsigned* p, unsigned v) { return __hip_atomic_fetch_add(p, v, __ATOMIC_RELAXED, __HIP_MEMORY_SCOPE_AGENT); }
__device__ __forceinline__ unsigned xb_xcc_id() { return (unsigned)__builtin_amdgcn_s_getreg((3 << 11) | 20) & 0xFu; }
#define XB_SPIN(cond, bar) do { unsigned _sp = 0; while (cond) { __builtin_amdgcn_s_sleep(1); \
    if ((++_sp & 255u) == 0u) { if (xb_ld(&(bar)[XB_TMO])) break; if (_sp > XB_SPIN_CAP) { atomicAdd(&(bar)[XB_TMO], 1u); break; } } } } while (0)

struct XcdBarrier {
    unsigned* bar; unsigned x;
    volatile LAS unsigned* st;
};

__device__ __forceinline__ XcdBarrier xcd_barrier_post(unsigned* bar, volatile LAS unsigned* st) {
    XcdBarrier b; b.bar = bar; b.x = xb_xcc_id(); b.st = st;
    if (threadIdx.x == 0) (void)xb_add(&bar[XB_XCNT(b.x)], 1u);
    return b;
}
__device__ __forceinline__ void xcd_barrier_complete(unsigned* bar, unsigned x, unsigned& nloc, unsigned& nx) {
    const unsigned G = gridDim.x * gridDim.y * gridDim.z;
    unsigned sum, cnt, mine, sp = 0u;
    for (;;) {
        sum = 0u; cnt = 0u; mine = 0u;
#pragma unroll
        for (unsigned j = 0; j < 16; ++j) { const unsigned c = xb_ld(&bar[XB_XCNT(j)]); sum += c; cnt += (c > 0u) ? 1u : 0u; mine = (j == x) ? c : mine; }
        if (sum == G) break;
        __builtin_amdgcn_s_sleep(1);
        if ((++sp & 255u) == 0u) { if (xb_ld(&bar[XB_TMO])) break; if (sp > XB_SPIN_CAP) { atomicAdd(&bar[XB_TMO], 1u); break; } }
    }
    nloc = mine > 0u ? mine : 1u; nx = cnt > 0u ? cnt : 1u;
}

__device__ __forceinline__ void xcd_barrier(const XcdBarrier& b) {
    asm volatile("s_waitcnt vmcnt(0)" ::: "memory");
    __syncthreads();
    if (threadIdx.x == 0) {
        unsigned* bar = b.bar;
        __builtin_amdgcn_s_waitcnt(0);
        unsigned nloc = b.st[0], nx = b.st[1];
        if (nloc == 0u) { xcd_barrier_complete(bar, b.x, nloc, nx); b.st[0] = nloc; b.st[1] = nx; }
        const unsigned old = xb_add(&bar[XB_XSUB(b.x)], 1u);
        const unsigned gen = old / nloc;
        if (old + 1u == (gen + 1u) * nloc) {
            __builtin_amdgcn_fence(__ATOMIC_RELEASE, "agent");
            asm volatile("s_waitcnt vmcnt(0)" ::: "memory");
            const unsigned og = xb_add(&bar[XB_TOP], 1u);
            const unsigned tg = og / nx;
            if (og + 1u == (tg + 1u) * nx) xb_add(&bar[XB_TOPGEN], 1u);
            else XB_SPIN(xb_ld(&bar[XB_TOPGEN]) == tg, bar);
            __builtin_amdgcn_fence(__ATOMIC_ACQUIRE, "agent");
            xb_add(&bar[XB_XGEN(b.x)], 1u);
            asm volatile("s_waitcnt vmcnt(0)" ::: "memory");
        } else {
            XB_SPIN(xb_ld(&bar[XB_XGEN(b.x)]) == gen, bar);
            __builtin_amdgcn_fence(__ATOMIC_ACQUIRE, "agent");
            asm volatile("s_waitcnt vmcnt(0)" ::: "memory");
        }
    }
    __syncthreads();
}

template <int PH>
__device__ __forceinline__ void run_phase(const P& p, int bid, int nb, char* smem) {
    if constexpr (PH == 0) ph_prologue(p, bid, nb, smem);
    if constexpr (PH == 1) ph_inproj(p, bid, nb, smem);
    if constexpr (PH == 2) { ph_compress(p, bid, nb, smem); __syncthreads(); ph_rwkv_chunk(p, bid, nb, smem); }
    if constexpr (PH == 3) {
        if (bid < SCAN_BLOCKS) ph_rwkv_seq(p, bid, SCAN_BLOCKS, smem);
        ph_nsa(p, bid - SCAN_BLOCKS, nb - SCAN_BLOCKS, smem);
    }
    if constexpr (PH == 12) ph_rwkv_out(p, bid, nb, smem);
    if constexpr (PH == 4) ph_merge(p, bid, nb, smem);
    if constexpr (PH == 5) ph_outproj(p, bid, nb, smem);
    if constexpr (PH == 6) ph_route(p, bid, nb, smem);
    if constexpr (PH == 7) ph_scatter(p, bid, nb, smem);
    if constexpr (PH == 9) ph_moe1(p, bid, nb, smem);
    if constexpr (PH == 10) ph_moe2(p, bid, nb, smem);
    if constexpr (PH == 11) ph_final(p, bid, nb, smem);
}

template <int PH>
__global__ void __launch_bounds__(NT) kph(P p) {
    extern __shared__ __attribute__((aligned(16))) char smem[];
    run_phase<PH>(p, blockIdx.x, gridDim.x, smem);
}

__global__ void __launch_bounds__(NT, 2) mega(P p) {
    extern __shared__ __attribute__((aligned(16))) char smem[];
    volatile LAS unsigned* st = (volatile LAS unsigned*)(smem + SMEM_BYTES - 16);
    if (threadIdx.x == 0) { st[0] = 0u; st[1] = 0u; st[2] = 0u; st[3] = 0u; }
    __syncthreads();
    XcdBarrier bar = xcd_barrier_post(p.bar, st);
    const int bid = blockIdx.x, nb = gridDim.x;
#define RUNP(N, BAR) { unsigned long long t0_ = 0; if ((TPROBE >> N) & 1) t0_ = __builtin_amdgcn_s_memrealtime(); run_phase<N>(p, bid, nb, smem); \
        unsigned long long tw_ = 0; if (((TPROBE >> N) & 1) && TPSEL) tw_ = __builtin_amdgcn_s_memrealtime() - t0_; if (BAR) xcd_barrier(bar); \
        if ((TPROBE >> N) & 1) { const unsigned long long t1_ = __builtin_amdgcn_s_memrealtime(); const unsigned long long dt_ = TPSEL ? tw_ : t1_ - t0_; \
            if (!TPSEL || (TPSEL == 1 ? (bid < SCAN_BLOCKS) : (bid >= SCAN_BLOCKS))) while (__builtin_amdgcn_s_memrealtime() - t1_ < dt_) __builtin_amdgcn_s_sleep(8); if (TPSEL) xcd_barrier(bar); } }
    RUNP(0, 1) RUNP(1, 1) RUNP(2, 1) RUNP(3, 1) RUNP(12, 1) RUNP(4, 1) RUNP(5, 1) RUNP(6, 1) RUNP(7, 1) RUNP(9, 1) RUNP(10, 1) RUNP(11, 0)
}

extern "C" void kernel_launch(void* const* d_in, const int* in_sizes, int n_in,
                              void* d_out, int out_size, void* d_ws, size_t ws_size,
                              hipStream_t stream) {
    P p{};
    p.x = (const float*)d_in[0]; p.pos = (const int*)d_in[1]; p.g_mix = (const float*)d_in[2]; p.w_in = (const float*)d_in[3];
    p.pe_k = (const float*)d_in[4]; p.w1_k = (const float*)d_in[5]; p.b1_k = (const float*)d_in[6]; p.w2_k = (const float*)d_in[7]; p.b2_k = (const float*)d_in[8];
    p.pe_v = (const float*)d_in[9]; p.w1_v = (const float*)d_in[10]; p.b1_v = (const float*)d_in[11]; p.w2_v = (const float*)d_in[12]; p.b2_v = (const float*)d_in[13];
    p.mu = (const float*)d_in[14]; p.w0 = (const float*)d_in[15]; p.w2 = (const float*)d_in[16]; p.a0 = (const float*)d_in[17]; p.a2 = (const float*)d_in[18];
    p.g2 = (const float*)d_in[19]; p.k_k = (const float*)d_in[20]; p.k_a = (const float*)d_in[21]; p.r_k = (const float*)d_in[22]; p.ln_w = (const float*)d_in[23]; p.ln_b = (const float*)d_in[24];
    p.wpa = (const float*)d_in[25]; p.wpb = (const float*)d_in[26]; p.wout = (const float*)d_in[27]; p.g_ffn = (const float*)d_in[28];
    p.w_grp = (const float*)d_in[29]; p.b_grp = (const float*)d_in[30]; p.w_exp = (const float*)d_in[31]; p.b_exp = (const float*)d_in[32];
    p.e_w1 = (const float*)d_in[33]; p.e_w3 = (const float*)d_in[34]; p.e_w2 = (const float*)d_in[35]; p.g_final = (const float*)d_in[36];
    p.out = (float*)d_out;
    char* ws = (char*)d_ws;
    const size_t MiB = 1ull << 20;
    p.hbuf = (u16*)(ws + 0 * MiB);
    p.q    = (u16*)(ws + 64 * MiB);
    p.kc   = (u16*)(ws + 96 * MiB);  p.vc   = (u16*)(ws + 104 * MiB);
    p.ksl  = (u16*)(ws + 112 * MiB); p.vslT = (u16*)(ws + 120 * MiB);
    p.kwn  = (u16*)(ws + 128 * MiB); p.vwnT = (u16*)(ws + 136 * MiB);
    p.nsag = (float*)(ws + 144 * MiB);
    p.kcb  = (u16*)(ws + 148 * MiB); p.vcT  = (u16*)(ws + 149 * MiB);
    p.prw  = (u16*)(ws + 160 * MiB);
    p.cdat = (u16*)(ws + 272 * MiB);
    p.bon  = (float*)(ws + 150 * MiB);
    p.w2T  = (u16*)(ws + 151 * MiB); p.a2T = p.w2T + 512 * 64; p.g2T = p.a2T + 512 * 64;
    p.cw1Tk = (u16*)(ws + 152 * MiB); p.cw1Tv = (u16*)(ws + 153 * MiB);
    p.cw2Tk = (u16*)(ws + 154 * MiB); p.cw2Tv = p.cw2Tk + 128 * 256;
    p.chid = (u16*)(ws + 155 * MiB);
    p.xact = (u16*)(ws + 488 * MiB);
    p.oa   = (u16*)(ws + 400 * MiB);
    p.ob   = (u16*)(ws + 432 * MiB);
    p.merged = (u16*)(ws + 64 * MiB);
    p.x1   = (float*)(ws + 160 * MiB);
    char* rt = ws + 288 * MiB;
    p.tok_e = (int*)(rt);                        rt += NTOK * 2 * 4;
    p.tok_gate = (float*)(rt);                   rt += NTOK * 2 * 4;
    p.tokslot = (int*)(rt);                      rt += NTOK * 2 * 4;
    p.list_tok = (int*)(rt);                     rt += NTOK * 2 * 4;
    p.list_gate = (float*)(rt);                  rt += NTOK * 2 * 4;
    p.blk_e = (int*)(rt);                        rt += 2048 * 4;
    p.blk_r0 = (int*)(rt);                       rt += 2048 * 4;
    p.rsb = (float*)(rt);                        rt += NTOK * 4;
    p.hid  = (u16*)(ws + 296 * MiB);
    p.ybuf = (u16*)(ws + 336 * MiB);
    char* misc = ws + 470 * MiB;
    p.counts = (int*)(misc); p.cursor = (int*)(misc + 256); p.offs = (int*)(misc + 512); p.nblk = (int*)(misc + 1024); p.nsactr = (int*)(misc + 2048);
    p.bar = (unsigned*)(ws + 471 * MiB);
    p.cb1k = (float*)(misc + 65536); p.cb1v = p.cb1k + 256;
    {
        char* wa = ws + 472 * MiB;
        p.winT = (u16*)wa;  wa += (size_t)3328 * 1024 * 2;
        p.wgT  = (u16*)wa;  wa += (size_t)2048 * 1024 * 2;
        p.wpaT = (u16*)wa;  wa += (size_t)1024 * 512 * 2;
        p.wpbT = (u16*)wa;  wa += (size_t)1024 * 512 * 2;
        p.woutT = (u16*)wa; wa += (size_t)1024 * 1024 * 2;
        p.ew1T = (u16*)(ws + 64 * MiB);  p.ew3T = (u16*)(ws + 80 * MiB);  p.ew2T = (u16*)(ws + 96 * MiB);
    }
    if (ws_size < (size_t)505 * MiB) return;

#if MEGA
    {
        static int mgrid = 0;
        if (mgrid == 0) {
            int dev = 0, cus = 0, per_cu = 0;
            hipGetDevice(&dev);
            hipDeviceGetAttribute(&cus, hipDeviceAttributeMultiprocessorCount, dev);
            hipFuncSetAttribute((const void*)mega, hipFuncAttributeMaxDynamicSharedMemorySize, SMEM_BYTES);
            hipOccupancyMaxActiveBlocksPerMultiprocessor(&per_cu, (const void*)mega, NT, SMEM_BYTES);
            (void)hipGetLastError();
            mgrid = cus;
        }
        hipMemsetAsync(p.bar, 0, XCD_BAR_WORDS * sizeof(unsigned) + 512 * sizeof(float), stream);
        mega<<<mgrid, NT, SMEM_BYTES, stream>>>(p);
        return;
    }
#else
    const int grid = 512;
    hipMemsetAsync(p.bar, 0, XCD_BAR_WORDS * sizeof(unsigned) + 512 * sizeof(float), stream);
    hipFuncSetAttribute((const void*)kph<0>, hipFuncAttributeMaxDynamicSharedMemorySize, SMEM_BYTES);
    hipFuncSetAttribute((const void*)kph<1>, hipFuncAttributeMaxDynamicSharedMemorySize, SMEM_BYTES);
    hipFuncSetAttribute((const void*)kph<2>, hipFuncAttributeMaxDynamicSharedMemorySize, SMEM_BYTES);
    hipFuncSetAttribute((const void*)kph<3>, hipFuncAttributeMaxDynamicSharedMemorySize, SMEM_BYTES);
    hipFuncSetAttribute((const void*)kph<4>, hipFuncAttributeMaxDynamicSharedMemorySize, SMEM_BYTES);
    hipFuncSetAttribute((const void*)kph<5>, hipFuncAttributeMaxDynamicSharedMemorySize, SMEM_BYTES);
    hipFuncSetAttribute((const void*)kph<6>, hipFuncAttributeMaxDynamicSharedMemorySize, SMEM_BYTES);
    hipFuncSetAttribute((const void*)kph<7>, hipFuncAttributeMaxDynamicSharedMemorySize, SMEM_BYTES);
    hipFuncSetAttribute((const void*)kph<8>, hipFuncAttributeMaxDynamicSharedMemorySize, SMEM_BYTES);
    hipFuncSetAttribute((const void*)kph<9>, hipFuncAttributeMaxDynamicSharedMemorySize, SMEM_BYTES);
    hipFuncSetAttribute((const void*)kph<10>, hipFuncAttributeMaxDynamicSharedMemorySize, SMEM_BYTES);
    hipFuncSetAttribute((const void*)kph<11>, hipFuncAttributeMaxDynamicSharedMemorySize, SMEM_BYTES);
    kph<0><<<grid, NT, SMEM_BYTES, stream>>>(p);
    kph<1><<<grid, NT, SMEM_BYTES, stream>>>(p);
    kph<2><<<grid, NT, SMEM_BYTES, stream>>>(p);
    kph<3><<<grid, NT, SMEM_BYTES, stream>>>(p);
    kph<12><<<grid, NT, SMEM_BYTES, stream>>>(p);
    kph<4><<<grid, NT, SMEM_BYTES, stream>>>(p);
    kph<5><<<grid, NT, SMEM_BYTES, stream>>>(p);
    kph<6><<<grid, NT, SMEM_BYTES, stream>>>(p);
    kph<7><<<grid, NT, SMEM_BYTES, stream>>>(p);
    kph<8><<<grid, NT, SMEM_BYTES, stream>>>(p);
    kph<9><<<grid, NT, SMEM_BYTES, stream>>>(p);
    kph<10><<<grid, NT, SMEM_BYTES, stream>>>(p);
    kph<11><<<grid, NT, SMEM_BYTES, stream>>>(p);
#endif
}
```

```cpp
#include <hip/hip_runtime.h>
#include <stdint.h>

typedef unsigned short u16;
using bf16x8 = __attribute__((ext_vector_type(8))) short;
using f32x4  = __attribute__((ext_vector_type(4))) float;

#ifndef MEGA
#define MEGA 1
#endif

constexpr int B_ = 4, S_ = 8192, D_ = 1024, NTOK = B_ * S_;
constexpr int CIN = 5144;
constexpr int NCMP = 511;
constexpr int CRW = 1792;
constexpr int NEXP = 32;
constexpr int NT = 512;
constexpr int NW = NT / 64;
constexpr int SMEM_BYTES = 160 * 1024;
constexpr int SCAN_BLOCKS = 16;
#ifndef TPROBE
#define TPROBE 0
#define TPSEL 0
#endif
constexpr float QSCALE = 0.125f * 1.4426950408889634f;

struct P {
    const float* x; const int* pos; const float* g_mix; const float* w_in;
    const float *pe_k, *w1_k, *b1_k, *w2_k, *b2_k, *pe_v, *w1_v, *b1_v, *w2_v, *b2_v;
    const float *mu, *w0, *w2, *a0, *a2, *g2, *k_k, *k_a, *r_k, *ln_w, *ln_b;
    const float *wpa, *wpb, *wout, *g_ffn, *w_grp, *b_grp, *w_exp, *b_exp, *e_w1, *e_w3, *e_w2, *g_final;
    float* out;
    u16* hbuf; u16 *q, *kc, *vc, *ksl, *vslT, *kwn, *vwnT, *kcb, *vcT; float* nsag; u16* prw;
    u16* cdat; float* bon; u16 *w2T, *a2T, *g2T; u16 *oa, *ob; u16* merged; float* x1;
    int* tok_e; float* tok_gate; int* tokslot; int* list_tok; float* list_gate;
    int* counts; int* offs; int* cursor; int* blk_e; int* blk_r0; int* nblk; float* rsb; int* nsactr;
    u16* hid; u16* ybuf; unsigned* bar;
    u16 *winT, *wgT, *wpaT, *wpbT, *woutT, *ew1T, *ew3T, *ew2T;
    u16 *cw1Tk, *cw1Tv, *cw2Tk, *cw2Tv, *chid, *xact; float *cb1k, *cb1v;
};

typedef __bf16 bf16x2_t __attribute__((ext_vector_type(2)));
typedef float f32x2_t __attribute__((ext_vector_type(2)));
__device__ __forceinline__ unsigned pack2(float a, float b) {
    f32x2_t f = {a, b};
    return __builtin_bit_cast(unsigned, __builtin_convertvector(f, bf16x2_t));
}
__device__ __forceinline__ u16 f2bf(float f) { return (u16)(pack2(f, f) & 0xFFFFu); }
__device__ __forceinline__ float bf2f(u16 h) { return __uint_as_float(((unsigned)h) << 16); }
__device__ __forceinline__ float sigmoidf_(float x) { return __builtin_amdgcn_rcpf(1.f + __expf(-x)); }
__device__ __forceinline__ float tanhf_(float x) { return 1.f - 2.f * __builtin_amdgcn_rcpf(1.f + __builtin_amdgcn_exp2f(x * 2.8853900817779268f)); }
__device__ __forceinline__ int get_tid() { int t = threadIdx.x; asm volatile("" : "+v"(t)); return t; }
__device__ __forceinline__ uint2 pack4(const f32x4& v) { uint2 o; o.x = pack2(v[0], v[1]); o.y = pack2(v[2], v[3]); return o; }
__device__ __forceinline__ f32x4 unpack4(uint2 u) { return f32x4{__uint_as_float(u.x << 16), __uint_as_float(u.x & 0xFFFF0000u), __uint_as_float(u.y << 16), __uint_as_float(u.y & 0xFFFF0000u)}; }
#define LDS_BARRIER() do { asm volatile("s_waitcnt lgkmcnt(0)" ::: "memory"); __builtin_amdgcn_s_barrier(); asm volatile("" ::: "memory"); } while (0)
__device__ __forceinline__ int opaque(int x) { asm volatile("" : "+v"(x)); return x; }
template <int CTRL>
__device__ __forceinline__ float dppf(float x) { return __int_as_float(__builtin_amdgcn_update_dpp(0, __float_as_int(x), CTRL, 0xF, 0xF, true)); }
__device__ __forceinline__ float wave_sum(float v) {
    v += dppf<0xB1>(v);
    v += dppf<0x4E>(v);
    v += dppf<0x141>(v);
    v += dppf<0x140>(v);
    const int vi = __float_as_int(v);
    return (__int_as_float(__builtin_amdgcn_readlane(vi, 0)) + __int_as_float(__builtin_amdgcn_readlane(vi, 16)))
         + (__int_as_float(__builtin_amdgcn_readlane(vi, 32)) + __int_as_float(__builtin_amdgcn_readlane(vi, 48)));
}

__device__ __forceinline__ float xrow_sum(float v) {
    auto r = __builtin_amdgcn_permlane16_swap(__float_as_uint(v), __float_as_uint(v), false, false);
    v = __uint_as_float(r[0]) + __uint_as_float(r[1]);
    auto r2 = __builtin_amdgcn_permlane32_swap(__float_as_uint(v), __float_as_uint(v), false, false);
    return __uint_as_float(r2[0]) + __uint_as_float(r2[1]);
}
__device__ __forceinline__ float xrow_max(float v) {
    auto r = __builtin_amdgcn_permlane16_swap(__float_as_uint(v), __float_as_uint(v), false, false);
    v = fmaxf(__uint_as_float(r[0]), __uint_as_float(r[1]));
    auto r2 = __builtin_amdgcn_permlane32_swap(__float_as_uint(v), __float_as_uint(v), false, false);
    return fmaxf(__uint_as_float(r2[0]), __uint_as_float(r2[1]));
}
__constant__ double ROPE_FREQ[32] = {
    1.00000000000000000000e+00, 7.49894209332455874417e-01, 5.62341325190349072827e-01, 4.21696503428582225581e-01,
    3.16227766016837941176e-01, 2.37137370566165517349e-01, 1.77827941003892292526e-01, 1.33352143216332402753e-01,
    1.00000000000000005551e-01, 7.49894209332455791150e-02, 5.62341325190349114460e-02, 4.21696503428582239459e-02,
    3.16227766016837913421e-02, 2.37137370566165538166e-02, 1.77827941003892292526e-02, 1.33352143216332406223e-02,
    1.00000000000000002082e-02, 7.49894209332455791150e-03, 5.62341325190349097113e-03, 4.21696503428582291501e-03,
    3.16227766016837939442e-03, 2.37137370566165538166e-03, 1.77827941003892275179e-03, 1.33352143216332406223e-03,
    1.00000000000000002082e-03, 7.49894209332455856203e-04, 5.62341325190349097113e-04, 4.21696503428582237290e-04,
    3.16227766016837939442e-04, 2.37137370566165538166e-04, 1.77827941003892269758e-04, 1.33352143216332395381e-04};

constexpr int G_ABYTES = 256 * 64 * 2, G_BBYTES = 128 * 64 * 2, G_TILE = G_ABYTES + G_BBYTES;
#define LAS3 __attribute__((address_space(3)))
#define GAS1 __attribute__((address_space(1)))
__device__ __forceinline__ void glds16(const u16* g, char* l) {
    __builtin_amdgcn_global_load_lds((const GAS1 unsigned*)g, (LAS3 unsigned*)l, 16, 0, 0);
}
template <bool TR = false, class ARow>
__device__ __forceinline__ void gemm_core(int K, ARow arow, const u16* __restrict__ BT, int ldb, f32x4 (&acc)[4][4], u16* sm) {
    char* base = (char*)sm;
    const int tid = get_tid(), lane = tid & 63, wv = tid >> 6;
    const int wm = wv >> 1, wn = wv & 1, kr = lane & 15, qq = lane >> 4;
    const int lr = tid >> 3, lk = ((tid & 7) ^ ((lr >> 1) & 7)) * 8;
    const u16* ap0 = arow(lr) + lk; const u16* ap1 = arow(lr + 64) + lk;
    const u16* ap2 = arow(lr + 128) + lk; const u16* ap3 = arow(lr + 192) + lk;
    const u16* bp0 = BT + (size_t)lr * ldb + lk; const u16* bp1 = BT + (size_t)(lr + 64) * ldb + lk;
#pragma unroll
    for (int mt = 0; mt < 4; mt++)
#pragma unroll
        for (int nt = 0; nt < 4; nt++) acc[mt][nt] = f32x4{0.f, 0.f, 0.f, 0.f};
    const int nk = K >> 6;
#define G_ISSUE(t, b) { char* d = base + (b) * G_TILE + tid * 16; const int ko = (t) * 64; \
        glds16(ap0 + ko, d); glds16(ap1 + ko, d + 8192); glds16(ap2 + ko, d + 16384); glds16(ap3 + ko, d + 24576); \
        glds16(bp0 + ko, d + G_ABYTES); glds16(bp1 + ko, d + G_ABYTES + 8192); }
    const int sw = kr >> 1;
    const int po0 = ((0 * 4 + qq) ^ sw) * 16, po1 = ((1 * 4 + qq) ^ sw) * 16;
    const int aoff = (wm * 64 + kr) * 128, boff = G_ABYTES + (wn * 64 + kr) * 128;
#define G_READ(FA, FB, b) { const char* Ab = base + (b) * G_TILE + aoff; const char* Bb = base + (b) * G_TILE + boff; \
        _Pragma("unroll") for (int mt = 0; mt < 4; mt++) { FA[0][mt] = *(const bf16x8*)(Ab + mt * 2048 + po0); FA[1][mt] = *(const bf16x8*)(Ab + mt * 2048 + po1); } \
        _Pragma("unroll") for (int nt = 0; nt < 4; nt++) { FB[0][nt] = *(const bf16x8*)(Bb + nt * 2048 + po0); FB[1][nt] = *(const bf16x8*)(Bb + nt * 2048 + po1); } }
#define G_MMA(FA, FB) { __builtin_amdgcn_s_setprio(1); \
        _Pragma("unroll") for (int ks = 0; ks < 2; ks++) \
            _Pragma("unroll") for (int nt = 0; nt < 4; nt++) \
                _Pragma("unroll") for (int mt = 0; mt < 4; mt++) \
                    acc[mt][nt] = TR ? __builtin_amdgcn_mfma_f32_16x16x32_bf16(FA[ks][mt], FB[ks][nt], acc[mt][nt], 0, 0, 0) \
                                     : __builtin_amdgcn_mfma_f32_16x16x32_bf16(FB[ks][nt], FA[ks][mt], acc[mt][nt], 0, 0, 0); \
        __builtin_amdgcn_s_setprio(0); }
    bf16x8 fa0[2][4], fb0[2][4], fa1[2][4], fb1[2][4];
    G_ISSUE(0, 0)
    if (nk > 1) G_ISSUE(1, 1)
    if (nk > 2) G_ISSUE(2, 2)
    if (nk > 2) asm volatile("s_waitcnt vmcnt(12)" ::: "memory");
    else if (nk > 1) asm volatile("s_waitcnt vmcnt(6)" ::: "memory");
    else asm volatile("s_waitcnt vmcnt(0)" ::: "memory");
    __builtin_amdgcn_s_barrier();
    G_READ(fa0, fb0, 0)
    int bnext = 1, bfree = 0;
#define G_STEP(FAC, FBC, FAN, FBN, kt) { \
        if ((kt) + 1 < nk) { \
            if ((kt) + 2 < nk) asm volatile("s_waitcnt vmcnt(6) lgkmcnt(0)" ::: "memory"); else asm volatile("s_waitcnt vmcnt(0) lgkmcnt(0)" ::: "memory"); \
            __builtin_amdgcn_s_barrier();                   \
            if ((kt) + 3 < nk) G_ISSUE((kt) + 3, bfree) \
            G_READ(FAN, FBN, bnext) \
        } \
        G_MMA(FAC, FBC) \
        bfree = bnext; bnext = (bnext == 2) ? 0 : bnext + 1; }
    for (int kt = 0; kt < nk; kt += 2) {
        G_STEP(fa0, fb0, fa1, fb1, kt)
        G_STEP(fa1, fb1, fa0, fb0, kt + 1)
    }
    __builtin_amdgcn_s_barrier();
#undef G_READ
#undef G_MMA
#undef G_STEP
#undef G_ISSUE
}

__device__ __forceinline__ int xcd_item(int bid, int nb, int k, int nitems) {
    if (nb & 7) return bid + k * nb;
    const int per = nb >> 3, chunk = (nitems + 7) >> 3;
    const int j = k * per + (bid >> 3);
    return (j < chunk) ? (bid & 7) * chunk + j : nitems;
}
struct GUnit { int pm, pn; };
constexpr int G8_HTB = 128 * 64 * 2;
__device__ __forceinline__ int g8_lds_byte(int r, int c) { const int st = (r >> 4) * 2 + (c >> 5), rr = r & 15, cc = c & 31, ob = rr * 64 + cc * 2; return st * 1024 + (ob ^ (((ob >> 9) & 1) << 5)); }
__device__ __forceinline__ void g8_stage_rc(int b, int& R, int& C) { const int st = b / 1024, sb = b % 1024, swz = sb ^ (((sb >> 9) & 1) << 5); R = (st >> 1) * 16 + swz / 64; C = (st & 1) * 32 + (swz % 64) / 2; }
__host__ __device__ __forceinline__ int perm32(int rho) { const int n = rho >> 4, i = rho & 15; return 8 * (i >> 2) + 4 * n + (i & 3); }

template <class Epi, class Sched>
__device__ __forceinline__ void gemm256(char* smem, const char* Ab, int K, const Sched& S, const Epi& E) {
    LAS3 unsigned char* lds = (LAS3 unsigned char*)smem;
    const int tid = get_tid(), wid = __builtin_amdgcn_readfirstlane(tid >> 6), lane = tid & 63, wr = wid >> 2, wc = wid & 3, fr = lane & 15, fq = lane >> 4;
    int nt = K >> 6; asm volatile("" : "+s"(nt));
    unsigned voffB[2], voffA[2][2];
#pragma unroll
    for (int i = 0; i < 2; ++i) { int sR, sC; g8_stage_rc(tid * 16 + i * 8192, sR, sC); voffB[i] = (unsigned)(sR * K + sC) * 2u; }
#define G8_AOFFS(un) do { const int t3_ = get_tid(); _Pragma("unroll") for (int i = 0; i < 2; ++i) { int sR, sC; g8_stage_rc(t3_ * 16 + i * 8192, sR, sC); \
        _Pragma("unroll") for (int h = 0; h < 2; ++h) voffA[h][i] = S.a_off(un, h, sR) + (unsigned)sC * 2u; } } while (0)
    const size_t kstep = 128;
    const size_t hstep = (size_t)128 * K * 2;
    const unsigned ldsw = (unsigned)wid * 1024u;
    const int aoff = g8_lds_byte(wr * 64 + fr, fq * 8), boff = g8_lds_byte(wc * 32 + fr, fq * 8);
#define G8_SA(b, h) (((b) * 2 + (h)) * G8_HTB)
#define G8_SB(b, h) ((4 + (b) * 2 + (h)) * G8_HTB)
#define G8_STAGE2(bufoff, gbase, v0, v1) do { \
        __builtin_amdgcn_global_load_lds((const GAS1 unsigned*)((const char*)(gbase) + (v0)), (LAS3 unsigned*)(lds + (bufoff) + ldsw), 16, 0, 0); \
        __builtin_amdgcn_global_load_lds((const GAS1 unsigned*)((const char*)(gbase) + (v1)), (LAS3 unsigned*)(lds + (bufoff) + ldsw + 8192), 16, 0, 0); } while (0)
#define G8_STAGEB(bufoff, gbase) G8_STAGE2(bufoff, gbase, voffB[0], voffB[1])
#define G8_LDA(dst, b, h) do { _Pragma("unroll") for (int m = 0; m < 4; ++m) _Pragma("unroll") for (int k = 0; k < 2; ++k) dst[m][k] = *(const LAS3 bf16x8*)(lds + G8_SA(b, h) + aoff + m * 2048 + k * 1024); } while (0)
#define G8_LDB(dst, b, h) do { _Pragma("unroll") for (int n = 0; n < 2; ++n) _Pragma("unroll") for (int k = 0; k < 2; ++k) dst[n][k] = *(const LAS3 bf16x8*)(lds + G8_SB(b, h) + boff + n * 2048 + k * 1024); } while (0)
#define G8_MMA(ai, bj, At, Bt) do { __builtin_amdgcn_s_setprio(1); _Pragma("unroll") for (int m = 0; m < 4; ++m) _Pragma("unroll") for (int n = 0; n < 2; ++n) _Pragma("unroll") for (int k = 0; k < 2; ++k) \
        acc[ai][bj][m][n] = __builtin_amdgcn_mfma_f32_16x16x32_bf16(Bt[n][k], At[m][k], acc[ai][bj][m][n], 0, 0, 0); __builtin_amdgcn_s_setprio(0); } while (0)
#define G8_WAIT_V(n) asm volatile("s_waitcnt vmcnt(" #n ")" ::: "memory")
#define G8_WAIT_L(n) asm volatile("s_waitcnt lgkmcnt(" #n ")" ::: "memory")
#define G8_BAR __builtin_amdgcn_s_barrier()
#define G8_SCHED __builtin_amdgcn_sched_barrier(0)
    GUnit cur, nxt; int ui = 0;
    if (!S.next(0, cur)) return;
    f32x4 acc[2][2][4][2];
#pragma unroll
    for (int a = 0; a < 2; ++a)
#pragma unroll
        for (int b = 0; b < 2; ++b)
#pragma unroll
            for (int m = 0; m < 4; ++m)
#pragma unroll
                for (int n = 0; n < 2; ++n) acc[a][b][m][n] = (f32x4){0.f, 0.f, 0.f, 0.f};
    bf16x8 At[4][2], B0[2][2], B1[2][2];
    G8_AOFFS(cur);
    const char* cB = S.b_ptr(cur);
    G8_STAGEB(G8_SB(0, 0), cB); G8_STAGE2(G8_SA(0, 0), Ab, voffA[0][0], voffA[0][1]); G8_STAGEB(G8_SB(0, 1), cB + hstep); G8_STAGE2(G8_SA(0, 1), Ab, voffA[1][0], voffA[1][1]);
    if (wr == 1) G8_BAR;
    G8_WAIT_V(4); G8_BAR;
    G8_STAGEB(G8_SB(1, 0), cB + kstep); G8_STAGE2(G8_SA(1, 0), Ab + kstep, voffA[0][0], voffA[0][1]); G8_STAGEB(G8_SB(1, 1), cB + hstep + kstep);
    G8_WAIT_V(6); G8_BAR;
    for (;;) {
        const bool has_next = S.next(ui + 1, nxt);
        const char* nB = has_next ? S.b_ptr(nxt) : cB;
        for (int t = 0; t < nt; t += 2) {
            const bool last = (t == nt - 2);
            const char* a1 = Ab + (size_t)(t + 1) * kstep;
            const unsigned va10 = voffA[1][0], va11 = voffA[1][1];
            if (last && has_next) G8_AOFFS(nxt);
            const char* a2 = last ? Ab : Ab + (size_t)(t + 2) * kstep; const char* b2 = last ? nB : cB + (size_t)(t + 2) * kstep;
            const char* a3 = a2 + kstep; const char* b3 = b2 + kstep;
            G8_LDB(B0, 0, 0); G8_SCHED; G8_LDA(At, 0, 0); G8_STAGE2(G8_SA(1, 1), a1, va10, va11);
            G8_WAIT_L(8); G8_BAR; G8_WAIT_L(0); G8_MMA(0, 0, At, B0); G8_BAR; G8_SCHED;
            G8_LDB(B1, 0, 1); G8_STAGEB(G8_SB(0, 0), b2);
            G8_BAR; G8_WAIT_L(0); G8_MMA(0, 1, At, B1); G8_BAR;
            G8_LDA(At, 0, 1); G8_STAGE2(G8_SA(0, 0), a2, voffA[0][0], voffA[0][1]);
            G8_BAR; G8_WAIT_L(0); G8_MMA(1, 0, At, B0); G8_BAR; G8_SCHED;
            G8_STAGEB(G8_SB(0, 1), b2 + hstep);
            G8_WAIT_V(6); G8_BAR; G8_MMA(1, 1, At, B1); G8_BAR;
            G8_LDB(B0, 1, 0); G8_SCHED; G8_LDA(At, 1, 0); G8_STAGE2(G8_SA(0, 1), a2, voffA[1][0], voffA[1][1]);
            G8_WAIT_L(8); G8_BAR; G8_WAIT_L(0); G8_MMA(0, 0, At, B0); G8_BAR; G8_SCHED;
            G8_LDB(B1, 1, 1); G8_STAGEB(G8_SB(1, 0), b3);
            G8_BAR; G8_WAIT_L(0); G8_MMA(0, 1, At, B1); G8_BAR;
            G8_LDA(At, 1, 1); G8_STAGE2(G8_SA(1, 0), a3, voffA[0][0], voffA[0][1]);
            G8_BAR; G8_WAIT_L(0); G8_MMA(1, 0, At, B0); G8_BAR; G8_SCHED;
            G8_STAGEB(G8_SB(1, 1), b3 + hstep);
            G8_WAIT_V(6); G8_BAR; G8_MMA(1, 1, At, B1); G8_BAR;
        }
        E(acc, cur, wr, wc, fr, fq);
        if (!has_next) break;
#pragma unroll
        for (int a = 0; a < 2; ++a)
#pragma unroll
            for (int b = 0; b < 2; ++b)
#pragma unroll
                for (int m = 0; m < 4; ++m)
#pragma unroll
                    for (int n = 0; n < 2; ++n) acc[a][b][m][n] = (f32x4){0.f, 0.f, 0.f, 0.f};
        cur = nxt; cB = nB; ++ui;
    }
    G8_WAIT_V(0);
    if (wr == 0) G8_BAR;
    G8_BAR;
#undef G8_SA
#undef G8_AOFFS
#undef G8_SB
#undef G8_STAGE2
#undef G8_STAGEB
#undef G8_LDA
#undef G8_LDB
#undef G8_MMA
#undef G8_WAIT_V
#undef G8_WAIT_L
#undef G8_BAR
#undef G8_SCHED
}
struct DenseSched {
    int nM, nN, nwg, G, c, K; const char* Bt;
    __device__ __forceinline__ void init(int M, int N, int K_, const void* Bt_, int G_, int c_) { nM = M >> 8; nN = N >> 8; nwg = nM * nN; G = G_; c = c_; K = K_; Bt = (const char*)Bt_; }
    __device__ __forceinline__ bool next(int i, GUnit& u) const {
        const int L = i * G + c; if (L >= nwg) return false;
        int wgid = L; { const int q = nwg >> 3, r = nwg & 7, xcd = wgid & 7, off = wgid >> 3; wgid = (xcd < r ? xcd * (q + 1) : r * (q + 1) + (xcd - r) * q) + off; }
        const int nig = 8 * nN, gid = wgid / nig, fm = gid * 8, gsz = (nM - fm) < 8 ? (nM - fm) : 8, w = wgid - gid * nig;
        u.pn = w / gsz; u.pm = fm + (w - u.pn * gsz); return true;
    }
    __device__ __forceinline__ unsigned a_off(const GUnit& u, int h, int R) const { return (unsigned)((u.pm * 256 + h * 128 + R) * K) * 2u; }
    __device__ __forceinline__ const char* b_ptr(const GUnit& u) const { return Bt + (size_t)u.pn * 256 * K * 2; }
};

template <class SRC>
__device__ __forceinline__ void convert_wT(const float* __restrict__ W, int K, int N, u16* __restrict__ WT, int rows, SRC src, int gtid, int gnt) {
    const int kch = K >> 3;
    const int total = rows * kch;
    for (int i0 = gtid; i0 < total; i0 += 4 * gnt) {
        float f[4][8]; int sc[4];
#pragma unroll
        for (int u = 0; u < 4; u++) {
            const int i = i0 + u * gnt;
            sc[u] = -1;
            if (i < total) {
                const int kc = i / rows, j = i - kc * rows;
                sc[u] = src(j);
                if (sc[u] >= 0) {
                    const float* wp = W + (size_t)(kc * 8) * N + sc[u];
#pragma unroll
                    for (int q = 0; q < 8; q++) f[u][q] = wp[(size_t)q * N];
                }
            }
        }
#pragma unroll
        for (int u = 0; u < 4; u++) {
            const int i = i0 + u * gnt;
            if (i < total) {
                const int kc = i / rows, j = i - kc * rows;
                uint4 v = make_uint4(0u, 0u, 0u, 0u);
                if (sc[u] >= 0) { v.x = pack2(f[u][0], f[u][1]); v.y = pack2(f[u][2], f[u][3]); v.z = pack2(f[u][4], f[u][5]); v.w = pack2(f[u][6], f[u][7]); }
                *(uint4*)&WT[(size_t)j * K + kc * 8] = v;
            }
        }
    }
}

__device__ __forceinline__ void convert_later_weights(const P& p, int gtid, int gnt) {
    convert_wT(p.w_in, D_, CIN, p.wgT, 2048, [](int j) { const int t = j >> 8, r = j & 255, cl = r & 127; return 3096 + (r >> 7) * 1024 + t * 128 + (cl & ~31) + perm32(cl & 31); }, gtid, gnt);
    convert_wT(p.wpa, 512, D_, p.wpaT, 1024, [](int j) { return (j & ~31) + perm32(j & 31); }, gtid, gnt);
    convert_wT(p.wpb, 512, D_, p.wpbT, 1024, [](int j) { return (j & ~31) + perm32(j & 31); }, gtid, gnt);
    convert_wT(p.wout, D_, D_, p.woutT, 1024, [](int j) { return j; }, gtid, gnt);
    convert_wT(p.w2, 64, 512, p.w2T, 512, [](int j) { return j; }, gtid, gnt);
    convert_wT(p.w1_k, 2048, 256, p.cw1Tk, 256, [](int j) { return j; }, gtid, gnt);
    convert_wT(p.w1_v, 2048, 256, p.cw1Tv, 256, [](int j) { return j; }, gtid, gnt);
    convert_wT(p.w2_k, 256, 64, p.cw2Tk, 128, [](int j) { return j < 64 ? j : -1; }, gtid, gnt);
    convert_wT(p.w2_v, 256, 64, p.cw2Tv, 128, [](int j) { return j < 64 ? j : -1; }, gtid, gnt);
    convert_wT(p.a2, 64, 512, p.a2T, 512, [](int j) { return j; }, gtid, gnt);
    convert_wT(p.g2, 128, 512, p.g2T, 512, [](int j) { return j; }, gtid, gnt);
}
__device__ void ph_prologue(const P& p, int bid, int nb, char* smem) {
    const int tid = get_tid(), lane = tid & 63, wv = tid >> 6;
    if (bid >= 1 && bid <= 64) {
        const int j = tid & 255; const bool isv = tid >= 256;
        const float* pe = isv ? p.pe_v : p.pe_k; const float* w1 = isv ? p.w1_v : p.w1_k;
        const int kb = (bid - 1) * 32;
        float a0 = 0.f, a1 = 0.f;
#pragma unroll 4
        for (int k = kb; k < kb + 32; k += 2) { a0 += pe[k] * w1[(size_t)k * 256 + j]; a1 += pe[k + 1] * w1[(size_t)(k + 1) * 256 + j]; }
        p.cb1k[(bid - 1) * 512 + (isv ? 256 : 0) + j] = a0 + a1;
    }
    if (bid == 0) {
        if (tid < 32) { p.counts[tid] = 0; p.cursor[tid] = 0; }
        if (tid == 32) *p.nsactr = 0;
        for (int i = tid; i < 8 * 64; i += NT) {
            const int bg = i >> 6, d = i & 63;
            p.kcb[((size_t)bg * 512 + 511) * 64 + d] = 0;
            p.vcT[(((size_t)bg * 8 + 7) * 64 + d) * 64 + 63] = 0;
        }
    }
    {
        const int gtid = bid * NT + tid, gnt = nb * NT;
        convert_wT(p.w_in, D_, CIN, p.winT, 3328, [](int j) {
            const int t = j >> 8, s = j & 255;
            if (t < 5) {
                const int bj = s >> 7, wc = (s >> 5) & 3, n = (s >> 4) & 1, i = s & 15;
                const int dim = 32 * bj + 8 * (i >> 2) + 4 * n + (i & 3), hq = 4 * t + wc;
                int hb;
                if (hq < 8) hb = 64 * hq;
                else { const int k = (hq - 8) >> 1; hb = (k == 0 ? 512 : (k == 1 ? 640 : (k == 2 ? 768 : (k == 3 ? 1024 : (k == 4 ? 896 : 1152))))) + 64 * (hq & 1); }
                return hb + dim;
            }
            const int c = (s & ~31) + perm32(s & 31);
            if (t < 12) return 1304 + (t - 5) * 256 + c;
            return c < 24 ? 1280 + c : -1; }, gtid, gnt);
        if (nb != 256) convert_later_weights(p, gtid, gnt);
    }
    for (int row = bid * NW + wv; row < NTOK; row += nb * NW) {
        const float* xr = p.x + (size_t)row * D_;
        float v[16];
        float ss = 0.f;
#pragma unroll
        for (int i = 0; i < 4; i++) {
            float4 t = *(const float4*)&xr[i * 256 + lane * 4];
            v[4 * i] = t.x; v[4 * i + 1] = t.y; v[4 * i + 2] = t.z; v[4 * i + 3] = t.w;
            ss += t.x * t.x + t.y * t.y + t.z * t.z + t.w * t.w;
        }
        ss = wave_sum(ss);
        const float rs = rsqrtf(ss * (1.f / D_) + 1e-6f);
#pragma unroll
        for (int i = 0; i < 4; i++) {
            const int c = i * 256 + lane * 4;
            float4 g = *(const float4*)&p.g_mix[c];
            uint2 o;
            o.x = pack2(v[4 * i] * rs * g.x, v[4 * i + 1] * rs * g.y);
            o.y = pack2(v[4 * i + 2] * rs * g.z, v[4 * i + 3] * rs * g.w);
            *(uint2*)&p.hbuf[(size_t)row * D_ + c] = o;
        }
    }
}

__device__ __forceinline__ uint4 pack8(const f32x4& a, const f32x4& b) { uint4 o; o.x = pack2(a[0], a[1]); o.y = pack2(a[2], a[3]); o.z = pack2(b[0], b[1]); o.w = pack2(b[2], b[3]); return o; }
struct EpiInproj {
    const P* pp;
    __device__ __forceinline__ void operator()(const f32x4 (&acc)[2][2][4][2], const GUnit& u, int, int, int, int) const {
        const int t2_ = get_tid(), wid_ = __builtin_amdgcn_readfirstlane(t2_ >> 6), wr = wid_ >> 2, wc = wid_ & 3, fr = t2_ & 15, fq = (t2_ >> 4) & 3;
        const P& p = *pp;
        const int pn = u.pn;
        const int rowb = u.pm * 256 + wr * 64;
        if (pn < 4) {
            const int hq = 4 * pn + wc;
            const bool rope = !(pn == 2 && wc >= 2);
            u16* dst; size_t rstride; int cofs;
            if (pn < 2) { dst = p.q; rstride = 512; cofs = hq * 64; }
            else { dst = (pn == 2) ? (wc < 2 ? p.kc : p.vc) : (wc < 2 ? p.ksl : p.kwn); rstride = 64; cofs = 0; }
            const int g = wc & 1;
#pragma unroll
            for (int ai = 0; ai < 2; ++ai)
#pragma unroll
                for (int m = 0; m < 4; ++m) {
                    const int row = rowb + ai * 128 + m * 16 + fr;
                    f32x4 o1[2], o2[2];
#pragma unroll
                    for (int n = 0; n < 2; ++n) { o1[n] = acc[ai][0][m][n]; o2[n] = acc[ai][1][m][n]; }
                    if (rope) {
                        const double posd = (double)p.pos[row];
#pragma unroll
                        for (int n = 0; n < 2; ++n)
#pragma unroll
                            for (int j = 0; j < 4; ++j) {
                                const double tr = posd * ROPE_FREQ[8 * fq + 4 * n + j] * 0.15915494309189535;
                                const float fr_ = (float)(tr - rint(tr));
                                const float cs = __builtin_amdgcn_cosf(fr_), sn = __builtin_amdgcn_sinf(fr_);
                                const float x1 = o1[n][j], x2 = o2[n][j];
                                o1[n][j] = x1 * cs - x2 * sn; o2[n][j] = x1 * sn + x2 * cs;
                            }
                    }
                    size_t ro;
                    if (pn < 2) {
#pragma unroll
                        for (int n = 0; n < 2; ++n)
#pragma unroll
                            for (int j = 0; j < 4; ++j) { o1[n][j] *= QSCALE; o2[n][j] *= QSCALE; }
                        ro = (size_t)row * 512 + cofs + 8 * fq;
                    } else {
                        const int bb = row >> 13, t = row & (S_ - 1);
                        ro = ((size_t)(bb * 2 + g) * S_ + t) * 64 + 8 * fq;
                    }
                    *(uint4*)&dst[ro] = pack8(o1[0], o1[1]);
                    *(uint4*)&dst[ro + 32] = pack8(o2[0], o2[1]);
                }
        } else if (pn == 4) {
            u16* dst = (wc < 2) ? p.vslT : p.vwnT;
            const int g = wc & 1;
#pragma unroll
            for (int ai = 0; ai < 2; ++ai) {
                const int r0 = rowb + ai * 128, bb = r0 >> 13, tb = r0 & (S_ - 1);
                u16* base = dst + ((size_t)(bb * 2 + g) * 128 + (tb >> 6)) * 4096;
#pragma unroll
                for (int m = 0; m < 4; ++m)
#pragma unroll
                    for (int bj = 0; bj < 2; ++bj)
#pragma unroll
                        for (int n = 0; n < 2; ++n)
#pragma unroll
                            for (int j = 0; j < 4; ++j)
                                base[(32 * bj + 8 * fq + 4 * n + j) * 64 + m * 16 + fr] = f2bf(acc[ai][bj][m][n][j]);
            }
        } else if (pn < 12) {
            const int cb = (pn - 5) * 256 + wc * 32 + 8 * fq;
#pragma unroll
            for (int ai = 0; ai < 2; ++ai)
#pragma unroll
                for (int m = 0; m < 4; ++m) {
                    const size_t ro = (size_t)(rowb + ai * 128 + m * 16 + fr) * CRW + cb;
#pragma unroll
                    for (int bj = 0; bj < 2; ++bj) *(uint4*)&p.prw[ro + bj * 128] = pack8(acc[ai][bj][m][0], acc[ai][bj][m][1]);
                }
        } else {
            if (wc == 0 && fq < 3) {
#pragma unroll
                for (int ai = 0; ai < 2; ++ai)
#pragma unroll
                    for (int m = 0; m < 4; ++m) {
                        const size_t ro = (size_t)(rowb + ai * 128 + m * 16 + fr) * 24 + 8 * fq;
#pragma unroll
                        for (int n = 0; n < 2; ++n) {
                            float4 o; o.x = sigmoidf_(acc[ai][0][m][n][0]); o.y = sigmoidf_(acc[ai][0][m][n][1]); o.z = sigmoidf_(acc[ai][0][m][n][2]); o.w = sigmoidf_(acc[ai][0][m][n][3]);
                            *(float4*)&p.nsag[ro + 4 * n] = o;
                        }
                    }
            }
        }
    }
};
__device__ void ph_inproj(const P& p, int bid, int nb, char* smem) {
    DenseSched S; S.init(NTOK, 3328, D_, p.winT, nb, bid);
    EpiInproj E{&p};
    gemm256(smem, (const char*)p.hbuf, D_, S, E);
    if (nb == 256 && bid >= 128) convert_later_weights(p, (bid - 128) * NT + get_tid(), 128 * NT);
}

__device__ __forceinline__ float gelu_tanh(float x) {
    const float c = 0.7978845608028654f;
    return 0.5f * x * (1.f + tanhf_(c * (x + 0.044715f * x * x * x)));
}
__device__ void ph_compress(const P& p, int bid, int nb, char* smem) {
    u16* sm = (u16*)smem;
    const int tid = get_tid(), lane = tid & 63, wv = tid >> 6;
    const int wm = wv >> 1, wn = wv & 1;
    for (int it = bid; it < 32; it += nb) {
        const int rt = it & 1, g = (it >> 1) & 1, b = (it >> 2) & 3, kv = it >> 4;
        const int bg = b * 2 + g, i0 = rt * 256;
        const u16* src = (kv ? p.vc : p.kc) + (size_t)bg * S_ * 64;
        const u16* w1T = kv ? p.cw1Tv : p.cw1Tk;
        const u16* w2T = kv ? p.cw2Tv : p.cw2Tk;
        float* cb1 = (float*)(smem + 3 * G_TILE);
        __syncthreads();
        { const int t2 = get_tid(); if (t2 < 256) { float a = 0.f; for (int q = 0; q < 64; q++) a += p.cb1k[q * 512 + kv * 256 + t2]; cb1[t2] = a; } }
        __syncthreads();
        const float* b1 = kv ? p.b1_v : p.b1_k;
        const float* b2 = kv ? p.b2_v : p.b2_k;
        u16* hidp = p.chid + (size_t)it * 256 * 256;
        auto arow = [&](int r) { int i = i0 + r; if (i > 510) i = 510; return src + (size_t)i * 1024; };
#pragma unroll 1
        for (int ct = 0; ct < 2; ct++) {
            f32x4 acc[4][4];
            gemm_core<false>(2048, arow, w1T + (size_t)ct * 128 * 2048, 2048, acc, sm);
            const int le = get_tid() & 63;
#pragma unroll
            for (int mt = 0; mt < 4; mt++) {
                const int r = wm * 64 + mt * 16 + (le & 15);
#pragma unroll
                for (int nt = 0; nt < 4; nt++) {
                    const int col = ct * 128 + wn * 64 + nt * 16 + (le >> 4) * 4;
                    const float4 c1 = *(const float4*)&cb1[col], bb1 = *(const float4*)&b1[col];
                    f32x4 o;
                    o[0] = gelu_tanh(acc[mt][nt][0] + c1.x + bb1.x); o[1] = gelu_tanh(acc[mt][nt][1] + c1.y + bb1.y);
                    o[2] = gelu_tanh(acc[mt][nt][2] + c1.z + bb1.z); o[3] = gelu_tanh(acc[mt][nt][3] + c1.w + bb1.w);
                    *(uint2*)&hidp[r * 256 + col] = pack4(o);
                }
            }
        }
        __syncthreads();
        {
            f32x4 acc[4][4];
            gemm_core<true>(256, [&](int r) { return hidp + (size_t)r * 256; }, w2T, 256, acc, sm);
            if (wn == 0) {
#pragma unroll
                for (int mt = 0; mt < 4; mt++)
#pragma unroll
                    for (int nt = 0; nt < 4; nt++) {
                        const int d = nt * 16 + (lane & 15);
                        const int ib = i0 + wm * 64 + mt * 16 + (lane >> 4) * 4;
                        float o[4];
#pragma unroll
                        for (int j = 0; j < 4; j++) o[j] = (ib + j < NCMP) ? (acc[mt][nt][j] + b2[d]) : 0.f;
                        if (kv == 0) {
#pragma unroll
                            for (int j = 0; j < 4; j++) p.kcb[((size_t)bg * 512 + ib + j) * 64 + d] = f2bf(o[j]);
                        } else {
                            uint2 ov; ov.x = pack2(o[0], o[1]); ov.y = pack2(o[2], o[3]);
                            *(uint2*)&p.vcT[(((size_t)bg * 8 + (ib >> 6)) * 64 + d) * 64 + (ib & 63)] = ov;
                        }
                    }
            }
        }
        __syncthreads();
    }
}

#ifndef NSAPROBE
#define NSAPROBE 0
#endif
#define NSA_TS(k) if (NSAPROBE == k) ts_ = __builtin_amdgcn_s_memrealtime();
#define NSA_TE(k) if (NSAPROBE == k) tacc_ += __builtin_amdgcn_s_memrealtime() - ts_;
constexpr int KSTR = 72;
struct Sub { f32x4 O[4]; float m, l; };
#define NEG_BIG (-1.0e30f)

__device__ __forceinline__ float xq_max(float v) {
    return xrow_max(v);
}
__device__ __forceinline__ float xq_sum(float v) {
    return xrow_sum(v);
}
template <int OFF> __device__ __forceinline__ bf16x8 gload_b128(const u16* p) { bf16x8 r; asm volatile("global_load_dwordx4 %0, %1, off offset:%2" : "=v"(r) : "v"(p), "n"(OFF) : "memory"); return r; }
typedef unsigned u32x2 __attribute__((ext_vector_type(2)));
template <int OFF> __device__ __forceinline__ u32x2 gload_b64(const u16* p) { u32x2 r; asm volatile("global_load_dwordx2 %0, %1, off offset:%2" : "=v"(r) : "v"(p), "n"(OFF) : "memory"); return r; }
union VF { bf16x8 v; u32x2 h[2]; };
template <int OFF> __device__ __forceinline__ u32x2 lds_read_b64(unsigned addr) { u32x2 r; asm volatile("ds_read_b64 %0, %1 offset:%2" : "=v"(r) : "v"(addr), "n"(OFF)); return r; }
#define NSA_LDV_ASM(vf, Vs, kr, qq, swz) { const unsigned va_ = (unsigned)(size_t)(const LAS3 char*)((const char*)(Vs) + (kr) * 128 + ((qq) & 1) * 8); const int vo_ = (((qq) >> 1) ^ (swz)) << 4; \
        const unsigned a0_ = va_ + vo_, a1_ = va_ + (vo_ ^ 32), a2_ = va_ + (vo_ ^ 64), a3_ = va_ + (vo_ ^ 96); \
        vf[0][0].h[0] = lds_read_b64<0>(a0_);    vf[0][0].h[1] = lds_read_b64<0>(a1_);    vf[0][1].h[0] = lds_read_b64<0>(a2_);    vf[0][1].h[1] = lds_read_b64<0>(a3_); \
        vf[1][0].h[0] = lds_read_b64<2048>(a0_); vf[1][0].h[1] = lds_read_b64<2048>(a1_); vf[1][1].h[0] = lds_read_b64<2048>(a2_); vf[1][1].h[1] = lds_read_b64<2048>(a3_); \
        vf[2][0].h[0] = lds_read_b64<4096>(a0_); vf[2][0].h[1] = lds_read_b64<4096>(a1_); vf[2][1].h[0] = lds_read_b64<4096>(a2_); vf[2][1].h[1] = lds_read_b64<4096>(a3_); \
        vf[3][0].h[0] = lds_read_b64<6144>(a0_); vf[3][0].h[1] = lds_read_b64<6144>(a1_); vf[3][1].h[0] = lds_read_b64<6144>(a2_); vf[3][1].h[1] = lds_read_b64<6144>(a3_); }
#define NSA_VWAIT(vf) asm volatile("s_waitcnt lgkmcnt(0)" : "+v"(vf[0][0].v), "+v"(vf[0][1].v), "+v"(vf[1][0].v), "+v"(vf[1][1].v), "+v"(vf[2][0].v), "+v"(vf[2][1].v), "+v"(vf[3][0].v), "+v"(vf[3][1].v) :: "memory")
template <bool MASK, bool IMP, bool PV>
__device__ __forceinline__ void nsa_visit(const u16* Ks, const u16* Vs, const u16* qrow, Sub& s, int lo, int hi, int lane, float* e, float* p3) {
    const int kr = lane & 15, qq = lane >> 4;
    f32x4 S[4];
    const int qsw = ((kr & 3) >> 1) ^ ((kr >> 2) << 1);
    const bf16x8 qf0 = *(const bf16x8*)(qrow + ((qq ^ qsw) << 3)), qf1 = *(const bf16x8*)(qrow + (((4 + qq) ^ qsw) << 3));
    bf16x8 kf[4][2];
    const int swz = kr >> 1;
    {
        const char* kb_ = (const char*)Ks + kr * 128;
        const int ko0 = (qq ^ swz) << 4, ko1 = ko0 ^ 64;
#pragma unroll
        for (int kt = 0; kt < 4; kt++) { kf[kt][0] = *(const bf16x8*)(kb_ + kt * 2048 + ko0); kf[kt][1] = *(const bf16x8*)(kb_ + kt * 2048 + ko1); }
    }
    __builtin_amdgcn_sched_barrier(0);
#pragma unroll
    for (int kt = 0; kt < 4; kt++) {
        S[kt] = __builtin_amdgcn_mfma_f32_16x16x32_bf16(kf[kt][0], qf0, f32x4{0.f, 0.f, 0.f, 0.f}, 0, 0, 0);
        S[kt] = __builtin_amdgcn_mfma_f32_16x16x32_bf16(kf[kt][1], qf1, S[kt], 0, 0, 0);
    }
    float mx = NEG_BIG;
#pragma unroll
    for (int kt = 0; kt < 4; kt++)
#pragma unroll
        for (int r = 0; r < 4; r++) {
            if (MASK) { const int o = kt * 16 + qq * 4 + r; if (o < lo || o > hi) S[kt][r] = -INFINITY; }
            mx = fmaxf(mx, S[kt][r]);
        }
    mx = xq_max(mx);
    const float mnew = fmaxf(s.m, mx);
    const float alpha = __builtin_amdgcn_exp2f(s.m - mnew);
    s.m = mnew;
    float psum = 0.f;
#pragma unroll
    for (int kt = 0; kt < 4; kt++) {
#pragma unroll
        for (int r = 0; r < 4; r++) { S[kt][r] = __builtin_amdgcn_exp2f(S[kt][r] - mnew); }
        const float ee = (S[kt][0] + S[kt][1]) + (S[kt][2] + S[kt][3]);
        psum += ee;
        if (IMP) { e[kt] = ee; p3[kt] = S[kt][3]; }
    }
    s.l = s.l * alpha + psum;
    if (PV) {
        if (!__all(alpha == 1.f)) {
#pragma unroll
            for (int dt = 0; dt < 4; dt++)
#pragma unroll
                for (int r = 0; r < 4; r++) s.O[dt][r] *= alpha;
        }
        VF vf[4][2];
        NSA_LDV_ASM(vf, Vs, kr, qq, swz)
        bf16x8 pb[2];
#pragma unroll
        for (int k2 = 0; k2 < 2; k2++) {
            union { bf16x8 v; unsigned u[4]; } t;
            t.u[0] = pack2(S[2 * k2][0], S[2 * k2][1]); t.u[1] = pack2(S[2 * k2][2], S[2 * k2][3]);
            t.u[2] = pack2(S[2 * k2 + 1][0], S[2 * k2 + 1][1]); t.u[3] = pack2(S[2 * k2 + 1][2], S[2 * k2 + 1][3]);
            pb[k2] = t.v;
        }
        NSA_VWAIT(vf);
        __builtin_amdgcn_sched_barrier(0);
#pragma unroll
        for (int dt = 0; dt < 4; dt++)
#pragma unroll
            for (int k2 = 0; k2 < 2; k2++) s.O[dt] = __builtin_amdgcn_mfma_f32_16x16x32_bf16(vf[dt][k2].v, pb[k2], s.O[dt], 0, 0, 0);
    }
}
template <bool IMP, bool PV, bool MASK>
__device__ __forceinline__ void nsa_visit2(const u16* Ks, const u16* Vs, const u16* qrow0, const u16* qrow1, Sub (&st)[2], const int (&hi)[2], int lane, float (&e)[2][4], float (&p3)[2][4]) {
    const int kr = lane & 15, qq = lane >> 4;
    const int qsw = ((kr & 3) >> 1) ^ ((kr >> 2) << 1);
    bf16x8 qf0[2], qf1[2];
    qf0[0] = *(const bf16x8*)(qrow0 + ((qq ^ qsw) << 3)); qf1[0] = *(const bf16x8*)(qrow0 + (((4 + qq) ^ qsw) << 3));
    qf0[1] = *(const bf16x8*)(qrow1 + ((qq ^ qsw) << 3)); qf1[1] = *(const bf16x8*)(qrow1 + (((4 + qq) ^ qsw) << 3));
    bf16x8 kf[4][2];
    const int swz = kr >> 1;
    {
        const char* kb_ = (const char*)Ks + kr * 128;
        const int ko0 = (qq ^ swz) << 4, ko1 = ko0 ^ 64;
#pragma unroll
        for (int kt = 0; kt < 4; kt++) { kf[kt][0] = *(const bf16x8*)(kb_ + kt * 2048 + ko0); kf[kt][1] = *(const bf16x8*)(kb_ + kt * 2048 + ko1); }
    }
    __builtin_amdgcn_sched_barrier(0);
    f32x4 S[2][4];
#pragma unroll
    for (int kt = 0; kt < 4; kt++)
#pragma unroll
        for (int q = 0; q < 2; q++) {
            const float s0 = PV ? -st[q].m : 0.f;
            S[q][kt] = __builtin_amdgcn_mfma_f32_16x16x32_bf16(kf[kt][0], qf0[q], f32x4{s0, s0, s0, s0}, 0, 0, 0);
            S[q][kt] = __builtin_amdgcn_mfma_f32_16x16x32_bf16(kf[kt][1], qf1[q], S[q][kt], 0, 0, 0);
        }
    VF vf[4][2];
    bf16x8 pb[2][2];
#pragma unroll
    for (int q = 0; q < 2; q++) {
        Sub& s = st[q];
        float mnew = 0.f;
        if (MASK) {
#pragma unroll
            for (int kt = 0; kt < 4; kt++)
#pragma unroll
                for (int r = 0; r < 4; r++) { const int o = kt * 16 + qq * 4 + r; if (o > hi[q]) S[q][kt][r] = -INFINITY; }
        }
        if (!PV) {
            float mx = NEG_BIG;
#pragma unroll
            for (int kt = 0; kt < 4; kt++)
#pragma unroll
                for (int r = 0; r < 4; r++) mx = fmaxf(mx, S[q][kt][r]);
            mx = xq_max(mx);
            mnew = fmaxf(s.m, mx);
            const float alpha = __builtin_amdgcn_exp2f(s.m - mnew);
            s.m = mnew;
            s.l *= alpha;
        }
        float psum = 0.f;
#pragma unroll
        for (int kt = 0; kt < 4; kt++) {
#pragma unroll
            for (int r = 0; r < 4; r++) { S[q][kt][r] = __builtin_amdgcn_exp2f(PV ? S[q][kt][r] : S[q][kt][r] - mnew); }
            const float ee = (S[q][kt][0] + S[q][kt][1]) + (S[q][kt][2] + S[q][kt][3]);
            psum += ee;
            if (IMP) { e[q][kt] = ee; p3[q][kt] = S[q][kt][3]; }
        }
        s.l += psum;
        if (PV) {
#pragma unroll
            for (int k2 = 0; k2 < 2; k2++) {
                union { bf16x8 v; unsigned u[4]; } t;
                t.u[0] = pack2(S[q][2 * k2][0], S[q][2 * k2][1]); t.u[1] = pack2(S[q][2 * k2][2], S[q][2 * k2][3]);
                t.u[2] = pack2(S[q][2 * k2 + 1][0], S[q][2 * k2 + 1][1]); t.u[3] = pack2(S[q][2 * k2 + 1][2], S[q][2 * k2 + 1][3]);
                pb[q][k2] = t.v;
            }
            if (q == 0) NSA_LDV_ASM(vf, Vs, kr, qq, swz)
        }
    }
    if (PV) {
        NSA_VWAIT(vf);
        __builtin_amdgcn_sched_barrier(0);
#pragma unroll
        for (int dt = 0; dt < 4; dt++)
#pragma unroll
            for (int k2 = 0; k2 < 2; k2++)
#pragma unroll
                for (int q = 0; q < 2; q++) st[q].O[dt] = __builtin_amdgcn_mfma_f32_16x16x32_bf16(vf[dt][k2].v, pb[q][k2], st[q].O[dt], 0, 0, 0);
    }
}
template <int MMODE, bool FIXM, int NQ>
__device__ __forceinline__ void nsa_visit_gn(const u16* Ks, const u16* Vs, const u16* qs, float* Os, float* Ms, float* Ls, const int (&tok)[NQ], const bool (&valid)[NQ], int lane) {
    const int kr = lane & 15, qq = lane >> 4, hh = kr & 3;
    int row[NQ], osw[NQ]; float* orow[NQ];
    f32x4 O[NQ][4]; float m_old[NQ], l_old[NQ]; bf16x8 qf0[NQ], qf1[NQ];
#pragma unroll
    for (int q = 0; q < NQ; q++) {
        row[q] = tok[q] * 4 + hh; orow[q] = Os + row[q] * 64;
        osw[q] = hh ^ ((tok[q] & 3) << 2);
        if (FIXM) {
#pragma unroll
            for (int dt = 0; dt < 4; dt++) O[q][dt] = *(const f32x4*)(orow[q] + (((dt * 4 + qq) ^ osw[q]) << 2));
            m_old[q] = Ms[row[q]]; l_old[q] = Ls[row[q]];
        } else {
#pragma unroll
            for (int dt = 0; dt < 4; dt++) O[q][dt] = f32x4{0.f, 0.f, 0.f, 0.f};
            m_old[q] = NEG_BIG; l_old[q] = 0.f;
        }
        const u16* qrow = qs + row[q] * 64;
        const int qsw = (hh >> 1) ^ ((tok[q] & 3) << 1);
        qf0[q] = *(const bf16x8*)(qrow + ((qq ^ qsw) << 3)); qf1[q] = *(const bf16x8*)(qrow + (((4 + qq) ^ qsw) << 3));
    }
    bf16x8 kf[4][2];
    const int swz = kr >> 1;
    {
        const char* kb_ = (const char*)Ks + kr * 128;
        const int ko0 = (qq ^ swz) << 4, ko1 = ko0 ^ 64;
#pragma unroll
        for (int kt = 0; kt < 4; kt++) { kf[kt][0] = *(const bf16x8*)(kb_ + kt * 2048 + ko0); kf[kt][1] = *(const bf16x8*)(kb_ + kt * 2048 + ko1); }
    }
    __builtin_amdgcn_sched_barrier(0);
    f32x4 S[NQ][4];
#pragma unroll
    for (int kt = 0; kt < 4; kt++)
#pragma unroll
        for (int q = 0; q < NQ; q++) {
            const float s0 = FIXM ? (valid[q] ? -m_old[q] : -INFINITY) : 0.f;
            S[q][kt] = __builtin_amdgcn_mfma_f32_16x16x32_bf16(kf[kt][0], qf0[q], f32x4{s0, s0, s0, s0}, 0, 0, 0);
            S[q][kt] = __builtin_amdgcn_mfma_f32_16x16x32_bf16(kf[kt][1], qf1[q], S[q][kt], 0, 0, 0);
        }
    VF vf[4][2];
#define NSA_LDV NSA_LDV_ASM(vf, Vs, kr, qq, swz)
    if (NQ == 1) NSA_LDV
    bf16x8 pb[NQ][2];
#pragma unroll
    for (int q = 0; q < NQ; q++) {
        float mx = NEG_BIG;
#pragma unroll
        for (int kt = 0; kt < 4; kt++)
#pragma unroll
            for (int r = 0; r < 4; r++) {
                if (MMODE == 1) { const int o = kt * 16 + qq * 4 + r; if (o > tok[q]) S[q][kt][r] = -INFINITY; }
                if (MMODE == 2) { const int o = kt * 16 + qq * 4 + r; if (o <= tok[q]) S[q][kt][r] = -INFINITY; }
                if (!FIXM) mx = fmaxf(mx, S[q][kt][r]);
            }
        float mnew = m_old[q], alpha = 1.f;
        if (!FIXM) {
            if (!valid[q]) mx = NEG_BIG;
            mx = xq_max(mx);
            mnew = fmaxf(m_old[q], mx);
            alpha = __builtin_amdgcn_exp2f(m_old[q] - mnew);
        }
#pragma unroll
        for (int kt = 0; kt < 4; kt++)
#pragma unroll
            for (int r = 0; r < 4; r++) { S[q][kt][r] = __builtin_amdgcn_exp2f(FIXM ? S[q][kt][r] : S[q][kt][r] - mnew); }
#pragma unroll
        for (int k2 = 0; k2 < 2; k2++) {
            union { bf16x8 v; unsigned u[4]; } t;
            t.u[0] = pack2(S[q][2 * k2][0], S[q][2 * k2][1]); t.u[1] = pack2(S[q][2 * k2][2], S[q][2 * k2][3]);
            t.u[2] = pack2(S[q][2 * k2 + 1][0], S[q][2 * k2 + 1][1]); t.u[3] = pack2(S[q][2 * k2 + 1][2], S[q][2 * k2 + 1][3]);
            pb[q][k2] = t.v;
        }
        float psum;
        {
            const bf16x8 ones = {0x3F80, 0x3F80, 0x3F80, 0x3F80, 0x3F80, 0x3F80, 0x3F80, 0x3F80};
            f32x4 ps = __builtin_amdgcn_mfma_f32_16x16x32_bf16(ones, pb[q][0], f32x4{0.f, 0.f, 0.f, 0.f}, 0, 0, 0);
            ps = __builtin_amdgcn_mfma_f32_16x16x32_bf16(ones, pb[q][1], ps, 0, 0, 0);
            psum = ps[0];
        }
        if (FIXM) { if (valid[q] && qq == 0) Ls[row[q]] = l_old[q] + psum; }
        else { if (valid[q] && qq == 0) { Ms[row[q]] = mnew; Ls[row[q]] = psum; } }
        if (NQ == 2 && q == 0) { asm volatile("" ::: "memory"); NSA_LDV }
    }
#undef NSA_LDV
    NSA_VWAIT(vf);
    __builtin_amdgcn_sched_barrier(0);
#pragma unroll
    for (int dt = 0; dt < 4; dt++)
#pragma unroll
        for (int k2 = 0; k2 < 2; k2++)
#pragma unroll
            for (int q = 0; q < NQ; q++) O[q][dt] = __builtin_amdgcn_mfma_f32_16x16x32_bf16(vf[dt][k2].v, pb[q][k2], O[q][dt], 0, 0, 0);
#pragma unroll
    for (int q = 0; q < NQ; q++)
        if (valid[q]) {
#pragma unroll
            for (int dt = 0; dt < 4; dt++) *(f32x4*)(orow[q] + (((dt * 4 + qq) ^ osw[q]) << 2)) = O[q][dt];
        }
}
template <int MMODE, bool FIXM>
__device__ __forceinline__ void nsa_visit_g(const u16* Ks, const u16* Vs, const u16* qs, float* Os, float* Ms, float* Ls, int tok, bool valid, int lane) {
    const int tk[1] = {tok}; const bool vl[1] = {valid};
    nsa_visit_gn<MMODE, FIXM, 1>(Ks, Vs, qs, Os, Ms, Ls, tk, vl, lane);
}
__device__ __forceinline__ void nsa_fold_lds(float* Os, float* Ms, float* Ls, int row, int qq, int hh, f32x4 (&T)[4], float gate, bool reset) {
    const float lt = Ls[row];
    const float sc = (lt > 0.f) ? gate / lt : 0.f;
#pragma unroll
    for (int dt = 0; dt < 4; dt++) {
        float* op = Os + row * 64 + (((dt * 4 + qq) ^ hh ^ (((row >> 2) & 3) << 2)) << 2);
        const f32x4 o = *(const f32x4*)op;
#pragma unroll
        for (int r = 0; r < 4; r++) T[dt][r] += o[r] * sc;
    }
    (void)reset; (void)Ms;
}
template <int MODE>
__device__ __forceinline__ void nsa_fold(Sub& s, f32x4 (&T)[4], float gate) {
    const float lt = xq_sum(s.l);
    const float sc = (lt > 0.f) ? gate / lt : 0.f;
#pragma unroll
    for (int dt = 0; dt < 4; dt++)
#pragma unroll
        for (int r = 0; r < 4; r++) {
            const float v = s.O[dt][r] * sc;
            T[dt][r] = (MODE == 1) ? T[dt][r] + v : v;
            s.O[dt][r] = 0.f;
        }
    s.m = NEG_BIG; s.l = 0.f;
}

constexpr int NSA_R = 3;
template <bool HASV, class KSrc, class VSrc, class Body>
__device__ __forceinline__ void nsa_stream(char* ring, int n, KSrc ksrc, VSrc vsrc, Body body) {
    const int t = get_tid();
    const int so = (t >> 3) * 64 + (((t & 7) ^ ((t >> 4) & 7)) << 3);
    char* dl = ring + t * 16;
#define NSA_ISSUE(i, slot) { glds16(ksrc(i) + so, dl + (slot) * 16384); if (HASV) glds16(vsrc(i) + so, dl + (slot) * 16384 + 8192); }
    asm volatile("s_waitcnt lgkmcnt(0)" ::: "memory");
    __builtin_amdgcn_s_barrier();
    if (n > 0) NSA_ISSUE(0, 0)
    if (n > 1) NSA_ISSUE(1, 1)
    int slot = 0;
    for (int i = 0; i < n; i++) {
        if (i + 1 < n) { if (HASV) asm volatile("s_waitcnt vmcnt(2)" ::: "memory"); else asm volatile("s_waitcnt vmcnt(1)" ::: "memory"); }
        else asm volatile("s_waitcnt vmcnt(0)" ::: "memory");
        asm volatile("s_waitcnt lgkmcnt(0)" ::: "memory");
        __builtin_amdgcn_s_barrier();
        asm volatile("" ::: "memory");
        const int sl2 = (slot == 0) ? 2 : slot - 1;
        if (i + 2 < n) NSA_ISSUE(i + 2, sl2)
        body(i, (const u16*)(ring + slot * 16384), (const u16*)(ring + slot * 16384 + 8192));
        slot = (slot == 2) ? 0 : slot + 1;
    }
#undef NSA_ISSUE
}
#define NSA_TOK(u) const int t3_ = get_tid(); const size_t ntk_ = (size_t)b * S_ + t0 + 8 * (t3_ >> 6) + 4 * (u) + ((t3_ & 15) >> 2); const int hd_ = g * 4 + (t3_ & 3);
__device__ void ph_nsa(const P& p, int bid, int nb, char* smem) {
    char* ring = smem;
    unsigned* selm = (unsigned*)(smem + NSA_R * 16384);
    int* blist = (int*)(selm + 256);
    int* nlistp = blist + 128;
    int* lcnt = nlistp + 4;
    unsigned char* lists = (unsigned char*)(lcnt + 128);
    float* Ms = (float*)(lists + 128 * 64);
    float* Ls = Ms + 256;
    float* Os = Ls + 256;
    float* impl = Os;
    u16* qs = (u16*)(Os + 64 * 4 * 64);
    unsigned long long ts_ = 0, tacc_ = 0;
    const int nitems = B_ * 2 * 128;
    for (int rr = 0;; rr++) {
        int it = bid;
        if (rr > 0 || bid < 0) {
            __syncthreads();
            if (get_tid() == 0) nlistp[3] = nb + atomicAdd(p.nsactr, 1);
            __syncthreads();
            it = nlistp[3];
        }
        if (it >= nitems) break;
        const int tid = get_tid(), lane = tid & 63, wv = tid >> 6;
        const int kr = lane & 15, qq = lane >> 4, ts = kr >> 2, hh = kr & 3;
        float* myimp = impl + wv * (32 * 2 * 16);
        const int tt = 127 - (it >> 3);
        const int bg = it & 7, b = bg >> 1, g = bg & 1;
        const int t0 = tt * 64, cur = tt;
        const int head = g * 4 + hh;
        Sub st[2];
        f32x4 T[2][4];
        int tl[2]; size_t ntok[2];
        __syncthreads();
#pragma unroll
        for (int u = 0; u < 2; u++) {
            tl[u] = 8 * wv + 4 * u + ts;
            ntok[u] = (size_t)b * S_ + t0 + tl[u];
#pragma unroll
            for (int ks = 0; ks < 2; ks++) *(bf16x8*)&qs[(tl[u] * 4 + hh) * 64 + (((ks * 4 + qq) ^ (hh >> 1) ^ ((tl[u] & 3) << 1)) << 3)] = *(const bf16x8*)&p.q[ntok[u] * 512 + head * 64 + ks * 32 + qq * 8];
#pragma unroll
            for (int dt = 0; dt < 4; dt++) st[u].O[dt] = f32x4{0.f, 0.f, 0.f, 0.f};
            st[u].m = NEG_BIG; st[u].l = 0.f;
        }
        const u16* kcb = p.kcb + (size_t)bg * 512 * 64;
        const u16* vcT = p.vcT + (size_t)bg * 8 * 4096;
        int nv[2];
#pragma unroll
        for (int u = 0; u < 2; u++) { const int t = t0 + tl[u]; nv[u] = (t >= 31) ? min((t - 31) / 16 + 1, NCMP) : 0; }
        const int tmax = t0 + 63;
        const int nvmax = (tmax >= 31) ? min((tmax - 31) / 16 + 1, NCMP) : 0;
        const int nvb = (nvmax + 63) >> 6;
        NSA_TS(1)
        __syncthreads();
        nsa_stream<false>(ring, nvb, [&](int kb) { return kcb + (size_t)kb * 4096; }, [&](int kb) { return vcT + (size_t)kb * 4096; },
            [&](int kb, const u16* Ks, const u16* Vs) {
                const int hi2[2] = {nv[0] - kb * 64 - 1, nv[1] - kb * 64 - 1};
                float e_[2][4], p3_[2][4];
                if (__all(hi2[0] >= 63 && hi2[1] >= 63)) nsa_visit2<false, false, false>(Ks, Vs, qs + (tl[0] * 4 + hh) * 64, qs + (tl[1] * 4 + hh) * 64, st, hi2, lane, e_, p3_);
                else nsa_visit2<false, false, true>(Ks, Vs, qs + (tl[0] * 4 + hh) * 64, qs + (tl[1] * 4 + hh) * 64, st, hi2, lane, e_, p3_);
            });
        float invl[2];
#pragma unroll
        for (int u = 0; u < 2; u++) { const float lt = xq_sum(st[u].l); invl[u] = (lt > 0.f) ? 1.f / lt : 0.f; st[u].l = 0.f; }
        float carry[2] = {0.f, 0.f};
        nsa_stream<true>(ring, nvb, [&](int kb) { return kcb + (size_t)kb * 4096; }, [&](int kb) { return vcT + (size_t)kb * 4096; },
            [&](int kb, const u16* Ks, const u16* Vs) {
            const int hi2[2] = {nv[0] - kb * 64 - 1, nv[1] - kb * 64 - 1};
            float e_[2][4], p3_[2][4];
            if (__all(hi2[0] >= 63 && hi2[1] >= 63)) nsa_visit2<true, true, false>(Ks, Vs, qs + (tl[0] * 4 + hh) * 64, qs + (tl[1] * 4 + hh) * 64, st, hi2, lane, e_, p3_);
            else nsa_visit2<true, true, true>(Ks, Vs, qs + (tl[0] * 4 + hh) * 64, qs + (tl[1] * 4 + hh) * 64, st, hi2, lane, e_, p3_);
#pragma unroll
            for (int u = 0; u < 2; u++) {
#pragma unroll
                for (int kt = 0; kt < 4; kt++) {
                    float ev = e_[u][kt] * invl[u], pv = p3_[u][kt] * invl[u];
                    ev += dppf<0xB1>(ev); ev += dppf<0x4E>(ev);
                    pv += dppf<0xB1>(pv); pv += dppf<0x4E>(pv);
                    const float sh = __int_as_float(__builtin_amdgcn_ds_bpermute(((lane - 16) & 63) << 2, __float_as_int(pv)));
                    const float nbv = (qq == 0) ? carry[u] : sh;
                    carry[u] = sh;
                    myimp[((kb * 4 + kt) * 2 + u) * 16 + ts * 4 + qq] = ev + nbv;
                }
            }
            });
        NSA_TE(1)
        NSA_TS(2)
#pragma unroll
        for (int u = 0; u < 2; u++) {
            float mv[8];
#pragma unroll
            for (int i = 0; i < 8; i++) {
                const int kk = 8 * hh + i, j = 4 * kk + qq;
                const float v = myimp[(kk * 2 + u) * 16 + ts * 4 + qq];
                mv[i] = (j >= 1 && j <= cur - 2) ? v : -1.f;
            }
            unsigned sel = 0u;
            const int ncand = max(0, cur - 2);
            const int nforced = (cur >= 2) ? 3 : (cur + 1);
            const int need = 16 - nforced;
            if (ncand <= need) {
#pragma unroll
                for (int i = 0; i < 8; i++) if (mv[i] >= 0.f) sel |= (1u << i);
            } else {
                for (int rnd = 0; rnd < need; rnd++) {
                    const float b01 = fmaxf(mv[0], mv[1]), b23 = fmaxf(mv[2], mv[3]), b45 = fmaxf(mv[4], mv[5]), b67 = fmaxf(mv[6], mv[7]);
                    float best = fmaxf(fmaxf(b01, b23), fmaxf(b45, b67));
                    int bi = 7;
#pragma unroll
                    for (int i = 6; i >= 0; i--) bi = (mv[i] == best) ? i : bi;
                    int bj = (best >= 0.f) ? (4 * (8 * hh + bi) + qq) : 9999;
#define TK_MERGE(ov, oj) { const float v2_ = (ov); const int j2_ = (oj); const bool tk_ = (v2_ > best) || (v2_ == best && j2_ < bj); best = tk_ ? v2_ : best; bj = tk_ ? j2_ : bj; }
                    TK_MERGE(dppf<0xB1>(best), __builtin_amdgcn_update_dpp(0, bj, 0xB1, 0xF, 0xF, true))
                    TK_MERGE(dppf<0x4E>(best), __builtin_amdgcn_update_dpp(0, bj, 0x4E, 0xF, 0xF, true))
                    {
                        auto rv = __builtin_amdgcn_permlane16_swap(__float_as_uint(best), __float_as_uint(best), false, false);
                        auto rj = __builtin_amdgcn_permlane16_swap((unsigned)bj, (unsigned)bj, false, false);
                        float v0 = __uint_as_float(rv[0]), v1 = __uint_as_float(rv[1]); int j0 = (int)rj[0], j1 = (int)rj[1];
                        if (v1 > v0 || (v1 == v0 && j1 < j0)) { v0 = v1; j0 = j1; }
                        rv = __builtin_amdgcn_permlane32_swap(__float_as_uint(v0), __float_as_uint(v0), false, false);
                        rj = __builtin_amdgcn_permlane32_swap((unsigned)j0, (unsigned)j0, false, false);
                        best = __uint_as_float(rv[0]); bj = (int)rj[0];
                        const float v2 = __uint_as_float(rv[1]); const int j2 = (int)rj[1];
                        if (v2 > best || (v2 == best && j2 < bj)) { best = v2; bj = j2; }
                    }
#undef TK_MERGE
                    const bool mine = (bj < 512) && ((bj >> 5) == hh) && ((bj & 3) == qq);
                    const int li = (bj >> 2) & 7;
#pragma unroll
                    for (int i = 0; i < 8; i++) mv[i] = (mine && li == i) ? -1.f : mv[i];
                    if (mine) sel |= (1u << li);
                }
            }
            if (qq == 0 && hh == 0) sel |= 1u;
            if ((cur & 3) == qq && (cur >> 5) == hh) sel |= (1u << ((cur >> 2) & 7));
            if (cur >= 1 && ((cur - 1) & 3) == qq && ((cur - 1) >> 5) == hh) sel |= (1u << (((cur - 1) >> 2) & 7));
            unsigned w = sel << (8 * hh);
            w |= (unsigned)__builtin_amdgcn_update_dpp(0, (int)w, 0xB1, 0xF, 0xF, true);
            w |= (unsigned)__builtin_amdgcn_update_dpp(0, (int)w, 0x4E, 0xF, 0xF, true);
            if (hh == 0) selm[tl[u] * 4 + qq] = w;
        }
        NSA_TE(2)
        NSA_TS(3)
        __syncthreads();
#pragma unroll
        for (int u = 0; u < 2; u++) { NSA_TOK(u) nsa_fold<0>(st[u], T[u], p.nsag[ntk_ * 24 + hd_ * 3 + 0]); }
        {
            const int t2 = get_tid();
            unsigned long long tm = 0ull; int lrank = 0;
            if (t2 < 128) {
                const int j = t2;
                for (int tk = 0; tk < 64; tk++) tm |= (unsigned long long)((selm[tk * 4 + (j & 3)] >> (j >> 2)) & 1u) << tk;
                if (j > cur) tm = 0ull;
                const unsigned long long bal = __ballot(tm != 0ull);
                lrank = __popcll(bal & ((1ull << (t2 & 63)) - 1ull));
                if ((t2 & 63) == 0) nlistp[t2 >> 6] = __popcll(bal);
            }
            __syncthreads();
            if (t2 < 128 && tm != 0ull) {
                const int pos = lrank + ((t2 >= 64) ? nlistp[0] : 0);
                blist[pos] = t2; lcnt[pos] = __popcll(tm);
                int c = 0;
                while (tm) { lists[pos * 64 + c] = (unsigned char)(__ffsll((long long)tm) - 1); c++; tm &= tm - 1ull; }
            }
            __syncthreads();
        }
        const int nlist = nlistp[0] + nlistp[1];
        NSA_TE(3)
        NSA_TS(4)
        const u16* ksl = p.ksl + (size_t)bg * S_ * 64;
        const u16* vslT = p.vslT + (size_t)bg * 128 * 4096;
        {
            const int t4 = get_tid(), wv4 = __builtin_amdgcn_readfirstlane(t4 >> 6), ts4 = (t4 & 15) >> 2;
            const int td = t4 & 255;
            const int so = (td >> 3) * 64 + (((td & 7) ^ ((td >> 4) & 7)) << 3);
            char* dl = ring + td * 16;
#define NSA_RI(i) (nlist - 1 - (i))
#define NSA_ISSUE2(i, slot) if (wv4 >= 4) { const int jj_ = blist[NSA_RI(i)]; const u16* kp_ = ksl + (size_t)jj_ * 4096 + so; const u16* vp_ = vslT + (size_t)jj_ * 4096 + so; char* d_ = dl + (slot) * 16384; \
                glds16(kp_, d_); glds16(kp_ + 2048, d_ + 4096); glds16(vp_, d_ + 8192); glds16(vp_ + 2048, d_ + 12288); }
            asm volatile("s_waitcnt lgkmcnt(0)" ::: "memory");
            __builtin_amdgcn_s_barrier();
            if (nlist > 0) NSA_ISSUE2(0, 0)
            if (nlist > 1) NSA_ISSUE2(1, 1)
            int jn = 0, nn = 0, tokn = 0;
            if (nlist > 0) { jn = blist[NSA_RI(0)]; nn = lcnt[NSA_RI(0)]; tokn = lists[NSA_RI(0) * 64 + wv4 * 4 + ts4]; }
            int slot = 0;
            for (int i = 0; i < nlist; i++) {
                if (i + 1 < nlist) asm volatile("s_waitcnt vmcnt(4)" ::: "memory"); else asm volatile("s_waitcnt vmcnt(0)" ::: "memory");
                asm volatile("s_waitcnt lgkmcnt(0)" ::: "memory");
                __builtin_amdgcn_s_barrier();
                asm volatile("" ::: "memory");
                const int sl2 = (slot == 0) ? 2 : slot - 1;
                if (i + 2 < nlist) NSA_ISSUE2(i + 2, sl2)
                const int j = jn, n = nn, tok0 = tokn;
                if (i + 1 < nlist) { jn = blist[NSA_RI(i + 1)]; nn = lcnt[NSA_RI(i + 1)]; tokn = lists[NSA_RI(i + 1) * 64 + wv4 * 4 + ts4]; }
                const u16* Ks = (const u16*)(ring + slot * 16384); const u16* Vs = Ks + 4096;
                if ((wv4 + NW) * 4 < n) {
                    const int e1 = (wv4 + NW) * 4 + ts4;
                    const bool vl2[2] = {true, e1 < n};
                    const int tk2[2] = {tok0, vl2[1] ? (int)lists[NSA_RI(i) * 64 + (e1 & 63)] : 0};
                    if (j == cur) nsa_visit_gn<1, false, 2>(Ks, Vs, qs, Os, Ms, Ls, tk2, vl2, t4 & 63);
                    else nsa_visit_gn<0, true, 2>(Ks, Vs, qs, Os, Ms, Ls, tk2, vl2, t4 & 63);
                } else if (wv4 * 4 < n) {
                    const int e = wv4 * 4 + ts4;
                    const bool valid = e < n;
                    const int tok = valid ? tok0 : 0;
                    if (j == cur) nsa_visit_g<1, false>(Ks, Vs, qs, Os, Ms, Ls, tok, valid, t4 & 63);
                    else nsa_visit_g<0, true>(Ks, Vs, qs, Os, Ms, Ls, tok, valid, t4 & 63);
                }
                slot = (slot == 2) ? 0 : slot + 1;
            }
#undef NSA_RI
#undef NSA_ISSUE2
        }
        __syncthreads();
        NSA_TE(4)
        NSA_TS(5)
#pragma unroll
        for (int u = 0; u < 2; u++) {
            NSA_TOK(u)
            const int t5 = t3_ & 63;
            nsa_fold_lds(Os, Ms, Ls, (8 * (t3_ >> 6) + 4 * u + ((t5 & 15) >> 2)) * 4 + (t5 & 3), t5 >> 4, t5 & 3, T[u], p.nsag[ntk_ * 24 + hd_ * 3 + 1], true);
        }
        const u16* kwn = p.kwn + (size_t)bg * S_ * 64;
        const u16* vwnT = p.vwnT + (size_t)bg * 128 * 4096;
        uint2 Tp[2][4];
#pragma unroll
        for (int u = 0; u < 2; u++)
#pragma unroll
            for (int dt = 0; dt < 4; dt++) { Tp[u][dt] = pack4(T[u][dt]); asm volatile("" : "+v"(Tp[u][dt].x), "+v"(Tp[u][dt].y)); }
        {
            const int jlo = max(0, cur - 8);
            nsa_stream<true>(ring, cur - jlo + 1, [&](int i) { return kwn + (size_t)(cur - i) * 4096; }, [&](int i) { return vwnT + (size_t)(cur - i) * 4096; },
                [&](int i, const u16* Ks, const u16* Vs) {
                    const int j = cur - i;
                    const int t4 = get_tid();
                    const int tb_ = 8 * (t4 >> 6) + ((t4 & 15) >> 2);
                    const int tk2[2] = {tb_, tb_ + 4}; const bool vl2[2] = {true, true};
                    if (j == cur) nsa_visit_gn<1, false, 2>(Ks, Vs, qs, Os, Ms, Ls, tk2, vl2, t4 & 63);
                    else if (j == cur - 8) nsa_visit_gn<2, true, 2>(Ks, Vs, qs, Os, Ms, Ls, tk2, vl2, t4 & 63);
                    else nsa_visit_gn<0, true, 2>(Ks, Vs, qs, Os, Ms, Ls, tk2, vl2, t4 & 63);
                });
        }
#pragma unroll
        for (int u = 0; u < 2; u++) {
            NSA_TOK(u)
#pragma unroll
            for (int dt = 0; dt < 4; dt++) T[u][dt] = unpack4(Tp[u][dt]);
            { const int t5 = t3_ & 63; nsa_fold_lds(Os, Ms, Ls, (8 * (t3_ >> 6) + 4 * u + ((t5 & 15) >> 2)) * 4 + (t5 & 3), t5 >> 4, t5 & 3, T[u], p.nsag[ntk_ * 24 + hd_ * 3 + 2], false); }
#pragma unroll
            for (int dt = 0; dt < 4; dt++) *(uint2*)&p.oa[ntk_ * 512 + hd_ * 64 + dt * 16 + ((t3_ & 63) >> 4) * 4] = pack4(T[u][dt]);
        }
        NSA_TE(5)
    }
    if (NSAPROBE) { __syncthreads(); const unsigned long long t1_ = __builtin_amdgcn_s_memrealtime(); while (__builtin_amdgcn_s_memrealtime() - t1_ < tacc_) __builtin_amdgcn_s_sleep(8); }
}

#ifndef CHPROBE
#define CHPROBE 0
#endif
#define CH_TS(k) if (CHPROBE == k) cts_ = __builtin_amdgcn_s_memrealtime();
#define CH_TE(k) if (CHPROBE == k) ctacc_ += __builtin_amdgcn_s_memrealtime() - cts_;
constexpr int RS = 72;
constexpr int RSLOT = 64 * RS;
__device__ __forceinline__ void mm64(const u16* A, int lda, const u16* Bz, int ldb, f32x4 (&acc)[2], int lane, int wv) {
    const int mt = wv >> 1, nt0 = (wv & 1) * 2, kr = lane & 15, qq = lane >> 4;
    bf16x8 a[2], b[2][2];
#pragma unroll
    for (int ks = 0; ks < 2; ks++) {
        a[ks] = *(const bf16x8*)&A[(mt * 16 + kr) * lda + ks * 32 + qq * 8];
#pragma unroll
        for (int i = 0; i < 2; i++) b[ks][i] = *(const bf16x8*)&Bz[((nt0 + i) * 16 + kr) * ldb + ks * 32 + qq * 8];
    }
#pragma unroll
    for (int ks = 0; ks < 2; ks++)
#pragma unroll
        for (int i = 0; i < 2; i++) acc[i] = __builtin_amdgcn_mfma_f32_16x16x32_bf16(a[ks], b[ks][i], acc[i], 0, 0, 0);
}
__device__ __forceinline__ void st_t(u16* dst, int ld, const f32x4& v, int mt, int nt, int lane) {
    uint2 o; o.x = pack2(v[0], v[1]); o.y = pack2(v[2], v[3]);
    *(uint2*)&dst[(nt * 16 + (lane & 15)) * ld + mt * 16 + (lane >> 4) * 4] = o;
}
__device__ __forceinline__ void st_n(u16* dst, int ld, const f32x4& v, int mt, int nt, int lane) {
#pragma unroll
    for (int r = 0; r < 4; r++) dst[(mt * 16 + (lane >> 4) * 4 + r) * ld + nt * 16 + (lane & 15)] = f2bf(v[r]);
}
#define ZACC(a) { a[0] = f32x4{0.f, 0.f, 0.f, 0.f}; a[1] = f32x4{0.f, 0.f, 0.f, 0.f}; }

__device__ void ph_rwkv_chunk(const P& p, int bid, int nb, char* smem) {
    unsigned long long cts_ = 0, ctacc_ = 0;
    u16* sl = (u16*)smem;
    float* tot = (float*)(sl + 14 * RSLOT);
    float* gl = tot + 512;
#define RW_IDX const int tid = get_tid(), lane = tid & 63, wv = tid >> 6, mt = wv >> 1, nt0 = (wv & 1) * 2, kr = lane & 15, qq = lane >> 4; (void)mt; (void)nt0; (void)kr; (void)qq; (void)lane;
    const int nitems = B_ * 128;
    for (int it0 = bid; it0 < nitems; it0 += nb) {
      const int c = it0 & 127, b = it0 >> 7;
      const size_t n0 = (size_t)b * S_ + c * 64;
      __syncthreads();
      bf16x8 xa_[8], wb[2][2], ab[2][2], gb[2][4];
      u16 rc[8][3], rp0[3];
      float w0c[2], a0c[2], hc_[6];
#define S1_LOADW(hh_) { RW_IDX \
          _Pragma("unroll") for (int i = 0; i < 2; i++) { const int cc = (nt0 + i) * 16 + kr; w0c[i] = p.w0[(hh_) * 64 + cc]; a0c[i] = p.a0[(hh_) * 64 + cc]; \
              _Pragma("unroll") for (int ks = 0; ks < 2; ks++) { wb[i][ks] = *(const bf16x8*)&p.w2T[((size_t)(hh_) * 64 + cc) * 64 + ks * 32 + qq * 8]; \
                                                                 ab[i][ks] = *(const bf16x8*)&p.a2T[((size_t)(hh_) * 64 + cc) * 64 + ks * 32 + qq * 8]; } \
              _Pragma("unroll") for (int ks = 0; ks < 4; ks++) gb[i][ks] = *(const bf16x8*)&p.g2T[((size_t)(hh_) * 64 + cc) * 128 + ks * 32 + qq * 8]; } }
#define S2_LOADX(hh_) { RW_IDX const int ch_ = (hh_) * 64 + lane; \
          hc_[0] = p.mu[ch_]; hc_[1] = p.mu[512 + ch_]; hc_[2] = p.mu[1024 + ch_]; hc_[3] = p.k_k[ch_]; hc_[4] = p.k_a[ch_]; hc_[5] = p.r_k[ch_]; \
          _Pragma("unroll") for (int i = 0; i < 8; i++) { const int t = wv * 8 + i; const u16* cr = p.prw + (n0 + t) * CRW; \
              rc[i][0] = cr[ch_]; rc[i][1] = cr[512 + ch_]; rc[i][2] = cr[1024 + ch_]; } \
          rp0[0] = 0; rp0[1] = 0; rp0[2] = 0;     \
          if (c * 64 + wv * 8 > 0) { const u16* pp = p.prw + (n0 + wv * 8 - 1) * CRW; rp0[0] = pp[ch_]; rp0[1] = pp[512 + ch_]; rp0[2] = pp[1024 + ch_]; } }
      S2_LOADX(0)
      {
          RW_IDX
          const int t = tid >> 3, part = tid & 7;
          const size_t n = n0 + t;
          const bool hasprev = (c * 64 + t) > 0;
          u16* dst = p.xact + n * 256 + part * 32;
#pragma unroll
          for (int j = 0; j < 4; j++) {
              const int col = 1536 + part * 32 + j * 8;
              const uint4 cu = *(const uint4*)&p.prw[n * CRW + col];
              uint4 pv = make_uint4(0u, 0u, 0u, 0u);
              if (hasprev) pv = *(const uint4*)&p.prw[(n - 1) * CRW + col];
              const unsigned cw[4] = {cu.x, cu.y, cu.z, cu.w}, pw[4] = {pv.x, pv.y, pv.z, pv.w};
              unsigned ow[4];
#pragma unroll
              for (int e2 = 0; e2 < 4; e2++) {
                  float x0 = __uint_as_float(cw[e2] << 16), x1 = __uint_as_float(cw[e2] & 0xFFFF0000u);
                  const float q0 = __uint_as_float(pw[e2] << 16), q1 = __uint_as_float(pw[e2] & 0xFFFF0000u);
                  x0 = x0 + (q0 - x0) * p.mu[col + 2 * e2]; x1 = x1 + (q1 - x1) * p.mu[col + 2 * e2 + 1];
                  if (part < 2) { x0 = tanhf_(x0); x1 = tanhf_(x1); }
                  else if (part >= 4) { x0 = sigmoidf_(x0); x1 = sigmoidf_(x1); }
                  ow[e2] = pack2(x0, x1);
              }
              *(uint4*)&dst[j * 8] = make_uint4(ow[0], ow[1], ow[2], ow[3]);
          }
      }
      __syncthreads();
      const u16* xa = p.xact + n0 * 256;
      {
          RW_IDX
#pragma unroll
          for (int k8 = 0; k8 < 8; k8++) xa_[k8] = *(const bf16x8*)&xa[(mt * 16 + kr) * 256 + k8 * 32 + qq * 8];
      }
      S1_LOADW(0)
#pragma unroll 1
      for (int h = 0; h < 8; h++) {
        u16* cd = p.cdat + ((size_t)((b * 8 + h) * 128 + c)) * 4 * 4096;
        LDS_BARRIER();
        CH_TS(1)
        float* LW = (float*)(sl + 8 * RSLOT); float* LA = (float*)(sl + 10 * RSLOT);
        {
            RW_IDX
            f32x4 aw[2], aa2[2], ag[2];
#pragma unroll
            for (int i = 0; i < 2; i++) {
                aw[i] = f32x4{0.f, 0.f, 0.f, 0.f}; aa2[i] = aw[i]; ag[i] = aw[i];
#pragma unroll
                for (int ks = 0; ks < 2; ks++) {
                    aw[i] = __builtin_amdgcn_mfma_f32_16x16x32_bf16(xa_[ks], wb[i][ks], aw[i], 0, 0, 0);
                    aa2[i] = __builtin_amdgcn_mfma_f32_16x16x32_bf16(xa_[2 + ks], ab[i][ks], aa2[i], 0, 0, 0);
                }
#pragma unroll
                for (int ks = 0; ks < 4; ks++) ag[i] = __builtin_amdgcn_mfma_f32_16x16x32_bf16(xa_[4 + ks], gb[i][ks], ag[i], 0, 0, 0);
            }
#pragma unroll
            for (int i = 0; i < 2; i++)
#pragma unroll
                for (int r = 0; r < 4; r++) {
                    const int t = mt * 16 + qq * 4 + r, cc = (nt0 + i) * 16 + kr;
                    const float wl = w0c[i] + aw[i][r];
                    const float z = -wl;
                    const float sp = fmaxf(z, 0.f) + 0.6931471805599453f * __builtin_amdgcn_logf(1.f + __expf(-fabsf(z)));
                    LW[t * 64 + cc] = -__expf(-sp - 0.5f);
                    LA[t * 64 + cc] = sigmoidf_(a0c[i] + aa2[i][r]);
                    p.ob[(n0 + t) * 512 + h * 64 + cc] = f2bf(ag[i][r]);
                }
        }
        LDS_BARRIER();
        CH_TE(1) CH_TS(2)
        {
            RW_IDX
            const int ch = h * 64 + lane;
            const float mur = hc_[0], muk = hc_[1], muv = hc_[2];
            const float kkw = hc_[3], kaw = hc_[4], rkw = hc_[5];
            float rr[8], k2[8], vv[8], kkn[8], aa[8], lg[8], cs[8];
            float run = 0.f;
#pragma unroll
            for (int i = 0; i < 8; i++) {
                const int t = wv * 8 + i; const size_t n = n0 + t;
                float r = bf2f(rc[i][0]), k = bf2f(rc[i][1]), v = bf2f(rc[i][2]);
                const float pr = bf2f(i ? rc[i - 1][0] : rp0[0]), pk = bf2f(i ? rc[i - 1][1] : rp0[1]), pv = bf2f(i ? rc[i - 1][2] : rp0[2]);
                r = r + (pr - r) * mur; k = k + (pk - k) * muk; v = v + (pv - v) * muv;
                const float a = LA[t * 64 + lane];
                lg[i] = LW[t * 64 + lane];
                float kk = k * kkw;
                kkn[i] = kk * __builtin_amdgcn_rsqf(fmaxf(wave_sum(kk * kk), 1e-24f));
                k2[i] = k * (1.f + (a - 1.f) * kaw);
                const float bon = wave_sum(r * k2[i] * rkw);
                if (lane == 0) p.bon[n * 8 + h] = bon;
                rr[i] = r; vv[i] = v; aa[i] = a;
                run += lg[i]; cs[i] = run;
            }
            tot[wv * 64 + lane] = run;
            LDS_BARRIER();
            float off = 0.f, cumL = 0.f;
#pragma unroll
            for (int w2 = 0; w2 < 8; w2++) { const float tv = tot[w2 * 64 + lane]; cumL += tv; if (w2 < wv) off += tv; }
            if (wv == 0) gl[lane] = __expf(cumL);
            unsigned pa[4], pb[4], pk4[4], pv4[4];
#pragma unroll
            for (int i = 0; i < 8; i += 2) {
                float at[2], bt[2], kt[2], rt[2];
#pragma unroll
                for (int e2 = 0; e2 < 2; e2++) {
                    const int ii = i + e2; const int t = wv * 8 + ii;
                    const float cm = off + cs[ii];
                    const float g = __expf(cm), gp = __expf(cm - lg[ii]), gi = __expf(-cm);
                    at[e2] = -kkn[ii] * gp; bt[e2] = kkn[ii] * aa[ii] * gi; kt[e2] = k2[ii] * gi; rt[e2] = rr[ii] * g;
                    sl[0 * RSLOT + t * RS + lane] = f2bf(at[e2]);
                    sl[1 * RSLOT + t * RS + lane] = f2bf(bt[e2]);
                    sl[2 * RSLOT + t * RS + lane] = f2bf(kt[e2]);
                    sl[3 * RSLOT + t * RS + lane] = f2bf(rt[e2]);
                }
                pa[i >> 1] = pack2(at[0], at[1]); pb[i >> 1] = pack2(bt[0], bt[1]);
                pk4[i >> 1] = pack2(kt[0], kt[1]); pv4[i >> 1] = pack2(vv[i], vv[i + 1]);
            }
            *(uint4*)&sl[4 * RSLOT + lane * RS + wv * 8] = make_uint4(pa[0], pa[1], pa[2], pa[3]);
            *(uint4*)&sl[5 * RSLOT + lane * RS + wv * 8] = make_uint4(pb[0], pb[1], pb[2], pb[3]);
            *(uint4*)&sl[6 * RSLOT + lane * RS + wv * 8] = make_uint4(pk4[0], pk4[1], pk4[2], pk4[3]);
            *(uint4*)&sl[7 * RSLOT + lane * RS + wv * 8] = make_uint4(pv4[0], pv4[1], pv4[2], pv4[3]);
        }
        LDS_BARRIER();
        if (h + 1 < 8) { asm volatile("s_waitcnt vmcnt(0)" ::: "memory");
                         S1_LOADW(h + 1) S2_LOADX(h + 1) }
        CH_TE(2) CH_TS(3)
        {
            RW_IDX
            f32x4 acc[2];
            ZACC(acc); mm64(sl + 1 * RSLOT, RS, sl + 0 * RSLOT, RS, acc, lane, wv);
#pragma unroll
            for (int i = 0; i < 2; i++) {
                f32x4 pm;
#pragma unroll
                for (int r = 0; r < 4; r++) {
                    const int m = mt * 16 + qq * 4 + r, n = (nt0 + i) * 16 + kr;
                    if (!(m < n)) acc[i][r] = 0.f;
                    pm[r] = acc[i][r] + ((m == n) ? 1.f : 0.f);
                }
                st_t(sl + 8 * RSLOT, RS, acc[i], mt, nt0 + i, lane);
                st_n(sl + 9 * RSLOT, RS, acc[i], mt, nt0 + i, lane);
                st_t(sl + 13 * RSLOT, RS, pm, mt, nt0 + i, lane);
            }
            ZACC(acc); mm64(sl + 0 * RSLOT, RS, sl + 2 * RSLOT, RS, acc, lane, wv);
#pragma unroll
            for (int i = 0; i < 2; i++) {
#pragma unroll
                for (int r = 0; r < 4; r++) { const int m = mt * 16 + qq * 4 + r, n = (nt0 + i) * 16 + kr; if (!(m > n)) acc[i][r] = 0.f; }
                st_t(sl + 10 * RSLOT, RS, acc[i], mt, nt0 + i, lane);
            }
            ZACC(acc); mm64(sl + 1 * RSLOT, RS, sl + 3 * RSLOT, RS, acc, lane, wv);
#pragma unroll
            for (int i = 0; i < 2; i++) {
#pragma unroll
                for (int r = 0; r < 4; r++) { const int m = mt * 16 + qq * 4 + r, n = (nt0 + i) * 16 + kr; if (m > n) acc[i][r] = 0.f; }
                st_t(sl + 11 * RSLOT, RS, acc[i], mt, nt0 + i, lane);
            }
            ZACC(acc); mm64(sl + 2 * RSLOT, RS, sl + 3 * RSLOT, RS, acc, lane, wv);
#pragma unroll
            for (int i = 0; i < 2; i++) {
#pragma unroll
                for (int r = 0; r < 4; r++) { const int m = mt * 16 + qq * 4 + r, n = (nt0 + i) * 16 + kr; if (m > n) acc[i][r] = 0.f; }
                st_t(sl + 12 * RSLOT, RS, acc[i], mt, nt0 + i, lane);
            }
        }
        LDS_BARRIER();
        CH_TE(3) CH_TS(4)
        u16* X = sl + 8 * RSLOT; u16* XT = sl + 9 * RSLOT; u16* X2 = sl + 0 * RSLOT; u16* X2T = sl + 1 * RSLOT;
        u16* Pc = sl + 13 * RSLOT; u16* Pn = sl + 2 * RSLOT;
#pragma unroll 1
        for (int j = 1; j <= 6; j++) {
            RW_IDX
            f32x4 acc[2];
            if (j <= 5) {
                ZACC(acc); mm64(X, RS, XT, RS, acc, lane, wv);
#pragma unroll
                for (int i = 0; i < 2; i++) { st_t(X2T, RS, acc[i], mt, nt0 + i, lane); st_n(X2, RS, acc[i], mt, nt0 + i, lane); }
            }
            if (j >= 2) {
                ZACC(acc); mm64(XT, RS, Pc, RS, acc, lane, wv);
#pragma unroll
                for (int i = 0; i < 2; i++) {
                    const uint2 pv = *(const uint2*)&Pc[((nt0 + i) * 16 + kr) * RS + mt * 16 + qq * 4];
                    acc[i][0] += __uint_as_float(pv.x << 16); acc[i][1] += __uint_as_float(pv.x & 0xFFFF0000u);
                    acc[i][2] += __uint_as_float(pv.y << 16); acc[i][3] += __uint_as_float(pv.y & 0xFFFF0000u);
                    st_t(Pn, RS, acc[i], mt, nt0 + i, lane);
                }
            }
            LDS_BARRIER();
            if (j >= 2) { u16* tp = Pc; Pc = Pn; Pn = tp; }
            if (j <= 5) { u16* tx = X; X = X2; X2 = tx; tx = XT; XT = X2T; X2T = tx; }
        }
        CH_TE(4) CH_TS(5)
        u16* TT = Pc;
        {
            RW_IDX
            f32x4 acc[2];
            ZACC(acc); mm64(TT, RS, sl + 4 * RSLOT, RS, acc, lane, wv);
#pragma unroll
            for (int i = 0; i < 2; i++) st_t(sl + 0 * RSLOT, RS, acc[i], mt, nt0 + i, lane);
            ZACC(acc); mm64(sl + 10 * RSLOT, RS, TT, RS, acc, lane, wv);
#pragma unroll
            for (int i = 0; i < 2; i++) st_t(sl + 8 * RSLOT, RS, acc[i], mt, nt0 + i, lane);
        }
        LDS_BARRIER();
        {
            RW_IDX
            f32x4 acc[2];
            ZACC(acc); mm64(sl + 8 * RSLOT, RS, sl + 7 * RSLOT, RS, acc, lane, wv);
#pragma unroll
            for (int i = 0; i < 2; i++) st_t(sl + 9 * RSLOT, RS, acc[i], mt, nt0 + i, lane);
            ZACC(acc); mm64(sl + 0 * RSLOT, RS, sl + 5 * RSLOT, RS, acc, lane, wv);
#pragma unroll
            for (int i = 0; i < 2; i++) {
                const int n = (nt0 + i) * 16 + kr; const float gn = gl[n];
#pragma unroll
                for (int r = 0; r < 4; r++) { const int m = mt * 16 + qq * 4 + r; acc[i][r] = acc[i][r] * gn + ((m == n) ? gn : 0.f); }
                st_t(cd, 64, acc[i], mt, nt0 + i, lane);
            }
            ZACC(acc); mm64(sl + 0 * RSLOT, RS, sl + 11 * RSLOT, RS, acc, lane, wv);
#pragma unroll
            for (int i = 0; i < 2; i++) {
                const uint2 rv = *(const uint2*)&sl[3 * RSLOT + ((nt0 + i) * 16 + kr) * RS + mt * 16 + qq * 4];
                acc[i][0] += __uint_as_float(rv.x << 16); acc[i][1] += __uint_as_float(rv.x & 0xFFFF0000u);
                acc[i][2] += __uint_as_float(rv.y << 16); acc[i][3] += __uint_as_float(rv.y & 0xFFFF0000u);
                st_t(cd + 2 * 4096, 64, acc[i], mt, nt0 + i, lane);
            }
        }
        LDS_BARRIER();
        {
            RW_IDX
            f32x4 acc[2];
            ZACC(acc);
            mm64(sl + 5 * RSLOT, RS, sl + 9 * RSLOT, RS, acc, lane, wv);
            mm64(sl + 6 * RSLOT, RS, sl + 7 * RSLOT, RS, acc, lane, wv);
#pragma unroll
            for (int i = 0; i < 2; i++) {
#pragma unroll
                for (int r = 0; r < 4; r++) acc[i][r] *= gl[mt * 16 + qq * 4 + r];
                st_t(cd + 1 * 4096, 64, acc[i], mt, nt0 + i, lane);
            }
            ZACC(acc);
            mm64(sl + 9 * RSLOT, RS, sl + 11 * RSLOT, RS, acc, lane, wv);
            mm64(sl + 7 * RSLOT, RS, sl + 12 * RSLOT, RS, acc, lane, wv);
#pragma unroll
            for (int i = 0; i < 2; i++) st_t(cd + 3 * 4096, 64, acc[i], mt, nt0 + i, lane);
        }
        CH_TE(5)
      }
    }
    if (CHPROBE) { __syncthreads(); const unsigned long long t1_ = __builtin_amdgcn_s_memrealtime(); while (__builtin_amdgcn_s_memrealtime() - t1_ < ctacc_) __builtin_amdgcn_s_sleep(8); }
}

__device__ void ph_rwkv_seq(const P& p, int bid, int nb, char* smem) {
    u16* SL = (u16*)smem;
    const int tid = get_tid(), lane = tid & 63, wv = __builtin_amdgcn_readfirstlane(tid >> 6);
    const int kr = lane & 15, qq = lane >> 4, chn = wv >> 2, vt = wv & 3;
    for (int pair = bid; pair < B_ * 4; pair += nb) {
        const int bh = pair * 2 + chn;
        u16* mySL = SL + chn * RSLOT;
        __syncthreads();
#pragma unroll
        for (int ks = 0; ks < 2; ks++) *(uint4*)&mySL[(vt * 16 + kr) * RS + ks * 32 + qq * 8] = make_uint4(0u, 0u, 0u, 0u);
        u16* cbase = p.cdat + (size_t)bh * 128 * 4 * 4096;
        bf16x8 GA0[4][2], GA1[4][2], GA2[4][2], GA3[4][2]; u32x2 H0[4], H1[4], H2[4], H3[4];
#define SEQ_LD(GAx, Hx, c) { const u16* g0_ = cbase + (size_t)(c) * 4 * 4096 + kr * 64 + qq * 8; const u16* g1_ = g0_ + 2048; \
            const u16* hp_ = cbase + (size_t)(c) * 4 * 4096 + 4096 + (vt * 16 + kr) * 64 + qq * 4; \
            GAx[0][0] = gload_b128<0>(g0_); GAx[0][1] = gload_b128<64>(g0_); GAx[1][0] = gload_b128<2048>(g0_); GAx[1][1] = gload_b128<2112>(g0_); \
            GAx[2][0] = gload_b128<0>(g1_); GAx[2][1] = gload_b128<64>(g1_); GAx[3][0] = gload_b128<2048>(g1_); GAx[3][1] = gload_b128<2112>(g1_); \
            Hx[0] = gload_b64<0>(hp_); Hx[1] = gload_b64<32>(hp_); Hx[2] = gload_b64<64>(hp_); Hx[3] = gload_b64<96>(hp_); }
#define SEQ_STEP(GAx, Hx, c, nw) { \
            if ((nw) == 48) asm volatile("s_waitcnt vmcnt(48)" ::: "memory"); else if ((nw) == 36) asm volatile("s_waitcnt vmcnt(36)" ::: "memory"); \
            else if ((nw) == 24) asm volatile("s_waitcnt vmcnt(24)" ::: "memory"); else asm volatile("s_waitcnt vmcnt(12)" ::: "memory"); \
              \
            asm volatile("" : "+v"(GAx[0][0]), "+v"(GAx[0][1]), "+v"(GAx[1][0]), "+v"(GAx[1][1]), "+v"(GAx[2][0]), "+v"(GAx[2][1]), "+v"(GAx[3][0]), "+v"(GAx[3][1]), \
                              "+v"(Hx[0]), "+v"(Hx[1]), "+v"(Hx[2]), "+v"(Hx[3]) :: "memory"); \
            bf16x8 Z0[2]; \
            _Pragma("unroll") for (int ks = 0; ks < 2; ks++) Z0[ks] = *(const bf16x8*)&mySL[(vt * 16 + kr) * RS + ks * 32 + qq * 8]; \
            f32x4 zs[4]; \
            _Pragma("unroll") for (int m4 = 0; m4 < 4; m4++) { \
                zs[m4] = unpack4(make_uint2(Hx[m4].x, Hx[m4].y)); \
                _Pragma("unroll") for (int ks = 0; ks < 2; ks++) zs[m4] = __builtin_amdgcn_mfma_f32_16x16x32_bf16(GAx[m4][ks], Z0[ks], zs[m4], 0, 0, 0); } \
            u16* sn_ = cbase + (size_t)(c) * 4 * 4096 + 1 * 4096 + (vt * 16 + kr) * 64 + qq * 4; \
            _Pragma("unroll") for (int m4 = 0; m4 < 4; m4++) { \
                const uint2 pk_ = pack4(zs[m4]); \
                *(uint2*)&mySL[(vt * 16 + kr) * RS + m4 * 16 + qq * 4] = pk_; \
                *(uint2*)&sn_[m4 * 16] = pk_; } \
            asm volatile("" ::: "memory"); \
            if ((c) + 4 < 128) SEQ_LD(GAx, Hx, (c) + 4) }
        asm volatile("s_waitcnt vmcnt(0)" ::: "memory");
        SEQ_LD(GA0, H0, 0) SEQ_LD(GA1, H1, 1) SEQ_LD(GA2, H2, 2) SEQ_LD(GA3, H3, 3)
#pragma unroll 1
        for (int c = 0; c < 128; c += 4) {
            const bool first = (c == 0), lastt = (c == 124);
            SEQ_STEP(GA0, H0, c, first ? 36 : 48)
            SEQ_STEP(GA1, H1, c + 1, (first || lastt) ? 36 : 48)
            SEQ_STEP(GA2, H2, c + 2, first ? 36 : (lastt ? 24 : 48))
            SEQ_STEP(GA3, H3, c + 3, lastt ? 12 : 48)
        }
        asm volatile("s_waitcnt vmcnt(0)" ::: "memory");
#undef SEQ_LD
#undef SEQ_STEP
    }
}

__device__ void ph_rwkv_out(const P& p, int bid, int nb, char* smem) {
    const int tid = get_tid(), lane = tid & 63, wv = tid >> 6;
    const int kr = lane & 15, qq = lane >> 4;
    for (int it = bid * NW + wv; it < B_ * 8 * 128; it += nb * NW) {
        const int c = it & 127, bh = it >> 7, b = bh >> 3, h = bh & 7;
        const u16* cd = p.cdat + ((size_t)bh * 128 + c) * 4 * 4096;
        f32x4 ys[4][4];
#pragma unroll
        for (int mt = 0; mt < 4; mt++)
#pragma unroll
            for (int nt = 0; nt < 4; nt++) ys[mt][nt] = unpack4(*(const uint2*)&cd[3 * 4096 + (nt * 16 + kr) * 64 + mt * 16 + qq * 4]);
        if (c > 0) {
            const u16* s0 = cd - 4 * 4096 + 1 * 4096;
#pragma unroll
            for (int ks = 0; ks < 2; ks++) {
                bf16x8 af[4], bq[4];
#pragma unroll
                for (int mt = 0; mt < 4; mt++) af[mt] = *(const bf16x8*)&s0[(mt * 16 + kr) * 64 + ks * 32 + qq * 8];
#pragma unroll
                for (int nt = 0; nt < 4; nt++) bq[nt] = *(const bf16x8*)&cd[2 * 4096 + (nt * 16 + kr) * 64 + ks * 32 + qq * 8];
#pragma unroll
                for (int mt = 0; mt < 4; mt++)
#pragma unroll
                    for (int nt = 0; nt < 4; nt++) ys[mt][nt] = __builtin_amdgcn_mfma_f32_16x16x32_bf16(af[mt], bq[nt], ys[mt][nt], 0, 0, 0);
            }
        }
#pragma unroll
        for (int nt = 0; nt < 4; nt++) {
            float s1 = 0.f, s2 = 0.f;
#pragma unroll
            for (int mt = 0; mt < 4; mt++)
#pragma unroll
                for (int r = 0; r < 4; r++) { s1 += ys[mt][nt][r]; s2 += ys[mt][nt][r] * ys[mt][nt][r]; }
            s1 = xrow_sum(s1); s2 = xrow_sum(s2);
            const float mean = s1 * (1.f / 64.f);
            const float var = fmaxf(s2 * (1.f / 64.f) - mean * mean, 0.f);
            const float rstd = rsqrtf(var + 64e-5f);
            const int t = nt * 16 + kr;
            const size_t n = (size_t)b * S_ + c * 64 + t;
            const float bon = p.bon[n * 8 + h];
#pragma unroll
            for (int mt = 0; mt < 4; mt++) {
                const int vch = h * 64 + mt * 16 + qq * 4;
                const f32x4 vcf = unpack4(*(const uint2*)&p.prw[n * CRW + 1024 + vch]);
                const f32x4 vpf = (c * 64 + t > 0) ? unpack4(*(const uint2*)&p.prw[(n - 1) * CRW + 1024 + vch]) : f32x4{0.f, 0.f, 0.f, 0.f};
                const f32x4 ggf = unpack4(*(const uint2*)&p.ob[n * 512 + vch]);
                const float4 lw = *(const float4*)&p.ln_w[vch], lb = *(const float4*)&p.ln_b[vch], mv = *(const float4*)&p.mu[1024 + vch];
                const float lwa[4] = {lw.x, lw.y, lw.z, lw.w}, lba[4] = {lb.x, lb.y, lb.z, lb.w}, mva[4] = {mv.x, mv.y, mv.z, mv.w};
                f32x4 o;
#pragma unroll
                for (int r = 0; r < 4; r++) {
                    const float vsh = vcf[r] + (vpf[r] - vcf[r]) * mva[r];
                    o[r] = ((ys[mt][nt][r] - mean) * rstd * lwa[r] + lba[r] + bon * vsh) * ggf[r];
                }
                *(uint2*)&p.ob[n * 512 + vch] = pack4(o);
            }
        }
    }
}

__device__ __forceinline__ void unpack8(const uint4& u, f32x4& a, f32x4& b) {
    a = f32x4{__uint_as_float(u.x << 16), __uint_as_float(u.x & 0xFFFF0000u), __uint_as_float(u.y << 16), __uint_as_float(u.y & 0xFFFF0000u)};
    b = f32x4{__uint_as_float(u.z << 16), __uint_as_float(u.z & 0xFFFF0000u), __uint_as_float(u.w << 16), __uint_as_float(u.w & 0xFFFF0000u)};
}
struct EpiMerge {
    u16* merged; u16* tmp2; int pass;
    __device__ __forceinline__ void operator()(const f32x4 (&acc)[2][2][4][2], const GUnit& u, int, int, int, int) const {
        const int t2_ = get_tid(), wid_ = __builtin_amdgcn_readfirstlane(t2_ >> 6), wr = wid_ >> 2, wc = wid_ & 3, fr = t2_ & 15, fq = (t2_ >> 4) & 3;
        const int row0 = u.pm * 256 + wr * 64 + fr;
        if (pass < 2) {
            u16* dst = pass ? tmp2 : merged;
            const int col0 = u.pn * 256 + wc * 32 + 8 * fq;
#pragma unroll
            for (int ai = 0; ai < 2; ++ai)
#pragma unroll
                for (int m = 0; m < 4; ++m) {
                    const size_t off = (size_t)(row0 + ai * 128 + m * 16) * D_ + col0;
#pragma unroll
                    for (int bj = 0; bj < 2; ++bj) *(uint4*)&dst[off + bj * 128] = pack8(acc[ai][bj][m][0], acc[ai][bj][m][1]);
                }
        } else {
            const int col0 = u.pn * 128 + wc * 32 + 8 * fq;
#pragma unroll
            for (int ai = 0; ai < 2; ++ai)
#pragma unroll
                for (int m = 0; m < 4; ++m) {
                    const size_t off = (size_t)(row0 + ai * 128 + m * 16) * D_ + col0;
                    const uint4 ma = *(const uint4*)&merged[off], mb = *(const uint4*)&tmp2[off];
                    f32x4 a0, a1, b0, b1; unpack8(ma, a0, a1); unpack8(mb, b0, b1);
                    f32x4 v0, v1;
#pragma unroll
                    for (int r = 0; r < 4; r++) {
                        v0[r] = a0[r] * sigmoidf_(acc[ai][0][m][0][r]) + b0[r] * sigmoidf_(acc[ai][1][m][0][r]);
                        v1[r] = a1[r] * sigmoidf_(acc[ai][0][m][1][r]) + b1[r] * sigmoidf_(acc[ai][1][m][1][r]);
                    }
                    *(uint4*)&merged[off] = pack8(v0, v1);
                    asm volatile("" ::: "memory");
                }
        }
    }
};
struct MergeSched {
    DenseSched d; bool split;
    __device__ __forceinline__ bool next(int i, GUnit& u) const {
        if (!split) return d.next(i, u);
        if (!d.next(i >> 1, u)) return false;
        u.pn = 2 * u.pn + (i & 1); return true;
    }
    __device__ __forceinline__ unsigned a_off(const GUnit& u, int h, int R) const { return d.a_off(u, h, R); }
    __device__ __forceinline__ const char* b_ptr(const GUnit& u) const { return d.b_ptr(u); }
};
__device__ void ph_merge(const P& p, int bid, int nb, char* smem) {
    u16* tmp2 = (u16*)p.x1;
#pragma unroll 1
    for (int pass = 0; pass < 3; ++pass) {
        const int K = (pass == 2) ? D_ : 512;
        const u16* A = (pass == 2) ? p.hbuf : (pass == 0 ? p.oa : p.ob);
        const u16* Bt = (pass == 0) ? p.wpaT : (pass == 1 ? p.wpbT : p.wgT);
        MergeSched S; S.d.init(NTOK, D_, K, Bt, nb, bid); S.split = (pass == 2);
        EpiMerge E{p.merged, tmp2, pass};
        gemm256(smem, (const char*)A, K, S, E);
    }
}

struct EpiOutproj {
    const float* x; float* x1;
    __device__ __forceinline__ void operator()(const f32x4 (&acc)[2][2][4][2], const GUnit& u, int, int, int, int) const {
        const int t2_ = get_tid(), wid_ = __builtin_amdgcn_readfirstlane(t2_ >> 6), wr = wid_ >> 2, wc = wid_ & 3, fr = t2_ & 15, fq = (t2_ >> 4) & 3;
        const int row0 = u.pm * 256 + wr * 64 + fr, col0 = u.pn * 256 + wc * 32 + 4 * fq;
#pragma unroll
        for (int ai = 0; ai < 2; ++ai)
#pragma unroll
            for (int m = 0; m < 4; ++m) {
                const size_t off = (size_t)(row0 + ai * 128 + m * 16) * D_ + col0;
                f32x4 xin[2][2];
#pragma unroll
                for (int bj = 0; bj < 2; ++bj)
#pragma unroll
                    for (int n = 0; n < 2; ++n) xin[bj][n] = *(const f32x4*)&x[off + bj * 128 + n * 16];
#pragma unroll
                for (int bj = 0; bj < 2; ++bj)
#pragma unroll
                    for (int n = 0; n < 2; ++n) *(f32x4*)&x1[off + bj * 128 + n * 16] = xin[bj][n] + acc[ai][bj][m][n];
                asm volatile("" ::: "memory");
            }
    }
};
__device__ void ph_outproj(const P& p, int bid, int nb, char* smem) {
    DenseSched S; S.init(NTOK, D_, D_, p.woutT, nb, bid);
    EpiOutproj E{p.x, p.x1};
    gemm256(smem, (const char*)p.merged, D_, S, E);
}

__device__ __forceinline__ float red8f(float x) {
    x += dppf<0xB1>(x);
    x += dppf<0x4E>(x);
    x += dppf<0x141>(x);
    return x;
}
__device__ void ph_route(const P& p, int bid, int nb, char* smem) {
    float* wr = (float*)smem;
    const int tid = get_tid(), lane = tid & 63, wv = tid >> 6;
    {
        u16* Tl = (u16*)smem;
        const int t = get_tid();
        const int lrow = t >> 3, lc8 = (t & 7) * 8;
        const int sslot = t >> 3, skc = t & 7;
        const int scol = (sslot & 32) + perm32(sslot & 31);
        constexpr int NT13 = NEXP * 2 * 4 * 16, NT2 = NEXP * 16 * 4;
        for (int tile = bid; tile < NT13 + NT2; tile += nb) {
            const float* src; u16* dst; int N, Kd;
            if (tile < NT13) {
                const int kt = tile & 15, sg = (tile >> 4) & 3, half = (tile >> 6) & 1, e = tile >> 7;
                const int sl0 = sg * 64;
                N = 256; Kd = D_;
                src = ((sl0 >> 7) ? p.e_w3 : p.e_w1) + (size_t)e * D_ * 256 + (size_t)(kt * 64) * 256 + half * 128 + (sl0 & 127);
                dst = p.ew1T + ((size_t)e * 512 + half * 256 + sl0) * D_ + kt * 64;
            } else {
                const int t2 = tile - NT13;
                const int kt = t2 & 3, sg = (t2 >> 2) & 15, e = t2 >> 6;
                N = D_; Kd = 256;
                src = p.e_w2 + (size_t)e * 256 * D_ + (size_t)(kt * 64) * D_ + sg * 64;
                dst = p.ew2T + ((size_t)e * D_ + sg * 64) * 256 + kt * 64;
            }
            const float4 f0 = *(const float4*)&src[(size_t)lrow * N + lc8], f1 = *(const float4*)&src[(size_t)lrow * N + lc8 + 4];
            __syncthreads();
            const unsigned h0 = pack2(f0.x, f0.y), h1 = pack2(f0.z, f0.w), h2 = pack2(f1.x, f1.y), h3 = pack2(f1.z, f1.w);
            Tl[(lc8 + 0) * 72 + lrow] = (u16)(h0 & 0xFFFFu); Tl[(lc8 + 1) * 72 + lrow] = (u16)(h0 >> 16);
            Tl[(lc8 + 2) * 72 + lrow] = (u16)(h1 & 0xFFFFu); Tl[(lc8 + 3) * 72 + lrow] = (u16)(h1 >> 16);
            Tl[(lc8 + 4) * 72 + lrow] = (u16)(h2 & 0xFFFFu); Tl[(lc8 + 5) * 72 + lrow] = (u16)(h2 >> 16);
            Tl[(lc8 + 6) * 72 + lrow] = (u16)(h3 & 0xFFFFu); Tl[(lc8 + 7) * 72 + lrow] = (u16)(h3 >> 16);
            __syncthreads();
            *(uint4*)&dst[(size_t)sslot * Kd + skc * 8] = *(const uint4*)&Tl[scol * 72 + skc * 8];
        }
        __syncthreads();
    }
    for (int i = tid; i < 1024 * 36; i += NT) {
        const int k = i / 36, j = i - k * 36;
        const int kp = (k & ~31) + ((k & 3) << 3) + ((k >> 2) & 7);
        wr[kp * 36 + j] = (j < 4) ? p.w_grp[k * 4 + j] : p.w_exp[k * 32 + (j - 4)];
    }
    int* lcount = (int*)(smem + 1024 * 36 * 4);
    if (tid < 32) lcount[tid] = 0;
    __syncthreads();
    const int sub = lane & 7, tk = lane >> 3;
    for (int n0 = (bid * NW + wv) * 16; n0 < NTOK; n0 += nb * NW * 16) {
        float acc[2][36]; float ss[2] = {0.f, 0.f};
#pragma unroll
        for (int t = 0; t < 2; t++)
#pragma unroll
            for (int j = 0; j < 36; j++) acc[t][j] = 0.f;
#pragma unroll 1
        for (int i0 = 0; i0 < 32; i0 += 4) {
            float4 xv[2][4];
#pragma unroll
            for (int t = 0; t < 2; t++)
#pragma unroll
                for (int i = 0; i < 4; i++) xv[t][i] = *(const float4*)&p.x1[(size_t)(n0 + 8 * t + tk) * D_ + (i0 + i) * 32 + sub * 4];
#pragma unroll
            for (int i = 0; i < 4; i++) {
                const int k0 = (i0 + i) * 32 + sub * 4;
                const float4 gf = *(const float4*)&p.g_ffn[k0];
                float hv[2][4];
#pragma unroll
                for (int t = 0; t < 2; t++) {
                    const float4 x = xv[t][i];
                    ss[t] += x.x * x.x + x.y * x.y + x.z * x.z + x.w * x.w;
                    hv[t][0] = x.x * gf.x; hv[t][1] = x.y * gf.y; hv[t][2] = x.z * gf.z; hv[t][3] = x.w * gf.w;
                    uint2 o; o.x = pack2(hv[t][0], hv[t][1]); o.y = pack2(hv[t][2], hv[t][3]);
                    *(uint2*)&p.hbuf[(size_t)(n0 + 8 * t + tk) * D_ + k0] = o;
                }
#pragma unroll
                for (int e2 = 0; e2 < 4; e2++) {
                    asm volatile("" ::: "memory");
                    const float* wrow = wr + ((i0 + i) * 32 + e2 * 8 + sub) * 36;
#pragma unroll
                    for (int j4 = 0; j4 < 9; j4++) {
                        const float4 wv4 = *(const float4*)&wrow[j4 * 4];
#pragma unroll
                        for (int t = 0; t < 2; t++) {
                            acc[t][j4 * 4 + 0] += hv[t][e2] * wv4.x; acc[t][j4 * 4 + 1] += hv[t][e2] * wv4.y;
                            acc[t][j4 * 4 + 2] += hv[t][e2] * wv4.z; acc[t][j4 * 4 + 3] += hv[t][e2] * wv4.w;
                        }
                    }
                }
            }
        }
#pragma unroll
        for (int t = 0; t < 2; t++) {
            const size_t n = (size_t)n0 + 8 * t + tk;
            const float sst = red8f(ss[t]);
#pragma unroll
            for (int j = 0; j < 36; j++) acc[t][j] = red8f(acc[t][j]);
            const float rs = rsqrtf(sst * (1.f / D_) + 1e-6f);
            if (sub == 0) {
                p.rsb[n] = rs;
                float gl[4]; int gs = 0;
#pragma unroll
                for (int j = 0; j < 4; j++) gl[j] = acc[t][j] * rs + p.b_grp[j];
                float gm = gl[0];
#pragma unroll
                for (int j = 1; j < 4; j++) if (gl[j] > gm) { gm = gl[j]; gs = j; }
                float gsum = 0.f;
#pragma unroll
                for (int j = 0; j < 4; j++) gsum += __expf(gl[j] - gm);
                const float pg = 1.f / gsum;
                float el[8]; float em = -3.0e38f;
#pragma unroll
                for (int j = 0; j < 8; j++) {
                    float a = (gs == 0) ? acc[t][4 + j] : ((gs == 1) ? acc[t][12 + j] : ((gs == 2) ? acc[t][20 + j] : acc[t][28 + j]));
                    a = a * rs + p.b_exp[gs * 8 + j];
                    el[j] = a; em = fmaxf(em, a);
                }
                int j0 = 0, j1 = -1; float v0 = -3.0e38f, v1 = -3.0e38f;
#pragma unroll
                for (int j = 0; j < 8; j++) { el[j] = __expf(el[j] - em); }
#pragma unroll
                for (int j = 0; j < 8; j++) { if (el[j] > v0) { v0 = el[j]; j0 = j; } }
#pragma unroll
                for (int j = 0; j < 8; j++) { if (j != j0 && el[j] > v1) { v1 = el[j]; j1 = j; } }
                const float den = v0 + v1;
                const int e0 = gs * 8 + j0, e1 = gs * 8 + j1;
                p.tok_e[n * 2] = e0; p.tok_e[n * 2 + 1] = e1;
                p.tok_gate[n * 2] = pg * v0 / den; p.tok_gate[n * 2 + 1] = pg * v1 / den;
                atomicAdd(&lcount[e0], 1); atomicAdd(&lcount[e1], 1);
            }
        }
    }
    __syncthreads();
    { const int t2 = get_tid(); if (t2 < 32) { const int c = lcount[t2]; if (c) atomicAdd(&p.counts[t2], c); } }
}

__device__ void ph_scatter(const P& p, int bid, int nb, char* smem) {
    int* offl = (int*)smem;
    int* hist = offl + 64;
    int* gbase = hist + 32;
    const int tid = get_tid();
    if (tid == 0) {
        int off = 0;
        for (int e = 0; e < NEXP; e++) { offl[e] = off; off += p.counts[e]; }
        offl[NEXP] = off;
    }
    if (bid == 0 && tid == 64) {
        int off = 0, nb_ = 0;
        for (int e = 0; e < NEXP; e++) {
            const int c = p.counts[e];
            p.offs[e] = off;
            for (int r = 0; r < c; r += 256) { p.blk_e[nb_] = e; p.blk_r0[nb_] = off + r; nb_++; }
            off += c;
        }
        p.offs[NEXP] = off;
        *p.nblk = nb_;
    }
    for (int base = bid * NT; base < NTOK * 2; base += nb * NT) {
        __syncthreads();
        if (tid < 32) hist[tid] = 0;
        __syncthreads();
        const int i = base + tid;
        const int e = p.tok_e[i];
        const int rl = atomicAdd(&hist[e], 1);
        __syncthreads();
        if (tid < 32) gbase[tid] = atomicAdd(&p.cursor[tid], hist[tid]);
        __syncthreads();
        const int slot = offl[e] + gbase[e] + rl;
        p.list_tok[slot] = i >> 1; p.list_gate[slot] = p.tok_gate[i]; p.tokslot[i] = slot;
    }
}
template <int CTS>
struct MoeSched {
    const P* pp; int nunits, G, c; unsigned rowbytes; const u16* Bt; size_t b_estride, b_tstride;
    bool gather;
    __device__ __forceinline__ bool next(int i, GUnit& u) const {
        const int L = i * G + c; if (L >= nunits) return false;
        int wgid = L; { const int q = nunits >> 3, r = nunits & 7, xcd = wgid & 7, off = wgid >> 3; wgid = (xcd < r ? xcd * (q + 1) : r * (q + 1) + (xcd - r) * q) + off; }
        u.pm = wgid / CTS; u.pn = wgid & (CTS - 1); return true;
    }
    __device__ __forceinline__ unsigned a_off(const GUnit& u, int h, int R) const {
        const P& p = *pp;
        const int e = __builtin_amdgcn_readfirstlane(p.blk_e[u.pm]), rend = __builtin_amdgcn_readfirstlane(p.offs[e + 1]);
        int sl = __builtin_amdgcn_readfirstlane(p.blk_r0[u.pm]) + h * 128 + R; if (sl >= rend) sl = rend - 1;
        return (unsigned)(gather ? p.list_tok[sl] : sl) * rowbytes;
    }
    __device__ __forceinline__ const char* b_ptr(const GUnit& u) const { return (const char*)(Bt + (size_t)__builtin_amdgcn_readfirstlane(pp->blk_e[u.pm]) * b_estride + (size_t)u.pn * b_tstride); }
};
struct EpiMoe1 {
    const P* pp;
    __device__ __forceinline__ void operator()(const f32x4 (&acc)[2][2][4][2], const GUnit& u, int, int, int, int) const {
        const int t2_ = get_tid(), wid_ = __builtin_amdgcn_readfirstlane(t2_ >> 6), wr = wid_ >> 2, wc = wid_ & 3, fr = t2_ & 15, fq = (t2_ >> 4) & 3;
        const P& p = *pp;
        const int e = __builtin_amdgcn_readfirstlane(p.blk_e[u.pm]), r0 = __builtin_amdgcn_readfirstlane(p.blk_r0[u.pm]), rend = __builtin_amdgcn_readfirstlane(p.offs[e + 1]);
#pragma unroll
        for (int ai = 0; ai < 2; ++ai)
#pragma unroll
            for (int m = 0; m < 4; ++m) {
                const int sl = r0 + ai * 128 + wr * 64 + m * 16 + fr;
                if (sl < rend) {
                    const float rs = p.rsb[p.list_tok[sl]];
                    f32x4 v[2];
#pragma unroll
                    for (int n = 0; n < 2; ++n)
#pragma unroll
                        for (int r = 0; r < 4; r++) { const float a = acc[ai][0][m][n][r] * rs; v[n][r] = a * sigmoidf_(a) * (acc[ai][1][m][n][r] * rs); }
                    *(uint4*)&p.hid[(size_t)sl * 256 + u.pn * 128 + wc * 32 + 8 * fq] = pack8(v[0], v[1]);
                }
            }
    }
};
__device__ void ph_moe1(const P& p, int bid, int nb, char* smem) {
    MoeSched<2> S{&p, __builtin_amdgcn_readfirstlane(*p.nblk) * 2, nb, bid, (unsigned)(D_ * 2), p.ew1T, (size_t)512 * D_, (size_t)256 * D_, true};
    EpiMoe1 E{&p};
    gemm256(smem, (const char*)p.hbuf, D_, S, E);
}
struct EpiMoe2 {
    const P* pp;
    __device__ __forceinline__ void operator()(const f32x4 (&acc)[2][2][4][2], const GUnit& u, int, int, int, int) const {
        const int t2_ = get_tid(), wid_ = __builtin_amdgcn_readfirstlane(t2_ >> 6), wr = wid_ >> 2, wc = wid_ & 3, fr = t2_ & 15, fq = (t2_ >> 4) & 3;
        const P& p = *pp;
        const int e = __builtin_amdgcn_readfirstlane(p.blk_e[u.pm]), r0 = __builtin_amdgcn_readfirstlane(p.blk_r0[u.pm]), rend = __builtin_amdgcn_readfirstlane(p.offs[e + 1]);
#pragma unroll
        for (int ai = 0; ai < 2; ++ai)
#pragma unroll
            for (int m = 0; m < 4; ++m) {
                const int sl = r0 + ai * 128 + wr * 64 + m * 16 + fr;
                if (sl < rend) {
                    const float gt = p.list_gate[sl];
                    u16* yp = p.ybuf + (size_t)sl * D_ + u.pn * 256 + wc * 32 + 8 * fq;
#pragma unroll
                    for (int bj = 0; bj < 2; ++bj) *(uint4*)&yp[bj * 128] = pack8(acc[ai][bj][m][0] * gt, acc[ai][bj][m][1] * gt);
                }
            }
    }
};
__device__ void ph_moe2(const P& p, int bid, int nb, char* smem) {
    MoeSched<4> S{&p, __builtin_amdgcn_readfirstlane(*p.nblk) * 4, nb, bid, 512u, p.ew2T, (size_t)D_ * 256, (size_t)256 * 256, false};
    EpiMoe2 E{&p};
    gemm256(smem, (const char*)p.hid, 256, S, E);
}
__device__ void ph_final(const P& p, int bid, int nb, char* smem) {
    const int tid = get_tid(), lane = tid & 63, wv = tid >> 6;
    for (int row = bid * NW + wv; row < NTOK; row += nb * NW) {
        const int s0 = p.tokslot[row * 2], s1 = p.tokslot[row * 2 + 1];
        float v[16]; float ss = 0.f;
#pragma unroll
        for (int i = 0; i < 4; i++) {
            const int c = i * 256 + lane * 4;
            const float4 t = *(const float4*)&p.x1[(size_t)row * D_ + c];
            const uint2 a = *(const uint2*)&p.ybuf[(size_t)s0 * D_ + c];
            const uint2 bq = *(const uint2*)&p.ybuf[(size_t)s1 * D_ + c];
            v[4 * i]     = t.x + __uint_as_float(a.x << 16) + __uint_as_float(bq.x << 16);
            v[4 * i + 1] = t.y + __uint_as_float(a.x & 0xFFFF0000u) + __uint_as_float(bq.x & 0xFFFF0000u);
            v[4 * i + 2] = t.z + __uint_as_float(a.y << 16) + __uint_as_float(bq.y << 16);
            v[4 * i + 3] = t.w + __uint_as_float(a.y & 0xFFFF0000u) + __uint_as_float(bq.y & 0xFFFF0000u);
            ss += v[4 * i] * v[4 * i] + v[4 * i + 1] * v[4 * i + 1] + v[4 * i + 2] * v[4 * i + 2] + v[4 * i + 3] * v[4 * i + 3];
        }
        ss = wave_sum(ss);
        const float rs = rsqrtf(ss * (1.f / D_) + 1e-6f);
#pragma unroll
        for (int i = 0; i < 4; i++) {
            const int c = i * 256 + lane * 4;
            const float4 g = *(const float4*)&p.g_final[c];
            float4 o; o.x = v[4 * i] * rs * g.x; o.y = v[4 * i + 1] * rs * g.y; o.z = v[4 * i + 2] * rs * g.z; o.w = v[4 * i + 3] * rs * g.w;
            *(float4*)&p.out[(size_t)row * D_ + c] = o;
        }
    }
}

#define XB_TMO      128
#define XB_XCNT(j)  (256  + 64 * (j))
#define XB_XSUB(j)  (1280 + 64 * (j))
#define XB_XGEN(j)  (2304 + 64 * (j))
#define XB_TOP      3328
#define XB_TOPGEN   3392
#define XCD_BAR_WORDS 3456
#define XB_SPIN_CAP (1u << 18)
#define LAS __attribute__((address_space(3)))

__device__ __forceinline__ unsigned xb_ld(unsigned* p)              { return __hip_atomic_load(p, __ATOMIC_RELAXED, __HIP_MEMORY_SCOPE_AGENT); }
__device__ __forceinline__ unsigned xb_add(unsigned* p, unsigned v) { return __hip_atomic_fetch_add(p, v, __ATOMIC_RELAXED, __HIP_MEMORY_SCOPE_AGENT); }
__device__ __forceinline__ unsigned xb_xcc_id() { return (unsigned)__builtin_amdgcn_s_getreg((3 << 11) | 20) & 0xFu; }
#define XB_SPIN(cond, bar) do { unsigned _sp = 0; while (cond) { __builtin_amdgcn_s_sleep(1); \
    if ((++_sp & 255u) == 0u) { if (xb_ld(&(bar)[XB_TMO])) break; if (_sp > XB_SPIN_CAP) { atomicAdd(&(bar)[XB_TMO], 1u); break; } } } } while (0)

struct XcdBarrier {
    unsigned* bar; unsigned x;
    volatile LAS unsigned* st;
};

__device__ __forceinline__ XcdBarrier xcd_barrier_post(unsigned* bar, volatile LAS unsigned* st) {
    XcdBarrier b; b.bar = bar; b.x = xb_xcc_id(); b.st = st;
    if (threadIdx.x == 0) (void)xb_add(&bar[XB_XCNT(b.x)], 1u);
    return b;
}
__device__ __forceinline__ void xcd_barrier_complete(unsigned* bar, unsigned x, unsigned& nloc, unsigned& nx) {
    const unsigned G = gridDim.x * gridDim.y * gridDim.z;
    unsigned sum, cnt, mine, sp = 0u;
    for (;;) {
        sum = 0u; cnt = 0u; mine = 0u;
#pragma unroll
        for (unsigned j = 0; j < 16; ++j) { const unsigned c = xb_ld(&bar[XB_XCNT(j)]); sum += c; cnt += (c > 0u) ? 1u : 0u; mine = (j == x) ? c : mine; }
        if (sum == G) break;
        __builtin_amdgcn_s_sleep(1);
        if ((++sp & 255u) == 0u) { if (xb_ld(&bar[XB_TMO])) break; if (sp > XB_SPIN_CAP) { atomicAdd(&bar[XB_TMO], 1u); break; } }
    }
    nloc = mine > 0u ? mine : 1u; nx = cnt > 0u ? cnt : 1u;
}

__device__ __forceinline__ void xcd_barrier(const XcdBarrier& b) {
    asm volatile("s_waitcnt vmcnt(0)" ::: "memory");
    __syncthreads();
    if (threadIdx.x == 0) {
        unsigned* bar = b.bar;
        __builtin_amdgcn_s_waitcnt(0);
        unsigned nloc = b.st[0], nx = b.st[1];
        if (nloc == 0u) { xcd_barrier_complete(bar, b.x, nloc, nx); b.st[0] = nloc; b.st[1] = nx; }
        const unsigned old = xb_add(&bar[XB_XSUB(b.x)], 1u);
        const unsigned gen = old / nloc;
        if (old + 1u == (gen + 1u) * nloc) {
            __builtin_amdgcn_fence(__ATOMIC_RELEASE, "agent");
            asm volatile("s_waitcnt vmcnt(0)" ::: "memory");
            const unsigned og = xb_add(&bar[XB_TOP], 1u);
            const unsigned tg = og / nx;
            if (og + 1u == (tg + 1u) * nx) xb_add(&bar[XB_TOPGEN], 1u);
            else XB_SPIN(xb_ld(&bar[XB_TOPGEN]) == tg, bar);
            __builtin_amdgcn_fence(__ATOMIC_ACQUIRE, "agent");
            xb_add(&bar[XB_XGEN(b.x)], 1u);
            asm volatile("s_waitcnt vmcnt(0)" ::: "memory");
        } else {
            XB_SPIN(xb_ld(&bar[XB_XGEN(b.x)]) == gen, bar);
            __builtin_amdgcn_fence(__ATOMIC_ACQUIRE, "agent");
            asm volatile("s_waitcnt vmcnt(0)" ::: "memory");
        }
    }
    __syncthreads();
}

template <int PH>
__device__ __forceinline__ void run_phase(const P& p, int bid, int nb, char* smem) {
    if constexpr (PH == 0) ph_prologue(p, bid, nb, smem);
    if constexpr (PH == 1) ph_inproj(p, bid, nb, smem);
    if constexpr (PH == 2) { ph_compress(p, bid, nb, smem); __syncthreads(); ph_rwkv_chunk(p, bid, nb, smem); }
    if constexpr (PH == 3) {
        if (bid < SCAN_BLOCKS) ph_rwkv_seq(p, bid, SCAN_BLOCKS, smem);
        ph_nsa(p, bid - SCAN_BLOCKS, nb - SCAN_BLOCKS, smem);
    }
    if constexpr (PH == 12) ph_rwkv_out(p, bid, nb, smem);
    if constexpr (PH == 4) ph_merge(p, bid, nb, smem);
    if constexpr (PH == 5) ph_outproj(p, bid, nb, smem);
    if constexpr (PH == 6) ph_route(p, bid, nb, smem);
    if constexpr (PH == 7) ph_scatter(p, bid, nb, smem);
    if constexpr (PH == 9) ph_moe1(p, bid, nb, smem);
    if constexpr (PH == 10) ph_moe2(p, bid, nb, smem);
    if constexpr (PH == 11) ph_final(p, bid, nb, smem);
}

template <int PH>
__global__ void __launch_bounds__(NT) kph(P p) {
    extern __shared__ __attribute__((aligned(16))) char smem[];
    run_phase<PH>(p, blockIdx.x, gridDim.x, smem);
}

__global__ void __launch_bounds__(NT, 2) mega(P p) {
    extern __shared__ __attribute__((aligned(16))) char smem[];
    volatile LAS unsigned* st = (volatile LAS unsigned*)(smem + SMEM_BYTES - 16);
    if (threadIdx.x == 0) { st[0] = 0u; st[1] = 0u; st[2] = 0u; st[3] = 0u; }
    __syncthreads();
    XcdBarrier bar = xcd_barrier_post(p.bar, st);
    const int bid = blockIdx.x, nb = gridDim.x;
#define RUNP(N, BAR) { unsigned long long t0_ = 0; if ((TPROBE >> N) & 1) t0_ = __builtin_amdgcn_s_memrealtime(); run_phase<N>(p, bid, nb, smem); \
        unsigned long long tw_ = 0; if (((TPROBE >> N) & 1) && TPSEL) tw_ = __builtin_amdgcn_s_memrealtime() - t0_; if (BAR) xcd_barrier(bar); \
        if ((TPROBE >> N) & 1) { const unsigned long long t1_ = __builtin_amdgcn_s_memrealtime(); const unsigned long long dt_ = TPSEL ? tw_ : t1_ - t0_; \
            if (!TPSEL || (TPSEL == 1 ? (bid < SCAN_BLOCKS) : (bid >= SCAN_BLOCKS))) while (__builtin_amdgcn_s_memrealtime() - t1_ < dt_) __builtin_amdgcn_s_sleep(8); if (TPSEL) xcd_barrier(bar); } }
    RUNP(0, 1) RUNP(1, 1) RUNP(2, 1) RUNP(3, 1) RUNP(12, 1) RUNP(4, 1) RUNP(5, 1) RUNP(6, 1) RUNP(7, 1) RUNP(9, 1) RUNP(10, 1) RUNP(11, 0)
}

extern "C" void kernel_launch(void* const* d_in, const int* in_sizes, int n_in,
                              void* d_out, int out_size, void* d_ws, size_t ws_size,
                              hipStream_t stream) {
    P p{};
    p.x = (const float*)d_in[0]; p.pos = (const int*)d_in[1]; p.g_mix = (const float*)d_in[2]; p.w_in = (const float*)d_in[3];
    p.pe_k = (const float*)d_in[4]; p.w1_k = (const float*)d_in[5]; p.b1_k = (const float*)d_in[6]; p.w2_k = (const float*)d_in[7]; p.b2_k = (const float*)d_in[8];
    p.pe_v = (const float*)d_in[9]; p.w1_v = (const float*)d_in[10]; p.b1_v = (const float*)d_in[11]; p.w2_v = (const float*)d_in[12]; p.b2_v = (const float*)d_in[13];
    p.mu = (const float*)d_in[14]; p.w0 = (const float*)d_in[15]; p.w2 = (const float*)d_in[16]; p.a0 = (const float*)d_in[17]; p.a2 = (const float*)d_in[18];
    p.g2 = (const float*)d_in[19]; p.k_k = (const float*)d_in[20]; p.k_a = (const float*)d_in[21]; p.r_k = (const float*)d_in[22]; p.ln_w = (const float*)d_in[23]; p.ln_b = (const float*)d_in[24];
    p.wpa = (const float*)d_in[25]; p.wpb = (const float*)d_in[26]; p.wout = (const float*)d_in[27]; p.g_ffn = (const float*)d_in[28];
    p.w_grp = (const float*)d_in[29]; p.b_grp = (const float*)d_in[30]; p.w_exp = (const float*)d_in[31]; p.b_exp = (const float*)d_in[32];
    p.e_w1 = (const float*)d_in[33]; p.e_w3 = (const float*)d_in[34]; p.e_w2 = (const float*)d_in[35]; p.g_final = (const float*)d_in[36];
    p.out = (float*)d_out;
    char* ws = (char*)d_ws;
    const size_t MiB = 1ull << 20;
    p.hbuf = (u16*)(ws + 0 * MiB);
    p.q    = (u16*)(ws + 64 * MiB);
    p.kc   = (u16*)(ws + 96 * MiB);  p.vc   = (u16*)(ws + 104 * MiB);
    p.ksl  = (u16*)(ws + 112 * MiB); p.vslT = (u16*)(ws + 120 * MiB);
    p.kwn  = (u16*)(ws + 128 * MiB); p.vwnT = (u16*)(ws + 136 * MiB);
    p.nsag = (float*)(ws + 144 * MiB);
    p.kcb  = (u16*)(ws + 148 * MiB); p.vcT  = (u16*)(ws + 149 * MiB);
    p.prw  = (u16*)(ws + 160 * MiB);
    p.cdat = (u16*)(ws + 272 * MiB);
    p.bon  = (float*)(ws + 150 * MiB);
    p.w2T  = (u16*)(ws + 151 * MiB); p.a2T = p.w2T + 512 * 64; p.g2T = p.a2T + 512 * 64;
    p.cw1Tk = (u16*)(ws + 152 * MiB); p.cw1Tv = (u16*)(ws + 153 * MiB);
    p.cw2Tk = (u16*)(ws + 154 * MiB); p.cw2Tv = p.cw2Tk + 128 * 256;
    p.chid = (u16*)(ws + 155 * MiB);
    p.xact = (u16*)(ws + 488 * MiB);
    p.oa   = (u16*)(ws + 400 * MiB);
    p.ob   = (u16*)(ws + 432 * MiB);
    p.merged = (u16*)(ws + 64 * MiB);
    p.x1   = (float*)(ws + 160 * MiB);
    char* rt = ws + 288 * MiB;
    p.tok_e = (int*)(rt);                        rt += NTOK * 2 * 4;
    p.tok_gate = (float*)(rt);                   rt += NTOK * 2 * 4;
    p.tokslot = (int*)(rt);                      rt += NTOK * 2 * 4;
    p.list_tok = (int*)(rt);                     rt += NTOK * 2 * 4;
    p.list_gate = (float*)(rt);                  rt += NTOK * 2 * 4;
    p.blk_e = (int*)(rt);                        rt += 2048 * 4;
    p.blk_r0 = (int*)(rt);                       rt += 2048 * 4;
    p.rsb = (float*)(rt);                        rt += NTOK * 4;
    p.hid  = (u16*)(ws + 296 * MiB);
    p.ybuf = (u16*)(ws + 336 * MiB);
    char* misc = ws + 470 * MiB;
    p.counts = (int*)(misc); p.cursor = (int*)(misc + 256); p.offs = (int*)(misc + 512); p.nblk = (int*)(misc + 1024); p.nsactr = (int*)(misc + 2048);
    p.bar = (unsigned*)(ws + 471 * MiB);
    p.cb1k = (float*)(misc + 65536); p.cb1v = p.cb1k + 256;
    {
        char* wa = ws + 472 * MiB;
        p.winT = (u16*)wa;  wa += (size_t)3328 * 1024 * 2;
        p.wgT  = (u16*)wa;  wa += (size_t)2048 * 1024 * 2;
        p.wpaT = (u16*)wa;  wa += (size_t)1024 * 512 * 2;
        p.wpbT = (u16*)wa;  wa += (size_t)1024 * 512 * 2;
        p.woutT = (u16*)wa; wa += (size_t)1024 * 1024 * 2;
        p.ew1T = (u16*)(ws + 64 * MiB);  p.ew3T = (u16*)(ws + 80 * MiB);  p.ew2T = (u16*)(ws + 96 * MiB);
    }
    if (ws_size < (size_t)505 * MiB) return;

#if MEGA
    {
        static int mgrid = 0;
        if (mgrid == 0) {
            int dev = 0, cus = 0, per_cu = 0;
            hipGetDevice(&dev);
            hipDeviceGetAttribute(&cus, hipDeviceAttributeMultiprocessorCount, dev);
            hipFuncSetAttribute((const void*)mega, hipFuncAttributeMaxDynamicSharedMemorySize, SMEM_BYTES);
            hipOccupancyMaxActiveBlocksPerMultiprocessor(&per_cu, (const void*)mega, NT, SMEM_BYTES);
            (void)hipGetLastError();
            mgrid = cus;
        }
        hipMemsetAsync(p.bar, 0, XCD_BAR_WORDS * sizeof(unsigned) + 512 * sizeof(float), stream);
        mega<<<mgrid, NT, SMEM_BYTES, stream>>>(p);
        return;
    }
#else
    const int grid = 512;
    hipMemsetAsync(p.bar, 0, XCD_BAR_WORDS * sizeof(unsigned) + 512 * sizeof(float), stream);
    hipFuncSetAttribute((const void*)kph<0>, hipFuncAttributeMaxDynamicSharedMemorySize, SMEM_BYTES);
    hipFuncSetAttribute((const void*)kph<1>, hipFuncAttributeMaxDynamicSharedMemorySize, SMEM_BYTES);
    hipFuncSetAttribute((const void*)kph<2>, hipFuncAttributeMaxDynamicSharedMemorySize, SMEM_BYTES);
    hipFuncSetAttribute((const void*)kph<3>, hipFuncAttributeMaxDynamicSharedMemorySize, SMEM_BYTES);
    hipFuncSetAttribute((const void*)kph<4>, hipFuncAttributeMaxDynamicSharedMemorySize, SMEM_BYTES);
    hipFuncSetAttribute((const void*)kph<5>, hipFuncAttributeMaxDynamicSharedMemorySize, SMEM_BYTES);
    hipFuncSetAttribute((const void*)kph<6>, hipFuncAttributeMaxDynamicSharedMemorySize, SMEM_BYTES);
    hipFuncSetAttribute((const void*)kph<7>, hipFuncAttributeMaxDynamicSharedMemorySize, SMEM_BYTES);
    hipFuncSetAttribute((const void*)kph<8>, hipFuncAttributeMaxDynamicSharedMemorySize, SMEM_BYTES);
    hipFuncSetAttribute((const void*)kph<9>, hipFuncAttributeMaxDynamicSharedMemorySize, SMEM_BYTES);
    hipFuncSetAttribute((const void*)kph<10>, hipFuncAttributeMaxDynamicSharedMemorySize, SMEM_BYTES);
    hipFuncSetAttribute((const void*)kph<11>, hipFuncAttributeMaxDynamicSharedMemorySize, SMEM_BYTES);
    kph<0><<<grid, NT, SMEM_BYTES, stream>>>(p);
    kph<1><<<grid, NT, SMEM_BYTES, stream>>>(p);
    kph<2><<<grid, NT, SMEM_BYTES, stream>>>(p);
    kph<3><<<grid, NT, SMEM_BYTES, stream>>>(p);
    kph<12><<<grid, NT, SMEM_BYTES, stream>>>(p);
    kph<4><<<grid, NT, SMEM_BYTES, stream>>>(p);
    kph<5><<<grid, NT, SMEM_BYTES, stream>>>(p);
    kph<6><<<grid, NT, SMEM_BYTES, stream>>>(p);
    kph<7><<<grid, NT, SMEM_BYTES, stream>>>(p);
    kph<8><<<grid, NT, SMEM_BYTES, stream>>>(p);
    kph<9><<<grid, NT, SMEM_BYTES, stream>>>(p);
    kph<10><<<grid, NT, SMEM_BYTES, stream>>>(p);
    kph<11><<<grid, NT, SMEM_BYTES, stream>>>(p);
#endif
}
```

```cpp
#include <hip/hip_runtime.h>
#include <stdint.h>

typedef unsigned short u16;
using bf16x8 = __attribute__((ext_vector_type(8))) short;
using f32x4  = __attribute__((ext_vector_type(4))) float;

#ifndef MEGA
#define MEGA 1
#endif

constexpr int B_ = 4, S_ = 8192, D_ = 1024, NTOK = B_ * S_;
constexpr int CIN = 5144;
constexpr int NCMP = 511;
constexpr int CRW = 1792;
constexpr int NEXP = 32;
constexpr int NT = 512;
constexpr int NW = NT / 64;
constexpr int SMEM_BYTES = 160 * 1024;
constexpr int SCAN_BLOCKS = 16;
#ifndef TPROBE
#define TPROBE 0
#define TPSEL 0
#endif
constexpr float QSCALE = 0.125f * 1.4426950408889634f;

struct P {
    const float* x; const int* pos; const float* g_mix; const float* w_in;
    const float *pe_k, *w1_k, *b1_k, *w2_k, *b2_k, *pe_v, *w1_v, *b1_v, *w2_v, *b2_v;
    const float *mu, *w0, *w2, *a0, *a2, *g2, *k_k, *k_a, *r_k, *ln_w, *ln_b;
    const float *wpa, *wpb, *wout, *g_ffn, *w_grp, *b_grp, *w_exp, *b_exp, *e_w1, *e_w3, *e_w2, *g_final;
    float* out;
    u16* hbuf; u16 *q, *kc, *vc, *ksl, *vslT, *kwn, *vwnT, *kcb, *vcT; float* nsag; u16* prw;
    u16* cdat; float* bon; u16 *w2T, *a2T, *g2T; u16 *oa, *ob; u16* merged; float* x1;
    int* tok_e; float* tok_gate; int* tokslot; int* list_tok; float* list_gate;
    int* counts; int* offs; int* cursor; int* blk_e; int* blk_r0; int* nblk; float* rsb; int* nsactr; unsigned* mdone;
    u16* hid; u16* ybuf; unsigned* bar;
    u16 *winT, *wgT, *wpaT, *wpbT, *woutT, *ew1T, *ew3T, *ew2T;
    u16 *cw1Tk, *cw1Tv, *cw2Tk, *cw2Tv, *chid, *xact; float *cb1k, *cb1v;
};

typedef __bf16 bf16x2_t __attribute__((ext_vector_type(2)));
typedef float f32x2_t __attribute__((ext_vector_type(2)));
__device__ __forceinline__ unsigned pack2(float a, float b) {
    f32x2_t f = {a, b};
    return __builtin_bit_cast(unsigned, __builtin_convertvector(f, bf16x2_t));
}
__device__ __forceinline__ u16 f2bf(float f) { return (u16)(pack2(f, f) & 0xFFFFu); }
__device__ __forceinline__ float bf2f(u16 h) { return __uint_as_float(((unsigned)h) << 16); }
__device__ __forceinline__ float sigmoidf_(float x) { return __builtin_amdgcn_rcpf(1.f + __expf(-x)); }
__device__ __forceinline__ float tanhf_(float x) { return 1.f - 2.f * __builtin_amdgcn_rcpf(1.f + __builtin_amdgcn_exp2f(x * 2.8853900817779268f)); }
__device__ __forceinline__ int get_tid() { int t = threadIdx.x; asm volatile("" : "+v"(t)); return t; }
__device__ __forceinline__ uint2 pack4(const f32x4& v) { uint2 o; o.x = pack2(v[0], v[1]); o.y = pack2(v[2], v[3]); return o; }
__device__ __forceinline__ f32x4 unpack4(uint2 u) { return f32x4{__uint_as_float(u.x << 16), __uint_as_float(u.x & 0xFFFF0000u), __uint_as_float(u.y << 16), __uint_as_float(u.y & 0xFFFF0000u)}; }
#define LDS_BARRIER() do { asm volatile("s_waitcnt lgkmcnt(0)" ::: "memory"); __builtin_amdgcn_s_barrier(); asm volatile("" ::: "memory"); } while (0)
__device__ __forceinline__ int opaque(int x) { asm volatile("" : "+v"(x)); return x; }
template <int CTRL>
__device__ __forceinline__ float dppf(float x) { return __int_as_float(__builtin_amdgcn_update_dpp(0, __float_as_int(x), CTRL, 0xF, 0xF, true)); }
__device__ __forceinline__ float wave_sum(float v) {
    v += dppf<0xB1>(v);
    v += dppf<0x4E>(v);
    v += dppf<0x141>(v);
    v += dppf<0x140>(v);
    const int vi = __float_as_int(v);
    return (__int_as_float(__builtin_amdgcn_readlane(vi, 0)) + __int_as_float(__builtin_amdgcn_readlane(vi, 16)))
         + (__int_as_float(__builtin_amdgcn_readlane(vi, 32)) + __int_as_float(__builtin_amdgcn_readlane(vi, 48)));
}

__device__ __forceinline__ float xrow_sum(float v) {
    auto r = __builtin_amdgcn_permlane16_swap(__float_as_uint(v), __float_as_uint(v), false, false);
    v = __uint_as_float(r[0]) + __uint_as_float(r[1]);
    auto r2 = __builtin_amdgcn_permlane32_swap(__float_as_uint(v), __float_as_uint(v), false, false);
    return __uint_as_float(r2[0]) + __uint_as_float(r2[1]);
}
__device__ __forceinline__ float xrow_max(float v) {
    auto r = __builtin_amdgcn_permlane16_swap(__float_as_uint(v), __float_as_uint(v), false, false);
    v = fmaxf(__uint_as_float(r[0]), __uint_as_float(r[1]));
    auto r2 = __builtin_amdgcn_permlane32_swap(__float_as_uint(v), __float_as_uint(v), false, false);
    return fmaxf(__uint_as_float(r2[0]), __uint_as_float(r2[1]));
}
__constant__ double ROPE_FREQ[32] = {
    1.00000000000000000000e+00, 7.49894209332455874417e-01, 5.62341325190349072827e-01, 4.21696503428582225581e-01,
    3.16227766016837941176e-01, 2.37137370566165517349e-01, 1.77827941003892292526e-01, 1.33352143216332402753e-01,
    1.00000000000000005551e-01, 7.49894209332455791150e-02, 5.62341325190349114460e-02, 4.21696503428582239459e-02,
    3.16227766016837913421e-02, 2.37137370566165538166e-02, 1.77827941003892292526e-02, 1.33352143216332406223e-02,
    1.00000000000000002082e-02, 7.49894209332455791150e-03, 5.62341325190349097113e-03, 4.21696503428582291501e-03,
    3.16227766016837939442e-03, 2.37137370566165538166e-03, 1.77827941003892275179e-03, 1.33352143216332406223e-03,
    1.00000000000000002082e-03, 7.49894209332455856203e-04, 5.62341325190349097113e-04, 4.21696503428582237290e-04,
    3.16227766016837939442e-04, 2.37137370566165538166e-04, 1.77827941003892269758e-04, 1.33352143216332395381e-04};

constexpr int G_ABYTES = 256 * 64 * 2, G_BBYTES = 128 * 64 * 2, G_TILE = G_ABYTES + G_BBYTES;
#define LAS3 __attribute__((address_space(3)))
#define GAS1 __attribute__((address_space(1)))
__device__ __forceinline__ void glds16(const u16* g, char* l) {
    __builtin_amdgcn_global_load_lds((const GAS1 unsigned*)g, (LAS3 unsigned*)l, 16, 0, 0);
}
template <bool TR = false, class ARow>
__device__ __forceinline__ void gemm_core(int K, ARow arow, const u16* __restrict__ BT, int ldb, f32x4 (&acc)[4][4], u16* sm) {
    char* base = (char*)sm;
    const int tid = get_tid(), lane = tid & 63, wv = tid >> 6;
    const int wm = wv >> 1, wn = wv & 1, kr = lane & 15, qq = lane >> 4;
    const int lr = tid >> 3, lk = ((tid & 7) ^ ((lr >> 1) & 7)) * 8;
    const u16* ap0 = arow(lr) + lk; const u16* ap1 = arow(lr + 64) + lk;
    const u16* ap2 = arow(lr + 128) + lk; const u16* ap3 = arow(lr + 192) + lk;
    const u16* bp0 = BT + (size_t)lr * ldb + lk; const u16* bp1 = BT + (size_t)(lr + 64) * ldb + lk;
#pragma unroll
    for (int mt = 0; mt < 4; mt++)
#pragma unroll
        for (int nt = 0; nt < 4; nt++) acc[mt][nt] = f32x4{0.f, 0.f, 0.f, 0.f};
    const int nk = K >> 6;
#define G_ISSUE(t, b) { char* d = base + (b) * G_TILE + tid * 16; const int ko = (t) * 64; \
        glds16(ap0 + ko, d); glds16(ap1 + ko, d + 8192); glds16(ap2 + ko, d + 16384); glds16(ap3 + ko, d + 24576); \
        glds16(bp0 + ko, d + G_ABYTES); glds16(bp1 + ko, d + G_ABYTES + 8192); }
    const int sw = kr >> 1;
    const int po0 = ((0 * 4 + qq) ^ sw) * 16, po1 = ((1 * 4 + qq) ^ sw) * 16;
    const int aoff = (wm * 64 + kr) * 128, boff = G_ABYTES + (wn * 64 + kr) * 128;
#define G_READ(FA, FB, b) { const char* Ab = base + (b) * G_TILE + aoff; const char* Bb = base + (b) * G_TILE + boff; \
        _Pragma("unroll") for (int mt = 0; mt < 4; mt++) { FA[0][mt] = *(const bf16x8*)(Ab + mt * 2048 + po0); FA[1][mt] = *(const bf16x8*)(Ab + mt * 2048 + po1); } \
        _Pragma("unroll") for (int nt = 0; nt < 4; nt++) { FB[0][nt] = *(const bf16x8*)(Bb + nt * 2048 + po0); FB[1][nt] = *(const bf16x8*)(Bb + nt * 2048 + po1); } }
#define G_MMA(FA, FB) { __builtin_amdgcn_s_setprio(1); \
        _Pragma("unroll") for (int ks = 0; ks < 2; ks++) \
            _Pragma("unroll") for (int nt = 0; nt < 4; nt++) \
                _Pragma("unroll") for (int mt = 0; mt < 4; mt++) \
                    acc[mt][nt] = TR ? __builtin_amdgcn_mfma_f32_16x16x32_bf16(FA[ks][mt], FB[ks][nt], acc[mt][nt], 0, 0, 0) \
                                     : __builtin_amdgcn_mfma_f32_16x16x32_bf16(FB[ks][nt], FA[ks][mt], acc[mt][nt], 0, 0, 0); \
        __builtin_amdgcn_s_setprio(0); }
    bf16x8 fa0[2][4], fb0[2][4], fa1[2][4], fb1[2][4];
    G_ISSUE(0, 0)
    if (nk > 1) G_ISSUE(1, 1)
    if (nk > 2) G_ISSUE(2, 2)
    if (nk > 2) asm volatile("s_waitcnt vmcnt(12)" ::: "memory");
    else if (nk > 1) asm volatile("s_waitcnt vmcnt(6)" ::: "memory");
    else asm volatile("s_waitcnt vmcnt(0)" ::: "memory");
    __builtin_amdgcn_s_barrier();
    G_READ(fa0, fb0, 0)
    int bnext = 1, bfree = 0;
#define G_STEP(FAC, FBC, FAN, FBN, kt) { \
        if ((kt) + 1 < nk) { \
            if ((kt) + 2 < nk) asm volatile("s_waitcnt vmcnt(6) lgkmcnt(0)" ::: "memory"); else asm volatile("s_waitcnt vmcnt(0) lgkmcnt(0)" ::: "memory"); \
            __builtin_amdgcn_s_barrier();                   \
            if ((kt) + 3 < nk) G_ISSUE((kt) + 3, bfree) \
            G_READ(FAN, FBN, bnext) \
        } \
        G_MMA(FAC, FBC) \
        bfree = bnext; bnext = (bnext == 2) ? 0 : bnext + 1; }
    for (int kt = 0; kt < nk; kt += 2) {
        G_STEP(fa0, fb0, fa1, fb1, kt)
        G_STEP(fa1, fb1, fa0, fb0, kt + 1)
    }
    __builtin_amdgcn_s_barrier();
#undef G_READ
#undef G_MMA
#undef G_STEP
#undef G_ISSUE
}

__device__ __forceinline__ int xcd_item(int bid, int nb, int k, int nitems) {
    if (nb & 7) return bid + k * nb;
    const int per = nb >> 3, chunk = (nitems + 7) >> 3;
    const int j = k * per + (bid >> 3);
    return (j < chunk) ? (bid & 7) * chunk + j : nitems;
}
struct GUnit { int pm, pn; };
typedef unsigned u32x4 __attribute__((ext_vector_type(4)));
constexpr int G8_HTB = 128 * 64 * 2;
__device__ __forceinline__ int g8_lds_byte(int r, int c) { const int st = (r >> 4) * 2 + (c >> 5), rr = r & 15, cc = c & 31, ob = rr * 64 + cc * 2; return st * 1024 + (ob ^ (((ob >> 9) & 1) << 5)); }
__device__ __forceinline__ void g8_stage_rc(int b, int& R, int& C) { const int st = b / 1024, sb = b % 1024, swz = sb ^ (((sb >> 9) & 1) << 5); R = (st >> 1) * 16 + swz / 64; C = (st & 1) * 32 + (swz % 64) / 2; }
__host__ __device__ __forceinline__ int perm32(int rho) { const int n = rho >> 4, i = rho & 15; return 8 * (i >> 2) + 4 * n + (i & 3); }

template <class Epi, class Sched>
__device__ __forceinline__ void gemm256(char* smem, const char* Ab, int K, const Sched& S, const Epi& E) {
    LAS3 unsigned char* lds = (LAS3 unsigned char*)smem;
    const int tid = get_tid(), wid = __builtin_amdgcn_readfirstlane(tid >> 6), lane = tid & 63, wr = wid >> 2, wc = wid & 3, fr = lane & 15, fq = lane >> 4;
    int nt = K >> 6; asm volatile("" : "+s"(nt));
    unsigned voffB[2], voffA[2][2];
#pragma unroll
    for (int i = 0; i < 2; ++i) { int sR, sC; g8_stage_rc(tid * 16 + i * 8192, sR, sC); voffB[i] = (unsigned)(sR * K + sC) * 2u; }
#define G8_AOFFS(un) do { const int t3_ = get_tid(); _Pragma("unroll") for (int i = 0; i < 2; ++i) { int sR, sC; g8_stage_rc(t3_ * 16 + i * 8192, sR, sC); \
        _Pragma("unroll") for (int h = 0; h < 2; ++h) voffA[h][i] = S.a_off(un, h, sR) + (unsigned)sC * 2u; } } while (0)
    const size_t kstep = 128;
    const size_t hstep = (size_t)128 * K * 2;
    const unsigned ldsw = (unsigned)wid * 1024u;
    const int aoff = g8_lds_byte(wr * 64 + fr, fq * 8), boff = g8_lds_byte(wc * 32 + fr, fq * 8);
#define G8_SA(b, h) (((b) * 2 + (h)) * G8_HTB)
#define G8_SB(b, h) ((4 + (b) * 2 + (h)) * G8_HTB)
#define G8_STAGE2(bufoff, gbase, v0, v1) do { \
        __builtin_amdgcn_global_load_lds((const GAS1 unsigned*)((const char*)(gbase) + (v0)), (LAS3 unsigned*)(lds + (bufoff) + ldsw), 16, 0, 0); \
        __builtin_amdgcn_global_load_lds((const GAS1 unsigned*)((const char*)(gbase) + (v1)), (LAS3 unsigned*)(lds + (bufoff) + ldsw + 8192), 16, 0, 0); } while (0)
#define G8_STAGEB(bufoff, gbase) G8_STAGE2(bufoff, gbase, voffB[0], voffB[1])
#define G8_LDA(dst, b, h) do { _Pragma("unroll") for (int m = 0; m < 4; ++m) _Pragma("unroll") for (int k = 0; k < 2; ++k) dst[m][k] = *(const LAS3 bf16x8*)(lds + G8_SA(b, h) + aoff + m * 2048 + k * 1024); } while (0)
#define G8_LDB(dst, b, h) do { _Pragma("unroll") for (int n = 0; n < 2; ++n) _Pragma("unroll") for (int k = 0; k < 2; ++k) dst[n][k] = *(const LAS3 bf16x8*)(lds + G8_SB(b, h) + boff + n * 2048 + k * 1024); } while (0)
#define G8_MMA(ai, bj, At, Bt) do { __builtin_amdgcn_s_setprio(1); _Pragma("unroll") for (int m = 0; m < 4; ++m) _Pragma("unroll") for (int n = 0; n < 2; ++n) _Pragma("unroll") for (int k = 0; k < 2; ++k) \
        acc[ai][bj][m][n] = __builtin_amdgcn_mfma_f32_16x16x32_bf16(Bt[n][k], At[m][k], acc[ai][bj][m][n], 0, 0, 0); __builtin_amdgcn_s_setprio(0); } while (0)
#define G8_WAIT_V(n) asm volatile("s_waitcnt vmcnt(" #n ")" ::: "memory")
#define G8_WAIT_L(n) asm volatile("s_waitcnt lgkmcnt(" #n ")" ::: "memory")
#define G8_BAR __builtin_amdgcn_s_barrier()
#define G8_SCHED __builtin_amdgcn_sched_barrier(0)
    GUnit cur, nxt, prv; int ui = 0; prv.pm = 0; prv.pn = 0;
    if (!S.next(0, cur)) return;
    f32x4 acc[2][2][4][2];
#pragma unroll
    for (int a = 0; a < 2; ++a)
#pragma unroll
        for (int b = 0; b < 2; ++b)
#pragma unroll
            for (int m = 0; m < 4; ++m)
#pragma unroll
                for (int n = 0; n < 2; ++n) acc[a][b][m][n] = (f32x4){0.f, 0.f, 0.f, 0.f};
    bf16x8 At[4][2], B0[2][2], B1[2][2];
    G8_AOFFS(cur);
    const char* cB = S.b_ptr(cur);
    G8_STAGEB(G8_SB(0, 0), cB); G8_STAGE2(G8_SA(0, 0), Ab, voffA[0][0], voffA[0][1]); G8_STAGEB(G8_SB(0, 1), cB + hstep); G8_STAGE2(G8_SA(0, 1), Ab, voffA[1][0], voffA[1][1]);
    if (wr == 1) G8_BAR;
    G8_WAIT_V(4); G8_BAR;
    G8_STAGEB(G8_SB(1, 0), cB + kstep); G8_STAGE2(G8_SA(1, 0), Ab + kstep, voffA[0][0], voffA[0][1]); G8_STAGEB(G8_SB(1, 1), cB + hstep + kstep);
    G8_WAIT_V(6); G8_BAR;
    for (;;) {
        const bool has_next = S.next(ui + 1, nxt);
        const char* nB = has_next ? S.b_ptr(nxt) : cB;
        for (int t = 0; t < nt; t += 2) {
            const bool last = (t == nt - 2);
            const char* a1 = Ab + (size_t)(t + 1) * kstep;
            const unsigned va10 = voffA[1][0], va11 = voffA[1][1];
            if (last && has_next) G8_AOFFS(nxt);
            const char* a2 = last ? Ab : Ab + (size_t)(t + 2) * kstep; const char* b2 = last ? nB : cB + (size_t)(t + 2) * kstep;
            const char* a3 = a2 + kstep; const char* b3 = b2 + kstep;
            G8_LDB(B0, 0, 0); G8_SCHED; G8_LDA(At, 0, 0); G8_STAGE2(G8_SA(1, 1), a1, va10, va11);
            G8_WAIT_L(8); G8_BAR; G8_WAIT_L(0); G8_MMA(0, 0, At, B0); G8_BAR; G8_SCHED;
            G8_LDB(B1, 0, 1); G8_STAGEB(G8_SB(0, 0), b2);
            G8_BAR; G8_WAIT_L(0); G8_MMA(0, 1, At, B1); G8_BAR;
            G8_LDA(At, 0, 1); G8_STAGE2(G8_SA(0, 0), a2, voffA[0][0], voffA[0][1]);
            G8_BAR; G8_WAIT_L(0); G8_MMA(1, 0, At, B0); G8_BAR; G8_SCHED;
            G8_STAGEB(G8_SB(0, 1), b2 + hstep);
            G8_WAIT_V(6); G8_BAR; G8_MMA(1, 1, At, B1); G8_BAR;
            if (t == 0 && ui > 0) S.signal(prv);
            G8_LDB(B0, 1, 0); G8_SCHED; G8_LDA(At, 1, 0); G8_STAGE2(G8_SA(0, 1), a2, voffA[1][0], voffA[1][1]);
            G8_WAIT_L(8); G8_BAR; G8_WAIT_L(0); G8_MMA(0, 0, At, B0); G8_BAR; G8_SCHED;
            G8_LDB(B1, 1, 1); G8_STAGEB(G8_SB(1, 0), b3);
            G8_BAR; G8_WAIT_L(0); G8_MMA(0, 1, At, B1); G8_BAR;
            G8_LDA(At, 1, 1); G8_STAGE2(G8_SA(1, 0), a3, voffA[0][0], voffA[0][1]);
            G8_BAR; G8_WAIT_L(0); G8_MMA(1, 0, At, B0); G8_BAR; G8_SCHED;
            G8_STAGEB(G8_SB(1, 1), b3 + hstep);
            G8_WAIT_V(6); G8_BAR; G8_MMA(1, 1, At, B1); G8_BAR;
        }
        E(acc, cur, wr, wc, fr, fq);
        if (!has_next) break;
#pragma unroll
        for (int a = 0; a < 2; ++a)
#pragma unroll
            for (int b = 0; b < 2; ++b)
#pragma unroll
                for (int m = 0; m < 4; ++m)
#pragma unroll
                    for (int n = 0; n < 2; ++n) acc[a][b][m][n] = (f32x4){0.f, 0.f, 0.f, 0.f};
        prv = cur; cur = nxt; cB = nB; ++ui;
    }
    G8_WAIT_V(0); S.signal(cur);
    if (wr == 0) G8_BAR;
    G8_BAR;
#undef G8_SA
#undef G8_AOFFS
#undef G8_SB
#undef G8_STAGE2
#undef G8_STAGEB
#undef G8_LDA
#undef G8_LDB
#undef G8_MMA
#undef G8_WAIT_V
#undef G8_WAIT_L
#undef G8_BAR
#undef G8_SCHED
}
struct DenseSched {
    __device__ __forceinline__ void signal(const GUnit&) const {}
    int nM, nN, nwg, G, c, K; const char* Bt;
    __device__ __forceinline__ void init(int M, int N, int K_, const void* Bt_, int G_, int c_) { nM = M >> 8; nN = N >> 8; nwg = nM * nN; G = G_; c = c_; K = K_; Bt = (const char*)Bt_; }
    __device__ __forceinline__ bool next(int i, GUnit& u) const {
        const int L = i * G + c; if (L >= nwg) return false;
        int wgid = L; { const int q = nwg >> 3, r = nwg & 7, xcd = wgid & 7, off = wgid >> 3; wgid = (xcd < r ? xcd * (q + 1) : r * (q + 1) + (xcd - r) * q) + off; }
        const int nig = 8 * nN, gid = wgid / nig, fm = gid * 8, gsz = (nM - fm) < 8 ? (nM - fm) : 8, w = wgid - gid * nig;
        u.pn = w / gsz; u.pm = fm + (w - u.pn * gsz); return true;
    }
    __device__ __forceinline__ unsigned a_off(const GUnit& u, int h, int R) const { return (unsigned)((u.pm * 256 + h * 128 + R) * K) * 2u; }
    __device__ __forceinline__ const char* b_ptr(const GUnit& u) const { return Bt + (size_t)u.pn * 256 * K * 2; }
};

template <class SRC>
__device__ __forceinline__ void convert_wT(const float* __restrict__ W, int K, int N, u16* __restrict__ WT, int rows, SRC src, int gtid, int gnt) {
    const int kch = K >> 3;
    const int total = rows * kch;
    for (int i0 = gtid; i0 < total; i0 += 4 * gnt) {
        float f[4][8]; int sc[4];
#pragma unroll
        for (int u = 0; u < 4; u++) {
            const int i = i0 + u * gnt;
            sc[u] = -1;
            if (i < total) {
                const int kc = i / rows, j = i - kc * rows;
                sc[u] = src(j);
                if (sc[u] >= 0) {
                    const float* wp = W + (size_t)(kc * 8) * N + sc[u];
#pragma unroll
                    for (int q = 0; q < 8; q++) f[u][q] = wp[(size_t)q * N];
                }
            }
        }
#pragma unroll
        for (int u = 0; u < 4; u++) {
            const int i = i0 + u * gnt;
            if (i < total) {
                const int kc = i / rows, j = i - kc * rows;
                uint4 v = make_uint4(0u, 0u, 0u, 0u);
                if (sc[u] >= 0) { v.x = pack2(f[u][0], f[u][1]); v.y = pack2(f[u][2], f[u][3]); v.z = pack2(f[u][4], f[u][5]); v.w = pack2(f[u][6], f[u][7]); }
                *(uint4*)&WT[(size_t)j * K + kc * 8] = v;
            }
        }
    }
}

__device__ __forceinline__ void convert_later_weights(const P& p, int gtid, int gnt) {
    convert_wT(p.w_in, D_, CIN, p.wgT, 2048, [](int j) { const int t = j >> 8, r = j & 255, cl = r & 127; return 3096 + (r >> 7) * 1024 + t * 128 + (cl & ~31) + perm32(cl & 31); }, gtid, gnt);
    convert_wT(p.wpa, 512, D_, p.wpaT, 1024, [](int j) { return (j & ~31) + perm32(j & 31); }, gtid, gnt);
    convert_wT(p.wpb, 512, D_, p.wpbT, 1024, [](int j) { return (j & ~31) + perm32(j & 31); }, gtid, gnt);
    convert_wT(p.wout, D_, D_, p.woutT, 1024, [](int j) { return j; }, gtid, gnt);
    convert_wT(p.w2, 64, 512, p.w2T, 512, [](int j) { return j; }, gtid, gnt);
    convert_wT(p.w1_k, 2048, 256, p.cw1Tk, 256, [](int j) { return j; }, gtid, gnt);
    convert_wT(p.w1_v, 2048, 256, p.cw1Tv, 256, [](int j) { return j; }, gtid, gnt);
    convert_wT(p.w2_k, 256, 64, p.cw2Tk, 128, [](int j) { return j < 64 ? j : -1; }, gtid, gnt);
    convert_wT(p.w2_v, 256, 64, p.cw2Tv, 128, [](int j) { return j < 64 ? j : -1; }, gtid, gnt);
    convert_wT(p.a2, 64, 512, p.a2T, 512, [](int j) { return j; }, gtid, gnt);
    convert_wT(p.g2, 128, 512, p.g2T, 512, [](int j) { return j; }, gtid, gnt);
}
__device__ void ph_prologue(const P& p, int bid, int nb, char* smem) {
    const int tid = get_tid(), lane = tid & 63, wv = tid >> 6;
    if (bid >= 1 && bid <= 64) {
        const int j = tid & 255; const bool isv = tid >= 256;
        const float* pe = isv ? p.pe_v : p.pe_k; const float* w1 = isv ? p.w1_v : p.w1_k;
        const int kb = (bid - 1) * 32;
        float a0 = 0.f, a1 = 0.f;
#pragma unroll 4
        for (int k = kb; k < kb + 32; k += 2) { a0 += pe[k] * w1[(size_t)k * 256 + j]; a1 += pe[k + 1] * w1[(size_t)(k + 1) * 256 + j]; }
        p.cb1k[(bid - 1) * 512 + (isv ? 256 : 0) + j] = a0 + a1;
    }
    if (bid == 0) {
        if (tid < 32) { p.counts[tid] = 0; p.cursor[tid] = 0; }
        if (tid == 32) *p.nsactr = 0;
        for (int i = tid; i < 2048; i += NT) p.mdone[i] = 0u;
        for (int i = tid; i < 8 * 64; i += NT) {
            const int bg = i >> 6, d = i & 63;
            p.kcb[((size_t)bg * 512 + 511) * 64 + d] = 0;
            p.vcT[(((size_t)bg * 8 + 7) * 64 + d) * 64 + 63] = 0;
        }
    }
    {
        const int gtid = bid * NT + tid, gnt = nb * NT;
        convert_wT(p.w_in, D_, CIN, p.winT, 3328, [](int j) {
            const int t = j >> 8, s = j & 255;
            if (t < 5) {
                const int bj = s >> 7, wc = (s >> 5) & 3, n = (s >> 4) & 1, i = s & 15;
                const int dim = 32 * bj + 8 * (i >> 2) + 4 * n + (i & 3), hq = 4 * t + wc;
                int hb;
                if (hq < 8) hb = 64 * hq;
                else { const int k = (hq - 8) >> 1; hb = (k == 0 ? 512 : (k == 1 ? 640 : (k == 2 ? 768 : (k == 3 ? 1024 : (k == 4 ? 896 : 1152))))) + 64 * (hq & 1); }
                return hb + dim;
            }
            const int c = (s & ~31) + perm32(s & 31);
            if (t < 12) return 1304 + (t - 5) * 256 + c;
            return c < 24 ? 1280 + c : -1; }, gtid, gnt);
        if (nb != 256) convert_later_weights(p, gtid, gnt);
    }
    for (int row = bid * NW + wv; row < NTOK; row += nb * NW) {
        const float* xr = p.x + (size_t)row * D_;
        float v[16];
        float ss = 0.f;
#pragma unroll
        for (int i = 0; i < 4; i++) {
            float4 t = *(const float4*)&xr[i * 256 + lane * 4];
            v[4 * i] = t.x; v[4 * i + 1] = t.y; v[4 * i + 2] = t.z; v[4 * i + 3] = t.w;
            ss += t.x * t.x + t.y * t.y + t.z * t.z + t.w * t.w;
        }
        ss = wave_sum(ss);
        const float rs = rsqrtf(ss * (1.f / D_) + 1e-6f);
#pragma unroll
        for (int i = 0; i < 4; i++) {
            const int c = i * 256 + lane * 4;
            float4 g = *(const float4*)&p.g_mix[c];
            uint2 o;
            o.x = pack2(v[4 * i] * rs * g.x, v[4 * i + 1] * rs * g.y);
            o.y = pack2(v[4 * i + 2] * rs * g.z, v[4 * i + 3] * rs * g.w);
            *(uint2*)&p.hbuf[(size_t)row * D_ + c] = o;
        }
    }
}

__device__ __forceinline__ uint4 pack8(const f32x4& a, const f32x4& b) { uint4 o; o.x = pack2(a[0], a[1]); o.y = pack2(a[2], a[3]); o.z = pack2(b[0], b[1]); o.w = pack2(b[2], b[3]); return o; }
struct EpiInproj {
    const P* pp;
    __device__ __forceinline__ void operator()(const f32x4 (&acc)[2][2][4][2], const GUnit& u, int, int, int, int) const {
        const int t2_ = get_tid(), wid_ = __builtin_amdgcn_readfirstlane(t2_ >> 6), wr = wid_ >> 2, wc = wid_ & 3, fr = t2_ & 15, fq = (t2_ >> 4) & 3;
        const P& p = *pp;
        const int pn = u.pn;
        const int rowb = u.pm * 256 + wr * 64;
        if (pn < 4) {
            const int hq = 4 * pn + wc;
            const bool rope = !(pn == 2 && wc >= 2);
            u16* dst; size_t rstride; int cofs;
            if (pn < 2) { dst = p.q; rstride = 512; cofs = hq * 64; }
            else { dst = (pn == 2) ? (wc < 2 ? p.kc : p.vc) : (wc < 2 ? p.ksl : p.kwn); rstride = 64; cofs = 0; }
            const int g = wc & 1;
            int posv[2][4];
#pragma unroll
            for (int ai = 0; ai < 2; ++ai)
#pragma unroll
                for (int m = 0; m < 4; ++m) posv[ai][m] = p.pos[rowb + ai * 128 + m * 16 + fr];
#pragma unroll
            for (int ai = 0; ai < 2; ++ai)
#pragma unroll
                for (int m = 0; m < 4; ++m) {
                    const int row = rowb + ai * 128 + m * 16 + fr;
                    f32x4 o1[2], o2[2];
#pragma unroll
                    for (int n = 0; n < 2; ++n) { o1[n] = acc[ai][0][m][n]; o2[n] = acc[ai][1][m][n]; }
                    if (rope) {
                        const double posd = (double)posv[ai][m];
#pragma unroll
                        for (int n = 0; n < 2; ++n)
#pragma unroll
                            for (int j = 0; j < 4; ++j) {
                                const double tr = posd * ROPE_FREQ[8 * fq + 4 * n + j] * 0.15915494309189535;
                                const float fr_ = (float)(tr - rint(tr));
                                const float cs = __builtin_amdgcn_cosf(fr_), sn = __builtin_amdgcn_sinf(fr_);
                                const float x1 = o1[n][j], x2 = o2[n][j];
                                o1[n][j] = x1 * cs - x2 * sn; o2[n][j] = x1 * sn + x2 * cs;
                            }
                    }
                    size_t ro;
                    if (pn < 2) {
#pragma unroll
                        for (int n = 0; n < 2; ++n)
#pragma unroll
                            for (int j = 0; j < 4; ++j) { o1[n][j] *= QSCALE; o2[n][j] *= QSCALE; }
                        ro = (size_t)row * 512 + cofs + 8 * fq;
                    } else {
                        const int bb = row >> 13, t = row & (S_ - 1);
                        ro = ((size_t)(bb * 2 + g) * S_ + t) * 64 + 8 * fq;
                    }
                    *(uint4*)&dst[ro] = pack8(o1[0], o1[1]);
                    *(uint4*)&dst[ro + 32] = pack8(o2[0], o2[1]);
                }
        } else if (pn == 4) {
            u16* dst = (wc < 2) ? p.vslT : p.vwnT;
            const int g = wc & 1;
#pragma unroll
            for (int ai = 0; ai < 2; ++ai) {
                const int r0 = rowb + ai * 128, bb = r0 >> 13, tb = r0 & (S_ - 1);
                u16* base = dst + ((size_t)(bb * 2 + g) * 128 + (tb >> 6)) * 4096;
#pragma unroll
                for (int m = 0; m < 4; ++m)
#pragma unroll
                    for (int bj = 0; bj < 2; ++bj)
#pragma unroll
                        for (int n = 0; n < 2; ++n)
#pragma unroll
                            for (int j = 0; j < 4; ++j)
                                base[(32 * bj + 8 * fq + 4 * n + j) * 64 + m * 16 + fr] = f2bf(acc[ai][bj][m][n][j]);
            }
        } else if (pn < 12) {
            const int cb = (pn - 5) * 256 + wc * 32 + 8 * fq;
#pragma unroll
            for (int ai = 0; ai < 2; ++ai)
#pragma unroll
                for (int m = 0; m < 4; ++m) {
                    const size_t ro = (size_t)(rowb + ai * 128 + m * 16 + fr) * CRW + cb;
#pragma unroll
                    for (int bj = 0; bj < 2; ++bj) *(uint4*)&p.prw[ro + bj * 128] = pack8(acc[ai][bj][m][0], acc[ai][bj][m][1]);
                }
        } else {
            if (wc == 0 && fq < 3) {
#pragma unroll
                for (int ai = 0; ai < 2; ++ai)
#pragma unroll
                    for (int m = 0; m < 4; ++m) {
                        const size_t ro = (size_t)(rowb + ai * 128 + m * 16 + fr) * 24 + 8 * fq;
#pragma unroll
                        for (int n = 0; n < 2; ++n) {
                            float4 o; o.x = sigmoidf_(acc[ai][0][m][n][0]); o.y = sigmoidf_(acc[ai][0][m][n][1]); o.z = sigmoidf_(acc[ai][0][m][n][2]); o.w = sigmoidf_(acc[ai][0][m][n][3]);
                            *(float4*)&p.nsag[ro + 4 * n] = o;
                        }
                    }
            }
        }
    }
};
__device__ void ph_inproj(const P& p, int bid, int nb, char* smem) {
    DenseSched S; S.init(NTOK, 3328, D_, p.winT, nb, bid);
    EpiInproj E{&p};
    gemm256(smem, (const char*)p.hbuf, D_, S, E);
    if (nb == 256 && bid >= 128) convert_later_weights(p, (bid - 128) * NT + get_tid(), 128 * NT);
}

__device__ __forceinline__ float gelu_tanh(float x) {
    const float c = 0.7978845608028654f;
    return 0.5f * x * (1.f + tanhf_(c * (x + 0.044715f * x * x * x)));
}
struct CmpSched {
    __device__ __forceinline__ void signal(const GUnit&) const {}
    int i0; const char* Bt;
    __device__ __forceinline__ bool next(int i, GUnit& u) const { u.pm = 0; u.pn = 0; return i == 0; }
    __device__ __forceinline__ unsigned a_off(const GUnit&, int h, int R) const { int i = i0 + h * 128 + R; if (i > 510) i = 510; return (unsigned)i * 2048u; }
    __device__ __forceinline__ const char* b_ptr(const GUnit&) const { return Bt; }
};
struct EpiCmp1 {
    const float* cb1; const float* b1; u16* hidp;
    __device__ __forceinline__ void operator()(const f32x4 (&acc)[2][2][4][2], const GUnit&, int, int, int, int) const {
        const int t2_ = get_tid(), wid_ = __builtin_amdgcn_readfirstlane(t2_ >> 6), wr = wid_ >> 2, wc = wid_ & 3, fr = t2_ & 15, fq = (t2_ >> 4) & 3;
#pragma unroll
        for (int bj = 0; bj < 2; ++bj)
#pragma unroll
            for (int n = 0; n < 2; ++n) {
                const int col = bj * 128 + wc * 32 + n * 16 + 4 * fq;
                const float4 c1 = *(const float4*)&cb1[col], bb1 = *(const float4*)&b1[col];
                const float bs[4] = {c1.x + bb1.x, c1.y + bb1.y, c1.z + bb1.z, c1.w + bb1.w};
#pragma unroll
                for (int ai = 0; ai < 2; ++ai)
#pragma unroll
                    for (int m = 0; m < 4; ++m) {
                        const int r = ai * 128 + wr * 64 + m * 16 + fr;
                        f32x4 o;
#pragma unroll
                        for (int j = 0; j < 4; j++) o[j] = gelu_tanh(acc[ai][bj][m][n][j] + bs[j]);
                        *(uint2*)&hidp[r * 256 + col] = pack4(o);
                    }
            }
    }
};
__device__ void ph_compress(const P& p, int bid, int nb, char* smem) {
    u16* sm = (u16*)smem;
    const int tid = get_tid(), lane = tid & 63, wv = tid >> 6;
    const int wm = wv >> 1, wn = wv & 1;
    for (int it = bid; it < 32; it += nb) {
        const int rt = it & 1, g = (it >> 1) & 1, b = (it >> 2) & 3, kv = it >> 4;
        const int bg = b * 2 + g, i0 = rt * 256;
        const u16* src = (kv ? p.vc : p.kc) + (size_t)bg * S_ * 64;
        const u16* w1T = kv ? p.cw1Tv : p.cw1Tk;
        const u16* w2T = kv ? p.cw2Tv : p.cw2Tk;
        float* cb1 = (float*)(smem + 3 * G_TILE);
        __syncthreads();
        { const int t2 = get_tid(); if (t2 < 256) { float a = 0.f; for (int q = 0; q < 64; q++) a += p.cb1k[q * 512 + kv * 256 + t2]; cb1[t2] = a; } }
        __syncthreads();
        const float* b1 = kv ? p.b1_v : p.b1_k;
        const float* b2 = kv ? p.b2_v : p.b2_k;
        u16* hidp = p.chid + (size_t)it * 256 * 256;
        {
            CmpSched S{i0, (const char*)w1T};
            EpiCmp1 E{cb1, b1, hidp};
            gemm256(smem, (const char*)src, 2048, S, E);
        }
        __syncthreads();
        {
            f32x4 acc[4][4];
            gemm_core<true>(256, [&](int r) { return hidp + (size_t)r * 256; }, w2T, 256, acc, sm);
            if (wn == 0) {
#pragma unroll
                for (int mt = 0; mt < 4; mt++)
#pragma unroll
                    for (int nt = 0; nt < 4; nt++) {
                        const int d = nt * 16 + (lane & 15);
                        const int ib = i0 + wm * 64 + mt * 16 + (lane >> 4) * 4;
                        float o[4];
#pragma unroll
                        for (int j = 0; j < 4; j++) o[j] = (ib + j < NCMP) ? (acc[mt][nt][j] + b2[d]) : 0.f;
                        if (kv == 0) {
#pragma unroll
                            for (int j = 0; j < 4; j++) p.kcb[((size_t)bg * 512 + ib + j) * 64 + d] = f2bf(o[j]);
                        } else {
                            uint2 ov; ov.x = pack2(o[0], o[1]); ov.y = pack2(o[2], o[3]);
                            *(uint2*)&p.vcT[(((size_t)bg * 8 + (ib >> 6)) * 64 + d) * 64 + (ib & 63)] = ov;
                        }
                    }
            }
        }
        __syncthreads();
    }
}

#ifndef NSAPROBE
#define NSAPROBE 0
#endif
#define NSA_TS(k) if (NSAPROBE == k) ts_ = __builtin_amdgcn_s_memrealtime();
#define NSA_TE(k) if (NSAPROBE == k) tacc_ += __builtin_amdgcn_s_memrealtime() - ts_;
constexpr int KSTR = 72;
struct Sub { f32x4 O[4]; float m, l; };
#define NEG_BIG (-1.0e30f)

__device__ __forceinline__ float xq_max(float v) {
    return xrow_max(v);
}
__device__ __forceinline__ float xq_sum(float v) {
    return xrow_sum(v);
}
template <int OFF> __device__ __forceinline__ bf16x8 gload_b128(const u16* p) { bf16x8 r; asm volatile("global_load_dwordx4 %0, %1, off offset:%2" : "=v"(r) : "v"(p), "n"(OFF) : "memory"); return r; }
typedef unsigned u32x2 __attribute__((ext_vector_type(2)));
template <int OFF> __device__ __forceinline__ u32x2 gload_b64(const u16* p) { u32x2 r; asm volatile("global_load_dwordx2 %0, %1, off offset:%2" : "=v"(r) : "v"(p), "n"(OFF) : "memory"); return r; }
union VF { bf16x8 v; u32x2 h[2]; };
template <int OFF> __device__ __forceinline__ u32x2 lds_read_b64(unsigned addr) { u32x2 r; asm volatile("ds_read_b64 %0, %1 offset:%2" : "=v"(r) : "v"(addr), "n"(OFF)); return r; }
#define NSA_LDV_ASM(vf, Vs, kr, qq, swz) { const unsigned va_ = (unsigned)(size_t)(const LAS3 char*)((const char*)(Vs) + (kr) * 128 + ((qq) & 1) * 8); const int vo_ = (((qq) >> 1) ^ (swz)) << 4; \
        const unsigned a0_ = va_ + vo_, a1_ = va_ + (vo_ ^ 32), a2_ = va_ + (vo_ ^ 64), a3_ = va_ + (vo_ ^ 96); \
        vf[0][0].h[0] = lds_read_b64<0>(a0_);    vf[0][0].h[1] = lds_read_b64<0>(a1_);    vf[0][1].h[0] = lds_read_b64<0>(a2_);    vf[0][1].h[1] = lds_read_b64<0>(a3_); \
        vf[1][0].h[0] = lds_read_b64<2048>(a0_); vf[1][0].h[1] = lds_read_b64<2048>(a1_); vf[1][1].h[0] = lds_read_b64<2048>(a2_); vf[1][1].h[1] = lds_read_b64<2048>(a3_); \
        vf[2][0].h[0] = lds_read_b64<4096>(a0_); vf[2][0].h[1] = lds_read_b64<4096>(a1_); vf[2][1].h[0] = lds_read_b64<4096>(a2_); vf[2][1].h[1] = lds_read_b64<4096>(a3_); \
        vf[3][0].h[0] = lds_read_b64<6144>(a0_); vf[3][0].h[1] = lds_read_b64<6144>(a1_); vf[3][1].h[0] = lds_read_b64<6144>(a2_); vf[3][1].h[1] = lds_read_b64<6144>(a3_); }
#define NSA_VWAIT(vf) asm volatile("s_waitcnt lgkmcnt(0)" : "+v"(vf[0][0].v), "+v"(vf[0][1].v), "+v"(vf[1][0].v), "+v"(vf[1][1].v), "+v"(vf[2][0].v), "+v"(vf[2][1].v), "+v"(vf[3][0].v), "+v"(vf[3][1].v) :: "memory")
template <bool MASK, bool IMP, bool PV>
__device__ __forceinline__ void nsa_visit(const u16* Ks, const u16* Vs, const u16* qrow, Sub& s, int lo, int hi, int lane, float* e, float* p3) {
    const int kr = lane & 15, qq = lane >> 4;
    f32x4 S[4];
    const int qsw = ((kr & 3) >> 1) ^ ((kr >> 2) << 1);
    const bf16x8 qf0 = *(const bf16x8*)(qrow + ((qq ^ qsw) << 3)), qf1 = *(const bf16x8*)(qrow + (((4 + qq) ^ qsw) << 3));
    bf16x8 kf[4][2];
    const int swz = kr >> 1;
    {
        const char* kb_ = (const char*)Ks + kr * 128;
        const int ko0 = (qq ^ swz) << 4, ko1 = ko0 ^ 64;
#pragma unroll
        for (int kt = 0; kt < 4; kt++) { kf[kt][0] = *(const bf16x8*)(kb_ + kt * 2048 + ko0); kf[kt][1] = *(const bf16x8*)(kb_ + kt * 2048 + ko1); }
    }
    __builtin_amdgcn_sched_barrier(0);
#pragma unroll
    for (int kt = 0; kt < 4; kt++) {
        S[kt] = __builtin_amdgcn_mfma_f32_16x16x32_bf16(kf[kt][0], qf0, f32x4{0.f, 0.f, 0.f, 0.f}, 0, 0, 0);
        S[kt] = __builtin_amdgcn_mfma_f32_16x16x32_bf16(kf[kt][1], qf1, S[kt], 0, 0, 0);
    }
    float mx = NEG_BIG;
#pragma unroll
    for (int kt = 0; kt < 4; kt++)
#pragma unroll
        for (int r = 0; r < 4; r++) {
            if (MASK) { const int o = kt * 16 + qq * 4 + r; if (o < lo || o > hi) S[kt][r] = -INFINITY; }
            mx = fmaxf(mx, S[kt][r]);
        }
    mx = xq_max(mx);
    const float mnew = fmaxf(s.m, mx);
    const float alpha = __builtin_amdgcn_exp2f(s.m - mnew);
    s.m = mnew;
    float psum = 0.f;
#pragma unroll
    for (int kt = 0; kt < 4; kt++) {
#pragma unroll
        for (int r = 0; r < 4; r++) { S[kt][r] = __builtin_amdgcn_exp2f(S[kt][r] - mnew); }
        const float ee = (S[kt][0] + S[kt][1]) + (S[kt][2] + S[kt][3]);
        psum += ee;
        if (IMP) { e[kt] = ee; p3[kt] = S[kt][3]; }
    }
    s.l = s.l * alpha + psum;
    if (PV) {
        if (!__all(alpha == 1.f)) {
#pragma unroll
            for (int dt = 0; dt < 4; dt++)
#pragma unroll
                for (int r = 0; r < 4; r++) s.O[dt][r] *= alpha;
        }
        VF vf[4][2];
        NSA_LDV_ASM(vf, Vs, kr, qq, swz)
        bf16x8 pb[2];
#pragma unroll
        for (int k2 = 0; k2 < 2; k2++) {
            union { bf16x8 v; unsigned u[4]; } t;
            t.u[0] = pack2(S[2 * k2][0], S[2 * k2][1]); t.u[1] = pack2(S[2 * k2][2], S[2 * k2][3]);
            t.u[2] = pack2(S[2 * k2 + 1][0], S[2 * k2 + 1][1]); t.u[3] = pack2(S[2 * k2 + 1][2], S[2 * k2 + 1][3]);
            pb[k2] = t.v;
        }
        NSA_VWAIT(vf);
        __builtin_amdgcn_sched_barrier(0);
#pragma unroll
        for (int dt = 0; dt < 4; dt++)
#pragma unroll
            for (int k2 = 0; k2 < 2; k2++) s.O[dt] = __builtin_amdgcn_mfma_f32_16x16x32_bf16(vf[dt][k2].v, pb[k2], s.O[dt], 0, 0, 0);
    }
}
template <bool IMP, bool PV, bool MASK, bool FIRST = false, bool MASKLO = false>
__device__ __forceinline__ void nsa_visit2(const u16* Ks, const u16* Vs, const u16* qrow0, const u16* qrow1, Sub (&st)[2], const int (&hi)[2], int lane, float (&e)[2][4], float (&p3)[2][4]) {
    const int kr = lane & 15, qq = lane >> 4;
    const int qsw = ((kr & 3) >> 1) ^ ((kr >> 2) << 1);
    bf16x8 qf0[2], qf1[2];
    qf0[0] = *(const bf16x8*)(qrow0 + ((qq ^ qsw) << 3)); qf1[0] = *(const bf16x8*)(qrow0 + (((4 + qq) ^ qsw) << 3));
    qf0[1] = *(const bf16x8*)(qrow1 + ((qq ^ qsw) << 3)); qf1[1] = *(const bf16x8*)(qrow1 + (((4 + qq) ^ qsw) << 3));
    bf16x8 kf[4][2];
    const int swz = kr >> 1;
    {
        const char* kb_ = (const char*)Ks + kr * 128;
        const int ko0 = (qq ^ swz) << 4, ko1 = ko0 ^ 64;
#pragma unroll
        for (int kt = 0; kt < 4; kt++) { kf[kt][0] = *(const bf16x8*)(kb_ + kt * 2048 + ko0); kf[kt][1] = *(const bf16x8*)(kb_ + kt * 2048 + ko1); }
    }
    __builtin_amdgcn_sched_barrier(0);
    f32x4 S[2][4];
#pragma unroll
    for (int kt = 0; kt < 4; kt++)
#pragma unroll
        for (int q = 0; q < 2; q++) {
            const float s0 = (PV && !FIRST) ? -st[q].m : 0.f;
            S[q][kt] = __builtin_amdgcn_mfma_f32_16x16x32_bf16(kf[kt][0], qf0[q], f32x4{s0, s0, s0, s0}, 0, 0, 0);
            S[q][kt] = __builtin_amdgcn_mfma_f32_16x16x32_bf16(kf[kt][1], qf1[q], S[q][kt], 0, 0, 0);
        }
    VF vf[4][2];
    bf16x8 pb[2][2];
#pragma unroll
    for (int q = 0; q < 2; q++) {
        Sub& s = st[q];
        float mnew = 0.f;
        if (MASK) {
#pragma unroll
            for (int kt = 0; kt < 4; kt++)
#pragma unroll
                for (int r = 0; r < 4; r++) { const int o = kt * 16 + qq * 4 + r; if (MASKLO ? (o <= hi[q]) : (o > hi[q])) S[q][kt][r] = -INFINITY; }
        }
        if (!PV || FIRST) {
            float mx = NEG_BIG;
#pragma unroll
            for (int kt = 0; kt < 4; kt++)
#pragma unroll
                for (int r = 0; r < 4; r++) mx = fmaxf(mx, S[q][kt][r]);
            mx = xq_max(mx);
            mnew = fmaxf(s.m, mx);
            const float alpha = __builtin_amdgcn_exp2f(s.m - mnew);
            s.m = mnew;
            s.l *= alpha;
        }
        float psum = 0.f;
#pragma unroll
        for (int kt = 0; kt < 4; kt++) {
#pragma unroll
            for (int r = 0; r < 4; r++) { S[q][kt][r] = __builtin_amdgcn_exp2f((PV && !FIRST) ? S[q][kt][r] : S[q][kt][r] - mnew); }
            const float ee = (S[q][kt][0] + S[q][kt][1]) + (S[q][kt][2] + S[q][kt][3]);
            psum += ee;
            if (IMP) { e[q][kt] = ee; p3[q][kt] = S[q][kt][3]; }
        }
        s.l += psum;
        if (PV) {
#pragma unroll
            for (int k2 = 0; k2 < 2; k2++) {
                union { bf16x8 v; unsigned u[4]; } t;
                t.u[0] = pack2(S[q][2 * k2][0], S[q][2 * k2][1]); t.u[1] = pack2(S[q][2 * k2][2], S[q][2 * k2][3]);
                t.u[2] = pack2(S[q][2 * k2 + 1][0], S[q][2 * k2 + 1][1]); t.u[3] = pack2(S[q][2 * k2 + 1][2], S[q][2 * k2 + 1][3]);
                pb[q][k2] = t.v;
            }
            if (q == 0) NSA_LDV_ASM(vf, Vs, kr, qq, swz)
        }
    }
    if (PV) {
        NSA_VWAIT(vf);
        __builtin_amdgcn_sched_barrier(0);
#pragma unroll
        for (int dt = 0; dt < 4; dt++)
#pragma unroll
            for (int k2 = 0; k2 < 2; k2++)
#pragma unroll
                for (int q = 0; q < 2; q++) st[q].O[dt] = __builtin_amdgcn_mfma_f32_16x16x32_bf16(vf[dt][k2].v, pb[q][k2], st[q].O[dt], 0, 0, 0);
    }
}
template <int MMODE, bool FIXM, int NQ>
__device__ __forceinline__ void nsa_visit_gn(const u16* Ks, const u16* Vs, const u16* qs, float* Os, float* Ms, float* Ls, const int (&tok)[NQ], const bool (&valid)[NQ], int lane) {
    const int kr = lane & 15, qq = lane >> 4, hh = kr & 3;
    int row[NQ], osw[NQ]; float* orow[NQ];
    f32x4 O[NQ][4]; float m_old[NQ], l_old[NQ]; bf16x8 qf0[NQ], qf1[NQ];
#pragma unroll
    for (int q = 0; q < NQ; q++) {
        row[q] = tok[q] * 4 + hh; orow[q] = Os + row[q] * 64;
        osw[q] = hh ^ ((tok[q] & 3) << 2);
        if (FIXM) {
#pragma unroll
            for (int dt = 0; dt < 4; dt++) O[q][dt] = *(const f32x4*)(orow[q] + (((dt * 4 + qq) ^ osw[q]) << 2));
            m_old[q] = Ms[row[q]]; l_old[q] = Ls[row[q]];
        } else {
#pragma unroll
            for (int dt = 0; dt < 4; dt++) O[q][dt] = f32x4{0.f, 0.f, 0.f, 0.f};
            m_old[q] = NEG_BIG; l_old[q] = 0.f;
        }
        const u16* qrow = qs + row[q] * 64;
        const int qsw = (hh >> 1) ^ ((tok[q] & 3) << 1);
        qf0[q] = *(const bf16x8*)(qrow + ((qq ^ qsw) << 3)); qf1[q] = *(const bf16x8*)(qrow + (((4 + qq) ^ qsw) << 3));
    }
    bf16x8 kf[4][2];
    const int swz = kr >> 1;
    {
        const char* kb_ = (const char*)Ks + kr * 128;
        const int ko0 = (qq ^ swz) << 4, ko1 = ko0 ^ 64;
#pragma unroll
        for (int kt = 0; kt < 4; kt++) { kf[kt][0] = *(const bf16x8*)(kb_ + kt * 2048 + ko0); kf[kt][1] = *(const bf16x8*)(kb_ + kt * 2048 + ko1); }
    }
    __builtin_amdgcn_sched_barrier(0);
    f32x4 S[NQ][4];
#pragma unroll
    for (int kt = 0; kt < 4; kt++)
#pragma unroll
        for (int q = 0; q < NQ; q++) {
            const float s0 = FIXM ? (valid[q] ? -m_old[q] : -INFINITY) : 0.f;
            S[q][kt] = __builtin_amdgcn_mfma_f32_16x16x32_bf16(kf[kt][0], qf0[q], f32x4{s0, s0, s0, s0}, 0, 0, 0);
            S[q][kt] = __builtin_amdgcn_mfma_f32_16x16x32_bf16(kf[kt][1], qf1[q], S[q][kt], 0, 0, 0);
        }
    VF vf[4][2];
#define NSA_LDV NSA_LDV_ASM(vf, Vs, kr, qq, swz)
    if (NQ == 1) NSA_LDV
    bf16x8 pb[NQ][2];
#pragma unroll
    for (int q = 0; q < NQ; q++) {
        float mx = NEG_BIG;
#pragma unroll
        for (int kt = 0; kt < 4; kt++)
#pragma unroll
            for (int r = 0; r < 4; r++) {
                if (MMODE == 1) { const int o = kt * 16 + qq * 4 + r; if (o > tok[q]) S[q][kt][r] = -INFINITY; }
                if (MMODE == 2) { const int o = kt * 16 + qq * 4 + r; if (o <= tok[q]) S[q][kt][r] = -INFINITY; }
                if (!FIXM) mx = fmaxf(mx, S[q][kt][r]);
            }
        float mnew = m_old[q], alpha = 1.f;
        if (!FIXM) {
            if (!valid[q]) mx = NEG_BIG;
            mx = xq_max(mx);
            mnew = fmaxf(m_old[q], mx);
            alpha = __builtin_amdgcn_exp2f(m_old[q] - mnew);
        }
#pragma unroll
        for (int kt = 0; kt < 4; kt++)
#pragma unroll
            for (int r = 0; r < 4; r++) { S[q][kt][r] = __builtin_amdgcn_exp2f(FIXM ? S[q][kt][r] : S[q][kt][r] - mnew); }
#pragma unroll
        for (int k2 = 0; k2 < 2; k2++) {
            union { bf16x8 v; unsigned u[4]; } t;
            t.u[0] = pack2(S[q][2 * k2][0], S[q][2 * k2][1]); t.u[1] = pack2(S[q][2 * k2][2], S[q][2 * k2][3]);
            t.u[2] = pack2(S[q][2 * k2 + 1][0], S[q][2 * k2 + 1][1]); t.u[3] = pack2(S[q][2 * k2 + 1][2], S[q][2 * k2 + 1][3]);
            pb[q][k2] = t.v;
        }
        float psum;
        {
            const bf16x8 ones = {0x3F80, 0x3F80, 0x3F80, 0x3F80, 0x3F80, 0x3F80, 0x3F80, 0x3F80};
            f32x4 ps = __builtin_amdgcn_mfma_f32_16x16x32_bf16(ones, pb[q][0], f32x4{0.f, 0.f, 0.f, 0.f}, 0, 0, 0);
            ps = __builtin_amdgcn_mfma_f32_16x16x32_bf16(ones, pb[q][1], ps, 0, 0, 0);
            psum = ps[0];
        }
        if (FIXM) { if (valid[q] && qq == 0) Ls[row[q]] = l_old[q] + psum; }
        else { if (valid[q] && qq == 0) { Ms[row[q]] = mnew; Ls[row[q]] = psum; } }
        if (NQ == 2 && q == 0) { asm volatile("" ::: "memory"); NSA_LDV }
    }
#undef NSA_LDV
    NSA_VWAIT(vf);
    __builtin_amdgcn_sched_barrier(0);
#pragma unroll
    for (int dt = 0; dt < 4; dt++)
#pragma unroll
        for (int k2 = 0; k2 < 2; k2++)
#pragma unroll
            for (int q = 0; q < NQ; q++) O[q][dt] = __builtin_amdgcn_mfma_f32_16x16x32_bf16(vf[dt][k2].v, pb[q][k2], O[q][dt], 0, 0, 0);
#pragma unroll
    for (int q = 0; q < NQ; q++)
        if (valid[q]) {
#pragma unroll
            for (int dt = 0; dt < 4; dt++) *(f32x4*)(orow[q] + (((dt * 4 + qq) ^ osw[q]) << 2)) = O[q][dt];
        }
}
template <int MMODE, bool FIXM>
__device__ __forceinline__ void nsa_visit_g(const u16* Ks, const u16* Vs, const u16* qs, float* Os, float* Ms, float* Ls, int tok, bool valid, int lane) {
    const int tk[1] = {tok}; const bool vl[1] = {valid};
    nsa_visit_gn<MMODE, FIXM, 1>(Ks, Vs, qs, Os, Ms, Ls, tk, vl, lane);
}
__device__ __forceinline__ void nsa_fold_lds(float* Os, float* Ms, float* Ls, int row, int qq, int hh, f32x4 (&T)[4], float gate, bool reset) {
    const float lt = Ls[row];
    const float sc = (lt > 0.f) ? gate / lt : 0.f;
#pragma unroll
    for (int dt = 0; dt < 4; dt++) {
        float* op = Os + row * 64 + (((dt * 4 + qq) ^ hh ^ (((row >> 2) & 3) << 2)) << 2);
        const f32x4 o = *(const f32x4*)op;
#pragma unroll
        for (int r = 0; r < 4; r++) T[dt][r] += o[r] * sc;
    }
    (void)reset; (void)Ms;
}
template <int MODE>
__device__ __forceinline__ void nsa_fold(Sub& s, f32x4 (&T)[4], float gate) {
    const float lt = xq_sum(s.l);
    const float sc = (lt > 0.f) ? gate / lt : 0.f;
#pragma unroll
    for (int dt = 0; dt < 4; dt++)
#pragma unroll
        for (int r = 0; r < 4; r++) {
            const float v = s.O[dt][r] * sc;
            T[dt][r] = (MODE == 1) ? T[dt][r] + v : v;
            s.O[dt][r] = 0.f;
        }
    s.m = NEG_BIG; s.l = 0.f;
}

constexpr int NSA_R = 3;
template <bool HASV, class KSrc, class VSrc, class Body>
__device__ __forceinline__ void nsa_stream(char* ring, int n, KSrc ksrc, VSrc vsrc, Body body) {
    const int t = get_tid();
    const int so = (t >> 3) * 64 + (((t & 7) ^ ((t >> 4) & 7)) << 3);
    char* dl = ring + t * 16;
#define NSA_ISSUE(i, slot) { glds16(ksrc(i) + so, dl + (slot) * 16384); if (HASV) glds16(vsrc(i) + so, dl + (slot) * 16384 + 8192); }
    asm volatile("s_waitcnt lgkmcnt(0)" ::: "memory");
    __builtin_amdgcn_s_barrier();
    if (n > 0) NSA_ISSUE(0, 0)
    if (n > 1) NSA_ISSUE(1, 1)
    int slot = 0;
    for (int i = 0; i < n; i++) {
        if (i + 1 < n) { if (HASV) asm volatile("s_waitcnt vmcnt(2)" ::: "memory"); else asm volatile("s_waitcnt vmcnt(1)" ::: "memory"); }
        else asm volatile("s_waitcnt vmcnt(0)" ::: "memory");
        asm volatile("s_waitcnt lgkmcnt(0)" ::: "memory");
        __builtin_amdgcn_s_barrier();
        asm volatile("" ::: "memory");
        const int sl2 = (slot == 0) ? 2 : slot - 1;
        if (i + 2 < n) NSA_ISSUE(i + 2, sl2)
        body(i, (const u16*)(ring + slot * 16384), (const u16*)(ring + slot * 16384 + 8192));
        slot = (slot == 2) ? 0 : slot + 1;
    }
#undef NSA_ISSUE
}
#define NSA_TOK(u) const int t3_ = get_tid(); const size_t ntk_ = (size_t)b * S_ + t0 + 8 * (t3_ >> 6) + 4 * (u) + ((t3_ & 15) >> 2); const int hd_ = g * 4 + (t3_ & 3); (void)ntk_; (void)hd_; \
        const int gix_ = ((8 * (t3_ >> 6) + 4 * (u) + ((t3_ & 15) >> 2)) * 4 + (t3_ & 3)) * 3;
__device__ void ph_nsa(const P& p, int bid, int nb, char* smem) {
    char* ring = smem;
    unsigned* selm = (unsigned*)(smem + NSA_R * 16384);
    int* blist = (int*)(selm + 256);
    int* nlistp = blist + 128;
    int* lcnt = nlistp + 4;
    unsigned char* lists = (unsigned char*)(lcnt + 128);
    float* Ms = (float*)(lists + 128 * 64);
    float* Ls = Ms + 256;
    float* Os = Ls + 256;
    float* impl = Os;
    u16* qs = (u16*)(Os + 64 * 4 * 64);
    float* gl3 = (float*)(qs + 64 * 4 * 64);
    unsigned long long ts_ = 0, tacc_ = 0;
    const int nitems = B_ * 2 * 128;
    for (int rr = 0;; rr++) {
        int it = bid;
        if (rr > 0 || bid < 0) {
            __syncthreads();
            if (get_tid() == 0) nlistp[3] = nb + atomicAdd(p.nsactr, 1);
            __syncthreads();
            it = nlistp[3];
        }
        if (it >= nitems) break;
        const int tid = get_tid(), lane = tid & 63, wv = tid >> 6;
        const int kr = lane & 15, qq = lane >> 4, ts = kr >> 2, hh = kr & 3;
        float* myimp = impl + wv * (32 * 2 * 16);
        const int tt = 127 - (it >> 3);
        const int bg = it & 7, b = bg >> 1, g = bg & 1;
        const int t0 = tt * 64, cur = tt;
        const int head = g * 4 + hh;
        Sub st[2];
        f32x4 T[2][4];
        int tl[2]; size_t ntok[2];
        __syncthreads();
        { const int t5_ = get_tid(); if (t5_ < 256) { const float* gp_ = p.nsag + ((size_t)b * S_ + t0 + (t5_ >> 2)) * 24 + (g * 4 + (t5_ & 3)) * 3; float* gd_ = gl3 + t5_ * 3; gd_[0] = gp_[0]; gd_[1] = gp_[1]; gd_[2] = gp_[2]; } }
#pragma unroll
        for (int u = 0; u < 2; u++) {
            tl[u] = 8 * wv + 4 * u + ts;
            ntok[u] = (size_t)b * S_ + t0 + tl[u];
#pragma unroll
            for (int ks = 0; ks < 2; ks++) *(bf16x8*)&qs[(tl[u] * 4 + hh) * 64 + (((ks * 4 + qq) ^ (hh >> 1) ^ ((tl[u] & 3) << 1)) << 3)] = *(const bf16x8*)&p.q[ntok[u] * 512 + head * 64 + ks * 32 + qq * 8];
#pragma unroll
            for (int dt = 0; dt < 4; dt++) st[u].O[dt] = f32x4{0.f, 0.f, 0.f, 0.f};
            st[u].m = NEG_BIG; st[u].l = 0.f;
        }
        const u16* kcb = p.kcb + (size_t)bg * 512 * 64;
        const u16* vcT = p.vcT + (size_t)bg * 8 * 4096;
        int nv[2];
#pragma unroll
        for (int u = 0; u < 2; u++) { const int t = t0 + tl[u]; nv[u] = (t >= 31) ? min((t - 31) / 16 + 1, NCMP) : 0; }
        const int tmax = t0 + 63;
        const int nvmax = (tmax >= 31) ? min((tmax - 31) / 16 + 1, NCMP) : 0;
        const int nvb = (nvmax + 63) >> 6;
        NSA_TS(1)
        __syncthreads();
        float carry[2] = {0.f, 0.f};
        u16* myimp16 = (u16*)impl + wv * (32 * 2 * 16 * 4);
        nsa_stream<true>(ring, nvb, [&](int kb) { return kcb + (size_t)kb * 4096; }, [&](int kb) { return vcT + (size_t)kb * 4096; },
            [&](int kb, const u16* Ks, const u16* Vs) {
            const int hi2[2] = {nv[0] - kb * 64 - 1, nv[1] - kb * 64 - 1};
            float e_[2][4], p3_[2][4];
            if (kb == 0) nsa_visit2<true, true, true, true>(Ks, Vs, qs + (tl[0] * 4 + hh) * 64, qs + (tl[1] * 4 + hh) * 64, st, hi2, lane, e_, p3_);
            else if (__all(hi2[0] >= 63 && hi2[1] >= 63)) nsa_visit2<true, true, false>(Ks, Vs, qs + (tl[0] * 4 + hh) * 64, qs + (tl[1] * 4 + hh) * 64, st, hi2, lane, e_, p3_);
            else nsa_visit2<true, true, true>(Ks, Vs, qs + (tl[0] * 4 + hh) * 64, qs + (tl[1] * 4 + hh) * 64, st, hi2, lane, e_, p3_);
#pragma unroll
            for (int u = 0; u < 2; u++) {
#pragma unroll
                for (int kt = 0; kt < 4; kt++) {
                    const float pv = p3_[u][kt];
                    const float sh = __int_as_float(__builtin_amdgcn_ds_bpermute(((lane - 16) & 63) << 2, __float_as_int(pv)));
                    const float nbv = (qq == 0) ? carry[u] : sh;
                    carry[u] = sh;
                    myimp16[(((kb * 4 + kt) * 2 + u) * 16 + ts * 4 + qq) * 4 + hh] = f2bf(e_[u][kt] + nbv);
                }
            }
            });
        float invl[2];
#pragma unroll
        for (int u = 0; u < 2; u++) { const float lt = xq_sum(st[u].l); invl[u] = (lt > 0.f) ? 1.f / lt : 0.f; }
        NSA_TE(1)
        NSA_TS(2)
#pragma unroll
        for (int u = 0; u < 2; u++) {
            unsigned ku[8];
            const float w0 = dppf<0x00>(invl[u]), w1 = dppf<0x55>(invl[u]), w2 = dppf<0xAA>(invl[u]), w3 = dppf<0xFF>(invl[u]);
#pragma unroll
            for (int i = 0; i < 8; i++) {
                const int kk = 8 * hh + i, j = 4 * kk + qq;
                const uint2 eh = *(const uint2*)&myimp16[((kk * 2 + u) * 16 + ts * 4 + qq) * 4];
                const float v = (__uint_as_float(eh.x << 16) * w0 + __uint_as_float(eh.x & 0xFFFF0000u) * w1) + (__uint_as_float(eh.y << 16) * w2 + __uint_as_float(eh.y & 0xFFFF0000u) * w3);
                ku[i] = (j >= 1 && j <= cur - 2) ? ((__float_as_uint(v) & 0xFFFFFF80u) | (unsigned)(128 - j)) : 0u;
            }
            unsigned sel = 0u;
            const int ncand = max(0, cur - 2);
            const int nforced = (cur >= 2) ? 3 : (cur + 1);
            const int need = 16 - nforced;
            if (ncand <= need) {
#pragma unroll
                for (int i = 0; i < 8; i++) if (ku[i] != 0u) sel |= (1u << i);
            } else {
                for (int rnd = 0; rnd < need; rnd++) {
                    unsigned best = max(max(max(ku[0], ku[1]), max(ku[2], ku[3])), max(max(ku[4], ku[5]), max(ku[6], ku[7])));
                    best = max(best, (unsigned)__builtin_amdgcn_update_dpp(0, (int)best, 0xB1, 0xF, 0xF, true));
                    best = max(best, (unsigned)__builtin_amdgcn_update_dpp(0, (int)best, 0x4E, 0xF, 0xF, true));
                    { auto r = __builtin_amdgcn_permlane16_swap(best, best, false, false); best = max(r[0], r[1]); }
                    { auto r = __builtin_amdgcn_permlane32_swap(best, best, false, false); best = max(r[0], r[1]); }
#pragma unroll
                    for (int i = 0; i < 8; i++) { const bool hit = (ku[i] == best) && (best != 0u); ku[i] = hit ? 0u : ku[i]; sel |= hit ? (1u << i) : 0u; }
                }
            }
            if (qq == 0 && hh == 0) sel |= 1u;
            if ((cur & 3) == qq && (cur >> 5) == hh) sel |= (1u << ((cur >> 2) & 7));
            if (cur >= 1 && ((cur - 1) & 3) == qq && ((cur - 1) >> 5) == hh) sel |= (1u << (((cur - 1) >> 2) & 7));
            unsigned w = sel << (8 * hh);
            w |= (unsigned)__builtin_amdgcn_update_dpp(0, (int)w, 0xB1, 0xF, 0xF, true);
            w |= (unsigned)__builtin_amdgcn_update_dpp(0, (int)w, 0x4E, 0xF, 0xF, true);
            if (hh == 0) selm[tl[u] * 4 + qq] = w;
        }
        NSA_TE(2)
        NSA_TS(3)
        __syncthreads();
#pragma unroll
        for (int u = 0; u < 2; u++) { NSA_TOK(u) nsa_fold<0>(st[u], T[u], gl3[gix_ + 0]); }
        {
            const int t2 = get_tid();
            unsigned long long tm = 0ull; int lrank = 0;
            if (t2 < 128) {
                const int j = t2;
                for (int tk = 0; tk < 64; tk++) tm |= (unsigned long long)((selm[tk * 4 + (j & 3)] >> (j >> 2)) & 1u) << tk;
                if (j > cur) tm = 0ull;
                const unsigned long long bal = __ballot(tm != 0ull);
                lrank = __popcll(bal & ((1ull << (t2 & 63)) - 1ull));
                if ((t2 & 63) == 0) nlistp[t2 >> 6] = __popcll(bal);
            }
            __syncthreads();
            if (t2 < 128 && tm != 0ull) {
                const int pos = lrank + ((t2 >= 64) ? nlistp[0] : 0);
                blist[pos] = t2; lcnt[pos] = __popcll(tm);
                if (tm == ~0ull) {
#pragma unroll 1
                    for (int c4 = 0; c4 < 16; c4++) *(unsigned*)&lists[pos * 64 + c4 * 4] = 0x03020100u + 0x04040404u * (unsigned)c4;
                } else {
                    int c = 0;
                    while (tm) { lists[pos * 64 + c] = (unsigned char)(__ffsll((long long)tm) - 1); c++; tm &= tm - 1ull; }
                }
            }
            __syncthreads();
        }
        const int nlist = nlistp[0] + nlistp[1];
        NSA_TE(3)
        NSA_TS(4)
        const u16* ksl = p.ksl + (size_t)bg * S_ * 64;
        const u16* vslT = p.vslT + (size_t)bg * 128 * 4096;
        {
            const int t4 = get_tid(), wv4 = __builtin_amdgcn_readfirstlane(t4 >> 6), ts4 = (t4 & 15) >> 2;
            const int td = t4 & 255;
            const int so = (td >> 3) * 64 + (((td & 7) ^ ((td >> 4) & 7)) << 3);
            char* dl = ring + td * 16;
#define NSA_RI(i) (nlist - 1 - (i))
#define NSA_ISSUE2(i, slot) if (wv4 >= 4) { const int jj_ = blist[NSA_RI(i)]; const u16* kp_ = ksl + (size_t)jj_ * 4096 + so; const u16* vp_ = vslT + (size_t)jj_ * 4096 + so; char* d_ = dl + (slot) * 16384; \
                glds16(kp_, d_); glds16(kp_ + 2048, d_ + 4096); glds16(vp_, d_ + 8192); glds16(vp_ + 2048, d_ + 12288); }
            asm volatile("s_waitcnt lgkmcnt(0)" ::: "memory");
            __builtin_amdgcn_s_barrier();
            if (nlist > 0) NSA_ISSUE2(0, 0)
            if (nlist > 1) NSA_ISSUE2(1, 1)
            int jn = 0, nn = 0, tokn = 0;
            if (nlist > 0) { jn = blist[NSA_RI(0)]; nn = lcnt[NSA_RI(0)]; tokn = lists[NSA_RI(0) * 64 + wv4 * 4 + ts4]; }
            int slot = 0;
            for (int i = 0; i < nlist; i++) {
                if (i + 1 < nlist) asm volatile("s_waitcnt vmcnt(4)" ::: "memory"); else asm volatile("s_waitcnt vmcnt(0)" ::: "memory");
                asm volatile("s_waitcnt lgkmcnt(0)" ::: "memory");
                __builtin_amdgcn_s_barrier();
                asm volatile("" ::: "memory");
                const int sl2 = (slot == 0) ? 2 : slot - 1;
                if (i + 2 < nlist) NSA_ISSUE2(i + 2, sl2)
                const int j = jn, n = nn, tok0 = tokn;
                if (i + 1 < nlist) { jn = blist[NSA_RI(i + 1)]; nn = lcnt[NSA_RI(i + 1)]; tokn = lists[NSA_RI(i + 1) * 64 + wv4 * 4 + ts4]; }
                const u16* Ks = (const u16*)(ring + slot * 16384); const u16* Vs = Ks + 4096;
                if ((wv4 + NW) * 4 < n) {
                    const int e1 = (wv4 + NW) * 4 + ts4;
                    const bool vl2[2] = {true, e1 < n};
                    const int tk2[2] = {tok0, vl2[1] ? (int)lists[NSA_RI(i) * 64 + (e1 & 63)] : 0};
                    if (j == cur) nsa_visit_gn<1, false, 2>(Ks, Vs, qs, Os, Ms, Ls, tk2, vl2, t4 & 63);
                    else nsa_visit_gn<0, true, 2>(Ks, Vs, qs, Os, Ms, Ls, tk2, vl2, t4 & 63);
                } else if (wv4 * 4 < n) {
                    const int e = wv4 * 4 + ts4;
                    const bool valid = e < n;
                    const int tok = valid ? tok0 : 0;
                    if (j == cur) nsa_visit_g<1, false>(Ks, Vs, qs, Os, Ms, Ls, tok, valid, t4 & 63);
                    else nsa_visit_g<0, true>(Ks, Vs, qs, Os, Ms, Ls, tok, valid, t4 & 63);
                }
                slot = (slot == 2) ? 0 : slot + 1;
            }
#undef NSA_RI
#undef NSA_ISSUE2
        }
        __syncthreads();
        NSA_TE(4)
        NSA_TS(5)
#pragma unroll
        for (int u = 0; u < 2; u++) {
            NSA_TOK(u)
            const int t5 = t3_ & 63;
            nsa_fold_lds(Os, Ms, Ls, (8 * (t3_ >> 6) + 4 * u + ((t5 & 15) >> 2)) * 4 + (t5 & 3), t5 >> 4, t5 & 3, T[u], gl3[gix_ + 1], true);
        }
        const u16* kwn = p.kwn + (size_t)bg * S_ * 64;
        const u16* vwnT = p.vwnT + (size_t)bg * 128 * 4096;
        uint2 Tp[2][4];
#pragma unroll
        for (int u = 0; u < 2; u++)
#pragma unroll
            for (int dt = 0; dt < 4; dt++) { Tp[u][dt] = pack4(T[u][dt]); asm volatile("" : "+v"(Tp[u][dt].x), "+v"(Tp[u][dt].y)); }
        {
            const int jlo = max(0, cur - 8);
            nsa_stream<true>(ring, cur - jlo + 1, [&](int i) { return kwn + (size_t)(cur - i) * 4096; }, [&](int i) { return vwnT + (size_t)(cur - i) * 4096; },
                [&](int i, const u16* Ks, const u16* Vs) {
                    const int j = cur - i;
                    const int t4 = get_tid();
                    const int tb_ = 8 * (t4 >> 6) + ((t4 & 15) >> 2), hh_ = t4 & 3;
                    const int hi2[2] = {tb_, tb_ + 4};
                    float e_[2][4], p3_[2][4];
                    const u16* q0_ = qs + (tb_ * 4 + hh_) * 64; const u16* q1_ = qs + ((tb_ + 4) * 4 + hh_) * 64;
                    if (j == cur) nsa_visit2<false, true, true, true, false>(Ks, Vs, q0_, q1_, st, hi2, t4 & 63, e_, p3_);
                    else if (j == cur - 8) nsa_visit2<false, true, true, false, true>(Ks, Vs, q0_, q1_, st, hi2, t4 & 63, e_, p3_);
                    else nsa_visit2<false, true, false>(Ks, Vs, q0_, q1_, st, hi2, t4 & 63, e_, p3_);
                });
        }
#pragma unroll
        for (int u = 0; u < 2; u++) {
            NSA_TOK(u)
#pragma unroll
            for (int dt = 0; dt < 4; dt++) T[u][dt] = unpack4(Tp[u][dt]);
            nsa_fold<1>(st[u], T[u], gl3[gix_ + 2]);
#pragma unroll
            for (int dt = 0; dt < 4; dt++) *(uint2*)&p.oa[ntk_ * 512 + hd_ * 64 + dt * 16 + ((t3_ & 63) >> 4) * 4] = pack4(T[u][dt]);
        }
        NSA_TE(5)
    }
    if (NSAPROBE) { __syncthreads(); const unsigned long long t1_ = __builtin_amdgcn_s_memrealtime(); while (__builtin_amdgcn_s_memrealtime() - t1_ < tacc_) __builtin_amdgcn_s_sleep(8); }
}

#ifndef CHPROBE
#define CHPROBE 0
#endif
#define CH_TS(k) if (CHPROBE == k) cts_ = __builtin_amdgcn_s_memrealtime();
#define CH_TE(k) if (CHPROBE == k) ctacc_ += __builtin_amdgcn_s_memrealtime() - cts_;
constexpr int RS = 72;
constexpr int RSLOT = 64 * RS;
__device__ __forceinline__ void mm64(const u16* A, int lda, const u16* Bz, int ldb, f32x4 (&acc)[2], int lane, int wv) {
    const int mt = wv >> 1, nt0 = (wv & 1) * 2, kr = lane & 15, qq = lane >> 4;
    bf16x8 a[2], b[2][2];
#pragma unroll
    for (int ks = 0; ks < 2; ks++) {
        a[ks] = *(const bf16x8*)&A[(mt * 16 + kr) * lda + ks * 32 + qq * 8];
#pragma unroll
        for (int i = 0; i < 2; i++) b[ks][i] = *(const bf16x8*)&Bz[((nt0 + i) * 16 + kr) * ldb + ks * 32 + qq * 8];
    }
#pragma unroll
    for (int ks = 0; ks < 2; ks++)
#pragma unroll
        for (int i = 0; i < 2; i++) acc[i] = __builtin_amdgcn_mfma_f32_16x16x32_bf16(a[ks], b[ks][i], acc[i], 0, 0, 0);
}
__device__ __forceinline__ void st_t(u16* dst, int ld, const f32x4& v, int mt, int nt, int lane) {
    uint2 o; o.x = pack2(v[0], v[1]); o.y = pack2(v[2], v[3]);
    *(uint2*)&dst[(nt * 16 + (lane & 15)) * ld + mt * 16 + (lane >> 4) * 4] = o;
}
__device__ __forceinline__ void st_n(u16* dst, int ld, const f32x4& v, int mt, int nt, int lane) {
#pragma unroll
    for (int r = 0; r < 4; r++) dst[(mt * 16 + (lane >> 4) * 4 + r) * ld + nt * 16 + (lane & 15)] = f2bf(v[r]);
}
#define ZACC(a) { a[0] = f32x4{0.f, 0.f, 0.f, 0.f}; a[1] = f32x4{0.f, 0.f, 0.f, 0.f}; }

__device__ void ph_rwkv_chunk(const P& p, int bid, int nb, char* smem) {
    unsigned long long cts_ = 0, ctacc_ = 0;
    u16* sl = (u16*)smem;
    float* tot = (float*)(sl + 14 * RSLOT);
    float* gl = tot + 512;
#define RW_IDX const int tid = get_tid(), lane = tid & 63, wv = tid >> 6, mt = wv >> 1, nt0 = (wv & 1) * 2, kr = lane & 15, qq = lane >> 4; (void)mt; (void)nt0; (void)kr; (void)qq; (void)lane;
    const int nitems = B_ * 128;
    for (int it0 = bid; it0 < nitems; it0 += nb) {
      const int c = it0 & 127, b = it0 >> 7;
      const size_t n0 = (size_t)b * S_ + c * 64;
      __syncthreads();
      bf16x8 xa_[8], wb[2][2], ab[2][2], gb[2][4];
      u16 rc[8][3], rp0[3];
      float w0c[2], a0c[2], hc_[6];
#define S1_LOADW(hh_) { RW_IDX \
          _Pragma("unroll") for (int i = 0; i < 2; i++) { const int cc = (nt0 + i) * 16 + kr; w0c[i] = p.w0[(hh_) * 64 + cc]; a0c[i] = p.a0[(hh_) * 64 + cc]; \
              _Pragma("unroll") for (int ks = 0; ks < 2; ks++) { wb[i][ks] = *(const bf16x8*)&p.w2T[((size_t)(hh_) * 64 + cc) * 64 + ks * 32 + qq * 8]; \
                                                                 ab[i][ks] = *(const bf16x8*)&p.a2T[((size_t)(hh_) * 64 + cc) * 64 + ks * 32 + qq * 8]; } \
              _Pragma("unroll") for (int ks = 0; ks < 4; ks++) gb[i][ks] = *(const bf16x8*)&p.g2T[((size_t)(hh_) * 64 + cc) * 128 + ks * 32 + qq * 8]; } }
#define S2_LOADX(hh_) { RW_IDX const int ch_ = (hh_) * 64 + lane; \
          hc_[0] = p.mu[ch_]; hc_[1] = p.mu[512 + ch_]; hc_[2] = p.mu[1024 + ch_]; hc_[3] = p.k_k[ch_]; hc_[4] = p.k_a[ch_]; hc_[5] = p.r_k[ch_]; \
          _Pragma("unroll") for (int i = 0; i < 8; i++) { const int t = wv * 8 + i; const u16* cr = p.prw + (n0 + t) * CRW; \
              rc[i][0] = cr[ch_]; rc[i][1] = cr[512 + ch_]; rc[i][2] = cr[1024 + ch_]; } \
          rp0[0] = 0; rp0[1] = 0; rp0[2] = 0;     \
          if (c * 64 + wv * 8 > 0) { const u16* pp = p.prw + (n0 + wv * 8 - 1) * CRW; rp0[0] = pp[ch_]; rp0[1] = pp[512 + ch_]; rp0[2] = pp[1024 + ch_]; } }
      S2_LOADX(0)
      {
          RW_IDX
          const int t = tid >> 3, part = tid & 7;
          const size_t n = n0 + t;
          const bool hasprev = (c * 64 + t) > 0;
          u16* dst = sl + t * 264 + part * 32;
          uint4 cuv[4], pvv[4]; float4 mua[4], mub[4];
#pragma unroll
          for (int j = 0; j < 4; j++) {
              const int col = 1536 + part * 32 + j * 8;
              cuv[j] = *(const uint4*)&p.prw[n * CRW + col];
              pvv[j] = make_uint4(0u, 0u, 0u, 0u);
              if (hasprev) pvv[j] = *(const uint4*)&p.prw[(n - 1) * CRW + col];
              mua[j] = *(const float4*)&p.mu[col]; mub[j] = *(const float4*)&p.mu[col + 4];
          }
#pragma unroll
          for (int j = 0; j < 4; j++) {
              const unsigned cw[4] = {cuv[j].x, cuv[j].y, cuv[j].z, cuv[j].w}, pw[4] = {pvv[j].x, pvv[j].y, pvv[j].z, pvv[j].w};
              const float mw[8] = {mua[j].x, mua[j].y, mua[j].z, mua[j].w, mub[j].x, mub[j].y, mub[j].z, mub[j].w};
              unsigned ow[4];
#pragma unroll
              for (int e2 = 0; e2 < 4; e2++) {
                  float x0 = __uint_as_float(cw[e2] << 16), x1 = __uint_as_float(cw[e2] & 0xFFFF0000u);
                  const float q0 = __uint_as_float(pw[e2] << 16), q1 = __uint_as_float(pw[e2] & 0xFFFF0000u);
                  x0 = x0 + (q0 - x0) * mw[2 * e2]; x1 = x1 + (q1 - x1) * mw[2 * e2 + 1];
                  if (part < 2) { x0 = tanhf_(x0); x1 = tanhf_(x1); }
                  else if (part >= 4) { x0 = sigmoidf_(x0); x1 = sigmoidf_(x1); }
                  ow[e2] = pack2(x0, x1);
              }
              *(uint4*)&dst[j * 8] = make_uint4(ow[0], ow[1], ow[2], ow[3]);
          }
      }
      S1_LOADW(0)
      __syncthreads();
      const u16* xa = sl;
      {
          RW_IDX
#pragma unroll
          for (int k8 = 0; k8 < 8; k8++) xa_[k8] = *(const bf16x8*)&xa[(mt * 16 + kr) * 264 + k8 * 32 + qq * 8];
      }
#pragma unroll 1
      for (int h = 0; h < 8; h++) {
        u16* cd = p.cdat + ((size_t)((b * 8 + h) * 128 + c)) * 4 * 4096;
        LDS_BARRIER();
        CH_TS(1)
        float* LW = (float*)(sl + 8 * RSLOT); float* LA = (float*)(sl + 10 * RSLOT);
        {
            RW_IDX
            f32x4 aw[2], aa2[2], ag[2];
#pragma unroll
            for (int i = 0; i < 2; i++) {
                aw[i] = f32x4{0.f, 0.f, 0.f, 0.f}; aa2[i] = aw[i]; ag[i] = aw[i];
#pragma unroll
                for (int ks = 0; ks < 2; ks++) {
                    aw[i] = __builtin_amdgcn_mfma_f32_16x16x32_bf16(xa_[ks], wb[i][ks], aw[i], 0, 0, 0);
                    aa2[i] = __builtin_amdgcn_mfma_f32_16x16x32_bf16(xa_[2 + ks], ab[i][ks], aa2[i], 0, 0, 0);
                }
#pragma unroll
                for (int ks = 0; ks < 4; ks++) ag[i] = __builtin_amdgcn_mfma_f32_16x16x32_bf16(xa_[4 + ks], gb[i][ks], ag[i], 0, 0, 0);
            }
#pragma unroll
            for (int i = 0; i < 2; i++)
#pragma unroll
                for (int r = 0; r < 4; r++) {
                    const int t = mt * 16 + qq * 4 + r, cc = (nt0 + i) * 16 + kr;
                    const float wl = w0c[i] + aw[i][r];
                    const float z = -wl;
                    const float sp = fmaxf(z, 0.f) + 0.6931471805599453f * __builtin_amdgcn_logf(1.f + __expf(-fabsf(z)));
                    LW[t * 64 + cc] = -__expf(-sp - 0.5f);
                    LA[t * 64 + cc] = sigmoidf_(a0c[i] + aa2[i][r]);
                    p.ob[(n0 + t) * 512 + h * 64 + cc] = f2bf(ag[i][r]);
                }
        }
        LDS_BARRIER();
        CH_TE(1) CH_TS(2)
        {
            RW_IDX
            const int ch = h * 64 + lane;
            const float mur = hc_[0], muk = hc_[1], muv = hc_[2];
            const float kkw = hc_[3], kaw = hc_[4], rkw = hc_[5];
            float rr[8], k2[8], vv[8], kkn[8], aa[8], lg[8], cs[8];
            float run = 0.f;
#pragma unroll
            for (int i = 0; i < 8; i++) {
                const int t = wv * 8 + i; const size_t n = n0 + t;
                float r = bf2f(rc[i][0]), k = bf2f(rc[i][1]), v = bf2f(rc[i][2]);
                const float pr = bf2f(i ? rc[i - 1][0] : rp0[0]), pk = bf2f(i ? rc[i - 1][1] : rp0[1]), pv = bf2f(i ? rc[i - 1][2] : rp0[2]);
                r = r + (pr - r) * mur; k = k + (pk - k) * muk; v = v + (pv - v) * muv;
                const float a = LA[t * 64 + lane];
                lg[i] = LW[t * 64 + lane];
                float kk = k * kkw;
                kkn[i] = kk * __builtin_amdgcn_rsqf(fmaxf(wave_sum(kk * kk), 1e-24f));
                k2[i] = k * (1.f + (a - 1.f) * kaw);
                const float bon = wave_sum(r * k2[i] * rkw);
                if (lane == 0) p.bon[n * 8 + h] = bon;
                rr[i] = r; vv[i] = v; aa[i] = a;
                run += lg[i]; cs[i] = run;
            }
            tot[wv * 64 + lane] = run;
            LDS_BARRIER();
            float off = 0.f, cumL = 0.f;
#pragma unroll
            for (int w2 = 0; w2 < 8; w2++) { const float tv = tot[w2 * 64 + lane]; cumL += tv; if (w2 < wv) off += tv; }
            if (wv == 0) gl[lane] = __expf(cumL);
            unsigned pa[4], pb[4], pk4[4], pv4[4];
#pragma unroll
            for (int i = 0; i < 8; i += 2) {
                float at[2], bt[2], kt[2], rt[2];
#pragma unroll
                for (int e2 = 0; e2 < 2; e2++) {
                    const int ii = i + e2; const int t = wv * 8 + ii;
                    const float cm = off + cs[ii];
                    const float g = __expf(cm), gp = __expf(cm - lg[ii]), gi = __expf(-cm);
                    at[e2] = -kkn[ii] * gp; bt[e2] = kkn[ii] * aa[ii] * gi; kt[e2] = k2[ii] * gi; rt[e2] = rr[ii] * g;
                    sl[0 * RSLOT + t * RS + lane] = f2bf(at[e2]);
                    sl[1 * RSLOT + t * RS + lane] = f2bf(bt[e2]);
                    sl[2 * RSLOT + t * RS + lane] = f2bf(kt[e2]);
                    sl[3 * RSLOT + t * RS + lane] = f2bf(rt[e2]);
                }
                pa[i >> 1] = pack2(at[0], at[1]); pb[i >> 1] = pack2(bt[0], bt[1]);
                pk4[i >> 1] = pack2(kt[0], kt[1]); pv4[i >> 1] = pack2(vv[i], vv[i + 1]);
            }
            *(uint4*)&sl[4 * RSLOT + lane * RS + wv * 8] = make_uint4(pa[0], pa[1], pa[2], pa[3]);
            *(uint4*)&sl[5 * RSLOT + lane * RS + wv * 8] = make_uint4(pb[0], pb[1], pb[2], pb[3]);
            *(uint4*)&sl[6 * RSLOT + lane * RS + wv * 8] = make_uint4(pk4[0], pk4[1], pk4[2], pk4[3]);
            *(uint4*)&sl[7 * RSLOT + lane * RS + wv * 8] = make_uint4(pv4[0], pv4[1], pv4[2], pv4[3]);
        }
        LDS_BARRIER();
        if (h + 1 < 8) { asm volatile("s_waitcnt vmcnt(0)" ::: "memory");
                         S1_LOADW(h + 1) S2_LOADX(h + 1) }
        CH_TE(2) CH_TS(3)
        {
            RW_IDX
            f32x4 acc[2];
            ZACC(acc); mm64(sl + 1 * RSLOT, RS, sl + 0 * RSLOT, RS, acc, lane, wv);
#pragma unroll
            for (int i = 0; i < 2; i++) {
                f32x4 pm;
#pragma unroll
                for (int r = 0; r < 4; r++) {
                    const int m = mt * 16 + qq * 4 + r, n = (nt0 + i) * 16 + kr;
                    if (!(m < n)) acc[i][r] = 0.f;
                    pm[r] = acc[i][r] + ((m == n) ? 1.f : 0.f);
                }
                st_t(sl + 8 * RSLOT, RS, acc[i], mt, nt0 + i, lane);
                st_n(sl + 9 * RSLOT, RS, acc[i], mt, nt0 + i, lane);
                st_t(sl + 13 * RSLOT, RS, pm, mt, nt0 + i, lane);
            }
            ZACC(acc); mm64(sl + 0 * RSLOT, RS, sl + 2 * RSLOT, RS, acc, lane, wv);
#pragma unroll
            for (int i = 0; i < 2; i++) {
#pragma unroll
                for (int r = 0; r < 4; r++) { const int m = mt * 16 + qq * 4 + r, n = (nt0 + i) * 16 + kr; if (!(m > n)) acc[i][r] = 0.f; }
                st_t(sl + 10 * RSLOT, RS, acc[i], mt, nt0 + i, lane);
            }
            ZACC(acc); mm64(sl + 1 * RSLOT, RS, sl + 3 * RSLOT, RS, acc, lane, wv);
#pragma unroll
            for (int i = 0; i < 2; i++) {
#pragma unroll
                for (int r = 0; r < 4; r++) { const int m = mt * 16 + qq * 4 + r, n = (nt0 + i) * 16 + kr; if (m > n) acc[i][r] = 0.f; }
                st_t(sl + 11 * RSLOT, RS, acc[i], mt, nt0 + i, lane);
            }
            ZACC(acc); mm64(sl + 2 * RSLOT, RS, sl + 3 * RSLOT, RS, acc, lane, wv);
#pragma unroll
            for (int i = 0; i < 2; i++) {
#pragma unroll
                for (int r = 0; r < 4; r++) { const int m = mt * 16 + qq * 4 + r, n = (nt0 + i) * 16 + kr; if (m > n) acc[i][r] = 0.f; }
                st_t(sl + 12 * RSLOT, RS, acc[i], mt, nt0 + i, lane);
            }
        }
        LDS_BARRIER();
        CH_TE(3) CH_TS(4)
        u16* X = sl + 8 * RSLOT; u16* XT = sl + 9 * RSLOT; u16* X2 = sl + 0 * RSLOT; u16* X2T = sl + 1 * RSLOT;
        u16* Pc = sl + 13 * RSLOT; u16* Pn = sl + 2 * RSLOT;
#pragma unroll 1
        for (int j = 1; j <= 6; j++) {
            RW_IDX
            f32x4 acc[2];
            if (j <= 5) {
                ZACC(acc); mm64(X, RS, XT, RS, acc, lane, wv);
#pragma unroll
                for (int i = 0; i < 2; i++) { st_t(X2T, RS, acc[i], mt, nt0 + i, lane); st_n(X2, RS, acc[i], mt, nt0 + i, lane); }
            }
            if (j >= 2) {
                ZACC(acc); mm64(XT, RS, Pc, RS, acc, lane, wv);
#pragma unroll
                for (int i = 0; i < 2; i++) {
                    const uint2 pv = *(const uint2*)&Pc[((nt0 + i) * 16 + kr) * RS + mt * 16 + qq * 4];
                    acc[i][0] += __uint_as_float(pv.x << 16); acc[i][1] += __uint_as_float(pv.x & 0xFFFF0000u);
                    acc[i][2] += __uint_as_float(pv.y << 16); acc[i][3] += __uint_as_float(pv.y & 0xFFFF0000u);
                    st_t(Pn, RS, acc[i], mt, nt0 + i, lane);
                }
            }
            LDS_BARRIER();
            if (j >= 2) { u16* tp = Pc; Pc = Pn; Pn = tp; }
            if (j <= 5) { u16* tx = X; X = X2; X2 = tx; tx = XT; XT = X2T; X2T = tx; }
        }
        CH_TE(4) CH_TS(5)
        u16* TT = Pc;
        {
            RW_IDX
            f32x4 acc[2];
            ZACC(acc); mm64(TT, RS, sl + 4 * RSLOT, RS, acc, lane, wv);
#pragma unroll
            for (int i = 0; i < 2; i++) st_t(sl + 0 * RSLOT, RS, acc[i], mt, nt0 + i, lane);
            ZACC(acc); mm64(sl + 10 * RSLOT, RS, TT, RS, acc, lane, wv);
#pragma unroll
            for (int i = 0; i < 2; i++) st_t(sl + 8 * RSLOT, RS, acc[i], mt, nt0 + i, lane);
        }
        LDS_BARRIER();
        {
            RW_IDX
            f32x4 acc[2];
            ZACC(acc); mm64(sl + 8 * RSLOT, RS, sl + 7 * RSLOT, RS, acc, lane, wv);
#pragma unroll
            for (int i = 0; i < 2; i++) st_t(sl + 9 * RSLOT, RS, acc[i], mt, nt0 + i, lane);
            ZACC(acc); mm64(sl + 0 * RSLOT, RS, sl + 5 * RSLOT, RS, acc, lane, wv);
#pragma unroll
            for (int i = 0; i < 2; i++) {
                const int n = (nt0 + i) * 16 + kr; const float gn = gl[n];
#pragma unroll
                for (int r = 0; r < 4; r++) { const int m = mt * 16 + qq * 4 + r; acc[i][r] = acc[i][r] * gn + ((m == n) ? gn : 0.f); }
                st_t(cd, 64, acc[i], mt, nt0 + i, lane);
            }
            ZACC(acc); mm64(sl + 0 * RSLOT, RS, sl + 11 * RSLOT, RS, acc, lane, wv);
#pragma unroll
            for (int i = 0; i < 2; i++) {
                const uint2 rv = *(const uint2*)&sl[3 * RSLOT + ((nt0 + i) * 16 + kr) * RS + mt * 16 + qq * 4];
                acc[i][0] += __uint_as_float(rv.x << 16); acc[i][1] += __uint_as_float(rv.x & 0xFFFF0000u);
                acc[i][2] += __uint_as_float(rv.y << 16); acc[i][3] += __uint_as_float(rv.y & 0xFFFF0000u);
                st_t(cd + 2 * 4096, 64, acc[i], mt, nt0 + i, lane);
            }
        }
        LDS_BARRIER();
        {
            RW_IDX
            f32x4 acc[2];
            ZACC(acc);
            mm64(sl + 5 * RSLOT, RS, sl + 9 * RSLOT, RS, acc, lane, wv);
            mm64(sl + 6 * RSLOT, RS, sl + 7 * RSLOT, RS, acc, lane, wv);
#pragma unroll
            for (int i = 0; i < 2; i++) {
#pragma unroll
                for (int r = 0; r < 4; r++) acc[i][r] *= gl[mt * 16 + qq * 4 + r];
                st_t(cd + 1 * 4096, 64, acc[i], mt, nt0 + i, lane);
            }
            ZACC(acc);
            mm64(sl + 9 * RSLOT, RS, sl + 11 * RSLOT, RS, acc, lane, wv);
            mm64(sl + 7 * RSLOT, RS, sl + 12 * RSLOT, RS, acc, lane, wv);
#pragma unroll
            for (int i = 0; i < 2; i++) st_t(cd + 3 * 4096, 64, acc[i], mt, nt0 + i, lane);
        }
        CH_TE(5)
      }
    }
    if (CHPROBE) { __syncthreads(); const unsigned long long t1_ = __builtin_amdgcn_s_memrealtime(); while (__builtin_amdgcn_s_memrealtime() - t1_ < ctacc_) __builtin_amdgcn_s_sleep(8); }
}

__device__ void ph_rwkv_seq(const P& p, int bid, int nb, char* smem) {
    u16* SL = (u16*)smem;
    const int tid = get_tid(), lane = tid & 63, wv = __builtin_amdgcn_readfirstlane(tid >> 6);
    const int kr = lane & 15, qq = lane >> 4, chn = wv >> 2, vt = wv & 3;
    for (int pair = bid; pair < B_ * 4; pair += nb) {
        const int bh = pair * 2 + chn;
        u16* mySL = SL + chn * RSLOT;
        __syncthreads();
#pragma unroll
        for (int ks = 0; ks < 2; ks++) *(uint4*)&mySL[(vt * 16 + kr) * RS + ks * 32 + qq * 8] = make_uint4(0u, 0u, 0u, 0u);
        u16* cbase = p.cdat + (size_t)bh * 128 * 4 * 4096;
        bf16x8 GA0[4][2], GA1[4][2], GA2[4][2], GA3[4][2]; u32x2 H0[4], H1[4], H2[4], H3[4];
#define SEQ_LD(GAx, Hx, c) { const u16* g0_ = cbase + (size_t)(c) * 4 * 4096 + kr * 64 + qq * 8; const u16* g1_ = g0_ + 2048; \
            const u16* hp_ = cbase + (size_t)(c) * 4 * 4096 + 4096 + (vt * 16 + kr) * 64 + qq * 4; \
            GAx[0][0] = gload_b128<0>(g0_); GAx[0][1] = gload_b128<64>(g0_); GAx[1][0] = gload_b128<2048>(g0_); GAx[1][1] = gload_b128<2112>(g0_); \
            GAx[2][0] = gload_b128<0>(g1_); GAx[2][1] = gload_b128<64>(g1_); GAx[3][0] = gload_b128<2048>(g1_); GAx[3][1] = gload_b128<2112>(g1_); \
            Hx[0] = gload_b64<0>(hp_); Hx[1] = gload_b64<32>(hp_); Hx[2] = gload_b64<64>(hp_); Hx[3] = gload_b64<96>(hp_); }
#define SEQ_STEP(GAx, Hx, c, nw) { \
            if ((nw) == 48) asm volatile("s_waitcnt vmcnt(48)" ::: "memory"); else if ((nw) == 36) asm volatile("s_waitcnt vmcnt(36)" ::: "memory"); \
            else if ((nw) == 24) asm volatile("s_waitcnt vmcnt(24)" ::: "memory"); else asm volatile("s_waitcnt vmcnt(12)" ::: "memory"); \
              \
            asm volatile("" : "+v"(GAx[0][0]), "+v"(GAx[0][1]), "+v"(GAx[1][0]), "+v"(GAx[1][1]), "+v"(GAx[2][0]), "+v"(GAx[2][1]), "+v"(GAx[3][0]), "+v"(GAx[3][1]), \
                              "+v"(Hx[0]), "+v"(Hx[1]), "+v"(Hx[2]), "+v"(Hx[3]) :: "memory"); \
            bf16x8 Z0[2]; \
            _Pragma("unroll") for (int ks = 0; ks < 2; ks++) Z0[ks] = *(const bf16x8*)&mySL[(vt * 16 + kr) * RS + ks * 32 + qq * 8]; \
            f32x4 zs[4]; \
            _Pragma("unroll") for (int m4 = 0; m4 < 4; m4++) { \
                zs[m4] = unpack4(make_uint2(Hx[m4].x, Hx[m4].y)); \
                _Pragma("unroll") for (int ks = 0; ks < 2; ks++) zs[m4] = __builtin_amdgcn_mfma_f32_16x16x32_bf16(GAx[m4][ks], Z0[ks], zs[m4], 0, 0, 0); } \
            u16* sn_ = cbase + (size_t)(c) * 4 * 4096 + 1 * 4096 + (vt * 16 + kr) * 64 + qq * 4; \
            _Pragma("unroll") for (int m4 = 0; m4 < 4; m4++) { \
                const uint2 pk_ = pack4(zs[m4]); \
                *(uint2*)&mySL[(vt * 16 + kr) * RS + m4 * 16 + qq * 4] = pk_; \
                *(uint2*)&sn_[m4 * 16] = pk_; } \
            asm volatile("" ::: "memory"); \
            if ((c) + 4 < 128) SEQ_LD(GAx, Hx, (c) + 4) }
        asm volatile("s_waitcnt vmcnt(0)" ::: "memory");
        SEQ_LD(GA0, H0, 0) SEQ_LD(GA1, H1, 1) SEQ_LD(GA2, H2, 2) SEQ_LD(GA3, H3, 3)
#pragma unroll 1
        for (int c = 0; c < 128; c += 4) {
            const bool first = (c == 0), lastt = (c == 124);
            SEQ_STEP(GA0, H0, c, first ? 36 : 48)
            SEQ_STEP(GA1, H1, c + 1, (first || lastt) ? 36 : 48)
            SEQ_STEP(GA2, H2, c + 2, first ? 36 : (lastt ? 24 : 48))
            SEQ_STEP(GA3, H3, c + 3, lastt ? 12 : 48)
        }
        asm volatile("s_waitcnt vmcnt(0)" ::: "memory");
#undef SEQ_LD
#undef SEQ_STEP
    }
}

__device__ void ph_rwkv_out(const P& p, int bid, int nb, char* smem) {
    const int tid = get_tid(), lane = tid & 63, wv = tid >> 6;
    const int kr = lane & 15, qq = lane >> 4;
    for (int it = bid * NW + wv; it < B_ * 8 * 128; it += nb * NW) {
        const int c = it & 127, bh = it >> 7, b = bh >> 3, h = bh & 7;
        const u16* cd = p.cdat + ((size_t)bh * 128 + c) * 4 * 4096;
        f32x4 ys[4][4];
#pragma unroll
        for (int mt = 0; mt < 4; mt++)
#pragma unroll
            for (int nt = 0; nt < 4; nt++) ys[mt][nt] = unpack4(*(const uint2*)&cd[3 * 4096 + (nt * 16 + kr) * 64 + mt * 16 + qq * 4]);
        if (c > 0) {
            const u16* s0 = cd - 4 * 4096 + 1 * 4096;
#pragma unroll
            for (int ks = 0; ks < 2; ks++) {
                bf16x8 af[4], bq[4];
#pragma unroll
                for (int mt = 0; mt < 4; mt++) af[mt] = *(const bf16x8*)&s0[(mt * 16 + kr) * 64 + ks * 32 + qq * 8];
#pragma unroll
                for (int nt = 0; nt < 4; nt++) bq[nt] = *(const bf16x8*)&cd[2 * 4096 + (nt * 16 + kr) * 64 + ks * 32 + qq * 8];
#pragma unroll
                for (int mt = 0; mt < 4; mt++)
#pragma unroll
                    for (int nt = 0; nt < 4; nt++) ys[mt][nt] = __builtin_amdgcn_mfma_f32_16x16x32_bf16(af[mt], bq[nt], ys[mt][nt], 0, 0, 0);
            }
        }
        float4 lwv[4], lbv[4], mvv[4];
#pragma unroll
        for (int mt = 0; mt < 4; mt++) { const int vch = h * 64 + mt * 16 + qq * 4; lwv[mt] = *(const float4*)&p.ln_w[vch]; lbv[mt] = *(const float4*)&p.ln_b[vch]; mvv[mt] = *(const float4*)&p.mu[1024 + vch]; }
        uint2 vcu[2][4], vpu[2][4], ggu[2][4]; float bonv[2];
#define P12_LOAD(nt_, bf_) { const int t_ = (nt_) * 16 + kr; const size_t n_ = (size_t)b * S_ + c * 64 + t_; bonv[bf_] = p.bon[n_ * 8 + h]; \
            _Pragma("unroll") for (int mt = 0; mt < 4; mt++) { const int vch = h * 64 + mt * 16 + qq * 4; \
                vcu[bf_][mt] = *(const uint2*)&p.prw[n_ * CRW + 1024 + vch]; \
                vpu[bf_][mt] = make_uint2(0u, 0u); if (c * 64 + t_ > 0) vpu[bf_][mt] = *(const uint2*)&p.prw[(n_ - 1) * CRW + 1024 + vch]; \
                ggu[bf_][mt] = *(const uint2*)&p.ob[n_ * 512 + vch]; } }
        P12_LOAD(0, 0)
#pragma unroll
        for (int nt = 0; nt < 4; nt++) {
            float s1 = 0.f, s2 = 0.f;
#pragma unroll
            for (int mt = 0; mt < 4; mt++)
#pragma unroll
                for (int r = 0; r < 4; r++) { s1 += ys[mt][nt][r]; s2 += ys[mt][nt][r] * ys[mt][nt][r]; }
            s1 = xrow_sum(s1); s2 = xrow_sum(s2);
            const float mean = s1 * (1.f / 64.f);
            const float var = fmaxf(s2 * (1.f / 64.f) - mean * mean, 0.f);
            const float rstd = rsqrtf(var + 64e-5f);
            const int t = nt * 16 + kr;
            const size_t n = (size_t)b * S_ + c * 64 + t;
            if (nt + 1 < 4) P12_LOAD(nt + 1, (nt + 1) & 1)
            const float bon = bonv[nt & 1];
#pragma unroll
            for (int mt = 0; mt < 4; mt++) {
                const int vch = h * 64 + mt * 16 + qq * 4;
                const f32x4 vcf = unpack4(vcu[nt & 1][mt]);
                const f32x4 vpf = unpack4(vpu[nt & 1][mt]);
                const f32x4 ggf = unpack4(ggu[nt & 1][mt]);
                const float lwa[4] = {lwv[mt].x, lwv[mt].y, lwv[mt].z, lwv[mt].w}, lba[4] = {lbv[mt].x, lbv[mt].y, lbv[mt].z, lbv[mt].w}, mva[4] = {mvv[mt].x, mvv[mt].y, mvv[mt].z, mvv[mt].w};
                f32x4 o;
#pragma unroll
                for (int r = 0; r < 4; r++) {
                    const float vsh = vcf[r] + (vpf[r] - vcf[r]) * mva[r];
                    o[r] = ((ys[mt][nt][r] - mean) * rstd * lwa[r] + lba[r] + bon * vsh) * ggf[r];
                }
                *(uint2*)&p.ob[n * 512 + vch] = pack4(o);
            }
        }
#undef P12_LOAD
    }
}

__device__ __forceinline__ void unpack8(const uint4& u, f32x4& a, f32x4& b) {
    a = f32x4{__uint_as_float(u.x << 16), __uint_as_float(u.x & 0xFFFF0000u), __uint_as_float(u.y << 16), __uint_as_float(u.y & 0xFFFF0000u)};
    b = f32x4{__uint_as_float(u.z << 16), __uint_as_float(u.z & 0xFFFF0000u), __uint_as_float(u.w << 16), __uint_as_float(u.w & 0xFFFF0000u)};
}
struct EpiMerge {
    u16* merged; u16* tmp2; int pass;
    __device__ __forceinline__ void operator()(const f32x4 (&acc)[2][2][4][2], const GUnit& u, int, int, int, int) const {
        const int t2_ = get_tid(), wid_ = __builtin_amdgcn_readfirstlane(t2_ >> 6), wr = wid_ >> 2, wc = wid_ & 3, fr = t2_ & 15, fq = (t2_ >> 4) & 3;
        const int row0 = u.pm * 256 + wr * 64 + fr;
        if (pass < 2) {
            u16* dst = pass ? tmp2 : merged;
            const int col0 = u.pn * 256 + wc * 32 + 8 * fq;
#pragma unroll
            for (int ai = 0; ai < 2; ++ai)
#pragma unroll
                for (int m = 0; m < 4; ++m) {
                    const size_t off = (size_t)(row0 + ai * 128 + m * 16) * D_ + col0;
#pragma unroll
                    for (int bj = 0; bj < 2; ++bj) *(uint4*)&dst[off + bj * 128] = pack8(acc[ai][bj][m][0], acc[ai][bj][m][1]);
                }
        } else {
            const int col0 = u.pn * 128 + wc * 32 + 8 * fq;
#pragma unroll
            for (int ai = 0; ai < 2; ++ai) {
                uint4 ma[4], mb[4];
#pragma unroll
                for (int m = 0; m < 4; ++m) {
                    const size_t off = (size_t)(row0 + ai * 128 + m * 16) * D_ + col0;
                    ma[m] = *(const uint4*)&merged[off]; mb[m] = *(const uint4*)&tmp2[off];
                }
#pragma unroll
                for (int m = 0; m < 4; ++m) {
                    const size_t off = (size_t)(row0 + ai * 128 + m * 16) * D_ + col0;
                    f32x4 a0, a1, b0, b1; unpack8(ma[m], a0, a1); unpack8(mb[m], b0, b1);
                    f32x4 v0, v1;
#pragma unroll
                    for (int r = 0; r < 4; r++) {
                        v0[r] = a0[r] * sigmoidf_(acc[ai][0][m][0][r]) + b0[r] * sigmoidf_(acc[ai][1][m][0][r]);
                        v1[r] = a1[r] * sigmoidf_(acc[ai][0][m][1][r]) + b1[r] * sigmoidf_(acc[ai][1][m][1][r]);
                    }
                    *(uint4*)&merged[off] = pack8(v0, v1);
                }
                asm volatile("" ::: "memory");
            }
        }
    }
};
struct MergeSched {
    __device__ __forceinline__ void signal(const GUnit&) const {}
    DenseSched d; bool split;
    __device__ __forceinline__ bool next(int i, GUnit& u) const {
        if (!split) return d.next(i, u);
        if (!d.next(i >> 1, u)) return false;
        u.pn = 2 * u.pn + (i & 1); return true;
    }
    __device__ __forceinline__ unsigned a_off(const GUnit& u, int h, int R) const { return d.a_off(u, h, R); }
    __device__ __forceinline__ const char* b_ptr(const GUnit& u) const { return d.b_ptr(u); }
};
__device__ void ph_merge(const P& p, int bid, int nb, char* smem) {
    u16* tmp2 = (u16*)p.x1;
#pragma unroll 1
    for (int pass = 0; pass < 3; ++pass) {
        const int K = (pass == 2) ? D_ : 512;
        const u16* A = (pass == 2) ? p.hbuf : (pass == 0 ? p.oa : p.ob);
        const u16* Bt = (pass == 0) ? p.wpaT : (pass == 1 ? p.wpbT : p.wgT);
        MergeSched S; S.d.init(NTOK, D_, K, Bt, nb, bid); S.split = (pass == 2);
        EpiMerge E{p.merged, tmp2, pass};
        gemm256(smem, (const char*)A, K, S, E);
    }
}

struct EpiOutproj {
    const float* x; float* x1;
    __device__ __forceinline__ void operator()(const f32x4 (&acc)[2][2][4][2], const GUnit& u, int, int, int, int) const {
        const int t2_ = get_tid(), wid_ = __builtin_amdgcn_readfirstlane(t2_ >> 6), wr = wid_ >> 2, wc = wid_ & 3, fr = t2_ & 15, fq = (t2_ >> 4) & 3;
        const int row0 = u.pm * 256 + wr * 64 + fr, col0 = u.pn * 256 + wc * 32 + 4 * fq;
#pragma unroll
        for (int ai = 0; ai < 2; ++ai) {
            f32x4 xin[4][2][2];
#pragma unroll
            for (int m = 0; m < 4; ++m) {
                const size_t off = (size_t)(row0 + ai * 128 + m * 16) * D_ + col0;
#pragma unroll
                for (int bj = 0; bj < 2; ++bj)
#pragma unroll
                    for (int n = 0; n < 2; ++n) xin[m][bj][n] = *(const f32x4*)&x[off + bj * 128 + n * 16];
            }
#pragma unroll
            for (int m = 0; m < 4; ++m) {
                const size_t off = (size_t)(row0 + ai * 128 + m * 16) * D_ + col0;
#pragma unroll
                for (int bj = 0; bj < 2; ++bj)
#pragma unroll
                    for (int n = 0; n < 2; ++n) *(f32x4*)&x1[off + bj * 128 + n * 16] = xin[m][bj][n] + acc[ai][bj][m][n];
            }
            asm volatile("" ::: "memory");
        }
    }
};
__device__ void ph_outproj(const P& p, int bid, int nb, char* smem) {
    DenseSched S; S.init(NTOK, D_, D_, p.woutT, nb, bid);
    EpiOutproj E{p.x, p.x1};
    gemm256(smem, (const char*)p.merged, D_, S, E);
}

__device__ __forceinline__ float red8f(float x) {
    x += dppf<0xB1>(x);
    x += dppf<0x4E>(x);
    x += dppf<0x141>(x);
    return x;
}
__device__ void ph_route(const P& p, int bid, int nb, char* smem) {
    float* wr = (float*)smem;
    const int tid = get_tid(), lane = tid & 63, wv = tid >> 6;
    {
        u16* Tl = (u16*)smem;
        const int t = get_tid();
        const int lrow = t >> 3, lc8 = (t & 7) * 8;
        const int sslot = t >> 3, skc = t & 7;
        const int scol = (sslot & 32) + perm32(sslot & 31);
        constexpr int NT13 = NEXP * 2 * 4 * 16, NT2 = NEXP * 16 * 4;
        auto tsrc = [&](int tile, int& N) -> const float* {
            if (tile < NT13) {
                const int kt = tile & 15, sg = (tile >> 4) & 3, half = (tile >> 6) & 1, e = tile >> 7;
                const int sl0 = sg * 64;
                N = 256;
                return ((sl0 >> 7) ? p.e_w3 : p.e_w1) + (size_t)e * D_ * 256 + (size_t)(kt * 64) * 256 + half * 128 + (sl0 & 127);
            }
            const int t2 = tile - NT13;
            const int kt = t2 & 3, sg = (t2 >> 2) & 15, e = t2 >> 6;
            N = D_;
            return p.e_w2 + (size_t)e * 256 * D_ + (size_t)(kt * 64) * D_ + sg * 64;
        };
        float4 f0 = make_float4(0.f, 0.f, 0.f, 0.f), f1 = f0;
        if (bid < NT13 + NT2) { int N; const float* src = tsrc(bid, N); f0 = *(const float4*)&src[(size_t)lrow * N + lc8]; f1 = *(const float4*)&src[(size_t)lrow * N + lc8 + 4]; }
        for (int tile = bid; tile < NT13 + NT2; tile += nb) {
            u16* dst; int Kd;
            if (tile < NT13) {
                const int kt = tile & 15, sg = (tile >> 4) & 3, half = (tile >> 6) & 1, e = tile >> 7;
                Kd = D_; dst = p.ew1T + ((size_t)e * 512 + half * 256 + sg * 64) * D_ + kt * 64;
            } else {
                const int t2 = tile - NT13;
                const int kt = t2 & 3, sg = (t2 >> 2) & 15, e = t2 >> 6;
                Kd = 256; dst = p.ew2T + ((size_t)e * D_ + sg * 64) * 256 + kt * 64;
            }
            float4 g0 = f0, g1 = f1;
            if (tile + nb < NT13 + NT2) { int N; const float* src = tsrc(tile + nb, N); g0 = *(const float4*)&src[(size_t)lrow * N + lc8]; g1 = *(const float4*)&src[(size_t)lrow * N + lc8 + 4]; }
            __syncthreads();
            const unsigned h0 = pack2(f0.x, f0.y), h1 = pack2(f0.z, f0.w), h2 = pack2(f1.x, f1.y), h3 = pack2(f1.z, f1.w);
            Tl[(lc8 + 0) * 72 + lrow] = (u16)(h0 & 0xFFFFu); Tl[(lc8 + 1) * 72 + lrow] = (u16)(h0 >> 16);
            Tl[(lc8 + 2) * 72 + lrow] = (u16)(h1 & 0xFFFFu); Tl[(lc8 + 3) * 72 + lrow] = (u16)(h1 >> 16);
            Tl[(lc8 + 4) * 72 + lrow] = (u16)(h2 & 0xFFFFu); Tl[(lc8 + 5) * 72 + lrow] = (u16)(h2 >> 16);
            Tl[(lc8 + 6) * 72 + lrow] = (u16)(h3 & 0xFFFFu); Tl[(lc8 + 7) * 72 + lrow] = (u16)(h3 >> 16);
            __syncthreads();
            *(uint4*)&dst[(size_t)sslot * Kd + skc * 8] = *(const uint4*)&Tl[scol * 72 + skc * 8];
            f0 = g0; f1 = g1;
        }
        __syncthreads();
    }
    for (int i = tid; i < 1024 * 36; i += NT) {
        const int k = i / 36, j = i - k * 36;
        const int kp = (k & ~31) + ((k & 3) << 3) + ((k >> 2) & 7);
        wr[kp * 36 + j] = (j < 4) ? p.w_grp[k * 4 + j] : p.w_exp[k * 32 + (j - 4)];
    }
    int* lcount = (int*)(smem + 1024 * 36 * 4);
    if (tid < 32) lcount[tid] = 0;
    __syncthreads();
    const int sub = lane & 7, tk = lane >> 3;
    for (int n0 = (bid * NW + wv) * 16; n0 < NTOK; n0 += nb * NW * 16) {
        float acc[2][36]; float ss[2] = {0.f, 0.f};
#pragma unroll
        for (int t = 0; t < 2; t++)
#pragma unroll
            for (int j = 0; j < 36; j++) acc[t][j] = 0.f;
#pragma unroll 1
        for (int i0 = 0; i0 < 32; i0 += 4) {
            float4 xv[2][4];
#pragma unroll
            for (int t = 0; t < 2; t++)
#pragma unroll
                for (int i = 0; i < 4; i++) xv[t][i] = *(const float4*)&p.x1[(size_t)(n0 + 8 * t + tk) * D_ + (i0 + i) * 32 + sub * 4];
#pragma unroll
            for (int i = 0; i < 4; i++) {
                const int k0 = (i0 + i) * 32 + sub * 4;
                const float4 gf = *(const float4*)&p.g_ffn[k0];
                float hv[2][4];
#pragma unroll
                for (int t = 0; t < 2; t++) {
                    const float4 x = xv[t][i];
                    ss[t] += x.x * x.x + x.y * x.y + x.z * x.z + x.w * x.w;
                    hv[t][0] = x.x * gf.x; hv[t][1] = x.y * gf.y; hv[t][2] = x.z * gf.z; hv[t][3] = x.w * gf.w;
                    uint2 o; o.x = pack2(hv[t][0], hv[t][1]); o.y = pack2(hv[t][2], hv[t][3]);
                    *(uint2*)&p.hbuf[(size_t)(n0 + 8 * t + tk) * D_ + k0] = o;
                }
#pragma unroll
                for (int e2 = 0; e2 < 4; e2++) {
                    asm volatile("" ::: "memory");
                    const float* wrow = wr + ((i0 + i) * 32 + e2 * 8 + sub) * 36;
#pragma unroll
                    for (int j4 = 0; j4 < 9; j4++) {
                        const float4 wv4 = *(const float4*)&wrow[j4 * 4];
#pragma unroll
                        for (int t = 0; t < 2; t++) {
                            acc[t][j4 * 4 + 0] += hv[t][e2] * wv4.x; acc[t][j4 * 4 + 1] += hv[t][e2] * wv4.y;
                            acc[t][j4 * 4 + 2] += hv[t][e2] * wv4.z; acc[t][j4 * 4 + 3] += hv[t][e2] * wv4.w;
                        }
                    }
                }
            }
        }
#pragma unroll
        for (int t = 0; t < 2; t++) {
            const size_t n = (size_t)n0 + 8 * t + tk;
            const float sst = red8f(ss[t]);
#pragma unroll
            for (int j = 0; j < 36; j++) acc[t][j] = red8f(acc[t][j]);
            const float rs = rsqrtf(sst * (1.f / D_) + 1e-6f);
            if (sub == 0) {
                p.rsb[n] = rs;
                float gl[4]; int gs = 0;
#pragma unroll
                for (int j = 0; j < 4; j++) gl[j] = acc[t][j] * rs + p.b_grp[j];
                float gm = gl[0];
#pragma unroll
                for (int j = 1; j < 4; j++) if (gl[j] > gm) { gm = gl[j]; gs = j; }
                float gsum = 0.f;
#pragma unroll
                for (int j = 0; j < 4; j++) gsum += __expf(gl[j] - gm);
                const float pg = 1.f / gsum;
                float el[8]; float em = -3.0e38f;
#pragma unroll
                for (int j = 0; j < 8; j++) {
                    float a = (gs == 0) ? acc[t][4 + j] : ((gs == 1) ? acc[t][12 + j] : ((gs == 2) ? acc[t][20 + j] : acc[t][28 + j]));
                    a = a * rs + p.b_exp[gs * 8 + j];
                    el[j] = a; em = fmaxf(em, a);
                }
                int j0 = 0, j1 = -1; float v0 = -3.0e38f, v1 = -3.0e38f;
#pragma unroll
                for (int j = 0; j < 8; j++) { el[j] = __expf(el[j] - em); }
#pragma unroll
                for (int j = 0; j < 8; j++) { if (el[j] > v0) { v0 = el[j]; j0 = j; } }
#pragma unroll
                for (int j = 0; j < 8; j++) { if (j != j0 && el[j] > v1) { v1 = el[j]; j1 = j; } }
                const float den = v0 + v1;
                const int e0 = gs * 8 + j0, e1 = gs * 8 + j1;
                p.tok_e[n * 2] = e0; p.tok_e[n * 2 + 1] = e1;
                p.tok_gate[n * 2] = pg * v0 / den; p.tok_gate[n * 2 + 1] = pg * v1 / den;
                atomicAdd(&lcount[e0], 1); atomicAdd(&lcount[e1], 1);
            }
        }
    }
    __syncthreads();
    { const int t2 = get_tid(); if (t2 < 32) { const int c = lcount[t2]; if (c) atomicAdd(&p.counts[t2], c); } }
}

__device__ void ph_scatter(const P& p, int bid, int nb, char* smem) {
    int* offl = (int*)smem;
    int* hist = offl + 64;
    int* gbase = hist + 32;
    int* cntl = gbase + 32;
    int* bofl = cntl + 32;
    const int tid = get_tid();
    if (tid < 32) cntl[tid] = p.counts[tid];
    __syncthreads();
    if (tid < 32) {
        int off = 0, bo = 0;
#pragma unroll
        for (int j = 0; j < 32; j++) { const int c = cntl[j]; if (j < tid) { off += c; bo += (c + 255) >> 8; } }
        offl[tid] = off; bofl[tid] = bo;
        if (tid == 31) { offl[32] = off + cntl[31]; bofl[32] = bo + ((cntl[31] + 255) >> 8); }
    }
    __syncthreads();
    if (bid == 0 && tid < 32) {
        const int e = tid, c = cntl[e], off = offl[e]; int nb_ = bofl[e];
        p.offs[e] = off;
        for (int r = 0; r < c; r += 256) { p.blk_e[nb_] = e; p.blk_r0[nb_] = off + r; nb_++; }
        if (e == 0) { p.offs[NEXP] = offl[NEXP]; *p.nblk = bofl[NEXP]; }
    }
    for (int base = bid * NT; base < NTOK * 2; base += nb * NT) {
        __syncthreads();
        if (tid < 32) hist[tid] = 0;
        __syncthreads();
        const int i = base + tid;
        const int e = p.tok_e[i];
        const float tg_ = p.tok_gate[i];
        const int rl = atomicAdd(&hist[e], 1);
        __syncthreads();
        if (tid < 32) gbase[tid] = atomicAdd(&p.cursor[tid], hist[tid]);
        __syncthreads();
        const int slot = offl[e] + gbase[e] + rl;
        p.list_tok[slot] = i >> 1; p.list_gate[slot] = tg_; p.tokslot[i] = slot;
    }
}
template <int CTS, bool DEP, bool PROD>
struct MoeSched {
    const P* pp; int nunits, G, c; unsigned rowbytes; const u16* Bt; size_t b_estride, b_tstride;
    bool gather; int R;
    __device__ __forceinline__ bool next(int i, GUnit& u) const {
        const int k = i + ((c < R) ? 2 : 0);
        const int L = c + G * k - (k < 1 ? 1 : 2) * R; if (L >= nunits) return false;
        int wgid = L; { const int q = nunits >> 3, r = nunits & 7, xcd = wgid & 7, off = wgid >> 3; wgid = (xcd < r ? xcd * (q + 1) : r * (q + 1) + (xcd - r) * q) + off; }
        u.pm = wgid / CTS; u.pn = wgid & (CTS - 1);
        if (DEP) {
            unsigned* d = pp->mdone + u.pm; unsigned sp = 0u;
            while ((unsigned)__builtin_amdgcn_readfirstlane(__hip_atomic_load(d, __ATOMIC_RELAXED, __HIP_MEMORY_SCOPE_AGENT)) < 16u) { __builtin_amdgcn_s_sleep(1); if (++sp > (1u << 22)) break; }
            if (sp) { __builtin_amdgcn_s_sleep(127); __builtin_amdgcn_s_sleep(127); __builtin_amdgcn_s_sleep(127); }
            asm volatile("" ::: "memory");
        }
        return true;
    }
    __device__ __forceinline__ void signal(const GUnit& u) const {
        if (PROD) { if ((get_tid() & 63) == 0) __hip_atomic_fetch_add(pp->mdone + u.pm, 1u, __ATOMIC_RELAXED, __HIP_MEMORY_SCOPE_AGENT); }
    }
    __device__ __forceinline__ unsigned a_off(const GUnit& u, int h, int R_) const {
        const P& p = *pp;
        const int e = __builtin_amdgcn_readfirstlane(p.blk_e[u.pm]), rend = __builtin_amdgcn_readfirstlane(p.offs[e + 1]);
        int sl = __builtin_amdgcn_readfirstlane(p.blk_r0[u.pm]) + h * 128 + R_; if (sl >= rend) sl = rend - 1;
        return (unsigned)(gather ? p.list_tok[sl] : sl) * rowbytes;
    }
    __device__ __forceinline__ const char* b_ptr(const GUnit& u) const { return (const char*)(Bt + (size_t)__builtin_amdgcn_readfirstlane(pp->blk_e[u.pm]) * b_estride + (size_t)u.pn * b_tstride); }
};
struct EpiMoe1 {
    const P* pp;
    __device__ __forceinline__ void operator()(const f32x4 (&acc)[2][2][4][2], const GUnit& u, int, int, int, int) const {
        const int t2_ = get_tid(), wid_ = __builtin_amdgcn_readfirstlane(t2_ >> 6), wr = wid_ >> 2, wc = wid_ & 3, fr = t2_ & 15, fq = (t2_ >> 4) & 3;
        const P& p = *pp;
        const int e = __builtin_amdgcn_readfirstlane(p.blk_e[u.pm]), r0 = __builtin_amdgcn_readfirstlane(p.blk_r0[u.pm]), rend = __builtin_amdgcn_readfirstlane(p.offs[e + 1]);
        float rsv[2][4];
#pragma unroll
        for (int ai = 0; ai < 2; ++ai)
#pragma unroll
            for (int m = 0; m < 4; ++m) { int sl = r0 + ai * 128 + wr * 64 + m * 16 + fr; if (sl >= rend) sl = rend - 1; rsv[ai][m] = p.rsb[p.list_tok[sl]]; }
#pragma unroll
        for (int ai = 0; ai < 2; ++ai)
#pragma unroll
            for (int m = 0; m < 4; ++m) {
                const int sl = r0 + ai * 128 + wr * 64 + m * 16 + fr;
                if (sl < rend) {
                    const float rs = rsv[ai][m];
                    f32x4 v[2];
#pragma unroll
                    for (int n = 0; n < 2; ++n)
#pragma unroll
                        for (int r = 0; r < 4; r++) { const float a = acc[ai][0][m][n][r] * rs; v[n][r] = a * sigmoidf_(a) * (acc[ai][1][m][n][r] * rs); }
                    const uint4 pk = pack8(v[0], v[1]);
                    const u32x4 pv = {pk.x, pk.y, pk.z, pk.w};
                    asm volatile("global_store_dwordx4 %0, %1, off sc1\n\ts_nop 1" :: "v"(&p.hid[(size_t)sl * 256 + u.pn * 128 + wc * 32 + 8 * fq]), "v"(pv) : "memory");
                }
            }
    }
};
__device__ void ph_moe1(const P& p, int bid, int nb, char* smem) {
    MoeSched<2, false, true> S{&p, __builtin_amdgcn_readfirstlane(*p.nblk) * 2, nb, bid, (unsigned)(D_ * 2), p.ew1T, (size_t)512 * D_, (size_t)256 * D_, true, 0};
    EpiMoe1 E{&p};
    gemm256(smem, (const char*)p.hbuf, D_, S, E);
}
struct EpiMoe2 {
    const P* pp;
    __device__ __forceinline__ void operator()(const f32x4 (&acc)[2][2][4][2], const GUnit& u, int, int, int, int) const {
        const int t2_ = get_tid(), wid_ = __builtin_amdgcn_readfirstlane(t2_ >> 6), wr = wid_ >> 2, wc = wid_ & 3, fr = t2_ & 15, fq = (t2_ >> 4) & 3;
        const P& p = *pp;
        const int e = __builtin_amdgcn_readfirstlane(p.blk_e[u.pm]), r0 = __builtin_amdgcn_readfirstlane(p.blk_r0[u.pm]), rend = __builtin_amdgcn_readfirstlane(p.offs[e + 1]);
        float gtv[2][4];
#pragma unroll
        for (int ai = 0; ai < 2; ++ai)
#pragma unroll
            for (int m = 0; m < 4; ++m) { int sl = r0 + ai * 128 + wr * 64 + m * 16 + fr; if (sl >= rend) sl = rend - 1; gtv[ai][m] = p.list_gate[sl]; }
#pragma unroll
        for (int ai = 0; ai < 2; ++ai)
#pragma unroll
            for (int m = 0; m < 4; ++m) {
                const int sl = r0 + ai * 128 + wr * 64 + m * 16 + fr;
                if (sl < rend) {
                    const float gt = gtv[ai][m];
                    u16* yp = p.ybuf + (size_t)sl * D_ + u.pn * 256 + wc * 32 + 8 * fq;
#pragma unroll
                    for (int bj = 0; bj < 2; ++bj) *(uint4*)&yp[bj * 128] = pack8(acc[ai][bj][m][0] * gt, acc[ai][bj][m][1] * gt);
                }
            }
    }
};
__device__ void ph_moe2(const P& p, int bid, int nb, char* smem) {
    const int nblk = __builtin_amdgcn_readfirstlane(*p.nblk);
    MoeSched<4, true, false> S{&p, nblk * 4, nb, bid, 512u, p.ew2T, (size_t)D_ * 256, (size_t)256 * 256, false, (nblk * 2) % nb};
    EpiMoe2 E{&p};
    gemm256(smem, (const char*)p.hid, 256, S, E);
}
__device__ void ph_final(const P& p, int bid, int nb, char* smem) {
    const int tid = get_tid(), lane = tid & 63, wv = tid >> 6;
    int s0n = 0, s1n = 0;
    { const int r0_ = bid * NW + wv; if (r0_ < NTOK) { s0n = p.tokslot[r0_ * 2]; s1n = p.tokslot[r0_ * 2 + 1]; } }
    float4 gfin[4];
#pragma unroll
    for (int i = 0; i < 4; i++) gfin[i] = *(const float4*)&p.g_final[i * 256 + lane * 4];
    for (int row = bid * NW + wv; row < NTOK; row += nb * NW) {
        const int s0 = s0n, s1 = s1n;
        { const int rn_ = row + nb * NW; if (rn_ < NTOK) { s0n = p.tokslot[rn_ * 2]; s1n = p.tokslot[rn_ * 2 + 1]; } }
        float v[16]; float ss = 0.f;
#pragma unroll
        for (int i = 0; i < 4; i++) {
            const int c = i * 256 + lane * 4;
            const float4 t = *(const float4*)&p.x1[(size_t)row * D_ + c];
            const uint2 a = *(const uint2*)&p.ybuf[(size_t)s0 * D_ + c];
            const uint2 bq = *(const uint2*)&p.ybuf[(size_t)s1 * D_ + c];
            v[4 * i]     = t.x + __uint_as_float(a.x << 16) + __uint_as_float(bq.x << 16);
            v[4 * i + 1] = t.y + __uint_as_float(a.x & 0xFFFF0000u) + __uint_as_float(bq.x & 0xFFFF0000u);
            v[4 * i + 2] = t.z + __uint_as_float(a.y << 16) + __uint_as_float(bq.y << 16);
            v[4 * i + 3] = t.w + __uint_as_float(a.y & 0xFFFF0000u) + __uint_as_float(bq.y & 0xFFFF0000u);
            ss += v[4 * i] * v[4 * i] + v[4 * i + 1] * v[4 * i + 1] + v[4 * i + 2] * v[4 * i + 2] + v[4 * i + 3] * v[4 * i + 3];
        }
        ss = wave_sum(ss);
        const float rs = rsqrtf(ss * (1.f / D_) + 1e-6f);
#pragma unroll
        for (int i = 0; i < 4; i++) {
            const int c = i * 256 + lane * 4;
            const float4 g = gfin[i];
            float4 o; o.x = v[4 * i] * rs * g.x; o.y = v[4 * i + 1] * rs * g.y; o.z = v[4 * i + 2] * rs * g.z; o.w = v[4 * i + 3] * rs * g.w;
            *(float4*)&p.out[(size_t)row * D_ + c] = o;
        }
    }
}

#define XB_TMO      128
#define XB_XCNT(j)  (256  + 64 * (j))
#define XB_XSUB(j)  (1280 + 64 * (j))
#define XB_XGEN(j)  (2304 + 64 * (j))
#define XB_TOP      3328
#define XB_TOPGEN   3392
#define XCD_BAR_WORDS 3456
#define XB_SPIN_CAP (1u << 18)
#define LAS __attribute__((address_space(3)))

__device__ __forceinline__ unsigned xb_ld(unsigned* p)              { return __hip_atomic_load(p, __ATOMIC_RELAXED, __HIP_MEMORY_SCOPE_AGENT); }
__device__ __forceinline__ unsigned xb_add(unsigned* p, unsigned v) { return __hip_atomic_fetch_add(p, v, __ATOMIC_RELAXED, __HIP_MEMORY_SCOPE_AGENT); }
__device__ __forceinline__ unsigned xb_xcc_id() { return (unsigned)__builtin_amdgcn_s_getreg((3 << 11) | 20) & 0xFu; }
#define XB_SPIN(cond, bar) do { unsigned _sp = 0; while (cond) { __builtin_amdgcn_s_sleep(1); \
    if ((++_sp & 255u) == 0u) { if (xb_ld(&(bar)[XB_TMO])) break; if (_sp > XB_SPIN_CAP) { atomicAdd(&(bar)[XB_TMO], 1u); break; } } } } while (0)

struct XcdBarrier {
    unsigned* bar; unsigned x;
    volatile LAS unsigned* st;
};

__device__ __forceinline__ XcdBarrier xcd_barrier_post(unsigned* bar, volatile LAS unsigned* st) {
    XcdBarrier b; b.bar = bar; b.x = xb_xcc_id(); b.st = st;
    if (threadIdx.x == 0) (void)xb_add(&bar[XB_XCNT(b.x)], 1u);
    return b;
}
__device__ __forceinline__ void xcd_barrier_complete(unsigned* bar, unsigned x, unsigned& nloc, unsigned& nx) {
    const unsigned G = gridDim.x * gridDim.y * gridDim.z;
    unsigned sum, cnt, mine, sp = 0u;
    for (;;) {
        sum = 0u; cnt = 0u; mine = 0u;
#pragma unroll
        for (unsigned j = 0; j < 16; ++j) { const unsigned c = xb_ld(&bar[XB_XCNT(j)]); sum += c; cnt += (c > 0u) ? 1u : 0u; mine = (j == x) ? c : mine; }
        if (sum == G) break;
        __builtin_amdgcn_s_sleep(1);
        if ((++sp & 255u) == 0u) { if (xb_ld(&bar[XB_TMO])) break; if (sp > XB_SPIN_CAP) { atomicAdd(&bar[XB_TMO], 1u); break; } }
    }
    nloc = mine > 0u ? mine : 1u; nx = cnt > 0u ? cnt : 1u;
}

__device__ __forceinline__ void xcd_barrier(const XcdBarrier& b) {
    asm volatile("s_waitcnt vmcnt(0)" ::: "memory");
    __syncthreads();
    if (threadIdx.x == 0) {
        unsigned* bar = b.bar;
        __builtin_amdgcn_s_waitcnt(0);
        unsigned nloc = b.st[0], nx = b.st[1];
        if (nloc == 0u) { xcd_barrier_complete(bar, b.x, nloc, nx); b.st[0] = nloc; b.st[1] = nx; }
        const unsigned old = xb_add(&bar[XB_XSUB(b.x)], 1u);
        const unsigned gen = old / nloc;
        if (old + 1u == (gen + 1u) * nloc) {
            __builtin_amdgcn_fence(__ATOMIC_RELEASE, "agent");
            asm volatile("s_waitcnt vmcnt(0)" ::: "memory");
            const unsigned og = xb_add(&bar[XB_TOP], 1u);
            const unsigned tg = og / nx;
            if (og + 1u == (tg + 1u) * nx) xb_add(&bar[XB_TOPGEN], 1u);
            else XB_SPIN(xb_ld(&bar[XB_TOPGEN]) == tg, bar);
            __builtin_amdgcn_fence(__ATOMIC_ACQUIRE, "agent");
            xb_add(&bar[XB_XGEN(b.x)], 1u);
            asm volatile("s_waitcnt vmcnt(0)" ::: "memory");
        } else {
            XB_SPIN(xb_ld(&bar[XB_XGEN(b.x)]) == gen, bar);
            __builtin_amdgcn_fence(__ATOMIC_ACQUIRE, "agent");
            asm volatile("s_waitcnt vmcnt(0)" ::: "memory");
        }
    }
    __syncthreads();
}

template <int PH>
__device__ __forceinline__ void run_phase(const P& p, int bid, int nb, char* smem) {
    if constexpr (PH == 0) ph_prologue(p, bid, nb, smem);
    if constexpr (PH == 1) ph_inproj(p, bid, nb, smem);
    if constexpr (PH == 2) { ph_compress(p, bid, nb, smem); __syncthreads(); ph_rwkv_chunk(p, bid, nb, smem); }
    if constexpr (PH == 3) {
        if (bid < SCAN_BLOCKS) ph_rwkv_seq(p, bid, SCAN_BLOCKS, smem);
        ph_nsa(p, bid - SCAN_BLOCKS, nb - SCAN_BLOCKS, smem);
    }
    if constexpr (PH == 12) ph_rwkv_out(p, bid, nb, smem);
    if constexpr (PH == 4) ph_merge(p, bid, nb, smem);
    if constexpr (PH == 5) ph_outproj(p, bid, nb, smem);
    if constexpr (PH == 6) ph_route(p, bid, nb, smem);
    if constexpr (PH == 7) ph_scatter(p, bid, nb, smem);
    if constexpr (PH == 9) ph_moe1(p, bid, nb, smem);
    if constexpr (PH == 10) ph_moe2(p, bid, nb, smem);
    if constexpr (PH == 11) ph_final(p, bid, nb, smem);
}

template <int PH>
__global__ void __launch_bounds__(NT) kph(P p) {
    extern __shared__ __attribute__((aligned(16))) char smem[];
    run_phase<PH>(p, blockIdx.x, gridDim.x, smem);
}

__global__ void __launch_bounds__(NT, 2) mega(P p) {
    extern __shared__ __attribute__((aligned(16))) char smem[];
    volatile LAS unsigned* st = (volatile LAS unsigned*)(smem + SMEM_BYTES - 16);
    if (threadIdx.x == 0) { st[0] = 0u; st[1] = 0u; st[2] = 0u; st[3] = 0u; }
    __syncthreads();
    XcdBarrier bar = xcd_barrier_post(p.bar, st);
    const int bid = blockIdx.x, nb = gridDim.x;
#define RUNP(N, BAR) { unsigned long long t0_ = 0; if ((TPROBE >> N) & 1) t0_ = __builtin_amdgcn_s_memrealtime(); run_phase<N>(p, bid, nb, smem); \
        unsigned long long tw_ = 0; if (((TPROBE >> N) & 1) && TPSEL) tw_ = __builtin_amdgcn_s_memrealtime() - t0_; if (BAR) xcd_barrier(bar); \
        if ((TPROBE >> N) & 1) { const unsigned long long t1_ = __builtin_amdgcn_s_memrealtime(); const unsigned long long dt_ = TPSEL ? tw_ : t1_ - t0_; \
            if (!TPSEL || (TPSEL == 1 ? (bid < SCAN_BLOCKS) : (bid >= SCAN_BLOCKS))) while (__builtin_amdgcn_s_memrealtime() - t1_ < dt_) __builtin_amdgcn_s_sleep(8); if (TPSEL) xcd_barrier(bar); } }
    RUNP(0, 1) RUNP(1, 1) RUNP(2, 1) RUNP(3, 1) RUNP(12, 1) RUNP(4, 1) RUNP(5, 1) RUNP(6, 1) RUNP(7, 1) RUNP(9, 0) RUNP(10, 1) RUNP(11, 0)
}

extern "C" void kernel_launch(void* const* d_in, const int* in_sizes, int n_in,
                              void* d_out, int out_size, void* d_ws, size_t ws_size,
                              hipStream_t stream) {
    P p{};
    p.x = (const float*)d_in[0]; p.pos = (const int*)d_in[1]; p.g_mix = (const float*)d_in[2]; p.w_in = (const float*)d_in[3];
    p.pe_k = (const float*)d_in[4]; p.w1_k = (const float*)d_in[5]; p.b1_k = (const float*)d_in[6]; p.w2_k = (const float*)d_in[7]; p.b2_k = (const float*)d_in[8];
    p.pe_v = (const float*)d_in[9]; p.w1_v = (const float*)d_in[10]; p.b1_v = (const float*)d_in[11]; p.w2_v = (const float*)d_in[12]; p.b2_v = (const float*)d_in[13];
    p.mu = (const float*)d_in[14]; p.w0 = (const float*)d_in[15]; p.w2 = (const float*)d_in[16]; p.a0 = (const float*)d_in[17]; p.a2 = (const float*)d_in[18];
    p.g2 = (const float*)d_in[19]; p.k_k = (const float*)d_in[20]; p.k_a = (const float*)d_in[21]; p.r_k = (const float*)d_in[22]; p.ln_w = (const float*)d_in[23]; p.ln_b = (const float*)d_in[24];
    p.wpa = (const float*)d_in[25]; p.wpb = (const float*)d_in[26]; p.wout = (const float*)d_in[27]; p.g_ffn = (const float*)d_in[28];
    p.w_grp = (const float*)d_in[29]; p.b_grp = (const float*)d_in[30]; p.w_exp = (const float*)d_in[31]; p.b_exp = (const float*)d_in[32];
    p.e_w1 = (const float*)d_in[33]; p.e_w3 = (const float*)d_in[34]; p.e_w2 = (const float*)d_in[35]; p.g_final = (const float*)d_in[36];
    p.out = (float*)d_out;
    char* ws = (char*)d_ws;
    const size_t MiB = 1ull << 20;
    p.hbuf = (u16*)(ws + 0 * MiB);
    p.q    = (u16*)(ws + 64 * MiB);
    p.kc   = (u16*)(ws + 96 * MiB);  p.vc   = (u16*)(ws + 104 * MiB);
    p.ksl  = (u16*)(ws + 112 * MiB); p.vslT = (u16*)(ws + 120 * MiB);
    p.kwn  = (u16*)(ws + 128 * MiB); p.vwnT = (u16*)(ws + 136 * MiB);
    p.nsag = (float*)(ws + 144 * MiB);
    p.kcb  = (u16*)(ws + 148 * MiB); p.vcT  = (u16*)(ws + 149 * MiB);
    p.prw  = (u16*)(ws + 160 * MiB);
    p.cdat = (u16*)(ws + 272 * MiB);
    p.bon  = (float*)(ws + 150 * MiB);
    p.w2T  = (u16*)(ws + 151 * MiB); p.a2T = p.w2T + 512 * 64; p.g2T = p.a2T + 512 * 64;
    p.cw1Tk = (u16*)(ws + 152 * MiB); p.cw1Tv = (u16*)(ws + 153 * MiB);
    p.cw2Tk = (u16*)(ws + 154 * MiB); p.cw2Tv = p.cw2Tk + 128 * 256;
    p.chid = (u16*)(ws + 155 * MiB);
    p.xact = (u16*)(ws + 488 * MiB);
    p.oa   = (u16*)(ws + 400 * MiB);
    p.ob   = (u16*)(ws + 432 * MiB);
    p.merged = (u16*)(ws + 64 * MiB);
    p.x1   = (float*)(ws + 160 * MiB);
    char* rt = ws + 288 * MiB;
    p.tok_e = (int*)(rt);                        rt += NTOK * 2 * 4;
    p.tok_gate = (float*)(rt);                   rt += NTOK * 2 * 4;
    p.tokslot = (int*)(rt);                      rt += NTOK * 2 * 4;
    p.list_tok = (int*)(rt);                     rt += NTOK * 2 * 4;
    p.list_gate = (float*)(rt);                  rt += NTOK * 2 * 4;
    p.blk_e = (int*)(rt);                        rt += 2048 * 4;
    p.blk_r0 = (int*)(rt);                       rt += 2048 * 4;
    p.rsb = (float*)(rt);                        rt += NTOK * 4;
    p.hid  = (u16*)(ws + 296 * MiB);
    p.ybuf = (u16*)(ws + 336 * MiB);
    char* misc = ws + 470 * MiB;
    p.counts = (int*)(misc); p.cursor = (int*)(misc + 256); p.offs = (int*)(misc + 512); p.nblk = (int*)(misc + 1024); p.nsactr = (int*)(misc + 2048); p.mdone = (unsigned*)(misc + 8192);
    p.bar = (unsigned*)(ws + 471 * MiB);
    p.cb1k = (float*)(misc + 65536); p.cb1v = p.cb1k + 256;
    {
        char* wa = ws + 472 * MiB;
        p.winT = (u16*)wa;  wa += (size_t)3328 * 1024 * 2;
        p.wgT  = (u16*)wa;  wa += (size_t)2048 * 1024 * 2;
        p.wpaT = (u16*)wa;  wa += (size_t)1024 * 512 * 2;
        p.wpbT = (u16*)wa;  wa += (size_t)1024 * 512 * 2;
        p.woutT = (u16*)wa; wa += (size_t)1024 * 1024 * 2;
        p.ew1T = (u16*)(ws + 64 * MiB);  p.ew3T = (u16*)(ws + 80 * MiB);  p.ew2T = (u16*)(ws + 96 * MiB);
    }
    if (ws_size < (size_t)505 * MiB) return;

#if MEGA
    {
        static int mgrid = 0;
        if (mgrid == 0) {
            int dev = 0, cus = 0, per_cu = 0;
            hipGetDevice(&dev);
            hipDeviceGetAttribute(&cus, hipDeviceAttributeMultiprocessorCount, dev);
            hipFuncSetAttribute((const void*)mega, hipFuncAttributeMaxDynamicSharedMemorySize, SMEM_BYTES);
            hipOccupancyMaxActiveBlocksPerMultiprocessor(&per_cu, (const void*)mega, NT, SMEM_BYTES);
            (void)hipGetLastError();
            mgrid = cus;
        }
        hipMemsetAsync(p.bar, 0, XCD_BAR_WORDS * sizeof(unsigned) + 512 * sizeof(float), stream);
        mega<<<mgrid, NT, SMEM_BYTES, stream>>>(p);
        return;
    }
#else
    const int grid = 512;
    hipMemsetAsync(p.bar, 0, XCD_BAR_WORDS * sizeof(unsigned) + 512 * sizeof(float), stream);
    hipFuncSetAttribute((const void*)kph<0>, hipFuncAttributeMaxDynamicSharedMemorySize, SMEM_BYTES);
    hipFuncSetAttribute((const void*)kph<1>, hipFuncAttributeMaxDynamicSharedMemorySize, SMEM_BYTES);
    hipFuncSetAttribute((const void*)kph<2>, hipFuncAttributeMaxDynamicSharedMemorySize, SMEM_BYTES);
    hipFuncSetAttribute((const void*)kph<3>, hipFuncAttributeMaxDynamicSharedMemorySize, SMEM_BYTES);
    hipFuncSetAttribute((const void*)kph<4>, hipFuncAttributeMaxDynamicSharedMemorySize, SMEM_BYTES);
    hipFuncSetAttribute((const void*)kph<5>, hipFuncAttributeMaxDynamicSharedMemorySize, SMEM_BYTES);
    hipFuncSetAttribute((const void*)kph<6>, hipFuncAttributeMaxDynamicSharedMemorySize, SMEM_BYTES);
    hipFuncSetAttribute((const void*)kph<7>, hipFuncAttributeMaxDynamicSharedMemorySize, SMEM_BYTES);
    hipFuncSetAttribute((const void*)kph<8>, hipFuncAttributeMaxDynamicSharedMemorySize, SMEM_BYTES);
    hipFuncSetAttribute((const void*)kph<9>, hipFuncAttributeMaxDynamicSharedMemorySize, SMEM_BYTES);
    hipFuncSetAttribute((const void*)kph<10>, hipFuncAttributeMaxDynamicSharedMemorySize, SMEM_BYTES);
    hipFuncSetAttribute((const void*)kph<11>, hipFuncAttributeMaxDynamicSharedMemorySize, SMEM_BYTES);
    kph<0><<<grid, NT, SMEM_BYTES, stream>>>(p);
    kph<1><<<grid, NT, SMEM_BYTES, stream>>>(p);
    kph<2><<<grid, NT, SMEM_BYTES, stream>>>(p);
    kph<3><<<grid, NT, SMEM_BYTES, stream>>>(p);
    kph<12><<<grid, NT, SMEM_BYTES, stream>>>(p);
    kph<4><<<grid, NT, SMEM_BYTES, stream>>>(p);
    kph<5><<<grid, NT, SMEM_BYTES, stream>>>(p);
    kph<6><<<grid, NT, SMEM_BYTES, stream>>>(p);
    kph<7><<<grid, NT, SMEM_BYTES, stream>>>(p);
    kph<8><<<grid, NT, SMEM_BYTES, stream>>>(p);
    kph<9><<<grid, NT, SMEM_BYTES, stream>>>(p);
    kph<10><<<grid, NT, SMEM_BYTES, stream>>>(p);
    kph<11><<<grid, NT, SMEM_BYTES, stream>>>(p);
#endif
}
```
